# Optimizing an MI355X kernel written in HIP

```python
import math
import jax, jax.numpy as jnp
from jax import lax
import numpy as np

D_MODEL = 1024
BATCH = 8
SEQ = 4096
DEPTH = 4

MIX_HALF = D_MODEL // 2
HEAD_DIM = 64
ROT_DIMS = HEAD_DIM // 4
ROPE_THETA = 500000.0
GLA_DK = 64
GLA_DV = 128
N_GLA_HEADS = MIX_HALF // GLA_DV
GLA_GATE_RANK = 16
GLA_GATE_NORMALIZER = 16.0
GLA_CHUNK = 64
N_SWA_HEADS = MIX_HALF // HEAD_DIM
N_SWA_KV_HEADS = 2
WINDOW = 128
N_DIFF_HEADS = MIX_HALF // (2 * HEAD_DIM)
Q_BLOCK = 128
HGRN_EXPAND = 128
N_HGRN_HEADS = MIX_HALF // HGRN_EXPAND
HGRN_DV = MIX_HALF // N_HGRN_HEADS
HGRN_CHUNK = 64
D_FF = 2816
CONV_WIDTH = 3
N_EVEN = (DEPTH + 1) // 2
N_ODD = DEPTH // 2
EVEN_SPLITS = (N_GLA_HEADS * GLA_DK, N_GLA_HEADS * GLA_DK, N_GLA_HEADS * GLA_DV, N_GLA_HEADS * GLA_DV,
               GLA_GATE_RANK, N_SWA_HEADS * HEAD_DIM, N_SWA_KV_HEADS * HEAD_DIM, N_SWA_KV_HEADS * HEAD_DIM)
ODD_SPLITS = (N_DIFF_HEADS * 2 * HEAD_DIM, N_DIFF_HEADS * 2 * HEAD_DIM, N_DIFF_HEADS * 2 * HEAD_DIM,
              N_HGRN_HEADS * HGRN_EXPAND, N_HGRN_HEADS * HGRN_EXPAND, N_HGRN_HEADS * HGRN_DV, N_HGRN_HEADS * HGRN_DV)

kernel_name = 'hybrid_gla_swa_diff_hgrn2_convffn_adaln'

F32 = jnp.float32


def rms_norm(x, w, eps=1e-6):
    x32 = x.astype(F32)
    y = x32 * lax.rsqrt(jnp.mean(x32 * x32, axis=-1, keepdims=True) + eps)
    return (y * w.astype(F32)).astype(x.dtype)


def split_cols(t, sizes):
    idx = np.cumsum(np.array(sizes))[:-1].tolist()
    return jnp.split(t, idx, axis=-1)


def rope_tables(positions):
    inv_freq = ROPE_THETA ** (-jnp.arange(0, ROT_DIMS, 2, dtype=F32) / ROT_DIMS)
    ang = positions.astype(F32)[..., None] * inv_freq
    return jnp.cos(ang), jnp.sin(ang)


def apply_partial_rope(x, cos, sin):
    half = ROT_DIMS // 2
    shape = cos.shape[:2] + (1,) * (x.ndim - 3) + (half,)
    cs = cos.reshape(shape).astype(x.dtype)
    sn = sin.reshape(shape).astype(x.dtype)
    x1 = x[..., :half]
    x2 = x[..., half:ROT_DIMS]
    return jnp.concatenate([x1 * cs - x2 * sn, x2 * cs + x1 * sn, x[..., ROT_DIMS:]], axis=-1)


def gated_linear_chunked(q, k, v, log_g, chunk):
    bsz, seq, nh, dk = q.shape
    dv = v.shape[-1]
    n = seq // chunk

    def to_chunks(t):
        return t.reshape(bsz, n, chunk, nh, t.shape[-1]).transpose(1, 0, 3, 2, 4)

    qc, kc, vc = to_chunks(q), to_chunks(k), to_chunks(v)
    gc = to_chunks(log_g.astype(F32))
    causal = jnp.tril(jnp.ones((chunk, chunk), dtype=bool))[:, :, None]

    def step(state, inp):
        qb, kb, vb, gb = inp
        qb, kb, vb = qb.astype(F32), kb.astype(F32), vb.astype(F32)
        bcum = lax.cumsum(gb, axis=2)
        diff = bcum[:, :, :, None, :] - bcum[:, :, None, :, :]
        decay = jnp.exp(jnp.where(causal, diff, -jnp.inf))
        scores = jnp.einsum('bhik,bhjk,bhijk->bhij', qb, kb, decay)
        intra = jnp.einsum('bhij,bhjv->bhiv', scores, vb)
        inter = jnp.einsum('bhik,bhkv->bhiv', qb * jnp.exp(bcum), state)
        total = bcum[:, :, -1, :]
        state = state * jnp.exp(total)[..., None] + jnp.einsum(
            'bhjk,bhjv->bhkv', kb * jnp.exp(total[:, :, None, :] - bcum), vb)
        return state, intra + inter

    state0 = jnp.zeros((bsz, nh, dk, dv), F32)
    _, out = lax.scan(step, state0, (qc, kc, vc, gc))
    return out.transpose(1, 0, 3, 2, 4).reshape(bsz, seq, nh, dv).astype(v.dtype)


def sliding_window_sink_attention(q, k, v, sinks):
    bsz, seq, hq, d = q.shape
    hkv = k.shape[2]
    grp = hq // hkv
    nb = seq // WINDOW
    qb = q.reshape(bsz, nb, WINDOW, hkv, grp, d)

    def with_prev(t):
        tb = t.reshape(bsz, nb, WINDOW, hkv, d)
        prev = jnp.concatenate([jnp.zeros_like(tb[:, :1]), tb[:, :-1]], axis=1)
        return jnp.concatenate([prev, tb], axis=2)

    kk, vv = with_prev(k), with_prev(v)
    s = jnp.einsum('bnqhgd,bnkhd->bnhgqk', qb, kk).astype(F32) * (d ** -0.5)
    qi = jnp.arange(WINDOW)[:, None] + WINDOW
    kj = jnp.arange(2 * WINDOW)[None, :]
    rel = qi - kj
    band = (rel >= 0) & (rel < WINDOW)
    blk = jnp.arange(nb)[:, None, None]
    mask = band[None] & ((blk > 0) | (kj >= WINDOW)[None])
    s = jnp.where(mask[None, :, None, None], s, -jnp.inf)
    sink = sinks.astype(F32).reshape(1, 1, hkv, grp, 1, 1)
    m = jnp.maximum(jnp.max(s, axis=-1, keepdims=True), sink)
    p = jnp.exp(s - m)
    p = p / (jnp.sum(p, axis=-1, keepdims=True) + jnp.exp(sink - m))
    o = jnp.einsum('bnhgqk,bnkhd->bnqhgd', p.astype(v.dtype), vv)
    return o.reshape(bsz, seq, hq, d)


def differential_attention(q, k, v, lam):
    bsz, seq, nh, _, d = q.shape
    nb = seq // Q_BLOCK
    qblocks = q.reshape(bsz, nb, Q_BLOCK, nh, 2, d).transpose(1, 0, 2, 3, 4, 5)
    kpos = jnp.arange(seq)
    scale = d ** -0.5

    def one_block(args):
        qb, n = args
        s = jnp.einsum('bqhmd,bkhmd->bhmqk', qb, k).astype(F32) * scale
        qpos = n * Q_BLOCK + jnp.arange(Q_BLOCK)
        s = jnp.where(kpos[None, :] <= qpos[:, None], s, -jnp.inf)
        p = jax.nn.softmax(s, axis=-1)
        a = p[:, :, 0] - lam * p[:, :, 1]
        return jnp.einsum('bhqk,bkhe->bqhe', a.astype(v.dtype), v)

    out = lax.map(one_block, (qblocks, jnp.arange(nb)))
    return out.transpose(1, 0, 2, 3, 4).reshape(bsz, seq, nh, v.shape[-1])


def even_mixer(h, w_in, gla_gate_w, gla_gate_b, gla_norm_w, swa_sinks, w_out, cos, sin):
    bsz, seq, _ = h.shape
    gq, gk, gv, gr, glr, sq, sk, sv = split_cols(h @ w_in, EVEN_SPLITS)
    gq = gq.reshape(bsz, seq, N_GLA_HEADS, GLA_DK) * (GLA_DK ** -0.5)
    gk = gk.reshape(bsz, seq, N_GLA_HEADS, GLA_DK)
    gv = gv.reshape(bsz, seq, N_GLA_HEADS, GLA_DV)
    log_a = jax.nn.log_sigmoid((glr @ gla_gate_w + gla_gate_b).astype(F32)) / GLA_GATE_NORMALIZER
    log_a = log_a.reshape(bsz, seq, N_GLA_HEADS, GLA_DK)
    o_gla = gated_linear_chunked(gq, gk, gv, log_a, GLA_CHUNK)
    o_gla = rms_norm(o_gla, gla_norm_w).reshape(bsz, seq, -1) * jax.nn.silu(gr)
    sq = apply_partial_rope(sq.reshape(bsz, seq, N_SWA_HEADS, HEAD_DIM), cos, sin)
    sk = apply_partial_rope(sk.reshape(bsz, seq, N_SWA_KV_HEADS, HEAD_DIM), cos, sin)
    sv = sv.reshape(bsz, seq, N_SWA_KV_HEADS, HEAD_DIM)
    o_swa = sliding_window_sink_attention(sq, sk, sv, swa_sinks).reshape(bsz, seq, -1)
    return jnp.concatenate([o_gla, o_swa], axis=-1) @ w_out


def odd_mixer(h, w_in, diff_lambda, diff_norm_w, lb, hgrn_norm_w, w_out, cos, sin, lam_init):
    bsz, seq, _ = h.shape
    dq, dk, dv, hq, hf, hi, hg = split_cols(h @ w_in, ODD_SPLITS)
    dq = apply_partial_rope(dq.reshape(bsz, seq, N_DIFF_HEADS, 2, HEAD_DIM), cos, sin)
    dk = apply_partial_rope(dk.reshape(bsz, seq, N_DIFF_HEADS, 2, HEAD_DIM), cos, sin)
    dv = dv.reshape(bsz, seq, N_DIFF_HEADS, 2 * HEAD_DIM)
    lv = diff_lambda.astype(F32)
    lam = jnp.exp(jnp.sum(lv[0] * lv[1])) - jnp.exp(jnp.sum(lv[2] * lv[3])) + lam_init
    o_diff = differential_attention(dq, dk, dv, lam)
    o_diff = rms_norm(o_diff, diff_norm_w).reshape(bsz, seq, -1) * (1.0 - lam_init)
    hq = (jax.nn.silu(hq) * (HGRN_EXPAND ** -0.5)).reshape(bsz, seq, N_HGRN_HEADS, HGRN_EXPAND)
    z = hf.astype(F32)
    log_f = jnp.logaddexp(jnp.log(lb), jnp.log1p(-lb) + jax.nn.log_sigmoid(z))
    k_in = (1.0 - lb) * jax.nn.sigmoid(-z)
    log_f = log_f.reshape(bsz, seq, N_HGRN_HEADS, HGRN_EXPAND)
    k_in = k_in.reshape(bsz, seq, N_HGRN_HEADS, HGRN_EXPAND)
    hi = hi.reshape(bsz, seq, N_HGRN_HEADS, HGRN_DV)
    o_h = gated_linear_chunked(hq, k_in, hi, log_f, HGRN_CHUNK)
    o_h = rms_norm(o_h, hgrn_norm_w).reshape(bsz, seq, -1) * jax.nn.silu(hg)
    return jnp.concatenate([o_diff, o_h], axis=-1) @ w_out


def conv_ffn(h, w_in, conv_w, conv_b, w_out):
    a, u = jnp.split(h @ w_in, 2, axis=-1)
    ap = jnp.pad(a, ((0, 0), (CONV_WIDTH - 1, 0), (0, 0)))
    a = ap[:, :-2] * conv_w[0] + ap[:, 1:-1] * conv_w[1] + ap[:, 2:] * conv_w[2] + conv_b
    return (jax.nn.silu(a) * u) @ w_out


def setup_inputs(seed: int = 0) -> dict:
    key = jax.random.key(seed)
    ks = jax.random.split(key, 32)

    def nrm(k, shape, s):
        return jax.random.normal(k, shape, F32) * s

    offsets = jax.random.randint(ks[2], (BATCH, 1), 0, 4096, dtype=jnp.int32)
    return {
        'x': nrm(ks[0], (BATCH, SEQ, D_MODEL), 1.0),
        'c': nrm(ks[1], (BATCH, D_MODEL), 1.0),
        'positions': offsets + jnp.arange(SEQ, dtype=jnp.int32)[None, :],
        'mod_w': nrm(ks[3], (DEPTH, D_MODEL, 6 * D_MODEL), 0.5 * D_MODEL ** -0.5),
        'mod_b': nrm(ks[4], (DEPTH, 6 * D_MODEL), 0.01),
        'norm_mix_w': 1.0 + nrm(ks[5], (DEPTH, D_MODEL), 0.02),
        'norm_ffn_w': 1.0 + nrm(ks[6], (DEPTH, D_MODEL), 0.02),
        'ev_w_in': nrm(ks[7], (N_EVEN, D_MODEL, sum(EVEN_SPLITS)), D_MODEL ** -0.5),
        'gla_gate_w': nrm(ks[8], (N_EVEN, GLA_GATE_RANK, N_GLA_HEADS * GLA_DK), GLA_GATE_RANK ** -0.5),
        'gla_gate_b': nrm(ks[9], (N_EVEN, N_GLA_HEADS * GLA_DK), 0.01),
        'gla_norm_w': 1.0 + nrm(ks[10], (N_EVEN, GLA_DV), 0.02),
        'swa_sinks': nrm(ks[11], (N_EVEN, N_SWA_HEADS), 1.0),
        'ev_w_out': nrm(ks[12], (N_EVEN, D_MODEL, D_MODEL), D_MODEL ** -0.5),
        'od_w_in': nrm(ks[13], (N_ODD, D_MODEL, sum(ODD_SPLITS)), D_MODEL ** -0.5),
        'diff_lambda': nrm(ks[14], (N_ODD, 4, HEAD_DIM), 0.1),
        'diff_norm_w': 1.0 + nrm(ks[15], (N_ODD, 2 * HEAD_DIM), 0.02),
        'hgrn_lb_logits': nrm(ks[16], (N_ODD, N_HGRN_HEADS * HGRN_EXPAND), 1.0),
        'hgrn_norm_w': 1.0 + nrm(ks[17], (N_ODD, HGRN_DV), 0.02),
        'od_w_out': nrm(ks[18], (N_ODD, D_MODEL, D_MODEL), D_MODEL ** -0.5),
        'ffn_w_in': nrm(ks[19], (DEPTH, D_MODEL, 2 * D_FF), D_MODEL ** -0.5),
        'ffn_conv_w': nrm(ks[20], (DEPTH, CONV_WIDTH, D_FF), CONV_WIDTH ** -0.5),
        'ffn_conv_b': nrm(ks[21], (DEPTH, D_FF), 0.01),
        'ffn_w_out': nrm(ks[22], (DEPTH, D_FF, D_MODEL), D_FF ** -0.5),
        'final_norm_w': 1.0 + nrm(ks[23], (D_MODEL,), 0.02),
    }


def reference(x, c, positions, mod_w, mod_b, norm_mix_w, norm_ffn_w, ev_w_in, gla_gate_w, gla_gate_b,
              gla_norm_w, swa_sinks, ev_w_out, od_w_in, diff_lambda, diff_norm_w, hgrn_lb_logits,
              hgrn_norm_w, od_w_out, ffn_w_in, ffn_conv_w, ffn_conv_b, ffn_w_out, final_norm_w):
    cos, sin = rope_tables(positions)
    lbs = lax.cumsum(jax.nn.softmax(hgrn_lb_logits.astype(F32), axis=0), axis=0)
    lbs = lbs - lbs[0:1]
    c_act = jax.nn.silu(c)
    for l in range(DEPTH):
        mod = (c_act @ mod_w[l] + mod_b[l])[:, None, :]
        sh1, sc1, g1, sh2, sc2, g2 = jnp.split(mod, 6, axis=-1)
        h = rms_norm(x, norm_mix_w[l]) * (1.0 + sc1) + sh1
        j = l // 2
        if l % 2 == 0:
            y = even_mixer(h, ev_w_in[j], gla_gate_w[j], gla_gate_b[j], gla_norm_w[j], swa_sinks[j],
                           ev_w_out[j], cos, sin)
        else:
            lam_init = 0.8 - 0.6 * math.exp(-0.3 * l)
            y = odd_mixer(h, od_w_in[j], diff_lambda[j], diff_norm_w[j], lbs[j], hgrn_norm_w[j],
                          od_w_out[j], cos, sin, lam_init)
        x = x + g1 * y
        h = rms_norm(x, norm_ffn_w[l]) * (1.0 + sc2) + sh2
        x = x + g2 * conv_ffn(h, ffn_w_in[l], ffn_conv_w[l], ffn_conv_b[l], ffn_w_out[l])
    return rms_norm(x, final_norm_w)
```

```cpp
#include <hip/hip_runtime.h>
#include <hip/hip_cooperative_groups.h>
#include <hip/hip_bf16.h>
#include <cstdio>
#include <cstdint>
#include <cmath>
__device__ __forceinline__ int otid_() { int t = threadIdx.x; asm volatile("" : "+v"(t)); return t; }
namespace pg8 {
#define PG8_LAS __attribute__((address_space(3)))
typedef unsigned short bf16_t;
typedef short bf16x8 __attribute__((ext_vector_type(8)));
typedef float f32x4 __attribute__((ext_vector_type(4)));
typedef unsigned u32x4 __attribute__((ext_vector_type(4)));
constexpr int BM = 256, BK = 64, HALF = 128, HTB = HALF * BK * 2  , STAGE_BYTES = 8 * HTB, NXCD = 8, WGM = 8;

__host__ __device__ __forceinline__ int lds_byte(int r, int c) { const int st = (r >> 4) * 2 + (c >> 5), rr = r & 15, cc = c & 31, ob = rr * 64 + cc * 2; return st * 1024 + (ob ^ (((ob >> 9) & 1) << 5)); }
__host__ __device__ __forceinline__ void stage_rc(int b, int& R, int& C) { const int st = b / 1024, sb = b % 1024, swz = sb ^ (((sb >> 9) & 1) << 5); R = (st >> 1) * 16 + swz / 64; C = (st & 1) * 32 + (swz % 64) / 2; }
__host__ __device__ __forceinline__ int perm32(int rho) { const int n = rho >> 4, i = rho & 15; return 8 * (i >> 2) + 4 * n + (i & 3); }

struct Unit { int pm, pn; };
struct Gemm { const bf16_t* A; const bf16_t* Bt; int M, N, K; };

struct StaticOrder {
    int nM, nN, nwg, G, c;
    __host__ __device__ void init(int M, int N, int G_, int c_) { nM = M / BM; nN = N / BM; nwg = nM * nN; G = G_; c = c_; }
    __host__ __device__ bool next(int i, Unit& u) const {
        const long L = (long)i * G + c; if (L >= nwg) return false;
        int wgid = (int)L; { const int q = nwg / NXCD, r = nwg % NXCD, xcd = wgid % NXCD, off = wgid / NXCD; wgid = (xcd < r ? xcd * (q + 1) : r * (q + 1) + (xcd - r) * q) + off; }
        const int nig = WGM * nN, gid = wgid / nig, fm = gid * WGM, gsz = (nM - fm) < WGM ? (nM - fm) : WGM;
        u.pm = fm + ((wgid % nig) % gsz); u.pn = (wgid % nig) / gsz; return true;
    }
    __device__ __forceinline__ void a_ready(const Unit&) const {}
    __device__ __forceinline__ void done(const Unit&) const {}
};

__device__ __forceinline__ unsigned cvt_pk_bf16(float lo, float hi) { unsigned r; asm volatile("v_cvt_pk_bf16_f32 %0, %1, %2" : "=v"(r) : "v"(lo), "v"(hi)); return r; }
typedef float f32x2 __attribute__((ext_vector_type(2)));
template <class Epi, class Sched, bool ALIGN_EPI = false, bool SP2 = false>
__device__ __forceinline__ void gemm_phase(PG8_LAS unsigned char* lds, const Gemm g, const Sched& S, const Epi& E) {
    const int tid = otid_(), wid = __builtin_amdgcn_readfirstlane(tid >> 6), lane = tid & 63, wr = wid >> 2, wc = wid & 3, fr = lane & 15, fq = lane >> 4;
    const int K = g.K, nt = K / BK;
    unsigned voffA[2], voffB[2];
#pragma unroll
    for (int i = 0; i < 2; ++i) { int R, C; stage_rc(tid * 16 + i * 8192, R, C); const int Rb = Epi::PERM ? ((R & ~31) + perm32(R & 31)) : R;
        voffA[i] = (unsigned)(R * K + C) * 2u; voffB[i] = (unsigned)(Rb * K + C) * 2u; }
    const size_t kstep = (size_t)(BK * 2);
    const size_t hstep = (size_t)HALF * K * 2;
    const size_t tstep = 2 * hstep;
    const unsigned ldsw = (unsigned)wid * 1024u;
    const int aoff = lds_byte(wr * 64 + fr, fq * 8), boff = lds_byte(wc * 32 + fr, fq * 8);
#define PG8_SA(b, h) (((b) * 2 + (h)) * HTB)
#define PG8_SB(b, h) ((4 + (b) * 2 + (h)) * HTB)
#define PG8_STAGE(bufoff, gbase, voff) do { _Pragma("unroll") for (int _i = 0; _i < 2; ++_i) \
        __builtin_amdgcn_global_load_lds((const unsigned*)((const char*)(gbase) + (voff)[_i]), (PG8_LAS unsigned*)(lds + (bufoff) + ldsw + _i * 8192), 16, 0, 0); } while (0)
#define PG8_LDA(dst, b, h) do { _Pragma("unroll") for (int m = 0; m < 4; ++m) _Pragma("unroll") for (int k = 0; k < 2; ++k) dst[m][k] = *(const PG8_LAS bf16x8*)(lds + PG8_SA(b, h) + aoff + m * 2048 + k * 1024); } while (0)
#define PG8_LDB(dst, b, h) do { _Pragma("unroll") for (int n = 0; n < 2; ++n) _Pragma("unroll") for (int k = 0; k < 2; ++k) dst[n][k] = *(const PG8_LAS bf16x8*)(lds + PG8_SB(b, h) + boff + n * 2048 + k * 1024); } while (0)
#define PG8_MMA(ai, bj, At, Bt) do { __builtin_amdgcn_s_setprio(1); _Pragma("unroll") for (int m = 0; m < 4; ++m) _Pragma("unroll") for (int n = 0; n < 2; ++n) _Pragma("unroll") for (int k = 0; k < 2; ++k) \
        acc[ai][bj][m][n] = __builtin_amdgcn_mfma_f32_16x16x32_bf16(Bt[n][k], At[m][k], acc[ai][bj][m][n], 0, 0, 0); __builtin_amdgcn_s_setprio(0); } while (0)
#define PG8_WAIT_V(n) asm volatile("s_waitcnt vmcnt(" #n ")" ::: "memory")
#define PG8_WAIT_L(n) asm volatile("s_waitcnt lgkmcnt(" #n ")" ::: "memory")
#define PG8_BAR __builtin_amdgcn_s_barrier()
#define PG8_SCHED __builtin_amdgcn_sched_barrier(0)
    Unit cur, nxt; int ui = 0;
    if (!S.next(0, cur)) return;
    f32x4 acc[2][2][4][2];
#pragma unroll
    for (int a = 0; a < 2; ++a)
#pragma unroll
        for (int b = 0; b < 2; ++b)
#pragma unroll
            for (int m = 0; m < 4; ++m)
#pragma unroll
                for (int n = 0; n < 2; ++n) acc[a][b][m][n] = (f32x4){0.f, 0.f, 0.f, 0.f};
    bf16x8 At[4][2], B0[2][2], B1[2][2];
    const char* cA = (const char*)g.A + (size_t)cur.pm * tstep; const char* cB = (const char*)g.Bt + (size_t)cur.pn * tstep;
    S.a_ready(cur);
    if constexpr (SP2) {
        PG8_STAGE(PG8_SB(0, 0), cB, voffB); PG8_STAGE(PG8_SB(0, 1), cB + hstep, voffB); PG8_STAGE(PG8_SA(0, 0), cA, voffA); PG8_STAGE(PG8_SA(0, 1), cA + hstep, voffA);
        if (wr == 1) PG8_BAR;
        PG8_WAIT_V(2); PG8_BAR;
        PG8_STAGE(PG8_SB(1, 0), cB + kstep, voffB); PG8_STAGE(PG8_SA(1, 0), cA + kstep, voffA); PG8_STAGE(PG8_SB(1, 1), cB + hstep + kstep, voffB);
        PG8_WAIT_V(6); PG8_BAR;
    } else {
        PG8_STAGE(PG8_SB(0, 0), cB, voffB); PG8_STAGE(PG8_SA(0, 0), cA, voffA); PG8_STAGE(PG8_SB(0, 1), cB + hstep, voffB); PG8_STAGE(PG8_SA(0, 1), cA + hstep, voffA);
        if (wr == 1) PG8_BAR;
        PG8_WAIT_V(4); PG8_BAR;
        PG8_STAGE(PG8_SB(1, 0), cB + kstep, voffB); PG8_STAGE(PG8_SA(1, 0), cA + kstep, voffA); PG8_STAGE(PG8_SB(1, 1), cB + hstep + kstep, voffB);
        PG8_WAIT_V(6); PG8_BAR;
    }
    for (;;) {
        const bool has_next = S.next(ui + 1, nxt);
        const char* nA = has_next ? (const char*)g.A + (size_t)nxt.pm * tstep : cA; const char* nB = has_next ? (const char*)g.Bt + (size_t)nxt.pn * tstep : cB;
        for (int t = 0; t < nt; t += 2) {
            const bool last = (t == nt - 2);
            const char* a1 = cA + (size_t)(t + 1) * kstep;
            const char* a2 = last ? nA : cA + (size_t)(t + 2) * kstep; const char* b2 = last ? nB : cB + (size_t)(t + 2) * kstep;
            const char* a3 = a2 + kstep; const char* b3 = b2 + kstep;
            if (last && has_next) S.a_ready(nxt);
            if constexpr (SP2) {
            PG8_LDB(B0, 0, 0); PG8_LDB(B1, 0, 1); PG8_SCHED; PG8_LDA(At, 0, 0); PG8_STAGE(PG8_SA(1, 1), a1 + hstep, voffA);
            PG8_WAIT_V(8); PG8_WAIT_L(0); PG8_BAR; PG8_MMA(0, 0, At, B0); PG8_MMA(0, 1, At, B1); PG8_BAR; PG8_SCHED;
            PG8_LDA(At, 0, 1); PG8_STAGE(PG8_SB(0, 0), b2, voffB); PG8_STAGE(PG8_SB(0, 1), b2 + hstep, voffB); PG8_STAGE(PG8_SA(0, 0), a2, voffA);
            PG8_WAIT_V(8); PG8_WAIT_L(0); PG8_BAR; PG8_MMA(1, 0, At, B0); PG8_MMA(1, 1, At, B1); PG8_BAR; PG8_SCHED;
            PG8_LDB(B0, 1, 0); PG8_LDB(B1, 1, 1); PG8_SCHED; PG8_LDA(At, 1, 0); PG8_STAGE(PG8_SA(0, 1), a2 + hstep, voffA);
            PG8_WAIT_V(8); PG8_WAIT_L(0); PG8_BAR; PG8_MMA(0, 0, At, B0); PG8_MMA(0, 1, At, B1); PG8_BAR; PG8_SCHED;
            PG8_LDA(At, 1, 1); PG8_STAGE(PG8_SB(1, 0), b3, voffB); PG8_STAGE(PG8_SB(1, 1), b3 + hstep, voffB); PG8_STAGE(PG8_SA(1, 0), a3, voffA);
            PG8_WAIT_V(8); PG8_WAIT_L(0); PG8_BAR; PG8_MMA(1, 0, At, B0); PG8_MMA(1, 1, At, B1); PG8_BAR; PG8_SCHED;
            } else {
            PG8_LDB(B0, 0, 0); PG8_SCHED; PG8_LDA(At, 0, 0); PG8_STAGE(PG8_SA(1, 1), a1 + hstep, voffA);
            PG8_WAIT_L(8); PG8_BAR; PG8_WAIT_L(0); PG8_MMA(0, 0, At, B0); PG8_BAR; PG8_SCHED;
            PG8_LDB(B1, 0, 1); PG8_STAGE(PG8_SB(0, 0), b2, voffB);
            PG8_BAR; PG8_WAIT_L(0); PG8_MMA(0, 1, At, B1); PG8_BAR;
            PG8_LDA(At, 0, 1); PG8_STAGE(PG8_SA(0, 0), a2, voffA);
            PG8_BAR; PG8_WAIT_L(0); PG8_MMA(1, 0, At, B0); PG8_BAR; PG8_SCHED;
            PG8_STAGE(PG8_SB(0, 1), b2 + hstep, voffB);
            PG8_WAIT_V(6); PG8_BAR; PG8_MMA(1, 1, At, B1); PG8_BAR;
            PG8_LDB(B0, 1, 0); PG8_SCHED; PG8_LDA(At, 1, 0); PG8_STAGE(PG8_SA(0, 1), a2 + hstep, voffA);
            PG8_WAIT_L(8); PG8_BAR; PG8_WAIT_L(0); PG8_MMA(0, 0, At, B0); PG8_BAR; PG8_SCHED;
            PG8_LDB(B1, 1, 1); PG8_STAGE(PG8_SB(1, 0), b3, voffB);
            PG8_BAR; PG8_WAIT_L(0); PG8_MMA(0, 1, At, B1); PG8_BAR;
            PG8_LDA(At, 1, 1); PG8_STAGE(PG8_SA(1, 0), a3, voffA);
            PG8_BAR; PG8_WAIT_L(0); PG8_MMA(1, 0, At, B0); PG8_BAR; PG8_SCHED;
            PG8_STAGE(PG8_SB(1, 1), b3 + hstep, voffB);
            PG8_WAIT_V(6); PG8_BAR; PG8_MMA(1, 1, At, B1); PG8_BAR;
            }
        }
        if constexpr (ALIGN_EPI) { if (wr == 0) PG8_BAR; }
        if constexpr (!Epi::AFTER_DRAIN) { E(acc, cur, wr, wc, fr, fq); S.done(cur); }
        if (!has_next) break;
#pragma unroll
        for (int a = 0; a < 2; ++a)
#pragma unroll
            for (int b = 0; b < 2; ++b)
#pragma unroll
                for (int m = 0; m < 4; ++m)
#pragma unroll
                    for (int n = 0; n < 2; ++n) acc[a][b][m][n] = (f32x4){0.f, 0.f, 0.f, 0.f};
        cur = nxt; cA = nA; cB = nB; ++ui;
        if constexpr (ALIGN_EPI) { if (wr == 1) PG8_BAR; }
    }
    PG8_WAIT_V(0);
    if constexpr (!ALIGN_EPI) { if (wr == 0) PG8_BAR; }
    PG8_BAR;
    if constexpr (Epi::AFTER_DRAIN) { E.fused(acc, cur, wr, wc, fr, fq, lds, wid, lane); S.done(cur); }
#undef PG8_SA
#undef PG8_SB
#undef PG8_STAGE
#undef PG8_LDA
#undef PG8_LDB
#undef PG8_MMA
#undef PG8_WAIT_V
#undef PG8_WAIT_L
#undef PG8_BAR
#undef PG8_SCHED
}
}
#include <hip/hip_bf16.h>
namespace attn_body {
using bf16=__hip_bfloat16;
using bf16x8=__attribute__((ext_vector_type(8)))short;
using s16x4=__attribute__((ext_vector_type(4)))short;
using f32x16=__attribute__((ext_vector_type(16)))float;
using u32x4=__attribute__((ext_vector_type(4)))unsigned;
constexpr int BATCH=8,NHEAD=16,SEQ=4096,D=64,PITI=3584,PITO=1024;
constexpr int NW=8,QBLK=32,QB=QBLK*NW,KVBLK=64,NQB=SEQ/QB;
__device__ __forceinline__ int crow(int r,int hi){return (r&3)+8*(r>>2)+4*hi;}
#define SBAR() __builtin_amdgcn_sched_barrier(0)
__device__ __forceinline__ void cmask(f32x16&p0,f32x16&p1,int jb,int qrel,int hi){
  const float NEG=-INFINITY; int kb=64*jb+4*hi;
  #pragma unroll
  for(int r=0;r<16;++r){int kv=kb+(r&3)+8*(r>>2); if(kv>qrel)p0[r]=NEG; if(kv+32>qrel)p1[r]=NEG;}
}

constexpr int NSLOT=3, SLOTB=8192;
constexpr int LDS_K=0, LDS_V=NSLOT*SLOTB, LDS_WS=2*NSLOT*SLOTB, LDS_OST=LDS_WS+NW*64*4, LDS_BYTES=LDS_OST+NW*4096;
constexpr float C2=0.125f*1.4426950408889634f;
__device__ __forceinline__ void glds16(const void*gsrc,unsigned lds_dst){unsigned keep;
  asm volatile("s_mov_b32 %0, m0\n\ts_mov_b32 m0, %2\n\ts_nop 0\n\tglobal_load_lds_dwordx4 %1, off\n\ts_mov_b32 m0, %0":"=&s"(keep):"v"(gsrc),"s"(lds_dst):"memory");}
__device__ __forceinline__ float max3f(float a,float b,float c){float r;asm("v_max3_f32 %0, %1, %2, %3":"=v"(r):"v"(a),"v"(b),"v"(c));return r;}
__device__ __forceinline__ float max2f(float a,float b){float r;asm("v_max_f32_e32 %0, %1, %2":"=v"(r):"v"(a),"v"(b));return r;}
__device__ __forceinline__ float fadd_s(float a,float b){float r;asm("v_add_f32_e32 %0, %1, %2":"=v"(r):"v"(a),"v"(b));return r;}
__device__ __forceinline__ float fsub_s(float a,float b){float r;asm("v_sub_f32_e32 %0, %1, %2":"=v"(r):"v"(a),"v"(b));return r;}
typedef float f32x2_t __attribute__((ext_vector_type(2))); typedef __bf16 bf16x2_t __attribute__((ext_vector_type(2)));
__device__ __forceinline__ unsigned cvtpk_s(float lo,float hi){f32x2_t v={lo,hi};bf16x2_t b=__builtin_convertvector(v,bf16x2_t);return __builtin_bit_cast(unsigned,b);}
#define WAIT_BAR(N) asm volatile("s_waitcnt vmcnt(" #N ") lgkmcnt(0)\n\ts_barrier":::"memory")

__device__ __forceinline__ void qkt(f32x16&p0,f32x16&p1,const char*Kslot,const bf16x8*qr,const f32x16&negm,int r32,int hi){
  const char*kb=Kslot+hi*1024+r32*16;
  #pragma unroll
  for(int d0=0;d0<4;++d0){
    const bf16x8 b0=*reinterpret_cast<const bf16x8*>(kb+d0*2048);
    const bf16x8 b1=*reinterpret_cast<const bf16x8*>(kb+d0*2048+512);
    if(d0==0){p0=__builtin_amdgcn_mfma_f32_32x32x16_bf16(b0,qr[0],negm,0,0,0);p1=__builtin_amdgcn_mfma_f32_32x32x16_bf16(b1,qr[0],negm,0,0,0);}
    else{p0=__builtin_amdgcn_mfma_f32_32x32x16_bf16(b0,qr[d0],p0,0,0,0);p1=__builtin_amdgcn_mfma_f32_32x32x16_bf16(b1,qr[d0],p1,0,0,0);}}
}
typedef __attribute__((address_space(3))) const char* lds_cptr;
typedef short v4i16_t __attribute__((ext_vector_type(4)));
__device__ __forceinline__ void kload8(bf16x8*kf,lds_cptr kp){
  kf[0]=*(const __attribute__((address_space(3))) bf16x8*)(kp);      kf[1]=*(const __attribute__((address_space(3))) bf16x8*)(kp+512);
  kf[2]=*(const __attribute__((address_space(3))) bf16x8*)(kp+2048); kf[3]=*(const __attribute__((address_space(3))) bf16x8*)(kp+2560);
  kf[4]=*(const __attribute__((address_space(3))) bf16x8*)(kp+4096); kf[5]=*(const __attribute__((address_space(3))) bf16x8*)(kp+4608);
  kf[6]=*(const __attribute__((address_space(3))) bf16x8*)(kp+6144); kf[7]=*(const __attribute__((address_space(3))) bf16x8*)(kp+6656);
}
__device__ __forceinline__ void kload2(bf16x8*kf,lds_cptr kp,int j){ kf[2*j]=*(const __attribute__((address_space(3))) bf16x8*)(kp+j*2048); kf[2*j+1]=*(const __attribute__((address_space(3))) bf16x8*)(kp+j*2048+512); }
__device__ __forceinline__ s16x4 vtr(lds_cptr p){ return __builtin_bit_cast(s16x4,__builtin_amdgcn_ds_read_tr16_b64_v4i16((__attribute__((address_space(3))) v4i16_t*)p)); }
__device__ __forceinline__ float rowmax(const f32x16&p0,const f32x16&p1){
  float a=max3f(p0[0],p0[1],p1[0]),b=max3f(p0[2],p0[3],p1[1]);a=max3f(a,p1[2],p1[3]);
  #pragma unroll
  for(int r=4;r<16;r+=4){a=max3f(a,p0[r],p0[r+1]);b=max3f(b,p0[r+2],p0[r+3]);a=max3f(a,p1[r],p1[r+1]);b=max3f(b,p1[r+2],p1[r+3]);}
  const float m=max2f(a,b);
  auto rr=__builtin_amdgcn_permlane32_swap(__float_as_uint(m),__float_as_uint(m),false,false);
  return max2f(__uint_as_float(rr[0]),__uint_as_float(rr[1]));
}
__device__ __forceinline__ void pv(f32x16*o,int vb,bf16x8 pa0,bf16x8 pa1,bf16x8 pa2,bf16x8 pa3){
  #pragma unroll
  for(int d0=0;d0<2;++d0){s16x4 lo[4],hi[4];
    #pragma unroll
    for(int ks=0;ks<4;++ks){
      asm volatile("ds_read_b64_tr_b16 %0,%1 offset:%c2":"=&v"(lo[ks]):"v"(vb),"i"(d0*4096+ks*1024):"memory");
      asm volatile("ds_read_b64_tr_b16 %0,%1 offset:%c2":"=&v"(hi[ks]):"v"(vb),"i"(d0*4096+ks*1024+512):"memory");}
    asm volatile("s_waitcnt lgkmcnt(0)":::"memory");SBAR();
    #define PK(k) (bf16x8){lo[k][0],lo[k][1],lo[k][2],lo[k][3],hi[k][0],hi[k][1],hi[k][2],hi[k][3]}
    o[d0]=__builtin_amdgcn_mfma_f32_32x32x16_bf16(pa0,PK(0),o[d0],0,0,0);
    o[d0]=__builtin_amdgcn_mfma_f32_32x32x16_bf16(pa1,PK(1),o[d0],0,0,0);
    o[d0]=__builtin_amdgcn_mfma_f32_32x32x16_bf16(pa2,PK(2),o[d0],0,0,0);
    o[d0]=__builtin_amdgcn_mfma_f32_32x32x16_bf16(pa3,PK(3),o[d0],0,0,0);
    #undef PK
  }
}

#ifndef ATTN_STORE16
#define ATTN_STORE16(p,v) (*(u32x4*)(p)=(v))
#endif
template<int THRL> __device__ __forceinline__ void attn_unit(int b,int h,int qb,const bf16*Q,const bf16*__restrict__ K,const bf16*__restrict__ V,bf16*O,char*shm){
  const int tid=otid_(),lane=tid&63,r32=lane&31,hi=lane>>5; const int wid=__builtin_amdgcn_readfirstlane(tid>>6);
  const long rowbase=(long)b*SEQ; const int q0=qb*QB;
  const bf16*Qw=Q+(rowbase+q0+wid*QBLK)*PITI;
  const bf16*Kh=K+rowbase*PITI,*Vh=V+rowbase*PITI;
  const unsigned lds0=(unsigned)(uintptr_t)shm;
  float*wsf=(float*)(shm+LDS_WS)+wid*64;
  const bf16*ksrc=Kh+(long)lane*PITI+wid*8;
  const bf16*vsrc=Vh+(long)(16*(wid&3)+(lane>>2))*PITI+(wid>>2)*32+(lane&3)*8;
  const unsigned kdst=lds0+LDS_K+wid*1024, vdst=lds0+LDS_V+wid*1024;
  #define DMA_K(t,slot) glds16(ksrc+(long)(t)*KVBLK*PITI,(unsigned)__builtin_amdgcn_readfirstlane(kdst+(slot)))
  #define DMA_V(t,slot) glds16(vsrc+(long)(t)*KVBLK*PITI,(unsigned)__builtin_amdgcn_readfirstlane(vdst+(slot)))
  const int vb0=(int)(lds0+LDS_V)+((lane>>4)&1)*32+(lane&3)*8+(4*hi+((lane&15)>>2))*64;
  const char*Kbase=shm+LDS_K; bf16x8 kf[8];
  const lds_cptr shm3=(lds_cptr)shm; const lds_cptr kp0=shm3+LDS_K+hi*1024+r32*16; const lds_cptr vp0=shm3+LDS_V+((lane>>4)&1)*32+(lane&3)*8+(4*hi+((lane&15)>>2))*64;
  const int NT=(q0+QB)/KVBLK;
  DMA_K(0,0);DMA_V(0,0);DMA_K(1,SLOTB);
  bf16x8 qr[4];
  #pragma unroll
  for(int d0=0;d0<4;++d0)qr[d0]=*reinterpret_cast<const bf16x8*>(&Qw[(long)r32*PITI+d0*16+hi*8]);
  float mhat=0.f,l_reg=0.f;f32x16 o[2];o[0]=f32x16{};o[1]=f32x16{};f32x16 negm=f32x16{};asm volatile("":"+v"(negm));
  const int qrel=wid*QBLK+r32;
  #define CMASK(P0,P1,t) do{int jb_=(t)-(NT-4); if(jb_>=0)cmask(P0,P1,jb_,qrel,hi);}while(0)
  bool resc=false;
  #define START(P0,P1) do{ const float rm=rowmax(P0,P1); resc=false; \
    { const float dl=rm; mhat=fadd_s(mhat,dl); \
      _Pragma("unroll") for(int r=0;r<16;++r){P0[r]=fsub_s(P0[r],dl);P1[r]=fsub_s(P1[r],dl);} \
      _Pragma("unroll") for(int r=0;r<16;++r)negm[r]=-mhat; asm volatile("":"+v"(negm)); } \
    _Pragma("unroll") for(int r=0;r<16;++r)P0[r]=__builtin_amdgcn_exp2f(P0[r]); }while(0)
  #define RESC() do{ if(resc){ asm volatile("s_waitcnt lgkmcnt(0)":::"memory"); \
      _Pragma("unroll") for(int d_=0;d_<2;++d_) _Pragma("unroll") for(int r=0;r<16;++r)o[d_][r]*=wsf[crow(r,hi)]; } }while(0)
  f32x16 pA0,pA1,pB0,pB1;
  int sl_prev=0,sl_cur=0,sl_next=SLOTB;
  #define ROT() do{sl_prev=sl_cur;sl_cur=sl_next;sl_next=(sl_next==(NSLOT-1)*SLOTB)?0:sl_next+SLOTB;}while(0)
  DMA_K(2,2*SLOTB);
  WAIT_BAR(3);
  qkt(pA0,pA1,Kbase,qr,negm,r32,hi);asm volatile("s_nop 15\n\ts_nop 7":"+v"(pA0),"+v"(pA1));CMASK(pA0,pA1,0);
  START(pA0,pA1);
  _Pragma("unroll") for(int r=0;r<16;++r)pA1[r]=__builtin_amdgcn_exp2f(pA1[r]);
  WAIT_BAR(0);
  DMA_K(3,0);DMA_V(1,SLOTB);
  ROT();
  kload8(kf,kp0+sl_cur);
  WAIT_BAR(2);
  s16x4 vlo[8],vhi[8]; u32x4 pw0,pw1,pw2,pw3;
  #define PKW(P,B) cvtpk_s(P[B],P[B+1])
  #define PAF(k) __builtin_bit_cast(bf16x8,pw##k)
  #define VFR(i) (bf16x8){vlo[i][0],vlo[i][1],vlo[i][2],vlo[i][3],vhi[i][0],vhi[i][1],vhi[i][2],vhi[i][3]}
  #define PIN(x) asm volatile("":"+v"(x))
  #define MX3(a,b,c) __builtin_fmaxf(__builtin_fmaxf((a),(b)),(c))
  #define GAPA(MF,A0,A1,A2,A3,W0,W1,PW) do{ MF; sacc+=A0; sacc+=A1; sacc+=A2; sacc+=A3; PIN(sacc); W0; W1; PIN(PW); SBAR(); }while(0)
  #define EX(v) __builtin_amdgcn_exp2f(v)
  #define GAPB(MF,X,B) do{ MF; X[B]=EX(X[B]); X[B+1]=EX(X[B+1]); X[B+2]=EX(X[B+2]); X[B+3]=EX(X[B+3]); PIN(X); SBAR(); }while(0)
  #define VRD(i) do{ vlo[i]=vtr(vp_+(((i)>>2)*4096+((i)&3)*1024)); vhi[i]=vtr(vp_+(((i)>>2)*4096+((i)&3)*1024+512)); }while(0)
  #define KRD(G,j) do{ if(G){ kload2(kf,kp0+sl_next,j); SBAR(); } }while(0)
  #define STEP(C0,C1,P0,P1,t,GK,GV,GL) do{ SBAR(); \
    const lds_cptr vp_=vp0+sl_prev; \
    VRD(0); SBAR(); float sacc=(P0[0]+P0[1]); \
    GAPA(C0=__builtin_amdgcn_mfma_f32_32x32x16_bf16(kf[0],qr[0],negm,0,0,0), P0[2],P0[3],P0[4],P0[5],     pw0[0]=PKW(P0,0), pw0[1]=PKW(P0,2), pw0); \
    VRD(4); SBAR(); GAPA(C1=__builtin_amdgcn_mfma_f32_32x32x16_bf16(kf[1],qr[0],negm,0,0,0), P0[6],P0[7],P0[8],P0[9],     pw0[2]=PKW(P0,4), pw0[3]=PKW(P0,6), pw0); \
    VRD(1); SBAR(); GAPA(C0=__builtin_amdgcn_mfma_f32_32x32x16_bf16(kf[2],qr[1],C0,0,0,0),   P0[10],P0[11],P0[12],P0[13], pw1[0]=PKW(P0,8), pw1[1]=PKW(P0,10), pw1); \
    VRD(5); SBAR(); GAPA(C1=__builtin_amdgcn_mfma_f32_32x32x16_bf16(kf[3],qr[1],C1,0,0,0),   P0[14],P0[15],P1[0],P1[1],   pw1[2]=PKW(P0,12),pw1[3]=PKW(P0,14), pw1); \
    VRD(2); SBAR(); GAPA(C0=__builtin_amdgcn_mfma_f32_32x32x16_bf16(kf[4],qr[2],C0,0,0,0),   P1[2],P1[3],P1[4],P1[5],     pw2[0]=PKW(P1,0), pw2[1]=PKW(P1,2), pw2); \
    VRD(6); SBAR(); GAPA(C1=__builtin_amdgcn_mfma_f32_32x32x16_bf16(kf[5],qr[2],C1,0,0,0),   P1[6],P1[7],P1[8],P1[9],     pw2[2]=PKW(P1,4), pw2[3]=PKW(P1,6), pw2); \
    VRD(3); SBAR(); GAPA(C0=__builtin_amdgcn_mfma_f32_32x32x16_bf16(kf[6],qr[3],C0,0,0,0),   P1[10],P1[11],P1[12],P1[13], pw3[0]=PKW(P1,8), pw3[1]=PKW(P1,10), pw3); \
    VRD(7); SBAR(); GAPA(C1=__builtin_amdgcn_mfma_f32_32x32x16_bf16(kf[7],qr[3],C1,0,0,0),   P1[14],P1[15],0.f,0.f,       pw3[2]=PKW(P1,12),pw3[3]=PKW(P1,14), pw3); \
    l_reg+=sacc; \
    if(GK){DMA_K((t)+3,sl_cur);} if(GV){DMA_V((t)+1,sl_next);} \
    CMASK(C0,C1,t); \
    { float a=MX3(C0[0],C0[1],C1[0]),b=MX3(C0[2],C0[3],C1[1]); a=MX3(a,C1[2],C1[3]); \
      _Pragma("unroll") for(int r=4;r<16;r+=4){a=MX3(a,C0[r],C0[r+1]);b=MX3(b,C0[r+2],C0[r+3]);a=MX3(a,C1[r],C1[r+1]);b=MX3(b,C1[r+2],C1[r+3]);} \
      float rm=__builtin_fmaxf(a,b); { auto rr=__builtin_amdgcn_permlane32_swap(__float_as_uint(rm),__float_as_uint(rm),false,false); rm=__builtin_fmaxf(__uint_as_float(rr[0]),__uint_as_float(rr[1])); } \
      resc=false; \
      if(__builtin_expect(__any(rm>(float)THRL),0)){ const float dl=__builtin_fmaxf(rm,0.f); mhat+=dl; \
        _Pragma("unroll") for(int r=0;r<16;++r){C0[r]-=dl;C1[r]-=dl;} \
        _Pragma("unroll") for(int r=0;r<16;++r)negm[r]=-mhat; asm volatile("":"+v"(negm)); \
        const float f=__builtin_amdgcn_exp2f(-dl); l_reg*=f; if(hi==0)wsf[r32]=f; resc=true; } } \
    SBAR(); \
    GAPB(o[0]=__builtin_amdgcn_mfma_f32_32x32x16_bf16(PAF(0),VFR(0),o[0],0,0,0), C0,0); \
    GAPB(o[1]=__builtin_amdgcn_mfma_f32_32x32x16_bf16(PAF(0),VFR(4),o[1],0,0,0), C0,4); \
    KRD(GL,0); GAPB(o[0]=__builtin_amdgcn_mfma_f32_32x32x16_bf16(PAF(1),VFR(1),o[0],0,0,0), C0,8); \
    KRD(GL,1); GAPB(o[1]=__builtin_amdgcn_mfma_f32_32x32x16_bf16(PAF(1),VFR(5),o[1],0,0,0), C0,12); \
    KRD(GL,2); GAPB(o[0]=__builtin_amdgcn_mfma_f32_32x32x16_bf16(PAF(2),VFR(2),o[0],0,0,0), C1,0); \
    KRD(GL,3); GAPB(o[1]=__builtin_amdgcn_mfma_f32_32x32x16_bf16(PAF(2),VFR(6),o[1],0,0,0), C1,4); \
    GAPB(o[0]=__builtin_amdgcn_mfma_f32_32x32x16_bf16(PAF(3),VFR(3),o[0],0,0,0), C1,8); \
    GAPB(o[1]=__builtin_amdgcn_mfma_f32_32x32x16_bf16(PAF(3),VFR(7),o[1],0,0,0), C1,12); \
    }while(0)
  int t=1;
  #undef CMASK
  #define CMASK(P0,P1,t) do{}while(0)
  for(;t+5<NT;t+=2){
    STEP(pB0,pB1,pA0,pA1,t,true,true,true);     WAIT_BAR(2); RESC(); ROT();
    STEP(pA0,pA1,pB0,pB1,t+1,true,true,true);   WAIT_BAR(2); RESC(); ROT();
  }
  #undef CMASK
  #define CMASK(P0,P1,t) do{int jb_=(t)-(NT-4); if(jb_>=0)cmask(P0,P1,jb_,qrel,hi);}while(0)
  #define ENDW(tt) do{ if((tt)+3<NT){WAIT_BAR(2);} else if((tt)+2<NT){WAIT_BAR(1);} else {WAIT_BAR(0);} }while(0)
  for(;t+1<NT;t+=2){
    STEP(pB0,pB1,pA0,pA1,t,(t+3<NT),(t+1<NT),(t+1<NT));       ENDW(t);   RESC(); ROT();
    STEP(pA0,pA1,pB0,pB1,t+1,(t+4<NT),(t+2<NT),(t+2<NT));     ENDW(t+1); RESC(); ROT();
  }
  STEP(pB0,pB1,pA0,pA1,NT-1,false,false,false); RESC();
  { float sacc=pB0[0]+pB0[1]; _Pragma("unroll") for(int r=2;r<16;++r)sacc+=pB0[r]; _Pragma("unroll") for(int r=0;r<16;++r)sacc+=pB1[r]; l_reg+=sacc;
    pw0=(u32x4){PKW(pB0,0),PKW(pB0,2),PKW(pB0,4),PKW(pB0,6)};pw1=(u32x4){PKW(pB0,8),PKW(pB0,10),PKW(pB0,12),PKW(pB0,14)};pw2=(u32x4){PKW(pB1,0),PKW(pB1,2),PKW(pB1,4),PKW(pB1,6)};pw3=(u32x4){PKW(pB1,8),PKW(pB1,10),PKW(pB1,12),PKW(pB1,14)};
    SBAR(); pv(o,vb0+sl_cur,PAF(0),PAF(1),PAF(2),PAF(3)); }
  #undef PKW
  #undef PAF
  #undef VFR
  #undef PIN
  #undef MX3
  #undef GAPA
  #undef GAPB
  #undef EX
  #undef VRD
  #undef KRD
  #undef STEP
  #undef ENDW
  {auto rr=__builtin_amdgcn_permlane32_swap(__float_as_uint(l_reg),__float_as_uint(l_reg),false,false);l_reg=__uint_as_float(rr[0])+__uint_as_float(rr[1]);}
  if(hi==0)wsf[32+r32]=l_reg;asm volatile("s_waitcnt lgkmcnt(0)":::"memory");
  float rli[16];
  #pragma unroll
  for(int r=0;r<16;++r)rli[r]=__builtin_amdgcn_rcpf(wsf[32+crow(r,hi)]);
  bf16*Ow=O+(rowbase+q0+wid*QBLK)*PITO;
  { bf16*stg=(bf16*)(shm+LDS_OST)+wid*2048;
    #pragma unroll
    for(int r=0;r<16;++r){const int orow=crow(r,hi);
      #pragma unroll
      for(int d0=0;d0<2;++d0)stg[orow*64+d0*32+r32]=__float2bfloat16(o[d0][r]*rli[r]);}
    asm volatile("s_waitcnt lgkmcnt(0)":::"memory");
    #pragma unroll
    for(int i=0;i<4;++i){const int row=i*8+(lane>>3),ch=lane&7; const u32x4 v=*(const u32x4*)(stg+row*64+ch*8); ATTN_STORE16(Ow+(long)row*PITO+ch*8,v);} }
  asm volatile("s_waitcnt lgkmcnt(0)\n\ts_barrier":::"memory");
  #undef DMA_K
  #undef DMA_V
  #undef CMASK
  #undef START
  #undef RESC
  #undef ROT
}
constexpr int ATTN_LDS_BYTES=LDS_BYTES;
#undef SBAR
#undef WAIT_BAR
}

namespace cg = cooperative_groups;
typedef unsigned short bf16_t;
typedef float f32x4 __attribute__((ext_vector_type(4)));
typedef float f32x16 __attribute__((ext_vector_type(16)));
typedef unsigned u32x4 __attribute__((ext_vector_type(4)));
typedef unsigned u32x2 __attribute__((ext_vector_type(2)));
typedef short bf16x8 __attribute__((ext_vector_type(8)));
#define LAS3 __attribute__((address_space(3)))

constexpr int T_ = 32768, DM_ = 1024, SEQ_ = 4096, DFF_ = 2816;
constexpr int NTHR = 512;
constexpr int LDS_BYTES = 147456;
constexpr size_t MiB_ = 1u << 20;
constexpr size_t WS_MOD = 0, WS_COS = 1 * MiB_, WS_SIN = 2 * MiB_;
constexpr size_t WS_WIN = 4 * MiB_, WS_WOUT = 11 * MiB_, WS_FIN = 13 * MiB_, WS_FOUT = 24 * MiB_;
constexpr size_t WS_A = 32 * MiB_, WS_X2 = 96 * MiB_, WS_ST = 160 * MiB_, WS_TOT = 224 * MiB_, WS_R1 = 226 * MiB_, WS_END = 450 * MiB_;
constexpr size_t WS_HP = WS_ST, WS_HU = WS_ST + 12 * MiB_, WS_HA = WS_ST + 24 * MiB_;
constexpr float LOG2E_ = 1.4426950408889634f;
constexpr float QSCALE_ = 0.125f * 1.4426950408889634f;

struct Params {
    const float* x; const float* c; const int* positions; const float* mod_w; const float* mod_b; const float* norm_mix_w; const float* norm_ffn_w;
    const float* ev_w_in; const float* gla_gate_w; const float* gla_gate_b; const float* gla_norm_w; const float* swa_sinks; const float* ev_w_out;
    const float* od_w_in; const float* diff_lambda; const float* diff_norm_w; const float* hgrn_lb_logits; const float* hgrn_norm_w; const float* od_w_out;
    const float* ffn_w_in; const float* ffn_conv_w; const float* ffn_conv_b; const float* ffn_w_out; const float* final_norm_w;
    float* out; unsigned char* ws; unsigned long long pad[6];
};

__device__ __forceinline__ unsigned pk2(float lo, float hi) {
    typedef float f32x2_t __attribute__((ext_vector_type(2))); typedef __bf16 bf16x2_t __attribute__((ext_vector_type(2)));
    f32x2_t v = {lo, hi}; bf16x2_t b = __builtin_convertvector(v, bf16x2_t); return __builtin_bit_cast(unsigned, b);
}
__device__ __forceinline__ float bflo(unsigned u) { return __uint_as_float(u << 16); }
__device__ __forceinline__ float bfhi(unsigned u) { return __uint_as_float(u & 0xffff0000u); }
__device__ __forceinline__ float sigmoidf_(float x) { return 1.f / (1.f + __expf(-x)); }
__device__ __forceinline__ float siluf_(float x) { return x / (1.f + __expf(-x)); }
__device__ __forceinline__ float wave_sum(float v) {
#pragma unroll
    for (int o = 1; o < 64; o <<= 1) v += __shfl_xor(v, o);
    return v;
}
__device__ __forceinline__ int crow_(int r, int hi) { return (r & 3) + 8 * (r >> 2) + 4 * hi; }

namespace pg8 {
struct EpiProj {
    static constexpr bool PERM = true, AFTER_DRAIN = false;
    bf16_t* O; int ldc; unsigned ropemask; unsigned scalemask; float scale; const float* cs; const float* sn;
    __device__ __forceinline__ void operator()(const f32x4 (&acc)[2][2][4][2], const Unit& u, int wr, int wc, int fr, int fq) const {
        const int row0 = u.pm * BM + wr * 64 + fr; const int col0 = u.pn * BM + wc * 32 + 8 * fq;
#pragma unroll
        for (int bj = 0; bj < 2; ++bj) {
            const int grp = u.pn * 2 + bj;
            const bool rope = ((ropemask >> grp) & 1u) && ((wc & 1) == 0);
            const float sc = ((scalemask >> grp) & 1u) ? scale : 1.f;
#pragma unroll
            for (int ai = 0; ai < 2; ++ai)
#pragma unroll
                for (int m = 0; m < 4; ++m) {
                    const int row = row0 + ai * HALF + m * 16;
                    f32x4 v0 = acc[ai][bj][m][0], v1 = acc[ai][bj][m][1];
                    if (rope) {
                        const f32x4 c0 = *(const f32x4*)(cs + (size_t)row * 8), c1 = *(const f32x4*)(cs + (size_t)row * 8 + 4);
                        const f32x4 s0 = *(const f32x4*)(sn + (size_t)row * 8), s1 = *(const f32x4*)(sn + (size_t)row * 8 + 4);
                        const float sg = (fq == 0) ? -1.f : 1.f;
#pragma unroll
                        for (int e = 0; e < 4; ++e) {
                            const float p0 = __shfl_xor(v0[e], 16), p1 = __shfl_xor(v1[e], 16);
                            const float r0 = v0[e] * c0[e] + sg * p0 * s0[e], r1 = v1[e] * c1[e] + sg * p1 * s1[e];
                            if (fq < 2) { v0[e] = r0; v1[e] = r1; }
                        }
                    }
                    v0 = v0 * sc; v1 = v1 * sc;
                    u32x4 w; w.x = pk2(v0[0], v0[1]); w.y = pk2(v0[2], v0[3]); w.z = pk2(v1[0], v1[1]); w.w = pk2(v1[2], v1[3]);
                    *(u32x4*)(O + (size_t)row * ldc + col0 + bj * HALF) = w;
                    asm volatile("" ::: "memory");
                }
        }
    }
};
struct EpiRes {
    static constexpr bool PERM = false, AFTER_DRAIN = false;
    const float* xin; float* xout; const float* gate;
    __device__ __forceinline__ void operator()(const f32x4 (&acc)[2][2][4][2], const Unit& u, int wr, int wc, int fr, int fq) const {
        const int col0 = u.pn * BM + wc * 32 + 4 * fq;
#pragma unroll
        for (int ai = 0; ai < 2; ++ai)
#pragma unroll
            for (int m = 0; m < 4; ++m) {
                const int row = u.pm * BM + ai * HALF + wr * 64 + m * 16 + fr;
                const float* g = gate + (size_t)(row >> 12) * 6144;
                const size_t off = (size_t)row * 1024 + col0;
#pragma unroll
                for (int bj = 0; bj < 2; ++bj)
#pragma unroll
                    for (int n = 0; n < 2; ++n) {
                        const int cc = bj * HALF + n * 16;
                        const f32x4 g4 = *(const f32x4*)(g + col0 + cc);
                        const f32x4 x4 = *(const f32x4*)(xin + off + cc);
                        *(f32x4*)(xout + off + cc) = x4 + g4 * acc[ai][bj][m][n];
                    }
                asm volatile("" ::: "memory");
            }
    }
};
struct EpiFfn {
    static constexpr bool PERM = true, AFTER_DRAIN = false;
    bf16_t* G; float* HP; float* HU; float* HA; const float* cw; const float* cb;
    __device__ __forceinline__ void operator()(const f32x4 (&acc)[2][2][4][2], const Unit& u, int wr, int wc, int fr, int fq) const {
        const int ch0 = u.pn * 128 + wc * 32 + 8 * fq;
        f32x4 w0[2], w1[2], w2[2], bb[2];
#pragma unroll
        for (int n = 0; n < 2; ++n) { w0[n] = *(const f32x4*)(cw + ch0 + 4 * n); w1[n] = *(const f32x4*)(cw + DFF_ + ch0 + 4 * n); w2[n] = *(const f32x4*)(cw + 2 * DFF_ + ch0 + 4 * n); bb[n] = *(const f32x4*)(cb + ch0 + 4 * n); }
        const int lane = fr + 16 * fq;
        const int src1 = (lane & ~15) | ((fr + 15) & 15), src2 = (lane & ~15) | ((fr + 14) & 15);
#pragma unroll
        for (int ai = 0; ai < 2; ++ai) {
            const int seg = u.pm * 4 + ai * 2 + wr;
#pragma unroll
            for (int m = 0; m < 4; ++m) {
                const int row = u.pm * BM + ai * HALF + wr * 64 + m * 16 + fr;
                f32x4 val[2];
#pragma unroll
                for (int n = 0; n < 2; ++n) {
                    const f32x4 a = acc[ai][0][m][n];
                    f32x4 ap = (f32x4){0.f, 0.f, 0.f, 0.f};
                    if (m > 0) ap = acc[ai][0][m > 0 ? m - 1 : 0][n];
#pragma unroll
                    for (int e = 0; e < 4; ++e) {
                        const float t1 = (fr == 15) ? ap[e] : a[e];
                        const float t2 = (fr >= 14) ? ap[e] : a[e];
                        const float p1 = __shfl(t1, src1), p2 = __shfl(t2, src2);
                        val[n][e] = w2[n][e] * a[e] + w1[n][e] * p1 + w0[n][e] * p2 + bb[n][e];
                    }
                }
                const f32x4 u0 = acc[ai][1][m][0], u1 = acc[ai][1][m][1];
                f32x4 g0, g1;
#pragma unroll
                for (int e = 0; e < 4; ++e) { g0[e] = siluf_(val[0][e]) * u0[e]; g1[e] = siluf_(val[1][e]) * u1[e]; }
                u32x4 w; w.x = pk2(g0[0], g0[1]); w.y = pk2(g0[2], g0[3]); w.z = pk2(g1[0], g1[1]); w.w = pk2(g1[2], g1[3]);
                *(u32x4*)(G + (size_t)row * DFF_ + ch0) = w;
                if (m == 0 && fr < 2) {
                    const size_t ho = (size_t)(seg * 2 + fr) * DFF_ + ch0;
                    *(f32x4*)(HP + ho) = val[0]; *(f32x4*)(HP + ho + 4) = val[1];
                    *(f32x4*)(HU + ho) = u0; *(f32x4*)(HU + ho + 4) = u1;
                }
                if (m == 3 && fr >= 14) {
                    const size_t ho = (size_t)(seg * 2 + (fr - 14)) * DFF_ + ch0;
                    *(f32x4*)(HA + ho) = acc[ai][0][3][0]; *(f32x4*)(HA + ho + 4) = acc[ai][0][3][1];
                }
                asm volatile("" ::: "memory");
            }
        }
    }
};
}

struct Ctx { Params p; unsigned char* lds; int tid, lane, wave, gw, ngw; };

__device__ __forceinline__ void phase_prologue(const Ctx& C) {
    const Params& p = C.p;
    float* cact = (float*)C.lds;
    float* red = (float*)(C.lds + 32768);
    float* mod = (float*)(p.ws + WS_MOD);
    const int tid = C.tid;
    for (int i = tid; i < 8192; i += NTHR) { const float c = p.c[i]; cact[i] = c / (1.f + __expf(-c)); }
    __syncthreads();
    const int col = tid & 63, kp = tid >> 6;
    for (int g = blockIdx.x; g < 384; g += gridDim.x) {
        const int l = g / 96, j = (g % 96) * 64 + col;
        const float* w = p.mod_w + (size_t)l * 1024 * 6144 + (size_t)(kp * 128) * 6144 + j;
        float a0 = 0.f, a1 = 0.f, a2 = 0.f, a3 = 0.f, a4 = 0.f, a5 = 0.f, a6 = 0.f, a7 = 0.f;
        const float* ca = cact + kp * 128;
#pragma unroll 8
        for (int k = 0; k < 128; ++k) {
            const float wv = w[(size_t)k * 6144];
            a0 += ca[k] * wv; a1 += ca[1024 + k] * wv; a2 += ca[2048 + k] * wv; a3 += ca[3072 + k] * wv;
            a4 += ca[4096 + k] * wv; a5 += ca[5120 + k] * wv; a6 += ca[6144 + k] * wv; a7 += ca[7168 + k] * wv;
        }
        float* r = red + (kp * 8) * 64 + col;
        r[0] = a0; r[64] = a1; r[128] = a2; r[192] = a3; r[256] = a4; r[320] = a5; r[384] = a6; r[448] = a7;
        __syncthreads();
        { const int b = tid >> 6; float s = 0.f;
#pragma unroll
          for (int kk = 0; kk < 8; ++kk) s += red[(kk * 8 + b) * 64 + col];
          mod[(size_t)(l * 8 + b) * 6144 + j] = s + p.mod_b[l * 6144 + j]; }
        __syncthreads();
    }
    float* cs = (float*)(p.ws + WS_COS); float* sn = (float*)(p.ws + WS_SIN);
    const float invf[8] = {1.0f, 0.1939227432012558f, 0.03760603070259094f, 0.007292664609849453f, 0.0014142135623842478f, 0.00027424818836152554f, 5.3182957344688475e-05f, 1.0313385246263351e-05f};
    for (int r = blockIdx.x * NTHR + tid; r < T_; r += gridDim.x * NTHR) {
        const float pos = (float)p.positions[r];
        f32x4 c4[2], s4[2];
#pragma unroll
        for (int i = 0; i < 8; ++i) {
            const float ang = pos * invf[i];
            const double xr = (double)ang * 0.15915494309189535;
            const float f = (float)(xr - rint(xr));
            c4[i >> 2][i & 3] = __builtin_amdgcn_cosf(f); s4[i >> 2][i & 3] = __builtin_amdgcn_sinf(f);
        }
        *(f32x4*)(cs + (size_t)r * 8) = c4[0]; *(f32x4*)(cs + (size_t)r * 8 + 4) = c4[1];
        *(f32x4*)(sn + (size_t)r * 8) = s4[0]; *(f32x4*)(sn + (size_t)r * 8 + 4) = s4[1];
    }
}

__device__ __forceinline__ void tr_item(const float* W, int Nsrc, int srccol0, bf16_t* WT, int K, int dstrow0, int k0, float* scr, int lane) {
#pragma unroll 8
    for (int i = 0; i < 32; ++i) { const int kk = 2 * i + (lane >> 5); scr[kk * 33 + (lane & 31)] = W[(size_t)(k0 + kk) * Nsrc + srccol0 + (lane & 31)]; }
    asm volatile("s_waitcnt lgkmcnt(0)" ::: "memory");
    const int c = lane & 7;
#pragma unroll
    for (int j = 0; j < 4; ++j) { const int n = (lane >> 3) + 8 * j; const float* s = scr + (8 * c) * 33 + n;
        u32x4 o; o.x = pk2(s[0 * 33], s[1 * 33]); o.y = pk2(s[2 * 33], s[3 * 33]); o.z = pk2(s[4 * 33], s[5 * 33]); o.w = pk2(s[6 * 33], s[7 * 33]);
        *(u32x4*)(WT + (size_t)(dstrow0 + n) * K + k0 + 8 * c) = o; }
    asm volatile("s_waitcnt lgkmcnt(0)" ::: "memory");
}
__device__ __forceinline__ void phase_convert(const Ctx& C, int l) {
    const Params& p = C.p; const int j = l >> 1; const bool even = !(l & 1);
    float* scr = (float*)(C.lds + C.wave * 16384);
    bf16_t* WIN = (bf16_t*)(p.ws + WS_WIN); bf16_t* WOUT = (bf16_t*)(p.ws + WS_WOUT); bf16_t* FIN = (bf16_t*)(p.ws + WS_FIN); bf16_t* FOUT = (bf16_t*)(p.ws + WS_FOUT);
    const int nA = even ? 80 : 112;
    const int IA = 16 * nA, IB = 16 * 32, IC = 16 * 176, ID = 44 * 32;
    const float* win = even ? p.ev_w_in + (size_t)j * 1024 * 2320 : p.od_w_in + (size_t)j * 1024 * 3584;
    const float* wout = even ? p.ev_w_out + (size_t)j * 1024 * 1024 : p.od_w_out + (size_t)j * 1024 * 1024;
    const float* fin = p.ffn_w_in + (size_t)l * 1024 * 5632; const float* fout = p.ffn_w_out + (size_t)l * 2816 * 1024;
    for (int it = C.gw; it < IA + IB + IC + ID; it += C.ngw) {
        int r = it;
        if (r < IA) { const int kb = r / nA, nb = r % nA, n0 = nb * 32; int sc = n0;
            if (even) { if (n0 >= 512 && n0 < 768) continue; if (n0 >= 1792) sc = n0 - 240; else if (n0 >= 768) sc = n0 - 256; }
            tr_item(win, even ? 2320 : 3584, sc, WIN, 1024, n0, kb * 64, scr, C.lane); continue; }
        r -= IA;
        if (r < IB) { const int kb = r / 32, nb = r % 32; tr_item(wout, 1024, nb * 32, WOUT, 1024, nb * 32, kb * 64, scr, C.lane); continue; }
        r -= IB;
        if (r < IC) { const int kb = r / 176, nb = r % 176, n0 = nb * 32; const int pn = n0 >> 8, jj = n0 & 255;
            const int sc = (jj < 128) ? pn * 128 + jj : 2816 + pn * 128 + (jj - 128);
            tr_item(fin, 5632, sc, FIN, 1024, n0, kb * 64, scr, C.lane); continue; }
        r -= IC;
        { const int kb = r / 32, nb = r % 32; tr_item(fout, 1024, nb * 32, FOUT, 2816, nb * 32, kb * 64, scr, C.lane); }
    }
    if (even) {
        const float* gw = p.gla_gate_w + (size_t)j * 16 * 256;
        for (int u = blockIdx.x * NTHR + C.tid; u < 256 * 128; u += gridDim.x * NTHR) {
            const int k8 = u & 127, n = u >> 7;
            float g[16];
#pragma unroll
            for (int r = 0; r < 16; ++r) g[r] = gw[r * 256 + n];
            float o[8];
#pragma unroll
            for (int e = 0; e < 8; ++e) {
                const float* wr = win + (size_t)(k8 * 8 + e) * 2320 + 1536;
                const f32x4 a0 = *(const f32x4*)wr, a1 = *(const f32x4*)(wr + 4), a2 = *(const f32x4*)(wr + 8), a3 = *(const f32x4*)(wr + 12);
                o[e] = a0[0] * g[0] + a0[1] * g[1] + a0[2] * g[2] + a0[3] * g[3] + a1[0] * g[4] + a1[1] * g[5] + a1[2] * g[6] + a1[3] * g[7]
                     + a2[0] * g[8] + a2[1] * g[9] + a2[2] * g[10] + a2[3] * g[11] + a3[0] * g[12] + a3[1] * g[13] + a3[2] * g[14] + a3[3] * g[15];
            }
            u32x4 w; w.x = pk2(o[0], o[1]); w.y = pk2(o[2], o[3]); w.z = pk2(o[4], o[5]); w.w = pk2(o[6], o[7]);
            *(u32x4*)(WIN + (size_t)(512 + n) * 1024 + k8 * 8) = w;
        }
    }
}

__device__ __forceinline__ void phase_norm(const Ctx& C, const float* xin, const float* w, const float* modl, int shoff, int scoff, bf16_t* out) {
    for (int row = C.gw; row < T_; row += C.ngw) {
        const f32x4* xr = (const f32x4*)(xin + (size_t)row * 1024) + C.lane;
        f32x4 v[4]; float ss = 0.f;
#pragma unroll
        for (int j = 0; j < 4; ++j) { v[j] = xr[64 * j]; ss += (v[j].x * v[j].x + v[j].y * v[j].y) + (v[j].z * v[j].z + v[j].w * v[j].w); }
        const float rs = rsqrtf(wave_sum(ss) * (1.f / 1024.f) + 1e-6f);
        const float* mb = modl + (size_t)(row >> 12) * 6144;
        u32x2* o8 = (u32x2*)(out + (size_t)row * 1024) + C.lane;
#pragma unroll
        for (int j = 0; j < 4; ++j) {
            const int col = 4 * C.lane + 256 * j;
            const f32x4 w4 = *(const f32x4*)(w + col), sc = *(const f32x4*)(mb + scoff + col), sh = *(const f32x4*)(mb + shoff + col);
            const f32x4 y = (v[j] * rs) * w4 * (sc + 1.f) + sh;
            u32x2 q; q.x = pk2(y.x, y.y); q.y = pk2(y.z, y.w); o8[64 * j] = q;
        }
    }
}
__device__ __forceinline__ void phase_final_norm(const Ctx& C, float* x, const float* w) {
    for (int row = C.gw; row < T_; row += C.ngw) {
        f32x4* xr = (f32x4*)(x + (size_t)row * 1024) + C.lane;
        f32x4 v[4]; float ss = 0.f;
#pragma unroll
        for (int j = 0; j < 4; ++j) { v[j] = xr[64 * j]; ss += (v[j].x * v[j].x + v[j].y * v[j].y) + (v[j].z * v[j].z + v[j].w * v[j].w); }
        const float rs = rsqrtf(wave_sum(ss) * (1.f / 1024.f) + 1e-6f);
#pragma unroll
        for (int j = 0; j < 4; ++j) { const f32x4 w4 = *(const f32x4*)(w + 4 * C.lane + 256 * j); xr[64 * j] = (v[j] * rs) * w4; }
    }
}

__device__ __forceinline__ void phase_diff_combine(const Ctx& C, int l) {
    const Params& p = C.p; const int j = l >> 1;
    const float lam_init = 0.8f - 0.6f * expf(-0.3f * (float)l);
    const float* lv = p.diff_lambda + j * 256;
    const float s1 = wave_sum(lv[C.lane] * lv[64 + C.lane]), s2 = wave_sum(lv[128 + C.lane] * lv[192 + C.lane]);
    const float lam = expf(s1) - expf(s2) + lam_init;
    const bf16_t* X2 = (const bf16_t*)(p.ws + WS_X2); bf16_t* A = (bf16_t*)(p.ws + WS_A);
    const int head = C.lane >> 4, d0 = (C.lane & 15) * 8;
    const float* nw = p.diff_norm_w + j * 128 + d0;
    const f32x4 n0 = *(const f32x4*)nw, n1 = *(const f32x4*)(nw + 4);
    const float og = 1.f - lam_init;
    for (int row = C.gw; row < T_; row += C.ngw) {
        const bf16_t* src = X2 + (size_t)row * 1024 + head * 256 + d0;
        const u32x4 a = *(const u32x4*)src, b = *(const u32x4*)(src + 128);
        float od[8];
        od[0] = bflo(a.x) - lam * bflo(b.x); od[1] = bfhi(a.x) - lam * bfhi(b.x); od[2] = bflo(a.y) - lam * bflo(b.y); od[3] = bfhi(a.y) - lam * bfhi(b.y);
        od[4] = bflo(a.z) - lam * bflo(b.z); od[5] = bfhi(a.z) - lam * bfhi(b.z); od[6] = bflo(a.w) - lam * bflo(b.w); od[7] = bfhi(a.w) - lam * bfhi(b.w);
        float ss = 0.f;
#pragma unroll
        for (int e = 0; e < 8; ++e) ss += od[e] * od[e];
        ss += __shfl_xor(ss, 1); ss += __shfl_xor(ss, 2); ss += __shfl_xor(ss, 4); ss += __shfl_xor(ss, 8);
        const float rs = rsqrtf(ss * (1.f / 128.f) + 1e-6f) * og;
        u32x4 w; w.x = pk2(od[0] * rs * n0[0], od[1] * rs * n0[1]); w.y = pk2(od[2] * rs * n0[2], od[3] * rs * n0[3]);
        w.z = pk2(od[4] * rs * n1[0], od[5] * rs * n1[1]); w.w = pk2(od[6] * rs * n1[2], od[7] * rs * n1[3]);
        *(u32x4*)(A + (size_t)row * 1024 + head * 128 + d0) = w;
    }
}

__device__ __forceinline__ void phase_ffn_fixup(const Ctx& C, int l) {
    const Params& p = C.p;
    const float* HP = (const float*)(p.ws + WS_HP); const float* HU = (const float*)(p.ws + WS_HU); const float* HA = (const float*)(p.ws + WS_HA);
    bf16_t* G = (bf16_t*)(p.ws + WS_R1);
    const float* cw = p.ffn_conv_w + (size_t)l * 3 * DFF_;
    for (int u = blockIdx.x * NTHR + C.tid; u < 512 * 2 * 704; u += gridDim.x * NTHR) {
        const int c4 = u % 704, sj = u / 704, jj = sj & 1, seg = sj >> 1, ch = c4 * 4;
        const size_t ho = (size_t)sj * DFF_ + ch;
        f32x4 val = *(const f32x4*)(HP + ho); const f32x4 uu = *(const f32x4*)(HU + ho);
        if ((seg & 63) != 0) {
            const f32x4 am1 = *(const f32x4*)(HA + (size_t)((seg - 1) * 2 + 1) * DFF_ + ch), am2 = *(const f32x4*)(HA + (size_t)((seg - 1) * 2) * DFF_ + ch);
            const f32x4 w0 = *(const f32x4*)(cw + ch), w1 = *(const f32x4*)(cw + DFF_ + ch);
            if (jj == 0) val = val + w1 * am1 + w0 * am2; else val = val + w0 * am1;
        }
        u32x2 q; q.x = pk2(siluf_(val.x) * uu.x, siluf_(val.y) * uu.y); q.y = pk2(siluf_(val.z) * uu.z, siluf_(val.w) * uu.w);
        *(u32x2*)(G + (size_t)(seg * 64 + jj) * DFF_ + ch) = q;
    }
}

__device__ __forceinline__ void phase_swa(const Ctx& C, int l) {
    const Params& p = C.p;
    const bf16_t* proj = (const bf16_t*)(p.ws + WS_R1); bf16_t* A = (bf16_t*)(p.ws + WS_A);
    bf16_t* Ks = (bf16_t*)C.lds;
    bf16_t* Vt = (bf16_t*)(C.lds + 27648);
    const int tid = C.tid, lane = C.lane, wid = C.wave, r32 = lane & 31, hi = lane >> 5;
    const float* sinks = p.swa_sinks + (l >> 1) * 8;
    for (int u = blockIdx.x; u < 1024; u += gridDim.x) {
        const int b = u >> 7, kvh = (u >> 6) & 1, qb = u & 63, q0 = qb * 64; const size_t rowbase = (size_t)b * SEQ_;
        for (int c = tid; c < 1536; c += NTHR) {
            const int kk = c >> 3, ch = c & 7, pl = q0 - 128 + kk;
            u32x4 kv = (u32x4){0u, 0u, 0u, 0u}, vv = (u32x4){0u, 0u, 0u, 0u};
            if (pl >= 0) { const bf16_t* src = proj + (rowbase + pl) * 2560 + 2304 + kvh * 64 + ch * 8; kv = *(const u32x4*)src; vv = *(const u32x4*)(src + 128); }
            *(u32x4*)(Ks + kk * 72 + ch * 8) = kv;
            bf16_t* vd = Vt + (ch * 8) * 200 + kk;
            vd[0] = (bf16_t)(vv.x & 0xffffu); vd[200] = (bf16_t)(vv.x >> 16); vd[400] = (bf16_t)(vv.y & 0xffffu); vd[600] = (bf16_t)(vv.y >> 16);
            vd[800] = (bf16_t)(vv.z & 0xffffu); vd[1000] = (bf16_t)(vv.z >> 16); vd[1200] = (bf16_t)(vv.w & 0xffffu); vd[1400] = (bf16_t)(vv.w >> 16);
        }
        __syncthreads();
        const int g = wid >> 1, qh = kvh * 4 + g, qhalf = wid & 1, pq = q0 + 32 * qhalf + r32;
        const bf16_t* qsrc = proj + (rowbase + pq) * 2560 + 1792 + qh * 64;
        bf16x8 qr[4];
#pragma unroll
        for (int d0 = 0; d0 < 4; ++d0) qr[d0] = *(const bf16x8*)(qsrc + d0 * 16 + hi * 8);
        f32x16 s[5];
#pragma unroll
        for (int t = 0; t < 5; ++t) {
            f32x16 a = {};
#pragma unroll
            for (int d0 = 0; d0 < 4; ++d0) {
                const bf16x8 kf = *(const bf16x8*)(Ks + (32 * (qhalf + t) + r32) * 72 + d0 * 16 + hi * 8);
                a = __builtin_amdgcn_mfma_f32_32x32x16_bf16(kf, qr[d0], a, 0, 0, 0);
            }
            s[t] = a;
        }
        const float sink2 = sinks[qh] * LOG2E_;
        float mx = sink2;
#pragma unroll
        for (int t = 0; t < 5; ++t)
#pragma unroll
            for (int r = 0; r < 16; ++r) {
                const int pk = q0 - 128 + 32 * (qhalf + t) + crow_(r, hi);
                const bool valid = (pk >= 0) && (pk <= pq) && (pq - pk < 128);
                const float v = valid ? s[t][r] : -INFINITY; s[t][r] = v; mx = fmaxf(mx, v);
            }
        mx = fmaxf(mx, __shfl_xor(mx, 32));
        float sum = 0.f;
#pragma unroll
        for (int t = 0; t < 5; ++t)
#pragma unroll
            for (int r = 0; r < 16; ++r) { const float e = __builtin_amdgcn_exp2f(s[t][r] - mx); s[t][r] = e; sum += e; }
        sum += __shfl_xor(sum, 32);
        sum += __builtin_amdgcn_exp2f(sink2 - mx);
        const float inv = 1.f / sum;
        f32x16 o[2]; o[0] = f32x16{}; o[1] = f32x16{};
#pragma unroll
        for (int t = 0; t < 5; ++t)
#pragma unroll
            for (int ss = 0; ss < 2; ++ss) {
                u32x4 pw; pw.x = pk2(s[t][8 * ss + 0], s[t][8 * ss + 1]); pw.y = pk2(s[t][8 * ss + 2], s[t][8 * ss + 3]); pw.z = pk2(s[t][8 * ss + 4], s[t][8 * ss + 5]); pw.w = pk2(s[t][8 * ss + 6], s[t][8 * ss + 7]);
                const bf16x8 pf = __builtin_bit_cast(bf16x8, pw);
#pragma unroll
                for (int dt = 0; dt < 2; ++dt) {
                    const bf16_t* vp = Vt + (32 * dt + r32) * 200 + 32 * (qhalf + t) + 16 * ss + 4 * hi;
                    const u32x2 lo = *(const u32x2*)vp, h2 = *(const u32x2*)(vp + 8);
                    u32x4 vw; vw.x = lo.x; vw.y = lo.y; vw.z = h2.x; vw.w = h2.y;
                    o[dt] = __builtin_amdgcn_mfma_f32_32x32x16_bf16(__builtin_bit_cast(bf16x8, vw), pf, o[dt], 0, 0, 0);
                }
            }
        bf16_t* orow = A + (rowbase + pq) * 1024 + 512 + qh * 64;
#pragma unroll
        for (int dt = 0; dt < 2; ++dt)
#pragma unroll
            for (int g4 = 0; g4 < 4; ++g4) {
                u32x2 q; q.x = pk2(o[dt][4 * g4] * inv, o[dt][4 * g4 + 1] * inv); q.y = pk2(o[dt][4 * g4 + 2] * inv, o[dt][4 * g4 + 3] * inv);
                *(u32x2*)(orow + 32 * dt + 8 * g4 + 4 * hi) = q;
            }
        __syncthreads();
    }
}

template <int MODE> struct LaCfg {
    static constexpr int DK = MODE ? 128 : 64, LDK = DK + 4, PITCH = MODE ? 3584 : 2560;
    static constexpr int QCOL = MODE ? 1536 : 0, KCOL = MODE ? 0 : 256, ZCOL = MODE ? 2048 : 512, VCOL = MODE ? 2560 : 768, GCOL = MODE ? 3072 : 1280, OCOL = MODE ? 512 : 0;
};
template <int MODE, bool NEEDQ> __device__ __forceinline__ void la_load(const Ctx& C, int l, int b, int h, int c, float* Qs, float* Ks, float* Gs, bf16_t* Vb) {
    typedef LaCfg<MODE> Cf; const Params& p = C.p; const int j = l >> 1;
    const bf16_t* proj = (const bf16_t*)(p.ws + WS_R1);
    const size_t row0 = (size_t)b * SEQ_ + (size_t)c * 64;
    constexpr int NG = Cf::DK / 8;
    for (int u = C.tid; u < 64 * NG; u += NTHR) {
        const int r = u / NG, g8 = u % NG, kk = g8 * 8;
        const bf16_t* rp = proj + (row0 + r) * Cf::PITCH + h * Cf::DK + kk;
        const u32x4 zr = *(const u32x4*)(rp + Cf::ZCOL);
        float z[8] = {bflo(zr.x), bfhi(zr.x), bflo(zr.y), bfhi(zr.y), bflo(zr.z), bfhi(zr.z), bflo(zr.w), bfhi(zr.w)};
        float kv[8], lg[8];
        if (MODE == 0) {
            const u32x4 kr = *(const u32x4*)(rp + Cf::KCOL);
            kv[0] = bflo(kr.x); kv[1] = bfhi(kr.x); kv[2] = bflo(kr.y); kv[3] = bfhi(kr.y); kv[4] = bflo(kr.z); kv[5] = bfhi(kr.z); kv[6] = bflo(kr.w); kv[7] = bfhi(kr.w);
            const float* gb = p.gla_gate_b + j * 256 + h * 64 + kk;
#pragma unroll
            for (int e = 0; e < 8; ++e) { const float x = z[e] + gb[e]; lg[e] = (fminf(x, 0.f) - log1pf(__expf(-fabsf(x)))) * (LOG2E_ / 16.f); }
        } else {
            const float* lg0 = p.hgrn_lb_logits + h * 128 + kk;
#pragma unroll
            for (int e = 0; e < 8; ++e) {
                const float lb = (j == 0) ? 0.f : sigmoidf_(lg0[512 + e] - lg0[e]);
                const float sg = 1.f / (1.f + __expf(-z[e])), sgn = 1.f / (1.f + __expf(z[e]));
                lg[e] = __log2f(lb + (1.f - lb) * sg); kv[e] = (1.f - lb) * sgn;
            }
        }
        float* kd = Ks + r * Cf::LDK + kk; float* gd = Gs + r * Cf::LDK + kk;
        *(f32x4*)kd = (f32x4){kv[0], kv[1], kv[2], kv[3]}; *(f32x4*)(kd + 4) = (f32x4){kv[4], kv[5], kv[6], kv[7]};
        *(f32x4*)gd = (f32x4){lg[0], lg[1], lg[2], lg[3]}; *(f32x4*)(gd + 4) = (f32x4){lg[4], lg[5], lg[6], lg[7]};
        if (NEEDQ) {
            const u32x4 qr = *(const u32x4*)(rp + Cf::QCOL);
            float q[8] = {bflo(qr.x), bfhi(qr.x), bflo(qr.y), bfhi(qr.y), bflo(qr.z), bfhi(qr.z), bflo(qr.w), bfhi(qr.w)};
#pragma unroll
            for (int e = 0; e < 8; ++e) q[e] = MODE ? siluf_(q[e]) * 0.08838834764831845f : q[e] * 0.125f;
            float* qd = Qs + r * Cf::LDK + kk;
            *(f32x4*)qd = (f32x4){q[0], q[1], q[2], q[3]}; *(f32x4*)(qd + 4) = (f32x4){q[4], q[5], q[6], q[7]};
        }
    }
    for (int u = C.tid; u < 64 * 16; u += NTHR) {
        const int r = u >> 4, g8 = u & 15;
        *(u32x4*)(Vb + r * 128 + g8 * 8) = *(const u32x4*)(proj + (row0 + r) * Cf::PITCH + Cf::VCOL + h * 128 + g8 * 8);
    }
}
template <int MODE> __device__ __forceinline__ void la_cumsum(const Ctx& C, float* Gs) {
    typedef LaCfg<MODE> Cf;
    if (C.tid < Cf::DK) { float a = 0.f; float* g = Gs + C.tid;
#pragma unroll 8
        for (int r = 0; r < 64; ++r) { a += g[r * Cf::LDK]; g[r * Cf::LDK] = a; } }
}

template <int MODE> __device__ __forceinline__ void phase_la_p1(const Ctx& C, int l) {
    typedef LaCfg<MODE> Cf; const Params& p = C.p; constexpr int DK = Cf::DK, LDK = Cf::LDK;
    float* Ks = (float*)C.lds; float* Gs = Ks + 64 * LDK; bf16_t* Vb = (bf16_t*)(Gs + 64 * LDK);
    bf16_t* ST = (bf16_t*)(p.ws + WS_ST); float* TOT = (float*)(p.ws + WS_TOT);
    constexpr int NVG = NTHR / (DK / 4), VG = 128 / NVG;
    const int vg = C.tid % NVG, kg = C.tid / NVG;
    for (int it = blockIdx.x; it < 2048; it += gridDim.x) {
        const int bh = it >> 6, c = it & 63, b = bh >> 2, h = bh & 3;
        la_load<MODE, false>(C, l, b, h, c, nullptr, Ks, Gs, Vb);
        __syncthreads();
        la_cumsum<MODE>(C, Gs);
        __syncthreads();
        for (int u = C.tid; u < 64 * DK; u += NTHR) { const int r = u / DK, k = u % DK; Ks[r * LDK + k] *= __builtin_amdgcn_exp2f(Gs[63 * LDK + k] - Gs[r * LDK + k]); }
        if (C.tid < DK) TOT[(size_t)it * 128 + C.tid] = Gs[63 * LDK + C.tid];
        __syncthreads();
        float acc[4][VG];
#pragma unroll
        for (int a = 0; a < 4; ++a)
#pragma unroll
            for (int v = 0; v < VG; ++v) acc[a][v] = 0.f;
#pragma unroll 4
        for (int jr = 0; jr < 64; ++jr) {
            const f32x4 k4 = *(const f32x4*)(Ks + jr * LDK + 4 * kg);
            float vv[VG];
            if (VG == 8) { const u32x4 w = *(const u32x4*)(Vb + jr * 128 + vg * 8); vv[0] = bflo(w.x); vv[1] = bfhi(w.x); vv[2] = bflo(w.y); vv[3] = bfhi(w.y); vv[4 % VG] = bflo(w.z); vv[5 % VG] = bfhi(w.z); vv[6 % VG] = bflo(w.w); vv[7 % VG] = bfhi(w.w); }
            else { const u32x2 w = *(const u32x2*)(Vb + jr * 128 + vg * 4); vv[0] = bflo(w.x); vv[1] = bfhi(w.x); vv[2] = bflo(w.y); vv[3] = bfhi(w.y); }
#pragma unroll
            for (int a = 0; a < 4; ++a)
#pragma unroll
                for (int v = 0; v < VG; ++v) acc[a][v] += k4[a] * vv[v];
        }
        bf16_t* so = ST + (size_t)it * DK * 128 + (size_t)(4 * kg) * 128 + vg * VG;
#pragma unroll
        for (int a = 0; a < 4; ++a) {
            if (VG == 8) { u32x4 w; w.x = pk2(acc[a][0], acc[a][1]); w.y = pk2(acc[a][2], acc[a][3]); w.z = pk2(acc[a][4 % VG], acc[a][5 % VG]); w.w = pk2(acc[a][6 % VG], acc[a][7 % VG]); *(u32x4*)(so + a * 128) = w; }
            else { u32x2 w; w.x = pk2(acc[a][0], acc[a][1]); w.y = pk2(acc[a][2], acc[a][3]); *(u32x2*)(so + a * 128) = w; }
        }
        __syncthreads();
    }
}

template <int MODE> __device__ __forceinline__ void phase_la_p2(const Ctx& C) {
    typedef LaCfg<MODE> Cf; const Params& p = C.p; constexpr int DK = Cf::DK;
    bf16_t* ST = (bf16_t*)(p.ws + WS_ST); const float* TOT = (const float*)(p.ws + WS_TOT);
    for (int u = blockIdx.x * NTHR + C.tid; u < 32 * DK * 16; u += gridDim.x * NTHR) {
        const int v8 = u & 15, k = (u >> 4) % DK, bh = (u >> 4) / DK;
        float S[8];
#pragma unroll
        for (int e = 0; e < 8; ++e) S[e] = 0.f;
        bf16_t* base = ST + ((size_t)bh * 64 * DK + k) * 128 + v8 * 8;
        const float* tb = TOT + (size_t)bh * 64 * 128 + k;
#pragma unroll 8
        for (int c = 0; c < 64; ++c) {
            u32x4* ptr = (u32x4*)(base + (size_t)c * DK * 128);
            const u32x4 w = *ptr; const float dec = __builtin_amdgcn_exp2f(tb[c * 128]);
            u32x4 o; o.x = pk2(S[0], S[1]); o.y = pk2(S[2], S[3]); o.z = pk2(S[4], S[5]); o.w = pk2(S[6], S[7]);
            *ptr = o;
            S[0] = S[0] * dec + bflo(w.x); S[1] = S[1] * dec + bfhi(w.x); S[2] = S[2] * dec + bflo(w.y); S[3] = S[3] * dec + bfhi(w.y);
            S[4] = S[4] * dec + bflo(w.z); S[5] = S[5] * dec + bfhi(w.z); S[6] = S[6] * dec + bflo(w.w); S[7] = S[7] * dec + bfhi(w.w);
        }
    }
}

template <int MODE> __device__ __forceinline__ void phase_la_p3(const Ctx& C, int l) {
    typedef LaCfg<MODE> Cf; const Params& p = C.p; constexpr int DK = Cf::DK, LDK = Cf::LDK, KG = DK / 4;
    float* Qs = (float*)C.lds; float* Ks = Qs + 64 * LDK; float* Gs = Ks + 64 * LDK; bf16_t* Vb = (bf16_t*)(Gs + 64 * LDK); float* SC = (float*)(Vb + 64 * 128);
    float* SS = Ks;
    static_assert(DK * 128 <= 2 * 64 * LDK, "state overlay");
    const bf16_t* ST = (const bf16_t*)(p.ws + WS_ST); const bf16_t* proj = (const bf16_t*)(p.ws + WS_R1); bf16_t* A = (bf16_t*)(p.ws + WS_A);
    const float* nw = (MODE ? p.hgrn_norm_w : p.gla_norm_w) + (l >> 1) * 128;
    const int ig = C.tid >> 5, vg = C.tid & 31;
    for (int it = blockIdx.x; it < 2048; it += gridDim.x) {
        const int bh = it >> 6, c = it & 63, b = bh >> 2, h = bh & 3;
        la_load<MODE, true>(C, l, b, h, c, Qs, Ks, Gs, Vb);
        for (int u = C.tid; u < 64 * 64 / 4; u += NTHR) *(f32x4*)(SC + 4 * u) = (f32x4){0.f, 0.f, 0.f, 0.f};
        __syncthreads();
        la_cumsum<MODE>(C, Gs);
        __syncthreads();
        for (int u = C.tid; u < 136 * KG; u += NTHR) {
            const int t = u % 136, kg = u / 136;
            int ib = (int)((sqrtf(8.f * (float)t + 1.f) - 1.f) * 0.5f);
            while ((ib + 1) * (ib + 2) / 2 <= t) ++ib;
            while (ib * (ib + 1) / 2 > t) --ib;
            const int jb = t - ib * (ib + 1) / 2;
            f32x4 qv[4], gq[4], kv[4], gk[4];
#pragma unroll
            for (int a = 0; a < 4; ++a) { qv[a] = *(const f32x4*)(Qs + (4 * ib + a) * LDK + 4 * kg); gq[a] = *(const f32x4*)(Gs + (4 * ib + a) * LDK + 4 * kg);
                kv[a] = *(const f32x4*)(Ks + (4 * jb + a) * LDK + 4 * kg); gk[a] = *(const f32x4*)(Gs + (4 * jb + a) * LDK + 4 * kg); }
            float acc[4][4];
#pragma unroll
            for (int a = 0; a < 4; ++a)
#pragma unroll
                for (int bb = 0; bb < 4; ++bb) acc[a][bb] = 0.f;
#pragma unroll
            for (int ch = 0; ch < 4; ++ch) {
                const float gref = gk[3][ch];
                float qe[4], ke[4];
#pragma unroll
                for (int a = 0; a < 4; ++a) { qe[a] = qv[a][ch] * __builtin_amdgcn_exp2f(gq[a][ch] - gref); ke[a] = kv[a][ch] * __builtin_amdgcn_exp2f(gref - gk[a][ch]); }
#pragma unroll
                for (int a = 0; a < 4; ++a)
#pragma unroll
                    for (int bb = 0; bb < 4; ++bb) acc[a][bb] += qe[a] * ke[bb];
            }
#pragma unroll
            for (int a = 0; a < 4; ++a)
#pragma unroll
                for (int bb = 0; bb < 4; ++bb)
                    if (4 * jb + bb <= 4 * ib + a) __hip_atomic_fetch_add((LAS3 float*)(SC + (4 * ib + a) * 64 + 4 * jb + bb), acc[a][bb], __ATOMIC_RELAXED, __HIP_MEMORY_SCOPE_WORKGROUP);
        }
        __syncthreads();
        for (int u = C.tid; u < 64 * DK; u += NTHR) { const int r = u / DK, k = u % DK; Qs[r * LDK + k] *= __builtin_amdgcn_exp2f(Gs[r * LDK + k]); }
        __syncthreads();
        { const bf16_t* sp = ST + (size_t)it * DK * 128;
          for (int u = C.tid; u < DK * 16; u += NTHR) { const u32x4 w = *(const u32x4*)(sp + u * 8); float* d = SS + u * 8;
              *(f32x4*)d = (f32x4){bflo(w.x), bfhi(w.x), bflo(w.y), bfhi(w.y)}; *(f32x4*)(d + 4) = (f32x4){bflo(w.z), bfhi(w.z), bflo(w.w), bfhi(w.w)}; } }
        __syncthreads();
        float o[4][4];
#pragma unroll
        for (int a = 0; a < 4; ++a)
#pragma unroll
            for (int v = 0; v < 4; ++v) o[a][v] = 0.f;
        for (int j4 = 0; j4 <= ig; ++j4) {
            f32x4 sc[4]; float vv[4][4];
#pragma unroll
            for (int a = 0; a < 4; ++a) sc[a] = *(const f32x4*)(SC + (4 * ig + a) * 64 + 4 * j4);
#pragma unroll
            for (int jj = 0; jj < 4; ++jj) { const u32x2 w = *(const u32x2*)(Vb + (4 * j4 + jj) * 128 + 4 * vg); vv[jj][0] = bflo(w.x); vv[jj][1] = bfhi(w.x); vv[jj][2] = bflo(w.y); vv[jj][3] = bfhi(w.y); }
#pragma unroll
            for (int a = 0; a < 4; ++a)
#pragma unroll
                for (int jj = 0; jj < 4; ++jj)
#pragma unroll
                    for (int v = 0; v < 4; ++v) o[a][v] += sc[a][jj] * vv[jj][v];
        }
#pragma unroll 2
        for (int k4 = 0; k4 < KG; ++k4) {
            f32x4 q4[4], s4[4];
#pragma unroll
            for (int a = 0; a < 4; ++a) { q4[a] = *(const f32x4*)(Qs + (4 * ig + a) * LDK + 4 * k4); s4[a] = *(const f32x4*)(SS + (4 * k4 + a) * 128 + 4 * vg); }
#pragma unroll
            for (int a = 0; a < 4; ++a)
#pragma unroll
                for (int kk = 0; kk < 4; ++kk)
#pragma unroll
                    for (int v = 0; v < 4; ++v) o[a][v] += q4[a][kk] * s4[kk][v];
        }
        const f32x4 nw4 = *(const f32x4*)(nw + 4 * vg);
#pragma unroll
        for (int a = 0; a < 4; ++a) {
            float ss = o[a][0] * o[a][0] + o[a][1] * o[a][1] + o[a][2] * o[a][2] + o[a][3] * o[a][3];
            ss += __shfl_xor(ss, 1); ss += __shfl_xor(ss, 2); ss += __shfl_xor(ss, 4); ss += __shfl_xor(ss, 8); ss += __shfl_xor(ss, 16);
            const float rs = rsqrtf(ss * (1.f / 128.f) + 1e-6f);
            const size_t row = (size_t)b * SEQ_ + (size_t)c * 64 + 4 * ig + a;
            const u32x2 gw = *(const u32x2*)(proj + row * Cf::PITCH + Cf::GCOL + h * 128 + 4 * vg);
            u32x2 q; q.x = pk2(o[a][0] * rs * nw4[0] * siluf_(bflo(gw.x)), o[a][1] * rs * nw4[1] * siluf_(bfhi(gw.x)));
            q.y = pk2(o[a][2] * rs * nw4[2] * siluf_(bflo(gw.y)), o[a][3] * rs * nw4[3] * siluf_(bfhi(gw.y)));
            *(u32x2*)(A + row * 1024 + Cf::OCOL + h * 128 + 4 * vg) = q;
        }
        __syncthreads();
    }
}


typedef unsigned u32x16 __attribute__((ext_vector_type(16)));
__device__ __forceinline__ void load_params(Params& p) {
    auto kp = __builtin_amdgcn_kernarg_segment_ptr();
    u32x16 a, b, c, d;
    asm volatile("s_load_dwordx16 %0, %4, 0x0\n\ts_load_dwordx16 %1, %4, 0x40\n\ts_load_dwordx16 %2, %4, 0x80\n\ts_load_dwordx16 %3, %4, 0xc0\n\ts_waitcnt lgkmcnt(0)"
                 : "=&s"(a), "=&s"(b), "=&s"(c), "=&s"(d) : "s"(kp) : "memory");
    unsigned long long q[32];
#pragma unroll
    for (int i = 0; i < 8; ++i) { q[i] = ((unsigned long long)a[2 * i + 1] << 32) | a[2 * i]; q[8 + i] = ((unsigned long long)b[2 * i + 1] << 32) | b[2 * i];
        q[16 + i] = ((unsigned long long)c[2 * i + 1] << 32) | c[2 * i]; q[24 + i] = ((unsigned long long)d[2 * i + 1] << 32) | d[2 * i]; }
    p.x = (const float*)q[0]; p.c = (const float*)q[1]; p.positions = (const int*)q[2]; p.mod_w = (const float*)q[3]; p.mod_b = (const float*)q[4]; p.norm_mix_w = (const float*)q[5]; p.norm_ffn_w = (const float*)q[6];
    p.ev_w_in = (const float*)q[7]; p.gla_gate_w = (const float*)q[8]; p.gla_gate_b = (const float*)q[9]; p.gla_norm_w = (const float*)q[10]; p.swa_sinks = (const float*)q[11]; p.ev_w_out = (const float*)q[12];
    p.od_w_in = (const float*)q[13]; p.diff_lambda = (const float*)q[14]; p.diff_norm_w = (const float*)q[15]; p.hgrn_lb_logits = (const float*)q[16]; p.hgrn_norm_w = (const float*)q[17]; p.od_w_out = (const float*)q[18];
    p.ffn_w_in = (const float*)q[19]; p.ffn_conv_w = (const float*)q[20]; p.ffn_conv_b = (const float*)q[21]; p.ffn_w_out = (const float*)q[22]; p.final_norm_w = (const float*)q[23];
    p.out = (float*)q[24]; p.ws = (unsigned char*)q[25];
}

__global__ void __launch_bounds__(NTHR, 2) fwd_megakernel(Params pin) {
    extern __shared__ __attribute__((aligned(16))) unsigned char lds[];
    cg::grid_group grid = cg::this_grid();
    Ctx C; C.lds = lds; C.tid = threadIdx.x; C.lane = C.tid & 63; C.wave = __builtin_amdgcn_readfirstlane(C.tid >> 6);
    C.gw = blockIdx.x * 8 + C.wave; C.ngw = gridDim.x * 8;
    PG8_LAS unsigned char* ldsg = (PG8_LAS unsigned char*)lds;
#define RP() do { load_params(C.p); C.tid = otid_(); C.lane = C.tid & 63; C.wave = __builtin_amdgcn_readfirstlane(C.tid >> 6); C.gw = blockIdx.x * 8 + C.wave; } while (0)
#define WSP(off) (C.p.ws + (off))

#ifndef NO_PRO
    RP(); phase_prologue(C);
#endif
    grid.sync();
#pragma unroll 1
    for (int l = 0; l < 4; ++l) {
        const bool even = !(l & 1);
#ifndef NO_CONV
        RP(); phase_convert(C, l);
#endif
#ifndef NO_NORM
        RP(); phase_norm(C, (l == 0) ? C.p.x : C.p.out, C.p.norm_mix_w + l * 1024, (const float*)WSP(WS_MOD) + (size_t)l * 8 * 6144, 0, 1024, (bf16_t*)WSP(WS_A));
#endif
        grid.sync();
        {
            RP();
            const int N = even ? 2560 : 3584;
            pg8::Gemm g{(const bf16_t*)WSP(WS_A), (const bf16_t*)WSP(WS_WIN), T_, N, 1024}; pg8::StaticOrder S; S.init(T_, N, (int)gridDim.x, (int)blockIdx.x);
            pg8::EpiProj E{(bf16_t*)WSP(WS_R1), N, even ? 0x7C000u : 0xFFu, even ? 0x3C000u : 0xFu, QSCALE_, (const float*)WSP(WS_COS), (const float*)WSP(WS_SIN)};
#ifndef NO_GPROJ
            pg8::gemm_phase<pg8::EpiProj, pg8::StaticOrder, true, true>(ldsg, g, S, E);
#endif
        }
        grid.sync();
        if (even) {
#ifndef NO_SWA
            RP(); phase_swa(C, l);
#endif
#ifndef NO_P1
            RP(); phase_la_p1<0>(C, l);
#endif
            grid.sync();
#ifndef NO_P2
            RP(); phase_la_p2<0>(C);
#endif
            grid.sync();
#ifndef NO_P3
            RP(); phase_la_p3<0>(C, l);
#endif
        } else {
            {
                RP();
                const bf16_t* R1 = (const bf16_t*)WSP(WS_R1); bf16_t* X2 = (bf16_t*)WSP(WS_X2);
                const int G = (int)gridDim.x, bid = (int)blockIdx.x;
#pragma unroll 1
                for (int i = 0; i * G < 2048; ++i) {
                    const int L = i * G + ((i & 1) ? (G - 1 - bid) : bid);
                    if (L >= 2048) continue;
                    const int qb = 15 - (L >> 7), bh = L & 127, b = bh >> 4, hv = bh & 15;
                    const attn_body::bf16* Q = (const attn_body::bf16*)(R1 + (hv >> 1) * 64);
                    const attn_body::bf16* K = (const attn_body::bf16*)(R1 + 512 + (hv >> 1) * 64);
                    const attn_body::bf16* V = (const attn_body::bf16*)(R1 + 1024 + (hv >> 2) * 128 + (hv & 1) * 64);
#ifndef NO_ATTN
                    attn_body::attn_unit<8>(b, hv, qb, Q, K, V, (attn_body::bf16*)(X2 + hv * 64), (char*)lds);
#endif
                }
            }
#ifndef NO_P1
            RP(); phase_la_p1<1>(C, l);
#endif
            grid.sync();
#ifndef NO_P2
            RP(); phase_la_p2<1>(C);
#endif
#ifndef NO_COMB
            RP(); phase_diff_combine(C, l);
#endif
            grid.sync();
#ifndef NO_P3
            RP(); phase_la_p3<1>(C, l);
#endif
        }
        grid.sync();
        {
            RP();
            pg8::Gemm g{(const bf16_t*)WSP(WS_A), (const bf16_t*)WSP(WS_WOUT), T_, 1024, 1024}; pg8::StaticOrder S; S.init(T_, 1024, (int)gridDim.x, (int)blockIdx.x);
            pg8::EpiRes E{(l == 0) ? C.p.x : C.p.out, C.p.out, (const float*)WSP(WS_MOD) + (size_t)l * 8 * 6144 + 2048};
#ifndef NO_GRES
            pg8::gemm_phase<pg8::EpiRes, pg8::StaticOrder, true, true>(ldsg, g, S, E);
#endif
        }
        grid.sync();
#ifndef NO_NORM
        RP(); phase_norm(C, C.p.out, C.p.norm_ffn_w + l * 1024, (const float*)WSP(WS_MOD) + (size_t)l * 8 * 6144, 3072, 4096, (bf16_t*)WSP(WS_A));
#endif
        grid.sync();
        {
            RP();
            pg8::Gemm g{(const bf16_t*)WSP(WS_A), (const bf16_t*)WSP(WS_FIN), T_, 5632, 1024}; pg8::StaticOrder S; S.init(T_, 5632, (int)gridDim.x, (int)blockIdx.x);
            pg8::EpiFfn E{(bf16_t*)WSP(WS_R1), (float*)WSP(WS_HP), (float*)WSP(WS_HU), (float*)WSP(WS_HA), C.p.ffn_conv_w + (size_t)l * 3 * DFF_, C.p.ffn_conv_b + (size_t)l * DFF_};
#ifndef NO_GFFN
            pg8::gemm_phase<pg8::EpiFfn, pg8::StaticOrder, true, true>(ldsg, g, S, E);
#endif
        }
        grid.sync();
#ifndef NO_FIX
        RP(); phase_ffn_fixup(C, l);
#endif
        grid.sync();
        {
            RP();
            pg8::Gemm g{(const bf16_t*)WSP(WS_R1), (const bf16_t*)WSP(WS_FOUT), T_, 1024, DFF_}; pg8::StaticOrder S; S.init(T_, 1024, (int)gridDim.x, (int)blockIdx.x);
            pg8::EpiRes E{C.p.out, C.p.out, (const float*)WSP(WS_MOD) + (size_t)l * 8 * 6144 + 5120};
#ifndef NO_GRES
            pg8::gemm_phase<pg8::EpiRes, pg8::StaticOrder, true, true>(ldsg, g, S, E);
#endif
        }
        grid.sync();
    }
    RP(); phase_final_norm(C, C.p.out, C.p.final_norm_w);
}

extern "C" void kernel_launch(void* const* d_in, const int* in_sizes, int n_in, void* d_out, int out_size, void* d_ws, size_t ws_size, hipStream_t stream) {
    static int grid_blocks = 0;
    if (grid_blocks == 0) {
        if (n_in != 24 || ws_size < WS_END) { fprintf(stderr, "kernel_launch: unexpected n_in %d / ws %zu\n", n_in, ws_size); grid_blocks = -1; return; }
        int dev = 0, cus = 0, per_cu = 0;
        hipGetDevice(&dev); hipDeviceGetAttribute(&cus, hipDeviceAttributeMultiprocessorCount, dev);
        if (hipFuncSetAttribute((const void*)fwd_megakernel, hipFuncAttributeMaxDynamicSharedMemorySize, LDS_BYTES) != hipSuccess) { fprintf(stderr, "kernel_launch: hipFuncSetAttribute failed\n"); grid_blocks = -1; return; }
        if (hipOccupancyMaxActiveBlocksPerMultiprocessor(&per_cu, (const void*)fwd_megakernel, NTHR, LDS_BYTES) != hipSuccess || per_cu < 1) { fprintf(stderr, "kernel_launch: occupancy query gave %d\n", per_cu); per_cu = 1; }
        (void)hipGetLastError();
        grid_blocks = cus * per_cu;
    }
    if (grid_blocks < 0) return;
    Params p{};
    p.x = (const float*)d_in[0]; p.c = (const float*)d_in[1]; p.positions = (const int*)d_in[2]; p.mod_w = (const float*)d_in[3]; p.mod_b = (const float*)d_in[4];
    p.norm_mix_w = (const float*)d_in[5]; p.norm_ffn_w = (const float*)d_in[6]; p.ev_w_in = (const float*)d_in[7]; p.gla_gate_w = (const float*)d_in[8];
    p.gla_gate_b = (const float*)d_in[9]; p.gla_norm_w = (const float*)d_in[10]; p.swa_sinks = (const float*)d_in[11]; p.ev_w_out = (const float*)d_in[12];
    p.od_w_in = (const float*)d_in[13]; p.diff_lambda = (const float*)d_in[14]; p.diff_norm_w = (const float*)d_in[15]; p.hgrn_lb_logits = (const float*)d_in[16];
    p.hgrn_norm_w = (const float*)d_in[17]; p.od_w_out = (const float*)d_in[18]; p.ffn_w_in = (const float*)d_in[19]; p.ffn_conv_w = (const float*)d_in[20];
    p.ffn_conv_b = (const float*)d_in[21]; p.ffn_w_out = (const float*)d_in[22]; p.final_norm_w = (const float*)d_in[23];
    p.out = (float*)d_out; p.ws = (unsigned char*)d_ws;
    void* args[] = {&p};
    hipError_t e = hipLaunchCooperativeKernel((const void*)fwd_megakernel, dim3(grid_blocks), dim3(NTHR), args, LDS_BYTES, stream);
    if (e != hipSuccess) fprintf(stderr, "cooperative launch failed: %s (grid %d)\n", hipGetErrorString(e), grid_blocks);
}
```

```cpp
#include <hip/hip_runtime.h>
#include <hip/hip_cooperative_groups.h>
#include <hip/hip_bf16.h>
#include <cstdio>
#include <cstdint>
#include <cmath>
__device__ __forceinline__ int otid_() { int t = threadIdx.x; asm volatile("" : "+v"(t)); return t; }
namespace pg8 {
#define PG8_LAS __attribute__((address_space(3)))
typedef unsigned short bf16_t;
typedef short bf16x8 __attribute__((ext_vector_type(8)));
typedef float f32x4 __attribute__((ext_vector_type(4)));
typedef unsigned u32x4 __attribute__((ext_vector_type(4)));
constexpr int BM = 256, BK = 64, HALF = 128, HTB = HALF * BK * 2  , STAGE_BYTES = 8 * HTB, NXCD = 8, WGM = 8;

__host__ __device__ __forceinline__ int lds_byte(int r, int c) { const int st = (r >> 4) * 2 + (c >> 5), rr = r & 15, cc = c & 31, ob = rr * 64 + cc * 2; return st * 1024 + (ob ^ (((ob >> 9) & 1) << 5)); }
__host__ __device__ __forceinline__ void stage_rc(int b, int& R, int& C) { const int st = b / 1024, sb = b % 1024, swz = sb ^ (((sb >> 9) & 1) << 5); R = (st >> 1) * 16 + swz / 64; C = (st & 1) * 32 + (swz % 64) / 2; }
__host__ __device__ __forceinline__ int perm32(int rho) { const int n = rho >> 4, i = rho & 15; return 8 * (i >> 2) + 4 * n + (i & 3); }

struct Unit { int pm, pn; };
struct Gemm { const bf16_t* A; const bf16_t* Bt; int M, N, K; };

struct StaticOrder {
    int nM, nN, nwg, G, c;
    __host__ __device__ void init(int M, int N, int G_, int c_) { nM = M / BM; nN = N / BM; nwg = nM * nN; G = G_; c = c_; }
    __host__ __device__ bool next(int i, Unit& u) const {
        const long L = (long)i * G + c; if (L >= nwg) return false;
        int wgid = (int)L; { const int q = nwg / NXCD, r = nwg % NXCD, xcd = wgid % NXCD, off = wgid / NXCD; wgid = (xcd < r ? xcd * (q + 1) : r * (q + 1) + (xcd - r) * q) + off; }
        const int nig = WGM * nN, gid = wgid / nig, fm = gid * WGM, gsz = (nM - fm) < WGM ? (nM - fm) : WGM;
        u.pm = fm + ((wgid % nig) % gsz); u.pn = (wgid % nig) / gsz; return true;
    }
    __device__ __forceinline__ void a_ready(const Unit&) const {}
    __device__ __forceinline__ void done(const Unit&) const {}
};

__device__ __forceinline__ unsigned cvt_pk_bf16(float lo, float hi) { unsigned r; asm volatile("v_cvt_pk_bf16_f32 %0, %1, %2" : "=v"(r) : "v"(lo), "v"(hi)); return r; }
typedef float f32x2 __attribute__((ext_vector_type(2)));
template <class Epi, class Sched, bool ALIGN_EPI = false, bool SP2 = false>
__device__ __forceinline__ void gemm_phase(PG8_LAS unsigned char* lds, const Gemm g, const Sched& S, const Epi& E) {
    const int tid = otid_(), wid = __builtin_amdgcn_readfirstlane(tid >> 6), lane = tid & 63, wr = wid >> 2, wc = wid & 3, fr = lane & 15, fq = lane >> 4;
    const int K = g.K, nt = K / BK;
    unsigned voffA[2], voffB[2];
#pragma unroll
    for (int i = 0; i < 2; ++i) { int R, C; stage_rc(tid * 16 + i * 8192, R, C); const int Rb = Epi::PERM ? ((R & ~31) + perm32(R & 31)) : R;
        voffA[i] = (unsigned)(R * K + C) * 2u; voffB[i] = (unsigned)(Rb * K + C) * 2u; }
    const size_t kstep = (size_t)(BK * 2);
    const size_t hstep = (size_t)HALF * K * 2;
    const size_t tstep = 2 * hstep;
    const unsigned ldsw = (unsigned)wid * 1024u;
    const int aoff = lds_byte(wr * 64 + fr, fq * 8), boff = lds_byte(wc * 32 + fr, fq * 8);
#define PG8_SA(b, h) (((b) * 2 + (h)) * HTB)
#define PG8_SB(b, h) ((4 + (b) * 2 + (h)) * HTB)
#define PG8_STAGE(bufoff, gbase, voff) do { _Pragma("unroll") for (int _i = 0; _i < 2; ++_i) \
        __builtin_amdgcn_global_load_lds((const unsigned*)((const char*)(gbase) + (voff)[_i]), (PG8_LAS unsigned*)(lds + (bufoff) + ldsw + _i * 8192), 16, 0, 0); } while (0)
#define PG8_LDA(dst, b, h) do { _Pragma("unroll") for (int m = 0; m < 4; ++m) _Pragma("unroll") for (int k = 0; k < 2; ++k) dst[m][k] = *(const PG8_LAS bf16x8*)(lds + PG8_SA(b, h) + aoff + m * 2048 + k * 1024); } while (0)
#define PG8_LDB(dst, b, h) do { _Pragma("unroll") for (int n = 0; n < 2; ++n) _Pragma("unroll") for (int k = 0; k < 2; ++k) dst[n][k] = *(const PG8_LAS bf16x8*)(lds + PG8_SB(b, h) + boff + n * 2048 + k * 1024); } while (0)
#define PG8_MMA(ai, bj, At, Bt) do { __builtin_amdgcn_s_setprio(1); _Pragma("unroll") for (int m = 0; m < 4; ++m) _Pragma("unroll") for (int n = 0; n < 2; ++n) _Pragma("unroll") for (int k = 0; k < 2; ++k) \
        acc[ai][bj][m][n] = __builtin_amdgcn_mfma_f32_16x16x32_bf16(Bt[n][k], At[m][k], acc[ai][bj][m][n], 0, 0, 0); __builtin_amdgcn_s_setprio(0); } while (0)
#define PG8_WAIT_V(n) asm volatile("s_waitcnt vmcnt(" #n ")" ::: "memory")
#define PG8_WAIT_L(n) asm volatile("s_waitcnt lgkmcnt(" #n ")" ::: "memory")
#define PG8_BAR __builtin_amdgcn_s_barrier()
#define PG8_SCHED __builtin_amdgcn_sched_barrier(0)
    Unit cur, nxt; int ui = 0;
    if (!S.next(0, cur)) return;
    f32x4 acc[2][2][4][2];
#pragma unroll
    for (int a = 0; a < 2; ++a)
#pragma unroll
        for (int b = 0; b < 2; ++b)
#pragma unroll
            for (int m = 0; m < 4; ++m)
#pragma unroll
                for (int n = 0; n < 2; ++n) acc[a][b][m][n] = (f32x4){0.f, 0.f, 0.f, 0.f};
    bf16x8 At[4][2], B0[2][2], B1[2][2];
    const char* cA = (const char*)g.A + (size_t)cur.pm * tstep; const char* cB = (const char*)g.Bt + (size_t)cur.pn * tstep;
    S.a_ready(cur);
    if constexpr (SP2) {
        PG8_STAGE(PG8_SB(0, 0), cB, voffB); PG8_STAGE(PG8_SB(0, 1), cB + hstep, voffB); PG8_STAGE(PG8_SA(0, 0), cA, voffA); PG8_STAGE(PG8_SA(0, 1), cA + hstep, voffA);
        if (wr == 1) PG8_BAR;
        PG8_WAIT_V(2); PG8_BAR;
        PG8_STAGE(PG8_SB(1, 0), cB + kstep, voffB); PG8_STAGE(PG8_SA(1, 0), cA + kstep, voffA); PG8_STAGE(PG8_SB(1, 1), cB + hstep + kstep, voffB);
        PG8_WAIT_V(6); PG8_BAR;
    } else {
        PG8_STAGE(PG8_SB(0, 0), cB, voffB); PG8_STAGE(PG8_SA(0, 0), cA, voffA); PG8_STAGE(PG8_SB(0, 1), cB + hstep, voffB); PG8_STAGE(PG8_SA(0, 1), cA + hstep, voffA);
        if (wr == 1) PG8_BAR;
        PG8_WAIT_V(4); PG8_BAR;
        PG8_STAGE(PG8_SB(1, 0), cB + kstep, voffB); PG8_STAGE(PG8_SA(1, 0), cA + kstep, voffA); PG8_STAGE(PG8_SB(1, 1), cB + hstep + kstep, voffB);
        PG8_WAIT_V(6); PG8_BAR;
    }
    for (;;) {
        const bool has_next = S.next(ui + 1, nxt);
        const char* nA = has_next ? (const char*)g.A + (size_t)nxt.pm * tstep : cA; const char* nB = has_next ? (const char*)g.Bt + (size_t)nxt.pn * tstep : cB;
        for (int t = 0; t < nt; t += 2) {
            const bool last = (t == nt - 2);
            const char* a1 = cA + (size_t)(t + 1) * kstep;
            const char* a2 = last ? nA : cA + (size_t)(t + 2) * kstep; const char* b2 = last ? nB : cB + (size_t)(t + 2) * kstep;
            const char* a3 = a2 + kstep; const char* b3 = b2 + kstep;
            if (last && has_next) S.a_ready(nxt);
            if constexpr (SP2) {
            PG8_LDB(B0, 0, 0); PG8_LDB(B1, 0, 1); PG8_SCHED; PG8_LDA(At, 0, 0); PG8_STAGE(PG8_SA(1, 1), a1 + hstep, voffA);
            PG8_WAIT_V(8); PG8_WAIT_L(0); PG8_BAR; PG8_MMA(0, 0, At, B0); PG8_MMA(0, 1, At, B1); PG8_BAR; PG8_SCHED;
            PG8_LDA(At, 0, 1); PG8_STAGE(PG8_SB(0, 0), b2, voffB); PG8_STAGE(PG8_SB(0, 1), b2 + hstep, voffB); PG8_STAGE(PG8_SA(0, 0), a2, voffA);
            PG8_WAIT_V(8); PG8_WAIT_L(0); PG8_BAR; PG8_MMA(1, 0, At, B0); PG8_MMA(1, 1, At, B1); PG8_BAR; PG8_SCHED;
            PG8_LDB(B0, 1, 0); PG8_LDB(B1, 1, 1); PG8_SCHED; PG8_LDA(At, 1, 0); PG8_STAGE(PG8_SA(0, 1), a2 + hstep, voffA);
            PG8_WAIT_V(8); PG8_WAIT_L(0); PG8_BAR; PG8_MMA(0, 0, At, B0); PG8_MMA(0, 1, At, B1); PG8_BAR; PG8_SCHED;
            PG8_LDA(At, 1, 1); PG8_STAGE(PG8_SB(1, 0), b3, voffB); PG8_STAGE(PG8_SB(1, 1), b3 + hstep, voffB); PG8_STAGE(PG8_SA(1, 0), a3, voffA);
            PG8_WAIT_V(8); PG8_WAIT_L(0); PG8_BAR; PG8_MMA(1, 0, At, B0); PG8_MMA(1, 1, At, B1); PG8_BAR; PG8_SCHED;
            } else {
            PG8_LDB(B0, 0, 0); PG8_SCHED; PG8_LDA(At, 0, 0); PG8_STAGE(PG8_SA(1, 1), a1 + hstep, voffA);
            PG8_WAIT_L(8); PG8_BAR; PG8_WAIT_L(0); PG8_MMA(0, 0, At, B0); PG8_BAR; PG8_SCHED;
            PG8_LDB(B1, 0, 1); PG8_STAGE(PG8_SB(0, 0), b2, voffB);
            PG8_BAR; PG8_WAIT_L(0); PG8_MMA(0, 1, At, B1); PG8_BAR;
            PG8_LDA(At, 0, 1); PG8_STAGE(PG8_SA(0, 0), a2, voffA);
            PG8_BAR; PG8_WAIT_L(0); PG8_MMA(1, 0, At, B0); PG8_BAR; PG8_SCHED;
            PG8_STAGE(PG8_SB(0, 1), b2 + hstep, voffB);
            PG8_WAIT_V(6); PG8_BAR; PG8_MMA(1, 1, At, B1); PG8_BAR;
            PG8_LDB(B0, 1, 0); PG8_SCHED; PG8_LDA(At, 1, 0); PG8_STAGE(PG8_SA(0, 1), a2 + hstep, voffA);
            PG8_WAIT_L(8); PG8_BAR; PG8_WAIT_L(0); PG8_MMA(0, 0, At, B0); PG8_BAR; PG8_SCHED;
            PG8_LDB(B1, 1, 1); PG8_STAGE(PG8_SB(1, 0), b3, voffB);
            PG8_BAR; PG8_WAIT_L(0); PG8_MMA(0, 1, At, B1); PG8_BAR;
            PG8_LDA(At, 1, 1); PG8_STAGE(PG8_SA(1, 0), a3, voffA);
            PG8_BAR; PG8_WAIT_L(0); PG8_MMA(1, 0, At, B0); PG8_BAR; PG8_SCHED;
            PG8_STAGE(PG8_SB(1, 1), b3 + hstep, voffB);
            PG8_WAIT_V(6); PG8_BAR; PG8_MMA(1, 1, At, B1); PG8_BAR;
            }
        }
        if constexpr (ALIGN_EPI) { if (wr == 0) PG8_BAR; }
        if constexpr (!Epi::AFTER_DRAIN) { E(acc, cur, wr, wc, fr, fq); S.done(cur); }
        if (!has_next) break;
#pragma unroll
        for (int a = 0; a < 2; ++a)
#pragma unroll
            for (int b = 0; b < 2; ++b)
#pragma unroll
                for (int m = 0; m < 4; ++m)
#pragma unroll
                    for (int n = 0; n < 2; ++n) acc[a][b][m][n] = (f32x4){0.f, 0.f, 0.f, 0.f};
        cur = nxt; cA = nA; cB = nB; ++ui;
        if constexpr (ALIGN_EPI) { if (wr == 1) PG8_BAR; }
    }
    PG8_WAIT_V(0);
    if constexpr (!ALIGN_EPI) { if (wr == 0) PG8_BAR; }
    PG8_BAR;
    if constexpr (Epi::AFTER_DRAIN) { E.fused(acc, cur, wr, wc, fr, fq, lds, wid, lane); S.done(cur); }
#undef PG8_SA
#undef PG8_SB
#undef PG8_STAGE
#undef PG8_LDA
#undef PG8_LDB
#undef PG8_MMA
#undef PG8_WAIT_V
#undef PG8_WAIT_L
#undef PG8_BAR
#undef PG8_SCHED
}
}
#include <hip/hip_bf16.h>
namespace attn_body {
using bf16=__hip_bfloat16;
using bf16x8=__attribute__((ext_vector_type(8)))short;
using s16x4=__attribute__((ext_vector_type(4)))short;
using f32x16=__attribute__((ext_vector_type(16)))float;
using u32x4=__attribute__((ext_vector_type(4)))unsigned;
constexpr int BATCH=8,NHEAD=16,SEQ=4096,D=64,PITI=3584,PITO=1024;
constexpr int NW=8,QBLK=32,QB=QBLK*NW,KVBLK=64,NQB=SEQ/QB;
__device__ __forceinline__ int crow(int r,int hi){return (r&3)+8*(r>>2)+4*hi;}
#define SBAR() __builtin_amdgcn_sched_barrier(0)
__device__ __forceinline__ void cmask(f32x16&p0,f32x16&p1,int jb,int qrel,int hi){
  const float NEG=-INFINITY; int kb=64*jb+4*hi;
  #pragma unroll
  for(int r=0;r<16;++r){int kv=kb+(r&3)+8*(r>>2); if(kv>qrel)p0[r]=NEG; if(kv+32>qrel)p1[r]=NEG;}
}

constexpr int NSLOT=3, SLOTB=8192;
constexpr int LDS_K=0, LDS_V=NSLOT*SLOTB, LDS_WS=2*NSLOT*SLOTB, LDS_OST=LDS_WS+NW*64*4, LDS_BYTES=LDS_OST+NW*4096;
constexpr float C2=0.125f*1.4426950408889634f;
__device__ __forceinline__ void glds16(const void*gsrc,unsigned lds_dst){unsigned keep;
  asm volatile("s_mov_b32 %0, m0\n\ts_mov_b32 m0, %2\n\ts_nop 0\n\tglobal_load_lds_dwordx4 %1, off\n\ts_mov_b32 m0, %0":"=&s"(keep):"v"(gsrc),"s"(lds_dst):"memory");}
__device__ __forceinline__ float max3f(float a,float b,float c){float r;asm("v_max3_f32 %0, %1, %2, %3":"=v"(r):"v"(a),"v"(b),"v"(c));return r;}
__device__ __forceinline__ float max2f(float a,float b){float r;asm("v_max_f32_e32 %0, %1, %2":"=v"(r):"v"(a),"v"(b));return r;}
__device__ __forceinline__ float fadd_s(float a,float b){float r;asm("v_add_f32_e32 %0, %1, %2":"=v"(r):"v"(a),"v"(b));return r;}
__device__ __forceinline__ float fsub_s(float a,float b){float r;asm("v_sub_f32_e32 %0, %1, %2":"=v"(r):"v"(a),"v"(b));return r;}
typedef float f32x2_t __attribute__((ext_vector_type(2))); typedef __bf16 bf16x2_t __attribute__((ext_vector_type(2)));
__device__ __forceinline__ unsigned cvtpk_s(float lo,float hi){f32x2_t v={lo,hi};bf16x2_t b=__builtin_convertvector(v,bf16x2_t);return __builtin_bit_cast(unsigned,b);}
#define WAIT_BAR(N) asm volatile("s_waitcnt vmcnt(" #N ") lgkmcnt(0)\n\ts_barrier":::"memory")

__device__ __forceinline__ void qkt(f32x16&p0,f32x16&p1,const char*Kslot,const bf16x8*qr,const f32x16&negm,int r32,int hi){
  const char*kb=Kslot+hi*1024+r32*16;
  #pragma unroll
  for(int d0=0;d0<4;++d0){
    const bf16x8 b0=*reinterpret_cast<const bf16x8*>(kb+d0*2048);
    const bf16x8 b1=*reinterpret_cast<const bf16x8*>(kb+d0*2048+512);
    if(d0==0){p0=__builtin_amdgcn_mfma_f32_32x32x16_bf16(b0,qr[0],negm,0,0,0);p1=__builtin_amdgcn_mfma_f32_32x32x16_bf16(b1,qr[0],negm,0,0,0);}
    else{p0=__builtin_amdgcn_mfma_f32_32x32x16_bf16(b0,qr[d0],p0,0,0,0);p1=__builtin_amdgcn_mfma_f32_32x32x16_bf16(b1,qr[d0],p1,0,0,0);}}
}
typedef __attribute__((address_space(3))) const char* lds_cptr;
typedef short v4i16_t __attribute__((ext_vector_type(4)));
__device__ __forceinline__ void kload8(bf16x8*kf,lds_cptr kp){
  kf[0]=*(const __attribute__((address_space(3))) bf16x8*)(kp);      kf[1]=*(const __attribute__((address_space(3))) bf16x8*)(kp+512);
  kf[2]=*(const __attribute__((address_space(3))) bf16x8*)(kp+2048); kf[3]=*(const __attribute__((address_space(3))) bf16x8*)(kp+2560);
  kf[4]=*(const __attribute__((address_space(3))) bf16x8*)(kp+4096); kf[5]=*(const __attribute__((address_space(3))) bf16x8*)(kp+4608);
  kf[6]=*(const __attribute__((address_space(3))) bf16x8*)(kp+6144); kf[7]=*(const __attribute__((address_space(3))) bf16x8*)(kp+6656);
}
__device__ __forceinline__ void kload2(bf16x8*kf,lds_cptr kp,int j){ kf[2*j]=*(const __attribute__((address_space(3))) bf16x8*)(kp+j*2048); kf[2*j+1]=*(const __attribute__((address_space(3))) bf16x8*)(kp+j*2048+512); }
__device__ __forceinline__ s16x4 vtr(lds_cptr p){ return __builtin_bit_cast(s16x4,__builtin_amdgcn_ds_read_tr16_b64_v4i16((__attribute__((address_space(3))) v4i16_t*)p)); }
__device__ __forceinline__ float rowmax(const f32x16&p0,const f32x16&p1){
  float a=max3f(p0[0],p0[1],p1[0]),b=max3f(p0[2],p0[3],p1[1]);a=max3f(a,p1[2],p1[3]);
  #pragma unroll
  for(int r=4;r<16;r+=4){a=max3f(a,p0[r],p0[r+1]);b=max3f(b,p0[r+2],p0[r+3]);a=max3f(a,p1[r],p1[r+1]);b=max3f(b,p1[r+2],p1[r+3]);}
  const float m=max2f(a,b);
  auto rr=__builtin_amdgcn_permlane32_swap(__float_as_uint(m),__float_as_uint(m),false,false);
  return max2f(__uint_as_float(rr[0]),__uint_as_float(rr[1]));
}
__device__ __forceinline__ void pv(f32x16*o,int vb,bf16x8 pa0,bf16x8 pa1,bf16x8 pa2,bf16x8 pa3){
  #pragma unroll
  for(int d0=0;d0<2;++d0){s16x4 lo[4],hi[4];
    #pragma unroll
    for(int ks=0;ks<4;++ks){
      asm volatile("ds_read_b64_tr_b16 %0,%1 offset:%c2":"=&v"(lo[ks]):"v"(vb),"i"(d0*4096+ks*1024):"memory");
      asm volatile("ds_read_b64_tr_b16 %0,%1 offset:%c2":"=&v"(hi[ks]):"v"(vb),"i"(d0*4096+ks*1024+512):"memory");}
    asm volatile("s_waitcnt lgkmcnt(0)":::"memory");SBAR();
    #define PK(k) (bf16x8){lo[k][0],lo[k][1],lo[k][2],lo[k][3],hi[k][0],hi[k][1],hi[k][2],hi[k][3]}
    o[d0]=__builtin_amdgcn_mfma_f32_32x32x16_bf16(pa0,PK(0),o[d0],0,0,0);
    o[d0]=__builtin_amdgcn_mfma_f32_32x32x16_bf16(pa1,PK(1),o[d0],0,0,0);
    o[d0]=__builtin_amdgcn_mfma_f32_32x32x16_bf16(pa2,PK(2),o[d0],0,0,0);
    o[d0]=__builtin_amdgcn_mfma_f32_32x32x16_bf16(pa3,PK(3),o[d0],0,0,0);
    #undef PK
  }
}

#ifndef ATTN_STORE16
#define ATTN_STORE16(p,v) (*(u32x4*)(p)=(v))
#endif
template<int THRL> __device__ __forceinline__ void attn_unit(int b,int h,int qb,const bf16*Q,const bf16*__restrict__ K,const bf16*__restrict__ V,bf16*O,char*shm){
  const int tid=otid_(),lane=tid&63,r32=lane&31,hi=lane>>5; const int wid=__builtin_amdgcn_readfirstlane(tid>>6);
  const long rowbase=(long)b*SEQ; const int q0=qb*QB;
  const bf16*Qw=Q+(rowbase+q0+wid*QBLK)*PITI;
  const bf16*Kh=K+rowbase*PITI,*Vh=V+rowbase*PITI;
  const unsigned lds0=(unsigned)(uintptr_t)shm;
  float*wsf=(float*)(shm+LDS_WS)+wid*64;
  const bf16*ksrc=Kh+(long)lane*PITI+wid*8;
  const bf16*vsrc=Vh+(long)(16*(wid&3)+(lane>>2))*PITI+(wid>>2)*32+(lane&3)*8;
  const unsigned kdst=lds0+LDS_K+wid*1024, vdst=lds0+LDS_V+wid*1024;
  #define DMA_K(t,slot) glds16(ksrc+(long)(t)*KVBLK*PITI,(unsigned)__builtin_amdgcn_readfirstlane(kdst+(slot)))
  #define DMA_V(t,slot) glds16(vsrc+(long)(t)*KVBLK*PITI,(unsigned)__builtin_amdgcn_readfirstlane(vdst+(slot)))
  const int vb0=(int)(lds0+LDS_V)+((lane>>4)&1)*32+(lane&3)*8+(4*hi+((lane&15)>>2))*64;
  const char*Kbase=shm+LDS_K; bf16x8 kf[8];
  const lds_cptr shm3=(lds_cptr)shm; const lds_cptr kp0=shm3+LDS_K+hi*1024+r32*16; const lds_cptr vp0=shm3+LDS_V+((lane>>4)&1)*32+(lane&3)*8+(4*hi+((lane&15)>>2))*64;
  const int NT=(q0+QB)/KVBLK;
  DMA_K(0,0);DMA_V(0,0);DMA_K(1,SLOTB);
  bf16x8 qr[4];
  #pragma unroll
  for(int d0=0;d0<4;++d0)qr[d0]=*reinterpret_cast<const bf16x8*>(&Qw[(long)r32*PITI+d0*16+hi*8]);
  float mhat=0.f,l_reg=0.f;f32x16 o[2];o[0]=f32x16{};o[1]=f32x16{};f32x16 negm=f32x16{};asm volatile("":"+v"(negm));
  const int qrel=wid*QBLK+r32;
  #define CMASK(P0,P1,t) do{int jb_=(t)-(NT-4); if(jb_>=0)cmask(P0,P1,jb_,qrel,hi);}while(0)
  bool resc=false;
  #define START(P0,P1) do{ const float rm=rowmax(P0,P1); resc=false; \
    { const float dl=rm; mhat=fadd_s(mhat,dl); \
      _Pragma("unroll") for(int r=0;r<16;++r){P0[r]=fsub_s(P0[r],dl);P1[r]=fsub_s(P1[r],dl);} \
      _Pragma("unroll") for(int r=0;r<16;++r)negm[r]=-mhat; asm volatile("":"+v"(negm)); } \
    _Pragma("unroll") for(int r=0;r<16;++r)P0[r]=__builtin_amdgcn_exp2f(P0[r]); }while(0)
  #define RESC() do{ if(resc){ asm volatile("s_waitcnt lgkmcnt(0)":::"memory"); \
      _Pragma("unroll") for(int d_=0;d_<2;++d_) _Pragma("unroll") for(int r=0;r<16;++r)o[d_][r]*=wsf[crow(r,hi)]; } }while(0)
  f32x16 pA0,pA1,pB0,pB1;
  int sl_prev=0,sl_cur=0,sl_next=SLOTB;
  #define ROT() do{sl_prev=sl_cur;sl_cur=sl_next;sl_next=(sl_next==(NSLOT-1)*SLOTB)?0:sl_next+SLOTB;}while(0)
  DMA_K(2,2*SLOTB);
  WAIT_BAR(3);
  qkt(pA0,pA1,Kbase,qr,negm,r32,hi);asm volatile("s_nop 15\n\ts_nop 7":"+v"(pA0),"+v"(pA1));CMASK(pA0,pA1,0);
  START(pA0,pA1);
  _Pragma("unroll") for(int r=0;r<16;++r)pA1[r]=__builtin_amdgcn_exp2f(pA1[r]);
  WAIT_BAR(0);
  DMA_K(3,0);DMA_V(1,SLOTB);
  ROT();
  kload8(kf,kp0+sl_cur);
  WAIT_BAR(2);
  s16x4 vlo[8],vhi[8]; u32x4 pw0,pw1,pw2,pw3;
  #define PKW(P,B) cvtpk_s(P[B],P[B+1])
  #define PAF(k) __builtin_bit_cast(bf16x8,pw##k)
  #define VFR(i) (bf16x8){vlo[i][0],vlo[i][1],vlo[i][2],vlo[i][3],vhi[i][0],vhi[i][1],vhi[i][2],vhi[i][3]}
  #define PIN(x) asm volatile("":"+v"(x))
  #define MX3(a,b,c) __builtin_fmaxf(__builtin_fmaxf((a),(b)),(c))
  #define GAPA(MF,A0,A1,A2,A3,W0,W1,PW) do{ MF; sacc+=A0; sacc+=A1; sacc+=A2; sacc+=A3; PIN(sacc); W0; W1; PIN(PW); SBAR(); }while(0)
  #define EX(v) __builtin_amdgcn_exp2f(v)
  #define GAPB(MF,X,B) do{ MF; X[B]=EX(X[B]); X[B+1]=EX(X[B+1]); X[B+2]=EX(X[B+2]); X[B+3]=EX(X[B+3]); PIN(X); SBAR(); }while(0)
  #define VRD(i) do{ vlo[i]=vtr(vp_+(((i)>>2)*4096+((i)&3)*1024)); vhi[i]=vtr(vp_+(((i)>>2)*4096+((i)&3)*1024+512)); }while(0)
  #define KRD(G,j) do{ if(G){ kload2(kf,kp0+sl_next,j); SBAR(); } }while(0)
  #define STEP(C0,C1,P0,P1,t,GK,GV,GL) do{ SBAR(); \
    const lds_cptr vp_=vp0+sl_prev; \
    VRD(0); SBAR(); float sacc=(P0[0]+P0[1]); \
    GAPA(C0=__builtin_amdgcn_mfma_f32_32x32x16_bf16(kf[0],qr[0],negm,0,0,0), P0[2],P0[3],P0[4],P0[5],     pw0[0]=PKW(P0,0), pw0[1]=PKW(P0,2), pw0); \
    VRD(4); SBAR(); GAPA(C1=__builtin_amdgcn_mfma_f32_32x32x16_bf16(kf[1],qr[0],negm,0,0,0), P0[6],P0[7],P0[8],P0[9],     pw0[2]=PKW(P0,4), pw0[3]=PKW(P0,6), pw0); \
    VRD(1); SBAR(); GAPA(C0=__builtin_amdgcn_mfma_f32_32x32x16_bf16(kf[2],qr[1],C0,0,0,0),   P0[10],P0[11],P0[12],P0[13], pw1[0]=PKW(P0,8), pw1[1]=PKW(P0,10), pw1); \
    VRD(5); SBAR(); GAPA(C1=__builtin_amdgcn_mfma_f32_32x32x16_bf16(kf[3],qr[1],C1,0,0,0),   P0[14],P0[15],P1[0],P1[1],   pw1[2]=PKW(P0,12),pw1[3]=PKW(P0,14), pw1); \
    VRD(2); SBAR(); GAPA(C0=__builtin_amdgcn_mfma_f32_32x32x16_bf16(kf[4],qr[2],C0,0,0,0),   P1[2],P1[3],P1[4],P1[5],     pw2[0]=PKW(P1,0), pw2[1]=PKW(P1,2), pw2); \
    VRD(6); SBAR(); GAPA(C1=__builtin_amdgcn_mfma_f32_32x32x16_bf16(kf[5],qr[2],C1,0,0,0),   P1[6],P1[7],P1[8],P1[9],     pw2[2]=PKW(P1,4), pw2[3]=PKW(P1,6), pw2); \
    VRD(3); SBAR(); GAPA(C0=__builtin_amdgcn_mfma_f32_32x32x16_bf16(kf[6],qr[3],C0,0,0,0),   P1[10],P1[11],P1[12],P1[13], pw3[0]=PKW(P1,8), pw3[1]=PKW(P1,10), pw3); \
    VRD(7); SBAR(); GAPA(C1=__builtin_amdgcn_mfma_f32_32x32x16_bf16(kf[7],qr[3],C1,0,0,0),   P1[14],P1[15],0.f,0.f,       pw3[2]=PKW(P1,12),pw3[3]=PKW(P1,14), pw3); \
    l_reg+=sacc; \
    if(GK){DMA_K((t)+3,sl_cur);} if(GV){DMA_V((t)+1,sl_next);} \
    CMASK(C0,C1,t); \
    { float a=MX3(C0[0],C0[1],C1[0]),b=MX3(C0[2],C0[3],C1[1]); a=MX3(a,C1[2],C1[3]); \
      _Pragma("unroll") for(int r=4;r<16;r+=4){a=MX3(a,C0[r],C0[r+1]);b=MX3(b,C0[r+2],C0[r+3]);a=MX3(a,C1[r],C1[r+1]);b=MX3(b,C1[r+2],C1[r+3]);} \
      float rm=__builtin_fmaxf(a,b); { auto rr=__builtin_amdgcn_permlane32_swap(__float_as_uint(rm),__float_as_uint(rm),false,false); rm=__builtin_fmaxf(__uint_as_float(rr[0]),__uint_as_float(rr[1])); } \
      resc=false; \
      if(__builtin_expect(__any(rm>(float)THRL),0)){ const float dl=__builtin_fmaxf(rm,0.f); mhat+=dl; \
        _Pragma("unroll") for(int r=0;r<16;++r){C0[r]-=dl;C1[r]-=dl;} \
        _Pragma("unroll") for(int r=0;r<16;++r)negm[r]=-mhat; asm volatile("":"+v"(negm)); \
        const float f=__builtin_amdgcn_exp2f(-dl); l_reg*=f; if(hi==0)wsf[r32]=f; resc=true; } } \
    SBAR(); \
    GAPB(o[0]=__builtin_amdgcn_mfma_f32_32x32x16_bf16(PAF(0),VFR(0),o[0],0,0,0), C0,0); \
    GAPB(o[1]=__builtin_amdgcn_mfma_f32_32x32x16_bf16(PAF(0),VFR(4),o[1],0,0,0), C0,4); \
    KRD(GL,0); GAPB(o[0]=__builtin_amdgcn_mfma_f32_32x32x16_bf16(PAF(1),VFR(1),o[0],0,0,0), C0,8); \
    KRD(GL,1); GAPB(o[1]=__builtin_amdgcn_mfma_f32_32x32x16_bf16(PAF(1),VFR(5),o[1],0,0,0), C0,12); \
    KRD(GL,2); GAPB(o[0]=__builtin_amdgcn_mfma_f32_32x32x16_bf16(PAF(2),VFR(2),o[0],0,0,0), C1,0); \
    KRD(GL,3); GAPB(o[1]=__builtin_amdgcn_mfma_f32_32x32x16_bf16(PAF(2),VFR(6),o[1],0,0,0), C1,4); \
    GAPB(o[0]=__builtin_amdgcn_mfma_f32_32x32x16_bf16(PAF(3),VFR(3),o[0],0,0,0), C1,8); \
    GAPB(o[1]=__builtin_amdgcn_mfma_f32_32x32x16_bf16(PAF(3),VFR(7),o[1],0,0,0), C1,12); \
    }while(0)
  int t=1;
  #undef CMASK
  #define CMASK(P0,P1,t) do{}while(0)
  for(;t+5<NT;t+=2){
    STEP(pB0,pB1,pA0,pA1,t,true,true,true);     WAIT_BAR(2); RESC(); ROT();
    STEP(pA0,pA1,pB0,pB1,t+1,true,true,true);   WAIT_BAR(2); RESC(); ROT();
  }
  #undef CMASK
  #define CMASK(P0,P1,t) do{int jb_=(t)-(NT-4); if(jb_>=0)cmask(P0,P1,jb_,qrel,hi);}while(0)
  #define ENDW(tt) do{ if((tt)+3<NT){WAIT_BAR(2);} else if((tt)+2<NT){WAIT_BAR(1);} else {WAIT_BAR(0);} }while(0)
  for(;t+1<NT;t+=2){
    STEP(pB0,pB1,pA0,pA1,t,(t+3<NT),(t+1<NT),(t+1<NT));       ENDW(t);   RESC(); ROT();
    STEP(pA0,pA1,pB0,pB1,t+1,(t+4<NT),(t+2<NT),(t+2<NT));     ENDW(t+1); RESC(); ROT();
  }
  STEP(pB0,pB1,pA0,pA1,NT-1,false,false,false); RESC();
  { float sacc=pB0[0]+pB0[1]; _Pragma("unroll") for(int r=2;r<16;++r)sacc+=pB0[r]; _Pragma("unroll") for(int r=0;r<16;++r)sacc+=pB1[r]; l_reg+=sacc;
    pw0=(u32x4){PKW(pB0,0),PKW(pB0,2),PKW(pB0,4),PKW(pB0,6)};pw1=(u32x4){PKW(pB0,8),PKW(pB0,10),PKW(pB0,12),PKW(pB0,14)};pw2=(u32x4){PKW(pB1,0),PKW(pB1,2),PKW(pB1,4),PKW(pB1,6)};pw3=(u32x4){PKW(pB1,8),PKW(pB1,10),PKW(pB1,12),PKW(pB1,14)};
    SBAR(); pv(o,vb0+sl_cur,PAF(0),PAF(1),PAF(2),PAF(3)); }
  #undef PKW
  #undef PAF
  #undef VFR
  #undef PIN
  #undef MX3
  #undef GAPA
  #undef GAPB
  #undef EX
  #undef VRD
  #undef KRD
  #undef STEP
  #undef ENDW
  {auto rr=__builtin_amdgcn_permlane32_swap(__float_as_uint(l_reg),__float_as_uint(l_reg),false,false);l_reg=__uint_as_float(rr[0])+__uint_as_float(rr[1]);}
  if(hi==0)wsf[32+r32]=l_reg;asm volatile("s_waitcnt lgkmcnt(0)":::"memory");
  float rli[16];
  #pragma unroll
  for(int r=0;r<16;++r)rli[r]=__builtin_amdgcn_rcpf(wsf[32+crow(r,hi)]);
  bf16*Ow=O+(rowbase+q0+wid*QBLK)*PITO;
  { bf16*stg=(bf16*)(shm+LDS_OST)+wid*2048;
    #pragma unroll
    for(int r=0;r<16;++r){const int orow=crow(r,hi);
      #pragma unroll
      for(int d0=0;d0<2;++d0)stg[orow*64+d0*32+r32]=__float2bfloat16(o[d0][r]*rli[r]);}
    asm volatile("s_waitcnt lgkmcnt(0)":::"memory");
    #pragma unroll
    for(int i=0;i<4;++i){const int row=i*8+(lane>>3),ch=lane&7; const u32x4 v=*(const u32x4*)(stg+row*64+ch*8); ATTN_STORE16(Ow+(long)row*PITO+ch*8,v);} }
  asm volatile("s_waitcnt lgkmcnt(0)\n\ts_barrier":::"memory");
  #undef DMA_K
  #undef DMA_V
  #undef CMASK
  #undef START
  #undef RESC
  #undef ROT
}
constexpr int ATTN_LDS_BYTES=LDS_BYTES;
#undef SBAR
#undef WAIT_BAR
}

namespace cg = cooperative_groups;
typedef unsigned short bf16_t;
typedef float f32x4 __attribute__((ext_vector_type(4)));
typedef float f32x16 __attribute__((ext_vector_type(16)));
typedef unsigned u32x4 __attribute__((ext_vector_type(4)));
typedef unsigned u32x2 __attribute__((ext_vector_type(2)));
typedef short bf16x8 __attribute__((ext_vector_type(8)));
#define LAS3 __attribute__((address_space(3)))

constexpr int T_ = 32768, DM_ = 1024, SEQ_ = 4096, DFF_ = 2816;
constexpr int NTHR = 512;
constexpr int LDS_BYTES = 147456;
constexpr size_t MiB_ = 1u << 20;
constexpr size_t WS_MOD = 0, WS_COS = 1 * MiB_, WS_SIN = 2 * MiB_;
constexpr size_t WS_WIN = 4 * MiB_, WS_WOUT = 11 * MiB_, WS_FIN = 13 * MiB_, WS_FOUT = 24 * MiB_;
constexpr size_t WS_A = 32 * MiB_, WS_X2 = 96 * MiB_, WS_ST = 160 * MiB_, WS_TOT = 224 * MiB_, WS_R1 = 226 * MiB_, WS_END = 450 * MiB_;
constexpr size_t WS_HP = WS_ST, WS_HU = WS_ST + 12 * MiB_, WS_HA = WS_ST + 24 * MiB_;
constexpr float LOG2E_ = 1.4426950408889634f;
constexpr float QSCALE_ = 0.125f * 1.4426950408889634f;

struct Params {
    const float* x; const float* c; const int* positions; const float* mod_w; const float* mod_b; const float* norm_mix_w; const float* norm_ffn_w;
    const float* ev_w_in; const float* gla_gate_w; const float* gla_gate_b; const float* gla_norm_w; const float* swa_sinks; const float* ev_w_out;
    const float* od_w_in; const float* diff_lambda; const float* diff_norm_w; const float* hgrn_lb_logits; const float* hgrn_norm_w; const float* od_w_out;
    const float* ffn_w_in; const float* ffn_conv_w; const float* ffn_conv_b; const float* ffn_w_out; const float* final_norm_w;
    float* out; unsigned char* ws; unsigned long long pad[6];
};

__device__ __forceinline__ unsigned pk2(float lo, float hi) {
    typedef float f32x2_t __attribute__((ext_vector_type(2))); typedef __bf16 bf16x2_t __attribute__((ext_vector_type(2)));
    f32x2_t v = {lo, hi}; bf16x2_t b = __builtin_convertvector(v, bf16x2_t); return __builtin_bit_cast(unsigned, b);
}
__device__ __forceinline__ float bflo(unsigned u) { return __uint_as_float(u << 16); }
__device__ __forceinline__ float bfhi(unsigned u) { return __uint_as_float(u & 0xffff0000u); }
__device__ __forceinline__ float sigmoidf_(float x) { return 1.f / (1.f + __expf(-x)); }
__device__ __forceinline__ float siluf_(float x) { return x / (1.f + __expf(-x)); }
__device__ __forceinline__ float wave_sum(float v) {
#pragma unroll
    for (int o = 1; o < 64; o <<= 1) v += __shfl_xor(v, o);
    return v;
}
__device__ __forceinline__ int crow_(int r, int hi) { return (r & 3) + 8 * (r >> 2) + 4 * hi; }

namespace pg8 {
struct EpiProj {
    static constexpr bool PERM = true, AFTER_DRAIN = false;
    bf16_t* O; int ldc; unsigned ropemask; unsigned scalemask; float scale; const float* cs; const float* sn;
    __device__ __forceinline__ void operator()(const f32x4 (&acc)[2][2][4][2], const Unit& u, int wr, int wc, int fr, int fq) const {
        const int row0 = u.pm * BM + wr * 64 + fr; const int col0 = u.pn * BM + wc * 32 + 8 * fq;
#pragma unroll
        for (int bj = 0; bj < 2; ++bj) {
            const int grp = u.pn * 2 + bj;
            const bool rope = ((ropemask >> grp) & 1u) && ((wc & 1) == 0);
            const float sc = ((scalemask >> grp) & 1u) ? scale : 1.f;
#pragma unroll
            for (int ai = 0; ai < 2; ++ai)
#pragma unroll
                for (int m = 0; m < 4; ++m) {
                    const int row = row0 + ai * HALF + m * 16;
                    f32x4 v0 = acc[ai][bj][m][0], v1 = acc[ai][bj][m][1];
                    if (rope) {
                        const f32x4 c0 = *(const f32x4*)(cs + (size_t)row * 8), c1 = *(const f32x4*)(cs + (size_t)row * 8 + 4);
                        const f32x4 s0 = *(const f32x4*)(sn + (size_t)row * 8), s1 = *(const f32x4*)(sn + (size_t)row * 8 + 4);
                        const float sg = (fq == 0) ? -1.f : 1.f;
#pragma unroll
                        for (int e = 0; e < 4; ++e) {
                            const float p0 = __shfl_xor(v0[e], 16), p1 = __shfl_xor(v1[e], 16);
                            const float r0 = v0[e] * c0[e] + sg * p0 * s0[e], r1 = v1[e] * c1[e] + sg * p1 * s1[e];
                            if (fq < 2) { v0[e] = r0; v1[e] = r1; }
                        }
                    }
                    v0 = v0 * sc; v1 = v1 * sc;
                    u32x4 w; w.x = pk2(v0[0], v0[1]); w.y = pk2(v0[2], v0[3]); w.z = pk2(v1[0], v1[1]); w.w = pk2(v1[2], v1[3]);
                    *(u32x4*)(O + (size_t)row * ldc + col0 + bj * HALF) = w;
                    asm volatile("" ::: "memory");
                }
        }
    }
};
struct EpiRes {
    static constexpr bool PERM = false, AFTER_DRAIN = false;
    const float* xin; float* xout; const float* gate;
    __device__ __forceinline__ void operator()(const f32x4 (&acc)[2][2][4][2], const Unit& u, int wr, int wc, int fr, int fq) const {
        const int col0 = u.pn * BM + wc * 32 + 4 * fq;
#pragma unroll
        for (int ai = 0; ai < 2; ++ai)
#pragma unroll
            for (int m = 0; m < 4; ++m) {
                const int row = u.pm * BM + ai * HALF + wr * 64 + m * 16 + fr;
                const float* g = gate + (size_t)(row >> 12) * 6144;
                const size_t off = (size_t)row * 1024 + col0;
#pragma unroll
                for (int bj = 0; bj < 2; ++bj)
#pragma unroll
                    for (int n = 0; n < 2; ++n) {
                        const int cc = bj * HALF + n * 16;
                        const f32x4 g4 = *(const f32x4*)(g + col0 + cc);
                        const f32x4 x4 = *(const f32x4*)(xin + off + cc);
                        *(f32x4*)(xout + off + cc) = x4 + g4 * acc[ai][bj][m][n];
                    }
                asm volatile("" ::: "memory");
            }
    }
};
struct EpiFfn {
    static constexpr bool PERM = true, AFTER_DRAIN = false;
    bf16_t* G; float* HP; float* HU; float* HA; const float* cw; const float* cb;
    __device__ __forceinline__ void operator()(const f32x4 (&acc)[2][2][4][2], const Unit& u, int wr, int wc, int fr, int fq) const {
        const int ch0 = u.pn * 128 + wc * 32 + 8 * fq;
        f32x4 w0[2], w1[2], w2[2], bb[2];
#pragma unroll
        for (int n = 0; n < 2; ++n) { w0[n] = *(const f32x4*)(cw + ch0 + 4 * n); w1[n] = *(const f32x4*)(cw + DFF_ + ch0 + 4 * n); w2[n] = *(const f32x4*)(cw + 2 * DFF_ + ch0 + 4 * n); bb[n] = *(const f32x4*)(cb + ch0 + 4 * n); }
        const int lane = fr + 16 * fq;
        const int src1 = (lane & ~15) | ((fr + 15) & 15), src2 = (lane & ~15) | ((fr + 14) & 15);
#pragma unroll
        for (int ai = 0; ai < 2; ++ai) {
            const int seg = u.pm * 4 + ai * 2 + wr;
#pragma unroll
            for (int m = 0; m < 4; ++m) {
                const int row = u.pm * BM + ai * HALF + wr * 64 + m * 16 + fr;
                f32x4 val[2];
#pragma unroll
                for (int n = 0; n < 2; ++n) {
                    const f32x4 a = acc[ai][0][m][n];
                    f32x4 ap = (f32x4){0.f, 0.f, 0.f, 0.f};
                    if (m > 0) ap = acc[ai][0][m > 0 ? m - 1 : 0][n];
#pragma unroll
                    for (int e = 0; e < 4; ++e) {
                        const float t1 = (fr == 15) ? ap[e] : a[e];
                        const float t2 = (fr >= 14) ? ap[e] : a[e];
                        const float p1 = __shfl(t1, src1), p2 = __shfl(t2, src2);
                        val[n][e] = w2[n][e] * a[e] + w1[n][e] * p1 + w0[n][e] * p2 + bb[n][e];
                    }
                }
                const f32x4 u0 = acc[ai][1][m][0], u1 = acc[ai][1][m][1];
                f32x4 g0, g1;
#pragma unroll
                for (int e = 0; e < 4; ++e) { g0[e] = siluf_(val[0][e]) * u0[e]; g1[e] = siluf_(val[1][e]) * u1[e]; }
                u32x4 w; w.x = pk2(g0[0], g0[1]); w.y = pk2(g0[2], g0[3]); w.z = pk2(g1[0], g1[1]); w.w = pk2(g1[2], g1[3]);
                *(u32x4*)(G + (size_t)row * DFF_ + ch0) = w;
                if (m == 0 && fr < 2) {
                    const size_t ho = (size_t)(seg * 2 + fr) * DFF_ + ch0;
                    *(f32x4*)(HP + ho) = val[0]; *(f32x4*)(HP + ho + 4) = val[1];
                    *(f32x4*)(HU + ho) = u0; *(f32x4*)(HU + ho + 4) = u1;
                }
                if (m == 3 && fr >= 14) {
                    const size_t ho = (size_t)(seg * 2 + (fr - 14)) * DFF_ + ch0;
                    *(f32x4*)(HA + ho) = acc[ai][0][3][0]; *(f32x4*)(HA + ho + 4) = acc[ai][0][3][1];
                }
                asm volatile("" ::: "memory");
            }
        }
    }
};
}

struct Ctx { Params p; unsigned char* lds; int tid, lane, wave, gw, ngw; };

__device__ __forceinline__ void phase_prologue(const Ctx& C) {
    const Params& p = C.p;
    float* cact = (float*)C.lds;
    float* red = (float*)(C.lds + 32768);
    float* mod = (float*)(p.ws + WS_MOD);
    const int tid = C.tid;
    for (int i = tid; i < 8192; i += NTHR) { const float c = p.c[i]; cact[i] = c / (1.f + __expf(-c)); }
    __syncthreads();
    const int col = tid & 63, kp = tid >> 6;
    for (int g = blockIdx.x; g < 384; g += gridDim.x) {
        const int l = g / 96, j = (g % 96) * 64 + col;
        const float* w = p.mod_w + (size_t)l * 1024 * 6144 + (size_t)(kp * 128) * 6144 + j;
        float a0 = 0.f, a1 = 0.f, a2 = 0.f, a3 = 0.f, a4 = 0.f, a5 = 0.f, a6 = 0.f, a7 = 0.f;
        const float* ca = cact + kp * 128;
#pragma unroll 8
        for (int k = 0; k < 128; ++k) {
            const float wv = w[(size_t)k * 6144];
            a0 += ca[k] * wv; a1 += ca[1024 + k] * wv; a2 += ca[2048 + k] * wv; a3 += ca[3072 + k] * wv;
            a4 += ca[4096 + k] * wv; a5 += ca[5120 + k] * wv; a6 += ca[6144 + k] * wv; a7 += ca[7168 + k] * wv;
        }
        float* r = red + (kp * 8) * 64 + col;
        r[0] = a0; r[64] = a1; r[128] = a2; r[192] = a3; r[256] = a4; r[320] = a5; r[384] = a6; r[448] = a7;
        __syncthreads();
        { const int b = tid >> 6; float s = 0.f;
#pragma unroll
          for (int kk = 0; kk < 8; ++kk) s += red[(kk * 8 + b) * 64 + col];
          mod[(size_t)(l * 8 + b) * 6144 + j] = s + p.mod_b[l * 6144 + j]; }
        __syncthreads();
    }
    float* cs = (float*)(p.ws + WS_COS); float* sn = (float*)(p.ws + WS_SIN);
    const float invf[8] = {1.0f, 0.1939227432012558f, 0.03760603070259094f, 0.007292664609849453f, 0.0014142135623842478f, 0.00027424818836152554f, 5.3182957344688475e-05f, 1.0313385246263351e-05f};
    for (int r = blockIdx.x * NTHR + tid; r < T_; r += gridDim.x * NTHR) {
        const float pos = (float)p.positions[r];
        f32x4 c4[2], s4[2];
#pragma unroll
        for (int i = 0; i < 8; ++i) {
            const float ang = pos * invf[i];
            const double xr = (double)ang * 0.15915494309189535;
            const float f = (float)(xr - rint(xr));
            c4[i >> 2][i & 3] = __builtin_amdgcn_cosf(f); s4[i >> 2][i & 3] = __builtin_amdgcn_sinf(f);
        }
        *(f32x4*)(cs + (size_t)r * 8) = c4[0]; *(f32x4*)(cs + (size_t)r * 8 + 4) = c4[1];
        *(f32x4*)(sn + (size_t)r * 8) = s4[0]; *(f32x4*)(sn + (size_t)r * 8 + 4) = s4[1];
    }
}

__device__ __forceinline__ void tr_item(const float* W, int Nsrc, int srccol0, bf16_t* WT, int K, int dstrow0, int k0, float* scr, int lane) {
#pragma unroll 8
    for (int i = 0; i < 32; ++i) { const int kk = 2 * i + (lane >> 5); scr[kk * 33 + (lane & 31)] = W[(size_t)(k0 + kk) * Nsrc + srccol0 + (lane & 31)]; }
    asm volatile("s_waitcnt lgkmcnt(0)" ::: "memory");
    const int c = lane & 7;
#pragma unroll
    for (int j = 0; j < 4; ++j) { const int n = (lane >> 3) + 8 * j; const float* s = scr + (8 * c) * 33 + n;
        u32x4 o; o.x = pk2(s[0 * 33], s[1 * 33]); o.y = pk2(s[2 * 33], s[3 * 33]); o.z = pk2(s[4 * 33], s[5 * 33]); o.w = pk2(s[6 * 33], s[7 * 33]);
        *(u32x4*)(WT + (size_t)(dstrow0 + n) * K + k0 + 8 * c) = o; }
    asm volatile("s_waitcnt lgkmcnt(0)" ::: "memory");
}
__device__ __forceinline__ void phase_convert(const Ctx& C, int l) {
    const Params& p = C.p; const int j = l >> 1; const bool even = !(l & 1);
    float* scr = (float*)(C.lds + C.wave * 16384);
    bf16_t* WIN = (bf16_t*)(p.ws + WS_WIN); bf16_t* WOUT = (bf16_t*)(p.ws + WS_WOUT); bf16_t* FIN = (bf16_t*)(p.ws + WS_FIN); bf16_t* FOUT = (bf16_t*)(p.ws + WS_FOUT);
    const int nA = even ? 80 : 112;
    const int IA = 16 * nA, IB = 16 * 32, IC = 16 * 176, ID = 44 * 32;
    const float* win = even ? p.ev_w_in + (size_t)j * 1024 * 2320 : p.od_w_in + (size_t)j * 1024 * 3584;
    const float* wout = even ? p.ev_w_out + (size_t)j * 1024 * 1024 : p.od_w_out + (size_t)j * 1024 * 1024;
    const float* fin = p.ffn_w_in + (size_t)l * 1024 * 5632; const float* fout = p.ffn_w_out + (size_t)l * 2816 * 1024;
    for (int it = C.gw; it < IA + IB + IC + ID; it += C.ngw) {
        int r = it;
        if (r < IA) { const int kb = r / nA, nb = r % nA, n0 = nb * 32; int sc = n0;
            if (even) { if (n0 >= 512 && n0 < 768) continue; if (n0 >= 1792) sc = n0 - 240; else if (n0 >= 768) sc = n0 - 256; }
            tr_item(win, even ? 2320 : 3584, sc, WIN, 1024, n0, kb * 64, scr, C.lane); continue; }
        r -= IA;
        if (r < IB) { const int kb = r / 32, nb = r % 32; tr_item(wout, 1024, nb * 32, WOUT, 1024, nb * 32, kb * 64, scr, C.lane); continue; }
        r -= IB;
        if (r < IC) { const int kb = r / 176, nb = r % 176, n0 = nb * 32; const int pn = n0 >> 8, jj = n0 & 255;
            const int sc = (jj < 128) ? pn * 128 + jj : 2816 + pn * 128 + (jj - 128);
            tr_item(fin, 5632, sc, FIN, 1024, n0, kb * 64, scr, C.lane); continue; }
        r -= IC;
        { const int kb = r / 32, nb = r % 32; tr_item(fout, 1024, nb * 32, FOUT, 2816, nb * 32, kb * 64, scr, C.lane); }
    }
    if (even) {
        const float* gw = p.gla_gate_w + (size_t)j * 16 * 256;
        for (int u = blockIdx.x * NTHR + C.tid; u < 256 * 128; u += gridDim.x * NTHR) {
            const int k8 = u & 127, n = u >> 7;
            float g[16];
#pragma unroll
            for (int r = 0; r < 16; ++r) g[r] = gw[r * 256 + n];
            float o[8];
#pragma unroll
            for (int e = 0; e < 8; ++e) {
                const float* wr = win + (size_t)(k8 * 8 + e) * 2320 + 1536;
                const f32x4 a0 = *(const f32x4*)wr, a1 = *(const f32x4*)(wr + 4), a2 = *(const f32x4*)(wr + 8), a3 = *(const f32x4*)(wr + 12);
                o[e] = a0[0] * g[0] + a0[1] * g[1] + a0[2] * g[2] + a0[3] * g[3] + a1[0] * g[4] + a1[1] * g[5] + a1[2] * g[6] + a1[3] * g[7]
                     + a2[0] * g[8] + a2[1] * g[9] + a2[2] * g[10] + a2[3] * g[11] + a3[0] * g[12] + a3[1] * g[13] + a3[2] * g[14] + a3[3] * g[15];
            }
            u32x4 w; w.x = pk2(o[0], o[1]); w.y = pk2(o[2], o[3]); w.z = pk2(o[4], o[5]); w.w = pk2(o[6], o[7]);
            *(u32x4*)(WIN + (size_t)(512 + n) * 1024 + k8 * 8) = w;
        }
    }
}

__device__ __forceinline__ void phase_norm(const Ctx& C, const float* xin, const float* w, const float* modl, int shoff, int scoff, bf16_t* out) {
    for (int row = C.gw; row < T_; row += C.ngw) {
        const f32x4* xr = (const f32x4*)(xin + (size_t)row * 1024) + C.lane;
        f32x4 v[4]; float ss = 0.f;
#pragma unroll
        for (int j = 0; j < 4; ++j) { v[j] = xr[64 * j]; ss += (v[j].x * v[j].x + v[j].y * v[j].y) + (v[j].z * v[j].z + v[j].w * v[j].w); }
        const float rs = rsqrtf(wave_sum(ss) * (1.f / 1024.f) + 1e-6f);
        const float* mb = modl + (size_t)(row >> 12) * 6144;
        u32x2* o8 = (u32x2*)(out + (size_t)row * 1024) + C.lane;
#pragma unroll
        for (int j = 0; j < 4; ++j) {
            const int col = 4 * C.lane + 256 * j;
            const f32x4 w4 = *(const f32x4*)(w + col), sc = *(const f32x4*)(mb + scoff + col), sh = *(const f32x4*)(mb + shoff + col);
            const f32x4 y = (v[j] * rs) * w4 * (sc + 1.f) + sh;
            u32x2 q; q.x = pk2(y.x, y.y); q.y = pk2(y.z, y.w); o8[64 * j] = q;
        }
    }
}
__device__ __forceinline__ void phase_final_norm(const Ctx& C, float* x, const float* w) {
    for (int row = C.gw; row < T_; row += C.ngw) {
        f32x4* xr = (f32x4*)(x + (size_t)row * 1024) + C.lane;
        f32x4 v[4]; float ss = 0.f;
#pragma unroll
        for (int j = 0; j < 4; ++j) { v[j] = xr[64 * j]; ss += (v[j].x * v[j].x + v[j].y * v[j].y) + (v[j].z * v[j].z + v[j].w * v[j].w); }
        const float rs = rsqrtf(wave_sum(ss) * (1.f / 1024.f) + 1e-6f);
#pragma unroll
        for (int j = 0; j < 4; ++j) { const f32x4 w4 = *(const f32x4*)(w + 4 * C.lane + 256 * j); xr[64 * j] = (v[j] * rs) * w4; }
    }
}

__device__ __forceinline__ void phase_diff_combine(const Ctx& C, int l) {
    const Params& p = C.p; const int j = l >> 1;
    const float lam_init = 0.8f - 0.6f * expf(-0.3f * (float)l);
    const float* lv = p.diff_lambda + j * 256;
    const float s1 = wave_sum(lv[C.lane] * lv[64 + C.lane]), s2 = wave_sum(lv[128 + C.lane] * lv[192 + C.lane]);
    const float lam = expf(s1) - expf(s2) + lam_init;
    const bf16_t* X2 = (const bf16_t*)(p.ws + WS_X2); bf16_t* A = (bf16_t*)(p.ws + WS_A);
    const int head = C.lane >> 4, d0 = (C.lane & 15) * 8;
    const float* nw = p.diff_norm_w + j * 128 + d0;
    const f32x4 n0 = *(const f32x4*)nw, n1 = *(const f32x4*)(nw + 4);
    const float og = 1.f - lam_init;
    for (int row = C.gw; row < T_; row += C.ngw) {
        const bf16_t* src = X2 + (size_t)row * 1024 + head * 256 + d0;
        const u32x4 a = *(const u32x4*)src, b = *(const u32x4*)(src + 128);
        float od[8];
        od[0] = bflo(a.x) - lam * bflo(b.x); od[1] = bfhi(a.x) - lam * bfhi(b.x); od[2] = bflo(a.y) - lam * bflo(b.y); od[3] = bfhi(a.y) - lam * bfhi(b.y);
        od[4] = bflo(a.z) - lam * bflo(b.z); od[5] = bfhi(a.z) - lam * bfhi(b.z); od[6] = bflo(a.w) - lam * bflo(b.w); od[7] = bfhi(a.w) - lam * bfhi(b.w);
        float ss = 0.f;
#pragma unroll
        for (int e = 0; e < 8; ++e) ss += od[e] * od[e];
        ss += __shfl_xor(ss, 1); ss += __shfl_xor(ss, 2); ss += __shfl_xor(ss, 4); ss += __shfl_xor(ss, 8);
        const float rs = rsqrtf(ss * (1.f / 128.f) + 1e-6f) * og;
        u32x4 w; w.x = pk2(od[0] * rs * n0[0], od[1] * rs * n0[1]); w.y = pk2(od[2] * rs * n0[2], od[3] * rs * n0[3]);
        w.z = pk2(od[4] * rs * n1[0], od[5] * rs * n1[1]); w.w = pk2(od[6] * rs * n1[2], od[7] * rs * n1[3]);
        *(u32x4*)(A + (size_t)row * 1024 + head * 128 + d0) = w;
    }
}

__device__ __forceinline__ void phase_ffn_fixup(const Ctx& C, int l) {
    const Params& p = C.p;
    const float* HP = (const float*)(p.ws + WS_HP); const float* HU = (const float*)(p.ws + WS_HU); const float* HA = (const float*)(p.ws + WS_HA);
    bf16_t* G = (bf16_t*)(p.ws + WS_R1);
    const float* cw = p.ffn_conv_w + (size_t)l * 3 * DFF_;
    for (int u = blockIdx.x * NTHR + C.tid; u < 512 * 2 * 704; u += gridDim.x * NTHR) {
        const int c4 = u % 704, sj = u / 704, jj = sj & 1, seg = sj >> 1, ch = c4 * 4;
        const size_t ho = (size_t)sj * DFF_ + ch;
        f32x4 val = *(const f32x4*)(HP + ho); const f32x4 uu = *(const f32x4*)(HU + ho);
        if ((seg & 63) != 0) {
            const f32x4 am1 = *(const f32x4*)(HA + (size_t)((seg - 1) * 2 + 1) * DFF_ + ch), am2 = *(const f32x4*)(HA + (size_t)((seg - 1) * 2) * DFF_ + ch);
            const f32x4 w0 = *(const f32x4*)(cw + ch), w1 = *(const f32x4*)(cw + DFF_ + ch);
            if (jj == 0) val = val + w1 * am1 + w0 * am2; else val = val + w0 * am1;
        }
        u32x2 q; q.x = pk2(siluf_(val.x) * uu.x, siluf_(val.y) * uu.y); q.y = pk2(siluf_(val.z) * uu.z, siluf_(val.w) * uu.w);
        *(u32x2*)(G + (size_t)(seg * 64 + jj) * DFF_ + ch) = q;
    }
}

__device__ __forceinline__ void phase_swa(const Ctx& C, int l) {
    const Params& p = C.p;
    const bf16_t* proj = (const bf16_t*)(p.ws + WS_R1); bf16_t* A = (bf16_t*)(p.ws + WS_A);
    bf16_t* Ks = (bf16_t*)C.lds;
    bf16_t* Vt = (bf16_t*)(C.lds + 27648);
    const int tid = C.tid, lane = C.lane, wid = C.wave, r32 = lane & 31, hi = lane >> 5;
    const float* sinks = p.swa_sinks + (l >> 1) * 8;
    for (int u = blockIdx.x; u < 1024; u += gridDim.x) {
        const int b = u >> 7, kvh = (u >> 6) & 1, qb = u & 63, q0 = qb * 64; const size_t rowbase = (size_t)b * SEQ_;
        for (int c = tid; c < 1536; c += NTHR) {
            const int kk = c >> 3, ch = c & 7, pl = q0 - 128 + kk;
            u32x4 kv = (u32x4){0u, 0u, 0u, 0u}, vv = (u32x4){0u, 0u, 0u, 0u};
            if (pl >= 0) { const bf16_t* src = proj + (rowbase + pl) * 2560 + 2304 + kvh * 64 + ch * 8; kv = *(const u32x4*)src; vv = *(const u32x4*)(src + 128); }
            *(u32x4*)(Ks + kk * 72 + ch * 8) = kv;
            bf16_t* vd = Vt + (ch * 8) * 200 + kk;
            vd[0] = (bf16_t)(vv.x & 0xffffu); vd[200] = (bf16_t)(vv.x >> 16); vd[400] = (bf16_t)(vv.y & 0xffffu); vd[600] = (bf16_t)(vv.y >> 16);
            vd[800] = (bf16_t)(vv.z & 0xffffu); vd[1000] = (bf16_t)(vv.z >> 16); vd[1200] = (bf16_t)(vv.w & 0xffffu); vd[1400] = (bf16_t)(vv.w >> 16);
        }
        __syncthreads();
        const int g = wid >> 1, qh = kvh * 4 + g, qhalf = wid & 1, pq = q0 + 32 * qhalf + r32;
        const bf16_t* qsrc = proj + (rowbase + pq) * 2560 + 1792 + qh * 64;
        bf16x8 qr[4];
#pragma unroll
        for (int d0 = 0; d0 < 4; ++d0) qr[d0] = *(const bf16x8*)(qsrc + d0 * 16 + hi * 8);
        f32x16 s[5];
#pragma unroll
        for (int t = 0; t < 5; ++t) {
            f32x16 a = {};
#pragma unroll
            for (int d0 = 0; d0 < 4; ++d0) {
                const bf16x8 kf = *(const bf16x8*)(Ks + (32 * (qhalf + t) + r32) * 72 + d0 * 16 + hi * 8);
                a = __builtin_amdgcn_mfma_f32_32x32x16_bf16(kf, qr[d0], a, 0, 0, 0);
            }
            s[t] = a;
        }
        const float sink2 = sinks[qh] * LOG2E_;
        float mx = sink2;
#pragma unroll
        for (int t = 0; t < 5; ++t)
#pragma unroll
            for (int r = 0; r < 16; ++r) {
                const int pk = q0 - 128 + 32 * (qhalf + t) + crow_(r, hi);
                const bool valid = (pk >= 0) && (pk <= pq) && (pq - pk < 128);
                const float v = valid ? s[t][r] : -INFINITY; s[t][r] = v; mx = fmaxf(mx, v);
            }
        mx = fmaxf(mx, __shfl_xor(mx, 32));
        float sum = 0.f;
#pragma unroll
        for (int t = 0; t < 5; ++t)
#pragma unroll
            for (int r = 0; r < 16; ++r) { const float e = __builtin_amdgcn_exp2f(s[t][r] - mx); s[t][r] = e; sum += e; }
        sum += __shfl_xor(sum, 32);
        sum += __builtin_amdgcn_exp2f(sink2 - mx);
        const float inv = 1.f / sum;
        f32x16 o[2]; o[0] = f32x16{}; o[1] = f32x16{};
#pragma unroll
        for (int t = 0; t < 5; ++t)
#pragma unroll
            for (int ss = 0; ss < 2; ++ss) {
                u32x4 pw; pw.x = pk2(s[t][8 * ss + 0], s[t][8 * ss + 1]); pw.y = pk2(s[t][8 * ss + 2], s[t][8 * ss + 3]); pw.z = pk2(s[t][8 * ss + 4], s[t][8 * ss + 5]); pw.w = pk2(s[t][8 * ss + 6], s[t][8 * ss + 7]);
                const bf16x8 pf = __builtin_bit_cast(bf16x8, pw);
#pragma unroll
                for (int dt = 0; dt < 2; ++dt) {
                    const bf16_t* vp = Vt + (32 * dt + r32) * 200 + 32 * (qhalf + t) + 16 * ss + 4 * hi;
                    const u32x2 lo = *(const u32x2*)vp, h2 = *(const u32x2*)(vp + 8);
                    u32x4 vw; vw.x = lo.x; vw.y = lo.y; vw.z = h2.x; vw.w = h2.y;
                    o[dt] = __builtin_amdgcn_mfma_f32_32x32x16_bf16(__builtin_bit_cast(bf16x8, vw), pf, o[dt], 0, 0, 0);
                }
            }
        bf16_t* orow = A + (rowbase + pq) * 1024 + 512 + qh * 64;
#pragma unroll
        for (int dt = 0; dt < 2; ++dt)
#pragma unroll
            for (int g4 = 0; g4 < 4; ++g4) {
                u32x2 q; q.x = pk2(o[dt][4 * g4] * inv, o[dt][4 * g4 + 1] * inv); q.y = pk2(o[dt][4 * g4 + 2] * inv, o[dt][4 * g4 + 3] * inv);
                *(u32x2*)(orow + 32 * dt + 8 * g4 + 4 * hi) = q;
            }
        __syncthreads();
    }
}

template <int MODE> struct LaCfg {
    static constexpr int DK = MODE ? 128 : 64, LQ = DK + 8, LG = DK + 4, PITCH = MODE ? 3584 : 2560, NG = DK / 8;
    static constexpr int QCOL = MODE ? 1536 : 0, KCOL = MODE ? 0 : 256, ZCOL = MODE ? 2048 : 512, VCOL = MODE ? 2560 : 768, GCOL = MODE ? 3072 : 1280, OCOL = MODE ? 512 : 0;
    static constexpr int O_QB = 0, O_KB = O_QB + 64 * LQ * 2, O_GF = O_KB + 64 * LQ * 2, O_VT = O_GF + 64 * LG * 4, O_SC = O_VT + 128 * 72 * 2, O_QE = O_SC + 64 * 72 * 2,
                         O_KT = O_QE + 64 * LQ * 2  , O_SEG = O_KT + DK * 72 * 2, O_RED = O_SEG + 8 * 128 * 4, O_END = O_RED + 8 * 64 * 4;
    static_assert(O_END <= LDS_BYTES, "LA LDS map");
};
__device__ __forceinline__ void unpack8(const u32x4 w, float (&f)[8]) { f[0] = bflo(w.x); f[1] = bfhi(w.x); f[2] = bflo(w.y); f[3] = bfhi(w.y); f[4] = bflo(w.z); f[5] = bfhi(w.z); f[6] = bflo(w.w); f[7] = bfhi(w.w); }
__device__ __forceinline__ u32x4 pack8(const float (&f)[8]) { u32x4 w; w.x = pk2(f[0], f[1]); w.y = pk2(f[2], f[3]); w.z = pk2(f[4], f[5]); w.w = pk2(f[6], f[7]); return w; }
__device__ __forceinline__ void ld8f(const float* p, float (&f)[8]) { const f32x4 a = *(const f32x4*)p, b = *(const f32x4*)(p + 4); f[0] = a[0]; f[1] = a[1]; f[2] = a[2]; f[3] = a[3]; f[4] = b[0]; f[5] = b[1]; f[6] = b[2]; f[7] = b[3]; }

template <int MODE, bool NEEDQ> __device__ __forceinline__ void la_load(const Ctx& C, int l, int b, int h, int c, bf16_t* Qb, bf16_t* Kb, float* Gf, bf16_t* Vt) {
    typedef LaCfg<MODE> Cf; const Params& p = C.p; const int j = l >> 1;
    const bf16_t* proj = (const bf16_t*)(p.ws + WS_R1);
    const size_t row0 = (size_t)b * SEQ_ + (size_t)c * 64;
    constexpr int NG = Cf::NG;
    for (int u = C.tid; u < 64 * NG; u += NTHR) {
        const int r = u / NG, kk = (u % NG) * 8;
        const bf16_t* rp = proj + (row0 + r) * Cf::PITCH + h * Cf::DK + kk;
        float z[8], kv[8], lg[8];
        unpack8(*(const u32x4*)(rp + Cf::ZCOL), z);
        if (MODE == 0) {
            unpack8(*(const u32x4*)(rp + Cf::KCOL), kv);
            const float* gb = p.gla_gate_b + j * 256 + h * 64 + kk;
#pragma unroll
            for (int e = 0; e < 8; ++e) { const float x = z[e] + gb[e]; lg[e] = (fminf(x, 0.f) * LOG2E_ - __log2f(1.f + __expf(-fabsf(x)))) * (1.f / 16.f); }
        } else {
            const float* lg0 = p.hgrn_lb_logits + h * 128 + kk;
#pragma unroll
            for (int e = 0; e < 8; ++e) {
                const float lb = (j == 0) ? 0.f : sigmoidf_(lg0[512 + e] - lg0[e]);
                const float sg = 1.f / (1.f + __expf(-z[e])), sgn = 1.f / (1.f + __expf(z[e]));
                lg[e] = __log2f(lb + (1.f - lb) * sg); kv[e] = (1.f - lb) * sgn;
            }
        }
        *(u32x4*)(Kb + r * Cf::LQ + kk) = pack8(kv);
        float* gd = Gf + r * Cf::LG + kk;
        *(f32x4*)gd = (f32x4){lg[0], lg[1], lg[2], lg[3]}; *(f32x4*)(gd + 4) = (f32x4){lg[4], lg[5], lg[6], lg[7]};
        if (NEEDQ) {
            float q[8]; unpack8(*(const u32x4*)(rp + Cf::QCOL), q);
#pragma unroll
            for (int e = 0; e < 8; ++e) q[e] = MODE ? siluf_(q[e]) * 0.08838834764831845f : q[e] * 0.125f;
            *(u32x4*)(Qb + r * Cf::LQ + kk) = pack8(q);
        }
    }
    for (int u = C.tid; u < 64 * 16; u += NTHR) {
        const int r = u >> 4, g8 = u & 15;
        const u32x4 w = *(const u32x4*)(proj + (row0 + r) * Cf::PITCH + Cf::VCOL + h * 128 + g8 * 8);
        bf16_t* vd = Vt + (g8 * 8) * 72 + r;
        vd[0] = (bf16_t)(w.x & 0xffffu); vd[72] = (bf16_t)(w.x >> 16); vd[144] = (bf16_t)(w.y & 0xffffu); vd[216] = (bf16_t)(w.y >> 16);
        vd[288] = (bf16_t)(w.z & 0xffffu); vd[360] = (bf16_t)(w.z >> 16); vd[432] = (bf16_t)(w.w & 0xffffu); vd[504] = (bf16_t)(w.w >> 16);
    }
}
template <int MODE> __device__ __forceinline__ void la_cumsum(const Ctx& C, float* Gf, float* segs) {
    typedef LaCfg<MODE> Cf; constexpr int DK = Cf::DK, NSEG = NTHR / DK, RPS = 64 / NSEG;
    const int k = C.tid % DK, seg = C.tid / DK;
    float v[RPS];
#pragma unroll
    for (int i = 0; i < RPS; ++i) v[i] = Gf[(seg * RPS + i) * Cf::LG + k];
#pragma unroll
    for (int i = 1; i < RPS; ++i) v[i] += v[i - 1];
    segs[seg * DK + k] = v[RPS - 1];
    __syncthreads();
    float off = 0.f;
#pragma unroll
    for (int s = 0; s < NSEG; ++s) { const float t = segs[s * DK + k]; off += (s < seg) ? t : 0.f; }
#pragma unroll
    for (int i = 0; i < RPS; ++i) Gf[(seg * RPS + i) * Cf::LG + k] = v[i] + off;
}

template <int MODE> __device__ __forceinline__ void phase_la_p1(const Ctx& C, int l) {
    typedef LaCfg<MODE> Cf; const Params& p = C.p; constexpr int DK = Cf::DK, LQ = Cf::LQ, LG = Cf::LG, NG = Cf::NG;
    bf16_t* Kb = (bf16_t*)(C.lds + Cf::O_KB); float* Gf = (float*)(C.lds + Cf::O_GF); bf16_t* Vt = (bf16_t*)(C.lds + Cf::O_VT);
    bf16_t* KhT = (bf16_t*)(C.lds + Cf::O_KT); float* segs = (float*)(C.lds + Cf::O_SEG);
    bf16_t* ST = (bf16_t*)(p.ws + WS_ST); float* TOT = (float*)(p.ws + WS_TOT);
    const int r16 = C.lane & 15, g = C.lane >> 4, w = C.wave;
    for (int it = blockIdx.x; it < 2048; it += gridDim.x) {
        const int bh = it >> 6, c = it & 63, b = bh >> 2, h = bh & 3;
        la_load<MODE, false>(C, l, b, h, c, nullptr, Kb, Gf, Vt);
        __syncthreads();
        la_cumsum<MODE>(C, Gf, segs);
        __syncthreads();
        for (int u = C.tid; u < 64 * NG; u += NTHR) {
            const int r = u / NG, kk = (u % NG) * 8;
            float kv[8], gj[8], gt[8];
            unpack8(*(const u32x4*)(Kb + r * LQ + kk), kv); ld8f(Gf + r * LG + kk, gj); ld8f(Gf + 63 * LG + kk, gt);
            bf16_t* kd = KhT + kk * 72 + r;
#pragma unroll
            for (int e = 0; e < 8; e += 2) { const unsigned pw = pk2(kv[e] * __builtin_amdgcn_exp2f(gt[e] - gj[e]), kv[e + 1] * __builtin_amdgcn_exp2f(gt[e + 1] - gj[e + 1]));
                kd[e * 72] = (bf16_t)(pw & 0xffffu); kd[(e + 1) * 72] = (bf16_t)(pw >> 16); }
        }
        if (C.tid < DK) TOT[(size_t)it * 128 + C.tid] = Gf[63 * LG + C.tid];
        __syncthreads();
        {
            const bf16x8 b0 = *(const bf16x8*)(Vt + (16 * w + r16) * 72 + 8 * g), b1 = *(const bf16x8*)(Vt + (16 * w + r16) * 72 + 32 + 8 * g);
            bf16_t* so = ST + (size_t)it * DK * 128 + (size_t)(16 * w + r16) * DK + 4 * g;
#pragma unroll
            for (int mt = 0; mt < DK / 16; ++mt) {
                const bf16x8 a0 = *(const bf16x8*)(KhT + (16 * mt + r16) * 72 + 8 * g), a1 = *(const bf16x8*)(KhT + (16 * mt + r16) * 72 + 32 + 8 * g);
                f32x4 acc = (f32x4){0.f, 0.f, 0.f, 0.f};
                acc = __builtin_amdgcn_mfma_f32_16x16x32_bf16(a0, b0, acc, 0, 0, 0);
                acc = __builtin_amdgcn_mfma_f32_16x16x32_bf16(a1, b1, acc, 0, 0, 0);
                u32x2 q; q.x = pk2(acc[0], acc[1]); q.y = pk2(acc[2], acc[3]);
                *(u32x2*)(so + 16 * mt) = q;
            }
        }
        __syncthreads();
    }
}

template <int MODE> __device__ __forceinline__ void phase_la_p2(const Ctx& C) {
    typedef LaCfg<MODE> Cf; const Params& p = C.p; constexpr int DK = Cf::DK, NG = Cf::NG;
    bf16_t* ST = (bf16_t*)(p.ws + WS_ST); const float* TOT = (const float*)(p.ws + WS_TOT);
    for (int u = blockIdx.x * NTHR + C.tid; u < 32 * 128 * NG; u += gridDim.x * NTHR) {
        const int k8 = u % NG, v = (u / NG) & 127, bh = u / (NG * 128);
        float S[8];
#pragma unroll
        for (int e = 0; e < 8; ++e) S[e] = 0.f;
        bf16_t* base = ST + (size_t)bh * 64 * DK * 128 + (size_t)v * DK + k8 * 8;
        const float* tb = TOT + (size_t)bh * 64 * 128 + k8 * 8;
#pragma unroll 4
        for (int c = 0; c < 64; ++c) {
            u32x4* ptr = (u32x4*)(base + (size_t)c * DK * 128);
            float kvv[8], dc[8]; unpack8(*ptr, kvv); ld8f(tb + c * 128, dc);
            *ptr = pack8(S);
#pragma unroll
            for (int e = 0; e < 8; ++e) S[e] = S[e] * __builtin_amdgcn_exp2f(dc[e]) + kvv[e];
        }
    }
}

template <int MODE> __device__ __forceinline__ void phase_la_p3(const Ctx& C, int l) {
    typedef LaCfg<MODE> Cf; const Params& p = C.p; constexpr int DK = Cf::DK, LQ = Cf::LQ, LG = Cf::LG, NG = Cf::NG, NKS = DK / 32;
    bf16_t* Qb = (bf16_t*)(C.lds + Cf::O_QB); bf16_t* Kb = (bf16_t*)(C.lds + Cf::O_KB); float* Gf = (float*)(C.lds + Cf::O_GF); bf16_t* Vt = (bf16_t*)(C.lds + Cf::O_VT);
    bf16_t* Sc = (bf16_t*)(C.lds + Cf::O_SC); bf16_t* Qe = (bf16_t*)(C.lds + Cf::O_QE); float* segs = (float*)(C.lds + Cf::O_SEG); float* red = (float*)(C.lds + Cf::O_RED);
    const bf16_t* ST = (const bf16_t*)(p.ws + WS_ST); const bf16_t* proj = (const bf16_t*)(p.ws + WS_R1); bf16_t* A = (bf16_t*)(p.ws + WS_A);
    const float* nw = (MODE ? p.hgrn_norm_w : p.gla_norm_w) + (l >> 1) * 128;
    const int r16 = C.lane & 15, g = C.lane >> 4, w = C.wave;
    const f32x4 nw4 = *(const f32x4*)(nw + 16 * w + 4 * g);
    for (int it = blockIdx.x; it < 2048; it += gridDim.x) {
        const int bh = it >> 6, c = it & 63, b = bh >> 2, h = bh & 3;
        bf16x8 sfr[NKS];
        { const bf16_t* sp = ST + (size_t)it * DK * 128 + (size_t)(16 * w + r16) * DK + 8 * g;
#pragma unroll
          for (int ks = 0; ks < NKS; ++ks) sfr[ks] = *(const bf16x8*)(sp + 32 * ks); }
        la_load<MODE, true>(C, l, b, h, c, Qb, Kb, Gf, Vt);
        for (int u = C.tid; u < 64 * 72 / 8; u += NTHR) *(u32x4*)(Sc + u * 8) = (u32x4){0u, 0u, 0u, 0u};
        __syncthreads();
        la_cumsum<MODE>(C, Gf, segs);
        __syncthreads();
        for (int t = w; t < 10; t += 8) {
            const int I = (t >= 6) ? 3 : (t >= 3) ? 2 : (t >= 1) ? 1 : 0, J = t - I * (I + 1) / 2;
            f32x4 acc = (f32x4){0.f, 0.f, 0.f, 0.f};
#pragma unroll
            for (int ks = 0; ks < NKS; ++ks) {
                const int kc = 32 * ks + 8 * g;
                float gref[8], gj[8], gi[8], kv[8], qv[8];
                ld8f(Gf + (16 * J + 15) * LG + kc, gref); ld8f(Gf + (16 * J + r16) * LG + kc, gj); ld8f(Gf + (16 * I + r16) * LG + kc, gi);
                unpack8(*(const u32x4*)(Kb + (16 * J + r16) * LQ + kc), kv); unpack8(*(const u32x4*)(Qb + (16 * I + r16) * LQ + kc), qv);
#pragma unroll
                for (int e = 0; e < 8; ++e) { kv[e] *= __builtin_amdgcn_exp2f(gref[e] - gj[e]); qv[e] *= __builtin_amdgcn_exp2f(gi[e] - gref[e]); }
                acc = __builtin_amdgcn_mfma_f32_16x16x32_bf16(__builtin_bit_cast(bf16x8, pack8(kv)), __builtin_bit_cast(bf16x8, pack8(qv)), acc, 0, 0, 0);
            }
            if (I == J) {
#pragma unroll
                for (int e = 0; e < 4; ++e) if (4 * g + e > r16) acc[e] = 0.f;
            }
            u32x2 q; q.x = pk2(acc[0], acc[1]); q.y = pk2(acc[2], acc[3]);
            *(u32x2*)(Sc + (16 * I + r16) * 72 + 16 * J + 4 * g) = q;
        }
        for (int u = C.tid; u < 64 * NG; u += NTHR) {
            const int r = u / NG, kk = (u % NG) * 8;
            float qv[8], gi[8]; unpack8(*(const u32x4*)(Qb + r * LQ + kk), qv); ld8f(Gf + r * LG + kk, gi);
#pragma unroll
            for (int e = 0; e < 8; ++e) qv[e] *= __builtin_amdgcn_exp2f(gi[e]);
            *(u32x4*)(Qe + r * LQ + kk) = pack8(qv);
        }
        __syncthreads();
        f32x4 o[4];
        {
            const bf16x8 v0 = *(const bf16x8*)(Vt + (16 * w + r16) * 72 + 8 * g), v1 = *(const bf16x8*)(Vt + (16 * w + r16) * 72 + 32 + 8 * g);
#pragma unroll
            for (int nt = 0; nt < 4; ++nt) {
                f32x4 acc = (f32x4){0.f, 0.f, 0.f, 0.f};
                acc = __builtin_amdgcn_mfma_f32_16x16x32_bf16(v0, *(const bf16x8*)(Sc + (16 * nt + r16) * 72 + 8 * g), acc, 0, 0, 0);
                if (nt >= 2) acc = __builtin_amdgcn_mfma_f32_16x16x32_bf16(v1, *(const bf16x8*)(Sc + (16 * nt + r16) * 72 + 32 + 8 * g), acc, 0, 0, 0);
#pragma unroll
                for (int ks = 0; ks < NKS; ++ks) acc = __builtin_amdgcn_mfma_f32_16x16x32_bf16(sfr[ks], *(const bf16x8*)(Qe + (16 * nt + r16) * LQ + 32 * ks + 8 * g), acc, 0, 0, 0);
                o[nt] = acc;
                float ss = acc[0] * acc[0] + acc[1] * acc[1] + acc[2] * acc[2] + acc[3] * acc[3];
                ss += __shfl_xor(ss, 16); ss += __shfl_xor(ss, 32);
                if (g == 0) red[w * 64 + 16 * nt + r16] = ss;
            }
        }
        __syncthreads();
#pragma unroll
        for (int nt = 0; nt < 4; ++nt) {
            float tot = 0.f;
#pragma unroll
            for (int ww = 0; ww < 8; ++ww) tot += red[ww * 64 + 16 * nt + r16];
            const float rs = rsqrtf(tot * (1.f / 128.f) + 1e-6f);
            const size_t row = (size_t)b * SEQ_ + (size_t)c * 64 + 16 * nt + r16;
            const u32x2 gw = *(const u32x2*)(proj + row * Cf::PITCH + Cf::GCOL + h * 128 + 16 * w + 4 * g);
            u32x2 q; q.x = pk2(o[nt][0] * rs * nw4[0] * siluf_(bflo(gw.x)), o[nt][1] * rs * nw4[1] * siluf_(bfhi(gw.x)));
            q.y = pk2(o[nt][2] * rs * nw4[2] * siluf_(bflo(gw.y)), o[nt][3] * rs * nw4[3] * siluf_(bfhi(gw.y)));
            *(u32x2*)(A + row * 1024 + Cf::OCOL + h * 128 + 16 * w + 4 * g) = q;
        }
        __syncthreads();
    }
}


typedef unsigned u32x16 __attribute__((ext_vector_type(16)));
__device__ __forceinline__ void load_params(Params& p) {
    auto kp = __builtin_amdgcn_kernarg_segment_ptr();
    u32x16 a, b, c, d;
    asm volatile("s_load_dwordx16 %0, %4, 0x0\n\ts_load_dwordx16 %1, %4, 0x40\n\ts_load_dwordx16 %2, %4, 0x80\n\ts_load_dwordx16 %3, %4, 0xc0\n\ts_waitcnt lgkmcnt(0)"
                 : "=&s"(a), "=&s"(b), "=&s"(c), "=&s"(d) : "s"(kp) : "memory");
    unsigned long long q[32];
#pragma unroll
    for (int i = 0; i < 8; ++i) { q[i] = ((unsigned long long)a[2 * i + 1] << 32) | a[2 * i]; q[8 + i] = ((unsigned long long)b[2 * i + 1] << 32) | b[2 * i];
        q[16 + i] = ((unsigned long long)c[2 * i + 1] << 32) | c[2 * i]; q[24 + i] = ((unsigned long long)d[2 * i + 1] << 32) | d[2 * i]; }
    p.x = (const float*)q[0]; p.c = (const float*)q[1]; p.positions = (const int*)q[2]; p.mod_w = (const float*)q[3]; p.mod_b = (const float*)q[4]; p.norm_mix_w = (const float*)q[5]; p.norm_ffn_w = (const float*)q[6];
    p.ev_w_in = (const float*)q[7]; p.gla_gate_w = (const float*)q[8]; p.gla_gate_b = (const float*)q[9]; p.gla_norm_w = (const float*)q[10]; p.swa_sinks = (const float*)q[11]; p.ev_w_out = (const float*)q[12];
    p.od_w_in = (const float*)q[13]; p.diff_lambda = (const float*)q[14]; p.diff_norm_w = (const float*)q[15]; p.hgrn_lb_logits = (const float*)q[16]; p.hgrn_norm_w = (const float*)q[17]; p.od_w_out = (const float*)q[18];
    p.ffn_w_in = (const float*)q[19]; p.ffn_conv_w = (const float*)q[20]; p.ffn_conv_b = (const float*)q[21]; p.ffn_w_out = (const float*)q[22]; p.final_norm_w = (const float*)q[23];
    p.out = (float*)q[24]; p.ws = (unsigned char*)q[25];
}

#ifndef REP_LA
#define REP_LA 1
#endif
#ifndef REP_AT
#define REP_AT 1
#endif
#ifndef REP_SM
#define REP_SM 1
#endif
__global__ void __launch_bounds__(NTHR, 2) fwd_megakernel(Params pin) {
    extern __shared__ __attribute__((aligned(16))) unsigned char lds[];
    cg::grid_group grid = cg::this_grid();
    Ctx C; C.lds = lds; C.tid = threadIdx.x; C.lane = C.tid & 63; C.wave = __builtin_amdgcn_readfirstlane(C.tid >> 6);
    C.gw = blockIdx.x * 8 + C.wave; C.ngw = gridDim.x * 8;
    PG8_LAS unsigned char* ldsg = (PG8_LAS unsigned char*)lds;
#define RP() do { load_params(C.p); C.tid = otid_(); C.lane = C.tid & 63; C.wave = __builtin_amdgcn_readfirstlane(C.tid >> 6); C.gw = blockIdx.x * 8 + C.wave; } while (0)
#define WSP(off) (C.p.ws + (off))

#ifndef NO_PRO
    for (int rep_ = 0; rep_ < REP_SM; ++rep_) { RP(); phase_prologue(C); }
#endif
    grid.sync();
#pragma unroll 1
    for (int l = 0; l < 4; ++l) {
        const bool even = !(l & 1);
#ifndef NO_CONV
        for (int rep_ = 0; rep_ < REP_SM; ++rep_) { RP(); phase_convert(C, l); }
#endif
#ifndef NO_NORM
        for (int rep_ = 0; rep_ < REP_SM; ++rep_) { RP(); phase_norm(C, (l == 0) ? C.p.x : C.p.out, C.p.norm_mix_w + l * 1024, (const float*)WSP(WS_MOD) + (size_t)l * 8 * 6144, 0, 1024, (bf16_t*)WSP(WS_A)); }
#endif
        grid.sync();
        {
            RP();
            const int N = even ? 2560 : 3584;
            pg8::Gemm g{(const bf16_t*)WSP(WS_A), (const bf16_t*)WSP(WS_WIN), T_, N, 1024}; pg8::StaticOrder S; S.init(T_, N, (int)gridDim.x, (int)blockIdx.x);
            pg8::EpiProj E{(bf16_t*)WSP(WS_R1), N, even ? 0x7C000u : 0xFFu, even ? 0x3C000u : 0xFu, QSCALE_, (const float*)WSP(WS_COS), (const float*)WSP(WS_SIN)};
#ifndef NO_GPROJ
            pg8::gemm_phase<pg8::EpiProj, pg8::StaticOrder, true, true>(ldsg, g, S, E);
#endif
        }
        grid.sync();
        if (even) {
#ifndef NO_SWA
            for (int rep_ = 0; rep_ < REP_AT; ++rep_) { RP(); phase_swa(C, l); }
#endif
#ifndef NO_P1
            for (int rep_ = 0; rep_ < REP_LA; ++rep_) { RP(); phase_la_p1<0>(C, l); }
#endif
            grid.sync();
#ifndef NO_P2
            RP(); phase_la_p2<0>(C);
#endif
            grid.sync();
#ifndef NO_P3
            for (int rep_ = 0; rep_ < REP_LA; ++rep_) { RP(); phase_la_p3<0>(C, l); }
#endif
        } else {
            for (int rep_ = 0; rep_ < REP_AT; ++rep_) {
                RP();
                const bf16_t* R1 = (const bf16_t*)WSP(WS_R1); bf16_t* X2 = (bf16_t*)WSP(WS_X2);
                const int G = (int)gridDim.x, bid = (int)blockIdx.x;
#pragma unroll 1
                for (int i = 0; i * G < 2048; ++i) {
                    const int L = i * G + ((i & 1) ? (G - 1 - bid) : bid);
                    if (L >= 2048) continue;
                    const int qb = 15 - (L >> 7), bh = L & 127, b = bh >> 4, hv = bh & 15;
                    const attn_body::bf16* Q = (const attn_body::bf16*)(R1 + (hv >> 1) * 64);
                    const attn_body::bf16* K = (const attn_body::bf16*)(R1 + 512 + (hv >> 1) * 64);
                    const attn_body::bf16* V = (const attn_body::bf16*)(R1 + 1024 + (hv >> 2) * 128 + (hv & 1) * 64);
#ifndef NO_ATTN
                    attn_body::attn_unit<8>(b, hv, qb, Q, K, V, (attn_body::bf16*)(X2 + hv * 64), (char*)lds);
#endif
                }
            }
#ifndef NO_P1
            for (int rep_ = 0; rep_ < REP_LA; ++rep_) { RP(); phase_la_p1<1>(C, l); }
#endif
            grid.sync();
#ifndef NO_P2
            RP(); phase_la_p2<1>(C);
#endif
#ifndef NO_COMB
            RP(); phase_diff_combine(C, l);
#endif
            grid.sync();
#ifndef NO_P3
            for (int rep_ = 0; rep_ < REP_LA; ++rep_) { RP(); phase_la_p3<1>(C, l); }
#endif
        }
        grid.sync();
        {
            RP();
            pg8::Gemm g{(const bf16_t*)WSP(WS_A), (const bf16_t*)WSP(WS_WOUT), T_, 1024, 1024}; pg8::StaticOrder S; S.init(T_, 1024, (int)gridDim.x, (int)blockIdx.x);
            pg8::EpiRes E{(l == 0) ? C.p.x : C.p.out, C.p.out, (const float*)WSP(WS_MOD) + (size_t)l * 8 * 6144 + 2048};
#ifndef NO_GRES
            pg8::gemm_phase<pg8::EpiRes, pg8::StaticOrder, true, true>(ldsg, g, S, E);
#endif
        }
        grid.sync();
#ifndef NO_NORM
        for (int rep_ = 0; rep_ < REP_SM; ++rep_) { RP(); phase_norm(C, C.p.out, C.p.norm_ffn_w + l * 1024, (const float*)WSP(WS_MOD) + (size_t)l * 8 * 6144, 3072, 4096, (bf16_t*)WSP(WS_A)); }
#endif
        grid.sync();
        {
            RP();
            pg8::Gemm g{(const bf16_t*)WSP(WS_A), (const bf16_t*)WSP(WS_FIN), T_, 5632, 1024}; pg8::StaticOrder S; S.init(T_, 5632, (int)gridDim.x, (int)blockIdx.x);
            pg8::EpiFfn E{(bf16_t*)WSP(WS_R1), (float*)WSP(WS_HP), (float*)WSP(WS_HU), (float*)WSP(WS_HA), C.p.ffn_conv_w + (size_t)l * 3 * DFF_, C.p.ffn_conv_b + (size_t)l * DFF_};
#ifndef NO_GFFN
            pg8::gemm_phase<pg8::EpiFfn, pg8::StaticOrder, true, true>(ldsg, g, S, E);
#endif
        }
        grid.sync();
#ifndef NO_FIX
        for (int rep_ = 0; rep_ < REP_SM; ++rep_) { RP(); phase_ffn_fixup(C, l); }
#endif
        grid.sync();
        {
            RP();
            pg8::Gemm g{(const bf16_t*)WSP(WS_R1), (const bf16_t*)WSP(WS_FOUT), T_, 1024, DFF_}; pg8::StaticOrder S; S.init(T_, 1024, (int)gridDim.x, (int)blockIdx.x);
            pg8::EpiRes E{C.p.out, C.p.out, (const float*)WSP(WS_MOD) + (size_t)l * 8 * 6144 + 5120};
#ifndef NO_GRES
            pg8::gemm_phase<pg8::EpiRes, pg8::StaticOrder, true, true>(ldsg, g, S, E);
#endif
        }
        grid.sync();
    }
    RP(); phase_final_norm(C, C.p.out, C.p.final_norm_w);
}

extern "C" void kernel_launch(void* const* d_in, const int* in_sizes, int n_in, void* d_out, int out_size, void* d_ws, size_t ws_size, hipStream_t stream) {
    static int grid_blocks = 0;
    if (grid_blocks == 0) {
        if (n_in != 24 || ws_size < WS_END) { fprintf(stderr, "kernel_launch: unexpected n_in %d / ws %zu\n", n_in, ws_size); grid_blocks = -1; return; }
        int dev = 0, cus = 0, per_cu = 0;
        hipGetDevice(&dev); hipDeviceGetAttribute(&cus, hipDeviceAttributeMultiprocessorCount, dev);
        if (hipFuncSetAttribute((const void*)fwd_megakernel, hipFuncAttributeMaxDynamicSharedMemorySize, LDS_BYTES) != hipSuccess) { fprintf(stderr, "kernel_launch: hipFuncSetAttribute failed\n"); grid_blocks = -1; return; }
        if (hipOccupancyMaxActiveBlocksPerMultiprocessor(&per_cu, (const void*)fwd_megakernel, NTHR, LDS_BYTES) != hipSuccess || per_cu < 1) { fprintf(stderr, "kernel_launch: occupancy query gave %d\n", per_cu); per_cu = 1; }
        (void)hipGetLastError();
        grid_blocks = cus * per_cu;
    }
    if (grid_blocks < 0) return;
    Params p{};
    p.x = (const float*)d_in[0]; p.c = (const float*)d_in[1]; p.positions = (const int*)d_in[2]; p.mod_w = (const float*)d_in[3]; p.mod_b = (const float*)d_in[4];
    p.norm_mix_w = (const float*)d_in[5]; p.norm_ffn_w = (const float*)d_in[6]; p.ev_w_in = (const float*)d_in[7]; p.gla_gate_w = (const float*)d_in[8];
    p.gla_gate_b = (const float*)d_in[9]; p.gla_norm_w = (const float*)d_in[10]; p.swa_sinks = (const float*)d_in[11]; p.ev_w_out = (const float*)d_in[12];
    p.od_w_in = (const float*)d_in[13]; p.diff_lambda = (const float*)d_in[14]; p.diff_norm_w = (const float*)d_in[15]; p.hgrn_lb_logits = (const float*)d_in[16];
    p.hgrn_norm_w = (const float*)d_in[17]; p.od_w_out = (const float*)d_in[18]; p.ffn_w_in = (const float*)d_in[19]; p.ffn_conv_w = (const float*)d_in[20];
    p.ffn_conv_b = (const float*)d_in[21]; p.ffn_w_out = (const float*)d_in[22]; p.final_norm_w = (const float*)d_in[23];
    p.out = (float*)d_out; p.ws = (unsigned char*)d_ws;
    void* args[] = {&p};
    hipError_t e = hipLaunchCooperativeKernel((const void*)fwd_megakernel, dim3(grid_blocks), dim3(NTHR), args, LDS_BYTES, stream);
    if (e != hipSuccess) fprintf(stderr, "cooperative launch failed: %s (grid %d)\n", hipGetErrorString(e), grid_blocks);
}
```

```cpp
#include <hip/hip_runtime.h>
#include <hip/hip_cooperative_groups.h>
#include <hip/hip_bf16.h>
#include <cstdio>
#include <cstdint>
#include <cmath>
__device__ __forceinline__ int otid_() { int t = threadIdx.x; asm volatile("" : "+v"(t)); return t; }
namespace pg8 {
#define PG8_LAS __attribute__((address_space(3)))
typedef unsigned short bf16_t;
typedef short bf16x8 __attribute__((ext_vector_type(8)));
typedef float f32x4 __attribute__((ext_vector_type(4)));
typedef unsigned u32x4 __attribute__((ext_vector_type(4)));
constexpr int BM = 256, BK = 64, HALF = 128, HTB = HALF * BK * 2  , STAGE_BYTES = 8 * HTB, NXCD = 8, WGM = 8;

__host__ __device__ __forceinline__ int lds_byte(int r, int c) { const int st = (r >> 4) * 2 + (c >> 5), rr = r & 15, cc = c & 31, ob = rr * 64 + cc * 2; return st * 1024 + (ob ^ (((ob >> 9) & 1) << 5)); }
__host__ __device__ __forceinline__ void stage_rc(int b, int& R, int& C) { const int st = b / 1024, sb = b % 1024, swz = sb ^ (((sb >> 9) & 1) << 5); R = (st >> 1) * 16 + swz / 64; C = (st & 1) * 32 + (swz % 64) / 2; }
__host__ __device__ __forceinline__ int perm32(int rho) { const int n = rho >> 4, i = rho & 15; return 8 * (i >> 2) + 4 * n + (i & 3); }

struct Unit { int pm, pn; };
struct Gemm { const bf16_t* A; const bf16_t* Bt; int M, N, K; };

struct StaticOrder {
    int nM, nN, nwg, G, c;
    __host__ __device__ void init(int M, int N, int G_, int c_) { nM = M / BM; nN = N / BM; nwg = nM * nN; G = G_; c = c_; }
    __host__ __device__ bool next(int i, Unit& u) const {
        const long L = (long)i * G + c; if (L >= nwg) return false;
        int wgid = (int)L; { const int q = nwg / NXCD, r = nwg % NXCD, xcd = wgid % NXCD, off = wgid / NXCD; wgid = (xcd < r ? xcd * (q + 1) : r * (q + 1) + (xcd - r) * q) + off; }
        const int nig = WGM * nN, gid = wgid / nig, fm = gid * WGM, gsz = (nM - fm) < WGM ? (nM - fm) : WGM;
        u.pm = fm + ((wgid % nig) % gsz); u.pn = (wgid % nig) / gsz; return true;
    }
    __device__ __forceinline__ void a_ready(const Unit&) const {}
    __device__ __forceinline__ void done(const Unit&) const {}
};

__device__ __forceinline__ unsigned cvt_pk_bf16(float lo, float hi) { unsigned r; asm volatile("v_cvt_pk_bf16_f32 %0, %1, %2" : "=v"(r) : "v"(lo), "v"(hi)); return r; }
typedef float f32x2 __attribute__((ext_vector_type(2)));
template <class Epi, class Sched, bool ALIGN_EPI = false, bool SP2 = false>
__device__ __forceinline__ void gemm_phase(PG8_LAS unsigned char* lds, const Gemm g, const Sched& S, const Epi& E) {
    const int tid = otid_(), wid = __builtin_amdgcn_readfirstlane(tid >> 6), lane = tid & 63, wr = wid >> 2, wc = wid & 3, fr = lane & 15, fq = lane >> 4;
    const int K = g.K, nt = K / BK;
    unsigned voffA[2], voffB[2];
#pragma unroll
    for (int i = 0; i < 2; ++i) { int R, C; stage_rc(tid * 16 + i * 8192, R, C); const int Rb = Epi::PERM ? ((R & ~31) + perm32(R & 31)) : R;
        voffA[i] = (unsigned)(R * K + C) * 2u; voffB[i] = (unsigned)(Rb * K + C) * 2u; }
    const size_t kstep = (size_t)(BK * 2);
    const size_t hstep = (size_t)HALF * K * 2;
    const size_t tstep = 2 * hstep;
    const unsigned ldsw = (unsigned)wid * 1024u;
    const int aoff = lds_byte(wr * 64 + fr, fq * 8), boff = lds_byte(wc * 32 + fr, fq * 8);
#define PG8_SA(b, h) (((b) * 2 + (h)) * HTB)
#define PG8_SB(b, h) ((4 + (b) * 2 + (h)) * HTB)
#define PG8_STAGE(bufoff, gbase, voff) do { _Pragma("unroll") for (int _i = 0; _i < 2; ++_i) \
        __builtin_amdgcn_global_load_lds((const unsigned*)((const char*)(gbase) + (voff)[_i]), (PG8_LAS unsigned*)(lds + (bufoff) + ldsw + _i * 8192), 16, 0, 0); } while (0)
#define PG8_LDA(dst, b, h) do { _Pragma("unroll") for (int m = 0; m < 4; ++m) _Pragma("unroll") for (int k = 0; k < 2; ++k) dst[m][k] = *(const PG8_LAS bf16x8*)(lds + PG8_SA(b, h) + aoff + m * 2048 + k * 1024); } while (0)
#define PG8_LDB(dst, b, h) do { _Pragma("unroll") for (int n = 0; n < 2; ++n) _Pragma("unroll") for (int k = 0; k < 2; ++k) dst[n][k] = *(const PG8_LAS bf16x8*)(lds + PG8_SB(b, h) + boff + n * 2048 + k * 1024); } while (0)
#define PG8_MMA(ai, bj, At, Bt) do { __builtin_amdgcn_s_setprio(1); _Pragma("unroll") for (int m = 0; m < 4; ++m) _Pragma("unroll") for (int n = 0; n < 2; ++n) _Pragma("unroll") for (int k = 0; k < 2; ++k) \
        acc[ai][bj][m][n] = __builtin_amdgcn_mfma_f32_16x16x32_bf16(Bt[n][k], At[m][k], acc[ai][bj][m][n], 0, 0, 0); __builtin_amdgcn_s_setprio(0); } while (0)
#define PG8_WAIT_V(n) asm volatile("s_waitcnt vmcnt(" #n ")" ::: "memory")
#define PG8_WAIT_L(n) asm volatile("s_waitcnt lgkmcnt(" #n ")" ::: "memory")
#define PG8_BAR __builtin_amdgcn_s_barrier()
#define PG8_SCHED __builtin_amdgcn_sched_barrier(0)
    Unit cur, nxt; int ui = 0;
    if (!S.next(0, cur)) return;
    f32x4 acc[2][2][4][2];
#pragma unroll
    for (int a = 0; a < 2; ++a)
#pragma unroll
        for (int b = 0; b < 2; ++b)
#pragma unroll
            for (int m = 0; m < 4; ++m)
#pragma unroll
                for (int n = 0; n < 2; ++n) acc[a][b][m][n] = (f32x4){0.f, 0.f, 0.f, 0.f};
    bf16x8 At[4][2], B0[2][2], B1[2][2];
    const char* cA = (const char*)g.A + (size_t)cur.pm * tstep; const char* cB = (const char*)g.Bt + (size_t)cur.pn * tstep;
    S.a_ready(cur);
    if constexpr (SP2) {
        PG8_STAGE(PG8_SB(0, 0), cB, voffB); PG8_STAGE(PG8_SB(0, 1), cB + hstep, voffB); PG8_STAGE(PG8_SA(0, 0), cA, voffA); PG8_STAGE(PG8_SA(0, 1), cA + hstep, voffA);
        if (wr == 1) PG8_BAR;
        PG8_WAIT_V(2); PG8_BAR;
        PG8_STAGE(PG8_SB(1, 0), cB + kstep, voffB); PG8_STAGE(PG8_SA(1, 0), cA + kstep, voffA); PG8_STAGE(PG8_SB(1, 1), cB + hstep + kstep, voffB);
        PG8_WAIT_V(6); PG8_BAR;
    } else {
        PG8_STAGE(PG8_SB(0, 0), cB, voffB); PG8_STAGE(PG8_SA(0, 0), cA, voffA); PG8_STAGE(PG8_SB(0, 1), cB + hstep, voffB); PG8_STAGE(PG8_SA(0, 1), cA + hstep, voffA);
        if (wr == 1) PG8_BAR;
        PG8_WAIT_V(4); PG8_BAR;
        PG8_STAGE(PG8_SB(1, 0), cB + kstep, voffB); PG8_STAGE(PG8_SA(1, 0), cA + kstep, voffA); PG8_STAGE(PG8_SB(1, 1), cB + hstep + kstep, voffB);
        PG8_WAIT_V(6); PG8_BAR;
    }
    for (;;) {
        const bool has_next = S.next(ui + 1, nxt);
        const char* nA = has_next ? (const char*)g.A + (size_t)nxt.pm * tstep : cA; const char* nB = has_next ? (const char*)g.Bt + (size_t)nxt.pn * tstep : cB;
        for (int t = 0; t < nt; t += 2) {
            const bool last = (t == nt - 2);
            const char* a1 = cA + (size_t)(t + 1) * kstep;
            const char* a2 = last ? nA : cA + (size_t)(t + 2) * kstep; const char* b2 = last ? nB : cB + (size_t)(t + 2) * kstep;
            const char* a3 = a2 + kstep; const char* b3 = b2 + kstep;
            if (last && has_next) S.a_ready(nxt);
            if constexpr (SP2) {
            PG8_LDB(B0, 0, 0); PG8_LDB(B1, 0, 1); PG8_SCHED; PG8_LDA(At, 0, 0); PG8_STAGE(PG8_SA(1, 1), a1 + hstep, voffA);
            PG8_WAIT_V(8); PG8_WAIT_L(0); PG8_BAR; PG8_MMA(0, 0, At, B0); PG8_MMA(0, 1, At, B1); PG8_BAR; PG8_SCHED;
            PG8_LDA(At, 0, 1); PG8_STAGE(PG8_SB(0, 0), b2, voffB); PG8_STAGE(PG8_SB(0, 1), b2 + hstep, voffB); PG8_STAGE(PG8_SA(0, 0), a2, voffA);
            PG8_WAIT_V(8); PG8_WAIT_L(0); PG8_BAR; PG8_MMA(1, 0, At, B0); PG8_MMA(1, 1, At, B1); PG8_BAR; PG8_SCHED;
            PG8_LDB(B0, 1, 0); PG8_LDB(B1, 1, 1); PG8_SCHED; PG8_LDA(At, 1, 0); PG8_STAGE(PG8_SA(0, 1), a2 + hstep, voffA);
            PG8_WAIT_V(8); PG8_WAIT_L(0); PG8_BAR; PG8_MMA(0, 0, At, B0); PG8_MMA(0, 1, At, B1); PG8_BAR; PG8_SCHED;
            PG8_LDA(At, 1, 1); PG8_STAGE(PG8_SB(1, 0), b3, voffB); PG8_STAGE(PG8_SB(1, 1), b3 + hstep, voffB); PG8_STAGE(PG8_SA(1, 0), a3, voffA);
            PG8_WAIT_V(8); PG8_WAIT_L(0); PG8_BAR; PG8_MMA(1, 0, At, B0); PG8_MMA(1, 1, At, B1); PG8_BAR; PG8_SCHED;
            } else {
            PG8_LDB(B0, 0, 0); PG8_SCHED; PG8_LDA(At, 0, 0); PG8_STAGE(PG8_SA(1, 1), a1 + hstep, voffA);
            PG8_WAIT_L(8); PG8_BAR; PG8_WAIT_L(0); PG8_MMA(0, 0, At, B0); PG8_BAR; PG8_SCHED;
            PG8_LDB(B1, 0, 1); PG8_STAGE(PG8_SB(0, 0), b2, voffB);
            PG8_BAR; PG8_WAIT_L(0); PG8_MMA(0, 1, At, B1); PG8_BAR;
            PG8_LDA(At, 0, 1); PG8_STAGE(PG8_SA(0, 0), a2, voffA);
            PG8_BAR; PG8_WAIT_L(0); PG8_MMA(1, 0, At, B0); PG8_BAR; PG8_SCHED;
            PG8_STAGE(PG8_SB(0, 1), b2 + hstep, voffB);
            PG8_WAIT_V(6); PG8_BAR; PG8_MMA(1, 1, At, B1); PG8_BAR;
            PG8_LDB(B0, 1, 0); PG8_SCHED; PG8_LDA(At, 1, 0); PG8_STAGE(PG8_SA(0, 1), a2 + hstep, voffA);
            PG8_WAIT_L(8); PG8_BAR; PG8_WAIT_L(0); PG8_MMA(0, 0, At, B0); PG8_BAR; PG8_SCHED;
            PG8_LDB(B1, 1, 1); PG8_STAGE(PG8_SB(1, 0), b3, voffB);
            PG8_BAR; PG8_WAIT_L(0); PG8_MMA(0, 1, At, B1); PG8_BAR;
            PG8_LDA(At, 1, 1); PG8_STAGE(PG8_SA(1, 0), a3, voffA);
            PG8_BAR; PG8_WAIT_L(0); PG8_MMA(1, 0, At, B0); PG8_BAR; PG8_SCHED;
            PG8_STAGE(PG8_SB(1, 1), b3 + hstep, voffB);
            PG8_WAIT_V(6); PG8_BAR; PG8_MMA(1, 1, At, B1); PG8_BAR;
            }
        }
        if constexpr (ALIGN_EPI) { if (wr == 0) PG8_BAR; }
        if constexpr (!Epi::AFTER_DRAIN) { E(acc, cur, wr, wc, fr, fq); S.done(cur); }
        if (!has_next) break;
#pragma unroll
        for (int a = 0; a < 2; ++a)
#pragma unroll
            for (int b = 0; b < 2; ++b)
#pragma unroll
                for (int m = 0; m < 4; ++m)
#pragma unroll
                    for (int n = 0; n < 2; ++n) acc[a][b][m][n] = (f32x4){0.f, 0.f, 0.f, 0.f};
        cur = nxt; cA = nA; cB = nB; ++ui;
        if constexpr (ALIGN_EPI) { if (wr == 1) PG8_BAR; }
    }
    PG8_WAIT_V(0);
    if constexpr (!ALIGN_EPI) { if (wr == 0) PG8_BAR; }
    PG8_BAR;
    if constexpr (Epi::AFTER_DRAIN) { E.fused(acc, cur, wr, wc, fr, fq, lds, wid, lane); S.done(cur); }
#undef PG8_SA
#undef PG8_SB
#undef PG8_STAGE
#undef PG8_LDA
#undef PG8_LDB
#undef PG8_MMA
#undef PG8_WAIT_V
#undef PG8_WAIT_L
#undef PG8_BAR
#undef PG8_SCHED
}
}
#include <hip/hip_bf16.h>
namespace attn_body {
using bf16=__hip_bfloat16;
using bf16x8=__attribute__((ext_vector_type(8)))short;
using s16x4=__attribute__((ext_vector_type(4)))short;
using f32x16=__attribute__((ext_vector_type(16)))float;
using u32x4=__attribute__((ext_vector_type(4)))unsigned;
constexpr int BATCH=8,NHEAD=16,SEQ=4096,D=64,PITI=3584,PITO=1024;
constexpr int NW=8,QBLK=32,QB=QBLK*NW,KVBLK=64,NQB=SEQ/QB;
__device__ __forceinline__ int crow(int r,int hi){return (r&3)+8*(r>>2)+4*hi;}
#define SBAR() __builtin_amdgcn_sched_barrier(0)
__device__ __forceinline__ void cmask(f32x16&p0,f32x16&p1,int jb,int qrel,int hi){
  const float NEG=-INFINITY; int kb=64*jb+4*hi;
  #pragma unroll
  for(int r=0;r<16;++r){int kv=kb+(r&3)+8*(r>>2); if(kv>qrel)p0[r]=NEG; if(kv+32>qrel)p1[r]=NEG;}
}

constexpr int NSLOT=3, SLOTB=8192;
constexpr int LDS_K=0, LDS_V=NSLOT*SLOTB, LDS_WS=2*NSLOT*SLOTB, LDS_OST=LDS_WS+NW*64*4, LDS_BYTES=LDS_OST+NW*4096;
constexpr float C2=0.125f*1.4426950408889634f;
__device__ __forceinline__ void glds16(const void*gsrc,unsigned lds_dst){unsigned keep;
  asm volatile("s_mov_b32 %0, m0\n\ts_mov_b32 m0, %2\n\ts_nop 0\n\tglobal_load_lds_dwordx4 %1, off\n\ts_mov_b32 m0, %0":"=&s"(keep):"v"(gsrc),"s"(lds_dst):"memory");}
__device__ __forceinline__ float max3f(float a,float b,float c){float r;asm("v_max3_f32 %0, %1, %2, %3":"=v"(r):"v"(a),"v"(b),"v"(c));return r;}
__device__ __forceinline__ float max2f(float a,float b){float r;asm("v_max_f32_e32 %0, %1, %2":"=v"(r):"v"(a),"v"(b));return r;}
__device__ __forceinline__ float fadd_s(float a,float b){float r;asm("v_add_f32_e32 %0, %1, %2":"=v"(r):"v"(a),"v"(b));return r;}
__device__ __forceinline__ float fsub_s(float a,float b){float r;asm("v_sub_f32_e32 %0, %1, %2":"=v"(r):"v"(a),"v"(b));return r;}
typedef float f32x2_t __attribute__((ext_vector_type(2))); typedef __bf16 bf16x2_t __attribute__((ext_vector_type(2)));
__device__ __forceinline__ unsigned cvtpk_s(float lo,float hi){f32x2_t v={lo,hi};bf16x2_t b=__builtin_convertvector(v,bf16x2_t);return __builtin_bit_cast(unsigned,b);}
#define WAIT_BAR(N) asm volatile("s_waitcnt vmcnt(" #N ") lgkmcnt(0)\n\ts_barrier":::"memory")

__device__ __forceinline__ void qkt(f32x16&p0,f32x16&p1,const char*Kslot,const bf16x8*qr,const f32x16&negm,int r32,int hi){
  const char*kb=Kslot+hi*1024+r32*16;
  #pragma unroll
  for(int d0=0;d0<4;++d0){
    const bf16x8 b0=*reinterpret_cast<const bf16x8*>(kb+d0*2048);
    const bf16x8 b1=*reinterpret_cast<const bf16x8*>(kb+d0*2048+512);
    if(d0==0){p0=__builtin_amdgcn_mfma_f32_32x32x16_bf16(b0,qr[0],negm,0,0,0);p1=__builtin_amdgcn_mfma_f32_32x32x16_bf16(b1,qr[0],negm,0,0,0);}
    else{p0=__builtin_amdgcn_mfma_f32_32x32x16_bf16(b0,qr[d0],p0,0,0,0);p1=__builtin_amdgcn_mfma_f32_32x32x16_bf16(b1,qr[d0],p1,0,0,0);}}
}
typedef __attribute__((address_space(3))) const char* lds_cptr;
typedef short v4i16_t __attribute__((ext_vector_type(4)));
__device__ __forceinline__ void kload8(bf16x8*kf,lds_cptr kp){
  kf[0]=*(const __attribute__((address_space(3))) bf16x8*)(kp);      kf[1]=*(const __attribute__((address_space(3))) bf16x8*)(kp+512);
  kf[2]=*(const __attribute__((address_space(3))) bf16x8*)(kp+2048); kf[3]=*(const __attribute__((address_space(3))) bf16x8*)(kp+2560);
  kf[4]=*(const __attribute__((address_space(3))) bf16x8*)(kp+4096); kf[5]=*(const __attribute__((address_space(3))) bf16x8*)(kp+4608);
  kf[6]=*(const __attribute__((address_space(3))) bf16x8*)(kp+6144); kf[7]=*(const __attribute__((address_space(3))) bf16x8*)(kp+6656);
}
__device__ __forceinline__ void kload2(bf16x8*kf,lds_cptr kp,int j){ kf[2*j]=*(const __attribute__((address_space(3))) bf16x8*)(kp+j*2048); kf[2*j+1]=*(const __attribute__((address_space(3))) bf16x8*)(kp+j*2048+512); }
__device__ __forceinline__ s16x4 vtr(lds_cptr p){ return __builtin_bit_cast(s16x4,__builtin_amdgcn_ds_read_tr16_b64_v4i16((__attribute__((address_space(3))) v4i16_t*)p)); }
__device__ __forceinline__ float rowmax(const f32x16&p0,const f32x16&p1){
  float a=max3f(p0[0],p0[1],p1[0]),b=max3f(p0[2],p0[3],p1[1]);a=max3f(a,p1[2],p1[3]);
  #pragma unroll
  for(int r=4;r<16;r+=4){a=max3f(a,p0[r],p0[r+1]);b=max3f(b,p0[r+2],p0[r+3]);a=max3f(a,p1[r],p1[r+1]);b=max3f(b,p1[r+2],p1[r+3]);}
  const float m=max2f(a,b);
  auto rr=__builtin_amdgcn_permlane32_swap(__float_as_uint(m),__float_as_uint(m),false,false);
  return max2f(__uint_as_float(rr[0]),__uint_as_float(rr[1]));
}
__device__ __forceinline__ void pv(f32x16*o,int vb,bf16x8 pa0,bf16x8 pa1,bf16x8 pa2,bf16x8 pa3){
  #pragma unroll
  for(int d0=0;d0<2;++d0){s16x4 lo[4],hi[4];
    #pragma unroll
    for(int ks=0;ks<4;++ks){
      asm volatile("ds_read_b64_tr_b16 %0,%1 offset:%c2":"=&v"(lo[ks]):"v"(vb),"i"(d0*4096+ks*1024):"memory");
      asm volatile("ds_read_b64_tr_b16 %0,%1 offset:%c2":"=&v"(hi[ks]):"v"(vb),"i"(d0*4096+ks*1024+512):"memory");}
    asm volatile("s_waitcnt lgkmcnt(0)":::"memory");SBAR();
    #define PK(k) (bf16x8){lo[k][0],lo[k][1],lo[k][2],lo[k][3],hi[k][0],hi[k][1],hi[k][2],hi[k][3]}
    o[d0]=__builtin_amdgcn_mfma_f32_32x32x16_bf16(pa0,PK(0),o[d0],0,0,0);
    o[d0]=__builtin_amdgcn_mfma_f32_32x32x16_bf16(pa1,PK(1),o[d0],0,0,0);
    o[d0]=__builtin_amdgcn_mfma_f32_32x32x16_bf16(pa2,PK(2),o[d0],0,0,0);
    o[d0]=__builtin_amdgcn_mfma_f32_32x32x16_bf16(pa3,PK(3),o[d0],0,0,0);
    #undef PK
  }
}

#ifndef ATTN_STORE16
#define ATTN_STORE16(p,v) (*(u32x4*)(p)=(v))
#endif
template<int THRL> __device__ __forceinline__ void attn_unit(int b,int h,int qb,const bf16*Q,const bf16*__restrict__ K,const bf16*__restrict__ V,bf16*O,char*shm){
  const int tid=otid_(),lane=tid&63,r32=lane&31,hi=lane>>5; const int wid=__builtin_amdgcn_readfirstlane(tid>>6);
  const long rowbase=(long)b*SEQ; const int q0=qb*QB;
  const bf16*Qw=Q+(rowbase+q0+wid*QBLK)*PITI;
  const bf16*Kh=K+rowbase*PITI,*Vh=V+rowbase*PITI;
  const unsigned lds0=(unsigned)(uintptr_t)shm;
  float*wsf=(float*)(shm+LDS_WS)+wid*64;
  const bf16*ksrc=Kh+(long)lane*PITI+wid*8;
  const bf16*vsrc=Vh+(long)(16*(wid&3)+(lane>>2))*PITI+(wid>>2)*32+(lane&3)*8;
  const unsigned kdst=lds0+LDS_K+wid*1024, vdst=lds0+LDS_V+wid*1024;
  #define DMA_K(t,slot) glds16(ksrc+(long)(t)*KVBLK*PITI,(unsigned)__builtin_amdgcn_readfirstlane(kdst+(slot)))
  #define DMA_V(t,slot) glds16(vsrc+(long)(t)*KVBLK*PITI,(unsigned)__builtin_amdgcn_readfirstlane(vdst+(slot)))
  const int vb0=(int)(lds0+LDS_V)+((lane>>4)&1)*32+(lane&3)*8+(4*hi+((lane&15)>>2))*64;
  const char*Kbase=shm+LDS_K; bf16x8 kf[8];
  const lds_cptr shm3=(lds_cptr)shm; const lds_cptr kp0=shm3+LDS_K+hi*1024+r32*16; const lds_cptr vp0=shm3+LDS_V+((lane>>4)&1)*32+(lane&3)*8+(4*hi+((lane&15)>>2))*64;
  const int NT=(q0+QB)/KVBLK;
  DMA_K(0,0);DMA_V(0,0);DMA_K(1,SLOTB);
  bf16x8 qr[4];
  #pragma unroll
  for(int d0=0;d0<4;++d0)qr[d0]=*reinterpret_cast<const bf16x8*>(&Qw[(long)r32*PITI+d0*16+hi*8]);
  float mhat=0.f,l_reg=0.f;f32x16 o[2];o[0]=f32x16{};o[1]=f32x16{};f32x16 negm=f32x16{};asm volatile("":"+v"(negm));
  const int qrel=wid*QBLK+r32;
  #define CMASK(P0,P1,t) do{int jb_=(t)-(NT-4); if(jb_>=0)cmask(P0,P1,jb_,qrel,hi);}while(0)
  bool resc=false;
  #define START(P0,P1) do{ const float rm=rowmax(P0,P1); resc=false; \
    { const float dl=rm; mhat=fadd_s(mhat,dl); \
      _Pragma("unroll") for(int r=0;r<16;++r){P0[r]=fsub_s(P0[r],dl);P1[r]=fsub_s(P1[r],dl);} \
      _Pragma("unroll") for(int r=0;r<16;++r)negm[r]=-mhat; asm volatile("":"+v"(negm)); } \
    _Pragma("unroll") for(int r=0;r<16;++r)P0[r]=__builtin_amdgcn_exp2f(P0[r]); }while(0)
  #define RESC() do{ if(resc){ asm volatile("s_waitcnt lgkmcnt(0)":::"memory"); \
      _Pragma("unroll") for(int d_=0;d_<2;++d_) _Pragma("unroll") for(int r=0;r<16;++r)o[d_][r]*=wsf[crow(r,hi)]; } }while(0)
  f32x16 pA0,pA1,pB0,pB1;
  int sl_prev=0,sl_cur=0,sl_next=SLOTB;
  #define ROT() do{sl_prev=sl_cur;sl_cur=sl_next;sl_next=(sl_next==(NSLOT-1)*SLOTB)?0:sl_next+SLOTB;}while(0)
  DMA_K(2,2*SLOTB);
  WAIT_BAR(3);
  qkt(pA0,pA1,Kbase,qr,negm,r32,hi);asm volatile("s_nop 15\n\ts_nop 7":"+v"(pA0),"+v"(pA1));CMASK(pA0,pA1,0);
  START(pA0,pA1);
  _Pragma("unroll") for(int r=0;r<16;++r)pA1[r]=__builtin_amdgcn_exp2f(pA1[r]);
  WAIT_BAR(0);
  DMA_K(3,0);DMA_V(1,SLOTB);
  ROT();
  kload8(kf,kp0+sl_cur);
  WAIT_BAR(2);
  s16x4 vlo[8],vhi[8]; u32x4 pw0,pw1,pw2,pw3;
  #define PKW(P,B) cvtpk_s(P[B],P[B+1])
  #define PAF(k) __builtin_bit_cast(bf16x8,pw##k)
  #define VFR(i) (bf16x8){vlo[i][0],vlo[i][1],vlo[i][2],vlo[i][3],vhi[i][0],vhi[i][1],vhi[i][2],vhi[i][3]}
  #define PIN(x) asm volatile("":"+v"(x))
  #define MX3(a,b,c) __builtin_fmaxf(__builtin_fmaxf((a),(b)),(c))
  #define GAPA(MF,A0,A1,A2,A3,W0,W1,PW) do{ MF; sacc+=A0; sacc+=A1; sacc+=A2; sacc+=A3; PIN(sacc); W0; W1; PIN(PW); SBAR(); }while(0)
  #define EX(v) __builtin_amdgcn_exp2f(v)
  #define GAPB(MF,X,B) do{ MF; X[B]=EX(X[B]); X[B+1]=EX(X[B+1]); X[B+2]=EX(X[B+2]); X[B+3]=EX(X[B+3]); PIN(X); SBAR(); }while(0)
  #define VRD(i) do{ vlo[i]=vtr(vp_+(((i)>>2)*4096+((i)&3)*1024)); vhi[i]=vtr(vp_+(((i)>>2)*4096+((i)&3)*1024+512)); }while(0)
  #define KRD(G,j) do{ if(G){ kload2(kf,kp0+sl_next,j); SBAR(); } }while(0)
  #define STEP(C0,C1,P0,P1,t,GK,GV,GL) do{ SBAR(); \
    const lds_cptr vp_=vp0+sl_prev; \
    VRD(0); SBAR(); float sacc=(P0[0]+P0[1]); \
    GAPA(C0=__builtin_amdgcn_mfma_f32_32x32x16_bf16(kf[0],qr[0],negm,0,0,0), P0[2],P0[3],P0[4],P0[5],     pw0[0]=PKW(P0,0), pw0[1]=PKW(P0,2), pw0); \
    VRD(4); SBAR(); GAPA(C1=__builtin_amdgcn_mfma_f32_32x32x16_bf16(kf[1],qr[0],negm,0,0,0), P0[6],P0[7],P0[8],P0[9],     pw0[2]=PKW(P0,4), pw0[3]=PKW(P0,6), pw0); \
    VRD(1); SBAR(); GAPA(C0=__builtin_amdgcn_mfma_f32_32x32x16_bf16(kf[2],qr[1],C0,0,0,0),   P0[10],P0[11],P0[12],P0[13], pw1[0]=PKW(P0,8), pw1[1]=PKW(P0,10), pw1); \
    VRD(5); SBAR(); GAPA(C1=__builtin_amdgcn_mfma_f32_32x32x16_bf16(kf[3],qr[1],C1,0,0,0),   P0[14],P0[15],P1[0],P1[1],   pw1[2]=PKW(P0,12),pw1[3]=PKW(P0,14), pw1); \
    VRD(2); SBAR(); GAPA(C0=__builtin_amdgcn_mfma_f32_32x32x16_bf16(kf[4],qr[2],C0,0,0,0),   P1[2],P1[3],P1[4],P1[5],     pw2[0]=PKW(P1,0), pw2[1]=PKW(P1,2), pw2); \
    VRD(6); SBAR(); GAPA(C1=__builtin_amdgcn_mfma_f32_32x32x16_bf16(kf[5],qr[2],C1,0,0,0),   P1[6],P1[7],P1[8],P1[9],     pw2[2]=PKW(P1,4), pw2[3]=PKW(P1,6), pw2); \
    VRD(3); SBAR(); GAPA(C0=__builtin_amdgcn_mfma_f32_32x32x16_bf16(kf[6],qr[3],C0,0,0,0),   P1[10],P1[11],P1[12],P1[13], pw3[0]=PKW(P1,8), pw3[1]=PKW(P1,10), pw3); \
    VRD(7); SBAR(); GAPA(C1=__builtin_amdgcn_mfma_f32_32x32x16_bf16(kf[7],qr[3],C1,0,0,0),   P1[14],P1[15],0.f,0.f,       pw3[2]=PKW(P1,12),pw3[3]=PKW(P1,14), pw3); \
    l_reg+=sacc; \
    if(GK){DMA_K((t)+3,sl_cur);} if(GV){DMA_V((t)+1,sl_next);} \
    CMASK(C0,C1,t); \
    { float a=MX3(C0[0],C0[1],C1[0]),b=MX3(C0[2],C0[3],C1[1]); a=MX3(a,C1[2],C1[3]); \
      _Pragma("unroll") for(int r=4;r<16;r+=4){a=MX3(a,C0[r],C0[r+1]);b=MX3(b,C0[r+2],C0[r+3]);a=MX3(a,C1[r],C1[r+1]);b=MX3(b,C1[r+2],C1[r+3]);} \
      float rm=__builtin_fmaxf(a,b); { auto rr=__builtin_amdgcn_permlane32_swap(__float_as_uint(rm),__float_as_uint(rm),false,false); rm=__builtin_fmaxf(__uint_as_float(rr[0]),__uint_as_float(rr[1])); } \
      resc=false; \
      if(__builtin_expect(__any(rm>(float)THRL),0)){ const float dl=__builtin_fmaxf(rm,0.f); mhat+=dl; \
        _Pragma("unroll") for(int r=0;r<16;++r){C0[r]-=dl;C1[r]-=dl;} \
        _Pragma("unroll") for(int r=0;r<16;++r)negm[r]=-mhat; asm volatile("":"+v"(negm)); \
        const float f=__builtin_amdgcn_exp2f(-dl); l_reg*=f; if(hi==0)wsf[r32]=f; resc=true; } } \
    SBAR(); \
    GAPB(o[0]=__builtin_amdgcn_mfma_f32_32x32x16_bf16(PAF(0),VFR(0),o[0],0,0,0), C0,0); \
    GAPB(o[1]=__builtin_amdgcn_mfma_f32_32x32x16_bf16(PAF(0),VFR(4),o[1],0,0,0), C0,4); \
    KRD(GL,0); GAPB(o[0]=__builtin_amdgcn_mfma_f32_32x32x16_bf16(PAF(1),VFR(1),o[0],0,0,0), C0,8); \
    KRD(GL,1); GAPB(o[1]=__builtin_amdgcn_mfma_f32_32x32x16_bf16(PAF(1),VFR(5),o[1],0,0,0), C0,12); \
    KRD(GL,2); GAPB(o[0]=__builtin_amdgcn_mfma_f32_32x32x16_bf16(PAF(2),VFR(2),o[0],0,0,0), C1,0); \
    KRD(GL,3); GAPB(o[1]=__builtin_amdgcn_mfma_f32_32x32x16_bf16(PAF(2),VFR(6),o[1],0,0,0), C1,4); \
    GAPB(o[0]=__builtin_amdgcn_mfma_f32_32x32x16_bf16(PAF(3),VFR(3),o[0],0,0,0), C1,8); \
    GAPB(o[1]=__builtin_amdgcn_mfma_f32_32x32x16_bf16(PAF(3),VFR(7),o[1],0,0,0), C1,12); \
    }while(0)
  int t=1;
  #undef CMASK
  #define CMASK(P0,P1,t) do{}while(0)
  for(;t+5<NT;t+=2){
    STEP(pB0,pB1,pA0,pA1,t,true,true,true);     WAIT_BAR(2); RESC(); ROT();
    STEP(pA0,pA1,pB0,pB1,t+1,true,true,true);   WAIT_BAR(2); RESC(); ROT();
  }
  #undef CMASK
  #define CMASK(P0,P1,t) do{int jb_=(t)-(NT-4); if(jb_>=0)cmask(P0,P1,jb_,qrel,hi);}while(0)
  #define ENDW(tt) do{ if((tt)+3<NT){WAIT_BAR(2);} else if((tt)+2<NT){WAIT_BAR(1);} else {WAIT_BAR(0);} }while(0)
  for(;t+1<NT;t+=2){
    STEP(pB0,pB1,pA0,pA1,t,(t+3<NT),(t+1<NT),(t+1<NT));       ENDW(t);   RESC(); ROT();
    STEP(pA0,pA1,pB0,pB1,t+1,(t+4<NT),(t+2<NT),(t+2<NT));     ENDW(t+1); RESC(); ROT();
  }
  STEP(pB0,pB1,pA0,pA1,NT-1,false,false,false); RESC();
  { float sacc=pB0[0]+pB0[1]; _Pragma("unroll") for(int r=2;r<16;++r)sacc+=pB0[r]; _Pragma("unroll") for(int r=0;r<16;++r)sacc+=pB1[r]; l_reg+=sacc;
    pw0=(u32x4){PKW(pB0,0),PKW(pB0,2),PKW(pB0,4),PKW(pB0,6)};pw1=(u32x4){PKW(pB0,8),PKW(pB0,10),PKW(pB0,12),PKW(pB0,14)};pw2=(u32x4){PKW(pB1,0),PKW(pB1,2),PKW(pB1,4),PKW(pB1,6)};pw3=(u32x4){PKW(pB1,8),PKW(pB1,10),PKW(pB1,12),PKW(pB1,14)};
    SBAR(); pv(o,vb0+sl_cur,PAF(0),PAF(1),PAF(2),PAF(3)); }
  #undef PKW
  #undef PAF
  #undef VFR
  #undef PIN
  #undef MX3
  #undef GAPA
  #undef GAPB
  #undef EX
  #undef VRD
  #undef KRD
  #undef STEP
  #undef ENDW
  {auto rr=__builtin_amdgcn_permlane32_swap(__float_as_uint(l_reg),__float_as_uint(l_reg),false,false);l_reg=__uint_as_float(rr[0])+__uint_as_float(rr[1]);}
  if(hi==0)wsf[32+r32]=l_reg;asm volatile("s_waitcnt lgkmcnt(0)":::"memory");
  float rli[16];
  #pragma unroll
  for(int r=0;r<16;++r)rli[r]=__builtin_amdgcn_rcpf(wsf[32+crow(r,hi)]);
  bf16*Ow=O+(rowbase+q0+wid*QBLK)*PITO;
  { bf16*stg=(bf16*)(shm+LDS_OST)+wid*2048;
    #pragma unroll
    for(int r=0;r<16;++r){const int orow=crow(r,hi);
      #pragma unroll
      for(int d0=0;d0<2;++d0)stg[orow*64+d0*32+r32]=__float2bfloat16(o[d0][r]*rli[r]);}
    asm volatile("s_waitcnt lgkmcnt(0)":::"memory");
    #pragma unroll
    for(int i=0;i<4;++i){const int row=i*8+(lane>>3),ch=lane&7; const u32x4 v=*(const u32x4*)(stg+row*64+ch*8); ATTN_STORE16(Ow+(long)row*PITO+ch*8,v);} }
  asm volatile("s_waitcnt lgkmcnt(0)\n\ts_barrier":::"memory");
  #undef DMA_K
  #undef DMA_V
  #undef CMASK
  #undef START
  #undef RESC
  #undef ROT
}
constexpr int ATTN_LDS_BYTES=LDS_BYTES;
#undef SBAR
#undef WAIT_BAR
}

namespace cg = cooperative_groups;
typedef unsigned short bf16_t;
typedef float f32x4 __attribute__((ext_vector_type(4)));
typedef float f32x16 __attribute__((ext_vector_type(16)));
typedef unsigned u32x4 __attribute__((ext_vector_type(4)));
typedef unsigned u32x2 __attribute__((ext_vector_type(2)));
typedef short bf16x8 __attribute__((ext_vector_type(8)));
#define LAS3 __attribute__((address_space(3)))

constexpr int T_ = 32768, DM_ = 1024, SEQ_ = 4096, DFF_ = 2816;
constexpr int NTHR = 512;
constexpr int LDS_BYTES = 147456;
constexpr size_t MiB_ = 1u << 20;
constexpr size_t WS_MOD = 0, WS_COS = 1 * MiB_, WS_SIN = 2 * MiB_, WS_BAR = 3 * MiB_;
constexpr size_t WS_WIN = 4 * MiB_, WS_WOUT = 11 * MiB_, WS_FIN = 13 * MiB_, WS_FOUT = 24 * MiB_;
constexpr size_t WS_A = 32 * MiB_, WS_X2 = 96 * MiB_, WS_ST = 160 * MiB_, WS_TOT = 224 * MiB_, WS_R1 = 226 * MiB_, WS_END = 450 * MiB_;
constexpr size_t WS_HP = WS_ST, WS_HU = WS_ST + 12 * MiB_, WS_HA = WS_ST + 24 * MiB_;
constexpr float LOG2E_ = 1.4426950408889634f;
constexpr float QSCALE_ = 0.125f * 1.4426950408889634f;

struct Params {
    const float* x; const float* c; const int* positions; const float* mod_w; const float* mod_b; const float* norm_mix_w; const float* norm_ffn_w;
    const float* ev_w_in; const float* gla_gate_w; const float* gla_gate_b; const float* gla_norm_w; const float* swa_sinks; const float* ev_w_out;
    const float* od_w_in; const float* diff_lambda; const float* diff_norm_w; const float* hgrn_lb_logits; const float* hgrn_norm_w; const float* od_w_out;
    const float* ffn_w_in; const float* ffn_conv_w; const float* ffn_conv_b; const float* ffn_w_out; const float* final_norm_w;
    float* out; unsigned char* ws; unsigned long long pad[6];
};

__device__ __forceinline__ unsigned pk2(float lo, float hi) {
    typedef float f32x2_t __attribute__((ext_vector_type(2))); typedef __bf16 bf16x2_t __attribute__((ext_vector_type(2)));
    f32x2_t v = {lo, hi}; bf16x2_t b = __builtin_convertvector(v, bf16x2_t); return __builtin_bit_cast(unsigned, b);
}
__device__ __forceinline__ float bflo(unsigned u) { return __uint_as_float(u << 16); }
__device__ __forceinline__ float bfhi(unsigned u) { return __uint_as_float(u & 0xffff0000u); }
__device__ __forceinline__ float sigmoidf_(float x) { return 1.f / (1.f + __expf(-x)); }
__device__ __forceinline__ float siluf_(float x) { return x / (1.f + __expf(-x)); }
__device__ __forceinline__ float wave_sum(float v) {
#pragma unroll
    for (int o = 1; o < 64; o <<= 1) v += __shfl_xor(v, o);
    return v;
}
__device__ __forceinline__ int crow_(int r, int hi) { return (r & 3) + 8 * (r >> 2) + 4 * hi; }

namespace pg8 {
struct EpiProj {
    static constexpr bool PERM = true, AFTER_DRAIN = false;
    bf16_t* O; int ldc; unsigned ropemask; unsigned scalemask; float scale; const float* cs; const float* sn;
    __device__ __forceinline__ void operator()(const f32x4 (&acc)[2][2][4][2], const Unit& u, int wr, int wc, int fr, int fq) const {
        const int row0 = u.pm * BM + wr * 64 + fr; const int col0 = u.pn * BM + wc * 32 + 8 * fq;
#pragma unroll
        for (int bj = 0; bj < 2; ++bj) {
            const int grp = u.pn * 2 + bj;
            const bool rope = ((ropemask >> grp) & 1u) && ((wc & 1) == 0);
            const float sc = ((scalemask >> grp) & 1u) ? scale : 1.f;
#pragma unroll
            for (int ai = 0; ai < 2; ++ai)
#pragma unroll
                for (int m = 0; m < 4; ++m) {
                    const int row = row0 + ai * HALF + m * 16;
                    f32x4 v0 = acc[ai][bj][m][0], v1 = acc[ai][bj][m][1];
                    if (rope) {
                        const f32x4 c0 = *(const f32x4*)(cs + (size_t)row * 8), c1 = *(const f32x4*)(cs + (size_t)row * 8 + 4);
                        const f32x4 s0 = *(const f32x4*)(sn + (size_t)row * 8), s1 = *(const f32x4*)(sn + (size_t)row * 8 + 4);
                        const float sg = (fq == 0) ? -1.f : 1.f;
#pragma unroll
                        for (int e = 0; e < 4; ++e) {
                            const float p0 = __shfl_xor(v0[e], 16), p1 = __shfl_xor(v1[e], 16);
                            const float r0 = v0[e] * c0[e] + sg * p0 * s0[e], r1 = v1[e] * c1[e] + sg * p1 * s1[e];
                            if (fq < 2) { v0[e] = r0; v1[e] = r1; }
                        }
                    }
                    v0 = v0 * sc; v1 = v1 * sc;
                    u32x4 w; w.x = pk2(v0[0], v0[1]); w.y = pk2(v0[2], v0[3]); w.z = pk2(v1[0], v1[1]); w.w = pk2(v1[2], v1[3]);
                    *(u32x4*)(O + (size_t)row * ldc + col0 + bj * HALF) = w;
                    asm volatile("" ::: "memory");
                }
        }
    }
};
struct EpiRes {
    static constexpr bool PERM = false, AFTER_DRAIN = false;
    const float* xin; float* xout; const float* gate;
    __device__ __forceinline__ void operator()(const f32x4 (&acc)[2][2][4][2], const Unit& u, int wr, int wc, int fr, int fq) const {
        const int col0 = u.pn * BM + wc * 32 + 4 * fq;
#pragma unroll
        for (int ai = 0; ai < 2; ++ai)
#pragma unroll
            for (int m = 0; m < 4; ++m) {
                const int row = u.pm * BM + ai * HALF + wr * 64 + m * 16 + fr;
                const float* g = gate + (size_t)(row >> 12) * 6144;
                const size_t off = (size_t)row * 1024 + col0;
#pragma unroll
                for (int bj = 0; bj < 2; ++bj)
#pragma unroll
                    for (int n = 0; n < 2; ++n) {
                        const int cc = bj * HALF + n * 16;
                        const f32x4 g4 = *(const f32x4*)(g + col0 + cc);
                        const f32x4 x4 = *(const f32x4*)(xin + off + cc);
                        *(f32x4*)(xout + off + cc) = x4 + g4 * acc[ai][bj][m][n];
                    }
                asm volatile("" ::: "memory");
            }
    }
};
struct EpiFfn {
    static constexpr bool PERM = true, AFTER_DRAIN = false;
    bf16_t* G; float* HP; float* HU; float* HA; const float* cw; const float* cb;
    __device__ __forceinline__ void operator()(const f32x4 (&acc)[2][2][4][2], const Unit& u, int wr, int wc, int fr, int fq) const {
        const int ch0 = u.pn * 128 + wc * 32 + 8 * fq;
        f32x4 w0[2], w1[2], w2[2], bb[2];
#pragma unroll
        for (int n = 0; n < 2; ++n) { w0[n] = *(const f32x4*)(cw + ch0 + 4 * n); w1[n] = *(const f32x4*)(cw + DFF_ + ch0 + 4 * n); w2[n] = *(const f32x4*)(cw + 2 * DFF_ + ch0 + 4 * n); bb[n] = *(const f32x4*)(cb + ch0 + 4 * n); }
        const int lane = fr + 16 * fq;
        const int src1 = (lane & ~15) | ((fr + 15) & 15), src2 = (lane & ~15) | ((fr + 14) & 15);
#pragma unroll
        for (int ai = 0; ai < 2; ++ai) {
            const int seg = u.pm * 4 + ai * 2 + wr;
#pragma unroll
            for (int m = 0; m < 4; ++m) {
                const int row = u.pm * BM + ai * HALF + wr * 64 + m * 16 + fr;
                f32x4 val[2];
#pragma unroll
                for (int n = 0; n < 2; ++n) {
                    const f32x4 a = acc[ai][0][m][n];
                    f32x4 ap = (f32x4){0.f, 0.f, 0.f, 0.f};
                    if (m > 0) ap = acc[ai][0][m > 0 ? m - 1 : 0][n];
#pragma unroll
                    for (int e = 0; e < 4; ++e) {
                        const float t1 = (fr == 15) ? ap[e] : a[e];
                        const float t2 = (fr >= 14) ? ap[e] : a[e];
                        const float p1 = __shfl(t1, src1), p2 = __shfl(t2, src2);
                        val[n][e] = w2[n][e] * a[e] + w1[n][e] * p1 + w0[n][e] * p2 + bb[n][e];
                    }
                }
                const f32x4 u0 = acc[ai][1][m][0], u1 = acc[ai][1][m][1];
                f32x4 g0, g1;
#pragma unroll
                for (int e = 0; e < 4; ++e) { g0[e] = siluf_(val[0][e]) * u0[e]; g1[e] = siluf_(val[1][e]) * u1[e]; }
                u32x4 w; w.x = pk2(g0[0], g0[1]); w.y = pk2(g0[2], g0[3]); w.z = pk2(g1[0], g1[1]); w.w = pk2(g1[2], g1[3]);
                *(u32x4*)(G + (size_t)row * DFF_ + ch0) = w;
                if (m == 0 && fr < 2) {
                    const size_t ho = (size_t)(seg * 2 + fr) * DFF_ + ch0;
                    *(f32x4*)(HP + ho) = val[0]; *(f32x4*)(HP + ho + 4) = val[1];
                    *(f32x4*)(HU + ho) = u0; *(f32x4*)(HU + ho + 4) = u1;
                }
                if (m == 3 && fr >= 14) {
                    const size_t ho = (size_t)(seg * 2 + (fr - 14)) * DFF_ + ch0;
                    *(f32x4*)(HA + ho) = acc[ai][0][3][0]; *(f32x4*)(HA + ho + 4) = acc[ai][0][3][1];
                }
                asm volatile("" ::: "memory");
            }
        }
    }
};
}

struct Ctx { Params p; unsigned char* lds; int tid, lane, wave, gw, ngw; };

__device__ __forceinline__ void phase_prologue(const Ctx& C) {
    const Params& p = C.p;
    float* cact = (float*)C.lds;
    float* red = (float*)(C.lds + 32768);
    float* mod = (float*)(p.ws + WS_MOD);
    const int tid = C.tid;
    for (int i = tid; i < 8192; i += NTHR) { const float c = p.c[i]; cact[i] = c / (1.f + __expf(-c)); }
    __syncthreads();
    const int col = tid & 63, kp = tid >> 6;
    for (int g = blockIdx.x; g < 384; g += gridDim.x) {
        const int l = g / 96, j = (g % 96) * 64 + col;
        const float* w = p.mod_w + (size_t)l * 1024 * 6144 + (size_t)(kp * 128) * 6144 + j;
        float a0 = 0.f, a1 = 0.f, a2 = 0.f, a3 = 0.f, a4 = 0.f, a5 = 0.f, a6 = 0.f, a7 = 0.f;
        const float* ca = cact + kp * 128;
#pragma unroll 8
        for (int k = 0; k < 128; ++k) {
            const float wv = w[(size_t)k * 6144];
            a0 += ca[k] * wv; a1 += ca[1024 + k] * wv; a2 += ca[2048 + k] * wv; a3 += ca[3072 + k] * wv;
            a4 += ca[4096 + k] * wv; a5 += ca[5120 + k] * wv; a6 += ca[6144 + k] * wv; a7 += ca[7168 + k] * wv;
        }
        float* r = red + (kp * 8) * 64 + col;
        r[0] = a0; r[64] = a1; r[128] = a2; r[192] = a3; r[256] = a4; r[320] = a5; r[384] = a6; r[448] = a7;
        __syncthreads();
        { const int b = tid >> 6; float s = 0.f;
#pragma unroll
          for (int kk = 0; kk < 8; ++kk) s += red[(kk * 8 + b) * 64 + col];
          mod[(size_t)(l * 8 + b) * 6144 + j] = s + p.mod_b[l * 6144 + j]; }
        __syncthreads();
    }
    float* cs = (float*)(p.ws + WS_COS); float* sn = (float*)(p.ws + WS_SIN);
    const float invf[8] = {1.0f, 0.1939227432012558f, 0.03760603070259094f, 0.007292664609849453f, 0.0014142135623842478f, 0.00027424818836152554f, 5.3182957344688475e-05f, 1.0313385246263351e-05f};
    for (int r = blockIdx.x * NTHR + tid; r < T_; r += gridDim.x * NTHR) {
        const float pos = (float)p.positions[r];
        f32x4 c4[2], s4[2];
#pragma unroll
        for (int i = 0; i < 8; ++i) {
            const float ang = pos * invf[i];
            const double xr = (double)ang * 0.15915494309189535;
            const float f = (float)(xr - rint(xr));
            c4[i >> 2][i & 3] = __builtin_amdgcn_cosf(f); s4[i >> 2][i & 3] = __builtin_amdgcn_sinf(f);
        }
        *(f32x4*)(cs + (size_t)r * 8) = c4[0]; *(f32x4*)(cs + (size_t)r * 8 + 4) = c4[1];
        *(f32x4*)(sn + (size_t)r * 8) = s4[0]; *(f32x4*)(sn + (size_t)r * 8 + 4) = s4[1];
    }
}

__device__ __forceinline__ void tr_item(const float* W, int Nsrc, int srccol0, bf16_t* WT, int K, int dstrow0, int k0, float* scr, int lane) {
#pragma unroll 8
    for (int i = 0; i < 32; ++i) { const int kk = 2 * i + (lane >> 5); scr[kk * 33 + (lane & 31)] = W[(size_t)(k0 + kk) * Nsrc + srccol0 + (lane & 31)]; }
    asm volatile("s_waitcnt lgkmcnt(0)" ::: "memory");
    const int c = lane & 7;
#pragma unroll
    for (int j = 0; j < 4; ++j) { const int n = (lane >> 3) + 8 * j; const float* s = scr + (8 * c) * 33 + n;
        u32x4 o; o.x = pk2(s[0 * 33], s[1 * 33]); o.y = pk2(s[2 * 33], s[3 * 33]); o.z = pk2(s[4 * 33], s[5 * 33]); o.w = pk2(s[6 * 33], s[7 * 33]);
        *(u32x4*)(WT + (size_t)(dstrow0 + n) * K + k0 + 8 * c) = o; }
    asm volatile("s_waitcnt lgkmcnt(0)" ::: "memory");
}
__device__ __forceinline__ void phase_convert(const Ctx& C, int l) {
    const Params& p = C.p; const int j = l >> 1; const bool even = !(l & 1);
    float* scr = (float*)(C.lds + C.wave * 16384);
    bf16_t* WIN = (bf16_t*)(p.ws + WS_WIN); bf16_t* WOUT = (bf16_t*)(p.ws + WS_WOUT); bf16_t* FIN = (bf16_t*)(p.ws + WS_FIN); bf16_t* FOUT = (bf16_t*)(p.ws + WS_FOUT);
    const int nA = even ? 80 : 112;
    const int IA = 16 * nA, IB = 16 * 32, IC = 16 * 176, ID = 44 * 32;
    const float* win = even ? p.ev_w_in + (size_t)j * 1024 * 2320 : p.od_w_in + (size_t)j * 1024 * 3584;
    const float* wout = even ? p.ev_w_out + (size_t)j * 1024 * 1024 : p.od_w_out + (size_t)j * 1024 * 1024;
    const float* fin = p.ffn_w_in + (size_t)l * 1024 * 5632; const float* fout = p.ffn_w_out + (size_t)l * 2816 * 1024;
    for (int it = C.gw; it < IA + IB + IC + ID; it += C.ngw) {
        int r = it;
        if (r < IA) { const int kb = r / nA, nb = r % nA, n0 = nb * 32; int sc = n0;
            if (even) { if (n0 >= 512 && n0 < 768) continue; if (n0 >= 1792) sc = n0 - 240; else if (n0 >= 768) sc = n0 - 256; }
            tr_item(win, even ? 2320 : 3584, sc, WIN, 1024, n0, kb * 64, scr, C.lane); continue; }
        r -= IA;
        if (r < IB) { const int kb = r / 32, nb = r % 32; tr_item(wout, 1024, nb * 32, WOUT, 1024, nb * 32, kb * 64, scr, C.lane); continue; }
        r -= IB;
        if (r < IC) { const int kb = r / 176, nb = r % 176, n0 = nb * 32; const int pn = n0 >> 8, jj = n0 & 255;
            const int sc = (jj < 128) ? pn * 128 + jj : 2816 + pn * 128 + (jj - 128);
            tr_item(fin, 5632, sc, FIN, 1024, n0, kb * 64, scr, C.lane); continue; }
        r -= IC;
        { const int kb = r / 32, nb = r % 32; tr_item(fout, 1024, nb * 32, FOUT, 2816, nb * 32, kb * 64, scr, C.lane); }
    }
    if (even) {
        const float* gw = p.gla_gate_w + (size_t)j * 16 * 256;
        for (int u = blockIdx.x * NTHR + C.tid; u < 256 * 128; u += gridDim.x * NTHR) {
            const int k8 = u & 127, n = u >> 7;
            float g[16];
#pragma unroll
            for (int r = 0; r < 16; ++r) g[r] = gw[r * 256 + n];
            float o[8];
#pragma unroll
            for (int e = 0; e < 8; ++e) {
                const float* wr = win + (size_t)(k8 * 8 + e) * 2320 + 1536;
                const f32x4 a0 = *(const f32x4*)wr, a1 = *(const f32x4*)(wr + 4), a2 = *(const f32x4*)(wr + 8), a3 = *(const f32x4*)(wr + 12);
                o[e] = a0[0] * g[0] + a0[1] * g[1] + a0[2] * g[2] + a0[3] * g[3] + a1[0] * g[4] + a1[1] * g[5] + a1[2] * g[6] + a1[3] * g[7]
                     + a2[0] * g[8] + a2[1] * g[9] + a2[2] * g[10] + a2[3] * g[11] + a3[0] * g[12] + a3[1] * g[13] + a3[2] * g[14] + a3[3] * g[15];
            }
            u32x4 w; w.x = pk2(o[0], o[1]); w.y = pk2(o[2], o[3]); w.z = pk2(o[4], o[5]); w.w = pk2(o[6], o[7]);
            *(u32x4*)(WIN + (size_t)(512 + n) * 1024 + k8 * 8) = w;
        }
    }
}

__device__ __forceinline__ void phase_norm(const Ctx& C, const float* xin, const float* w, const float* modl, int shoff, int scoff, bf16_t* out) {
    for (int row = C.gw; row < T_; row += C.ngw) {
        const f32x4* xr = (const f32x4*)(xin + (size_t)row * 1024) + C.lane;
        f32x4 v[4]; float ss = 0.f;
#pragma unroll
        for (int j = 0; j < 4; ++j) { v[j] = xr[64 * j]; ss += (v[j].x * v[j].x + v[j].y * v[j].y) + (v[j].z * v[j].z + v[j].w * v[j].w); }
        const float rs = rsqrtf(wave_sum(ss) * (1.f / 1024.f) + 1e-6f);
        const float* mb = modl + (size_t)(row >> 12) * 6144;
        u32x2* o8 = (u32x2*)(out + (size_t)row * 1024) + C.lane;
#pragma unroll
        for (int j = 0; j < 4; ++j) {
            const int col = 4 * C.lane + 256 * j;
            const f32x4 w4 = *(const f32x4*)(w + col), sc = *(const f32x4*)(mb + scoff + col), sh = *(const f32x4*)(mb + shoff + col);
            const f32x4 y = (v[j] * rs) * w4 * (sc + 1.f) + sh;
            u32x2 q; q.x = pk2(y.x, y.y); q.y = pk2(y.z, y.w); o8[64 * j] = q;
        }
    }
}
__device__ __forceinline__ void phase_final_norm(const Ctx& C, float* x, const float* w) {
    for (int row = C.gw; row < T_; row += C.ngw) {
        f32x4* xr = (f32x4*)(x + (size_t)row * 1024) + C.lane;
        f32x4 v[4]; float ss = 0.f;
#pragma unroll
        for (int j = 0; j < 4; ++j) { v[j] = xr[64 * j]; ss += (v[j].x * v[j].x + v[j].y * v[j].y) + (v[j].z * v[j].z + v[j].w * v[j].w); }
        const float rs = rsqrtf(wave_sum(ss) * (1.f / 1024.f) + 1e-6f);
#pragma unroll
        for (int j = 0; j < 4; ++j) { const f32x4 w4 = *(const f32x4*)(w + 4 * C.lane + 256 * j); xr[64 * j] = (v[j] * rs) * w4; }
    }
}

__device__ __forceinline__ void phase_diff_combine(const Ctx& C, int l) {
    const Params& p = C.p; const int j = l >> 1;
    const float lam_init = 0.8f - 0.6f * expf(-0.3f * (float)l);
    const float* lv = p.diff_lambda + j * 256;
    const float s1 = wave_sum(lv[C.lane] * lv[64 + C.lane]), s2 = wave_sum(lv[128 + C.lane] * lv[192 + C.lane]);
    const float lam = expf(s1) - expf(s2) + lam_init;
    const bf16_t* X2 = (const bf16_t*)(p.ws + WS_X2); bf16_t* A = (bf16_t*)(p.ws + WS_A);
    const int head = C.lane >> 4, d0 = (C.lane & 15) * 8;
    const float* nw = p.diff_norm_w + j * 128 + d0;
    const f32x4 n0 = *(const f32x4*)nw, n1 = *(const f32x4*)(nw + 4);
    const float og = 1.f - lam_init;
    for (int row = C.gw; row < T_; row += C.ngw) {
        const bf16_t* src = X2 + (size_t)row * 1024 + head * 256 + d0;
        const u32x4 a = *(const u32x4*)src, b = *(const u32x4*)(src + 128);
        float od[8];
        od[0] = bflo(a.x) - lam * bflo(b.x); od[1] = bfhi(a.x) - lam * bfhi(b.x); od[2] = bflo(a.y) - lam * bflo(b.y); od[3] = bfhi(a.y) - lam * bfhi(b.y);
        od[4] = bflo(a.z) - lam * bflo(b.z); od[5] = bfhi(a.z) - lam * bfhi(b.z); od[6] = bflo(a.w) - lam * bflo(b.w); od[7] = bfhi(a.w) - lam * bfhi(b.w);
        float ss = 0.f;
#pragma unroll
        for (int e = 0; e < 8; ++e) ss += od[e] * od[e];
        ss += __shfl_xor(ss, 1); ss += __shfl_xor(ss, 2); ss += __shfl_xor(ss, 4); ss += __shfl_xor(ss, 8);
        const float rs = rsqrtf(ss * (1.f / 128.f) + 1e-6f) * og;
        u32x4 w; w.x = pk2(od[0] * rs * n0[0], od[1] * rs * n0[1]); w.y = pk2(od[2] * rs * n0[2], od[3] * rs * n0[3]);
        w.z = pk2(od[4] * rs * n1[0], od[5] * rs * n1[1]); w.w = pk2(od[6] * rs * n1[2], od[7] * rs * n1[3]);
        *(u32x4*)(A + (size_t)row * 1024 + head * 128 + d0) = w;
    }
}

__device__ __forceinline__ void phase_ffn_fixup(const Ctx& C, int l) {
    const Params& p = C.p;
    const float* HP = (const float*)(p.ws + WS_HP); const float* HU = (const float*)(p.ws + WS_HU); const float* HA = (const float*)(p.ws + WS_HA);
    bf16_t* G = (bf16_t*)(p.ws + WS_R1);
    const float* cw = p.ffn_conv_w + (size_t)l * 3 * DFF_;
    for (int u = blockIdx.x * NTHR + C.tid; u < 512 * 2 * 704; u += gridDim.x * NTHR) {
        const int c4 = u % 704, sj = u / 704, jj = sj & 1, seg = sj >> 1, ch = c4 * 4;
        const size_t ho = (size_t)sj * DFF_ + ch;
        f32x4 val = *(const f32x4*)(HP + ho); const f32x4 uu = *(const f32x4*)(HU + ho);
        if ((seg & 63) != 0) {
            const f32x4 am1 = *(const f32x4*)(HA + (size_t)((seg - 1) * 2 + 1) * DFF_ + ch), am2 = *(const f32x4*)(HA + (size_t)((seg - 1) * 2) * DFF_ + ch);
            const f32x4 w0 = *(const f32x4*)(cw + ch), w1 = *(const f32x4*)(cw + DFF_ + ch);
            if (jj == 0) val = val + w1 * am1 + w0 * am2; else val = val + w0 * am1;
        }
        u32x2 q; q.x = pk2(siluf_(val.x) * uu.x, siluf_(val.y) * uu.y); q.y = pk2(siluf_(val.z) * uu.z, siluf_(val.w) * uu.w);
        *(u32x2*)(G + (size_t)(seg * 64 + jj) * DFF_ + ch) = q;
    }
}

__device__ __forceinline__ void phase_swa(const Ctx& C, int l) {
    const Params& p = C.p;
    const bf16_t* proj = (const bf16_t*)(p.ws + WS_R1); bf16_t* A = (bf16_t*)(p.ws + WS_A);
    bf16_t* Ks = (bf16_t*)C.lds;
    bf16_t* Vt = (bf16_t*)(C.lds + 27648);
    const int tid = C.tid, lane = C.lane, wid = C.wave, r32 = lane & 31, hi = lane >> 5;
    const float* sinks = p.swa_sinks + (l >> 1) * 8;
    for (int u = blockIdx.x; u < 1024; u += gridDim.x) {
        const int b = u >> 7, kvh = (u >> 6) & 1, qb = u & 63, q0 = qb * 64; const size_t rowbase = (size_t)b * SEQ_;
        for (int c = tid; c < 1536; c += NTHR) {
            const int kk = c >> 3, ch = c & 7, pl = q0 - 128 + kk;
            u32x4 kv = (u32x4){0u, 0u, 0u, 0u}, vv = (u32x4){0u, 0u, 0u, 0u};
            if (pl >= 0) { const bf16_t* src = proj + (rowbase + pl) * 2560 + 2304 + kvh * 64 + ch * 8; kv = *(const u32x4*)src; vv = *(const u32x4*)(src + 128); }
            *(u32x4*)(Ks + kk * 72 + ch * 8) = kv;
            bf16_t* vd = Vt + (ch * 8) * 200 + kk;
            vd[0] = (bf16_t)(vv.x & 0xffffu); vd[200] = (bf16_t)(vv.x >> 16); vd[400] = (bf16_t)(vv.y & 0xffffu); vd[600] = (bf16_t)(vv.y >> 16);
            vd[800] = (bf16_t)(vv.z & 0xffffu); vd[1000] = (bf16_t)(vv.z >> 16); vd[1200] = (bf16_t)(vv.w & 0xffffu); vd[1400] = (bf16_t)(vv.w >> 16);
        }
        __syncthreads();
        const int g = wid >> 1, qh = kvh * 4 + g, qhalf = wid & 1, pq = q0 + 32 * qhalf + r32;
        const bf16_t* qsrc = proj + (rowbase + pq) * 2560 + 1792 + qh * 64;
        bf16x8 qr[4];
#pragma unroll
        for (int d0 = 0; d0 < 4; ++d0) qr[d0] = *(const bf16x8*)(qsrc + d0 * 16 + hi * 8);
        f32x16 s[5];
#pragma unroll
        for (int t = 0; t < 5; ++t) {
            f32x16 a = {};
#pragma unroll
            for (int d0 = 0; d0 < 4; ++d0) {
                const bf16x8 kf = *(const bf16x8*)(Ks + (32 * (qhalf + t) + r32) * 72 + d0 * 16 + hi * 8);
                a = __builtin_amdgcn_mfma_f32_32x32x16_bf16(kf, qr[d0], a, 0, 0, 0);
            }
            s[t] = a;
        }
        const float sink2 = sinks[qh] * LOG2E_;
        float mx = sink2;
#pragma unroll
        for (int t = 0; t < 5; ++t)
#pragma unroll
            for (int r = 0; r < 16; ++r) {
                const int pk = q0 - 128 + 32 * (qhalf + t) + crow_(r, hi);
                const bool valid = (pk >= 0) && (pk <= pq) && (pq - pk < 128);
                const float v = valid ? s[t][r] : -INFINITY; s[t][r] = v; mx = fmaxf(mx, v);
            }
        mx = fmaxf(mx, __shfl_xor(mx, 32));
        float sum = 0.f;
#pragma unroll
        for (int t = 0; t < 5; ++t)
#pragma unroll
            for (int r = 0; r < 16; ++r) { const float e = __builtin_amdgcn_exp2f(s[t][r] - mx); s[t][r] = e; sum += e; }
        sum += __shfl_xor(sum, 32);
        sum += __builtin_amdgcn_exp2f(sink2 - mx);
        const float inv = 1.f / sum;
        f32x16 o[2]; o[0] = f32x16{}; o[1] = f32x16{};
#pragma unroll
        for (int t = 0; t < 5; ++t)
#pragma unroll
            for (int ss = 0; ss < 2; ++ss) {
                u32x4 pw; pw.x = pk2(s[t][8 * ss + 0], s[t][8 * ss + 1]); pw.y = pk2(s[t][8 * ss + 2], s[t][8 * ss + 3]); pw.z = pk2(s[t][8 * ss + 4], s[t][8 * ss + 5]); pw.w = pk2(s[t][8 * ss + 6], s[t][8 * ss + 7]);
                const bf16x8 pf = __builtin_bit_cast(bf16x8, pw);
#pragma unroll
                for (int dt = 0; dt < 2; ++dt) {
                    const bf16_t* vp = Vt + (32 * dt + r32) * 200 + 32 * (qhalf + t) + 16 * ss + 4 * hi;
                    const u32x2 lo = *(const u32x2*)vp, h2 = *(const u32x2*)(vp + 8);
                    u32x4 vw; vw.x = lo.x; vw.y = lo.y; vw.z = h2.x; vw.w = h2.y;
                    o[dt] = __builtin_amdgcn_mfma_f32_32x32x16_bf16(__builtin_bit_cast(bf16x8, vw), pf, o[dt], 0, 0, 0);
                }
            }
        bf16_t* orow = A + (rowbase + pq) * 1024 + 512 + qh * 64;
#pragma unroll
        for (int dt = 0; dt < 2; ++dt)
#pragma unroll
            for (int g4 = 0; g4 < 4; ++g4) {
                u32x2 q; q.x = pk2(o[dt][4 * g4] * inv, o[dt][4 * g4 + 1] * inv); q.y = pk2(o[dt][4 * g4 + 2] * inv, o[dt][4 * g4 + 3] * inv);
                *(u32x2*)(orow + 32 * dt + 8 * g4 + 4 * hi) = q;
            }
        __syncthreads();
    }
}

template <int MODE> struct LaCfg {
    static constexpr int DK = MODE ? 128 : 64, LQ = DK + 8, LG = DK + 4, PITCH = MODE ? 3584 : 2560, NG = DK / 8;
    static constexpr int QCOL = MODE ? 1536 : 0, KCOL = MODE ? 0 : 256, ZCOL = MODE ? 2048 : 512, VCOL = MODE ? 2560 : 768, GCOL = MODE ? 3072 : 1280, OCOL = MODE ? 512 : 0;
    static constexpr int O_QB = 0, O_KB = O_QB + 64 * LQ * 2, O_GF = O_KB + 64 * LQ * 2, O_VT = O_GF + 64 * LG * 4, O_SC = O_VT + 128 * 72 * 2, O_QE = O_SC + 64 * 72 * 2,
                         O_KT = O_QE + 64 * LQ * 2  , O_SEG = O_KT + DK * 72 * 2, O_RED = O_SEG + 8 * 128 * 4, O_END = O_RED + 8 * 64 * 4;
    static_assert(O_END <= LDS_BYTES, "LA LDS map");
};
__device__ __forceinline__ void unpack8(const u32x4 w, float (&f)[8]) { f[0] = bflo(w.x); f[1] = bfhi(w.x); f[2] = bflo(w.y); f[3] = bfhi(w.y); f[4] = bflo(w.z); f[5] = bfhi(w.z); f[6] = bflo(w.w); f[7] = bfhi(w.w); }
__device__ __forceinline__ u32x4 pack8(const float (&f)[8]) { u32x4 w; w.x = pk2(f[0], f[1]); w.y = pk2(f[2], f[3]); w.z = pk2(f[4], f[5]); w.w = pk2(f[6], f[7]); return w; }
__device__ __forceinline__ void ld8f(const float* p, float (&f)[8]) { const f32x4 a = *(const f32x4*)p, b = *(const f32x4*)(p + 4); f[0] = a[0]; f[1] = a[1]; f[2] = a[2]; f[3] = a[3]; f[4] = b[0]; f[5] = b[1]; f[6] = b[2]; f[7] = b[3]; }

template <int MODE, bool NEEDQ> __device__ __forceinline__ void la_load(const Ctx& C, int l, int b, int h, int c, bf16_t* Qb, bf16_t* Kb, float* Gf, bf16_t* Vt) {
    typedef LaCfg<MODE> Cf; const Params& p = C.p; const int j = l >> 1;
    const bf16_t* proj = (const bf16_t*)(p.ws + WS_R1);
    const size_t row0 = (size_t)b * SEQ_ + (size_t)c * 64;
    constexpr int NG = Cf::NG;
    for (int u = C.tid; u < 64 * NG; u += NTHR) {
        const int r = u / NG, kk = (u % NG) * 8;
        const bf16_t* rp = proj + (row0 + r) * Cf::PITCH + h * Cf::DK + kk;
        float z[8], kv[8], lg[8];
        unpack8(*(const u32x4*)(rp + Cf::ZCOL), z);
        if (MODE == 0) {
            unpack8(*(const u32x4*)(rp + Cf::KCOL), kv);
            const float* gb = p.gla_gate_b + j * 256 + h * 64 + kk;
#pragma unroll
            for (int e = 0; e < 8; ++e) { const float x = z[e] + gb[e]; lg[e] = (fminf(x, 0.f) * LOG2E_ - __log2f(1.f + __expf(-fabsf(x)))) * (1.f / 16.f); }
        } else {
            const float* lg0 = p.hgrn_lb_logits + h * 128 + kk;
#pragma unroll
            for (int e = 0; e < 8; ++e) {
                const float lb = (j == 0) ? 0.f : sigmoidf_(lg0[512 + e] - lg0[e]);
                const float sg = 1.f / (1.f + __expf(-z[e])), sgn = 1.f / (1.f + __expf(z[e]));
                lg[e] = __log2f(lb + (1.f - lb) * sg); kv[e] = (1.f - lb) * sgn;
            }
        }
        *(u32x4*)(Kb + r * Cf::LQ + kk) = pack8(kv);
        float* gd = Gf + r * Cf::LG + kk;
        *(f32x4*)gd = (f32x4){lg[0], lg[1], lg[2], lg[3]}; *(f32x4*)(gd + 4) = (f32x4){lg[4], lg[5], lg[6], lg[7]};
        if (NEEDQ) {
            float q[8]; unpack8(*(const u32x4*)(rp + Cf::QCOL), q);
#pragma unroll
            for (int e = 0; e < 8; ++e) q[e] = MODE ? siluf_(q[e]) * 0.08838834764831845f : q[e] * 0.125f;
            *(u32x4*)(Qb + r * Cf::LQ + kk) = pack8(q);
        }
    }
    for (int u = C.tid; u < 64 * 16; u += NTHR) {
        const int r = u >> 4, g8 = u & 15;
        const u32x4 w = *(const u32x4*)(proj + (row0 + r) * Cf::PITCH + Cf::VCOL + h * 128 + g8 * 8);
        bf16_t* vd = Vt + (g8 * 8) * 72 + r;
        vd[0] = (bf16_t)(w.x & 0xffffu); vd[72] = (bf16_t)(w.x >> 16); vd[144] = (bf16_t)(w.y & 0xffffu); vd[216] = (bf16_t)(w.y >> 16);
        vd[288] = (bf16_t)(w.z & 0xffffu); vd[360] = (bf16_t)(w.z >> 16); vd[432] = (bf16_t)(w.w & 0xffffu); vd[504] = (bf16_t)(w.w >> 16);
    }
}
template <int MODE> __device__ __forceinline__ void la_cumsum(const Ctx& C, float* Gf, float* segs) {
    typedef LaCfg<MODE> Cf; constexpr int DK = Cf::DK, NSEG = NTHR / DK, RPS = 64 / NSEG;
    const int k = C.tid % DK, seg = C.tid / DK;
    float v[RPS];
#pragma unroll
    for (int i = 0; i < RPS; ++i) v[i] = Gf[(seg * RPS + i) * Cf::LG + k];
#pragma unroll
    for (int i = 1; i < RPS; ++i) v[i] += v[i - 1];
    segs[seg * DK + k] = v[RPS - 1];
    __syncthreads();
    float off = 0.f;
#pragma unroll
    for (int s = 0; s < NSEG; ++s) { const float t = segs[s * DK + k]; off += (s < seg) ? t : 0.f; }
#pragma unroll
    for (int i = 0; i < RPS; ++i) Gf[(seg * RPS + i) * Cf::LG + k] = v[i] + off;
}

template <int MODE> __device__ __forceinline__ void phase_la_p1(const Ctx& C, int l) {
    typedef LaCfg<MODE> Cf; const Params& p = C.p; constexpr int DK = Cf::DK, LQ = Cf::LQ, LG = Cf::LG, NG = Cf::NG;
    bf16_t* Kb = (bf16_t*)(C.lds + Cf::O_KB); float* Gf = (float*)(C.lds + Cf::O_GF); bf16_t* Vt = (bf16_t*)(C.lds + Cf::O_VT);
    bf16_t* KhT = (bf16_t*)(C.lds + Cf::O_KT); float* segs = (float*)(C.lds + Cf::O_SEG);
    bf16_t* ST = (bf16_t*)(p.ws + WS_ST); float* TOT = (float*)(p.ws + WS_TOT);
    const int r16 = C.lane & 15, g = C.lane >> 4, w = C.wave;
    for (int it = blockIdx.x; it < 2048; it += gridDim.x) {
        const int bh = it >> 6, c = it & 63, b = bh >> 2, h = bh & 3;
        la_load<MODE, false>(C, l, b, h, c, nullptr, Kb, Gf, Vt);
        __syncthreads();
        la_cumsum<MODE>(C, Gf, segs);
        __syncthreads();
        for (int u = C.tid; u < 64 * NG; u += NTHR) {
            const int r = u / NG, kk = (u % NG) * 8;
            float kv[8], gj[8], gt[8];
            unpack8(*(const u32x4*)(Kb + r * LQ + kk), kv); ld8f(Gf + r * LG + kk, gj); ld8f(Gf + 63 * LG + kk, gt);
            bf16_t* kd = KhT + kk * 72 + r;
#pragma unroll
            for (int e = 0; e < 8; e += 2) { const unsigned pw = pk2(kv[e] * __builtin_amdgcn_exp2f(gt[e] - gj[e]), kv[e + 1] * __builtin_amdgcn_exp2f(gt[e + 1] - gj[e + 1]));
                kd[e * 72] = (bf16_t)(pw & 0xffffu); kd[(e + 1) * 72] = (bf16_t)(pw >> 16); }
        }
        if (C.tid < DK) TOT[(size_t)it * 128 + C.tid] = Gf[63 * LG + C.tid];
        __syncthreads();
        {
            const bf16x8 b0 = *(const bf16x8*)(Vt + (16 * w + r16) * 72 + 8 * g), b1 = *(const bf16x8*)(Vt + (16 * w + r16) * 72 + 32 + 8 * g);
            bf16_t* so = ST + (size_t)it * DK * 128 + (size_t)(16 * w + r16) * DK + 4 * g;
#pragma unroll
            for (int mt = 0; mt < DK / 16; ++mt) {
                const bf16x8 a0 = *(const bf16x8*)(KhT + (16 * mt + r16) * 72 + 8 * g), a1 = *(const bf16x8*)(KhT + (16 * mt + r16) * 72 + 32 + 8 * g);
                f32x4 acc = (f32x4){0.f, 0.f, 0.f, 0.f};
                acc = __builtin_amdgcn_mfma_f32_16x16x32_bf16(a0, b0, acc, 0, 0, 0);
                acc = __builtin_amdgcn_mfma_f32_16x16x32_bf16(a1, b1, acc, 0, 0, 0);
                u32x2 q; q.x = pk2(acc[0], acc[1]); q.y = pk2(acc[2], acc[3]);
                *(u32x2*)(so + 16 * mt) = q;
            }
        }
        __syncthreads();
    }
}

template <int MODE> __device__ __forceinline__ void phase_la_p2(const Ctx& C) {
    typedef LaCfg<MODE> Cf; const Params& p = C.p; constexpr int DK = Cf::DK, NG = Cf::NG;
    bf16_t* ST = (bf16_t*)(p.ws + WS_ST); const float* TOT = (const float*)(p.ws + WS_TOT);
    for (int u = blockIdx.x * NTHR + C.tid; u < 32 * 128 * NG; u += gridDim.x * NTHR) {
        const int k8 = u % NG, v = (u / NG) & 127, bh = u / (NG * 128);
        float S[8];
#pragma unroll
        for (int e = 0; e < 8; ++e) S[e] = 0.f;
        bf16_t* base = ST + (size_t)bh * 64 * DK * 128 + (size_t)v * DK + k8 * 8;
        const float* tb = TOT + (size_t)bh * 64 * 128 + k8 * 8;
#pragma unroll 4
        for (int c = 0; c < 64; ++c) {
            u32x4* ptr = (u32x4*)(base + (size_t)c * DK * 128);
            float kvv[8], dc[8]; unpack8(*ptr, kvv); ld8f(tb + c * 128, dc);
            *ptr = pack8(S);
#pragma unroll
            for (int e = 0; e < 8; ++e) S[e] = S[e] * __builtin_amdgcn_exp2f(dc[e]) + kvv[e];
        }
    }
}

template <int MODE> __device__ __forceinline__ void phase_la_p3(const Ctx& C, int l) {
    typedef LaCfg<MODE> Cf; const Params& p = C.p; constexpr int DK = Cf::DK, LQ = Cf::LQ, LG = Cf::LG, NG = Cf::NG, NKS = DK / 32;
    bf16_t* Qb = (bf16_t*)(C.lds + Cf::O_QB); bf16_t* Kb = (bf16_t*)(C.lds + Cf::O_KB); float* Gf = (float*)(C.lds + Cf::O_GF); bf16_t* Vt = (bf16_t*)(C.lds + Cf::O_VT);
    bf16_t* Sc = (bf16_t*)(C.lds + Cf::O_SC); bf16_t* Qe = (bf16_t*)(C.lds + Cf::O_QE); float* segs = (float*)(C.lds + Cf::O_SEG); float* red = (float*)(C.lds + Cf::O_RED);
    const bf16_t* ST = (const bf16_t*)(p.ws + WS_ST); const bf16_t* proj = (const bf16_t*)(p.ws + WS_R1); bf16_t* A = (bf16_t*)(p.ws + WS_A);
    const float* nw = (MODE ? p.hgrn_norm_w : p.gla_norm_w) + (l >> 1) * 128;
    const int r16 = C.lane & 15, g = C.lane >> 4, w = C.wave;
    const f32x4 nw4 = *(const f32x4*)(nw + 16 * w + 4 * g);
    for (int it = blockIdx.x; it < 2048; it += gridDim.x) {
        const int bh = it >> 6, c = it & 63, b = bh >> 2, h = bh & 3;
        bf16x8 sfr[NKS];
        { const bf16_t* sp = ST + (size_t)it * DK * 128 + (size_t)(16 * w + r16) * DK + 8 * g;
#pragma unroll
          for (int ks = 0; ks < NKS; ++ks) sfr[ks] = *(const bf16x8*)(sp + 32 * ks); }
        la_load<MODE, true>(C, l, b, h, c, Qb, Kb, Gf, Vt);
        for (int u = C.tid; u < 64 * 72 / 8; u += NTHR) *(u32x4*)(Sc + u * 8) = (u32x4){0u, 0u, 0u, 0u};
        __syncthreads();
        la_cumsum<MODE>(C, Gf, segs);
        __syncthreads();
        for (int t = w; t < 10; t += 8) {
            const int I = (t >= 6) ? 3 : (t >= 3) ? 2 : (t >= 1) ? 1 : 0, J = t - I * (I + 1) / 2;
            f32x4 acc = (f32x4){0.f, 0.f, 0.f, 0.f};
#pragma unroll
            for (int ks = 0; ks < NKS; ++ks) {
                const int kc = 32 * ks + 8 * g;
                float gref[8], gj[8], gi[8], kv[8], qv[8];
                ld8f(Gf + (16 * J + 15) * LG + kc, gref); ld8f(Gf + (16 * J + r16) * LG + kc, gj); ld8f(Gf + (16 * I + r16) * LG + kc, gi);
                unpack8(*(const u32x4*)(Kb + (16 * J + r16) * LQ + kc), kv); unpack8(*(const u32x4*)(Qb + (16 * I + r16) * LQ + kc), qv);
#pragma unroll
                for (int e = 0; e < 8; ++e) { kv[e] *= __builtin_amdgcn_exp2f(gref[e] - gj[e]); qv[e] *= __builtin_amdgcn_exp2f(gi[e] - gref[e]); }
                acc = __builtin_amdgcn_mfma_f32_16x16x32_bf16(__builtin_bit_cast(bf16x8, pack8(kv)), __builtin_bit_cast(bf16x8, pack8(qv)), acc, 0, 0, 0);
            }
            if (I == J) {
#pragma unroll
                for (int e = 0; e < 4; ++e) if (4 * g + e > r16) acc[e] = 0.f;
            }
            u32x2 q; q.x = pk2(acc[0], acc[1]); q.y = pk2(acc[2], acc[3]);
            *(u32x2*)(Sc + (16 * I + r16) * 72 + 16 * J + 4 * g) = q;
        }
        for (int u = C.tid; u < 64 * NG; u += NTHR) {
            const int r = u / NG, kk = (u % NG) * 8;
            float qv[8], gi[8]; unpack8(*(const u32x4*)(Qb + r * LQ + kk), qv); ld8f(Gf + r * LG + kk, gi);
#pragma unroll
            for (int e = 0; e < 8; ++e) qv[e] *= __builtin_amdgcn_exp2f(gi[e]);
            *(u32x4*)(Qe + r * LQ + kk) = pack8(qv);
        }
        __syncthreads();
        f32x4 o[4];
        {
            const bf16x8 v0 = *(const bf16x8*)(Vt + (16 * w + r16) * 72 + 8 * g), v1 = *(const bf16x8*)(Vt + (16 * w + r16) * 72 + 32 + 8 * g);
#pragma unroll
            for (int nt = 0; nt < 4; ++nt) {
                f32x4 acc = (f32x4){0.f, 0.f, 0.f, 0.f};
                acc = __builtin_amdgcn_mfma_f32_16x16x32_bf16(v0, *(const bf16x8*)(Sc + (16 * nt + r16) * 72 + 8 * g), acc, 0, 0, 0);
                if (nt >= 2) acc = __builtin_amdgcn_mfma_f32_16x16x32_bf16(v1, *(const bf16x8*)(Sc + (16 * nt + r16) * 72 + 32 + 8 * g), acc, 0, 0, 0);
#pragma unroll
                for (int ks = 0; ks < NKS; ++ks) acc = __builtin_amdgcn_mfma_f32_16x16x32_bf16(sfr[ks], *(const bf16x8*)(Qe + (16 * nt + r16) * LQ + 32 * ks + 8 * g), acc, 0, 0, 0);
                o[nt] = acc;
                float ss = acc[0] * acc[0] + acc[1] * acc[1] + acc[2] * acc[2] + acc[3] * acc[3];
                ss += __shfl_xor(ss, 16); ss += __shfl_xor(ss, 32);
                if (g == 0) red[w * 64 + 16 * nt + r16] = ss;
            }
        }
        __syncthreads();
#pragma unroll
        for (int nt = 0; nt < 4; ++nt) {
            float tot = 0.f;
#pragma unroll
            for (int ww = 0; ww < 8; ++ww) tot += red[ww * 64 + 16 * nt + r16];
            const float rs = rsqrtf(tot * (1.f / 128.f) + 1e-6f);
            const size_t row = (size_t)b * SEQ_ + (size_t)c * 64 + 16 * nt + r16;
            const u32x2 gw = *(const u32x2*)(proj + row * Cf::PITCH + Cf::GCOL + h * 128 + 16 * w + 4 * g);
            u32x2 q; q.x = pk2(o[nt][0] * rs * nw4[0] * siluf_(bflo(gw.x)), o[nt][1] * rs * nw4[1] * siluf_(bfhi(gw.x)));
            q.y = pk2(o[nt][2] * rs * nw4[2] * siluf_(bflo(gw.y)), o[nt][3] * rs * nw4[3] * siluf_(bfhi(gw.y)));
            *(u32x2*)(A + row * 1024 + Cf::OCOL + h * 128 + 16 * w + 4 * g) = q;
        }
        __syncthreads();
    }
}


#define LAS __attribute__((address_space(3)))
#define XB_TMO      128
#define XB_XCNT(j)  (256  + 64 * (j))
#define XB_XSUB(j)  (1280 + 64 * (j))
#define XB_XGEN(j)  (2304 + 64 * (j))
#define XB_TOP      3328
#define XB_TOPGEN   3392
#define XCD_BAR_WORDS 3456
#define XB_SPIN_CAP (1u << 18)

__device__ __forceinline__ unsigned xb_ld(unsigned* p)              { return __hip_atomic_load(p, __ATOMIC_RELAXED, __HIP_MEMORY_SCOPE_AGENT); }
__device__ __forceinline__ unsigned xb_add(unsigned* p, unsigned v) { return __hip_atomic_fetch_add(p, v, __ATOMIC_RELAXED, __HIP_MEMORY_SCOPE_AGENT); }
__device__ __forceinline__ unsigned xb_xcc_id() { return (unsigned)__builtin_amdgcn_s_getreg((3 << 11) | 20) & 0xFu; }
#define XB_SPIN(cond, bar) do { unsigned _sp = 0; while (cond) { __builtin_amdgcn_s_sleep(1); \
    if ((++_sp & 255u) == 0u) { if (xb_ld(&(bar)[XB_TMO])) break; if (_sp > XB_SPIN_CAP) { atomicAdd(&(bar)[XB_TMO], 1u); break; } } } } while (0)

struct XcdBarrier {
    unsigned* bar; unsigned x;
    volatile LAS unsigned* st;
};

__device__ __forceinline__ XcdBarrier xcd_barrier_post(unsigned* bar, volatile LAS unsigned* st) {
    XcdBarrier b; b.bar = bar; b.x = xb_xcc_id(); b.st = st;
    if (threadIdx.x == 0) (void)xb_add(&bar[XB_XCNT(b.x)], 1u);
    return b;
}
__device__ __forceinline__ void xcd_barrier_complete(unsigned* bar, unsigned x, unsigned& nloc, unsigned& nx) {
    const unsigned G = gridDim.x * gridDim.y * gridDim.z;
    unsigned sum, cnt, mine, sp = 0u;
    for (;;) {
        sum = 0u; cnt = 0u; mine = 0u;
#pragma unroll
        for (unsigned j = 0; j < 16; ++j) { const unsigned c = xb_ld(&bar[XB_XCNT(j)]); sum += c; cnt += (c > 0u) ? 1u : 0u; mine = (j == x) ? c : mine; }
        if (sum == G) break;
        __builtin_amdgcn_s_sleep(1);
        if ((++sp & 255u) == 0u) { if (xb_ld(&bar[XB_TMO])) break; if (sp > XB_SPIN_CAP) { atomicAdd(&bar[XB_TMO], 1u); break; } }
    }
    nloc = mine > 0u ? mine : 1u; nx = cnt > 0u ? cnt : 1u;
}

__device__ __forceinline__ void xcd_barrier(const XcdBarrier& b) {
    asm volatile("s_waitcnt vmcnt(0)" ::: "memory");
    __syncthreads();
    if (threadIdx.x == 0) {
        unsigned* bar = b.bar;
        __builtin_amdgcn_s_waitcnt(0);
        unsigned nloc = b.st[0], nx = b.st[1];
        if (nloc == 0u) { xcd_barrier_complete(bar, b.x, nloc, nx); b.st[0] = nloc; b.st[1] = nx; }
        const unsigned old = xb_add(&bar[XB_XSUB(b.x)], 1u);
        const unsigned gen = old / nloc;
        if (old + 1u == (gen + 1u) * nloc) {
            __builtin_amdgcn_fence(__ATOMIC_RELEASE, "agent");
            asm volatile("s_waitcnt vmcnt(0)" ::: "memory");
            const unsigned og = xb_add(&bar[XB_TOP], 1u);
            const unsigned tg = og / nx;
            if (og + 1u == (tg + 1u) * nx) xb_add(&bar[XB_TOPGEN], 1u);
            else XB_SPIN(xb_ld(&bar[XB_TOPGEN]) == tg, bar);
            __builtin_amdgcn_fence(__ATOMIC_ACQUIRE, "agent");
            xb_add(&bar[XB_XGEN(b.x)], 1u);
            asm volatile("s_waitcnt vmcnt(0)" ::: "memory");
        } else {
            XB_SPIN(xb_ld(&bar[XB_XGEN(b.x)]) == gen, bar);
            __builtin_amdgcn_fence(__ATOMIC_ACQUIRE, "agent");
            asm volatile("s_waitcnt vmcnt(0)" ::: "memory");
        }
    }
    __syncthreads();
}

typedef unsigned u32x16 __attribute__((ext_vector_type(16)));
__device__ __forceinline__ void load_params(Params& p) {
    auto kp = __builtin_amdgcn_kernarg_segment_ptr();
    u32x16 a, b, c, d;
    asm volatile("s_load_dwordx16 %0, %4, 0x0\n\ts_load_dwordx16 %1, %4, 0x40\n\ts_load_dwordx16 %2, %4, 0x80\n\ts_load_dwordx16 %3, %4, 0xc0\n\ts_waitcnt lgkmcnt(0)"
                 : "=&s"(a), "=&s"(b), "=&s"(c), "=&s"(d) : "s"(kp) : "memory");
    unsigned long long q[32];
#pragma unroll
    for (int i = 0; i < 8; ++i) { q[i] = ((unsigned long long)a[2 * i + 1] << 32) | a[2 * i]; q[8 + i] = ((unsigned long long)b[2 * i + 1] << 32) | b[2 * i];
        q[16 + i] = ((unsigned long long)c[2 * i + 1] << 32) | c[2 * i]; q[24 + i] = ((unsigned long long)d[2 * i + 1] << 32) | d[2 * i]; }
    p.x = (const float*)q[0]; p.c = (const float*)q[1]; p.positions = (const int*)q[2]; p.mod_w = (const float*)q[3]; p.mod_b = (const float*)q[4]; p.norm_mix_w = (const float*)q[5]; p.norm_ffn_w = (const float*)q[6];
    p.ev_w_in = (const float*)q[7]; p.gla_gate_w = (const float*)q[8]; p.gla_gate_b = (const float*)q[9]; p.gla_norm_w = (const float*)q[10]; p.swa_sinks = (const float*)q[11]; p.ev_w_out = (const float*)q[12];
    p.od_w_in = (const float*)q[13]; p.diff_lambda = (const float*)q[14]; p.diff_norm_w = (const float*)q[15]; p.hgrn_lb_logits = (const float*)q[16]; p.hgrn_norm_w = (const float*)q[17]; p.od_w_out = (const float*)q[18];
    p.ffn_w_in = (const float*)q[19]; p.ffn_conv_w = (const float*)q[20]; p.ffn_conv_b = (const float*)q[21]; p.ffn_w_out = (const float*)q[22]; p.final_norm_w = (const float*)q[23];
    p.out = (float*)q[24]; p.ws = (unsigned char*)q[25];
}

#ifndef REP_SYNC
#define REP_SYNC 1
#endif
#ifndef REP_G
#define REP_G 1
#endif
#ifndef REP_LA
#define REP_LA 1
#endif
#ifndef REP_AT
#define REP_AT 1
#endif
#ifndef REP_SM
#define REP_SM 1
#endif
__global__ void __launch_bounds__(NTHR, 2) fwd_megakernel(Params pin) {
    extern __shared__ __attribute__((aligned(16))) unsigned char lds[];
    cg::grid_group grid = cg::this_grid();
    Ctx C; C.lds = lds; C.tid = threadIdx.x; C.lane = C.tid & 63; C.wave = __builtin_amdgcn_readfirstlane(C.tid >> 6);
    C.gw = blockIdx.x * 8 + C.wave; C.ngw = gridDim.x * 8;
    PG8_LAS unsigned char* ldsg = (PG8_LAS unsigned char*)lds;
    volatile LAS unsigned* bst = (volatile LAS unsigned*)(ldsg + (LDS_BYTES - 64));
    if (threadIdx.x < 2) bst[threadIdx.x] = 0u;
    __syncthreads();
    XcdBarrier xbar = xcd_barrier_post((unsigned*)(pin.ws + WS_BAR), bst);
#define GSYNC() do { for (int rs_ = 0; rs_ < REP_SYNC; ++rs_) xcd_barrier(xbar); } while (0)
#define RP() do { load_params(C.p); C.tid = otid_(); C.lane = C.tid & 63; C.wave = __builtin_amdgcn_readfirstlane(C.tid >> 6); C.gw = blockIdx.x * 8 + C.wave; } while (0)
#define WSP(off) (C.p.ws + (off))

#ifndef NO_PRO
    for (int rep_ = 0; rep_ < REP_SM; ++rep_) { RP(); phase_prologue(C); }
#endif
    grid.sync();
#pragma unroll 1
    for (int l = 0; l < 4; ++l) {
        const bool even = !(l & 1);
#ifndef NO_CONV
        for (int rep_ = 0; rep_ < REP_SM; ++rep_) { RP(); phase_convert(C, l); }
#endif
#ifndef NO_NORM
        for (int rep_ = 0; rep_ < REP_SM; ++rep_) { RP(); phase_norm(C, (l == 0) ? C.p.x : C.p.out, C.p.norm_mix_w + l * 1024, (const float*)WSP(WS_MOD) + (size_t)l * 8 * 6144, 0, 1024, (bf16_t*)WSP(WS_A)); }
#endif
        GSYNC();
        {
            RP();
            const int N = even ? 2560 : 3584;
            pg8::Gemm g{(const bf16_t*)WSP(WS_A), (const bf16_t*)WSP(WS_WIN), T_, N, 1024}; pg8::StaticOrder S; S.init(T_, N, (int)gridDim.x, (int)blockIdx.x);
            pg8::EpiProj E{(bf16_t*)WSP(WS_R1), N, even ? 0x7C000u : 0xFFu, even ? 0x3C000u : 0xFu, QSCALE_, (const float*)WSP(WS_COS), (const float*)WSP(WS_SIN)};
#ifndef NO_GPROJ
            for (int rep_ = 0; rep_ < REP_G; ++rep_) pg8::gemm_phase<pg8::EpiProj, pg8::StaticOrder, true, true>(ldsg, g, S, E);
#endif
        }
        GSYNC();
        if (even) {
#ifndef NO_SWA
            for (int rep_ = 0; rep_ < REP_AT; ++rep_) { RP(); phase_swa(C, l); }
#endif
#ifndef NO_P1
            for (int rep_ = 0; rep_ < REP_LA; ++rep_) { RP(); phase_la_p1<0>(C, l); }
#endif
            GSYNC();
#ifndef NO_P2
            RP(); phase_la_p2<0>(C);
#endif
            GSYNC();
#ifndef NO_P3
            for (int rep_ = 0; rep_ < REP_LA; ++rep_) { RP(); phase_la_p3<0>(C, l); }
#endif
        } else {
            for (int rep_ = 0; rep_ < REP_AT; ++rep_) {
                RP();
                const bf16_t* R1 = (const bf16_t*)WSP(WS_R1); bf16_t* X2 = (bf16_t*)WSP(WS_X2);
                const int G = (int)gridDim.x, bid = (int)blockIdx.x;
#pragma unroll 1
                for (int i = 0; i * G < 2048; ++i) {
                    const int L = i * G + ((i & 1) ? (G - 1 - bid) : bid);
                    if (L >= 2048) continue;
                    const int qb = 15 - (L >> 7), bh = L & 127, b = bh >> 4, hv = bh & 15;
                    const attn_body::bf16* Q = (const attn_body::bf16*)(R1 + (hv >> 1) * 64);
                    const attn_body::bf16* K = (const attn_body::bf16*)(R1 + 512 + (hv >> 1) * 64);
                    const attn_body::bf16* V = (const attn_body::bf16*)(R1 + 1024 + (hv >> 2) * 128 + (hv & 1) * 64);
#ifndef NO_ATTN
                    attn_body::attn_unit<8>(b, hv, qb, Q, K, V, (attn_body::bf16*)(X2 + hv * 64), (char*)lds);
#endif
                }
            }
#ifndef NO_P1
            for (int rep_ = 0; rep_ < REP_LA; ++rep_) { RP(); phase_la_p1<1>(C, l); }
#endif
            GSYNC();
#ifndef NO_P2
            RP(); phase_la_p2<1>(C);
#endif
#ifndef NO_COMB
            RP(); phase_diff_combine(C, l);
#endif
            GSYNC();
#ifndef NO_P3
            for (int rep_ = 0; rep_ < REP_LA; ++rep_) { RP(); phase_la_p3<1>(C, l); }
#endif
        }
        GSYNC();
        {
            RP();
            pg8::Gemm g{(const bf16_t*)WSP(WS_A), (const bf16_t*)WSP(WS_WOUT), T_, 1024, 1024}; pg8::StaticOrder S; S.init(T_, 1024, (int)gridDim.x, (int)blockIdx.x);
            pg8::EpiRes E{(l == 0) ? C.p.x : C.p.out, C.p.out, (const float*)WSP(WS_MOD) + (size_t)l * 8 * 6144 + 2048};
#ifndef NO_GRES
            pg8::gemm_phase<pg8::EpiRes, pg8::StaticOrder, true, true>(ldsg, g, S, E);
#endif
        }
        GSYNC();
#ifndef NO_NORM
        for (int rep_ = 0; rep_ < REP_SM; ++rep_) { RP(); phase_norm(C, C.p.out, C.p.norm_ffn_w + l * 1024, (const float*)WSP(WS_MOD) + (size_t)l * 8 * 6144, 3072, 4096, (bf16_t*)WSP(WS_A)); }
#endif
        GSYNC();
        {
            RP();
            pg8::Gemm g{(const bf16_t*)WSP(WS_A), (const bf16_t*)WSP(WS_FIN), T_, 5632, 1024}; pg8::StaticOrder S; S.init(T_, 5632, (int)gridDim.x, (int)blockIdx.x);
            pg8::EpiFfn E{(bf16_t*)WSP(WS_R1), (float*)WSP(WS_HP), (float*)WSP(WS_HU), (float*)WSP(WS_HA), C.p.ffn_conv_w + (size_t)l * 3 * DFF_, C.p.ffn_conv_b + (size_t)l * DFF_};
#ifndef NO_GFFN
            for (int rep_ = 0; rep_ < REP_G; ++rep_) pg8::gemm_phase<pg8::EpiFfn, pg8::StaticOrder, true, true>(ldsg, g, S, E);
#endif
        }
        GSYNC();
#ifndef NO_FIX
        for (int rep_ = 0; rep_ < REP_SM; ++rep_) { RP(); phase_ffn_fixup(C, l); }
#endif
        GSYNC();
        {
            RP();
            pg8::Gemm g{(const bf16_t*)WSP(WS_R1), (const bf16_t*)WSP(WS_FOUT), T_, 1024, DFF_}; pg8::StaticOrder S; S.init(T_, 1024, (int)gridDim.x, (int)blockIdx.x);
            pg8::EpiRes E{C.p.out, C.p.out, (const float*)WSP(WS_MOD) + (size_t)l * 8 * 6144 + 5120};
#ifndef NO_GRES
            pg8::gemm_phase<pg8::EpiRes, pg8::StaticOrder, true, true>(ldsg, g, S, E);
#endif
        }
        GSYNC();
    }
    RP(); phase_final_norm(C, C.p.out, C.p.final_norm_w);
}

extern "C" void kernel_launch(void* const* d_in, const int* in_sizes, int n_in, void* d_out, int out_size, void* d_ws, size_t ws_size, hipStream_t stream) {
    static int grid_blocks = 0;
    if (grid_blocks == 0) {
        if (n_in != 24 || ws_size < WS_END) { fprintf(stderr, "kernel_launch: unexpected n_in %d / ws %zu\n", n_in, ws_size); grid_blocks = -1; return; }
        int dev = 0, cus = 0, per_cu = 0;
        hipGetDevice(&dev); hipDeviceGetAttribute(&cus, hipDeviceAttributeMultiprocessorCount, dev);
        if (hipFuncSetAttribute((const void*)fwd_megakernel, hipFuncAttributeMaxDynamicSharedMemorySize, LDS_BYTES) != hipSuccess) { fprintf(stderr, "kernel_launch: hipFuncSetAttribute failed\n"); grid_blocks = -1; return; }
        if (hipOccupancyMaxActiveBlocksPerMultiprocessor(&per_cu, (const void*)fwd_megakernel, NTHR, LDS_BYTES) != hipSuccess || per_cu < 1) { fprintf(stderr, "kernel_launch: occupancy query gave %d\n", per_cu); per_cu = 1; }
        (void)hipGetLastError();
        grid_blocks = cus * per_cu;
    }
    if (grid_blocks < 0) return;
    Params p{};
    p.x = (const float*)d_in[0]; p.c = (const float*)d_in[1]; p.positions = (const int*)d_in[2]; p.mod_w = (const float*)d_in[3]; p.mod_b = (const float*)d_in[4];
    p.norm_mix_w = (const float*)d_in[5]; p.norm_ffn_w = (const float*)d_in[6]; p.ev_w_in = (const float*)d_in[7]; p.gla_gate_w = (const float*)d_in[8];
    p.gla_gate_b = (const float*)d_in[9]; p.gla_norm_w = (const float*)d_in[10]; p.swa_sinks = (const float*)d_in[11]; p.ev_w_out = (const float*)d_in[12];
    p.od_w_in = (const float*)d_in[13]; p.diff_lambda = (const float*)d_in[14]; p.diff_norm_w = (const float*)d_in[15]; p.hgrn_lb_logits = (const float*)d_in[16];
    p.hgrn_norm_w = (const float*)d_in[17]; p.od_w_out = (const float*)d_in[18]; p.ffn_w_in = (const float*)d_in[19]; p.ffn_conv_w = (const float*)d_in[20];
    p.ffn_conv_b = (const float*)d_in[21]; p.ffn_w_out = (const float*)d_in[22]; p.final_norm_w = (const float*)d_in[23];
    p.out = (float*)d_out; p.ws = (unsigned char*)d_ws;
    if (hipMemsetAsync((char*)d_ws + WS_BAR, 0, 16384, stream) != hipSuccess) { fprintf(stderr, "kernel_launch: memset failed\n"); return; }
    void* args[] = {&p};
    hipError_t e = hipLaunchCooperativeKernel((const void*)fwd_megakernel, dim3(grid_blocks), dim3(NTHR), args, LDS_BYTES, stream);
    if (e != hipSuccess) fprintf(stderr, "cooperative launch failed: %s (grid %d)\n", hipGetErrorString(e), grid_blocks);
}
```

```cpp
#include <hip/hip_runtime.h>
#include <hip/hip_cooperative_groups.h>
#include <hip/hip_bf16.h>
#include <cstdio>
#include <cstdint>
#include <cmath>
__device__ __forceinline__ int otid_() { int t = threadIdx.x; asm volatile("" : "+v"(t)); return t; }
namespace pg8 {
#define PG8_LAS __attribute__((address_space(3)))
typedef unsigned short bf16_t;
typedef short bf16x8 __attribute__((ext_vector_type(8)));
typedef float f32x4 __attribute__((ext_vector_type(4)));
typedef unsigned u32x4 __attribute__((ext_vector_type(4)));
constexpr int BM = 256, BK = 64, HALF = 128, HTB = HALF * BK * 2  , STAGE_BYTES = 8 * HTB, NXCD = 8, WGM = 8;

__host__ __device__ __forceinline__ int lds_byte(int r, int c) { const int st = (r >> 4) * 2 + (c >> 5), rr = r & 15, cc = c & 31, ob = rr * 64 + cc * 2; return st * 1024 + (ob ^ (((ob >> 9) & 1) << 5)); }
__host__ __device__ __forceinline__ void stage_rc(int b, int& R, int& C) { const int st = b / 1024, sb = b % 1024, swz = sb ^ (((sb >> 9) & 1) << 5); R = (st >> 1) * 16 + swz / 64; C = (st & 1) * 32 + (swz % 64) / 2; }
__host__ __device__ __forceinline__ int perm32(int rho) { const int n = rho >> 4, i = rho & 15; return 8 * (i >> 2) + 4 * n + (i & 3); }

struct Unit { int pm, pn; };
struct Gemm { const bf16_t* A; const bf16_t* Bt; int M, N, K; };

struct StaticOrder {
    int nM, nN, nwg, G, c;
    __host__ __device__ void init(int M, int N, int G_, int c_) { nM = M / BM; nN = N / BM; nwg = nM * nN; G = G_; c = c_; }
    __host__ __device__ bool next(int i, Unit& u) const {
        const long L = (long)i * G + c; if (L >= nwg) return false;
        int wgid = (int)L; { const int q = nwg / NXCD, r = nwg % NXCD, xcd = wgid % NXCD, off = wgid / NXCD; wgid = (xcd < r ? xcd * (q + 1) : r * (q + 1) + (xcd - r) * q) + off; }
        const int nig = WGM * nN, gid = wgid / nig, fm = gid * WGM, gsz = (nM - fm) < WGM ? (nM - fm) : WGM;
        u.pm = fm + ((wgid % nig) % gsz); u.pn = (wgid % nig) / gsz; return true;
    }
    __device__ __forceinline__ void a_ready(const Unit&) const {}
    __device__ __forceinline__ void done(const Unit&) const {}
};

__device__ __forceinline__ unsigned cvt_pk_bf16(float lo, float hi) { unsigned r; asm volatile("v_cvt_pk_bf16_f32 %0, %1, %2" : "=v"(r) : "v"(lo), "v"(hi)); return r; }
typedef float f32x2 __attribute__((ext_vector_type(2)));
template <class Epi, class Sched, bool ALIGN_EPI = false, bool SP2 = false>
__device__ __forceinline__ void gemm_phase(PG8_LAS unsigned char* lds, const Gemm g, const Sched& S, const Epi& E) {
    const int tid = otid_(), wid = __builtin_amdgcn_readfirstlane(tid >> 6), lane = tid & 63, wr = wid >> 2, wc = wid & 3, fr = lane & 15, fq = lane >> 4;
    const int K = g.K, nt = K / BK;
    unsigned voffA[2], voffB[2];
#pragma unroll
    for (int i = 0; i < 2; ++i) { int R, C; stage_rc(tid * 16 + i * 8192, R, C); const int Rb = Epi::PERM ? ((R & ~31) + perm32(R & 31)) : R;
        voffA[i] = (unsigned)(R * K + C) * 2u; voffB[i] = (unsigned)(Rb * K + C) * 2u; }
    const size_t kstep = (size_t)(BK * 2);
    const size_t hstep = (size_t)HALF * K * 2;
    const size_t tstep = 2 * hstep;
    const unsigned ldsw = (unsigned)wid * 1024u;
    const int aoff = lds_byte(wr * 64 + fr, fq * 8), boff = lds_byte(wc * 32 + fr, fq * 8);
#define PG8_SA(b, h) (((b) * 2 + (h)) * HTB)
#define PG8_SB(b, h) ((4 + (b) * 2 + (h)) * HTB)
#define PG8_STAGE(bufoff, gbase, voff) do { _Pragma("unroll") for (int _i = 0; _i < 2; ++_i) \
        __builtin_amdgcn_global_load_lds((const unsigned*)((const char*)(gbase) + (voff)[_i]), (PG8_LAS unsigned*)(lds + (bufoff) + ldsw + _i * 8192), 16, 0, 0); } while (0)
#define PG8_LDA(dst, b, h) do { _Pragma("unroll") for (int m = 0; m < 4; ++m) _Pragma("unroll") for (int k = 0; k < 2; ++k) dst[m][k] = *(const PG8_LAS bf16x8*)(lds + PG8_SA(b, h) + aoff + m * 2048 + k * 1024); } while (0)
#define PG8_LDB(dst, b, h) do { _Pragma("unroll") for (int n = 0; n < 2; ++n) _Pragma("unroll") for (int k = 0; k < 2; ++k) dst[n][k] = *(const PG8_LAS bf16x8*)(lds + PG8_SB(b, h) + boff + n * 2048 + k * 1024); } while (0)
#define PG8_MMA(ai, bj, At, Bt) do { __builtin_amdgcn_s_setprio(1); _Pragma("unroll") for (int m = 0; m < 4; ++m) _Pragma("unroll") for (int n = 0; n < 2; ++n) _Pragma("unroll") for (int k = 0; k < 2; ++k) \
        acc[ai][bj][m][n] = __builtin_amdgcn_mfma_f32_16x16x32_bf16(Bt[n][k], At[m][k], acc[ai][bj][m][n], 0, 0, 0); __builtin_amdgcn_s_setprio(0); } while (0)
#define PG8_WAIT_V(n) asm volatile("s_waitcnt vmcnt(" #n ")" ::: "memory")
#define PG8_WAIT_L(n) asm volatile("s_waitcnt lgkmcnt(" #n ")" ::: "memory")
#define PG8_BAR __builtin_amdgcn_s_barrier()
#define PG8_SCHED __builtin_amdgcn_sched_barrier(0)
    Unit cur, nxt; int ui = 0;
    if (!S.next(0, cur)) return;
    f32x4 acc[2][2][4][2];
#pragma unroll
    for (int a = 0; a < 2; ++a)
#pragma unroll
        for (int b = 0; b < 2; ++b)
#pragma unroll
            for (int m = 0; m < 4; ++m)
#pragma unroll
                for (int n = 0; n < 2; ++n) acc[a][b][m][n] = (f32x4){0.f, 0.f, 0.f, 0.f};
    bf16x8 At[4][2], B0[2][2], B1[2][2];
    const char* cA = (const char*)g.A + (size_t)cur.pm * tstep; const char* cB = (const char*)g.Bt + (size_t)cur.pn * tstep;
    S.a_ready(cur);
    if constexpr (SP2) {
        PG8_STAGE(PG8_SB(0, 0), cB, voffB); PG8_STAGE(PG8_SB(0, 1), cB + hstep, voffB); PG8_STAGE(PG8_SA(0, 0), cA, voffA); PG8_STAGE(PG8_SA(0, 1), cA + hstep, voffA);
        if (wr == 1) PG8_BAR;
        PG8_WAIT_V(2); PG8_BAR;
        PG8_STAGE(PG8_SB(1, 0), cB + kstep, voffB); PG8_STAGE(PG8_SA(1, 0), cA + kstep, voffA); PG8_STAGE(PG8_SB(1, 1), cB + hstep + kstep, voffB);
        PG8_WAIT_V(6); PG8_BAR;
    } else {
        PG8_STAGE(PG8_SB(0, 0), cB, voffB); PG8_STAGE(PG8_SA(0, 0), cA, voffA); PG8_STAGE(PG8_SB(0, 1), cB + hstep, voffB); PG8_STAGE(PG8_SA(0, 1), cA + hstep, voffA);
        if (wr == 1) PG8_BAR;
        PG8_WAIT_V(4); PG8_BAR;
        PG8_STAGE(PG8_SB(1, 0), cB + kstep, voffB); PG8_STAGE(PG8_SA(1, 0), cA + kstep, voffA); PG8_STAGE(PG8_SB(1, 1), cB + hstep + kstep, voffB);
        PG8_WAIT_V(6); PG8_BAR;
    }
    for (;;) {
        const bool has_next = S.next(ui + 1, nxt);
        const char* nA = has_next ? (const char*)g.A + (size_t)nxt.pm * tstep : cA; const char* nB = has_next ? (const char*)g.Bt + (size_t)nxt.pn * tstep : cB;
        for (int t = 0; t < nt; t += 2) {
            const bool last = (t == nt - 2);
            const char* a1 = cA + (size_t)(t + 1) * kstep;
            const char* a2 = last ? nA : cA + (size_t)(t + 2) * kstep; const char* b2 = last ? nB : cB + (size_t)(t + 2) * kstep;
            const char* a3 = a2 + kstep; const char* b3 = b2 + kstep;
            if (last && has_next) S.a_ready(nxt);
            if constexpr (SP2) {
            PG8_LDB(B0, 0, 0); PG8_LDB(B1, 0, 1); PG8_SCHED; PG8_LDA(At, 0, 0); PG8_STAGE(PG8_SA(1, 1), a1 + hstep, voffA);
            PG8_WAIT_V(8); PG8_WAIT_L(0); PG8_BAR; PG8_MMA(0, 0, At, B0); PG8_MMA(0, 1, At, B1); PG8_BAR; PG8_SCHED;
            PG8_LDA(At, 0, 1); PG8_STAGE(PG8_SB(0, 0), b2, voffB); PG8_STAGE(PG8_SB(0, 1), b2 + hstep, voffB); PG8_STAGE(PG8_SA(0, 0), a2, voffA);
            PG8_WAIT_V(8); PG8_WAIT_L(0); PG8_BAR; PG8_MMA(1, 0, At, B0); PG8_MMA(1, 1, At, B1); PG8_BAR; PG8_SCHED;
            PG8_LDB(B0, 1, 0); PG8_LDB(B1, 1, 1); PG8_SCHED; PG8_LDA(At, 1, 0); PG8_STAGE(PG8_SA(0, 1), a2 + hstep, voffA);
            PG8_WAIT_V(8); PG8_WAIT_L(0); PG8_BAR; PG8_MMA(0, 0, At, B0); PG8_MMA(0, 1, At, B1); PG8_BAR; PG8_SCHED;
            PG8_LDA(At, 1, 1); PG8_STAGE(PG8_SB(1, 0), b3, voffB); PG8_STAGE(PG8_SB(1, 1), b3 + hstep, voffB); PG8_STAGE(PG8_SA(1, 0), a3, voffA);
            PG8_WAIT_V(8); PG8_WAIT_L(0); PG8_BAR; PG8_MMA(1, 0, At, B0); PG8_MMA(1, 1, At, B1); PG8_BAR; PG8_SCHED;
            } else {
            PG8_LDB(B0, 0, 0); PG8_SCHED; PG8_LDA(At, 0, 0); PG8_STAGE(PG8_SA(1, 1), a1 + hstep, voffA);
            PG8_WAIT_L(8); PG8_BAR; PG8_WAIT_L(0); PG8_MMA(0, 0, At, B0); PG8_BAR; PG8_SCHED;
            PG8_LDB(B1, 0, 1); PG8_STAGE(PG8_SB(0, 0), b2, voffB);
            PG8_BAR; PG8_WAIT_L(0); PG8_MMA(0, 1, At, B1); PG8_BAR;
            PG8_LDA(At, 0, 1); PG8_STAGE(PG8_SA(0, 0), a2, voffA);
            PG8_BAR; PG8_WAIT_L(0); PG8_MMA(1, 0, At, B0); PG8_BAR; PG8_SCHED;
            PG8_STAGE(PG8_SB(0, 1), b2 + hstep, voffB);
            PG8_WAIT_V(6); PG8_BAR; PG8_MMA(1, 1, At, B1); PG8_BAR;
            PG8_LDB(B0, 1, 0); PG8_SCHED; PG8_LDA(At, 1, 0); PG8_STAGE(PG8_SA(0, 1), a2 + hstep, voffA);
            PG8_WAIT_L(8); PG8_BAR; PG8_WAIT_L(0); PG8_MMA(0, 0, At, B0); PG8_BAR; PG8_SCHED;
            PG8_LDB(B1, 1, 1); PG8_STAGE(PG8_SB(1, 0), b3, voffB);
            PG8_BAR; PG8_WAIT_L(0); PG8_MMA(0, 1, At, B1); PG8_BAR;
            PG8_LDA(At, 1, 1); PG8_STAGE(PG8_SA(1, 0), a3, voffA);
            PG8_BAR; PG8_WAIT_L(0); PG8_MMA(1, 0, At, B0); PG8_BAR; PG8_SCHED;
            PG8_STAGE(PG8_SB(1, 1), b3 + hstep, voffB);
            PG8_WAIT_V(6); PG8_BAR; PG8_MMA(1, 1, At, B1); PG8_BAR;
            }
        }
        if constexpr (ALIGN_EPI) { if (wr == 0) PG8_BAR; }
        if constexpr (!Epi::AFTER_DRAIN) { E(acc, cur, wr, wc, fr, fq); S.done(cur); }
        if (!has_next) break;
#pragma unroll
        for (int a = 0; a < 2; ++a)
#pragma unroll
            for (int b = 0; b < 2; ++b)
#pragma unroll
                for (int m = 0; m < 4; ++m)
#pragma unroll
                    for (int n = 0; n < 2; ++n) acc[a][b][m][n] = (f32x4){0.f, 0.f, 0.f, 0.f};
        cur = nxt; cA = nA; cB = nB; ++ui;
        if constexpr (ALIGN_EPI) { if (wr == 1) PG8_BAR; }
    }
    PG8_WAIT_V(0);
    if constexpr (!ALIGN_EPI) { if (wr == 0) PG8_BAR; }
    PG8_BAR;
    if constexpr (Epi::AFTER_DRAIN) { E.fused(acc, cur, wr, wc, fr, fq, lds, wid, lane); S.done(cur); }
#undef PG8_SA
#undef PG8_SB
#undef PG8_STAGE
#undef PG8_LDA
#undef PG8_LDB
#undef PG8_MMA
#undef PG8_WAIT_V
#undef PG8_WAIT_L
#undef PG8_BAR
#undef PG8_SCHED
}
}
#include <hip/hip_bf16.h>
namespace attn_body {
using bf16=__hip_bfloat16;
using bf16x8=__attribute__((ext_vector_type(8)))short;
using s16x4=__attribute__((ext_vector_type(4)))short;
using f32x16=__attribute__((ext_vector_type(16)))float;
using u32x4=__attribute__((ext_vector_type(4)))unsigned;
constexpr int BATCH=8,NHEAD=16,SEQ=4096,D=64,PITI=3584,PITO=1024;
constexpr int NW=8,QBLK=32,QB=QBLK*NW,KVBLK=64,NQB=SEQ/QB;
__device__ __forceinline__ int crow(int r,int hi){return (r&3)+8*(r>>2)+4*hi;}
#define SBAR() __builtin_amdgcn_sched_barrier(0)
__device__ __forceinline__ void cmask(f32x16&p0,f32x16&p1,int jb,int qrel,int hi){
  const float NEG=-INFINITY; int kb=64*jb+4*hi;
  #pragma unroll
  for(int r=0;r<16;++r){int kv=kb+(r&3)+8*(r>>2); if(kv>qrel)p0[r]=NEG; if(kv+32>qrel)p1[r]=NEG;}
}

constexpr int NSLOT=3, SLOTB=8192;
constexpr int LDS_K=0, LDS_V=NSLOT*SLOTB, LDS_WS=2*NSLOT*SLOTB, LDS_OST=LDS_WS+NW*64*4, LDS_BYTES=LDS_OST+NW*4096;
constexpr float C2=0.125f*1.4426950408889634f;
__device__ __forceinline__ void glds16(const void*gsrc,unsigned lds_dst){unsigned keep;
  asm volatile("s_mov_b32 %0, m0\n\ts_mov_b32 m0, %2\n\ts_nop 0\n\tglobal_load_lds_dwordx4 %1, off\n\ts_mov_b32 m0, %0":"=&s"(keep):"v"(gsrc),"s"(lds_dst):"memory");}
__device__ __forceinline__ float max3f(float a,float b,float c){float r;asm("v_max3_f32 %0, %1, %2, %3":"=v"(r):"v"(a),"v"(b),"v"(c));return r;}
__device__ __forceinline__ float max2f(float a,float b){float r;asm("v_max_f32_e32 %0, %1, %2":"=v"(r):"v"(a),"v"(b));return r;}
__device__ __forceinline__ float fadd_s(float a,float b){float r;asm("v_add_f32_e32 %0, %1, %2":"=v"(r):"v"(a),"v"(b));return r;}
__device__ __forceinline__ float fsub_s(float a,float b){float r;asm("v_sub_f32_e32 %0, %1, %2":"=v"(r):"v"(a),"v"(b));return r;}
typedef float f32x2_t __attribute__((ext_vector_type(2))); typedef __bf16 bf16x2_t __attribute__((ext_vector_type(2)));
__device__ __forceinline__ unsigned cvtpk_s(float lo,float hi){f32x2_t v={lo,hi};bf16x2_t b=__builtin_convertvector(v,bf16x2_t);return __builtin_bit_cast(unsigned,b);}
#define WAIT_BAR(N) asm volatile("s_waitcnt vmcnt(" #N ") lgkmcnt(0)\n\ts_barrier":::"memory")

__device__ __forceinline__ void qkt(f32x16&p0,f32x16&p1,const char*Kslot,const bf16x8*qr,const f32x16&negm,int r32,int hi){
  const char*kb=Kslot+hi*1024+r32*16;
  #pragma unroll
  for(int d0=0;d0<4;++d0){
    const bf16x8 b0=*reinterpret_cast<const bf16x8*>(kb+d0*2048);
    const bf16x8 b1=*reinterpret_cast<const bf16x8*>(kb+d0*2048+512);
    if(d0==0){p0=__builtin_amdgcn_mfma_f32_32x32x16_bf16(b0,qr[0],negm,0,0,0);p1=__builtin_amdgcn_mfma_f32_32x32x16_bf16(b1,qr[0],negm,0,0,0);}
    else{p0=__builtin_amdgcn_mfma_f32_32x32x16_bf16(b0,qr[d0],p0,0,0,0);p1=__builtin_amdgcn_mfma_f32_32x32x16_bf16(b1,qr[d0],p1,0,0,0);}}
}
typedef __attribute__((address_space(3))) const char* lds_cptr;
typedef short v4i16_t __attribute__((ext_vector_type(4)));
__device__ __forceinline__ void kload8(bf16x8*kf,lds_cptr kp){
  kf[0]=*(const __attribute__((address_space(3))) bf16x8*)(kp);      kf[1]=*(const __attribute__((address_space(3))) bf16x8*)(kp+512);
  kf[2]=*(const __attribute__((address_space(3))) bf16x8*)(kp+2048); kf[3]=*(const __attribute__((address_space(3))) bf16x8*)(kp+2560);
  kf[4]=*(const __attribute__((address_space(3))) bf16x8*)(kp+4096); kf[5]=*(const __attribute__((address_space(3))) bf16x8*)(kp+4608);
  kf[6]=*(const __attribute__((address_space(3))) bf16x8*)(kp+6144); kf[7]=*(const __attribute__((address_space(3))) bf16x8*)(kp+6656);
}
__device__ __forceinline__ void kload2(bf16x8*kf,lds_cptr kp,int j){ kf[2*j]=*(const __attribute__((address_space(3))) bf16x8*)(kp+j*2048); kf[2*j+1]=*(const __attribute__((address_space(3))) bf16x8*)(kp+j*2048+512); }
__device__ __forceinline__ s16x4 vtr(lds_cptr p){ return __builtin_bit_cast(s16x4,__builtin_amdgcn_ds_read_tr16_b64_v4i16((__attribute__((address_space(3))) v4i16_t*)p)); }
__device__ __forceinline__ float rowmax(const f32x16&p0,const f32x16&p1){
  float a=max3f(p0[0],p0[1],p1[0]),b=max3f(p0[2],p0[3],p1[1]);a=max3f(a,p1[2],p1[3]);
  #pragma unroll
  for(int r=4;r<16;r+=4){a=max3f(a,p0[r],p0[r+1]);b=max3f(b,p0[r+2],p0[r+3]);a=max3f(a,p1[r],p1[r+1]);b=max3f(b,p1[r+2],p1[r+3]);}
  const float m=max2f(a,b);
  auto rr=__builtin_amdgcn_permlane32_swap(__float_as_uint(m),__float_as_uint(m),false,false);
  return max2f(__uint_as_float(rr[0]),__uint_as_float(rr[1]));
}
__device__ __forceinline__ void pv(f32x16*o,int vb,bf16x8 pa0,bf16x8 pa1,bf16x8 pa2,bf16x8 pa3){
  #pragma unroll
  for(int d0=0;d0<2;++d0){s16x4 lo[4],hi[4];
    #pragma unroll
    for(int ks=0;ks<4;++ks){
      asm volatile("ds_read_b64_tr_b16 %0,%1 offset:%c2":"=&v"(lo[ks]):"v"(vb),"i"(d0*4096+ks*1024):"memory");
      asm volatile("ds_read_b64_tr_b16 %0,%1 offset:%c2":"=&v"(hi[ks]):"v"(vb),"i"(d0*4096+ks*1024+512):"memory");}
    asm volatile("s_waitcnt lgkmcnt(0)":::"memory");SBAR();
    #define PK(k) (bf16x8){lo[k][0],lo[k][1],lo[k][2],lo[k][3],hi[k][0],hi[k][1],hi[k][2],hi[k][3]}
    o[d0]=__builtin_amdgcn_mfma_f32_32x32x16_bf16(pa0,PK(0),o[d0],0,0,0);
    o[d0]=__builtin_amdgcn_mfma_f32_32x32x16_bf16(pa1,PK(1),o[d0],0,0,0);
    o[d0]=__builtin_amdgcn_mfma_f32_32x32x16_bf16(pa2,PK(2),o[d0],0,0,0);
    o[d0]=__builtin_amdgcn_mfma_f32_32x32x16_bf16(pa3,PK(3),o[d0],0,0,0);
    #undef PK
  }
}

#ifndef ATTN_STORE16
#define ATTN_STORE16(p,v) (*(u32x4*)(p)=(v))
#endif
template<int THRL> __device__ __forceinline__ void attn_unit(int b,int h,int qb,const bf16*Q,const bf16*__restrict__ K,const bf16*__restrict__ V,bf16*O,char*shm){
  const int tid=otid_(),lane=tid&63,r32=lane&31,hi=lane>>5; const int wid=__builtin_amdgcn_readfirstlane(tid>>6);
  const long rowbase=(long)b*SEQ; const int q0=qb*QB;
  const bf16*Qw=Q+(rowbase+q0+wid*QBLK)*PITI;
  const bf16*Kh=K+rowbase*PITI,*Vh=V+rowbase*PITI;
  const unsigned lds0=(unsigned)(uintptr_t)shm;
  float*wsf=(float*)(shm+LDS_WS)+wid*64;
  const bf16*ksrc=Kh+(long)lane*PITI+wid*8;
  const bf16*vsrc=Vh+(long)(16*(wid&3)+(lane>>2))*PITI+(wid>>2)*32+(lane&3)*8;
  const unsigned kdst=lds0+LDS_K+wid*1024, vdst=lds0+LDS_V+wid*1024;
  #define DMA_K(t,slot) glds16(ksrc+(long)(t)*KVBLK*PITI,(unsigned)__builtin_amdgcn_readfirstlane(kdst+(slot)))
  #define DMA_V(t,slot) glds16(vsrc+(long)(t)*KVBLK*PITI,(unsigned)__builtin_amdgcn_readfirstlane(vdst+(slot)))
  const int vb0=(int)(lds0+LDS_V)+((lane>>4)&1)*32+(lane&3)*8+(4*hi+((lane&15)>>2))*64;
  const char*Kbase=shm+LDS_K; bf16x8 kf[8];
  const lds_cptr shm3=(lds_cptr)shm; const lds_cptr kp0=shm3+LDS_K+hi*1024+r32*16; const lds_cptr vp0=shm3+LDS_V+((lane>>4)&1)*32+(lane&3)*8+(4*hi+((lane&15)>>2))*64;
  const int NT=(q0+QB)/KVBLK;
  DMA_K(0,0);DMA_V(0,0);DMA_K(1,SLOTB);
  bf16x8 qr[4];
  #pragma unroll
  for(int d0=0;d0<4;++d0)qr[d0]=*reinterpret_cast<const bf16x8*>(&Qw[(long)r32*PITI+d0*16+hi*8]);
  float mhat=0.f,l_reg=0.f;f32x16 o[2];o[0]=f32x16{};o[1]=f32x16{};f32x16 negm=f32x16{};asm volatile("":"+v"(negm));
  const int qrel=wid*QBLK+r32;
  #define CMASK(P0,P1,t) do{int jb_=(t)-(NT-4); if(jb_>=0)cmask(P0,P1,jb_,qrel,hi);}while(0)
  bool resc=false;
  #define START(P0,P1) do{ const float rm=rowmax(P0,P1); resc=false; \
    { const float dl=rm; mhat=fadd_s(mhat,dl); \
      _Pragma("unroll") for(int r=0;r<16;++r){P0[r]=fsub_s(P0[r],dl);P1[r]=fsub_s(P1[r],dl);} \
      _Pragma("unroll") for(int r=0;r<16;++r)negm[r]=-mhat; asm volatile("":"+v"(negm)); } \
    _Pragma("unroll") for(int r=0;r<16;++r)P0[r]=__builtin_amdgcn_exp2f(P0[r]); }while(0)
  #define RESC() do{ if(resc){ asm volatile("s_waitcnt lgkmcnt(0)":::"memory"); \
      _Pragma("unroll") for(int d_=0;d_<2;++d_) _Pragma("unroll") for(int r=0;r<16;++r)o[d_][r]*=wsf[crow(r,hi)]; } }while(0)
  f32x16 pA0,pA1,pB0,pB1;
  int sl_prev=0,sl_cur=0,sl_next=SLOTB;
  #define ROT() do{sl_prev=sl_cur;sl_cur=sl_next;sl_next=(sl_next==(NSLOT-1)*SLOTB)?0:sl_next+SLOTB;}while(0)
  DMA_K(2,2*SLOTB);
  WAIT_BAR(3);
  qkt(pA0,pA1,Kbase,qr,negm,r32,hi);asm volatile("s_nop 15\n\ts_nop 7":"+v"(pA0),"+v"(pA1));CMASK(pA0,pA1,0);
  START(pA0,pA1);
  _Pragma("unroll") for(int r=0;r<16;++r)pA1[r]=__builtin_amdgcn_exp2f(pA1[r]);
  WAIT_BAR(0);
  DMA_K(3,0);DMA_V(1,SLOTB);
  ROT();
  kload8(kf,kp0+sl_cur);
  WAIT_BAR(2);
  s16x4 vlo[8],vhi[8]; u32x4 pw0,pw1,pw2,pw3;
  #define PKW(P,B) cvtpk_s(P[B],P[B+1])
  #define PAF(k) __builtin_bit_cast(bf16x8,pw##k)
  #define VFR(i) (bf16x8){vlo[i][0],vlo[i][1],vlo[i][2],vlo[i][3],vhi[i][0],vhi[i][1],vhi[i][2],vhi[i][3]}
  #define PIN(x) asm volatile("":"+v"(x))
  #define MX3(a,b,c) __builtin_fmaxf(__builtin_fmaxf((a),(b)),(c))
  #define GAPA(MF,A0,A1,A2,A3,W0,W1,PW) do{ MF; sacc+=A0; sacc+=A1; sacc+=A2; sacc+=A3; PIN(sacc); W0; W1; PIN(PW); SBAR(); }while(0)
  #define EX(v) __builtin_amdgcn_exp2f(v)
  #define GAPB(MF,X,B) do{ MF; X[B]=EX(X[B]); X[B+1]=EX(X[B+1]); X[B+2]=EX(X[B+2]); X[B+3]=EX(X[B+3]); PIN(X); SBAR(); }while(0)
  #define VRD(i) do{ vlo[i]=vtr(vp_+(((i)>>2)*4096+((i)&3)*1024)); vhi[i]=vtr(vp_+(((i)>>2)*4096+((i)&3)*1024+512)); }while(0)
  #define KRD(G,j) do{ if(G){ kload2(kf,kp0+sl_next,j); SBAR(); } }while(0)
  #define STEP(C0,C1,P0,P1,t,GK,GV,GL) do{ SBAR(); \
    const lds_cptr vp_=vp0+sl_prev; \
    VRD(0); SBAR(); float sacc=(P0[0]+P0[1]); \
    GAPA(C0=__builtin_amdgcn_mfma_f32_32x32x16_bf16(kf[0],qr[0],negm,0,0,0), P0[2],P0[3],P0[4],P0[5],     pw0[0]=PKW(P0,0), pw0[1]=PKW(P0,2), pw0); \
    VRD(4); SBAR(); GAPA(C1=__builtin_amdgcn_mfma_f32_32x32x16_bf16(kf[1],qr[0],negm,0,0,0), P0[6],P0[7],P0[8],P0[9],     pw0[2]=PKW(P0,4), pw0[3]=PKW(P0,6), pw0); \
    VRD(1); SBAR(); GAPA(C0=__builtin_amdgcn_mfma_f32_32x32x16_bf16(kf[2],qr[1],C0,0,0,0),   P0[10],P0[11],P0[12],P0[13], pw1[0]=PKW(P0,8), pw1[1]=PKW(P0,10), pw1); \
    VRD(5); SBAR(); GAPA(C1=__builtin_amdgcn_mfma_f32_32x32x16_bf16(kf[3],qr[1],C1,0,0,0),   P0[14],P0[15],P1[0],P1[1],   pw1[2]=PKW(P0,12),pw1[3]=PKW(P0,14), pw1); \
    VRD(2); SBAR(); GAPA(C0=__builtin_amdgcn_mfma_f32_32x32x16_bf16(kf[4],qr[2],C0,0,0,0),   P1[2],P1[3],P1[4],P1[5],     pw2[0]=PKW(P1,0), pw2[1]=PKW(P1,2), pw2); \
    VRD(6); SBAR(); GAPA(C1=__builtin_amdgcn_mfma_f32_32x32x16_bf16(kf[5],qr[2],C1,0,0,0),   P1[6],P1[7],P1[8],P1[9],     pw2[2]=PKW(P1,4), pw2[3]=PKW(P1,6), pw2); \
    VRD(3); SBAR(); GAPA(C0=__builtin_amdgcn_mfma_f32_32x32x16_bf16(kf[6],qr[3],C0,0,0,0),   P1[10],P1[11],P1[12],P1[13], pw3[0]=PKW(P1,8), pw3[1]=PKW(P1,10), pw3); \
    VRD(7); SBAR(); GAPA(C1=__builtin_amdgcn_mfma_f32_32x32x16_bf16(kf[7],qr[3],C1,0,0,0),   P1[14],P1[15],0.f,0.f,       pw3[2]=PKW(P1,12),pw3[3]=PKW(P1,14), pw3); \
    l_reg+=sacc; \
    if(GK){DMA_K((t)+3,sl_cur);} if(GV){DMA_V((t)+1,sl_next);} \
    CMASK(C0,C1,t); \
    { float a=MX3(C0[0],C0[1],C1[0]),b=MX3(C0[2],C0[3],C1[1]); a=MX3(a,C1[2],C1[3]); \
      _Pragma("unroll") for(int r=4;r<16;r+=4){a=MX3(a,C0[r],C0[r+1]);b=MX3(b,C0[r+2],C0[r+3]);a=MX3(a,C1[r],C1[r+1]);b=MX3(b,C1[r+2],C1[r+3]);} \
      float rm=__builtin_fmaxf(a,b); { auto rr=__builtin_amdgcn_permlane32_swap(__float_as_uint(rm),__float_as_uint(rm),false,false); rm=__builtin_fmaxf(__uint_as_float(rr[0]),__uint_as_float(rr[1])); } \
      resc=false; \
      if(__builtin_expect(__any(rm>(float)THRL),0)){ const float dl=__builtin_fmaxf(rm,0.f); mhat+=dl; \
        _Pragma("unroll") for(int r=0;r<16;++r){C0[r]-=dl;C1[r]-=dl;} \
        _Pragma("unroll") for(int r=0;r<16;++r)negm[r]=-mhat; asm volatile("":"+v"(negm)); \
        const float f=__builtin_amdgcn_exp2f(-dl); l_reg*=f; if(hi==0)wsf[r32]=f; resc=true; } } \
    SBAR(); \
    GAPB(o[0]=__builtin_amdgcn_mfma_f32_32x32x16_bf16(PAF(0),VFR(0),o[0],0,0,0), C0,0); \
    GAPB(o[1]=__builtin_amdgcn_mfma_f32_32x32x16_bf16(PAF(0),VFR(4),o[1],0,0,0), C0,4); \
    KRD(GL,0); GAPB(o[0]=__builtin_amdgcn_mfma_f32_32x32x16_bf16(PAF(1),VFR(1),o[0],0,0,0), C0,8); \
    KRD(GL,1); GAPB(o[1]=__builtin_amdgcn_mfma_f32_32x32x16_bf16(PAF(1),VFR(5),o[1],0,0,0), C0,12); \
    KRD(GL,2); GAPB(o[0]=__builtin_amdgcn_mfma_f32_32x32x16_bf16(PAF(2),VFR(2),o[0],0,0,0), C1,0); \
    KRD(GL,3); GAPB(o[1]=__builtin_amdgcn_mfma_f32_32x32x16_bf16(PAF(2),VFR(6),o[1],0,0,0), C1,4); \
    GAPB(o[0]=__builtin_amdgcn_mfma_f32_32x32x16_bf16(PAF(3),VFR(3),o[0],0,0,0), C1,8); \
    GAPB(o[1]=__builtin_amdgcn_mfma_f32_32x32x16_bf16(PAF(3),VFR(7),o[1],0,0,0), C1,12); \
    }while(0)
  int t=1;
  #undef CMASK
  #define CMASK(P0,P1,t) do{}while(0)
  for(;t+5<NT;t+=2){
    STEP(pB0,pB1,pA0,pA1,t,true,true,true);     WAIT_BAR(2); RESC(); ROT();
    STEP(pA0,pA1,pB0,pB1,t+1,true,true,true);   WAIT_BAR(2); RESC(); ROT();
  }
  #undef CMASK
  #define CMASK(P0,P1,t) do{int jb_=(t)-(NT-4); if(jb_>=0)cmask(P0,P1,jb_,qrel,hi);}while(0)
  #define ENDW(tt) do{ if((tt)+3<NT){WAIT_BAR(2);} else if((tt)+2<NT){WAIT_BAR(1);} else {WAIT_BAR(0);} }while(0)
  for(;t+1<NT;t+=2){
    STEP(pB0,pB1,pA0,pA1,t,(t+3<NT),(t+1<NT),(t+1<NT));       ENDW(t);   RESC(); ROT();
    STEP(pA0,pA1,pB0,pB1,t+1,(t+4<NT),(t+2<NT),(t+2<NT));     ENDW(t+1); RESC(); ROT();
  }
  STEP(pB0,pB1,pA0,pA1,NT-1,false,false,false); RESC();
  { float sacc=pB0[0]+pB0[1]; _Pragma("unroll") for(int r=2;r<16;++r)sacc+=pB0[r]; _Pragma("unroll") for(int r=0;r<16;++r)sacc+=pB1[r]; l_reg+=sacc;
    pw0=(u32x4){PKW(pB0,0),PKW(pB0,2),PKW(pB0,4),PKW(pB0,6)};pw1=(u32x4){PKW(pB0,8),PKW(pB0,10),PKW(pB0,12),PKW(pB0,14)};pw2=(u32x4){PKW(pB1,0),PKW(pB1,2),PKW(pB1,4),PKW(pB1,6)};pw3=(u32x4){PKW(pB1,8),PKW(pB1,10),PKW(pB1,12),PKW(pB1,14)};
    SBAR(); pv(o,vb0+sl_cur,PAF(0),PAF(1),PAF(2),PAF(3)); }
  #undef PKW
  #undef PAF
  #undef VFR
  #undef PIN
  #undef MX3
  #undef GAPA
  #undef GAPB
  #undef EX
  #undef VRD
  #undef KRD
  #undef STEP
  #undef ENDW
  {auto rr=__builtin_amdgcn_permlane32_swap(__float_as_uint(l_reg),__float_as_uint(l_reg),false,false);l_reg=__uint_as_float(rr[0])+__uint_as_float(rr[1]);}
  if(hi==0)wsf[32+r32]=l_reg;asm volatile("s_waitcnt lgkmcnt(0)":::"memory");
  float rli[16];
  #pragma unroll
  for(int r=0;r<16;++r)rli[r]=__builtin_amdgcn_rcpf(wsf[32+crow(r,hi)]);
  bf16*Ow=O+(rowbase+q0+wid*QBLK)*PITO;
  { bf16*stg=(bf16*)(shm+LDS_OST)+wid*2048;
    #pragma unroll
    for(int r=0;r<16;++r){const int orow=crow(r,hi);
      #pragma unroll
      for(int d0=0;d0<2;++d0)stg[orow*64+d0*32+r32]=__float2bfloat16(o[d0][r]*rli[r]);}
    asm volatile("s_waitcnt lgkmcnt(0)":::"memory");
    #pragma unroll
    for(int i=0;i<4;++i){const int row=i*8+(lane>>3),ch=lane&7; const u32x4 v=*(const u32x4*)(stg+row*64+ch*8); ATTN_STORE16(Ow+(long)row*PITO+ch*8,v);} }
  asm volatile("s_waitcnt lgkmcnt(0)\n\ts_barrier":::"memory");
  #undef DMA_K
  #undef DMA_V
  #undef CMASK
  #undef START
  #undef RESC
  #undef ROT
}
constexpr int ATTN_LDS_BYTES=LDS_BYTES;
#undef SBAR
#undef WAIT_BAR
}

namespace cg = cooperative_groups;
typedef unsigned short bf16_t;
typedef float f32x4 __attribute__((ext_vector_type(4)));
typedef float f32x16 __attribute__((ext_vector_type(16)));
typedef unsigned u32x4 __attribute__((ext_vector_type(4)));
typedef unsigned u32x2 __attribute__((ext_vector_type(2)));
typedef short bf16x8 __attribute__((ext_vector_type(8)));
#define LAS3 __attribute__((address_space(3)))

constexpr int T_ = 32768, DM_ = 1024, SEQ_ = 4096, DFF_ = 2816;
constexpr int NTHR = 512;
constexpr int LDS_BYTES = 147456;
constexpr size_t MiB_ = 1u << 20;
constexpr size_t WS_MOD = 0, WS_COS = 1 * MiB_, WS_SIN = 2 * MiB_, WS_BAR = 3 * MiB_;
constexpr size_t WS_WIN = 4 * MiB_, WS_WOUT = 11 * MiB_, WS_FIN = 13 * MiB_, WS_FOUT = 24 * MiB_;
constexpr size_t WS_A = 32 * MiB_, WS_X2 = 96 * MiB_, WS_ST = 160 * MiB_, WS_TOT = 224 * MiB_, WS_R1 = 226 * MiB_, WS_END = 450 * MiB_;
constexpr size_t WS_HP = WS_ST, WS_HU = WS_ST + 12 * MiB_, WS_HA = WS_ST + 24 * MiB_;
constexpr float LOG2E_ = 1.4426950408889634f;
constexpr float QSCALE_ = 0.125f * 1.4426950408889634f;

struct Params {
    const float* x; const float* c; const int* positions; const float* mod_w; const float* mod_b; const float* norm_mix_w; const float* norm_ffn_w;
    const float* ev_w_in; const float* gla_gate_w; const float* gla_gate_b; const float* gla_norm_w; const float* swa_sinks; const float* ev_w_out;
    const float* od_w_in; const float* diff_lambda; const float* diff_norm_w; const float* hgrn_lb_logits; const float* hgrn_norm_w; const float* od_w_out;
    const float* ffn_w_in; const float* ffn_conv_w; const float* ffn_conv_b; const float* ffn_w_out; const float* final_norm_w;
    float* out; unsigned char* ws; unsigned long long pad[6];
};

__device__ __forceinline__ unsigned pk2(float lo, float hi) {
    typedef float f32x2_t __attribute__((ext_vector_type(2))); typedef __bf16 bf16x2_t __attribute__((ext_vector_type(2)));
    f32x2_t v = {lo, hi}; bf16x2_t b = __builtin_convertvector(v, bf16x2_t); return __builtin_bit_cast(unsigned, b);
}
__device__ __forceinline__ float bflo(unsigned u) { return __uint_as_float(u << 16); }
__device__ __forceinline__ float bfhi(unsigned u) { return __uint_as_float(u & 0xffff0000u); }
__device__ __forceinline__ float sigmoidf_(float x) { return __builtin_amdgcn_rcpf(1.f + __expf(-x)); }
__device__ __forceinline__ float siluf_(float x) { return x * __builtin_amdgcn_rcpf(1.f + __expf(-x)); }
__device__ __forceinline__ float wave_sum(float v) {
#pragma unroll
    for (int o = 1; o < 64; o <<= 1) v += __shfl_xor(v, o);
    return v;
}
__device__ __forceinline__ int crow_(int r, int hi) { return (r & 3) + 8 * (r >> 2) + 4 * hi; }

namespace pg8 {
struct EpiProj {
    static constexpr bool PERM = true, AFTER_DRAIN = false;
    bf16_t* O; int ldc; unsigned ropemask; unsigned scalemask; float scale; const float* cs; const float* sn;
    __device__ __forceinline__ void operator()(const f32x4 (&acc)[2][2][4][2], const Unit& u, int wr, int wc, int fr, int fq) const {
        const int row0 = u.pm * BM + wr * 64 + fr; const int col0 = u.pn * BM + wc * 32 + 8 * fq;
#pragma unroll
        for (int bj = 0; bj < 2; ++bj) {
            const int grp = u.pn * 2 + bj;
            const bool rope = ((ropemask >> grp) & 1u) && ((wc & 1) == 0);
            const float sc = ((scalemask >> grp) & 1u) ? scale : 1.f;
#pragma unroll
            for (int ai = 0; ai < 2; ++ai)
#pragma unroll
                for (int m = 0; m < 4; ++m) {
                    const int row = row0 + ai * HALF + m * 16;
                    f32x4 v0 = acc[ai][bj][m][0], v1 = acc[ai][bj][m][1];
                    if (rope) {
                        const f32x4 c0 = *(const f32x4*)(cs + (size_t)row * 8), c1 = *(const f32x4*)(cs + (size_t)row * 8 + 4);
                        const f32x4 s0 = *(const f32x4*)(sn + (size_t)row * 8), s1 = *(const f32x4*)(sn + (size_t)row * 8 + 4);
                        const float sg = (fq == 0) ? -1.f : 1.f;
#pragma unroll
                        for (int e = 0; e < 4; ++e) {
                            const float p0 = __shfl_xor(v0[e], 16), p1 = __shfl_xor(v1[e], 16);
                            const float r0 = v0[e] * c0[e] + sg * p0 * s0[e], r1 = v1[e] * c1[e] + sg * p1 * s1[e];
                            if (fq < 2) { v0[e] = r0; v1[e] = r1; }
                        }
                    }
                    v0 = v0 * sc; v1 = v1 * sc;
                    u32x4 w; w.x = pk2(v0[0], v0[1]); w.y = pk2(v0[2], v0[3]); w.z = pk2(v1[0], v1[1]); w.w = pk2(v1[2], v1[3]);
                    *(u32x4*)(O + (size_t)row * ldc + col0 + bj * HALF) = w;
                    asm volatile("" ::: "memory");
                }
        }
    }
};
struct EpiRes {
    static constexpr bool PERM = false, AFTER_DRAIN = false;
    const float* xin; float* xout; const float* gate;
    __device__ __forceinline__ void operator()(const f32x4 (&acc)[2][2][4][2], const Unit& u, int wr, int wc, int fr, int fq) const {
        const int col0 = u.pn * BM + wc * 32 + 4 * fq;
#pragma unroll
        for (int ai = 0; ai < 2; ++ai)
#pragma unroll
            for (int m = 0; m < 4; ++m) {
                const int row = u.pm * BM + ai * HALF + wr * 64 + m * 16 + fr;
                const float* g = gate + (size_t)(row >> 12) * 6144;
                const size_t off = (size_t)row * 1024 + col0;
#pragma unroll
                for (int bj = 0; bj < 2; ++bj)
#pragma unroll
                    for (int n = 0; n < 2; ++n) {
                        const int cc = bj * HALF + n * 16;
                        const f32x4 g4 = *(const f32x4*)(g + col0 + cc);
                        const f32x4 x4 = *(const f32x4*)(xin + off + cc);
                        *(f32x4*)(xout + off + cc) = x4 + g4 * acc[ai][bj][m][n];
                    }
                asm volatile("" ::: "memory");
            }
    }
};
struct EpiFfn {
    static constexpr bool PERM = true, AFTER_DRAIN = false;
    bf16_t* G; float* HP; float* HU; float* HA; const float* cw; const float* cb;
    __device__ __forceinline__ void operator()(const f32x4 (&acc)[2][2][4][2], const Unit& u, int wr, int wc, int fr, int fq) const {
        const int ch0 = u.pn * 128 + wc * 32 + 8 * fq;
        f32x4 w0[2], w1[2], w2[2], bb[2];
#pragma unroll
        for (int n = 0; n < 2; ++n) { w0[n] = *(const f32x4*)(cw + ch0 + 4 * n); w1[n] = *(const f32x4*)(cw + DFF_ + ch0 + 4 * n); w2[n] = *(const f32x4*)(cw + 2 * DFF_ + ch0 + 4 * n); bb[n] = *(const f32x4*)(cb + ch0 + 4 * n); }
        const int lane = fr + 16 * fq;
        const int src1 = (lane & ~15) | ((fr + 15) & 15), src2 = (lane & ~15) | ((fr + 14) & 15);
#pragma unroll
        for (int ai = 0; ai < 2; ++ai) {
            const int seg = u.pm * 4 + ai * 2 + wr;
#pragma unroll
            for (int m = 0; m < 4; ++m) {
                const int row = u.pm * BM + ai * HALF + wr * 64 + m * 16 + fr;
                f32x4 val[2];
#pragma unroll
                for (int n = 0; n < 2; ++n) {
                    const f32x4 a = acc[ai][0][m][n];
                    f32x4 ap = (f32x4){0.f, 0.f, 0.f, 0.f};
                    if (m > 0) ap = acc[ai][0][m > 0 ? m - 1 : 0][n];
#pragma unroll
                    for (int e = 0; e < 4; ++e) {
                        const float t1 = (fr == 15) ? ap[e] : a[e];
                        const float t2 = (fr >= 14) ? ap[e] : a[e];
                        const float p1 = __shfl(t1, src1), p2 = __shfl(t2, src2);
                        val[n][e] = w2[n][e] * a[e] + w1[n][e] * p1 + w0[n][e] * p2 + bb[n][e];
                    }
                }
                const f32x4 u0 = acc[ai][1][m][0], u1 = acc[ai][1][m][1];
                f32x4 g0, g1;
#pragma unroll
                for (int e = 0; e < 4; ++e) { g0[e] = siluf_(val[0][e]) * u0[e]; g1[e] = siluf_(val[1][e]) * u1[e]; }
                u32x4 w; w.x = pk2(g0[0], g0[1]); w.y = pk2(g0[2], g0[3]); w.z = pk2(g1[0], g1[1]); w.w = pk2(g1[2], g1[3]);
                *(u32x4*)(G + (size_t)row * DFF_ + ch0) = w;
                if (m == 0 && fr < 2) {
                    const size_t ho = (size_t)(seg * 2 + fr) * DFF_ + ch0;
                    *(f32x4*)(HP + ho) = val[0]; *(f32x4*)(HP + ho + 4) = val[1];
                    *(f32x4*)(HU + ho) = u0; *(f32x4*)(HU + ho + 4) = u1;
                }
                if (m == 3 && fr >= 14) {
                    const size_t ho = (size_t)(seg * 2 + (fr - 14)) * DFF_ + ch0;
                    *(f32x4*)(HA + ho) = acc[ai][0][3][0]; *(f32x4*)(HA + ho + 4) = acc[ai][0][3][1];
                }
                asm volatile("" ::: "memory");
            }
        }
    }
};
}

struct Ctx { Params p; unsigned char* lds; int tid, lane, wave, gw, ngw; };

__device__ __forceinline__ void phase_prologue(const Ctx& C) {
    const Params& p = C.p;
    float* cact = (float*)C.lds;
    float* red = (float*)(C.lds + 32768);
    float* mod = (float*)(p.ws + WS_MOD);
    const int tid = C.tid;
    for (int i = tid; i < 8192; i += NTHR) { const float c = p.c[i]; cact[i] = c / (1.f + __expf(-c)); }
    __syncthreads();
    const int col = tid & 63, kp = tid >> 6;
    for (int g = blockIdx.x; g < 384; g += gridDim.x) {
        const int l = g / 96, j = (g % 96) * 64 + col;
        const float* w = p.mod_w + (size_t)l * 1024 * 6144 + (size_t)(kp * 128) * 6144 + j;
        float a0 = 0.f, a1 = 0.f, a2 = 0.f, a3 = 0.f, a4 = 0.f, a5 = 0.f, a6 = 0.f, a7 = 0.f;
        const float* ca = cact + kp * 128;
#pragma unroll 8
        for (int k = 0; k < 128; ++k) {
            const float wv = w[(size_t)k * 6144];
            a0 += ca[k] * wv; a1 += ca[1024 + k] * wv; a2 += ca[2048 + k] * wv; a3 += ca[3072 + k] * wv;
            a4 += ca[4096 + k] * wv; a5 += ca[5120 + k] * wv; a6 += ca[6144 + k] * wv; a7 += ca[7168 + k] * wv;
        }
        float* r = red + (kp * 8) * 64 + col;
        r[0] = a0; r[64] = a1; r[128] = a2; r[192] = a3; r[256] = a4; r[320] = a5; r[384] = a6; r[448] = a7;
        __syncthreads();
        { const int b = tid >> 6; float s = 0.f;
#pragma unroll
          for (int kk = 0; kk < 8; ++kk) s += red[(kk * 8 + b) * 64 + col];
          mod[(size_t)(l * 8 + b) * 6144 + j] = s + p.mod_b[l * 6144 + j]; }
        __syncthreads();
    }
    float* cs = (float*)(p.ws + WS_COS); float* sn = (float*)(p.ws + WS_SIN);
    const float invf[8] = {1.0f, 0.1939227432012558f, 0.03760603070259094f, 0.007292664609849453f, 0.0014142135623842478f, 0.00027424818836152554f, 5.3182957344688475e-05f, 1.0313385246263351e-05f};
    for (int r = blockIdx.x * NTHR + tid; r < T_; r += gridDim.x * NTHR) {
        const float pos = (float)p.positions[r];
        f32x4 c4[2], s4[2];
#pragma unroll
        for (int i = 0; i < 8; ++i) {
            const float ang = pos * invf[i];
            const double xr = (double)ang * 0.15915494309189535;
            const float f = (float)(xr - rint(xr));
            c4[i >> 2][i & 3] = __builtin_amdgcn_cosf(f); s4[i >> 2][i & 3] = __builtin_amdgcn_sinf(f);
        }
        *(f32x4*)(cs + (size_t)r * 8) = c4[0]; *(f32x4*)(cs + (size_t)r * 8 + 4) = c4[1];
        *(f32x4*)(sn + (size_t)r * 8) = s4[0]; *(f32x4*)(sn + (size_t)r * 8 + 4) = s4[1];
    }
}

__device__ __forceinline__ void tr_item(const float* W, int Nsrc, int srccol0, bf16_t* WT, int K, int dstrow0, int k0, float* scr, int lane) {
#pragma unroll 8
    for (int i = 0; i < 32; ++i) { const int kk = 2 * i + (lane >> 5); scr[kk * 33 + (lane & 31)] = W[(size_t)(k0 + kk) * Nsrc + srccol0 + (lane & 31)]; }
    asm volatile("s_waitcnt lgkmcnt(0)" ::: "memory");
    const int c = lane & 7;
#pragma unroll
    for (int j = 0; j < 4; ++j) { const int n = (lane >> 3) + 8 * j; const float* s = scr + (8 * c) * 33 + n;
        u32x4 o; o.x = pk2(s[0 * 33], s[1 * 33]); o.y = pk2(s[2 * 33], s[3 * 33]); o.z = pk2(s[4 * 33], s[5 * 33]); o.w = pk2(s[6 * 33], s[7 * 33]);
        *(u32x4*)(WT + (size_t)(dstrow0 + n) * K + k0 + 8 * c) = o; }
    asm volatile("s_waitcnt lgkmcnt(0)" ::: "memory");
}
__device__ __forceinline__ void phase_convert(const Ctx& C, int l) {
    const Params& p = C.p; const int j = l >> 1; const bool even = !(l & 1);
    float* scr = (float*)(C.lds + C.wave * 16384);
    bf16_t* WIN = (bf16_t*)(p.ws + WS_WIN); bf16_t* WOUT = (bf16_t*)(p.ws + WS_WOUT); bf16_t* FIN = (bf16_t*)(p.ws + WS_FIN); bf16_t* FOUT = (bf16_t*)(p.ws + WS_FOUT);
    const int nA = even ? 80 : 112;
    const int IA = 16 * nA, IB = 16 * 32, IC = 16 * 176, ID = 44 * 32;
    const float* win = even ? p.ev_w_in + (size_t)j * 1024 * 2320 : p.od_w_in + (size_t)j * 1024 * 3584;
    const float* wout = even ? p.ev_w_out + (size_t)j * 1024 * 1024 : p.od_w_out + (size_t)j * 1024 * 1024;
    const float* fin = p.ffn_w_in + (size_t)l * 1024 * 5632; const float* fout = p.ffn_w_out + (size_t)l * 2816 * 1024;
    for (int it = C.gw; it < IA + IB + IC + ID; it += C.ngw) {
        int r = it;
        if (r < IA) { const int kb = r / nA, nb = r % nA, n0 = nb * 32; int sc = n0;
            if (even) { if (n0 >= 512 && n0 < 768) continue; if (n0 >= 1792) sc = n0 - 240; else if (n0 >= 768) sc = n0 - 256; }
            tr_item(win, even ? 2320 : 3584, sc, WIN, 1024, n0, kb * 64, scr, C.lane); continue; }
        r -= IA;
        if (r < IB) { const int kb = r / 32, nb = r % 32; tr_item(wout, 1024, nb * 32, WOUT, 1024, nb * 32, kb * 64, scr, C.lane); continue; }
        r -= IB;
        if (r < IC) { const int kb = r / 176, nb = r % 176, n0 = nb * 32; const int pn = n0 >> 8, jj = n0 & 255;
            const int sc = (jj < 128) ? pn * 128 + jj : 2816 + pn * 128 + (jj - 128);
            tr_item(fin, 5632, sc, FIN, 1024, n0, kb * 64, scr, C.lane); continue; }
        r -= IC;
        { const int kb = r / 32, nb = r % 32; tr_item(fout, 1024, nb * 32, FOUT, 2816, nb * 32, kb * 64, scr, C.lane); }
    }
    if (even) {
        const float* gw = p.gla_gate_w + (size_t)j * 16 * 256;
        for (int u = blockIdx.x * NTHR + C.tid; u < 256 * 128; u += gridDim.x * NTHR) {
            const int k8 = u & 127, n = u >> 7;
            float g[16];
#pragma unroll
            for (int r = 0; r < 16; ++r) g[r] = gw[r * 256 + n];
            float o[8];
#pragma unroll
            for (int e = 0; e < 8; ++e) {
                const float* wr = win + (size_t)(k8 * 8 + e) * 2320 + 1536;
                const f32x4 a0 = *(const f32x4*)wr, a1 = *(const f32x4*)(wr + 4), a2 = *(const f32x4*)(wr + 8), a3 = *(const f32x4*)(wr + 12);
                o[e] = a0[0] * g[0] + a0[1] * g[1] + a0[2] * g[2] + a0[3] * g[3] + a1[0] * g[4] + a1[1] * g[5] + a1[2] * g[6] + a1[3] * g[7]
                     + a2[0] * g[8] + a2[1] * g[9] + a2[2] * g[10] + a2[3] * g[11] + a3[0] * g[12] + a3[1] * g[13] + a3[2] * g[14] + a3[3] * g[15];
            }
            u32x4 w; w.x = pk2(o[0], o[1]); w.y = pk2(o[2], o[3]); w.z = pk2(o[4], o[5]); w.w = pk2(o[6], o[7]);
            *(u32x4*)(WIN + (size_t)(512 + n) * 1024 + k8 * 8) = w;
        }
    }
}

__device__ __forceinline__ void phase_norm(const Ctx& C, const float* xin, const float* w, const float* modl, int shoff, int scoff, bf16_t* out) {
    for (int row = C.gw; row < T_; row += C.ngw) {
        const f32x4* xr = (const f32x4*)(xin + (size_t)row * 1024) + C.lane;
        f32x4 v[4]; float ss = 0.f;
#pragma unroll
        for (int j = 0; j < 4; ++j) { v[j] = xr[64 * j]; ss += (v[j].x * v[j].x + v[j].y * v[j].y) + (v[j].z * v[j].z + v[j].w * v[j].w); }
        const float rs = rsqrtf(wave_sum(ss) * (1.f / 1024.f) + 1e-6f);
        const float* mb = modl + (size_t)(row >> 12) * 6144;
        u32x2* o8 = (u32x2*)(out + (size_t)row * 1024) + C.lane;
#pragma unroll
        for (int j = 0; j < 4; ++j) {
            const int col = 4 * C.lane + 256 * j;
            const f32x4 w4 = *(const f32x4*)(w + col), sc = *(const f32x4*)(mb + scoff + col), sh = *(const f32x4*)(mb + shoff + col);
            const f32x4 y = (v[j] * rs) * w4 * (sc + 1.f) + sh;
            u32x2 q; q.x = pk2(y.x, y.y); q.y = pk2(y.z, y.w); o8[64 * j] = q;
        }
    }
}
__device__ __forceinline__ void phase_final_norm(const Ctx& C, float* x, const float* w) {
    for (int row = C.gw; row < T_; row += C.ngw) {
        f32x4* xr = (f32x4*)(x + (size_t)row * 1024) + C.lane;
        f32x4 v[4]; float ss = 0.f;
#pragma unroll
        for (int j = 0; j < 4; ++j) { v[j] = xr[64 * j]; ss += (v[j].x * v[j].x + v[j].y * v[j].y) + (v[j].z * v[j].z + v[j].w * v[j].w); }
        const float rs = rsqrtf(wave_sum(ss) * (1.f / 1024.f) + 1e-6f);
#pragma unroll
        for (int j = 0; j < 4; ++j) { const f32x4 w4 = *(const f32x4*)(w + 4 * C.lane + 256 * j); xr[64 * j] = (v[j] * rs) * w4; }
    }
}

__device__ __forceinline__ void phase_diff_combine(const Ctx& C, int l) {
    const Params& p = C.p; const int j = l >> 1;
    const float lam_init = 0.8f - 0.6f * expf(-0.3f * (float)l);
    const float* lv = p.diff_lambda + j * 256;
    const float s1 = wave_sum(lv[C.lane] * lv[64 + C.lane]), s2 = wave_sum(lv[128 + C.lane] * lv[192 + C.lane]);
    const float lam = expf(s1) - expf(s2) + lam_init;
    const bf16_t* X2 = (const bf16_t*)(p.ws + WS_X2); bf16_t* A = (bf16_t*)(p.ws + WS_A);
    const int head = C.lane >> 4, d0 = (C.lane & 15) * 8;
    const float* nw = p.diff_norm_w + j * 128 + d0;
    const f32x4 n0 = *(const f32x4*)nw, n1 = *(const f32x4*)(nw + 4);
    const float og = 1.f - lam_init;
    for (int row = C.gw; row < T_; row += C.ngw) {
        const bf16_t* src = X2 + (size_t)row * 1024 + head * 256 + d0;
        const u32x4 a = *(const u32x4*)src, b = *(const u32x4*)(src + 128);
        float od[8];
        od[0] = bflo(a.x) - lam * bflo(b.x); od[1] = bfhi(a.x) - lam * bfhi(b.x); od[2] = bflo(a.y) - lam * bflo(b.y); od[3] = bfhi(a.y) - lam * bfhi(b.y);
        od[4] = bflo(a.z) - lam * bflo(b.z); od[5] = bfhi(a.z) - lam * bfhi(b.z); od[6] = bflo(a.w) - lam * bflo(b.w); od[7] = bfhi(a.w) - lam * bfhi(b.w);
        float ss = 0.f;
#pragma unroll
        for (int e = 0; e < 8; ++e) ss += od[e] * od[e];
        ss += __shfl_xor(ss, 1); ss += __shfl_xor(ss, 2); ss += __shfl_xor(ss, 4); ss += __shfl_xor(ss, 8);
        const float rs = rsqrtf(ss * (1.f / 128.f) + 1e-6f) * og;
        u32x4 w; w.x = pk2(od[0] * rs * n0[0], od[1] * rs * n0[1]); w.y = pk2(od[2] * rs * n0[2], od[3] * rs * n0[3]);
        w.z = pk2(od[4] * rs * n1[0], od[5] * rs * n1[1]); w.w = pk2(od[6] * rs * n1[2], od[7] * rs * n1[3]);
        *(u32x4*)(A + (size_t)row * 1024 + head * 128 + d0) = w;
    }
}

__device__ __forceinline__ void phase_ffn_fixup(const Ctx& C, int l) {
    const Params& p = C.p;
    const float* HP = (const float*)(p.ws + WS_HP); const float* HU = (const float*)(p.ws + WS_HU); const float* HA = (const float*)(p.ws + WS_HA);
    bf16_t* G = (bf16_t*)(p.ws + WS_R1);
    const float* cw = p.ffn_conv_w + (size_t)l * 3 * DFF_;
    for (int u = blockIdx.x * NTHR + C.tid; u < 512 * 2 * 704; u += gridDim.x * NTHR) {
        const int c4 = u % 704, sj = u / 704, jj = sj & 1, seg = sj >> 1, ch = c4 * 4;
        const size_t ho = (size_t)sj * DFF_ + ch;
        f32x4 val = *(const f32x4*)(HP + ho); const f32x4 uu = *(const f32x4*)(HU + ho);
        if ((seg & 63) != 0) {
            const f32x4 am1 = *(const f32x4*)(HA + (size_t)((seg - 1) * 2 + 1) * DFF_ + ch), am2 = *(const f32x4*)(HA + (size_t)((seg - 1) * 2) * DFF_ + ch);
            const f32x4 w0 = *(const f32x4*)(cw + ch), w1 = *(const f32x4*)(cw + DFF_ + ch);
            if (jj == 0) val = val + w1 * am1 + w0 * am2; else val = val + w0 * am1;
        }
        u32x2 q; q.x = pk2(siluf_(val.x) * uu.x, siluf_(val.y) * uu.y); q.y = pk2(siluf_(val.z) * uu.z, siluf_(val.w) * uu.w);
        *(u32x2*)(G + (size_t)(seg * 64 + jj) * DFF_ + ch) = q;
    }
}

__device__ __forceinline__ void phase_swa(const Ctx& C, int l) {
    const Params& p = C.p;
    const bf16_t* proj = (const bf16_t*)(p.ws + WS_R1); bf16_t* A = (bf16_t*)(p.ws + WS_A);
    bf16_t* Ks = (bf16_t*)C.lds;
    bf16_t* Vt = (bf16_t*)(C.lds + 27648);
    const int tid = C.tid, lane = C.lane, wid = C.wave, r32 = lane & 31, hi = lane >> 5;
    const float* sinks = p.swa_sinks + (l >> 1) * 8;
    for (int u = blockIdx.x; u < 1024; u += gridDim.x) {
        const int b = u >> 7, kvh = (u >> 6) & 1, qb = u & 63, q0 = qb * 64; const size_t rowbase = (size_t)b * SEQ_;
        for (int c = tid; c < 1536; c += NTHR) {
            const int kk = c >> 3, ch = c & 7, pl = q0 - 128 + kk;
            u32x4 kv = (u32x4){0u, 0u, 0u, 0u}, vv = (u32x4){0u, 0u, 0u, 0u};
            if (pl >= 0) { const bf16_t* src = proj + (rowbase + pl) * 2560 + 2304 + kvh * 64 + ch * 8; kv = *(const u32x4*)src; vv = *(const u32x4*)(src + 128); }
            *(u32x4*)(Ks + kk * 72 + ch * 8) = kv;
            bf16_t* vd = Vt + (ch * 8) * 200 + kk;
            vd[0] = (bf16_t)(vv.x & 0xffffu); vd[200] = (bf16_t)(vv.x >> 16); vd[400] = (bf16_t)(vv.y & 0xffffu); vd[600] = (bf16_t)(vv.y >> 16);
            vd[800] = (bf16_t)(vv.z & 0xffffu); vd[1000] = (bf16_t)(vv.z >> 16); vd[1200] = (bf16_t)(vv.w & 0xffffu); vd[1400] = (bf16_t)(vv.w >> 16);
        }
        __syncthreads();
        const int g = wid >> 1, qh = kvh * 4 + g, qhalf = wid & 1, pq = q0 + 32 * qhalf + r32;
        const bf16_t* qsrc = proj + (rowbase + pq) * 2560 + 1792 + qh * 64;
        bf16x8 qr[4];
#pragma unroll
        for (int d0 = 0; d0 < 4; ++d0) qr[d0] = *(const bf16x8*)(qsrc + d0 * 16 + hi * 8);
        f32x16 s[5];
#pragma unroll
        for (int t = 0; t < 5; ++t) {
            f32x16 a = {};
#pragma unroll
            for (int d0 = 0; d0 < 4; ++d0) {
                const bf16x8 kf = *(const bf16x8*)(Ks + (32 * (qhalf + t) + r32) * 72 + d0 * 16 + hi * 8);
                a = __builtin_amdgcn_mfma_f32_32x32x16_bf16(kf, qr[d0], a, 0, 0, 0);
            }
            s[t] = a;
        }
        const float sink2 = sinks[qh] * LOG2E_;
        float mx = sink2;
#pragma unroll
        for (int t = 0; t < 5; ++t)
#pragma unroll
            for (int r = 0; r < 16; ++r) {
                const int pk = q0 - 128 + 32 * (qhalf + t) + crow_(r, hi);
                const bool valid = (pk >= 0) && (pk <= pq) && (pq - pk < 128);
                const float v = valid ? s[t][r] : -INFINITY; s[t][r] = v; mx = fmaxf(mx, v);
            }
        mx = fmaxf(mx, __shfl_xor(mx, 32));
        float sum = 0.f;
#pragma unroll
        for (int t = 0; t < 5; ++t)
#pragma unroll
            for (int r = 0; r < 16; ++r) { const float e = __builtin_amdgcn_exp2f(s[t][r] - mx); s[t][r] = e; sum += e; }
        sum += __shfl_xor(sum, 32);
        sum += __builtin_amdgcn_exp2f(sink2 - mx);
        const float inv = 1.f / sum;
        f32x16 o[2]; o[0] = f32x16{}; o[1] = f32x16{};
#pragma unroll
        for (int t = 0; t < 5; ++t)
#pragma unroll
            for (int ss = 0; ss < 2; ++ss) {
                u32x4 pw; pw.x = pk2(s[t][8 * ss + 0], s[t][8 * ss + 1]); pw.y = pk2(s[t][8 * ss + 2], s[t][8 * ss + 3]); pw.z = pk2(s[t][8 * ss + 4], s[t][8 * ss + 5]); pw.w = pk2(s[t][8 * ss + 6], s[t][8 * ss + 7]);
                const bf16x8 pf = __builtin_bit_cast(bf16x8, pw);
#pragma unroll
                for (int dt = 0; dt < 2; ++dt) {
                    const bf16_t* vp = Vt + (32 * dt + r32) * 200 + 32 * (qhalf + t) + 16 * ss + 4 * hi;
                    const u32x2 lo = *(const u32x2*)vp, h2 = *(const u32x2*)(vp + 8);
                    u32x4 vw; vw.x = lo.x; vw.y = lo.y; vw.z = h2.x; vw.w = h2.y;
                    o[dt] = __builtin_amdgcn_mfma_f32_32x32x16_bf16(__builtin_bit_cast(bf16x8, vw), pf, o[dt], 0, 0, 0);
                }
            }
        bf16_t* orow = A + (rowbase + pq) * 1024 + 512 + qh * 64;
#pragma unroll
        for (int dt = 0; dt < 2; ++dt)
#pragma unroll
            for (int g4 = 0; g4 < 4; ++g4) {
                u32x2 q; q.x = pk2(o[dt][4 * g4] * inv, o[dt][4 * g4 + 1] * inv); q.y = pk2(o[dt][4 * g4 + 2] * inv, o[dt][4 * g4 + 3] * inv);
                *(u32x2*)(orow + 32 * dt + 8 * g4 + 4 * hi) = q;
            }
        __syncthreads();
    }
}

template <int MODE> struct LaCfg {
    static constexpr int DK = MODE ? 128 : 64, LQ = DK + 8, LG = DK + 4, PITCH = MODE ? 3584 : 2560, NG = DK / 8;
    static constexpr int QCOL = MODE ? 1536 : 0, KCOL = MODE ? 0 : 256, ZCOL = MODE ? 2048 : 512, VCOL = MODE ? 2560 : 768, GCOL = MODE ? 3072 : 1280, OCOL = MODE ? 512 : 0;
    static constexpr int O_QB = 0, O_KB = O_QB + 64 * LQ * 2, O_GF = O_KB + 64 * LQ * 2, O_VT = O_GF + 64 * LG * 4, O_SC = O_VT + 128 * 72 * 2, O_QE = O_SC + 64 * 72 * 2,
                         O_KT = O_QE + 64 * LQ * 2  , O_SEG = O_KT + DK * 72 * 2, O_RED = O_SEG + 8 * 128 * 4, O_PAR = O_RED + 8 * 64 * 4, O_END = O_PAR + 128 * 4;
    static_assert(O_END <= LDS_BYTES, "LA LDS map");
};
__device__ __forceinline__ void unpack8(const u32x4 w, float (&f)[8]) { f[0] = bflo(w.x); f[1] = bfhi(w.x); f[2] = bflo(w.y); f[3] = bfhi(w.y); f[4] = bflo(w.z); f[5] = bfhi(w.z); f[6] = bflo(w.w); f[7] = bfhi(w.w); }
__device__ __forceinline__ u32x4 pack8(const float (&f)[8]) { u32x4 w; w.x = pk2(f[0], f[1]); w.y = pk2(f[2], f[3]); w.z = pk2(f[4], f[5]); w.w = pk2(f[6], f[7]); return w; }
__device__ __forceinline__ void ld8f(const float* p, float (&f)[8]) { const f32x4 a = *(const f32x4*)p, b = *(const f32x4*)(p + 4); f[0] = a[0]; f[1] = a[1]; f[2] = a[2]; f[3] = a[3]; f[4] = b[0]; f[5] = b[1]; f[6] = b[2]; f[7] = b[3]; }

template <int MODE> struct LaRaw { static constexpr int NI = 64 * LaCfg<MODE>::NG / NTHR; u32x4 z[NI], k[NI], q[NI], v[2]; };
template <int MODE, bool NEEDQ> __device__ __forceinline__ void la_fetch(const Ctx& C, int b, int h, int c, LaRaw<MODE>& R) {
    typedef LaCfg<MODE> Cf; const bf16_t* proj = (const bf16_t*)(C.p.ws + WS_R1);
    const size_t row0 = (size_t)b * SEQ_ + (size_t)c * 64;
#pragma unroll
    for (int it = 0; it < LaRaw<MODE>::NI; ++it) {
        const int u = C.tid + it * NTHR, r = u / Cf::NG, kk = (u % Cf::NG) * 8;
        const bf16_t* rp = proj + (row0 + r) * Cf::PITCH + h * Cf::DK + kk;
        R.z[it] = *(const u32x4*)(rp + Cf::ZCOL);
        if (MODE == 0) R.k[it] = *(const u32x4*)(rp + Cf::KCOL);
        if (NEEDQ) R.q[it] = *(const u32x4*)(rp + Cf::QCOL);
    }
#pragma unroll
    for (int it = 0; it < 2; ++it) {
        const int u = C.tid + it * NTHR, r = u >> 4, g8 = u & 15;
        R.v[it] = *(const u32x4*)(proj + (row0 + r) * Cf::PITCH + Cf::VCOL + h * 128 + g8 * 8);
    }
}
template <int MODE, bool NEEDQ> __device__ __forceinline__ void la_store(const Ctx& C, const LaRaw<MODE>& R, const float* par, bf16_t* Qb, bf16_t* Kb, float* Gf, bf16_t* Vt) {
    typedef LaCfg<MODE> Cf;
#pragma unroll
    for (int it = 0; it < LaRaw<MODE>::NI; ++it) {
        const int u = C.tid + it * NTHR, r = u / Cf::NG, kk = (u % Cf::NG) * 8;
        float z[8], kv[8], lg[8], pc[8];
        unpack8(R.z[it], z); ld8f(par + kk, pc);
        if (MODE == 0) {
            unpack8(R.k[it], kv);
#pragma unroll
            for (int e = 0; e < 8; ++e) { const float x = z[e] + pc[e]; lg[e] = (fminf(x, 0.f) * LOG2E_ - __log2f(1.f + __expf(-fabsf(x)))) * (1.f / 16.f); }
        } else {
#pragma unroll
            for (int e = 0; e < 8; ++e) {
                const float zz = fminf(fmaxf(z[e], -60.f), 60.f), ez = __expf(-zz), sg = __builtin_amdgcn_rcpf(1.f + ez), lb = pc[e];
                lg[e] = __log2f(lb + (1.f - lb) * sg); kv[e] = (1.f - lb) * (ez * sg);
            }
        }
        *(u32x4*)(Kb + r * Cf::LQ + kk) = pack8(kv);
        float* gd = Gf + r * Cf::LG + kk;
        *(f32x4*)gd = (f32x4){lg[0], lg[1], lg[2], lg[3]}; *(f32x4*)(gd + 4) = (f32x4){lg[4], lg[5], lg[6], lg[7]};
        if (NEEDQ) {
            float q[8]; unpack8(R.q[it], q);
#pragma unroll
            for (int e = 0; e < 8; ++e) q[e] = MODE ? siluf_(q[e]) * 0.08838834764831845f : q[e] * 0.125f;
            *(u32x4*)(Qb + r * Cf::LQ + kk) = pack8(q);
        }
    }
#pragma unroll
    for (int it = 0; it < 2; ++it) {
        const int u = C.tid + it * NTHR, r = u >> 4, g8 = u & 15;
        const u32x4 w = R.v[it];
        bf16_t* vd = Vt + (g8 * 8) * 72 + r;
        vd[0] = (bf16_t)(w.x & 0xffffu); vd[72] = (bf16_t)(w.x >> 16); vd[144] = (bf16_t)(w.y & 0xffffu); vd[216] = (bf16_t)(w.y >> 16);
        vd[288] = (bf16_t)(w.z & 0xffffu); vd[360] = (bf16_t)(w.z >> 16); vd[432] = (bf16_t)(w.w & 0xffffu); vd[504] = (bf16_t)(w.w >> 16);
    }
}
template <int MODE> __device__ __forceinline__ void la_params(const Ctx& C, int l, int h, float* par) {
    typedef LaCfg<MODE> Cf; const int j = l >> 1;
    if (C.tid < Cf::DK) {
        if (MODE == 0) par[C.tid] = C.p.gla_gate_b[j * 256 + h * 64 + C.tid];
        else { const float* lg0 = C.p.hgrn_lb_logits + h * 128 + C.tid; par[C.tid] = (j == 0) ? 0.f : sigmoidf_(lg0[512] - lg0[0]); }
    }
}
template <int MODE> __device__ __forceinline__ void la_cumsum(const Ctx& C, float* Gf, float* segs) {
    typedef LaCfg<MODE> Cf; constexpr int DK = Cf::DK, NSEG = NTHR / DK, RPS = 64 / NSEG;
    const int k = C.tid % DK, seg = C.tid / DK;
    float v[RPS];
#pragma unroll
    for (int i = 0; i < RPS; ++i) v[i] = Gf[(seg * RPS + i) * Cf::LG + k];
#pragma unroll
    for (int i = 1; i < RPS; ++i) v[i] += v[i - 1];
    segs[seg * DK + k] = v[RPS - 1];
    __syncthreads();
    float off = 0.f;
#pragma unroll
    for (int s = 0; s < NSEG; ++s) { const float t = segs[s * DK + k]; off += (s < seg) ? t : 0.f; }
#pragma unroll
    for (int i = 0; i < RPS; ++i) Gf[(seg * RPS + i) * Cf::LG + k] = v[i] + off;
}

template <int MODE> __device__ __forceinline__ void phase_la_p1(const Ctx& C, int l) {
    typedef LaCfg<MODE> Cf; const Params& p = C.p; constexpr int DK = Cf::DK, LQ = Cf::LQ, LG = Cf::LG, NG = Cf::NG;
    bf16_t* Kb = (bf16_t*)(C.lds + Cf::O_KB); float* Gf = (float*)(C.lds + Cf::O_GF); bf16_t* Vt = (bf16_t*)(C.lds + Cf::O_VT);
    bf16_t* KhT = (bf16_t*)(C.lds + Cf::O_KT); float* segs = (float*)(C.lds + Cf::O_SEG);
    bf16_t* ST = (bf16_t*)(p.ws + WS_ST); float* TOT = (float*)(p.ws + WS_TOT);
    const int r16 = C.lane & 15, g = C.lane >> 4, w = C.wave;
    float* par = (float*)(C.lds + Cf::O_PAR);
    LaRaw<MODE> R; int hcur = -1;
    if ((int)blockIdx.x < 2048) la_fetch<MODE, false>(C, (int)blockIdx.x >> 8, ((int)blockIdx.x >> 6) & 3, (int)blockIdx.x & 63, R);
    for (int it = blockIdx.x; it < 2048; it += gridDim.x) {
        const int bh = it >> 6, c = it & 63, b = bh >> 2, h = bh & 3;
        if (h != hcur) { la_params<MODE>(C, l, h, par); hcur = h; __syncthreads(); }
        la_store<MODE, false>(C, R, par, nullptr, Kb, Gf, Vt);
        { const int nx = it + (int)gridDim.x; if (nx < 2048) la_fetch<MODE, false>(C, nx >> 8, (nx >> 6) & 3, nx & 63, R); }
        __syncthreads();
        la_cumsum<MODE>(C, Gf, segs);
        __syncthreads();
        for (int u = C.tid; u < 64 * NG; u += NTHR) {
            const int r = u / NG, kk = (u % NG) * 8;
            float kv[8], gj[8], gt[8];
            unpack8(*(const u32x4*)(Kb + r * LQ + kk), kv); ld8f(Gf + r * LG + kk, gj); ld8f(Gf + 63 * LG + kk, gt);
            bf16_t* kd = KhT + kk * 72 + r;
#pragma unroll
            for (int e = 0; e < 8; e += 2) { const unsigned pw = pk2(kv[e] * __builtin_amdgcn_exp2f(gt[e] - gj[e]), kv[e + 1] * __builtin_amdgcn_exp2f(gt[e + 1] - gj[e + 1]));
                kd[e * 72] = (bf16_t)(pw & 0xffffu); kd[(e + 1) * 72] = (bf16_t)(pw >> 16); }
        }
        if (C.tid < DK) TOT[(size_t)it * 128 + C.tid] = Gf[63 * LG + C.tid];
        __syncthreads();
        {
            const bf16x8 b0 = *(const bf16x8*)(Vt + (16 * w + r16) * 72 + 8 * g), b1 = *(const bf16x8*)(Vt + (16 * w + r16) * 72 + 32 + 8 * g);
            bf16_t* so = ST + (size_t)it * DK * 128 + (size_t)(16 * w + r16) * DK + 4 * g;
#pragma unroll
            for (int mt = 0; mt < DK / 16; ++mt) {
                const bf16x8 a0 = *(const bf16x8*)(KhT + (16 * mt + r16) * 72 + 8 * g), a1 = *(const bf16x8*)(KhT + (16 * mt + r16) * 72 + 32 + 8 * g);
                f32x4 acc = (f32x4){0.f, 0.f, 0.f, 0.f};
                acc = __builtin_amdgcn_mfma_f32_16x16x32_bf16(a0, b0, acc, 0, 0, 0);
                acc = __builtin_amdgcn_mfma_f32_16x16x32_bf16(a1, b1, acc, 0, 0, 0);
                u32x2 q; q.x = pk2(acc[0], acc[1]); q.y = pk2(acc[2], acc[3]);
                *(u32x2*)(so + 16 * mt) = q;
            }
        }
        __syncthreads();
    }
}

template <int MODE> __device__ __forceinline__ void phase_la_p2(const Ctx& C) {
    typedef LaCfg<MODE> Cf; const Params& p = C.p; constexpr int DK = Cf::DK, NG = Cf::NG;
    bf16_t* ST = (bf16_t*)(p.ws + WS_ST); const float* TOT = (const float*)(p.ws + WS_TOT);
    for (int u = blockIdx.x * NTHR + C.tid; u < 32 * 128 * NG; u += gridDim.x * NTHR) {
        const int k8 = u % NG, v = (u / NG) & 127, bh = u / (NG * 128);
        float S[8];
#pragma unroll
        for (int e = 0; e < 8; ++e) S[e] = 0.f;
        bf16_t* base = ST + (size_t)bh * 64 * DK * 128 + (size_t)v * DK + k8 * 8;
        const float* tb = TOT + (size_t)bh * 64 * 128 + k8 * 8;
#pragma unroll 4
        for (int c = 0; c < 64; ++c) {
            u32x4* ptr = (u32x4*)(base + (size_t)c * DK * 128);
            float kvv[8], dc[8]; unpack8(*ptr, kvv); ld8f(tb + c * 128, dc);
            *ptr = pack8(S);
#pragma unroll
            for (int e = 0; e < 8; ++e) S[e] = S[e] * __builtin_amdgcn_exp2f(dc[e]) + kvv[e];
        }
    }
}

template <int MODE> __device__ __forceinline__ void phase_la_p3(const Ctx& C, int l) {
    typedef LaCfg<MODE> Cf; const Params& p = C.p; constexpr int DK = Cf::DK, LQ = Cf::LQ, LG = Cf::LG, NG = Cf::NG, NKS = DK / 32;
    bf16_t* Qb = (bf16_t*)(C.lds + Cf::O_QB); bf16_t* Kb = (bf16_t*)(C.lds + Cf::O_KB); float* Gf = (float*)(C.lds + Cf::O_GF); bf16_t* Vt = (bf16_t*)(C.lds + Cf::O_VT);
    bf16_t* Sc = (bf16_t*)(C.lds + Cf::O_SC); bf16_t* Qe = (bf16_t*)(C.lds + Cf::O_QE); float* segs = (float*)(C.lds + Cf::O_SEG); float* red = (float*)(C.lds + Cf::O_RED);
    const bf16_t* ST = (const bf16_t*)(p.ws + WS_ST); const bf16_t* proj = (const bf16_t*)(p.ws + WS_R1); bf16_t* A = (bf16_t*)(p.ws + WS_A);
    const float* nw = (MODE ? p.hgrn_norm_w : p.gla_norm_w) + (l >> 1) * 128;
    const int r16 = C.lane & 15, g = C.lane >> 4, w = C.wave;
    const f32x4 nw4 = *(const f32x4*)(nw + 16 * w + 4 * g);
    float* par = (float*)(C.lds + Cf::O_PAR);
    LaRaw<MODE> R; int hcur = -1;
    if ((int)blockIdx.x < 2048) la_fetch<MODE, true>(C, (int)blockIdx.x >> 8, ((int)blockIdx.x >> 6) & 3, (int)blockIdx.x & 63, R);
    for (int it = blockIdx.x; it < 2048; it += gridDim.x) {
        const int bh = it >> 6, c = it & 63, b = bh >> 2, h = bh & 3;
        bf16x8 sfr[NKS];
        { const bf16_t* sp = ST + (size_t)it * DK * 128 + (size_t)(16 * w + r16) * DK + 8 * g;
#pragma unroll
          for (int ks = 0; ks < NKS; ++ks) sfr[ks] = *(const bf16x8*)(sp + 32 * ks); }
        if (h != hcur) { la_params<MODE>(C, l, h, par); hcur = h; __syncthreads(); }
        la_store<MODE, true>(C, R, par, Qb, Kb, Gf, Vt);
        { const int nx = it + (int)gridDim.x; if (nx < 2048) la_fetch<MODE, true>(C, nx >> 8, (nx >> 6) & 3, nx & 63, R); }
        for (int u = C.tid; u < 64 * 72 / 8; u += NTHR) *(u32x4*)(Sc + u * 8) = (u32x4){0u, 0u, 0u, 0u};
        __syncthreads();
        la_cumsum<MODE>(C, Gf, segs);
        __syncthreads();
        for (int t = w; t < 10; t += 8) {
            const int I = (t >= 6) ? 3 : (t >= 3) ? 2 : (t >= 1) ? 1 : 0, J = t - I * (I + 1) / 2;
            f32x4 acc = (f32x4){0.f, 0.f, 0.f, 0.f};
#pragma unroll
            for (int ks = 0; ks < NKS; ++ks) {
                const int kc = 32 * ks + 8 * g;
                float gref[8], gj[8], gi[8], kv[8], qv[8];
                ld8f(Gf + (16 * J + 15) * LG + kc, gref); ld8f(Gf + (16 * J + r16) * LG + kc, gj); ld8f(Gf + (16 * I + r16) * LG + kc, gi);
                unpack8(*(const u32x4*)(Kb + (16 * J + r16) * LQ + kc), kv); unpack8(*(const u32x4*)(Qb + (16 * I + r16) * LQ + kc), qv);
#pragma unroll
                for (int e = 0; e < 8; ++e) { kv[e] *= __builtin_amdgcn_exp2f(gref[e] - gj[e]); qv[e] *= __builtin_amdgcn_exp2f(gi[e] - gref[e]); }
                acc = __builtin_amdgcn_mfma_f32_16x16x32_bf16(__builtin_bit_cast(bf16x8, pack8(kv)), __builtin_bit_cast(bf16x8, pack8(qv)), acc, 0, 0, 0);
            }
            if (I == J) {
#pragma unroll
                for (int e = 0; e < 4; ++e) if (4 * g + e > r16) acc[e] = 0.f;
            }
            u32x2 q; q.x = pk2(acc[0], acc[1]); q.y = pk2(acc[2], acc[3]);
            *(u32x2*)(Sc + (16 * I + r16) * 72 + 16 * J + 4 * g) = q;
        }
        for (int u = C.tid; u < 64 * NG; u += NTHR) {
            const int r = u / NG, kk = (u % NG) * 8;
            float qv[8], gi[8]; unpack8(*(const u32x4*)(Qb + r * LQ + kk), qv); ld8f(Gf + r * LG + kk, gi);
#pragma unroll
            for (int e = 0; e < 8; ++e) qv[e] *= __builtin_amdgcn_exp2f(gi[e]);
            *(u32x4*)(Qe + r * LQ + kk) = pack8(qv);
        }
        __syncthreads();
        f32x4 o[4];
        {
            const bf16x8 v0 = *(const bf16x8*)(Vt + (16 * w + r16) * 72 + 8 * g), v1 = *(const bf16x8*)(Vt + (16 * w + r16) * 72 + 32 + 8 * g);
#pragma unroll
            for (int nt = 0; nt < 4; ++nt) {
                f32x4 acc = (f32x4){0.f, 0.f, 0.f, 0.f};
                acc = __builtin_amdgcn_mfma_f32_16x16x32_bf16(v0, *(const bf16x8*)(Sc + (16 * nt + r16) * 72 + 8 * g), acc, 0, 0, 0);
                if (nt >= 2) acc = __builtin_amdgcn_mfma_f32_16x16x32_bf16(v1, *(const bf16x8*)(Sc + (16 * nt + r16) * 72 + 32 + 8 * g), acc, 0, 0, 0);
#pragma unroll
                for (int ks = 0; ks < NKS; ++ks) acc = __builtin_amdgcn_mfma_f32_16x16x32_bf16(sfr[ks], *(const bf16x8*)(Qe + (16 * nt + r16) * LQ + 32 * ks + 8 * g), acc, 0, 0, 0);
                o[nt] = acc;
                float ss = acc[0] * acc[0] + acc[1] * acc[1] + acc[2] * acc[2] + acc[3] * acc[3];
                ss += __shfl_xor(ss, 16); ss += __shfl_xor(ss, 32);
                if (g == 0) red[w * 64 + 16 * nt + r16] = ss;
            }
        }
        __syncthreads();
#pragma unroll
        for (int nt = 0; nt < 4; ++nt) {
            float tot = 0.f;
#pragma unroll
            for (int ww = 0; ww < 8; ++ww) tot += red[ww * 64 + 16 * nt + r16];
            const float rs = rsqrtf(tot * (1.f / 128.f) + 1e-6f);
            const size_t row = (size_t)b * SEQ_ + (size_t)c * 64 + 16 * nt + r16;
            const u32x2 gw = *(const u32x2*)(proj + row * Cf::PITCH + Cf::GCOL + h * 128 + 16 * w + 4 * g);
            u32x2 q; q.x = pk2(o[nt][0] * rs * nw4[0] * siluf_(bflo(gw.x)), o[nt][1] * rs * nw4[1] * siluf_(bfhi(gw.x)));
            q.y = pk2(o[nt][2] * rs * nw4[2] * siluf_(bflo(gw.y)), o[nt][3] * rs * nw4[3] * siluf_(bfhi(gw.y)));
            *(u32x2*)(A + row * 1024 + Cf::OCOL + h * 128 + 16 * w + 4 * g) = q;
        }
        __syncthreads();
    }
}


#define LAS __attribute__((address_space(3)))
#define XB_TMO      128
#define XB_XCNT(j)  (256  + 64 * (j))
#define XB_XSUB(j)  (1280 + 64 * (j))
#define XB_XGEN(j)  (2304 + 64 * (j))
#define XB_TOP      3328
#define XB_TOPGEN   3392
#define XCD_BAR_WORDS 3456
#define XB_SPIN_CAP (1u << 18)

__device__ __forceinline__ unsigned xb_ld(unsigned* p)              { return __hip_atomic_load(p, __ATOMIC_RELAXED, __HIP_MEMORY_SCOPE_AGENT); }
__device__ __forceinline__ unsigned xb_add(unsigned* p, unsigned v) { return __hip_atomic_fetch_add(p, v, __ATOMIC_RELAXED, __HIP_MEMORY_SCOPE_AGENT); }
__device__ __forceinline__ unsigned xb_xcc_id() { return (unsigned)__builtin_amdgcn_s_getreg((3 << 11) | 20) & 0xFu; }
#define XB_SPIN(cond, bar) do { unsigned _sp = 0; while (cond) { __builtin_amdgcn_s_sleep(1); \
    if ((++_sp & 255u) == 0u) { if (xb_ld(&(bar)[XB_TMO])) break; if (_sp > XB_SPIN_CAP) { atomicAdd(&(bar)[XB_TMO], 1u); break; } } } } while (0)

struct XcdBarrier {
    unsigned* bar; unsigned x;
    volatile LAS unsigned* st;
};

__device__ __forceinline__ XcdBarrier xcd_barrier_post(unsigned* bar, volatile LAS unsigned* st) {
    XcdBarrier b; b.bar = bar; b.x = xb_xcc_id(); b.st = st;
    if (threadIdx.x == 0) (void)xb_add(&bar[XB_XCNT(b.x)], 1u);
    return b;
}
__device__ __forceinline__ void xcd_barrier_complete(unsigned* bar, unsigned x, unsigned& nloc, unsigned& nx) {
    const unsigned G = gridDim.x * gridDim.y * gridDim.z;
    unsigned sum, cnt, mine, sp = 0u;
    for (;;) {
        sum = 0u; cnt = 0u; mine = 0u;
#pragma unroll
        for (unsigned j = 0; j < 16; ++j) { const unsigned c = xb_ld(&bar[XB_XCNT(j)]); sum += c; cnt += (c > 0u) ? 1u : 0u; mine = (j == x) ? c : mine; }
        if (sum == G) break;
        __builtin_amdgcn_s_sleep(1);
        if ((++sp & 255u) == 0u) { if (xb_ld(&bar[XB_TMO])) break; if (sp > XB_SPIN_CAP) { atomicAdd(&bar[XB_TMO], 1u); break; } }
    }
    nloc = mine > 0u ? mine : 1u; nx = cnt > 0u ? cnt : 1u;
}

__device__ __forceinline__ void xcd_barrier(const XcdBarrier& b) {
    asm volatile("s_waitcnt vmcnt(0)" ::: "memory");
    __syncthreads();
    if (threadIdx.x == 0) {
        unsigned* bar = b.bar;
        __builtin_amdgcn_s_waitcnt(0);
        unsigned nloc = b.st[0], nx = b.st[1];
        if (nloc == 0u) { xcd_barrier_complete(bar, b.x, nloc, nx); b.st[0] = nloc; b.st[1] = nx; }
        const unsigned old = xb_add(&bar[XB_XSUB(b.x)], 1u);
        const unsigned gen = old / nloc;
        if (old + 1u == (gen + 1u) * nloc) {
            __builtin_amdgcn_fence(__ATOMIC_RELEASE, "agent");
            asm volatile("s_waitcnt vmcnt(0)" ::: "memory");
            const unsigned og = xb_add(&bar[XB_TOP], 1u);
            const unsigned tg = og / nx;
            if (og + 1u == (tg + 1u) * nx) xb_add(&bar[XB_TOPGEN], 1u);
            else XB_SPIN(xb_ld(&bar[XB_TOPGEN]) == tg, bar);
            __builtin_amdgcn_fence(__ATOMIC_ACQUIRE, "agent");
            xb_add(&bar[XB_XGEN(b.x)], 1u);
            asm volatile("s_waitcnt vmcnt(0)" ::: "memory");
        } else {
            XB_SPIN(xb_ld(&bar[XB_XGEN(b.x)]) == gen, bar);
            __builtin_amdgcn_fence(__ATOMIC_ACQUIRE, "agent");
            asm volatile("s_waitcnt vmcnt(0)" ::: "memory");
        }
    }
    __syncthreads();
}

typedef unsigned u32x16 __attribute__((ext_vector_type(16)));
__device__ __forceinline__ void load_params(Params& p) {
    auto kp = __builtin_amdgcn_kernarg_segment_ptr();
    u32x16 a, b, c, d;
    asm volatile("s_load_dwordx16 %0, %4, 0x0\n\ts_load_dwordx16 %1, %4, 0x40\n\ts_load_dwordx16 %2, %4, 0x80\n\ts_load_dwordx16 %3, %4, 0xc0\n\ts_waitcnt lgkmcnt(0)"
                 : "=&s"(a), "=&s"(b), "=&s"(c), "=&s"(d) : "s"(kp) : "memory");
    unsigned long long q[32];
#pragma unroll
    for (int i = 0; i < 8; ++i) { q[i] = ((unsigned long long)a[2 * i + 1] << 32) | a[2 * i]; q[8 + i] = ((unsigned long long)b[2 * i + 1] << 32) | b[2 * i];
        q[16 + i] = ((unsigned long long)c[2 * i + 1] << 32) | c[2 * i]; q[24 + i] = ((unsigned long long)d[2 * i + 1] << 32) | d[2 * i]; }
    p.x = (const float*)q[0]; p.c = (const float*)q[1]; p.positions = (const int*)q[2]; p.mod_w = (const float*)q[3]; p.mod_b = (const float*)q[4]; p.norm_mix_w = (const float*)q[5]; p.norm_ffn_w = (const float*)q[6];
    p.ev_w_in = (const float*)q[7]; p.gla_gate_w = (const float*)q[8]; p.gla_gate_b = (const float*)q[9]; p.gla_norm_w = (const float*)q[10]; p.swa_sinks = (const float*)q[11]; p.ev_w_out = (const float*)q[12];
    p.od_w_in = (const float*)q[13]; p.diff_lambda = (const float*)q[14]; p.diff_norm_w = (const float*)q[15]; p.hgrn_lb_logits = (const float*)q[16]; p.hgrn_norm_w = (const float*)q[17]; p.od_w_out = (const float*)q[18];
    p.ffn_w_in = (const float*)q[19]; p.ffn_conv_w = (const float*)q[20]; p.ffn_conv_b = (const float*)q[21]; p.ffn_w_out = (const float*)q[22]; p.final_norm_w = (const float*)q[23];
    p.out = (float*)q[24]; p.ws = (unsigned char*)q[25];
}

#ifndef REP_SYNC
#define REP_SYNC 1
#endif
#ifndef REP_G
#define REP_G 1
#endif
#ifndef REP_LA
#define REP_LA 1
#endif
#ifndef REP_AT
#define REP_AT 1
#endif
#ifndef REP_SM
#define REP_SM 1
#endif
__global__ void __launch_bounds__(NTHR, 2) fwd_megakernel(Params pin) {
    extern __shared__ __attribute__((aligned(16))) unsigned char lds[];
    cg::grid_group grid = cg::this_grid();
    Ctx C; C.lds = lds; C.tid = threadIdx.x; C.lane = C.tid & 63; C.wave = __builtin_amdgcn_readfirstlane(C.tid >> 6);
    C.gw = blockIdx.x * 8 + C.wave; C.ngw = gridDim.x * 8;
    PG8_LAS unsigned char* ldsg = (PG8_LAS unsigned char*)lds;
    volatile LAS unsigned* bst = (volatile LAS unsigned*)(ldsg + (LDS_BYTES - 64));
    if (threadIdx.x < 2) bst[threadIdx.x] = 0u;
    __syncthreads();
    XcdBarrier xbar = xcd_barrier_post((unsigned*)(pin.ws + WS_BAR), bst);
#define GSYNC() do { for (int rs_ = 0; rs_ < REP_SYNC; ++rs_) xcd_barrier(xbar); } while (0)
#define RP() do { load_params(C.p); C.tid = otid_(); C.lane = C.tid & 63; C.wave = __builtin_amdgcn_readfirstlane(C.tid >> 6); C.gw = blockIdx.x * 8 + C.wave; } while (0)
#define WSP(off) (C.p.ws + (off))

#ifndef NO_PRO
    for (int rep_ = 0; rep_ < REP_SM; ++rep_) { RP(); phase_prologue(C); }
#endif
    grid.sync();
#pragma unroll 1
    for (int l = 0; l < 4; ++l) {
        const bool even = !(l & 1);
#ifndef NO_CONV
        for (int rep_ = 0; rep_ < REP_SM; ++rep_) { RP(); phase_convert(C, l); }
#endif
#ifndef NO_NORM
        for (int rep_ = 0; rep_ < REP_SM; ++rep_) { RP(); phase_norm(C, (l == 0) ? C.p.x : C.p.out, C.p.norm_mix_w + l * 1024, (const float*)WSP(WS_MOD) + (size_t)l * 8 * 6144, 0, 1024, (bf16_t*)WSP(WS_A)); }
#endif
        GSYNC();
        {
            RP();
            const int N = even ? 2560 : 3584;
            pg8::Gemm g{(const bf16_t*)WSP(WS_A), (const bf16_t*)WSP(WS_WIN), T_, N, 1024}; pg8::StaticOrder S; S.init(T_, N, (int)gridDim.x, (int)blockIdx.x);
            pg8::EpiProj E{(bf16_t*)WSP(WS_R1), N, even ? 0x7C000u : 0xFFu, even ? 0x3C000u : 0xFu, QSCALE_, (const float*)WSP(WS_COS), (const float*)WSP(WS_SIN)};
#ifndef NO_GPROJ
            for (int rep_ = 0; rep_ < REP_G; ++rep_) pg8::gemm_phase<pg8::EpiProj, pg8::StaticOrder, true, true>(ldsg, g, S, E);
#endif
        }
        GSYNC();
        if (even) {
#ifndef NO_SWA
            for (int rep_ = 0; rep_ < REP_AT; ++rep_) { RP(); phase_swa(C, l); }
#endif
#ifndef NO_P1
            for (int rep_ = 0; rep_ < REP_LA; ++rep_) { RP(); phase_la_p1<0>(C, l); }
#endif
            GSYNC();
#ifndef NO_P2
            RP(); phase_la_p2<0>(C);
#endif
            GSYNC();
#ifndef NO_P3
            for (int rep_ = 0; rep_ < REP_LA; ++rep_) { RP(); phase_la_p3<0>(C, l); }
#endif
        } else {
            for (int rep_ = 0; rep_ < REP_AT; ++rep_) {
                RP();
                const bf16_t* R1 = (const bf16_t*)WSP(WS_R1); bf16_t* X2 = (bf16_t*)WSP(WS_X2);
                const int G = (int)gridDim.x, bid = (int)blockIdx.x;
#pragma unroll 1
                for (int i = 0; i * G < 2048; ++i) {
                    const int L = i * G + ((i & 1) ? (G - 1 - bid) : bid);
                    if (L >= 2048) continue;
                    const int qb = 15 - (L >> 7), bh = L & 127, b = bh >> 4, hv = bh & 15;
                    const attn_body::bf16* Q = (const attn_body::bf16*)(R1 + (hv >> 1) * 64);
                    const attn_body::bf16* K = (const attn_body::bf16*)(R1 + 512 + (hv >> 1) * 64);
                    const attn_body::bf16* V = (const attn_body::bf16*)(R1 + 1024 + (hv >> 2) * 128 + (hv & 1) * 64);
#ifndef NO_ATTN
                    attn_body::attn_unit<8>(b, hv, qb, Q, K, V, (attn_body::bf16*)(X2 + hv * 64), (char*)lds);
#endif
                }
            }
#ifndef NO_P1
            for (int rep_ = 0; rep_ < REP_LA; ++rep_) { RP(); phase_la_p1<1>(C, l); }
#endif
            GSYNC();
#ifndef NO_P2
            RP(); phase_la_p2<1>(C);
#endif
#ifndef NO_COMB
            RP(); phase_diff_combine(C, l);
#endif
            GSYNC();
#ifndef NO_P3
            for (int rep_ = 0; rep_ < REP_LA; ++rep_) { RP(); phase_la_p3<1>(C, l); }
#endif
        }
        GSYNC();
        {
            RP();
            pg8::Gemm g{(const bf16_t*)WSP(WS_A), (const bf16_t*)WSP(WS_WOUT), T_, 1024, 1024}; pg8::StaticOrder S; S.init(T_, 1024, (int)gridDim.x, (int)blockIdx.x);
            pg8::EpiRes E{(l == 0) ? C.p.x : C.p.out, C.p.out, (const float*)WSP(WS_MOD) + (size_t)l * 8 * 6144 + 2048};
#ifndef NO_GRES
            pg8::gemm_phase<pg8::EpiRes, pg8::StaticOrder, true, true>(ldsg, g, S, E);
#endif
        }
        GSYNC();
#ifndef NO_NORM
        for (int rep_ = 0; rep_ < REP_SM; ++rep_) { RP(); phase_norm(C, C.p.out, C.p.norm_ffn_w + l * 1024, (const float*)WSP(WS_MOD) + (size_t)l * 8 * 6144, 3072, 4096, (bf16_t*)WSP(WS_A)); }
#endif
        GSYNC();
        {
            RP();
            pg8::Gemm g{(const bf16_t*)WSP(WS_A), (const bf16_t*)WSP(WS_FIN), T_, 5632, 1024}; pg8::StaticOrder S; S.init(T_, 5632, (int)gridDim.x, (int)blockIdx.x);
            pg8::EpiFfn E{(bf16_t*)WSP(WS_R1), (float*)WSP(WS_HP), (float*)WSP(WS_HU), (float*)WSP(WS_HA), C.p.ffn_conv_w + (size_t)l * 3 * DFF_, C.p.ffn_conv_b + (size_t)l * DFF_};
#ifndef NO_GFFN
            for (int rep_ = 0; rep_ < REP_G; ++rep_) pg8::gemm_phase<pg8::EpiFfn, pg8::StaticOrder, true, true>(ldsg, g, S, E);
#endif
        }
        GSYNC();
#ifndef NO_FIX
        for (int rep_ = 0; rep_ < REP_SM; ++rep_) { RP(); phase_ffn_fixup(C, l); }
#endif
        GSYNC();
        {
            RP();
            pg8::Gemm g{(const bf16_t*)WSP(WS_R1), (const bf16_t*)WSP(WS_FOUT), T_, 1024, DFF_}; pg8::StaticOrder S; S.init(T_, 1024, (int)gridDim.x, (int)blockIdx.x);
            pg8::EpiRes E{C.p.out, C.p.out, (const float*)WSP(WS_MOD) + (size_t)l * 8 * 6144 + 5120};
#ifndef NO_GRES
            pg8::gemm_phase<pg8::EpiRes, pg8::StaticOrder, true, true>(ldsg, g, S, E);
#endif
        }
        GSYNC();
    }
    RP(); phase_final_norm(C, C.p.out, C.p.final_norm_w);
}

extern "C" void kernel_launch(void* const* d_in, const int* in_sizes, int n_in, void* d_out, int out_size, void* d_ws, size_t ws_size, hipStream_t stream) {
    static int grid_blocks = 0;
    if (grid_blocks == 0) {
        if (n_in != 24 || ws_size < WS_END) { fprintf(stderr, "kernel_launch: unexpected n_in %d / ws %zu\n", n_in, ws_size); grid_blocks = -1; return; }
        int dev = 0, cus = 0, per_cu = 0;
        hipGetDevice(&dev); hipDeviceGetAttribute(&cus, hipDeviceAttributeMultiprocessorCount, dev);
        if (hipFuncSetAttribute((const void*)fwd_megakernel, hipFuncAttributeMaxDynamicSharedMemorySize, LDS_BYTES) != hipSuccess) { fprintf(stderr, "kernel_launch: hipFuncSetAttribute failed\n"); grid_blocks = -1; return; }
        if (hipOccupancyMaxActiveBlocksPerMultiprocessor(&per_cu, (const void*)fwd_megakernel, NTHR, LDS_BYTES) != hipSuccess || per_cu < 1) { fprintf(stderr, "kernel_launch: occupancy query gave %d\n", per_cu); per_cu = 1; }
        (void)hipGetLastError();
        grid_blocks = cus * per_cu;
    }
    if (grid_blocks < 0) return;
    Params p{};
    p.x = (const float*)d_in[0]; p.c = (const float*)d_in[1]; p.positions = (const int*)d_in[2]; p.mod_w = (const float*)d_in[3]; p.mod_b = (const float*)d_in[4];
    p.norm_mix_w = (const float*)d_in[5]; p.norm_ffn_w = (const float*)d_in[6]; p.ev_w_in = (const float*)d_in[7]; p.gla_gate_w = (const float*)d_in[8];
    p.gla_gate_b = (const float*)d_in[9]; p.gla_norm_w = (const float*)d_in[10]; p.swa_sinks = (const float*)d_in[11]; p.ev_w_out = (const float*)d_in[12];
    p.od_w_in = (const float*)d_in[13]; p.diff_lambda = (const float*)d_in[14]; p.diff_norm_w = (const float*)d_in[15]; p.hgrn_lb_logits = (const float*)d_in[16];
    p.hgrn_norm_w = (const float*)d_in[17]; p.od_w_out = (const float*)d_in[18]; p.ffn_w_in = (const float*)d_in[19]; p.ffn_conv_w = (const float*)d_in[20];
    p.ffn_conv_b = (const float*)d_in[21]; p.ffn_w_out = (const float*)d_in[22]; p.final_norm_w = (const float*)d_in[23];
    p.out = (float*)d_out; p.ws = (unsigned char*)d_ws;
    if (hipMemsetAsync((char*)d_ws + WS_BAR, 0, 16384, stream) != hipSuccess) { fprintf(stderr, "kernel_launch: memset failed\n"); return; }
    void* args[] = {&p};
    hipError_t e = hipLaunchCooperativeKernel((const void*)fwd_megakernel, dim3(grid_blocks), dim3(NTHR), args, LDS_BYTES, stream);
    if (e != hipSuccess) fprintf(stderr, "cooperative launch failed: %s (grid %d)\n", hipGetErrorString(e), grid_blocks);
}
```

```cpp
#include <hip/hip_runtime.h>
#include <hip/hip_cooperative_groups.h>
#include <hip/hip_bf16.h>
#include <cstdio>
#include <cstdint>
#include <cmath>
__device__ __forceinline__ int otid_() { int t = threadIdx.x; asm volatile("" : "+v"(t)); return t; }
namespace pg8 {
#define PG8_LAS __attribute__((address_space(3)))
typedef unsigned short bf16_t;
typedef short bf16x8 __attribute__((ext_vector_type(8)));
typedef float f32x4 __attribute__((ext_vector_type(4)));
typedef unsigned u32x4 __attribute__((ext_vector_type(4)));
constexpr int BM = 256, BK = 64, HALF = 128, HTB = HALF * BK * 2  , STAGE_BYTES = 8 * HTB, NXCD = 8, WGM = 8;

__host__ __device__ __forceinline__ int lds_byte(int r, int c) { const int st = (r >> 4) * 2 + (c >> 5), rr = r & 15, cc = c & 31, ob = rr * 64 + cc * 2; return st * 1024 + (ob ^ (((ob >> 9) & 1) << 5)); }
__host__ __device__ __forceinline__ void stage_rc(int b, int& R, int& C) { const int st = b / 1024, sb = b % 1024, swz = sb ^ (((sb >> 9) & 1) << 5); R = (st >> 1) * 16 + swz / 64; C = (st & 1) * 32 + (swz % 64) / 2; }
__host__ __device__ __forceinline__ int perm32(int rho) { const int n = rho >> 4, i = rho & 15; return 8 * (i >> 2) + 4 * n + (i & 3); }

struct Unit { int pm, pn; };
struct Gemm { const bf16_t* A; const bf16_t* Bt; int M, N, K; };

struct StaticOrder {
    int nM, nN, nwg, G, c;
    __host__ __device__ void init(int M, int N, int G_, int c_) { nM = M / BM; nN = N / BM; nwg = nM * nN; G = G_; c = c_; }
    __host__ __device__ bool next(int i, Unit& u) const {
        const long L = (long)i * G + c; if (L >= nwg) return false;
        int wgid = (int)L; { const int q = nwg / NXCD, r = nwg % NXCD, xcd = wgid % NXCD, off = wgid / NXCD; wgid = (xcd < r ? xcd * (q + 1) : r * (q + 1) + (xcd - r) * q) + off; }
        const int nig = WGM * nN, gid = wgid / nig, fm = gid * WGM, gsz = (nM - fm) < WGM ? (nM - fm) : WGM;
        u.pm = fm + ((wgid % nig) % gsz); u.pn = (wgid % nig) / gsz; return true;
    }
    __device__ __forceinline__ void a_ready(const Unit&) const {}
    __device__ __forceinline__ void done(const Unit&) const {}
};

__device__ __forceinline__ unsigned cvt_pk_bf16(float lo, float hi) { unsigned r; asm volatile("v_cvt_pk_bf16_f32 %0, %1, %2" : "=v"(r) : "v"(lo), "v"(hi)); return r; }
typedef float f32x2 __attribute__((ext_vector_type(2)));
template <class Epi, class Sched, bool ALIGN_EPI = false, bool SP2 = false>
__device__ __forceinline__ void gemm_phase(PG8_LAS unsigned char* lds, const Gemm g, const Sched& S, const Epi& E) {
    const int tid = otid_(), wid = __builtin_amdgcn_readfirstlane(tid >> 6), lane = tid & 63, wr = wid >> 2, wc = wid & 3, fr = lane & 15, fq = lane >> 4;
    const int K = g.K, nt = K / BK;
    unsigned voffA[2], voffB[2];
#pragma unroll
    for (int i = 0; i < 2; ++i) { int R, C; stage_rc(tid * 16 + i * 8192, R, C); const int Rb = Epi::PERM ? ((R & ~31) + perm32(R & 31)) : R;
        voffA[i] = (unsigned)(R * K + C) * 2u; voffB[i] = (unsigned)(Rb * K + C) * 2u; }
    const size_t kstep = (size_t)(BK * 2);
    const size_t hstep = (size_t)HALF * K * 2;
    const size_t tstep = 2 * hstep;
    const unsigned ldsw = (unsigned)wid * 1024u;
    const int aoff = lds_byte(wr * 64 + fr, fq * 8), boff = lds_byte(wc * 32 + fr, fq * 8);
#define PG8_SA(b, h) (((b) * 2 + (h)) * HTB)
#define PG8_SB(b, h) ((4 + (b) * 2 + (h)) * HTB)
#define PG8_STAGE(bufoff, gbase, voff) do { _Pragma("unroll") for (int _i = 0; _i < 2; ++_i) \
        __builtin_amdgcn_global_load_lds((const unsigned*)((const char*)(gbase) + (voff)[_i]), (PG8_LAS unsigned*)(lds + (bufoff) + ldsw + _i * 8192), 16, 0, 0); } while (0)
#define PG8_LDA(dst, b, h) do { _Pragma("unroll") for (int m = 0; m < 4; ++m) _Pragma("unroll") for (int k = 0; k < 2; ++k) dst[m][k] = *(const PG8_LAS bf16x8*)(lds + PG8_SA(b, h) + aoff + m * 2048 + k * 1024); } while (0)
#define PG8_LDB(dst, b, h) do { _Pragma("unroll") for (int n = 0; n < 2; ++n) _Pragma("unroll") for (int k = 0; k < 2; ++k) dst[n][k] = *(const PG8_LAS bf16x8*)(lds + PG8_SB(b, h) + boff + n * 2048 + k * 1024); } while (0)
#define PG8_MMA(ai, bj, At, Bt) do { __builtin_amdgcn_s_setprio(1); _Pragma("unroll") for (int m = 0; m < 4; ++m) _Pragma("unroll") for (int n = 0; n < 2; ++n) _Pragma("unroll") for (int k = 0; k < 2; ++k) \
        acc[ai][bj][m][n] = __builtin_amdgcn_mfma_f32_16x16x32_bf16(Bt[n][k], At[m][k], acc[ai][bj][m][n], 0, 0, 0); __builtin_amdgcn_s_setprio(0); } while (0)
#define PG8_WAIT_V(n) asm volatile("s_waitcnt vmcnt(" #n ")" ::: "memory")
#define PG8_WAIT_L(n) asm volatile("s_waitcnt lgkmcnt(" #n ")" ::: "memory")
#define PG8_BAR __builtin_amdgcn_s_barrier()
#define PG8_SCHED __builtin_amdgcn_sched_barrier(0)
    Unit cur, nxt; int ui = 0;
    if (!S.next(0, cur)) return;
    f32x4 acc[2][2][4][2];
#pragma unroll
    for (int a = 0; a < 2; ++a)
#pragma unroll
        for (int b = 0; b < 2; ++b)
#pragma unroll
            for (int m = 0; m < 4; ++m)
#pragma unroll
                for (int n = 0; n < 2; ++n) acc[a][b][m][n] = (f32x4){0.f, 0.f, 0.f, 0.f};
    bf16x8 At[4][2], B0[2][2], B1[2][2];
    const char* cA = (const char*)g.A + (size_t)cur.pm * tstep; const char* cB = (const char*)g.Bt + (size_t)cur.pn * tstep;
    S.a_ready(cur);
    if constexpr (SP2) {
        PG8_STAGE(PG8_SB(0, 0), cB, voffB); PG8_STAGE(PG8_SB(0, 1), cB + hstep, voffB); PG8_STAGE(PG8_SA(0, 0), cA, voffA); PG8_STAGE(PG8_SA(0, 1), cA + hstep, voffA);
        if (wr == 1) PG8_BAR;
        PG8_WAIT_V(2); PG8_BAR;
        PG8_STAGE(PG8_SB(1, 0), cB + kstep, voffB); PG8_STAGE(PG8_SA(1, 0), cA + kstep, voffA); PG8_STAGE(PG8_SB(1, 1), cB + hstep + kstep, voffB);
        PG8_WAIT_V(6); PG8_BAR;
    } else {
        PG8_STAGE(PG8_SB(0, 0), cB, voffB); PG8_STAGE(PG8_SA(0, 0), cA, voffA); PG8_STAGE(PG8_SB(0, 1), cB + hstep, voffB); PG8_STAGE(PG8_SA(0, 1), cA + hstep, voffA);
        if (wr == 1) PG8_BAR;
        PG8_WAIT_V(4); PG8_BAR;
        PG8_STAGE(PG8_SB(1, 0), cB + kstep, voffB); PG8_STAGE(PG8_SA(1, 0), cA + kstep, voffA); PG8_STAGE(PG8_SB(1, 1), cB + hstep + kstep, voffB);
        PG8_WAIT_V(6); PG8_BAR;
    }
    for (;;) {
        const bool has_next = S.next(ui + 1, nxt);
        const char* nA = has_next ? (const char*)g.A + (size_t)nxt.pm * tstep : cA; const char* nB = has_next ? (const char*)g.Bt + (size_t)nxt.pn * tstep : cB;
        for (int t = 0; t < nt; t += 2) {
            const bool last = (t == nt - 2);
            const char* a1 = cA + (size_t)(t + 1) * kstep;
            const char* a2 = last ? nA : cA + (size_t)(t + 2) * kstep; const char* b2 = last ? nB : cB + (size_t)(t + 2) * kstep;
            const char* a3 = a2 + kstep; const char* b3 = b2 + kstep;
            if (last && has_next) S.a_ready(nxt);
            if constexpr (SP2) {
            PG8_LDB(B0, 0, 0); PG8_LDB(B1, 0, 1); PG8_SCHED; PG8_LDA(At, 0, 0); PG8_STAGE(PG8_SA(1, 1), a1 + hstep, voffA);
            PG8_WAIT_V(8); PG8_WAIT_L(0); PG8_BAR; PG8_MMA(0, 0, At, B0); PG8_MMA(0, 1, At, B1); PG8_BAR; PG8_SCHED;
            PG8_LDA(At, 0, 1); PG8_STAGE(PG8_SB(0, 0), b2, voffB); PG8_STAGE(PG8_SB(0, 1), b2 + hstep, voffB); PG8_STAGE(PG8_SA(0, 0), a2, voffA);
            PG8_WAIT_V(8); PG8_WAIT_L(0); PG8_BAR; PG8_MMA(1, 0, At, B0); PG8_MMA(1, 1, At, B1); PG8_BAR; PG8_SCHED;
            PG8_LDB(B0, 1, 0); PG8_LDB(B1, 1, 1); PG8_SCHED; PG8_LDA(At, 1, 0); PG8_STAGE(PG8_SA(0, 1), a2 + hstep, voffA);
            PG8_WAIT_V(8); PG8_WAIT_L(0); PG8_BAR; PG8_MMA(0, 0, At, B0); PG8_MMA(0, 1, At, B1); PG8_BAR; PG8_SCHED;
            PG8_LDA(At, 1, 1); PG8_STAGE(PG8_SB(1, 0), b3, voffB); PG8_STAGE(PG8_SB(1, 1), b3 + hstep, voffB); PG8_STAGE(PG8_SA(1, 0), a3, voffA);
            PG8_WAIT_V(8); PG8_WAIT_L(0); PG8_BAR; PG8_MMA(1, 0, At, B0); PG8_MMA(1, 1, At, B1); PG8_BAR; PG8_SCHED;
            } else {
            PG8_LDB(B0, 0, 0); PG8_SCHED; PG8_LDA(At, 0, 0); PG8_STAGE(PG8_SA(1, 1), a1 + hstep, voffA);
            PG8_WAIT_L(8); PG8_BAR; PG8_WAIT_L(0); PG8_MMA(0, 0, At, B0); PG8_BAR; PG8_SCHED;
            PG8_LDB(B1, 0, 1); PG8_STAGE(PG8_SB(0, 0), b2, voffB);
            PG8_BAR; PG8_WAIT_L(0); PG8_MMA(0, 1, At, B1); PG8_BAR;
            PG8_LDA(At, 0, 1); PG8_STAGE(PG8_SA(0, 0), a2, voffA);
            PG8_BAR; PG8_WAIT_L(0); PG8_MMA(1, 0, At, B0); PG8_BAR; PG8_SCHED;
            PG8_STAGE(PG8_SB(0, 1), b2 + hstep, voffB);
            PG8_WAIT_V(6); PG8_BAR; PG8_MMA(1, 1, At, B1); PG8_BAR;
            PG8_LDB(B0, 1, 0); PG8_SCHED; PG8_LDA(At, 1, 0); PG8_STAGE(PG8_SA(0, 1), a2 + hstep, voffA);
            PG8_WAIT_L(8); PG8_BAR; PG8_WAIT_L(0); PG8_MMA(0, 0, At, B0); PG8_BAR; PG8_SCHED;
            PG8_LDB(B1, 1, 1); PG8_STAGE(PG8_SB(1, 0), b3, voffB);
            PG8_BAR; PG8_WAIT_L(0); PG8_MMA(0, 1, At, B1); PG8_BAR;
            PG8_LDA(At, 1, 1); PG8_STAGE(PG8_SA(1, 0), a3, voffA);
            PG8_BAR; PG8_WAIT_L(0); PG8_MMA(1, 0, At, B0); PG8_BAR; PG8_SCHED;
            PG8_STAGE(PG8_SB(1, 1), b3 + hstep, voffB);
            PG8_WAIT_V(6); PG8_BAR; PG8_MMA(1, 1, At, B1); PG8_BAR;
            }
        }
        if constexpr (ALIGN_EPI) { if (wr == 0) PG8_BAR; }
        if constexpr (!Epi::AFTER_DRAIN) { E(acc, cur, wr, wc, fr, fq); S.done(cur); }
        if (!has_next) break;
#pragma unroll
        for (int a = 0; a < 2; ++a)
#pragma unroll
            for (int b = 0; b < 2; ++b)
#pragma unroll
                for (int m = 0; m < 4; ++m)
#pragma unroll
                    for (int n = 0; n < 2; ++n) acc[a][b][m][n] = (f32x4){0.f, 0.f, 0.f, 0.f};
        cur = nxt; cA = nA; cB = nB; ++ui;
        if constexpr (ALIGN_EPI) { if (wr == 1) PG8_BAR; }
    }
    PG8_WAIT_V(0);
    if constexpr (!ALIGN_EPI) { if (wr == 0) PG8_BAR; }
    PG8_BAR;
    if constexpr (Epi::AFTER_DRAIN) { E.fused(acc, cur, wr, wc, fr, fq, lds, wid, lane); S.done(cur); }
#undef PG8_SA
#undef PG8_SB
#undef PG8_STAGE
#undef PG8_LDA
#undef PG8_LDB
#undef PG8_MMA
#undef PG8_WAIT_V
#undef PG8_WAIT_L
#undef PG8_BAR
#undef PG8_SCHED
}
}
#include <hip/hip_bf16.h>
namespace attn_body {
using bf16=__hip_bfloat16;
using bf16x8=__attribute__((ext_vector_type(8)))short;
using s16x4=__attribute__((ext_vector_type(4)))short;
using f32x16=__attribute__((ext_vector_type(16)))float;
using u32x4=__attribute__((ext_vector_type(4)))unsigned;
constexpr int BATCH=8,NHEAD=16,SEQ=4096,D=64,PITI=3584,PITO=1024;
constexpr int NW=8,QBLK=32,QB=QBLK*NW,KVBLK=64,NQB=SEQ/QB;
__device__ __forceinline__ int crow(int r,int hi){return (r&3)+8*(r>>2)+4*hi;}
#define SBAR() __builtin_amdgcn_sched_barrier(0)
__device__ __forceinline__ void cmask(f32x16&p0,f32x16&p1,int jb,int qrel,int hi){
  const float NEG=-INFINITY; int kb=64*jb+4*hi;
  #pragma unroll
  for(int r=0;r<16;++r){int kv=kb+(r&3)+8*(r>>2); if(kv>qrel)p0[r]=NEG; if(kv+32>qrel)p1[r]=NEG;}
}

constexpr int NSLOT=3, SLOTB=8192;
constexpr int LDS_K=0, LDS_V=NSLOT*SLOTB, LDS_WS=2*NSLOT*SLOTB, LDS_OST=LDS_WS+NW*64*4, LDS_BYTES=LDS_OST+NW*4096;
constexpr float C2=0.125f*1.4426950408889634f;
__device__ __forceinline__ void glds16(const void*gsrc,unsigned lds_dst){unsigned keep;
  asm volatile("s_mov_b32 %0, m0\n\ts_mov_b32 m0, %2\n\ts_nop 0\n\tglobal_load_lds_dwordx4 %1, off\n\ts_mov_b32 m0, %0":"=&s"(keep):"v"(gsrc),"s"(lds_dst):"memory");}
__device__ __forceinline__ float max3f(float a,float b,float c){float r;asm("v_max3_f32 %0, %1, %2, %3":"=v"(r):"v"(a),"v"(b),"v"(c));return r;}
__device__ __forceinline__ float max2f(float a,float b){float r;asm("v_max_f32_e32 %0, %1, %2":"=v"(r):"v"(a),"v"(b));return r;}
__device__ __forceinline__ float fadd_s(float a,float b){float r;asm("v_add_f32_e32 %0, %1, %2":"=v"(r):"v"(a),"v"(b));return r;}
__device__ __forceinline__ float fsub_s(float a,float b){float r;asm("v_sub_f32_e32 %0, %1, %2":"=v"(r):"v"(a),"v"(b));return r;}
typedef float f32x2_t __attribute__((ext_vector_type(2))); typedef __bf16 bf16x2_t __attribute__((ext_vector_type(2)));
__device__ __forceinline__ unsigned cvtpk_s(float lo,float hi){f32x2_t v={lo,hi};bf16x2_t b=__builtin_convertvector(v,bf16x2_t);return __builtin_bit_cast(unsigned,b);}
#define WAIT_BAR(N) asm volatile("s_waitcnt vmcnt(" #N ") lgkmcnt(0)\n\ts_barrier":::"memory")

__device__ __forceinline__ void qkt(f32x16&p0,f32x16&p1,const char*Kslot,const bf16x8*qr,const f32x16&negm,int r32,int hi){
  const char*kb=Kslot+hi*1024+r32*16;
  #pragma unroll
  for(int d0=0;d0<4;++d0){
    const bf16x8 b0=*reinterpret_cast<const bf16x8*>(kb+d0*2048);
    const bf16x8 b1=*reinterpret_cast<const bf16x8*>(kb+d0*2048+512);
    if(d0==0){p0=__builtin_amdgcn_mfma_f32_32x32x16_bf16(b0,qr[0],negm,0,0,0);p1=__builtin_amdgcn_mfma_f32_32x32x16_bf16(b1,qr[0],negm,0,0,0);}
    else{p0=__builtin_amdgcn_mfma_f32_32x32x16_bf16(b0,qr[d0],p0,0,0,0);p1=__builtin_amdgcn_mfma_f32_32x32x16_bf16(b1,qr[d0],p1,0,0,0);}}
}
typedef __attribute__((address_space(3))) const char* lds_cptr;
typedef short v4i16_t __attribute__((ext_vector_type(4)));
__device__ __forceinline__ void kload8(bf16x8*kf,lds_cptr kp){
  kf[0]=*(const __attribute__((address_space(3))) bf16x8*)(kp);      kf[1]=*(const __attribute__((address_space(3))) bf16x8*)(kp+512);
  kf[2]=*(const __attribute__((address_space(3))) bf16x8*)(kp+2048); kf[3]=*(const __attribute__((address_space(3))) bf16x8*)(kp+2560);
  kf[4]=*(const __attribute__((address_space(3))) bf16x8*)(kp+4096); kf[5]=*(const __attribute__((address_space(3))) bf16x8*)(kp+4608);
  kf[6]=*(const __attribute__((address_space(3))) bf16x8*)(kp+6144); kf[7]=*(const __attribute__((address_space(3))) bf16x8*)(kp+6656);
}
__device__ __forceinline__ void kload2(bf16x8*kf,lds_cptr kp,int j){ kf[2*j]=*(const __attribute__((address_space(3))) bf16x8*)(kp+j*2048); kf[2*j+1]=*(const __attribute__((address_space(3))) bf16x8*)(kp+j*2048+512); }
__device__ __forceinline__ s16x4 vtr(lds_cptr p){ return __builtin_bit_cast(s16x4,__builtin_amdgcn_ds_read_tr16_b64_v4i16((__attribute__((address_space(3))) v4i16_t*)p)); }
__device__ __forceinline__ float rowmax(const f32x16&p0,const f32x16&p1){
  float a=max3f(p0[0],p0[1],p1[0]),b=max3f(p0[2],p0[3],p1[1]);a=max3f(a,p1[2],p1[3]);
  #pragma unroll
  for(int r=4;r<16;r+=4){a=max3f(a,p0[r],p0[r+1]);b=max3f(b,p0[r+2],p0[r+3]);a=max3f(a,p1[r],p1[r+1]);b=max3f(b,p1[r+2],p1[r+3]);}
  const float m=max2f(a,b);
  auto rr=__builtin_amdgcn_permlane32_swap(__float_as_uint(m),__float_as_uint(m),false,false);
  return max2f(__uint_as_float(rr[0]),__uint_as_float(rr[1]));
}
__device__ __forceinline__ void pv(f32x16*o,int vb,bf16x8 pa0,bf16x8 pa1,bf16x8 pa2,bf16x8 pa3){
  #pragma unroll
  for(int d0=0;d0<2;++d0){s16x4 lo[4],hi[4];
    #pragma unroll
    for(int ks=0;ks<4;++ks){
      asm volatile("ds_read_b64_tr_b16 %0,%1 offset:%c2":"=&v"(lo[ks]):"v"(vb),"i"(d0*4096+ks*1024):"memory");
      asm volatile("ds_read_b64_tr_b16 %0,%1 offset:%c2":"=&v"(hi[ks]):"v"(vb),"i"(d0*4096+ks*1024+512):"memory");}
    asm volatile("s_waitcnt lgkmcnt(0)":::"memory");SBAR();
    #define PK(k) (bf16x8){lo[k][0],lo[k][1],lo[k][2],lo[k][3],hi[k][0],hi[k][1],hi[k][2],hi[k][3]}
    o[d0]=__builtin_amdgcn_mfma_f32_32x32x16_bf16(pa0,PK(0),o[d0],0,0,0);
    o[d0]=__builtin_amdgcn_mfma_f32_32x32x16_bf16(pa1,PK(1),o[d0],0,0,0);
    o[d0]=__builtin_amdgcn_mfma_f32_32x32x16_bf16(pa2,PK(2),o[d0],0,0,0);
    o[d0]=__builtin_amdgcn_mfma_f32_32x32x16_bf16(pa3,PK(3),o[d0],0,0,0);
    #undef PK
  }
}

#ifndef ATTN_STORE16
#define ATTN_STORE16(p,v) (*(u32x4*)(p)=(v))
#endif
template<int THRL> __device__ __forceinline__ void attn_unit(int b,int h,int qb,const bf16*Q,const bf16*__restrict__ K,const bf16*__restrict__ V,bf16*O,char*shm){
  const int tid=otid_(),lane=tid&63,r32=lane&31,hi=lane>>5; const int wid=__builtin_amdgcn_readfirstlane(tid>>6);
  const long rowbase=(long)b*SEQ; const int q0=qb*QB;
  const bf16*Qw=Q+(rowbase+q0+wid*QBLK)*PITI;
  const bf16*Kh=K+rowbase*PITI,*Vh=V+rowbase*PITI;
  const unsigned lds0=(unsigned)(uintptr_t)shm;
  float*wsf=(float*)(shm+LDS_WS)+wid*64;
  const bf16*ksrc=Kh+(long)lane*PITI+wid*8;
  const bf16*vsrc=Vh+(long)(16*(wid&3)+(lane>>2))*PITI+(wid>>2)*32+(lane&3)*8;
  const unsigned kdst=lds0+LDS_K+wid*1024, vdst=lds0+LDS_V+wid*1024;
  #define DMA_K(t,slot) glds16(ksrc+(long)(t)*KVBLK*PITI,(unsigned)__builtin_amdgcn_readfirstlane(kdst+(slot)))
  #define DMA_V(t,slot) glds16(vsrc+(long)(t)*KVBLK*PITI,(unsigned)__builtin_amdgcn_readfirstlane(vdst+(slot)))
  const int vb0=(int)(lds0+LDS_V)+((lane>>4)&1)*32+(lane&3)*8+(4*hi+((lane&15)>>2))*64;
  const char*Kbase=shm+LDS_K; bf16x8 kf[8];
  const lds_cptr shm3=(lds_cptr)shm; const lds_cptr kp0=shm3+LDS_K+hi*1024+r32*16; const lds_cptr vp0=shm3+LDS_V+((lane>>4)&1)*32+(lane&3)*8+(4*hi+((lane&15)>>2))*64;
  const int NT=(q0+QB)/KVBLK;
  DMA_K(0,0);DMA_V(0,0);DMA_K(1,SLOTB);
  bf16x8 qr[4];
  #pragma unroll
  for(int d0=0;d0<4;++d0)qr[d0]=*reinterpret_cast<const bf16x8*>(&Qw[(long)r32*PITI+d0*16+hi*8]);
  float mhat=0.f,l_reg=0.f;f32x16 o[2];o[0]=f32x16{};o[1]=f32x16{};f32x16 negm=f32x16{};asm volatile("":"+v"(negm));
  const int qrel=wid*QBLK+r32;
  #define CMASK(P0,P1,t) do{int jb_=(t)-(NT-4); if(jb_>=0)cmask(P0,P1,jb_,qrel,hi);}while(0)
  bool resc=false;
  #define START(P0,P1) do{ const float rm=rowmax(P0,P1); resc=false; \
    { const float dl=rm; mhat=fadd_s(mhat,dl); \
      _Pragma("unroll") for(int r=0;r<16;++r){P0[r]=fsub_s(P0[r],dl);P1[r]=fsub_s(P1[r],dl);} \
      _Pragma("unroll") for(int r=0;r<16;++r)negm[r]=-mhat; asm volatile("":"+v"(negm)); } \
    _Pragma("unroll") for(int r=0;r<16;++r)P0[r]=__builtin_amdgcn_exp2f(P0[r]); }while(0)
  #define RESC() do{ if(resc){ asm volatile("s_waitcnt lgkmcnt(0)":::"memory"); \
      _Pragma("unroll") for(int d_=0;d_<2;++d_) _Pragma("unroll") for(int r=0;r<16;++r)o[d_][r]*=wsf[crow(r,hi)]; } }while(0)
  f32x16 pA0,pA1,pB0,pB1;
  int sl_prev=0,sl_cur=0,sl_next=SLOTB;
  #define ROT() do{sl_prev=sl_cur;sl_cur=sl_next;sl_next=(sl_next==(NSLOT-1)*SLOTB)?0:sl_next+SLOTB;}while(0)
  DMA_K(2,2*SLOTB);
  WAIT_BAR(3);
  qkt(pA0,pA1,Kbase,qr,negm,r32,hi);asm volatile("s_nop 15\n\ts_nop 7":"+v"(pA0),"+v"(pA1));CMASK(pA0,pA1,0);
  START(pA0,pA1);
  _Pragma("unroll") for(int r=0;r<16;++r)pA1[r]=__builtin_amdgcn_exp2f(pA1[r]);
  WAIT_BAR(0);
  DMA_K(3,0);DMA_V(1,SLOTB);
  ROT();
  kload8(kf,kp0+sl_cur);
  WAIT_BAR(2);
  s16x4 vlo[8],vhi[8]; u32x4 pw0,pw1,pw2,pw3;
  #define PKW(P,B) cvtpk_s(P[B],P[B+1])
  #define PAF(k) __builtin_bit_cast(bf16x8,pw##k)
  #define VFR(i) (bf16x8){vlo[i][0],vlo[i][1],vlo[i][2],vlo[i][3],vhi[i][0],vhi[i][1],vhi[i][2],vhi[i][3]}
  #define PIN(x) asm volatile("":"+v"(x))
  #define MX3(a,b,c) __builtin_fmaxf(__builtin_fmaxf((a),(b)),(c))
  #define GAPA(MF,A0,A1,A2,A3,W0,W1,PW) do{ MF; sacc+=A0; sacc+=A1; sacc+=A2; sacc+=A3; PIN(sacc); W0; W1; PIN(PW); SBAR(); }while(0)
  #define EX(v) __builtin_amdgcn_exp2f(v)
  #define GAPB(MF,X,B) do{ MF; X[B]=EX(X[B]); X[B+1]=EX(X[B+1]); X[B+2]=EX(X[B+2]); X[B+3]=EX(X[B+3]); PIN(X); SBAR(); }while(0)
  #define VRD(i) do{ vlo[i]=vtr(vp_+(((i)>>2)*4096+((i)&3)*1024)); vhi[i]=vtr(vp_+(((i)>>2)*4096+((i)&3)*1024+512)); }while(0)
  #define KRD(G,j) do{ if(G){ kload2(kf,kp0+sl_next,j); SBAR(); } }while(0)
  #define STEP(C0,C1,P0,P1,t,GK,GV,GL) do{ SBAR(); \
    const lds_cptr vp_=vp0+sl_prev; \
    VRD(0); SBAR(); float sacc=(P0[0]+P0[1]); \
    GAPA(C0=__builtin_amdgcn_mfma_f32_32x32x16_bf16(kf[0],qr[0],negm,0,0,0), P0[2],P0[3],P0[4],P0[5],     pw0[0]=PKW(P0,0), pw0[1]=PKW(P0,2), pw0); \
    VRD(4); SBAR(); GAPA(C1=__builtin_amdgcn_mfma_f32_32x32x16_bf16(kf[1],qr[0],negm,0,0,0), P0[6],P0[7],P0[8],P0[9],     pw0[2]=PKW(P0,4), pw0[3]=PKW(P0,6), pw0); \
    VRD(1); SBAR(); GAPA(C0=__builtin_amdgcn_mfma_f32_32x32x16_bf16(kf[2],qr[1],C0,0,0,0),   P0[10],P0[11],P0[12],P0[13], pw1[0]=PKW(P0,8), pw1[1]=PKW(P0,10), pw1); \
    VRD(5); SBAR(); GAPA(C1=__builtin_amdgcn_mfma_f32_32x32x16_bf16(kf[3],qr[1],C1,0,0,0),   P0[14],P0[15],P1[0],P1[1],   pw1[2]=PKW(P0,12),pw1[3]=PKW(P0,14), pw1); \
    VRD(2); SBAR(); GAPA(C0=__builtin_amdgcn_mfma_f32_32x32x16_bf16(kf[4],qr[2],C0,0,0,0),   P1[2],P1[3],P1[4],P1[5],     pw2[0]=PKW(P1,0), pw2[1]=PKW(P1,2), pw2); \
    VRD(6); SBAR(); GAPA(C1=__builtin_amdgcn_mfma_f32_32x32x16_bf16(kf[5],qr[2],C1,0,0,0),   P1[6],P1[7],P1[8],P1[9],     pw2[2]=PKW(P1,4), pw2[3]=PKW(P1,6), pw2); \
    VRD(3); SBAR(); GAPA(C0=__builtin_amdgcn_mfma_f32_32x32x16_bf16(kf[6],qr[3],C0,0,0,0),   P1[10],P1[11],P1[12],P1[13], pw3[0]=PKW(P1,8), pw3[1]=PKW(P1,10), pw3); \
    VRD(7); SBAR(); GAPA(C1=__builtin_amdgcn_mfma_f32_32x32x16_bf16(kf[7],qr[3],C1,0,0,0),   P1[14],P1[15],0.f,0.f,       pw3[2]=PKW(P1,12),pw3[3]=PKW(P1,14), pw3); \
    l_reg+=sacc; \
    if(GK){DMA_K((t)+3,sl_cur);} if(GV){DMA_V((t)+1,sl_next);} \
    CMASK(C0,C1,t); \
    { float a=MX3(C0[0],C0[1],C1[0]),b=MX3(C0[2],C0[3],C1[1]); a=MX3(a,C1[2],C1[3]); \
      _Pragma("unroll") for(int r=4;r<16;r+=4){a=MX3(a,C0[r],C0[r+1]);b=MX3(b,C0[r+2],C0[r+3]);a=MX3(a,C1[r],C1[r+1]);b=MX3(b,C1[r+2],C1[r+3]);} \
      float rm=__builtin_fmaxf(a,b); { auto rr=__builtin_amdgcn_permlane32_swap(__float_as_uint(rm),__float_as_uint(rm),false,false); rm=__builtin_fmaxf(__uint_as_float(rr[0]),__uint_as_float(rr[1])); } \
      resc=false; \
      if(__builtin_expect(__any(rm>(float)THRL),0)){ const float dl=__builtin_fmaxf(rm,0.f); mhat+=dl; \
        _Pragma("unroll") for(int r=0;r<16;++r){C0[r]-=dl;C1[r]-=dl;} \
        _Pragma("unroll") for(int r=0;r<16;++r)negm[r]=-mhat; asm volatile("":"+v"(negm)); \
        const float f=__builtin_amdgcn_exp2f(-dl); l_reg*=f; if(hi==0)wsf[r32]=f; resc=true; } } \
    SBAR(); \
    GAPB(o[0]=__builtin_amdgcn_mfma_f32_32x32x16_bf16(PAF(0),VFR(0),o[0],0,0,0), C0,0); \
    GAPB(o[1]=__builtin_amdgcn_mfma_f32_32x32x16_bf16(PAF(0),VFR(4),o[1],0,0,0), C0,4); \
    KRD(GL,0); GAPB(o[0]=__builtin_amdgcn_mfma_f32_32x32x16_bf16(PAF(1),VFR(1),o[0],0,0,0), C0,8); \
    KRD(GL,1); GAPB(o[1]=__builtin_amdgcn_mfma_f32_32x32x16_bf16(PAF(1),VFR(5),o[1],0,0,0), C0,12); \
    KRD(GL,2); GAPB(o[0]=__builtin_amdgcn_mfma_f32_32x32x16_bf16(PAF(2),VFR(2),o[0],0,0,0), C1,0); \
    KRD(GL,3); GAPB(o[1]=__builtin_amdgcn_mfma_f32_32x32x16_bf16(PAF(2),VFR(6),o[1],0,0,0), C1,4); \
    GAPB(o[0]=__builtin_amdgcn_mfma_f32_32x32x16_bf16(PAF(3),VFR(3),o[0],0,0,0), C1,8); \
    GAPB(o[1]=__builtin_amdgcn_mfma_f32_32x32x16_bf16(PAF(3),VFR(7),o[1],0,0,0), C1,12); \
    }while(0)
  int t=1;
  #undef CMASK
  #define CMASK(P0,P1,t) do{}while(0)
  for(;t+5<NT;t+=2){
    STEP(pB0,pB1,pA0,pA1,t,true,true,true);     WAIT_BAR(2); RESC(); ROT();
    STEP(pA0,pA1,pB0,pB1,t+1,true,true,true);   WAIT_BAR(2); RESC(); ROT();
  }
  #undef CMASK
  #define CMASK(P0,P1,t) do{int jb_=(t)-(NT-4); if(jb_>=0)cmask(P0,P1,jb_,qrel,hi);}while(0)
  #define ENDW(tt) do{ if((tt)+3<NT){WAIT_BAR(2);} else if((tt)+2<NT){WAIT_BAR(1);} else {WAIT_BAR(0);} }while(0)
  for(;t+1<NT;t+=2){
    STEP(pB0,pB1,pA0,pA1,t,(t+3<NT),(t+1<NT),(t+1<NT));       ENDW(t);   RESC(); ROT();
    STEP(pA0,pA1,pB0,pB1,t+1,(t+4<NT),(t+2<NT),(t+2<NT));     ENDW(t+1); RESC(); ROT();
  }
  STEP(pB0,pB1,pA0,pA1,NT-1,false,false,false); RESC();
  { float sacc=pB0[0]+pB0[1]; _Pragma("unroll") for(int r=2;r<16;++r)sacc+=pB0[r]; _Pragma("unroll") for(int r=0;r<16;++r)sacc+=pB1[r]; l_reg+=sacc;
    pw0=(u32x4){PKW(pB0,0),PKW(pB0,2),PKW(pB0,4),PKW(pB0,6)};pw1=(u32x4){PKW(pB0,8),PKW(pB0,10),PKW(pB0,12),PKW(pB0,14)};pw2=(u32x4){PKW(pB1,0),PKW(pB1,2),PKW(pB1,4),PKW(pB1,6)};pw3=(u32x4){PKW(pB1,8),PKW(pB1,10),PKW(pB1,12),PKW(pB1,14)};
    SBAR(); pv(o,vb0+sl_cur,PAF(0),PAF(1),PAF(2),PAF(3)); }
  #undef PKW
  #undef PAF
  #undef VFR
  #undef PIN
  #undef MX3
  #undef GAPA
  #undef GAPB
  #undef EX
  #undef VRD
  #undef KRD
  #undef STEP
  #undef ENDW
  {auto rr=__builtin_amdgcn_permlane32_swap(__float_as_uint(l_reg),__float_as_uint(l_reg),false,false);l_reg=__uint_as_float(rr[0])+__uint_as_float(rr[1]);}
  if(hi==0)wsf[32+r32]=l_reg;asm volatile("s_waitcnt lgkmcnt(0)":::"memory");
  float rli[16];
  #pragma unroll
  for(int r=0;r<16;++r)rli[r]=__builtin_amdgcn_rcpf(wsf[32+crow(r,hi)]);
  bf16*Ow=O+(rowbase+q0+wid*QBLK)*PITO;
  { bf16*stg=(bf16*)(shm+LDS_OST)+wid*2048;
    #pragma unroll
    for(int r=0;r<16;++r){const int orow=crow(r,hi);
      #pragma unroll
      for(int d0=0;d0<2;++d0)stg[orow*64+d0*32+r32]=__float2bfloat16(o[d0][r]*rli[r]);}
    asm volatile("s_waitcnt lgkmcnt(0)":::"memory");
    #pragma unroll
    for(int i=0;i<4;++i){const int row=i*8+(lane>>3),ch=lane&7; const u32x4 v=*(const u32x4*)(stg+row*64+ch*8); ATTN_STORE16(Ow+(long)row*PITO+ch*8,v);} }
  asm volatile("s_waitcnt lgkmcnt(0)\n\ts_barrier":::"memory");
  #undef DMA_K
  #undef DMA_V
  #undef CMASK
  #undef START
  #undef RESC
  #undef ROT
}
constexpr int ATTN_LDS_BYTES=LDS_BYTES;
#undef SBAR
#undef WAIT_BAR
}

namespace cg = cooperative_groups;
typedef unsigned short bf16_t;
typedef float f32x4 __attribute__((ext_vector_type(4)));
typedef float f32x16 __attribute__((ext_vector_type(16)));
typedef unsigned u32x4 __attribute__((ext_vector_type(4)));
typedef unsigned u32x2 __attribute__((ext_vector_type(2)));
typedef short bf16x8 __attribute__((ext_vector_type(8)));
#define LAS3 __attribute__((address_space(3)))

constexpr int T_ = 32768, DM_ = 1024, SEQ_ = 4096, DFF_ = 2816;
constexpr int NTHR = 512;
constexpr int LDS_BYTES = 147456;
constexpr size_t MiB_ = 1u << 20;
constexpr size_t WS_MOD = 0, WS_COS = 1 * MiB_, WS_SIN = 2 * MiB_, WS_BAR = 3 * MiB_;
constexpr size_t WS_WIN = 4 * MiB_, WS_WOUT = 11 * MiB_, WS_FIN = 13 * MiB_, WS_FOUT = 24 * MiB_;
constexpr size_t WS_A = 32 * MiB_, WS_X2 = 96 * MiB_, WS_ST = 160 * MiB_, WS_TOT = 224 * MiB_, WS_R1 = 226 * MiB_, WS_END = 450 * MiB_;
constexpr size_t WS_HP = WS_ST, WS_HU = WS_ST + 12 * MiB_, WS_HA = WS_ST + 24 * MiB_;
constexpr float LOG2E_ = 1.4426950408889634f;
constexpr float QSCALE_ = 0.125f * 1.4426950408889634f;

struct Params {
    const float* x; const float* c; const int* positions; const float* mod_w; const float* mod_b; const float* norm_mix_w; const float* norm_ffn_w;
    const float* ev_w_in; const float* gla_gate_w; const float* gla_gate_b; const float* gla_norm_w; const float* swa_sinks; const float* ev_w_out;
    const float* od_w_in; const float* diff_lambda; const float* diff_norm_w; const float* hgrn_lb_logits; const float* hgrn_norm_w; const float* od_w_out;
    const float* ffn_w_in; const float* ffn_conv_w; const float* ffn_conv_b; const float* ffn_w_out; const float* final_norm_w;
    float* out; unsigned char* ws; unsigned long long pad[6];
};

__device__ __forceinline__ unsigned pk2(float lo, float hi) {
    typedef float f32x2_t __attribute__((ext_vector_type(2))); typedef __bf16 bf16x2_t __attribute__((ext_vector_type(2)));
    f32x2_t v = {lo, hi}; bf16x2_t b = __builtin_convertvector(v, bf16x2_t); return __builtin_bit_cast(unsigned, b);
}
__device__ __forceinline__ float bflo(unsigned u) { return __uint_as_float(u << 16); }
__device__ __forceinline__ float bfhi(unsigned u) { return __uint_as_float(u & 0xffff0000u); }
__device__ __forceinline__ float sigmoidf_(float x) { return __builtin_amdgcn_rcpf(1.f + __expf(-x)); }
__device__ __forceinline__ float siluf_(float x) { return x * __builtin_amdgcn_rcpf(1.f + __expf(-x)); }
__device__ __forceinline__ float wave_sum(float v) {
#pragma unroll
    for (int o = 1; o < 64; o <<= 1) v += __shfl_xor(v, o);
    return v;
}
__device__ __forceinline__ int crow_(int r, int hi) { return (r & 3) + 8 * (r >> 2) + 4 * hi; }

namespace pg8 {
struct EpiProj {
    static constexpr bool PERM = true, AFTER_DRAIN = false;
    bf16_t* O; int ldc; unsigned ropemask; unsigned scalemask; float scale; const float* cs; const float* sn;
    __device__ __forceinline__ void operator()(const f32x4 (&acc)[2][2][4][2], const Unit& u, int wr, int wc, int fr, int fq) const {
        const int row0 = u.pm * BM + wr * 64 + fr; const int col0 = u.pn * BM + wc * 32 + 8 * fq;
#pragma unroll
        for (int bj = 0; bj < 2; ++bj) {
            const int grp = u.pn * 2 + bj;
            const bool rope = ((ropemask >> grp) & 1u) && ((wc & 1) == 0);
            const float sc = ((scalemask >> grp) & 1u) ? scale : 1.f;
#pragma unroll
            for (int ai = 0; ai < 2; ++ai)
#pragma unroll
                for (int m = 0; m < 4; ++m) {
                    const int row = row0 + ai * HALF + m * 16;
                    f32x4 v0 = acc[ai][bj][m][0], v1 = acc[ai][bj][m][1];
                    if (rope) {
                        const f32x4 c0 = *(const f32x4*)(cs + (size_t)row * 8), c1 = *(const f32x4*)(cs + (size_t)row * 8 + 4);
                        const f32x4 s0 = *(const f32x4*)(sn + (size_t)row * 8), s1 = *(const f32x4*)(sn + (size_t)row * 8 + 4);
                        const float sg = (fq == 0) ? -1.f : 1.f;
#pragma unroll
                        for (int e = 0; e < 4; ++e) {
                            const float p0 = __shfl_xor(v0[e], 16), p1 = __shfl_xor(v1[e], 16);
                            const float r0 = v0[e] * c0[e] + sg * p0 * s0[e], r1 = v1[e] * c1[e] + sg * p1 * s1[e];
                            if (fq < 2) { v0[e] = r0; v1[e] = r1; }
                        }
                    }
                    v0 = v0 * sc; v1 = v1 * sc;
                    u32x4 w; w.x = pk2(v0[0], v0[1]); w.y = pk2(v0[2], v0[3]); w.z = pk2(v1[0], v1[1]); w.w = pk2(v1[2], v1[3]);
                    *(u32x4*)(O + (size_t)row * ldc + col0 + bj * HALF) = w;
                    asm volatile("" ::: "memory");
                }
        }
    }
};
struct EpiRes {
    static constexpr bool PERM = false, AFTER_DRAIN = false;
    const float* xin; float* xout; const float* gate;
    __device__ __forceinline__ void operator()(const f32x4 (&acc)[2][2][4][2], const Unit& u, int wr, int wc, int fr, int fq) const {
        const int col0 = u.pn * BM + wc * 32 + 4 * fq;
        const float* g = gate + (size_t)((u.pm * BM) >> 12) * 6144 + col0;
        f32x4 gv[2][2];
#pragma unroll
        for (int bj = 0; bj < 2; ++bj)
#pragma unroll
            for (int n = 0; n < 2; ++n) gv[bj][n] = *(const f32x4*)(g + bj * HALF + n * 16);
        const size_t off0 = (size_t)(u.pm * BM + wr * 64 + fr) * 1024 + col0;
        f32x4 xb[2][2][2];
#pragma unroll
        for (int bj = 0; bj < 2; ++bj)
#pragma unroll
            for (int n = 0; n < 2; ++n) xb[0][bj][n] = *(const f32x4*)(xin + off0 + bj * HALF + n * 16);
#pragma unroll
        for (int grp = 0; grp < 8; ++grp) {
            const int ai = grp >> 2, m = grp & 3;
            if (grp + 1 < 8) {
                const size_t offn = off0 + (size_t)(((grp + 1) >> 2) * HALF + ((grp + 1) & 3) * 16) * 1024;
#pragma unroll
                for (int bj = 0; bj < 2; ++bj)
#pragma unroll
                    for (int n = 0; n < 2; ++n) xb[(grp + 1) & 1][bj][n] = *(const f32x4*)(xin + offn + bj * HALF + n * 16);
            }
            const size_t off = off0 + (size_t)(ai * HALF + m * 16) * 1024;
#pragma unroll
            for (int bj = 0; bj < 2; ++bj)
#pragma unroll
                for (int n = 0; n < 2; ++n) *(f32x4*)(xout + off + bj * HALF + n * 16) = xb[grp & 1][bj][n] + gv[bj][n] * acc[ai][bj][m][n];
            asm volatile("" ::: "memory");
        }
    }
};
struct EpiFfn {
    static constexpr bool PERM = true, AFTER_DRAIN = false;
    bf16_t* G; float* HP; float* HU; float* HA; const float* cw; const float* cb;
    __device__ __forceinline__ void operator()(const f32x4 (&acc)[2][2][4][2], const Unit& u, int wr, int wc, int fr, int fq) const {
        const int ch0 = u.pn * 128 + wc * 32 + 8 * fq;
        f32x4 w0[2], w1[2], w2[2], bb[2];
#pragma unroll
        for (int n = 0; n < 2; ++n) { w0[n] = *(const f32x4*)(cw + ch0 + 4 * n); w1[n] = *(const f32x4*)(cw + DFF_ + ch0 + 4 * n); w2[n] = *(const f32x4*)(cw + 2 * DFF_ + ch0 + 4 * n); bb[n] = *(const f32x4*)(cb + ch0 + 4 * n); }
        const int lane = fr + 16 * fq;
        const int src1 = (lane & ~15) | ((fr + 15) & 15), src2 = (lane & ~15) | ((fr + 14) & 15);
#pragma unroll
        for (int ai = 0; ai < 2; ++ai) {
            const int seg = u.pm * 4 + ai * 2 + wr;
#pragma unroll
            for (int m = 0; m < 4; ++m) {
                const int row = u.pm * BM + ai * HALF + wr * 64 + m * 16 + fr;
                f32x4 val[2];
#pragma unroll
                for (int n = 0; n < 2; ++n) {
                    const f32x4 a = acc[ai][0][m][n];
                    f32x4 ap = (f32x4){0.f, 0.f, 0.f, 0.f};
                    if (m > 0) ap = acc[ai][0][m > 0 ? m - 1 : 0][n];
#pragma unroll
                    for (int e = 0; e < 4; ++e) {
                        const float t1 = (fr == 15) ? ap[e] : a[e];
                        const float t2 = (fr >= 14) ? ap[e] : a[e];
                        const float p1 = __shfl(t1, src1), p2 = __shfl(t2, src2);
                        val[n][e] = w2[n][e] * a[e] + w1[n][e] * p1 + w0[n][e] * p2 + bb[n][e];
                    }
                }
                const f32x4 u0 = acc[ai][1][m][0], u1 = acc[ai][1][m][1];
                f32x4 g0, g1;
#pragma unroll
                for (int e = 0; e < 4; ++e) { g0[e] = siluf_(val[0][e]) * u0[e]; g1[e] = siluf_(val[1][e]) * u1[e]; }
                u32x4 w; w.x = pk2(g0[0], g0[1]); w.y = pk2(g0[2], g0[3]); w.z = pk2(g1[0], g1[1]); w.w = pk2(g1[2], g1[3]);
                *(u32x4*)(G + (size_t)row * DFF_ + ch0) = w;
                if (m == 0 && fr < 2) {
                    const size_t ho = (size_t)(seg * 2 + fr) * DFF_ + ch0;
                    *(f32x4*)(HP + ho) = val[0]; *(f32x4*)(HP + ho + 4) = val[1];
                    *(f32x4*)(HU + ho) = u0; *(f32x4*)(HU + ho + 4) = u1;
                }
                if (m == 3 && fr >= 14) {
                    const size_t ho = (size_t)(seg * 2 + (fr - 14)) * DFF_ + ch0;
                    *(f32x4*)(HA + ho) = acc[ai][0][3][0]; *(f32x4*)(HA + ho + 4) = acc[ai][0][3][1];
                }
                asm volatile("" ::: "memory");
            }
        }
    }
};
}

struct Ctx { Params p; unsigned char* lds; int tid, lane, wave, gw, ngw; };

__device__ __forceinline__ void phase_prologue(const Ctx& C) {
    const Params& p = C.p;
    float* cact = (float*)C.lds;
    float* red = (float*)(C.lds + 32768);
    float* mod = (float*)(p.ws + WS_MOD);
    const int tid = C.tid;
    for (int i = tid; i < 8192; i += NTHR) { const float c = p.c[i]; cact[i] = c / (1.f + __expf(-c)); }
    __syncthreads();
    const int col = tid & 63, kp = tid >> 6;
    for (int g = blockIdx.x; g < 384; g += gridDim.x) {
        const int l = g / 96, j = (g % 96) * 64 + col;
        const float* w = p.mod_w + (size_t)l * 1024 * 6144 + (size_t)(kp * 128) * 6144 + j;
        float a0 = 0.f, a1 = 0.f, a2 = 0.f, a3 = 0.f, a4 = 0.f, a5 = 0.f, a6 = 0.f, a7 = 0.f;
        const float* ca = cact + kp * 128;
#pragma unroll 8
        for (int k = 0; k < 128; ++k) {
            const float wv = w[(size_t)k * 6144];
            a0 += ca[k] * wv; a1 += ca[1024 + k] * wv; a2 += ca[2048 + k] * wv; a3 += ca[3072 + k] * wv;
            a4 += ca[4096 + k] * wv; a5 += ca[5120 + k] * wv; a6 += ca[6144 + k] * wv; a7 += ca[7168 + k] * wv;
        }
        float* r = red + (kp * 8) * 64 + col;
        r[0] = a0; r[64] = a1; r[128] = a2; r[192] = a3; r[256] = a4; r[320] = a5; r[384] = a6; r[448] = a7;
        __syncthreads();
        { const int b = tid >> 6; float s = 0.f;
#pragma unroll
          for (int kk = 0; kk < 8; ++kk) s += red[(kk * 8 + b) * 64 + col];
          mod[(size_t)(l * 8 + b) * 6144 + j] = s + p.mod_b[l * 6144 + j]; }
        __syncthreads();
    }
    float* cs = (float*)(p.ws + WS_COS); float* sn = (float*)(p.ws + WS_SIN);
    const float invf[8] = {1.0f, 0.1939227432012558f, 0.03760603070259094f, 0.007292664609849453f, 0.0014142135623842478f, 0.00027424818836152554f, 5.3182957344688475e-05f, 1.0313385246263351e-05f};
    for (int r = blockIdx.x * NTHR + tid; r < T_; r += gridDim.x * NTHR) {
        const float pos = (float)p.positions[r];
        f32x4 c4[2], s4[2];
#pragma unroll
        for (int i = 0; i < 8; ++i) {
            const float ang = pos * invf[i];
            const double xr = (double)ang * 0.15915494309189535;
            const float f = (float)(xr - rint(xr));
            c4[i >> 2][i & 3] = __builtin_amdgcn_cosf(f); s4[i >> 2][i & 3] = __builtin_amdgcn_sinf(f);
        }
        *(f32x4*)(cs + (size_t)r * 8) = c4[0]; *(f32x4*)(cs + (size_t)r * 8 + 4) = c4[1];
        *(f32x4*)(sn + (size_t)r * 8) = s4[0]; *(f32x4*)(sn + (size_t)r * 8 + 4) = s4[1];
    }
}

__device__ __forceinline__ void tr_item(const float* W, int Nsrc, int srccol0, bf16_t* WT, int K, int dstrow0, int k0, float* scr, int lane) {
#pragma unroll 8
    for (int i = 0; i < 32; ++i) { const int kk = 2 * i + (lane >> 5); scr[kk * 33 + (lane & 31)] = W[(size_t)(k0 + kk) * Nsrc + srccol0 + (lane & 31)]; }
    asm volatile("s_waitcnt lgkmcnt(0)" ::: "memory");
    const int c = lane & 7;
#pragma unroll
    for (int j = 0; j < 4; ++j) { const int n = (lane >> 3) + 8 * j; const float* s = scr + (8 * c) * 33 + n;
        u32x4 o; o.x = pk2(s[0 * 33], s[1 * 33]); o.y = pk2(s[2 * 33], s[3 * 33]); o.z = pk2(s[4 * 33], s[5 * 33]); o.w = pk2(s[6 * 33], s[7 * 33]);
        *(u32x4*)(WT + (size_t)(dstrow0 + n) * K + k0 + 8 * c) = o; }
    asm volatile("s_waitcnt lgkmcnt(0)" ::: "memory");
}
__device__ __forceinline__ void phase_convert(const Ctx& C, int l) {
    const Params& p = C.p; const int j = l >> 1; const bool even = !(l & 1);
    float* scr = (float*)(C.lds + C.wave * 16384);
    bf16_t* WIN = (bf16_t*)(p.ws + WS_WIN); bf16_t* WOUT = (bf16_t*)(p.ws + WS_WOUT); bf16_t* FIN = (bf16_t*)(p.ws + WS_FIN); bf16_t* FOUT = (bf16_t*)(p.ws + WS_FOUT);
    const int nA = even ? 80 : 112;
    const int IA = 16 * nA, IB = 16 * 32, IC = 16 * 176, ID = 44 * 32;
    const float* win = even ? p.ev_w_in + (size_t)j * 1024 * 2320 : p.od_w_in + (size_t)j * 1024 * 3584;
    const float* wout = even ? p.ev_w_out + (size_t)j * 1024 * 1024 : p.od_w_out + (size_t)j * 1024 * 1024;
    const float* fin = p.ffn_w_in + (size_t)l * 1024 * 5632; const float* fout = p.ffn_w_out + (size_t)l * 2816 * 1024;
    for (int it = C.gw; it < IA + IB + IC + ID; it += C.ngw) {
        int r = it;
        if (r < IA) { const int kb = r / nA, nb = r % nA, n0 = nb * 32; int sc = n0;
            if (even) { if (n0 >= 512 && n0 < 768) continue; if (n0 >= 1792) sc = n0 - 240; else if (n0 >= 768) sc = n0 - 256; }
            tr_item(win, even ? 2320 : 3584, sc, WIN, 1024, n0, kb * 64, scr, C.lane); continue; }
        r -= IA;
        if (r < IB) { const int kb = r / 32, nb = r % 32; tr_item(wout, 1024, nb * 32, WOUT, 1024, nb * 32, kb * 64, scr, C.lane); continue; }
        r -= IB;
        if (r < IC) { const int kb = r / 176, nb = r % 176, n0 = nb * 32; const int pn = n0 >> 8, jj = n0 & 255;
            const int sc = (jj < 128) ? pn * 128 + jj : 2816 + pn * 128 + (jj - 128);
            tr_item(fin, 5632, sc, FIN, 1024, n0, kb * 64, scr, C.lane); continue; }
        r -= IC;
        { const int kb = r / 32, nb = r % 32; tr_item(fout, 1024, nb * 32, FOUT, 2816, nb * 32, kb * 64, scr, C.lane); }
    }
    if (even) {
        const float* gw = p.gla_gate_w + (size_t)j * 16 * 256;
        for (int u = blockIdx.x * NTHR + C.tid; u < 256 * 128; u += gridDim.x * NTHR) {
            const int k8 = u & 127, n = u >> 7;
            float g[16];
#pragma unroll
            for (int r = 0; r < 16; ++r) g[r] = gw[r * 256 + n];
            float o[8];
#pragma unroll
            for (int e = 0; e < 8; ++e) {
                const float* wr = win + (size_t)(k8 * 8 + e) * 2320 + 1536;
                const f32x4 a0 = *(const f32x4*)wr, a1 = *(const f32x4*)(wr + 4), a2 = *(const f32x4*)(wr + 8), a3 = *(const f32x4*)(wr + 12);
                o[e] = a0[0] * g[0] + a0[1] * g[1] + a0[2] * g[2] + a0[3] * g[3] + a1[0] * g[4] + a1[1] * g[5] + a1[2] * g[6] + a1[3] * g[7]
                     + a2[0] * g[8] + a2[1] * g[9] + a2[2] * g[10] + a2[3] * g[11] + a3[0] * g[12] + a3[1] * g[13] + a3[2] * g[14] + a3[3] * g[15];
            }
            u32x4 w; w.x = pk2(o[0], o[1]); w.y = pk2(o[2], o[3]); w.z = pk2(o[4], o[5]); w.w = pk2(o[6], o[7]);
            *(u32x4*)(WIN + (size_t)(512 + n) * 1024 + k8 * 8) = w;
        }
    }
}

__device__ __forceinline__ void phase_norm(const Ctx& C, const float* xin, const float* w, const float* modl, int shoff, int scoff, bf16_t* out) {
    for (int row = C.gw; row < T_; row += C.ngw) {
        const f32x4* xr = (const f32x4*)(xin + (size_t)row * 1024) + C.lane;
        f32x4 v[4]; float ss = 0.f;
#pragma unroll
        for (int j = 0; j < 4; ++j) { v[j] = xr[64 * j]; ss += (v[j].x * v[j].x + v[j].y * v[j].y) + (v[j].z * v[j].z + v[j].w * v[j].w); }
        const float rs = rsqrtf(wave_sum(ss) * (1.f / 1024.f) + 1e-6f);
        const float* mb = modl + (size_t)(row >> 12) * 6144;
        u32x2* o8 = (u32x2*)(out + (size_t)row * 1024) + C.lane;
#pragma unroll
        for (int j = 0; j < 4; ++j) {
            const int col = 4 * C.lane + 256 * j;
            const f32x4 w4 = *(const f32x4*)(w + col), sc = *(const f32x4*)(mb + scoff + col), sh = *(const f32x4*)(mb + shoff + col);
            const f32x4 y = (v[j] * rs) * w4 * (sc + 1.f) + sh;
            u32x2 q; q.x = pk2(y.x, y.y); q.y = pk2(y.z, y.w); o8[64 * j] = q;
        }
    }
}
__device__ __forceinline__ void phase_final_norm(const Ctx& C, float* x, const float* w) {
    for (int row = C.gw; row < T_; row += C.ngw) {
        f32x4* xr = (f32x4*)(x + (size_t)row * 1024) + C.lane;
        f32x4 v[4]; float ss = 0.f;
#pragma unroll
        for (int j = 0; j < 4; ++j) { v[j] = xr[64 * j]; ss += (v[j].x * v[j].x + v[j].y * v[j].y) + (v[j].z * v[j].z + v[j].w * v[j].w); }
        const float rs = rsqrtf(wave_sum(ss) * (1.f / 1024.f) + 1e-6f);
#pragma unroll
        for (int j = 0; j < 4; ++j) { const f32x4 w4 = *(const f32x4*)(w + 4 * C.lane + 256 * j); xr[64 * j] = (v[j] * rs) * w4; }
    }
}

__device__ __forceinline__ void phase_diff_combine(const Ctx& C, int l) {
    const Params& p = C.p; const int j = l >> 1;
    const float lam_init = 0.8f - 0.6f * expf(-0.3f * (float)l);
    const float* lv = p.diff_lambda + j * 256;
    const float s1 = wave_sum(lv[C.lane] * lv[64 + C.lane]), s2 = wave_sum(lv[128 + C.lane] * lv[192 + C.lane]);
    const float lam = expf(s1) - expf(s2) + lam_init;
    const bf16_t* X2 = (const bf16_t*)(p.ws + WS_X2); bf16_t* A = (bf16_t*)(p.ws + WS_A);
    const int head = C.lane >> 4, d0 = (C.lane & 15) * 8;
    const float* nw = p.diff_norm_w + j * 128 + d0;
    const f32x4 n0 = *(const f32x4*)nw, n1 = *(const f32x4*)(nw + 4);
    const float og = 1.f - lam_init;
    for (int row = C.gw; row < T_; row += C.ngw) {
        const bf16_t* src = X2 + (size_t)row * 1024 + head * 256 + d0;
        const u32x4 a = *(const u32x4*)src, b = *(const u32x4*)(src + 128);
        float od[8];
        od[0] = bflo(a.x) - lam * bflo(b.x); od[1] = bfhi(a.x) - lam * bfhi(b.x); od[2] = bflo(a.y) - lam * bflo(b.y); od[3] = bfhi(a.y) - lam * bfhi(b.y);
        od[4] = bflo(a.z) - lam * bflo(b.z); od[5] = bfhi(a.z) - lam * bfhi(b.z); od[6] = bflo(a.w) - lam * bflo(b.w); od[7] = bfhi(a.w) - lam * bfhi(b.w);
        float ss = 0.f;
#pragma unroll
        for (int e = 0; e < 8; ++e) ss += od[e] * od[e];
        ss += __shfl_xor(ss, 1); ss += __shfl_xor(ss, 2); ss += __shfl_xor(ss, 4); ss += __shfl_xor(ss, 8);
        const float rs = rsqrtf(ss * (1.f / 128.f) + 1e-6f) * og;
        u32x4 w; w.x = pk2(od[0] * rs * n0[0], od[1] * rs * n0[1]); w.y = pk2(od[2] * rs * n0[2], od[3] * rs * n0[3]);
        w.z = pk2(od[4] * rs * n1[0], od[5] * rs * n1[1]); w.w = pk2(od[6] * rs * n1[2], od[7] * rs * n1[3]);
        *(u32x4*)(A + (size_t)row * 1024 + head * 128 + d0) = w;
    }
}

__device__ __forceinline__ void phase_ffn_fixup(const Ctx& C, int l) {
    const Params& p = C.p;
    const float* HP = (const float*)(p.ws + WS_HP); const float* HU = (const float*)(p.ws + WS_HU); const float* HA = (const float*)(p.ws + WS_HA);
    bf16_t* G = (bf16_t*)(p.ws + WS_R1);
    const float* cw = p.ffn_conv_w + (size_t)l * 3 * DFF_;
    for (int u = blockIdx.x * NTHR + C.tid; u < 512 * 2 * 704; u += gridDim.x * NTHR) {
        const int c4 = u % 704, sj = u / 704, jj = sj & 1, seg = sj >> 1, ch = c4 * 4;
        const size_t ho = (size_t)sj * DFF_ + ch;
        f32x4 val = *(const f32x4*)(HP + ho); const f32x4 uu = *(const f32x4*)(HU + ho);
        if ((seg & 63) != 0) {
            const f32x4 am1 = *(const f32x4*)(HA + (size_t)((seg - 1) * 2 + 1) * DFF_ + ch), am2 = *(const f32x4*)(HA + (size_t)((seg - 1) * 2) * DFF_ + ch);
            const f32x4 w0 = *(const f32x4*)(cw + ch), w1 = *(const f32x4*)(cw + DFF_ + ch);
            if (jj == 0) val = val + w1 * am1 + w0 * am2; else val = val + w0 * am1;
        }
        u32x2 q; q.x = pk2(siluf_(val.x) * uu.x, siluf_(val.y) * uu.y); q.y = pk2(siluf_(val.z) * uu.z, siluf_(val.w) * uu.w);
        *(u32x2*)(G + (size_t)(seg * 64 + jj) * DFF_ + ch) = q;
    }
}

__device__ __forceinline__ void phase_swa(const Ctx& C, int l) {
    const Params& p = C.p;
    const bf16_t* proj = (const bf16_t*)(p.ws + WS_R1); bf16_t* A = (bf16_t*)(p.ws + WS_A);
    bf16_t* Ks = (bf16_t*)C.lds;
    bf16_t* Vt = (bf16_t*)(C.lds + 27648);
    const int tid = C.tid, lane = C.lane, wid = C.wave, r32 = lane & 31, hi = lane >> 5;
    const float* sinks = p.swa_sinks + (l >> 1) * 8;
    for (int u = blockIdx.x; u < 1024; u += gridDim.x) {
        const int b = u >> 7, kvh = (u >> 6) & 1, qb = u & 63, q0 = qb * 64; const size_t rowbase = (size_t)b * SEQ_;
        for (int c = tid; c < 1536; c += NTHR) {
            const int kk = c >> 3, ch = c & 7, pl = q0 - 128 + kk;
            u32x4 kv = (u32x4){0u, 0u, 0u, 0u}, vv = (u32x4){0u, 0u, 0u, 0u};
            if (pl >= 0) { const bf16_t* src = proj + (rowbase + pl) * 2560 + 2304 + kvh * 64 + ch * 8; kv = *(const u32x4*)src; vv = *(const u32x4*)(src + 128); }
            *(u32x4*)(Ks + kk * 72 + ch * 8) = kv;
            bf16_t* vd = Vt + (ch * 8) * 200 + kk;
            vd[0] = (bf16_t)(vv.x & 0xffffu); vd[200] = (bf16_t)(vv.x >> 16); vd[400] = (bf16_t)(vv.y & 0xffffu); vd[600] = (bf16_t)(vv.y >> 16);
            vd[800] = (bf16_t)(vv.z & 0xffffu); vd[1000] = (bf16_t)(vv.z >> 16); vd[1200] = (bf16_t)(vv.w & 0xffffu); vd[1400] = (bf16_t)(vv.w >> 16);
        }
        __syncthreads();
        const int g = wid >> 1, qh = kvh * 4 + g, qhalf = wid & 1, pq = q0 + 32 * qhalf + r32;
        const bf16_t* qsrc = proj + (rowbase + pq) * 2560 + 1792 + qh * 64;
        bf16x8 qr[4];
#pragma unroll
        for (int d0 = 0; d0 < 4; ++d0) qr[d0] = *(const bf16x8*)(qsrc + d0 * 16 + hi * 8);
        f32x16 s[5];
#pragma unroll
        for (int t = 0; t < 5; ++t) {
            f32x16 a = {};
#pragma unroll
            for (int d0 = 0; d0 < 4; ++d0) {
                const bf16x8 kf = *(const bf16x8*)(Ks + (32 * (qhalf + t) + r32) * 72 + d0 * 16 + hi * 8);
                a = __builtin_amdgcn_mfma_f32_32x32x16_bf16(kf, qr[d0], a, 0, 0, 0);
            }
            s[t] = a;
        }
        const float sink2 = sinks[qh] * LOG2E_;
        float mx = sink2;
#pragma unroll
        for (int t = 0; t < 5; ++t)
#pragma unroll
            for (int r = 0; r < 16; ++r) {
                const int pk = q0 - 128 + 32 * (qhalf + t) + crow_(r, hi);
                const bool valid = (pk >= 0) && (pk <= pq) && (pq - pk < 128);
                const float v = valid ? s[t][r] : -INFINITY; s[t][r] = v; mx = fmaxf(mx, v);
            }
        mx = fmaxf(mx, __shfl_xor(mx, 32));
        float sum = 0.f;
#pragma unroll
        for (int t = 0; t < 5; ++t)
#pragma unroll
            for (int r = 0; r < 16; ++r) { const float e = __builtin_amdgcn_exp2f(s[t][r] - mx); s[t][r] = e; sum += e; }
        sum += __shfl_xor(sum, 32);
        sum += __builtin_amdgcn_exp2f(sink2 - mx);
        const float inv = 1.f / sum;
        f32x16 o[2]; o[0] = f32x16{}; o[1] = f32x16{};
#pragma unroll
        for (int t = 0; t < 5; ++t)
#pragma unroll
            for (int ss = 0; ss < 2; ++ss) {
                u32x4 pw; pw.x = pk2(s[t][8 * ss + 0], s[t][8 * ss + 1]); pw.y = pk2(s[t][8 * ss + 2], s[t][8 * ss + 3]); pw.z = pk2(s[t][8 * ss + 4], s[t][8 * ss + 5]); pw.w = pk2(s[t][8 * ss + 6], s[t][8 * ss + 7]);
                const bf16x8 pf = __builtin_bit_cast(bf16x8, pw);
#pragma unroll
                for (int dt = 0; dt < 2; ++dt) {
                    const bf16_t* vp = Vt + (32 * dt + r32) * 200 + 32 * (qhalf + t) + 16 * ss + 4 * hi;
                    const u32x2 lo = *(const u32x2*)vp, h2 = *(const u32x2*)(vp + 8);
                    u32x4 vw; vw.x = lo.x; vw.y = lo.y; vw.z = h2.x; vw.w = h2.y;
                    o[dt] = __builtin_amdgcn_mfma_f32_32x32x16_bf16(__builtin_bit_cast(bf16x8, vw), pf, o[dt], 0, 0, 0);
                }
            }
        bf16_t* orow = A + (rowbase + pq) * 1024 + 512 + qh * 64;
#pragma unroll
        for (int dt = 0; dt < 2; ++dt)
#pragma unroll
            for (int g4 = 0; g4 < 4; ++g4) {
                u32x2 q; q.x = pk2(o[dt][4 * g4] * inv, o[dt][4 * g4 + 1] * inv); q.y = pk2(o[dt][4 * g4 + 2] * inv, o[dt][4 * g4 + 3] * inv);
                *(u32x2*)(orow + 32 * dt + 8 * g4 + 4 * hi) = q;
            }
        __syncthreads();
    }
}

template <int MODE> struct LaCfg {
    static constexpr int DK = MODE ? 128 : 64, LQ = DK + 8, LG = DK + 4, PITCH = MODE ? 3584 : 2560, NG = DK / 8;
    static constexpr int QCOL = MODE ? 1536 : 0, KCOL = MODE ? 0 : 256, ZCOL = MODE ? 2048 : 512, VCOL = MODE ? 2560 : 768, GCOL = MODE ? 3072 : 1280, OCOL = MODE ? 512 : 0;
    static constexpr int O_QB = 0, O_KB = O_QB + 64 * LQ * 2, O_GF = O_KB + 64 * LQ * 2, O_VT = O_GF + 64 * LG * 4, O_SC = O_VT + 128 * 72 * 2, O_QE = O_SC + 64 * 72 * 2,
                         O_KT = O_QE + 64 * LQ * 2  , O_SEG = O_KT + DK * 72 * 2, O_RED = O_SEG + 8 * 128 * 4, O_PAR = O_RED + 8 * 64 * 4, O_END = O_PAR + 128 * 4;
    static_assert(O_END <= LDS_BYTES, "LA LDS map");
};
__device__ __forceinline__ void unpack8(const u32x4 w, float (&f)[8]) { f[0] = bflo(w.x); f[1] = bfhi(w.x); f[2] = bflo(w.y); f[3] = bfhi(w.y); f[4] = bflo(w.z); f[5] = bfhi(w.z); f[6] = bflo(w.w); f[7] = bfhi(w.w); }
__device__ __forceinline__ u32x4 pack8(const float (&f)[8]) { u32x4 w; w.x = pk2(f[0], f[1]); w.y = pk2(f[2], f[3]); w.z = pk2(f[4], f[5]); w.w = pk2(f[6], f[7]); return w; }
__device__ __forceinline__ void ld8f(const float* p, float (&f)[8]) { const f32x4 a = *(const f32x4*)p, b = *(const f32x4*)(p + 4); f[0] = a[0]; f[1] = a[1]; f[2] = a[2]; f[3] = a[3]; f[4] = b[0]; f[5] = b[1]; f[6] = b[2]; f[7] = b[3]; }

template <int MODE> struct LaRaw { static constexpr int NI = 64 * LaCfg<MODE>::NG / NTHR; u32x4 z[NI], k[NI], q[NI], v[2]; };
template <int MODE, bool NEEDQ> __device__ __forceinline__ void la_fetch(const Ctx& C, int b, int h, int c, LaRaw<MODE>& R) {
    typedef LaCfg<MODE> Cf; const bf16_t* proj = (const bf16_t*)(C.p.ws + WS_R1);
    const size_t row0 = (size_t)b * SEQ_ + (size_t)c * 64;
#pragma unroll
    for (int it = 0; it < LaRaw<MODE>::NI; ++it) {
        const int u = C.tid + it * NTHR, r = u / Cf::NG, kk = (u % Cf::NG) * 8;
        const bf16_t* rp = proj + (row0 + r) * Cf::PITCH + h * Cf::DK + kk;
        R.z[it] = *(const u32x4*)(rp + Cf::ZCOL);
        if (MODE == 0) R.k[it] = *(const u32x4*)(rp + Cf::KCOL);
        if (NEEDQ) R.q[it] = *(const u32x4*)(rp + Cf::QCOL);
    }
#pragma unroll
    for (int it = 0; it < 2; ++it) {
        const int u = C.tid + it * NTHR, r = u >> 4, g8 = u & 15;
        R.v[it] = *(const u32x4*)(proj + (row0 + r) * Cf::PITCH + Cf::VCOL + h * 128 + g8 * 8);
    }
}
template <int MODE, bool NEEDQ> __device__ __forceinline__ void la_store(const Ctx& C, const LaRaw<MODE>& R, const float* par, bf16_t* Qb, bf16_t* Kb, float* Gf, bf16_t* Vt) {
    typedef LaCfg<MODE> Cf;
#pragma unroll
    for (int it = 0; it < LaRaw<MODE>::NI; ++it) {
        const int u = C.tid + it * NTHR, r = u / Cf::NG, kk = (u % Cf::NG) * 8;
        float z[8], kv[8], lg[8], pc[8];
        unpack8(R.z[it], z); ld8f(par + kk, pc);
        if (MODE == 0) {
            unpack8(R.k[it], kv);
#pragma unroll
            for (int e = 0; e < 8; ++e) { const float x = z[e] + pc[e]; lg[e] = (fminf(x, 0.f) * LOG2E_ - __log2f(1.f + __expf(-fabsf(x)))) * (1.f / 16.f); }
        } else {
#pragma unroll
            for (int e = 0; e < 8; ++e) {
                const float zz = fminf(fmaxf(z[e], -60.f), 60.f), ez = __expf(-zz), sg = __builtin_amdgcn_rcpf(1.f + ez), lb = pc[e];
                lg[e] = __log2f(lb + (1.f - lb) * sg); kv[e] = (1.f - lb) * (ez * sg);
            }
        }
        *(u32x4*)(Kb + r * Cf::LQ + kk) = pack8(kv);
        float* gd = Gf + r * Cf::LG + kk;
        *(f32x4*)gd = (f32x4){lg[0], lg[1], lg[2], lg[3]}; *(f32x4*)(gd + 4) = (f32x4){lg[4], lg[5], lg[6], lg[7]};
        if (NEEDQ) {
            float q[8]; unpack8(R.q[it], q);
#pragma unroll
            for (int e = 0; e < 8; ++e) q[e] = MODE ? siluf_(q[e]) * 0.08838834764831845f : q[e] * 0.125f;
            *(u32x4*)(Qb + r * Cf::LQ + kk) = pack8(q);
        }
    }
#pragma unroll
    for (int it = 0; it < 2; ++it) {
        const int u = C.tid + it * NTHR, r = u >> 4, g8 = u & 15;
        const u32x4 w = R.v[it];
        bf16_t* vd = Vt + (g8 * 8) * 72 + r;
        vd[0] = (bf16_t)(w.x & 0xffffu); vd[72] = (bf16_t)(w.x >> 16); vd[144] = (bf16_t)(w.y & 0xffffu); vd[216] = (bf16_t)(w.y >> 16);
        vd[288] = (bf16_t)(w.z & 0xffffu); vd[360] = (bf16_t)(w.z >> 16); vd[432] = (bf16_t)(w.w & 0xffffu); vd[504] = (bf16_t)(w.w >> 16);
    }
}
template <int MODE> __device__ __forceinline__ void la_params(const Ctx& C, int l, int h, float* par) {
    typedef LaCfg<MODE> Cf; const int j = l >> 1;
    if (C.tid < Cf::DK) {
        if (MODE == 0) par[C.tid] = C.p.gla_gate_b[j * 256 + h * 64 + C.tid];
        else { const float* lg0 = C.p.hgrn_lb_logits + h * 128 + C.tid; par[C.tid] = (j == 0) ? 0.f : sigmoidf_(lg0[512] - lg0[0]); }
    }
}
template <int MODE> __device__ __forceinline__ void la_cumsum(const Ctx& C, float* Gf, float* segs) {
    typedef LaCfg<MODE> Cf; constexpr int DK = Cf::DK, NSEG = NTHR / DK, RPS = 64 / NSEG;
    const int k = C.tid % DK, seg = C.tid / DK;
    float v[RPS];
#pragma unroll
    for (int i = 0; i < RPS; ++i) v[i] = Gf[(seg * RPS + i) * Cf::LG + k];
#pragma unroll
    for (int i = 1; i < RPS; ++i) v[i] += v[i - 1];
    segs[seg * DK + k] = v[RPS - 1];
    __syncthreads();
    float off = 0.f;
#pragma unroll
    for (int s = 0; s < NSEG; ++s) { const float t = segs[s * DK + k]; off += (s < seg) ? t : 0.f; }
#pragma unroll
    for (int i = 0; i < RPS; ++i) Gf[(seg * RPS + i) * Cf::LG + k] = v[i] + off;
}

template <int MODE> __device__ __forceinline__ void phase_la_p1(const Ctx& C, int l) {
    typedef LaCfg<MODE> Cf; const Params& p = C.p; constexpr int DK = Cf::DK, LQ = Cf::LQ, LG = Cf::LG, NG = Cf::NG;
    bf16_t* Kb = (bf16_t*)(C.lds + Cf::O_KB); float* Gf = (float*)(C.lds + Cf::O_GF); bf16_t* Vt = (bf16_t*)(C.lds + Cf::O_VT);
    bf16_t* KhT = (bf16_t*)(C.lds + Cf::O_KT); float* segs = (float*)(C.lds + Cf::O_SEG);
    bf16_t* ST = (bf16_t*)(p.ws + WS_ST); float* TOT = (float*)(p.ws + WS_TOT);
    const int r16 = C.lane & 15, g = C.lane >> 4, w = C.wave;
    float* par = (float*)(C.lds + Cf::O_PAR);
    LaRaw<MODE> R; int hcur = -1;
    if ((int)blockIdx.x < 2048) la_fetch<MODE, false>(C, (int)blockIdx.x >> 8, ((int)blockIdx.x >> 6) & 3, (int)blockIdx.x & 63, R);
    for (int it = blockIdx.x; it < 2048; it += gridDim.x) {
        const int bh = it >> 6, c = it & 63, b = bh >> 2, h = bh & 3;
        if (h != hcur) { la_params<MODE>(C, l, h, par); hcur = h; __syncthreads(); }
        la_store<MODE, false>(C, R, par, nullptr, Kb, Gf, Vt);
        { const int nx = it + (int)gridDim.x; if (nx < 2048) la_fetch<MODE, false>(C, nx >> 8, (nx >> 6) & 3, nx & 63, R); }
        __syncthreads();
        la_cumsum<MODE>(C, Gf, segs);
        __syncthreads();
        for (int u = C.tid; u < 64 * NG; u += NTHR) {
            const int r = u / NG, kk = (u % NG) * 8;
            float kv[8], gj[8], gt[8];
            unpack8(*(const u32x4*)(Kb + r * LQ + kk), kv); ld8f(Gf + r * LG + kk, gj); ld8f(Gf + 63 * LG + kk, gt);
            bf16_t* kd = KhT + kk * 72 + r;
#pragma unroll
            for (int e = 0; e < 8; e += 2) { const unsigned pw = pk2(kv[e] * __builtin_amdgcn_exp2f(gt[e] - gj[e]), kv[e + 1] * __builtin_amdgcn_exp2f(gt[e + 1] - gj[e + 1]));
                kd[e * 72] = (bf16_t)(pw & 0xffffu); kd[(e + 1) * 72] = (bf16_t)(pw >> 16); }
        }
        if (C.tid < DK) TOT[(size_t)it * 128 + C.tid] = Gf[63 * LG + C.tid];
        __syncthreads();
        {
            const bf16x8 b0 = *(const bf16x8*)(Vt + (16 * w + r16) * 72 + 8 * g), b1 = *(const bf16x8*)(Vt + (16 * w + r16) * 72 + 32 + 8 * g);
            bf16_t* so = ST + (size_t)it * DK * 128 + (size_t)(16 * w + r16) * DK + 4 * g;
#pragma unroll
            for (int mt = 0; mt < DK / 16; ++mt) {
                const bf16x8 a0 = *(const bf16x8*)(KhT + (16 * mt + r16) * 72 + 8 * g), a1 = *(const bf16x8*)(KhT + (16 * mt + r16) * 72 + 32 + 8 * g);
                f32x4 acc = (f32x4){0.f, 0.f, 0.f, 0.f};
                acc = __builtin_amdgcn_mfma_f32_16x16x32_bf16(a0, b0, acc, 0, 0, 0);
                acc = __builtin_amdgcn_mfma_f32_16x16x32_bf16(a1, b1, acc, 0, 0, 0);
                u32x2 q; q.x = pk2(acc[0], acc[1]); q.y = pk2(acc[2], acc[3]);
                *(u32x2*)(so + 16 * mt) = q;
            }
        }
        __syncthreads();
    }
}

template <int MODE> __device__ __forceinline__ void phase_la_p2(const Ctx& C) {
    typedef LaCfg<MODE> Cf; const Params& p = C.p; constexpr int DK = Cf::DK, NQ = DK / 4;
    bf16_t* ST = (bf16_t*)(p.ws + WS_ST); const float* TOT = (const float*)(p.ws + WS_TOT);
    for (int u = blockIdx.x * NTHR + C.tid; u < 32 * 128 * NQ; u += gridDim.x * NTHR) {
        const int k4 = u % NQ, v = (u / NQ) & 127, bh = u / (NQ * 128);
        float S0 = 0.f, S1 = 0.f, S2 = 0.f, S3 = 0.f;
        bf16_t* base = ST + (size_t)bh * 64 * DK * 128 + (size_t)v * DK + k4 * 4;
        const float* tb = TOT + (size_t)bh * 64 * 128 + k4 * 4;
#pragma unroll 8
        for (int c = 0; c < 64; ++c) {
            u32x2* ptr = (u32x2*)(base + (size_t)c * DK * 128);
            const u32x2 w = *ptr; const f32x4 dc = *(const f32x4*)(tb + c * 128);
            u32x2 o; o.x = pk2(S0, S1); o.y = pk2(S2, S3);
            *ptr = o;
            S0 = S0 * __builtin_amdgcn_exp2f(dc[0]) + bflo(w.x); S1 = S1 * __builtin_amdgcn_exp2f(dc[1]) + bfhi(w.x);
            S2 = S2 * __builtin_amdgcn_exp2f(dc[2]) + bflo(w.y); S3 = S3 * __builtin_amdgcn_exp2f(dc[3]) + bfhi(w.y);
        }
    }
}

template <int MODE> __device__ __forceinline__ void phase_la_p3(const Ctx& C, int l) {
    typedef LaCfg<MODE> Cf; const Params& p = C.p; constexpr int DK = Cf::DK, LQ = Cf::LQ, LG = Cf::LG, NG = Cf::NG, NKS = DK / 32;
    bf16_t* Qb = (bf16_t*)(C.lds + Cf::O_QB); bf16_t* Kb = (bf16_t*)(C.lds + Cf::O_KB); float* Gf = (float*)(C.lds + Cf::O_GF); bf16_t* Vt = (bf16_t*)(C.lds + Cf::O_VT);
    bf16_t* Sc = (bf16_t*)(C.lds + Cf::O_SC); bf16_t* Qe = (bf16_t*)(C.lds + Cf::O_QE); float* segs = (float*)(C.lds + Cf::O_SEG); float* red = (float*)(C.lds + Cf::O_RED);
    const bf16_t* ST = (const bf16_t*)(p.ws + WS_ST); const bf16_t* proj = (const bf16_t*)(p.ws + WS_R1); bf16_t* A = (bf16_t*)(p.ws + WS_A);
    const float* nw = (MODE ? p.hgrn_norm_w : p.gla_norm_w) + (l >> 1) * 128;
    const int r16 = C.lane & 15, g = C.lane >> 4, w = C.wave;
    const f32x4 nw4 = *(const f32x4*)(nw + 16 * w + 4 * g);
    float* par = (float*)(C.lds + Cf::O_PAR);
    LaRaw<MODE> R; int hcur = -1;
    if ((int)blockIdx.x < 2048) la_fetch<MODE, true>(C, (int)blockIdx.x >> 8, ((int)blockIdx.x >> 6) & 3, (int)blockIdx.x & 63, R);
    for (int it = blockIdx.x; it < 2048; it += gridDim.x) {
        const int bh = it >> 6, c = it & 63, b = bh >> 2, h = bh & 3;
        bf16x8 sfr[NKS];
        { const bf16_t* sp = ST + (size_t)it * DK * 128 + (size_t)(16 * w + r16) * DK + 8 * g;
#pragma unroll
          for (int ks = 0; ks < NKS; ++ks) sfr[ks] = *(const bf16x8*)(sp + 32 * ks); }
        if (h != hcur) { la_params<MODE>(C, l, h, par); hcur = h; __syncthreads(); }
        la_store<MODE, true>(C, R, par, Qb, Kb, Gf, Vt);
        { const int nx = it + (int)gridDim.x; if (nx < 2048) la_fetch<MODE, true>(C, nx >> 8, (nx >> 6) & 3, nx & 63, R); }
        for (int u = C.tid; u < 64 * 72 / 8; u += NTHR) *(u32x4*)(Sc + u * 8) = (u32x4){0u, 0u, 0u, 0u};
        __syncthreads();
        la_cumsum<MODE>(C, Gf, segs);
        __syncthreads();
        for (int t = w; t < 10; t += 8) {
            const int I = (t >= 6) ? 3 : (t >= 3) ? 2 : (t >= 1) ? 1 : 0, J = t - I * (I + 1) / 2;
            f32x4 acc = (f32x4){0.f, 0.f, 0.f, 0.f};
#pragma unroll
            for (int ks = 0; ks < NKS; ++ks) {
                const int kc = 32 * ks + 8 * g;
                float gref[8], gj[8], gi[8], kv[8], qv[8];
                ld8f(Gf + (16 * J + 15) * LG + kc, gref); ld8f(Gf + (16 * J + r16) * LG + kc, gj); ld8f(Gf + (16 * I + r16) * LG + kc, gi);
                unpack8(*(const u32x4*)(Kb + (16 * J + r16) * LQ + kc), kv); unpack8(*(const u32x4*)(Qb + (16 * I + r16) * LQ + kc), qv);
#pragma unroll
                for (int e = 0; e < 8; ++e) { kv[e] *= __builtin_amdgcn_exp2f(gref[e] - gj[e]); qv[e] *= __builtin_amdgcn_exp2f(gi[e] - gref[e]); }
                acc = __builtin_amdgcn_mfma_f32_16x16x32_bf16(__builtin_bit_cast(bf16x8, pack8(kv)), __builtin_bit_cast(bf16x8, pack8(qv)), acc, 0, 0, 0);
            }
            if (I == J) {
#pragma unroll
                for (int e = 0; e < 4; ++e) if (4 * g + e > r16) acc[e] = 0.f;
            }
            u32x2 q; q.x = pk2(acc[0], acc[1]); q.y = pk2(acc[2], acc[3]);
            *(u32x2*)(Sc + (16 * I + r16) * 72 + 16 * J + 4 * g) = q;
        }
        for (int u = C.tid; u < 64 * NG; u += NTHR) {
            const int r = u / NG, kk = (u % NG) * 8;
            float qv[8], gi[8]; unpack8(*(const u32x4*)(Qb + r * LQ + kk), qv); ld8f(Gf + r * LG + kk, gi);
#pragma unroll
            for (int e = 0; e < 8; ++e) qv[e] *= __builtin_amdgcn_exp2f(gi[e]);
            *(u32x4*)(Qe + r * LQ + kk) = pack8(qv);
        }
        __syncthreads();
        f32x4 o[4];
        {
            const bf16x8 v0 = *(const bf16x8*)(Vt + (16 * w + r16) * 72 + 8 * g), v1 = *(const bf16x8*)(Vt + (16 * w + r16) * 72 + 32 + 8 * g);
#pragma unroll
            for (int nt = 0; nt < 4; ++nt) {
                f32x4 acc = (f32x4){0.f, 0.f, 0.f, 0.f};
                acc = __builtin_amdgcn_mfma_f32_16x16x32_bf16(v0, *(const bf16x8*)(Sc + (16 * nt + r16) * 72 + 8 * g), acc, 0, 0, 0);
                if (nt >= 2) acc = __builtin_amdgcn_mfma_f32_16x16x32_bf16(v1, *(const bf16x8*)(Sc + (16 * nt + r16) * 72 + 32 + 8 * g), acc, 0, 0, 0);
#pragma unroll
                for (int ks = 0; ks < NKS; ++ks) acc = __builtin_amdgcn_mfma_f32_16x16x32_bf16(sfr[ks], *(const bf16x8*)(Qe + (16 * nt + r16) * LQ + 32 * ks + 8 * g), acc, 0, 0, 0);
                o[nt] = acc;
                float ss = acc[0] * acc[0] + acc[1] * acc[1] + acc[2] * acc[2] + acc[3] * acc[3];
                ss += __shfl_xor(ss, 16); ss += __shfl_xor(ss, 32);
                if (g == 0) red[w * 64 + 16 * nt + r16] = ss;
            }
        }
        __syncthreads();
#pragma unroll
        for (int nt = 0; nt < 4; ++nt) {
            float tot = 0.f;
#pragma unroll
            for (int ww = 0; ww < 8; ++ww) tot += red[ww * 64 + 16 * nt + r16];
            const float rs = rsqrtf(tot * (1.f / 128.f) + 1e-6f);
            const size_t row = (size_t)b * SEQ_ + (size_t)c * 64 + 16 * nt + r16;
            const u32x2 gw = *(const u32x2*)(proj + row * Cf::PITCH + Cf::GCOL + h * 128 + 16 * w + 4 * g);
            u32x2 q; q.x = pk2(o[nt][0] * rs * nw4[0] * siluf_(bflo(gw.x)), o[nt][1] * rs * nw4[1] * siluf_(bfhi(gw.x)));
            q.y = pk2(o[nt][2] * rs * nw4[2] * siluf_(bflo(gw.y)), o[nt][3] * rs * nw4[3] * siluf_(bfhi(gw.y)));
            *(u32x2*)(A + row * 1024 + Cf::OCOL + h * 128 + 16 * w + 4 * g) = q;
        }
        __syncthreads();
    }
}


#define LAS __attribute__((address_space(3)))
#define XB_TMO      128
#define XB_XCNT(j)  (256  + 64 * (j))
#define XB_XSUB(j)  (1280 + 64 * (j))
#define XB_XGEN(j)  (2304 + 64 * (j))
#define XB_TOP      3328
#define XB_TOPGEN   3392
#define XCD_BAR_WORDS 3456
#define XB_SPIN_CAP (1u << 18)

__device__ __forceinline__ unsigned xb_ld(unsigned* p)              { return __hip_atomic_load(p, __ATOMIC_RELAXED, __HIP_MEMORY_SCOPE_AGENT); }
__device__ __forceinline__ unsigned xb_add(unsigned* p, unsigned v) { return __hip_atomic_fetch_add(p, v, __ATOMIC_RELAXED, __HIP_MEMORY_SCOPE_AGENT); }
__device__ __forceinline__ unsigned xb_xcc_id() { return (unsigned)__builtin_amdgcn_s_getreg((3 << 11) | 20) & 0xFu; }
#define XB_SPIN(cond, bar) do { unsigned _sp = 0; while (cond) { __builtin_amdgcn_s_sleep(1); \
    if ((++_sp & 255u) == 0u) { if (xb_ld(&(bar)[XB_TMO])) break; if (_sp > XB_SPIN_CAP) { atomicAdd(&(bar)[XB_TMO], 1u); break; } } } } while (0)

struct XcdBarrier {
    unsigned* bar; unsigned x;
    volatile LAS unsigned* st;
};

__device__ __forceinline__ XcdBarrier xcd_barrier_post(unsigned* bar, volatile LAS unsigned* st) {
    XcdBarrier b; b.bar = bar; b.x = xb_xcc_id(); b.st = st;
    if (threadIdx.x == 0) (void)xb_add(&bar[XB_XCNT(b.x)], 1u);
    return b;
}
__device__ __forceinline__ void xcd_barrier_complete(unsigned* bar, unsigned x, unsigned& nloc, unsigned& nx) {
    const unsigned G = gridDim.x * gridDim.y * gridDim.z;
    unsigned sum, cnt, mine, sp = 0u;
    for (;;) {
        sum = 0u; cnt = 0u; mine = 0u;
#pragma unroll
        for (unsigned j = 0; j < 16; ++j) { const unsigned c = xb_ld(&bar[XB_XCNT(j)]); sum += c; cnt += (c > 0u) ? 1u : 0u; mine = (j == x) ? c : mine; }
        if (sum == G) break;
        __builtin_amdgcn_s_sleep(1);
        if ((++sp & 255u) == 0u) { if (xb_ld(&bar[XB_TMO])) break; if (sp > XB_SPIN_CAP) { atomicAdd(&bar[XB_TMO], 1u); break; } }
    }
    nloc = mine > 0u ? mine : 1u; nx = cnt > 0u ? cnt : 1u;
}

__device__ __forceinline__ void xcd_barrier(const XcdBarrier& b) {
    asm volatile("s_waitcnt vmcnt(0)" ::: "memory");
    __syncthreads();
    if (threadIdx.x == 0) {
        unsigned* bar = b.bar;
        __builtin_amdgcn_s_waitcnt(0);
        unsigned nloc = b.st[0], nx = b.st[1];
        if (nloc == 0u) { xcd_barrier_complete(bar, b.x, nloc, nx); b.st[0] = nloc; b.st[1] = nx; }
        const unsigned old = xb_add(&bar[XB_XSUB(b.x)], 1u);
        const unsigned gen = old / nloc;
        if (old + 1u == (gen + 1u) * nloc) {
            __builtin_amdgcn_fence(__ATOMIC_RELEASE, "agent");
            asm volatile("s_waitcnt vmcnt(0)" ::: "memory");
            const unsigned og = xb_add(&bar[XB_TOP], 1u);
            const unsigned tg = og / nx;
            if (og + 1u == (tg + 1u) * nx) xb_add(&bar[XB_TOPGEN], 1u);
            else XB_SPIN(xb_ld(&bar[XB_TOPGEN]) == tg, bar);
            __builtin_amdgcn_fence(__ATOMIC_ACQUIRE, "agent");
            xb_add(&bar[XB_XGEN(b.x)], 1u);
            asm volatile("s_waitcnt vmcnt(0)" ::: "memory");
        } else {
            XB_SPIN(xb_ld(&bar[XB_XGEN(b.x)]) == gen, bar);
            __builtin_amdgcn_fence(__ATOMIC_ACQUIRE, "agent");
            asm volatile("s_waitcnt vmcnt(0)" ::: "memory");
        }
    }
    __syncthreads();
}

typedef unsigned u32x16 __attribute__((ext_vector_type(16)));
__device__ __forceinline__ void load_params(Params& p) {
    auto kp = __builtin_amdgcn_kernarg_segment_ptr();
    u32x16 a, b, c, d;
    asm volatile("s_load_dwordx16 %0, %4, 0x0\n\ts_load_dwordx16 %1, %4, 0x40\n\ts_load_dwordx16 %2, %4, 0x80\n\ts_load_dwordx16 %3, %4, 0xc0\n\ts_waitcnt lgkmcnt(0)"
                 : "=&s"(a), "=&s"(b), "=&s"(c), "=&s"(d) : "s"(kp) : "memory");
    unsigned long long q[32];
#pragma unroll
    for (int i = 0; i < 8; ++i) { q[i] = ((unsigned long long)a[2 * i + 1] << 32) | a[2 * i]; q[8 + i] = ((unsigned long long)b[2 * i + 1] << 32) | b[2 * i];
        q[16 + i] = ((unsigned long long)c[2 * i + 1] << 32) | c[2 * i]; q[24 + i] = ((unsigned long long)d[2 * i + 1] << 32) | d[2 * i]; }
    p.x = (const float*)q[0]; p.c = (const float*)q[1]; p.positions = (const int*)q[2]; p.mod_w = (const float*)q[3]; p.mod_b = (const float*)q[4]; p.norm_mix_w = (const float*)q[5]; p.norm_ffn_w = (const float*)q[6];
    p.ev_w_in = (const float*)q[7]; p.gla_gate_w = (const float*)q[8]; p.gla_gate_b = (const float*)q[9]; p.gla_norm_w = (const float*)q[10]; p.swa_sinks = (const float*)q[11]; p.ev_w_out = (const float*)q[12];
    p.od_w_in = (const float*)q[13]; p.diff_lambda = (const float*)q[14]; p.diff_norm_w = (const float*)q[15]; p.hgrn_lb_logits = (const float*)q[16]; p.hgrn_norm_w = (const float*)q[17]; p.od_w_out = (const float*)q[18];
    p.ffn_w_in = (const float*)q[19]; p.ffn_conv_w = (const float*)q[20]; p.ffn_conv_b = (const float*)q[21]; p.ffn_w_out = (const float*)q[22]; p.final_norm_w = (const float*)q[23];
    p.out = (float*)q[24]; p.ws = (unsigned char*)q[25];
}

#ifndef REP_SYNC
#define REP_SYNC 1
#endif
#ifndef REP_G
#define REP_G 1
#endif
#ifndef REP_R
#define REP_R 1
#endif
#ifndef REP_LA
#define REP_LA 1
#endif
#ifndef REP_AT
#define REP_AT 1
#endif
#ifndef REP_SM
#define REP_SM 1
#endif
__global__ void __launch_bounds__(NTHR, 2) fwd_megakernel(Params pin) {
    extern __shared__ __attribute__((aligned(16))) unsigned char lds[];
    cg::grid_group grid = cg::this_grid();
    Ctx C; C.lds = lds; C.tid = threadIdx.x; C.lane = C.tid & 63; C.wave = __builtin_amdgcn_readfirstlane(C.tid >> 6);
    C.gw = blockIdx.x * 8 + C.wave; C.ngw = gridDim.x * 8;
    PG8_LAS unsigned char* ldsg = (PG8_LAS unsigned char*)lds;
    volatile LAS unsigned* bst = (volatile LAS unsigned*)(ldsg + (LDS_BYTES - 64));
    if (threadIdx.x < 2) bst[threadIdx.x] = 0u;
    __syncthreads();
    XcdBarrier xbar = xcd_barrier_post((unsigned*)(pin.ws + WS_BAR), bst);
#define GSYNC() do { for (int rs_ = 0; rs_ < REP_SYNC; ++rs_) xcd_barrier(xbar); } while (0)
#define RP() do { load_params(C.p); C.tid = otid_(); C.lane = C.tid & 63; C.wave = __builtin_amdgcn_readfirstlane(C.tid >> 6); C.gw = blockIdx.x * 8 + C.wave; } while (0)
#define WSP(off) (C.p.ws + (off))

#ifndef NO_PRO
    for (int rep_ = 0; rep_ < REP_SM; ++rep_) { RP(); phase_prologue(C); }
#endif
    grid.sync();
#pragma unroll 1
    for (int l = 0; l < 4; ++l) {
        const bool even = !(l & 1);
#ifndef NO_CONV
        for (int rep_ = 0; rep_ < REP_SM; ++rep_) { RP(); phase_convert(C, l); }
#endif
#ifndef NO_NORM
        for (int rep_ = 0; rep_ < REP_SM; ++rep_) { RP(); phase_norm(C, (l == 0) ? C.p.x : C.p.out, C.p.norm_mix_w + l * 1024, (const float*)WSP(WS_MOD) + (size_t)l * 8 * 6144, 0, 1024, (bf16_t*)WSP(WS_A)); }
#endif
        GSYNC();
        {
            RP();
            const int N = even ? 2560 : 3584;
            pg8::Gemm g{(const bf16_t*)WSP(WS_A), (const bf16_t*)WSP(WS_WIN), T_, N, 1024}; pg8::StaticOrder S; S.init(T_, N, (int)gridDim.x, (int)blockIdx.x);
            pg8::EpiProj E{(bf16_t*)WSP(WS_R1), N, even ? 0x7C000u : 0xFFu, even ? 0x3C000u : 0xFu, QSCALE_, (const float*)WSP(WS_COS), (const float*)WSP(WS_SIN)};
#ifndef NO_GPROJ
            for (int rep_ = 0; rep_ < REP_G; ++rep_) pg8::gemm_phase<pg8::EpiProj, pg8::StaticOrder, true, true>(ldsg, g, S, E);
#endif
        }
        GSYNC();
        if (even) {
#ifndef NO_SWA
            for (int rep_ = 0; rep_ < REP_AT; ++rep_) { RP(); phase_swa(C, l); }
#endif
#ifndef NO_P1
            for (int rep_ = 0; rep_ < REP_LA; ++rep_) { RP(); phase_la_p1<0>(C, l); }
#endif
            GSYNC();
#ifndef NO_P2
            RP(); phase_la_p2<0>(C);
#endif
            GSYNC();
#ifndef NO_P3
            for (int rep_ = 0; rep_ < REP_LA; ++rep_) { RP(); phase_la_p3<0>(C, l); }
#endif
        } else {
            for (int rep_ = 0; rep_ < REP_AT; ++rep_) {
                RP();
                const bf16_t* R1 = (const bf16_t*)WSP(WS_R1); bf16_t* X2 = (bf16_t*)WSP(WS_X2);
                const int G = (int)gridDim.x, bid = (int)blockIdx.x;
#pragma unroll 1
                for (int i = 0; i * G < 2048; ++i) {
                    const int L = i * G + ((i & 1) ? (G - 1 - bid) : bid);
                    if (L >= 2048) continue;
                    const int qb = 15 - (L >> 7), bh = L & 127, b = bh >> 4, hv = bh & 15;
                    const attn_body::bf16* Q = (const attn_body::bf16*)(R1 + (hv >> 1) * 64);
                    const attn_body::bf16* K = (const attn_body::bf16*)(R1 + 512 + (hv >> 1) * 64);
                    const attn_body::bf16* V = (const attn_body::bf16*)(R1 + 1024 + (hv >> 2) * 128 + (hv & 1) * 64);
#ifndef NO_ATTN
                    attn_body::attn_unit<8>(b, hv, qb, Q, K, V, (attn_body::bf16*)(X2 + hv * 64), (char*)lds);
#endif
                }
            }
#ifndef NO_P1
            for (int rep_ = 0; rep_ < REP_LA; ++rep_) { RP(); phase_la_p1<1>(C, l); }
#endif
            GSYNC();
#ifndef NO_P2
            RP(); phase_la_p2<1>(C);
#endif
#ifndef NO_COMB
            RP(); phase_diff_combine(C, l);
#endif
            GSYNC();
#ifndef NO_P3
            for (int rep_ = 0; rep_ < REP_LA; ++rep_) { RP(); phase_la_p3<1>(C, l); }
#endif
        }
        GSYNC();
        {
            RP();
            pg8::Gemm g{(const bf16_t*)WSP(WS_A), (const bf16_t*)WSP(WS_WOUT), T_, 1024, 1024}; pg8::StaticOrder S; S.init(T_, 1024, (int)gridDim.x, (int)blockIdx.x);
            pg8::EpiRes E{(l == 0) ? C.p.x : C.p.out, C.p.out, (const float*)WSP(WS_MOD) + (size_t)l * 8 * 6144 + 2048};
#ifndef NO_GRES
            for (int rep_ = 1; rep_ < REP_R; ++rep_) { pg8::EpiRes E2{(l == 0) ? C.p.x : C.p.out, (float*)WSP(WS_X2), (const float*)WSP(WS_MOD) + (size_t)l * 8 * 6144 + 2048}; pg8::gemm_phase<pg8::EpiRes, pg8::StaticOrder, true, true>(ldsg, g, S, E2); }
            pg8::gemm_phase<pg8::EpiRes, pg8::StaticOrder, true, true>(ldsg, g, S, E);
#endif
        }
        GSYNC();
#ifndef NO_NORM
        for (int rep_ = 0; rep_ < REP_SM; ++rep_) { RP(); phase_norm(C, C.p.out, C.p.norm_ffn_w + l * 1024, (const float*)WSP(WS_MOD) + (size_t)l * 8 * 6144, 3072, 4096, (bf16_t*)WSP(WS_A)); }
#endif
        GSYNC();
        {
            RP();
            pg8::Gemm g{(const bf16_t*)WSP(WS_A), (const bf16_t*)WSP(WS_FIN), T_, 5632, 1024}; pg8::StaticOrder S; S.init(T_, 5632, (int)gridDim.x, (int)blockIdx.x);
            pg8::EpiFfn E{(bf16_t*)WSP(WS_R1), (float*)WSP(WS_HP), (float*)WSP(WS_HU), (float*)WSP(WS_HA), C.p.ffn_conv_w + (size_t)l * 3 * DFF_, C.p.ffn_conv_b + (size_t)l * DFF_};
#ifndef NO_GFFN
            for (int rep_ = 0; rep_ < REP_G; ++rep_) pg8::gemm_phase<pg8::EpiFfn, pg8::StaticOrder, true, true>(ldsg, g, S, E);
#endif
        }
        GSYNC();
#ifndef NO_FIX
        for (int rep_ = 0; rep_ < REP_SM; ++rep_) { RP(); phase_ffn_fixup(C, l); }
#endif
        GSYNC();
        {
            RP();
            pg8::Gemm g{(const bf16_t*)WSP(WS_R1), (const bf16_t*)WSP(WS_FOUT), T_, 1024, DFF_}; pg8::StaticOrder S; S.init(T_, 1024, (int)gridDim.x, (int)blockIdx.x);
            pg8::EpiRes E{C.p.out, C.p.out, (const float*)WSP(WS_MOD) + (size_t)l * 8 * 6144 + 5120};
#ifndef NO_GRES
            for (int rep_ = 1; rep_ < REP_R; ++rep_) { pg8::EpiRes E2{C.p.out, (float*)WSP(WS_X2), (const float*)WSP(WS_MOD) + (size_t)l * 8 * 6144 + 5120}; pg8::gemm_phase<pg8::EpiRes, pg8::StaticOrder, true, true>(ldsg, g, S, E2); }
            pg8::gemm_phase<pg8::EpiRes, pg8::StaticOrder, true, true>(ldsg, g, S, E);
#endif
        }
        GSYNC();
    }
    RP(); phase_final_norm(C, C.p.out, C.p.final_norm_w);
}

extern "C" void kernel_launch(void* const* d_in, const int* in_sizes, int n_in, void* d_out, int out_size, void* d_ws, size_t ws_size, hipStream_t stream) {
    static int grid_blocks = 0;
    if (grid_blocks == 0) {
        if (n_in != 24 || ws_size < WS_END) { fprintf(stderr, "kernel_launch: unexpected n_in %d / ws %zu\n", n_in, ws_size); grid_blocks = -1; return; }
        int dev = 0, cus = 0, per_cu = 0;
        hipGetDevice(&dev); hipDeviceGetAttribute(&cus, hipDeviceAttributeMultiprocessorCount, dev);
        if (hipFuncSetAttribute((const void*)fwd_megakernel, hipFuncAttributeMaxDynamicSharedMemorySize, LDS_BYTES) != hipSuccess) { fprintf(stderr, "kernel_launch: hipFuncSetAttribute failed\n"); grid_blocks = -1; return; }
        if (hipOccupancyMaxActiveBlocksPerMultiprocessor(&per_cu, (const void*)fwd_megakernel, NTHR, LDS_BYTES) != hipSuccess || per_cu < 1) { fprintf(stderr, "kernel_launch: occupancy query gave %d\n", per_cu); per_cu = 1; }
        (void)hipGetLastError();
        grid_blocks = cus * per_cu;
    }
    if (grid_blocks < 0) return;
    Params p{};
    p.x = (const float*)d_in[0]; p.c = (const float*)d_in[1]; p.positions = (const int*)d_in[2]; p.mod_w = (const float*)d_in[3]; p.mod_b = (const float*)d_in[4];
    p.norm_mix_w = (const float*)d_in[5]; p.norm_ffn_w = (const float*)d_in[6]; p.ev_w_in = (const float*)d_in[7]; p.gla_gate_w = (const float*)d_in[8];
    p.gla_gate_b = (const float*)d_in[9]; p.gla_norm_w = (const float*)d_in[10]; p.swa_sinks = (const float*)d_in[11]; p.ev_w_out = (const float*)d_in[12];
    p.od_w_in = (const float*)d_in[13]; p.diff_lambda = (const float*)d_in[14]; p.diff_norm_w = (const float*)d_in[15]; p.hgrn_lb_logits = (const float*)d_in[16];
    p.hgrn_norm_w = (const float*)d_in[17]; p.od_w_out = (const float*)d_in[18]; p.ffn_w_in = (const float*)d_in[19]; p.ffn_conv_w = (const float*)d_in[20];
    p.ffn_conv_b = (const float*)d_in[21]; p.ffn_w_out = (const float*)d_in[22]; p.final_norm_w = (const float*)d_in[23];
    p.out = (float*)d_out; p.ws = (unsigned char*)d_ws;
    if (hipMemsetAsync((char*)d_ws + WS_BAR, 0, 16384, stream) != hipSuccess) { fprintf(stderr, "kernel_launch: memset failed\n"); return; }
    void* args[] = {&p};
    hipError_t e = hipLaunchCooperativeKernel((const void*)fwd_megakernel, dim3(grid_blocks), dim3(NTHR), args, LDS_BYTES, stream);
    if (e != hipSuccess) fprintf(stderr, "cooperative launch failed: %s (grid %d)\n", hipGetErrorString(e), grid_blocks);
}
```

```cpp
#include <hip/hip_runtime.h>
#include <hip/hip_cooperative_groups.h>
#include <hip/hip_bf16.h>
#include <cstdio>
#include <cstdint>
#include <cmath>
__device__ __forceinline__ int otid_() { int t = threadIdx.x; asm volatile("" : "+v"(t)); return t; }
namespace pg8 {
#define PG8_LAS __attribute__((address_space(3)))
typedef unsigned short bf16_t;
typedef short bf16x8 __attribute__((ext_vector_type(8)));
typedef float f32x4 __attribute__((ext_vector_type(4)));
typedef unsigned u32x4 __attribute__((ext_vector_type(4)));
constexpr int BM = 256, BK = 64, HALF = 128, HTB = HALF * BK * 2  , STAGE_BYTES = 8 * HTB, NXCD = 8, WGM = 8;

__host__ __device__ __forceinline__ int lds_byte(int r, int c) { const int st = (r >> 4) * 2 + (c >> 5), rr = r & 15, cc = c & 31, ob = rr * 64 + cc * 2; return st * 1024 + (ob ^ (((ob >> 9) & 1) << 5)); }
__host__ __device__ __forceinline__ void stage_rc(int b, int& R, int& C) { const int st = b / 1024, sb = b % 1024, swz = sb ^ (((sb >> 9) & 1) << 5); R = (st >> 1) * 16 + swz / 64; C = (st & 1) * 32 + (swz % 64) / 2; }
__host__ __device__ __forceinline__ int perm32(int rho) { const int n = rho >> 4, i = rho & 15; return 8 * (i >> 2) + 4 * n + (i & 3); }

struct Unit { int pm, pn; };
struct Gemm { const bf16_t* A; const bf16_t* Bt; int M, N, K; };

struct StaticOrder {
    int nM, nN, nwg, G, c;
    __host__ __device__ void init(int M, int N, int G_, int c_) { nM = M / BM; nN = N / BM; nwg = nM * nN; G = G_; c = c_; }
    __host__ __device__ bool next(int i, Unit& u) const {
        const long L = (long)i * G + c; if (L >= nwg) return false;
        int wgid = (int)L; { const int q = nwg / NXCD, r = nwg % NXCD, xcd = wgid % NXCD, off = wgid / NXCD; wgid = (xcd < r ? xcd * (q + 1) : r * (q + 1) + (xcd - r) * q) + off; }
        const int nig = WGM * nN, gid = wgid / nig, fm = gid * WGM, gsz = (nM - fm) < WGM ? (nM - fm) : WGM;
        u.pm = fm + ((wgid % nig) % gsz); u.pn = (wgid % nig) / gsz; return true;
    }
    __device__ __forceinline__ void a_ready(const Unit&) const {}
    __device__ __forceinline__ void done(const Unit&) const {}
};

__device__ __forceinline__ unsigned cvt_pk_bf16(float lo, float hi) { unsigned r; asm volatile("v_cvt_pk_bf16_f32 %0, %1, %2" : "=v"(r) : "v"(lo), "v"(hi)); return r; }
typedef float f32x2 __attribute__((ext_vector_type(2)));
template <class Epi, class Sched, bool ALIGN_EPI = false, bool SP2 = false>
__device__ __forceinline__ void gemm_phase(PG8_LAS unsigned char* lds, const Gemm g, const Sched& S, const Epi& E) {
    const int tid = otid_(), wid = __builtin_amdgcn_readfirstlane(tid >> 6), lane = tid & 63, wr = wid >> 2, wc = wid & 3, fr = lane & 15, fq = lane >> 4;
    const int K = g.K, nt = K / BK;
    unsigned voffA[2], voffB[2];
#pragma unroll
    for (int i = 0; i < 2; ++i) { int R, C; stage_rc(tid * 16 + i * 8192, R, C); const int Rb = Epi::PERM ? ((R & ~31) + perm32(R & 31)) : R;
        voffA[i] = (unsigned)(R * K + C) * 2u; voffB[i] = (unsigned)(Rb * K + C) * 2u; }
    const size_t kstep = (size_t)(BK * 2);
    const size_t hstep = (size_t)HALF * K * 2;
    const size_t tstep = 2 * hstep;
    const unsigned ldsw = (unsigned)wid * 1024u;
    const int aoff = lds_byte(wr * 64 + fr, fq * 8), boff = lds_byte(wc * 32 + fr, fq * 8);
#define PG8_SA(b, h) (((b) * 2 + (h)) * HTB)
#define PG8_SB(b, h) ((4 + (b) * 2 + (h)) * HTB)
#define PG8_STAGE(bufoff, gbase, voff) do { _Pragma("unroll") for (int _i = 0; _i < 2; ++_i) \
        __builtin_amdgcn_global_load_lds((const unsigned*)((const char*)(gbase) + (voff)[_i]), (PG8_LAS unsigned*)(lds + (bufoff) + ldsw + _i * 8192), 16, 0, 0); } while (0)
#define PG8_LDA(dst, b, h) do { _Pragma("unroll") for (int m = 0; m < 4; ++m) _Pragma("unroll") for (int k = 0; k < 2; ++k) dst[m][k] = *(const PG8_LAS bf16x8*)(lds + PG8_SA(b, h) + aoff + m * 2048 + k * 1024); } while (0)
#define PG8_LDB(dst, b, h) do { _Pragma("unroll") for (int n = 0; n < 2; ++n) _Pragma("unroll") for (int k = 0; k < 2; ++k) dst[n][k] = *(const PG8_LAS bf16x8*)(lds + PG8_SB(b, h) + boff + n * 2048 + k * 1024); } while (0)
#define PG8_MMA(ai, bj, At, Bt) do { __builtin_amdgcn_s_setprio(1); _Pragma("unroll") for (int m = 0; m < 4; ++m) _Pragma("unroll") for (int n = 0; n < 2; ++n) _Pragma("unroll") for (int k = 0; k < 2; ++k) \
        acc[ai][bj][m][n] = __builtin_amdgcn_mfma_f32_16x16x32_bf16(Bt[n][k], At[m][k], acc[ai][bj][m][n], 0, 0, 0); __builtin_amdgcn_s_setprio(0); } while (0)
#define PG8_WAIT_V(n) asm volatile("s_waitcnt vmcnt(" #n ")" ::: "memory")
#define PG8_WAIT_L(n) asm volatile("s_waitcnt lgkmcnt(" #n ")" ::: "memory")
#define PG8_BAR __builtin_amdgcn_s_barrier()
#define PG8_SCHED __builtin_amdgcn_sched_barrier(0)
    Unit cur, nxt; int ui = 0;
    if (!S.next(0, cur)) return;
    f32x4 acc[2][2][4][2];
#pragma unroll
    for (int a = 0; a < 2; ++a)
#pragma unroll
        for (int b = 0; b < 2; ++b)
#pragma unroll
            for (int m = 0; m < 4; ++m)
#pragma unroll
                for (int n = 0; n < 2; ++n) acc[a][b][m][n] = (f32x4){0.f, 0.f, 0.f, 0.f};
    bf16x8 At[4][2], B0[2][2], B1[2][2];
    const char* cA = (const char*)g.A + (size_t)cur.pm * tstep; const char* cB = (const char*)g.Bt + (size_t)cur.pn * tstep;
    S.a_ready(cur);
    if constexpr (SP2) {
        PG8_STAGE(PG8_SB(0, 0), cB, voffB); PG8_STAGE(PG8_SB(0, 1), cB + hstep, voffB); PG8_STAGE(PG8_SA(0, 0), cA, voffA); PG8_STAGE(PG8_SA(0, 1), cA + hstep, voffA);
        if (wr == 1) PG8_BAR;
        PG8_WAIT_V(2); PG8_BAR;
        PG8_STAGE(PG8_SB(1, 0), cB + kstep, voffB); PG8_STAGE(PG8_SA(1, 0), cA + kstep, voffA); PG8_STAGE(PG8_SB(1, 1), cB + hstep + kstep, voffB);
        PG8_WAIT_V(6); PG8_BAR;
    } else {
        PG8_STAGE(PG8_SB(0, 0), cB, voffB); PG8_STAGE(PG8_SA(0, 0), cA, voffA); PG8_STAGE(PG8_SB(0, 1), cB + hstep, voffB); PG8_STAGE(PG8_SA(0, 1), cA + hstep, voffA);
        if (wr == 1) PG8_BAR;
        PG8_WAIT_V(4); PG8_BAR;
        PG8_STAGE(PG8_SB(1, 0), cB + kstep, voffB); PG8_STAGE(PG8_SA(1, 0), cA + kstep, voffA); PG8_STAGE(PG8_SB(1, 1), cB + hstep + kstep, voffB);
        PG8_WAIT_V(6); PG8_BAR;
    }
    for (;;) {
        const bool has_next = S.next(ui + 1, nxt);
        const char* nA = has_next ? (const char*)g.A + (size_t)nxt.pm * tstep : cA; const char* nB = has_next ? (const char*)g.Bt + (size_t)nxt.pn * tstep : cB;
        for (int t = 0; t < nt; t += 2) {
            const bool last = (t == nt - 2);
            const char* a1 = cA + (size_t)(t + 1) * kstep;
            const char* a2 = last ? nA : cA + (size_t)(t + 2) * kstep; const char* b2 = last ? nB : cB + (size_t)(t + 2) * kstep;
            const char* a3 = a2 + kstep; const char* b3 = b2 + kstep;
            if (last && has_next) S.a_ready(nxt);
            if constexpr (SP2) {
            PG8_LDB(B0, 0, 0); PG8_LDB(B1, 0, 1); PG8_SCHED; PG8_LDA(At, 0, 0); PG8_STAGE(PG8_SA(1, 1), a1 + hstep, voffA);
            PG8_WAIT_V(8); PG8_WAIT_L(0); PG8_BAR; PG8_MMA(0, 0, At, B0); PG8_MMA(0, 1, At, B1); PG8_BAR; PG8_SCHED;
            PG8_LDA(At, 0, 1); PG8_STAGE(PG8_SB(0, 0), b2, voffB); PG8_STAGE(PG8_SB(0, 1), b2 + hstep, voffB); PG8_STAGE(PG8_SA(0, 0), a2, voffA);
            PG8_WAIT_V(8); PG8_WAIT_L(0); PG8_BAR; PG8_MMA(1, 0, At, B0); PG8_MMA(1, 1, At, B1); PG8_BAR; PG8_SCHED;
            PG8_LDB(B0, 1, 0); PG8_LDB(B1, 1, 1); PG8_SCHED; PG8_LDA(At, 1, 0); PG8_STAGE(PG8_SA(0, 1), a2 + hstep, voffA);
            PG8_WAIT_V(8); PG8_WAIT_L(0); PG8_BAR; PG8_MMA(0, 0, At, B0); PG8_MMA(0, 1, At, B1); PG8_BAR; PG8_SCHED;
            PG8_LDA(At, 1, 1); PG8_STAGE(PG8_SB(1, 0), b3, voffB); PG8_STAGE(PG8_SB(1, 1), b3 + hstep, voffB); PG8_STAGE(PG8_SA(1, 0), a3, voffA);
            PG8_WAIT_V(8); PG8_WAIT_L(0); PG8_BAR; PG8_MMA(1, 0, At, B0); PG8_MMA(1, 1, At, B1); PG8_BAR; PG8_SCHED;
            } else {
            PG8_LDB(B0, 0, 0); PG8_SCHED; PG8_LDA(At, 0, 0); PG8_STAGE(PG8_SA(1, 1), a1 + hstep, voffA);
            PG8_WAIT_L(8); PG8_BAR; PG8_WAIT_L(0); PG8_MMA(0, 0, At, B0); PG8_BAR; PG8_SCHED;
            PG8_LDB(B1, 0, 1); PG8_STAGE(PG8_SB(0, 0), b2, voffB);
            PG8_BAR; PG8_WAIT_L(0); PG8_MMA(0, 1, At, B1); PG8_BAR;
            PG8_LDA(At, 0, 1); PG8_STAGE(PG8_SA(0, 0), a2, voffA);
            PG8_BAR; PG8_WAIT_L(0); PG8_MMA(1, 0, At, B0); PG8_BAR; PG8_SCHED;
            PG8_STAGE(PG8_SB(0, 1), b2 + hstep, voffB);
            PG8_WAIT_V(6); PG8_BAR; PG8_MMA(1, 1, At, B1); PG8_BAR;
            PG8_LDB(B0, 1, 0); PG8_SCHED; PG8_LDA(At, 1, 0); PG8_STAGE(PG8_SA(0, 1), a2 + hstep, voffA);
            PG8_WAIT_L(8); PG8_BAR; PG8_WAIT_L(0); PG8_MMA(0, 0, At, B0); PG8_BAR; PG8_SCHED;
            PG8_LDB(B1, 1, 1); PG8_STAGE(PG8_SB(1, 0), b3, voffB);
            PG8_BAR; PG8_WAIT_L(0); PG8_MMA(0, 1, At, B1); PG8_BAR;
            PG8_LDA(At, 1, 1); PG8_STAGE(PG8_SA(1, 0), a3, voffA);
            PG8_BAR; PG8_WAIT_L(0); PG8_MMA(1, 0, At, B0); PG8_BAR; PG8_SCHED;
            PG8_STAGE(PG8_SB(1, 1), b3 + hstep, voffB);
            PG8_WAIT_V(6); PG8_BAR; PG8_MMA(1, 1, At, B1); PG8_BAR;
            }
        }
        if constexpr (ALIGN_EPI) { if (wr == 0) PG8_BAR; }
        if constexpr (!Epi::AFTER_DRAIN) { E(acc, cur, wr, wc, fr, fq); S.done(cur); }
        if (!has_next) break;
#pragma unroll
        for (int a = 0; a < 2; ++a)
#pragma unroll
            for (int b = 0; b < 2; ++b)
#pragma unroll
                for (int m = 0; m < 4; ++m)
#pragma unroll
                    for (int n = 0; n < 2; ++n) acc[a][b][m][n] = (f32x4){0.f, 0.f, 0.f, 0.f};
        cur = nxt; cA = nA; cB = nB; ++ui;
        if constexpr (ALIGN_EPI) { if (wr == 1) PG8_BAR; }
    }
    PG8_WAIT_V(0);
    if constexpr (!ALIGN_EPI) { if (wr == 0) PG8_BAR; }
    PG8_BAR;
    if constexpr (Epi::AFTER_DRAIN) { E.fused(acc, cur, wr, wc, fr, fq, lds, wid, lane); S.done(cur); }
#undef PG8_SA
#undef PG8_SB
#undef PG8_STAGE
#undef PG8_LDA
#undef PG8_LDB
#undef PG8_MMA
#undef PG8_WAIT_V
#undef PG8_WAIT_L
#undef PG8_BAR
#undef PG8_SCHED
}
}
#include <hip/hip_bf16.h>
namespace attn_body {
using bf16=__hip_bfloat16;
using bf16x8=__attribute__((ext_vector_type(8)))short;
using s16x4=__attribute__((ext_vector_type(4)))short;
using f32x16=__attribute__((ext_vector_type(16)))float;
using u32x4=__attribute__((ext_vector_type(4)))unsigned;
constexpr int BATCH=8,NHEAD=16,SEQ=4096,D=64,PITI=3584,PITO=1024;
constexpr int NW=8,QBLK=32,QB=QBLK*NW,KVBLK=64,NQB=SEQ/QB;
__device__ __forceinline__ int crow(int r,int hi){return (r&3)+8*(r>>2)+4*hi;}
#define SBAR() __builtin_amdgcn_sched_barrier(0)
__device__ __forceinline__ void cmask(f32x16&p0,f32x16&p1,int jb,int qrel,int hi){
  const float NEG=-INFINITY; int kb=64*jb+4*hi;
  #pragma unroll
  for(int r=0;r<16;++r){int kv=kb+(r&3)+8*(r>>2); if(kv>qrel)p0[r]=NEG; if(kv+32>qrel)p1[r]=NEG;}
}

constexpr int NSLOT=3, SLOTB=8192;
constexpr int LDS_K=0, LDS_V=NSLOT*SLOTB, LDS_WS=2*NSLOT*SLOTB, LDS_OST=LDS_WS+NW*64*4, LDS_BYTES=LDS_OST+NW*4096;
constexpr float C2=0.125f*1.4426950408889634f;
__device__ __forceinline__ void glds16(const void*gsrc,unsigned lds_dst){unsigned keep;
  asm volatile("s_mov_b32 %0, m0\n\ts_mov_b32 m0, %2\n\ts_nop 0\n\tglobal_load_lds_dwordx4 %1, off\n\ts_mov_b32 m0, %0":"=&s"(keep):"v"(gsrc),"s"(lds_dst):"memory");}
__device__ __forceinline__ float max3f(float a,float b,float c){float r;asm("v_max3_f32 %0, %1, %2, %3":"=v"(r):"v"(a),"v"(b),"v"(c));return r;}
__device__ __forceinline__ float max2f(float a,float b){float r;asm("v_max_f32_e32 %0, %1, %2":"=v"(r):"v"(a),"v"(b));return r;}
__device__ __forceinline__ float fadd_s(float a,float b){float r;asm("v_add_f32_e32 %0, %1, %2":"=v"(r):"v"(a),"v"(b));return r;}
__device__ __forceinline__ float fsub_s(float a,float b){float r;asm("v_sub_f32_e32 %0, %1, %2":"=v"(r):"v"(a),"v"(b));return r;}
typedef float f32x2_t __attribute__((ext_vector_type(2))); typedef __bf16 bf16x2_t __attribute__((ext_vector_type(2)));
__device__ __forceinline__ unsigned cvtpk_s(float lo,float hi){f32x2_t v={lo,hi};bf16x2_t b=__builtin_convertvector(v,bf16x2_t);return __builtin_bit_cast(unsigned,b);}
#define WAIT_BAR(N) asm volatile("s_waitcnt vmcnt(" #N ") lgkmcnt(0)\n\ts_barrier":::"memory")

__device__ __forceinline__ void qkt(f32x16&p0,f32x16&p1,const char*Kslot,const bf16x8*qr,const f32x16&negm,int r32,int hi){
  const char*kb=Kslot+hi*1024+r32*16;
  #pragma unroll
  for(int d0=0;d0<4;++d0){
    const bf16x8 b0=*reinterpret_cast<const bf16x8*>(kb+d0*2048);
    const bf16x8 b1=*reinterpret_cast<const bf16x8*>(kb+d0*2048+512);
    if(d0==0){p0=__builtin_amdgcn_mfma_f32_32x32x16_bf16(b0,qr[0],negm,0,0,0);p1=__builtin_amdgcn_mfma_f32_32x32x16_bf16(b1,qr[0],negm,0,0,0);}
    else{p0=__builtin_amdgcn_mfma_f32_32x32x16_bf16(b0,qr[d0],p0,0,0,0);p1=__builtin_amdgcn_mfma_f32_32x32x16_bf16(b1,qr[d0],p1,0,0,0);}}
}
typedef __attribute__((address_space(3))) const char* lds_cptr;
typedef short v4i16_t __attribute__((ext_vector_type(4)));
__device__ __forceinline__ void kload8(bf16x8*kf,lds_cptr kp){
  kf[0]=*(const __attribute__((address_space(3))) bf16x8*)(kp);      kf[1]=*(const __attribute__((address_space(3))) bf16x8*)(kp+512);
  kf[2]=*(const __attribute__((address_space(3))) bf16x8*)(kp+2048); kf[3]=*(const __attribute__((address_space(3))) bf16x8*)(kp+2560);
  kf[4]=*(const __attribute__((address_space(3))) bf16x8*)(kp+4096); kf[5]=*(const __attribute__((address_space(3))) bf16x8*)(kp+4608);
  kf[6]=*(const __attribute__((address_space(3))) bf16x8*)(kp+6144); kf[7]=*(const __attribute__((address_space(3))) bf16x8*)(kp+6656);
}
__device__ __forceinline__ void kload2(bf16x8*kf,lds_cptr kp,int j){ kf[2*j]=*(const __attribute__((address_space(3))) bf16x8*)(kp+j*2048); kf[2*j+1]=*(const __attribute__((address_space(3))) bf16x8*)(kp+j*2048+512); }
__device__ __forceinline__ s16x4 vtr(lds_cptr p){ return __builtin_bit_cast(s16x4,__builtin_amdgcn_ds_read_tr16_b64_v4i16((__attribute__((address_space(3))) v4i16_t*)p)); }
__device__ __forceinline__ float rowmax(const f32x16&p0,const f32x16&p1){
  float a=max3f(p0[0],p0[1],p1[0]),b=max3f(p0[2],p0[3],p1[1]);a=max3f(a,p1[2],p1[3]);
  #pragma unroll
  for(int r=4;r<16;r+=4){a=max3f(a,p0[r],p0[r+1]);b=max3f(b,p0[r+2],p0[r+3]);a=max3f(a,p1[r],p1[r+1]);b=max3f(b,p1[r+2],p1[r+3]);}
  const float m=max2f(a,b);
  auto rr=__builtin_amdgcn_permlane32_swap(__float_as_uint(m),__float_as_uint(m),false,false);
  return max2f(__uint_as_float(rr[0]),__uint_as_float(rr[1]));
}
__device__ __forceinline__ void pv(f32x16*o,int vb,bf16x8 pa0,bf16x8 pa1,bf16x8 pa2,bf16x8 pa3){
  #pragma unroll
  for(int d0=0;d0<2;++d0){s16x4 lo[4],hi[4];
    #pragma unroll
    for(int ks=0;ks<4;++ks){
      asm volatile("ds_read_b64_tr_b16 %0,%1 offset:%c2":"=&v"(lo[ks]):"v"(vb),"i"(d0*4096+ks*1024):"memory");
      asm volatile("ds_read_b64_tr_b16 %0,%1 offset:%c2":"=&v"(hi[ks]):"v"(vb),"i"(d0*4096+ks*1024+512):"memory");}
    asm volatile("s_waitcnt lgkmcnt(0)":::"memory");SBAR();
    #define PK(k) (bf16x8){lo[k][0],lo[k][1],lo[k][2],lo[k][3],hi[k][0],hi[k][1],hi[k][2],hi[k][3]}
    o[d0]=__builtin_amdgcn_mfma_f32_32x32x16_bf16(pa0,PK(0),o[d0],0,0,0);
    o[d0]=__builtin_amdgcn_mfma_f32_32x32x16_bf16(pa1,PK(1),o[d0],0,0,0);
    o[d0]=__builtin_amdgcn_mfma_f32_32x32x16_bf16(pa2,PK(2),o[d0],0,0,0);
    o[d0]=__builtin_amdgcn_mfma_f32_32x32x16_bf16(pa3,PK(3),o[d0],0,0,0);
    #undef PK
  }
}

#ifndef ATTN_STORE16
#define ATTN_STORE16(p,v) (*(u32x4*)(p)=(v))
#endif
template<int THRL> __device__ __forceinline__ void attn_unit(int b,int h,int qb,const bf16*Q,const bf16*__restrict__ K,const bf16*__restrict__ V,bf16*O,char*shm){
  const int tid=otid_(),lane=tid&63,r32=lane&31,hi=lane>>5; const int wid=__builtin_amdgcn_readfirstlane(tid>>6);
  const long rowbase=(long)b*SEQ; const int q0=qb*QB;
  const bf16*Qw=Q+(rowbase+q0+wid*QBLK)*PITI;
  const bf16*Kh=K+rowbase*PITI,*Vh=V+rowbase*PITI;
  const unsigned lds0=(unsigned)(uintptr_t)shm;
  float*wsf=(float*)(shm+LDS_WS)+wid*64;
  const bf16*ksrc=Kh+(long)lane*PITI+wid*8;
  const bf16*vsrc=Vh+(long)(16*(wid&3)+(lane>>2))*PITI+(wid>>2)*32+(lane&3)*8;
  const unsigned kdst=lds0+LDS_K+wid*1024, vdst=lds0+LDS_V+wid*1024;
  #define DMA_K(t,slot) glds16(ksrc+(long)(t)*KVBLK*PITI,(unsigned)__builtin_amdgcn_readfirstlane(kdst+(slot)))
  #define DMA_V(t,slot) glds16(vsrc+(long)(t)*KVBLK*PITI,(unsigned)__builtin_amdgcn_readfirstlane(vdst+(slot)))
  const int vb0=(int)(lds0+LDS_V)+((lane>>4)&1)*32+(lane&3)*8+(4*hi+((lane&15)>>2))*64;
  const char*Kbase=shm+LDS_K; bf16x8 kf[8];
  const lds_cptr shm3=(lds_cptr)shm; const lds_cptr kp0=shm3+LDS_K+hi*1024+r32*16; const lds_cptr vp0=shm3+LDS_V+((lane>>4)&1)*32+(lane&3)*8+(4*hi+((lane&15)>>2))*64;
  const int NT=(q0+QB)/KVBLK;
  DMA_K(0,0);DMA_V(0,0);DMA_K(1,SLOTB);
  bf16x8 qr[4];
  #pragma unroll
  for(int d0=0;d0<4;++d0)qr[d0]=*reinterpret_cast<const bf16x8*>(&Qw[(long)r32*PITI+d0*16+hi*8]);
  float mhat=0.f,l_reg=0.f;f32x16 o[2];o[0]=f32x16{};o[1]=f32x16{};f32x16 negm=f32x16{};asm volatile("":"+v"(negm));
  const int qrel=wid*QBLK+r32;
  #define CMASK(P0,P1,t) do{int jb_=(t)-(NT-4); if(jb_>=0)cmask(P0,P1,jb_,qrel,hi);}while(0)
  bool resc=false;
  #define START(P0,P1) do{ const float rm=rowmax(P0,P1); resc=false; \
    { const float dl=rm; mhat=fadd_s(mhat,dl); \
      _Pragma("unroll") for(int r=0;r<16;++r){P0[r]=fsub_s(P0[r],dl);P1[r]=fsub_s(P1[r],dl);} \
      _Pragma("unroll") for(int r=0;r<16;++r)negm[r]=-mhat; asm volatile("":"+v"(negm)); } \
    _Pragma("unroll") for(int r=0;r<16;++r)P0[r]=__builtin_amdgcn_exp2f(P0[r]); }while(0)
  #define RESC() do{ if(resc){ asm volatile("s_waitcnt lgkmcnt(0)":::"memory"); \
      _Pragma("unroll") for(int d_=0;d_<2;++d_) _Pragma("unroll") for(int r=0;r<16;++r)o[d_][r]*=wsf[crow(r,hi)]; } }while(0)
  f32x16 pA0,pA1,pB0,pB1;
  int sl_prev=0,sl_cur=0,sl_next=SLOTB;
  #define ROT() do{sl_prev=sl_cur;sl_cur=sl_next;sl_next=(sl_next==(NSLOT-1)*SLOTB)?0:sl_next+SLOTB;}while(0)
  DMA_K(2,2*SLOTB);
  WAIT_BAR(3);
  qkt(pA0,pA1,Kbase,qr,negm,r32,hi);asm volatile("s_nop 15\n\ts_nop 7":"+v"(pA0),"+v"(pA1));CMASK(pA0,pA1,0);
  START(pA0,pA1);
  _Pragma("unroll") for(int r=0;r<16;++r)pA1[r]=__builtin_amdgcn_exp2f(pA1[r]);
  WAIT_BAR(0);
  DMA_K(3,0);DMA_V(1,SLOTB);
  ROT();
  kload8(kf,kp0+sl_cur);
  WAIT_BAR(2);
  s16x4 vlo[8],vhi[8]; u32x4 pw0,pw1,pw2,pw3;
  #define PKW(P,B) cvtpk_s(P[B],P[B+1])
  #define PAF(k) __builtin_bit_cast(bf16x8,pw##k)
  #define VFR(i) (bf16x8){vlo[i][0],vlo[i][1],vlo[i][2],vlo[i][3],vhi[i][0],vhi[i][1],vhi[i][2],vhi[i][3]}
  #define PIN(x) asm volatile("":"+v"(x))
  #define MX3(a,b,c) __builtin_fmaxf(__builtin_fmaxf((a),(b)),(c))
  #define GAPA(MF,A0,A1,A2,A3,W0,W1,PW) do{ MF; sacc+=A0; sacc+=A1; sacc+=A2; sacc+=A3; PIN(sacc); W0; W1; PIN(PW); SBAR(); }while(0)
  #define EX(v) __builtin_amdgcn_exp2f(v)
  #define GAPB(MF,X,B) do{ MF; X[B]=EX(X[B]); X[B+1]=EX(X[B+1]); X[B+2]=EX(X[B+2]); X[B+3]=EX(X[B+3]); PIN(X); SBAR(); }while(0)
  #define VRD(i) do{ vlo[i]=vtr(vp_+(((i)>>2)*4096+((i)&3)*1024)); vhi[i]=vtr(vp_+(((i)>>2)*4096+((i)&3)*1024+512)); }while(0)
  #define KRD(G,j) do{ if(G){ kload2(kf,kp0+sl_next,j); SBAR(); } }while(0)
  #define STEP(C0,C1,P0,P1,t,GK,GV,GL) do{ SBAR(); \
    const lds_cptr vp_=vp0+sl_prev; \
    VRD(0); SBAR(); float sacc=(P0[0]+P0[1]); \
    GAPA(C0=__builtin_amdgcn_mfma_f32_32x32x16_bf16(kf[0],qr[0],negm,0,0,0), P0[2],P0[3],P0[4],P0[5],     pw0[0]=PKW(P0,0), pw0[1]=PKW(P0,2), pw0); \
    VRD(4); SBAR(); GAPA(C1=__builtin_amdgcn_mfma_f32_32x32x16_bf16(kf[1],qr[0],negm,0,0,0), P0[6],P0[7],P0[8],P0[9],     pw0[2]=PKW(P0,4), pw0[3]=PKW(P0,6), pw0); \
    VRD(1); SBAR(); GAPA(C0=__builtin_amdgcn_mfma_f32_32x32x16_bf16(kf[2],qr[1],C0,0,0,0),   P0[10],P0[11],P0[12],P0[13], pw1[0]=PKW(P0,8), pw1[1]=PKW(P0,10), pw1); \
    VRD(5); SBAR(); GAPA(C1=__builtin_amdgcn_mfma_f32_32x32x16_bf16(kf[3],qr[1],C1,0,0,0),   P0[14],P0[15],P1[0],P1[1],   pw1[2]=PKW(P0,12),pw1[3]=PKW(P0,14), pw1); \
    VRD(2); SBAR(); GAPA(C0=__builtin_amdgcn_mfma_f32_32x32x16_bf16(kf[4],qr[2],C0,0,0,0),   P1[2],P1[3],P1[4],P1[5],     pw2[0]=PKW(P1,0), pw2[1]=PKW(P1,2), pw2); \
    VRD(6); SBAR(); GAPA(C1=__builtin_amdgcn_mfma_f32_32x32x16_bf16(kf[5],qr[2],C1,0,0,0),   P1[6],P1[7],P1[8],P1[9],     pw2[2]=PKW(P1,4), pw2[3]=PKW(P1,6), pw2); \
    VRD(3); SBAR(); GAPA(C0=__builtin_amdgcn_mfma_f32_32x32x16_bf16(kf[6],qr[3],C0,0,0,0),   P1[10],P1[11],P1[12],P1[13], pw3[0]=PKW(P1,8), pw3[1]=PKW(P1,10), pw3); \
    VRD(7); SBAR(); GAPA(C1=__builtin_amdgcn_mfma_f32_32x32x16_bf16(kf[7],qr[3],C1,0,0,0),   P1[14],P1[15],0.f,0.f,       pw3[2]=PKW(P1,12),pw3[3]=PKW(P1,14), pw3); \
    l_reg+=sacc; \
    if(GK){DMA_K((t)+3,sl_cur);} if(GV){DMA_V((t)+1,sl_next);} \
    CMASK(C0,C1,t); \
    { float a=MX3(C0[0],C0[1],C1[0]),b=MX3(C0[2],C0[3],C1[1]); a=MX3(a,C1[2],C1[3]); \
      _Pragma("unroll") for(int r=4;r<16;r+=4){a=MX3(a,C0[r],C0[r+1]);b=MX3(b,C0[r+2],C0[r+3]);a=MX3(a,C1[r],C1[r+1]);b=MX3(b,C1[r+2],C1[r+3]);} \
      float rm=__builtin_fmaxf(a,b); { auto rr=__builtin_amdgcn_permlane32_swap(__float_as_uint(rm),__float_as_uint(rm),false,false); rm=__builtin_fmaxf(__uint_as_float(rr[0]),__uint_as_float(rr[1])); } \
      resc=false; \
      if(__builtin_expect(__any(rm>(float)THRL),0)){ const float dl=__builtin_fmaxf(rm,0.f); mhat+=dl; \
        _Pragma("unroll") for(int r=0;r<16;++r){C0[r]-=dl;C1[r]-=dl;} \
        _Pragma("unroll") for(int r=0;r<16;++r)negm[r]=-mhat; asm volatile("":"+v"(negm)); \
        const float f=__builtin_amdgcn_exp2f(-dl); l_reg*=f; if(hi==0)wsf[r32]=f; resc=true; } } \
    SBAR(); \
    GAPB(o[0]=__builtin_amdgcn_mfma_f32_32x32x16_bf16(PAF(0),VFR(0),o[0],0,0,0), C0,0); \
    GAPB(o[1]=__builtin_amdgcn_mfma_f32_32x32x16_bf16(PAF(0),VFR(4),o[1],0,0,0), C0,4); \
    KRD(GL,0); GAPB(o[0]=__builtin_amdgcn_mfma_f32_32x32x16_bf16(PAF(1),VFR(1),o[0],0,0,0), C0,8); \
    KRD(GL,1); GAPB(o[1]=__builtin_amdgcn_mfma_f32_32x32x16_bf16(PAF(1),VFR(5),o[1],0,0,0), C0,12); \
    KRD(GL,2); GAPB(o[0]=__builtin_amdgcn_mfma_f32_32x32x16_bf16(PAF(2),VFR(2),o[0],0,0,0), C1,0); \
    KRD(GL,3); GAPB(o[1]=__builtin_amdgcn_mfma_f32_32x32x16_bf16(PAF(2),VFR(6),o[1],0,0,0), C1,4); \
    GAPB(o[0]=__builtin_amdgcn_mfma_f32_32x32x16_bf16(PAF(3),VFR(3),o[0],0,0,0), C1,8); \
    GAPB(o[1]=__builtin_amdgcn_mfma_f32_32x32x16_bf16(PAF(3),VFR(7),o[1],0,0,0), C1,12); \
    }while(0)
  int t=1;
  #undef CMASK
  #define CMASK(P0,P1,t) do{}while(0)
  for(;t+5<NT;t+=2){
    STEP(pB0,pB1,pA0,pA1,t,true,true,true);     WAIT_BAR(2); RESC(); ROT();
    STEP(pA0,pA1,pB0,pB1,t+1,true,true,true);   WAIT_BAR(2); RESC(); ROT();
  }
  #undef CMASK
  #define CMASK(P0,P1,t) do{int jb_=(t)-(NT-4); if(jb_>=0)cmask(P0,P1,jb_,qrel,hi);}while(0)
  #define ENDW(tt) do{ if((tt)+3<NT){WAIT_BAR(2);} else if((tt)+2<NT){WAIT_BAR(1);} else {WAIT_BAR(0);} }while(0)
  for(;t+1<NT;t+=2){
    STEP(pB0,pB1,pA0,pA1,t,(t+3<NT),(t+1<NT),(t+1<NT));       ENDW(t);   RESC(); ROT();
    STEP(pA0,pA1,pB0,pB1,t+1,(t+4<NT),(t+2<NT),(t+2<NT));     ENDW(t+1); RESC(); ROT();
  }
  STEP(pB0,pB1,pA0,pA1,NT-1,false,false,false); RESC();
  { float sacc=pB0[0]+pB0[1]; _Pragma("unroll") for(int r=2;r<16;++r)sacc+=pB0[r]; _Pragma("unroll") for(int r=0;r<16;++r)sacc+=pB1[r]; l_reg+=sacc;
    pw0=(u32x4){PKW(pB0,0),PKW(pB0,2),PKW(pB0,4),PKW(pB0,6)};pw1=(u32x4){PKW(pB0,8),PKW(pB0,10),PKW(pB0,12),PKW(pB0,14)};pw2=(u32x4){PKW(pB1,0),PKW(pB1,2),PKW(pB1,4),PKW(pB1,6)};pw3=(u32x4){PKW(pB1,8),PKW(pB1,10),PKW(pB1,12),PKW(pB1,14)};
    SBAR(); pv(o,vb0+sl_cur,PAF(0),PAF(1),PAF(2),PAF(3)); }
  #undef PKW
  #undef PAF
  #undef VFR
  #undef PIN
  #undef MX3
  #undef GAPA
  #undef GAPB
  #undef EX
  #undef VRD
  #undef KRD
  #undef STEP
  #undef ENDW
  {auto rr=__builtin_amdgcn_permlane32_swap(__float_as_uint(l_reg),__float_as_uint(l_reg),false,false);l_reg=__uint_as_float(rr[0])+__uint_as_float(rr[1]);}
  if(hi==0)wsf[32+r32]=l_reg;asm volatile("s_waitcnt lgkmcnt(0)":::"memory");
  float rli[16];
  #pragma unroll
  for(int r=0;r<16;++r)rli[r]=__builtin_amdgcn_rcpf(wsf[32+crow(r,hi)]);
  bf16*Ow=O+(rowbase+q0+wid*QBLK)*PITO;
  { bf16*stg=(bf16*)(shm+LDS_OST)+wid*2048;
    #pragma unroll
    for(int r=0;r<16;++r){const int orow=crow(r,hi);
      #pragma unroll
      for(int d0=0;d0<2;++d0)stg[orow*64+d0*32+r32]=__float2bfloat16(o[d0][r]*rli[r]);}
    asm volatile("s_waitcnt lgkmcnt(0)":::"memory");
    #pragma unroll
    for(int i=0;i<4;++i){const int row=i*8+(lane>>3),ch=lane&7; const u32x4 v=*(const u32x4*)(stg+row*64+ch*8); ATTN_STORE16(Ow+(long)row*PITO+ch*8,v);} }
  asm volatile("s_waitcnt lgkmcnt(0)\n\ts_barrier":::"memory");
  #undef DMA_K
  #undef DMA_V
  #undef CMASK
  #undef START
  #undef RESC
  #undef ROT
}
constexpr int ATTN_LDS_BYTES=LDS_BYTES;
#undef SBAR
#undef WAIT_BAR
}

namespace cg = cooperative_groups;
typedef unsigned short bf16_t;
typedef float f32x4 __attribute__((ext_vector_type(4)));
typedef float f32x16 __attribute__((ext_vector_type(16)));
typedef unsigned u32x4 __attribute__((ext_vector_type(4)));
typedef unsigned u32x2 __attribute__((ext_vector_type(2)));
typedef short bf16x8 __attribute__((ext_vector_type(8)));
#define LAS3 __attribute__((address_space(3)))

constexpr int T_ = 32768, DM_ = 1024, SEQ_ = 4096, DFF_ = 2816;
constexpr int NTHR = 512;
constexpr int LDS_BYTES = 147456;
constexpr size_t MiB_ = 1u << 20;
constexpr size_t WS_MOD = 0, WS_COS = 1 * MiB_, WS_SIN = 2 * MiB_, WS_BAR = 3 * MiB_;
constexpr size_t WS_WIN = 4 * MiB_, WS_WOUT = 11 * MiB_, WS_FIN = 13 * MiB_, WS_FOUT = 24 * MiB_;
constexpr size_t WS_A = 32 * MiB_, WS_X2 = 96 * MiB_, WS_ST = 160 * MiB_, WS_TOT = 224 * MiB_, WS_R1 = 226 * MiB_, WS_BIAS = 450 * MiB_, WS_ROWSS = 452 * MiB_, WS_FOUT2 = 454 * MiB_, WS_END = 460 * MiB_;
constexpr int BIAS_L = 8 * (3584 + 5632);
constexpr size_t WS_HP = WS_ST, WS_HU = WS_ST + 12 * MiB_, WS_HA = WS_ST + 24 * MiB_;
constexpr float LOG2E_ = 1.4426950408889634f;
constexpr float QSCALE_ = 0.125f * 1.4426950408889634f;

struct Params {
    const float* x; const float* c; const int* positions; const float* mod_w; const float* mod_b; const float* norm_mix_w; const float* norm_ffn_w;
    const float* ev_w_in; const float* gla_gate_w; const float* gla_gate_b; const float* gla_norm_w; const float* swa_sinks; const float* ev_w_out;
    const float* od_w_in; const float* diff_lambda; const float* diff_norm_w; const float* hgrn_lb_logits; const float* hgrn_norm_w; const float* od_w_out;
    const float* ffn_w_in; const float* ffn_conv_w; const float* ffn_conv_b; const float* ffn_w_out; const float* final_norm_w;
    float* out; unsigned char* ws; unsigned long long pad[6];
};

__device__ __forceinline__ unsigned pk2(float lo, float hi) {
    typedef float f32x2_t __attribute__((ext_vector_type(2))); typedef __bf16 bf16x2_t __attribute__((ext_vector_type(2)));
    f32x2_t v = {lo, hi}; bf16x2_t b = __builtin_convertvector(v, bf16x2_t); return __builtin_bit_cast(unsigned, b);
}
__device__ __forceinline__ float bflo(unsigned u) { return __uint_as_float(u << 16); }
__device__ __forceinline__ float bfhi(unsigned u) { return __uint_as_float(u & 0xffff0000u); }
__device__ __forceinline__ float sigmoidf_(float x) { return __builtin_amdgcn_rcpf(1.f + __expf(-x)); }
__device__ __forceinline__ float siluf_(float x) { return x * __builtin_amdgcn_rcpf(1.f + __expf(-x)); }
__device__ __forceinline__ float wave_sum(float v) {
#pragma unroll
    for (int o = 1; o < 64; o <<= 1) v += __shfl_xor(v, o);
    return v;
}
__device__ __forceinline__ int crow_(int r, int hi) { return (r & 3) + 8 * (r >> 2) + 4 * hi; }

namespace pg8 {
struct EpiProj {
    static constexpr bool PERM = true, AFTER_DRAIN = false;
    bf16_t* O; int ldc; unsigned ropemask; unsigned scalemask; float scale; const float* cs; const float* sn; const float* rowss; const float* bias;
    __device__ __forceinline__ void operator()(const f32x4 (&acc)[2][2][4][2], const Unit& u, int wr, int wc, int fr, int fq) const {
        const int row0 = u.pm * BM + wr * 64 + fr; const int col0 = u.pn * BM + wc * 32 + 8 * fq;
        float rs[2][4];
#pragma unroll
        for (int ai = 0; ai < 2; ++ai)
#pragma unroll
            for (int m = 0; m < 4; ++m) rs[ai][m] = rsqrtf(rowss[row0 + ai * HALF + m * 16] * (1.f / 1024.f) + 1e-6f);
        const float* bp = bias + (size_t)((u.pm * BM) >> 12) * ldc + col0;
#pragma unroll
        for (int bj = 0; bj < 2; ++bj) {
            const f32x4 bv0 = *(const f32x4*)(bp + bj * HALF), bv1 = *(const f32x4*)(bp + bj * HALF + 4);
            const int grp = u.pn * 2 + bj;
            const bool rope = ((ropemask >> grp) & 1u) && ((wc & 1) == 0);
            const float sc = ((scalemask >> grp) & 1u) ? scale : 1.f;
#pragma unroll
            for (int ai = 0; ai < 2; ++ai)
#pragma unroll
                for (int m = 0; m < 4; ++m) {
                    const int row = row0 + ai * HALF + m * 16;
                    f32x4 v0 = acc[ai][bj][m][0] * rs[ai][m] + bv0, v1 = acc[ai][bj][m][1] * rs[ai][m] + bv1;
                    if (rope) {
                        const f32x4 c0 = *(const f32x4*)(cs + (size_t)row * 8), c1 = *(const f32x4*)(cs + (size_t)row * 8 + 4);
                        const f32x4 s0 = *(const f32x4*)(sn + (size_t)row * 8), s1 = *(const f32x4*)(sn + (size_t)row * 8 + 4);
                        const float sg = (fq == 0) ? -1.f : 1.f;
#pragma unroll
                        for (int e = 0; e < 4; ++e) {
                            const float p0 = __shfl_xor(v0[e], 16), p1 = __shfl_xor(v1[e], 16);
                            const float r0 = v0[e] * c0[e] + sg * p0 * s0[e], r1 = v1[e] * c1[e] + sg * p1 * s1[e];
                            if (fq < 2) { v0[e] = r0; v1[e] = r1; }
                        }
                    }
                    v0 = v0 * sc; v1 = v1 * sc;
                    u32x4 w; w.x = pk2(v0[0], v0[1]); w.y = pk2(v0[2], v0[3]); w.z = pk2(v1[0], v1[1]); w.w = pk2(v1[2], v1[3]);
                    *(u32x4*)(O + (size_t)row * ldc + col0 + bj * HALF) = w;
                    asm volatile("" ::: "memory");
                }
        }
    }
};
struct EpiRes {
    static constexpr bool PERM = false, AFTER_DRAIN = false;
    const float* xin; float* xout; const float* gate;
    bf16_t* Aout; const float* nw; const float* sc; float* rowss;
    __device__ __forceinline__ void operator()(const f32x4 (&acc)[2][2][4][2], const Unit& u, int wr, int wc, int fr, int fq) const {
        const int col0 = u.pn * BM + wc * 32 + 4 * fq;
        const size_t boff = (size_t)((u.pm * BM) >> 12) * 6144 + col0;
        f32x4 gv[2][2], wsc[2][2];
#pragma unroll
        for (int bj = 0; bj < 2; ++bj)
#pragma unroll
            for (int n = 0; n < 2; ++n) { gv[bj][n] = *(const f32x4*)(gate + boff + bj * HALF + n * 16);
                if (Aout) wsc[bj][n] = *(const f32x4*)(nw + col0 + bj * HALF + n * 16) * (*(const f32x4*)(sc + boff + bj * HALF + n * 16) + 1.f); }
        const int rowb = u.pm * BM + wr * 64 + fr;
        const size_t off0 = (size_t)rowb * 1024 + col0;
        f32x4 xb[2][2][2];
#pragma unroll
        for (int bj = 0; bj < 2; ++bj)
#pragma unroll
            for (int n = 0; n < 2; ++n) xb[0][bj][n] = *(const f32x4*)(xin + off0 + bj * HALF + n * 16);
#pragma unroll
        for (int grp = 0; grp < 8; ++grp) {
            const int ai = grp >> 2, m = grp & 3;
            if (grp + 1 < 8) {
                const size_t offn = off0 + (size_t)(((grp + 1) >> 2) * HALF + ((grp + 1) & 3) * 16) * 1024;
#pragma unroll
                for (int bj = 0; bj < 2; ++bj)
#pragma unroll
                    for (int n = 0; n < 2; ++n) xb[(grp + 1) & 1][bj][n] = *(const f32x4*)(xin + offn + bj * HALF + n * 16);
            }
            const size_t off = off0 + (size_t)(ai * HALF + m * 16) * 1024;
            float ss = 0.f;
#pragma unroll
            for (int bj = 0; bj < 2; ++bj)
#pragma unroll
                for (int n = 0; n < 2; ++n) {
                    const f32x4 xn = xb[grp & 1][bj][n] + gv[bj][n] * acc[ai][bj][m][n];
                    *(f32x4*)(xout + off + bj * HALF + n * 16) = xn;
                    if (Aout) {
                        ss += (xn[0] * xn[0] + xn[1] * xn[1]) + (xn[2] * xn[2] + xn[3] * xn[3]);
                        const f32x4 a = xn * wsc[bj][n];
                        u32x2 q; q.x = pk2(a[0], a[1]); q.y = pk2(a[2], a[3]);
                        *(u32x2*)(Aout + off + bj * HALF + n * 16) = q;
                    }
                }
            if (Aout) {
                ss += __shfl_xor(ss, 16); ss += __shfl_xor(ss, 32);
                if (fq == 0) atomicAdd(rowss + rowb + ai * HALF + m * 16, ss);
            }
            asm volatile("" ::: "memory");
        }
    }
};
struct EpiFfn {
    static constexpr bool PERM = true, AFTER_DRAIN = false;
    bf16_t* G; float* HP; float* HU; float* HA; const float* cw; const float* cb; const float* rowss; const float* bias;
    __device__ __forceinline__ void operator()(const f32x4 (&acc)[2][2][4][2], const Unit& u, int wr, int wc, int fr, int fq) const {
        const int ch0 = u.pn * 128 + wc * 32 + 8 * fq;
        f32x4 w0[2], w1[2], w2[2], bb[2];
#pragma unroll
        for (int n = 0; n < 2; ++n) { w0[n] = *(const f32x4*)(cw + ch0 + 4 * n); w1[n] = *(const f32x4*)(cw + DFF_ + ch0 + 4 * n); w2[n] = *(const f32x4*)(cw + 2 * DFF_ + ch0 + 4 * n); bb[n] = *(const f32x4*)(cb + ch0 + 4 * n); }
        const int lane = fr + 16 * fq;
        const int src1 = (lane & ~15) | ((fr + 15) & 15), src2 = (lane & ~15) | ((fr + 14) & 15);
        const float* bp = bias + (size_t)((u.pm * BM) >> 12) * 5632 + u.pn * BM + wc * 32 + 8 * fq;
        f32x4 ba[2], bu[2];
#pragma unroll
        for (int n = 0; n < 2; ++n) { ba[n] = *(const f32x4*)(bp + 4 * n); bu[n] = *(const f32x4*)(bp + HALF + 4 * n); }
#pragma unroll
        for (int ai = 0; ai < 2; ++ai) {
            const int seg = u.pm * 4 + ai * 2 + wr;
            f32x4 aprev[2]; aprev[0] = (f32x4){0.f, 0.f, 0.f, 0.f}; aprev[1] = (f32x4){0.f, 0.f, 0.f, 0.f};
#pragma unroll
            for (int m = 0; m < 4; ++m) {
                const int row = u.pm * BM + ai * HALF + wr * 64 + m * 16 + fr;
                const float rs = rsqrtf(rowss[row] * (1.f / 1024.f) + 1e-6f);
                f32x4 val[2], acur[2];
#pragma unroll
                for (int n = 0; n < 2; ++n) {
                    const f32x4 a = acc[ai][0][m][n] * rs + ba[n];
                    acur[n] = a;
                    const f32x4 ap = aprev[n];
#pragma unroll
                    for (int e = 0; e < 4; ++e) {
                        const float t1 = (fr == 15) ? ap[e] : a[e];
                        const float t2 = (fr >= 14) ? ap[e] : a[e];
                        const float p1 = __shfl(t1, src1), p2 = __shfl(t2, src2);
                        val[n][e] = w2[n][e] * a[e] + w1[n][e] * p1 + w0[n][e] * p2 + bb[n][e];
                    }
                }
                const f32x4 u0 = acc[ai][1][m][0] * rs + bu[0], u1 = acc[ai][1][m][1] * rs + bu[1];
                f32x4 g0, g1;
#pragma unroll
                for (int e = 0; e < 4; ++e) { g0[e] = siluf_(val[0][e]) * u0[e]; g1[e] = siluf_(val[1][e]) * u1[e]; }
                u32x4 w; w.x = pk2(g0[0], g0[1]); w.y = pk2(g0[2], g0[3]); w.z = pk2(g1[0], g1[1]); w.w = pk2(g1[2], g1[3]);
                *(u32x4*)(G + (size_t)row * DFF_ + ch0) = w;
                if (m == 0 && fr < 2) {
                    const size_t ho = (size_t)(seg * 2 + fr) * DFF_ + ch0;
                    *(f32x4*)(HP + ho) = val[0]; *(f32x4*)(HP + ho + 4) = val[1];
                    *(f32x4*)(HU + ho) = u0; *(f32x4*)(HU + ho + 4) = u1;
                }
                if (m == 3 && fr >= 14) {
                    const size_t ho = (size_t)(seg * 2 + (fr - 14)) * DFF_ + ch0;
                    *(f32x4*)(HA + ho) = acur[0]; *(f32x4*)(HA + ho + 4) = acur[1];
                }
                aprev[0] = acur[0]; aprev[1] = acur[1];
                asm volatile("" ::: "memory");
            }
        }
    }
};
}

struct Ctx { Params p; unsigned char* lds; int tid, lane, wave, gw, ngw; };

__device__ __forceinline__ void phase_prologue(const Ctx& C) {
    const Params& p = C.p;
    float* cact = (float*)C.lds;
    float* red = (float*)(C.lds + 32768);
    float* mod = (float*)(p.ws + WS_MOD);
    const int tid = C.tid;
    for (int i = tid; i < 8192; i += NTHR) { const float c = p.c[i]; cact[i] = c / (1.f + __expf(-c)); }
    __syncthreads();
    const int col = tid & 63, kp = tid >> 6;
    for (int g = blockIdx.x; g < 384; g += gridDim.x) {
        const int l = g / 96, j = (g % 96) * 64 + col;
        const float* w = p.mod_w + (size_t)l * 1024 * 6144 + (size_t)(kp * 128) * 6144 + j;
        float a0 = 0.f, a1 = 0.f, a2 = 0.f, a3 = 0.f, a4 = 0.f, a5 = 0.f, a6 = 0.f, a7 = 0.f;
        const float* ca = cact + kp * 128;
#pragma unroll 8
        for (int k = 0; k < 128; ++k) {
            const float wv = w[(size_t)k * 6144];
            a0 += ca[k] * wv; a1 += ca[1024 + k] * wv; a2 += ca[2048 + k] * wv; a3 += ca[3072 + k] * wv;
            a4 += ca[4096 + k] * wv; a5 += ca[5120 + k] * wv; a6 += ca[6144 + k] * wv; a7 += ca[7168 + k] * wv;
        }
        float* r = red + (kp * 8) * 64 + col;
        r[0] = a0; r[64] = a1; r[128] = a2; r[192] = a3; r[256] = a4; r[320] = a5; r[384] = a6; r[448] = a7;
        __syncthreads();
        { const int b = tid >> 6; float s = 0.f;
#pragma unroll
          for (int kk = 0; kk < 8; ++kk) s += red[(kk * 8 + b) * 64 + col];
          mod[(size_t)(l * 8 + b) * 6144 + j] = s + p.mod_b[l * 6144 + j]; }
        __syncthreads();
    }
    {
        u32x4* zb = (u32x4*)(p.ws + WS_BIAS); const int nzb = 4 * BIAS_L * 4 / 16;
        for (int i = blockIdx.x * NTHR + tid; i < nzb; i += gridDim.x * NTHR) zb[i] = (u32x4){0u, 0u, 0u, 0u};
        u32x4* zr = (u32x4*)(p.ws + WS_ROWSS);
        for (int i = blockIdx.x * NTHR + tid; i < 8 * T_ * 4 / 16; i += gridDim.x * NTHR) zr[i] = (u32x4){0u, 0u, 0u, 0u};
    }
    float* cs = (float*)(p.ws + WS_COS); float* sn = (float*)(p.ws + WS_SIN);
    const float invf[8] = {1.0f, 0.1939227432012558f, 0.03760603070259094f, 0.007292664609849453f, 0.0014142135623842478f, 0.00027424818836152554f, 5.3182957344688475e-05f, 1.0313385246263351e-05f};
    for (int r = blockIdx.x * NTHR + tid; r < T_; r += gridDim.x * NTHR) {
        const float pos = (float)p.positions[r];
        f32x4 c4[2], s4[2];
#pragma unroll
        for (int i = 0; i < 8; ++i) {
            const float ang = pos * invf[i];
            const double xr = (double)ang * 0.15915494309189535;
            const float f = (float)(xr - rint(xr));
            c4[i >> 2][i & 3] = __builtin_amdgcn_cosf(f); s4[i >> 2][i & 3] = __builtin_amdgcn_sinf(f);
        }
        *(f32x4*)(cs + (size_t)r * 8) = c4[0]; *(f32x4*)(cs + (size_t)r * 8 + 4) = c4[1];
        *(f32x4*)(sn + (size_t)r * 8) = s4[0]; *(f32x4*)(sn + (size_t)r * 8 + 4) = s4[1];
    }
}

__device__ __forceinline__ void tr_item(const float* W, int Nsrc, int srccol0, bf16_t* WT, int K, int dstrow0, int k0, float* scr, int lane) {
#pragma unroll 8
    for (int i = 0; i < 32; ++i) { const int kk = 2 * i + (lane >> 5); scr[kk * 33 + (lane & 31)] = W[(size_t)(k0 + kk) * Nsrc + srccol0 + (lane & 31)]; }
    asm volatile("s_waitcnt lgkmcnt(0)" ::: "memory");
    const int c = lane & 7;
#pragma unroll
    for (int j = 0; j < 4; ++j) { const int n = (lane >> 3) + 8 * j; const float* s = scr + (8 * c) * 33 + n;
        u32x4 o; o.x = pk2(s[0 * 33], s[1 * 33]); o.y = pk2(s[2 * 33], s[3 * 33]); o.z = pk2(s[4 * 33], s[5 * 33]); o.w = pk2(s[6 * 33], s[7 * 33]);
        *(u32x4*)(WT + (size_t)(dstrow0 + n) * K + k0 + 8 * c) = o; }
    asm volatile("s_waitcnt lgkmcnt(0)" ::: "memory");
}
__device__ __forceinline__ void phase_convert(const Ctx& C, int l) {
    const Params& p = C.p; const int j = l >> 1; const bool even = !(l & 1);
    float* scr = (float*)(C.lds + C.wave * 8704);
    bf16_t* WIN = (bf16_t*)(p.ws + WS_WIN); bf16_t* WOUT = (bf16_t*)(p.ws + WS_WOUT); bf16_t* FIN = (bf16_t*)(p.ws + WS_FIN); bf16_t* FOUT = (bf16_t*)(p.ws + ((l & 1) ? WS_FOUT2 : WS_FOUT));
    const int nA = even ? 80 : 112;
    const int IA = 16 * nA, IB = 16 * 32, IC = 16 * 176, ID = 44 * 32;
    const float* win = even ? p.ev_w_in + (size_t)j * 1024 * 2320 : p.od_w_in + (size_t)j * 1024 * 3584;
    const float* wout = even ? p.ev_w_out + (size_t)j * 1024 * 1024 : p.od_w_out + (size_t)j * 1024 * 1024;
    const float* fin = p.ffn_w_in + (size_t)l * 1024 * 5632; const float* fout = p.ffn_w_out + (size_t)l * 2816 * 1024;
    for (int it = C.gw; it < IA + IB + IC + ID; it += C.ngw) {
        int r = it;
        if (r < IA) { const int kb = r / nA, nb = r % nA, n0 = nb * 32; int sc = n0;
            if (even) { if (n0 >= 512 && n0 < 768) continue; if (n0 >= 1792) sc = n0 - 240; else if (n0 >= 768) sc = n0 - 256; }
            tr_item(win, even ? 2320 : 3584, sc, WIN, 1024, n0, kb * 64, scr, C.lane); continue; }
        r -= IA;
        if (r < IB) { const int kb = r / 32, nb = r % 32; tr_item(wout, 1024, nb * 32, WOUT, 1024, nb * 32, kb * 64, scr, C.lane); continue; }
        r -= IB;
        if (r < IC) { const int kb = r / 176, nb = r % 176, n0 = nb * 32; const int pn = n0 >> 8, jj = n0 & 255;
            const int sc = (jj < 128) ? pn * 128 + jj : 2816 + pn * 128 + (jj - 128);
            tr_item(fin, 5632, sc, FIN, 1024, n0, kb * 64, scr, C.lane); continue; }
        r -= IC;
        { const int kb = r / 32, nb = r % 32; tr_item(fout, 1024, nb * 32, FOUT, 2816, nb * 32, kb * 64, scr, C.lane); }
    }
    {
        float* shl = (float*)(C.lds + 69632);
        const float* modl = (const float*)(p.ws + WS_MOD) + (size_t)l * 8 * 6144;
        __syncthreads();
        for (int i2 = C.tid; i2 < 2 * 8192; i2 += NTHR) { const int which = i2 >> 13, k = (i2 >> 3) & 1023, b = i2 & 7; shl[i2] = modl[(size_t)b * 6144 + (which ? 3072 : 0) + k]; }
        __syncthreads();
        float* bias_in = (float*)(p.ws + WS_BIAS) + (size_t)l * BIAS_L; float* bias_ff = bias_in + 8 * 3584;
        const int Nin = even ? 2560 : 3584, Nsrc = even ? 2320 : 3584;
        const float* gwp = p.gla_gate_w + (size_t)j * 16 * 256;
        for (int u = blockIdx.x * NTHR + C.tid; u < (Nin + 5632) * 16; u += gridDim.x * NTHR) {
            const bool ff = u >= Nin * 16; const int uu = ff ? u - Nin * 16 : u, N = ff ? 5632 : Nin, n = uu % N, kp = uu / N;
            float a[8];
#pragma unroll
            for (int b = 0; b < 8; ++b) a[b] = 0.f;
            const float* shp = shl + (ff ? 8192 : 0) + kp * 64 * 8;
            if (!ff && even && n >= 512 && n < 768) {
                float g[16];
#pragma unroll
                for (int r = 0; r < 16; ++r) g[r] = gwp[r * 256 + (n - 512)];
                for (int k = 0; k < 64; ++k) {
                    const float* wr = win + (size_t)(kp * 64 + k) * 2320 + 1536;
                    float wv = 0.f;
#pragma unroll
                    for (int r = 0; r < 16; ++r) wv += wr[r] * g[r];
                    const f32x4 s0 = *(const f32x4*)(shp + k * 8), s1 = *(const f32x4*)(shp + k * 8 + 4);
                    a[0] += s0[0] * wv; a[1] += s0[1] * wv; a[2] += s0[2] * wv; a[3] += s0[3] * wv; a[4] += s1[0] * wv; a[5] += s1[1] * wv; a[6] += s1[2] * wv; a[7] += s1[3] * wv;
                }
            } else {
                int sc; const float* W; int Ns;
                if (ff) { const int pn = n >> 8, jj = n & 255; sc = (jj < 128) ? pn * 128 + jj : 2816 + pn * 128 + (jj - 128); W = fin; Ns = 5632; }
                else { sc = n; if (even) { if (n >= 1792) sc = n - 240; else if (n >= 768) sc = n - 256; } W = win; Ns = Nsrc; }
                const float* wp = W + (size_t)(kp * 64) * Ns + sc;
#pragma unroll 8
                for (int k = 0; k < 64; ++k) {
                    const float wv = wp[(size_t)k * Ns];
                    const f32x4 s0 = *(const f32x4*)(shp + k * 8), s1 = *(const f32x4*)(shp + k * 8 + 4);
                    a[0] += s0[0] * wv; a[1] += s0[1] * wv; a[2] += s0[2] * wv; a[3] += s0[3] * wv; a[4] += s1[0] * wv; a[5] += s1[1] * wv; a[6] += s1[2] * wv; a[7] += s1[3] * wv;
                }
            }
            float* bo = (ff ? bias_ff : bias_in) + n;
#pragma unroll
            for (int b = 0; b < 8; ++b) atomicAdd(bo + (size_t)b * N, a[b]);
        }
    }
    if (even) {
        const float* gw = p.gla_gate_w + (size_t)j * 16 * 256;
        for (int u = blockIdx.x * NTHR + C.tid; u < 256 * 128; u += gridDim.x * NTHR) {
            const int k8 = u & 127, n = u >> 7;
            float g[16];
#pragma unroll
            for (int r = 0; r < 16; ++r) g[r] = gw[r * 256 + n];
            float o[8];
#pragma unroll
            for (int e = 0; e < 8; ++e) {
                const float* wr = win + (size_t)(k8 * 8 + e) * 2320 + 1536;
                const f32x4 a0 = *(const f32x4*)wr, a1 = *(const f32x4*)(wr + 4), a2 = *(const f32x4*)(wr + 8), a3 = *(const f32x4*)(wr + 12);
                o[e] = a0[0] * g[0] + a0[1] * g[1] + a0[2] * g[2] + a0[3] * g[3] + a1[0] * g[4] + a1[1] * g[5] + a1[2] * g[6] + a1[3] * g[7]
                     + a2[0] * g[8] + a2[1] * g[9] + a2[2] * g[10] + a2[3] * g[11] + a3[0] * g[12] + a3[1] * g[13] + a3[2] * g[14] + a3[3] * g[15];
            }
            u32x4 w; w.x = pk2(o[0], o[1]); w.y = pk2(o[2], o[3]); w.z = pk2(o[4], o[5]); w.w = pk2(o[6], o[7]);
            *(u32x4*)(WIN + (size_t)(512 + n) * 1024 + k8 * 8) = w;
        }
    }
}

__device__ __forceinline__ void phase_prep(const Ctx& C, const float* xin, const float* w, const float* modl, int scoff, bf16_t* out, float* rowss) {
    for (int row = C.gw; row < T_; row += C.ngw) {
        const f32x4* xr = (const f32x4*)(xin + (size_t)row * 1024) + C.lane;
        f32x4 v[4]; float ss = 0.f;
#pragma unroll
        for (int j = 0; j < 4; ++j) { v[j] = xr[64 * j]; ss += (v[j].x * v[j].x + v[j].y * v[j].y) + (v[j].z * v[j].z + v[j].w * v[j].w); }
        ss = wave_sum(ss);
        if (C.lane == 0) rowss[row] = ss;
        const float* mb = modl + (size_t)(row >> 12) * 6144;
        u32x2* o8 = (u32x2*)(out + (size_t)row * 1024) + C.lane;
#pragma unroll
        for (int j = 0; j < 4; ++j) {
            const int col = 4 * C.lane + 256 * j;
            const f32x4 w4 = *(const f32x4*)(w + col), sc = *(const f32x4*)(mb + scoff + col);
            const f32x4 y = v[j] * w4 * (sc + 1.f);
            u32x2 q; q.x = pk2(y.x, y.y); q.y = pk2(y.z, y.w); o8[64 * j] = q;
        }
    }
}
__device__ __forceinline__ void phase_final_norm(const Ctx& C, float* x, const float* w) {
    for (int row = C.gw; row < T_; row += C.ngw) {
        f32x4* xr = (f32x4*)(x + (size_t)row * 1024) + C.lane;
        f32x4 v[4]; float ss = 0.f;
#pragma unroll
        for (int j = 0; j < 4; ++j) { v[j] = xr[64 * j]; ss += (v[j].x * v[j].x + v[j].y * v[j].y) + (v[j].z * v[j].z + v[j].w * v[j].w); }
        const float rs = rsqrtf(wave_sum(ss) * (1.f / 1024.f) + 1e-6f);
#pragma unroll
        for (int j = 0; j < 4; ++j) { const f32x4 w4 = *(const f32x4*)(w + 4 * C.lane + 256 * j); xr[64 * j] = (v[j] * rs) * w4; }
    }
}

__device__ __forceinline__ void phase_diff_combine(const Ctx& C, int l) {
    const Params& p = C.p; const int j = l >> 1;
    const float lam_init = 0.8f - 0.6f * expf(-0.3f * (float)l);
    const float* lv = p.diff_lambda + j * 256;
    const float s1 = wave_sum(lv[C.lane] * lv[64 + C.lane]), s2 = wave_sum(lv[128 + C.lane] * lv[192 + C.lane]);
    const float lam = expf(s1) - expf(s2) + lam_init;
    const bf16_t* X2 = (const bf16_t*)(p.ws + WS_X2); bf16_t* A = (bf16_t*)(p.ws + WS_A);
    const int head = C.lane >> 4, d0 = (C.lane & 15) * 8;
    const float* nw = p.diff_norm_w + j * 128 + d0;
    const f32x4 n0 = *(const f32x4*)nw, n1 = *(const f32x4*)(nw + 4);
    const float og = 1.f - lam_init;
    for (int row = C.gw; row < T_; row += C.ngw) {
        const bf16_t* src = X2 + (size_t)row * 1024 + head * 256 + d0;
        const u32x4 a = *(const u32x4*)src, b = *(const u32x4*)(src + 128);
        float od[8];
        od[0] = bflo(a.x) - lam * bflo(b.x); od[1] = bfhi(a.x) - lam * bfhi(b.x); od[2] = bflo(a.y) - lam * bflo(b.y); od[3] = bfhi(a.y) - lam * bfhi(b.y);
        od[4] = bflo(a.z) - lam * bflo(b.z); od[5] = bfhi(a.z) - lam * bfhi(b.z); od[6] = bflo(a.w) - lam * bflo(b.w); od[7] = bfhi(a.w) - lam * bfhi(b.w);
        float ss = 0.f;
#pragma unroll
        for (int e = 0; e < 8; ++e) ss += od[e] * od[e];
        ss += __shfl_xor(ss, 1); ss += __shfl_xor(ss, 2); ss += __shfl_xor(ss, 4); ss += __shfl_xor(ss, 8);
        const float rs = rsqrtf(ss * (1.f / 128.f) + 1e-6f) * og;
        u32x4 w; w.x = pk2(od[0] * rs * n0[0], od[1] * rs * n0[1]); w.y = pk2(od[2] * rs * n0[2], od[3] * rs * n0[3]);
        w.z = pk2(od[4] * rs * n1[0], od[5] * rs * n1[1]); w.w = pk2(od[6] * rs * n1[2], od[7] * rs * n1[3]);
        *(u32x4*)(A + (size_t)row * 1024 + head * 128 + d0) = w;
    }
}

__device__ __forceinline__ void phase_ffn_fixup(const Ctx& C, int l) {
    const Params& p = C.p;
    const float* HP = (const float*)(p.ws + WS_HP); const float* HU = (const float*)(p.ws + WS_HU); const float* HA = (const float*)(p.ws + WS_HA);
    bf16_t* G = (bf16_t*)(p.ws + WS_R1);
    const float* cw = p.ffn_conv_w + (size_t)l * 3 * DFF_;
    for (int u = blockIdx.x * NTHR + C.tid; u < 512 * 2 * 704; u += gridDim.x * NTHR) {
        const int c4 = u % 704, sj = u / 704, jj = sj & 1, seg = sj >> 1, ch = c4 * 4;
        const size_t ho = (size_t)sj * DFF_ + ch;
        f32x4 val = *(const f32x4*)(HP + ho); const f32x4 uu = *(const f32x4*)(HU + ho);
        if ((seg & 63) != 0) {
            const f32x4 am1 = *(const f32x4*)(HA + (size_t)((seg - 1) * 2 + 1) * DFF_ + ch), am2 = *(const f32x4*)(HA + (size_t)((seg - 1) * 2) * DFF_ + ch);
            const f32x4 w0 = *(const f32x4*)(cw + ch), w1 = *(const f32x4*)(cw + DFF_ + ch);
            if (jj == 0) val = val + w1 * am1 + w0 * am2; else val = val + w0 * am1;
        }
        u32x2 q; q.x = pk2(siluf_(val.x) * uu.x, siluf_(val.y) * uu.y); q.y = pk2(siluf_(val.z) * uu.z, siluf_(val.w) * uu.w);
        *(u32x2*)(G + (size_t)(seg * 64 + jj) * DFF_ + ch) = q;
    }
}

__device__ __forceinline__ void phase_swa(const Ctx& C, int l) {
    const Params& p = C.p;
    const bf16_t* proj = (const bf16_t*)(p.ws + WS_R1); bf16_t* A = (bf16_t*)(p.ws + WS_A);
    bf16_t* Ks = (bf16_t*)C.lds;
    bf16_t* Vt = (bf16_t*)(C.lds + 27648);
    const int tid = C.tid, lane = C.lane, wid = C.wave, r32 = lane & 31, hi = lane >> 5;
    const float* sinks = p.swa_sinks + (l >> 1) * 8;
    for (int u = blockIdx.x; u < 1024; u += gridDim.x) {
        const int b = u >> 7, kvh = (u >> 6) & 1, qb = u & 63, q0 = qb * 64; const size_t rowbase = (size_t)b * SEQ_;
        for (int c = tid; c < 1536; c += NTHR) {
            const int kk = c >> 3, ch = c & 7, pl = q0 - 128 + kk;
            u32x4 kv = (u32x4){0u, 0u, 0u, 0u}, vv = (u32x4){0u, 0u, 0u, 0u};
            if (pl >= 0) { const bf16_t* src = proj + (rowbase + pl) * 2560 + 2304 + kvh * 64 + ch * 8; kv = *(const u32x4*)src; vv = *(const u32x4*)(src + 128); }
            *(u32x4*)(Ks + kk * 72 + ch * 8) = kv;
            bf16_t* vd = Vt + (ch * 8) * 200 + kk;
            vd[0] = (bf16_t)(vv.x & 0xffffu); vd[200] = (bf16_t)(vv.x >> 16); vd[400] = (bf16_t)(vv.y & 0xffffu); vd[600] = (bf16_t)(vv.y >> 16);
            vd[800] = (bf16_t)(vv.z & 0xffffu); vd[1000] = (bf16_t)(vv.z >> 16); vd[1200] = (bf16_t)(vv.w & 0xffffu); vd[1400] = (bf16_t)(vv.w >> 16);
        }
        __syncthreads();
        const int g = wid >> 1, qh = kvh * 4 + g, qhalf = wid & 1, pq = q0 + 32 * qhalf + r32;
        const bf16_t* qsrc = proj + (rowbase + pq) * 2560 + 1792 + qh * 64;
        bf16x8 qr[4];
#pragma unroll
        for (int d0 = 0; d0 < 4; ++d0) qr[d0] = *(const bf16x8*)(qsrc + d0 * 16 + hi * 8);
        f32x16 s[5];
#pragma unroll
        for (int t = 0; t < 5; ++t) {
            f32x16 a = {};
#pragma unroll
            for (int d0 = 0; d0 < 4; ++d0) {
                const bf16x8 kf = *(const bf16x8*)(Ks + (32 * (qhalf + t) + r32) * 72 + d0 * 16 + hi * 8);
                a = __builtin_amdgcn_mfma_f32_32x32x16_bf16(kf, qr[d0], a, 0, 0, 0);
            }
            s[t] = a;
        }
        const float sink2 = sinks[qh] * LOG2E_;
        float mx = sink2;
#pragma unroll
        for (int t = 0; t < 5; ++t)
#pragma unroll
            for (int r = 0; r < 16; ++r) {
                const int pk = q0 - 128 + 32 * (qhalf + t) + crow_(r, hi);
                const bool valid = (pk >= 0) && (pk <= pq) && (pq - pk < 128);
                const float v = valid ? s[t][r] : -INFINITY; s[t][r] = v; mx = fmaxf(mx, v);
            }
        mx = fmaxf(mx, __shfl_xor(mx, 32));
        float sum = 0.f;
#pragma unroll
        for (int t = 0; t < 5; ++t)
#pragma unroll
            for (int r = 0; r < 16; ++r) { const float e = __builtin_amdgcn_exp2f(s[t][r] - mx); s[t][r] = e; sum += e; }
        sum += __shfl_xor(sum, 32);
        sum += __builtin_amdgcn_exp2f(sink2 - mx);
        const float inv = 1.f / sum;
        f32x16 o[2]; o[0] = f32x16{}; o[1] = f32x16{};
#pragma unroll
        for (int t = 0; t < 5; ++t)
#pragma unroll
            for (int ss = 0; ss < 2; ++ss) {
                u32x4 pw; pw.x = pk2(s[t][8 * ss + 0], s[t][8 * ss + 1]); pw.y = pk2(s[t][8 * ss + 2], s[t][8 * ss + 3]); pw.z = pk2(s[t][8 * ss + 4], s[t][8 * ss + 5]); pw.w = pk2(s[t][8 * ss + 6], s[t][8 * ss + 7]);
                const bf16x8 pf = __builtin_bit_cast(bf16x8, pw);
#pragma unroll
                for (int dt = 0; dt < 2; ++dt) {
                    const bf16_t* vp = Vt + (32 * dt + r32) * 200 + 32 * (qhalf + t) + 16 * ss + 4 * hi;
                    const u32x2 lo = *(const u32x2*)vp, h2 = *(const u32x2*)(vp + 8);
                    u32x4 vw; vw.x = lo.x; vw.y = lo.y; vw.z = h2.x; vw.w = h2.y;
                    o[dt] = __builtin_amdgcn_mfma_f32_32x32x16_bf16(__builtin_bit_cast(bf16x8, vw), pf, o[dt], 0, 0, 0);
                }
            }
        bf16_t* orow = A + (rowbase + pq) * 1024 + 512 + qh * 64;
#pragma unroll
        for (int dt = 0; dt < 2; ++dt)
#pragma unroll
            for (int g4 = 0; g4 < 4; ++g4) {
                u32x2 q; q.x = pk2(o[dt][4 * g4] * inv, o[dt][4 * g4 + 1] * inv); q.y = pk2(o[dt][4 * g4 + 2] * inv, o[dt][4 * g4 + 3] * inv);
                *(u32x2*)(orow + 32 * dt + 8 * g4 + 4 * hi) = q;
            }
        __syncthreads();
    }
}

template <int MODE> struct LaCfg {
    static constexpr int DK = MODE ? 128 : 64, LQ = DK + 8, LG = DK + 4, PITCH = MODE ? 3584 : 2560, NG = DK / 8;
    static constexpr int QCOL = MODE ? 1536 : 0, KCOL = MODE ? 0 : 256, ZCOL = MODE ? 2048 : 512, VCOL = MODE ? 2560 : 768, GCOL = MODE ? 3072 : 1280, OCOL = MODE ? 512 : 0;
    static constexpr int O_QB = 0, O_KB = O_QB + 64 * LQ * 2, O_GF = O_KB + 64 * LQ * 2, O_VT = O_GF + 64 * LG * 4, O_SC = O_VT + 128 * 72 * 2, O_QE = O_SC + 64 * 72 * 2,
                         O_KT = O_QE + 64 * LQ * 2  , O_SEG = O_KT + DK * 72 * 2, O_RED = O_SEG + 8 * 128 * 4, O_PAR = O_RED + 8 * 64 * 4, O_END = O_PAR + 128 * 4;
    static_assert(O_END <= LDS_BYTES, "LA LDS map");
};
__device__ __forceinline__ void unpack8(const u32x4 w, float (&f)[8]) { f[0] = bflo(w.x); f[1] = bfhi(w.x); f[2] = bflo(w.y); f[3] = bfhi(w.y); f[4] = bflo(w.z); f[5] = bfhi(w.z); f[6] = bflo(w.w); f[7] = bfhi(w.w); }
__device__ __forceinline__ u32x4 pack8(const float (&f)[8]) { u32x4 w; w.x = pk2(f[0], f[1]); w.y = pk2(f[2], f[3]); w.z = pk2(f[4], f[5]); w.w = pk2(f[6], f[7]); return w; }
__device__ __forceinline__ void ld8f(const float* p, float (&f)[8]) { const f32x4 a = *(const f32x4*)p, b = *(const f32x4*)(p + 4); f[0] = a[0]; f[1] = a[1]; f[2] = a[2]; f[3] = a[3]; f[4] = b[0]; f[5] = b[1]; f[6] = b[2]; f[7] = b[3]; }

template <int MODE> struct LaRaw { static constexpr int NI = 64 * LaCfg<MODE>::NG / NTHR; u32x4 z[NI], k[NI], q[NI], v[2]; };
template <int MODE, bool NEEDQ> __device__ __forceinline__ void la_fetch(const Ctx& C, int b, int h, int c, LaRaw<MODE>& R) {
    typedef LaCfg<MODE> Cf; const bf16_t* proj = (const bf16_t*)(C.p.ws + WS_R1);
    const size_t row0 = (size_t)b * SEQ_ + (size_t)c * 64;
#pragma unroll
    for (int it = 0; it < LaRaw<MODE>::NI; ++it) {
        const int u = C.tid + it * NTHR, r = u / Cf::NG, kk = (u % Cf::NG) * 8;
        const bf16_t* rp = proj + (row0 + r) * Cf::PITCH + h * Cf::DK + kk;
        R.z[it] = *(const u32x4*)(rp + Cf::ZCOL);
        if (MODE == 0) R.k[it] = *(const u32x4*)(rp + Cf::KCOL);
        if (NEEDQ) R.q[it] = *(const u32x4*)(rp + Cf::QCOL);
    }
#pragma unroll
    for (int it = 0; it < 2; ++it) {
        const int u = C.tid + it * NTHR, r = u >> 4, g8 = u & 15;
        R.v[it] = *(const u32x4*)(proj + (row0 + r) * Cf::PITCH + Cf::VCOL + h * 128 + g8 * 8);
    }
}
template <int MODE, bool NEEDQ> __device__ __forceinline__ void la_store(const Ctx& C, const LaRaw<MODE>& R, const float* par, bf16_t* Qb, bf16_t* Kb, float* Gf, bf16_t* Vt) {
    typedef LaCfg<MODE> Cf;
#pragma unroll
    for (int it = 0; it < LaRaw<MODE>::NI; ++it) {
        const int u = C.tid + it * NTHR, r = u / Cf::NG, kk = (u % Cf::NG) * 8;
        float z[8], kv[8], lg[8], pc[8];
        unpack8(R.z[it], z); ld8f(par + kk, pc);
        if (MODE == 0) {
            unpack8(R.k[it], kv);
#pragma unroll
            for (int e = 0; e < 8; ++e) { const float x = z[e] + pc[e]; lg[e] = (fminf(x, 0.f) * LOG2E_ - __log2f(1.f + __expf(-fabsf(x)))) * (1.f / 16.f); }
        } else {
#pragma unroll
            for (int e = 0; e < 8; ++e) {
                const float zz = fminf(fmaxf(z[e], -60.f), 60.f), ez = __expf(-zz), sg = __builtin_amdgcn_rcpf(1.f + ez), lb = pc[e];
                lg[e] = __log2f(lb + (1.f - lb) * sg); kv[e] = (1.f - lb) * (ez * sg);
            }
        }
        *(u32x4*)(Kb + r * Cf::LQ + kk) = pack8(kv);
        float* gd = Gf + r * Cf::LG + kk;
        *(f32x4*)gd = (f32x4){lg[0], lg[1], lg[2], lg[3]}; *(f32x4*)(gd + 4) = (f32x4){lg[4], lg[5], lg[6], lg[7]};
        if (NEEDQ) {
            float q[8]; unpack8(R.q[it], q);
#pragma unroll
            for (int e = 0; e < 8; ++e) q[e] = MODE ? siluf_(q[e]) * 0.08838834764831845f : q[e] * 0.125f;
            *(u32x4*)(Qb + r * Cf::LQ + kk) = pack8(q);
        }
    }
#pragma unroll
    for (int it = 0; it < 2; ++it) {
        const int u = C.tid + it * NTHR, r = u >> 4, g8 = u & 15;
        const u32x4 w = R.v[it];
        bf16_t* vd = Vt + (g8 * 8) * 72 + r;
        vd[0] = (bf16_t)(w.x & 0xffffu); vd[72] = (bf16_t)(w.x >> 16); vd[144] = (bf16_t)(w.y & 0xffffu); vd[216] = (bf16_t)(w.y >> 16);
        vd[288] = (bf16_t)(w.z & 0xffffu); vd[360] = (bf16_t)(w.z >> 16); vd[432] = (bf16_t)(w.w & 0xffffu); vd[504] = (bf16_t)(w.w >> 16);
    }
}
template <int MODE> __device__ __forceinline__ void la_params(const Ctx& C, int l, int h, float* par) {
    typedef LaCfg<MODE> Cf; const int j = l >> 1;
    if (C.tid < Cf::DK) {
        if (MODE == 0) par[C.tid] = C.p.gla_gate_b[j * 256 + h * 64 + C.tid];
        else { const float* lg0 = C.p.hgrn_lb_logits + h * 128 + C.tid; par[C.tid] = (j == 0) ? 0.f : sigmoidf_(lg0[512] - lg0[0]); }
    }
}
template <int MODE> __device__ __forceinline__ void la_cumsum(const Ctx& C, float* Gf, float* segs) {
    typedef LaCfg<MODE> Cf; constexpr int DK = Cf::DK, NSEG = NTHR / DK, RPS = 64 / NSEG;
    const int k = C.tid % DK, seg = C.tid / DK;
    float v[RPS];
#pragma unroll
    for (int i = 0; i < RPS; ++i) v[i] = Gf[(seg * RPS + i) * Cf::LG + k];
#pragma unroll
    for (int i = 1; i < RPS; ++i) v[i] += v[i - 1];
    segs[seg * DK + k] = v[RPS - 1];
    __syncthreads();
    float off = 0.f;
#pragma unroll
    for (int s = 0; s < NSEG; ++s) { const float t = segs[s * DK + k]; off += (s < seg) ? t : 0.f; }
#pragma unroll
    for (int i = 0; i < RPS; ++i) Gf[(seg * RPS + i) * Cf::LG + k] = v[i] + off;
}

template <int MODE> __device__ __forceinline__ void phase_la_p1(const Ctx& C, int l) {
    typedef LaCfg<MODE> Cf; const Params& p = C.p; constexpr int DK = Cf::DK, LQ = Cf::LQ, LG = Cf::LG, NG = Cf::NG;
    bf16_t* Kb = (bf16_t*)(C.lds + Cf::O_KB); float* Gf = (float*)(C.lds + Cf::O_GF); bf16_t* Vt = (bf16_t*)(C.lds + Cf::O_VT);
    bf16_t* KhT = (bf16_t*)(C.lds + Cf::O_KT); float* segs = (float*)(C.lds + Cf::O_SEG);
    bf16_t* ST = (bf16_t*)(p.ws + WS_ST); float* TOT = (float*)(p.ws + WS_TOT);
    const int r16 = C.lane & 15, g = C.lane >> 4, w = C.wave;
    float* par = (float*)(C.lds + Cf::O_PAR);
    LaRaw<MODE> R; int hcur = -1;
    if ((int)blockIdx.x < 2048) la_fetch<MODE, false>(C, (int)blockIdx.x >> 8, ((int)blockIdx.x >> 6) & 3, (int)blockIdx.x & 63, R);
    for (int it = blockIdx.x; it < 2048; it += gridDim.x) {
        const int bh = it >> 6, c = it & 63, b = bh >> 2, h = bh & 3;
        if (h != hcur) { la_params<MODE>(C, l, h, par); hcur = h; __syncthreads(); }
        la_store<MODE, false>(C, R, par, nullptr, Kb, Gf, Vt);
        { const int nx = it + (int)gridDim.x; if (nx < 2048) la_fetch<MODE, false>(C, nx >> 8, (nx >> 6) & 3, nx & 63, R); }
        __syncthreads();
        la_cumsum<MODE>(C, Gf, segs);
        __syncthreads();
        for (int u = C.tid; u < 64 * NG; u += NTHR) {
            const int r = u / NG, kk = (u % NG) * 8;
            float kv[8], gj[8], gt[8];
            unpack8(*(const u32x4*)(Kb + r * LQ + kk), kv); ld8f(Gf + r * LG + kk, gj); ld8f(Gf + 63 * LG + kk, gt);
            bf16_t* kd = KhT + kk * 72 + r;
#pragma unroll
            for (int e = 0; e < 8; e += 2) { const unsigned pw = pk2(kv[e] * __builtin_amdgcn_exp2f(gt[e] - gj[e]), kv[e + 1] * __builtin_amdgcn_exp2f(gt[e + 1] - gj[e + 1]));
                kd[e * 72] = (bf16_t)(pw & 0xffffu); kd[(e + 1) * 72] = (bf16_t)(pw >> 16); }
        }
        if (C.tid < DK) TOT[(size_t)it * 128 + C.tid] = Gf[63 * LG + C.tid];
        __syncthreads();
        {
            const bf16x8 b0 = *(const bf16x8*)(Vt + (16 * w + r16) * 72 + 8 * g), b1 = *(const bf16x8*)(Vt + (16 * w + r16) * 72 + 32 + 8 * g);
            bf16_t* so = ST + (size_t)it * DK * 128 + (size_t)(16 * w + r16) * DK + 4 * g;
#pragma unroll
            for (int mt = 0; mt < DK / 16; ++mt) {
                const bf16x8 a0 = *(const bf16x8*)(KhT + (16 * mt + r16) * 72 + 8 * g), a1 = *(const bf16x8*)(KhT + (16 * mt + r16) * 72 + 32 + 8 * g);
                f32x4 acc = (f32x4){0.f, 0.f, 0.f, 0.f};
                acc = __builtin_amdgcn_mfma_f32_16x16x32_bf16(a0, b0, acc, 0, 0, 0);
                acc = __builtin_amdgcn_mfma_f32_16x16x32_bf16(a1, b1, acc, 0, 0, 0);
                u32x2 q; q.x = pk2(acc[0], acc[1]); q.y = pk2(acc[2], acc[3]);
                *(u32x2*)(so + 16 * mt) = q;
            }
        }
        __syncthreads();
    }
}

template <int MODE> __device__ __forceinline__ void phase_la_p2(const Ctx& C) {
    typedef LaCfg<MODE> Cf; const Params& p = C.p; constexpr int DK = Cf::DK, NQ = DK / 4;
    bf16_t* ST = (bf16_t*)(p.ws + WS_ST); const float* TOT = (const float*)(p.ws + WS_TOT);
    for (int u = blockIdx.x * NTHR + C.tid; u < 32 * 128 * NQ; u += gridDim.x * NTHR) {
        const int k4 = u % NQ, v = (u / NQ) & 127, bh = u / (NQ * 128);
        float S0 = 0.f, S1 = 0.f, S2 = 0.f, S3 = 0.f;
        bf16_t* base = ST + (size_t)bh * 64 * DK * 128 + (size_t)v * DK + k4 * 4;
        const float* tb = TOT + (size_t)bh * 64 * 128 + k4 * 4;
#pragma unroll 8
        for (int c = 0; c < 64; ++c) {
            u32x2* ptr = (u32x2*)(base + (size_t)c * DK * 128);
            const u32x2 w = *ptr; const f32x4 dc = *(const f32x4*)(tb + c * 128);
            u32x2 o; o.x = pk2(S0, S1); o.y = pk2(S2, S3);
            *ptr = o;
            S0 = S0 * __builtin_amdgcn_exp2f(dc[0]) + bflo(w.x); S1 = S1 * __builtin_amdgcn_exp2f(dc[1]) + bfhi(w.x);
            S2 = S2 * __builtin_amdgcn_exp2f(dc[2]) + bflo(w.y); S3 = S3 * __builtin_amdgcn_exp2f(dc[3]) + bfhi(w.y);
        }
    }
}

template <int MODE> __device__ __forceinline__ void phase_la_p3(const Ctx& C, int l) {
    typedef LaCfg<MODE> Cf; const Params& p = C.p; constexpr int DK = Cf::DK, LQ = Cf::LQ, LG = Cf::LG, NG = Cf::NG, NKS = DK / 32;
    bf16_t* Qb = (bf16_t*)(C.lds + Cf::O_QB); bf16_t* Kb = (bf16_t*)(C.lds + Cf::O_KB); float* Gf = (float*)(C.lds + Cf::O_GF); bf16_t* Vt = (bf16_t*)(C.lds + Cf::O_VT);
    bf16_t* Sc = (bf16_t*)(C.lds + Cf::O_SC); bf16_t* Qe = (bf16_t*)(C.lds + Cf::O_QE); float* segs = (float*)(C.lds + Cf::O_SEG); float* red = (float*)(C.lds + Cf::O_RED);
    const bf16_t* ST = (const bf16_t*)(p.ws + WS_ST); const bf16_t* proj = (const bf16_t*)(p.ws + WS_R1); bf16_t* A = (bf16_t*)(p.ws + WS_A);
    const float* nw = (MODE ? p.hgrn_norm_w : p.gla_norm_w) + (l >> 1) * 128;
    const int r16 = C.lane & 15, g = C.lane >> 4, w = C.wave;
    const f32x4 nw4 = *(const f32x4*)(nw + 16 * w + 4 * g);
    float* par = (float*)(C.lds + Cf::O_PAR);
    LaRaw<MODE> R; int hcur = -1;
    if ((int)blockIdx.x < 2048) la_fetch<MODE, true>(C, (int)blockIdx.x >> 8, ((int)blockIdx.x >> 6) & 3, (int)blockIdx.x & 63, R);
    for (int it = blockIdx.x; it < 2048; it += gridDim.x) {
        const int bh = it >> 6, c = it & 63, b = bh >> 2, h = bh & 3;
        bf16x8 sfr[NKS];
        { const bf16_t* sp = ST + (size_t)it * DK * 128 + (size_t)(16 * w + r16) * DK + 8 * g;
#pragma unroll
          for (int ks = 0; ks < NKS; ++ks) sfr[ks] = *(const bf16x8*)(sp + 32 * ks); }
        if (h != hcur) { la_params<MODE>(C, l, h, par); hcur = h; __syncthreads(); }
        la_store<MODE, true>(C, R, par, Qb, Kb, Gf, Vt);
        { const int nx = it + (int)gridDim.x; if (nx < 2048) la_fetch<MODE, true>(C, nx >> 8, (nx >> 6) & 3, nx & 63, R); }
        for (int u = C.tid; u < 64 * 72 / 8; u += NTHR) *(u32x4*)(Sc + u * 8) = (u32x4){0u, 0u, 0u, 0u};
        __syncthreads();
        la_cumsum<MODE>(C, Gf, segs);
        __syncthreads();
        for (int t = w; t < 10; t += 8) {
            const int I = (t >= 6) ? 3 : (t >= 3) ? 2 : (t >= 1) ? 1 : 0, J = t - I * (I + 1) / 2;
            f32x4 acc = (f32x4){0.f, 0.f, 0.f, 0.f};
#pragma unroll
            for (int ks = 0; ks < NKS; ++ks) {
                const int kc = 32 * ks + 8 * g;
                float gref[8], gj[8], gi[8], kv[8], qv[8];
                ld8f(Gf + (16 * J + 15) * LG + kc, gref); ld8f(Gf + (16 * J + r16) * LG + kc, gj); ld8f(Gf + (16 * I + r16) * LG + kc, gi);
                unpack8(*(const u32x4*)(Kb + (16 * J + r16) * LQ + kc), kv); unpack8(*(const u32x4*)(Qb + (16 * I + r16) * LQ + kc), qv);
#pragma unroll
                for (int e = 0; e < 8; ++e) { kv[e] *= __builtin_amdgcn_exp2f(gref[e] - gj[e]); qv[e] *= __builtin_amdgcn_exp2f(gi[e] - gref[e]); }
                acc = __builtin_amdgcn_mfma_f32_16x16x32_bf16(__builtin_bit_cast(bf16x8, pack8(kv)), __builtin_bit_cast(bf16x8, pack8(qv)), acc, 0, 0, 0);
            }
            if (I == J) {
#pragma unroll
                for (int e = 0; e < 4; ++e) if (4 * g + e > r16) acc[e] = 0.f;
            }
            u32x2 q; q.x = pk2(acc[0], acc[1]); q.y = pk2(acc[2], acc[3]);
            *(u32x2*)(Sc + (16 * I + r16) * 72 + 16 * J + 4 * g) = q;
        }
        for (int u = C.tid; u < 64 * NG; u += NTHR) {
            const int r = u / NG, kk = (u % NG) * 8;
            float qv[8], gi[8]; unpack8(*(const u32x4*)(Qb + r * LQ + kk), qv); ld8f(Gf + r * LG + kk, gi);
#pragma unroll
            for (int e = 0; e < 8; ++e) qv[e] *= __builtin_amdgcn_exp2f(gi[e]);
            *(u32x4*)(Qe + r * LQ + kk) = pack8(qv);
        }
        __syncthreads();
        f32x4 o[4];
        {
            const bf16x8 v0 = *(const bf16x8*)(Vt + (16 * w + r16) * 72 + 8 * g), v1 = *(const bf16x8*)(Vt + (16 * w + r16) * 72 + 32 + 8 * g);
#pragma unroll
            for (int nt = 0; nt < 4; ++nt) {
                f32x4 acc = (f32x4){0.f, 0.f, 0.f, 0.f};
                acc = __builtin_amdgcn_mfma_f32_16x16x32_bf16(v0, *(const bf16x8*)(Sc + (16 * nt + r16) * 72 + 8 * g), acc, 0, 0, 0);
                if (nt >= 2) acc = __builtin_amdgcn_mfma_f32_16x16x32_bf16(v1, *(const bf16x8*)(Sc + (16 * nt + r16) * 72 + 32 + 8 * g), acc, 0, 0, 0);
#pragma unroll
                for (int ks = 0; ks < NKS; ++ks) acc = __builtin_amdgcn_mfma_f32_16x16x32_bf16(sfr[ks], *(const bf16x8*)(Qe + (16 * nt + r16) * LQ + 32 * ks + 8 * g), acc, 0, 0, 0);
                o[nt] = acc;
                float ss = acc[0] * acc[0] + acc[1] * acc[1] + acc[2] * acc[2] + acc[3] * acc[3];
                ss += __shfl_xor(ss, 16); ss += __shfl_xor(ss, 32);
                if (g == 0) red[w * 64 + 16 * nt + r16] = ss;
            }
        }
        __syncthreads();
#pragma unroll
        for (int nt = 0; nt < 4; ++nt) {
            float tot = 0.f;
#pragma unroll
            for (int ww = 0; ww < 8; ++ww) tot += red[ww * 64 + 16 * nt + r16];
            const float rs = rsqrtf(tot * (1.f / 128.f) + 1e-6f);
            const size_t row = (size_t)b * SEQ_ + (size_t)c * 64 + 16 * nt + r16;
            const u32x2 gw = *(const u32x2*)(proj + row * Cf::PITCH + Cf::GCOL + h * 128 + 16 * w + 4 * g);
            u32x2 q; q.x = pk2(o[nt][0] * rs * nw4[0] * siluf_(bflo(gw.x)), o[nt][1] * rs * nw4[1] * siluf_(bfhi(gw.x)));
            q.y = pk2(o[nt][2] * rs * nw4[2] * siluf_(bflo(gw.y)), o[nt][3] * rs * nw4[3] * siluf_(bfhi(gw.y)));
            *(u32x2*)(A + row * 1024 + Cf::OCOL + h * 128 + 16 * w + 4 * g) = q;
        }
        __syncthreads();
    }
}


#define LAS __attribute__((address_space(3)))
#define XB_TMO      128
#define XB_XCNT(j)  (256  + 64 * (j))
#define XB_XSUB(j)  (1280 + 64 * (j))
#define XB_XGEN(j)  (2304 + 64 * (j))
#define XB_TOP      3328
#define XB_TOPGEN   3392
#define XCD_BAR_WORDS 3456
#define XB_SPIN_CAP (1u << 18)

__device__ __forceinline__ unsigned xb_ld(unsigned* p)              { return __hip_atomic_load(p, __ATOMIC_RELAXED, __HIP_MEMORY_SCOPE_AGENT); }
__device__ __forceinline__ unsigned xb_add(unsigned* p, unsigned v) { return __hip_atomic_fetch_add(p, v, __ATOMIC_RELAXED, __HIP_MEMORY_SCOPE_AGENT); }
__device__ __forceinline__ unsigned xb_xcc_id() { return (unsigned)__builtin_amdgcn_s_getreg((3 << 11) | 20) & 0xFu; }
#define XB_SPIN(cond, bar) do { unsigned _sp = 0; while (cond) { __builtin_amdgcn_s_sleep(1); \
    if ((++_sp & 255u) == 0u) { if (xb_ld(&(bar)[XB_TMO])) break; if (_sp > XB_SPIN_CAP) { atomicAdd(&(bar)[XB_TMO], 1u); break; } } } } while (0)

struct XcdBarrier {
    unsigned* bar; unsigned x;
    volatile LAS unsigned* st;
};

__device__ __forceinline__ XcdBarrier xcd_barrier_post(unsigned* bar, volatile LAS unsigned* st) {
    XcdBarrier b; b.bar = bar; b.x = xb_xcc_id(); b.st = st;
    if (threadIdx.x == 0) (void)xb_add(&bar[XB_XCNT(b.x)], 1u);
    return b;
}
__device__ __forceinline__ void xcd_barrier_complete(unsigned* bar, unsigned x, unsigned& nloc, unsigned& nx) {
    const unsigned G = gridDim.x * gridDim.y * gridDim.z;
    unsigned sum, cnt, mine, sp = 0u;
    for (;;) {
        sum = 0u; cnt = 0u; mine = 0u;
#pragma unroll
        for (unsigned j = 0; j < 16; ++j) { const unsigned c = xb_ld(&bar[XB_XCNT(j)]); sum += c; cnt += (c > 0u) ? 1u : 0u; mine = (j == x) ? c : mine; }
        if (sum == G) break;
        __builtin_amdgcn_s_sleep(1);
        if ((++sp & 255u) == 0u) { if (xb_ld(&bar[XB_TMO])) break; if (sp > XB_SPIN_CAP) { atomicAdd(&bar[XB_TMO], 1u); break; } }
    }
    nloc = mine > 0u ? mine : 1u; nx = cnt > 0u ? cnt : 1u;
}

__device__ __forceinline__ void xcd_barrier(const XcdBarrier& b) {
    asm volatile("s_waitcnt vmcnt(0)" ::: "memory");
    __syncthreads();
    if (threadIdx.x == 0) {
        unsigned* bar = b.bar;
        __builtin_amdgcn_s_waitcnt(0);
        unsigned nloc = b.st[0], nx = b.st[1];
        if (nloc == 0u) { xcd_barrier_complete(bar, b.x, nloc, nx); b.st[0] = nloc; b.st[1] = nx; }
        const unsigned old = xb_add(&bar[XB_XSUB(b.x)], 1u);
        const unsigned gen = old / nloc;
        if (old + 1u == (gen + 1u) * nloc) {
            __builtin_amdgcn_fence(__ATOMIC_RELEASE, "agent");
            asm volatile("s_waitcnt vmcnt(0)" ::: "memory");
            const unsigned og = xb_add(&bar[XB_TOP], 1u);
            const unsigned tg = og / nx;
            if (og + 1u == (tg + 1u) * nx) xb_add(&bar[XB_TOPGEN], 1u);
            else XB_SPIN(xb_ld(&bar[XB_TOPGEN]) == tg, bar);
            __builtin_amdgcn_fence(__ATOMIC_ACQUIRE, "agent");
            xb_add(&bar[XB_XGEN(b.x)], 1u);
            asm volatile("s_waitcnt vmcnt(0)" ::: "memory");
        } else {
            XB_SPIN(xb_ld(&bar[XB_XGEN(b.x)]) == gen, bar);
            __builtin_amdgcn_fence(__ATOMIC_ACQUIRE, "agent");
            asm volatile("s_waitcnt vmcnt(0)" ::: "memory");
        }
    }
    __syncthreads();
}

typedef unsigned u32x16 __attribute__((ext_vector_type(16)));
__device__ __forceinline__ void load_params(Params& p) {
    auto kp = __builtin_amdgcn_kernarg_segment_ptr();
    u32x16 a, b, c, d;
    asm volatile("s_load_dwordx16 %0, %4, 0x0\n\ts_load_dwordx16 %1, %4, 0x40\n\ts_load_dwordx16 %2, %4, 0x80\n\ts_load_dwordx16 %3, %4, 0xc0\n\ts_waitcnt lgkmcnt(0)"
                 : "=&s"(a), "=&s"(b), "=&s"(c), "=&s"(d) : "s"(kp) : "memory");
    unsigned long long q[32];
#pragma unroll
    for (int i = 0; i < 8; ++i) { q[i] = ((unsigned long long)a[2 * i + 1] << 32) | a[2 * i]; q[8 + i] = ((unsigned long long)b[2 * i + 1] << 32) | b[2 * i];
        q[16 + i] = ((unsigned long long)c[2 * i + 1] << 32) | c[2 * i]; q[24 + i] = ((unsigned long long)d[2 * i + 1] << 32) | d[2 * i]; }
    p.x = (const float*)q[0]; p.c = (const float*)q[1]; p.positions = (const int*)q[2]; p.mod_w = (const float*)q[3]; p.mod_b = (const float*)q[4]; p.norm_mix_w = (const float*)q[5]; p.norm_ffn_w = (const float*)q[6];
    p.ev_w_in = (const float*)q[7]; p.gla_gate_w = (const float*)q[8]; p.gla_gate_b = (const float*)q[9]; p.gla_norm_w = (const float*)q[10]; p.swa_sinks = (const float*)q[11]; p.ev_w_out = (const float*)q[12];
    p.od_w_in = (const float*)q[13]; p.diff_lambda = (const float*)q[14]; p.diff_norm_w = (const float*)q[15]; p.hgrn_lb_logits = (const float*)q[16]; p.hgrn_norm_w = (const float*)q[17]; p.od_w_out = (const float*)q[18];
    p.ffn_w_in = (const float*)q[19]; p.ffn_conv_w = (const float*)q[20]; p.ffn_conv_b = (const float*)q[21]; p.ffn_w_out = (const float*)q[22]; p.final_norm_w = (const float*)q[23];
    p.out = (float*)q[24]; p.ws = (unsigned char*)q[25];
}

#ifndef REP_SYNC
#define REP_SYNC 1
#endif
#ifndef REP_G
#define REP_G 1
#endif
#ifndef REP_R
#define REP_R 1
#endif
#ifndef REP_LA
#define REP_LA 1
#endif
#ifndef REP_AT
#define REP_AT 1
#endif
#ifndef REP_SM
#define REP_SM 1
#endif
__global__ void __launch_bounds__(NTHR, 2) fwd_megakernel(Params pin) {
    extern __shared__ __attribute__((aligned(16))) unsigned char lds[];
    cg::grid_group grid = cg::this_grid();
    Ctx C; C.lds = lds; C.tid = threadIdx.x; C.lane = C.tid & 63; C.wave = __builtin_amdgcn_readfirstlane(C.tid >> 6);
    C.gw = blockIdx.x * 8 + C.wave; C.ngw = gridDim.x * 8;
    PG8_LAS unsigned char* ldsg = (PG8_LAS unsigned char*)lds;
    volatile LAS unsigned* bst = (volatile LAS unsigned*)(ldsg + (LDS_BYTES - 64));
    if (threadIdx.x < 2) bst[threadIdx.x] = 0u;
    __syncthreads();
    XcdBarrier xbar = xcd_barrier_post((unsigned*)(pin.ws + WS_BAR), bst);
#define GSYNC() do { for (int rs_ = 0; rs_ < REP_SYNC; ++rs_) xcd_barrier(xbar); } while (0)
#define RP() do { load_params(C.p); C.tid = otid_(); C.lane = C.tid & 63; C.wave = __builtin_amdgcn_readfirstlane(C.tid >> 6); C.gw = blockIdx.x * 8 + C.wave; } while (0)
#define WSP(off) (C.p.ws + (off))

    RP(); phase_prologue(C);
    grid.sync();
    RP(); phase_convert(C, 0);
    RP(); phase_prep(C, C.p.x, C.p.norm_mix_w, (const float*)WSP(WS_MOD), 1024, (bf16_t*)WSP(WS_A), (float*)WSP(WS_ROWSS));
    GSYNC();
#pragma unroll 1
    for (int l = 0; l < 4; ++l) {
        const bool even = !(l & 1);
        {
            RP();
            const int N = even ? 2560 : 3584;
            pg8::Gemm g{(const bf16_t*)WSP(WS_A), (const bf16_t*)WSP(WS_WIN), T_, N, 1024}; pg8::StaticOrder S; S.init(T_, N, (int)gridDim.x, (int)blockIdx.x);
            pg8::EpiProj E{(bf16_t*)WSP(WS_R1), N, even ? 0x7C000u : 0xFFu, even ? 0x3C000u : 0xFu, QSCALE_, (const float*)WSP(WS_COS), (const float*)WSP(WS_SIN),
                           (const float*)WSP(WS_ROWSS) + (size_t)(2 * l) * T_, (const float*)WSP(WS_BIAS) + (size_t)l * BIAS_L};
            for (int rep_ = 0; rep_ < REP_G; ++rep_) pg8::gemm_phase<pg8::EpiProj, pg8::StaticOrder, true, true>(ldsg, g, S, E);
        }
        GSYNC();
        if (even) {
            for (int rep_ = 0; rep_ < REP_AT; ++rep_) { RP(); phase_swa(C, l); }
            for (int rep_ = 0; rep_ < REP_LA; ++rep_) { RP(); phase_la_p1<0>(C, l); }
            GSYNC();
            RP(); phase_la_p2<0>(C);
            GSYNC();
            for (int rep_ = 0; rep_ < REP_LA; ++rep_) { RP(); phase_la_p3<0>(C, l); }
        } else {
            for (int rep_ = 0; rep_ < REP_AT; ++rep_) {
                RP();
                const bf16_t* R1 = (const bf16_t*)WSP(WS_R1); bf16_t* X2 = (bf16_t*)WSP(WS_X2);
                const int G = (int)gridDim.x, bid = (int)blockIdx.x;
#pragma unroll 1
                for (int i = 0; i * G < 2048; ++i) {
                    const int L = i * G + ((i & 1) ? (G - 1 - bid) : bid);
                    if (L >= 2048) continue;
                    const int qb = 15 - (L >> 7), bh = L & 127, b = bh >> 4, hv = bh & 15;
                    const attn_body::bf16* Q = (const attn_body::bf16*)(R1 + (hv >> 1) * 64);
                    const attn_body::bf16* K = (const attn_body::bf16*)(R1 + 512 + (hv >> 1) * 64);
                    const attn_body::bf16* V = (const attn_body::bf16*)(R1 + 1024 + (hv >> 2) * 128 + (hv & 1) * 64);
                    attn_body::attn_unit<8>(b, hv, qb, Q, K, V, (attn_body::bf16*)(X2 + hv * 64), (char*)lds);
                }
            }
            for (int rep_ = 0; rep_ < REP_LA; ++rep_) { RP(); phase_la_p1<1>(C, l); }
            GSYNC();
            RP(); phase_la_p2<1>(C);
            RP(); phase_diff_combine(C, l);
            GSYNC();
            for (int rep_ = 0; rep_ < REP_LA; ++rep_) { RP(); phase_la_p3<1>(C, l); }
        }
        GSYNC();
        {
            RP();
            const float* modl = (const float*)WSP(WS_MOD) + (size_t)l * 8 * 6144;
            pg8::Gemm g{(const bf16_t*)WSP(WS_A), (const bf16_t*)WSP(WS_WOUT), T_, 1024, 1024}; pg8::StaticOrder S; S.init(T_, 1024, (int)gridDim.x, (int)blockIdx.x);
            pg8::EpiRes E{(l == 0) ? C.p.x : C.p.out, C.p.out, modl + 2048, (bf16_t*)WSP(WS_X2), C.p.norm_ffn_w + l * 1024, modl + 4096, (float*)WSP(WS_ROWSS) + (size_t)(2 * l + 1) * T_};
            pg8::gemm_phase<pg8::EpiRes, pg8::StaticOrder, true, true>(ldsg, g, S, E);
        }
        GSYNC();
        {
            RP();
            pg8::Gemm g{(const bf16_t*)WSP(WS_X2), (const bf16_t*)WSP(WS_FIN), T_, 5632, 1024}; pg8::StaticOrder S; S.init(T_, 5632, (int)gridDim.x, (int)blockIdx.x);
            pg8::EpiFfn E{(bf16_t*)WSP(WS_R1), (float*)WSP(WS_HP), (float*)WSP(WS_HU), (float*)WSP(WS_HA), C.p.ffn_conv_w + (size_t)l * 3 * DFF_, C.p.ffn_conv_b + (size_t)l * DFF_,
                          (const float*)WSP(WS_ROWSS) + (size_t)(2 * l + 1) * T_, (const float*)WSP(WS_BIAS) + (size_t)l * BIAS_L + 8 * 3584};
            for (int rep_ = 0; rep_ < REP_G; ++rep_) pg8::gemm_phase<pg8::EpiFfn, pg8::StaticOrder, true, true>(ldsg, g, S, E);
        }
        GSYNC();
        RP(); phase_ffn_fixup(C, l);
        if (l < 3) { RP(); phase_convert(C, l + 1); }
        GSYNC();
        {
            RP();
            const float* modl = (const float*)WSP(WS_MOD) + (size_t)l * 8 * 6144;
            pg8::Gemm g{(const bf16_t*)WSP(WS_R1), (const bf16_t*)WSP((l & 1) ? WS_FOUT2 : WS_FOUT), T_, 1024, DFF_}; pg8::StaticOrder S; S.init(T_, 1024, (int)gridDim.x, (int)blockIdx.x);
            pg8::EpiRes E{C.p.out, C.p.out, modl + 5120, (l < 3) ? (bf16_t*)WSP(WS_A) : (bf16_t*)nullptr, C.p.norm_mix_w + ((l + 1) & 3) * 1024, modl + 6144 * 8 + 1024, (float*)WSP(WS_ROWSS) + (size_t)((2 * l + 2) & 7) * T_};
            pg8::gemm_phase<pg8::EpiRes, pg8::StaticOrder, true, true>(ldsg, g, S, E);
        }
        GSYNC();
    }
    RP(); phase_final_norm(C, C.p.out, C.p.final_norm_w);
}

extern "C" void kernel_launch(void* const* d_in, const int* in_sizes, int n_in, void* d_out, int out_size, void* d_ws, size_t ws_size, hipStream_t stream) {
    static int grid_blocks = 0;
    if (grid_blocks == 0) {
        if (n_in != 24 || ws_size < WS_END) { fprintf(stderr, "kernel_launch: unexpected n_in %d / ws %zu\n", n_in, ws_size); grid_blocks = -1; return; }
        int dev = 0, cus = 0, per_cu = 0;
        hipGetDevice(&dev); hipDeviceGetAttribute(&cus, hipDeviceAttributeMultiprocessorCount, dev);
        if (hipFuncSetAttribute((const void*)fwd_megakernel, hipFuncAttributeMaxDynamicSharedMemorySize, LDS_BYTES) != hipSuccess) { fprintf(stderr, "kernel_launch: hipFuncSetAttribute failed\n"); grid_blocks = -1; return; }
        if (hipOccupancyMaxActiveBlocksPerMultiprocessor(&per_cu, (const void*)fwd_megakernel, NTHR, LDS_BYTES) != hipSuccess || per_cu < 1) { fprintf(stderr, "kernel_launch: occupancy query gave %d\n", per_cu); per_cu = 1; }
        (void)hipGetLastError();
        grid_blocks = cus * per_cu;
    }
    if (grid_blocks < 0) return;
    Params p{};
    p.x = (const float*)d_in[0]; p.c = (const float*)d_in[1]; p.positions = (const int*)d_in[2]; p.mod_w = (const float*)d_in[3]; p.mod_b = (const float*)d_in[4];
    p.norm_mix_w = (const float*)d_in[5]; p.norm_ffn_w = (const float*)d_in[6]; p.ev_w_in = (const float*)d_in[7]; p.gla_gate_w = (const float*)d_in[8];
    p.gla_gate_b = (const float*)d_in[9]; p.gla_norm_w = (const float*)d_in[10]; p.swa_sinks = (const float*)d_in[11]; p.ev_w_out = (const float*)d_in[12];
    p.od_w_in = (const float*)d_in[13]; p.diff_lambda = (const float*)d_in[14]; p.diff_norm_w = (const float*)d_in[15]; p.hgrn_lb_logits = (const float*)d_in[16];
    p.hgrn_norm_w = (const float*)d_in[17]; p.od_w_out = (const float*)d_in[18]; p.ffn_w_in = (const float*)d_in[19]; p.ffn_conv_w = (const float*)d_in[20];
    p.ffn_conv_b = (const float*)d_in[21]; p.ffn_w_out = (const float*)d_in[22]; p.final_norm_w = (const float*)d_in[23];
    p.out = (float*)d_out; p.ws = (unsigned char*)d_ws;
    if (hipMemsetAsync((char*)d_ws + WS_BAR, 0, 16384, stream) != hipSuccess) { fprintf(stderr, "kernel_launch: memset failed\n"); return; }
    void* args[] = {&p};
    hipError_t e = hipLaunchCooperativeKernel((const void*)fwd_megakernel, dim3(grid_blocks), dim3(NTHR), args, LDS_BYTES, stream);
    if (e != hipSuccess) fprintf(stderr, "cooperative launch failed: %s (grid %d)\n", hipGetErrorString(e), grid_blocks);
}
```

```cpp
#include <hip/hip_runtime.h>
#include <hip/hip_cooperative_groups.h>
#include <hip/hip_bf16.h>
#include <cstdio>
#include <cstdint>
#include <cmath>
__device__ __forceinline__ int otid_() { int t = threadIdx.x; asm volatile("" : "+v"(t)); return t; }
namespace pg8 {
#define PG8_LAS __attribute__((address_space(3)))
typedef unsigned short bf16_t;
typedef short bf16x8 __attribute__((ext_vector_type(8)));
typedef float f32x4 __attribute__((ext_vector_type(4)));
typedef unsigned u32x4 __attribute__((ext_vector_type(4)));
constexpr int BM = 256, BK = 64, HALF = 128, HTB = HALF * BK * 2  , STAGE_BYTES = 8 * HTB, NXCD = 8, WGM = 8;

__host__ __device__ __forceinline__ int lds_byte(int r, int c) { const int st = (r >> 4) * 2 + (c >> 5), rr = r & 15, cc = c & 31, ob = rr * 64 + cc * 2; return st * 1024 + (ob ^ (((ob >> 9) & 1) << 5)); }
__host__ __device__ __forceinline__ void stage_rc(int b, int& R, int& C) { const int st = b / 1024, sb = b % 1024, swz = sb ^ (((sb >> 9) & 1) << 5); R = (st >> 1) * 16 + swz / 64; C = (st & 1) * 32 + (swz % 64) / 2; }
__host__ __device__ __forceinline__ int perm32(int rho) { const int n = rho >> 4, i = rho & 15; return 8 * (i >> 2) + 4 * n + (i & 3); }

struct Unit { int pm, pn; };
struct Gemm { const bf16_t* A; const bf16_t* Bt; int M, N, K; };

struct StaticOrder {
    int nM, nN, nwg, G, c;
    __host__ __device__ void init(int M, int N, int G_, int c_) { nM = M / BM; nN = N / BM; nwg = nM * nN; G = G_; c = c_; }
    __host__ __device__ bool next(int i, Unit& u) const {
        const long L = (long)i * G + c; if (L >= nwg) return false;
        int wgid = (int)L; { const int q = nwg / NXCD, r = nwg % NXCD, xcd = wgid % NXCD, off = wgid / NXCD; wgid = (xcd < r ? xcd * (q + 1) : r * (q + 1) + (xcd - r) * q) + off; }
        const int nig = WGM * nN, gid = wgid / nig, fm = gid * WGM, gsz = (nM - fm) < WGM ? (nM - fm) : WGM;
        u.pm = fm + ((wgid % nig) % gsz); u.pn = (wgid % nig) / gsz; return true;
    }
    __device__ __forceinline__ void a_ready(const Unit&) const {}
    __device__ __forceinline__ void done(const Unit&) const {}
};

__device__ __forceinline__ unsigned cvt_pk_bf16(float lo, float hi) { unsigned r; asm volatile("v_cvt_pk_bf16_f32 %0, %1, %2" : "=v"(r) : "v"(lo), "v"(hi)); return r; }
typedef float f32x2 __attribute__((ext_vector_type(2)));
template <class Epi, class Sched, bool ALIGN_EPI = false, bool SP2 = false>
__device__ __forceinline__ void gemm_phase(PG8_LAS unsigned char* lds, const Gemm g, const Sched& S, const Epi& E) {
    const int tid = otid_(), wid = __builtin_amdgcn_readfirstlane(tid >> 6), lane = tid & 63, wr = wid >> 2, wc = wid & 3, fr = lane & 15, fq = lane >> 4;
    const int K = g.K, nt = K / BK;
    unsigned voffA[2], voffB[2];
#pragma unroll
    for (int i = 0; i < 2; ++i) { int R, C; stage_rc(tid * 16 + i * 8192, R, C); const int Rb = Epi::PERM ? ((R & ~31) + perm32(R & 31)) : R;
        voffA[i] = (unsigned)(R * K + C) * 2u; voffB[i] = (unsigned)(Rb * K + C) * 2u; }
    const size_t kstep = (size_t)(BK * 2);
    const size_t hstep = (size_t)HALF * K * 2;
    const size_t tstep = 2 * hstep;
    const unsigned ldsw = (unsigned)wid * 1024u;
    const int aoff = lds_byte(wr * 64 + fr, fq * 8), boff = lds_byte(wc * 32 + fr, fq * 8);
#define PG8_SA(b, h) (((b) * 2 + (h)) * HTB)
#define PG8_SB(b, h) ((4 + (b) * 2 + (h)) * HTB)
#define PG8_STAGE(bufoff, gbase, voff) do { _Pragma("unroll") for (int _i = 0; _i < 2; ++_i) \
        __builtin_amdgcn_global_load_lds((const unsigned*)((const char*)(gbase) + (voff)[_i]), (PG8_LAS unsigned*)(lds + (bufoff) + ldsw + _i * 8192), 16, 0, 0); } while (0)
#define PG8_LDA(dst, b, h) do { _Pragma("unroll") for (int m = 0; m < 4; ++m) _Pragma("unroll") for (int k = 0; k < 2; ++k) dst[m][k] = *(const PG8_LAS bf16x8*)(lds + PG8_SA(b, h) + aoff + m * 2048 + k * 1024); } while (0)
#define PG8_LDB(dst, b, h) do { _Pragma("unroll") for (int n = 0; n < 2; ++n) _Pragma("unroll") for (int k = 0; k < 2; ++k) dst[n][k] = *(const PG8_LAS bf16x8*)(lds + PG8_SB(b, h) + boff + n * 2048 + k * 1024); } while (0)
#define PG8_MMA(ai, bj, At, Bt) do { __builtin_amdgcn_s_setprio(1); _Pragma("unroll") for (int m = 0; m < 4; ++m) _Pragma("unroll") for (int n = 0; n < 2; ++n) _Pragma("unroll") for (int k = 0; k < 2; ++k) \
        acc[ai][bj][m][n] = __builtin_amdgcn_mfma_f32_16x16x32_bf16(Bt[n][k], At[m][k], acc[ai][bj][m][n], 0, 0, 0); __builtin_amdgcn_s_setprio(0); } while (0)
#define PG8_WAIT_V(n) asm volatile("s_waitcnt vmcnt(" #n ")" ::: "memory")
#define PG8_WAIT_L(n) asm volatile("s_waitcnt lgkmcnt(" #n ")" ::: "memory")
#define PG8_BAR __builtin_amdgcn_s_barrier()
#define PG8_SCHED __builtin_amdgcn_sched_barrier(0)
    Unit cur, nxt; int ui = 0;
    if (!S.next(0, cur)) return;
    f32x4 acc[2][2][4][2];
#pragma unroll
    for (int a = 0; a < 2; ++a)
#pragma unroll
        for (int b = 0; b < 2; ++b)
#pragma unroll
            for (int m = 0; m < 4; ++m)
#pragma unroll
                for (int n = 0; n < 2; ++n) acc[a][b][m][n] = (f32x4){0.f, 0.f, 0.f, 0.f};
    bf16x8 At[4][2], B0[2][2], B1[2][2];
    const char* cA = (const char*)g.A + (size_t)cur.pm * tstep; const char* cB = (const char*)g.Bt + (size_t)cur.pn * tstep;
    S.a_ready(cur);
    if constexpr (SP2) {
        PG8_STAGE(PG8_SB(0, 0), cB, voffB); PG8_STAGE(PG8_SB(0, 1), cB + hstep, voffB); PG8_STAGE(PG8_SA(0, 0), cA, voffA); PG8_STAGE(PG8_SA(0, 1), cA + hstep, voffA);
        if (wr == 1) PG8_BAR;
        PG8_WAIT_V(2); PG8_BAR;
        PG8_STAGE(PG8_SB(1, 0), cB + kstep, voffB); PG8_STAGE(PG8_SA(1, 0), cA + kstep, voffA); PG8_STAGE(PG8_SB(1, 1), cB + hstep + kstep, voffB);
        PG8_WAIT_V(6); PG8_BAR;
    } else {
        PG8_STAGE(PG8_SB(0, 0), cB, voffB); PG8_STAGE(PG8_SA(0, 0), cA, voffA); PG8_STAGE(PG8_SB(0, 1), cB + hstep, voffB); PG8_STAGE(PG8_SA(0, 1), cA + hstep, voffA);
        if (wr == 1) PG8_BAR;
        PG8_WAIT_V(4); PG8_BAR;
        PG8_STAGE(PG8_SB(1, 0), cB + kstep, voffB); PG8_STAGE(PG8_SA(1, 0), cA + kstep, voffA); PG8_STAGE(PG8_SB(1, 1), cB + hstep + kstep, voffB);
        PG8_WAIT_V(6); PG8_BAR;
    }
    for (;;) {
        const bool has_next = S.next(ui + 1, nxt);
        const char* nA = has_next ? (const char*)g.A + (size_t)nxt.pm * tstep : cA; const char* nB = has_next ? (const char*)g.Bt + (size_t)nxt.pn * tstep : cB;
        for (int t = 0; t < nt; t += 2) {
            const bool last = (t == nt - 2);
            const char* a1 = cA + (size_t)(t + 1) * kstep;
            const char* a2 = last ? nA : cA + (size_t)(t + 2) * kstep; const char* b2 = last ? nB : cB + (size_t)(t + 2) * kstep;
            const char* a3 = a2 + kstep; const char* b3 = b2 + kstep;
            if (last && has_next) S.a_ready(nxt);
            if constexpr (SP2) {
            PG8_LDB(B0, 0, 0); PG8_LDB(B1, 0, 1); PG8_SCHED; PG8_LDA(At, 0, 0); PG8_STAGE(PG8_SA(1, 1), a1 + hstep, voffA);
            PG8_WAIT_V(8); PG8_WAIT_L(0); PG8_BAR; PG8_MMA(0, 0, At, B0); PG8_MMA(0, 1, At, B1); PG8_BAR; PG8_SCHED;
            PG8_LDA(At, 0, 1); PG8_STAGE(PG8_SB(0, 0), b2, voffB); PG8_STAGE(PG8_SB(0, 1), b2 + hstep, voffB); PG8_STAGE(PG8_SA(0, 0), a2, voffA);
            PG8_WAIT_V(8); PG8_WAIT_L(0); PG8_BAR; PG8_MMA(1, 0, At, B0); PG8_MMA(1, 1, At, B1); PG8_BAR; PG8_SCHED;
            PG8_LDB(B0, 1, 0); PG8_LDB(B1, 1, 1); PG8_SCHED; PG8_LDA(At, 1, 0); PG8_STAGE(PG8_SA(0, 1), a2 + hstep, voffA);
            PG8_WAIT_V(8); PG8_WAIT_L(0); PG8_BAR; PG8_MMA(0, 0, At, B0); PG8_MMA(0, 1, At, B1); PG8_BAR; PG8_SCHED;
            PG8_LDA(At, 1, 1); PG8_STAGE(PG8_SB(1, 0), b3, voffB); PG8_STAGE(PG8_SB(1, 1), b3 + hstep, voffB); PG8_STAGE(PG8_SA(1, 0), a3, voffA);
            PG8_WAIT_V(8); PG8_WAIT_L(0); PG8_BAR; PG8_MMA(1, 0, At, B0); PG8_MMA(1, 1, At, B1); PG8_BAR; PG8_SCHED;
            } else {
            PG8_LDB(B0, 0, 0); PG8_SCHED; PG8_LDA(At, 0, 0); PG8_STAGE(PG8_SA(1, 1), a1 + hstep, voffA);
            PG8_WAIT_L(8); PG8_BAR; PG8_WAIT_L(0); PG8_MMA(0, 0, At, B0); PG8_BAR; PG8_SCHED;
            PG8_LDB(B1, 0, 1); PG8_STAGE(PG8_SB(0, 0), b2, voffB);
            PG8_BAR; PG8_WAIT_L(0); PG8_MMA(0, 1, At, B1); PG8_BAR;
            PG8_LDA(At, 0, 1); PG8_STAGE(PG8_SA(0, 0), a2, voffA);
            PG8_BAR; PG8_WAIT_L(0); PG8_MMA(1, 0, At, B0); PG8_BAR; PG8_SCHED;
            PG8_STAGE(PG8_SB(0, 1), b2 + hstep, voffB);
            PG8_WAIT_V(6); PG8_BAR; PG8_MMA(1, 1, At, B1); PG8_BAR;
            PG8_LDB(B0, 1, 0); PG8_SCHED; PG8_LDA(At, 1, 0); PG8_STAGE(PG8_SA(0, 1), a2 + hstep, voffA);
            PG8_WAIT_L(8); PG8_BAR; PG8_WAIT_L(0); PG8_MMA(0, 0, At, B0); PG8_BAR; PG8_SCHED;
            PG8_LDB(B1, 1, 1); PG8_STAGE(PG8_SB(1, 0), b3, voffB);
            PG8_BAR; PG8_WAIT_L(0); PG8_MMA(0, 1, At, B1); PG8_BAR;
            PG8_LDA(At, 1, 1); PG8_STAGE(PG8_SA(1, 0), a3, voffA);
            PG8_BAR; PG8_WAIT_L(0); PG8_MMA(1, 0, At, B0); PG8_BAR; PG8_SCHED;
            PG8_STAGE(PG8_SB(1, 1), b3 + hstep, voffB);
            PG8_WAIT_V(6); PG8_BAR; PG8_MMA(1, 1, At, B1); PG8_BAR;
            }
        }
        if constexpr (ALIGN_EPI) { if (wr == 0) PG8_BAR; }
        if constexpr (!Epi::AFTER_DRAIN) { if (!Epi::LATE || has_next) { E(acc, cur, wr, wc, fr, fq); } S.done(cur); }
        if (!has_next) break;
#pragma unroll
        for (int a = 0; a < 2; ++a)
#pragma unroll
            for (int b = 0; b < 2; ++b)
#pragma unroll
                for (int m = 0; m < 4; ++m)
#pragma unroll
                    for (int n = 0; n < 2; ++n) acc[a][b][m][n] = (f32x4){0.f, 0.f, 0.f, 0.f};
        cur = nxt; cA = nA; cB = nB; ++ui;
        if constexpr (ALIGN_EPI) { if (wr == 1) PG8_BAR; }
    }
    PG8_WAIT_V(0);
    if constexpr (!ALIGN_EPI) { if (wr == 0) PG8_BAR; }
    PG8_BAR;
    if constexpr (Epi::AFTER_DRAIN) { E.fused(acc, cur, wr, wc, fr, fq, lds, wid, lane); S.done(cur); }
    if constexpr (!Epi::AFTER_DRAIN && Epi::LATE) { E(acc, cur, wr, wc, fr, fq); }
#undef PG8_SA
#undef PG8_SB
#undef PG8_STAGE
#undef PG8_LDA
#undef PG8_LDB
#undef PG8_MMA
#undef PG8_WAIT_V
#undef PG8_WAIT_L
#undef PG8_BAR
#undef PG8_SCHED
}
}
#include <hip/hip_bf16.h>
namespace attn_body {
using bf16=__hip_bfloat16;
using bf16x8=__attribute__((ext_vector_type(8)))short;
using s16x4=__attribute__((ext_vector_type(4)))short;
using f32x16=__attribute__((ext_vector_type(16)))float;
using u32x4=__attribute__((ext_vector_type(4)))unsigned;
constexpr int BATCH=8,NHEAD=16,SEQ=4096,D=64,PITI=3584,PITO=1024;
constexpr int NW=8,QBLK=32,QB=QBLK*NW,KVBLK=64,NQB=SEQ/QB;
__device__ __forceinline__ int crow(int r,int hi){return (r&3)+8*(r>>2)+4*hi;}
#define SBAR() __builtin_amdgcn_sched_barrier(0)
__device__ __forceinline__ void cmask(f32x16&p0,f32x16&p1,int jb,int qrel,int hi){
  const float NEG=-INFINITY; int kb=64*jb+4*hi;
  #pragma unroll
  for(int r=0;r<16;++r){int kv=kb+(r&3)+8*(r>>2); if(kv>qrel)p0[r]=NEG; if(kv+32>qrel)p1[r]=NEG;}
}

constexpr int NSLOT=3, SLOTB=8192;
constexpr int LDS_K=0, LDS_V=NSLOT*SLOTB, LDS_WS=2*NSLOT*SLOTB, LDS_OST=LDS_WS+NW*64*4, LDS_BYTES=LDS_OST+NW*4096;
constexpr float C2=0.125f*1.4426950408889634f;
__device__ __forceinline__ void glds16(const void*gsrc,unsigned lds_dst){unsigned keep;
  asm volatile("s_mov_b32 %0, m0\n\ts_mov_b32 m0, %2\n\ts_nop 0\n\tglobal_load_lds_dwordx4 %1, off\n\ts_mov_b32 m0, %0":"=&s"(keep):"v"(gsrc),"s"(lds_dst):"memory");}
__device__ __forceinline__ float max3f(float a,float b,float c){float r;asm("v_max3_f32 %0, %1, %2, %3":"=v"(r):"v"(a),"v"(b),"v"(c));return r;}
__device__ __forceinline__ float max2f(float a,float b){float r;asm("v_max_f32_e32 %0, %1, %2":"=v"(r):"v"(a),"v"(b));return r;}
__device__ __forceinline__ float fadd_s(float a,float b){float r;asm("v_add_f32_e32 %0, %1, %2":"=v"(r):"v"(a),"v"(b));return r;}
__device__ __forceinline__ float fsub_s(float a,float b){float r;asm("v_sub_f32_e32 %0, %1, %2":"=v"(r):"v"(a),"v"(b));return r;}
typedef float f32x2_t __attribute__((ext_vector_type(2))); typedef __bf16 bf16x2_t __attribute__((ext_vector_type(2)));
__device__ __forceinline__ unsigned cvtpk_s(float lo,float hi){f32x2_t v={lo,hi};bf16x2_t b=__builtin_convertvector(v,bf16x2_t);return __builtin_bit_cast(unsigned,b);}
#define WAIT_BAR(N) asm volatile("s_waitcnt vmcnt(" #N ") lgkmcnt(0)\n\ts_barrier":::"memory")

__device__ __forceinline__ void qkt(f32x16&p0,f32x16&p1,const char*Kslot,const bf16x8*qr,const f32x16&negm,int r32,int hi){
  const char*kb=Kslot+hi*1024+r32*16;
  #pragma unroll
  for(int d0=0;d0<4;++d0){
    const bf16x8 b0=*reinterpret_cast<const bf16x8*>(kb+d0*2048);
    const bf16x8 b1=*reinterpret_cast<const bf16x8*>(kb+d0*2048+512);
    if(d0==0){p0=__builtin_amdgcn_mfma_f32_32x32x16_bf16(b0,qr[0],negm,0,0,0);p1=__builtin_amdgcn_mfma_f32_32x32x16_bf16(b1,qr[0],negm,0,0,0);}
    else{p0=__builtin_amdgcn_mfma_f32_32x32x16_bf16(b0,qr[d0],p0,0,0,0);p1=__builtin_amdgcn_mfma_f32_32x32x16_bf16(b1,qr[d0],p1,0,0,0);}}
}
typedef __attribute__((address_space(3))) const char* lds_cptr;
typedef short v4i16_t __attribute__((ext_vector_type(4)));
__device__ __forceinline__ void kload8(bf16x8*kf,lds_cptr kp){
  kf[0]=*(const __attribute__((address_space(3))) bf16x8*)(kp);      kf[1]=*(const __attribute__((address_space(3))) bf16x8*)(kp+512);
  kf[2]=*(const __attribute__((address_space(3))) bf16x8*)(kp+2048); kf[3]=*(const __attribute__((address_space(3))) bf16x8*)(kp+2560);
  kf[4]=*(const __attribute__((address_space(3))) bf16x8*)(kp+4096); kf[5]=*(const __attribute__((address_space(3))) bf16x8*)(kp+4608);
  kf[6]=*(const __attribute__((address_space(3))) bf16x8*)(kp+6144); kf[7]=*(const __attribute__((address_space(3))) bf16x8*)(kp+6656);
}
__device__ __forceinline__ void kload2(bf16x8*kf,lds_cptr kp,int j){ kf[2*j]=*(const __attribute__((address_space(3))) bf16x8*)(kp+j*2048); kf[2*j+1]=*(const __attribute__((address_space(3))) bf16x8*)(kp+j*2048+512); }
__device__ __forceinline__ s16x4 vtr(lds_cptr p){ return __builtin_bit_cast(s16x4,__builtin_amdgcn_ds_read_tr16_b64_v4i16((__attribute__((address_space(3))) v4i16_t*)p)); }
__device__ __forceinline__ float rowmax(const f32x16&p0,const f32x16&p1){
  float a=max3f(p0[0],p0[1],p1[0]),b=max3f(p0[2],p0[3],p1[1]);a=max3f(a,p1[2],p1[3]);
  #pragma unroll
  for(int r=4;r<16;r+=4){a=max3f(a,p0[r],p0[r+1]);b=max3f(b,p0[r+2],p0[r+3]);a=max3f(a,p1[r],p1[r+1]);b=max3f(b,p1[r+2],p1[r+3]);}
  const float m=max2f(a,b);
  auto rr=__builtin_amdgcn_permlane32_swap(__float_as_uint(m),__float_as_uint(m),false,false);
  return max2f(__uint_as_float(rr[0]),__uint_as_float(rr[1]));
}
__device__ __forceinline__ void pv(f32x16*o,int vb,bf16x8 pa0,bf16x8 pa1,bf16x8 pa2,bf16x8 pa3){
  #pragma unroll
  for(int d0=0;d0<2;++d0){s16x4 lo[4],hi[4];
    #pragma unroll
    for(int ks=0;ks<4;++ks){
      asm volatile("ds_read_b64_tr_b16 %0,%1 offset:%c2":"=&v"(lo[ks]):"v"(vb),"i"(d0*4096+ks*1024):"memory");
      asm volatile("ds_read_b64_tr_b16 %0,%1 offset:%c2":"=&v"(hi[ks]):"v"(vb),"i"(d0*4096+ks*1024+512):"memory");}
    asm volatile("s_waitcnt lgkmcnt(0)":::"memory");SBAR();
    #define PK(k) (bf16x8){lo[k][0],lo[k][1],lo[k][2],lo[k][3],hi[k][0],hi[k][1],hi[k][2],hi[k][3]}
    o[d0]=__builtin_amdgcn_mfma_f32_32x32x16_bf16(pa0,PK(0),o[d0],0,0,0);
    o[d0]=__builtin_amdgcn_mfma_f32_32x32x16_bf16(pa1,PK(1),o[d0],0,0,0);
    o[d0]=__builtin_amdgcn_mfma_f32_32x32x16_bf16(pa2,PK(2),o[d0],0,0,0);
    o[d0]=__builtin_amdgcn_mfma_f32_32x32x16_bf16(pa3,PK(3),o[d0],0,0,0);
    #undef PK
  }
}

#ifndef ATTN_STORE16
#define ATTN_STORE16(p,v) (*(u32x4*)(p)=(v))
#endif
template<int THRL> __device__ __forceinline__ void attn_unit(int b,int h,int qb,const bf16*Q,const bf16*__restrict__ K,const bf16*__restrict__ V,bf16*O,char*shm){
  const int tid=otid_(),lane=tid&63,r32=lane&31,hi=lane>>5; const int wid=__builtin_amdgcn_readfirstlane(tid>>6);
  const long rowbase=(long)b*SEQ; const int q0=qb*QB;
  const bf16*Qw=Q+(rowbase+q0+wid*QBLK)*PITI;
  const bf16*Kh=K+rowbase*PITI,*Vh=V+rowbase*PITI;
  const unsigned lds0=(unsigned)(uintptr_t)shm;
  float*wsf=(float*)(shm+LDS_WS)+wid*64;
  const bf16*ksrc=Kh+(long)lane*PITI+wid*8;
  const bf16*vsrc=Vh+(long)(16*(wid&3)+(lane>>2))*PITI+(wid>>2)*32+(lane&3)*8;
  const unsigned kdst=lds0+LDS_K+wid*1024, vdst=lds0+LDS_V+wid*1024;
  #define DMA_K(t,slot) glds16(ksrc+(long)(t)*KVBLK*PITI,(unsigned)__builtin_amdgcn_readfirstlane(kdst+(slot)))
  #define DMA_V(t,slot) glds16(vsrc+(long)(t)*KVBLK*PITI,(unsigned)__builtin_amdgcn_readfirstlane(vdst+(slot)))
  const int vb0=(int)(lds0+LDS_V)+((lane>>4)&1)*32+(lane&3)*8+(4*hi+((lane&15)>>2))*64;
  const char*Kbase=shm+LDS_K; bf16x8 kf[8];
  const lds_cptr shm3=(lds_cptr)shm; const lds_cptr kp0=shm3+LDS_K+hi*1024+r32*16; const lds_cptr vp0=shm3+LDS_V+((lane>>4)&1)*32+(lane&3)*8+(4*hi+((lane&15)>>2))*64;
  const int NT=(q0+QB)/KVBLK;
  DMA_K(0,0);DMA_V(0,0);DMA_K(1,SLOTB);
  bf16x8 qr[4];
  #pragma unroll
  for(int d0=0;d0<4;++d0)qr[d0]=*reinterpret_cast<const bf16x8*>(&Qw[(long)r32*PITI+d0*16+hi*8]);
  float mhat=0.f,l_reg=0.f;f32x16 o[2];o[0]=f32x16{};o[1]=f32x16{};f32x16 negm=f32x16{};asm volatile("":"+v"(negm));
  const int qrel=wid*QBLK+r32;
  #define CMASK(P0,P1,t) do{int jb_=(t)-(NT-4); if(jb_>=0)cmask(P0,P1,jb_,qrel,hi);}while(0)
  bool resc=false;
  #define START(P0,P1) do{ const float rm=rowmax(P0,P1); resc=false; \
    { const float dl=rm; mhat=fadd_s(mhat,dl); \
      _Pragma("unroll") for(int r=0;r<16;++r){P0[r]=fsub_s(P0[r],dl);P1[r]=fsub_s(P1[r],dl);} \
      _Pragma("unroll") for(int r=0;r<16;++r)negm[r]=-mhat; asm volatile("":"+v"(negm)); } \
    _Pragma("unroll") for(int r=0;r<16;++r)P0[r]=__builtin_amdgcn_exp2f(P0[r]); }while(0)
  #define RESC() do{ if(resc){ asm volatile("s_waitcnt lgkmcnt(0)":::"memory"); \
      _Pragma("unroll") for(int d_=0;d_<2;++d_) _Pragma("unroll") for(int r=0;r<16;++r)o[d_][r]*=wsf[crow(r,hi)]; } }while(0)
  f32x16 pA0,pA1,pB0,pB1;
  int sl_prev=0,sl_cur=0,sl_next=SLOTB;
  #define ROT() do{sl_prev=sl_cur;sl_cur=sl_next;sl_next=(sl_next==(NSLOT-1)*SLOTB)?0:sl_next+SLOTB;}while(0)
  DMA_K(2,2*SLOTB);
  WAIT_BAR(3);
  qkt(pA0,pA1,Kbase,qr,negm,r32,hi);asm volatile("s_nop 15\n\ts_nop 7":"+v"(pA0),"+v"(pA1));CMASK(pA0,pA1,0);
  START(pA0,pA1);
  _Pragma("unroll") for(int r=0;r<16;++r)pA1[r]=__builtin_amdgcn_exp2f(pA1[r]);
  WAIT_BAR(0);
  DMA_K(3,0);DMA_V(1,SLOTB);
  ROT();
  kload8(kf,kp0+sl_cur);
  WAIT_BAR(2);
  s16x4 vlo[8],vhi[8]; u32x4 pw0,pw1,pw2,pw3;
  #define PKW(P,B) cvtpk_s(P[B],P[B+1])
  #define PAF(k) __builtin_bit_cast(bf16x8,pw##k)
  #define VFR(i) (bf16x8){vlo[i][0],vlo[i][1],vlo[i][2],vlo[i][3],vhi[i][0],vhi[i][1],vhi[i][2],vhi[i][3]}
  #define PIN(x) asm volatile("":"+v"(x))
  #define MX3(a,b,c) __builtin_fmaxf(__builtin_fmaxf((a),(b)),(c))
  #define GAPA(MF,A0,A1,A2,A3,W0,W1,PW) do{ MF; sacc+=A0; sacc+=A1; sacc+=A2; sacc+=A3; PIN(sacc); W0; W1; PIN(PW); SBAR(); }while(0)
  #define EX(v) __builtin_amdgcn_exp2f(v)
  #define GAPB(MF,X,B) do{ MF; X[B]=EX(X[B]); X[B+1]=EX(X[B+1]); X[B+2]=EX(X[B+2]); X[B+3]=EX(X[B+3]); PIN(X); SBAR(); }while(0)
  #define VRD(i) do{ vlo[i]=vtr(vp_+(((i)>>2)*4096+((i)&3)*1024)); vhi[i]=vtr(vp_+(((i)>>2)*4096+((i)&3)*1024+512)); }while(0)
  #define KRD(G,j) do{ if(G){ kload2(kf,kp0+sl_next,j); SBAR(); } }while(0)
  #define STEP(C0,C1,P0,P1,t,GK,GV,GL) do{ SBAR(); \
    const lds_cptr vp_=vp0+sl_prev; \
    VRD(0); SBAR(); float sacc=(P0[0]+P0[1]); \
    GAPA(C0=__builtin_amdgcn_mfma_f32_32x32x16_bf16(kf[0],qr[0],negm,0,0,0), P0[2],P0[3],P0[4],P0[5],     pw0[0]=PKW(P0,0), pw0[1]=PKW(P0,2), pw0); \
    VRD(4); SBAR(); GAPA(C1=__builtin_amdgcn_mfma_f32_32x32x16_bf16(kf[1],qr[0],negm,0,0,0), P0[6],P0[7],P0[8],P0[9],     pw0[2]=PKW(P0,4), pw0[3]=PKW(P0,6), pw0); \
    VRD(1); SBAR(); GAPA(C0=__builtin_amdgcn_mfma_f32_32x32x16_bf16(kf[2],qr[1],C0,0,0,0),   P0[10],P0[11],P0[12],P0[13], pw1[0]=PKW(P0,8), pw1[1]=PKW(P0,10), pw1); \
    VRD(5); SBAR(); GAPA(C1=__builtin_amdgcn_mfma_f32_32x32x16_bf16(kf[3],qr[1],C1,0,0,0),   P0[14],P0[15],P1[0],P1[1],   pw1[2]=PKW(P0,12),pw1[3]=PKW(P0,14), pw1); \
    VRD(2); SBAR(); GAPA(C0=__builtin_amdgcn_mfma_f32_32x32x16_bf16(kf[4],qr[2],C0,0,0,0),   P1[2],P1[3],P1[4],P1[5],     pw2[0]=PKW(P1,0), pw2[1]=PKW(P1,2), pw2); \
    VRD(6); SBAR(); GAPA(C1=__builtin_amdgcn_mfma_f32_32x32x16_bf16(kf[5],qr[2],C1,0,0,0),   P1[6],P1[7],P1[8],P1[9],     pw2[2]=PKW(P1,4), pw2[3]=PKW(P1,6), pw2); \
    VRD(3); SBAR(); GAPA(C0=__builtin_amdgcn_mfma_f32_32x32x16_bf16(kf[6],qr[3],C0,0,0,0),   P1[10],P1[11],P1[12],P1[13], pw3[0]=PKW(P1,8), pw3[1]=PKW(P1,10), pw3); \
    VRD(7); SBAR(); GAPA(C1=__builtin_amdgcn_mfma_f32_32x32x16_bf16(kf[7],qr[3],C1,0,0,0),   P1[14],P1[15],0.f,0.f,       pw3[2]=PKW(P1,12),pw3[3]=PKW(P1,14), pw3); \
    l_reg+=sacc; \
    if(GK){DMA_K((t)+3,sl_cur);} if(GV){DMA_V((t)+1,sl_next);} \
    CMASK(C0,C1,t); \
    { float a=MX3(C0[0],C0[1],C1[0]),b=MX3(C0[2],C0[3],C1[1]); a=MX3(a,C1[2],C1[3]); \
      _Pragma("unroll") for(int r=4;r<16;r+=4){a=MX3(a,C0[r],C0[r+1]);b=MX3(b,C0[r+2],C0[r+3]);a=MX3(a,C1[r],C1[r+1]);b=MX3(b,C1[r+2],C1[r+3]);} \
      float rm=__builtin_fmaxf(a,b); { auto rr=__builtin_amdgcn_permlane32_swap(__float_as_uint(rm),__float_as_uint(rm),false,false); rm=__builtin_fmaxf(__uint_as_float(rr[0]),__uint_as_float(rr[1])); } \
      resc=false; \
      if(__builtin_expect(__any(rm>(float)THRL),0)){ const float dl=__builtin_fmaxf(rm,0.f); mhat+=dl; \
        _Pragma("unroll") for(int r=0;r<16;++r){C0[r]-=dl;C1[r]-=dl;} \
        _Pragma("unroll") for(int r=0;r<16;++r)negm[r]=-mhat; asm volatile("":"+v"(negm)); \
        const float f=__builtin_amdgcn_exp2f(-dl); l_reg*=f; if(hi==0)wsf[r32]=f; resc=true; } } \
    SBAR(); \
    GAPB(o[0]=__builtin_amdgcn_mfma_f32_32x32x16_bf16(PAF(0),VFR(0),o[0],0,0,0), C0,0); \
    GAPB(o[1]=__builtin_amdgcn_mfma_f32_32x32x16_bf16(PAF(0),VFR(4),o[1],0,0,0), C0,4); \
    KRD(GL,0); GAPB(o[0]=__builtin_amdgcn_mfma_f32_32x32x16_bf16(PAF(1),VFR(1),o[0],0,0,0), C0,8); \
    KRD(GL,1); GAPB(o[1]=__builtin_amdgcn_mfma_f32_32x32x16_bf16(PAF(1),VFR(5),o[1],0,0,0), C0,12); \
    KRD(GL,2); GAPB(o[0]=__builtin_amdgcn_mfma_f32_32x32x16_bf16(PAF(2),VFR(2),o[0],0,0,0), C1,0); \
    KRD(GL,3); GAPB(o[1]=__builtin_amdgcn_mfma_f32_32x32x16_bf16(PAF(2),VFR(6),o[1],0,0,0), C1,4); \
    GAPB(o[0]=__builtin_amdgcn_mfma_f32_32x32x16_bf16(PAF(3),VFR(3),o[0],0,0,0), C1,8); \
    GAPB(o[1]=__builtin_amdgcn_mfma_f32_32x32x16_bf16(PAF(3),VFR(7),o[1],0,0,0), C1,12); \
    }while(0)
  int t=1;
  #undef CMASK
  #define CMASK(P0,P1,t) do{}while(0)
  for(;t+5<NT;t+=2){
    STEP(pB0,pB1,pA0,pA1,t,true,true,true);     WAIT_BAR(2); RESC(); ROT();
    STEP(pA0,pA1,pB0,pB1,t+1,true,true,true);   WAIT_BAR(2); RESC(); ROT();
  }
  #undef CMASK
  #define CMASK(P0,P1,t) do{int jb_=(t)-(NT-4); if(jb_>=0)cmask(P0,P1,jb_,qrel,hi);}while(0)
  #define ENDW(tt) do{ if((tt)+3<NT){WAIT_BAR(2);} else if((tt)+2<NT){WAIT_BAR(1);} else {WAIT_BAR(0);} }while(0)
  for(;t+1<NT;t+=2){
    STEP(pB0,pB1,pA0,pA1,t,(t+3<NT),(t+1<NT),(t+1<NT));       ENDW(t);   RESC(); ROT();
    STEP(pA0,pA1,pB0,pB1,t+1,(t+4<NT),(t+2<NT),(t+2<NT));     ENDW(t+1); RESC(); ROT();
  }
  STEP(pB0,pB1,pA0,pA1,NT-1,false,false,false); RESC();
  { float sacc=pB0[0]+pB0[1]; _Pragma("unroll") for(int r=2;r<16;++r)sacc+=pB0[r]; _Pragma("unroll") for(int r=0;r<16;++r)sacc+=pB1[r]; l_reg+=sacc;
    pw0=(u32x4){PKW(pB0,0),PKW(pB0,2),PKW(pB0,4),PKW(pB0,6)};pw1=(u32x4){PKW(pB0,8),PKW(pB0,10),PKW(pB0,12),PKW(pB0,14)};pw2=(u32x4){PKW(pB1,0),PKW(pB1,2),PKW(pB1,4),PKW(pB1,6)};pw3=(u32x4){PKW(pB1,8),PKW(pB1,10),PKW(pB1,12),PKW(pB1,14)};
    SBAR(); pv(o,vb0+sl_cur,PAF(0),PAF(1),PAF(2),PAF(3)); }
  #undef PKW
  #undef PAF
  #undef VFR
  #undef PIN
  #undef MX3
  #undef GAPA
  #undef GAPB
  #undef EX
  #undef VRD
  #undef KRD
  #undef STEP
  #undef ENDW
  {auto rr=__builtin_amdgcn_permlane32_swap(__float_as_uint(l_reg),__float_as_uint(l_reg),false,false);l_reg=__uint_as_float(rr[0])+__uint_as_float(rr[1]);}
  if(hi==0)wsf[32+r32]=l_reg;asm volatile("s_waitcnt lgkmcnt(0)":::"memory");
  float rli[16];
  #pragma unroll
  for(int r=0;r<16;++r)rli[r]=__builtin_amdgcn_rcpf(wsf[32+crow(r,hi)]);
  bf16*Ow=O+(rowbase+q0+wid*QBLK)*PITO;
  { bf16*stg=(bf16*)(shm+LDS_OST)+wid*2048;
    #pragma unroll
    for(int r=0;r<16;++r){const int orow=crow(r,hi);
      #pragma unroll
      for(int d0=0;d0<2;++d0)stg[orow*64+d0*32+r32]=__float2bfloat16(o[d0][r]*rli[r]);}
    asm volatile("s_waitcnt lgkmcnt(0)":::"memory");
    #pragma unroll
    for(int i=0;i<4;++i){const int row=i*8+(lane>>3),ch=lane&7; const u32x4 v=*(const u32x4*)(stg+row*64+ch*8); ATTN_STORE16(Ow+(long)row*PITO+ch*8,v);} }
  asm volatile("s_waitcnt lgkmcnt(0)\n\ts_barrier":::"memory");
  #undef DMA_K
  #undef DMA_V
  #undef CMASK
  #undef START
  #undef RESC
  #undef ROT
}
constexpr int ATTN_LDS_BYTES=LDS_BYTES;
#undef SBAR
#undef WAIT_BAR
}

namespace cg = cooperative_groups;
typedef unsigned short bf16_t;
typedef float f32x4 __attribute__((ext_vector_type(4)));
typedef float f32x16 __attribute__((ext_vector_type(16)));
typedef unsigned u32x4 __attribute__((ext_vector_type(4)));
typedef unsigned u32x2 __attribute__((ext_vector_type(2)));
typedef short bf16x8 __attribute__((ext_vector_type(8)));
#define LAS3 __attribute__((address_space(3)))

constexpr int T_ = 32768, DM_ = 1024, SEQ_ = 4096, DFF_ = 2816;
constexpr int NTHR = 512;
constexpr int LDS_BYTES = 147456;
constexpr size_t MiB_ = 1u << 20;
constexpr size_t WS_MOD = 0, WS_COS = 1 * MiB_, WS_SIN = 2 * MiB_, WS_BAR = 3 * MiB_;
constexpr size_t WS_WIN = 4 * MiB_, WS_WOUT = 11 * MiB_, WS_FIN = 13 * MiB_, WS_FOUT = 24 * MiB_;
constexpr size_t WS_A = 32 * MiB_, WS_X2 = 96 * MiB_, WS_ST = 160 * MiB_, WS_TOT = 224 * MiB_, WS_R1 = 226 * MiB_, WS_BIAS = 450 * MiB_, WS_ROWSS = 452 * MiB_, WS_FOUT2 = 454 * MiB_, WS_WOUT2 = 460 * MiB_, WS_FIN2 = 462 * MiB_, WS_END = 473 * MiB_;
constexpr int BIAS_L = 8 * (3584 + 5632);
constexpr size_t WS_HP = WS_ST, WS_HU = WS_ST + 12 * MiB_, WS_HA = WS_ST + 24 * MiB_;
constexpr float LOG2E_ = 1.4426950408889634f;
constexpr float QSCALE_ = 0.125f * 1.4426950408889634f;

struct Params {
    const float* x; const float* c; const int* positions; const float* mod_w; const float* mod_b; const float* norm_mix_w; const float* norm_ffn_w;
    const float* ev_w_in; const float* gla_gate_w; const float* gla_gate_b; const float* gla_norm_w; const float* swa_sinks; const float* ev_w_out;
    const float* od_w_in; const float* diff_lambda; const float* diff_norm_w; const float* hgrn_lb_logits; const float* hgrn_norm_w; const float* od_w_out;
    const float* ffn_w_in; const float* ffn_conv_w; const float* ffn_conv_b; const float* ffn_w_out; const float* final_norm_w;
    float* out; unsigned char* ws; unsigned long long pad[6];
};

__device__ __forceinline__ unsigned pk2(float lo, float hi) {
    typedef float f32x2_t __attribute__((ext_vector_type(2))); typedef __bf16 bf16x2_t __attribute__((ext_vector_type(2)));
    f32x2_t v = {lo, hi}; bf16x2_t b = __builtin_convertvector(v, bf16x2_t); return __builtin_bit_cast(unsigned, b);
}
__device__ __forceinline__ float bflo(unsigned u) { return __uint_as_float(u << 16); }
__device__ __forceinline__ float bfhi(unsigned u) { return __uint_as_float(u & 0xffff0000u); }
__device__ __forceinline__ float sigmoidf_(float x) { return __builtin_amdgcn_rcpf(1.f + __expf(-x)); }
__device__ __forceinline__ float siluf_(float x) { return x * __builtin_amdgcn_rcpf(1.f + __expf(-x)); }
__device__ __forceinline__ float wave_sum(float v) {
#pragma unroll
    for (int o = 1; o < 64; o <<= 1) v += __shfl_xor(v, o);
    return v;
}
__device__ __forceinline__ int crow_(int r, int hi) { return (r & 3) + 8 * (r >> 2) + 4 * hi; }

namespace pg8 {
struct EpiProj {
    static constexpr bool PERM = true, AFTER_DRAIN = false, LATE = false;
    bf16_t* O; int ldc; unsigned ropemask; unsigned scalemask; float scale; const float* cs; const float* sn; const float* rowss; const float* bias;
    __device__ __forceinline__ void operator()(const f32x4 (&acc)[2][2][4][2], const Unit& u, int, int, int, int) const {
        const int t_ = otid_(), l_ = t_ & 63, fr = l_ & 15, fq = l_ >> 4, wid_ = __builtin_amdgcn_readfirstlane(t_ >> 6), wr = wid_ >> 2, wc = wid_ & 3;
        const int row0 = u.pm * BM + wr * 64 + fr; const int col0 = u.pn * BM + wc * 32 + 8 * fq;
        float rs[2][4];
#pragma unroll
        for (int ai = 0; ai < 2; ++ai)
#pragma unroll
            for (int m = 0; m < 4; ++m) rs[ai][m] = rsqrtf(rowss[row0 + ai * HALF + m * 16] * (1.f / 1024.f) + 1e-6f);
        const float* bp = bias + (size_t)((u.pm * BM) >> 12) * ldc + col0;
#pragma unroll
        for (int bj = 0; bj < 2; ++bj) {
            const f32x4 bv0 = *(const f32x4*)(bp + bj * HALF), bv1 = *(const f32x4*)(bp + bj * HALF + 4);
            const int grp = u.pn * 2 + bj;
            const bool rope = ((ropemask >> grp) & 1u) && ((wc & 1) == 0);
            const float sc = ((scalemask >> grp) & 1u) ? scale : 1.f;
#pragma unroll
            for (int ai = 0; ai < 2; ++ai)
#pragma unroll
                for (int m = 0; m < 4; ++m) {
                    const int row = row0 + ai * HALF + m * 16;
                    f32x4 v0 = acc[ai][bj][m][0] * rs[ai][m] + bv0, v1 = acc[ai][bj][m][1] * rs[ai][m] + bv1;
                    if (rope) {
                        const f32x4 c0 = *(const f32x4*)(cs + (size_t)row * 8), c1 = *(const f32x4*)(cs + (size_t)row * 8 + 4);
                        const f32x4 s0 = *(const f32x4*)(sn + (size_t)row * 8), s1 = *(const f32x4*)(sn + (size_t)row * 8 + 4);
                        const float sg = (fq == 0) ? -1.f : 1.f;
#pragma unroll
                        for (int e = 0; e < 4; ++e) {
                            const float p0 = __shfl_xor(v0[e], 16), p1 = __shfl_xor(v1[e], 16);
                            const float r0 = v0[e] * c0[e] + sg * p0 * s0[e], r1 = v1[e] * c1[e] + sg * p1 * s1[e];
                            if (fq < 2) { v0[e] = r0; v1[e] = r1; }
                        }
                    }
                    v0 = v0 * sc; v1 = v1 * sc;
                    u32x4 w; w.x = pk2(v0[0], v0[1]); w.y = pk2(v0[2], v0[3]); w.z = pk2(v1[0], v1[1]); w.w = pk2(v1[2], v1[3]);
                    *(u32x4*)(O + (size_t)row * ldc + col0 + bj * HALF) = w;
                    asm volatile("" ::: "memory");
                }
        }
    }
};
struct EpiRes {
    static constexpr bool PERM = false, AFTER_DRAIN = false, LATE = true;
    const float* xin; float* xout; const float* gate;
    bf16_t* Aout; const float* nw; const float* sc; float* rowss;
    __device__ __forceinline__ void operator()(const f32x4 (&acc)[2][2][4][2], const Unit& u, int, int, int, int) const {
        const int t_ = otid_(), l_ = t_ & 63, fr = l_ & 15, fq = l_ >> 4, wid_ = __builtin_amdgcn_readfirstlane(t_ >> 6), wr = wid_ >> 2, wc = wid_ & 3;
        const int col0 = u.pn * BM + wc * 32 + 4 * fq;
        const size_t boff = (size_t)((u.pm * BM) >> 12) * 6144 + col0;
        f32x4 gv[2][2];
#pragma unroll
        for (int bj = 0; bj < 2; ++bj)
#pragma unroll
            for (int n = 0; n < 2; ++n) gv[bj][n] = *(const f32x4*)(gate + boff + bj * HALF + n * 16);
        const int rowb = u.pm * BM + wr * 64 + fr;
        const unsigned ob0 = ((unsigned)rowb * 1024u + (unsigned)col0) * 4u;
        const char* xi = (const char*)xin; char* xo = (char*)xout; char* ao = (char*)Aout;
#pragma unroll
        for (int grp = 0; grp < 8; ++grp) {
            const int ai = grp >> 2, m = grp & 3;
            const unsigned ob = ob0 + (unsigned)(ai * HALF + m * 16) * 4096u;
            float ss = 0.f;
#pragma unroll
            for (int bj = 0; bj < 2; ++bj)
#pragma unroll
                for (int n = 0; n < 2; ++n) {
                    const unsigned o2 = ob + (unsigned)(bj * HALF + n * 16) * 4u;
                    const f32x4 xn = *(const f32x4*)(xi + o2) + gv[bj][n] * acc[ai][bj][m][n];
                    *(f32x4*)(xo + o2) = xn;
                    if (Aout) {
                        ss += (xn[0] * xn[0] + xn[1] * xn[1]) + (xn[2] * xn[2] + xn[3] * xn[3]);
                        const f32x4 a = xn * (*(const f32x4*)(nw + col0 + bj * HALF + n * 16) * (*(const f32x4*)(sc + boff + bj * HALF + n * 16) + 1.f));
                        u32x2 q; q.x = pk2(a[0], a[1]); q.y = pk2(a[2], a[3]);
                        *(u32x2*)(ao + (o2 >> 1)) = q;
                    }
                }
            if (Aout) {
                ss += __shfl_xor(ss, 16); ss += __shfl_xor(ss, 32);
                if (fq == 0) atomicAdd(rowss + rowb + ai * HALF + m * 16, ss);
            }
            asm volatile("" ::: "memory");
        }
    }
};
struct EpiFfn {
    static constexpr bool PERM = true, AFTER_DRAIN = false, LATE = false;
    bf16_t* G; float* HP; float* HU; float* HA; const float* cw; const float* cb; const float* rowss; const float* bias;
    __device__ __forceinline__ void operator()(const f32x4 (&acc)[2][2][4][2], const Unit& u, int, int, int, int) const {
        const int t_ = otid_(), l_ = t_ & 63, fr = l_ & 15, fq = l_ >> 4, wid_ = __builtin_amdgcn_readfirstlane(t_ >> 6), wr = wid_ >> 2, wc = wid_ & 3;
        const int ch0 = u.pn * 128 + wc * 32 + 8 * fq;
        f32x4 w0[2], w1[2], w2[2], bb[2];
#pragma unroll
        for (int n = 0; n < 2; ++n) { w0[n] = *(const f32x4*)(cw + ch0 + 4 * n); w1[n] = *(const f32x4*)(cw + DFF_ + ch0 + 4 * n); w2[n] = *(const f32x4*)(cw + 2 * DFF_ + ch0 + 4 * n); bb[n] = *(const f32x4*)(cb + ch0 + 4 * n); }
        const int lane = fr + 16 * fq;
        const int src1 = (lane & ~15) | ((fr + 15) & 15), src2 = (lane & ~15) | ((fr + 14) & 15);
        const float* bp = bias + (size_t)((u.pm * BM) >> 12) * 5632 + u.pn * BM + wc * 32 + 8 * fq;
        f32x4 ba[2], bu[2];
#pragma unroll
        for (int n = 0; n < 2; ++n) { ba[n] = *(const f32x4*)(bp + 4 * n); bu[n] = *(const f32x4*)(bp + HALF + 4 * n); }
#pragma unroll
        for (int ai = 0; ai < 2; ++ai) {
            const int seg = u.pm * 4 + ai * 2 + wr;
            f32x4 aprev[2]; aprev[0] = (f32x4){0.f, 0.f, 0.f, 0.f}; aprev[1] = (f32x4){0.f, 0.f, 0.f, 0.f};
#pragma unroll
            for (int m = 0; m < 4; ++m) {
                const int row = u.pm * BM + ai * HALF + wr * 64 + m * 16 + fr;
                const float rs = rsqrtf(rowss[row] * (1.f / 1024.f) + 1e-6f);
                f32x4 val[2], acur[2];
#pragma unroll
                for (int n = 0; n < 2; ++n) {
                    const f32x4 a = acc[ai][0][m][n] * rs + ba[n];
                    acur[n] = a;
                    const f32x4 ap = aprev[n];
#pragma unroll
                    for (int e = 0; e < 4; ++e) {
                        const float t1 = (fr == 15) ? ap[e] : a[e];
                        const float t2 = (fr >= 14) ? ap[e] : a[e];
                        const float p1 = __shfl(t1, src1), p2 = __shfl(t2, src2);
                        val[n][e] = w2[n][e] * a[e] + w1[n][e] * p1 + w0[n][e] * p2 + bb[n][e];
                    }
                }
                const f32x4 u0 = acc[ai][1][m][0] * rs + bu[0], u1 = acc[ai][1][m][1] * rs + bu[1];
                f32x4 g0, g1;
#pragma unroll
                for (int e = 0; e < 4; ++e) { g0[e] = siluf_(val[0][e]) * u0[e]; g1[e] = siluf_(val[1][e]) * u1[e]; }
                u32x4 w; w.x = pk2(g0[0], g0[1]); w.y = pk2(g0[2], g0[3]); w.z = pk2(g1[0], g1[1]); w.w = pk2(g1[2], g1[3]);
                *(u32x4*)(G + (size_t)row * DFF_ + ch0) = w;
                if (m == 0 && fr < 2) {
                    const size_t ho = (size_t)(seg * 2 + fr) * DFF_ + ch0;
                    *(f32x4*)(HP + ho) = val[0]; *(f32x4*)(HP + ho + 4) = val[1];
                    *(f32x4*)(HU + ho) = u0; *(f32x4*)(HU + ho + 4) = u1;
                }
                if (m == 3 && fr >= 14) {
                    const size_t ho = (size_t)(seg * 2 + (fr - 14)) * DFF_ + ch0;
                    *(f32x4*)(HA + ho) = acur[0]; *(f32x4*)(HA + ho + 4) = acur[1];
                }
                aprev[0] = acur[0]; aprev[1] = acur[1];
                asm volatile("" ::: "memory");
            }
        }
    }
};
}

struct Ctx { Params p; unsigned char* lds; int tid, lane, wave, gw, ngw; };

__device__ __forceinline__ void phase_prologue(const Ctx& C) {
    const Params& p = C.p;
    float* cact = (float*)C.lds;
    float* red = (float*)(C.lds + 32768);
    float* mod = (float*)(p.ws + WS_MOD);
    const int tid = C.tid;
    for (int i = tid; i < 8192; i += NTHR) { const float c = p.c[i]; cact[i] = c / (1.f + __expf(-c)); }
    __syncthreads();
    const int col = tid & 63, kp = tid >> 6;
    for (int g = blockIdx.x; g < 384; g += gridDim.x) {
        const int l = g / 96, j = (g % 96) * 64 + col;
        const float* w = p.mod_w + (size_t)l * 1024 * 6144 + (size_t)(kp * 128) * 6144 + j;
        float a0 = 0.f, a1 = 0.f, a2 = 0.f, a3 = 0.f, a4 = 0.f, a5 = 0.f, a6 = 0.f, a7 = 0.f;
        const float* ca = cact + kp * 128;
#pragma unroll 8
        for (int k = 0; k < 128; ++k) {
            const float wv = w[(size_t)k * 6144];
            a0 += ca[k] * wv; a1 += ca[1024 + k] * wv; a2 += ca[2048 + k] * wv; a3 += ca[3072 + k] * wv;
            a4 += ca[4096 + k] * wv; a5 += ca[5120 + k] * wv; a6 += ca[6144 + k] * wv; a7 += ca[7168 + k] * wv;
        }
        float* r = red + (kp * 8) * 64 + col;
        r[0] = a0; r[64] = a1; r[128] = a2; r[192] = a3; r[256] = a4; r[320] = a5; r[384] = a6; r[448] = a7;
        __syncthreads();
        { const int b = tid >> 6; float s = 0.f;
#pragma unroll
          for (int kk = 0; kk < 8; ++kk) s += red[(kk * 8 + b) * 64 + col];
          mod[(size_t)(l * 8 + b) * 6144 + j] = s + p.mod_b[l * 6144 + j]; }
        __syncthreads();
    }
    {
        u32x4* zb = (u32x4*)(p.ws + WS_BIAS); const int nzb = 4 * BIAS_L * 4 / 16;
        for (int i = blockIdx.x * NTHR + tid; i < nzb; i += gridDim.x * NTHR) zb[i] = (u32x4){0u, 0u, 0u, 0u};
        u32x4* zr = (u32x4*)(p.ws + WS_ROWSS);
        for (int i = blockIdx.x * NTHR + tid; i < 8 * T_ * 4 / 16; i += gridDim.x * NTHR) zr[i] = (u32x4){0u, 0u, 0u, 0u};
    }
    float* cs = (float*)(p.ws + WS_COS); float* sn = (float*)(p.ws + WS_SIN);
    const float invf[8] = {1.0f, 0.1939227432012558f, 0.03760603070259094f, 0.007292664609849453f, 0.0014142135623842478f, 0.00027424818836152554f, 5.3182957344688475e-05f, 1.0313385246263351e-05f};
    for (int r = blockIdx.x * NTHR + tid; r < T_; r += gridDim.x * NTHR) {
        const float pos = (float)p.positions[r];
        f32x4 c4[2], s4[2];
#pragma unroll
        for (int i = 0; i < 8; ++i) {
            const float ang = pos * invf[i];
            const double xr = (double)ang * 0.15915494309189535;
            const float f = (float)(xr - rint(xr));
            c4[i >> 2][i & 3] = __builtin_amdgcn_cosf(f); s4[i >> 2][i & 3] = __builtin_amdgcn_sinf(f);
        }
        *(f32x4*)(cs + (size_t)r * 8) = c4[0]; *(f32x4*)(cs + (size_t)r * 8 + 4) = c4[1];
        *(f32x4*)(sn + (size_t)r * 8) = s4[0]; *(f32x4*)(sn + (size_t)r * 8 + 4) = s4[1];
    }
}

__device__ __forceinline__ void tr_item(const float* W, int Nsrc, int srccol0, bf16_t* WT, int K, int dstrow0, int k0, float* scr, int lane) {
    float wv[32];
#pragma unroll
    for (int i = 0; i < 32; ++i) wv[i] = W[(size_t)(k0 + 2 * i + (lane >> 5)) * Nsrc + srccol0 + (lane & 31)];
#pragma unroll
    for (int i = 0; i < 32; ++i) scr[(2 * i + (lane >> 5)) * 33 + (lane & 31)] = wv[i];
    asm volatile("s_waitcnt lgkmcnt(0)" ::: "memory");
    const int c = lane & 7;
#pragma unroll
    for (int j = 0; j < 4; ++j) { const int n = (lane >> 3) + 8 * j; const float* s = scr + (8 * c) * 33 + n;
        u32x4 o; o.x = pk2(s[0 * 33], s[1 * 33]); o.y = pk2(s[2 * 33], s[3 * 33]); o.z = pk2(s[4 * 33], s[5 * 33]); o.w = pk2(s[6 * 33], s[7 * 33]);
        *(u32x4*)(WT + (size_t)(dstrow0 + n) * K + k0 + 8 * c) = o; }
    asm volatile("s_waitcnt lgkmcnt(0)" ::: "memory");
}
__device__ __forceinline__ void phase_convert(const Ctx& C, int l, int parts, bool do_bias = true) {
    const Params& p = C.p; const int j = l >> 1; const bool even = !(l & 1);
    float* scr = (float*)(C.lds + C.wave * 8704);
    bf16_t* WIN = (bf16_t*)(p.ws + WS_WIN); bf16_t* WOUT = (bf16_t*)(p.ws + ((l & 1) ? WS_WOUT2 : WS_WOUT)); bf16_t* FIN = (bf16_t*)(p.ws + ((l & 1) ? WS_FIN2 : WS_FIN)); bf16_t* FOUT = (bf16_t*)(p.ws + ((l & 1) ? WS_FOUT2 : WS_FOUT));
    const int nA = even ? 80 : 112;
    const int IA = (parts & 1) ? 16 * nA : 0, IB = (parts & 2) ? 16 * 32 : 0, IC = (parts & 4) ? 16 * 176 : 0, ID = (parts & 8) ? 44 * 32 : 0;
    const float* win = even ? p.ev_w_in + (size_t)j * 1024 * 2320 : p.od_w_in + (size_t)j * 1024 * 3584;
    const float* wout = even ? p.ev_w_out + (size_t)j * 1024 * 1024 : p.od_w_out + (size_t)j * 1024 * 1024;
    const float* fin = p.ffn_w_in + (size_t)l * 1024 * 5632; const float* fout = p.ffn_w_out + (size_t)l * 2816 * 1024;
    for (int it = C.gw; it < IA + IB + IC + ID; it += C.ngw) {
        int r = it;
        if (r < IA) { const int kb = r / nA, nb = r % nA, n0 = nb * 32; int sc = n0;
            if (even) { if (n0 >= 512 && n0 < 768) continue; if (n0 >= 1792) sc = n0 - 240; else if (n0 >= 768) sc = n0 - 256; }
            tr_item(win, even ? 2320 : 3584, sc, WIN, 1024, n0, kb * 64, scr, C.lane); continue; }
        r -= IA;
        if (r < IB) { const int kb = r / 32, nb = r % 32; tr_item(wout, 1024, nb * 32, WOUT, 1024, nb * 32, kb * 64, scr, C.lane); continue; }
        r -= IB;
        if (r < IC) { const int kb = r / 176, nb = r % 176, n0 = nb * 32; const int pn = n0 >> 8, jj = n0 & 255;
            const int sc = (jj < 128) ? pn * 128 + jj : 2816 + pn * 128 + (jj - 128);
            tr_item(fin, 5632, sc, FIN, 1024, n0, kb * 64, scr, C.lane); continue; }
        r -= IC;
        { const int kb = r / 32, nb = r % 32; tr_item(fout, 1024, nb * 32, FOUT, 2816, nb * 32, kb * 64, scr, C.lane); }
    }
    if (do_bias && (parts & 5)) {
        float* shl = (float*)(C.lds + 69632);
        const float* modl = (const float*)(p.ws + WS_MOD) + (size_t)l * 8 * 6144;
        __syncthreads();
        for (int i2 = C.tid; i2 < 2 * 8192; i2 += NTHR) { const int which = i2 >> 13, k = (i2 >> 3) & 1023, b = i2 & 7; shl[i2] = modl[(size_t)b * 6144 + (which ? 3072 : 0) + k]; }
        __syncthreads();
        float* bias_in = (float*)(p.ws + WS_BIAS) + (size_t)l * BIAS_L; float* bias_ff = bias_in + 8 * 3584;
        const int Nin0 = even ? 2560 : 3584, Nsrc = even ? 2320 : 3584, Nin = (parts & 1) ? Nin0 : 0, Nff = (parts & 4) ? 5632 : 0;
        const float* gwp = p.gla_gate_w + (size_t)j * 16 * 256;
        for (int u = blockIdx.x * NTHR + C.tid; u < (Nin + Nff) * 16; u += gridDim.x * NTHR) {
            const bool ff = u >= Nin * 16; const int uu = ff ? u - Nin * 16 : u, N = ff ? 5632 : Nin0, n = uu % N, kp = uu / N;
            float a[8];
#pragma unroll
            for (int b = 0; b < 8; ++b) a[b] = 0.f;
            const float* shp = shl + (ff ? 8192 : 0) + kp * 64 * 8;
            if (!ff && even && n >= 512 && n < 768) {
                float g[16];
#pragma unroll
                for (int r = 0; r < 16; ++r) g[r] = gwp[r * 256 + (n - 512)];
                for (int k = 0; k < 64; ++k) {
                    const float* wr = win + (size_t)(kp * 64 + k) * 2320 + 1536;
                    float wv = 0.f;
#pragma unroll
                    for (int r = 0; r < 16; ++r) wv += wr[r] * g[r];
                    const f32x4 s0 = *(const f32x4*)(shp + k * 8), s1 = *(const f32x4*)(shp + k * 8 + 4);
                    a[0] += s0[0] * wv; a[1] += s0[1] * wv; a[2] += s0[2] * wv; a[3] += s0[3] * wv; a[4] += s1[0] * wv; a[5] += s1[1] * wv; a[6] += s1[2] * wv; a[7] += s1[3] * wv;
                }
            } else {
                int sc; const float* W; int Ns;
                if (ff) { const int pn = n >> 8, jj = n & 255; sc = (jj < 128) ? pn * 128 + jj : 2816 + pn * 128 + (jj - 128); W = fin; Ns = 5632; }
                else { sc = n; if (even) { if (n >= 1792) sc = n - 240; else if (n >= 768) sc = n - 256; } W = win; Ns = Nsrc; }
                const float* wp = W + (size_t)(kp * 64) * Ns + sc;
#pragma unroll 8
                for (int k = 0; k < 64; ++k) {
                    const float wv = wp[(size_t)k * Ns];
                    const f32x4 s0 = *(const f32x4*)(shp + k * 8), s1 = *(const f32x4*)(shp + k * 8 + 4);
                    a[0] += s0[0] * wv; a[1] += s0[1] * wv; a[2] += s0[2] * wv; a[3] += s0[3] * wv; a[4] += s1[0] * wv; a[5] += s1[1] * wv; a[6] += s1[2] * wv; a[7] += s1[3] * wv;
                }
            }
            float* bo = (ff ? bias_ff : bias_in) + n;
#pragma unroll
            for (int b = 0; b < 8; ++b) atomicAdd(bo + (size_t)b * N, a[b]);
        }
    }
    if (even && (parts & 1)) {
        const float* gw = p.gla_gate_w + (size_t)j * 16 * 256;
        for (int u = blockIdx.x * NTHR + C.tid; u < 256 * 128; u += gridDim.x * NTHR) {
            const int k8 = u & 127, n = u >> 7;
            float g[16];
#pragma unroll
            for (int r = 0; r < 16; ++r) g[r] = gw[r * 256 + n];
            float o[8];
#pragma unroll
            for (int e = 0; e < 8; ++e) {
                const float* wr = win + (size_t)(k8 * 8 + e) * 2320 + 1536;
                const f32x4 a0 = *(const f32x4*)wr, a1 = *(const f32x4*)(wr + 4), a2 = *(const f32x4*)(wr + 8), a3 = *(const f32x4*)(wr + 12);
                o[e] = a0[0] * g[0] + a0[1] * g[1] + a0[2] * g[2] + a0[3] * g[3] + a1[0] * g[4] + a1[1] * g[5] + a1[2] * g[6] + a1[3] * g[7]
                     + a2[0] * g[8] + a2[1] * g[9] + a2[2] * g[10] + a2[3] * g[11] + a3[0] * g[12] + a3[1] * g[13] + a3[2] * g[14] + a3[3] * g[15];
            }
            u32x4 w; w.x = pk2(o[0], o[1]); w.y = pk2(o[2], o[3]); w.z = pk2(o[4], o[5]); w.w = pk2(o[6], o[7]);
            *(u32x4*)(WIN + (size_t)(512 + n) * 1024 + k8 * 8) = w;
        }
    }
}

__device__ __forceinline__ void phase_prep(const Ctx& C, const float* xin, const float* w, const float* modl, int scoff, bf16_t* out, float* rowss) {
    for (int row = C.gw; row < T_; row += C.ngw) {
        const f32x4* xr = (const f32x4*)(xin + (size_t)row * 1024) + C.lane;
        f32x4 v[4]; float ss = 0.f;
#pragma unroll
        for (int j = 0; j < 4; ++j) { v[j] = xr[64 * j]; ss += (v[j].x * v[j].x + v[j].y * v[j].y) + (v[j].z * v[j].z + v[j].w * v[j].w); }
        ss = wave_sum(ss);
        if (C.lane == 0) rowss[row] = ss;
        const float* mb = modl + (size_t)(row >> 12) * 6144;
        u32x2* o8 = (u32x2*)(out + (size_t)row * 1024) + C.lane;
#pragma unroll
        for (int j = 0; j < 4; ++j) {
            const int col = 4 * C.lane + 256 * j;
            const f32x4 w4 = *(const f32x4*)(w + col), sc = *(const f32x4*)(mb + scoff + col);
            const f32x4 y = v[j] * w4 * (sc + 1.f);
            u32x2 q; q.x = pk2(y.x, y.y); q.y = pk2(y.z, y.w); o8[64 * j] = q;
        }
    }
}
__device__ __forceinline__ void phase_final_norm(const Ctx& C, float* x, const float* w) {
    for (int row = C.gw; row < T_; row += C.ngw) {
        f32x4* xr = (f32x4*)(x + (size_t)row * 1024) + C.lane;
        f32x4 v[4]; float ss = 0.f;
#pragma unroll
        for (int j = 0; j < 4; ++j) { v[j] = xr[64 * j]; ss += (v[j].x * v[j].x + v[j].y * v[j].y) + (v[j].z * v[j].z + v[j].w * v[j].w); }
        const float rs = rsqrtf(wave_sum(ss) * (1.f / 1024.f) + 1e-6f);
#pragma unroll
        for (int j = 0; j < 4; ++j) { const f32x4 w4 = *(const f32x4*)(w + 4 * C.lane + 256 * j); xr[64 * j] = (v[j] * rs) * w4; }
    }
}

__device__ __forceinline__ void phase_diff_combine(const Ctx& C, int l) {
    const Params& p = C.p; const int j = l >> 1;
    const float lam_init = 0.8f - 0.6f * expf(-0.3f * (float)l);
    const float* lv = p.diff_lambda + j * 256;
    const float s1 = wave_sum(lv[C.lane] * lv[64 + C.lane]), s2 = wave_sum(lv[128 + C.lane] * lv[192 + C.lane]);
    const float lam = expf(s1) - expf(s2) + lam_init;
    const bf16_t* X2 = (const bf16_t*)(p.ws + WS_X2); bf16_t* A = (bf16_t*)(p.ws + WS_A);
    const int head = C.lane >> 4, d0 = (C.lane & 15) * 8;
    const float* nw = p.diff_norm_w + j * 128 + d0;
    const f32x4 n0 = *(const f32x4*)nw, n1 = *(const f32x4*)(nw + 4);
    const float og = 1.f - lam_init;
    for (int row = C.gw; row < T_; row += C.ngw) {
        const bf16_t* src = X2 + (size_t)row * 1024 + head * 256 + d0;
        const u32x4 a = *(const u32x4*)src, b = *(const u32x4*)(src + 128);
        float od[8];
        od[0] = bflo(a.x) - lam * bflo(b.x); od[1] = bfhi(a.x) - lam * bfhi(b.x); od[2] = bflo(a.y) - lam * bflo(b.y); od[3] = bfhi(a.y) - lam * bfhi(b.y);
        od[4] = bflo(a.z) - lam * bflo(b.z); od[5] = bfhi(a.z) - lam * bfhi(b.z); od[6] = bflo(a.w) - lam * bflo(b.w); od[7] = bfhi(a.w) - lam * bfhi(b.w);
        float ss = 0.f;
#pragma unroll
        for (int e = 0; e < 8; ++e) ss += od[e] * od[e];
        ss += __shfl_xor(ss, 1); ss += __shfl_xor(ss, 2); ss += __shfl_xor(ss, 4); ss += __shfl_xor(ss, 8);
        const float rs = rsqrtf(ss * (1.f / 128.f) + 1e-6f) * og;
        u32x4 w; w.x = pk2(od[0] * rs * n0[0], od[1] * rs * n0[1]); w.y = pk2(od[2] * rs * n0[2], od[3] * rs * n0[3]);
        w.z = pk2(od[4] * rs * n1[0], od[5] * rs * n1[1]); w.w = pk2(od[6] * rs * n1[2], od[7] * rs * n1[3]);
        *(u32x4*)(A + (size_t)row * 1024 + head * 128 + d0) = w;
    }
}

__device__ __forceinline__ void phase_ffn_fixup(const Ctx& C, int l) {
    const Params& p = C.p;
    const float* HP = (const float*)(p.ws + WS_HP); const float* HU = (const float*)(p.ws + WS_HU); const float* HA = (const float*)(p.ws + WS_HA);
    bf16_t* G = (bf16_t*)(p.ws + WS_R1);
    const float* cw = p.ffn_conv_w + (size_t)l * 3 * DFF_;
    for (int u = blockIdx.x * NTHR + C.tid; u < 512 * 2 * 704; u += gridDim.x * NTHR) {
        const int c4 = u % 704, sj = u / 704, jj = sj & 1, seg = sj >> 1, ch = c4 * 4;
        const size_t ho = (size_t)sj * DFF_ + ch;
        f32x4 val = *(const f32x4*)(HP + ho); const f32x4 uu = *(const f32x4*)(HU + ho);
        if ((seg & 63) != 0) {
            const f32x4 am1 = *(const f32x4*)(HA + (size_t)((seg - 1) * 2 + 1) * DFF_ + ch), am2 = *(const f32x4*)(HA + (size_t)((seg - 1) * 2) * DFF_ + ch);
            const f32x4 w0 = *(const f32x4*)(cw + ch), w1 = *(const f32x4*)(cw + DFF_ + ch);
            if (jj == 0) val = val + w1 * am1 + w0 * am2; else val = val + w0 * am1;
        }
        u32x2 q; q.x = pk2(siluf_(val.x) * uu.x, siluf_(val.y) * uu.y); q.y = pk2(siluf_(val.z) * uu.z, siluf_(val.w) * uu.w);
        *(u32x2*)(G + (size_t)(seg * 64 + jj) * DFF_ + ch) = q;
    }
}

__device__ __forceinline__ void phase_swa(const Ctx& C, int l) {
    const Params& p = C.p;
    const bf16_t* proj = (const bf16_t*)(p.ws + WS_R1); bf16_t* A = (bf16_t*)(p.ws + WS_A);
    bf16_t* Ks = (bf16_t*)C.lds;
    bf16_t* Vt = (bf16_t*)(C.lds + 27648);
    const int tid = C.tid, lane = C.lane, wid = C.wave, r32 = lane & 31, hi = lane >> 5;
    const float* sinks = p.swa_sinks + (l >> 1) * 8;
    u32x4 kreg[3], vreg[3];
#define SWA_FETCH(uu) do { const int b_ = (uu) >> 7, kvh_ = ((uu) >> 6) & 1, q0_ = ((uu) & 63) * 64; const size_t rb_ = (size_t)b_ * SEQ_; \
        _Pragma("unroll") for (int i_ = 0; i_ < 3; ++i_) { const int c_ = tid + i_ * NTHR; \
            { const int kk_ = c_ >> 3, ch_ = c_ & 7, pl_ = q0_ - 128 + kk_; kreg[i_] = (u32x4){0u, 0u, 0u, 0u}; if (pl_ >= 0) kreg[i_] = *(const u32x4*)(proj + (rb_ + pl_) * 2560 + 2304 + kvh_ * 64 + ch_ * 8); } \
            { const int kk_ = c_ % 192, ch_ = c_ / 192, pl_ = q0_ - 128 + kk_; vreg[i_] = (u32x4){0u, 0u, 0u, 0u}; if (pl_ >= 0) vreg[i_] = *(const u32x4*)(proj + (rb_ + pl_) * 2560 + 2432 + kvh_ * 64 + ch_ * 8); } } } while (0)
    if ((int)blockIdx.x < 1024) SWA_FETCH((int)blockIdx.x);
    for (int u = blockIdx.x; u < 1024; u += gridDim.x) {
        const int b = u >> 7, kvh = (u >> 6) & 1, qb = u & 63, q0 = qb * 64; const size_t rowbase = (size_t)b * SEQ_;
#pragma unroll
        for (int i = 0; i < 3; ++i) {
            const int c = tid + i * NTHR;
            { const int kk = c >> 3, ch = c & 7; *(u32x4*)(Ks + kk * 72 + ch * 8) = kreg[i]; }
            { const int kk = c % 192, ch = c / 192; const u32x4 vv = vreg[i];
              bf16_t* vd = Vt + (ch * 8) * 200 + kk;
              vd[0] = (bf16_t)(vv.x & 0xffffu); vd[200] = (bf16_t)(vv.x >> 16); vd[400] = (bf16_t)(vv.y & 0xffffu); vd[600] = (bf16_t)(vv.y >> 16);
              vd[800] = (bf16_t)(vv.z & 0xffffu); vd[1000] = (bf16_t)(vv.z >> 16); vd[1200] = (bf16_t)(vv.w & 0xffffu); vd[1400] = (bf16_t)(vv.w >> 16); }
        }
        { const int nx = u + (int)gridDim.x; if (nx < 1024) SWA_FETCH(nx); }
        __syncthreads();
        const int g = wid >> 1, qh = kvh * 4 + g, qhalf = wid & 1, pq = q0 + 32 * qhalf + r32;
        const bf16_t* qsrc = proj + (rowbase + pq) * 2560 + 1792 + qh * 64;
        bf16x8 qr[4];
#pragma unroll
        for (int d0 = 0; d0 < 4; ++d0) qr[d0] = *(const bf16x8*)(qsrc + d0 * 16 + hi * 8);
        f32x16 s[5];
#pragma unroll
        for (int t = 0; t < 5; ++t) {
            f32x16 a = {};
#pragma unroll
            for (int d0 = 0; d0 < 4; ++d0) {
                const bf16x8 kf = *(const bf16x8*)(Ks + (32 * (qhalf + t) + r32) * 72 + d0 * 16 + hi * 8);
                a = __builtin_amdgcn_mfma_f32_32x32x16_bf16(kf, qr[d0], a, 0, 0, 0);
            }
            s[t] = a;
        }
        const float sink2 = sinks[qh] * LOG2E_;
        float mx = sink2;
#pragma unroll
        for (int t = 0; t < 5; ++t)
#pragma unroll
            for (int r = 0; r < 16; ++r) {
                const int pk = q0 - 128 + 32 * (qhalf + t) + crow_(r, hi);
                const bool valid = (pk >= 0) && (pk <= pq) && (pq - pk < 128);
                const float v = valid ? s[t][r] : -INFINITY; s[t][r] = v; mx = fmaxf(mx, v);
            }
        mx = fmaxf(mx, __shfl_xor(mx, 32));
        float sum = 0.f;
#pragma unroll
        for (int t = 0; t < 5; ++t)
#pragma unroll
            for (int r = 0; r < 16; ++r) { const float e = __builtin_amdgcn_exp2f(s[t][r] - mx); s[t][r] = e; sum += e; }
        sum += __shfl_xor(sum, 32);
        sum += __builtin_amdgcn_exp2f(sink2 - mx);
        const float inv = 1.f / sum;
        f32x16 o[2]; o[0] = f32x16{}; o[1] = f32x16{};
#pragma unroll
        for (int t = 0; t < 5; ++t)
#pragma unroll
            for (int ss = 0; ss < 2; ++ss) {
                u32x4 pw; pw.x = pk2(s[t][8 * ss + 0], s[t][8 * ss + 1]); pw.y = pk2(s[t][8 * ss + 2], s[t][8 * ss + 3]); pw.z = pk2(s[t][8 * ss + 4], s[t][8 * ss + 5]); pw.w = pk2(s[t][8 * ss + 6], s[t][8 * ss + 7]);
                const bf16x8 pf = __builtin_bit_cast(bf16x8, pw);
#pragma unroll
                for (int dt = 0; dt < 2; ++dt) {
                    const bf16_t* vp = Vt + (32 * dt + r32) * 200 + 32 * (qhalf + t) + 16 * ss + 4 * hi;
                    const u32x2 lo = *(const u32x2*)vp, h2 = *(const u32x2*)(vp + 8);
                    u32x4 vw; vw.x = lo.x; vw.y = lo.y; vw.z = h2.x; vw.w = h2.y;
                    o[dt] = __builtin_amdgcn_mfma_f32_32x32x16_bf16(__builtin_bit_cast(bf16x8, vw), pf, o[dt], 0, 0, 0);
                }
            }
        bf16_t* orow = A + (rowbase + pq) * 1024 + 512 + qh * 64;
#pragma unroll
        for (int dt = 0; dt < 2; ++dt)
#pragma unroll
            for (int g4 = 0; g4 < 4; ++g4) {
                u32x2 q; q.x = pk2(o[dt][4 * g4] * inv, o[dt][4 * g4 + 1] * inv); q.y = pk2(o[dt][4 * g4 + 2] * inv, o[dt][4 * g4 + 3] * inv);
                *(u32x2*)(orow + 32 * dt + 8 * g4 + 4 * hi) = q;
            }
        __syncthreads();
    }
}

template <int MODE> struct LaCfg {
    static constexpr int DK = MODE ? 128 : 64, LQ = DK + 8, LG = DK + 4, PITCH = MODE ? 3584 : 2560, NG = DK / 8;
    static constexpr int QCOL = MODE ? 1536 : 0, KCOL = MODE ? 0 : 256, ZCOL = MODE ? 2048 : 512, VCOL = MODE ? 2560 : 768, GCOL = MODE ? 3072 : 1280, OCOL = MODE ? 512 : 0;
    static constexpr int O_QB = 0, O_KB = O_QB + 64 * LQ * 2, O_GF = O_KB + 64 * LQ * 2, O_VT = O_GF + 64 * LG * 4, O_SC = O_VT + 128 * 72 * 2, O_QE = O_SC + 64 * 72 * 2,
                         O_KT = O_QE + 64 * LQ * 2  , O_SEG = O_KT + DK * 72 * 2, O_RED = O_SEG + 8 * 128 * 4, O_PAR = O_RED + 8 * 64 * 4, O_END = O_PAR + 128 * 4;
    static_assert(O_END <= LDS_BYTES, "LA LDS map");
};
__device__ __forceinline__ void unpack8(const u32x4 w, float (&f)[8]) { f[0] = bflo(w.x); f[1] = bfhi(w.x); f[2] = bflo(w.y); f[3] = bfhi(w.y); f[4] = bflo(w.z); f[5] = bfhi(w.z); f[6] = bflo(w.w); f[7] = bfhi(w.w); }
__device__ __forceinline__ u32x4 pack8(const float (&f)[8]) { u32x4 w; w.x = pk2(f[0], f[1]); w.y = pk2(f[2], f[3]); w.z = pk2(f[4], f[5]); w.w = pk2(f[6], f[7]); return w; }
__device__ __forceinline__ void ld8f(const float* p, float (&f)[8]) { const f32x4 a = *(const f32x4*)p, b = *(const f32x4*)(p + 4); f[0] = a[0]; f[1] = a[1]; f[2] = a[2]; f[3] = a[3]; f[4] = b[0]; f[5] = b[1]; f[6] = b[2]; f[7] = b[3]; }

template <int MODE> struct LaRaw { static constexpr int NI = 64 * LaCfg<MODE>::NG / NTHR; u32x4 z[NI], k[NI], q[NI], v[2]; };
template <int MODE, bool NEEDQ> __device__ __forceinline__ void la_fetch(const Ctx& C, int b, int h, int c, LaRaw<MODE>& R) {
    typedef LaCfg<MODE> Cf; const bf16_t* proj = (const bf16_t*)(C.p.ws + WS_R1);
    const size_t row0 = (size_t)b * SEQ_ + (size_t)c * 64;
#pragma unroll
    for (int it = 0; it < LaRaw<MODE>::NI; ++it) {
        const int u = C.tid + it * NTHR, r = u / Cf::NG, kk = (u % Cf::NG) * 8;
        const bf16_t* rp = proj + (row0 + r) * Cf::PITCH + h * Cf::DK + kk;
        R.z[it] = *(const u32x4*)(rp + Cf::ZCOL);
        if (MODE == 0) R.k[it] = *(const u32x4*)(rp + Cf::KCOL);
        if (NEEDQ) R.q[it] = *(const u32x4*)(rp + Cf::QCOL);
    }
#pragma unroll
    for (int it = 0; it < 2; ++it) {
        const int u = C.tid + it * NTHR, r = u & 63, g8 = u >> 6;
        R.v[it] = *(const u32x4*)(proj + (row0 + r) * Cf::PITCH + Cf::VCOL + h * 128 + g8 * 8);
    }
}
template <int MODE, bool NEEDQ> __device__ __forceinline__ void la_store(const Ctx& C, const LaRaw<MODE>& R, const float* par, bf16_t* Qb, bf16_t* Kb, float* Gf, bf16_t* Vt) {
    typedef LaCfg<MODE> Cf;
#pragma unroll
    for (int it = 0; it < LaRaw<MODE>::NI; ++it) {
        const int u = C.tid + it * NTHR, r = u / Cf::NG, kk = (u % Cf::NG) * 8;
        float z[8], kv[8], lg[8], pc[8];
        unpack8(R.z[it], z); ld8f(par + kk, pc);
        if (MODE == 0) {
            unpack8(R.k[it], kv);
#pragma unroll
            for (int e = 0; e < 8; ++e) { const float x = z[e] + pc[e]; lg[e] = (fminf(x, 0.f) * LOG2E_ - __log2f(1.f + __expf(-fabsf(x)))) * (1.f / 16.f); }
        } else {
#pragma unroll
            for (int e = 0; e < 8; ++e) {
                const float zz = fminf(fmaxf(z[e], -60.f), 60.f), ez = __expf(-zz), sg = __builtin_amdgcn_rcpf(1.f + ez), lb = pc[e];
                lg[e] = __log2f(lb + (1.f - lb) * sg); kv[e] = (1.f - lb) * (ez * sg);
            }
        }
        *(u32x4*)(Kb + r * Cf::LQ + kk) = pack8(kv);
        float* gd = Gf + r * Cf::LG + kk;
        *(f32x4*)gd = (f32x4){lg[0], lg[1], lg[2], lg[3]}; *(f32x4*)(gd + 4) = (f32x4){lg[4], lg[5], lg[6], lg[7]};
        if (NEEDQ) {
            float q[8]; unpack8(R.q[it], q);
#pragma unroll
            for (int e = 0; e < 8; ++e) q[e] = MODE ? siluf_(q[e]) * 0.08838834764831845f : q[e] * 0.125f;
            *(u32x4*)(Qb + r * Cf::LQ + kk) = pack8(q);
        }
    }
#pragma unroll
    for (int it = 0; it < 2; ++it) {
        const int u = C.tid + it * NTHR, r = u & 63, g8 = u >> 6;
        const u32x4 w = R.v[it];
        bf16_t* vd = Vt + (g8 * 8) * 72 + r;
        vd[0] = (bf16_t)(w.x & 0xffffu); vd[72] = (bf16_t)(w.x >> 16); vd[144] = (bf16_t)(w.y & 0xffffu); vd[216] = (bf16_t)(w.y >> 16);
        vd[288] = (bf16_t)(w.z & 0xffffu); vd[360] = (bf16_t)(w.z >> 16); vd[432] = (bf16_t)(w.w & 0xffffu); vd[504] = (bf16_t)(w.w >> 16);
    }
}
template <int MODE> __device__ __forceinline__ void la_params(const Ctx& C, int l, int h, float* par) {
    typedef LaCfg<MODE> Cf; const int j = l >> 1;
    if (C.tid < Cf::DK) {
        if (MODE == 0) par[C.tid] = C.p.gla_gate_b[j * 256 + h * 64 + C.tid];
        else { const float* lg0 = C.p.hgrn_lb_logits + h * 128 + C.tid; par[C.tid] = (j == 0) ? 0.f : sigmoidf_(lg0[512] - lg0[0]); }
    }
}
template <int MODE> __device__ __forceinline__ void la_cumsum(const Ctx& C, float* Gf, float* segs) {
    typedef LaCfg<MODE> Cf; constexpr int DK = Cf::DK, NSEG = NTHR / DK, RPS = 64 / NSEG;
    const int k = C.tid % DK, seg = C.tid / DK;
    float v[RPS];
#pragma unroll
    for (int i = 0; i < RPS; ++i) v[i] = Gf[(seg * RPS + i) * Cf::LG + k];
#pragma unroll
    for (int i = 1; i < RPS; ++i) v[i] += v[i - 1];
    segs[seg * DK + k] = v[RPS - 1];
    __syncthreads();
    float off = 0.f;
#pragma unroll
    for (int s = 0; s < NSEG; ++s) { const float t = segs[s * DK + k]; off += (s < seg) ? t : 0.f; }
#pragma unroll
    for (int i = 0; i < RPS; ++i) Gf[(seg * RPS + i) * Cf::LG + k] = v[i] + off;
}

template <int MODE> __device__ __forceinline__ void phase_la_p1(const Ctx& C, int l) {
    typedef LaCfg<MODE> Cf; const Params& p = C.p; constexpr int DK = Cf::DK, LQ = Cf::LQ, LG = Cf::LG, NG = Cf::NG;
    bf16_t* Kb = (bf16_t*)(C.lds + Cf::O_KB); float* Gf = (float*)(C.lds + Cf::O_GF); bf16_t* Vt = (bf16_t*)(C.lds + Cf::O_VT);
    bf16_t* KhT = (bf16_t*)(C.lds + Cf::O_KT); float* segs = (float*)(C.lds + Cf::O_SEG);
    bf16_t* ST = (bf16_t*)(p.ws + WS_ST); float* TOT = (float*)(p.ws + WS_TOT);
    const int r16 = C.lane & 15, g = C.lane >> 4, w = C.wave;
    float* par = (float*)(C.lds + Cf::O_PAR);
    LaRaw<MODE> R; int hcur = -1;
    if ((int)blockIdx.x < 2048) la_fetch<MODE, false>(C, (int)blockIdx.x >> 8, ((int)blockIdx.x >> 6) & 3, (int)blockIdx.x & 63, R);
    for (int it = blockIdx.x; it < 2048; it += gridDim.x) {
        const int bh = it >> 6, c = it & 63, b = bh >> 2, h = bh & 3;
        if (h != hcur) { la_params<MODE>(C, l, h, par); hcur = h; __syncthreads(); }
        la_store<MODE, false>(C, R, par, nullptr, Kb, Gf, Vt);
        { const int nx = it + (int)gridDim.x; if (nx < 2048) la_fetch<MODE, false>(C, nx >> 8, (nx >> 6) & 3, nx & 63, R); }
        __syncthreads();
        la_cumsum<MODE>(C, Gf, segs);
        __syncthreads();
        for (int u = C.tid; u < 64 * NG; u += NTHR) {
            const int r = u & 63, kk = (u >> 6) * 8;
            float kv[8], gj[8], gt[8];
            unpack8(*(const u32x4*)(Kb + r * LQ + kk), kv); ld8f(Gf + r * LG + kk, gj); ld8f(Gf + 63 * LG + kk, gt);
            bf16_t* kd = KhT + kk * 72 + r;
#pragma unroll
            for (int e = 0; e < 8; e += 2) { const unsigned pw = pk2(kv[e] * __builtin_amdgcn_exp2f(gt[e] - gj[e]), kv[e + 1] * __builtin_amdgcn_exp2f(gt[e + 1] - gj[e + 1]));
                kd[e * 72] = (bf16_t)(pw & 0xffffu); kd[(e + 1) * 72] = (bf16_t)(pw >> 16); }
        }
        if (C.tid < DK) TOT[(size_t)it * 128 + C.tid] = Gf[63 * LG + C.tid];
        __syncthreads();
        {
            const bf16x8 b0 = *(const bf16x8*)(Vt + (16 * w + r16) * 72 + 8 * g), b1 = *(const bf16x8*)(Vt + (16 * w + r16) * 72 + 32 + 8 * g);
            bf16_t* so = ST + (size_t)it * DK * 128 + (size_t)(16 * w + r16) * DK + 4 * g;
#pragma unroll
            for (int mt = 0; mt < DK / 16; ++mt) {
                const bf16x8 a0 = *(const bf16x8*)(KhT + (16 * mt + r16) * 72 + 8 * g), a1 = *(const bf16x8*)(KhT + (16 * mt + r16) * 72 + 32 + 8 * g);
                f32x4 acc = (f32x4){0.f, 0.f, 0.f, 0.f};
                acc = __builtin_amdgcn_mfma_f32_16x16x32_bf16(a0, b0, acc, 0, 0, 0);
                acc = __builtin_amdgcn_mfma_f32_16x16x32_bf16(a1, b1, acc, 0, 0, 0);
                u32x2 q; q.x = pk2(acc[0], acc[1]); q.y = pk2(acc[2], acc[3]);
                *(u32x2*)(so + 16 * mt) = q;
            }
        }
        __syncthreads();
    }
}

template <int MODE> __device__ __forceinline__ void phase_la_p2(const Ctx& C) {
    typedef LaCfg<MODE> Cf; const Params& p = C.p; constexpr int DK = Cf::DK, NQ = DK / 4;
    bf16_t* ST = (bf16_t*)(p.ws + WS_ST); const float* TOT = (const float*)(p.ws + WS_TOT);
    for (int u = blockIdx.x * NTHR + C.tid; u < 32 * 128 * NQ; u += gridDim.x * NTHR) {
        const int k4 = u % NQ, v = (u / NQ) & 127, bh = u / (NQ * 128);
        float S0 = 0.f, S1 = 0.f, S2 = 0.f, S3 = 0.f;
        bf16_t* base = ST + (size_t)bh * 64 * DK * 128 + (size_t)v * DK + k4 * 4;
        const float* tb = TOT + (size_t)bh * 64 * 128 + k4 * 4;
#pragma unroll 8
        for (int c = 0; c < 64; ++c) {
            u32x2* ptr = (u32x2*)(base + (size_t)c * DK * 128);
            const u32x2 w = *ptr; const f32x4 dc = *(const f32x4*)(tb + c * 128);
            u32x2 o; o.x = pk2(S0, S1); o.y = pk2(S2, S3);
            *ptr = o;
            S0 = S0 * __builtin_amdgcn_exp2f(dc[0]) + bflo(w.x); S1 = S1 * __builtin_amdgcn_exp2f(dc[1]) + bfhi(w.x);
            S2 = S2 * __builtin_amdgcn_exp2f(dc[2]) + bflo(w.y); S3 = S3 * __builtin_amdgcn_exp2f(dc[3]) + bfhi(w.y);
        }
    }
}

template <int MODE> __device__ __forceinline__ void phase_la_p3(const Ctx& C, int l) {
    typedef LaCfg<MODE> Cf; const Params& p = C.p; constexpr int DK = Cf::DK, LQ = Cf::LQ, LG = Cf::LG, NG = Cf::NG, NKS = DK / 32;
    bf16_t* Qb = (bf16_t*)(C.lds + Cf::O_QB); bf16_t* Kb = (bf16_t*)(C.lds + Cf::O_KB); float* Gf = (float*)(C.lds + Cf::O_GF); bf16_t* Vt = (bf16_t*)(C.lds + Cf::O_VT);
    bf16_t* Sc = (bf16_t*)(C.lds + Cf::O_SC); bf16_t* Qe = (bf16_t*)(C.lds + Cf::O_QE); float* segs = (float*)(C.lds + Cf::O_SEG); float* red = (float*)(C.lds + Cf::O_RED);
    const bf16_t* ST = (const bf16_t*)(p.ws + WS_ST); const bf16_t* proj = (const bf16_t*)(p.ws + WS_R1); bf16_t* A = (bf16_t*)(p.ws + WS_A);
    const float* nw = (MODE ? p.hgrn_norm_w : p.gla_norm_w) + (l >> 1) * 128;
    const int r16 = C.lane & 15, g = C.lane >> 4, w = C.wave;
    const f32x4 nw4 = *(const f32x4*)(nw + 16 * w + 4 * g);
    float* par = (float*)(C.lds + Cf::O_PAR);
    LaRaw<MODE> R; int hcur = -1;
    if ((int)blockIdx.x < 2048) la_fetch<MODE, true>(C, (int)blockIdx.x >> 8, ((int)blockIdx.x >> 6) & 3, (int)blockIdx.x & 63, R);
    for (int it = blockIdx.x; it < 2048; it += gridDim.x) {
        const int bh = it >> 6, c = it & 63, b = bh >> 2, h = bh & 3;
        bf16x8 sfr[NKS];
        { const bf16_t* sp = ST + (size_t)it * DK * 128 + (size_t)(16 * w + r16) * DK + 8 * g;
#pragma unroll
          for (int ks = 0; ks < NKS; ++ks) sfr[ks] = *(const bf16x8*)(sp + 32 * ks); }
        if (h != hcur) { la_params<MODE>(C, l, h, par); hcur = h; __syncthreads(); }
        la_store<MODE, true>(C, R, par, Qb, Kb, Gf, Vt);
        { const int nx = it + (int)gridDim.x; if (nx < 2048) la_fetch<MODE, true>(C, nx >> 8, (nx >> 6) & 3, nx & 63, R); }
        for (int u = C.tid; u < 64 * 72 / 8; u += NTHR) *(u32x4*)(Sc + u * 8) = (u32x4){0u, 0u, 0u, 0u};
        u32x2 gwv[4];
#pragma unroll
        for (int nt = 0; nt < 4; ++nt) gwv[nt] = *(const u32x2*)(proj + ((size_t)b * SEQ_ + (size_t)c * 64 + 16 * nt + r16) * Cf::PITCH + Cf::GCOL + h * 128 + 16 * w + 4 * g);
        __syncthreads();
        la_cumsum<MODE>(C, Gf, segs);
        __syncthreads();
        for (int t = w; t < 10; t += 8) {
            const int I = (t >= 6) ? 3 : (t >= 3) ? 2 : (t >= 1) ? 1 : 0, J = t - I * (I + 1) / 2;
            f32x4 acc = (f32x4){0.f, 0.f, 0.f, 0.f};
#pragma unroll
            for (int ks = 0; ks < NKS; ++ks) {
                const int kc = 32 * ks + 8 * g;
                float gref[8], gj[8], gi[8], kv[8], qv[8];
                ld8f(Gf + (16 * J + 15) * LG + kc, gref); ld8f(Gf + (16 * J + r16) * LG + kc, gj); ld8f(Gf + (16 * I + r16) * LG + kc, gi);
                unpack8(*(const u32x4*)(Kb + (16 * J + r16) * LQ + kc), kv); unpack8(*(const u32x4*)(Qb + (16 * I + r16) * LQ + kc), qv);
#pragma unroll
                for (int e = 0; e < 8; ++e) { kv[e] *= __builtin_amdgcn_exp2f(gref[e] - gj[e]); qv[e] *= __builtin_amdgcn_exp2f(gi[e] - gref[e]); }
                acc = __builtin_amdgcn_mfma_f32_16x16x32_bf16(__builtin_bit_cast(bf16x8, pack8(kv)), __builtin_bit_cast(bf16x8, pack8(qv)), acc, 0, 0, 0);
            }
            if (I == J) {
#pragma unroll
                for (int e = 0; e < 4; ++e) if (4 * g + e > r16) acc[e] = 0.f;
            }
            u32x2 q; q.x = pk2(acc[0], acc[1]); q.y = pk2(acc[2], acc[3]);
            *(u32x2*)(Sc + (16 * I + r16) * 72 + 16 * J + 4 * g) = q;
        }
        for (int u = C.tid; u < 64 * NG; u += NTHR) {
            const int r = u / NG, kk = (u % NG) * 8;
            float qv[8], gi[8]; unpack8(*(const u32x4*)(Qb + r * LQ + kk), qv); ld8f(Gf + r * LG + kk, gi);
#pragma unroll
            for (int e = 0; e < 8; ++e) qv[e] *= __builtin_amdgcn_exp2f(gi[e]);
            *(u32x4*)(Qe + r * LQ + kk) = pack8(qv);
        }
        __syncthreads();
        f32x4 o[4];
        {
            const bf16x8 v0 = *(const bf16x8*)(Vt + (16 * w + r16) * 72 + 8 * g), v1 = *(const bf16x8*)(Vt + (16 * w + r16) * 72 + 32 + 8 * g);
#pragma unroll
            for (int nt = 0; nt < 4; ++nt) {
                f32x4 acc = (f32x4){0.f, 0.f, 0.f, 0.f};
                acc = __builtin_amdgcn_mfma_f32_16x16x32_bf16(v0, *(const bf16x8*)(Sc + (16 * nt + r16) * 72 + 8 * g), acc, 0, 0, 0);
                if (nt >= 2) acc = __builtin_amdgcn_mfma_f32_16x16x32_bf16(v1, *(const bf16x8*)(Sc + (16 * nt + r16) * 72 + 32 + 8 * g), acc, 0, 0, 0);
#pragma unroll
                for (int ks = 0; ks < NKS; ++ks) acc = __builtin_amdgcn_mfma_f32_16x16x32_bf16(sfr[ks], *(const bf16x8*)(Qe + (16 * nt + r16) * LQ + 32 * ks + 8 * g), acc, 0, 0, 0);
                o[nt] = acc;
                float ss = acc[0] * acc[0] + acc[1] * acc[1] + acc[2] * acc[2] + acc[3] * acc[3];
                ss += __shfl_xor(ss, 16); ss += __shfl_xor(ss, 32);
                if (g == 0) red[w * 64 + 16 * nt + r16] = ss;
            }
        }
        __syncthreads();
#pragma unroll
        for (int nt = 0; nt < 4; ++nt) {
            float tot = 0.f;
#pragma unroll
            for (int ww = 0; ww < 8; ++ww) tot += red[ww * 64 + 16 * nt + r16];
            const float rs = rsqrtf(tot * (1.f / 128.f) + 1e-6f);
            const size_t row = (size_t)b * SEQ_ + (size_t)c * 64 + 16 * nt + r16;
            const u32x2 gw = gwv[nt];
            u32x2 q; q.x = pk2(o[nt][0] * rs * nw4[0] * siluf_(bflo(gw.x)), o[nt][1] * rs * nw4[1] * siluf_(bfhi(gw.x)));
            q.y = pk2(o[nt][2] * rs * nw4[2] * siluf_(bflo(gw.y)), o[nt][3] * rs * nw4[3] * siluf_(bfhi(gw.y)));
            *(u32x2*)(A + row * 1024 + Cf::OCOL + h * 128 + 16 * w + 4 * g) = q;
        }
        __syncthreads();
    }
}


#define LAS __attribute__((address_space(3)))
#define XB_TMO      128
#define XB_XCNT(j)  (256  + 64 * (j))
#define XB_XSUB(j)  (1280 + 64 * (j))
#define XB_XGEN(j)  (2304 + 64 * (j))
#define XB_TOP      3328
#define XB_TOPGEN   3392
#define XCD_BAR_WORDS 3456
#define XB_SPIN_CAP (1u << 18)

__device__ __forceinline__ unsigned xb_ld(unsigned* p)              { return __hip_atomic_load(p, __ATOMIC_RELAXED, __HIP_MEMORY_SCOPE_AGENT); }
__device__ __forceinline__ unsigned xb_add(unsigned* p, unsigned v) { return __hip_atomic_fetch_add(p, v, __ATOMIC_RELAXED, __HIP_MEMORY_SCOPE_AGENT); }
__device__ __forceinline__ unsigned xb_xcc_id() { return (unsigned)__builtin_amdgcn_s_getreg((3 << 11) | 20) & 0xFu; }
#define XB_SPIN(cond, bar) do { unsigned _sp = 0; while (cond) { __builtin_amdgcn_s_sleep(1); \
    if ((++_sp & 255u) == 0u) { if (xb_ld(&(bar)[XB_TMO])) break; if (_sp > XB_SPIN_CAP) { atomicAdd(&(bar)[XB_TMO], 1u); break; } } } } while (0)

struct XcdBarrier {
    unsigned* bar; unsigned x;
    volatile LAS unsigned* st;
};

__device__ __forceinline__ XcdBarrier xcd_barrier_post(unsigned* bar, volatile LAS unsigned* st) {
    XcdBarrier b; b.bar = bar; b.x = xb_xcc_id(); b.st = st;
    if (threadIdx.x == 0) (void)xb_add(&bar[XB_XCNT(b.x)], 1u);
    return b;
}
__device__ __forceinline__ void xcd_barrier_complete(unsigned* bar, unsigned x, unsigned& nloc, unsigned& nx) {
    const unsigned G = gridDim.x * gridDim.y * gridDim.z;
    unsigned sum, cnt, mine, sp = 0u;
    for (;;) {
        sum = 0u; cnt = 0u; mine = 0u;
#pragma unroll
        for (unsigned j = 0; j < 16; ++j) { const unsigned c = xb_ld(&bar[XB_XCNT(j)]); sum += c; cnt += (c > 0u) ? 1u : 0u; mine = (j == x) ? c : mine; }
        if (sum == G) break;
        __builtin_amdgcn_s_sleep(1);
        if ((++sp & 255u) == 0u) { if (xb_ld(&bar[XB_TMO])) break; if (sp > XB_SPIN_CAP) { atomicAdd(&bar[XB_TMO], 1u); break; } }
    }
    nloc = mine > 0u ? mine : 1u; nx = cnt > 0u ? cnt : 1u;
}

__device__ __forceinline__ void xcd_barrier(const XcdBarrier& b) {
    asm volatile("s_waitcnt vmcnt(0)" ::: "memory");
    __syncthreads();
    if (threadIdx.x == 0) {
        unsigned* bar = b.bar;
        __builtin_amdgcn_s_waitcnt(0);
        unsigned nloc = b.st[0], nx = b.st[1];
        if (nloc == 0u) { xcd_barrier_complete(bar, b.x, nloc, nx); b.st[0] = nloc; b.st[1] = nx; }
        const unsigned old = xb_add(&bar[XB_XSUB(b.x)], 1u);
        const unsigned gen = old / nloc;
        if (old + 1u == (gen + 1u) * nloc) {
            __builtin_amdgcn_fence(__ATOMIC_RELEASE, "agent");
            asm volatile("s_waitcnt vmcnt(0)" ::: "memory");
            const unsigned og = xb_add(&bar[XB_TOP], 1u);
            const unsigned tg = og / nx;
            if (og + 1u == (tg + 1u) * nx) xb_add(&bar[XB_TOPGEN], 1u);
            else XB_SPIN(xb_ld(&bar[XB_TOPGEN]) == tg, bar);
            __builtin_amdgcn_fence(__ATOMIC_ACQUIRE, "agent");
            xb_add(&bar[XB_XGEN(b.x)], 1u);
            asm volatile("s_waitcnt vmcnt(0)" ::: "memory");
        } else {
            XB_SPIN(xb_ld(&bar[XB_XGEN(b.x)]) == gen, bar);
            __builtin_amdgcn_fence(__ATOMIC_ACQUIRE, "agent");
            asm volatile("s_waitcnt vmcnt(0)" ::: "memory");
        }
    }
    __syncthreads();
}

typedef unsigned u32x16 __attribute__((ext_vector_type(16)));
__device__ __forceinline__ void load_params(Params& p) {
    auto kp = __builtin_amdgcn_kernarg_segment_ptr();
    u32x16 a, b, c, d;
    asm volatile("s_load_dwordx16 %0, %4, 0x0\n\ts_load_dwordx16 %1, %4, 0x40\n\ts_load_dwordx16 %2, %4, 0x80\n\ts_load_dwordx16 %3, %4, 0xc0\n\ts_waitcnt lgkmcnt(0)"
                 : "=&s"(a), "=&s"(b), "=&s"(c), "=&s"(d) : "s"(kp) : "memory");
    unsigned long long q[32];
#pragma unroll
    for (int i = 0; i < 8; ++i) { q[i] = ((unsigned long long)a[2 * i + 1] << 32) | a[2 * i]; q[8 + i] = ((unsigned long long)b[2 * i + 1] << 32) | b[2 * i];
        q[16 + i] = ((unsigned long long)c[2 * i + 1] << 32) | c[2 * i]; q[24 + i] = ((unsigned long long)d[2 * i + 1] << 32) | d[2 * i]; }
    p.x = (const float*)(__attribute__((address_space(1))) const float*)q[0]; p.c = (const float*)(__attribute__((address_space(1))) const float*)q[1]; p.positions = (const int*)(__attribute__((address_space(1))) const int*)q[2]; p.mod_w = (const float*)(__attribute__((address_space(1))) const float*)q[3]; p.mod_b = (const float*)(__attribute__((address_space(1))) const float*)q[4]; p.norm_mix_w = (const float*)(__attribute__((address_space(1))) const float*)q[5]; p.norm_ffn_w = (const float*)(__attribute__((address_space(1))) const float*)q[6];
    p.ev_w_in = (const float*)(__attribute__((address_space(1))) const float*)q[7]; p.gla_gate_w = (const float*)(__attribute__((address_space(1))) const float*)q[8]; p.gla_gate_b = (const float*)(__attribute__((address_space(1))) const float*)q[9]; p.gla_norm_w = (const float*)(__attribute__((address_space(1))) const float*)q[10]; p.swa_sinks = (const float*)(__attribute__((address_space(1))) const float*)q[11]; p.ev_w_out = (const float*)(__attribute__((address_space(1))) const float*)q[12];
    p.od_w_in = (const float*)(__attribute__((address_space(1))) const float*)q[13]; p.diff_lambda = (const float*)(__attribute__((address_space(1))) const float*)q[14]; p.diff_norm_w = (const float*)(__attribute__((address_space(1))) const float*)q[15]; p.hgrn_lb_logits = (const float*)(__attribute__((address_space(1))) const float*)q[16]; p.hgrn_norm_w = (const float*)(__attribute__((address_space(1))) const float*)q[17]; p.od_w_out = (const float*)(__attribute__((address_space(1))) const float*)q[18];
    p.ffn_w_in = (const float*)(__attribute__((address_space(1))) const float*)q[19]; p.ffn_conv_w = (const float*)(__attribute__((address_space(1))) const float*)q[20]; p.ffn_conv_b = (const float*)(__attribute__((address_space(1))) const float*)q[21]; p.ffn_w_out = (const float*)(__attribute__((address_space(1))) const float*)q[22]; p.final_norm_w = (const float*)(__attribute__((address_space(1))) const float*)q[23];
    p.out = (float*)(__attribute__((address_space(1))) float*)q[24]; p.ws = (unsigned char*)(__attribute__((address_space(1))) unsigned char*)q[25];
}

#ifndef REP_SYNC
#define REP_SYNC 1
#endif
#ifndef REP_G
#define REP_G 1
#endif
#ifndef REP_R
#define REP_R 1
#endif
#ifndef REP_CV
#define REP_CV 1
#endif
#ifndef REP_P12
#define REP_P12 1
#endif
#ifndef STG_A
#define STG_A 0
#endif
#ifndef STG_B
#define STG_B 0
#endif
#ifndef ALIGN_RES
#define ALIGN_RES true
#endif
#ifndef REP_LA
#define REP_LA 1
#endif
#ifndef REP_AT
#define REP_AT 1
#endif
#ifndef REP_SM
#define REP_SM 1
#endif
__global__ void __launch_bounds__(NTHR, 2) fwd_megakernel(Params pin) {
    extern __shared__ __attribute__((aligned(16))) unsigned char lds[];
    cg::grid_group grid = cg::this_grid();
    Ctx C; C.lds = lds; C.tid = threadIdx.x; C.lane = C.tid & 63; C.wave = __builtin_amdgcn_readfirstlane(C.tid >> 6);
    C.gw = blockIdx.x * 8 + C.wave; C.ngw = gridDim.x * 8;
    PG8_LAS unsigned char* ldsg = (PG8_LAS unsigned char*)lds;
    volatile LAS unsigned* bst = (volatile LAS unsigned*)(ldsg + (LDS_BYTES - 64));
    if (threadIdx.x < 2) bst[threadIdx.x] = 0u;
    __syncthreads();
    XcdBarrier xbar = xcd_barrier_post((unsigned*)(pin.ws + WS_BAR), bst);
#define GSYNC() do { for (int rs_ = 0; rs_ < REP_SYNC; ++rs_) xcd_barrier(xbar); } while (0)
#define RP() do { load_params(C.p); C.tid = otid_(); C.lane = C.tid & 63; C.wave = __builtin_amdgcn_readfirstlane(C.tid >> 6); C.gw = blockIdx.x * 8 + C.wave; } while (0)
#define WSP(off) (C.p.ws + (off))
#define STAGGER(ticks) do { if ((ticks) > 0 && (blockIdx.x & 1)) { const unsigned long long t0_ = __builtin_amdgcn_s_memrealtime(); while (__builtin_amdgcn_s_memrealtime() - t0_ < (unsigned long long)(ticks)) __builtin_amdgcn_s_sleep(16); } } while (0)

    if (pin.ws == nullptr) grid.sync();
    for (int rep_ = 0; rep_ < REP_SM; ++rep_) { RP(); phase_prologue(C); }
    GSYNC();
    RP(); phase_convert(C, 0, 15);
    for (int rep_ = 0; rep_ < REP_SM; ++rep_) { RP(); phase_prep(C, C.p.x, C.p.norm_mix_w, (const float*)WSP(WS_MOD), 1024, (bf16_t*)WSP(WS_A), (float*)WSP(WS_ROWSS)); }
    GSYNC();
#pragma unroll 1
    for (int l = 0; l < 4; ++l) {
        const bool even = !(l & 1);
        {
            RP();
            const int N = even ? 2560 : 3584;
            pg8::Gemm g{(const bf16_t*)WSP(WS_A), (const bf16_t*)WSP(WS_WIN), T_, N, 1024}; pg8::StaticOrder S; S.init(T_, N, (int)gridDim.x, (int)blockIdx.x);
            pg8::EpiProj E{(bf16_t*)WSP(WS_R1), N, even ? 0x7C000u : 0xFFu, even ? 0x3C000u : 0xFu, QSCALE_, (const float*)WSP(WS_COS), (const float*)WSP(WS_SIN),
                           (const float*)WSP(WS_ROWSS) + (size_t)(2 * l) * T_, (const float*)WSP(WS_BIAS) + (size_t)l * BIAS_L};
            for (int rep_ = 0; rep_ < REP_G; ++rep_) pg8::gemm_phase<pg8::EpiProj, pg8::StaticOrder, true, true>(ldsg, g, S, E);
        }
        GSYNC();
        if (even) {
            for (int rep_ = 0; rep_ < REP_AT; ++rep_) { RP(); phase_swa(C, l); }
            for (int rep_ = 0; rep_ < REP_LA; ++rep_) { RP(); phase_la_p1<0>(C, l); }
            GSYNC();
            RP(); phase_la_p2<0>(C);
            GSYNC();
#if REP_P12 > 1
            RP(); phase_la_p1<0>(C, l); GSYNC(); RP(); phase_la_p2<0>(C); GSYNC();
#endif
            for (int rep_ = 0; rep_ < REP_LA; ++rep_) { RP(); phase_la_p3<0>(C, l); }
        } else {
            for (int rep_ = 0; rep_ < REP_AT; ++rep_) {
                RP();
                const bf16_t* R1 = (const bf16_t*)WSP(WS_R1); bf16_t* X2 = (bf16_t*)WSP(WS_X2);
                const int G = (int)gridDim.x, bid = (int)blockIdx.x;
#pragma unroll 1
                for (int i = 0; i * G < 2048; ++i) {
                    const int L = i * G + ((i & 1) ? (G - 1 - bid) : bid);
                    if (L >= 2048) continue;
                    const int qb = 15 - (L >> 7), bh = L & 127, b = bh >> 4, hv = bh & 15;
                    const attn_body::bf16* Q = (const attn_body::bf16*)(R1 + (hv >> 1) * 64);
                    const attn_body::bf16* K = (const attn_body::bf16*)(R1 + 512 + (hv >> 1) * 64);
                    const attn_body::bf16* V = (const attn_body::bf16*)(R1 + 1024 + (hv >> 2) * 128 + (hv & 1) * 64);
                    attn_body::attn_unit<8>(b, hv, qb, Q, K, V, (attn_body::bf16*)(X2 + hv * 64), (char*)lds);
                }
            }
            for (int rep_ = 0; rep_ < REP_LA; ++rep_) { RP(); phase_la_p1<1>(C, l); }
            GSYNC();
            RP(); phase_la_p2<1>(C);
#if REP_P12 > 1
            GSYNC(); RP(); phase_la_p1<1>(C, l); GSYNC(); RP(); phase_la_p2<1>(C);
#endif
            for (int rep_ = 0; rep_ < REP_SM; ++rep_) { RP(); phase_diff_combine(C, l); }
            GSYNC();
            for (int rep_ = 0; rep_ < REP_LA; ++rep_) { RP(); phase_la_p3<1>(C, l); }
        }
        GSYNC();
        STAGGER(STG_A);
        {
            RP();
            const float* modl = (const float*)WSP(WS_MOD) + (size_t)l * 8 * 6144;
            pg8::Gemm g{(const bf16_t*)WSP(WS_A), (const bf16_t*)WSP((l & 1) ? WS_WOUT2 : WS_WOUT), T_, 1024, 1024}; pg8::StaticOrder S; S.init(T_, 1024, (int)gridDim.x, (int)blockIdx.x);
            pg8::EpiRes E{(l == 0) ? C.p.x : C.p.out, C.p.out, modl + 2048, (bf16_t*)WSP(WS_X2), C.p.norm_ffn_w + l * 1024, modl + 4096, (float*)WSP(WS_ROWSS) + (size_t)(2 * l + 1) * T_};
            pg8::gemm_phase<pg8::EpiRes, pg8::StaticOrder, ALIGN_RES, true>(ldsg, g, S, E);
        }
        if (l < 3) { RP(); phase_convert(C, l + 1, 3); }
        GSYNC();
        {
            RP();
            pg8::Gemm g{(const bf16_t*)WSP(WS_X2), (const bf16_t*)WSP((l & 1) ? WS_FIN2 : WS_FIN), T_, 5632, 1024}; pg8::StaticOrder S; S.init(T_, 5632, (int)gridDim.x, (int)blockIdx.x);
            pg8::EpiFfn E{(bf16_t*)WSP(WS_R1), (float*)WSP(WS_HP), (float*)WSP(WS_HU), (float*)WSP(WS_HA), C.p.ffn_conv_w + (size_t)l * 3 * DFF_, C.p.ffn_conv_b + (size_t)l * DFF_,
                          (const float*)WSP(WS_ROWSS) + (size_t)(2 * l + 1) * T_, (const float*)WSP(WS_BIAS) + (size_t)l * BIAS_L + 8 * 3584};
            for (int rep_ = 0; rep_ < REP_G; ++rep_) pg8::gemm_phase<pg8::EpiFfn, pg8::StaticOrder, true, true>(ldsg, g, S, E);
        }
        GSYNC();
        for (int rep_ = 0; rep_ < REP_SM; ++rep_) { RP(); phase_ffn_fixup(C, l); }
        GSYNC();
        STAGGER(STG_B);
        {
            RP();
            const float* modl = (const float*)WSP(WS_MOD) + (size_t)l * 8 * 6144;
            pg8::Gemm g{(const bf16_t*)WSP(WS_R1), (const bf16_t*)WSP((l & 1) ? WS_FOUT2 : WS_FOUT), T_, 1024, DFF_}; pg8::StaticOrder S; S.init(T_, 1024, (int)gridDim.x, (int)blockIdx.x);
            pg8::EpiRes E{C.p.out, C.p.out, modl + 5120, (l < 3) ? (bf16_t*)WSP(WS_A) : (bf16_t*)nullptr, C.p.norm_mix_w + ((l + 1) & 3) * 1024, modl + 6144 * 8 + 1024, (float*)WSP(WS_ROWSS) + (size_t)((2 * l + 2) & 7) * T_};
            pg8::gemm_phase<pg8::EpiRes, pg8::StaticOrder, ALIGN_RES, true>(ldsg, g, S, E);
        }
        if (l < 3) { RP(); phase_convert(C, l + 1, 12); }
        GSYNC();
    }
    RP(); phase_final_norm(C, C.p.out, C.p.final_norm_w);
}

extern "C" void kernel_launch(void* const* d_in, const int* in_sizes, int n_in, void* d_out, int out_size, void* d_ws, size_t ws_size, hipStream_t stream) {
    static int grid_blocks = 0;
    if (grid_blocks == 0) {
        if (n_in != 24 || ws_size < WS_END) { fprintf(stderr, "kernel_launch: unexpected n_in %d / ws %zu\n", n_in, ws_size); grid_blocks = -1; return; }
        int dev = 0, cus = 0, per_cu = 0;
        hipGetDevice(&dev); hipDeviceGetAttribute(&cus, hipDeviceAttributeMultiprocessorCount, dev);
        if (hipFuncSetAttribute((const void*)fwd_megakernel, hipFuncAttributeMaxDynamicSharedMemorySize, LDS_BYTES) != hipSuccess) { fprintf(stderr, "kernel_launch: hipFuncSetAttribute failed\n"); grid_blocks = -1; return; }
        if (hipOccupancyMaxActiveBlocksPerMultiprocessor(&per_cu, (const void*)fwd_megakernel, NTHR, LDS_BYTES) != hipSuccess || per_cu < 1) { fprintf(stderr, "kernel_launch: occupancy query gave %d\n", per_cu); per_cu = 1; }
        (void)hipGetLastError();
        grid_blocks = cus * per_cu;
    }
    if (grid_blocks < 0) return;
    Params p{};
    p.x = (const float*)d_in[0]; p.c = (const float*)d_in[1]; p.positions = (const int*)d_in[2]; p.mod_w = (const float*)d_in[3]; p.mod_b = (const float*)d_in[4];
    p.norm_mix_w = (const float*)d_in[5]; p.norm_ffn_w = (const float*)d_in[6]; p.ev_w_in = (const float*)d_in[7]; p.gla_gate_w = (const float*)d_in[8];
    p.gla_gate_b = (const float*)d_in[9]; p.gla_norm_w = (const float*)d_in[10]; p.swa_sinks = (const float*)d_in[11]; p.ev_w_out = (const float*)d_in[12];
    p.od_w_in = (const float*)d_in[13]; p.diff_lambda = (const float*)d_in[14]; p.diff_norm_w = (const float*)d_in[15]; p.hgrn_lb_logits = (const float*)d_in[16];
    p.hgrn_norm_w = (const float*)d_in[17]; p.od_w_out = (const float*)d_in[18]; p.ffn_w_in = (const float*)d_in[19]; p.ffn_conv_w = (const float*)d_in[20];
    p.ffn_conv_b = (const float*)d_in[21]; p.ffn_w_out = (const float*)d_in[22]; p.final_norm_w = (const float*)d_in[23];
    p.out = (float*)d_out; p.ws = (unsigned char*)d_ws;
    if (hipMemsetAsync((char*)d_ws + WS_BAR, 0, 16384, stream) != hipSuccess) { fprintf(stderr, "kernel_launch: memset failed\n"); return; }
    void* args[] = {&p};
    hipError_t e = hipLaunchCooperativeKernel((const void*)fwd_megakernel, dim3(grid_blocks), dim3(NTHR), args, LDS_BYTES, stream);
    if (e != hipSuccess) fprintf(stderr, "cooperative launch failed: %s (grid %d)\n", hipGetErrorString(e), grid_blocks);
}
```

```cpp
#include <hip/hip_runtime.h>
#include <hip/hip_cooperative_groups.h>
#include <hip/hip_bf16.h>
#include <cstdio>
#include <cstdint>
#include <cmath>
__device__ __forceinline__ int otid_() { int t = threadIdx.x; asm volatile("" : "+v"(t)); return t; }
namespace pg8 {
#define PG8_LAS __attribute__((address_space(3)))
typedef unsigned short bf16_t;
typedef short bf16x8 __attribute__((ext_vector_type(8)));
typedef float f32x4 __attribute__((ext_vector_type(4)));
typedef unsigned u32x4 __attribute__((ext_vector_type(4)));
constexpr int BM = 256, BK = 64, HALF = 128, HTB = HALF * BK * 2  , STAGE_BYTES = 8 * HTB, NXCD = 8, WGM = 8;

__host__ __device__ __forceinline__ int lds_byte(int r, int c) { const int st = (r >> 4) * 2 + (c >> 5), rr = r & 15, cc = c & 31, ob = rr * 64 + cc * 2; return st * 1024 + (ob ^ (((ob >> 9) & 1) << 5)); }
__host__ __device__ __forceinline__ void stage_rc(int b, int& R, int& C) { const int st = b / 1024, sb = b % 1024, swz = sb ^ (((sb >> 9) & 1) << 5); R = (st >> 1) * 16 + swz / 64; C = (st & 1) * 32 + (swz % 64) / 2; }
__host__ __device__ __forceinline__ int perm32(int rho) { const int n = rho >> 4, i = rho & 15; return 8 * (i >> 2) + 4 * n + (i & 3); }

struct Unit { int pm, pn; };
struct Gemm { const bf16_t* A; const bf16_t* Bt; int M, N, K; };

struct StaticOrder {
    int nM, nN, nwg, G, c;
    __host__ __device__ void init(int M, int N, int G_, int c_) { nM = M / BM; nN = N / BM; nwg = nM * nN; G = G_; c = c_; }
    __host__ __device__ bool next(int i, Unit& u) const {
        const long L = (long)i * G + c; if (L >= nwg) return false;
        int wgid = (int)L; { const int q = nwg / NXCD, r = nwg % NXCD, xcd = wgid % NXCD, off = wgid / NXCD; wgid = (xcd < r ? xcd * (q + 1) : r * (q + 1) + (xcd - r) * q) + off; }
        const int nig = WGM * nN, gid = wgid / nig, fm = gid * WGM, gsz = (nM - fm) < WGM ? (nM - fm) : WGM;
        u.pm = fm + ((wgid % nig) % gsz); u.pn = (wgid % nig) / gsz; return true;
    }
    __device__ __forceinline__ void a_ready(const Unit&) const {}
    __device__ __forceinline__ void done(const Unit&) const {}
};

__device__ __forceinline__ unsigned cvt_pk_bf16(float lo, float hi) { unsigned r; asm volatile("v_cvt_pk_bf16_f32 %0, %1, %2" : "=v"(r) : "v"(lo), "v"(hi)); return r; }
typedef float f32x2 __attribute__((ext_vector_type(2)));
template <class Epi, class Sched, bool ALIGN_EPI = false, bool SP2 = false>
__device__ __forceinline__ void gemm_phase(PG8_LAS unsigned char* lds, const Gemm g, const Sched& S, const Epi& E) {
    const int tid = otid_(), wid = __builtin_amdgcn_readfirstlane(tid >> 6), lane = tid & 63, wr = wid >> 2, wc = wid & 3, fr = lane & 15, fq = lane >> 4;
    const int K = g.K, nt = K / BK;
    unsigned voffA[2], voffB[2];
#pragma unroll
    for (int i = 0; i < 2; ++i) { int R, C; stage_rc(tid * 16 + i * 8192, R, C); const int Rb = Epi::PERM ? ((R & ~31) + perm32(R & 31)) : R;
        voffA[i] = (unsigned)(R * K + C) * 2u; voffB[i] = (unsigned)(Rb * K + C) * 2u; }
    const size_t kstep = (size_t)(BK * 2);
    const size_t hstep = (size_t)HALF * K * 2;
    const size_t tstep = 2 * hstep;
    const unsigned ldsw = (unsigned)wid * 1024u;
    const int aoff = lds_byte(wr * 64 + fr, fq * 8), boff = lds_byte(wc * 32 + fr, fq * 8);
#define PG8_SA(b, h) (((b) * 2 + (h)) * HTB)
#define PG8_SB(b, h) ((4 + (b) * 2 + (h)) * HTB)
#define PG8_STAGE(bufoff, gbase, voff) do { _Pragma("unroll") for (int _i = 0; _i < 2; ++_i) \
        __builtin_amdgcn_global_load_lds((const unsigned*)((const char*)(gbase) + (voff)[_i]), (PG8_LAS unsigned*)(lds + (bufoff) + ldsw + _i * 8192), 16, 0, 0); } while (0)
#define PG8_LDA(dst, b, h) do { _Pragma("unroll") for (int m = 0; m < 4; ++m) _Pragma("unroll") for (int k = 0; k < 2; ++k) dst[m][k] = *(const PG8_LAS bf16x8*)(lds + PG8_SA(b, h) + aoff + m * 2048 + k * 1024); } while (0)
#define PG8_LDB(dst, b, h) do { _Pragma("unroll") for (int n = 0; n < 2; ++n) _Pragma("unroll") for (int k = 0; k < 2; ++k) dst[n][k] = *(const PG8_LAS bf16x8*)(lds + PG8_SB(b, h) + boff + n * 2048 + k * 1024); } while (0)
#define PG8_MMA(ai, bj, At, Bt) do { __builtin_amdgcn_s_setprio(1); _Pragma("unroll") for (int m = 0; m < 4; ++m) _Pragma("unroll") for (int n = 0; n < 2; ++n) _Pragma("unroll") for (int k = 0; k < 2; ++k) \
        acc[ai][bj][m][n] = __builtin_amdgcn_mfma_f32_16x16x32_bf16(Bt[n][k], At[m][k], acc[ai][bj][m][n], 0, 0, 0); __builtin_amdgcn_s_setprio(0); } while (0)
#define PG8_WAIT_V(n) asm volatile("s_waitcnt vmcnt(" #n ")" ::: "memory")
#define PG8_WAIT_L(n) asm volatile("s_waitcnt lgkmcnt(" #n ")" ::: "memory")
#define PG8_BAR __builtin_amdgcn_s_barrier()
#define PG8_SCHED __builtin_amdgcn_sched_barrier(0)
    Unit cur, nxt; int ui = 0;
    if (!S.next(0, cur)) return;
    f32x4 acc[2][2][4][2];
#pragma unroll
    for (int a = 0; a < 2; ++a)
#pragma unroll
        for (int b = 0; b < 2; ++b)
#pragma unroll
            for (int m = 0; m < 4; ++m)
#pragma unroll
                for (int n = 0; n < 2; ++n) acc[a][b][m][n] = (f32x4){0.f, 0.f, 0.f, 0.f};
    bf16x8 At[4][2], B0[2][2], B1[2][2];
    const char* cA = (const char*)g.A + (size_t)cur.pm * tstep; const char* cB = (const char*)g.Bt + (size_t)cur.pn * tstep;
    S.a_ready(cur);
    if constexpr (SP2) {
        PG8_STAGE(PG8_SB(0, 0), cB, voffB); PG8_STAGE(PG8_SB(0, 1), cB + hstep, voffB); PG8_STAGE(PG8_SA(0, 0), cA, voffA); PG8_STAGE(PG8_SA(0, 1), cA + hstep, voffA);
        if (wr == 1) PG8_BAR;
        PG8_WAIT_V(2); PG8_BAR;
        PG8_STAGE(PG8_SB(1, 0), cB + kstep, voffB); PG8_STAGE(PG8_SA(1, 0), cA + kstep, voffA); PG8_STAGE(PG8_SB(1, 1), cB + hstep + kstep, voffB);
        PG8_WAIT_V(6); PG8_BAR;
    } else {
        PG8_STAGE(PG8_SB(0, 0), cB, voffB); PG8_STAGE(PG8_SA(0, 0), cA, voffA); PG8_STAGE(PG8_SB(0, 1), cB + hstep, voffB); PG8_STAGE(PG8_SA(0, 1), cA + hstep, voffA);
        if (wr == 1) PG8_BAR;
        PG8_WAIT_V(4); PG8_BAR;
        PG8_STAGE(PG8_SB(1, 0), cB + kstep, voffB); PG8_STAGE(PG8_SA(1, 0), cA + kstep, voffA); PG8_STAGE(PG8_SB(1, 1), cB + hstep + kstep, voffB);
        PG8_WAIT_V(6); PG8_BAR;
    }
    for (;;) {
        const bool has_next = S.next(ui + 1, nxt);
        const char* nA = has_next ? (const char*)g.A + (size_t)nxt.pm * tstep : cA; const char* nB = has_next ? (const char*)g.Bt + (size_t)nxt.pn * tstep : cB;
        for (int t = 0; t < nt; t += 2) {
            const bool last = (t == nt - 2);
            const char* a1 = cA + (size_t)(t + 1) * kstep;
            const char* a2 = last ? nA : cA + (size_t)(t + 2) * kstep; const char* b2 = last ? nB : cB + (size_t)(t + 2) * kstep;
            const char* a3 = a2 + kstep; const char* b3 = b2 + kstep;
            if (last && has_next) S.a_ready(nxt);
            if constexpr (SP2) {
            PG8_LDB(B0, 0, 0); PG8_LDB(B1, 0, 1); PG8_SCHED; PG8_LDA(At, 0, 0); PG8_STAGE(PG8_SA(1, 1), a1 + hstep, voffA);
            PG8_WAIT_V(8); PG8_WAIT_L(0); PG8_BAR; PG8_MMA(0, 0, At, B0); PG8_MMA(0, 1, At, B1); PG8_BAR; PG8_SCHED;
            PG8_LDA(At, 0, 1); PG8_STAGE(PG8_SB(0, 0), b2, voffB); PG8_STAGE(PG8_SB(0, 1), b2 + hstep, voffB); PG8_STAGE(PG8_SA(0, 0), a2, voffA);
            PG8_WAIT_V(8); PG8_WAIT_L(0); PG8_BAR; PG8_MMA(1, 0, At, B0); PG8_MMA(1, 1, At, B1); PG8_BAR; PG8_SCHED;
            PG8_LDB(B0, 1, 0); PG8_LDB(B1, 1, 1); PG8_SCHED; PG8_LDA(At, 1, 0); PG8_STAGE(PG8_SA(0, 1), a2 + hstep, voffA);
            PG8_WAIT_V(8); PG8_WAIT_L(0); PG8_BAR; PG8_MMA(0, 0, At, B0); PG8_MMA(0, 1, At, B1); PG8_BAR; PG8_SCHED;
            PG8_LDA(At, 1, 1); PG8_STAGE(PG8_SB(1, 0), b3, voffB); PG8_STAGE(PG8_SB(1, 1), b3 + hstep, voffB); PG8_STAGE(PG8_SA(1, 0), a3, voffA);
            PG8_WAIT_V(8); PG8_WAIT_L(0); PG8_BAR; PG8_MMA(1, 0, At, B0); PG8_MMA(1, 1, At, B1); PG8_BAR; PG8_SCHED;
            } else {
            PG8_LDB(B0, 0, 0); PG8_SCHED; PG8_LDA(At, 0, 0); PG8_STAGE(PG8_SA(1, 1), a1 + hstep, voffA);
            PG8_WAIT_L(8); PG8_BAR; PG8_WAIT_L(0); PG8_MMA(0, 0, At, B0); PG8_BAR; PG8_SCHED;
            PG8_LDB(B1, 0, 1); PG8_STAGE(PG8_SB(0, 0), b2, voffB);
            PG8_BAR; PG8_WAIT_L(0); PG8_MMA(0, 1, At, B1); PG8_BAR;
            PG8_LDA(At, 0, 1); PG8_STAGE(PG8_SA(0, 0), a2, voffA);
            PG8_BAR; PG8_WAIT_L(0); PG8_MMA(1, 0, At, B0); PG8_BAR; PG8_SCHED;
            PG8_STAGE(PG8_SB(0, 1), b2 + hstep, voffB);
            PG8_WAIT_V(6); PG8_BAR; PG8_MMA(1, 1, At, B1); PG8_BAR;
            PG8_LDB(B0, 1, 0); PG8_SCHED; PG8_LDA(At, 1, 0); PG8_STAGE(PG8_SA(0, 1), a2 + hstep, voffA);
            PG8_WAIT_L(8); PG8_BAR; PG8_WAIT_L(0); PG8_MMA(0, 0, At, B0); PG8_BAR; PG8_SCHED;
            PG8_LDB(B1, 1, 1); PG8_STAGE(PG8_SB(1, 0), b3, voffB);
            PG8_BAR; PG8_WAIT_L(0); PG8_MMA(0, 1, At, B1); PG8_BAR;
            PG8_LDA(At, 1, 1); PG8_STAGE(PG8_SA(1, 0), a3, voffA);
            PG8_BAR; PG8_WAIT_L(0); PG8_MMA(1, 0, At, B0); PG8_BAR; PG8_SCHED;
            PG8_STAGE(PG8_SB(1, 1), b3 + hstep, voffB);
            PG8_WAIT_V(6); PG8_BAR; PG8_MMA(1, 1, At, B1); PG8_BAR;
            }
        }
        if constexpr (ALIGN_EPI) { if (wr == 0) PG8_BAR; }
        if constexpr (!Epi::AFTER_DRAIN) { E(acc, cur, wr, wc, fr, fq); S.done(cur); }
        if (!has_next) break;
#pragma unroll
        for (int a = 0; a < 2; ++a)
#pragma unroll
            for (int b = 0; b < 2; ++b)
#pragma unroll
                for (int m = 0; m < 4; ++m)
#pragma unroll
                    for (int n = 0; n < 2; ++n) acc[a][b][m][n] = (f32x4){0.f, 0.f, 0.f, 0.f};
        cur = nxt; cA = nA; cB = nB; ++ui;
        if constexpr (ALIGN_EPI) { if (wr == 1) PG8_BAR; }
    }
    PG8_WAIT_V(0);
    if constexpr (!ALIGN_EPI) { if (wr == 0) PG8_BAR; }
    PG8_BAR;
    if constexpr (Epi::AFTER_DRAIN) { E.fused(acc, cur, wr, wc, fr, fq, lds, wid, lane); S.done(cur); }
#undef PG8_SA
#undef PG8_SB
#undef PG8_STAGE
#undef PG8_LDA
#undef PG8_LDB
#undef PG8_MMA
#undef PG8_WAIT_V
#undef PG8_WAIT_L
#undef PG8_BAR
#undef PG8_SCHED
}
}
#include <hip/hip_bf16.h>
namespace attn_body {
using bf16=__hip_bfloat16;
using bf16x8=__attribute__((ext_vector_type(8)))short;
using s16x4=__attribute__((ext_vector_type(4)))short;
using f32x16=__attribute__((ext_vector_type(16)))float;
using u32x4=__attribute__((ext_vector_type(4)))unsigned;
constexpr int BATCH=8,NHEAD=16,SEQ=4096,D=64,PITI=3584,PITO=1024;
constexpr int NW=8,QBLK=32,QB=QBLK*NW,KVBLK=64,NQB=SEQ/QB;
__device__ __forceinline__ int crow(int r,int hi){return (r&3)+8*(r>>2)+4*hi;}
#define SBAR() __builtin_amdgcn_sched_barrier(0)
__device__ __forceinline__ void cmask(f32x16&p0,f32x16&p1,int jb,int qrel,int hi){
  const float NEG=-INFINITY; int kb=64*jb+4*hi;
  #pragma unroll
  for(int r=0;r<16;++r){int kv=kb+(r&3)+8*(r>>2); if(kv>qrel)p0[r]=NEG; if(kv+32>qrel)p1[r]=NEG;}
}

constexpr int NSLOT=3, SLOTB=8192;
constexpr int LDS_K=0, LDS_V=NSLOT*SLOTB, LDS_WS=2*NSLOT*SLOTB, LDS_OST=LDS_WS+NW*64*4, LDS_BYTES=LDS_OST+NW*4096;
constexpr float C2=0.125f*1.4426950408889634f;
__device__ __forceinline__ void glds16(const void*gsrc,unsigned lds_dst){unsigned keep;
  asm volatile("s_mov_b32 %0, m0\n\ts_mov_b32 m0, %2\n\ts_nop 0\n\tglobal_load_lds_dwordx4 %1, off\n\ts_mov_b32 m0, %0":"=&s"(keep):"v"(gsrc),"s"(lds_dst):"memory");}
__device__ __forceinline__ float max3f(float a,float b,float c){float r;asm("v_max3_f32 %0, %1, %2, %3":"=v"(r):"v"(a),"v"(b),"v"(c));return r;}
__device__ __forceinline__ float max2f(float a,float b){float r;asm("v_max_f32_e32 %0, %1, %2":"=v"(r):"v"(a),"v"(b));return r;}
__device__ __forceinline__ float fadd_s(float a,float b){float r;asm("v_add_f32_e32 %0, %1, %2":"=v"(r):"v"(a),"v"(b));return r;}
__device__ __forceinline__ float fsub_s(float a,float b){float r;asm("v_sub_f32_e32 %0, %1, %2":"=v"(r):"v"(a),"v"(b));return r;}
typedef float f32x2_t __attribute__((ext_vector_type(2))); typedef __bf16 bf16x2_t __attribute__((ext_vector_type(2)));
__device__ __forceinline__ unsigned cvtpk_s(float lo,float hi){f32x2_t v={lo,hi};bf16x2_t b=__builtin_convertvector(v,bf16x2_t);return __builtin_bit_cast(unsigned,b);}
#define WAIT_BAR(N) asm volatile("s_waitcnt vmcnt(" #N ") lgkmcnt(0)\n\ts_barrier":::"memory")

__device__ __forceinline__ void qkt(f32x16&p0,f32x16&p1,const char*Kslot,const bf16x8*qr,const f32x16&negm,int r32,int hi){
  const char*kb=Kslot+hi*1024+r32*16;
  #pragma unroll
  for(int d0=0;d0<4;++d0){
    const bf16x8 b0=*reinterpret_cast<const bf16x8*>(kb+d0*2048);
    const bf16x8 b1=*reinterpret_cast<const bf16x8*>(kb+d0*2048+512);
    if(d0==0){p0=__builtin_amdgcn_mfma_f32_32x32x16_bf16(b0,qr[0],negm,0,0,0);p1=__builtin_amdgcn_mfma_f32_32x32x16_bf16(b1,qr[0],negm,0,0,0);}
    else{p0=__builtin_amdgcn_mfma_f32_32x32x16_bf16(b0,qr[d0],p0,0,0,0);p1=__builtin_amdgcn_mfma_f32_32x32x16_bf16(b1,qr[d0],p1,0,0,0);}}
}
typedef __attribute__((address_space(3))) const char* lds_cptr;
typedef short v4i16_t __attribute__((ext_vector_type(4)));
__device__ __forceinline__ void kload8(bf16x8*kf,lds_cptr kp){
  kf[0]=*(const __attribute__((address_space(3))) bf16x8*)(kp);      kf[1]=*(const __attribute__((address_space(3))) bf16x8*)(kp+512);
  kf[2]=*(const __attribute__((address_space(3))) bf16x8*)(kp+2048); kf[3]=*(const __attribute__((address_space(3))) bf16x8*)(kp+2560);
  kf[4]=*(const __attribute__((address_space(3))) bf16x8*)(kp+4096); kf[5]=*(const __attribute__((address_space(3))) bf16x8*)(kp+4608);
  kf[6]=*(const __attribute__((address_space(3))) bf16x8*)(kp+6144); kf[7]=*(const __attribute__((address_space(3))) bf16x8*)(kp+6656);
}
__device__ __forceinline__ void kload2(bf16x8*kf,lds_cptr kp,int j){ kf[2*j]=*(const __attribute__((address_space(3))) bf16x8*)(kp+j*2048); kf[2*j+1]=*(const __attribute__((address_space(3))) bf16x8*)(kp+j*2048+512); }
__device__ __forceinline__ s16x4 vtr(lds_cptr p){ return __builtin_bit_cast(s16x4,__builtin_amdgcn_ds_read_tr16_b64_v4i16((__attribute__((address_space(3))) v4i16_t*)p)); }
__device__ __forceinline__ float rowmax(const f32x16&p0,const f32x16&p1){
  float a=max3f(p0[0],p0[1],p1[0]),b=max3f(p0[2],p0[3],p1[1]);a=max3f(a,p1[2],p1[3]);
  #pragma unroll
  for(int r=4;r<16;r+=4){a=max3f(a,p0[r],p0[r+1]);b=max3f(b,p0[r+2],p0[r+3]);a=max3f(a,p1[r],p1[r+1]);b=max3f(b,p1[r+2],p1[r+3]);}
  const float m=max2f(a,b);
  auto rr=__builtin_amdgcn_permlane32_swap(__float_as_uint(m),__float_as_uint(m),false,false);
  return max2f(__uint_as_float(rr[0]),__uint_as_float(rr[1]));
}
__device__ __forceinline__ void pv(f32x16*o,int vb,bf16x8 pa0,bf16x8 pa1,bf16x8 pa2,bf16x8 pa3){
  #pragma unroll
  for(int d0=0;d0<2;++d0){s16x4 lo[4],hi[4];
    #pragma unroll
    for(int ks=0;ks<4;++ks){
      asm volatile("ds_read_b64_tr_b16 %0,%1 offset:%c2":"=&v"(lo[ks]):"v"(vb),"i"(d0*4096+ks*1024):"memory");
      asm volatile("ds_read_b64_tr_b16 %0,%1 offset:%c2":"=&v"(hi[ks]):"v"(vb),"i"(d0*4096+ks*1024+512):"memory");}
    asm volatile("s_waitcnt lgkmcnt(0)":::"memory");SBAR();
    #define PK(k) (bf16x8){lo[k][0],lo[k][1],lo[k][2],lo[k][3],hi[k][0],hi[k][1],hi[k][2],hi[k][3]}
    o[d0]=__builtin_amdgcn_mfma_f32_32x32x16_bf16(pa0,PK(0),o[d0],0,0,0);
    o[d0]=__builtin_amdgcn_mfma_f32_32x32x16_bf16(pa1,PK(1),o[d0],0,0,0);
    o[d0]=__builtin_amdgcn_mfma_f32_32x32x16_bf16(pa2,PK(2),o[d0],0,0,0);
    o[d0]=__builtin_amdgcn_mfma_f32_32x32x16_bf16(pa3,PK(3),o[d0],0,0,0);
    #undef PK
  }
}

#ifndef ATTN_STORE16
#define ATTN_STORE16(p,v) (*(u32x4*)(p)=(v))
#endif
template<int THRL> __device__ __forceinline__ void attn_unit(int b,int h,int qb,const bf16*Q,const bf16*__restrict__ K,const bf16*__restrict__ V,bf16*O,char*shm){
  const int tid=otid_(),lane=tid&63,r32=lane&31,hi=lane>>5; const int wid=__builtin_amdgcn_readfirstlane(tid>>6);
  const long rowbase=(long)b*SEQ; const int q0=qb*QB;
  const bf16*Qw=Q+(rowbase+q0+wid*QBLK)*PITI;
  const bf16*Kh=K+rowbase*PITI,*Vh=V+rowbase*PITI;
  const unsigned lds0=(unsigned)(uintptr_t)shm;
  float*wsf=(float*)(shm+LDS_WS)+wid*64;
  const bf16*ksrc=Kh+(long)lane*PITI+wid*8;
  const bf16*vsrc=Vh+(long)(16*(wid&3)+(lane>>2))*PITI+(wid>>2)*32+(lane&3)*8;
  const unsigned kdst=lds0+LDS_K+wid*1024, vdst=lds0+LDS_V+wid*1024;
  #define DMA_K(t,slot) glds16(ksrc+(long)(t)*KVBLK*PITI,(unsigned)__builtin_amdgcn_readfirstlane(kdst+(slot)))
  #define DMA_V(t,slot) glds16(vsrc+(long)(t)*KVBLK*PITI,(unsigned)__builtin_amdgcn_readfirstlane(vdst+(slot)))
  const int vb0=(int)(lds0+LDS_V)+((lane>>4)&1)*32+(lane&3)*8+(4*hi+((lane&15)>>2))*64;
  const char*Kbase=shm+LDS_K; bf16x8 kf[8];
  const lds_cptr shm3=(lds_cptr)shm; const lds_cptr kp0=shm3+LDS_K+hi*1024+r32*16; const lds_cptr vp0=shm3+LDS_V+((lane>>4)&1)*32+(lane&3)*8+(4*hi+((lane&15)>>2))*64;
  const int NT=(q0+QB)/KVBLK;
  DMA_K(0,0);DMA_V(0,0);DMA_K(1,SLOTB);
  bf16x8 qr[4];
  #pragma unroll
  for(int d0=0;d0<4;++d0)qr[d0]=*reinterpret_cast<const bf16x8*>(&Qw[(long)r32*PITI+d0*16+hi*8]);
  float mhat=0.f,l_reg=0.f;f32x16 o[2];o[0]=f32x16{};o[1]=f32x16{};f32x16 negm=f32x16{};asm volatile("":"+v"(negm));
  const int qrel=wid*QBLK+r32;
  #define CMASK(P0,P1,t) do{int jb_=(t)-(NT-4); if(jb_>=0)cmask(P0,P1,jb_,qrel,hi);}while(0)
  bool resc=false;
  #define START(P0,P1) do{ const float rm=rowmax(P0,P1); resc=false; \
    { const float dl=rm; mhat=fadd_s(mhat,dl); \
      _Pragma("unroll") for(int r=0;r<16;++r){P0[r]=fsub_s(P0[r],dl);P1[r]=fsub_s(P1[r],dl);} \
      _Pragma("unroll") for(int r=0;r<16;++r)negm[r]=-mhat; asm volatile("":"+v"(negm)); } \
    _Pragma("unroll") for(int r=0;r<16;++r)P0[r]=__builtin_amdgcn_exp2f(P0[r]); }while(0)
  #define RESC() do{ if(resc){ asm volatile("s_waitcnt lgkmcnt(0)":::"memory"); \
      _Pragma("unroll") for(int d_=0;d_<2;++d_) _Pragma("unroll") for(int r=0;r<16;++r)o[d_][r]*=wsf[crow(r,hi)]; } }while(0)
  f32x16 pA0,pA1,pB0,pB1;
  int sl_prev=0,sl_cur=0,sl_next=SLOTB;
  #define ROT() do{sl_prev=sl_cur;sl_cur=sl_next;sl_next=(sl_next==(NSLOT-1)*SLOTB)?0:sl_next+SLOTB;}while(0)
  DMA_K(2,2*SLOTB);
  WAIT_BAR(3);
  qkt(pA0,pA1,Kbase,qr,negm,r32,hi);asm volatile("s_nop 15\n\ts_nop 7":"+v"(pA0),"+v"(pA1));CMASK(pA0,pA1,0);
  START(pA0,pA1);
  _Pragma("unroll") for(int r=0;r<16;++r)pA1[r]=__builtin_amdgcn_exp2f(pA1[r]);
  WAIT_BAR(0);
  DMA_K(3,0);DMA_V(1,SLOTB);
  ROT();
  kload8(kf,kp0+sl_cur);
  WAIT_BAR(2);
  s16x4 vlo[8],vhi[8]; u32x4 pw0,pw1,pw2,pw3;
  #define PKW(P,B) cvtpk_s(P[B],P[B+1])
  #define PAF(k) __builtin_bit_cast(bf16x8,pw##k)
  #define VFR(i) (bf16x8){vlo[i][0],vlo[i][1],vlo[i][2],vlo[i][3],vhi[i][0],vhi[i][1],vhi[i][2],vhi[i][3]}
  #define PIN(x) asm volatile("":"+v"(x))
  #define MX3(a,b,c) __builtin_fmaxf(__builtin_fmaxf((a),(b)),(c))
  #define GAPA(MF,A0,A1,A2,A3,W0,W1,PW) do{ MF; sacc+=A0; sacc+=A1; sacc+=A2; sacc+=A3; PIN(sacc); W0; W1; PIN(PW); SBAR(); }while(0)
  #define EX(v) __builtin_amdgcn_exp2f(v)
  #define GAPB(MF,X,B) do{ MF; X[B]=EX(X[B]); X[B+1]=EX(X[B+1]); X[B+2]=EX(X[B+2]); X[B+3]=EX(X[B+3]); PIN(X); SBAR(); }while(0)
  #define VRD(i) do{ vlo[i]=vtr(vp_+(((i)>>2)*4096+((i)&3)*1024)); vhi[i]=vtr(vp_+(((i)>>2)*4096+((i)&3)*1024+512)); }while(0)
  #define KRD(G,j) do{ if(G){ kload2(kf,kp0+sl_next,j); SBAR(); } }while(0)
  #define STEP(C0,C1,P0,P1,t,GK,GV,GL) do{ SBAR(); \
    const lds_cptr vp_=vp0+sl_prev; \
    VRD(0); SBAR(); float sacc=(P0[0]+P0[1]); \
    GAPA(C0=__builtin_amdgcn_mfma_f32_32x32x16_bf16(kf[0],qr[0],negm,0,0,0), P0[2],P0[3],P0[4],P0[5],     pw0[0]=PKW(P0,0), pw0[1]=PKW(P0,2), pw0); \
    VRD(4); SBAR(); GAPA(C1=__builtin_amdgcn_mfma_f32_32x32x16_bf16(kf[1],qr[0],negm,0,0,0), P0[6],P0[7],P0[8],P0[9],     pw0[2]=PKW(P0,4), pw0[3]=PKW(P0,6), pw0); \
    VRD(1); SBAR(); GAPA(C0=__builtin_amdgcn_mfma_f32_32x32x16_bf16(kf[2],qr[1],C0,0,0,0),   P0[10],P0[11],P0[12],P0[13], pw1[0]=PKW(P0,8), pw1[1]=PKW(P0,10), pw1); \
    VRD(5); SBAR(); GAPA(C1=__builtin_amdgcn_mfma_f32_32x32x16_bf16(kf[3],qr[1],C1,0,0,0),   P0[14],P0[15],P1[0],P1[1],   pw1[2]=PKW(P0,12),pw1[3]=PKW(P0,14), pw1); \
    VRD(2); SBAR(); GAPA(C0=__builtin_amdgcn_mfma_f32_32x32x16_bf16(kf[4],qr[2],C0,0,0,0),   P1[2],P1[3],P1[4],P1[5],     pw2[0]=PKW(P1,0), pw2[1]=PKW(P1,2), pw2); \
    VRD(6); SBAR(); GAPA(C1=__builtin_amdgcn_mfma_f32_32x32x16_bf16(kf[5],qr[2],C1,0,0,0),   P1[6],P1[7],P1[8],P1[9],     pw2[2]=PKW(P1,4), pw2[3]=PKW(P1,6), pw2); \
    VRD(3); SBAR(); GAPA(C0=__builtin_amdgcn_mfma_f32_32x32x16_bf16(kf[6],qr[3],C0,0,0,0),   P1[10],P1[11],P1[12],P1[13], pw3[0]=PKW(P1,8), pw3[1]=PKW(P1,10), pw3); \
    VRD(7); SBAR(); GAPA(C1=__builtin_amdgcn_mfma_f32_32x32x16_bf16(kf[7],qr[3],C1,0,0,0),   P1[14],P1[15],0.f,0.f,       pw3[2]=PKW(P1,12),pw3[3]=PKW(P1,14), pw3); \
    l_reg+=sacc; \
    if(GK){DMA_K((t)+3,sl_cur);} if(GV){DMA_V((t)+1,sl_next);} \
    CMASK(C0,C1,t); \
    { float a=MX3(C0[0],C0[1],C1[0]),b=MX3(C0[2],C0[3],C1[1]); a=MX3(a,C1[2],C1[3]); \
      _Pragma("unroll") for(int r=4;r<16;r+=4){a=MX3(a,C0[r],C0[r+1]);b=MX3(b,C0[r+2],C0[r+3]);a=MX3(a,C1[r],C1[r+1]);b=MX3(b,C1[r+2],C1[r+3]);} \
      float rm=__builtin_fmaxf(a,b); { auto rr=__builtin_amdgcn_permlane32_swap(__float_as_uint(rm),__float_as_uint(rm),false,false); rm=__builtin_fmaxf(__uint_as_float(rr[0]),__uint_as_float(rr[1])); } \
      resc=false; \
      if(__builtin_expect(__any(rm>(float)THRL),0)){ const float dl=__builtin_fmaxf(rm,0.f); mhat+=dl; \
        _Pragma("unroll") for(int r=0;r<16;++r){C0[r]-=dl;C1[r]-=dl;} \
        _Pragma("unroll") for(int r=0;r<16;++r)negm[r]=-mhat; asm volatile("":"+v"(negm)); \
        const float f=__builtin_amdgcn_exp2f(-dl); l_reg*=f; if(hi==0)wsf[r32]=f; resc=true; } } \
    SBAR(); \
    GAPB(o[0]=__builtin_amdgcn_mfma_f32_32x32x16_bf16(PAF(0),VFR(0),o[0],0,0,0), C0,0); \
    GAPB(o[1]=__builtin_amdgcn_mfma_f32_32x32x16_bf16(PAF(0),VFR(4),o[1],0,0,0), C0,4); \
    KRD(GL,0); GAPB(o[0]=__builtin_amdgcn_mfma_f32_32x32x16_bf16(PAF(1),VFR(1),o[0],0,0,0), C0,8); \
    KRD(GL,1); GAPB(o[1]=__builtin_amdgcn_mfma_f32_32x32x16_bf16(PAF(1),VFR(5),o[1],0,0,0), C0,12); \
    KRD(GL,2); GAPB(o[0]=__builtin_amdgcn_mfma_f32_32x32x16_bf16(PAF(2),VFR(2),o[0],0,0,0), C1,0); \
    KRD(GL,3); GAPB(o[1]=__builtin_amdgcn_mfma_f32_32x32x16_bf16(PAF(2),VFR(6),o[1],0,0,0), C1,4); \
    GAPB(o[0]=__builtin_amdgcn_mfma_f32_32x32x16_bf16(PAF(3),VFR(3),o[0],0,0,0), C1,8); \
    GAPB(o[1]=__builtin_amdgcn_mfma_f32_32x32x16_bf16(PAF(3),VFR(7),o[1],0,0,0), C1,12); \
    }while(0)
  int t=1;
  #undef CMASK
  #define CMASK(P0,P1,t) do{}while(0)
  for(;t+5<NT;t+=2){
    STEP(pB0,pB1,pA0,pA1,t,true,true,true);     WAIT_BAR(2); RESC(); ROT();
    STEP(pA0,pA1,pB0,pB1,t+1,true,true,true);   WAIT_BAR(2); RESC(); ROT();
  }
  #undef CMASK
  #define CMASK(P0,P1,t) do{int jb_=(t)-(NT-4); if(jb_>=0)cmask(P0,P1,jb_,qrel,hi);}while(0)
  #define ENDW(tt) do{ if((tt)+3<NT){WAIT_BAR(2);} else if((tt)+2<NT){WAIT_BAR(1);} else {WAIT_BAR(0);} }while(0)
  for(;t+1<NT;t+=2){
    STEP(pB0,pB1,pA0,pA1,t,(t+3<NT),(t+1<NT),(t+1<NT));       ENDW(t);   RESC(); ROT();
    STEP(pA0,pA1,pB0,pB1,t+1,(t+4<NT),(t+2<NT),(t+2<NT));     ENDW(t+1); RESC(); ROT();
  }
  STEP(pB0,pB1,pA0,pA1,NT-1,false,false,false); RESC();
  { float sacc=pB0[0]+pB0[1]; _Pragma("unroll") for(int r=2;r<16;++r)sacc+=pB0[r]; _Pragma("unroll") for(int r=0;r<16;++r)sacc+=pB1[r]; l_reg+=sacc;
    pw0=(u32x4){PKW(pB0,0),PKW(pB0,2),PKW(pB0,4),PKW(pB0,6)};pw1=(u32x4){PKW(pB0,8),PKW(pB0,10),PKW(pB0,12),PKW(pB0,14)};pw2=(u32x4){PKW(pB1,0),PKW(pB1,2),PKW(pB1,4),PKW(pB1,6)};pw3=(u32x4){PKW(pB1,8),PKW(pB1,10),PKW(pB1,12),PKW(pB1,14)};
    SBAR(); pv(o,vb0+sl_cur,PAF(0),PAF(1),PAF(2),PAF(3)); }
  #undef PKW
  #undef PAF
  #undef VFR
  #undef PIN
  #undef MX3
  #undef GAPA
  #undef GAPB
  #undef EX
  #undef VRD
  #undef KRD
  #undef STEP
  #undef ENDW
  {auto rr=__builtin_amdgcn_permlane32_swap(__float_as_uint(l_reg),__float_as_uint(l_reg),false,false);l_reg=__uint_as_float(rr[0])+__uint_as_float(rr[1]);}
  if(hi==0)wsf[32+r32]=l_reg;asm volatile("s_waitcnt lgkmcnt(0)":::"memory");
  float rli[16];
  #pragma unroll
  for(int r=0;r<16;++r)rli[r]=__builtin_amdgcn_rcpf(wsf[32+crow(r,hi)]);
  bf16*Ow=O+(rowbase+q0+wid*QBLK)*PITO;
  { bf16*stg=(bf16*)(shm+LDS_OST)+wid*2048;
    #pragma unroll
    for(int r=0;r<16;++r){const int orow=crow(r,hi);
      #pragma unroll
      for(int d0=0;d0<2;++d0)stg[orow*64+d0*32+r32]=__float2bfloat16(o[d0][r]*rli[r]);}
    asm volatile("s_waitcnt lgkmcnt(0)":::"memory");
    #pragma unroll
    for(int i=0;i<4;++i){const int row=i*8+(lane>>3),ch=lane&7; const u32x4 v=*(const u32x4*)(stg+row*64+ch*8); ATTN_STORE16(Ow+(long)row*PITO+ch*8,v);} }
  asm volatile("s_waitcnt lgkmcnt(0)\n\ts_barrier":::"memory");
  #undef DMA_K
  #undef DMA_V
  #undef CMASK
  #undef START
  #undef RESC
  #undef ROT
}
constexpr int ATTN_LDS_BYTES=LDS_BYTES;
#undef SBAR
#undef WAIT_BAR
}

namespace cg = cooperative_groups;
typedef unsigned short bf16_t;
typedef float f32x4 __attribute__((ext_vector_type(4)));
typedef float f32x16 __attribute__((ext_vector_type(16)));
typedef unsigned u32x4 __attribute__((ext_vector_type(4)));
typedef unsigned u32x2 __attribute__((ext_vector_type(2)));
typedef short bf16x8 __attribute__((ext_vector_type(8)));
#define LAS3 __attribute__((address_space(3)))

constexpr int T_ = 32768, DM_ = 1024, SEQ_ = 4096, DFF_ = 2816;
constexpr int NTHR = 512;
constexpr int LDS_BYTES = 147456;
constexpr size_t MiB_ = 1u << 20;
constexpr size_t WS_MOD = 0, WS_COS = 1 * MiB_, WS_SIN = 2 * MiB_, WS_BAR = 3 * MiB_;
constexpr size_t WS_WIN = 4 * MiB_, WS_WOUT = 11 * MiB_, WS_FIN = 13 * MiB_, WS_FOUT = 24 * MiB_;
constexpr size_t WS_A = 32 * MiB_, WS_X2 = 96 * MiB_, WS_ST = 160 * MiB_, WS_TOT = 224 * MiB_, WS_R1 = 226 * MiB_, WS_BIAS = 450 * MiB_, WS_ROWSS = 452 * MiB_, WS_FOUT2 = 454 * MiB_, WS_END = 460 * MiB_;
constexpr int BIAS_L = 8 * (3584 + 5632);
constexpr size_t WS_HP = WS_ST, WS_HU = WS_ST + 12 * MiB_, WS_HA = WS_ST + 24 * MiB_;
constexpr float LOG2E_ = 1.4426950408889634f;
constexpr float QSCALE_ = 0.125f * 1.4426950408889634f;

struct Params {
    const float* x; const float* c; const int* positions; const float* mod_w; const float* mod_b; const float* norm_mix_w; const float* norm_ffn_w;
    const float* ev_w_in; const float* gla_gate_w; const float* gla_gate_b; const float* gla_norm_w; const float* swa_sinks; const float* ev_w_out;
    const float* od_w_in; const float* diff_lambda; const float* diff_norm_w; const float* hgrn_lb_logits; const float* hgrn_norm_w; const float* od_w_out;
    const float* ffn_w_in; const float* ffn_conv_w; const float* ffn_conv_b; const float* ffn_w_out; const float* final_norm_w;
    float* out; unsigned char* ws; unsigned long long pad[6];
};

__device__ __forceinline__ unsigned pk2(float lo, float hi) {
    typedef float f32x2_t __attribute__((ext_vector_type(2))); typedef __bf16 bf16x2_t __attribute__((ext_vector_type(2)));
    f32x2_t v = {lo, hi}; bf16x2_t b = __builtin_convertvector(v, bf16x2_t); return __builtin_bit_cast(unsigned, b);
}
__device__ __forceinline__ float bflo(unsigned u) { return __uint_as_float(u << 16); }
__device__ __forceinline__ float bfhi(unsigned u) { return __uint_as_float(u & 0xffff0000u); }
__device__ __forceinline__ float sigmoidf_(float x) { return __builtin_amdgcn_rcpf(1.f + __expf(-x)); }
__device__ __forceinline__ float siluf_(float x) { return x * __builtin_amdgcn_rcpf(1.f + __expf(-x)); }
__device__ __forceinline__ float wave_sum(float v) {
#pragma unroll
    for (int o = 1; o < 64; o <<= 1) v += __shfl_xor(v, o);
    return v;
}
__device__ __forceinline__ int crow_(int r, int hi) { return (r & 3) + 8 * (r >> 2) + 4 * hi; }

namespace pg8 {
struct EpiProj {
    static constexpr bool PERM = true, AFTER_DRAIN = false;
    bf16_t* O; int ldc; unsigned ropemask; unsigned scalemask; float scale; const float* cs; const float* sn; const float* rowss; const float* bias;
    __device__ __forceinline__ void operator()(const f32x4 (&acc)[2][2][4][2], const Unit& u, int, int, int, int) const {
        const int t_ = otid_(), l_ = t_ & 63, fr = l_ & 15, fq = l_ >> 4, wid_ = __builtin_amdgcn_readfirstlane(t_ >> 6), wr = wid_ >> 2, wc = wid_ & 3;
        const int row0 = u.pm * BM + wr * 64 + fr; const int col0 = u.pn * BM + wc * 32 + 8 * fq;
        float rs[2][4];
#pragma unroll
        for (int ai = 0; ai < 2; ++ai)
#pragma unroll
            for (int m = 0; m < 4; ++m) rs[ai][m] = rsqrtf(rowss[row0 + ai * HALF + m * 16] * (1.f / 1024.f) + 1e-6f);
        const float* bp = bias + (size_t)((u.pm * BM) >> 12) * ldc + col0;
#pragma unroll
        for (int bj = 0; bj < 2; ++bj) {
            const f32x4 bv0 = *(const f32x4*)(bp + bj * HALF), bv1 = *(const f32x4*)(bp + bj * HALF + 4);
            const int grp = u.pn * 2 + bj;
            const bool rope = ((ropemask >> grp) & 1u) && ((wc & 1) == 0);
            const float sc = ((scalemask >> grp) & 1u) ? scale : 1.f;
#pragma unroll
            for (int ai = 0; ai < 2; ++ai)
#pragma unroll
                for (int m = 0; m < 4; ++m) {
                    const int row = row0 + ai * HALF + m * 16;
                    f32x4 v0 = acc[ai][bj][m][0] * rs[ai][m] + bv0, v1 = acc[ai][bj][m][1] * rs[ai][m] + bv1;
                    if (rope) {
                        const f32x4 c0 = *(const f32x4*)(cs + (size_t)row * 8), c1 = *(const f32x4*)(cs + (size_t)row * 8 + 4);
                        const f32x4 s0 = *(const f32x4*)(sn + (size_t)row * 8), s1 = *(const f32x4*)(sn + (size_t)row * 8 + 4);
                        const float sg = (fq == 0) ? -1.f : 1.f;
#pragma unroll
                        for (int e = 0; e < 4; ++e) {
                            const float p0 = __shfl_xor(v0[e], 16), p1 = __shfl_xor(v1[e], 16);
                            const float r0 = v0[e] * c0[e] + sg * p0 * s0[e], r1 = v1[e] * c1[e] + sg * p1 * s1[e];
                            if (fq < 2) { v0[e] = r0; v1[e] = r1; }
                        }
                    }
                    v0 = v0 * sc; v1 = v1 * sc;
                    u32x4 w; w.x = pk2(v0[0], v0[1]); w.y = pk2(v0[2], v0[3]); w.z = pk2(v1[0], v1[1]); w.w = pk2(v1[2], v1[3]);
                    *(u32x4*)(O + (size_t)row * ldc + col0 + bj * HALF) = w;
                    asm volatile("" ::: "memory");
                }
        }
    }
};
typedef _Float16 h16x2 __attribute__((ext_vector_type(2)));
__device__ __forceinline__ unsigned pkh2(float lo, float hi) { typedef float f32x2_t __attribute__((ext_vector_type(2))); f32x2_t v = {lo, hi}; return __builtin_bit_cast(unsigned, __builtin_convertvector(v, h16x2)); }
__device__ __forceinline__ f32x4 unpkh4(unsigned w0, unsigned w1) { const h16x2 a = __builtin_bit_cast(h16x2, w0), b = __builtin_bit_cast(h16x2, w1); return (f32x4){(float)a[0], (float)a[1], (float)b[0], (float)b[1]}; }
struct EpiRes {
    static constexpr bool PERM = true, AFTER_DRAIN = false;
    const void* xin; void* xout; int inf32, outf32; const float* gate;
    bf16_t* Aout; const float* nw; const float* sc; float* rowss;
    __device__ __forceinline__ void operator()(const f32x4 (&acc)[2][2][4][2], const Unit& u, int, int, int, int) const {
        const int t_ = otid_(), l_ = t_ & 63, fr = l_ & 15, fq = l_ >> 4, wid_ = __builtin_amdgcn_readfirstlane(t_ >> 6), wr = wid_ >> 2, wc = wid_ & 3;
        const int col0 = u.pn * BM + wc * 32 + 8 * fq;
        const size_t boff = (size_t)((u.pm * BM) >> 12) * 6144 + col0;
        f32x4 gv[2][2];
#pragma unroll
        for (int bj = 0; bj < 2; ++bj)
#pragma unroll
            for (int n = 0; n < 2; ++n) gv[bj][n] = *(const f32x4*)(gate + boff + bj * HALF + n * 4);
        const int rowb = u.pm * BM + wr * 64 + fr;
        const unsigned eo0 = (unsigned)rowb * 1024u + (unsigned)col0;
        const char* xi = (const char*)xin; char* xo = (char*)xout; char* ao = (char*)Aout;
#pragma unroll
        for (int grp = 0; grp < 8; ++grp) {
            const int ai = grp >> 2, m = grp & 3;
            const unsigned eo = eo0 + (unsigned)(ai * HALF + m * 16) * 1024u;
            float ss = 0.f;
#pragma unroll
            for (int bj = 0; bj < 2; ++bj) {
                const unsigned e2 = eo + (unsigned)(bj * HALF);
                f32x4 x0, x1;
                if (inf32) { x0 = *(const f32x4*)(xi + e2 * 4u); x1 = *(const f32x4*)(xi + e2 * 4u + 16u); }
                else { const u32x4 h = *(const u32x4*)(xi + e2 * 2u); x0 = unpkh4(h.x, h.y); x1 = unpkh4(h.z, h.w); }
                const f32x4 xn0 = x0 + gv[bj][0] * acc[ai][bj][m][0], xn1 = x1 + gv[bj][1] * acc[ai][bj][m][1];
                if (outf32) { *(f32x4*)(xo + e2 * 4u) = xn0; *(f32x4*)(xo + e2 * 4u + 16u) = xn1; }
                else { u32x4 h; h.x = pkh2(xn0[0], xn0[1]); h.y = pkh2(xn0[2], xn0[3]); h.z = pkh2(xn1[0], xn1[1]); h.w = pkh2(xn1[2], xn1[3]); *(u32x4*)(xo + e2 * 2u) = h; }
                if (Aout) {
                    ss += ((xn0[0] * xn0[0] + xn0[1] * xn0[1]) + (xn0[2] * xn0[2] + xn0[3] * xn0[3])) + ((xn1[0] * xn1[0] + xn1[1] * xn1[1]) + (xn1[2] * xn1[2] + xn1[3] * xn1[3]));
                    const f32x4 a0 = xn0 * (*(const f32x4*)(nw + col0 + bj * HALF) * (*(const f32x4*)(sc + boff + bj * HALF) + 1.f));
                    const f32x4 a1 = xn1 * (*(const f32x4*)(nw + col0 + bj * HALF + 4) * (*(const f32x4*)(sc + boff + bj * HALF + 4) + 1.f));
                    u32x4 q; q.x = pk2(a0[0], a0[1]); q.y = pk2(a0[2], a0[3]); q.z = pk2(a1[0], a1[1]); q.w = pk2(a1[2], a1[3]);
                    *(u32x4*)(ao + e2 * 2u) = q;
                }
            }
            if (Aout) {
                ss += __shfl_xor(ss, 16); ss += __shfl_xor(ss, 32);
                if (fq == 0) atomicAdd(rowss + rowb + ai * HALF + m * 16, ss);
            }
            asm volatile("" ::: "memory");
        }
    }
};
struct EpiFfn {
    static constexpr bool PERM = true, AFTER_DRAIN = false;
    bf16_t* G; float* HP; float* HU; float* HA; const float* cw; const float* cb; const float* rowss; const float* bias;
    __device__ __forceinline__ void operator()(const f32x4 (&acc)[2][2][4][2], const Unit& u, int, int, int, int) const {
        const int t_ = otid_(), l_ = t_ & 63, fr = l_ & 15, fq = l_ >> 4, wid_ = __builtin_amdgcn_readfirstlane(t_ >> 6), wr = wid_ >> 2, wc = wid_ & 3;
        const int ch0 = u.pn * 128 + wc * 32 + 8 * fq;
        f32x4 w0[2], w1[2], w2[2], bb[2];
#pragma unroll
        for (int n = 0; n < 2; ++n) { w0[n] = *(const f32x4*)(cw + ch0 + 4 * n); w1[n] = *(const f32x4*)(cw + DFF_ + ch0 + 4 * n); w2[n] = *(const f32x4*)(cw + 2 * DFF_ + ch0 + 4 * n); bb[n] = *(const f32x4*)(cb + ch0 + 4 * n); }
        const int lane = fr + 16 * fq;
        const int src1 = (lane & ~15) | ((fr + 15) & 15), src2 = (lane & ~15) | ((fr + 14) & 15);
        const float* bp = bias + (size_t)((u.pm * BM) >> 12) * 5632 + u.pn * BM + wc * 32 + 8 * fq;
        f32x4 ba[2], bu[2];
#pragma unroll
        for (int n = 0; n < 2; ++n) { ba[n] = *(const f32x4*)(bp + 4 * n); bu[n] = *(const f32x4*)(bp + HALF + 4 * n); }
#pragma unroll
        for (int ai = 0; ai < 2; ++ai) {
            const int seg = u.pm * 4 + ai * 2 + wr;
            f32x4 aprev[2]; aprev[0] = (f32x4){0.f, 0.f, 0.f, 0.f}; aprev[1] = (f32x4){0.f, 0.f, 0.f, 0.f};
#pragma unroll
            for (int m = 0; m < 4; ++m) {
                const int row = u.pm * BM + ai * HALF + wr * 64 + m * 16 + fr;
                const float rs = rsqrtf(rowss[row] * (1.f / 1024.f) + 1e-6f);
                f32x4 val[2], acur[2];
#pragma unroll
                for (int n = 0; n < 2; ++n) {
                    const f32x4 a = acc[ai][0][m][n] * rs + ba[n];
                    acur[n] = a;
                    const f32x4 ap = aprev[n];
#pragma unroll
                    for (int e = 0; e < 4; ++e) {
                        const float t1 = (fr == 15) ? ap[e] : a[e];
                        const float t2 = (fr >= 14) ? ap[e] : a[e];
                        const float p1 = __shfl(t1, src1), p2 = __shfl(t2, src2);
                        val[n][e] = w2[n][e] * a[e] + w1[n][e] * p1 + w0[n][e] * p2 + bb[n][e];
                    }
                }
                const f32x4 u0 = acc[ai][1][m][0] * rs + bu[0], u1 = acc[ai][1][m][1] * rs + bu[1];
                f32x4 g0, g1;
#pragma unroll
                for (int e = 0; e < 4; ++e) { g0[e] = siluf_(val[0][e]) * u0[e]; g1[e] = siluf_(val[1][e]) * u1[e]; }
                u32x4 w; w.x = pk2(g0[0], g0[1]); w.y = pk2(g0[2], g0[3]); w.z = pk2(g1[0], g1[1]); w.w = pk2(g1[2], g1[3]);
                *(u32x4*)(G + (size_t)row * DFF_ + ch0) = w;
                if (m == 0 && fr < 2) {
                    const size_t ho = (size_t)(seg * 2 + fr) * DFF_ + ch0;
                    *(f32x4*)(HP + ho) = val[0]; *(f32x4*)(HP + ho + 4) = val[1];
                    *(f32x4*)(HU + ho) = u0; *(f32x4*)(HU + ho + 4) = u1;
                }
                if (m == 3 && fr >= 14) {
                    const size_t ho = (size_t)(seg * 2 + (fr - 14)) * DFF_ + ch0;
                    *(f32x4*)(HA + ho) = acur[0]; *(f32x4*)(HA + ho + 4) = acur[1];
                }
                aprev[0] = acur[0]; aprev[1] = acur[1];
                asm volatile("" ::: "memory");
            }
        }
    }
};
}

struct Ctx { Params p; unsigned char* lds; int tid, lane, wave, gw, ngw; };

__device__ __forceinline__ void phase_prologue(const Ctx& C) {
    const Params& p = C.p;
    float* cact = (float*)C.lds;
    float* red = (float*)(C.lds + 32768);
    float* mod = (float*)(p.ws + WS_MOD);
    const int tid = C.tid;
    for (int i = tid; i < 8192; i += NTHR) { const float c = p.c[i]; cact[i] = c / (1.f + __expf(-c)); }
    __syncthreads();
    const int col = tid & 63, kp = tid >> 6;
    for (int g = blockIdx.x; g < 384; g += gridDim.x) {
        const int l = g / 96, j = (g % 96) * 64 + col;
        const float* w = p.mod_w + (size_t)l * 1024 * 6144 + (size_t)(kp * 128) * 6144 + j;
        float a0 = 0.f, a1 = 0.f, a2 = 0.f, a3 = 0.f, a4 = 0.f, a5 = 0.f, a6 = 0.f, a7 = 0.f;
        const float* ca = cact + kp * 128;
#pragma unroll 8
        for (int k = 0; k < 128; ++k) {
            const float wv = w[(size_t)k * 6144];
            a0 += ca[k] * wv; a1 += ca[1024 + k] * wv; a2 += ca[2048 + k] * wv; a3 += ca[3072 + k] * wv;
            a4 += ca[4096 + k] * wv; a5 += ca[5120 + k] * wv; a6 += ca[6144 + k] * wv; a7 += ca[7168 + k] * wv;
        }
        float* r = red + (kp * 8) * 64 + col;
        r[0] = a0; r[64] = a1; r[128] = a2; r[192] = a3; r[256] = a4; r[320] = a5; r[384] = a6; r[448] = a7;
        __syncthreads();
        { const int b = tid >> 6; float s = 0.f;
#pragma unroll
          for (int kk = 0; kk < 8; ++kk) s += red[(kk * 8 + b) * 64 + col];
          mod[(size_t)(l * 8 + b) * 6144 + j] = s + p.mod_b[l * 6144 + j]; }
        __syncthreads();
    }
    {
        u32x4* zb = (u32x4*)(p.ws + WS_BIAS); const int nzb = 4 * BIAS_L * 4 / 16;
        for (int i = blockIdx.x * NTHR + tid; i < nzb; i += gridDim.x * NTHR) zb[i] = (u32x4){0u, 0u, 0u, 0u};
        u32x4* zr = (u32x4*)(p.ws + WS_ROWSS);
        for (int i = blockIdx.x * NTHR + tid; i < 8 * T_ * 4 / 16; i += gridDim.x * NTHR) zr[i] = (u32x4){0u, 0u, 0u, 0u};
    }
    float* cs = (float*)(p.ws + WS_COS); float* sn = (float*)(p.ws + WS_SIN);
    const float invf[8] = {1.0f, 0.1939227432012558f, 0.03760603070259094f, 0.007292664609849453f, 0.0014142135623842478f, 0.00027424818836152554f, 5.3182957344688475e-05f, 1.0313385246263351e-05f};
    for (int r = blockIdx.x * NTHR + tid; r < T_; r += gridDim.x * NTHR) {
        const float pos = (float)p.positions[r];
        f32x4 c4[2], s4[2];
#pragma unroll
        for (int i = 0; i < 8; ++i) {
            const float ang = pos * invf[i];
            const double xr = (double)ang * 0.15915494309189535;
            const float f = (float)(xr - rint(xr));
            c4[i >> 2][i & 3] = __builtin_amdgcn_cosf(f); s4[i >> 2][i & 3] = __builtin_amdgcn_sinf(f);
        }
        *(f32x4*)(cs + (size_t)r * 8) = c4[0]; *(f32x4*)(cs + (size_t)r * 8 + 4) = c4[1];
        *(f32x4*)(sn + (size_t)r * 8) = s4[0]; *(f32x4*)(sn + (size_t)r * 8 + 4) = s4[1];
    }
}

__device__ __forceinline__ void tr_item(const float* W, int Nsrc, int srccol0, bf16_t* WT, int K, int dstrow0, int k0, float* scr, int lane) {
    float wv[32];
#pragma unroll
    for (int i = 0; i < 32; ++i) wv[i] = W[(size_t)(k0 + 2 * i + (lane >> 5)) * Nsrc + srccol0 + (lane & 31)];
#pragma unroll
    for (int i = 0; i < 32; ++i) scr[(2 * i + (lane >> 5)) * 33 + (lane & 31)] = wv[i];
    asm volatile("s_waitcnt lgkmcnt(0)" ::: "memory");
    const int c = lane & 7;
#pragma unroll
    for (int j = 0; j < 4; ++j) { const int n = (lane >> 3) + 8 * j; const float* s = scr + (8 * c) * 33 + n;
        u32x4 o; o.x = pk2(s[0 * 33], s[1 * 33]); o.y = pk2(s[2 * 33], s[3 * 33]); o.z = pk2(s[4 * 33], s[5 * 33]); o.w = pk2(s[6 * 33], s[7 * 33]);
        *(u32x4*)(WT + (size_t)(dstrow0 + n) * K + k0 + 8 * c) = o; }
    asm volatile("s_waitcnt lgkmcnt(0)" ::: "memory");
}
__device__ __forceinline__ void phase_convert(const Ctx& C, int l, bool do_bias = true) {
    const Params& p = C.p; const int j = l >> 1; const bool even = !(l & 1);
    float* scr = (float*)(C.lds + C.wave * 8704);
    bf16_t* WIN = (bf16_t*)(p.ws + WS_WIN); bf16_t* WOUT = (bf16_t*)(p.ws + WS_WOUT); bf16_t* FIN = (bf16_t*)(p.ws + WS_FIN); bf16_t* FOUT = (bf16_t*)(p.ws + ((l & 1) ? WS_FOUT2 : WS_FOUT));
    const int nA = even ? 80 : 112;
    const int IA = 16 * nA, IB = 16 * 32, IC = 16 * 176, ID = 44 * 32;
    const float* win = even ? p.ev_w_in + (size_t)j * 1024 * 2320 : p.od_w_in + (size_t)j * 1024 * 3584;
    const float* wout = even ? p.ev_w_out + (size_t)j * 1024 * 1024 : p.od_w_out + (size_t)j * 1024 * 1024;
    const float* fin = p.ffn_w_in + (size_t)l * 1024 * 5632; const float* fout = p.ffn_w_out + (size_t)l * 2816 * 1024;
    for (int it = C.gw; it < IA + IB + IC + ID; it += C.ngw) {
        int r = it;
        if (r < IA) { const int kb = r / nA, nb = r % nA, n0 = nb * 32; int sc = n0;
            if (even) { if (n0 >= 512 && n0 < 768) continue; if (n0 >= 1792) sc = n0 - 240; else if (n0 >= 768) sc = n0 - 256; }
            tr_item(win, even ? 2320 : 3584, sc, WIN, 1024, n0, kb * 64, scr, C.lane); continue; }
        r -= IA;
        if (r < IB) { const int kb = r / 32, nb = r % 32; tr_item(wout, 1024, nb * 32, WOUT, 1024, nb * 32, kb * 64, scr, C.lane); continue; }
        r -= IB;
        if (r < IC) { const int kb = r / 176, nb = r % 176, n0 = nb * 32; const int pn = n0 >> 8, jj = n0 & 255;
            const int sc = (jj < 128) ? pn * 128 + jj : 2816 + pn * 128 + (jj - 128);
            tr_item(fin, 5632, sc, FIN, 1024, n0, kb * 64, scr, C.lane); continue; }
        r -= IC;
        { const int kb = r / 32, nb = r % 32; tr_item(fout, 1024, nb * 32, FOUT, 2816, nb * 32, kb * 64, scr, C.lane); }
    }
    if (do_bias) {
        float* shl = (float*)(C.lds + 69632);
        const float* modl = (const float*)(p.ws + WS_MOD) + (size_t)l * 8 * 6144;
        __syncthreads();
        for (int i2 = C.tid; i2 < 2 * 8192; i2 += NTHR) { const int which = i2 >> 13, k = (i2 >> 3) & 1023, b = i2 & 7; shl[i2] = modl[(size_t)b * 6144 + (which ? 3072 : 0) + k]; }
        __syncthreads();
        float* bias_in = (float*)(p.ws + WS_BIAS) + (size_t)l * BIAS_L; float* bias_ff = bias_in + 8 * 3584;
        const int Nin = even ? 2560 : 3584, Nsrc = even ? 2320 : 3584;
        const float* gwp = p.gla_gate_w + (size_t)j * 16 * 256;
        for (int u = blockIdx.x * NTHR + C.tid; u < (Nin + 5632) * 16; u += gridDim.x * NTHR) {
            const bool ff = u >= Nin * 16; const int uu = ff ? u - Nin * 16 : u, N = ff ? 5632 : Nin, n = uu % N, kp = uu / N;
            float a[8];
#pragma unroll
            for (int b = 0; b < 8; ++b) a[b] = 0.f;
            const float* shp = shl + (ff ? 8192 : 0) + kp * 64 * 8;
            if (!ff && even && n >= 512 && n < 768) {
                float g[16];
#pragma unroll
                for (int r = 0; r < 16; ++r) g[r] = gwp[r * 256 + (n - 512)];
                for (int k = 0; k < 64; ++k) {
                    const float* wr = win + (size_t)(kp * 64 + k) * 2320 + 1536;
                    float wv = 0.f;
#pragma unroll
                    for (int r = 0; r < 16; ++r) wv += wr[r] * g[r];
                    const f32x4 s0 = *(const f32x4*)(shp + k * 8), s1 = *(const f32x4*)(shp + k * 8 + 4);
                    a[0] += s0[0] * wv; a[1] += s0[1] * wv; a[2] += s0[2] * wv; a[3] += s0[3] * wv; a[4] += s1[0] * wv; a[5] += s1[1] * wv; a[6] += s1[2] * wv; a[7] += s1[3] * wv;
                }
            } else {
                int sc; const float* W; int Ns;
                if (ff) { const int pn = n >> 8, jj = n & 255; sc = (jj < 128) ? pn * 128 + jj : 2816 + pn * 128 + (jj - 128); W = fin; Ns = 5632; }
                else { sc = n; if (even) { if (n >= 1792) sc = n - 240; else if (n >= 768) sc = n - 256; } W = win; Ns = Nsrc; }
                const float* wp = W + (size_t)(kp * 64) * Ns + sc;
#pragma unroll 8
                for (int k = 0; k < 64; ++k) {
                    const float wv = wp[(size_t)k * Ns];
                    const f32x4 s0 = *(const f32x4*)(shp + k * 8), s1 = *(const f32x4*)(shp + k * 8 + 4);
                    a[0] += s0[0] * wv; a[1] += s0[1] * wv; a[2] += s0[2] * wv; a[3] += s0[3] * wv; a[4] += s1[0] * wv; a[5] += s1[1] * wv; a[6] += s1[2] * wv; a[7] += s1[3] * wv;
                }
            }
            float* bo = (ff ? bias_ff : bias_in) + n;
#pragma unroll
            for (int b = 0; b < 8; ++b) atomicAdd(bo + (size_t)b * N, a[b]);
        }
    }
    if (even) {
        const float* gw = p.gla_gate_w + (size_t)j * 16 * 256;
        for (int u = blockIdx.x * NTHR + C.tid; u < 256 * 128; u += gridDim.x * NTHR) {
            const int k8 = u & 127, n = u >> 7;
            float g[16];
#pragma unroll
            for (int r = 0; r < 16; ++r) g[r] = gw[r * 256 + n];
            float o[8];
#pragma unroll
            for (int e = 0; e < 8; ++e) {
                const float* wr = win + (size_t)(k8 * 8 + e) * 2320 + 1536;
                const f32x4 a0 = *(const f32x4*)wr, a1 = *(const f32x4*)(wr + 4), a2 = *(const f32x4*)(wr + 8), a3 = *(const f32x4*)(wr + 12);
                o[e] = a0[0] * g[0] + a0[1] * g[1] + a0[2] * g[2] + a0[3] * g[3] + a1[0] * g[4] + a1[1] * g[5] + a1[2] * g[6] + a1[3] * g[7]
                     + a2[0] * g[8] + a2[1] * g[9] + a2[2] * g[10] + a2[3] * g[11] + a3[0] * g[12] + a3[1] * g[13] + a3[2] * g[14] + a3[3] * g[15];
            }
            u32x4 w; w.x = pk2(o[0], o[1]); w.y = pk2(o[2], o[3]); w.z = pk2(o[4], o[5]); w.w = pk2(o[6], o[7]);
            *(u32x4*)(WIN + (size_t)(512 + n) * 1024 + k8 * 8) = w;
        }
    }
}

__device__ __forceinline__ void phase_prep(const Ctx& C, const float* xin, const float* w, const float* modl, int scoff, bf16_t* out, float* rowss) {
    for (int row = C.gw; row < T_; row += C.ngw) {
        const f32x4* xr = (const f32x4*)(xin + (size_t)row * 1024) + C.lane;
        f32x4 v[4]; float ss = 0.f;
#pragma unroll
        for (int j = 0; j < 4; ++j) { v[j] = xr[64 * j]; ss += (v[j].x * v[j].x + v[j].y * v[j].y) + (v[j].z * v[j].z + v[j].w * v[j].w); }
        ss = wave_sum(ss);
        if (C.lane == 0) rowss[row] = ss;
        const float* mb = modl + (size_t)(row >> 12) * 6144;
        u32x2* o8 = (u32x2*)(out + (size_t)row * 1024) + C.lane;
#pragma unroll
        for (int j = 0; j < 4; ++j) {
            const int col = 4 * C.lane + 256 * j;
            const f32x4 w4 = *(const f32x4*)(w + col), sc = *(const f32x4*)(mb + scoff + col);
            const f32x4 y = v[j] * w4 * (sc + 1.f);
            u32x2 q; q.x = pk2(y.x, y.y); q.y = pk2(y.z, y.w); o8[64 * j] = q;
        }
    }
}
__device__ __forceinline__ void phase_final_norm(const Ctx& C, const float* xin, float* out, const float* w) {
    for (int row = C.gw; row < T_; row += C.ngw) {
        const f32x4* xr = (const f32x4*)(xin + (size_t)row * 1024) + C.lane;
        f32x4* orow = (f32x4*)(out + (size_t)row * 1024) + C.lane;
        f32x4 v[4]; float ss = 0.f;
#pragma unroll
        for (int j = 0; j < 4; ++j) { v[j] = xr[64 * j]; ss += (v[j].x * v[j].x + v[j].y * v[j].y) + (v[j].z * v[j].z + v[j].w * v[j].w); }
        const float rs = rsqrtf(wave_sum(ss) * (1.f / 1024.f) + 1e-6f);
#pragma unroll
        for (int j = 0; j < 4; ++j) { const f32x4 w4 = *(const f32x4*)(w + 4 * C.lane + 256 * j); orow[64 * j] = (v[j] * rs) * w4; }
    }
}

__device__ __forceinline__ void phase_diff_combine(const Ctx& C, int l) {
    const Params& p = C.p; const int j = l >> 1;
    const float lam_init = 0.8f - 0.6f * expf(-0.3f * (float)l);
    const float* lv = p.diff_lambda + j * 256;
    const float s1 = wave_sum(lv[C.lane] * lv[64 + C.lane]), s2 = wave_sum(lv[128 + C.lane] * lv[192 + C.lane]);
    const float lam = expf(s1) - expf(s2) + lam_init;
    const bf16_t* X2 = (const bf16_t*)(p.ws + WS_X2); bf16_t* A = (bf16_t*)(p.ws + WS_A);
    const int head = C.lane >> 4, d0 = (C.lane & 15) * 8;
    const float* nw = p.diff_norm_w + j * 128 + d0;
    const f32x4 n0 = *(const f32x4*)nw, n1 = *(const f32x4*)(nw + 4);
    const float og = 1.f - lam_init;
    for (int row = C.gw; row < T_; row += C.ngw) {
        const bf16_t* src = X2 + (size_t)row * 1024 + head * 256 + d0;
        const u32x4 a = *(const u32x4*)src, b = *(const u32x4*)(src + 128);
        float od[8];
        od[0] = bflo(a.x) - lam * bflo(b.x); od[1] = bfhi(a.x) - lam * bfhi(b.x); od[2] = bflo(a.y) - lam * bflo(b.y); od[3] = bfhi(a.y) - lam * bfhi(b.y);
        od[4] = bflo(a.z) - lam * bflo(b.z); od[5] = bfhi(a.z) - lam * bfhi(b.z); od[6] = bflo(a.w) - lam * bflo(b.w); od[7] = bfhi(a.w) - lam * bfhi(b.w);
        float ss = 0.f;
#pragma unroll
        for (int e = 0; e < 8; ++e) ss += od[e] * od[e];
        ss += __shfl_xor(ss, 1); ss += __shfl_xor(ss, 2); ss += __shfl_xor(ss, 4); ss += __shfl_xor(ss, 8);
        const float rs = rsqrtf(ss * (1.f / 128.f) + 1e-6f) * og;
        u32x4 w; w.x = pk2(od[0] * rs * n0[0], od[1] * rs * n0[1]); w.y = pk2(od[2] * rs * n0[2], od[3] * rs * n0[3]);
        w.z = pk2(od[4] * rs * n1[0], od[5] * rs * n1[1]); w.w = pk2(od[6] * rs * n1[2], od[7] * rs * n1[3]);
        *(u32x4*)(A + (size_t)row * 1024 + head * 128 + d0) = w;
    }
}

__device__ __forceinline__ void phase_ffn_fixup(const Ctx& C, int l) {
    const Params& p = C.p;
    const float* HP = (const float*)(p.ws + WS_HP); const float* HU = (const float*)(p.ws + WS_HU); const float* HA = (const float*)(p.ws + WS_HA);
    bf16_t* G = (bf16_t*)(p.ws + WS_R1);
    const float* cw = p.ffn_conv_w + (size_t)l * 3 * DFF_;
    for (int u = blockIdx.x * NTHR + C.tid; u < 512 * 2 * 704; u += gridDim.x * NTHR) {
        const int c4 = u % 704, sj = u / 704, jj = sj & 1, seg = sj >> 1, ch = c4 * 4;
        const size_t ho = (size_t)sj * DFF_ + ch;
        f32x4 val = *(const f32x4*)(HP + ho); const f32x4 uu = *(const f32x4*)(HU + ho);
        if ((seg & 63) != 0) {
            const f32x4 am1 = *(const f32x4*)(HA + (size_t)((seg - 1) * 2 + 1) * DFF_ + ch), am2 = *(const f32x4*)(HA + (size_t)((seg - 1) * 2) * DFF_ + ch);
            const f32x4 w0 = *(const f32x4*)(cw + ch), w1 = *(const f32x4*)(cw + DFF_ + ch);
            if (jj == 0) val = val + w1 * am1 + w0 * am2; else val = val + w0 * am1;
        }
        u32x2 q; q.x = pk2(siluf_(val.x) * uu.x, siluf_(val.y) * uu.y); q.y = pk2(siluf_(val.z) * uu.z, siluf_(val.w) * uu.w);
        *(u32x2*)(G + (size_t)(seg * 64 + jj) * DFF_ + ch) = q;
    }
}

__device__ __forceinline__ void phase_swa(const Ctx& C, int l) {
    const Params& p = C.p;
    const bf16_t* proj = (const bf16_t*)(p.ws + WS_R1); bf16_t* A = (bf16_t*)(p.ws + WS_A);
    bf16_t* Ks = (bf16_t*)C.lds;
    bf16_t* Vt = (bf16_t*)(C.lds + 27648);
    const int tid = C.tid, lane = C.lane, wid = C.wave, r32 = lane & 31, hi = lane >> 5;
    const float* sinks = p.swa_sinks + (l >> 1) * 8;
    u32x4 kreg[3], vreg[3];
#define SWA_FETCH(uu) do { const int b_ = (uu) >> 7, kvh_ = ((uu) >> 6) & 1, q0_ = ((uu) & 63) * 64; const size_t rb_ = (size_t)b_ * SEQ_; \
        _Pragma("unroll") for (int i_ = 0; i_ < 3; ++i_) { const int c_ = tid + i_ * NTHR; \
            { const int kk_ = c_ >> 3, ch_ = c_ & 7, pl_ = q0_ - 128 + kk_; kreg[i_] = (u32x4){0u, 0u, 0u, 0u}; if (pl_ >= 0) kreg[i_] = *(const u32x4*)(proj + (rb_ + pl_) * 2560 + 2304 + kvh_ * 64 + ch_ * 8); } \
            { const int kk_ = c_ % 192, ch_ = c_ / 192, pl_ = q0_ - 128 + kk_; vreg[i_] = (u32x4){0u, 0u, 0u, 0u}; if (pl_ >= 0) vreg[i_] = *(const u32x4*)(proj + (rb_ + pl_) * 2560 + 2432 + kvh_ * 64 + ch_ * 8); } } } while (0)
    if ((int)blockIdx.x < 1024) SWA_FETCH((int)blockIdx.x);
    for (int u = blockIdx.x; u < 1024; u += gridDim.x) {
        const int b = u >> 7, kvh = (u >> 6) & 1, qb = u & 63, q0 = qb * 64; const size_t rowbase = (size_t)b * SEQ_;
#pragma unroll
        for (int i = 0; i < 3; ++i) {
            const int c = tid + i * NTHR;
            { const int kk = c >> 3, ch = c & 7; *(u32x4*)(Ks + kk * 72 + ch * 8) = kreg[i]; }
            { const int kk = c % 192, ch = c / 192; const u32x4 vv = vreg[i];
              bf16_t* vd = Vt + (ch * 8) * 200 + kk;
              vd[0] = (bf16_t)(vv.x & 0xffffu); vd[200] = (bf16_t)(vv.x >> 16); vd[400] = (bf16_t)(vv.y & 0xffffu); vd[600] = (bf16_t)(vv.y >> 16);
              vd[800] = (bf16_t)(vv.z & 0xffffu); vd[1000] = (bf16_t)(vv.z >> 16); vd[1200] = (bf16_t)(vv.w & 0xffffu); vd[1400] = (bf16_t)(vv.w >> 16); }
        }
        { const int nx = u + (int)gridDim.x; if (nx < 1024) SWA_FETCH(nx); }
        __syncthreads();
        const int g = wid >> 1, qh = kvh * 4 + g, qhalf = wid & 1, pq = q0 + 32 * qhalf + r32;
        const bf16_t* qsrc = proj + (rowbase + pq) * 2560 + 1792 + qh * 64;
        bf16x8 qr[4];
#pragma unroll
        for (int d0 = 0; d0 < 4; ++d0) qr[d0] = *(const bf16x8*)(qsrc + d0 * 16 + hi * 8);
        f32x16 s[5];
#pragma unroll
        for (int t = 0; t < 5; ++t) {
            f32x16 a = {};
#pragma unroll
            for (int d0 = 0; d0 < 4; ++d0) {
                const bf16x8 kf = *(const bf16x8*)(Ks + (32 * (qhalf + t) + r32) * 72 + d0 * 16 + hi * 8);
                a = __builtin_amdgcn_mfma_f32_32x32x16_bf16(kf, qr[d0], a, 0, 0, 0);
            }
            s[t] = a;
        }
        const float sink2 = sinks[qh] * LOG2E_;
        float mx = sink2;
#pragma unroll
        for (int t = 0; t < 5; ++t)
#pragma unroll
            for (int r = 0; r < 16; ++r) {
                const int pk = q0 - 128 + 32 * (qhalf + t) + crow_(r, hi);
                const bool valid = (pk >= 0) && (pk <= pq) && (pq - pk < 128);
                const float v = valid ? s[t][r] : -INFINITY; s[t][r] = v; mx = fmaxf(mx, v);
            }
        mx = fmaxf(mx, __shfl_xor(mx, 32));
        float sum = 0.f;
#pragma unroll
        for (int t = 0; t < 5; ++t)
#pragma unroll
            for (int r = 0; r < 16; ++r) { const float e = __builtin_amdgcn_exp2f(s[t][r] - mx); s[t][r] = e; sum += e; }
        sum += __shfl_xor(sum, 32);
        sum += __builtin_amdgcn_exp2f(sink2 - mx);
        const float inv = 1.f / sum;
        f32x16 o[2]; o[0] = f32x16{}; o[1] = f32x16{};
#pragma unroll
        for (int t = 0; t < 5; ++t)
#pragma unroll
            for (int ss = 0; ss < 2; ++ss) {
                u32x4 pw; pw.x = pk2(s[t][8 * ss + 0], s[t][8 * ss + 1]); pw.y = pk2(s[t][8 * ss + 2], s[t][8 * ss + 3]); pw.z = pk2(s[t][8 * ss + 4], s[t][8 * ss + 5]); pw.w = pk2(s[t][8 * ss + 6], s[t][8 * ss + 7]);
                const bf16x8 pf = __builtin_bit_cast(bf16x8, pw);
#pragma unroll
                for (int dt = 0; dt < 2; ++dt) {
                    const bf16_t* vp = Vt + (32 * dt + r32) * 200 + 32 * (qhalf + t) + 16 * ss + 4 * hi;
                    const u32x2 lo = *(const u32x2*)vp, h2 = *(const u32x2*)(vp + 8);
                    u32x4 vw; vw.x = lo.x; vw.y = lo.y; vw.z = h2.x; vw.w = h2.y;
                    o[dt] = __builtin_amdgcn_mfma_f32_32x32x16_bf16(__builtin_bit_cast(bf16x8, vw), pf, o[dt], 0, 0, 0);
                }
            }
        bf16_t* orow = A + (rowbase + pq) * 1024 + 512 + qh * 64;
#pragma unroll
        for (int dt = 0; dt < 2; ++dt)
#pragma unroll
            for (int g4 = 0; g4 < 4; ++g4) {
                u32x2 q; q.x = pk2(o[dt][4 * g4] * inv, o[dt][4 * g4 + 1] * inv); q.y = pk2(o[dt][4 * g4 + 2] * inv, o[dt][4 * g4 + 3] * inv);
                *(u32x2*)(orow + 32 * dt + 8 * g4 + 4 * hi) = q;
            }
        __syncthreads();
    }
}

template <int MODE> struct LaCfg {
    static constexpr int DK = MODE ? 128 : 64, LQ = DK + 8, LG = DK + 4, PITCH = MODE ? 3584 : 2560, NG = DK / 8;
    static constexpr int QCOL = MODE ? 1536 : 0, KCOL = MODE ? 0 : 256, ZCOL = MODE ? 2048 : 512, VCOL = MODE ? 2560 : 768, GCOL = MODE ? 3072 : 1280, OCOL = MODE ? 512 : 0;
    static constexpr int O_QB = 0, O_KB = O_QB + 64 * LQ * 2, O_GF = O_KB + 64 * LQ * 2, O_VT = O_GF + 64 * LG * 4, O_SC = O_VT + 128 * 72 * 2, O_QE = O_SC + 64 * 72 * 2,
                         O_KT = O_QE + 64 * LQ * 2  , O_SEG = O_KT + DK * 72 * 2, O_RED = O_SEG + 8 * 128 * 4, O_PAR = O_RED + 8 * 64 * 4, O_END = O_PAR + 128 * 4;
    static_assert(O_END <= LDS_BYTES, "LA LDS map");
};
__device__ __forceinline__ void unpack8(const u32x4 w, float (&f)[8]) { f[0] = bflo(w.x); f[1] = bfhi(w.x); f[2] = bflo(w.y); f[3] = bfhi(w.y); f[4] = bflo(w.z); f[5] = bfhi(w.z); f[6] = bflo(w.w); f[7] = bfhi(w.w); }
__device__ __forceinline__ u32x4 pack8(const float (&f)[8]) { u32x4 w; w.x = pk2(f[0], f[1]); w.y = pk2(f[2], f[3]); w.z = pk2(f[4], f[5]); w.w = pk2(f[6], f[7]); return w; }
__device__ __forceinline__ void ld8f(const float* p, float (&f)[8]) { const f32x4 a = *(const f32x4*)p, b = *(const f32x4*)(p + 4); f[0] = a[0]; f[1] = a[1]; f[2] = a[2]; f[3] = a[3]; f[4] = b[0]; f[5] = b[1]; f[6] = b[2]; f[7] = b[3]; }

template <int MODE> struct LaRaw { static constexpr int NI = 64 * LaCfg<MODE>::NG / NTHR; u32x4 z[NI], k[NI], q[NI], v[2]; };
template <int MODE, bool NEEDQ> __device__ __forceinline__ void la_fetch(const Ctx& C, int b, int h, int c, LaRaw<MODE>& R) {
    typedef LaCfg<MODE> Cf; const bf16_t* proj = (const bf16_t*)(C.p.ws + WS_R1);
    const size_t row0 = (size_t)b * SEQ_ + (size_t)c * 64;
#pragma unroll
    for (int it = 0; it < LaRaw<MODE>::NI; ++it) {
        const int u = C.tid + it * NTHR, r = u / Cf::NG, kk = (u % Cf::NG) * 8;
        const bf16_t* rp = proj + (row0 + r) * Cf::PITCH + h * Cf::DK + kk;
        R.z[it] = *(const u32x4*)(rp + Cf::ZCOL);
        if (MODE == 0) R.k[it] = *(const u32x4*)(rp + Cf::KCOL);
        if (NEEDQ) R.q[it] = *(const u32x4*)(rp + Cf::QCOL);
    }
#pragma unroll
    for (int it = 0; it < 2; ++it) {
        const int u = C.tid + it * NTHR, r = u & 63, g8 = u >> 6;
        R.v[it] = *(const u32x4*)(proj + (row0 + r) * Cf::PITCH + Cf::VCOL + h * 128 + g8 * 8);
    }
}
template <int MODE, bool NEEDQ> __device__ __forceinline__ void la_store(const Ctx& C, const LaRaw<MODE>& R, const float* par, bf16_t* Qb, bf16_t* Kb, float* Gf, bf16_t* Vt) {
    typedef LaCfg<MODE> Cf;
#pragma unroll
    for (int it = 0; it < LaRaw<MODE>::NI; ++it) {
        const int u = C.tid + it * NTHR, r = u / Cf::NG, kk = (u % Cf::NG) * 8;
        float z[8], kv[8], lg[8], pc[8];
        unpack8(R.z[it], z); ld8f(par + kk, pc);
        if (MODE == 0) {
            unpack8(R.k[it], kv);
#pragma unroll
            for (int e = 0; e < 8; ++e) { const float x = z[e] + pc[e]; lg[e] = (fminf(x, 0.f) * LOG2E_ - __log2f(1.f + __expf(-fabsf(x)))) * (1.f / 16.f); }
        } else {
#pragma unroll
            for (int e = 0; e < 8; ++e) {
                const float zz = fminf(fmaxf(z[e], -60.f), 60.f), ez = __expf(-zz), sg = __builtin_amdgcn_rcpf(1.f + ez), lb = pc[e];
                lg[e] = __log2f(lb + (1.f - lb) * sg); kv[e] = (1.f - lb) * (ez * sg);
            }
        }
        *(u32x4*)(Kb + r * Cf::LQ + kk) = pack8(kv);
        float* gd = Gf + r * Cf::LG + kk;
        *(f32x4*)gd = (f32x4){lg[0], lg[1], lg[2], lg[3]}; *(f32x4*)(gd + 4) = (f32x4){lg[4], lg[5], lg[6], lg[7]};
        if (NEEDQ) {
            float q[8]; unpack8(R.q[it], q);
#pragma unroll
            for (int e = 0; e < 8; ++e) q[e] = MODE ? siluf_(q[e]) * 0.08838834764831845f : q[e] * 0.125f;
            *(u32x4*)(Qb + r * Cf::LQ + kk) = pack8(q);
        }
    }
#pragma unroll
    for (int it = 0; it < 2; ++it) {
        const int u = C.tid + it * NTHR, r = u & 63, g8 = u >> 6;
        const u32x4 w = R.v[it];
        bf16_t* vd = Vt + (g8 * 8) * 72 + r;
        vd[0] = (bf16_t)(w.x & 0xffffu); vd[72] = (bf16_t)(w.x >> 16); vd[144] = (bf16_t)(w.y & 0xffffu); vd[216] = (bf16_t)(w.y >> 16);
        vd[288] = (bf16_t)(w.z & 0xffffu); vd[360] = (bf16_t)(w.z >> 16); vd[432] = (bf16_t)(w.w & 0xffffu); vd[504] = (bf16_t)(w.w >> 16);
    }
}
template <int MODE> __device__ __forceinline__ void la_params(const Ctx& C, int l, int h, float* par) {
    typedef LaCfg<MODE> Cf; const int j = l >> 1;
    if (C.tid < Cf::DK) {
        if (MODE == 0) par[C.tid] = C.p.gla_gate_b[j * 256 + h * 64 + C.tid];
        else { const float* lg0 = C.p.hgrn_lb_logits + h * 128 + C.tid; par[C.tid] = (j == 0) ? 0.f : sigmoidf_(lg0[512] - lg0[0]); }
    }
}
template <int MODE> __device__ __forceinline__ void la_cumsum(const Ctx& C, float* Gf, float* segs) {
    typedef LaCfg<MODE> Cf; constexpr int DK = Cf::DK, NSEG = NTHR / DK, RPS = 64 / NSEG;
    const int k = C.tid % DK, seg = C.tid / DK;
    float v[RPS];
#pragma unroll
    for (int i = 0; i < RPS; ++i) v[i] = Gf[(seg * RPS + i) * Cf::LG + k];
#pragma unroll
    for (int i = 1; i < RPS; ++i) v[i] += v[i - 1];
    segs[seg * DK + k] = v[RPS - 1];
    __syncthreads();
    float off = 0.f;
#pragma unroll
    for (int s = 0; s < NSEG; ++s) { const float t = segs[s * DK + k]; off += (s < seg) ? t : 0.f; }
#pragma unroll
    for (int i = 0; i < RPS; ++i) Gf[(seg * RPS + i) * Cf::LG + k] = v[i] + off;
}

template <int MODE> __device__ __forceinline__ void phase_la_p1(const Ctx& C, int l) {
    typedef LaCfg<MODE> Cf; const Params& p = C.p; constexpr int DK = Cf::DK, LQ = Cf::LQ, LG = Cf::LG, NG = Cf::NG;
    bf16_t* Kb = (bf16_t*)(C.lds + Cf::O_KB); float* Gf = (float*)(C.lds + Cf::O_GF); bf16_t* Vt = (bf16_t*)(C.lds + Cf::O_VT);
    bf16_t* KhT = (bf16_t*)(C.lds + Cf::O_KT); float* segs = (float*)(C.lds + Cf::O_SEG);
    bf16_t* ST = (bf16_t*)(p.ws + WS_ST); float* TOT = (float*)(p.ws + WS_TOT);
    const int r16 = C.lane & 15, g = C.lane >> 4, w = C.wave;
    float* par = (float*)(C.lds + Cf::O_PAR);
    LaRaw<MODE> R; int hcur = -1;
    if ((int)blockIdx.x < 2048) la_fetch<MODE, false>(C, (int)blockIdx.x >> 8, ((int)blockIdx.x >> 6) & 3, (int)blockIdx.x & 63, R);
    for (int it = blockIdx.x; it < 2048; it += gridDim.x) {
        const int bh = it >> 6, c = it & 63, b = bh >> 2, h = bh & 3;
        if (h != hcur) { la_params<MODE>(C, l, h, par); hcur = h; __syncthreads(); }
        la_store<MODE, false>(C, R, par, nullptr, Kb, Gf, Vt);
        { const int nx = it + (int)gridDim.x; if (nx < 2048) la_fetch<MODE, false>(C, nx >> 8, (nx >> 6) & 3, nx & 63, R); }
        __syncthreads();
        la_cumsum<MODE>(C, Gf, segs);
        __syncthreads();
        for (int u = C.tid; u < 64 * NG; u += NTHR) {
            const int r = u & 63, kk = (u >> 6) * 8;
            float kv[8], gj[8], gt[8];
            unpack8(*(const u32x4*)(Kb + r * LQ + kk), kv); ld8f(Gf + r * LG + kk, gj); ld8f(Gf + 63 * LG + kk, gt);
            bf16_t* kd = KhT + kk * 72 + r;
#pragma unroll
            for (int e = 0; e < 8; e += 2) { const unsigned pw = pk2(kv[e] * __builtin_amdgcn_exp2f(gt[e] - gj[e]), kv[e + 1] * __builtin_amdgcn_exp2f(gt[e + 1] - gj[e + 1]));
                kd[e * 72] = (bf16_t)(pw & 0xffffu); kd[(e + 1) * 72] = (bf16_t)(pw >> 16); }
        }
        if (C.tid < DK) TOT[(size_t)it * 128 + C.tid] = Gf[63 * LG + C.tid];
        __syncthreads();
        {
            const bf16x8 b0 = *(const bf16x8*)(Vt + (16 * w + r16) * 72 + 8 * g), b1 = *(const bf16x8*)(Vt + (16 * w + r16) * 72 + 32 + 8 * g);
            bf16_t* so = ST + (size_t)it * DK * 128 + (size_t)(16 * w + r16) * DK + 4 * g;
#pragma unroll
            for (int mt = 0; mt < DK / 16; ++mt) {
                const bf16x8 a0 = *(const bf16x8*)(KhT + (16 * mt + r16) * 72 + 8 * g), a1 = *(const bf16x8*)(KhT + (16 * mt + r16) * 72 + 32 + 8 * g);
                f32x4 acc = (f32x4){0.f, 0.f, 0.f, 0.f};
                acc = __builtin_amdgcn_mfma_f32_16x16x32_bf16(a0, b0, acc, 0, 0, 0);
                acc = __builtin_amdgcn_mfma_f32_16x16x32_bf16(a1, b1, acc, 0, 0, 0);
                u32x2 q; q.x = pk2(acc[0], acc[1]); q.y = pk2(acc[2], acc[3]);
                *(u32x2*)(so + 16 * mt) = q;
            }
        }
        __syncthreads();
    }
}

template <int MODE> __device__ __forceinline__ void phase_la_p2(const Ctx& C) {
    typedef LaCfg<MODE> Cf; const Params& p = C.p; constexpr int DK = Cf::DK, NQ = DK / 4;
    bf16_t* ST = (bf16_t*)(p.ws + WS_ST); const float* TOT = (const float*)(p.ws + WS_TOT);
    for (int u = blockIdx.x * NTHR + C.tid; u < 32 * 128 * NQ; u += gridDim.x * NTHR) {
        const int k4 = u % NQ, v = (u / NQ) & 127, bh = u / (NQ * 128);
        float S0 = 0.f, S1 = 0.f, S2 = 0.f, S3 = 0.f;
        bf16_t* base = ST + (size_t)bh * 64 * DK * 128 + (size_t)v * DK + k4 * 4;
        const float* tb = TOT + (size_t)bh * 64 * 128 + k4 * 4;
#pragma unroll 8
        for (int c = 0; c < 64; ++c) {
            u32x2* ptr = (u32x2*)(base + (size_t)c * DK * 128);
            const u32x2 w = *ptr; const f32x4 dc = *(const f32x4*)(tb + c * 128);
            u32x2 o; o.x = pk2(S0, S1); o.y = pk2(S2, S3);
            *ptr = o;
            S0 = S0 * __builtin_amdgcn_exp2f(dc[0]) + bflo(w.x); S1 = S1 * __builtin_amdgcn_exp2f(dc[1]) + bfhi(w.x);
            S2 = S2 * __builtin_amdgcn_exp2f(dc[2]) + bflo(w.y); S3 = S3 * __builtin_amdgcn_exp2f(dc[3]) + bfhi(w.y);
        }
    }
}

template <int MODE> __device__ __forceinline__ void phase_la_p3(const Ctx& C, int l) {
    typedef LaCfg<MODE> Cf; const Params& p = C.p; constexpr int DK = Cf::DK, LQ = Cf::LQ, LG = Cf::LG, NG = Cf::NG, NKS = DK / 32;
    bf16_t* Qb = (bf16_t*)(C.lds + Cf::O_QB); bf16_t* Kb = (bf16_t*)(C.lds + Cf::O_KB); float* Gf = (float*)(C.lds + Cf::O_GF); bf16_t* Vt = (bf16_t*)(C.lds + Cf::O_VT);
    bf16_t* Sc = (bf16_t*)(C.lds + Cf::O_SC); bf16_t* Qe = (bf16_t*)(C.lds + Cf::O_QE); float* segs = (float*)(C.lds + Cf::O_SEG); float* red = (float*)(C.lds + Cf::O_RED);
    const bf16_t* ST = (const bf16_t*)(p.ws + WS_ST); const bf16_t* proj = (const bf16_t*)(p.ws + WS_R1); bf16_t* A = (bf16_t*)(p.ws + WS_A);
    const float* nw = (MODE ? p.hgrn_norm_w : p.gla_norm_w) + (l >> 1) * 128;
    const int r16 = C.lane & 15, g = C.lane >> 4, w = C.wave;
    const f32x4 nw4 = *(const f32x4*)(nw + 16 * w + 4 * g);
    float* par = (float*)(C.lds + Cf::O_PAR);
    LaRaw<MODE> R; int hcur = -1;
    if ((int)blockIdx.x < 2048) la_fetch<MODE, true>(C, (int)blockIdx.x >> 8, ((int)blockIdx.x >> 6) & 3, (int)blockIdx.x & 63, R);
    for (int it = blockIdx.x; it < 2048; it += gridDim.x) {
        const int bh = it >> 6, c = it & 63, b = bh >> 2, h = bh & 3;
        bf16x8 sfr[NKS];
        { const bf16_t* sp = ST + (size_t)it * DK * 128 + (size_t)(16 * w + r16) * DK + 8 * g;
#pragma unroll
          for (int ks = 0; ks < NKS; ++ks) sfr[ks] = *(const bf16x8*)(sp + 32 * ks); }
        if (h != hcur) { la_params<MODE>(C, l, h, par); hcur = h; __syncthreads(); }
        la_store<MODE, true>(C, R, par, Qb, Kb, Gf, Vt);
        { const int nx = it + (int)gridDim.x; if (nx < 2048) la_fetch<MODE, true>(C, nx >> 8, (nx >> 6) & 3, nx & 63, R); }
        for (int u = C.tid; u < 64 * 72 / 8; u += NTHR) *(u32x4*)(Sc + u * 8) = (u32x4){0u, 0u, 0u, 0u};
        u32x2 gwv[4];
#pragma unroll
        for (int nt = 0; nt < 4; ++nt) gwv[nt] = *(const u32x2*)(proj + ((size_t)b * SEQ_ + (size_t)c * 64 + 16 * nt + r16) * Cf::PITCH + Cf::GCOL + h * 128 + 16 * w + 4 * g);
        __syncthreads();
        la_cumsum<MODE>(C, Gf, segs);
        __syncthreads();
        for (int t = w; t < 10; t += 8) {
            const int I = (t >= 6) ? 3 : (t >= 3) ? 2 : (t >= 1) ? 1 : 0, J = t - I * (I + 1) / 2;
            f32x4 acc = (f32x4){0.f, 0.f, 0.f, 0.f};
#pragma unroll
            for (int ks = 0; ks < NKS; ++ks) {
                const int kc = 32 * ks + 8 * g;
                float gref[8], gj[8], gi[8], kv[8], qv[8];
                ld8f(Gf + (16 * J + 15) * LG + kc, gref); ld8f(Gf + (16 * J + r16) * LG + kc, gj); ld8f(Gf + (16 * I + r16) * LG + kc, gi);
                unpack8(*(const u32x4*)(Kb + (16 * J + r16) * LQ + kc), kv); unpack8(*(const u32x4*)(Qb + (16 * I + r16) * LQ + kc), qv);
#pragma unroll
                for (int e = 0; e < 8; ++e) { kv[e] *= __builtin_amdgcn_exp2f(gref[e] - gj[e]); qv[e] *= __builtin_amdgcn_exp2f(gi[e] - gref[e]); }
                acc = __builtin_amdgcn_mfma_f32_16x16x32_bf16(__builtin_bit_cast(bf16x8, pack8(kv)), __builtin_bit_cast(bf16x8, pack8(qv)), acc, 0, 0, 0);
            }
            if (I == J) {
#pragma unroll
                for (int e = 0; e < 4; ++e) if (4 * g + e > r16) acc[e] = 0.f;
            }
            u32x2 q; q.x = pk2(acc[0], acc[1]); q.y = pk2(acc[2], acc[3]);
            *(u32x2*)(Sc + (16 * I + r16) * 72 + 16 * J + 4 * g) = q;
        }
        for (int u = C.tid; u < 64 * NG; u += NTHR) {
            const int r = u / NG, kk = (u % NG) * 8;
            float qv[8], gi[8]; unpack8(*(const u32x4*)(Qb + r * LQ + kk), qv); ld8f(Gf + r * LG + kk, gi);
#pragma unroll
            for (int e = 0; e < 8; ++e) qv[e] *= __builtin_amdgcn_exp2f(gi[e]);
            *(u32x4*)(Qe + r * LQ + kk) = pack8(qv);
        }
        __syncthreads();
        f32x4 o[4];
        {
            const bf16x8 v0 = *(const bf16x8*)(Vt + (16 * w + r16) * 72 + 8 * g), v1 = *(const bf16x8*)(Vt + (16 * w + r16) * 72 + 32 + 8 * g);
#pragma unroll
            for (int nt = 0; nt < 4; ++nt) {
                f32x4 acc = (f32x4){0.f, 0.f, 0.f, 0.f};
                acc = __builtin_amdgcn_mfma_f32_16x16x32_bf16(v0, *(const bf16x8*)(Sc + (16 * nt + r16) * 72 + 8 * g), acc, 0, 0, 0);
                if (nt >= 2) acc = __builtin_amdgcn_mfma_f32_16x16x32_bf16(v1, *(const bf16x8*)(Sc + (16 * nt + r16) * 72 + 32 + 8 * g), acc, 0, 0, 0);
#pragma unroll
                for (int ks = 0; ks < NKS; ++ks) acc = __builtin_amdgcn_mfma_f32_16x16x32_bf16(sfr[ks], *(const bf16x8*)(Qe + (16 * nt + r16) * LQ + 32 * ks + 8 * g), acc, 0, 0, 0);
                o[nt] = acc;
                float ss = acc[0] * acc[0] + acc[1] * acc[1] + acc[2] * acc[2] + acc[3] * acc[3];
                ss += __shfl_xor(ss, 16); ss += __shfl_xor(ss, 32);
                if (g == 0) red[w * 64 + 16 * nt + r16] = ss;
            }
        }
        __syncthreads();
#pragma unroll
        for (int nt = 0; nt < 4; ++nt) {
            float tot = 0.f;
#pragma unroll
            for (int ww = 0; ww < 8; ++ww) tot += red[ww * 64 + 16 * nt + r16];
            const float rs = rsqrtf(tot * (1.f / 128.f) + 1e-6f);
            const size_t row = (size_t)b * SEQ_ + (size_t)c * 64 + 16 * nt + r16;
            const u32x2 gw = gwv[nt];
            u32x2 q; q.x = pk2(o[nt][0] * rs * nw4[0] * siluf_(bflo(gw.x)), o[nt][1] * rs * nw4[1] * siluf_(bfhi(gw.x)));
            q.y = pk2(o[nt][2] * rs * nw4[2] * siluf_(bflo(gw.y)), o[nt][3] * rs * nw4[3] * siluf_(bfhi(gw.y)));
            *(u32x2*)(A + row * 1024 + Cf::OCOL + h * 128 + 16 * w + 4 * g) = q;
        }
        __syncthreads();
    }
}


#define LAS __attribute__((address_space(3)))
#define XB_TMO      128
#define XB_XCNT(j)  (256  + 64 * (j))
#define XB_XSUB(j)  (1280 + 64 * (j))
#define XB_XGEN(j)  (2304 + 64 * (j))
#define XB_TOP      3328
#define XB_TOPGEN   3392
#define XCD_BAR_WORDS 3456
#define XB_SPIN_CAP (1u << 18)

__device__ __forceinline__ unsigned xb_ld(unsigned* p)              { return __hip_atomic_load(p, __ATOMIC_RELAXED, __HIP_MEMORY_SCOPE_AGENT); }
__device__ __forceinline__ unsigned xb_add(unsigned* p, unsigned v) { return __hip_atomic_fetch_add(p, v, __ATOMIC_RELAXED, __HIP_MEMORY_SCOPE_AGENT); }
__device__ __forceinline__ unsigned xb_xcc_id() { return (unsigned)__builtin_amdgcn_s_getreg((3 << 11) | 20) & 0xFu; }
#define XB_SPIN(cond, bar) do { unsigned _sp = 0; while (cond) { __builtin_amdgcn_s_sleep(1); \
    if ((++_sp & 255u) == 0u) { if (xb_ld(&(bar)[XB_TMO])) break; if (_sp > XB_SPIN_CAP) { atomicAdd(&(bar)[XB_TMO], 1u); break; } } } } while (0)

struct XcdBarrier {
    unsigned* bar; unsigned x;
    volatile LAS unsigned* st;
};

__device__ __forceinline__ XcdBarrier xcd_barrier_post(unsigned* bar, volatile LAS unsigned* st) {
    XcdBarrier b; b.bar = bar; b.x = xb_xcc_id(); b.st = st;
    if (threadIdx.x == 0) (void)xb_add(&bar[XB_XCNT(b.x)], 1u);
    return b;
}
__device__ __forceinline__ void xcd_barrier_complete(unsigned* bar, unsigned x, unsigned& nloc, unsigned& nx) {
    const unsigned G = gridDim.x * gridDim.y * gridDim.z;
    unsigned sum, cnt, mine, sp = 0u;
    for (;;) {
        sum = 0u; cnt = 0u; mine = 0u;
#pragma unroll
        for (unsigned j = 0; j < 16; ++j) { const unsigned c = xb_ld(&bar[XB_XCNT(j)]); sum += c; cnt += (c > 0u) ? 1u : 0u; mine = (j == x) ? c : mine; }
        if (sum == G) break;
        __builtin_amdgcn_s_sleep(1);
        if ((++sp & 255u) == 0u) { if (xb_ld(&bar[XB_TMO])) break; if (sp > XB_SPIN_CAP) { atomicAdd(&bar[XB_TMO], 1u); break; } }
    }
    nloc = mine > 0u ? mine : 1u; nx = cnt > 0u ? cnt : 1u;
}

__device__ __forceinline__ void xcd_barrier(const XcdBarrier& b) {
    asm volatile("s_waitcnt vmcnt(0)" ::: "memory");
    __syncthreads();
    if (threadIdx.x == 0) {
        unsigned* bar = b.bar;
        __builtin_amdgcn_s_waitcnt(0);
        unsigned nloc = b.st[0], nx = b.st[1];
        if (nloc == 0u) { xcd_barrier_complete(bar, b.x, nloc, nx); b.st[0] = nloc; b.st[1] = nx; }
        const unsigned old = xb_add(&bar[XB_XSUB(b.x)], 1u);
        const unsigned gen = old / nloc;
        if (old + 1u == (gen + 1u) * nloc) {
            __builtin_amdgcn_fence(__ATOMIC_RELEASE, "agent");
            asm volatile("s_waitcnt vmcnt(0)" ::: "memory");
            const unsigned og = xb_add(&bar[XB_TOP], 1u);
            const unsigned tg = og / nx;
            if (og + 1u == (tg + 1u) * nx) xb_add(&bar[XB_TOPGEN], 1u);
            else XB_SPIN(xb_ld(&bar[XB_TOPGEN]) == tg, bar);
            __builtin_amdgcn_fence(__ATOMIC_ACQUIRE, "agent");
            xb_add(&bar[XB_XGEN(b.x)], 1u);
            asm volatile("s_waitcnt vmcnt(0)" ::: "memory");
        } else {
            XB_SPIN(xb_ld(&bar[XB_XGEN(b.x)]) == gen, bar);
            __builtin_amdgcn_fence(__ATOMIC_ACQUIRE, "agent");
            asm volatile("s_waitcnt vmcnt(0)" ::: "memory");
        }
    }
    __syncthreads();
}

typedef unsigned u32x16 __attribute__((ext_vector_type(16)));
__device__ __forceinline__ void load_params(Params& p) {
    auto kp = __builtin_amdgcn_kernarg_segment_ptr();
    u32x16 a, b, c, d;
    asm volatile("s_load_dwordx16 %0, %4, 0x0\n\ts_load_dwordx16 %1, %4, 0x40\n\ts_load_dwordx16 %2, %4, 0x80\n\ts_load_dwordx16 %3, %4, 0xc0\n\ts_waitcnt lgkmcnt(0)"
                 : "=&s"(a), "=&s"(b), "=&s"(c), "=&s"(d) : "s"(kp) : "memory");
    unsigned long long q[32];
#pragma unroll
    for (int i = 0; i < 8; ++i) { q[i] = ((unsigned long long)a[2 * i + 1] << 32) | a[2 * i]; q[8 + i] = ((unsigned long long)b[2 * i + 1] << 32) | b[2 * i];
        q[16 + i] = ((unsigned long long)c[2 * i + 1] << 32) | c[2 * i]; q[24 + i] = ((unsigned long long)d[2 * i + 1] << 32) | d[2 * i]; }
    p.x = (const float*)(__attribute__((address_space(1))) const float*)q[0]; p.c = (const float*)(__attribute__((address_space(1))) const float*)q[1]; p.positions = (const int*)(__attribute__((address_space(1))) const int*)q[2]; p.mod_w = (const float*)(__attribute__((address_space(1))) const float*)q[3]; p.mod_b = (const float*)(__attribute__((address_space(1))) const float*)q[4]; p.norm_mix_w = (const float*)(__attribute__((address_space(1))) const float*)q[5]; p.norm_ffn_w = (const float*)(__attribute__((address_space(1))) const float*)q[6];
    p.ev_w_in = (const float*)(__attribute__((address_space(1))) const float*)q[7]; p.gla_gate_w = (const float*)(__attribute__((address_space(1))) const float*)q[8]; p.gla_gate_b = (const float*)(__attribute__((address_space(1))) const float*)q[9]; p.gla_norm_w = (const float*)(__attribute__((address_space(1))) const float*)q[10]; p.swa_sinks = (const float*)(__attribute__((address_space(1))) const float*)q[11]; p.ev_w_out = (const float*)(__attribute__((address_space(1))) const float*)q[12];
    p.od_w_in = (const float*)(__attribute__((address_space(1))) const float*)q[13]; p.diff_lambda = (const float*)(__attribute__((address_space(1))) const float*)q[14]; p.diff_norm_w = (const float*)(__attribute__((address_space(1))) const float*)q[15]; p.hgrn_lb_logits = (const float*)(__attribute__((address_space(1))) const float*)q[16]; p.hgrn_norm_w = (const float*)(__attribute__((address_space(1))) const float*)q[17]; p.od_w_out = (const float*)(__attribute__((address_space(1))) const float*)q[18];
    p.ffn_w_in = (const float*)(__attribute__((address_space(1))) const float*)q[19]; p.ffn_conv_w = (const float*)(__attribute__((address_space(1))) const float*)q[20]; p.ffn_conv_b = (const float*)(__attribute__((address_space(1))) const float*)q[21]; p.ffn_w_out = (const float*)(__attribute__((address_space(1))) const float*)q[22]; p.final_norm_w = (const float*)(__attribute__((address_space(1))) const float*)q[23];
    p.out = (float*)(__attribute__((address_space(1))) float*)q[24]; p.ws = (unsigned char*)(__attribute__((address_space(1))) unsigned char*)q[25];
}

#ifndef REP_SYNC
#define REP_SYNC 1
#endif
#ifndef REP_G
#define REP_G 1
#endif
#ifndef REP_R
#define REP_R 1
#endif
#ifndef REP_CV
#define REP_CV 1
#endif
#ifndef REP_P12
#define REP_P12 1
#endif
#ifndef STG_A
#define STG_A 0
#endif
#ifndef STG_B
#define STG_B 0
#endif
#ifndef ALIGN_RES
#define ALIGN_RES true
#endif
#ifndef REP_LA
#define REP_LA 1
#endif
#ifndef REP_AT
#define REP_AT 1
#endif
#ifndef REP_SM
#define REP_SM 1
#endif
__global__ void __launch_bounds__(NTHR, 2) fwd_megakernel(Params pin) {
    extern __shared__ __attribute__((aligned(16))) unsigned char lds[];
    cg::grid_group grid = cg::this_grid();
    Ctx C; C.lds = lds; C.tid = threadIdx.x; C.lane = C.tid & 63; C.wave = __builtin_amdgcn_readfirstlane(C.tid >> 6);
    C.gw = blockIdx.x * 8 + C.wave; C.ngw = gridDim.x * 8;
    PG8_LAS unsigned char* ldsg = (PG8_LAS unsigned char*)lds;
    volatile LAS unsigned* bst = (volatile LAS unsigned*)(ldsg + (LDS_BYTES - 64));
    if (threadIdx.x < 2) bst[threadIdx.x] = 0u;
    __syncthreads();
    XcdBarrier xbar = xcd_barrier_post((unsigned*)(pin.ws + WS_BAR), bst);
#define GSYNC() do { for (int rs_ = 0; rs_ < REP_SYNC; ++rs_) xcd_barrier(xbar); } while (0)
#define RP() do { load_params(C.p); C.tid = otid_(); C.lane = C.tid & 63; C.wave = __builtin_amdgcn_readfirstlane(C.tid >> 6); C.gw = blockIdx.x * 8 + C.wave; } while (0)
#define WSP(off) (C.p.ws + (off))
#define STAGGER(ticks) do { if ((ticks) > 0 && (blockIdx.x & 1)) { const unsigned long long t0_ = __builtin_amdgcn_s_memrealtime(); while (__builtin_amdgcn_s_memrealtime() - t0_ < (unsigned long long)(ticks)) __builtin_amdgcn_s_sleep(16); } } while (0)

    if (pin.ws == nullptr) grid.sync();
    for (int rep_ = 0; rep_ < REP_SM; ++rep_) { RP(); phase_prologue(C); }
    GSYNC();
#if REP_CV > 1
    RP(); phase_convert(C, 0, false);
#endif
    RP(); phase_convert(C, 0);
    for (int rep_ = 0; rep_ < REP_SM; ++rep_) { RP(); phase_prep(C, C.p.x, C.p.norm_mix_w, (const float*)WSP(WS_MOD), 1024, (bf16_t*)WSP(WS_A), (float*)WSP(WS_ROWSS)); }
    GSYNC();
#pragma unroll 1
    for (int l = 0; l < 4; ++l) {
        const bool even = !(l & 1);
        {
            RP();
            const int N = even ? 2560 : 3584;
            pg8::Gemm g{(const bf16_t*)WSP(WS_A), (const bf16_t*)WSP(WS_WIN), T_, N, 1024}; pg8::StaticOrder S; S.init(T_, N, (int)gridDim.x, (int)blockIdx.x);
            pg8::EpiProj E{(bf16_t*)WSP(WS_R1), N, even ? 0x7C000u : 0xFFu, even ? 0x3C000u : 0xFu, QSCALE_, (const float*)WSP(WS_COS), (const float*)WSP(WS_SIN),
                           (const float*)WSP(WS_ROWSS) + (size_t)(2 * l) * T_, (const float*)WSP(WS_BIAS) + (size_t)l * BIAS_L};
            for (int rep_ = 0; rep_ < REP_G; ++rep_) pg8::gemm_phase<pg8::EpiProj, pg8::StaticOrder, true, true>(ldsg, g, S, E);
        }
        GSYNC();
        if (even) {
            for (int rep_ = 0; rep_ < REP_AT; ++rep_) { RP(); phase_swa(C, l); }
            for (int rep_ = 0; rep_ < REP_LA; ++rep_) { RP(); phase_la_p1<0>(C, l); }
            GSYNC();
            RP(); phase_la_p2<0>(C);
            GSYNC();
#if REP_P12 > 1
            RP(); phase_la_p1<0>(C, l); GSYNC(); RP(); phase_la_p2<0>(C); GSYNC();
#endif
            for (int rep_ = 0; rep_ < REP_LA; ++rep_) { RP(); phase_la_p3<0>(C, l); }
        } else {
            for (int rep_ = 0; rep_ < REP_AT; ++rep_) {
                RP();
                const bf16_t* R1 = (const bf16_t*)WSP(WS_R1); bf16_t* X2 = (bf16_t*)WSP(WS_X2);
                const int G = (int)gridDim.x, bid = (int)blockIdx.x;
#pragma unroll 1
                for (int i = 0; i * G < 2048; ++i) {
                    const int L = i * G + ((i & 1) ? (G - 1 - bid) : bid);
                    if (L >= 2048) continue;
                    const int qb = 15 - (L >> 7), bh = L & 127, b = bh >> 4, hv = bh & 15;
                    const attn_body::bf16* Q = (const attn_body::bf16*)(R1 + (hv >> 1) * 64);
                    const attn_body::bf16* K = (const attn_body::bf16*)(R1 + 512 + (hv >> 1) * 64);
                    const attn_body::bf16* V = (const attn_body::bf16*)(R1 + 1024 + (hv >> 2) * 128 + (hv & 1) * 64);
                    attn_body::attn_unit<8>(b, hv, qb, Q, K, V, (attn_body::bf16*)(X2 + hv * 64), (char*)lds);
                }
            }
            for (int rep_ = 0; rep_ < REP_LA; ++rep_) { RP(); phase_la_p1<1>(C, l); }
            GSYNC();
            RP(); phase_la_p2<1>(C);
#if REP_P12 > 1
            GSYNC(); RP(); phase_la_p1<1>(C, l); GSYNC(); RP(); phase_la_p2<1>(C);
#endif
            for (int rep_ = 0; rep_ < REP_SM; ++rep_) { RP(); phase_diff_combine(C, l); }
            GSYNC();
            for (int rep_ = 0; rep_ < REP_LA; ++rep_) { RP(); phase_la_p3<1>(C, l); }
        }
        GSYNC();
        STAGGER(STG_A);
        {
            RP();
            const float* modl = (const float*)WSP(WS_MOD) + (size_t)l * 8 * 6144;
            pg8::Gemm g{(const bf16_t*)WSP(WS_A), (const bf16_t*)WSP(WS_WOUT), T_, 1024, 1024}; pg8::StaticOrder S; S.init(T_, 1024, (int)gridDim.x, (int)blockIdx.x);
            void* XH = (void*)((char*)C.p.out + 64 * MiB_);
            pg8::EpiRes E{(l == 0) ? (const void*)C.p.x : (const void*)XH, XH, (l == 0) ? 1 : 0, 0, modl + 2048, (bf16_t*)WSP(WS_X2), C.p.norm_ffn_w + l * 1024, modl + 4096, (float*)WSP(WS_ROWSS) + (size_t)(2 * l + 1) * T_};
            pg8::gemm_phase<pg8::EpiRes, pg8::StaticOrder, ALIGN_RES, true>(ldsg, g, S, E);
        }
        GSYNC();
        {
            RP();
            pg8::Gemm g{(const bf16_t*)WSP(WS_X2), (const bf16_t*)WSP(WS_FIN), T_, 5632, 1024}; pg8::StaticOrder S; S.init(T_, 5632, (int)gridDim.x, (int)blockIdx.x);
            pg8::EpiFfn E{(bf16_t*)WSP(WS_R1), (float*)WSP(WS_HP), (float*)WSP(WS_HU), (float*)WSP(WS_HA), C.p.ffn_conv_w + (size_t)l * 3 * DFF_, C.p.ffn_conv_b + (size_t)l * DFF_,
                          (const float*)WSP(WS_ROWSS) + (size_t)(2 * l + 1) * T_, (const float*)WSP(WS_BIAS) + (size_t)l * BIAS_L + 8 * 3584};
            for (int rep_ = 0; rep_ < REP_G; ++rep_) pg8::gemm_phase<pg8::EpiFfn, pg8::StaticOrder, true, true>(ldsg, g, S, E);
        }
        GSYNC();
        for (int rep_ = 0; rep_ < REP_SM; ++rep_) { RP(); phase_ffn_fixup(C, l); }
#if REP_CV > 1
        if (l < 3) { RP(); phase_convert(C, l + 1, false); }
#endif
        if (l < 3) { RP(); phase_convert(C, l + 1); }
        GSYNC();
        STAGGER(STG_B);
        {
            RP();
            const float* modl = (const float*)WSP(WS_MOD) + (size_t)l * 8 * 6144;
            pg8::Gemm g{(const bf16_t*)WSP(WS_R1), (const bf16_t*)WSP((l & 1) ? WS_FOUT2 : WS_FOUT), T_, 1024, DFF_}; pg8::StaticOrder S; S.init(T_, 1024, (int)gridDim.x, (int)blockIdx.x);
            void* XH = (void*)((char*)C.p.out + 64 * MiB_);
            pg8::EpiRes E{XH, (l < 3) ? XH : (void*)WSP(WS_X2), 0, (l < 3) ? 0 : 1, modl + 5120, (l < 3) ? (bf16_t*)WSP(WS_A) : (bf16_t*)nullptr, C.p.norm_mix_w + ((l + 1) & 3) * 1024, modl + 6144 * 8 + 1024, (float*)WSP(WS_ROWSS) + (size_t)((2 * l + 2) & 7) * T_};
            pg8::gemm_phase<pg8::EpiRes, pg8::StaticOrder, ALIGN_RES, true>(ldsg, g, S, E);
        }
        GSYNC();
    }
    RP(); phase_final_norm(C, (const float*)WSP(WS_X2), C.p.out, C.p.final_norm_w);
}

extern "C" void kernel_launch(void* const* d_in, const int* in_sizes, int n_in, void* d_out, int out_size, void* d_ws, size_t ws_size, hipStream_t stream) {
    static int grid_blocks = 0;
    if (grid_blocks == 0) {
        if (n_in != 24 || ws_size < WS_END) { fprintf(stderr, "kernel_launch: unexpected n_in %d / ws %zu\n", n_in, ws_size); grid_blocks = -1; return; }
        int dev = 0, cus = 0, per_cu = 0;
        hipGetDevice(&dev); hipDeviceGetAttribute(&cus, hipDeviceAttributeMultiprocessorCount, dev);
        if (hipFuncSetAttribute((const void*)fwd_megakernel, hipFuncAttributeMaxDynamicSharedMemorySize, LDS_BYTES) != hipSuccess) { fprintf(stderr, "kernel_launch: hipFuncSetAttribute failed\n"); grid_blocks = -1; return; }
        if (hipOccupancyMaxActiveBlocksPerMultiprocessor(&per_cu, (const void*)fwd_megakernel, NTHR, LDS_BYTES) != hipSuccess || per_cu < 1) { fprintf(stderr, "kernel_launch: occupancy query gave %d\n", per_cu); per_cu = 1; }
        (void)hipGetLastError();
        grid_blocks = cus * per_cu;
    }
    if (grid_blocks < 0) return;
    Params p{};
    p.x = (const float*)d_in[0]; p.c = (const float*)d_in[1]; p.positions = (const int*)d_in[2]; p.mod_w = (const float*)d_in[3]; p.mod_b = (const float*)d_in[4];
    p.norm_mix_w = (const float*)d_in[5]; p.norm_ffn_w = (const float*)d_in[6]; p.ev_w_in = (const float*)d_in[7]; p.gla_gate_w = (const float*)d_in[8];
    p.gla_gate_b = (const float*)d_in[9]; p.gla_norm_w = (const float*)d_in[10]; p.swa_sinks = (const float*)d_in[11]; p.ev_w_out = (const float*)d_in[12];
    p.od_w_in = (const float*)d_in[13]; p.diff_lambda = (const float*)d_in[14]; p.diff_norm_w = (const float*)d_in[15]; p.hgrn_lb_logits = (const float*)d_in[16];
    p.hgrn_norm_w = (const float*)d_in[17]; p.od_w_out = (const float*)d_in[18]; p.ffn_w_in = (const float*)d_in[19]; p.ffn_conv_w = (const float*)d_in[20];
    p.ffn_conv_b = (const float*)d_in[21]; p.ffn_w_out = (const float*)d_in[22]; p.final_norm_w = (const float*)d_in[23];
    p.out = (float*)d_out; p.ws = (unsigned char*)d_ws;
    if (hipMemsetAsync((char*)d_ws + WS_BAR, 0, 16384, stream) != hipSuccess) { fprintf(stderr, "kernel_launch: memset failed\n"); return; }
    void* args[] = {&p};
    hipError_t e = hipLaunchCooperativeKernel((const void*)fwd_megakernel, dim3(grid_blocks), dim3(NTHR), args, LDS_BYTES, stream);
    if (e != hipSuccess) fprintf(stderr, "cooperative launch failed: %s (grid %d)\n", hipGetErrorString(e), grid_blocks);
}
```

```cpp
#include <hip/hip_runtime.h>
#include <hip/hip_cooperative_groups.h>
#include <hip/hip_bf16.h>
#include <cstdio>
#include <cstdint>
#include <cmath>
__device__ __forceinline__ int otid_() { int t = threadIdx.x; asm volatile("" : "+v"(t)); return t; }
namespace pg8 {
#define PG8_LAS __attribute__((address_space(3)))
typedef unsigned short bf16_t;
typedef short bf16x8 __attribute__((ext_vector_type(8)));
typedef float f32x4 __attribute__((ext_vector_type(4)));
typedef unsigned u32x4 __attribute__((ext_vector_type(4)));
constexpr int BM = 256, BK = 64, HALF = 128, HTB = HALF * BK * 2  , STAGE_BYTES = 8 * HTB, NXCD = 8, WGM = 8;

__host__ __device__ __forceinline__ int lds_byte(int r, int c) { const int st = (r >> 4) * 2 + (c >> 5), rr = r & 15, cc = c & 31, ob = rr * 64 + cc * 2; return st * 1024 + (ob ^ (((ob >> 9) & 1) << 5)); }
__host__ __device__ __forceinline__ void stage_rc(int b, int& R, int& C) { const int st = b / 1024, sb = b % 1024, swz = sb ^ (((sb >> 9) & 1) << 5); R = (st >> 1) * 16 + swz / 64; C = (st & 1) * 32 + (swz % 64) / 2; }
__host__ __device__ __forceinline__ int perm32(int rho) { const int n = rho >> 4, i = rho & 15; return 8 * (i >> 2) + 4 * n + (i & 3); }

struct Unit { int pm, pn; };
struct Gemm { const bf16_t* A; const bf16_t* Bt; int M, N, K; };

struct StaticOrder {
    int nM, nN, nwg, G, c;
    __host__ __device__ void init(int M, int N, int G_, int c_) { nM = M / BM; nN = N / BM; nwg = nM * nN; G = G_; c = c_; }
    __host__ __device__ bool next(int i, Unit& u) const {
        const long L = (long)i * G + c; if (L >= nwg) return false;
        int wgid = (int)L; { const int q = nwg / NXCD, r = nwg % NXCD, xcd = wgid % NXCD, off = wgid / NXCD; wgid = (xcd < r ? xcd * (q + 1) : r * (q + 1) + (xcd - r) * q) + off; }
        const int nig = WGM * nN, gid = wgid / nig, fm = gid * WGM, gsz = (nM - fm) < WGM ? (nM - fm) : WGM;
        u.pm = fm + ((wgid % nig) % gsz); u.pn = (wgid % nig) / gsz; return true;
    }
    __device__ __forceinline__ void a_ready(const Unit&) const {}
    __device__ __forceinline__ void done(const Unit&) const {}
};

__device__ __forceinline__ unsigned cvt_pk_bf16(float lo, float hi) { unsigned r; asm volatile("v_cvt_pk_bf16_f32 %0, %1, %2" : "=v"(r) : "v"(lo), "v"(hi)); return r; }
typedef float f32x2 __attribute__((ext_vector_type(2)));
template <class Epi, class Sched, bool ALIGN_EPI = false, bool SP2 = false>
__device__ __forceinline__ void gemm_phase(PG8_LAS unsigned char* lds, const Gemm g, const Sched& S, const Epi& E) {
    const int tid = otid_(), wid = __builtin_amdgcn_readfirstlane(tid >> 6), lane = tid & 63, wr = wid >> 2, wc = wid & 3, fr = lane & 15, fq = lane >> 4;
    const int K = g.K, nt = K / BK;
    unsigned voffA[2], voffB[2];
#pragma unroll
    for (int i = 0; i < 2; ++i) { int R, C; stage_rc(tid * 16 + i * 8192, R, C); const int Rb = Epi::PERM ? ((R & ~31) + perm32(R & 31)) : R;
        voffA[i] = (unsigned)(R * K + C) * 2u; voffB[i] = (unsigned)(Rb * K + C) * 2u; }
    const size_t kstep = (size_t)(BK * 2);
    const size_t hstep = (size_t)HALF * K * 2;
    const size_t tstep = 2 * hstep;
    const unsigned ldsw = (unsigned)wid * 1024u;
    const int aoff = lds_byte(wr * 64 + fr, fq * 8), boff = lds_byte(wc * 32 + fr, fq * 8);
#define PG8_SA(b, h) (((b) * 2 + (h)) * HTB)
#define PG8_SB(b, h) ((4 + (b) * 2 + (h)) * HTB)
#define PG8_STAGE(bufoff, gbase, voff) do { _Pragma("unroll") for (int _i = 0; _i < 2; ++_i) \
        __builtin_amdgcn_global_load_lds((const unsigned*)((const char*)(gbase) + (voff)[_i]), (PG8_LAS unsigned*)(lds + (bufoff) + ldsw + _i * 8192), 16, 0, 0); } while (0)
#define PG8_LDA(dst, b, h) do { _Pragma("unroll") for (int m = 0; m < 4; ++m) _Pragma("unroll") for (int k = 0; k < 2; ++k) dst[m][k] = *(const PG8_LAS bf16x8*)(lds + PG8_SA(b, h) + aoff + m * 2048 + k * 1024); } while (0)
#define PG8_LDB(dst, b, h) do { _Pragma("unroll") for (int n = 0; n < 2; ++n) _Pragma("unroll") for (int k = 0; k < 2; ++k) dst[n][k] = *(const PG8_LAS bf16x8*)(lds + PG8_SB(b, h) + boff + n * 2048 + k * 1024); } while (0)
#define PG8_MMA(ai, bj, At, Bt) do { __builtin_amdgcn_s_setprio(1); _Pragma("unroll") for (int m = 0; m < 4; ++m) _Pragma("unroll") for (int n = 0; n < 2; ++n) _Pragma("unroll") for (int k = 0; k < 2; ++k) \
        acc[ai][bj][m][n] = __builtin_amdgcn_mfma_f32_16x16x32_bf16(Bt[n][k], At[m][k], acc[ai][bj][m][n], 0, 0, 0); __builtin_amdgcn_s_setprio(0); } while (0)
#define PG8_WAIT_V(n) asm volatile("s_waitcnt vmcnt(" #n ")" ::: "memory")
#define PG8_WAIT_L(n) asm volatile("s_waitcnt lgkmcnt(" #n ")" ::: "memory")
#define PG8_BAR __builtin_amdgcn_s_barrier()
#define PG8_SCHED __builtin_amdgcn_sched_barrier(0)
    Unit cur, nxt; int ui = 0;
    if (!S.next(0, cur)) return;
    f32x4 acc[2][2][4][2];
#pragma unroll
    for (int a = 0; a < 2; ++a)
#pragma unroll
        for (int b = 0; b < 2; ++b)
#pragma unroll
            for (int m = 0; m < 4; ++m)
#pragma unroll
                for (int n = 0; n < 2; ++n) acc[a][b][m][n] = (f32x4){0.f, 0.f, 0.f, 0.f};
    bf16x8 At[4][2], B0[2][2], B1[2][2];
    const char* cA = (const char*)g.A + (size_t)cur.pm * tstep; const char* cB = (const char*)g.Bt + (size_t)cur.pn * tstep;
    S.a_ready(cur);
    if constexpr (SP2) {
        PG8_STAGE(PG8_SB(0, 0), cB, voffB); PG8_STAGE(PG8_SB(0, 1), cB + hstep, voffB); PG8_STAGE(PG8_SA(0, 0), cA, voffA); PG8_STAGE(PG8_SA(0, 1), cA + hstep, voffA);
        if (wr == 1) PG8_BAR;
        PG8_WAIT_V(2); PG8_BAR;
        PG8_STAGE(PG8_SB(1, 0), cB + kstep, voffB); PG8_STAGE(PG8_SA(1, 0), cA + kstep, voffA); PG8_STAGE(PG8_SB(1, 1), cB + hstep + kstep, voffB);
        PG8_WAIT_V(6); PG8_BAR;
    } else {
        PG8_STAGE(PG8_SB(0, 0), cB, voffB); PG8_STAGE(PG8_SA(0, 0), cA, voffA); PG8_STAGE(PG8_SB(0, 1), cB + hstep, voffB); PG8_STAGE(PG8_SA(0, 1), cA + hstep, voffA);
        if (wr == 1) PG8_BAR;
        PG8_WAIT_V(4); PG8_BAR;
        PG8_STAGE(PG8_SB(1, 0), cB + kstep, voffB); PG8_STAGE(PG8_SA(1, 0), cA + kstep, voffA); PG8_STAGE(PG8_SB(1, 1), cB + hstep + kstep, voffB);
        PG8_WAIT_V(6); PG8_BAR;
    }
    for (;;) {
        const bool has_next = S.next(ui + 1, nxt);
        const char* nA = has_next ? (const char*)g.A + (size_t)nxt.pm * tstep : cA; const char* nB = has_next ? (const char*)g.Bt + (size_t)nxt.pn * tstep : cB;
        for (int t = 0; t < nt; t += 2) {
            const bool last = (t == nt - 2);
            const char* a1 = cA + (size_t)(t + 1) * kstep;
            const char* a2 = last ? nA : cA + (size_t)(t + 2) * kstep; const char* b2 = last ? nB : cB + (size_t)(t + 2) * kstep;
            const char* a3 = a2 + kstep; const char* b3 = b2 + kstep;
            if (last && has_next) S.a_ready(nxt);
            if constexpr (SP2) {
            PG8_LDB(B0, 0, 0); PG8_LDB(B1, 0, 1); PG8_SCHED; PG8_LDA(At, 0, 0); PG8_STAGE(PG8_SA(1, 1), a1 + hstep, voffA);
            PG8_WAIT_V(8); PG8_WAIT_L(0); PG8_BAR; PG8_MMA(0, 0, At, B0); PG8_MMA(0, 1, At, B1); PG8_BAR; PG8_SCHED;
            PG8_LDA(At, 0, 1); PG8_STAGE(PG8_SB(0, 0), b2, voffB); PG8_STAGE(PG8_SB(0, 1), b2 + hstep, voffB); PG8_STAGE(PG8_SA(0, 0), a2, voffA);
            PG8_WAIT_V(8); PG8_WAIT_L(0); PG8_BAR; PG8_MMA(1, 0, At, B0); PG8_MMA(1, 1, At, B1); PG8_BAR; PG8_SCHED;
            PG8_LDB(B0, 1, 0); PG8_LDB(B1, 1, 1); PG8_SCHED; PG8_LDA(At, 1, 0); PG8_STAGE(PG8_SA(0, 1), a2 + hstep, voffA);
            PG8_WAIT_V(8); PG8_WAIT_L(0); PG8_BAR; PG8_MMA(0, 0, At, B0); PG8_MMA(0, 1, At, B1); PG8_BAR; PG8_SCHED;
            PG8_LDA(At, 1, 1); PG8_STAGE(PG8_SB(1, 0), b3, voffB); PG8_STAGE(PG8_SB(1, 1), b3 + hstep, voffB); PG8_STAGE(PG8_SA(1, 0), a3, voffA);
            PG8_WAIT_V(8); PG8_WAIT_L(0); PG8_BAR; PG8_MMA(1, 0, At, B0); PG8_MMA(1, 1, At, B1); PG8_BAR; PG8_SCHED;
            } else {
            PG8_LDB(B0, 0, 0); PG8_SCHED; PG8_LDA(At, 0, 0); PG8_STAGE(PG8_SA(1, 1), a1 + hstep, voffA);
            PG8_WAIT_L(8); PG8_BAR; PG8_WAIT_L(0); PG8_MMA(0, 0, At, B0); PG8_BAR; PG8_SCHED;
            PG8_LDB(B1, 0, 1); PG8_STAGE(PG8_SB(0, 0), b2, voffB);
            PG8_BAR; PG8_WAIT_L(0); PG8_MMA(0, 1, At, B1); PG8_BAR;
            PG8_LDA(At, 0, 1); PG8_STAGE(PG8_SA(0, 0), a2, voffA);
            PG8_BAR; PG8_WAIT_L(0); PG8_MMA(1, 0, At, B0); PG8_BAR; PG8_SCHED;
            PG8_STAGE(PG8_SB(0, 1), b2 + hstep, voffB);
            PG8_WAIT_V(6); PG8_BAR; PG8_MMA(1, 1, At, B1); PG8_BAR;
            PG8_LDB(B0, 1, 0); PG8_SCHED; PG8_LDA(At, 1, 0); PG8_STAGE(PG8_SA(0, 1), a2 + hstep, voffA);
            PG8_WAIT_L(8); PG8_BAR; PG8_WAIT_L(0); PG8_MMA(0, 0, At, B0); PG8_BAR; PG8_SCHED;
            PG8_LDB(B1, 1, 1); PG8_STAGE(PG8_SB(1, 0), b3, voffB);
            PG8_BAR; PG8_WAIT_L(0); PG8_MMA(0, 1, At, B1); PG8_BAR;
            PG8_LDA(At, 1, 1); PG8_STAGE(PG8_SA(1, 0), a3, voffA);
            PG8_BAR; PG8_WAIT_L(0); PG8_MMA(1, 0, At, B0); PG8_BAR; PG8_SCHED;
            PG8_STAGE(PG8_SB(1, 1), b3 + hstep, voffB);
            PG8_WAIT_V(6); PG8_BAR; PG8_MMA(1, 1, At, B1); PG8_BAR;
            }
        }
        if constexpr (ALIGN_EPI) { if (wr == 0) PG8_BAR; }
        if constexpr (!Epi::AFTER_DRAIN) { E(acc, cur, wr, wc, fr, fq); S.done(cur); }
        if (!has_next) break;
#pragma unroll
        for (int a = 0; a < 2; ++a)
#pragma unroll
            for (int b = 0; b < 2; ++b)
#pragma unroll
                for (int m = 0; m < 4; ++m)
#pragma unroll
                    for (int n = 0; n < 2; ++n) acc[a][b][m][n] = (f32x4){0.f, 0.f, 0.f, 0.f};
        cur = nxt; cA = nA; cB = nB; ++ui;
        if constexpr (ALIGN_EPI) { if (wr == 1) PG8_BAR; }
    }
    PG8_WAIT_V(0);
    if constexpr (!ALIGN_EPI) { if (wr == 0) PG8_BAR; }
    PG8_BAR;
    if constexpr (Epi::AFTER_DRAIN) { E.fused(acc, cur, wr, wc, fr, fq, lds, wid, lane); S.done(cur); }
#undef PG8_SA
#undef PG8_SB
#undef PG8_STAGE
#undef PG8_LDA
#undef PG8_LDB
#undef PG8_MMA
#undef PG8_WAIT_V
#undef PG8_WAIT_L
#undef PG8_BAR
#undef PG8_SCHED
}
}
#include <hip/hip_bf16.h>
namespace attn_body {
using bf16=__hip_bfloat16;
using bf16x8=__attribute__((ext_vector_type(8)))short;
using s16x4=__attribute__((ext_vector_type(4)))short;
using f32x16=__attribute__((ext_vector_type(16)))float;
using u32x4=__attribute__((ext_vector_type(4)))unsigned;
constexpr int BATCH=8,NHEAD=16,SEQ=4096,D=64,PITI=3584,PITO=1024;
constexpr int NW=8,QBLK=32,QB=QBLK*NW,KVBLK=64,NQB=SEQ/QB;
__device__ __forceinline__ int crow(int r,int hi){return (r&3)+8*(r>>2)+4*hi;}
#define SBAR() __builtin_amdgcn_sched_barrier(0)
__device__ __forceinline__ void cmask(f32x16&p0,f32x16&p1,int jb,int qrel,int hi){
  const float NEG=-INFINITY; int kb=64*jb+4*hi;
  #pragma unroll
  for(int r=0;r<16;++r){int kv=kb+(r&3)+8*(r>>2); if(kv>qrel)p0[r]=NEG; if(kv+32>qrel)p1[r]=NEG;}
}

constexpr int NSLOT=3, SLOTB=8192;
constexpr int LDS_K=0, LDS_V=NSLOT*SLOTB, LDS_WS=2*NSLOT*SLOTB, LDS_OST=LDS_WS+NW*64*4, LDS_BYTES=LDS_OST+NW*4096;
constexpr float C2=0.125f*1.4426950408889634f;
__device__ __forceinline__ void glds16(const void*gsrc,unsigned lds_dst){unsigned keep;
  asm volatile("s_mov_b32 %0, m0\n\ts_mov_b32 m0, %2\n\ts_nop 0\n\tglobal_load_lds_dwordx4 %1, off\n\ts_mov_b32 m0, %0":"=&s"(keep):"v"(gsrc),"s"(lds_dst):"memory");}
__device__ __forceinline__ float max3f(float a,float b,float c){float r;asm("v_max3_f32 %0, %1, %2, %3":"=v"(r):"v"(a),"v"(b),"v"(c));return r;}
__device__ __forceinline__ float max2f(float a,float b){float r;asm("v_max_f32_e32 %0, %1, %2":"=v"(r):"v"(a),"v"(b));return r;}
__device__ __forceinline__ float fadd_s(float a,float b){float r;asm("v_add_f32_e32 %0, %1, %2":"=v"(r):"v"(a),"v"(b));return r;}
__device__ __forceinline__ float fsub_s(float a,float b){float r;asm("v_sub_f32_e32 %0, %1, %2":"=v"(r):"v"(a),"v"(b));return r;}
typedef float f32x2_t __attribute__((ext_vector_type(2))); typedef __bf16 bf16x2_t __attribute__((ext_vector_type(2)));
__device__ __forceinline__ unsigned cvtpk_s(float lo,float hi){f32x2_t v={lo,hi};bf16x2_t b=__builtin_convertvector(v,bf16x2_t);return __builtin_bit_cast(unsigned,b);}
#define WAIT_BAR(N) asm volatile("s_waitcnt vmcnt(" #N ") lgkmcnt(0)\n\ts_barrier":::"memory")

__device__ __forceinline__ void qkt(f32x16&p0,f32x16&p1,const char*Kslot,const bf16x8*qr,const f32x16&negm,int r32,int hi){
  const char*kb=Kslot+hi*1024+r32*16;
  #pragma unroll
  for(int d0=0;d0<4;++d0){
    const bf16x8 b0=*reinterpret_cast<const bf16x8*>(kb+d0*2048);
    const bf16x8 b1=*reinterpret_cast<const bf16x8*>(kb+d0*2048+512);
    if(d0==0){p0=__builtin_amdgcn_mfma_f32_32x32x16_bf16(b0,qr[0],negm,0,0,0);p1=__builtin_amdgcn_mfma_f32_32x32x16_bf16(b1,qr[0],negm,0,0,0);}
    else{p0=__builtin_amdgcn_mfma_f32_32x32x16_bf16(b0,qr[d0],p0,0,0,0);p1=__builtin_amdgcn_mfma_f32_32x32x16_bf16(b1,qr[d0],p1,0,0,0);}}
}
typedef __attribute__((address_space(3))) const char* lds_cptr;
typedef short v4i16_t __attribute__((ext_vector_type(4)));
__device__ __forceinline__ void kload8(bf16x8*kf,lds_cptr kp){
  kf[0]=*(const __attribute__((address_space(3))) bf16x8*)(kp);      kf[1]=*(const __attribute__((address_space(3))) bf16x8*)(kp+512);
  kf[2]=*(const __attribute__((address_space(3))) bf16x8*)(kp+2048); kf[3]=*(const __attribute__((address_space(3))) bf16x8*)(kp+2560);
  kf[4]=*(const __attribute__((address_space(3))) bf16x8*)(kp+4096); kf[5]=*(const __attribute__((address_space(3))) bf16x8*)(kp+4608);
  kf[6]=*(const __attribute__((address_space(3))) bf16x8*)(kp+6144); kf[7]=*(const __attribute__((address_space(3))) bf16x8*)(kp+6656);
}
__device__ __forceinline__ void kload2(bf16x8*kf,lds_cptr kp,int j){ kf[2*j]=*(const __attribute__((address_space(3))) bf16x8*)(kp+j*2048); kf[2*j+1]=*(const __attribute__((address_space(3))) bf16x8*)(kp+j*2048+512); }
__device__ __forceinline__ s16x4 vtr(lds_cptr p){ return __builtin_bit_cast(s16x4,__builtin_amdgcn_ds_read_tr16_b64_v4i16((__attribute__((address_space(3))) v4i16_t*)p)); }
__device__ __forceinline__ float rowmax(const f32x16&p0,const f32x16&p1){
  float a=max3f(p0[0],p0[1],p1[0]),b=max3f(p0[2],p0[3],p1[1]);a=max3f(a,p1[2],p1[3]);
  #pragma unroll
  for(int r=4;r<16;r+=4){a=max3f(a,p0[r],p0[r+1]);b=max3f(b,p0[r+2],p0[r+3]);a=max3f(a,p1[r],p1[r+1]);b=max3f(b,p1[r+2],p1[r+3]);}
  const float m=max2f(a,b);
  auto rr=__builtin_amdgcn_permlane32_swap(__float_as_uint(m),__float_as_uint(m),false,false);
  return max2f(__uint_as_float(rr[0]),__uint_as_float(rr[1]));
}
__device__ __forceinline__ void pv(f32x16*o,int vb,bf16x8 pa0,bf16x8 pa1,bf16x8 pa2,bf16x8 pa3){
  #pragma unroll
  for(int d0=0;d0<2;++d0){s16x4 lo[4],hi[4];
    #pragma unroll
    for(int ks=0;ks<4;++ks){
      asm volatile("ds_read_b64_tr_b16 %0,%1 offset:%c2":"=&v"(lo[ks]):"v"(vb),"i"(d0*4096+ks*1024):"memory");
      asm volatile("ds_read_b64_tr_b16 %0,%1 offset:%c2":"=&v"(hi[ks]):"v"(vb),"i"(d0*4096+ks*1024+512):"memory");}
    asm volatile("s_waitcnt lgkmcnt(0)":::"memory");SBAR();
    #define PK(k) (bf16x8){lo[k][0],lo[k][1],lo[k][2],lo[k][3],hi[k][0],hi[k][1],hi[k][2],hi[k][3]}
    o[d0]=__builtin_amdgcn_mfma_f32_32x32x16_bf16(pa0,PK(0),o[d0],0,0,0);
    o[d0]=__builtin_amdgcn_mfma_f32_32x32x16_bf16(pa1,PK(1),o[d0],0,0,0);
    o[d0]=__builtin_amdgcn_mfma_f32_32x32x16_bf16(pa2,PK(2),o[d0],0,0,0);
    o[d0]=__builtin_amdgcn_mfma_f32_32x32x16_bf16(pa3,PK(3),o[d0],0,0,0);
    #undef PK
  }
}

#ifndef ATTN_STORE16
#define ATTN_STORE16(p,v) (*(u32x4*)(p)=(v))
#endif
template<int THRL> __device__ __forceinline__ void attn_unit(int b,int h,int qb,const bf16*Q,const bf16*__restrict__ K,const bf16*__restrict__ V,bf16*O,char*shm){
  const int tid=otid_(),lane=tid&63,r32=lane&31,hi=lane>>5; const int wid=__builtin_amdgcn_readfirstlane(tid>>6);
  const long rowbase=(long)b*SEQ; const int q0=qb*QB;
  const bf16*Qw=Q+(rowbase+q0+wid*QBLK)*PITI;
  const bf16*Kh=K+rowbase*PITI,*Vh=V+rowbase*PITI;
  const unsigned lds0=(unsigned)(uintptr_t)shm;
  float*wsf=(float*)(shm+LDS_WS)+wid*64;
  const bf16*ksrc=Kh+(long)lane*PITI+wid*8;
  const bf16*vsrc=Vh+(long)(16*(wid&3)+(lane>>2))*PITI+(wid>>2)*32+(lane&3)*8;
  const unsigned kdst=lds0+LDS_K+wid*1024, vdst=lds0+LDS_V+wid*1024;
  #define DMA_K(t,slot) glds16(ksrc+(long)(t)*KVBLK*PITI,(unsigned)__builtin_amdgcn_readfirstlane(kdst+(slot)))
  #define DMA_V(t,slot) glds16(vsrc+(long)(t)*KVBLK*PITI,(unsigned)__builtin_amdgcn_readfirstlane(vdst+(slot)))
  const int vb0=(int)(lds0+LDS_V)+((lane>>4)&1)*32+(lane&3)*8+(4*hi+((lane&15)>>2))*64;
  const char*Kbase=shm+LDS_K; bf16x8 kf[8];
  const lds_cptr shm3=(lds_cptr)shm; const lds_cptr kp0=shm3+LDS_K+hi*1024+r32*16; const lds_cptr vp0=shm3+LDS_V+((lane>>4)&1)*32+(lane&3)*8+(4*hi+((lane&15)>>2))*64;
  const int NT=(q0+QB)/KVBLK;
  DMA_K(0,0);DMA_V(0,0);DMA_K(1,SLOTB);
  bf16x8 qr[4];
  #pragma unroll
  for(int d0=0;d0<4;++d0)qr[d0]=*reinterpret_cast<const bf16x8*>(&Qw[(long)r32*PITI+d0*16+hi*8]);
  float mhat=0.f,l_reg=0.f;f32x16 o[2];o[0]=f32x16{};o[1]=f32x16{};f32x16 negm=f32x16{};asm volatile("":"+v"(negm));
  const int qrel=wid*QBLK+r32;
  #define CMASK(P0,P1,t) do{int jb_=(t)-(NT-4); if(jb_>=0)cmask(P0,P1,jb_,qrel,hi);}while(0)
  bool resc=false;
  #define START(P0,P1) do{ const float rm=rowmax(P0,P1); resc=false; \
    { const float dl=rm; mhat=fadd_s(mhat,dl); \
      _Pragma("unroll") for(int r=0;r<16;++r){P0[r]=fsub_s(P0[r],dl);P1[r]=fsub_s(P1[r],dl);} \
      _Pragma("unroll") for(int r=0;r<16;++r)negm[r]=-mhat; asm volatile("":"+v"(negm)); } \
    _Pragma("unroll") for(int r=0;r<16;++r)P0[r]=__builtin_amdgcn_exp2f(P0[r]); }while(0)
  #define RESC() do{ if(resc){ asm volatile("s_waitcnt lgkmcnt(0)":::"memory"); \
      _Pragma("unroll") for(int d_=0;d_<2;++d_) _Pragma("unroll") for(int r=0;r<16;++r)o[d_][r]*=wsf[crow(r,hi)]; } }while(0)
  f32x16 pA0,pA1,pB0,pB1;
  int sl_prev=0,sl_cur=0,sl_next=SLOTB;
  #define ROT() do{sl_prev=sl_cur;sl_cur=sl_next;sl_next=(sl_next==(NSLOT-1)*SLOTB)?0:sl_next+SLOTB;}while(0)
  DMA_K(2,2*SLOTB);
  WAIT_BAR(3);
  qkt(pA0,pA1,Kbase,qr,negm,r32,hi);asm volatile("s_nop 15\n\ts_nop 7":"+v"(pA0),"+v"(pA1));CMASK(pA0,pA1,0);
  START(pA0,pA1);
  _Pragma("unroll") for(int r=0;r<16;++r)pA1[r]=__builtin_amdgcn_exp2f(pA1[r]);
  WAIT_BAR(0);
  DMA_K(3,0);DMA_V(1,SLOTB);
  ROT();
  kload8(kf,kp0+sl_cur);
  WAIT_BAR(2);
  s16x4 vlo[8],vhi[8]; u32x4 pw0,pw1,pw2,pw3;
  #define PKW(P,B) cvtpk_s(P[B],P[B+1])
  #define PAF(k) __builtin_bit_cast(bf16x8,pw##k)
  #define VFR(i) (bf16x8){vlo[i][0],vlo[i][1],vlo[i][2],vlo[i][3],vhi[i][0],vhi[i][1],vhi[i][2],vhi[i][3]}
  #define PIN(x) asm volatile("":"+v"(x))
  #define MX3(a,b,c) __builtin_fmaxf(__builtin_fmaxf((a),(b)),(c))
  #define GAPA(MF,A0,A1,A2,A3,W0,W1,PW) do{ MF; sacc+=A0; sacc+=A1; sacc+=A2; sacc+=A3; PIN(sacc); W0; W1; PIN(PW); SBAR(); }while(0)
  #define EX(v) __builtin_amdgcn_exp2f(v)
  #define GAPB(MF,X,B) do{ MF; X[B]=EX(X[B]); X[B+1]=EX(X[B+1]); X[B+2]=EX(X[B+2]); X[B+3]=EX(X[B+3]); PIN(X); SBAR(); }while(0)
  #define VRD(i) do{ vlo[i]=vtr(vp_+(((i)>>2)*4096+((i)&3)*1024)); vhi[i]=vtr(vp_+(((i)>>2)*4096+((i)&3)*1024+512)); }while(0)
  #define KRD(G,j) do{ if(G){ kload2(kf,kp0+sl_next,j); SBAR(); } }while(0)
  #define STEP(C0,C1,P0,P1,t,GK,GV,GL) do{ SBAR(); \
    const lds_cptr vp_=vp0+sl_prev; \
    VRD(0); SBAR(); float sacc=(P0[0]+P0[1]); \
    GAPA(C0=__builtin_amdgcn_mfma_f32_32x32x16_bf16(kf[0],qr[0],negm,0,0,0), P0[2],P0[3],P0[4],P0[5],     pw0[0]=PKW(P0,0), pw0[1]=PKW(P0,2), pw0); \
    VRD(4); SBAR(); GAPA(C1=__builtin_amdgcn_mfma_f32_32x32x16_bf16(kf[1],qr[0],negm,0,0,0), P0[6],P0[7],P0[8],P0[9],     pw0[2]=PKW(P0,4), pw0[3]=PKW(P0,6), pw0); \
    VRD(1); SBAR(); GAPA(C0=__builtin_amdgcn_mfma_f32_32x32x16_bf16(kf[2],qr[1],C0,0,0,0),   P0[10],P0[11],P0[12],P0[13], pw1[0]=PKW(P0,8), pw1[1]=PKW(P0,10), pw1); \
    VRD(5); SBAR(); GAPA(C1=__builtin_amdgcn_mfma_f32_32x32x16_bf16(kf[3],qr[1],C1,0,0,0),   P0[14],P0[15],P1[0],P1[1],   pw1[2]=PKW(P0,12),pw1[3]=PKW(P0,14), pw1); \
    VRD(2); SBAR(); GAPA(C0=__builtin_amdgcn_mfma_f32_32x32x16_bf16(kf[4],qr[2],C0,0,0,0),   P1[2],P1[3],P1[4],P1[5],     pw2[0]=PKW(P1,0), pw2[1]=PKW(P1,2), pw2); \
    VRD(6); SBAR(); GAPA(C1=__builtin_amdgcn_mfma_f32_32x32x16_bf16(kf[5],qr[2],C1,0,0,0),   P1[6],P1[7],P1[8],P1[9],     pw2[2]=PKW(P1,4), pw2[3]=PKW(P1,6), pw2); \
    VRD(3); SBAR(); GAPA(C0=__builtin_amdgcn_mfma_f32_32x32x16_bf16(kf[6],qr[3],C0,0,0,0),   P1[10],P1[11],P1[12],P1[13], pw3[0]=PKW(P1,8), pw3[1]=PKW(P1,10), pw3); \
    VRD(7); SBAR(); GAPA(C1=__builtin_amdgcn_mfma_f32_32x32x16_bf16(kf[7],qr[3],C1,0,0,0),   P1[14],P1[15],0.f,0.f,       pw3[2]=PKW(P1,12),pw3[3]=PKW(P1,14), pw3); \
    l_reg+=sacc; \
    if(GK){DMA_K((t)+3,sl_cur);} if(GV){DMA_V((t)+1,sl_next);} \
    CMASK(C0,C1,t); \
    { float a=MX3(C0[0],C0[1],C1[0]),b=MX3(C0[2],C0[3],C1[1]); a=MX3(a,C1[2],C1[3]); \
      _Pragma("unroll") for(int r=4;r<16;r+=4){a=MX3(a,C0[r],C0[r+1]);b=MX3(b,C0[r+2],C0[r+3]);a=MX3(a,C1[r],C1[r+1]);b=MX3(b,C1[r+2],C1[r+3]);} \
      float rm=__builtin_fmaxf(a,b); { auto rr=__builtin_amdgcn_permlane32_swap(__float_as_uint(rm),__float_as_uint(rm),false,false); rm=__builtin_fmaxf(__uint_as_float(rr[0]),__uint_as_float(rr[1])); } \
      resc=false; \
      if(__builtin_expect(__any(rm>(float)THRL),0)){ const float dl=__builtin_fmaxf(rm,0.f); mhat+=dl; \
        _Pragma("unroll") for(int r=0;r<16;++r){C0[r]-=dl;C1[r]-=dl;} \
        _Pragma("unroll") for(int r=0;r<16;++r)negm[r]=-mhat; asm volatile("":"+v"(negm)); \
        const float f=__builtin_amdgcn_exp2f(-dl); l_reg*=f; if(hi==0)wsf[r32]=f; resc=true; } } \
    SBAR(); \
    GAPB(o[0]=__builtin_amdgcn_mfma_f32_32x32x16_bf16(PAF(0),VFR(0),o[0],0,0,0), C0,0); \
    GAPB(o[1]=__builtin_amdgcn_mfma_f32_32x32x16_bf16(PAF(0),VFR(4),o[1],0,0,0), C0,4); \
    KRD(GL,0); GAPB(o[0]=__builtin_amdgcn_mfma_f32_32x32x16_bf16(PAF(1),VFR(1),o[0],0,0,0), C0,8); \
    KRD(GL,1); GAPB(o[1]=__builtin_amdgcn_mfma_f32_32x32x16_bf16(PAF(1),VFR(5),o[1],0,0,0), C0,12); \
    KRD(GL,2); GAPB(o[0]=__builtin_amdgcn_mfma_f32_32x32x16_bf16(PAF(2),VFR(2),o[0],0,0,0), C1,0); \
    KRD(GL,3); GAPB(o[1]=__builtin_amdgcn_mfma_f32_32x32x16_bf16(PAF(2),VFR(6),o[1],0,0,0), C1,4); \
    GAPB(o[0]=__builtin_amdgcn_mfma_f32_32x32x16_bf16(PAF(3),VFR(3),o[0],0,0,0), C1,8); \
    GAPB(o[1]=__builtin_amdgcn_mfma_f32_32x32x16_bf16(PAF(3),VFR(7),o[1],0,0,0), C1,12); \
    }while(0)
  int t=1;
  #undef CMASK
  #define CMASK(P0,P1,t) do{}while(0)
  for(;t+5<NT;t+=2){
    STEP(pB0,pB1,pA0,pA1,t,true,true,true);     WAIT_BAR(2); RESC(); ROT();
    STEP(pA0,pA1,pB0,pB1,t+1,true,true,true);   WAIT_BAR(2); RESC(); ROT();
  }
  #undef CMASK
  #define CMASK(P0,P1,t) do{int jb_=(t)-(NT-4); if(jb_>=0)cmask(P0,P1,jb_,qrel,hi);}while(0)
  #define ENDW(tt) do{ if((tt)+3<NT){WAIT_BAR(2);} else if((tt)+2<NT){WAIT_BAR(1);} else {WAIT_BAR(0);} }while(0)
  for(;t+1<NT;t+=2){
    STEP(pB0,pB1,pA0,pA1,t,(t+3<NT),(t+1<NT),(t+1<NT));       ENDW(t);   RESC(); ROT();
    STEP(pA0,pA1,pB0,pB1,t+1,(t+4<NT),(t+2<NT),(t+2<NT));     ENDW(t+1); RESC(); ROT();
  }
  STEP(pB0,pB1,pA0,pA1,NT-1,false,false,false); RESC();
  { float sacc=pB0[0]+pB0[1]; _Pragma("unroll") for(int r=2;r<16;++r)sacc+=pB0[r]; _Pragma("unroll") for(int r=0;r<16;++r)sacc+=pB1[r]; l_reg+=sacc;
    pw0=(u32x4){PKW(pB0,0),PKW(pB0,2),PKW(pB0,4),PKW(pB0,6)};pw1=(u32x4){PKW(pB0,8),PKW(pB0,10),PKW(pB0,12),PKW(pB0,14)};pw2=(u32x4){PKW(pB1,0),PKW(pB1,2),PKW(pB1,4),PKW(pB1,6)};pw3=(u32x4){PKW(pB1,8),PKW(pB1,10),PKW(pB1,12),PKW(pB1,14)};
    SBAR(); pv(o,vb0+sl_cur,PAF(0),PAF(1),PAF(2),PAF(3)); }
  #undef PKW
  #undef PAF
  #undef VFR
  #undef PIN
  #undef MX3
  #undef GAPA
  #undef GAPB
  #undef EX
  #undef VRD
  #undef KRD
  #undef STEP
  #undef ENDW
  {auto rr=__builtin_amdgcn_permlane32_swap(__float_as_uint(l_reg),__float_as_uint(l_reg),false,false);l_reg=__uint_as_float(rr[0])+__uint_as_float(rr[1]);}
  if(hi==0)wsf[32+r32]=l_reg;asm volatile("s_waitcnt lgkmcnt(0)":::"memory");
  float rli[16];
  #pragma unroll
  for(int r=0;r<16;++r)rli[r]=__builtin_amdgcn_rcpf(wsf[32+crow(r,hi)]);
  bf16*Ow=O+(rowbase+q0+wid*QBLK)*PITO;
  { bf16*stg=(bf16*)(shm+LDS_OST)+wid*2048;
    #pragma unroll
    for(int r=0;r<16;++r){const int orow=crow(r,hi);
      #pragma unroll
      for(int d0=0;d0<2;++d0)stg[orow*64+d0*32+r32]=__float2bfloat16(o[d0][r]*rli[r]);}
    asm volatile("s_waitcnt lgkmcnt(0)":::"memory");
    #pragma unroll
    for(int i=0;i<4;++i){const int row=i*8+(lane>>3),ch=lane&7; const u32x4 v=*(const u32x4*)(stg+row*64+ch*8); ATTN_STORE16(Ow+(long)row*PITO+ch*8,v);} }
  asm volatile("s_waitcnt lgkmcnt(0)\n\ts_barrier":::"memory");
  #undef DMA_K
  #undef DMA_V
  #undef CMASK
  #undef START
  #undef RESC
  #undef ROT
}
constexpr int ATTN_LDS_BYTES=LDS_BYTES;
#undef SBAR
#undef WAIT_BAR
}

namespace cg = cooperative_groups;
typedef unsigned short bf16_t;
typedef float f32x4 __attribute__((ext_vector_type(4)));
typedef float f32x16 __attribute__((ext_vector_type(16)));
typedef unsigned u32x4 __attribute__((ext_vector_type(4)));
typedef unsigned u32x2 __attribute__((ext_vector_type(2)));
typedef short bf16x8 __attribute__((ext_vector_type(8)));
#define LAS3 __attribute__((address_space(3)))

constexpr int T_ = 32768, DM_ = 1024, SEQ_ = 4096, DFF_ = 2816;
constexpr int NTHR = 512;
constexpr int LDS_BYTES = 147456;
constexpr size_t MiB_ = 1u << 20;
constexpr size_t WS_MOD = 0, WS_COS = 1 * MiB_, WS_SIN = 2 * MiB_, WS_BAR = 3 * MiB_;
constexpr size_t WS_WIN = 4 * MiB_, WS_WOUT = 11 * MiB_, WS_FIN = 13 * MiB_, WS_FOUT = 24 * MiB_;
constexpr size_t WS_A = 32 * MiB_, WS_X2 = 96 * MiB_, WS_ST = 160 * MiB_, WS_TOT = 224 * MiB_, WS_R1 = 226 * MiB_, WS_BIAS = 450 * MiB_, WS_ROWSS = 452 * MiB_, WS_FOUT2 = 454 * MiB_, WS_END = 460 * MiB_;
constexpr int BIAS_L = 8 * (3584 + 5632);
constexpr size_t WS_HP = WS_ST, WS_HU = WS_ST + 12 * MiB_, WS_HA = WS_ST + 24 * MiB_;
constexpr float LOG2E_ = 1.4426950408889634f;
constexpr float QSCALE_ = 0.125f * 1.4426950408889634f;

struct Params {
    const float* x; const float* c; const int* positions; const float* mod_w; const float* mod_b; const float* norm_mix_w; const float* norm_ffn_w;
    const float* ev_w_in; const float* gla_gate_w; const float* gla_gate_b; const float* gla_norm_w; const float* swa_sinks; const float* ev_w_out;
    const float* od_w_in; const float* diff_lambda; const float* diff_norm_w; const float* hgrn_lb_logits; const float* hgrn_norm_w; const float* od_w_out;
    const float* ffn_w_in; const float* ffn_conv_w; const float* ffn_conv_b; const float* ffn_w_out; const float* final_norm_w;
    float* out; unsigned char* ws; unsigned long long pad[6];
};

__device__ __forceinline__ unsigned pk2(float lo, float hi) {
    typedef float f32x2_t __attribute__((ext_vector_type(2))); typedef __bf16 bf16x2_t __attribute__((ext_vector_type(2)));
    f32x2_t v = {lo, hi}; bf16x2_t b = __builtin_convertvector(v, bf16x2_t); return __builtin_bit_cast(unsigned, b);
}
__device__ __forceinline__ float bflo(unsigned u) { return __uint_as_float(u << 16); }
__device__ __forceinline__ float bfhi(unsigned u) { return __uint_as_float(u & 0xffff0000u); }
__device__ __forceinline__ float sigmoidf_(float x) { return __builtin_amdgcn_rcpf(1.f + __expf(-x)); }
__device__ __forceinline__ float siluf_(float x) { return x * __builtin_amdgcn_rcpf(1.f + __expf(-x)); }
__device__ __forceinline__ float wave_sum(float v) {
#pragma unroll
    for (int o = 1; o < 64; o <<= 1) v += __shfl_xor(v, o);
    return v;
}
__device__ __forceinline__ int crow_(int r, int hi) { return (r & 3) + 8 * (r >> 2) + 4 * hi; }

namespace pg8 {
struct EpiProj {
    static constexpr bool PERM = true, AFTER_DRAIN = false;
    bf16_t* O; int ldc; unsigned ropemask; unsigned scalemask; float scale; const float* cs; const float* sn; const float* rowss; const float* bias;
    __device__ __forceinline__ void operator()(const f32x4 (&acc)[2][2][4][2], const Unit& u, int, int, int, int) const {
        const int t_ = otid_(), l_ = t_ & 63, fr = l_ & 15, fq = l_ >> 4, wid_ = __builtin_amdgcn_readfirstlane(t_ >> 6), wr = wid_ >> 2, wc = wid_ & 3;
        const int row0 = u.pm * BM + wr * 64 + fr; const int col0 = u.pn * BM + wc * 32 + 8 * fq;
        float rs[2][4];
#pragma unroll
        for (int ai = 0; ai < 2; ++ai)
#pragma unroll
            for (int m = 0; m < 4; ++m) rs[ai][m] = rsqrtf(rowss[row0 + ai * HALF + m * 16] * (1.f / 1024.f) + 1e-6f);
        const float* bp = bias + (size_t)((u.pm * BM) >> 12) * ldc + col0;
#pragma unroll
        for (int bj = 0; bj < 2; ++bj) {
            const f32x4 bv0 = *(const f32x4*)(bp + bj * HALF), bv1 = *(const f32x4*)(bp + bj * HALF + 4);
            const int grp = u.pn * 2 + bj;
            const bool rope = ((ropemask >> grp) & 1u) && ((wc & 1) == 0);
            const float sc = ((scalemask >> grp) & 1u) ? scale : 1.f;
#pragma unroll
            for (int ai = 0; ai < 2; ++ai)
#pragma unroll
                for (int m = 0; m < 4; ++m) {
                    const int row = row0 + ai * HALF + m * 16;
                    f32x4 v0 = acc[ai][bj][m][0] * rs[ai][m] + bv0, v1 = acc[ai][bj][m][1] * rs[ai][m] + bv1;
                    if (rope) {
                        const f32x4 c0 = *(const f32x4*)(cs + (size_t)row * 8), c1 = *(const f32x4*)(cs + (size_t)row * 8 + 4);
                        const f32x4 s0 = *(const f32x4*)(sn + (size_t)row * 8), s1 = *(const f32x4*)(sn + (size_t)row * 8 + 4);
                        const float sg = (fq == 0) ? -1.f : 1.f;
#pragma unroll
                        for (int e = 0; e < 4; ++e) {
                            const float p0 = __shfl_xor(v0[e], 16), p1 = __shfl_xor(v1[e], 16);
                            const float r0 = v0[e] * c0[e] + sg * p0 * s0[e], r1 = v1[e] * c1[e] + sg * p1 * s1[e];
                            if (fq < 2) { v0[e] = r0; v1[e] = r1; }
                        }
                    }
                    v0 = v0 * sc; v1 = v1 * sc;
                    u32x4 w; w.x = pk2(v0[0], v0[1]); w.y = pk2(v0[2], v0[3]); w.z = pk2(v1[0], v1[1]); w.w = pk2(v1[2], v1[3]);
                    *(u32x4*)(O + (size_t)row * ldc + col0 + bj * HALF) = w;
                    asm volatile("" ::: "memory");
                }
        }
    }
};
typedef _Float16 h16x2 __attribute__((ext_vector_type(2)));
__device__ __forceinline__ unsigned pkh2(float lo, float hi) { typedef float f32x2_t __attribute__((ext_vector_type(2))); f32x2_t v = {lo, hi}; return __builtin_bit_cast(unsigned, __builtin_convertvector(v, h16x2)); }
__device__ __forceinline__ f32x4 unpkh4(unsigned w0, unsigned w1) { const h16x2 a = __builtin_bit_cast(h16x2, w0), b = __builtin_bit_cast(h16x2, w1); return (f32x4){(float)a[0], (float)a[1], (float)b[0], (float)b[1]}; }
struct EpiRes {
    static constexpr bool PERM = true, AFTER_DRAIN = false;
    const void* xin; void* xout; int inf32, outf32; const float* gate;
    bf16_t* Aout; const float* nw; const float* sc; float* rowss;
    __device__ __forceinline__ void operator()(const f32x4 (&acc)[2][2][4][2], const Unit& u, int, int, int, int) const {
        const int t_ = otid_(), l_ = t_ & 63, fr = l_ & 15, fq = l_ >> 4, wid_ = __builtin_amdgcn_readfirstlane(t_ >> 6), wr = wid_ >> 2, wc = wid_ & 3;
        const int col0 = u.pn * BM + wc * 32 + 8 * fq;
        const size_t boff = (size_t)((u.pm * BM) >> 12) * 6144 + col0;
        f32x4 gv[2][2];
#pragma unroll
        for (int bj = 0; bj < 2; ++bj)
#pragma unroll
            for (int n = 0; n < 2; ++n) gv[bj][n] = *(const f32x4*)(gate + boff + bj * HALF + n * 4);
        const int rowb = u.pm * BM + wr * 64 + fr;
        const unsigned eo0 = (unsigned)rowb * 1024u + (unsigned)col0;
        const char* xi = (const char*)xin; char* xo = (char*)xout; char* ao = (char*)Aout;
#pragma unroll
        for (int grp = 0; grp < 8; ++grp) {
            const int ai = grp >> 2, m = grp & 3;
            const unsigned eo = eo0 + (unsigned)(ai * HALF + m * 16) * 1024u;
            float ss = 0.f;
#pragma unroll
            for (int bj = 0; bj < 2; ++bj) {
                const unsigned e2 = eo + (unsigned)(bj * HALF);
                f32x4 x0, x1;
                if (inf32) { x0 = *(const f32x4*)(xi + e2 * 4u); x1 = *(const f32x4*)(xi + e2 * 4u + 16u); }
                else { const u32x4 h = *(const u32x4*)(xi + e2 * 2u); x0 = unpkh4(h.x, h.y); x1 = unpkh4(h.z, h.w); }
                const f32x4 xn0 = x0 + gv[bj][0] * acc[ai][bj][m][0], xn1 = x1 + gv[bj][1] * acc[ai][bj][m][1];
                if (outf32) { *(f32x4*)(xo + e2 * 4u) = xn0; *(f32x4*)(xo + e2 * 4u + 16u) = xn1; }
                else { u32x4 h; h.x = pkh2(xn0[0], xn0[1]); h.y = pkh2(xn0[2], xn0[3]); h.z = pkh2(xn1[0], xn1[1]); h.w = pkh2(xn1[2], xn1[3]); *(u32x4*)(xo + e2 * 2u) = h; }
                if (Aout) {
                    ss += ((xn0[0] * xn0[0] + xn0[1] * xn0[1]) + (xn0[2] * xn0[2] + xn0[3] * xn0[3])) + ((xn1[0] * xn1[0] + xn1[1] * xn1[1]) + (xn1[2] * xn1[2] + xn1[3] * xn1[3]));
                    const f32x4 a0 = xn0 * (*(const f32x4*)(nw + col0 + bj * HALF) * (*(const f32x4*)(sc + boff + bj * HALF) + 1.f));
                    const f32x4 a1 = xn1 * (*(const f32x4*)(nw + col0 + bj * HALF + 4) * (*(const f32x4*)(sc + boff + bj * HALF + 4) + 1.f));
                    u32x4 q; q.x = pk2(a0[0], a0[1]); q.y = pk2(a0[2], a0[3]); q.z = pk2(a1[0], a1[1]); q.w = pk2(a1[2], a1[3]);
                    *(u32x4*)(ao + e2 * 2u) = q;
                }
            }
            if (Aout) {
                ss += __shfl_xor(ss, 16); ss += __shfl_xor(ss, 32);
                if (fq == 0) atomicAdd(rowss + rowb + ai * HALF + m * 16, ss);
            }
            asm volatile("" ::: "memory");
        }
    }
};
struct EpiFfn {
    static constexpr bool PERM = true, AFTER_DRAIN = false;
    bf16_t* G; float* HP; float* HU; float* HA; const float* cw; const float* cb; const float* rowss; const float* bias;
    __device__ __forceinline__ void operator()(const f32x4 (&acc)[2][2][4][2], const Unit& u, int, int, int, int) const {
        const int t_ = otid_(), l_ = t_ & 63, fr = l_ & 15, fq = l_ >> 4, wid_ = __builtin_amdgcn_readfirstlane(t_ >> 6), wr = wid_ >> 2, wc = wid_ & 3;
        const int ch0 = u.pn * 128 + wc * 32 + 8 * fq;
        f32x4 w0[2], w1[2], w2[2], bb[2];
#pragma unroll
        for (int n = 0; n < 2; ++n) { w0[n] = *(const f32x4*)(cw + ch0 + 4 * n); w1[n] = *(const f32x4*)(cw + DFF_ + ch0 + 4 * n); w2[n] = *(const f32x4*)(cw + 2 * DFF_ + ch0 + 4 * n); bb[n] = *(const f32x4*)(cb + ch0 + 4 * n); }
        const int lane = fr + 16 * fq;
        const int src1 = (lane & ~15) | ((fr + 15) & 15), src2 = (lane & ~15) | ((fr + 14) & 15);
        const float* bp = bias + (size_t)((u.pm * BM) >> 12) * 5632 + u.pn * BM + wc * 32 + 8 * fq;
        f32x4 ba[2], bu[2];
#pragma unroll
        for (int n = 0; n < 2; ++n) { ba[n] = *(const f32x4*)(bp + 4 * n); bu[n] = *(const f32x4*)(bp + HALF + 4 * n); }
#pragma unroll
        for (int ai = 0; ai < 2; ++ai) {
            const int seg = u.pm * 4 + ai * 2 + wr;
            f32x4 aprev[2]; aprev[0] = (f32x4){0.f, 0.f, 0.f, 0.f}; aprev[1] = (f32x4){0.f, 0.f, 0.f, 0.f};
#pragma unroll
            for (int m = 0; m < 4; ++m) {
                const int row = u.pm * BM + ai * HALF + wr * 64 + m * 16 + fr;
                const float rs = rsqrtf(rowss[row] * (1.f / 1024.f) + 1e-6f);
                f32x4 val[2], acur[2];
#pragma unroll
                for (int n = 0; n < 2; ++n) {
                    const f32x4 a = acc[ai][0][m][n] * rs + ba[n];
                    acur[n] = a;
                    const f32x4 ap = aprev[n];
#pragma unroll
                    for (int e = 0; e < 4; ++e) {
                        const float t1 = (fr == 15) ? ap[e] : a[e];
                        const float t2 = (fr >= 14) ? ap[e] : a[e];
                        const float p1 = __shfl(t1, src1), p2 = __shfl(t2, src2);
                        val[n][e] = w2[n][e] * a[e] + w1[n][e] * p1 + w0[n][e] * p2 + bb[n][e];
                    }
                }
                const f32x4 u0 = acc[ai][1][m][0] * rs + bu[0], u1 = acc[ai][1][m][1] * rs + bu[1];
                f32x4 g0, g1;
#pragma unroll
                for (int e = 0; e < 4; ++e) { g0[e] = siluf_(val[0][e]) * u0[e]; g1[e] = siluf_(val[1][e]) * u1[e]; }
                u32x4 w; w.x = pk2(g0[0], g0[1]); w.y = pk2(g0[2], g0[3]); w.z = pk2(g1[0], g1[1]); w.w = pk2(g1[2], g1[3]);
                *(u32x4*)(G + (size_t)row * DFF_ + ch0) = w;
                if (m == 0 && fr < 2) {
                    const size_t ho = (size_t)(seg * 2 + fr) * DFF_ + ch0;
                    *(f32x4*)(HP + ho) = val[0]; *(f32x4*)(HP + ho + 4) = val[1];
                    *(f32x4*)(HU + ho) = u0; *(f32x4*)(HU + ho + 4) = u1;
                }
                if (m == 3 && fr >= 14) {
                    const size_t ho = (size_t)(seg * 2 + (fr - 14)) * DFF_ + ch0;
                    *(f32x4*)(HA + ho) = acur[0]; *(f32x4*)(HA + ho + 4) = acur[1];
                }
                aprev[0] = acur[0]; aprev[1] = acur[1];
                asm volatile("" ::: "memory");
            }
        }
    }
};
}

struct Ctx { Params p; unsigned char* lds; int tid, lane, wave, gw, ngw; };

__device__ __forceinline__ void phase_prologue(const Ctx& C) {
    const Params& p = C.p;
    float* cact = (float*)C.lds;
    float* red = (float*)(C.lds + 32768);
    float* mod = (float*)(p.ws + WS_MOD);
    const int tid = C.tid;
    for (int i = tid; i < 8192; i += NTHR) { const float c = p.c[i]; cact[i] = c / (1.f + __expf(-c)); }
    __syncthreads();
    const int col = tid & 63, kp = tid >> 6;
    for (int g = blockIdx.x; g < 384; g += gridDim.x) {
        const int l = g / 96, j = (g % 96) * 64 + col;
        const float* w = p.mod_w + (size_t)l * 1024 * 6144 + (size_t)(kp * 128) * 6144 + j;
        float a0 = 0.f, a1 = 0.f, a2 = 0.f, a3 = 0.f, a4 = 0.f, a5 = 0.f, a6 = 0.f, a7 = 0.f;
        const float* ca = cact + kp * 128;
#pragma unroll 8
        for (int k = 0; k < 128; ++k) {
            const float wv = w[(size_t)k * 6144];
            a0 += ca[k] * wv; a1 += ca[1024 + k] * wv; a2 += ca[2048 + k] * wv; a3 += ca[3072 + k] * wv;
            a4 += ca[4096 + k] * wv; a5 += ca[5120 + k] * wv; a6 += ca[6144 + k] * wv; a7 += ca[7168 + k] * wv;
        }
        float* r = red + (kp * 8) * 64 + col;
        r[0] = a0; r[64] = a1; r[128] = a2; r[192] = a3; r[256] = a4; r[320] = a5; r[384] = a6; r[448] = a7;
        __syncthreads();
        { const int b = tid >> 6; float s = 0.f;
#pragma unroll
          for (int kk = 0; kk < 8; ++kk) s += red[(kk * 8 + b) * 64 + col];
          mod[(size_t)(l * 8 + b) * 6144 + j] = s + p.mod_b[l * 6144 + j]; }
        __syncthreads();
    }
    {
        u32x4* zb = (u32x4*)(p.ws + WS_BIAS); const int nzb = 4 * BIAS_L * 4 / 16;
        for (int i = blockIdx.x * NTHR + tid; i < nzb; i += gridDim.x * NTHR) zb[i] = (u32x4){0u, 0u, 0u, 0u};
        u32x4* zr = (u32x4*)(p.ws + WS_ROWSS);
        for (int i = blockIdx.x * NTHR + tid; i < 8 * T_ * 4 / 16; i += gridDim.x * NTHR) zr[i] = (u32x4){0u, 0u, 0u, 0u};
    }
    float* cs = (float*)(p.ws + WS_COS); float* sn = (float*)(p.ws + WS_SIN);
    const float invf[8] = {1.0f, 0.1939227432012558f, 0.03760603070259094f, 0.007292664609849453f, 0.0014142135623842478f, 0.00027424818836152554f, 5.3182957344688475e-05f, 1.0313385246263351e-05f};
    for (int r = blockIdx.x * NTHR + tid; r < T_; r += gridDim.x * NTHR) {
        const float pos = (float)p.positions[r];
        f32x4 c4[2], s4[2];
#pragma unroll
        for (int i = 0; i < 8; ++i) {
            const float ang = pos * invf[i];
            const double xr = (double)ang * 0.15915494309189535;
            const float f = (float)(xr - rint(xr));
            c4[i >> 2][i & 3] = __builtin_amdgcn_cosf(f); s4[i >> 2][i & 3] = __builtin_amdgcn_sinf(f);
        }
        *(f32x4*)(cs + (size_t)r * 8) = c4[0]; *(f32x4*)(cs + (size_t)r * 8 + 4) = c4[1];
        *(f32x4*)(sn + (size_t)r * 8) = s4[0]; *(f32x4*)(sn + (size_t)r * 8 + 4) = s4[1];
    }
}

__device__ __forceinline__ void tr_item(const float* W, int Nsrc, int srccol0, bf16_t* WT, int K, int dstrow0, int k0, float* scr, int lane) {
    float wv[32];
#pragma unroll
    for (int i = 0; i < 32; ++i) wv[i] = W[(size_t)(k0 + 2 * i + (lane >> 5)) * Nsrc + srccol0 + (lane & 31)];
#pragma unroll
    for (int i = 0; i < 32; ++i) scr[(2 * i + (lane >> 5)) * 33 + (lane & 31)] = wv[i];
    asm volatile("s_waitcnt lgkmcnt(0)" ::: "memory");
    const int c = lane & 7;
#pragma unroll
    for (int j = 0; j < 4; ++j) { const int n = (lane >> 3) + 8 * j; const float* s = scr + (8 * c) * 33 + n;
        u32x4 o; o.x = pk2(s[0 * 33], s[1 * 33]); o.y = pk2(s[2 * 33], s[3 * 33]); o.z = pk2(s[4 * 33], s[5 * 33]); o.w = pk2(s[6 * 33], s[7 * 33]);
        *(u32x4*)(WT + (size_t)(dstrow0 + n) * K + k0 + 8 * c) = o; }
    asm volatile("s_waitcnt lgkmcnt(0)" ::: "memory");
}
__device__ __forceinline__ void phase_convert(const Ctx& C, int l, bool do_bias = true) {
    const Params& p = C.p; const int j = l >> 1; const bool even = !(l & 1);
    float* scr = (float*)(C.lds + C.wave * 8704);
    bf16_t* WIN = (bf16_t*)(p.ws + WS_WIN); bf16_t* WOUT = (bf16_t*)(p.ws + WS_WOUT); bf16_t* FIN = (bf16_t*)(p.ws + WS_FIN); bf16_t* FOUT = (bf16_t*)(p.ws + ((l & 1) ? WS_FOUT2 : WS_FOUT));
    const int nA = even ? 80 : 112;
    const int IA = 16 * nA, IB = 16 * 32, IC = 16 * 176, ID = 44 * 32;
    const float* win = even ? p.ev_w_in + (size_t)j * 1024 * 2320 : p.od_w_in + (size_t)j * 1024 * 3584;
    const float* wout = even ? p.ev_w_out + (size_t)j * 1024 * 1024 : p.od_w_out + (size_t)j * 1024 * 1024;
    const float* fin = p.ffn_w_in + (size_t)l * 1024 * 5632; const float* fout = p.ffn_w_out + (size_t)l * 2816 * 1024;
    for (int it = C.gw; it < IA + IB + IC + ID; it += C.ngw) {
        int r = it;
        if (r < IA) { const int kb = r / nA, nb = r % nA, n0 = nb * 32; int sc = n0;
            if (even) { if (n0 >= 512 && n0 < 768) continue; if (n0 >= 1792) sc = n0 - 240; else if (n0 >= 768) sc = n0 - 256; }
            tr_item(win, even ? 2320 : 3584, sc, WIN, 1024, n0, kb * 64, scr, C.lane); continue; }
        r -= IA;
        if (r < IB) { const int kb = r / 32, nb = r % 32; tr_item(wout, 1024, nb * 32, WOUT, 1024, nb * 32, kb * 64, scr, C.lane); continue; }
        r -= IB;
        if (r < IC) { const int kb = r / 176, nb = r % 176, n0 = nb * 32; const int pn = n0 >> 8, jj = n0 & 255;
            const int sc = (jj < 128) ? pn * 128 + jj : 2816 + pn * 128 + (jj - 128);
            tr_item(fin, 5632, sc, FIN, 1024, n0, kb * 64, scr, C.lane); continue; }
        r -= IC;
        { const int kb = r / 32, nb = r % 32; tr_item(fout, 1024, nb * 32, FOUT, 2816, nb * 32, kb * 64, scr, C.lane); }
    }
    if (do_bias) {
        float* shl = (float*)(C.lds + 69632);
        const float* modl = (const float*)(p.ws + WS_MOD) + (size_t)l * 8 * 6144;
        __syncthreads();
        for (int i2 = C.tid; i2 < 2 * 8192; i2 += NTHR) { const int which = i2 >> 13, k = (i2 >> 3) & 1023, b = i2 & 7; shl[i2] = modl[(size_t)b * 6144 + (which ? 3072 : 0) + k]; }
        __syncthreads();
        float* bias_in = (float*)(p.ws + WS_BIAS) + (size_t)l * BIAS_L; float* bias_ff = bias_in + 8 * 3584;
        const int Nin = even ? 2560 : 3584, Nsrc = even ? 2320 : 3584;
        const float* gwp = p.gla_gate_w + (size_t)j * 16 * 256;
        for (int u = blockIdx.x * NTHR + C.tid; u < (Nin + 5632) * 16; u += gridDim.x * NTHR) {
            const bool ff = u >= Nin * 16; const int uu = ff ? u - Nin * 16 : u, N = ff ? 5632 : Nin, n = uu % N, kp = uu / N;
            float a[8];
#pragma unroll
            for (int b = 0; b < 8; ++b) a[b] = 0.f;
            const float* shp = shl + (ff ? 8192 : 0) + kp * 64 * 8;
            if (!ff && even && n >= 512 && n < 768) {
                float g[16];
#pragma unroll
                for (int r = 0; r < 16; ++r) g[r] = gwp[r * 256 + (n - 512)];
                for (int k = 0; k < 64; ++k) {
                    const float* wr = win + (size_t)(kp * 64 + k) * 2320 + 1536;
                    float wv = 0.f;
#pragma unroll
                    for (int r = 0; r < 16; ++r) wv += wr[r] * g[r];
                    const f32x4 s0 = *(const f32x4*)(shp + k * 8), s1 = *(const f32x4*)(shp + k * 8 + 4);
                    a[0] += s0[0] * wv; a[1] += s0[1] * wv; a[2] += s0[2] * wv; a[3] += s0[3] * wv; a[4] += s1[0] * wv; a[5] += s1[1] * wv; a[6] += s1[2] * wv; a[7] += s1[3] * wv;
                }
            } else {
                int sc; const float* W; int Ns;
                if (ff) { const int pn = n >> 8, jj = n & 255; sc = (jj < 128) ? pn * 128 + jj : 2816 + pn * 128 + (jj - 128); W = fin; Ns = 5632; }
                else { sc = n; if (even) { if (n >= 1792) sc = n - 240; else if (n >= 768) sc = n - 256; } W = win; Ns = Nsrc; }
                const float* wp = W + (size_t)(kp * 64) * Ns + sc;
#pragma unroll 8
                for (int k = 0; k < 64; ++k) {
                    const float wv = wp[(size_t)k * Ns];
                    const f32x4 s0 = *(const f32x4*)(shp + k * 8), s1 = *(const f32x4*)(shp + k * 8 + 4);
                    a[0] += s0[0] * wv; a[1] += s0[1] * wv; a[2] += s0[2] * wv; a[3] += s0[3] * wv; a[4] += s1[0] * wv; a[5] += s1[1] * wv; a[6] += s1[2] * wv; a[7] += s1[3] * wv;
                }
            }
            float* bo = (ff ? bias_ff : bias_in) + n;
#pragma unroll
            for (int b = 0; b < 8; ++b) atomicAdd(bo + (size_t)b * N, a[b]);
        }
    }
    if (even) {
        const float* gw = p.gla_gate_w + (size_t)j * 16 * 256;
        for (int u = blockIdx.x * NTHR + C.tid; u < 256 * 128; u += gridDim.x * NTHR) {
            const int k8 = u & 127, n = u >> 7;
            float g[16];
#pragma unroll
            for (int r = 0; r < 16; ++r) g[r] = gw[r * 256 + n];
            float o[8];
#pragma unroll
            for (int e = 0; e < 8; ++e) {
                const float* wr = win + (size_t)(k8 * 8 + e) * 2320 + 1536;
                const f32x4 a0 = *(const f32x4*)wr, a1 = *(const f32x4*)(wr + 4), a2 = *(const f32x4*)(wr + 8), a3 = *(const f32x4*)(wr + 12);
                o[e] = a0[0] * g[0] + a0[1] * g[1] + a0[2] * g[2] + a0[3] * g[3] + a1[0] * g[4] + a1[1] * g[5] + a1[2] * g[6] + a1[3] * g[7]
                     + a2[0] * g[8] + a2[1] * g[9] + a2[2] * g[10] + a2[3] * g[11] + a3[0] * g[12] + a3[1] * g[13] + a3[2] * g[14] + a3[3] * g[15];
            }
            u32x4 w; w.x = pk2(o[0], o[1]); w.y = pk2(o[2], o[3]); w.z = pk2(o[4], o[5]); w.w = pk2(o[6], o[7]);
            *(u32x4*)(WIN + (size_t)(512 + n) * 1024 + k8 * 8) = w;
        }
    }
}

__device__ __forceinline__ void phase_prep(const Ctx& C, const float* xin, const float* w, const float* modl, int scoff, bf16_t* out, float* rowss) {
    for (int row = C.gw; row < T_; row += C.ngw) {
        const f32x4* xr = (const f32x4*)(xin + (size_t)row * 1024) + C.lane;
        f32x4 v[4]; float ss = 0.f;
#pragma unroll
        for (int j = 0; j < 4; ++j) { v[j] = xr[64 * j]; ss += (v[j].x * v[j].x + v[j].y * v[j].y) + (v[j].z * v[j].z + v[j].w * v[j].w); }
        ss = wave_sum(ss);
        if (C.lane == 0) rowss[row] = ss;
        const float* mb = modl + (size_t)(row >> 12) * 6144;
        u32x2* o8 = (u32x2*)(out + (size_t)row * 1024) + C.lane;
#pragma unroll
        for (int j = 0; j < 4; ++j) {
            const int col = 4 * C.lane + 256 * j;
            const f32x4 w4 = *(const f32x4*)(w + col), sc = *(const f32x4*)(mb + scoff + col);
            const f32x4 y = v[j] * w4 * (sc + 1.f);
            u32x2 q; q.x = pk2(y.x, y.y); q.y = pk2(y.z, y.w); o8[64 * j] = q;
        }
    }
}
__device__ __forceinline__ void phase_final_norm(const Ctx& C, const void* xin  , float* out, const float* w) {
    for (int row = C.gw; row < T_; row += C.ngw) {
        const u32x2* xr = (const u32x2*)((const char*)xin + (size_t)row * 2048) + C.lane;
        f32x4* orow = (f32x4*)(out + (size_t)row * 1024) + C.lane;
        f32x4 v[4]; float ss = 0.f;
#pragma unroll
        for (int j = 0; j < 4; ++j) { const u32x2 h = xr[64 * j]; v[j] = pg8::unpkh4(h.x, h.y); ss += (v[j].x * v[j].x + v[j].y * v[j].y) + (v[j].z * v[j].z + v[j].w * v[j].w); }
        const float rs = rsqrtf(wave_sum(ss) * (1.f / 1024.f) + 1e-6f);
#pragma unroll
        for (int j = 0; j < 4; ++j) { const f32x4 w4 = *(const f32x4*)(w + 4 * C.lane + 256 * j); orow[64 * j] = (v[j] * rs) * w4; }
    }
}

__device__ __forceinline__ void phase_diff_combine(const Ctx& C, int l) {
    const Params& p = C.p; const int j = l >> 1;
    const float lam_init = 0.8f - 0.6f * expf(-0.3f * (float)l);
    const float* lv = p.diff_lambda + j * 256;
    const float s1 = wave_sum(lv[C.lane] * lv[64 + C.lane]), s2 = wave_sum(lv[128 + C.lane] * lv[192 + C.lane]);
    const float lam = expf(s1) - expf(s2) + lam_init;
    const bf16_t* X2 = (const bf16_t*)(p.ws + WS_X2); bf16_t* A = (bf16_t*)(p.ws + WS_A);
    const int head = C.lane >> 4, d0 = (C.lane & 15) * 8;
    const float* nw = p.diff_norm_w + j * 128 + d0;
    const f32x4 n0 = *(const f32x4*)nw, n1 = *(const f32x4*)(nw + 4);
    const float og = 1.f - lam_init;
    for (int row = C.gw; row < T_; row += C.ngw) {
        const bf16_t* src = X2 + (size_t)row * 1024 + head * 256 + d0;
        const u32x4 a = *(const u32x4*)src, b = *(const u32x4*)(src + 128);
        float od[8];
        od[0] = bflo(a.x) - lam * bflo(b.x); od[1] = bfhi(a.x) - lam * bfhi(b.x); od[2] = bflo(a.y) - lam * bflo(b.y); od[3] = bfhi(a.y) - lam * bfhi(b.y);
        od[4] = bflo(a.z) - lam * bflo(b.z); od[5] = bfhi(a.z) - lam * bfhi(b.z); od[6] = bflo(a.w) - lam * bflo(b.w); od[7] = bfhi(a.w) - lam * bfhi(b.w);
        float ss = 0.f;
#pragma unroll
        for (int e = 0; e < 8; ++e) ss += od[e] * od[e];
        ss += __shfl_xor(ss, 1); ss += __shfl_xor(ss, 2); ss += __shfl_xor(ss, 4); ss += __shfl_xor(ss, 8);
        const float rs = rsqrtf(ss * (1.f / 128.f) + 1e-6f) * og;
        u32x4 w; w.x = pk2(od[0] * rs * n0[0], od[1] * rs * n0[1]); w.y = pk2(od[2] * rs * n0[2], od[3] * rs * n0[3]);
        w.z = pk2(od[4] * rs * n1[0], od[5] * rs * n1[1]); w.w = pk2(od[6] * rs * n1[2], od[7] * rs * n1[3]);
        *(u32x4*)(A + (size_t)row * 1024 + head * 128 + d0) = w;
    }
}

__device__ __forceinline__ void phase_ffn_fixup(const Ctx& C, int l) {
    const Params& p = C.p;
    const float* HP = (const float*)(p.ws + WS_HP); const float* HU = (const float*)(p.ws + WS_HU); const float* HA = (const float*)(p.ws + WS_HA);
    bf16_t* G = (bf16_t*)(p.ws + WS_R1);
    const float* cw = p.ffn_conv_w + (size_t)l * 3 * DFF_;
    for (int u = blockIdx.x * NTHR + C.tid; u < 512 * 2 * 704; u += gridDim.x * NTHR) {
        const int c4 = u % 704, sj = u / 704, jj = sj & 1, seg = sj >> 1, ch = c4 * 4;
        const size_t ho = (size_t)sj * DFF_ + ch;
        f32x4 val = *(const f32x4*)(HP + ho); const f32x4 uu = *(const f32x4*)(HU + ho);
        if ((seg & 63) != 0) {
            const f32x4 am1 = *(const f32x4*)(HA + (size_t)((seg - 1) * 2 + 1) * DFF_ + ch), am2 = *(const f32x4*)(HA + (size_t)((seg - 1) * 2) * DFF_ + ch);
            const f32x4 w0 = *(const f32x4*)(cw + ch), w1 = *(const f32x4*)(cw + DFF_ + ch);
            if (jj == 0) val = val + w1 * am1 + w0 * am2; else val = val + w0 * am1;
        }
        u32x2 q; q.x = pk2(siluf_(val.x) * uu.x, siluf_(val.y) * uu.y); q.y = pk2(siluf_(val.z) * uu.z, siluf_(val.w) * uu.w);
        *(u32x2*)(G + (size_t)(seg * 64 + jj) * DFF_ + ch) = q;
    }
}

__device__ __forceinline__ void phase_swa(const Ctx& C, int l) {
    const Params& p = C.p;
    const bf16_t* proj = (const bf16_t*)(p.ws + WS_R1); bf16_t* A = (bf16_t*)(p.ws + WS_A);
    bf16_t* Ks = (bf16_t*)C.lds;
    bf16_t* Vt = (bf16_t*)(C.lds + 27648);
    const int tid = C.tid, lane = C.lane, wid = C.wave, r32 = lane & 31, hi = lane >> 5;
    const float* sinks = p.swa_sinks + (l >> 1) * 8;
    u32x4 kreg[3], vreg[3];
#define SWA_FETCH(uu) do { const int b_ = (uu) >> 7, kvh_ = ((uu) >> 6) & 1, q0_ = ((uu) & 63) * 64; const size_t rb_ = (size_t)b_ * SEQ_; \
        _Pragma("unroll") for (int i_ = 0; i_ < 3; ++i_) { const int c_ = tid + i_ * NTHR; \
            { const int kk_ = c_ >> 3, ch_ = c_ & 7, pl_ = q0_ - 128 + kk_; kreg[i_] = (u32x4){0u, 0u, 0u, 0u}; if (pl_ >= 0) kreg[i_] = *(const u32x4*)(proj + (rb_ + pl_) * 2560 + 2304 + kvh_ * 64 + ch_ * 8); } \
            { const int kk_ = c_ % 192, ch_ = c_ / 192, pl_ = q0_ - 128 + kk_; vreg[i_] = (u32x4){0u, 0u, 0u, 0u}; if (pl_ >= 0) vreg[i_] = *(const u32x4*)(proj + (rb_ + pl_) * 2560 + 2432 + kvh_ * 64 + ch_ * 8); } } } while (0)
    if ((int)blockIdx.x < 1024) SWA_FETCH((int)blockIdx.x);
    for (int u = blockIdx.x; u < 1024; u += gridDim.x) {
        const int b = u >> 7, kvh = (u >> 6) & 1, qb = u & 63, q0 = qb * 64; const size_t rowbase = (size_t)b * SEQ_;
#pragma unroll
        for (int i = 0; i < 3; ++i) {
            const int c = tid + i * NTHR;
            { const int kk = c >> 3, ch = c & 7; *(u32x4*)(Ks + kk * 72 + ch * 8) = kreg[i]; }
            { const int kk = c % 192, ch = c / 192; const u32x4 vv = vreg[i];
              bf16_t* vd = Vt + (ch * 8) * 200 + kk;
              vd[0] = (bf16_t)(vv.x & 0xffffu); vd[200] = (bf16_t)(vv.x >> 16); vd[400] = (bf16_t)(vv.y & 0xffffu); vd[600] = (bf16_t)(vv.y >> 16);
              vd[800] = (bf16_t)(vv.z & 0xffffu); vd[1000] = (bf16_t)(vv.z >> 16); vd[1200] = (bf16_t)(vv.w & 0xffffu); vd[1400] = (bf16_t)(vv.w >> 16); }
        }
        { const int nx = u + (int)gridDim.x; if (nx < 1024) SWA_FETCH(nx); }
        __syncthreads();
        const int g = wid >> 1, qh = kvh * 4 + g, qhalf = wid & 1, pq = q0 + 32 * qhalf + r32;
        const bf16_t* qsrc = proj + (rowbase + pq) * 2560 + 1792 + qh * 64;
        bf16x8 qr[4];
#pragma unroll
        for (int d0 = 0; d0 < 4; ++d0) qr[d0] = *(const bf16x8*)(qsrc + d0 * 16 + hi * 8);
        f32x16 s[5];
#pragma unroll
        for (int t = 0; t < 5; ++t) {
            f32x16 a = {};
#pragma unroll
            for (int d0 = 0; d0 < 4; ++d0) {
                const bf16x8 kf = *(const bf16x8*)(Ks + (32 * (qhalf + t) + r32) * 72 + d0 * 16 + hi * 8);
                a = __builtin_amdgcn_mfma_f32_32x32x16_bf16(kf, qr[d0], a, 0, 0, 0);
            }
            s[t] = a;
        }
        const float sink2 = sinks[qh] * LOG2E_;
        float mx = sink2;
#pragma unroll
        for (int t = 0; t < 5; ++t)
#pragma unroll
            for (int r = 0; r < 16; ++r) {
                const int pk = q0 - 128 + 32 * (qhalf + t) + crow_(r, hi);
                const bool valid = (pk >= 0) && (pk <= pq) && (pq - pk < 128);
                const float v = valid ? s[t][r] : -INFINITY; s[t][r] = v; mx = fmaxf(mx, v);
            }
        mx = fmaxf(mx, __shfl_xor(mx, 32));
        float sum = 0.f;
#pragma unroll
        for (int t = 0; t < 5; ++t)
#pragma unroll
            for (int r = 0; r < 16; ++r) { const float e = __builtin_amdgcn_exp2f(s[t][r] - mx); s[t][r] = e; sum += e; }
        sum += __shfl_xor(sum, 32);
        sum += __builtin_amdgcn_exp2f(sink2 - mx);
        const float inv = 1.f / sum;
        f32x16 o[2]; o[0] = f32x16{}; o[1] = f32x16{};
#pragma unroll
        for (int t = 0; t < 5; ++t)
#pragma unroll
            for (int ss = 0; ss < 2; ++ss) {
                u32x4 pw; pw.x = pk2(s[t][8 * ss + 0], s[t][8 * ss + 1]); pw.y = pk2(s[t][8 * ss + 2], s[t][8 * ss + 3]); pw.z = pk2(s[t][8 * ss + 4], s[t][8 * ss + 5]); pw.w = pk2(s[t][8 * ss + 6], s[t][8 * ss + 7]);
                const bf16x8 pf = __builtin_bit_cast(bf16x8, pw);
#pragma unroll
                for (int dt = 0; dt < 2; ++dt) {
                    const bf16_t* vp = Vt + (32 * dt + r32) * 200 + 32 * (qhalf + t) + 16 * ss + 4 * hi;
                    const u32x2 lo = *(const u32x2*)vp, h2 = *(const u32x2*)(vp + 8);
                    u32x4 vw; vw.x = lo.x; vw.y = lo.y; vw.z = h2.x; vw.w = h2.y;
                    o[dt] = __builtin_amdgcn_mfma_f32_32x32x16_bf16(__builtin_bit_cast(bf16x8, vw), pf, o[dt], 0, 0, 0);
                }
            }
        bf16_t* orow = A + (rowbase + pq) * 1024 + 512 + qh * 64;
#pragma unroll
        for (int dt = 0; dt < 2; ++dt)
#pragma unroll
            for (int g4 = 0; g4 < 4; ++g4) {
                u32x2 q; q.x = pk2(o[dt][4 * g4] * inv, o[dt][4 * g4 + 1] * inv); q.y = pk2(o[dt][4 * g4 + 2] * inv, o[dt][4 * g4 + 3] * inv);
                *(u32x2*)(orow + 32 * dt + 8 * g4 + 4 * hi) = q;
            }
        __syncthreads();
    }
}

template <int MODE> struct LaCfg {
    static constexpr int DK = MODE ? 128 : 64, LQ = DK + 8, LG = DK + 4, PITCH = MODE ? 3584 : 2560, NG = DK / 8;
    static constexpr int QCOL = MODE ? 1536 : 0, KCOL = MODE ? 0 : 256, ZCOL = MODE ? 2048 : 512, VCOL = MODE ? 2560 : 768, GCOL = MODE ? 3072 : 1280, OCOL = MODE ? 512 : 0;
    static constexpr int O_QB = 0, O_KB = O_QB + 64 * LQ * 2, O_GF = O_KB + 64 * LQ * 2, O_VT = O_GF + 64 * LG * 4, O_SC = O_VT + 128 * 72 * 2, O_QE = O_SC + 64 * 72 * 2,
                         O_KT = O_QE + 64 * LQ * 2  , O_SEG = O_KT + DK * 72 * 2, O_RED = O_SEG + 8 * 128 * 4, O_PAR = O_RED + 8 * 64 * 4, O_END = O_PAR + 128 * 4;
    static_assert(O_END <= LDS_BYTES, "LA LDS map");
};
__device__ __forceinline__ void unpack8(const u32x4 w, float (&f)[8]) { f[0] = bflo(w.x); f[1] = bfhi(w.x); f[2] = bflo(w.y); f[3] = bfhi(w.y); f[4] = bflo(w.z); f[5] = bfhi(w.z); f[6] = bflo(w.w); f[7] = bfhi(w.w); }
__device__ __forceinline__ u32x4 pack8(const float (&f)[8]) { u32x4 w; w.x = pk2(f[0], f[1]); w.y = pk2(f[2], f[3]); w.z = pk2(f[4], f[5]); w.w = pk2(f[6], f[7]); return w; }
__device__ __forceinline__ void ld8f(const float* p, float (&f)[8]) { const f32x4 a = *(const f32x4*)p, b = *(const f32x4*)(p + 4); f[0] = a[0]; f[1] = a[1]; f[2] = a[2]; f[3] = a[3]; f[4] = b[0]; f[5] = b[1]; f[6] = b[2]; f[7] = b[3]; }

template <int MODE> struct LaRaw { static constexpr int NI = 64 * LaCfg<MODE>::NG / NTHR; u32x4 z[NI], k[NI], q[NI], v[2]; };
template <int MODE, bool NEEDQ> __device__ __forceinline__ void la_fetch(const Ctx& C, int b, int h, int c, LaRaw<MODE>& R) {
    typedef LaCfg<MODE> Cf; const bf16_t* proj = (const bf16_t*)(C.p.ws + WS_R1);
    const size_t row0 = (size_t)b * SEQ_ + (size_t)c * 64;
#pragma unroll
    for (int it = 0; it < LaRaw<MODE>::NI; ++it) {
        const int u = C.tid + it * NTHR, r = u / Cf::NG, kk = (u % Cf::NG) * 8;
        const bf16_t* rp = proj + (row0 + r) * Cf::PITCH + h * Cf::DK + kk;
        R.z[it] = *(const u32x4*)(rp + Cf::ZCOL);
        if (MODE == 0) R.k[it] = *(const u32x4*)(rp + Cf::KCOL);
        if (NEEDQ) R.q[it] = *(const u32x4*)(rp + Cf::QCOL);
    }
#pragma unroll
    for (int it = 0; it < 2; ++it) {
        const int u = C.tid + it * NTHR, r = u & 63, g8 = u >> 6;
        R.v[it] = *(const u32x4*)(proj + (row0 + r) * Cf::PITCH + Cf::VCOL + h * 128 + g8 * 8);
    }
}
template <int MODE, bool NEEDQ> __device__ __forceinline__ void la_store(const Ctx& C, const LaRaw<MODE>& R, const float* par, bf16_t* Qb, bf16_t* Kb, float* Gf, bf16_t* Vt) {
    typedef LaCfg<MODE> Cf;
#pragma unroll
    for (int it = 0; it < LaRaw<MODE>::NI; ++it) {
        const int u = C.tid + it * NTHR, r = u / Cf::NG, kk = (u % Cf::NG) * 8;
        float z[8], kv[8], lg[8], pc[8];
        unpack8(R.z[it], z); ld8f(par + kk, pc);
        if (MODE == 0) {
            unpack8(R.k[it], kv);
#pragma unroll
            for (int e = 0; e < 8; ++e) { const float x = z[e] + pc[e]; lg[e] = (fminf(x, 0.f) * LOG2E_ - __log2f(1.f + __expf(-fabsf(x)))) * (1.f / 16.f); }
        } else {
#pragma unroll
            for (int e = 0; e < 8; ++e) {
                const float zz = fminf(fmaxf(z[e], -60.f), 60.f), ez = __expf(-zz), sg = __builtin_amdgcn_rcpf(1.f + ez), lb = pc[e];
                lg[e] = __log2f(lb + (1.f - lb) * sg); kv[e] = (1.f - lb) * (ez * sg);
            }
        }
        *(u32x4*)(Kb + r * Cf::LQ + kk) = pack8(kv);
        float* gd = Gf + r * Cf::LG + kk;
        *(f32x4*)gd = (f32x4){lg[0], lg[1], lg[2], lg[3]}; *(f32x4*)(gd + 4) = (f32x4){lg[4], lg[5], lg[6], lg[7]};
        if (NEEDQ) {
            float q[8]; unpack8(R.q[it], q);
#pragma unroll
            for (int e = 0; e < 8; ++e) q[e] = MODE ? siluf_(q[e]) * 0.08838834764831845f : q[e] * 0.125f;
            *(u32x4*)(Qb + r * Cf::LQ + kk) = pack8(q);
        }
    }
#pragma unroll
    for (int it = 0; it < 2; ++it) {
        const int u = C.tid + it * NTHR, r = u & 63, g8 = u >> 6;
        const u32x4 w = R.v[it];
        bf16_t* vd = Vt + (g8 * 8) * 72 + r;
        vd[0] = (bf16_t)(w.x & 0xffffu); vd[72] = (bf16_t)(w.x >> 16); vd[144] = (bf16_t)(w.y & 0xffffu); vd[216] = (bf16_t)(w.y >> 16);
        vd[288] = (bf16_t)(w.z & 0xffffu); vd[360] = (bf16_t)(w.z >> 16); vd[432] = (bf16_t)(w.w & 0xffffu); vd[504] = (bf16_t)(w.w >> 16);
    }
}
template <int MODE> __device__ __forceinline__ void la_params(const Ctx& C, int l, int h, float* par) {
    typedef LaCfg<MODE> Cf; const int j = l >> 1;
    if (C.tid < Cf::DK) {
        if (MODE == 0) par[C.tid] = C.p.gla_gate_b[j * 256 + h * 64 + C.tid];
        else { const float* lg0 = C.p.hgrn_lb_logits + h * 128 + C.tid; par[C.tid] = (j == 0) ? 0.f : sigmoidf_(lg0[512] - lg0[0]); }
    }
}
template <int MODE> __device__ __forceinline__ void la_cumsum(const Ctx& C, float* Gf, float* segs) {
    typedef LaCfg<MODE> Cf; constexpr int DK = Cf::DK, NSEG = NTHR / DK, RPS = 64 / NSEG;
    const int k = C.tid % DK, seg = C.tid / DK;
    float v[RPS];
#pragma unroll
    for (int i = 0; i < RPS; ++i) v[i] = Gf[(seg * RPS + i) * Cf::LG + k];
#pragma unroll
    for (int i = 1; i < RPS; ++i) v[i] += v[i - 1];
    segs[seg * DK + k] = v[RPS - 1];
    __syncthreads();
    float off = 0.f;
#pragma unroll
    for (int s = 0; s < NSEG; ++s) { const float t = segs[s * DK + k]; off += (s < seg) ? t : 0.f; }
#pragma unroll
    for (int i = 0; i < RPS; ++i) Gf[(seg * RPS + i) * Cf::LG + k] = v[i] + off;
}

template <int MODE> __device__ __forceinline__ void phase_la_p1(const Ctx& C, int l) {
    typedef LaCfg<MODE> Cf; const Params& p = C.p; constexpr int DK = Cf::DK, LQ = Cf::LQ, LG = Cf::LG, NG = Cf::NG;
    bf16_t* Kb = (bf16_t*)(C.lds + Cf::O_KB); float* Gf = (float*)(C.lds + Cf::O_GF); bf16_t* Vt = (bf16_t*)(C.lds + Cf::O_VT);
    bf16_t* KhT = (bf16_t*)(C.lds + Cf::O_KT); float* segs = (float*)(C.lds + Cf::O_SEG);
    bf16_t* ST = (bf16_t*)(p.ws + WS_ST); float* TOT = (float*)(p.ws + WS_TOT);
    const int r16 = C.lane & 15, g = C.lane >> 4, w = C.wave;
    float* par = (float*)(C.lds + Cf::O_PAR);
    LaRaw<MODE> R; int hcur = -1;
    if ((int)blockIdx.x < 2048) la_fetch<MODE, false>(C, (int)blockIdx.x >> 8, ((int)blockIdx.x >> 6) & 3, (int)blockIdx.x & 63, R);
    for (int it = blockIdx.x; it < 2048; it += gridDim.x) {
        const int bh = it >> 6, c = it & 63, b = bh >> 2, h = bh & 3;
        if (h != hcur) { la_params<MODE>(C, l, h, par); hcur = h; __syncthreads(); }
        la_store<MODE, false>(C, R, par, nullptr, Kb, Gf, Vt);
        { const int nx = it + (int)gridDim.x; if (nx < 2048) la_fetch<MODE, false>(C, nx >> 8, (nx >> 6) & 3, nx & 63, R); }
        __syncthreads();
        la_cumsum<MODE>(C, Gf, segs);
        __syncthreads();
        for (int u = C.tid; u < 64 * NG; u += NTHR) {
            const int r = u & 63, kk = (u >> 6) * 8;
            float kv[8], gj[8], gt[8];
            unpack8(*(const u32x4*)(Kb + r * LQ + kk), kv); ld8f(Gf + r * LG + kk, gj); ld8f(Gf + 63 * LG + kk, gt);
            bf16_t* kd = KhT + kk * 72 + r;
#pragma unroll
            for (int e = 0; e < 8; e += 2) { const unsigned pw = pk2(kv[e] * __builtin_amdgcn_exp2f(gt[e] - gj[e]), kv[e + 1] * __builtin_amdgcn_exp2f(gt[e + 1] - gj[e + 1]));
                kd[e * 72] = (bf16_t)(pw & 0xffffu); kd[(e + 1) * 72] = (bf16_t)(pw >> 16); }
        }
        if (C.tid < DK) TOT[(size_t)it * 128 + C.tid] = Gf[63 * LG + C.tid];
        __syncthreads();
        {
            const bf16x8 b0 = *(const bf16x8*)(Vt + (16 * w + r16) * 72 + 8 * g), b1 = *(const bf16x8*)(Vt + (16 * w + r16) * 72 + 32 + 8 * g);
            bf16_t* so = ST + (size_t)it * DK * 128 + (size_t)(16 * w + r16) * DK + 4 * g;
#pragma unroll
            for (int mt = 0; mt < DK / 16; ++mt) {
                const bf16x8 a0 = *(const bf16x8*)(KhT + (16 * mt + r16) * 72 + 8 * g), a1 = *(const bf16x8*)(KhT + (16 * mt + r16) * 72 + 32 + 8 * g);
                f32x4 acc = (f32x4){0.f, 0.f, 0.f, 0.f};
                acc = __builtin_amdgcn_mfma_f32_16x16x32_bf16(a0, b0, acc, 0, 0, 0);
                acc = __builtin_amdgcn_mfma_f32_16x16x32_bf16(a1, b1, acc, 0, 0, 0);
                u32x2 q; q.x = pk2(acc[0], acc[1]); q.y = pk2(acc[2], acc[3]);
                *(u32x2*)(so + 16 * mt) = q;
            }
        }
        __syncthreads();
    }
}

template <int MODE> __device__ __forceinline__ void phase_la_p2(const Ctx& C) {
    typedef LaCfg<MODE> Cf; const Params& p = C.p; constexpr int DK = Cf::DK, NQ = DK / 4;
    bf16_t* ST = (bf16_t*)(p.ws + WS_ST); const float* TOT = (const float*)(p.ws + WS_TOT);
    for (int u = blockIdx.x * NTHR + C.tid; u < 32 * 128 * NQ; u += gridDim.x * NTHR) {
        const int k4 = u % NQ, v = (u / NQ) & 127, bh = u / (NQ * 128);
        float S0 = 0.f, S1 = 0.f, S2 = 0.f, S3 = 0.f;
        bf16_t* base = ST + (size_t)bh * 64 * DK * 128 + (size_t)v * DK + k4 * 4;
        const float* tb = TOT + (size_t)bh * 64 * 128 + k4 * 4;
#pragma unroll 8
        for (int c = 0; c < 64; ++c) {
            u32x2* ptr = (u32x2*)(base + (size_t)c * DK * 128);
            const u32x2 w = *ptr; const f32x4 dc = *(const f32x4*)(tb + c * 128);
            u32x2 o; o.x = pk2(S0, S1); o.y = pk2(S2, S3);
            *ptr = o;
            S0 = S0 * __builtin_amdgcn_exp2f(dc[0]) + bflo(w.x); S1 = S1 * __builtin_amdgcn_exp2f(dc[1]) + bfhi(w.x);
            S2 = S2 * __builtin_amdgcn_exp2f(dc[2]) + bflo(w.y); S3 = S3 * __builtin_amdgcn_exp2f(dc[3]) + bfhi(w.y);
        }
    }
}

template <int MODE> __device__ __forceinline__ void phase_la_p3(const Ctx& C, int l) {
    typedef LaCfg<MODE> Cf; const Params& p = C.p; constexpr int DK = Cf::DK, LQ = Cf::LQ, LG = Cf::LG, NG = Cf::NG, NKS = DK / 32;
    bf16_t* Qb = (bf16_t*)(C.lds + Cf::O_QB); bf16_t* Kb = (bf16_t*)(C.lds + Cf::O_KB); float* Gf = (float*)(C.lds + Cf::O_GF); bf16_t* Vt = (bf16_t*)(C.lds + Cf::O_VT);
    bf16_t* Sc = (bf16_t*)(C.lds + Cf::O_SC); bf16_t* Qe = (bf16_t*)(C.lds + Cf::O_QE); float* segs = (float*)(C.lds + Cf::O_SEG); float* red = (float*)(C.lds + Cf::O_RED);
    const bf16_t* ST = (const bf16_t*)(p.ws + WS_ST); const bf16_t* proj = (const bf16_t*)(p.ws + WS_R1); bf16_t* A = (bf16_t*)(p.ws + WS_A);
    const float* nw = (MODE ? p.hgrn_norm_w : p.gla_norm_w) + (l >> 1) * 128;
    const int r16 = C.lane & 15, g = C.lane >> 4, w = C.wave;
    const f32x4 nw4 = *(const f32x4*)(nw + 16 * w + 4 * g);
    float* par = (float*)(C.lds + Cf::O_PAR);
    LaRaw<MODE> R; int hcur = -1;
    if ((int)blockIdx.x < 2048) la_fetch<MODE, true>(C, (int)blockIdx.x >> 8, ((int)blockIdx.x >> 6) & 3, (int)blockIdx.x & 63, R);
    for (int it = blockIdx.x; it < 2048; it += gridDim.x) {
        const int bh = it >> 6, c = it & 63, b = bh >> 2, h = bh & 3;
        bf16x8 sfr[NKS];
        { const bf16_t* sp = ST + (size_t)it * DK * 128 + (size_t)(16 * w + r16) * DK + 8 * g;
#pragma unroll
          for (int ks = 0; ks < NKS; ++ks) sfr[ks] = *(const bf16x8*)(sp + 32 * ks); }
        if (h != hcur) { la_params<MODE>(C, l, h, par); hcur = h; __syncthreads(); }
        la_store<MODE, true>(C, R, par, Qb, Kb, Gf, Vt);
        { const int nx = it + (int)gridDim.x; if (nx < 2048) la_fetch<MODE, true>(C, nx >> 8, (nx >> 6) & 3, nx & 63, R); }
        for (int u = C.tid; u < 64 * 72 / 8; u += NTHR) *(u32x4*)(Sc + u * 8) = (u32x4){0u, 0u, 0u, 0u};
        u32x2 gwv[4];
#pragma unroll
        for (int nt = 0; nt < 4; ++nt) gwv[nt] = *(const u32x2*)(proj + ((size_t)b * SEQ_ + (size_t)c * 64 + 16 * nt + r16) * Cf::PITCH + Cf::GCOL + h * 128 + 16 * w + 4 * g);
        __syncthreads();
        la_cumsum<MODE>(C, Gf, segs);
        __syncthreads();
        for (int t = w; t < 10; t += 8) {
            const int I = (t >= 6) ? 3 : (t >= 3) ? 2 : (t >= 1) ? 1 : 0, J = t - I * (I + 1) / 2;
            f32x4 acc = (f32x4){0.f, 0.f, 0.f, 0.f};
#pragma unroll
            for (int ks = 0; ks < NKS; ++ks) {
                const int kc = 32 * ks + 8 * g;
                float gref[8], gj[8], gi[8], kv[8], qv[8];
                ld8f(Gf + (16 * J + 15) * LG + kc, gref); ld8f(Gf + (16 * J + r16) * LG + kc, gj); ld8f(Gf + (16 * I + r16) * LG + kc, gi);
                unpack8(*(const u32x4*)(Kb + (16 * J + r16) * LQ + kc), kv); unpack8(*(const u32x4*)(Qb + (16 * I + r16) * LQ + kc), qv);
#pragma unroll
                for (int e = 0; e < 8; ++e) { kv[e] *= __builtin_amdgcn_exp2f(gref[e] - gj[e]); qv[e] *= __builtin_amdgcn_exp2f(gi[e] - gref[e]); }
                acc = __builtin_amdgcn_mfma_f32_16x16x32_bf16(__builtin_bit_cast(bf16x8, pack8(kv)), __builtin_bit_cast(bf16x8, pack8(qv)), acc, 0, 0, 0);
            }
            if (I == J) {
#pragma unroll
                for (int e = 0; e < 4; ++e) if (4 * g + e > r16) acc[e] = 0.f;
            }
            u32x2 q; q.x = pk2(acc[0], acc[1]); q.y = pk2(acc[2], acc[3]);
            *(u32x2*)(Sc + (16 * I + r16) * 72 + 16 * J + 4 * g) = q;
        }
        for (int u = C.tid; u < 64 * NG; u += NTHR) {
            const int r = u / NG, kk = (u % NG) * 8;
            float qv[8], gi[8]; unpack8(*(const u32x4*)(Qb + r * LQ + kk), qv); ld8f(Gf + r * LG + kk, gi);
#pragma unroll
            for (int e = 0; e < 8; ++e) qv[e] *= __builtin_amdgcn_exp2f(gi[e]);
            *(u32x4*)(Qe + r * LQ + kk) = pack8(qv);
        }
        __syncthreads();
        f32x4 o[4];
        {
            const bf16x8 v0 = *(const bf16x8*)(Vt + (16 * w + r16) * 72 + 8 * g), v1 = *(const bf16x8*)(Vt + (16 * w + r16) * 72 + 32 + 8 * g);
#pragma unroll
            for (int nt = 0; nt < 4; ++nt) {
                f32x4 acc = (f32x4){0.f, 0.f, 0.f, 0.f};
                acc = __builtin_amdgcn_mfma_f32_16x16x32_bf16(v0, *(const bf16x8*)(Sc + (16 * nt + r16) * 72 + 8 * g), acc, 0, 0, 0);
                if (nt >= 2) acc = __builtin_amdgcn_mfma_f32_16x16x32_bf16(v1, *(const bf16x8*)(Sc + (16 * nt + r16) * 72 + 32 + 8 * g), acc, 0, 0, 0);
#pragma unroll
                for (int ks = 0; ks < NKS; ++ks) acc = __builtin_amdgcn_mfma_f32_16x16x32_bf16(sfr[ks], *(const bf16x8*)(Qe + (16 * nt + r16) * LQ + 32 * ks + 8 * g), acc, 0, 0, 0);
                o[nt] = acc;
                float ss = acc[0] * acc[0] + acc[1] * acc[1] + acc[2] * acc[2] + acc[3] * acc[3];
                ss += __shfl_xor(ss, 16); ss += __shfl_xor(ss, 32);
                if (g == 0) red[w * 64 + 16 * nt + r16] = ss;
            }
        }
        __syncthreads();
#pragma unroll
        for (int nt = 0; nt < 4; ++nt) {
            float tot = 0.f;
#pragma unroll
            for (int ww = 0; ww < 8; ++ww) tot += red[ww * 64 + 16 * nt + r16];
            const float rs = rsqrtf(tot * (1.f / 128.f) + 1e-6f);
            const size_t row = (size_t)b * SEQ_ + (size_t)c * 64 + 16 * nt + r16;
            const u32x2 gw = gwv[nt];
            u32x2 q; q.x = pk2(o[nt][0] * rs * nw4[0] * siluf_(bflo(gw.x)), o[nt][1] * rs * nw4[1] * siluf_(bfhi(gw.x)));
            q.y = pk2(o[nt][2] * rs * nw4[2] * siluf_(bflo(gw.y)), o[nt][3] * rs * nw4[3] * siluf_(bfhi(gw.y)));
            *(u32x2*)(A + row * 1024 + Cf::OCOL + h * 128 + 16 * w + 4 * g) = q;
        }
        __syncthreads();
    }
}


#define LAS __attribute__((address_space(3)))
#define XB_TMO      128
#define XB_XCNT(j)  (256  + 64 * (j))
#define XB_XSUB(j)  (1280 + 64 * (j))
#define XB_XGEN(j)  (2304 + 64 * (j))
#define XB_TOP      3328
#define XB_TOPGEN   3392
#define XCD_BAR_WORDS 3456
#define XB_SPIN_CAP (1u << 18)

__device__ __forceinline__ unsigned xb_ld(unsigned* p)              { return __hip_atomic_load(p, __ATOMIC_RELAXED, __HIP_MEMORY_SCOPE_AGENT); }
__device__ __forceinline__ unsigned xb_add(unsigned* p, unsigned v) { return __hip_atomic_fetch_add(p, v, __ATOMIC_RELAXED, __HIP_MEMORY_SCOPE_AGENT); }
__device__ __forceinline__ unsigned xb_xcc_id() { return (unsigned)__builtin_amdgcn_s_getreg((3 << 11) | 20) & 0xFu; }
#define XB_SPIN(cond, bar) do { unsigned _sp = 0; while (cond) { __builtin_amdgcn_s_sleep(1); \
    if ((++_sp & 255u) == 0u) { if (xb_ld(&(bar)[XB_TMO])) break; if (_sp > XB_SPIN_CAP) { atomicAdd(&(bar)[XB_TMO], 1u); break; } } } } while (0)

struct XcdBarrier {
    unsigned* bar; unsigned x;
    volatile LAS unsigned* st;
};

__device__ __forceinline__ XcdBarrier xcd_barrier_post(unsigned* bar, volatile LAS unsigned* st) {
    XcdBarrier b; b.bar = bar; b.x = xb_xcc_id(); b.st = st;
    if (threadIdx.x == 0) (void)xb_add(&bar[XB_XCNT(b.x)], 1u);
    return b;
}
__device__ __forceinline__ void xcd_barrier_complete(unsigned* bar, unsigned x, unsigned& nloc, unsigned& nx) {
    const unsigned G = gridDim.x * gridDim.y * gridDim.z;
    unsigned sum, cnt, mine, sp = 0u;
    for (;;) {
        sum = 0u; cnt = 0u; mine = 0u;
#pragma unroll
        for (unsigned j = 0; j < 16; ++j) { const unsigned c = xb_ld(&bar[XB_XCNT(j)]); sum += c; cnt += (c > 0u) ? 1u : 0u; mine = (j == x) ? c : mine; }
        if (sum == G) break;
        __builtin_amdgcn_s_sleep(1);
        if ((++sp & 255u) == 0u) { if (xb_ld(&bar[XB_TMO])) break; if (sp > XB_SPIN_CAP) { atomicAdd(&bar[XB_TMO], 1u); break; } }
    }
    nloc = mine > 0u ? mine : 1u; nx = cnt > 0u ? cnt : 1u;
}

__device__ __forceinline__ void xcd_barrier(const XcdBarrier& b) {
    asm volatile("s_waitcnt vmcnt(0)" ::: "memory");
    __syncthreads();
    if (threadIdx.x == 0) {
        unsigned* bar = b.bar;
        __builtin_amdgcn_s_waitcnt(0);
        unsigned nloc = b.st[0], nx = b.st[1];
        if (nloc == 0u) { xcd_barrier_complete(bar, b.x, nloc, nx); b.st[0] = nloc; b.st[1] = nx; }
        const unsigned old = xb_add(&bar[XB_XSUB(b.x)], 1u);
        const unsigned gen = old / nloc;
        if (old + 1u == (gen + 1u) * nloc) {
            __builtin_amdgcn_fence(__ATOMIC_RELEASE, "agent");
            asm volatile("s_waitcnt vmcnt(0)" ::: "memory");
            const unsigned og = xb_add(&bar[XB_TOP], 1u);
            const unsigned tg = og / nx;
            if (og + 1u == (tg + 1u) * nx) xb_add(&bar[XB_TOPGEN], 1u);
            else XB_SPIN(xb_ld(&bar[XB_TOPGEN]) == tg, bar);
            __builtin_amdgcn_fence(__ATOMIC_ACQUIRE, "agent");
            xb_add(&bar[XB_XGEN(b.x)], 1u);
            asm volatile("s_waitcnt vmcnt(0)" ::: "memory");
        } else {
            XB_SPIN(xb_ld(&bar[XB_XGEN(b.x)]) == gen, bar);
            __builtin_amdgcn_fence(__ATOMIC_ACQUIRE, "agent");
            asm volatile("s_waitcnt vmcnt(0)" ::: "memory");
        }
    }
    __syncthreads();
}

typedef unsigned u32x16 __attribute__((ext_vector_type(16)));
__device__ __forceinline__ void load_params(Params& p) {
    auto kp = __builtin_amdgcn_kernarg_segment_ptr();
    u32x16 a, b, c, d;
    asm volatile("s_load_dwordx16 %0, %4, 0x0\n\ts_load_dwordx16 %1, %4, 0x40\n\ts_load_dwordx16 %2, %4, 0x80\n\ts_load_dwordx16 %3, %4, 0xc0\n\ts_waitcnt lgkmcnt(0)"
                 : "=&s"(a), "=&s"(b), "=&s"(c), "=&s"(d) : "s"(kp) : "memory");
    unsigned long long q[32];
#pragma unroll
    for (int i = 0; i < 8; ++i) { q[i] = ((unsigned long long)a[2 * i + 1] << 32) | a[2 * i]; q[8 + i] = ((unsigned long long)b[2 * i + 1] << 32) | b[2 * i];
        q[16 + i] = ((unsigned long long)c[2 * i + 1] << 32) | c[2 * i]; q[24 + i] = ((unsigned long long)d[2 * i + 1] << 32) | d[2 * i]; }
    p.x = (const float*)(__attribute__((address_space(1))) const float*)q[0]; p.c = (const float*)(__attribute__((address_space(1))) const float*)q[1]; p.positions = (const int*)(__attribute__((address_space(1))) const int*)q[2]; p.mod_w = (const float*)(__attribute__((address_space(1))) const float*)q[3]; p.mod_b = (const float*)(__attribute__((address_space(1))) const float*)q[4]; p.norm_mix_w = (const float*)(__attribute__((address_space(1))) const float*)q[5]; p.norm_ffn_w = (const float*)(__attribute__((address_space(1))) const float*)q[6];
    p.ev_w_in = (const float*)(__attribute__((address_space(1))) const float*)q[7]; p.gla_gate_w = (const float*)(__attribute__((address_space(1))) const float*)q[8]; p.gla_gate_b = (const float*)(__attribute__((address_space(1))) const float*)q[9]; p.gla_norm_w = (const float*)(__attribute__((address_space(1))) const float*)q[10]; p.swa_sinks = (const float*)(__attribute__((address_space(1))) const float*)q[11]; p.ev_w_out = (const float*)(__attribute__((address_space(1))) const float*)q[12];
    p.od_w_in = (const float*)(__attribute__((address_space(1))) const float*)q[13]; p.diff_lambda = (const float*)(__attribute__((address_space(1))) const float*)q[14]; p.diff_norm_w = (const float*)(__attribute__((address_space(1))) const float*)q[15]; p.hgrn_lb_logits = (const float*)(__attribute__((address_space(1))) const float*)q[16]; p.hgrn_norm_w = (const float*)(__attribute__((address_space(1))) const float*)q[17]; p.od_w_out = (const float*)(__attribute__((address_space(1))) const float*)q[18];
    p.ffn_w_in = (const float*)(__attribute__((address_space(1))) const float*)q[19]; p.ffn_conv_w = (const float*)(__attribute__((address_space(1))) const float*)q[20]; p.ffn_conv_b = (const float*)(__attribute__((address_space(1))) const float*)q[21]; p.ffn_w_out = (const float*)(__attribute__((address_space(1))) const float*)q[22]; p.final_norm_w = (const float*)(__attribute__((address_space(1))) const float*)q[23];
    p.out = (float*)(__attribute__((address_space(1))) float*)q[24]; p.ws = (unsigned char*)(__attribute__((address_space(1))) unsigned char*)q[25];
}

#ifndef REP_SYNC
#define REP_SYNC 1
#endif
#ifndef REP_G
#define REP_G 1
#endif
#ifndef REP_R
#define REP_R 1
#endif
#ifndef REP_CV
#define REP_CV 1
#endif
#ifndef REP_P12
#define REP_P12 1
#endif
#ifndef STG_A
#define STG_A 0
#endif
#ifndef STG_B
#define STG_B 0
#endif
#ifndef ALIGN_RES
#define ALIGN_RES true
#endif
#ifndef REP_LA
#define REP_LA 1
#endif
#ifndef REP_AT
#define REP_AT 1
#endif
#ifndef REP_SM
#define REP_SM 1
#endif
__global__ void __launch_bounds__(NTHR, 2) fwd_megakernel(Params pin) {
    extern __shared__ __attribute__((aligned(16))) unsigned char lds[];
    cg::grid_group grid = cg::this_grid();
    Ctx C; C.lds = lds; C.tid = threadIdx.x; C.lane = C.tid & 63; C.wave = __builtin_amdgcn_readfirstlane(C.tid >> 6);
    C.gw = blockIdx.x * 8 + C.wave; C.ngw = gridDim.x * 8;
    PG8_LAS unsigned char* ldsg = (PG8_LAS unsigned char*)lds;
    volatile LAS unsigned* bst = (volatile LAS unsigned*)(ldsg + (LDS_BYTES - 64));
    if (threadIdx.x < 2) bst[threadIdx.x] = 0u;
    __syncthreads();
    XcdBarrier xbar = xcd_barrier_post((unsigned*)(pin.ws + WS_BAR), bst);
#define GSYNC() do { for (int rs_ = 0; rs_ < REP_SYNC; ++rs_) xcd_barrier(xbar); } while (0)
#define RP() do { load_params(C.p); C.tid = otid_(); C.lane = C.tid & 63; C.wave = __builtin_amdgcn_readfirstlane(C.tid >> 6); C.gw = blockIdx.x * 8 + C.wave; } while (0)
#define WSP(off) (C.p.ws + (off))
#define STAGGER(ticks) do { if ((ticks) > 0 && (blockIdx.x & 1)) { const unsigned long long t0_ = __builtin_amdgcn_s_memrealtime(); while (__builtin_amdgcn_s_memrealtime() - t0_ < (unsigned long long)(ticks)) __builtin_amdgcn_s_sleep(16); } } while (0)

    if (pin.ws == nullptr) grid.sync();
    for (int rep_ = 0; rep_ < REP_SM; ++rep_) { RP(); phase_prologue(C); }
    GSYNC();
#if REP_CV > 1
    RP(); phase_convert(C, 0, false);
#endif
    RP(); phase_convert(C, 0);
    for (int rep_ = 0; rep_ < REP_SM; ++rep_) { RP(); phase_prep(C, C.p.x, C.p.norm_mix_w, (const float*)WSP(WS_MOD), 1024, (bf16_t*)WSP(WS_A), (float*)WSP(WS_ROWSS)); }
    GSYNC();
#pragma unroll 1
    for (int l = 0; l < 4; ++l) {
        const bool even = !(l & 1);
        {
            RP();
            const int N = even ? 2560 : 3584;
            pg8::Gemm g{(const bf16_t*)WSP(WS_A), (const bf16_t*)WSP(WS_WIN), T_, N, 1024}; pg8::StaticOrder S; S.init(T_, N, (int)gridDim.x, (int)blockIdx.x);
            pg8::EpiProj E{(bf16_t*)WSP(WS_R1), N, even ? 0x7C000u : 0xFFu, even ? 0x3C000u : 0xFu, QSCALE_, (const float*)WSP(WS_COS), (const float*)WSP(WS_SIN),
                           (const float*)WSP(WS_ROWSS) + (size_t)(2 * l) * T_, (const float*)WSP(WS_BIAS) + (size_t)l * BIAS_L};
            for (int rep_ = 0; rep_ < REP_G; ++rep_) pg8::gemm_phase<pg8::EpiProj, pg8::StaticOrder, true, true>(ldsg, g, S, E);
        }
        GSYNC();
        if (even) {
            for (int rep_ = 0; rep_ < REP_AT; ++rep_) { RP(); phase_swa(C, l); }
            for (int rep_ = 0; rep_ < REP_LA; ++rep_) { RP(); phase_la_p1<0>(C, l); }
            GSYNC();
            RP(); phase_la_p2<0>(C);
            GSYNC();
#if REP_P12 > 1
            RP(); phase_la_p1<0>(C, l); GSYNC(); RP(); phase_la_p2<0>(C); GSYNC();
#endif
            for (int rep_ = 0; rep_ < REP_LA; ++rep_) { RP(); phase_la_p3<0>(C, l); }
        } else {
            for (int rep_ = 0; rep_ < REP_AT; ++rep_) {
                RP();
                const bf16_t* R1 = (const bf16_t*)WSP(WS_R1); bf16_t* X2 = (bf16_t*)WSP(WS_X2);
                const int G = (int)gridDim.x, bid = (int)blockIdx.x;
#pragma unroll 1
                for (int i = 0; i * G < 2048; ++i) {
                    const int L = i * G + ((i & 1) ? (G - 1 - bid) : bid);
                    if (L >= 2048) continue;
                    const int qb = 15 - (L >> 7), bh = L & 127, b = bh >> 4, hv = bh & 15;
                    const attn_body::bf16* Q = (const attn_body::bf16*)(R1 + (hv >> 1) * 64);
                    const attn_body::bf16* K = (const attn_body::bf16*)(R1 + 512 + (hv >> 1) * 64);
                    const attn_body::bf16* V = (const attn_body::bf16*)(R1 + 1024 + (hv >> 2) * 128 + (hv & 1) * 64);
                    attn_body::attn_unit<8>(b, hv, qb, Q, K, V, (attn_body::bf16*)(X2 + hv * 64), (char*)lds);
                }
            }
            for (int rep_ = 0; rep_ < REP_LA; ++rep_) { RP(); phase_la_p1<1>(C, l); }
            GSYNC();
            RP(); phase_la_p2<1>(C);
#if REP_P12 > 1
            GSYNC(); RP(); phase_la_p1<1>(C, l); GSYNC(); RP(); phase_la_p2<1>(C);
#endif
            for (int rep_ = 0; rep_ < REP_SM; ++rep_) { RP(); phase_diff_combine(C, l); }
            GSYNC();
            for (int rep_ = 0; rep_ < REP_LA; ++rep_) { RP(); phase_la_p3<1>(C, l); }
        }
        GSYNC();
        STAGGER(STG_A);
        {
            RP();
            const float* modl = (const float*)WSP(WS_MOD) + (size_t)l * 8 * 6144;
            pg8::Gemm g{(const bf16_t*)WSP(WS_A), (const bf16_t*)WSP(WS_WOUT), T_, 1024, 1024}; pg8::StaticOrder S; S.init(T_, 1024, (int)gridDim.x, (int)blockIdx.x);
            void* XH = (void*)((char*)C.p.out + 64 * MiB_);
            pg8::EpiRes E{(l == 0) ? (const void*)C.p.x : (const void*)XH, XH, (l == 0) ? 1 : 0, 0, modl + 2048, (bf16_t*)WSP(WS_X2), C.p.norm_ffn_w + l * 1024, modl + 4096, (float*)WSP(WS_ROWSS) + (size_t)(2 * l + 1) * T_};
            pg8::gemm_phase<pg8::EpiRes, pg8::StaticOrder, ALIGN_RES, true>(ldsg, g, S, E);
        }
        GSYNC();
        {
            RP();
            pg8::Gemm g{(const bf16_t*)WSP(WS_X2), (const bf16_t*)WSP(WS_FIN), T_, 5632, 1024}; pg8::StaticOrder S; S.init(T_, 5632, (int)gridDim.x, (int)blockIdx.x);
            pg8::EpiFfn E{(bf16_t*)WSP(WS_R1), (float*)WSP(WS_HP), (float*)WSP(WS_HU), (float*)WSP(WS_HA), C.p.ffn_conv_w + (size_t)l * 3 * DFF_, C.p.ffn_conv_b + (size_t)l * DFF_,
                          (const float*)WSP(WS_ROWSS) + (size_t)(2 * l + 1) * T_, (const float*)WSP(WS_BIAS) + (size_t)l * BIAS_L + 8 * 3584};
            for (int rep_ = 0; rep_ < REP_G; ++rep_) pg8::gemm_phase<pg8::EpiFfn, pg8::StaticOrder, true, true>(ldsg, g, S, E);
        }
        GSYNC();
        for (int rep_ = 0; rep_ < REP_SM; ++rep_) { RP(); phase_ffn_fixup(C, l); }
#if REP_CV > 1
        if (l < 3) { RP(); phase_convert(C, l + 1, false); }
#endif
        if (l < 3) { RP(); phase_convert(C, l + 1); }
        GSYNC();
        STAGGER(STG_B);
        {
            RP();
            const float* modl = (const float*)WSP(WS_MOD) + (size_t)l * 8 * 6144;
            pg8::Gemm g{(const bf16_t*)WSP(WS_R1), (const bf16_t*)WSP((l & 1) ? WS_FOUT2 : WS_FOUT), T_, 1024, DFF_}; pg8::StaticOrder S; S.init(T_, 1024, (int)gridDim.x, (int)blockIdx.x);
            void* XH = (void*)((char*)C.p.out + 64 * MiB_);
            pg8::EpiRes E{XH, (l < 3) ? XH : (void*)WSP(WS_X2), 0, 0, modl + 5120, (l < 3) ? (bf16_t*)WSP(WS_A) : (bf16_t*)nullptr, C.p.norm_mix_w + ((l + 1) & 3) * 1024, modl + 6144 * 8 + 1024, (float*)WSP(WS_ROWSS) + (size_t)((2 * l + 2) & 7) * T_};
            pg8::gemm_phase<pg8::EpiRes, pg8::StaticOrder, ALIGN_RES, true>(ldsg, g, S, E);
        }
        GSYNC();
    }
    RP(); phase_final_norm(C, (const void*)WSP(WS_X2), C.p.out, C.p.final_norm_w);
}

extern "C" void kernel_launch(void* const* d_in, const int* in_sizes, int n_in, void* d_out, int out_size, void* d_ws, size_t ws_size, hipStream_t stream) {
    static int grid_blocks = 0;
    if (grid_blocks == 0) {
        if (n_in != 24 || ws_size < WS_END) { fprintf(stderr, "kernel_launch: unexpected n_in %d / ws %zu\n", n_in, ws_size); grid_blocks = -1; return; }
        int dev = 0, cus = 0, per_cu = 0;
        hipGetDevice(&dev); hipDeviceGetAttribute(&cus, hipDeviceAttributeMultiprocessorCount, dev);
        if (hipFuncSetAttribute((const void*)fwd_megakernel, hipFuncAttributeMaxDynamicSharedMemorySize, LDS_BYTES) != hipSuccess) { fprintf(stderr, "kernel_launch: hipFuncSetAttribute failed\n"); grid_blocks = -1; return; }
        if (hipOccupancyMaxActiveBlocksPerMultiprocessor(&per_cu, (const void*)fwd_megakernel, NTHR, LDS_BYTES) != hipSuccess || per_cu < 1) { fprintf(stderr, "kernel_launch: occupancy query gave %d\n", per_cu); per_cu = 1; }
        (void)hipGetLastError();
        grid_blocks = cus * per_cu;
    }
    if (grid_blocks < 0) return;
    Params p{};
    p.x = (const float*)d_in[0]; p.c = (const float*)d_in[1]; p.positions = (const int*)d_in[2]; p.mod_w = (const float*)d_in[3]; p.mod_b = (const float*)d_in[4];
    p.norm_mix_w = (const float*)d_in[5]; p.norm_ffn_w = (const float*)d_in[6]; p.ev_w_in = (const float*)d_in[7]; p.gla_gate_w = (const float*)d_in[8];
    p.gla_gate_b = (const float*)d_in[9]; p.gla_norm_w = (const float*)d_in[10]; p.swa_sinks = (const float*)d_in[11]; p.ev_w_out = (const float*)d_in[12];
    p.od_w_in = (const float*)d_in[13]; p.diff_lambda = (const float*)d_in[14]; p.diff_norm_w = (const float*)d_in[15]; p.hgrn_lb_logits = (const float*)d_in[16];
    p.hgrn_norm_w = (const float*)d_in[17]; p.od_w_out = (const float*)d_in[18]; p.ffn_w_in = (const float*)d_in[19]; p.ffn_conv_w = (const float*)d_in[20];
    p.ffn_conv_b = (const float*)d_in[21]; p.ffn_w_out = (const float*)d_in[22]; p.final_norm_w = (const float*)d_in[23];
    p.out = (float*)d_out; p.ws = (unsigned char*)d_ws;
    if (hipMemsetAsync((char*)d_ws + WS_BAR, 0, 16384, stream) != hipSuccess) { fprintf(stderr, "kernel_launch: memset failed\n"); return; }
    void* args[] = {&p};
    hipError_t e = hipLaunchCooperativeKernel((const void*)fwd_megakernel, dim3(grid_blocks), dim3(NTHR), args, LDS_BYTES, stream);
    if (e != hipSuccess) fprintf(stderr, "cooperative launch failed: %s (grid %d)\n", hipGetErrorString(e), grid_blocks);
}
```

```cpp
#include <hip/hip_runtime.h>
#include <hip/hip_cooperative_groups.h>
#include <hip/hip_bf16.h>
#include <cstdio>
#include <cstdint>
#include <cmath>
__device__ __forceinline__ int otid_() { int t = threadIdx.x; asm volatile("" : "+v"(t)); return t; }
namespace pg8 {
#define PG8_LAS __attribute__((address_space(3)))
typedef unsigned short bf16_t;
typedef short bf16x8 __attribute__((ext_vector_type(8)));
typedef float f32x4 __attribute__((ext_vector_type(4)));
typedef unsigned u32x4 __attribute__((ext_vector_type(4)));
constexpr int BM = 256, BK = 64, HALF = 128, HTB = HALF * BK * 2  , STAGE_BYTES = 8 * HTB, NXCD = 8, WGM = 8;

__host__ __device__ __forceinline__ int lds_byte(int r, int c) { const int st = (r >> 4) * 2 + (c >> 5), rr = r & 15, cc = c & 31, ob = rr * 64 + cc * 2; return st * 1024 + (ob ^ (((ob >> 9) & 1) << 5)); }
__host__ __device__ __forceinline__ void stage_rc(int b, int& R, int& C) { const int st = b / 1024, sb = b % 1024, swz = sb ^ (((sb >> 9) & 1) << 5); R = (st >> 1) * 16 + swz / 64; C = (st & 1) * 32 + (swz % 64) / 2; }
__host__ __device__ __forceinline__ int perm32(int rho) { const int n = rho >> 4, i = rho & 15; return 8 * (i >> 2) + 4 * n + (i & 3); }

struct Unit { int pm, pn; };
struct Gemm { const bf16_t* A; const bf16_t* Bt; int M, N, K; };

struct StaticOrder {
    int nM, nN, nwg, G, c;
    __host__ __device__ void init(int M, int N, int G_, int c_) { nM = M / BM; nN = N / BM; nwg = nM * nN; G = G_; c = c_; }
    __host__ __device__ bool next(int i, Unit& u) const {
        const long L = (long)i * G + c; if (L >= nwg) return false;
        int wgid = (int)L; { const int q = nwg / NXCD, r = nwg % NXCD, xcd = wgid % NXCD, off = wgid / NXCD; wgid = (xcd < r ? xcd * (q + 1) : r * (q + 1) + (xcd - r) * q) + off; }
        const int nig = WGM * nN, gid = wgid / nig, fm = gid * WGM, gsz = (nM - fm) < WGM ? (nM - fm) : WGM;
        u.pm = fm + ((wgid % nig) % gsz); u.pn = (wgid % nig) / gsz; return true;
    }
    __device__ __forceinline__ void a_ready(const Unit&) const {}
    __device__ __forceinline__ void done(const Unit&) const {}
};

__device__ __forceinline__ unsigned cvt_pk_bf16(float lo, float hi) { unsigned r; asm volatile("v_cvt_pk_bf16_f32 %0, %1, %2" : "=v"(r) : "v"(lo), "v"(hi)); return r; }
typedef float f32x2 __attribute__((ext_vector_type(2)));
template <class Epi, class Sched, bool ALIGN_EPI = false, bool SP2 = false>
__device__ __forceinline__ void gemm_phase(PG8_LAS unsigned char* lds, const Gemm g, const Sched& S, const Epi& E) {
    const int tid = otid_(), wid = __builtin_amdgcn_readfirstlane(tid >> 6), lane = tid & 63, wr = wid >> 2, wc = wid & 3, fr = lane & 15, fq = lane >> 4;
    const int K = g.K, nt = K / BK;
    unsigned voffA[2], voffB[2];
#pragma unroll
    for (int i = 0; i < 2; ++i) { int R, C; stage_rc(tid * 16 + i * 8192, R, C); const int Rb = Epi::PERM ? ((R & ~31) + perm32(R & 31)) : R;
        voffA[i] = (unsigned)(R * K + C) * 2u; voffB[i] = (unsigned)(Rb * K + C) * 2u; }
    const size_t kstep = (size_t)(BK * 2);
    const size_t hstep = (size_t)HALF * K * 2;
    const size_t tstep = 2 * hstep;
    const unsigned ldsw = (unsigned)wid * 1024u;
    const int aoff = lds_byte(wr * 64 + fr, fq * 8), boff = lds_byte(wc * 32 + fr, fq * 8);
#define PG8_SA(b, h) (((b) * 2 + (h)) * HTB)
#define PG8_SB(b, h) ((4 + (b) * 2 + (h)) * HTB)
#define PG8_STAGE(bufoff, gbase, voff) do { _Pragma("unroll") for (int _i = 0; _i < 2; ++_i) \
        __builtin_amdgcn_global_load_lds((const unsigned*)((const char*)(gbase) + (voff)[_i]), (PG8_LAS unsigned*)(lds + (bufoff) + ldsw + _i * 8192), 16, 0, 0); } while (0)
#define PG8_LDA(dst, b, h) do { _Pragma("unroll") for (int m = 0; m < 4; ++m) _Pragma("unroll") for (int k = 0; k < 2; ++k) dst[m][k] = *(const PG8_LAS bf16x8*)(lds + PG8_SA(b, h) + aoff + m * 2048 + k * 1024); } while (0)
#define PG8_LDB(dst, b, h) do { _Pragma("unroll") for (int n = 0; n < 2; ++n) _Pragma("unroll") for (int k = 0; k < 2; ++k) dst[n][k] = *(const PG8_LAS bf16x8*)(lds + PG8_SB(b, h) + boff + n * 2048 + k * 1024); } while (0)
#define PG8_MMA(ai, bj, At, Bt) do { __builtin_amdgcn_s_setprio(1); _Pragma("unroll") for (int m = 0; m < 4; ++m) _Pragma("unroll") for (int n = 0; n < 2; ++n) _Pragma("unroll") for (int k = 0; k < 2; ++k) \
        acc[ai][bj][m][n] = __builtin_amdgcn_mfma_f32_16x16x32_bf16(Bt[n][k], At[m][k], acc[ai][bj][m][n], 0, 0, 0); __builtin_amdgcn_s_setprio(0); } while (0)
#define PG8_WAIT_V(n) asm volatile("s_waitcnt vmcnt(" #n ")" ::: "memory")
#define PG8_WAIT_L(n) asm volatile("s_waitcnt lgkmcnt(" #n ")" ::: "memory")
#define PG8_BAR __builtin_amdgcn_s_barrier()
#define PG8_SCHED __builtin_amdgcn_sched_barrier(0)
    Unit cur, nxt; int ui = 0;
    if (!S.next(0, cur)) return;
    f32x4 acc[2][2][4][2];
#pragma unroll
    for (int a = 0; a < 2; ++a)
#pragma unroll
        for (int b = 0; b < 2; ++b)
#pragma unroll
            for (int m = 0; m < 4; ++m)
#pragma unroll
                for (int n = 0; n < 2; ++n) acc[a][b][m][n] = (f32x4){0.f, 0.f, 0.f, 0.f};
    bf16x8 At[4][2], B0[2][2], B1[2][2];
    const char* cA = (const char*)g.A + (size_t)cur.pm * tstep; const char* cB = (const char*)g.Bt + (size_t)cur.pn * tstep;
    S.a_ready(cur);
    if constexpr (SP2) {
        PG8_STAGE(PG8_SB(0, 0), cB, voffB); PG8_STAGE(PG8_SB(0, 1), cB + hstep, voffB); PG8_STAGE(PG8_SA(0, 0), cA, voffA); PG8_STAGE(PG8_SA(0, 1), cA + hstep, voffA);
        if (wr == 1) PG8_BAR;
        PG8_WAIT_V(2); PG8_BAR;
        PG8_STAGE(PG8_SB(1, 0), cB + kstep, voffB); PG8_STAGE(PG8_SA(1, 0), cA + kstep, voffA); PG8_STAGE(PG8_SB(1, 1), cB + hstep + kstep, voffB);
        PG8_WAIT_V(6); PG8_BAR;
    } else {
        PG8_STAGE(PG8_SB(0, 0), cB, voffB); PG8_STAGE(PG8_SA(0, 0), cA, voffA); PG8_STAGE(PG8_SB(0, 1), cB + hstep, voffB); PG8_STAGE(PG8_SA(0, 1), cA + hstep, voffA);
        if (wr == 1) PG8_BAR;
        PG8_WAIT_V(4); PG8_BAR;
        PG8_STAGE(PG8_SB(1, 0), cB + kstep, voffB); PG8_STAGE(PG8_SA(1, 0), cA + kstep, voffA); PG8_STAGE(PG8_SB(1, 1), cB + hstep + kstep, voffB);
        PG8_WAIT_V(6); PG8_BAR;
    }
    for (;;) {
        const bool has_next = S.next(ui + 1, nxt);
        const char* nA = has_next ? (const char*)g.A + (size_t)nxt.pm * tstep : cA; const char* nB = has_next ? (const char*)g.Bt + (size_t)nxt.pn * tstep : cB;
        for (int t = 0; t < nt; t += 2) {
            const bool last = (t == nt - 2);
            const char* a1 = cA + (size_t)(t + 1) * kstep;
            const char* a2 = last ? nA : cA + (size_t)(t + 2) * kstep; const char* b2 = last ? nB : cB + (size_t)(t + 2) * kstep;
            const char* a3 = a2 + kstep; const char* b3 = b2 + kstep;
            if (last && has_next) S.a_ready(nxt);
            if constexpr (SP2) {
            PG8_LDB(B0, 0, 0); PG8_LDB(B1, 0, 1); PG8_SCHED; PG8_LDA(At, 0, 0); PG8_STAGE(PG8_SA(1, 1), a1 + hstep, voffA);
            PG8_WAIT_V(8); PG8_WAIT_L(0); PG8_BAR; PG8_MMA(0, 0, At, B0); PG8_MMA(0, 1, At, B1); PG8_BAR; PG8_SCHED;
            PG8_LDA(At, 0, 1); PG8_STAGE(PG8_SB(0, 0), b2, voffB); PG8_STAGE(PG8_SB(0, 1), b2 + hstep, voffB); PG8_STAGE(PG8_SA(0, 0), a2, voffA);
            PG8_WAIT_V(8); PG8_WAIT_L(0); PG8_BAR; PG8_MMA(1, 0, At, B0); PG8_MMA(1, 1, At, B1); PG8_BAR; PG8_SCHED;
            PG8_LDB(B0, 1, 0); PG8_LDB(B1, 1, 1); PG8_SCHED; PG8_LDA(At, 1, 0); PG8_STAGE(PG8_SA(0, 1), a2 + hstep, voffA);
            PG8_WAIT_V(8); PG8_WAIT_L(0); PG8_BAR; PG8_MMA(0, 0, At, B0); PG8_MMA(0, 1, At, B1); PG8_BAR; PG8_SCHED;
            PG8_LDA(At, 1, 1); PG8_STAGE(PG8_SB(1, 0), b3, voffB); PG8_STAGE(PG8_SB(1, 1), b3 + hstep, voffB); PG8_STAGE(PG8_SA(1, 0), a3, voffA);
            PG8_WAIT_V(8); PG8_WAIT_L(0); PG8_BAR; PG8_MMA(1, 0, At, B0); PG8_MMA(1, 1, At, B1); PG8_BAR; PG8_SCHED;
            } else {
            PG8_LDB(B0, 0, 0); PG8_SCHED; PG8_LDA(At, 0, 0); PG8_STAGE(PG8_SA(1, 1), a1 + hstep, voffA);
            PG8_WAIT_L(8); PG8_BAR; PG8_WAIT_L(0); PG8_MMA(0, 0, At, B0); PG8_BAR; PG8_SCHED;
            PG8_LDB(B1, 0, 1); PG8_STAGE(PG8_SB(0, 0), b2, voffB);
            PG8_BAR; PG8_WAIT_L(0); PG8_MMA(0, 1, At, B1); PG8_BAR;
            PG8_LDA(At, 0, 1); PG8_STAGE(PG8_SA(0, 0), a2, voffA);
            PG8_BAR; PG8_WAIT_L(0); PG8_MMA(1, 0, At, B0); PG8_BAR; PG8_SCHED;
            PG8_STAGE(PG8_SB(0, 1), b2 + hstep, voffB);
            PG8_WAIT_V(6); PG8_BAR; PG8_MMA(1, 1, At, B1); PG8_BAR;
            PG8_LDB(B0, 1, 0); PG8_SCHED; PG8_LDA(At, 1, 0); PG8_STAGE(PG8_SA(0, 1), a2 + hstep, voffA);
            PG8_WAIT_L(8); PG8_BAR; PG8_WAIT_L(0); PG8_MMA(0, 0, At, B0); PG8_BAR; PG8_SCHED;
            PG8_LDB(B1, 1, 1); PG8_STAGE(PG8_SB(1, 0), b3, voffB);
            PG8_BAR; PG8_WAIT_L(0); PG8_MMA(0, 1, At, B1); PG8_BAR;
            PG8_LDA(At, 1, 1); PG8_STAGE(PG8_SA(1, 0), a3, voffA);
            PG8_BAR; PG8_WAIT_L(0); PG8_MMA(1, 0, At, B0); PG8_BAR; PG8_SCHED;
            PG8_STAGE(PG8_SB(1, 1), b3 + hstep, voffB);
            PG8_WAIT_V(6); PG8_BAR; PG8_MMA(1, 1, At, B1); PG8_BAR;
            }
        }
        if constexpr (ALIGN_EPI) { if (wr == 0) PG8_BAR; }
        if constexpr (!Epi::AFTER_DRAIN) { E(acc, cur, wr, wc, fr, fq); S.done(cur); }
        if (!has_next) break;
#pragma unroll
        for (int a = 0; a < 2; ++a)
#pragma unroll
            for (int b = 0; b < 2; ++b)
#pragma unroll
                for (int m = 0; m < 4; ++m)
#pragma unroll
                    for (int n = 0; n < 2; ++n) acc[a][b][m][n] = (f32x4){0.f, 0.f, 0.f, 0.f};
        cur = nxt; cA = nA; cB = nB; ++ui;
        if constexpr (ALIGN_EPI) { if (wr == 1) PG8_BAR; }
    }
    PG8_WAIT_V(0);
    if constexpr (!ALIGN_EPI) { if (wr == 0) PG8_BAR; }
    PG8_BAR;
    if constexpr (Epi::AFTER_DRAIN) { E.fused(acc, cur, wr, wc, fr, fq, lds, wid, lane); S.done(cur); }
#undef PG8_SA
#undef PG8_SB
#undef PG8_STAGE
#undef PG8_LDA
#undef PG8_LDB
#undef PG8_MMA
#undef PG8_WAIT_V
#undef PG8_WAIT_L
#undef PG8_BAR
#undef PG8_SCHED
}
}
#include <hip/hip_bf16.h>
namespace attn_body {
using bf16=__hip_bfloat16;
using bf16x8=__attribute__((ext_vector_type(8)))short;
using s16x4=__attribute__((ext_vector_type(4)))short;
using f32x16=__attribute__((ext_vector_type(16)))float;
using u32x4=__attribute__((ext_vector_type(4)))unsigned;
constexpr int BATCH=8,NHEAD=16,SEQ=4096,D=64,PITI=3584,PITO=1024;
constexpr int NW=8,QBLK=32,QB=QBLK*NW,KVBLK=64,NQB=SEQ/QB;
__device__ __forceinline__ int crow(int r,int hi){return (r&3)+8*(r>>2)+4*hi;}
#define SBAR() __builtin_amdgcn_sched_barrier(0)
__device__ __forceinline__ void cmask(f32x16&p0,f32x16&p1,int jb,int qrel,int hi){
  const float NEG=-INFINITY; int kb=64*jb+4*hi;
  #pragma unroll
  for(int r=0;r<16;++r){int kv=kb+(r&3)+8*(r>>2); if(kv>qrel)p0[r]=NEG; if(kv+32>qrel)p1[r]=NEG;}
}

constexpr int NSLOT=3, SLOTB=8192;
constexpr int LDS_K=0, LDS_V=NSLOT*SLOTB, LDS_WS=2*NSLOT*SLOTB, LDS_OST=LDS_WS+NW*64*4, LDS_BYTES=LDS_OST+NW*4096;
constexpr float C2=0.125f*1.4426950408889634f;
__device__ __forceinline__ void glds16(const void*gsrc,unsigned lds_dst){unsigned keep;
  asm volatile("s_mov_b32 %0, m0\n\ts_mov_b32 m0, %2\n\ts_nop 0\n\tglobal_load_lds_dwordx4 %1, off\n\ts_mov_b32 m0, %0":"=&s"(keep):"v"(gsrc),"s"(lds_dst):"memory");}
__device__ __forceinline__ float max3f(float a,float b,float c){float r;asm("v_max3_f32 %0, %1, %2, %3":"=v"(r):"v"(a),"v"(b),"v"(c));return r;}
__device__ __forceinline__ float max2f(float a,float b){float r;asm("v_max_f32_e32 %0, %1, %2":"=v"(r):"v"(a),"v"(b));return r;}
__device__ __forceinline__ float fadd_s(float a,float b){float r;asm("v_add_f32_e32 %0, %1, %2":"=v"(r):"v"(a),"v"(b));return r;}
__device__ __forceinline__ float fsub_s(float a,float b){float r;asm("v_sub_f32_e32 %0, %1, %2":"=v"(r):"v"(a),"v"(b));return r;}
typedef float f32x2_t __attribute__((ext_vector_type(2))); typedef __bf16 bf16x2_t __attribute__((ext_vector_type(2)));
__device__ __forceinline__ unsigned cvtpk_s(float lo,float hi){f32x2_t v={lo,hi};bf16x2_t b=__builtin_convertvector(v,bf16x2_t);return __builtin_bit_cast(unsigned,b);}
#define WAIT_BAR(N) asm volatile("s_waitcnt vmcnt(" #N ") lgkmcnt(0)\n\ts_barrier":::"memory")

__device__ __forceinline__ void qkt(f32x16&p0,f32x16&p1,const char*Kslot,const bf16x8*qr,const f32x16&negm,int r32,int hi){
  const char*kb=Kslot+hi*1024+r32*16;
  #pragma unroll
  for(int d0=0;d0<4;++d0){
    const bf16x8 b0=*reinterpret_cast<const bf16x8*>(kb+d0*2048);
    const bf16x8 b1=*reinterpret_cast<const bf16x8*>(kb+d0*2048+512);
    if(d0==0){p0=__builtin_amdgcn_mfma_f32_32x32x16_bf16(b0,qr[0],negm,0,0,0);p1=__builtin_amdgcn_mfma_f32_32x32x16_bf16(b1,qr[0],negm,0,0,0);}
    else{p0=__builtin_amdgcn_mfma_f32_32x32x16_bf16(b0,qr[d0],p0,0,0,0);p1=__builtin_amdgcn_mfma_f32_32x32x16_bf16(b1,qr[d0],p1,0,0,0);}}
}
typedef __attribute__((address_space(3))) const char* lds_cptr;
typedef short v4i16_t __attribute__((ext_vector_type(4)));
__device__ __forceinline__ void kload8(bf16x8*kf,lds_cptr kp){
  kf[0]=*(const __attribute__((address_space(3))) bf16x8*)(kp);      kf[1]=*(const __attribute__((address_space(3))) bf16x8*)(kp+512);
  kf[2]=*(const __attribute__((address_space(3))) bf16x8*)(kp+2048); kf[3]=*(const __attribute__((address_space(3))) bf16x8*)(kp+2560);
  kf[4]=*(const __attribute__((address_space(3))) bf16x8*)(kp+4096); kf[5]=*(const __attribute__((address_space(3))) bf16x8*)(kp+4608);
  kf[6]=*(const __attribute__((address_space(3))) bf16x8*)(kp+6144); kf[7]=*(const __attribute__((address_space(3))) bf16x8*)(kp+6656);
}
__device__ __forceinline__ void kload2(bf16x8*kf,lds_cptr kp,int j){ kf[2*j]=*(const __attribute__((address_space(3))) bf16x8*)(kp+j*2048); kf[2*j+1]=*(const __attribute__((address_space(3))) bf16x8*)(kp+j*2048+512); }
__device__ __forceinline__ s16x4 vtr(lds_cptr p){ return __builtin_bit_cast(s16x4,__builtin_amdgcn_ds_read_tr16_b64_v4i16((__attribute__((address_space(3))) v4i16_t*)p)); }
__device__ __forceinline__ float rowmax(const f32x16&p0,const f32x16&p1){
  float a=max3f(p0[0],p0[1],p1[0]),b=max3f(p0[2],p0[3],p1[1]);a=max3f(a,p1[2],p1[3]);
  #pragma unroll
  for(int r=4;r<16;r+=4){a=max3f(a,p0[r],p0[r+1]);b=max3f(b,p0[r+2],p0[r+3]);a=max3f(a,p1[r],p1[r+1]);b=max3f(b,p1[r+2],p1[r+3]);}
  const float m=max2f(a,b);
  auto rr=__builtin_amdgcn_permlane32_swap(__float_as_uint(m),__float_as_uint(m),false,false);
  return max2f(__uint_as_float(rr[0]),__uint_as_float(rr[1]));
}
__device__ __forceinline__ void pv(f32x16*o,int vb,bf16x8 pa0,bf16x8 pa1,bf16x8 pa2,bf16x8 pa3){
  #pragma unroll
  for(int d0=0;d0<2;++d0){s16x4 lo[4],hi[4];
    #pragma unroll
    for(int ks=0;ks<4;++ks){
      asm volatile("ds_read_b64_tr_b16 %0,%1 offset:%c2":"=&v"(lo[ks]):"v"(vb),"i"(d0*4096+ks*1024):"memory");
      asm volatile("ds_read_b64_tr_b16 %0,%1 offset:%c2":"=&v"(hi[ks]):"v"(vb),"i"(d0*4096+ks*1024+512):"memory");}
    asm volatile("s_waitcnt lgkmcnt(0)":::"memory");SBAR();
    #define PK(k) (bf16x8){lo[k][0],lo[k][1],lo[k][2],lo[k][3],hi[k][0],hi[k][1],hi[k][2],hi[k][3]}
    o[d0]=__builtin_amdgcn_mfma_f32_32x32x16_bf16(pa0,PK(0),o[d0],0,0,0);
    o[d0]=__builtin_amdgcn_mfma_f32_32x32x16_bf16(pa1,PK(1),o[d0],0,0,0);
    o[d0]=__builtin_amdgcn_mfma_f32_32x32x16_bf16(pa2,PK(2),o[d0],0,0,0);
    o[d0]=__builtin_amdgcn_mfma_f32_32x32x16_bf16(pa3,PK(3),o[d0],0,0,0);
    #undef PK
  }
}

#ifndef ATTN_STORE16
#define ATTN_STORE16(p,v) (*(u32x4*)(p)=(v))
#endif
template<int THRL> __device__ __forceinline__ void attn_unit(int b,int h,int qb,const bf16*Q,const bf16*__restrict__ K,const bf16*__restrict__ V,bf16*O,char*shm){
  const int tid=otid_(),lane=tid&63,r32=lane&31,hi=lane>>5; const int wid=__builtin_amdgcn_readfirstlane(tid>>6);
  const long rowbase=(long)b*SEQ; const int q0=qb*QB;
  const bf16*Qw=Q+(rowbase+q0+wid*QBLK)*PITI;
  const bf16*Kh=K+rowbase*PITI,*Vh=V+rowbase*PITI;
  const unsigned lds0=(unsigned)(uintptr_t)shm;
  float*wsf=(float*)(shm+LDS_WS)+wid*64;
  const bf16*ksrc=Kh+(long)lane*PITI+wid*8;
  const bf16*vsrc=Vh+(long)(16*(wid&3)+(lane>>2))*PITI+(wid>>2)*32+(lane&3)*8;
  const unsigned kdst=lds0+LDS_K+wid*1024, vdst=lds0+LDS_V+wid*1024;
  #define DMA_K(t,slot) glds16(ksrc+(long)(t)*KVBLK*PITI,(unsigned)__builtin_amdgcn_readfirstlane(kdst+(slot)))
  #define DMA_V(t,slot) glds16(vsrc+(long)(t)*KVBLK*PITI,(unsigned)__builtin_amdgcn_readfirstlane(vdst+(slot)))
  const int vb0=(int)(lds0+LDS_V)+((lane>>4)&1)*32+(lane&3)*8+(4*hi+((lane&15)>>2))*64;
  const char*Kbase=shm+LDS_K; bf16x8 kf[8];
  const lds_cptr shm3=(lds_cptr)shm; const lds_cptr kp0=shm3+LDS_K+hi*1024+r32*16; const lds_cptr vp0=shm3+LDS_V+((lane>>4)&1)*32+(lane&3)*8+(4*hi+((lane&15)>>2))*64;
  const int NT=(q0+QB)/KVBLK;
  DMA_K(0,0);DMA_V(0,0);DMA_K(1,SLOTB);
  bf16x8 qr[4];
  #pragma unroll
  for(int d0=0;d0<4;++d0)qr[d0]=*reinterpret_cast<const bf16x8*>(&Qw[(long)r32*PITI+d0*16+hi*8]);
  float mhat=0.f,l_reg=0.f;f32x16 o[2];o[0]=f32x16{};o[1]=f32x16{};f32x16 negm=f32x16{};asm volatile("":"+v"(negm));
  const int qrel=wid*QBLK+r32;
  #define CMASK(P0,P1,t) do{int jb_=(t)-(NT-4); if(jb_>=0)cmask(P0,P1,jb_,qrel,hi);}while(0)
  bool resc=false;
  #define START(P0,P1) do{ const float rm=rowmax(P0,P1); resc=false; \
    { const float dl=rm; mhat=fadd_s(mhat,dl); \
      _Pragma("unroll") for(int r=0;r<16;++r){P0[r]=fsub_s(P0[r],dl);P1[r]=fsub_s(P1[r],dl);} \
      _Pragma("unroll") for(int r=0;r<16;++r)negm[r]=-mhat; asm volatile("":"+v"(negm)); } \
    _Pragma("unroll") for(int r=0;r<16;++r)P0[r]=__builtin_amdgcn_exp2f(P0[r]); }while(0)
  #define RESC() do{ if(resc){ asm volatile("s_waitcnt lgkmcnt(0)":::"memory"); \
      _Pragma("unroll") for(int d_=0;d_<2;++d_) _Pragma("unroll") for(int r=0;r<16;++r)o[d_][r]*=wsf[crow(r,hi)]; } }while(0)
  f32x16 pA0,pA1,pB0,pB1;
  int sl_prev=0,sl_cur=0,sl_next=SLOTB;
  #define ROT() do{sl_prev=sl_cur;sl_cur=sl_next;sl_next=(sl_next==(NSLOT-1)*SLOTB)?0:sl_next+SLOTB;}while(0)
  DMA_K(2,2*SLOTB);
  WAIT_BAR(3);
  qkt(pA0,pA1,Kbase,qr,negm,r32,hi);asm volatile("s_nop 15\n\ts_nop 7":"+v"(pA0),"+v"(pA1));CMASK(pA0,pA1,0);
  START(pA0,pA1);
  _Pragma("unroll") for(int r=0;r<16;++r)pA1[r]=__builtin_amdgcn_exp2f(pA1[r]);
  WAIT_BAR(0);
  DMA_K(3,0);DMA_V(1,SLOTB);
  ROT();
  kload8(kf,kp0+sl_cur);
  WAIT_BAR(2);
  s16x4 vlo[8],vhi[8]; u32x4 pw0,pw1,pw2,pw3;
  #define PKW(P,B) cvtpk_s(P[B],P[B+1])
  #define PAF(k) __builtin_bit_cast(bf16x8,pw##k)
  #define VFR(i) (bf16x8){vlo[i][0],vlo[i][1],vlo[i][2],vlo[i][3],vhi[i][0],vhi[i][1],vhi[i][2],vhi[i][3]}
  #define PIN(x) asm volatile("":"+v"(x))
  #define MX3(a,b,c) __builtin_fmaxf(__builtin_fmaxf((a),(b)),(c))
  #define GAPA(MF,A0,A1,A2,A3,W0,W1,PW) do{ MF; sacc+=A0; sacc+=A1; sacc+=A2; sacc+=A3; PIN(sacc); W0; W1; PIN(PW); SBAR(); }while(0)
  #define EX(v) __builtin_amdgcn_exp2f(v)
  #define GAPB(MF,X,B) do{ MF; X[B]=EX(X[B]); X[B+1]=EX(X[B+1]); X[B+2]=EX(X[B+2]); X[B+3]=EX(X[B+3]); PIN(X); SBAR(); }while(0)
  #define VRD(i) do{ vlo[i]=vtr(vp_+(((i)>>2)*4096+((i)&3)*1024)); vhi[i]=vtr(vp_+(((i)>>2)*4096+((i)&3)*1024+512)); }while(0)
  #define KRD(G,j) do{ if(G){ kload2(kf,kp0+sl_next,j); SBAR(); } }while(0)
  #define STEP(C0,C1,P0,P1,t,GK,GV,GL) do{ SBAR(); \
    const lds_cptr vp_=vp0+sl_prev; \
    VRD(0); SBAR(); float sacc=(P0[0]+P0[1]); \
    GAPA(C0=__builtin_amdgcn_mfma_f32_32x32x16_bf16(kf[0],qr[0],negm,0,0,0), P0[2],P0[3],P0[4],P0[5],     pw0[0]=PKW(P0,0), pw0[1]=PKW(P0,2), pw0); \
    VRD(4); SBAR(); GAPA(C1=__builtin_amdgcn_mfma_f32_32x32x16_bf16(kf[1],qr[0],negm,0,0,0), P0[6],P0[7],P0[8],P0[9],     pw0[2]=PKW(P0,4), pw0[3]=PKW(P0,6), pw0); \
    VRD(1); SBAR(); GAPA(C0=__builtin_amdgcn_mfma_f32_32x32x16_bf16(kf[2],qr[1],C0,0,0,0),   P0[10],P0[11],P0[12],P0[13], pw1[0]=PKW(P0,8), pw1[1]=PKW(P0,10), pw1); \
    VRD(5); SBAR(); GAPA(C1=__builtin_amdgcn_mfma_f32_32x32x16_bf16(kf[3],qr[1],C1,0,0,0),   P0[14],P0[15],P1[0],P1[1],   pw1[2]=PKW(P0,12),pw1[3]=PKW(P0,14), pw1); \
    VRD(2); SBAR(); GAPA(C0=__builtin_amdgcn_mfma_f32_32x32x16_bf16(kf[4],qr[2],C0,0,0,0),   P1[2],P1[3],P1[4],P1[5],     pw2[0]=PKW(P1,0), pw2[1]=PKW(P1,2), pw2); \
    VRD(6); SBAR(); GAPA(C1=__builtin_amdgcn_mfma_f32_32x32x16_bf16(kf[5],qr[2],C1,0,0,0),   P1[6],P1[7],P1[8],P1[9],     pw2[2]=PKW(P1,4), pw2[3]=PKW(P1,6), pw2); \
    VRD(3); SBAR(); GAPA(C0=__builtin_amdgcn_mfma_f32_32x32x16_bf16(kf[6],qr[3],C0,0,0,0),   P1[10],P1[11],P1[12],P1[13], pw3[0]=PKW(P1,8), pw3[1]=PKW(P1,10), pw3); \
    VRD(7); SBAR(); GAPA(C1=__builtin_amdgcn_mfma_f32_32x32x16_bf16(kf[7],qr[3],C1,0,0,0),   P1[14],P1[15],0.f,0.f,       pw3[2]=PKW(P1,12),pw3[3]=PKW(P1,14), pw3); \
    l_reg+=sacc; \
    if(GK){DMA_K((t)+3,sl_cur);} if(GV){DMA_V((t)+1,sl_next);} \
    CMASK(C0,C1,t); \
    { float a=MX3(C0[0],C0[1],C1[0]),b=MX3(C0[2],C0[3],C1[1]); a=MX3(a,C1[2],C1[3]); \
      _Pragma("unroll") for(int r=4;r<16;r+=4){a=MX3(a,C0[r],C0[r+1]);b=MX3(b,C0[r+2],C0[r+3]);a=MX3(a,C1[r],C1[r+1]);b=MX3(b,C1[r+2],C1[r+3]);} \
      float rm=__builtin_fmaxf(a,b); { auto rr=__builtin_amdgcn_permlane32_swap(__float_as_uint(rm),__float_as_uint(rm),false,false); rm=__builtin_fmaxf(__uint_as_float(rr[0]),__uint_as_float(rr[1])); } \
      resc=false; \
      if(__builtin_expect(__any(rm>(float)THRL),0)){ const float dl=__builtin_fmaxf(rm,0.f); mhat+=dl; \
        _Pragma("unroll") for(int r=0;r<16;++r){C0[r]-=dl;C1[r]-=dl;} \
        _Pragma("unroll") for(int r=0;r<16;++r)negm[r]=-mhat; asm volatile("":"+v"(negm)); \
        const float f=__builtin_amdgcn_exp2f(-dl); l_reg*=f; if(hi==0)wsf[r32]=f; resc=true; } } \
    SBAR(); \
    GAPB(o[0]=__builtin_amdgcn_mfma_f32_32x32x16_bf16(PAF(0),VFR(0),o[0],0,0,0), C0,0); \
    GAPB(o[1]=__builtin_amdgcn_mfma_f32_32x32x16_bf16(PAF(0),VFR(4),o[1],0,0,0), C0,4); \
    KRD(GL,0); GAPB(o[0]=__builtin_amdgcn_mfma_f32_32x32x16_bf16(PAF(1),VFR(1),o[0],0,0,0), C0,8); \
    KRD(GL,1); GAPB(o[1]=__builtin_amdgcn_mfma_f32_32x32x16_bf16(PAF(1),VFR(5),o[1],0,0,0), C0,12); \
    KRD(GL,2); GAPB(o[0]=__builtin_amdgcn_mfma_f32_32x32x16_bf16(PAF(2),VFR(2),o[0],0,0,0), C1,0); \
    KRD(GL,3); GAPB(o[1]=__builtin_amdgcn_mfma_f32_32x32x16_bf16(PAF(2),VFR(6),o[1],0,0,0), C1,4); \
    GAPB(o[0]=__builtin_amdgcn_mfma_f32_32x32x16_bf16(PAF(3),VFR(3),o[0],0,0,0), C1,8); \
    GAPB(o[1]=__builtin_amdgcn_mfma_f32_32x32x16_bf16(PAF(3),VFR(7),o[1],0,0,0), C1,12); \
    }while(0)
  int t=1;
  #undef CMASK
  #define CMASK(P0,P1,t) do{}while(0)
  for(;t+5<NT;t+=2){
    STEP(pB0,pB1,pA0,pA1,t,true,true,true);     WAIT_BAR(2); RESC(); ROT();
    STEP(pA0,pA1,pB0,pB1,t+1,true,true,true);   WAIT_BAR(2); RESC(); ROT();
  }
  #undef CMASK
  #define CMASK(P0,P1,t) do{int jb_=(t)-(NT-4); if(jb_>=0)cmask(P0,P1,jb_,qrel,hi);}while(0)
  #define ENDW(tt) do{ if((tt)+3<NT){WAIT_BAR(2);} else if((tt)+2<NT){WAIT_BAR(1);} else {WAIT_BAR(0);} }while(0)
  for(;t+1<NT;t+=2){
    STEP(pB0,pB1,pA0,pA1,t,(t+3<NT),(t+1<NT),(t+1<NT));       ENDW(t);   RESC(); ROT();
    STEP(pA0,pA1,pB0,pB1,t+1,(t+4<NT),(t+2<NT),(t+2<NT));     ENDW(t+1); RESC(); ROT();
  }
  STEP(pB0,pB1,pA0,pA1,NT-1,false,false,false); RESC();
  { float sacc=pB0[0]+pB0[1]; _Pragma("unroll") for(int r=2;r<16;++r)sacc+=pB0[r]; _Pragma("unroll") for(int r=0;r<16;++r)sacc+=pB1[r]; l_reg+=sacc;
    pw0=(u32x4){PKW(pB0,0),PKW(pB0,2),PKW(pB0,4),PKW(pB0,6)};pw1=(u32x4){PKW(pB0,8),PKW(pB0,10),PKW(pB0,12),PKW(pB0,14)};pw2=(u32x4){PKW(pB1,0),PKW(pB1,2),PKW(pB1,4),PKW(pB1,6)};pw3=(u32x4){PKW(pB1,8),PKW(pB1,10),PKW(pB1,12),PKW(pB1,14)};
    SBAR(); pv(o,vb0+sl_cur,PAF(0),PAF(1),PAF(2),PAF(3)); }
  #undef PKW
  #undef PAF
  #undef VFR
  #undef PIN
  #undef MX3
  #undef GAPA
  #undef GAPB
  #undef EX
  #undef VRD
  #undef KRD
  #undef STEP
  #undef ENDW
  {auto rr=__builtin_amdgcn_permlane32_swap(__float_as_uint(l_reg),__float_as_uint(l_reg),false,false);l_reg=__uint_as_float(rr[0])+__uint_as_float(rr[1]);}
  if(hi==0)wsf[32+r32]=l_reg;asm volatile("s_waitcnt lgkmcnt(0)":::"memory");
  float rli[16];
  #pragma unroll
  for(int r=0;r<16;++r)rli[r]=__builtin_amdgcn_rcpf(wsf[32+crow(r,hi)]);
  bf16*Ow=O+(rowbase+q0+wid*QBLK)*PITO;
  { bf16*stg=(bf16*)(shm+LDS_OST)+wid*2048;
    #pragma unroll
    for(int r=0;r<16;++r){const int orow=crow(r,hi);
      #pragma unroll
      for(int d0=0;d0<2;++d0)stg[orow*64+d0*32+r32]=__float2bfloat16(o[d0][r]*rli[r]);}
    asm volatile("s_waitcnt lgkmcnt(0)":::"memory");
    #pragma unroll
    for(int i=0;i<4;++i){const int row=i*8+(lane>>3),ch=lane&7; const u32x4 v=*(const u32x4*)(stg+row*64+ch*8); ATTN_STORE16(Ow+(long)row*PITO+ch*8,v);} }
  asm volatile("s_waitcnt lgkmcnt(0)\n\ts_barrier":::"memory");
  #undef DMA_K
  #undef DMA_V
  #undef CMASK
  #undef START
  #undef RESC
  #undef ROT
}
constexpr int ATTN_LDS_BYTES=LDS_BYTES;
#undef SBAR
#undef WAIT_BAR
}

namespace cg = cooperative_groups;
typedef unsigned short bf16_t;
typedef float f32x4 __attribute__((ext_vector_type(4)));
typedef float f32x16 __attribute__((ext_vector_type(16)));
typedef unsigned u32x4 __attribute__((ext_vector_type(4)));
typedef unsigned u32x2 __attribute__((ext_vector_type(2)));
typedef short bf16x8 __attribute__((ext_vector_type(8)));
#define LAS3 __attribute__((address_space(3)))

constexpr int T_ = 32768, DM_ = 1024, SEQ_ = 4096, DFF_ = 2816;
constexpr int NTHR = 512;
constexpr int LDS_BYTES = 147456;
constexpr size_t MiB_ = 1u << 20;
constexpr size_t WS_MOD = 0, WS_COS = 1 * MiB_, WS_SIN = 2 * MiB_, WS_BAR = 3 * MiB_;
constexpr size_t WS_WIN = 4 * MiB_, WS_WOUT = 11 * MiB_, WS_FIN = 13 * MiB_, WS_FOUT = 24 * MiB_;
constexpr size_t WS_A = 32 * MiB_, WS_X2 = 96 * MiB_, WS_ST = 160 * MiB_, WS_TOT = 224 * MiB_, WS_R1 = 226 * MiB_, WS_BIAS = 450 * MiB_, WS_ROWSS = 452 * MiB_, WS_FOUT2 = 454 * MiB_, WS_END = 460 * MiB_;
constexpr int BIAS_L = 8 * (3584 + 5632);
constexpr size_t WS_HP = WS_ST, WS_HU = WS_ST + 12 * MiB_, WS_HA = WS_ST + 24 * MiB_;
constexpr float LOG2E_ = 1.4426950408889634f;
constexpr float QSCALE_ = 0.125f * 1.4426950408889634f;

struct Params {
    const float* x; const float* c; const int* positions; const float* mod_w; const float* mod_b; const float* norm_mix_w; const float* norm_ffn_w;
    const float* ev_w_in; const float* gla_gate_w; const float* gla_gate_b; const float* gla_norm_w; const float* swa_sinks; const float* ev_w_out;
    const float* od_w_in; const float* diff_lambda; const float* diff_norm_w; const float* hgrn_lb_logits; const float* hgrn_norm_w; const float* od_w_out;
    const float* ffn_w_in; const float* ffn_conv_w; const float* ffn_conv_b; const float* ffn_w_out; const float* final_norm_w;
    float* out; unsigned char* ws; unsigned long long pad[6];
};

__device__ __forceinline__ unsigned pk2(float lo, float hi) {
    typedef float f32x2_t __attribute__((ext_vector_type(2))); typedef __bf16 bf16x2_t __attribute__((ext_vector_type(2)));
    f32x2_t v = {lo, hi}; bf16x2_t b = __builtin_convertvector(v, bf16x2_t); return __builtin_bit_cast(unsigned, b);
}
__device__ __forceinline__ float bflo(unsigned u) { return __uint_as_float(u << 16); }
__device__ __forceinline__ float bfhi(unsigned u) { return __uint_as_float(u & 0xffff0000u); }
__device__ __forceinline__ float sigmoidf_(float x) { return __builtin_amdgcn_rcpf(1.f + __expf(-x)); }
__device__ __forceinline__ float siluf_(float x) { return x * __builtin_amdgcn_rcpf(1.f + __expf(-x)); }
__device__ __forceinline__ float wave_sum(float v) {
#pragma unroll
    for (int o = 1; o < 64; o <<= 1) v += __shfl_xor(v, o);
    return v;
}
__device__ __forceinline__ int crow_(int r, int hi) { return (r & 3) + 8 * (r >> 2) + 4 * hi; }

namespace pg8 {
struct EpiProj {
    static constexpr bool PERM = true, AFTER_DRAIN = false;
    bf16_t* O; int ldc; unsigned ropemask; unsigned scalemask; float scale; const float* cs; const float* sn; const float* rowss; const float* bias;
    __device__ __forceinline__ void operator()(const f32x4 (&acc)[2][2][4][2], const Unit& u, int, int, int, int) const {
        const int t_ = otid_(), l_ = t_ & 63, fr = l_ & 15, fq = l_ >> 4, wid_ = __builtin_amdgcn_readfirstlane(t_ >> 6), wr = wid_ >> 2, wc = wid_ & 3;
        const int row0 = u.pm * BM + wr * 64 + fr; const int col0 = u.pn * BM + wc * 32 + 8 * fq;
        float rs[2][4];
#pragma unroll
        for (int ai = 0; ai < 2; ++ai)
#pragma unroll
            for (int m = 0; m < 4; ++m) rs[ai][m] = rsqrtf(rowss[row0 + ai * HALF + m * 16] * (1.f / 1024.f) + 1e-6f);
        const float* bp = bias + (size_t)((u.pm * BM) >> 12) * ldc + col0;
#pragma unroll
        for (int bj = 0; bj < 2; ++bj) {
            const f32x4 bv0 = *(const f32x4*)(bp + bj * HALF), bv1 = *(const f32x4*)(bp + bj * HALF + 4);
            const int grp = u.pn * 2 + bj;
            const bool rope = ((ropemask >> grp) & 1u) && ((wc & 1) == 0);
            const float sc = ((scalemask >> grp) & 1u) ? scale : 1.f;
#pragma unroll
            for (int ai = 0; ai < 2; ++ai)
#pragma unroll
                for (int m = 0; m < 4; ++m) {
                    const int row = row0 + ai * HALF + m * 16;
                    f32x4 v0 = acc[ai][bj][m][0] * rs[ai][m] + bv0, v1 = acc[ai][bj][m][1] * rs[ai][m] + bv1;
                    if (rope) {
                        const f32x4 c0 = *(const f32x4*)(cs + (size_t)row * 8), c1 = *(const f32x4*)(cs + (size_t)row * 8 + 4);
                        const f32x4 s0 = *(const f32x4*)(sn + (size_t)row * 8), s1 = *(const f32x4*)(sn + (size_t)row * 8 + 4);
                        const float sg = (fq == 0) ? -1.f : 1.f;
#pragma unroll
                        for (int e = 0; e < 4; ++e) {
                            const float p0 = __shfl_xor(v0[e], 16), p1 = __shfl_xor(v1[e], 16);
                            const float r0 = v0[e] * c0[e] + sg * p0 * s0[e], r1 = v1[e] * c1[e] + sg * p1 * s1[e];
                            if (fq < 2) { v0[e] = r0; v1[e] = r1; }
                        }
                    }
                    v0 = v0 * sc; v1 = v1 * sc;
                    u32x4 w; w.x = pk2(v0[0], v0[1]); w.y = pk2(v0[2], v0[3]); w.z = pk2(v1[0], v1[1]); w.w = pk2(v1[2], v1[3]);
                    *(u32x4*)(O + (size_t)row * ldc + col0 + bj * HALF) = w;
                    asm volatile("" ::: "memory");
                }
        }
    }
};
typedef _Float16 h16x2 __attribute__((ext_vector_type(2)));
__device__ __forceinline__ unsigned pkh2(float lo, float hi) { typedef float f32x2_t __attribute__((ext_vector_type(2))); f32x2_t v = {lo, hi}; return __builtin_bit_cast(unsigned, __builtin_convertvector(v, h16x2)); }
__device__ __forceinline__ f32x4 unpkh4(unsigned w0, unsigned w1) { const h16x2 a = __builtin_bit_cast(h16x2, w0), b = __builtin_bit_cast(h16x2, w1); return (f32x4){(float)a[0], (float)a[1], (float)b[0], (float)b[1]}; }
struct EpiRes {
    static constexpr bool PERM = true, AFTER_DRAIN = false;
    const void* xin; void* xout; int inf32, outf32; const float* gate;
    bf16_t* Aout; const float* nw; const float* sc; float* rowss;
    __device__ __forceinline__ void operator()(const f32x4 (&acc)[2][2][4][2], const Unit& u, int, int, int, int) const {
        const int t_ = otid_(), l_ = t_ & 63, fr = l_ & 15, fq = l_ >> 4, wid_ = __builtin_amdgcn_readfirstlane(t_ >> 6), wr = wid_ >> 2, wc = wid_ & 3;
        const int col0 = u.pn * BM + wc * 32 + 8 * fq;
        const size_t boff = (size_t)((u.pm * BM) >> 12) * 6144 + col0;
        f32x4 gv[2][2];
#pragma unroll
        for (int bj = 0; bj < 2; ++bj)
#pragma unroll
            for (int n = 0; n < 2; ++n) gv[bj][n] = *(const f32x4*)(gate + boff + bj * HALF + n * 4);
        const int rowb = u.pm * BM + wr * 64 + fr;
        const unsigned eo0 = (unsigned)rowb * 1024u + (unsigned)col0;
        const char* xi = (const char*)xin; char* xo = (char*)xout; char* ao = (char*)Aout;
#pragma unroll
        for (int grp = 0; grp < 8; ++grp) {
            const int ai = grp >> 2, m = grp & 3;
            const unsigned eo = eo0 + (unsigned)(ai * HALF + m * 16) * 1024u;
            float ss = 0.f;
#pragma unroll
            for (int bj = 0; bj < 2; ++bj) {
                const unsigned e2 = eo + (unsigned)(bj * HALF);
                f32x4 x0, x1;
                if (inf32) { x0 = *(const f32x4*)(xi + e2 * 4u); x1 = *(const f32x4*)(xi + e2 * 4u + 16u); }
                else { const u32x4 h = *(const u32x4*)(xi + e2 * 2u); x0 = unpkh4(h.x, h.y); x1 = unpkh4(h.z, h.w); }
                const f32x4 xn0 = x0 + gv[bj][0] * acc[ai][bj][m][0], xn1 = x1 + gv[bj][1] * acc[ai][bj][m][1];
                if (outf32) { *(f32x4*)(xo + e2 * 4u) = xn0; *(f32x4*)(xo + e2 * 4u + 16u) = xn1; }
                else { u32x4 h; h.x = pkh2(xn0[0], xn0[1]); h.y = pkh2(xn0[2], xn0[3]); h.z = pkh2(xn1[0], xn1[1]); h.w = pkh2(xn1[2], xn1[3]); *(u32x4*)(xo + e2 * 2u) = h; }
                if (Aout) {
                    ss += ((xn0[0] * xn0[0] + xn0[1] * xn0[1]) + (xn0[2] * xn0[2] + xn0[3] * xn0[3])) + ((xn1[0] * xn1[0] + xn1[1] * xn1[1]) + (xn1[2] * xn1[2] + xn1[3] * xn1[3]));
                    const f32x4 a0 = xn0 * (*(const f32x4*)(nw + col0 + bj * HALF) * (*(const f32x4*)(sc + boff + bj * HALF) + 1.f));
                    const f32x4 a1 = xn1 * (*(const f32x4*)(nw + col0 + bj * HALF + 4) * (*(const f32x4*)(sc + boff + bj * HALF + 4) + 1.f));
                    u32x4 q; q.x = pk2(a0[0], a0[1]); q.y = pk2(a0[2], a0[3]); q.z = pk2(a1[0], a1[1]); q.w = pk2(a1[2], a1[3]);
                    *(u32x4*)(ao + e2 * 2u) = q;
                }
            }
            if (Aout) {
                ss += __shfl_xor(ss, 16); ss += __shfl_xor(ss, 32);
                if (fq == 0) atomicAdd(rowss + rowb + ai * HALF + m * 16, ss);
            }
            asm volatile("" ::: "memory");
        }
    }
};
struct EpiFfn {
    static constexpr bool PERM = true, AFTER_DRAIN = false;
    bf16_t* G; float* HP; float* HU; float* HA; const float* cw; const float* cb; const float* rowss; const float* bias;
    __device__ __forceinline__ void operator()(const f32x4 (&acc)[2][2][4][2], const Unit& u, int, int, int, int) const {
        const int t_ = otid_(), l_ = t_ & 63, fr = l_ & 15, fq = l_ >> 4, wid_ = __builtin_amdgcn_readfirstlane(t_ >> 6), wr = wid_ >> 2, wc = wid_ & 3;
        const int ch0 = u.pn * 128 + wc * 32 + 8 * fq;
        f32x4 w0[2], w1[2], w2[2], bb[2];
#pragma unroll
        for (int n = 0; n < 2; ++n) { w0[n] = *(const f32x4*)(cw + ch0 + 4 * n); w1[n] = *(const f32x4*)(cw + DFF_ + ch0 + 4 * n); w2[n] = *(const f32x4*)(cw + 2 * DFF_ + ch0 + 4 * n); bb[n] = *(const f32x4*)(cb + ch0 + 4 * n); }
        const int lane = fr + 16 * fq;
        const int src1 = (lane & ~15) | ((fr + 15) & 15), src2 = (lane & ~15) | ((fr + 14) & 15);
        const float* bp = bias + (size_t)((u.pm * BM) >> 12) * 5632 + u.pn * BM + wc * 32 + 8 * fq;
        f32x4 ba[2], bu[2];
#pragma unroll
        for (int n = 0; n < 2; ++n) { ba[n] = *(const f32x4*)(bp + 4 * n); bu[n] = *(const f32x4*)(bp + HALF + 4 * n); }
#pragma unroll
        for (int ai = 0; ai < 2; ++ai) {
            const int seg = u.pm * 4 + ai * 2 + wr;
            f32x4 aprev[2]; aprev[0] = (f32x4){0.f, 0.f, 0.f, 0.f}; aprev[1] = (f32x4){0.f, 0.f, 0.f, 0.f};
#pragma unroll
            for (int m = 0; m < 4; ++m) {
                const int row = u.pm * BM + ai * HALF + wr * 64 + m * 16 + fr;
                const float rs = rsqrtf(rowss[row] * (1.f / 1024.f) + 1e-6f);
                f32x4 val[2], acur[2];
#pragma unroll
                for (int n = 0; n < 2; ++n) {
                    const f32x4 a = acc[ai][0][m][n] * rs + ba[n];
                    acur[n] = a;
                    const f32x4 ap = aprev[n];
#pragma unroll
                    for (int e = 0; e < 4; ++e) {
                        const float t1 = (fr == 15) ? ap[e] : a[e];
                        const float t2 = (fr >= 14) ? ap[e] : a[e];
                        const float p1 = __shfl(t1, src1), p2 = __shfl(t2, src2);
                        val[n][e] = w2[n][e] * a[e] + w1[n][e] * p1 + w0[n][e] * p2 + bb[n][e];
                    }
                }
                const f32x4 u0 = acc[ai][1][m][0] * rs + bu[0], u1 = acc[ai][1][m][1] * rs + bu[1];
                f32x4 g0, g1;
#pragma unroll
                for (int e = 0; e < 4; ++e) { g0[e] = siluf_(val[0][e]) * u0[e]; g1[e] = siluf_(val[1][e]) * u1[e]; }
                u32x4 w; w.x = pk2(g0[0], g0[1]); w.y = pk2(g0[2], g0[3]); w.z = pk2(g1[0], g1[1]); w.w = pk2(g1[2], g1[3]);
                *(u32x4*)(G + (size_t)row * DFF_ + ch0) = w;
                if (m == 0 && fr < 2) {
                    const size_t ho = (size_t)(seg * 2 + fr) * DFF_ + ch0;
                    *(f32x4*)(HP + ho) = val[0]; *(f32x4*)(HP + ho + 4) = val[1];
                    *(f32x4*)(HU + ho) = u0; *(f32x4*)(HU + ho + 4) = u1;
                }
                if (m == 3 && fr >= 14) {
                    const size_t ho = (size_t)(seg * 2 + (fr - 14)) * DFF_ + ch0;
                    *(f32x4*)(HA + ho) = acur[0]; *(f32x4*)(HA + ho + 4) = acur[1];
                }
                aprev[0] = acur[0]; aprev[1] = acur[1];
                asm volatile("" ::: "memory");
            }
        }
    }
};
}

struct Ctx { Params p; unsigned char* lds; int tid, lane, wave, gw, ngw; };

__device__ __forceinline__ void phase_prologue(const Ctx& C) {
    const Params& p = C.p;
    float* cact = (float*)C.lds;
    float* red = (float*)(C.lds + 32768);
    float* mod = (float*)(p.ws + WS_MOD);
    const int tid = C.tid;
    for (int i = tid; i < 8192; i += NTHR) { const float c = p.c[i]; cact[i] = c / (1.f + __expf(-c)); }
    __syncthreads();
    const int col = tid & 63, kp = tid >> 6;
    for (int g = blockIdx.x; g < 384; g += gridDim.x) {
        const int l = g / 96, j = (g % 96) * 64 + col;
        const float* w = p.mod_w + (size_t)l * 1024 * 6144 + (size_t)(kp * 128) * 6144 + j;
        float a0 = 0.f, a1 = 0.f, a2 = 0.f, a3 = 0.f, a4 = 0.f, a5 = 0.f, a6 = 0.f, a7 = 0.f;
        const float* ca = cact + kp * 128;
#pragma unroll 8
        for (int k = 0; k < 128; ++k) {
            const float wv = w[(size_t)k * 6144];
            a0 += ca[k] * wv; a1 += ca[1024 + k] * wv; a2 += ca[2048 + k] * wv; a3 += ca[3072 + k] * wv;
            a4 += ca[4096 + k] * wv; a5 += ca[5120 + k] * wv; a6 += ca[6144 + k] * wv; a7 += ca[7168 + k] * wv;
        }
        float* r = red + (kp * 8) * 64 + col;
        r[0] = a0; r[64] = a1; r[128] = a2; r[192] = a3; r[256] = a4; r[320] = a5; r[384] = a6; r[448] = a7;
        __syncthreads();
        { const int b = tid >> 6; float s = 0.f;
#pragma unroll
          for (int kk = 0; kk < 8; ++kk) s += red[(kk * 8 + b) * 64 + col];
          mod[(size_t)(l * 8 + b) * 6144 + j] = s + p.mod_b[l * 6144 + j]; }
        __syncthreads();
    }
    {
        u32x4* zb = (u32x4*)(p.ws + WS_BIAS); const int nzb = 4 * BIAS_L * 4 / 16;
        for (int i = blockIdx.x * NTHR + tid; i < nzb; i += gridDim.x * NTHR) zb[i] = (u32x4){0u, 0u, 0u, 0u};
        u32x4* zr = (u32x4*)(p.ws + WS_ROWSS);
        for (int i = blockIdx.x * NTHR + tid; i < 8 * T_ * 4 / 16; i += gridDim.x * NTHR) zr[i] = (u32x4){0u, 0u, 0u, 0u};
    }
    float* cs = (float*)(p.ws + WS_COS); float* sn = (float*)(p.ws + WS_SIN);
    const float invf[8] = {1.0f, 0.1939227432012558f, 0.03760603070259094f, 0.007292664609849453f, 0.0014142135623842478f, 0.00027424818836152554f, 5.3182957344688475e-05f, 1.0313385246263351e-05f};
    for (int r = blockIdx.x * NTHR + tid; r < T_; r += gridDim.x * NTHR) {
        const float pos = (float)p.positions[r];
        f32x4 c4[2], s4[2];
#pragma unroll
        for (int i = 0; i < 8; ++i) {
            const float ang = pos * invf[i];
            const double xr = (double)ang * 0.15915494309189535;
            const float f = (float)(xr - rint(xr));
            c4[i >> 2][i & 3] = __builtin_amdgcn_cosf(f); s4[i >> 2][i & 3] = __builtin_amdgcn_sinf(f);
        }
        *(f32x4*)(cs + (size_t)r * 8) = c4[0]; *(f32x4*)(cs + (size_t)r * 8 + 4) = c4[1];
        *(f32x4*)(sn + (size_t)r * 8) = s4[0]; *(f32x4*)(sn + (size_t)r * 8 + 4) = s4[1];
    }
}

__device__ __forceinline__ void tr_item(const float* W, int Nsrc, int srccol0, bf16_t* WT, int K, int dstrow0, int k0, float* scr, int lane) {
    float wv[32];
#pragma unroll
    for (int i = 0; i < 32; ++i) wv[i] = W[(size_t)(k0 + 2 * i + (lane >> 5)) * Nsrc + srccol0 + (lane & 31)];
#pragma unroll
    for (int i = 0; i < 32; ++i) scr[(2 * i + (lane >> 5)) * 33 + (lane & 31)] = wv[i];
    asm volatile("s_waitcnt lgkmcnt(0)" ::: "memory");
    const int c = lane & 7;
#pragma unroll
    for (int j = 0; j < 4; ++j) { const int n = (lane >> 3) + 8 * j; const float* s = scr + (8 * c) * 33 + n;
        u32x4 o; o.x = pk2(s[0 * 33], s[1 * 33]); o.y = pk2(s[2 * 33], s[3 * 33]); o.z = pk2(s[4 * 33], s[5 * 33]); o.w = pk2(s[6 * 33], s[7 * 33]);
        *(u32x4*)(WT + (size_t)(dstrow0 + n) * K + k0 + 8 * c) = o; }
    asm volatile("s_waitcnt lgkmcnt(0)" ::: "memory");
}
__device__ __forceinline__ void phase_convert(const Ctx& C, int l, bool do_bias = true) {
    const Params& p = C.p; const int j = l >> 1; const bool even = !(l & 1);
    float* scr = (float*)(C.lds + C.wave * 8704);
    bf16_t* WIN = (bf16_t*)(p.ws + WS_WIN); bf16_t* WOUT = (bf16_t*)(p.ws + WS_WOUT); bf16_t* FIN = (bf16_t*)(p.ws + WS_FIN); bf16_t* FOUT = (bf16_t*)(p.ws + ((l & 1) ? WS_FOUT2 : WS_FOUT));
    const int nA = even ? 80 : 112;
    const int IA = 16 * nA, IB = 16 * 32, IC = 16 * 176, ID = 44 * 32;
    const float* win = even ? p.ev_w_in + (size_t)j * 1024 * 2320 : p.od_w_in + (size_t)j * 1024 * 3584;
    const float* wout = even ? p.ev_w_out + (size_t)j * 1024 * 1024 : p.od_w_out + (size_t)j * 1024 * 1024;
    const float* fin = p.ffn_w_in + (size_t)l * 1024 * 5632; const float* fout = p.ffn_w_out + (size_t)l * 2816 * 1024;
    for (int it = C.gw; it < IA + IB + IC + ID; it += C.ngw) {
        int r = it;
        if (r < IA) { const int kb = r / nA, nb = r % nA, n0 = nb * 32; int sc = n0;
            if (even) { if (n0 >= 512 && n0 < 768) continue; if (n0 >= 1792) sc = n0 - 240; else if (n0 >= 768) sc = n0 - 256; }
            tr_item(win, even ? 2320 : 3584, sc, WIN, 1024, n0, kb * 64, scr, C.lane); continue; }
        r -= IA;
        if (r < IB) { const int kb = r / 32, nb = r % 32; tr_item(wout, 1024, nb * 32, WOUT, 1024, nb * 32, kb * 64, scr, C.lane); continue; }
        r -= IB;
        if (r < IC) { const int kb = r / 176, nb = r % 176, n0 = nb * 32; const int pn = n0 >> 8, jj = n0 & 255;
            const int sc = (jj < 128) ? pn * 128 + jj : 2816 + pn * 128 + (jj - 128);
            tr_item(fin, 5632, sc, FIN, 1024, n0, kb * 64, scr, C.lane); continue; }
        r -= IC;
        { const int kb = r / 32, nb = r % 32; tr_item(fout, 1024, nb * 32, FOUT, 2816, nb * 32, kb * 64, scr, C.lane); }
    }
    if (do_bias) {
        float* shl = (float*)(C.lds + 69632);
        const float* modl = (const float*)(p.ws + WS_MOD) + (size_t)l * 8 * 6144;
        __syncthreads();
        for (int i2 = C.tid; i2 < 2 * 8192; i2 += NTHR) { const int which = i2 >> 13, k = (i2 >> 3) & 1023, b = i2 & 7; shl[i2] = modl[(size_t)b * 6144 + (which ? 3072 : 0) + k]; }
        __syncthreads();
        float* bias_in = (float*)(p.ws + WS_BIAS) + (size_t)l * BIAS_L; float* bias_ff = bias_in + 8 * 3584;
        const int Nin = even ? 2560 : 3584, Nsrc = even ? 2320 : 3584;
        const float* gwp = p.gla_gate_w + (size_t)j * 16 * 256;
        for (int u = blockIdx.x * NTHR + C.tid; u < (Nin + 5632) * 16; u += gridDim.x * NTHR) {
            const bool ff = u >= Nin * 16; const int uu = ff ? u - Nin * 16 : u, N = ff ? 5632 : Nin, n = uu % N, kp = uu / N;
            float a[8];
#pragma unroll
            for (int b = 0; b < 8; ++b) a[b] = 0.f;
            const float* shp = shl + (ff ? 8192 : 0) + kp * 64 * 8;
            if (!ff && even && n >= 512 && n < 768) {
                float g[16];
#pragma unroll
                for (int r = 0; r < 16; ++r) g[r] = gwp[r * 256 + (n - 512)];
                for (int k = 0; k < 64; ++k) {
                    const float* wr = win + (size_t)(kp * 64 + k) * 2320 + 1536;
                    float wv = 0.f;
#pragma unroll
                    for (int r = 0; r < 16; ++r) wv += wr[r] * g[r];
                    const f32x4 s0 = *(const f32x4*)(shp + k * 8), s1 = *(const f32x4*)(shp + k * 8 + 4);
                    a[0] += s0[0] * wv; a[1] += s0[1] * wv; a[2] += s0[2] * wv; a[3] += s0[3] * wv; a[4] += s1[0] * wv; a[5] += s1[1] * wv; a[6] += s1[2] * wv; a[7] += s1[3] * wv;
                }
            } else {
                int sc; const float* W; int Ns;
                if (ff) { const int pn = n >> 8, jj = n & 255; sc = (jj < 128) ? pn * 128 + jj : 2816 + pn * 128 + (jj - 128); W = fin; Ns = 5632; }
                else { sc = n; if (even) { if (n >= 1792) sc = n - 240; else if (n >= 768) sc = n - 256; } W = win; Ns = Nsrc; }
                const float* wp = W + (size_t)(kp * 64) * Ns + sc;
#pragma unroll 8
                for (int k = 0; k < 64; ++k) {
                    const float wv = wp[(size_t)k * Ns];
                    const f32x4 s0 = *(const f32x4*)(shp + k * 8), s1 = *(const f32x4*)(shp + k * 8 + 4);
                    a[0] += s0[0] * wv; a[1] += s0[1] * wv; a[2] += s0[2] * wv; a[3] += s0[3] * wv; a[4] += s1[0] * wv; a[5] += s1[1] * wv; a[6] += s1[2] * wv; a[7] += s1[3] * wv;
                }
            }
            float* bo = (ff ? bias_ff : bias_in) + n;
#pragma unroll
            for (int b = 0; b < 8; ++b) atomicAdd(bo + (size_t)b * N, a[b]);
        }
    }
    if (even) {
        const float* gw = p.gla_gate_w + (size_t)j * 16 * 256;
        for (int u = blockIdx.x * NTHR + C.tid; u < 256 * 128; u += gridDim.x * NTHR) {
            const int k8 = u & 127, n = u >> 7;
            float g[16];
#pragma unroll
            for (int r = 0; r < 16; ++r) g[r] = gw[r * 256 + n];
            float o[8];
#pragma unroll
            for (int e = 0; e < 8; ++e) {
                const float* wr = win + (size_t)(k8 * 8 + e) * 2320 + 1536;
                const f32x4 a0 = *(const f32x4*)wr, a1 = *(const f32x4*)(wr + 4), a2 = *(const f32x4*)(wr + 8), a3 = *(const f32x4*)(wr + 12);
                o[e] = a0[0] * g[0] + a0[1] * g[1] + a0[2] * g[2] + a0[3] * g[3] + a1[0] * g[4] + a1[1] * g[5] + a1[2] * g[6] + a1[3] * g[7]
                     + a2[0] * g[8] + a2[1] * g[9] + a2[2] * g[10] + a2[3] * g[11] + a3[0] * g[12] + a3[1] * g[13] + a3[2] * g[14] + a3[3] * g[15];
            }
            u32x4 w; w.x = pk2(o[0], o[1]); w.y = pk2(o[2], o[3]); w.z = pk2(o[4], o[5]); w.w = pk2(o[6], o[7]);
            *(u32x4*)(WIN + (size_t)(512 + n) * 1024 + k8 * 8) = w;
        }
    }
}

__device__ __forceinline__ void phase_prep(const Ctx& C, const float* xin, const float* w, const float* modl, int scoff, bf16_t* out, float* rowss) {
    for (int row = C.gw; row < T_; row += C.ngw) {
        const f32x4* xr = (const f32x4*)(xin + (size_t)row * 1024) + C.lane;
        f32x4 v[4]; float ss = 0.f;
#pragma unroll
        for (int j = 0; j < 4; ++j) { v[j] = xr[64 * j]; ss += (v[j].x * v[j].x + v[j].y * v[j].y) + (v[j].z * v[j].z + v[j].w * v[j].w); }
        ss = wave_sum(ss);
        if (C.lane == 0) rowss[row] = ss;
        const float* mb = modl + (size_t)(row >> 12) * 6144;
        u32x2* o8 = (u32x2*)(out + (size_t)row * 1024) + C.lane;
#pragma unroll
        for (int j = 0; j < 4; ++j) {
            const int col = 4 * C.lane + 256 * j;
            const f32x4 w4 = *(const f32x4*)(w + col), sc = *(const f32x4*)(mb + scoff + col);
            const f32x4 y = v[j] * w4 * (sc + 1.f);
            u32x2 q; q.x = pk2(y.x, y.y); q.y = pk2(y.z, y.w); o8[64 * j] = q;
        }
    }
}
__device__ __forceinline__ void phase_final_norm(const Ctx& C, const void* xin  , float* out, const float* w) {
    for (int row = C.gw; row < T_; row += C.ngw) {
        const u32x2* xr = (const u32x2*)((const char*)xin + (size_t)row * 2048) + C.lane;
        f32x4* orow = (f32x4*)(out + (size_t)row * 1024) + C.lane;
        f32x4 v[4]; float ss = 0.f;
#pragma unroll
        for (int j = 0; j < 4; ++j) { const u32x2 h = xr[64 * j]; v[j] = pg8::unpkh4(h.x, h.y); ss += (v[j].x * v[j].x + v[j].y * v[j].y) + (v[j].z * v[j].z + v[j].w * v[j].w); }
        const float rs = rsqrtf(wave_sum(ss) * (1.f / 1024.f) + 1e-6f);
#pragma unroll
        for (int j = 0; j < 4; ++j) { const f32x4 w4 = *(const f32x4*)(w + 4 * C.lane + 256 * j); orow[64 * j] = (v[j] * rs) * w4; }
    }
}

__device__ __forceinline__ void phase_diff_combine(const Ctx& C, int l) {
    const Params& p = C.p; const int j = l >> 1;
    const float lam_init = 0.8f - 0.6f * expf(-0.3f * (float)l);
    const float* lv = p.diff_lambda + j * 256;
    const float s1 = wave_sum(lv[C.lane] * lv[64 + C.lane]), s2 = wave_sum(lv[128 + C.lane] * lv[192 + C.lane]);
    const float lam = expf(s1) - expf(s2) + lam_init;
    const bf16_t* X2 = (const bf16_t*)(p.ws + WS_X2); bf16_t* A = (bf16_t*)(p.ws + WS_A);
    const int head = C.lane >> 4, d0 = (C.lane & 15) * 8;
    const float* nw = p.diff_norm_w + j * 128 + d0;
    const f32x4 n0 = *(const f32x4*)nw, n1 = *(const f32x4*)(nw + 4);
    const float og = 1.f - lam_init;
    for (int row = C.gw; row < T_; row += C.ngw) {
        const bf16_t* src = X2 + (size_t)row * 1024 + head * 256 + d0;
        const u32x4 a = *(const u32x4*)src, b = *(const u32x4*)(src + 128);
        float od[8];
        od[0] = bflo(a.x) - lam * bflo(b.x); od[1] = bfhi(a.x) - lam * bfhi(b.x); od[2] = bflo(a.y) - lam * bflo(b.y); od[3] = bfhi(a.y) - lam * bfhi(b.y);
        od[4] = bflo(a.z) - lam * bflo(b.z); od[5] = bfhi(a.z) - lam * bfhi(b.z); od[6] = bflo(a.w) - lam * bflo(b.w); od[7] = bfhi(a.w) - lam * bfhi(b.w);
        float ss = 0.f;
#pragma unroll
        for (int e = 0; e < 8; ++e) ss += od[e] * od[e];
        ss += __shfl_xor(ss, 1); ss += __shfl_xor(ss, 2); ss += __shfl_xor(ss, 4); ss += __shfl_xor(ss, 8);
        const float rs = rsqrtf(ss * (1.f / 128.f) + 1e-6f) * og;
        u32x4 w; w.x = pk2(od[0] * rs * n0[0], od[1] * rs * n0[1]); w.y = pk2(od[2] * rs * n0[2], od[3] * rs * n0[3]);
        w.z = pk2(od[4] * rs * n1[0], od[5] * rs * n1[1]); w.w = pk2(od[6] * rs * n1[2], od[7] * rs * n1[3]);
        *(u32x4*)(A + (size_t)row * 1024 + head * 128 + d0) = w;
    }
}

__device__ __forceinline__ void phase_ffn_fixup(const Ctx& C, int l) {
    const Params& p = C.p;
    const float* HP = (const float*)(p.ws + WS_HP); const float* HU = (const float*)(p.ws + WS_HU); const float* HA = (const float*)(p.ws + WS_HA);
    bf16_t* G = (bf16_t*)(p.ws + WS_R1);
    const float* cw = p.ffn_conv_w + (size_t)l * 3 * DFF_;
    for (int u = blockIdx.x * NTHR + C.tid; u < 512 * 2 * 704; u += gridDim.x * NTHR) {
        const int c4 = u % 704, sj = u / 704, jj = sj & 1, seg = sj >> 1, ch = c4 * 4;
        const size_t ho = (size_t)sj * DFF_ + ch;
        f32x4 val = *(const f32x4*)(HP + ho); const f32x4 uu = *(const f32x4*)(HU + ho);
        if ((seg & 63) != 0) {
            const f32x4 am1 = *(const f32x4*)(HA + (size_t)((seg - 1) * 2 + 1) * DFF_ + ch), am2 = *(const f32x4*)(HA + (size_t)((seg - 1) * 2) * DFF_ + ch);
            const f32x4 w0 = *(const f32x4*)(cw + ch), w1 = *(const f32x4*)(cw + DFF_ + ch);
            if (jj == 0) val = val + w1 * am1 + w0 * am2; else val = val + w0 * am1;
        }
        u32x2 q; q.x = pk2(siluf_(val.x) * uu.x, siluf_(val.y) * uu.y); q.y = pk2(siluf_(val.z) * uu.z, siluf_(val.w) * uu.w);
        *(u32x2*)(G + (size_t)(seg * 64 + jj) * DFF_ + ch) = q;
    }
}

__device__ __forceinline__ void phase_swa(const Ctx& C, int l) {
    const Params& p = C.p;
    const bf16_t* proj = (const bf16_t*)(p.ws + WS_R1); bf16_t* A = (bf16_t*)(p.ws + WS_A);
    bf16_t* Ks = (bf16_t*)C.lds;
    bf16_t* Vt = (bf16_t*)(C.lds + 27648);
    const int tid = C.tid, lane = C.lane, wid = C.wave, r32 = lane & 31, hi = lane >> 5;
    const float* sinks = p.swa_sinks + (l >> 1) * 8;
    u32x4 kreg[3], vreg[3];
#define SWA_FETCH(uu) do { const int b_ = (uu) >> 7, kvh_ = ((uu) >> 6) & 1, q0_ = ((uu) & 63) * 64; const size_t rb_ = (size_t)b_ * SEQ_; \
        _Pragma("unroll") for (int i_ = 0; i_ < 3; ++i_) { const int c_ = tid + i_ * NTHR; \
            { const int kk_ = c_ >> 3, ch_ = c_ & 7, pl_ = q0_ - 128 + kk_; kreg[i_] = (u32x4){0u, 0u, 0u, 0u}; if (pl_ >= 0) kreg[i_] = *(const u32x4*)(proj + (rb_ + pl_) * 2560 + 2304 + kvh_ * 64 + ch_ * 8); } \
            { const int kk_ = c_ % 192, ch_ = c_ / 192, pl_ = q0_ - 128 + kk_; vreg[i_] = (u32x4){0u, 0u, 0u, 0u}; if (pl_ >= 0) vreg[i_] = *(const u32x4*)(proj + (rb_ + pl_) * 2560 + 2432 + kvh_ * 64 + ch_ * 8); } } } while (0)
    if ((int)blockIdx.x < 1024) SWA_FETCH((int)blockIdx.x);
    for (int u = blockIdx.x; u < 1024; u += gridDim.x) {
        const int b = u >> 7, kvh = (u >> 6) & 1, qb = u & 63, q0 = qb * 64; const size_t rowbase = (size_t)b * SEQ_;
#pragma unroll
        for (int i = 0; i < 3; ++i) {
            const int c = tid + i * NTHR;
            { const int kk = c >> 3, ch = c & 7; *(u32x4*)(Ks + kk * 72 + ch * 8) = kreg[i]; }
            { const int kk = c % 192, ch = c / 192; const u32x4 vv = vreg[i];
              bf16_t* vd = Vt + (ch * 8) * 200 + kk;
              vd[0] = (bf16_t)(vv.x & 0xffffu); vd[200] = (bf16_t)(vv.x >> 16); vd[400] = (bf16_t)(vv.y & 0xffffu); vd[600] = (bf16_t)(vv.y >> 16);
              vd[800] = (bf16_t)(vv.z & 0xffffu); vd[1000] = (bf16_t)(vv.z >> 16); vd[1200] = (bf16_t)(vv.w & 0xffffu); vd[1400] = (bf16_t)(vv.w >> 16); }
        }
        { const int nx = u + (int)gridDim.x; if (nx < 1024) SWA_FETCH(nx); }
        __syncthreads();
        const int g = wid >> 1, qh = kvh * 4 + g, qhalf = wid & 1, pq = q0 + 32 * qhalf + r32;
        const bf16_t* qsrc = proj + (rowbase + pq) * 2560 + 1792 + qh * 64;
        bf16x8 qr[4];
#pragma unroll
        for (int d0 = 0; d0 < 4; ++d0) qr[d0] = *(const bf16x8*)(qsrc + d0 * 16 + hi * 8);
        f32x16 s[5];
#pragma unroll
        for (int t = 0; t < 5; ++t) {
            f32x16 a = {};
#pragma unroll
            for (int d0 = 0; d0 < 4; ++d0) {
                const bf16x8 kf = *(const bf16x8*)(Ks + (32 * (qhalf + t) + r32) * 72 + d0 * 16 + hi * 8);
                a = __builtin_amdgcn_mfma_f32_32x32x16_bf16(kf, qr[d0], a, 0, 0, 0);
            }
            s[t] = a;
        }
        const float sink2 = sinks[qh] * LOG2E_;
        float mx = sink2;
#pragma unroll
        for (int t = 0; t < 5; ++t)
#pragma unroll
            for (int r = 0; r < 16; ++r) {
                const int pk = q0 - 128 + 32 * (qhalf + t) + crow_(r, hi);
                const bool valid = (pk >= 0) && (pk <= pq) && (pq - pk < 128);
                const float v = valid ? s[t][r] : -INFINITY; s[t][r] = v; mx = fmaxf(mx, v);
            }
        mx = fmaxf(mx, __shfl_xor(mx, 32));
        float sum = 0.f;
#pragma unroll
        for (int t = 0; t < 5; ++t)
#pragma unroll
            for (int r = 0; r < 16; ++r) { const float e = __builtin_amdgcn_exp2f(s[t][r] - mx); s[t][r] = e; sum += e; }
        sum += __shfl_xor(sum, 32);
        sum += __builtin_amdgcn_exp2f(sink2 - mx);
        const float inv = 1.f / sum;
        f32x16 o[2]; o[0] = f32x16{}; o[1] = f32x16{};
#pragma unroll
        for (int t = 0; t < 5; ++t)
#pragma unroll
            for (int ss = 0; ss < 2; ++ss) {
                u32x4 pw; pw.x = pk2(s[t][8 * ss + 0], s[t][8 * ss + 1]); pw.y = pk2(s[t][8 * ss + 2], s[t][8 * ss + 3]); pw.z = pk2(s[t][8 * ss + 4], s[t][8 * ss + 5]); pw.w = pk2(s[t][8 * ss + 6], s[t][8 * ss + 7]);
                const bf16x8 pf = __builtin_bit_cast(bf16x8, pw);
#pragma unroll
                for (int dt = 0; dt < 2; ++dt) {
                    const bf16_t* vp = Vt + (32 * dt + r32) * 200 + 32 * (qhalf + t) + 16 * ss + 4 * hi;
                    const u32x2 lo = *(const u32x2*)vp, h2 = *(const u32x2*)(vp + 8);
                    u32x4 vw; vw.x = lo.x; vw.y = lo.y; vw.z = h2.x; vw.w = h2.y;
                    o[dt] = __builtin_amdgcn_mfma_f32_32x32x16_bf16(__builtin_bit_cast(bf16x8, vw), pf, o[dt], 0, 0, 0);
                }
            }
        bf16_t* orow = A + (rowbase + pq) * 1024 + 512 + qh * 64;
#pragma unroll
        for (int dt = 0; dt < 2; ++dt)
#pragma unroll
            for (int g4 = 0; g4 < 4; ++g4) {
                u32x2 q; q.x = pk2(o[dt][4 * g4] * inv, o[dt][4 * g4 + 1] * inv); q.y = pk2(o[dt][4 * g4 + 2] * inv, o[dt][4 * g4 + 3] * inv);
                *(u32x2*)(orow + 32 * dt + 8 * g4 + 4 * hi) = q;
            }
        __syncthreads();
    }
}

template <int MODE> struct LaCfg {
    static constexpr int DK = MODE ? 128 : 64, LQ = DK + 8, LG = DK + 4, PITCH = MODE ? 3584 : 2560, NG = DK / 8;
    static constexpr int QCOL = MODE ? 1536 : 0, KCOL = MODE ? 0 : 256, ZCOL = MODE ? 2048 : 512, VCOL = MODE ? 2560 : 768, GCOL = MODE ? 3072 : 1280, OCOL = MODE ? 512 : 0;
    static constexpr int O_QB = 0, O_KB = O_QB + 64 * LQ * 2, O_GF = O_KB + 64 * LQ * 2, O_VT = O_GF + 64 * LG * 4, O_SC = O_VT + 128 * 72 * 2, O_QE = O_SC + 64 * 72 * 2,
                         O_KT = O_QE + 64 * LQ * 2  , O_SEG = O_KT + DK * 72 * 2, O_RED = O_SEG + 8 * 128 * 4, O_PAR = O_RED + 8 * 64 * 4, O_END = O_PAR + 128 * 4;
    static_assert(O_END <= LDS_BYTES, "LA LDS map");
};
__device__ __forceinline__ void unpack8(const u32x4 w, float (&f)[8]) { f[0] = bflo(w.x); f[1] = bfhi(w.x); f[2] = bflo(w.y); f[3] = bfhi(w.y); f[4] = bflo(w.z); f[5] = bfhi(w.z); f[6] = bflo(w.w); f[7] = bfhi(w.w); }
__device__ __forceinline__ u32x4 pack8(const float (&f)[8]) { u32x4 w; w.x = pk2(f[0], f[1]); w.y = pk2(f[2], f[3]); w.z = pk2(f[4], f[5]); w.w = pk2(f[6], f[7]); return w; }
__device__ __forceinline__ void ld8f(const float* p, float (&f)[8]) { const f32x4 a = *(const f32x4*)p, b = *(const f32x4*)(p + 4); f[0] = a[0]; f[1] = a[1]; f[2] = a[2]; f[3] = a[3]; f[4] = b[0]; f[5] = b[1]; f[6] = b[2]; f[7] = b[3]; }

template <int MODE> struct LaRaw { static constexpr int NI = 64 * LaCfg<MODE>::NG / NTHR; u32x4 z[NI], k[NI], q[NI], v[2]; };
template <int MODE, bool NEEDQ> __device__ __forceinline__ void la_fetch(const Ctx& C, int b, int h, int c, LaRaw<MODE>& R) {
    typedef LaCfg<MODE> Cf; const bf16_t* proj = (const bf16_t*)(C.p.ws + WS_R1);
    const size_t row0 = (size_t)b * SEQ_ + (size_t)c * 64;
#pragma unroll
    for (int it = 0; it < LaRaw<MODE>::NI; ++it) {
        const int u = C.tid + it * NTHR, r = u / Cf::NG, kk = (u % Cf::NG) * 8;
        const bf16_t* rp = proj + (row0 + r) * Cf::PITCH + h * Cf::DK + kk;
        R.z[it] = *(const u32x4*)(rp + Cf::ZCOL);
        if (MODE == 0) R.k[it] = *(const u32x4*)(rp + Cf::KCOL);
        if (NEEDQ) R.q[it] = *(const u32x4*)(rp + Cf::QCOL);
    }
#pragma unroll
    for (int it = 0; it < 2; ++it) {
        const int u = C.tid + it * NTHR, r = u & 63, g8 = u >> 6;
        R.v[it] = *(const u32x4*)(proj + (row0 + r) * Cf::PITCH + Cf::VCOL + h * 128 + g8 * 8);
    }
}
template <int MODE, bool NEEDQ> __device__ __forceinline__ void la_store(const Ctx& C, const LaRaw<MODE>& R, const float* par, bf16_t* Qb, bf16_t* Kb, float* Gf, bf16_t* Vt) {
    typedef LaCfg<MODE> Cf;
#pragma unroll
    for (int it = 0; it < LaRaw<MODE>::NI; ++it) {
        const int u = C.tid + it * NTHR, r = u / Cf::NG, kk = (u % Cf::NG) * 8;
        float z[8], kv[8], lg[8], pc[8];
        unpack8(R.z[it], z); ld8f(par + kk, pc);
        if (MODE == 0) {
            unpack8(R.k[it], kv);
#pragma unroll
            for (int e = 0; e < 8; ++e) { const float x = z[e] + pc[e]; lg[e] = (fminf(x, 0.f) * LOG2E_ - __log2f(1.f + __expf(-fabsf(x)))) * (1.f / 16.f); }
        } else {
#pragma unroll
            for (int e = 0; e < 8; ++e) {
                const float zz = fminf(fmaxf(z[e], -60.f), 60.f), ez = __expf(-zz), sg = __builtin_amdgcn_rcpf(1.f + ez), lb = pc[e];
                lg[e] = __log2f(lb + (1.f - lb) * sg); kv[e] = (1.f - lb) * (ez * sg);
            }
        }
        *(u32x4*)(Kb + r * Cf::LQ + kk) = pack8(kv);
        float* gd = Gf + r * Cf::LG + kk;
        *(f32x4*)gd = (f32x4){lg[0], lg[1], lg[2], lg[3]}; *(f32x4*)(gd + 4) = (f32x4){lg[4], lg[5], lg[6], lg[7]};
        if (NEEDQ) {
            float q[8]; unpack8(R.q[it], q);
#pragma unroll
            for (int e = 0; e < 8; ++e) q[e] = MODE ? siluf_(q[e]) * 0.08838834764831845f : q[e] * 0.125f;
            *(u32x4*)(Qb + r * Cf::LQ + kk) = pack8(q);
        }
    }
#pragma unroll
    for (int it = 0; it < 2; ++it) {
        const int u = C.tid + it * NTHR, r = u & 63, g8 = u >> 6;
        const u32x4 w = R.v[it];
        bf16_t* vd = Vt + (g8 * 8) * 72 + r;
        vd[0] = (bf16_t)(w.x & 0xffffu); vd[72] = (bf16_t)(w.x >> 16); vd[144] = (bf16_t)(w.y & 0xffffu); vd[216] = (bf16_t)(w.y >> 16);
        vd[288] = (bf16_t)(w.z & 0xffffu); vd[360] = (bf16_t)(w.z >> 16); vd[432] = (bf16_t)(w.w & 0xffffu); vd[504] = (bf16_t)(w.w >> 16);
    }
}
template <int MODE> __device__ __forceinline__ void la_params(const Ctx& C, int l, int h, float* par) {
    typedef LaCfg<MODE> Cf; const int j = l >> 1;
    if (C.tid < Cf::DK) {
        if (MODE == 0) par[C.tid] = C.p.gla_gate_b[j * 256 + h * 64 + C.tid];
        else { const float* lg0 = C.p.hgrn_lb_logits + h * 128 + C.tid; par[C.tid] = (j == 0) ? 0.f : sigmoidf_(lg0[512] - lg0[0]); }
    }
}
template <int MODE> __device__ __forceinline__ void la_cumsum(const Ctx& C, float* Gf, float* segs) {
    typedef LaCfg<MODE> Cf; constexpr int DK = Cf::DK, NSEG = NTHR / DK, RPS = 64 / NSEG;
    const int k = C.tid % DK, seg = C.tid / DK;
    float v[RPS];
#pragma unroll
    for (int i = 0; i < RPS; ++i) v[i] = Gf[(seg * RPS + i) * Cf::LG + k];
#pragma unroll
    for (int i = 1; i < RPS; ++i) v[i] += v[i - 1];
    segs[seg * DK + k] = v[RPS - 1];
    __syncthreads();
    float off = 0.f;
#pragma unroll
    for (int s = 0; s < NSEG; ++s) { const float t = segs[s * DK + k]; off += (s < seg) ? t : 0.f; }
#pragma unroll
    for (int i = 0; i < RPS; ++i) Gf[(seg * RPS + i) * Cf::LG + k] = v[i] + off;
}

template <int MODE> __device__ __forceinline__ void phase_la_p1(const Ctx& C, int l) {
    typedef LaCfg<MODE> Cf; const Params& p = C.p; constexpr int DK = Cf::DK, LQ = Cf::LQ, LG = Cf::LG, NG = Cf::NG;
    bf16_t* Kb = (bf16_t*)(C.lds + Cf::O_KB); float* Gf = (float*)(C.lds + Cf::O_GF); bf16_t* Vt = (bf16_t*)(C.lds + Cf::O_VT);
    bf16_t* KhT = (bf16_t*)(C.lds + Cf::O_KT); float* segs = (float*)(C.lds + Cf::O_SEG);
    bf16_t* ST = (bf16_t*)(p.ws + WS_ST); float* TOT = (float*)(p.ws + WS_TOT);
    const int r16 = C.lane & 15, g = C.lane >> 4, w = C.wave;
    float* par = (float*)(C.lds + Cf::O_PAR);
    LaRaw<MODE> R; int hcur = -1;
    if ((int)blockIdx.x < 2048) la_fetch<MODE, false>(C, (int)blockIdx.x >> 8, ((int)blockIdx.x >> 6) & 3, (int)blockIdx.x & 63, R);
    for (int it = blockIdx.x; it < 2048; it += gridDim.x) {
        const int bh = it >> 6, c = it & 63, b = bh >> 2, h = bh & 3;
        if (h != hcur) { la_params<MODE>(C, l, h, par); hcur = h; __syncthreads(); }
        la_store<MODE, false>(C, R, par, nullptr, Kb, Gf, Vt);
        { const int nx = it + (int)gridDim.x; if (nx < 2048) la_fetch<MODE, false>(C, nx >> 8, (nx >> 6) & 3, nx & 63, R); }
        __syncthreads();
        la_cumsum<MODE>(C, Gf, segs);
        __syncthreads();
        for (int u = C.tid; u < 64 * NG; u += NTHR) {
            const int r = u & 63, kk = (u >> 6) * 8;
            float kv[8], gj[8], gt[8];
            unpack8(*(const u32x4*)(Kb + r * LQ + kk), kv); ld8f(Gf + r * LG + kk, gj); ld8f(Gf + 63 * LG + kk, gt);
            bf16_t* kd = KhT + kk * 72 + r;
#pragma unroll
            for (int e = 0; e < 8; e += 2) { const unsigned pw = pk2(kv[e] * __builtin_amdgcn_exp2f(gt[e] - gj[e]), kv[e + 1] * __builtin_amdgcn_exp2f(gt[e + 1] - gj[e + 1]));
                kd[e * 72] = (bf16_t)(pw & 0xffffu); kd[(e + 1) * 72] = (bf16_t)(pw >> 16); }
        }
        if (C.tid < DK) TOT[(size_t)it * 128 + C.tid] = Gf[63 * LG + C.tid];
        __syncthreads();
        {
            const bf16x8 b0 = *(const bf16x8*)(Vt + (16 * w + r16) * 72 + 8 * g), b1 = *(const bf16x8*)(Vt + (16 * w + r16) * 72 + 32 + 8 * g);
            bf16_t* so = ST + (size_t)it * DK * 128 + (size_t)(16 * w + r16) * DK + 4 * g;
#pragma unroll
            for (int mt = 0; mt < DK / 16; ++mt) {
                const bf16x8 a0 = *(const bf16x8*)(KhT + (16 * mt + r16) * 72 + 8 * g), a1 = *(const bf16x8*)(KhT + (16 * mt + r16) * 72 + 32 + 8 * g);
                f32x4 acc = (f32x4){0.f, 0.f, 0.f, 0.f};
                acc = __builtin_amdgcn_mfma_f32_16x16x32_bf16(a0, b0, acc, 0, 0, 0);
                acc = __builtin_amdgcn_mfma_f32_16x16x32_bf16(a1, b1, acc, 0, 0, 0);
                u32x2 q; q.x = pk2(acc[0], acc[1]); q.y = pk2(acc[2], acc[3]);
                *(u32x2*)(so + 16 * mt) = q;
            }
        }
        __syncthreads();
    }
}

template <int MODE> __device__ __forceinline__ void phase_la_p2(const Ctx& C) {
    typedef LaCfg<MODE> Cf; const Params& p = C.p; constexpr int DK = Cf::DK, NQ = DK / 4;
    bf16_t* ST = (bf16_t*)(p.ws + WS_ST); const float* TOT = (const float*)(p.ws + WS_TOT);
    for (int u = blockIdx.x * NTHR + C.tid; u < 32 * 128 * NQ; u += gridDim.x * NTHR) {
        const int k4 = u % NQ, v = (u / NQ) & 127, bh = u / (NQ * 128);
        float S0 = 0.f, S1 = 0.f, S2 = 0.f, S3 = 0.f;
        bf16_t* base = ST + (size_t)bh * 64 * DK * 128 + (size_t)v * DK + k4 * 4;
        const float* tb = TOT + (size_t)bh * 64 * 128 + k4 * 4;
#pragma unroll 8
        for (int c = 0; c < 64; ++c) {
            u32x2* ptr = (u32x2*)(base + (size_t)c * DK * 128);
            const u32x2 w = *ptr; const f32x4 dc = *(const f32x4*)(tb + c * 128);
            u32x2 o; o.x = pk2(S0, S1); o.y = pk2(S2, S3);
            *ptr = o;
            S0 = S0 * __builtin_amdgcn_exp2f(dc[0]) + bflo(w.x); S1 = S1 * __builtin_amdgcn_exp2f(dc[1]) + bfhi(w.x);
            S2 = S2 * __builtin_amdgcn_exp2f(dc[2]) + bflo(w.y); S3 = S3 * __builtin_amdgcn_exp2f(dc[3]) + bfhi(w.y);
        }
    }
}

template <int MODE> __device__ __forceinline__ void phase_la_p3(const Ctx& C, int l) {
    typedef LaCfg<MODE> Cf; const Params& p = C.p; constexpr int DK = Cf::DK, LQ = Cf::LQ, LG = Cf::LG, NG = Cf::NG, NKS = DK / 32;
    bf16_t* Qb = (bf16_t*)(C.lds + Cf::O_QB); bf16_t* Kb = (bf16_t*)(C.lds + Cf::O_KB); float* Gf = (float*)(C.lds + Cf::O_GF); bf16_t* Vt = (bf16_t*)(C.lds + Cf::O_VT);
    bf16_t* Sc = (bf16_t*)(C.lds + Cf::O_SC); bf16_t* Qe = (bf16_t*)(C.lds + Cf::O_QE); float* segs = (float*)(C.lds + Cf::O_SEG); float* red = (float*)(C.lds + Cf::O_RED);
    const bf16_t* ST = (const bf16_t*)(p.ws + WS_ST); const bf16_t* proj = (const bf16_t*)(p.ws + WS_R1); bf16_t* A = (bf16_t*)(p.ws + WS_A);
    const float* nw = (MODE ? p.hgrn_norm_w : p.gla_norm_w) + (l >> 1) * 128;
    const int r16 = C.lane & 15, g = C.lane >> 4, w = C.wave;
    const f32x4 nw4 = *(const f32x4*)(nw + 16 * w + 4 * g);
    float* par = (float*)(C.lds + Cf::O_PAR);
    LaRaw<MODE> R; int hcur = -1;
    if ((int)blockIdx.x < 2048) la_fetch<MODE, true>(C, (int)blockIdx.x >> 8, ((int)blockIdx.x >> 6) & 3, (int)blockIdx.x & 63, R);
    for (int it = blockIdx.x; it < 2048; it += gridDim.x) {
        const int bh = it >> 6, c = it & 63, b = bh >> 2, h = bh & 3;
        bf16x8 sfr[NKS];
        { const bf16_t* sp = ST + (size_t)it * DK * 128 + (size_t)(16 * w + r16) * DK + 8 * g;
#pragma unroll
          for (int ks = 0; ks < NKS; ++ks) sfr[ks] = *(const bf16x8*)(sp + 32 * ks); }
        if (h != hcur) { la_params<MODE>(C, l, h, par); hcur = h; __syncthreads(); }
        la_store<MODE, true>(C, R, par, Qb, Kb, Gf, Vt);
        { const int nx = it + (int)gridDim.x; if (nx < 2048) la_fetch<MODE, true>(C, nx >> 8, (nx >> 6) & 3, nx & 63, R); }
        for (int u = C.tid; u < 64 * 72 / 8; u += NTHR) *(u32x4*)(Sc + u * 8) = (u32x4){0u, 0u, 0u, 0u};
        u32x2 gwv[4];
#pragma unroll
        for (int nt = 0; nt < 4; ++nt) gwv[nt] = *(const u32x2*)(proj + ((size_t)b * SEQ_ + (size_t)c * 64 + 16 * nt + r16) * Cf::PITCH + Cf::GCOL + h * 128 + 16 * w + 4 * g);
        __syncthreads();
        la_cumsum<MODE>(C, Gf, segs);
        __syncthreads();
        for (int t = w; t < 10; t += 8) {
            const int I = (t >= 6) ? 3 : (t >= 3) ? 2 : (t >= 1) ? 1 : 0, J = t - I * (I + 1) / 2;
            f32x4 acc = (f32x4){0.f, 0.f, 0.f, 0.f};
#pragma unroll
            for (int ks = 0; ks < NKS; ++ks) {
                const int kc = 32 * ks + 8 * g;
                float gref[8], gj[8], gi[8], kv[8], qv[8];
                ld8f(Gf + (16 * J + 15) * LG + kc, gref); ld8f(Gf + (16 * J + r16) * LG + kc, gj); ld8f(Gf + (16 * I + r16) * LG + kc, gi);
                unpack8(*(const u32x4*)(Kb + (16 * J + r16) * LQ + kc), kv); unpack8(*(const u32x4*)(Qb + (16 * I + r16) * LQ + kc), qv);
#pragma unroll
                for (int e = 0; e < 8; ++e) { kv[e] *= __builtin_amdgcn_exp2f(gref[e] - gj[e]); qv[e] *= __builtin_amdgcn_exp2f(gi[e] - gref[e]); }
                acc = __builtin_amdgcn_mfma_f32_16x16x32_bf16(__builtin_bit_cast(bf16x8, pack8(kv)), __builtin_bit_cast(bf16x8, pack8(qv)), acc, 0, 0, 0);
            }
            if (I == J) {
#pragma unroll
                for (int e = 0; e < 4; ++e) if (4 * g + e > r16) acc[e] = 0.f;
            }
            u32x2 q; q.x = pk2(acc[0], acc[1]); q.y = pk2(acc[2], acc[3]);
            *(u32x2*)(Sc + (16 * I + r16) * 72 + 16 * J + 4 * g) = q;
        }
        for (int u = C.tid; u < 64 * NG; u += NTHR) {
            const int r = u / NG, kk = (u % NG) * 8;
            float qv[8], gi[8]; unpack8(*(const u32x4*)(Qb + r * LQ + kk), qv); ld8f(Gf + r * LG + kk, gi);
#pragma unroll
            for (int e = 0; e < 8; ++e) qv[e] *= __builtin_amdgcn_exp2f(gi[e]);
            *(u32x4*)(Qe + r * LQ + kk) = pack8(qv);
        }
        __syncthreads();
        f32x4 o[4];
        {
            const bf16x8 v0 = *(const bf16x8*)(Vt + (16 * w + r16) * 72 + 8 * g), v1 = *(const bf16x8*)(Vt + (16 * w + r16) * 72 + 32 + 8 * g);
#pragma unroll
            for (int nt = 0; nt < 4; ++nt) {
                f32x4 acc = (f32x4){0.f, 0.f, 0.f, 0.f};
                acc = __builtin_amdgcn_mfma_f32_16x16x32_bf16(v0, *(const bf16x8*)(Sc + (16 * nt + r16) * 72 + 8 * g), acc, 0, 0, 0);
                if (nt >= 2) acc = __builtin_amdgcn_mfma_f32_16x16x32_bf16(v1, *(const bf16x8*)(Sc + (16 * nt + r16) * 72 + 32 + 8 * g), acc, 0, 0, 0);
#pragma unroll
                for (int ks = 0; ks < NKS; ++ks) acc = __builtin_amdgcn_mfma_f32_16x16x32_bf16(sfr[ks], *(const bf16x8*)(Qe + (16 * nt + r16) * LQ + 32 * ks + 8 * g), acc, 0, 0, 0);
                o[nt] = acc;
                float ss = acc[0] * acc[0] + acc[1] * acc[1] + acc[2] * acc[2] + acc[3] * acc[3];
                ss += __shfl_xor(ss, 16); ss += __shfl_xor(ss, 32);
                if (g == 0) red[w * 64 + 16 * nt + r16] = ss;
            }
        }
        __syncthreads();
#pragma unroll
        for (int nt = 0; nt < 4; ++nt) {
            float tot = 0.f;
#pragma unroll
            for (int ww = 0; ww < 8; ++ww) tot += red[ww * 64 + 16 * nt + r16];
            const float rs = rsqrtf(tot * (1.f / 128.f) + 1e-6f);
            const size_t row = (size_t)b * SEQ_ + (size_t)c * 64 + 16 * nt + r16;
            const u32x2 gw = gwv[nt];
            u32x2 q; q.x = pk2(o[nt][0] * rs * nw4[0] * siluf_(bflo(gw.x)), o[nt][1] * rs * nw4[1] * siluf_(bfhi(gw.x)));
            q.y = pk2(o[nt][2] * rs * nw4[2] * siluf_(bflo(gw.y)), o[nt][3] * rs * nw4[3] * siluf_(bfhi(gw.y)));
            *(u32x2*)(A + row * 1024 + Cf::OCOL + h * 128 + 16 * w + 4 * g) = q;
        }
        __syncthreads();
    }
}


#define LAS __attribute__((address_space(3)))
#define XB_TMO      128
#define XB_XCNT(j)  (256  + 64 * (j))
#define XB_XSUB(j)  (1280 + 64 * (j))
#define XB_XGEN(j)  (2304 + 64 * (j))
#define XB_TOP      3328
#define XB_TOPGEN   3392
#define XCD_BAR_WORDS 3456
#define XB_SPIN_CAP (1u << 18)

__device__ __forceinline__ unsigned xb_ld(unsigned* p)              { return __hip_atomic_load(p, __ATOMIC_RELAXED, __HIP_MEMORY_SCOPE_AGENT); }
__device__ __forceinline__ unsigned xb_add(unsigned* p, unsigned v) { return __hip_atomic_fetch_add(p, v, __ATOMIC_RELAXED, __HIP_MEMORY_SCOPE_AGENT); }
__device__ __forceinline__ unsigned xb_xcc_id() { return (unsigned)__builtin_amdgcn_s_getreg((3 << 11) | 20) & 0xFu; }
#define XB_SPIN(cond, bar) do { unsigned _sp = 0; while (cond) { __builtin_amdgcn_s_sleep(1); \
    if ((++_sp & 255u) == 0u) { if (xb_ld(&(bar)[XB_TMO])) break; if (_sp > XB_SPIN_CAP) { atomicAdd(&(bar)[XB_TMO], 1u); break; } } } } while (0)

struct XcdBarrier {
    unsigned* bar; unsigned x;
    volatile LAS unsigned* st;
};

__device__ __forceinline__ XcdBarrier xcd_barrier_post(unsigned* bar, volatile LAS unsigned* st) {
    XcdBarrier b; b.bar = bar; b.x = xb_xcc_id(); b.st = st;
    if (threadIdx.x == 0) (void)xb_add(&bar[XB_XCNT(b.x)], 1u);
    return b;
}
__device__ __forceinline__ void xcd_barrier_complete(unsigned* bar, unsigned x, unsigned& nloc, unsigned& nx) {
    const unsigned G = gridDim.x * gridDim.y * gridDim.z;
    unsigned sum, cnt, mine, sp = 0u;
    for (;;) {
        sum = 0u; cnt = 0u; mine = 0u;
#pragma unroll
        for (unsigned j = 0; j < 16; ++j) { const unsigned c = xb_ld(&bar[XB_XCNT(j)]); sum += c; cnt += (c > 0u) ? 1u : 0u; mine = (j == x) ? c : mine; }
        if (sum == G) break;
        __builtin_amdgcn_s_sleep(1);
        if ((++sp & 255u) == 0u) { if (xb_ld(&bar[XB_TMO])) break; if (sp > XB_SPIN_CAP) { atomicAdd(&bar[XB_TMO], 1u); break; } }
    }
    nloc = mine > 0u ? mine : 1u; nx = cnt > 0u ? cnt : 1u;
}

__device__ __forceinline__ void xcd_barrier(const XcdBarrier& b) {
    asm volatile("s_waitcnt vmcnt(0)" ::: "memory");
    __syncthreads();
    if (threadIdx.x == 0) {
        unsigned* bar = b.bar;
        __builtin_amdgcn_s_waitcnt(0);
        unsigned nloc = b.st[0], nx = b.st[1];
        if (nloc == 0u) { xcd_barrier_complete(bar, b.x, nloc, nx); b.st[0] = nloc; b.st[1] = nx; }
        const unsigned old = xb_add(&bar[XB_XSUB(b.x)], 1u);
        const unsigned gen = old / nloc;
        if (old + 1u == (gen + 1u) * nloc) {
            __builtin_amdgcn_fence(__ATOMIC_RELEASE, "agent");
            asm volatile("s_waitcnt vmcnt(0)" ::: "memory");
            const unsigned og = xb_add(&bar[XB_TOP], 1u);
            const unsigned tg = og / nx;
            if (og + 1u == (tg + 1u) * nx) xb_add(&bar[XB_TOPGEN], 1u);
            else XB_SPIN(xb_ld(&bar[XB_TOPGEN]) == tg, bar);
            __builtin_amdgcn_fence(__ATOMIC_ACQUIRE, "agent");
            xb_add(&bar[XB_XGEN(b.x)], 1u);
            asm volatile("s_waitcnt vmcnt(0)" ::: "memory");
        } else {
            XB_SPIN(xb_ld(&bar[XB_XGEN(b.x)]) == gen, bar);
            __builtin_amdgcn_fence(__ATOMIC_ACQUIRE, "agent");
            asm volatile("s_waitcnt vmcnt(0)" ::: "memory");
        }
    }
    __syncthreads();
}

typedef unsigned u32x16 __attribute__((ext_vector_type(16)));
__device__ __forceinline__ void load_params(Params& p) {
    auto kp = __builtin_amdgcn_kernarg_segment_ptr();
    u32x16 a, b, c, d;
    asm volatile("s_load_dwordx16 %0, %4, 0x0\n\ts_load_dwordx16 %1, %4, 0x40\n\ts_load_dwordx16 %2, %4, 0x80\n\ts_load_dwordx16 %3, %4, 0xc0\n\ts_waitcnt lgkmcnt(0)"
                 : "=&s"(a), "=&s"(b), "=&s"(c), "=&s"(d) : "s"(kp) : "memory");
    unsigned long long q[32];
#pragma unroll
    for (int i = 0; i < 8; ++i) { q[i] = ((unsigned long long)a[2 * i + 1] << 32) | a[2 * i]; q[8 + i] = ((unsigned long long)b[2 * i + 1] << 32) | b[2 * i];
        q[16 + i] = ((unsigned long long)c[2 * i + 1] << 32) | c[2 * i]; q[24 + i] = ((unsigned long long)d[2 * i + 1] << 32) | d[2 * i]; }
    p.x = (const float*)(__attribute__((address_space(1))) const float*)q[0]; p.c = (const float*)(__attribute__((address_space(1))) const float*)q[1]; p.positions = (const int*)(__attribute__((address_space(1))) const int*)q[2]; p.mod_w = (const float*)(__attribute__((address_space(1))) const float*)q[3]; p.mod_b = (const float*)(__attribute__((address_space(1))) const float*)q[4]; p.norm_mix_w = (const float*)(__attribute__((address_space(1))) const float*)q[5]; p.norm_ffn_w = (const float*)(__attribute__((address_space(1))) const float*)q[6];
    p.ev_w_in = (const float*)(__attribute__((address_space(1))) const float*)q[7]; p.gla_gate_w = (const float*)(__attribute__((address_space(1))) const float*)q[8]; p.gla_gate_b = (const float*)(__attribute__((address_space(1))) const float*)q[9]; p.gla_norm_w = (const float*)(__attribute__((address_space(1))) const float*)q[10]; p.swa_sinks = (const float*)(__attribute__((address_space(1))) const float*)q[11]; p.ev_w_out = (const float*)(__attribute__((address_space(1))) const float*)q[12];
    p.od_w_in = (const float*)(__attribute__((address_space(1))) const float*)q[13]; p.diff_lambda = (const float*)(__attribute__((address_space(1))) const float*)q[14]; p.diff_norm_w = (const float*)(__attribute__((address_space(1))) const float*)q[15]; p.hgrn_lb_logits = (const float*)(__attribute__((address_space(1))) const float*)q[16]; p.hgrn_norm_w = (const float*)(__attribute__((address_space(1))) const float*)q[17]; p.od_w_out = (const float*)(__attribute__((address_space(1))) const float*)q[18];
    p.ffn_w_in = (const float*)(__attribute__((address_space(1))) const float*)q[19]; p.ffn_conv_w = (const float*)(__attribute__((address_space(1))) const float*)q[20]; p.ffn_conv_b = (const float*)(__attribute__((address_space(1))) const float*)q[21]; p.ffn_w_out = (const float*)(__attribute__((address_space(1))) const float*)q[22]; p.final_norm_w = (const float*)(__attribute__((address_space(1))) const float*)q[23];
    p.out = (float*)(__attribute__((address_space(1))) float*)q[24]; p.ws = (unsigned char*)(__attribute__((address_space(1))) unsigned char*)q[25];
}

#ifndef REP_SYNC
#define REP_SYNC 1
#endif
#ifndef REP_G
#define REP_G 1
#endif
#ifndef REP_R
#define REP_R 1
#endif
#ifndef REP_CV
#define REP_CV 1
#endif
#ifndef REP_P12
#define REP_P12 1
#endif
#ifndef STG_A
#define STG_A 0
#endif
#ifndef STG_B
#define STG_B 0
#endif
#ifndef ALIGN_RES
#define ALIGN_RES true
#endif
#ifndef REP_SWA
#define REP_SWA 1
#endif
#ifndef REP_LA
#define REP_LA 1
#endif
#ifndef REP_AT
#define REP_AT 1
#endif
#ifndef REP_SM
#define REP_SM 1
#endif
__global__ void __launch_bounds__(NTHR, 2) fwd_megakernel(Params pin) {
    extern __shared__ __attribute__((aligned(16))) unsigned char lds[];
    cg::grid_group grid = cg::this_grid();
    Ctx C; C.lds = lds; C.tid = threadIdx.x; C.lane = C.tid & 63; C.wave = __builtin_amdgcn_readfirstlane(C.tid >> 6);
    C.gw = blockIdx.x * 8 + C.wave; C.ngw = gridDim.x * 8;
    PG8_LAS unsigned char* ldsg = (PG8_LAS unsigned char*)lds;
    volatile LAS unsigned* bst = (volatile LAS unsigned*)(ldsg + (LDS_BYTES - 64));
    if (threadIdx.x < 2) bst[threadIdx.x] = 0u;
    __syncthreads();
    XcdBarrier xbar = xcd_barrier_post((unsigned*)(pin.ws + WS_BAR), bst);
#define GSYNC() do { for (int rs_ = 0; rs_ < REP_SYNC; ++rs_) xcd_barrier(xbar); } while (0)
#define RP() do { load_params(C.p); C.tid = otid_(); C.lane = C.tid & 63; C.wave = __builtin_amdgcn_readfirstlane(C.tid >> 6); C.gw = blockIdx.x * 8 + C.wave; } while (0)
#define WSP(off) (C.p.ws + (off))
#define STAGGER(ticks) do { if ((ticks) > 0 && (blockIdx.x & 1)) { const unsigned long long t0_ = __builtin_amdgcn_s_memrealtime(); while (__builtin_amdgcn_s_memrealtime() - t0_ < (unsigned long long)(ticks)) __builtin_amdgcn_s_sleep(16); } } while (0)

    if (pin.ws == nullptr) grid.sync();
    for (int rep_ = 0; rep_ < REP_SM; ++rep_) { RP(); phase_prologue(C); }
    GSYNC();
#if REP_CV > 1
    RP(); phase_convert(C, 0, false);
#endif
    RP(); phase_convert(C, 0);
    for (int rep_ = 0; rep_ < REP_SM; ++rep_) { RP(); phase_prep(C, C.p.x, C.p.norm_mix_w, (const float*)WSP(WS_MOD), 1024, (bf16_t*)WSP(WS_A), (float*)WSP(WS_ROWSS)); }
    GSYNC();
#pragma unroll 1
    for (int l = 0; l < 4; ++l) {
        const bool even = !(l & 1);
        {
            RP();
            const int N = even ? 2560 : 3584;
            pg8::Gemm g{(const bf16_t*)WSP(WS_A), (const bf16_t*)WSP(WS_WIN), T_, N, 1024}; pg8::StaticOrder S; S.init(T_, N, (int)gridDim.x, (int)blockIdx.x);
            pg8::EpiProj E{(bf16_t*)WSP(WS_R1), N, even ? 0x7C000u : 0xFFu, even ? 0x3C000u : 0xFu, QSCALE_, (const float*)WSP(WS_COS), (const float*)WSP(WS_SIN),
                           (const float*)WSP(WS_ROWSS) + (size_t)(2 * l) * T_, (const float*)WSP(WS_BIAS) + (size_t)l * BIAS_L};
            for (int rep_ = 0; rep_ < REP_G; ++rep_) pg8::gemm_phase<pg8::EpiProj, pg8::StaticOrder, true, true>(ldsg, g, S, E);
        }
        GSYNC();
        if (even) {
            for (int rep_ = 0; rep_ < REP_SWA; ++rep_) { RP(); phase_swa(C, l); }
            for (int rep_ = 0; rep_ < REP_LA; ++rep_) { RP(); phase_la_p1<0>(C, l); }
            GSYNC();
            RP(); phase_la_p2<0>(C);
            GSYNC();
#if REP_P12 > 1
            RP(); phase_la_p1<0>(C, l); GSYNC(); RP(); phase_la_p2<0>(C); GSYNC();
#endif
            for (int rep_ = 0; rep_ < REP_LA; ++rep_) { RP(); phase_la_p3<0>(C, l); }
        } else {
            for (int rep_ = 0; rep_ < REP_AT; ++rep_) {
                RP();
                const bf16_t* R1 = (const bf16_t*)WSP(WS_R1); bf16_t* X2 = (bf16_t*)WSP(WS_X2);
                const int G = (int)gridDim.x, bid = (int)blockIdx.x;
#pragma unroll 1
                for (int i = 0; i * G < 2048; ++i) {
                    const int L = i * G + ((i & 1) ? (G - 1 - bid) : bid);
                    if (L >= 2048) continue;
                    const int qb = 15 - (L >> 7), bh = ((L & 63) << 1) | ((L >> 6) & 1), b = bh >> 4, hv = bh & 15;
                    const attn_body::bf16* Q = (const attn_body::bf16*)(R1 + (hv >> 1) * 64);
                    const attn_body::bf16* K = (const attn_body::bf16*)(R1 + 512 + (hv >> 1) * 64);
                    const attn_body::bf16* V = (const attn_body::bf16*)(R1 + 1024 + (hv >> 2) * 128 + (hv & 1) * 64);
                    attn_body::attn_unit<8>(b, hv, qb, Q, K, V, (attn_body::bf16*)(X2 + hv * 64), (char*)lds);
                }
            }
            for (int rep_ = 0; rep_ < REP_LA; ++rep_) { RP(); phase_la_p1<1>(C, l); }
            GSYNC();
            RP(); phase_la_p2<1>(C);
#if REP_P12 > 1
            GSYNC(); RP(); phase_la_p1<1>(C, l); GSYNC(); RP(); phase_la_p2<1>(C);
#endif
            for (int rep_ = 0; rep_ < REP_SM; ++rep_) { RP(); phase_diff_combine(C, l); }
            GSYNC();
            for (int rep_ = 0; rep_ < REP_LA; ++rep_) { RP(); phase_la_p3<1>(C, l); }
        }
        GSYNC();
        STAGGER(STG_A);
        {
            RP();
            const float* modl = (const float*)WSP(WS_MOD) + (size_t)l * 8 * 6144;
            pg8::Gemm g{(const bf16_t*)WSP(WS_A), (const bf16_t*)WSP(WS_WOUT), T_, 1024, 1024}; pg8::StaticOrder S; S.init(T_, 1024, (int)gridDim.x, (int)blockIdx.x);
            void* XH = (void*)((char*)C.p.out + 64 * MiB_);
            pg8::EpiRes E{(l == 0) ? (const void*)C.p.x : (const void*)XH, XH, (l == 0) ? 1 : 0, 0, modl + 2048, (bf16_t*)WSP(WS_X2), C.p.norm_ffn_w + l * 1024, modl + 4096, (float*)WSP(WS_ROWSS) + (size_t)(2 * l + 1) * T_};
            pg8::gemm_phase<pg8::EpiRes, pg8::StaticOrder, ALIGN_RES, true>(ldsg, g, S, E);
        }
        GSYNC();
        {
            RP();
            pg8::Gemm g{(const bf16_t*)WSP(WS_X2), (const bf16_t*)WSP(WS_FIN), T_, 5632, 1024}; pg8::StaticOrder S; S.init(T_, 5632, (int)gridDim.x, (int)blockIdx.x);
            pg8::EpiFfn E{(bf16_t*)WSP(WS_R1), (float*)WSP(WS_HP), (float*)WSP(WS_HU), (float*)WSP(WS_HA), C.p.ffn_conv_w + (size_t)l * 3 * DFF_, C.p.ffn_conv_b + (size_t)l * DFF_,
                          (const float*)WSP(WS_ROWSS) + (size_t)(2 * l + 1) * T_, (const float*)WSP(WS_BIAS) + (size_t)l * BIAS_L + 8 * 3584};
            for (int rep_ = 0; rep_ < REP_G; ++rep_) pg8::gemm_phase<pg8::EpiFfn, pg8::StaticOrder, true, true>(ldsg, g, S, E);
        }
        GSYNC();
        for (int rep_ = 0; rep_ < REP_SM; ++rep_) { RP(); phase_ffn_fixup(C, l); }
#if REP_CV > 1
        if (l < 3) { RP(); phase_convert(C, l + 1, false); }
#endif
        if (l < 3) { RP(); phase_convert(C, l + 1); }
        GSYNC();
        STAGGER(STG_B);
        {
            RP();
            const float* modl = (const float*)WSP(WS_MOD) + (size_t)l * 8 * 6144;
            pg8::Gemm g{(const bf16_t*)WSP(WS_R1), (const bf16_t*)WSP((l & 1) ? WS_FOUT2 : WS_FOUT), T_, 1024, DFF_}; pg8::StaticOrder S; S.init(T_, 1024, (int)gridDim.x, (int)blockIdx.x);
            void* XH = (void*)((char*)C.p.out + 64 * MiB_);
            pg8::EpiRes E{XH, (l < 3) ? XH : (void*)WSP(WS_X2), 0, 0, modl + 5120, (l < 3) ? (bf16_t*)WSP(WS_A) : (bf16_t*)nullptr, C.p.norm_mix_w + ((l + 1) & 3) * 1024, modl + 6144 * 8 + 1024, (float*)WSP(WS_ROWSS) + (size_t)((2 * l + 2) & 7) * T_};
            pg8::gemm_phase<pg8::EpiRes, pg8::StaticOrder, ALIGN_RES, true>(ldsg, g, S, E);
        }
        GSYNC();
    }
    RP(); phase_final_norm(C, (const void*)WSP(WS_X2), C.p.out, C.p.final_norm_w);
}

extern "C" void kernel_launch(void* const* d_in, const int* in_sizes, int n_in, void* d_out, int out_size, void* d_ws, size_t ws_size, hipStream_t stream) {
    static int grid_blocks = 0;
    if (grid_blocks == 0) {
        if (n_in != 24 || ws_size < WS_END) { fprintf(stderr, "kernel_launch: unexpected n_in %d / ws %zu\n", n_in, ws_size); grid_blocks = -1; return; }
        int dev = 0, cus = 0, per_cu = 0;
        hipGetDevice(&dev); hipDeviceGetAttribute(&cus, hipDeviceAttributeMultiprocessorCount, dev);
        if (hipFuncSetAttribute((const void*)fwd_megakernel, hipFuncAttributeMaxDynamicSharedMemorySize, LDS_BYTES) != hipSuccess) { fprintf(stderr, "kernel_launch: hipFuncSetAttribute failed\n"); grid_blocks = -1; return; }
        if (hipOccupancyMaxActiveBlocksPerMultiprocessor(&per_cu, (const void*)fwd_megakernel, NTHR, LDS_BYTES) != hipSuccess || per_cu < 1) { fprintf(stderr, "kernel_launch: occupancy query gave %d\n", per_cu); per_cu = 1; }
        (void)hipGetLastError();
        grid_blocks = cus * per_cu;
    }
    if (grid_blocks < 0) return;
    Params p{};
    p.x = (const float*)d_in[0]; p.c = (const float*)d_in[1]; p.positions = (const int*)d_in[2]; p.mod_w = (const float*)d_in[3]; p.mod_b = (const float*)d_in[4];
    p.norm_mix_w = (const float*)d_in[5]; p.norm_ffn_w = (const float*)d_in[6]; p.ev_w_in = (const float*)d_in[7]; p.gla_gate_w = (const float*)d_in[8];
    p.gla_gate_b = (const float*)d_in[9]; p.gla_norm_w = (const float*)d_in[10]; p.swa_sinks = (const float*)d_in[11]; p.ev_w_out = (const float*)d_in[12];
    p.od_w_in = (const float*)d_in[13]; p.diff_lambda = (const float*)d_in[14]; p.diff_norm_w = (const float*)d_in[15]; p.hgrn_lb_logits = (const float*)d_in[16];
    p.hgrn_norm_w = (const float*)d_in[17]; p.od_w_out = (const float*)d_in[18]; p.ffn_w_in = (const float*)d_in[19]; p.ffn_conv_w = (const float*)d_in[20];
    p.ffn_conv_b = (const float*)d_in[21]; p.ffn_w_out = (const float*)d_in[22]; p.final_norm_w = (const float*)d_in[23];
    p.out = (float*)d_out; p.ws = (unsigned char*)d_ws;
    if (hipMemsetAsync((char*)d_ws + WS_BAR, 0, 16384, stream) != hipSuccess) { fprintf(stderr, "kernel_launch: memset failed\n"); return; }
    void* args[] = {&p};
    hipError_t e = hipLaunchCooperativeKernel((const void*)fwd_megakernel, dim3(grid_blocks), dim3(NTHR), args, LDS_BYTES, stream);
    if (e != hipSuccess) fprintf(stderr, "cooperative launch failed: %s (grid %d)\n", hipGetErrorString(e), grid_blocks);
}
```

```cpp
#include <hip/hip_runtime.h>
#include <hip/hip_cooperative_groups.h>
#include <hip/hip_bf16.h>
#include <cstdio>
#include <cstdint>
#include <cmath>
__device__ __forceinline__ int otid_() { int t = threadIdx.x; asm volatile("" : "+v"(t)); return t; }
namespace pg8 {
#define PG8_LAS __attribute__((address_space(3)))
typedef unsigned short bf16_t;
typedef short bf16x8 __attribute__((ext_vector_type(8)));
typedef float f32x4 __attribute__((ext_vector_type(4)));
typedef unsigned u32x4 __attribute__((ext_vector_type(4)));
constexpr int BM = 256, BK = 64, HALF = 128, HTB = HALF * BK * 2  , STAGE_BYTES = 8 * HTB, NXCD = 8, WGM = 8;

__host__ __device__ __forceinline__ int lds_byte(int r, int c) { const int st = (r >> 4) * 2 + (c >> 5), rr = r & 15, cc = c & 31, ob = rr * 64 + cc * 2; return st * 1024 + (ob ^ (((ob >> 9) & 1) << 5)); }
__host__ __device__ __forceinline__ void stage_rc(int b, int& R, int& C) { const int st = b / 1024, sb = b % 1024, swz = sb ^ (((sb >> 9) & 1) << 5); R = (st >> 1) * 16 + swz / 64; C = (st & 1) * 32 + (swz % 64) / 2; }
__host__ __device__ __forceinline__ int perm32(int rho) { const int n = rho >> 4, i = rho & 15; return 8 * (i >> 2) + 4 * n + (i & 3); }

struct Unit { int pm, pn; };
struct Gemm { const bf16_t* A; const bf16_t* Bt; int M, N, K; };

struct StaticOrder {
    int nM, nN, nwg, G, c;
    __host__ __device__ void init(int M, int N, int G_, int c_) { nM = M / BM; nN = N / BM; nwg = nM * nN; G = G_; c = c_; }
    __host__ __device__ bool next(int i, Unit& u) const {
        const long L = (long)i * G + c; if (L >= nwg) return false;
        int wgid = (int)L; { const int q = nwg / NXCD, r = nwg % NXCD, xcd = wgid % NXCD, off = wgid / NXCD; wgid = (xcd < r ? xcd * (q + 1) : r * (q + 1) + (xcd - r) * q) + off; }
        const int nig = WGM * nN, gid = wgid / nig, fm = gid * WGM, gsz = (nM - fm) < WGM ? (nM - fm) : WGM;
        u.pm = fm + ((wgid % nig) % gsz); u.pn = (wgid % nig) / gsz; return true;
    }
    __device__ __forceinline__ void a_ready(const Unit&) const {}
    __device__ __forceinline__ void done(const Unit&) const {}
};

__device__ __forceinline__ unsigned cvt_pk_bf16(float lo, float hi) { unsigned r; asm volatile("v_cvt_pk_bf16_f32 %0, %1, %2" : "=v"(r) : "v"(lo), "v"(hi)); return r; }
typedef float f32x2 __attribute__((ext_vector_type(2)));
template <class Epi, class Sched, bool ALIGN_EPI = false, bool SP2 = false>
__device__ __forceinline__ void gemm_phase(PG8_LAS unsigned char* lds, const Gemm g, const Sched& S, const Epi& E) {
    const int tid = otid_(), wid = __builtin_amdgcn_readfirstlane(tid >> 6), lane = tid & 63, wr = wid >> 2, wc = wid & 3, fr = lane & 15, fq = lane >> 4;
    const int K = g.K, nt = K / BK;
    unsigned voffA[2], voffB[2];
#pragma unroll
    for (int i = 0; i < 2; ++i) { int R, C; stage_rc(tid * 16 + i * 8192, R, C); const int Rb = Epi::PERM ? ((R & ~31) + perm32(R & 31)) : R;
        voffA[i] = (unsigned)(R * K + C) * 2u; voffB[i] = (unsigned)(Rb * K + C) * 2u; }
    const size_t kstep = (size_t)(BK * 2);
    const size_t hstep = (size_t)HALF * K * 2;
    const size_t tstep = 2 * hstep;
    const unsigned ldsw = (unsigned)wid * 1024u;
    const int aoff = lds_byte(wr * 64 + fr, fq * 8), boff = lds_byte(wc * 32 + fr, fq * 8);
#define PG8_SA(b, h) (((b) * 2 + (h)) * HTB)
#define PG8_SB(b, h) ((4 + (b) * 2 + (h)) * HTB)
#define PG8_STAGE(bufoff, gbase, voff) do { _Pragma("unroll") for (int _i = 0; _i < 2; ++_i) \
        __builtin_amdgcn_global_load_lds((const unsigned*)((const char*)(gbase) + (voff)[_i]), (PG8_LAS unsigned*)(lds + (bufoff) + ldsw + _i * 8192), 16, 0, 0); } while (0)
#define PG8_LDA(dst, b, h) do { _Pragma("unroll") for (int m = 0; m < 4; ++m) _Pragma("unroll") for (int k = 0; k < 2; ++k) dst[m][k] = *(const PG8_LAS bf16x8*)(lds + PG8_SA(b, h) + aoff + m * 2048 + k * 1024); } while (0)
#define PG8_LDB(dst, b, h) do { _Pragma("unroll") for (int n = 0; n < 2; ++n) _Pragma("unroll") for (int k = 0; k < 2; ++k) dst[n][k] = *(const PG8_LAS bf16x8*)(lds + PG8_SB(b, h) + boff + n * 2048 + k * 1024); } while (0)
#define PG8_MMA(ai, bj, At, Bt) do { __builtin_amdgcn_s_setprio(1); _Pragma("unroll") for (int m = 0; m < 4; ++m) _Pragma("unroll") for (int n = 0; n < 2; ++n) _Pragma("unroll") for (int k = 0; k < 2; ++k) \
        acc[ai][bj][m][n] = __builtin_amdgcn_mfma_f32_16x16x32_bf16(Bt[n][k], At[m][k], acc[ai][bj][m][n], 0, 0, 0); __builtin_amdgcn_s_setprio(0); } while (0)
#define PG8_WAIT_V(n) asm volatile("s_waitcnt vmcnt(" #n ")" ::: "memory")
#define PG8_WAIT_L(n) asm volatile("s_waitcnt lgkmcnt(" #n ")" ::: "memory")
#define PG8_BAR __builtin_amdgcn_s_barrier()
#define PG8_SCHED __builtin_amdgcn_sched_barrier(0)
    Unit cur, nxt; int ui = 0;
    if (!S.next(0, cur)) return;
    f32x4 acc[2][2][4][2];
#pragma unroll
    for (int a = 0; a < 2; ++a)
#pragma unroll
        for (int b = 0; b < 2; ++b)
#pragma unroll
            for (int m = 0; m < 4; ++m)
#pragma unroll
                for (int n = 0; n < 2; ++n) acc[a][b][m][n] = (f32x4){0.f, 0.f, 0.f, 0.f};
    bf16x8 At[4][2], B0[2][2], B1[2][2];
    const char* cA = (const char*)g.A + (size_t)cur.pm * tstep; const char* cB = (const char*)g.Bt + (size_t)cur.pn * tstep;
    S.a_ready(cur);
    if constexpr (SP2) {
        PG8_STAGE(PG8_SB(0, 0), cB, voffB); PG8_STAGE(PG8_SB(0, 1), cB + hstep, voffB); PG8_STAGE(PG8_SA(0, 0), cA, voffA); PG8_STAGE(PG8_SA(0, 1), cA + hstep, voffA);
        if (wr == 1) PG8_BAR;
        PG8_WAIT_V(2); PG8_BAR;
        PG8_STAGE(PG8_SB(1, 0), cB + kstep, voffB); PG8_STAGE(PG8_SA(1, 0), cA + kstep, voffA); PG8_STAGE(PG8_SB(1, 1), cB + hstep + kstep, voffB);
        PG8_WAIT_V(6); PG8_BAR;
    } else {
        PG8_STAGE(PG8_SB(0, 0), cB, voffB); PG8_STAGE(PG8_SA(0, 0), cA, voffA); PG8_STAGE(PG8_SB(0, 1), cB + hstep, voffB); PG8_STAGE(PG8_SA(0, 1), cA + hstep, voffA);
        if (wr == 1) PG8_BAR;
        PG8_WAIT_V(4); PG8_BAR;
        PG8_STAGE(PG8_SB(1, 0), cB + kstep, voffB); PG8_STAGE(PG8_SA(1, 0), cA + kstep, voffA); PG8_STAGE(PG8_SB(1, 1), cB + hstep + kstep, voffB);
        PG8_WAIT_V(6); PG8_BAR;
    }
    for (;;) {
        const bool has_next = S.next(ui + 1, nxt);
        const char* nA = has_next ? (const char*)g.A + (size_t)nxt.pm * tstep : cA; const char* nB = has_next ? (const char*)g.Bt + (size_t)nxt.pn * tstep : cB;
        for (int t = 0; t < nt; t += 2) {
            const bool last = (t == nt - 2);
            const char* a1 = cA + (size_t)(t + 1) * kstep;
            const char* a2 = last ? nA : cA + (size_t)(t + 2) * kstep; const char* b2 = last ? nB : cB + (size_t)(t + 2) * kstep;
            const char* a3 = a2 + kstep; const char* b3 = b2 + kstep;
            if (last && has_next) S.a_ready(nxt);
            if constexpr (SP2) {
            PG8_LDB(B0, 0, 0); PG8_LDB(B1, 0, 1); PG8_SCHED; PG8_LDA(At, 0, 0); PG8_STAGE(PG8_SA(1, 1), a1 + hstep, voffA);
            PG8_WAIT_V(8); PG8_WAIT_L(0); PG8_BAR; PG8_MMA(0, 0, At, B0); PG8_MMA(0, 1, At, B1); PG8_BAR; PG8_SCHED;
            PG8_LDA(At, 0, 1); PG8_STAGE(PG8_SB(0, 0), b2, voffB); PG8_STAGE(PG8_SB(0, 1), b2 + hstep, voffB); PG8_STAGE(PG8_SA(0, 0), a2, voffA);
            PG8_WAIT_V(8); PG8_WAIT_L(0); PG8_BAR; PG8_MMA(1, 0, At, B0); PG8_MMA(1, 1, At, B1); PG8_BAR; PG8_SCHED;
            PG8_LDB(B0, 1, 0); PG8_LDB(B1, 1, 1); PG8_SCHED; PG8_LDA(At, 1, 0); PG8_STAGE(PG8_SA(0, 1), a2 + hstep, voffA);
            PG8_WAIT_V(8); PG8_WAIT_L(0); PG8_BAR; PG8_MMA(0, 0, At, B0); PG8_MMA(0, 1, At, B1); PG8_BAR; PG8_SCHED;
            PG8_LDA(At, 1, 1); PG8_STAGE(PG8_SB(1, 0), b3, voffB); PG8_STAGE(PG8_SB(1, 1), b3 + hstep, voffB); PG8_STAGE(PG8_SA(1, 0), a3, voffA);
            PG8_WAIT_V(8); PG8_WAIT_L(0); PG8_BAR; PG8_MMA(1, 0, At, B0); PG8_MMA(1, 1, At, B1); PG8_BAR; PG8_SCHED;
            } else {
            PG8_LDB(B0, 0, 0); PG8_SCHED; PG8_LDA(At, 0, 0); PG8_STAGE(PG8_SA(1, 1), a1 + hstep, voffA);
            PG8_WAIT_L(8); PG8_BAR; PG8_WAIT_L(0); PG8_MMA(0, 0, At, B0); PG8_BAR; PG8_SCHED;
            PG8_LDB(B1, 0, 1); PG8_STAGE(PG8_SB(0, 0), b2, voffB);
            PG8_BAR; PG8_WAIT_L(0); PG8_MMA(0, 1, At, B1); PG8_BAR;
            PG8_LDA(At, 0, 1); PG8_STAGE(PG8_SA(0, 0), a2, voffA);
            PG8_BAR; PG8_WAIT_L(0); PG8_MMA(1, 0, At, B0); PG8_BAR; PG8_SCHED;
            PG8_STAGE(PG8_SB(0, 1), b2 + hstep, voffB);
            PG8_WAIT_V(6); PG8_BAR; PG8_MMA(1, 1, At, B1); PG8_BAR;
            PG8_LDB(B0, 1, 0); PG8_SCHED; PG8_LDA(At, 1, 0); PG8_STAGE(PG8_SA(0, 1), a2 + hstep, voffA);
            PG8_WAIT_L(8); PG8_BAR; PG8_WAIT_L(0); PG8_MMA(0, 0, At, B0); PG8_BAR; PG8_SCHED;
            PG8_LDB(B1, 1, 1); PG8_STAGE(PG8_SB(1, 0), b3, voffB);
            PG8_BAR; PG8_WAIT_L(0); PG8_MMA(0, 1, At, B1); PG8_BAR;
            PG8_LDA(At, 1, 1); PG8_STAGE(PG8_SA(1, 0), a3, voffA);
            PG8_BAR; PG8_WAIT_L(0); PG8_MMA(1, 0, At, B0); PG8_BAR; PG8_SCHED;
            PG8_STAGE(PG8_SB(1, 1), b3 + hstep, voffB);
            PG8_WAIT_V(6); PG8_BAR; PG8_MMA(1, 1, At, B1); PG8_BAR;
            }
        }
        if constexpr (ALIGN_EPI) { if (wr == 0) PG8_BAR; }
        if constexpr (!Epi::AFTER_DRAIN) { E(acc, cur, wr, wc, fr, fq); S.done(cur); }
        if (!has_next) break;
#pragma unroll
        for (int a = 0; a < 2; ++a)
#pragma unroll
            for (int b = 0; b < 2; ++b)
#pragma unroll
                for (int m = 0; m < 4; ++m)
#pragma unroll
                    for (int n = 0; n < 2; ++n) acc[a][b][m][n] = (f32x4){0.f, 0.f, 0.f, 0.f};
        cur = nxt; cA = nA; cB = nB; ++ui;
        if constexpr (ALIGN_EPI) { if (wr == 1) PG8_BAR; }
    }
    PG8_WAIT_V(0);
    if constexpr (!ALIGN_EPI) { if (wr == 0) PG8_BAR; }
    PG8_BAR;
    if constexpr (Epi::AFTER_DRAIN) { E.fused(acc, cur, wr, wc, fr, fq, lds, wid, lane); S.done(cur); }
#undef PG8_SA
#undef PG8_SB
#undef PG8_STAGE
#undef PG8_LDA
#undef PG8_LDB
#undef PG8_MMA
#undef PG8_WAIT_V
#undef PG8_WAIT_L
#undef PG8_BAR
#undef PG8_SCHED
}
}
#include <hip/hip_bf16.h>
namespace attn_body {
using bf16=__hip_bfloat16;
using bf16x8=__attribute__((ext_vector_type(8)))short;
using s16x4=__attribute__((ext_vector_type(4)))short;
using f32x16=__attribute__((ext_vector_type(16)))float;
using u32x4=__attribute__((ext_vector_type(4)))unsigned;
constexpr int BATCH=8,NHEAD=16,SEQ=4096,D=64,PITI=3584,PITO=1024;
constexpr int NW=8,QBLK=32,QB=QBLK*NW,KVBLK=64,NQB=SEQ/QB;
__device__ __forceinline__ int crow(int r,int hi){return (r&3)+8*(r>>2)+4*hi;}
#define SBAR() __builtin_amdgcn_sched_barrier(0)
__device__ __forceinline__ void cmask(f32x16&p0,f32x16&p1,int jb,int qrel,int hi){
  const float NEG=-INFINITY; int kb=64*jb+4*hi;
  #pragma unroll
  for(int r=0;r<16;++r){int kv=kb+(r&3)+8*(r>>2); if(kv>qrel)p0[r]=NEG; if(kv+32>qrel)p1[r]=NEG;}
}

constexpr int NSLOT=3, SLOTB=8192;
constexpr int LDS_K=0, LDS_V=NSLOT*SLOTB, LDS_WS=2*NSLOT*SLOTB, LDS_OST=LDS_WS+NW*64*4, LDS_BYTES=LDS_OST+NW*4096;
constexpr float C2=0.125f*1.4426950408889634f;
__device__ __forceinline__ void glds16(const void*gsrc,unsigned lds_dst){unsigned keep;
  asm volatile("s_mov_b32 %0, m0\n\ts_mov_b32 m0, %2\n\ts_nop 0\n\tglobal_load_lds_dwordx4 %1, off\n\ts_mov_b32 m0, %0":"=&s"(keep):"v"(gsrc),"s"(lds_dst):"memory");}
__device__ __forceinline__ float max3f(float a,float b,float c){float r;asm("v_max3_f32 %0, %1, %2, %3":"=v"(r):"v"(a),"v"(b),"v"(c));return r;}
__device__ __forceinline__ float max2f(float a,float b){float r;asm("v_max_f32_e32 %0, %1, %2":"=v"(r):"v"(a),"v"(b));return r;}
__device__ __forceinline__ float fadd_s(float a,float b){float r;asm("v_add_f32_e32 %0, %1, %2":"=v"(r):"v"(a),"v"(b));return r;}
__device__ __forceinline__ float fsub_s(float a,float b){float r;asm("v_sub_f32_e32 %0, %1, %2":"=v"(r):"v"(a),"v"(b));return r;}
typedef float f32x2_t __attribute__((ext_vector_type(2))); typedef __bf16 bf16x2_t __attribute__((ext_vector_type(2)));
__device__ __forceinline__ unsigned cvtpk_s(float lo,float hi){f32x2_t v={lo,hi};bf16x2_t b=__builtin_convertvector(v,bf16x2_t);return __builtin_bit_cast(unsigned,b);}
#define WAIT_BAR(N) asm volatile("s_waitcnt vmcnt(" #N ") lgkmcnt(0)\n\ts_barrier":::"memory")

__device__ __forceinline__ void qkt(f32x16&p0,f32x16&p1,const char*Kslot,const bf16x8*qr,const f32x16&negm,int r32,int hi){
  const char*kb=Kslot+hi*1024+r32*16;
  #pragma unroll
  for(int d0=0;d0<4;++d0){
    const bf16x8 b0=*reinterpret_cast<const bf16x8*>(kb+d0*2048);
    const bf16x8 b1=*reinterpret_cast<const bf16x8*>(kb+d0*2048+512);
    if(d0==0){p0=__builtin_amdgcn_mfma_f32_32x32x16_bf16(b0,qr[0],negm,0,0,0);p1=__builtin_amdgcn_mfma_f32_32x32x16_bf16(b1,qr[0],negm,0,0,0);}
    else{p0=__builtin_amdgcn_mfma_f32_32x32x16_bf16(b0,qr[d0],p0,0,0,0);p1=__builtin_amdgcn_mfma_f32_32x32x16_bf16(b1,qr[d0],p1,0,0,0);}}
}
typedef __attribute__((address_space(3))) const char* lds_cptr;
typedef short v4i16_t __attribute__((ext_vector_type(4)));
__device__ __forceinline__ void kload8(bf16x8*kf,lds_cptr kp){
  kf[0]=*(const __attribute__((address_space(3))) bf16x8*)(kp);      kf[1]=*(const __attribute__((address_space(3))) bf16x8*)(kp+512);
  kf[2]=*(const __attribute__((address_space(3))) bf16x8*)(kp+2048); kf[3]=*(const __attribute__((address_space(3))) bf16x8*)(kp+2560);
  kf[4]=*(const __attribute__((address_space(3))) bf16x8*)(kp+4096); kf[5]=*(const __attribute__((address_space(3))) bf16x8*)(kp+4608);
  kf[6]=*(const __attribute__((address_space(3))) bf16x8*)(kp+6144); kf[7]=*(const __attribute__((address_space(3))) bf16x8*)(kp+6656);
}
__device__ __forceinline__ void kload2(bf16x8*kf,lds_cptr kp,int j){ kf[2*j]=*(const __attribute__((address_space(3))) bf16x8*)(kp+j*2048); kf[2*j+1]=*(const __attribute__((address_space(3))) bf16x8*)(kp+j*2048+512); }
__device__ __forceinline__ s16x4 vtr(lds_cptr p){ return __builtin_bit_cast(s16x4,__builtin_amdgcn_ds_read_tr16_b64_v4i16((__attribute__((address_space(3))) v4i16_t*)p)); }
__device__ __forceinline__ float rowmax(const f32x16&p0,const f32x16&p1){
  float a=max3f(p0[0],p0[1],p1[0]),b=max3f(p0[2],p0[3],p1[1]);a=max3f(a,p1[2],p1[3]);
  #pragma unroll
  for(int r=4;r<16;r+=4){a=max3f(a,p0[r],p0[r+1]);b=max3f(b,p0[r+2],p0[r+3]);a=max3f(a,p1[r],p1[r+1]);b=max3f(b,p1[r+2],p1[r+3]);}
  const float m=max2f(a,b);
  auto rr=__builtin_amdgcn_permlane32_swap(__float_as_uint(m),__float_as_uint(m),false,false);
  return max2f(__uint_as_float(rr[0]),__uint_as_float(rr[1]));
}
__device__ __forceinline__ void pv(f32x16*o,int vb,bf16x8 pa0,bf16x8 pa1,bf16x8 pa2,bf16x8 pa3){
  #pragma unroll
  for(int d0=0;d0<2;++d0){s16x4 lo[4],hi[4];
    #pragma unroll
    for(int ks=0;ks<4;++ks){
      asm volatile("ds_read_b64_tr_b16 %0,%1 offset:%c2":"=&v"(lo[ks]):"v"(vb),"i"(d0*4096+ks*1024):"memory");
      asm volatile("ds_read_b64_tr_b16 %0,%1 offset:%c2":"=&v"(hi[ks]):"v"(vb),"i"(d0*4096+ks*1024+512):"memory");}
    asm volatile("s_waitcnt lgkmcnt(0)":::"memory");SBAR();
    #define PK(k) (bf16x8){lo[k][0],lo[k][1],lo[k][2],lo[k][3],hi[k][0],hi[k][1],hi[k][2],hi[k][3]}
    o[d0]=__builtin_amdgcn_mfma_f32_32x32x16_bf16(pa0,PK(0),o[d0],0,0,0);
    o[d0]=__builtin_amdgcn_mfma_f32_32x32x16_bf16(pa1,PK(1),o[d0],0,0,0);
    o[d0]=__builtin_amdgcn_mfma_f32_32x32x16_bf16(pa2,PK(2),o[d0],0,0,0);
    o[d0]=__builtin_amdgcn_mfma_f32_32x32x16_bf16(pa3,PK(3),o[d0],0,0,0);
    #undef PK
  }
}

#ifndef ATTN_STORE16
#define ATTN_STORE16(p,v) (*(u32x4*)(p)=(v))
#endif
template<int THRL> __device__ __forceinline__ void attn_unit(int b,int h,int qb,const bf16*Q,const bf16*__restrict__ K,const bf16*__restrict__ V,bf16*O,char*shm){
  const int tid=otid_(),lane=tid&63,r32=lane&31,hi=lane>>5; const int wid=__builtin_amdgcn_readfirstlane(tid>>6);
  const long rowbase=(long)b*SEQ; const int q0=qb*QB;
  const bf16*Qw=Q+(rowbase+q0+wid*QBLK)*PITI;
  const bf16*Kh=K+rowbase*PITI,*Vh=V+rowbase*PITI;
  const unsigned lds0=(unsigned)(uintptr_t)shm;
  float*wsf=(float*)(shm+LDS_WS)+wid*64;
  const bf16*ksrc=Kh+(long)lane*PITI+wid*8;
  const bf16*vsrc=Vh+(long)(16*(wid&3)+(lane>>2))*PITI+(wid>>2)*32+(lane&3)*8;
  const unsigned kdst=lds0+LDS_K+wid*1024, vdst=lds0+LDS_V+wid*1024;
  #define DMA_K(t,slot) glds16(ksrc+(long)(t)*KVBLK*PITI,(unsigned)__builtin_amdgcn_readfirstlane(kdst+(slot)))
  #define DMA_V(t,slot) glds16(vsrc+(long)(t)*KVBLK*PITI,(unsigned)__builtin_amdgcn_readfirstlane(vdst+(slot)))
  const int vb0=(int)(lds0+LDS_V)+((lane>>4)&1)*32+(lane&3)*8+(4*hi+((lane&15)>>2))*64;
  const char*Kbase=shm+LDS_K; bf16x8 kf[8];
  const lds_cptr shm3=(lds_cptr)shm; const lds_cptr kp0=shm3+LDS_K+hi*1024+r32*16; const lds_cptr vp0=shm3+LDS_V+((lane>>4)&1)*32+(lane&3)*8+(4*hi+((lane&15)>>2))*64;
  const int NT=(q0+QB)/KVBLK;
  DMA_K(0,0);DMA_V(0,0);DMA_K(1,SLOTB);
  bf16x8 qr[4];
  #pragma unroll
  for(int d0=0;d0<4;++d0)qr[d0]=*reinterpret_cast<const bf16x8*>(&Qw[(long)r32*PITI+d0*16+hi*8]);
  float mhat=0.f,l_reg=0.f;f32x16 o[2];o[0]=f32x16{};o[1]=f32x16{};f32x16 negm=f32x16{};asm volatile("":"+v"(negm));
  const int qrel=wid*QBLK+r32;
  #define CMASK(P0,P1,t) do{int jb_=(t)-(NT-4); if(jb_>=0)cmask(P0,P1,jb_,qrel,hi);}while(0)
  bool resc=false;
  #define START(P0,P1) do{ const float rm=rowmax(P0,P1); resc=false; \
    { const float dl=rm; mhat=fadd_s(mhat,dl); \
      _Pragma("unroll") for(int r=0;r<16;++r){P0[r]=fsub_s(P0[r],dl);P1[r]=fsub_s(P1[r],dl);} \
      _Pragma("unroll") for(int r=0;r<16;++r)negm[r]=-mhat; asm volatile("":"+v"(negm)); } \
    _Pragma("unroll") for(int r=0;r<16;++r)P0[r]=__builtin_amdgcn_exp2f(P0[r]); }while(0)
  #define RESC() do{ if(resc){ asm volatile("s_waitcnt lgkmcnt(0)":::"memory"); \
      _Pragma("unroll") for(int d_=0;d_<2;++d_) _Pragma("unroll") for(int r=0;r<16;++r)o[d_][r]*=wsf[crow(r,hi)]; } }while(0)
  f32x16 pA0,pA1,pB0,pB1;
  int sl_prev=0,sl_cur=0,sl_next=SLOTB;
  #define ROT() do{sl_prev=sl_cur;sl_cur=sl_next;sl_next=(sl_next==(NSLOT-1)*SLOTB)?0:sl_next+SLOTB;}while(0)
  DMA_K(2,2*SLOTB);
  WAIT_BAR(3);
  qkt(pA0,pA1,Kbase,qr,negm,r32,hi);asm volatile("s_nop 15\n\ts_nop 7":"+v"(pA0),"+v"(pA1));CMASK(pA0,pA1,0);
  START(pA0,pA1);
  _Pragma("unroll") for(int r=0;r<16;++r)pA1[r]=__builtin_amdgcn_exp2f(pA1[r]);
  WAIT_BAR(0);
  DMA_K(3,0);DMA_V(1,SLOTB);
  ROT();
  kload8(kf,kp0+sl_cur);
  WAIT_BAR(2);
  s16x4 vlo[8],vhi[8]; u32x4 pw0,pw1,pw2,pw3;
  #define PKW(P,B) cvtpk_s(P[B],P[B+1])
  #define PAF(k) __builtin_bit_cast(bf16x8,pw##k)
  #define VFR(i) (bf16x8){vlo[i][0],vlo[i][1],vlo[i][2],vlo[i][3],vhi[i][0],vhi[i][1],vhi[i][2],vhi[i][3]}
  #define PIN(x) asm volatile("":"+v"(x))
  #define MX3(a,b,c) __builtin_fmaxf(__builtin_fmaxf((a),(b)),(c))
  #define GAPA(MF,A0,A1,A2,A3,W0,W1,PW) do{ MF; sacc+=A0; sacc+=A1; sacc+=A2; sacc+=A3; PIN(sacc); W0; W1; PIN(PW); SBAR(); }while(0)
  #define EX(v) __builtin_amdgcn_exp2f(v)
  #define GAPB(MF,X,B) do{ MF; X[B]=EX(X[B]); X[B+1]=EX(X[B+1]); X[B+2]=EX(X[B+2]); X[B+3]=EX(X[B+3]); PIN(X); SBAR(); }while(0)
  #define VRD(i) do{ vlo[i]=vtr(vp_+(((i)>>2)*4096+((i)&3)*1024)); vhi[i]=vtr(vp_+(((i)>>2)*4096+((i)&3)*1024+512)); }while(0)
  #define KRD(G,j) do{ if(G){ kload2(kf,kp0+sl_next,j); SBAR(); } }while(0)
  #define STEP(C0,C1,P0,P1,t,GK,GV,GL) do{ SBAR(); \
    const lds_cptr vp_=vp0+sl_prev; \
    VRD(0); SBAR(); float sacc=(P0[0]+P0[1]); \
    GAPA(C0=__builtin_amdgcn_mfma_f32_32x32x16_bf16(kf[0],qr[0],negm,0,0,0), P0[2],P0[3],P0[4],P0[5],     pw0[0]=PKW(P0,0), pw0[1]=PKW(P0,2), pw0); \
    VRD(4); SBAR(); GAPA(C1=__builtin_amdgcn_mfma_f32_32x32x16_bf16(kf[1],qr[0],negm,0,0,0), P0[6],P0[7],P0[8],P0[9],     pw0[2]=PKW(P0,4), pw0[3]=PKW(P0,6), pw0); \
    VRD(1); SBAR(); GAPA(C0=__builtin_amdgcn_mfma_f32_32x32x16_bf16(kf[2],qr[1],C0,0,0,0),   P0[10],P0[11],P0[12],P0[13], pw1[0]=PKW(P0,8), pw1[1]=PKW(P0,10), pw1); \
    VRD(5); SBAR(); GAPA(C1=__builtin_amdgcn_mfma_f32_32x32x16_bf16(kf[3],qr[1],C1,0,0,0),   P0[14],P0[15],P1[0],P1[1],   pw1[2]=PKW(P0,12),pw1[3]=PKW(P0,14), pw1); \
    VRD(2); SBAR(); GAPA(C0=__builtin_amdgcn_mfma_f32_32x32x16_bf16(kf[4],qr[2],C0,0,0,0),   P1[2],P1[3],P1[4],P1[5],     pw2[0]=PKW(P1,0), pw2[1]=PKW(P1,2), pw2); \
    VRD(6); SBAR(); GAPA(C1=__builtin_amdgcn_mfma_f32_32x32x16_bf16(kf[5],qr[2],C1,0,0,0),   P1[6],P1[7],P1[8],P1[9],     pw2[2]=PKW(P1,4), pw2[3]=PKW(P1,6), pw2); \
    VRD(3); SBAR(); GAPA(C0=__builtin_amdgcn_mfma_f32_32x32x16_bf16(kf[6],qr[3],C0,0,0,0),   P1[10],P1[11],P1[12],P1[13], pw3[0]=PKW(P1,8), pw3[1]=PKW(P1,10), pw3); \
    VRD(7); SBAR(); GAPA(C1=__builtin_amdgcn_mfma_f32_32x32x16_bf16(kf[7],qr[3],C1,0,0,0),   P1[14],P1[15],0.f,0.f,       pw3[2]=PKW(P1,12),pw3[3]=PKW(P1,14), pw3); \
    l_reg+=sacc; \
    if(GK){DMA_K((t)+3,sl_cur);} if(GV){DMA_V((t)+1,sl_next);} \
    CMASK(C0,C1,t); \
    { float a=MX3(C0[0],C0[1],C1[0]),b=MX3(C0[2],C0[3],C1[1]); a=MX3(a,C1[2],C1[3]); \
      _Pragma("unroll") for(int r=4;r<16;r+=4){a=MX3(a,C0[r],C0[r+1]);b=MX3(b,C0[r+2],C0[r+3]);a=MX3(a,C1[r],C1[r+1]);b=MX3(b,C1[r+2],C1[r+3]);} \
      float rm=__builtin_fmaxf(a,b); { auto rr=__builtin_amdgcn_permlane32_swap(__float_as_uint(rm),__float_as_uint(rm),false,false); rm=__builtin_fmaxf(__uint_as_float(rr[0]),__uint_as_float(rr[1])); } \
      resc=false; \
      if(__builtin_expect(__any(rm>(float)THRL),0)){ const float dl=__builtin_fmaxf(rm,0.f); mhat+=dl; \
        _Pragma("unroll") for(int r=0;r<16;++r){C0[r]-=dl;C1[r]-=dl;} \
        _Pragma("unroll") for(int r=0;r<16;++r)negm[r]=-mhat; asm volatile("":"+v"(negm)); \
        const float f=__builtin_amdgcn_exp2f(-dl); l_reg*=f; if(hi==0)wsf[r32]=f; resc=true; } } \
    SBAR(); \
    GAPB(o[0]=__builtin_amdgcn_mfma_f32_32x32x16_bf16(PAF(0),VFR(0),o[0],0,0,0), C0,0); \
    GAPB(o[1]=__builtin_amdgcn_mfma_f32_32x32x16_bf16(PAF(0),VFR(4),o[1],0,0,0), C0,4); \
    KRD(GL,0); GAPB(o[0]=__builtin_amdgcn_mfma_f32_32x32x16_bf16(PAF(1),VFR(1),o[0],0,0,0), C0,8); \
    KRD(GL,1); GAPB(o[1]=__builtin_amdgcn_mfma_f32_32x32x16_bf16(PAF(1),VFR(5),o[1],0,0,0), C0,12); \
    KRD(GL,2); GAPB(o[0]=__builtin_amdgcn_mfma_f32_32x32x16_bf16(PAF(2),VFR(2),o[0],0,0,0), C1,0); \
    KRD(GL,3); GAPB(o[1]=__builtin_amdgcn_mfma_f32_32x32x16_bf16(PAF(2),VFR(6),o[1],0,0,0), C1,4); \
    GAPB(o[0]=__builtin_amdgcn_mfma_f32_32x32x16_bf16(PAF(3),VFR(3),o[0],0,0,0), C1,8); \
    GAPB(o[1]=__builtin_amdgcn_mfma_f32_32x32x16_bf16(PAF(3),VFR(7),o[1],0,0,0), C1,12); \
    }while(0)
  int t=1;
  #undef CMASK
  #define CMASK(P0,P1,t) do{}while(0)
  for(;t+5<NT;t+=2){
    STEP(pB0,pB1,pA0,pA1,t,true,true,true);     WAIT_BAR(2); RESC(); ROT();
    STEP(pA0,pA1,pB0,pB1,t+1,true,true,true);   WAIT_BAR(2); RESC(); ROT();
  }
  #undef CMASK
  #define CMASK(P0,P1,t) do{int jb_=(t)-(NT-4); if(jb_>=0)cmask(P0,P1,jb_,qrel,hi);}while(0)
  #define ENDW(tt) do{ if((tt)+3<NT){WAIT_BAR(2);} else if((tt)+2<NT){WAIT_BAR(1);} else {WAIT_BAR(0);} }while(0)
  for(;t+1<NT;t+=2){
    STEP(pB0,pB1,pA0,pA1,t,(t+3<NT),(t+1<NT),(t+1<NT));       ENDW(t);   RESC(); ROT();
    STEP(pA0,pA1,pB0,pB1,t+1,(t+4<NT),(t+2<NT),(t+2<NT));     ENDW(t+1); RESC(); ROT();
  }
  STEP(pB0,pB1,pA0,pA1,NT-1,false,false,false); RESC();
  { float sacc=pB0[0]+pB0[1]; _Pragma("unroll") for(int r=2;r<16;++r)sacc+=pB0[r]; _Pragma("unroll") for(int r=0;r<16;++r)sacc+=pB1[r]; l_reg+=sacc;
    pw0=(u32x4){PKW(pB0,0),PKW(pB0,2),PKW(pB0,4),PKW(pB0,6)};pw1=(u32x4){PKW(pB0,8),PKW(pB0,10),PKW(pB0,12),PKW(pB0,14)};pw2=(u32x4){PKW(pB1,0),PKW(pB1,2),PKW(pB1,4),PKW(pB1,6)};pw3=(u32x4){PKW(pB1,8),PKW(pB1,10),PKW(pB1,12),PKW(pB1,14)};
    SBAR(); pv(o,vb0+sl_cur,PAF(0),PAF(1),PAF(2),PAF(3)); }
  #undef PKW
  #undef PAF
  #undef VFR
  #undef PIN
  #undef MX3
  #undef GAPA
  #undef GAPB
  #undef EX
  #undef VRD
  #undef KRD
  #undef STEP
  #undef ENDW
  {auto rr=__builtin_amdgcn_permlane32_swap(__float_as_uint(l_reg),__float_as_uint(l_reg),false,false);l_reg=__uint_as_float(rr[0])+__uint_as_float(rr[1]);}
  if(hi==0)wsf[32+r32]=l_reg;asm volatile("s_waitcnt lgkmcnt(0)":::"memory");
  float rli[16];
  #pragma unroll
  for(int r=0;r<16;++r)rli[r]=__builtin_amdgcn_rcpf(wsf[32+crow(r,hi)]);
  bf16*Ow=O+(rowbase+q0+wid*QBLK)*PITO;
  { bf16*stg=(bf16*)(shm+LDS_OST)+wid*2048;
    #pragma unroll
    for(int r=0;r<16;++r){const int orow=crow(r,hi);
      #pragma unroll
      for(int d0=0;d0<2;++d0)stg[orow*64+d0*32+r32]=__float2bfloat16(o[d0][r]*rli[r]);}
    asm volatile("s_waitcnt lgkmcnt(0)":::"memory");
    #pragma unroll
    for(int i=0;i<4;++i){const int row=i*8+(lane>>3),ch=lane&7; const u32x4 v=*(const u32x4*)(stg+row*64+ch*8); ATTN_STORE16(Ow+(long)row*PITO+ch*8,v);} }
  asm volatile("s_waitcnt lgkmcnt(0)\n\ts_barrier":::"memory");
  #undef DMA_K
  #undef DMA_V
  #undef CMASK
  #undef START
  #undef RESC
  #undef ROT
}
constexpr int ATTN_LDS_BYTES=LDS_BYTES;
#undef SBAR
#undef WAIT_BAR
}

namespace cg = cooperative_groups;
typedef unsigned short bf16_t;
typedef float f32x4 __attribute__((ext_vector_type(4)));
typedef float f32x16 __attribute__((ext_vector_type(16)));
typedef unsigned u32x4 __attribute__((ext_vector_type(4)));
typedef unsigned u32x2 __attribute__((ext_vector_type(2)));
typedef short bf16x8 __attribute__((ext_vector_type(8)));
#define LAS3 __attribute__((address_space(3)))

constexpr int T_ = 32768, DM_ = 1024, SEQ_ = 4096, DFF_ = 2816;
constexpr int NTHR = 512;
constexpr int LDS_BYTES = 147456;
constexpr size_t MiB_ = 1u << 20;
constexpr size_t WS_MOD = 0, WS_COS = 1 * MiB_, WS_SIN = 2 * MiB_, WS_BAR = 3 * MiB_;
constexpr size_t WS_WIN = 4 * MiB_, WS_WOUT = 11 * MiB_, WS_FIN = 13 * MiB_, WS_FOUT = 24 * MiB_;
constexpr size_t WS_A = 32 * MiB_, WS_X2 = 96 * MiB_, WS_ST = 160 * MiB_, WS_TOT = 224 * MiB_, WS_R1 = 226 * MiB_, WS_BIAS = 450 * MiB_, WS_ROWSS = 452 * MiB_, WS_FOUT2 = 454 * MiB_, WS_END = 460 * MiB_;
constexpr int BIAS_L = 8 * (3584 + 5632);
constexpr size_t WS_HP = WS_ST, WS_HU = WS_ST + 12 * MiB_, WS_HA = WS_ST + 24 * MiB_;
constexpr float LOG2E_ = 1.4426950408889634f;
constexpr float QSCALE_ = 0.125f * 1.4426950408889634f;

struct Params {
    const float* x; const float* c; const int* positions; const float* mod_w; const float* mod_b; const float* norm_mix_w; const float* norm_ffn_w;
    const float* ev_w_in; const float* gla_gate_w; const float* gla_gate_b; const float* gla_norm_w; const float* swa_sinks; const float* ev_w_out;
    const float* od_w_in; const float* diff_lambda; const float* diff_norm_w; const float* hgrn_lb_logits; const float* hgrn_norm_w; const float* od_w_out;
    const float* ffn_w_in; const float* ffn_conv_w; const float* ffn_conv_b; const float* ffn_w_out; const float* final_norm_w;
    float* out; unsigned char* ws; unsigned long long pad[6];
};

__device__ __forceinline__ unsigned pk2(float lo, float hi) {
    typedef float f32x2_t __attribute__((ext_vector_type(2))); typedef __bf16 bf16x2_t __attribute__((ext_vector_type(2)));
    f32x2_t v = {lo, hi}; bf16x2_t b = __builtin_convertvector(v, bf16x2_t); return __builtin_bit_cast(unsigned, b);
}
__device__ __forceinline__ float bflo(unsigned u) { return __uint_as_float(u << 16); }
__device__ __forceinline__ float bfhi(unsigned u) { return __uint_as_float(u & 0xffff0000u); }
__device__ __forceinline__ float sigmoidf_(float x) { return __builtin_amdgcn_rcpf(1.f + __expf(-x)); }
__device__ __forceinline__ float siluf_(float x) { return x * __builtin_amdgcn_rcpf(1.f + __expf(-x)); }
__device__ __forceinline__ float wave_sum(float v) {
#pragma unroll
    for (int o = 1; o < 64; o <<= 1) v += __shfl_xor(v, o);
    return v;
}
__device__ __forceinline__ int crow_(int r, int hi) { return (r & 3) + 8 * (r >> 2) + 4 * hi; }

namespace pg8 {
struct EpiProj {
    static constexpr bool PERM = true, AFTER_DRAIN = false;
    bf16_t* O; int ldc; unsigned ropemask; unsigned scalemask; float scale; const float* cs; const float* sn; const float* rowss; const float* bias;
    __device__ __forceinline__ void operator()(const f32x4 (&acc)[2][2][4][2], const Unit& u, int, int, int, int) const {
        const int t_ = otid_(), l_ = t_ & 63, fr = l_ & 15, fq = l_ >> 4, wid_ = __builtin_amdgcn_readfirstlane(t_ >> 6), wr = wid_ >> 2, wc = wid_ & 3;
        const int row0 = u.pm * BM + wr * 64 + fr; const int col0 = u.pn * BM + wc * 32 + 8 * fq;
        float rs[2][4];
#pragma unroll
        for (int ai = 0; ai < 2; ++ai)
#pragma unroll
            for (int m = 0; m < 4; ++m) rs[ai][m] = rsqrtf(rowss[row0 + ai * HALF + m * 16] * (1.f / 1024.f) + 1e-6f);
        const float* bp = bias + (size_t)((u.pm * BM) >> 12) * ldc + col0;
#pragma unroll
        for (int bj = 0; bj < 2; ++bj) {
            const f32x4 bv0 = *(const f32x4*)(bp + bj * HALF), bv1 = *(const f32x4*)(bp + bj * HALF + 4);
            const int grp = u.pn * 2 + bj;
            const bool rope = ((ropemask >> grp) & 1u) && ((wc & 1) == 0);
            const float sc = ((scalemask >> grp) & 1u) ? scale : 1.f;
#pragma unroll
            for (int ai = 0; ai < 2; ++ai)
#pragma unroll
                for (int m = 0; m < 4; ++m) {
                    const int row = row0 + ai * HALF + m * 16;
                    f32x4 v0 = acc[ai][bj][m][0] * rs[ai][m] + bv0, v1 = acc[ai][bj][m][1] * rs[ai][m] + bv1;
                    if (rope) {
                        const f32x4 c0 = *(const f32x4*)(cs + (size_t)row * 8), c1 = *(const f32x4*)(cs + (size_t)row * 8 + 4);
                        const f32x4 s0 = *(const f32x4*)(sn + (size_t)row * 8), s1 = *(const f32x4*)(sn + (size_t)row * 8 + 4);
                        const float sg = (fq == 0) ? -1.f : 1.f;
#pragma unroll
                        for (int e = 0; e < 4; ++e) {
                            const float p0 = __shfl_xor(v0[e], 16), p1 = __shfl_xor(v1[e], 16);
                            const float r0 = v0[e] * c0[e] + sg * p0 * s0[e], r1 = v1[e] * c1[e] + sg * p1 * s1[e];
                            if (fq < 2) { v0[e] = r0; v1[e] = r1; }
                        }
                    }
                    v0 = v0 * sc; v1 = v1 * sc;
                    u32x4 w; w.x = pk2(v0[0], v0[1]); w.y = pk2(v0[2], v0[3]); w.z = pk2(v1[0], v1[1]); w.w = pk2(v1[2], v1[3]);
                    *(u32x4*)(O + (size_t)row * ldc + col0 + bj * HALF) = w;
                    asm volatile("" ::: "memory");
                }
        }
    }
};
typedef _Float16 h16x2 __attribute__((ext_vector_type(2)));
__device__ __forceinline__ unsigned pkh2(float lo, float hi) { typedef float f32x2_t __attribute__((ext_vector_type(2))); f32x2_t v = {lo, hi}; return __builtin_bit_cast(unsigned, __builtin_convertvector(v, h16x2)); }
__device__ __forceinline__ f32x4 unpkh4(unsigned w0, unsigned w1) { const h16x2 a = __builtin_bit_cast(h16x2, w0), b = __builtin_bit_cast(h16x2, w1); return (f32x4){(float)a[0], (float)a[1], (float)b[0], (float)b[1]}; }
struct EpiRes {
    static constexpr bool PERM = true, AFTER_DRAIN = false;
    const void* xin; void* xout; int inf32, outf32; const float* gate;
    bf16_t* Aout; const float* nw; const float* sc; float* rowss;
    __device__ __forceinline__ void operator()(const f32x4 (&acc)[2][2][4][2], const Unit& u, int, int, int, int) const {
        const int t_ = otid_(), l_ = t_ & 63, fr = l_ & 15, fq = l_ >> 4, wid_ = __builtin_amdgcn_readfirstlane(t_ >> 6), wr = wid_ >> 2, wc = wid_ & 3;
        const int col0 = u.pn * BM + wc * 32 + 8 * fq;
        const size_t boff = (size_t)((u.pm * BM) >> 12) * 6144 + col0;
        f32x4 gv[2][2];
#pragma unroll
        for (int bj = 0; bj < 2; ++bj)
#pragma unroll
            for (int n = 0; n < 2; ++n) gv[bj][n] = *(const f32x4*)(gate + boff + bj * HALF + n * 4);
        const int rowb = u.pm * BM + wr * 64 + fr;
        const unsigned eo0 = (unsigned)rowb * 1024u + (unsigned)col0;
        const char* xi = (const char*)xin; char* xo = (char*)xout; char* ao = (char*)Aout;
#pragma unroll
        for (int grp = 0; grp < 8; ++grp) {
            const int ai = grp >> 2, m = grp & 3;
            const unsigned eo = eo0 + (unsigned)(ai * HALF + m * 16) * 1024u;
            float ss = 0.f;
#pragma unroll
            for (int bj = 0; bj < 2; ++bj) {
                const unsigned e2 = eo + (unsigned)(bj * HALF);
                f32x4 x0, x1;
                if (inf32) { x0 = *(const f32x4*)(xi + e2 * 4u); x1 = *(const f32x4*)(xi + e2 * 4u + 16u); }
                else { const u32x4 h = *(const u32x4*)(xi + e2 * 2u); x0 = unpkh4(h.x, h.y); x1 = unpkh4(h.z, h.w); }
                const f32x4 xn0 = x0 + gv[bj][0] * acc[ai][bj][m][0], xn1 = x1 + gv[bj][1] * acc[ai][bj][m][1];
                if (outf32) { *(f32x4*)(xo + e2 * 4u) = xn0; *(f32x4*)(xo + e2 * 4u + 16u) = xn1; }
                else { u32x4 h; h.x = pkh2(xn0[0], xn0[1]); h.y = pkh2(xn0[2], xn0[3]); h.z = pkh2(xn1[0], xn1[1]); h.w = pkh2(xn1[2], xn1[3]); *(u32x4*)(xo + e2 * 2u) = h; }
                if (Aout) {
                    ss += ((xn0[0] * xn0[0] + xn0[1] * xn0[1]) + (xn0[2] * xn0[2] + xn0[3] * xn0[3])) + ((xn1[0] * xn1[0] + xn1[1] * xn1[1]) + (xn1[2] * xn1[2] + xn1[3] * xn1[3]));
                    const f32x4 a0 = xn0 * (*(const f32x4*)(nw + col0 + bj * HALF) * (*(const f32x4*)(sc + boff + bj * HALF) + 1.f));
                    const f32x4 a1 = xn1 * (*(const f32x4*)(nw + col0 + bj * HALF + 4) * (*(const f32x4*)(sc + boff + bj * HALF + 4) + 1.f));
                    u32x4 q; q.x = pk2(a0[0], a0[1]); q.y = pk2(a0[2], a0[3]); q.z = pk2(a1[0], a1[1]); q.w = pk2(a1[2], a1[3]);
                    *(u32x4*)(ao + e2 * 2u) = q;
                }
            }
            if (Aout) {
                ss += __shfl_xor(ss, 16); ss += __shfl_xor(ss, 32);
                if (fq == 0) atomicAdd(rowss + rowb + ai * HALF + m * 16, ss);
            }
            asm volatile("" ::: "memory");
        }
    }
};
struct EpiFfn {
    static constexpr bool PERM = true, AFTER_DRAIN = false;
    bf16_t* G; float* HP; float* HU; float* HA; const float* cw; const float* cb; const float* rowss; const float* bias;
    __device__ __forceinline__ void operator()(const f32x4 (&acc)[2][2][4][2], const Unit& u, int, int, int, int) const {
        const int t_ = otid_(), l_ = t_ & 63, fr = l_ & 15, fq = l_ >> 4, wid_ = __builtin_amdgcn_readfirstlane(t_ >> 6), wr = wid_ >> 2, wc = wid_ & 3;
        const int ch0 = u.pn * 128 + wc * 32 + 8 * fq;
        f32x4 w0[2], w1[2], w2[2], bb[2];
#pragma unroll
        for (int n = 0; n < 2; ++n) { w0[n] = *(const f32x4*)(cw + ch0 + 4 * n); w1[n] = *(const f32x4*)(cw + DFF_ + ch0 + 4 * n); w2[n] = *(const f32x4*)(cw + 2 * DFF_ + ch0 + 4 * n); bb[n] = *(const f32x4*)(cb + ch0 + 4 * n); }
        const int lane = fr + 16 * fq;
        const int src1 = (lane & ~15) | ((fr + 15) & 15), src2 = (lane & ~15) | ((fr + 14) & 15);
        const float* bp = bias + (size_t)((u.pm * BM) >> 12) * 5632 + u.pn * BM + wc * 32 + 8 * fq;
        f32x4 ba[2], bu[2];
#pragma unroll
        for (int n = 0; n < 2; ++n) { ba[n] = *(const f32x4*)(bp + 4 * n); bu[n] = *(const f32x4*)(bp + HALF + 4 * n); }
#pragma unroll
        for (int ai = 0; ai < 2; ++ai) {
            const int seg = u.pm * 4 + ai * 2 + wr;
            f32x4 aprev[2]; aprev[0] = (f32x4){0.f, 0.f, 0.f, 0.f}; aprev[1] = (f32x4){0.f, 0.f, 0.f, 0.f};
#pragma unroll
            for (int m = 0; m < 4; ++m) {
                const int row = u.pm * BM + ai * HALF + wr * 64 + m * 16 + fr;
                const float rs = rsqrtf(rowss[row] * (1.f / 1024.f) + 1e-6f);
                f32x4 val[2], acur[2];
#pragma unroll
                for (int n = 0; n < 2; ++n) {
                    const f32x4 a = acc[ai][0][m][n] * rs + ba[n];
                    acur[n] = a;
                    const f32x4 ap = aprev[n];
#pragma unroll
                    for (int e = 0; e < 4; ++e) {
                        const float t1 = (fr == 15) ? ap[e] : a[e];
                        const float t2 = (fr >= 14) ? ap[e] : a[e];
                        const float p1 = __shfl(t1, src1), p2 = __shfl(t2, src2);
                        val[n][e] = w2[n][e] * a[e] + w1[n][e] * p1 + w0[n][e] * p2 + bb[n][e];
                    }
                }
                const f32x4 u0 = acc[ai][1][m][0] * rs + bu[0], u1 = acc[ai][1][m][1] * rs + bu[1];
                f32x4 g0, g1;
#pragma unroll
                for (int e = 0; e < 4; ++e) { g0[e] = siluf_(val[0][e]) * u0[e]; g1[e] = siluf_(val[1][e]) * u1[e]; }
                u32x4 w; w.x = pk2(g0[0], g0[1]); w.y = pk2(g0[2], g0[3]); w.z = pk2(g1[0], g1[1]); w.w = pk2(g1[2], g1[3]);
                *(u32x4*)(G + (size_t)row * DFF_ + ch0) = w;
                if (m == 0 && fr < 2) {
                    const size_t ho = (size_t)(seg * 2 + fr) * DFF_ + ch0;
                    *(f32x4*)(HP + ho) = val[0]; *(f32x4*)(HP + ho + 4) = val[1];
                    *(f32x4*)(HU + ho) = u0; *(f32x4*)(HU + ho + 4) = u1;
                }
                if (m == 3 && fr >= 14) {
                    const size_t ho = (size_t)(seg * 2 + (fr - 14)) * DFF_ + ch0;
                    *(f32x4*)(HA + ho) = acur[0]; *(f32x4*)(HA + ho + 4) = acur[1];
                }
                aprev[0] = acur[0]; aprev[1] = acur[1];
                asm volatile("" ::: "memory");
            }
        }
    }
};
}

struct Ctx { Params p; unsigned char* lds; int tid, lane, wave, gw, ngw; };

__device__ __forceinline__ void phase_prologue(const Ctx& C) {
    const Params& p = C.p;
    float* cact = (float*)C.lds;
    float* red = (float*)(C.lds + 32768);
    float* mod = (float*)(p.ws + WS_MOD);
    const int tid = C.tid;
    for (int i = tid; i < 8192; i += NTHR) { const float c = p.c[i]; cact[i] = c / (1.f + __expf(-c)); }
    __syncthreads();
    const int col = tid & 63, kp = tid >> 6;
    for (int g = blockIdx.x; g < 384; g += gridDim.x) {
        const int l = g / 96, j = (g % 96) * 64 + col;
        const float* w = p.mod_w + (size_t)l * 1024 * 6144 + (size_t)(kp * 128) * 6144 + j;
        float a0 = 0.f, a1 = 0.f, a2 = 0.f, a3 = 0.f, a4 = 0.f, a5 = 0.f, a6 = 0.f, a7 = 0.f;
        const float* ca = cact + kp * 128;
#pragma unroll 8
        for (int k = 0; k < 128; ++k) {
            const float wv = w[(size_t)k * 6144];
            a0 += ca[k] * wv; a1 += ca[1024 + k] * wv; a2 += ca[2048 + k] * wv; a3 += ca[3072 + k] * wv;
            a4 += ca[4096 + k] * wv; a5 += ca[5120 + k] * wv; a6 += ca[6144 + k] * wv; a7 += ca[7168 + k] * wv;
        }
        float* r = red + (kp * 8) * 64 + col;
        r[0] = a0; r[64] = a1; r[128] = a2; r[192] = a3; r[256] = a4; r[320] = a5; r[384] = a6; r[448] = a7;
        __syncthreads();
        { const int b = tid >> 6; float s = 0.f;
#pragma unroll
          for (int kk = 0; kk < 8; ++kk) s += red[(kk * 8 + b) * 64 + col];
          mod[(size_t)(l * 8 + b) * 6144 + j] = s + p.mod_b[l * 6144 + j]; }
        __syncthreads();
    }
    {
        u32x4* zb = (u32x4*)(p.ws + WS_BIAS); const int nzb = 4 * BIAS_L * 4 / 16;
        for (int i = blockIdx.x * NTHR + tid; i < nzb; i += gridDim.x * NTHR) zb[i] = (u32x4){0u, 0u, 0u, 0u};
        u32x4* zr = (u32x4*)(p.ws + WS_ROWSS);
        for (int i = blockIdx.x * NTHR + tid; i < 8 * T_ * 4 / 16; i += gridDim.x * NTHR) zr[i] = (u32x4){0u, 0u, 0u, 0u};
    }
    float* cs = (float*)(p.ws + WS_COS); float* sn = (float*)(p.ws + WS_SIN);
    const float invf[8] = {1.0f, 0.1939227432012558f, 0.03760603070259094f, 0.007292664609849453f, 0.0014142135623842478f, 0.00027424818836152554f, 5.3182957344688475e-05f, 1.0313385246263351e-05f};
    for (int r = blockIdx.x * NTHR + tid; r < T_; r += gridDim.x * NTHR) {
        const float pos = (float)p.positions[r];
        f32x4 c4[2], s4[2];
#pragma unroll
        for (int i = 0; i < 8; ++i) {
            const float ang = pos * invf[i];
            const double xr = (double)ang * 0.15915494309189535;
            const float f = (float)(xr - rint(xr));
            c4[i >> 2][i & 3] = __builtin_amdgcn_cosf(f); s4[i >> 2][i & 3] = __builtin_amdgcn_sinf(f);
        }
        *(f32x4*)(cs + (size_t)r * 8) = c4[0]; *(f32x4*)(cs + (size_t)r * 8 + 4) = c4[1];
        *(f32x4*)(sn + (size_t)r * 8) = s4[0]; *(f32x4*)(sn + (size_t)r * 8 + 4) = s4[1];
    }
}

__device__ __forceinline__ void tr_item(const float* W, int Nsrc, int srccol0, bf16_t* WT, int K, int dstrow0, int k0, float* scr, int lane) {
    float wv[32];
#pragma unroll
    for (int i = 0; i < 32; ++i) wv[i] = W[(size_t)(k0 + 2 * i + (lane >> 5)) * Nsrc + srccol0 + (lane & 31)];
#pragma unroll
    for (int i = 0; i < 32; ++i) scr[(2 * i + (lane >> 5)) * 33 + (lane & 31)] = wv[i];
    asm volatile("s_waitcnt lgkmcnt(0)" ::: "memory");
    const int c = lane & 7;
#pragma unroll
    for (int j = 0; j < 4; ++j) { const int n = (lane >> 3) + 8 * j; const float* s = scr + (8 * c) * 33 + n;
        u32x4 o; o.x = pk2(s[0 * 33], s[1 * 33]); o.y = pk2(s[2 * 33], s[3 * 33]); o.z = pk2(s[4 * 33], s[5 * 33]); o.w = pk2(s[6 * 33], s[7 * 33]);
        *(u32x4*)(WT + (size_t)(dstrow0 + n) * K + k0 + 8 * c) = o; }
    asm volatile("s_waitcnt lgkmcnt(0)" ::: "memory");
}
__device__ __forceinline__ void phase_convert(const Ctx& C, int l, bool do_bias = true) {
    const Params& p = C.p; const int j = l >> 1; const bool even = !(l & 1);
    float* scr = (float*)(C.lds + C.wave * 8704);
    bf16_t* WIN = (bf16_t*)(p.ws + WS_WIN); bf16_t* WOUT = (bf16_t*)(p.ws + WS_WOUT); bf16_t* FIN = (bf16_t*)(p.ws + WS_FIN); bf16_t* FOUT = (bf16_t*)(p.ws + ((l & 1) ? WS_FOUT2 : WS_FOUT));
    const int nA = even ? 80 : 112;
    const int IA = 16 * nA, IB = 16 * 32, IC = 16 * 176, ID = 44 * 32;
    const float* win = even ? p.ev_w_in + (size_t)j * 1024 * 2320 : p.od_w_in + (size_t)j * 1024 * 3584;
    const float* wout = even ? p.ev_w_out + (size_t)j * 1024 * 1024 : p.od_w_out + (size_t)j * 1024 * 1024;
    const float* fin = p.ffn_w_in + (size_t)l * 1024 * 5632; const float* fout = p.ffn_w_out + (size_t)l * 2816 * 1024;
    for (int it = C.gw; it < IA + IB + IC + ID; it += C.ngw) {
        int r = it;
        if (r < IA) { const int kb = r / nA, nb = r % nA, n0 = nb * 32; int sc = n0;
            if (even) { if (n0 >= 512 && n0 < 768) continue; if (n0 >= 1792) sc = n0 - 240; else if (n0 >= 768) sc = n0 - 256; }
            tr_item(win, even ? 2320 : 3584, sc, WIN, 1024, n0, kb * 64, scr, C.lane); continue; }
        r -= IA;
        if (r < IB) { const int kb = r / 32, nb = r % 32; tr_item(wout, 1024, nb * 32, WOUT, 1024, nb * 32, kb * 64, scr, C.lane); continue; }
        r -= IB;
        if (r < IC) { const int kb = r / 176, nb = r % 176, n0 = nb * 32; const int pn = n0 >> 8, jj = n0 & 255;
            const int sc = (jj < 128) ? pn * 128 + jj : 2816 + pn * 128 + (jj - 128);
            tr_item(fin, 5632, sc, FIN, 1024, n0, kb * 64, scr, C.lane); continue; }
        r -= IC;
        { const int kb = r / 32, nb = r % 32; tr_item(fout, 1024, nb * 32, FOUT, 2816, nb * 32, kb * 64, scr, C.lane); }
    }
    if (do_bias) {
        float* shl = (float*)(C.lds + 69632);
        const float* modl = (const float*)(p.ws + WS_MOD) + (size_t)l * 8 * 6144;
        __syncthreads();
        for (int i2 = C.tid; i2 < 2 * 8192; i2 += NTHR) { const int which = i2 >> 13, k = (i2 >> 3) & 1023, b = i2 & 7; shl[i2] = modl[(size_t)b * 6144 + (which ? 3072 : 0) + k]; }
        __syncthreads();
        float* bias_in = (float*)(p.ws + WS_BIAS) + (size_t)l * BIAS_L; float* bias_ff = bias_in + 8 * 3584;
        const int Nin = even ? 2560 : 3584, Nsrc = even ? 2320 : 3584;
        const float* gwp = p.gla_gate_w + (size_t)j * 16 * 256;
        for (int u = blockIdx.x * NTHR + C.tid; u < (Nin + 5632) * 16; u += gridDim.x * NTHR) {
            const bool ff = u >= Nin * 16; const int uu = ff ? u - Nin * 16 : u, N = ff ? 5632 : Nin, n = uu % N, kp = uu / N;
            float a[8];
#pragma unroll
            for (int b = 0; b < 8; ++b) a[b] = 0.f;
            const float* shp = shl + (ff ? 8192 : 0) + kp * 64 * 8;
            if (!ff && even && n >= 512 && n < 768) {
                float g[16];
#pragma unroll
                for (int r = 0; r < 16; ++r) g[r] = gwp[r * 256 + (n - 512)];
                for (int k = 0; k < 64; ++k) {
                    const float* wr = win + (size_t)(kp * 64 + k) * 2320 + 1536;
                    float wv = 0.f;
#pragma unroll
                    for (int r = 0; r < 16; ++r) wv += wr[r] * g[r];
                    const f32x4 s0 = *(const f32x4*)(shp + k * 8), s1 = *(const f32x4*)(shp + k * 8 + 4);
                    a[0] += s0[0] * wv; a[1] += s0[1] * wv; a[2] += s0[2] * wv; a[3] += s0[3] * wv; a[4] += s1[0] * wv; a[5] += s1[1] * wv; a[6] += s1[2] * wv; a[7] += s1[3] * wv;
                }
            } else {
                int sc; const float* W; int Ns;
                if (ff) { const int pn = n >> 8, jj = n & 255; sc = (jj < 128) ? pn * 128 + jj : 2816 + pn * 128 + (jj - 128); W = fin; Ns = 5632; }
                else { sc = n; if (even) { if (n >= 1792) sc = n - 240; else if (n >= 768) sc = n - 256; } W = win; Ns = Nsrc; }
                const float* wp = W + (size_t)(kp * 64) * Ns + sc;
#pragma unroll 8
                for (int k = 0; k < 64; ++k) {
                    const float wv = wp[(size_t)k * Ns];
                    const f32x4 s0 = *(const f32x4*)(shp + k * 8), s1 = *(const f32x4*)(shp + k * 8 + 4);
                    a[0] += s0[0] * wv; a[1] += s0[1] * wv; a[2] += s0[2] * wv; a[3] += s0[3] * wv; a[4] += s1[0] * wv; a[5] += s1[1] * wv; a[6] += s1[2] * wv; a[7] += s1[3] * wv;
                }
            }
            float* bo = (ff ? bias_ff : bias_in) + n;
#pragma unroll
            for (int b = 0; b < 8; ++b) atomicAdd(bo + (size_t)b * N, a[b]);
        }
    }
    if (even) {
        const float* gw = p.gla_gate_w + (size_t)j * 16 * 256;
        for (int u = blockIdx.x * NTHR + C.tid; u < 256 * 128; u += gridDim.x * NTHR) {
            const int k8 = u & 127, n = u >> 7;
            float g[16];
#pragma unroll
            for (int r = 0; r < 16; ++r) g[r] = gw[r * 256 + n];
            float o[8];
#pragma unroll
            for (int e = 0; e < 8; ++e) {
                const float* wr = win + (size_t)(k8 * 8 + e) * 2320 + 1536;
                const f32x4 a0 = *(const f32x4*)wr, a1 = *(const f32x4*)(wr + 4), a2 = *(const f32x4*)(wr + 8), a3 = *(const f32x4*)(wr + 12);
                o[e] = a0[0] * g[0] + a0[1] * g[1] + a0[2] * g[2] + a0[3] * g[3] + a1[0] * g[4] + a1[1] * g[5] + a1[2] * g[6] + a1[3] * g[7]
                     + a2[0] * g[8] + a2[1] * g[9] + a2[2] * g[10] + a2[3] * g[11] + a3[0] * g[12] + a3[1] * g[13] + a3[2] * g[14] + a3[3] * g[15];
            }
            u32x4 w; w.x = pk2(o[0], o[1]); w.y = pk2(o[2], o[3]); w.z = pk2(o[4], o[5]); w.w = pk2(o[6], o[7]);
            *(u32x4*)(WIN + (size_t)(512 + n) * 1024 + k8 * 8) = w;
        }
    }
}

__device__ __forceinline__ void phase_prep(const Ctx& C, const float* xin, const float* w, const float* modl, int scoff, bf16_t* out, float* rowss) {
    for (int row = C.gw; row < T_; row += C.ngw) {
        const f32x4* xr = (const f32x4*)(xin + (size_t)row * 1024) + C.lane;
        f32x4 v[4]; float ss = 0.f;
#pragma unroll
        for (int j = 0; j < 4; ++j) { v[j] = xr[64 * j]; ss += (v[j].x * v[j].x + v[j].y * v[j].y) + (v[j].z * v[j].z + v[j].w * v[j].w); }
        ss = wave_sum(ss);
        if (C.lane == 0) rowss[row] = ss;
        const float* mb = modl + (size_t)(row >> 12) * 6144;
        u32x2* o8 = (u32x2*)(out + (size_t)row * 1024) + C.lane;
#pragma unroll
        for (int j = 0; j < 4; ++j) {
            const int col = 4 * C.lane + 256 * j;
            const f32x4 w4 = *(const f32x4*)(w + col), sc = *(const f32x4*)(mb + scoff + col);
            const f32x4 y = v[j] * w4 * (sc + 1.f);
            u32x2 q; q.x = pk2(y.x, y.y); q.y = pk2(y.z, y.w); o8[64 * j] = q;
        }
    }
}
__device__ __forceinline__ void phase_final_norm(const Ctx& C, const void* xin  , float* out, const float* w) {
    for (int row = C.gw; row < T_; row += C.ngw) {
        const u32x2* xr = (const u32x2*)((const char*)xin + (size_t)row * 2048) + C.lane;
        f32x4* orow = (f32x4*)(out + (size_t)row * 1024) + C.lane;
        f32x4 v[4]; float ss = 0.f;
#pragma unroll
        for (int j = 0; j < 4; ++j) { const u32x2 h = xr[64 * j]; v[j] = pg8::unpkh4(h.x, h.y); ss += (v[j].x * v[j].x + v[j].y * v[j].y) + (v[j].z * v[j].z + v[j].w * v[j].w); }
        const float rs = rsqrtf(wave_sum(ss) * (1.f / 1024.f) + 1e-6f);
#pragma unroll
        for (int j = 0; j < 4; ++j) { const f32x4 w4 = *(const f32x4*)(w + 4 * C.lane + 256 * j); orow[64 * j] = (v[j] * rs) * w4; }
    }
}

__device__ __forceinline__ void phase_diff_combine(const Ctx& C, int l) {
    const Params& p = C.p; const int j = l >> 1;
    const float lam_init = 0.8f - 0.6f * expf(-0.3f * (float)l);
    const float* lv = p.diff_lambda + j * 256;
    const float s1 = wave_sum(lv[C.lane] * lv[64 + C.lane]), s2 = wave_sum(lv[128 + C.lane] * lv[192 + C.lane]);
    const float lam = expf(s1) - expf(s2) + lam_init;
    const bf16_t* X2 = (const bf16_t*)(p.ws + WS_X2); bf16_t* A = (bf16_t*)(p.ws + WS_A);
    const int head = C.lane >> 4, d0 = (C.lane & 15) * 8;
    const float* nw = p.diff_norm_w + j * 128 + d0;
    const f32x4 n0 = *(const f32x4*)nw, n1 = *(const f32x4*)(nw + 4);
    const float og = 1.f - lam_init;
    for (int row = C.gw; row < T_; row += C.ngw) {
        const bf16_t* src = X2 + (size_t)row * 1024 + head * 256 + d0;
        const u32x4 a = *(const u32x4*)src, b = *(const u32x4*)(src + 128);
        float od[8];
        od[0] = bflo(a.x) - lam * bflo(b.x); od[1] = bfhi(a.x) - lam * bfhi(b.x); od[2] = bflo(a.y) - lam * bflo(b.y); od[3] = bfhi(a.y) - lam * bfhi(b.y);
        od[4] = bflo(a.z) - lam * bflo(b.z); od[5] = bfhi(a.z) - lam * bfhi(b.z); od[6] = bflo(a.w) - lam * bflo(b.w); od[7] = bfhi(a.w) - lam * bfhi(b.w);
        float ss = 0.f;
#pragma unroll
        for (int e = 0; e < 8; ++e) ss += od[e] * od[e];
        ss += __shfl_xor(ss, 1); ss += __shfl_xor(ss, 2); ss += __shfl_xor(ss, 4); ss += __shfl_xor(ss, 8);
        const float rs = rsqrtf(ss * (1.f / 128.f) + 1e-6f) * og;
        u32x4 w; w.x = pk2(od[0] * rs * n0[0], od[1] * rs * n0[1]); w.y = pk2(od[2] * rs * n0[2], od[3] * rs * n0[3]);
        w.z = pk2(od[4] * rs * n1[0], od[5] * rs * n1[1]); w.w = pk2(od[6] * rs * n1[2], od[7] * rs * n1[3]);
        *(u32x4*)(A + (size_t)row * 1024 + head * 128 + d0) = w;
    }
}

__device__ __forceinline__ void phase_ffn_fixup(const Ctx& C, int l) {
    const Params& p = C.p;
    const float* HP = (const float*)(p.ws + WS_HP); const float* HU = (const float*)(p.ws + WS_HU); const float* HA = (const float*)(p.ws + WS_HA);
    bf16_t* G = (bf16_t*)(p.ws + WS_R1);
    const float* cw = p.ffn_conv_w + (size_t)l * 3 * DFF_;
    for (int u = blockIdx.x * NTHR + C.tid; u < 512 * 2 * 704; u += gridDim.x * NTHR) {
        const int c4 = u % 704, sj = u / 704, jj = sj & 1, seg = sj >> 1, ch = c4 * 4;
        const size_t ho = (size_t)sj * DFF_ + ch;
        f32x4 val = *(const f32x4*)(HP + ho); const f32x4 uu = *(const f32x4*)(HU + ho);
        if ((seg & 63) != 0) {
            const f32x4 am1 = *(const f32x4*)(HA + (size_t)((seg - 1) * 2 + 1) * DFF_ + ch), am2 = *(const f32x4*)(HA + (size_t)((seg - 1) * 2) * DFF_ + ch);
            const f32x4 w0 = *(const f32x4*)(cw + ch), w1 = *(const f32x4*)(cw + DFF_ + ch);
            if (jj == 0) val = val + w1 * am1 + w0 * am2; else val = val + w0 * am1;
        }
        u32x2 q; q.x = pk2(siluf_(val.x) * uu.x, siluf_(val.y) * uu.y); q.y = pk2(siluf_(val.z) * uu.z, siluf_(val.w) * uu.w);
        *(u32x2*)(G + (size_t)(seg * 64 + jj) * DFF_ + ch) = q;
    }
}

__device__ __forceinline__ void phase_swa(const Ctx& C, int l) {
    const Params& p = C.p;
    const bf16_t* proj = (const bf16_t*)(p.ws + WS_R1); bf16_t* A = (bf16_t*)(p.ws + WS_A);
    bf16_t* Ks = (bf16_t*)C.lds;
    bf16_t* Vt = (bf16_t*)(C.lds + 27648);
    const int tid = C.tid, lane = C.lane, wid = C.wave, r32 = lane & 31, hi = lane >> 5;
    const float* sinks = p.swa_sinks + (l >> 1) * 8;
    u32x4 kreg[3], vreg[3];
#define SWA_FETCH(uu) do { const int b_ = (uu) >> 7, kvh_ = ((uu) >> 6) & 1, q0_ = ((uu) & 63) * 64; const size_t rb_ = (size_t)b_ * SEQ_; \
        _Pragma("unroll") for (int i_ = 0; i_ < 3; ++i_) { const int c_ = tid + i_ * NTHR; \
            { const int kk_ = c_ >> 3, ch_ = c_ & 7, pl_ = q0_ - 128 + kk_; kreg[i_] = (u32x4){0u, 0u, 0u, 0u}; if (pl_ >= 0) kreg[i_] = *(const u32x4*)(proj + (rb_ + pl_) * 2560 + 2304 + kvh_ * 64 + ch_ * 8); } \
            { const int kk_ = c_ % 192, ch_ = c_ / 192, pl_ = q0_ - 128 + kk_; vreg[i_] = (u32x4){0u, 0u, 0u, 0u}; if (pl_ >= 0) vreg[i_] = *(const u32x4*)(proj + (rb_ + pl_) * 2560 + 2432 + kvh_ * 64 + ch_ * 8); } } } while (0)
    if ((int)blockIdx.x < 1024) SWA_FETCH((int)blockIdx.x);
    for (int u = blockIdx.x; u < 1024; u += gridDim.x) {
        const int b = u >> 7, kvh = (u >> 6) & 1, qb = u & 63, q0 = qb * 64; const size_t rowbase = (size_t)b * SEQ_;
#pragma unroll
        for (int i = 0; i < 3; ++i) {
            const int c = tid + i * NTHR;
            { const int kk = c >> 3, ch = c & 7; *(u32x4*)(Ks + kk * 72 + ch * 8) = kreg[i]; }
            { const int kk = c % 192, ch = c / 192; const u32x4 vv = vreg[i];
              bf16_t* vd = Vt + (ch * 8) * 200 + kk;
              vd[0] = (bf16_t)(vv.x & 0xffffu); vd[200] = (bf16_t)(vv.x >> 16); vd[400] = (bf16_t)(vv.y & 0xffffu); vd[600] = (bf16_t)(vv.y >> 16);
              vd[800] = (bf16_t)(vv.z & 0xffffu); vd[1000] = (bf16_t)(vv.z >> 16); vd[1200] = (bf16_t)(vv.w & 0xffffu); vd[1400] = (bf16_t)(vv.w >> 16); }
        }
        { const int nx = u + (int)gridDim.x; if (nx < 1024) SWA_FETCH(nx); }
        __syncthreads();
        const int g = wid >> 1, qh = kvh * 4 + g, qhalf = wid & 1, pq = q0 + 32 * qhalf + r32;
        const bf16_t* qsrc = proj + (rowbase + pq) * 2560 + 1792 + qh * 64;
        bf16x8 qr[4];
#pragma unroll
        for (int d0 = 0; d0 < 4; ++d0) qr[d0] = *(const bf16x8*)(qsrc + d0 * 16 + hi * 8);
        f32x16 s[5];
#pragma unroll
        for (int t = 0; t < 5; ++t) {
            f32x16 a = {};
#pragma unroll
            for (int d0 = 0; d0 < 4; ++d0) {
                const bf16x8 kf = *(const bf16x8*)(Ks + (32 * (qhalf + t) + r32) * 72 + d0 * 16 + hi * 8);
                a = __builtin_amdgcn_mfma_f32_32x32x16_bf16(kf, qr[d0], a, 0, 0, 0);
            }
            s[t] = a;
        }
        const float sink2 = sinks[qh] * LOG2E_;
        float mx = sink2;
#pragma unroll
        for (int t = 0; t < 5; ++t)
#pragma unroll
            for (int r = 0; r < 16; ++r) {
                const int pk = q0 - 128 + 32 * (qhalf + t) + crow_(r, hi);
                const bool valid = (pk >= 0) && (pk <= pq) && (pq - pk < 128);
                const float v = valid ? s[t][r] : -INFINITY; s[t][r] = v; mx = fmaxf(mx, v);
            }
        mx = fmaxf(mx, __shfl_xor(mx, 32));
        float sum = 0.f;
#pragma unroll
        for (int t = 0; t < 5; ++t)
#pragma unroll
            for (int r = 0; r < 16; ++r) { const float e = __builtin_amdgcn_exp2f(s[t][r] - mx); s[t][r] = e; sum += e; }
        sum += __shfl_xor(sum, 32);
        sum += __builtin_amdgcn_exp2f(sink2 - mx);
        const float inv = 1.f / sum;
        f32x16 o[2]; o[0] = f32x16{}; o[1] = f32x16{};
#pragma unroll
        for (int t = 0; t < 5; ++t)
#pragma unroll
            for (int ss = 0; ss < 2; ++ss) {
                u32x4 pw; pw.x = pk2(s[t][8 * ss + 0], s[t][8 * ss + 1]); pw.y = pk2(s[t][8 * ss + 2], s[t][8 * ss + 3]); pw.z = pk2(s[t][8 * ss + 4], s[t][8 * ss + 5]); pw.w = pk2(s[t][8 * ss + 6], s[t][8 * ss + 7]);
                const bf16x8 pf = __builtin_bit_cast(bf16x8, pw);
#pragma unroll
                for (int dt = 0; dt < 2; ++dt) {
                    const bf16_t* vp = Vt + (32 * dt + r32) * 200 + 32 * (qhalf + t) + 16 * ss + 4 * hi;
                    const u32x2 lo = *(const u32x2*)vp, h2 = *(const u32x2*)(vp + 8);
                    u32x4 vw; vw.x = lo.x; vw.y = lo.y; vw.z = h2.x; vw.w = h2.y;
                    o[dt] = __builtin_amdgcn_mfma_f32_32x32x16_bf16(__builtin_bit_cast(bf16x8, vw), pf, o[dt], 0, 0, 0);
                }
            }
        bf16_t* orow = A + (rowbase + pq) * 1024 + 512 + qh * 64;
#pragma unroll
        for (int dt = 0; dt < 2; ++dt)
#pragma unroll
            for (int g4 = 0; g4 < 4; ++g4) {
                u32x2 q; q.x = pk2(o[dt][4 * g4] * inv, o[dt][4 * g4 + 1] * inv); q.y = pk2(o[dt][4 * g4 + 2] * inv, o[dt][4 * g4 + 3] * inv);
                *(u32x2*)(orow + 32 * dt + 8 * g4 + 4 * hi) = q;
            }
        __syncthreads();
    }
}

template <int MODE> struct LaCfg {
    static constexpr int DK = MODE ? 128 : 64, LQ = DK + 8, LG = DK + 4, PITCH = MODE ? 3584 : 2560, NG = DK / 8;
    static constexpr int QCOL = MODE ? 1536 : 0, KCOL = MODE ? 0 : 256, ZCOL = MODE ? 2048 : 512, VCOL = MODE ? 2560 : 768, GCOL = MODE ? 3072 : 1280, OCOL = MODE ? 512 : 0;
    static constexpr int O_QB = 0, O_KB = O_QB + 64 * LQ * 2, O_GF = O_KB + 64 * LQ * 2, O_VT = O_GF + 64 * LG * 4, O_SC = O_VT + 128 * 72 * 2, O_QE = O_SC + 64 * 72 * 2,
                         O_KT = O_QE + 64 * LQ * 2  , O_SEG = O_KT + DK * 72 * 2, O_RED = O_SEG + 8 * 128 * 4, O_PAR = O_RED + 8 * 64 * 4, O_END = O_PAR + 128 * 4;
    static_assert(O_END <= LDS_BYTES, "LA LDS map");
};
__device__ __forceinline__ void unpack8(const u32x4 w, float (&f)[8]) { f[0] = bflo(w.x); f[1] = bfhi(w.x); f[2] = bflo(w.y); f[3] = bfhi(w.y); f[4] = bflo(w.z); f[5] = bfhi(w.z); f[6] = bflo(w.w); f[7] = bfhi(w.w); }
__device__ __forceinline__ u32x4 pack8(const float (&f)[8]) { u32x4 w; w.x = pk2(f[0], f[1]); w.y = pk2(f[2], f[3]); w.z = pk2(f[4], f[5]); w.w = pk2(f[6], f[7]); return w; }
__device__ __forceinline__ void ld8f(const float* p, float (&f)[8]) { const f32x4 a = *(const f32x4*)p, b = *(const f32x4*)(p + 4); f[0] = a[0]; f[1] = a[1]; f[2] = a[2]; f[3] = a[3]; f[4] = b[0]; f[5] = b[1]; f[6] = b[2]; f[7] = b[3]; }

template <int MODE> struct LaRaw { static constexpr int NI = 64 * LaCfg<MODE>::NG / NTHR; u32x4 z[NI], k[NI], q[NI], v[2]; };
template <int MODE, bool NEEDQ> __device__ __forceinline__ void la_fetch(const Ctx& C, int b, int h, int c, LaRaw<MODE>& R) {
    typedef LaCfg<MODE> Cf; const bf16_t* proj = (const bf16_t*)(C.p.ws + WS_R1);
    const size_t row0 = (size_t)b * SEQ_ + (size_t)c * 64;
#pragma unroll
    for (int it = 0; it < LaRaw<MODE>::NI; ++it) {
        const int u = C.tid + it * NTHR, r = u / Cf::NG, kk = (u % Cf::NG) * 8;
        const bf16_t* rp = proj + (row0 + r) * Cf::PITCH + h * Cf::DK + kk;
        R.z[it] = *(const u32x4*)(rp + Cf::ZCOL);
        if (MODE == 0) R.k[it] = *(const u32x4*)(rp + Cf::KCOL);
        if (NEEDQ) R.q[it] = *(const u32x4*)(rp + Cf::QCOL);
    }
#pragma unroll
    for (int it = 0; it < 2; ++it) {
        const int u = C.tid + it * NTHR, r = u & 63, g8 = u >> 6;
        R.v[it] = *(const u32x4*)(proj + (row0 + r) * Cf::PITCH + Cf::VCOL + h * 128 + g8 * 8);
    }
}
template <int MODE, bool NEEDQ> __device__ __forceinline__ void la_store(const Ctx& C, const LaRaw<MODE>& R, const float* par, bf16_t* Qb, bf16_t* Kb, float* Gf, bf16_t* Vt) {
    typedef LaCfg<MODE> Cf;
#pragma unroll
    for (int it = 0; it < LaRaw<MODE>::NI; ++it) {
        const int u = C.tid + it * NTHR, r = u / Cf::NG, kk = (u % Cf::NG) * 8;
        float z[8], kv[8], lg[8], pc[8];
        unpack8(R.z[it], z); ld8f(par + kk, pc);
        if (MODE == 0) {
            unpack8(R.k[it], kv);
#pragma unroll
            for (int e = 0; e < 8; ++e) { const float x = z[e] + pc[e]; lg[e] = (fminf(x, 0.f) * LOG2E_ - __log2f(1.f + __expf(-fabsf(x)))) * (1.f / 16.f); }
        } else {
#pragma unroll
            for (int e = 0; e < 8; ++e) {
                const float zz = fminf(fmaxf(z[e], -60.f), 60.f), ez = __expf(-zz), sg = __builtin_amdgcn_rcpf(1.f + ez), lb = pc[e];
                lg[e] = __log2f(lb + (1.f - lb) * sg); kv[e] = (1.f - lb) * (ez * sg);
            }
        }
        *(u32x4*)(Kb + r * Cf::LQ + kk) = pack8(kv);
        float* gd = Gf + r * Cf::LG + kk;
        *(f32x4*)gd = (f32x4){lg[0], lg[1], lg[2], lg[3]}; *(f32x4*)(gd + 4) = (f32x4){lg[4], lg[5], lg[6], lg[7]};
        if (NEEDQ) {
            float q[8]; unpack8(R.q[it], q);
#pragma unroll
            for (int e = 0; e < 8; ++e) q[e] = MODE ? siluf_(q[e]) * 0.08838834764831845f : q[e] * 0.125f;
            *(u32x4*)(Qb + r * Cf::LQ + kk) = pack8(q);
        }
    }
#pragma unroll
    for (int it = 0; it < 2; ++it) {
        const int u = C.tid + it * NTHR, r = u & 63, g8 = u >> 6;
        const u32x4 w = R.v[it];
        bf16_t* vd = Vt + (g8 * 8) * 72 + r;
        vd[0] = (bf16_t)(w.x & 0xffffu); vd[72] = (bf16_t)(w.x >> 16); vd[144] = (bf16_t)(w.y & 0xffffu); vd[216] = (bf16_t)(w.y >> 16);
        vd[288] = (bf16_t)(w.z & 0xffffu); vd[360] = (bf16_t)(w.z >> 16); vd[432] = (bf16_t)(w.w & 0xffffu); vd[504] = (bf16_t)(w.w >> 16);
    }
}
template <int MODE> __device__ __forceinline__ void la_params(const Ctx& C, int l, int h, float* par) {
    typedef LaCfg<MODE> Cf; const int j = l >> 1;
    if (C.tid < Cf::DK) {
        if (MODE == 0) par[C.tid] = C.p.gla_gate_b[j * 256 + h * 64 + C.tid];
        else { const float* lg0 = C.p.hgrn_lb_logits + h * 128 + C.tid; par[C.tid] = (j == 0) ? 0.f : sigmoidf_(lg0[512] - lg0[0]); }
    }
}
template <int MODE> __device__ __forceinline__ void la_cumsum(const Ctx& C, float* Gf, float* segs) {
    typedef LaCfg<MODE> Cf; constexpr int DK = Cf::DK, NSEG = NTHR / DK, RPS = 64 / NSEG;
    const int k = C.tid % DK, seg = C.tid / DK;
    float v[RPS];
#pragma unroll
    for (int i = 0; i < RPS; ++i) v[i] = Gf[(seg * RPS + i) * Cf::LG + k];
#pragma unroll
    for (int i = 1; i < RPS; ++i) v[i] += v[i - 1];
    segs[seg * DK + k] = v[RPS - 1];
    __syncthreads();
    float off = 0.f;
#pragma unroll
    for (int s = 0; s < NSEG; ++s) { const float t = segs[s * DK + k]; off += (s < seg) ? t : 0.f; }
#pragma unroll
    for (int i = 0; i < RPS; ++i) Gf[(seg * RPS + i) * Cf::LG + k] = v[i] + off;
}

template <int MODE> __device__ __forceinline__ void phase_la_p1(const Ctx& C, int l) {
    typedef LaCfg<MODE> Cf; const Params& p = C.p; constexpr int DK = Cf::DK, LQ = Cf::LQ, LG = Cf::LG, NG = Cf::NG;
    bf16_t* Kb = (bf16_t*)(C.lds + Cf::O_KB); float* Gf = (float*)(C.lds + Cf::O_GF); bf16_t* Vt = (bf16_t*)(C.lds + Cf::O_VT);
    bf16_t* KhT = (bf16_t*)(C.lds + Cf::O_KT); float* segs = (float*)(C.lds + Cf::O_SEG);
    bf16_t* ST = (bf16_t*)(p.ws + WS_ST); float* TOT = (float*)(p.ws + WS_TOT);
    const int r16 = C.lane & 15, g = C.lane >> 4, w = C.wave;
    float* par = (float*)(C.lds + Cf::O_PAR);
    LaRaw<MODE> R; int hcur = -1;
    if ((int)blockIdx.x < 2048) la_fetch<MODE, false>(C, (int)blockIdx.x >> 8, ((int)blockIdx.x >> 6) & 3, (int)blockIdx.x & 63, R);
    for (int it = blockIdx.x; it < 2048; it += gridDim.x) {
        const int bh = it >> 6, c = it & 63, b = bh >> 2, h = bh & 3;
        if (h != hcur) { la_params<MODE>(C, l, h, par); hcur = h; __syncthreads(); }
        la_store<MODE, false>(C, R, par, nullptr, Kb, Gf, Vt);
        { const int nx = it + (int)gridDim.x; if (nx < 2048) la_fetch<MODE, false>(C, nx >> 8, (nx >> 6) & 3, nx & 63, R); }
        __syncthreads();
        la_cumsum<MODE>(C, Gf, segs);
        __syncthreads();
        for (int u = C.tid; u < 64 * NG; u += NTHR) {
            const int r = u & 63, kk = (u >> 6) * 8;
            float kv[8], gj[8], gt[8];
            unpack8(*(const u32x4*)(Kb + r * LQ + kk), kv); ld8f(Gf + r * LG + kk, gj); ld8f(Gf + 63 * LG + kk, gt);
            bf16_t* kd = KhT + kk * 72 + r;
#pragma unroll
            for (int e = 0; e < 8; e += 2) { const unsigned pw = pk2(kv[e] * __builtin_amdgcn_exp2f(gt[e] - gj[e]), kv[e + 1] * __builtin_amdgcn_exp2f(gt[e + 1] - gj[e + 1]));
                kd[e * 72] = (bf16_t)(pw & 0xffffu); kd[(e + 1) * 72] = (bf16_t)(pw >> 16); }
        }
        if (C.tid < DK) TOT[(size_t)it * 128 + C.tid] = Gf[63 * LG + C.tid];
        __syncthreads();
        {
            const bf16x8 b0 = *(const bf16x8*)(Vt + (16 * w + r16) * 72 + 8 * g), b1 = *(const bf16x8*)(Vt + (16 * w + r16) * 72 + 32 + 8 * g);
            bf16_t* so = ST + (size_t)it * DK * 128 + (size_t)(16 * w + r16) * DK + 4 * g;
#pragma unroll
            for (int mt = 0; mt < DK / 16; ++mt) {
                const bf16x8 a0 = *(const bf16x8*)(KhT + (16 * mt + r16) * 72 + 8 * g), a1 = *(const bf16x8*)(KhT + (16 * mt + r16) * 72 + 32 + 8 * g);
                f32x4 acc = (f32x4){0.f, 0.f, 0.f, 0.f};
                acc = __builtin_amdgcn_mfma_f32_16x16x32_bf16(a0, b0, acc, 0, 0, 0);
                acc = __builtin_amdgcn_mfma_f32_16x16x32_bf16(a1, b1, acc, 0, 0, 0);
                u32x2 q; q.x = pk2(acc[0], acc[1]); q.y = pk2(acc[2], acc[3]);
                *(u32x2*)(so + 16 * mt) = q;
            }
        }
        __syncthreads();
    }
}

template <int MODE> __device__ __forceinline__ void phase_la_p2(const Ctx& C) {
    typedef LaCfg<MODE> Cf; const Params& p = C.p; constexpr int DK = Cf::DK, NQ = DK / 4;
    bf16_t* ST = (bf16_t*)(p.ws + WS_ST); const float* TOT = (const float*)(p.ws + WS_TOT);
    for (int u = blockIdx.x * NTHR + C.tid; u < 32 * 128 * NQ; u += gridDim.x * NTHR) {
        const int k4 = u % NQ, v = (u / NQ) & 127, bh = u / (NQ * 128);
        float S0 = 0.f, S1 = 0.f, S2 = 0.f, S3 = 0.f;
        bf16_t* base = ST + (size_t)bh * 64 * DK * 128 + (size_t)v * DK + k4 * 4;
        const float* tb = TOT + (size_t)bh * 64 * 128 + k4 * 4;
#pragma unroll 8
        for (int c = 0; c < 64; ++c) {
            u32x2* ptr = (u32x2*)(base + (size_t)c * DK * 128);
            const u32x2 w = *ptr; const f32x4 dc = *(const f32x4*)(tb + c * 128);
            u32x2 o; o.x = pk2(S0, S1); o.y = pk2(S2, S3);
            *ptr = o;
            S0 = S0 * __builtin_amdgcn_exp2f(dc[0]) + bflo(w.x); S1 = S1 * __builtin_amdgcn_exp2f(dc[1]) + bfhi(w.x);
            S2 = S2 * __builtin_amdgcn_exp2f(dc[2]) + bflo(w.y); S3 = S3 * __builtin_amdgcn_exp2f(dc[3]) + bfhi(w.y);
        }
    }
}

template <int MODE> __device__ __forceinline__ void phase_la_p3(const Ctx& C, int l) {
    typedef LaCfg<MODE> Cf; const Params& p = C.p; constexpr int DK = Cf::DK, LQ = Cf::LQ, LG = Cf::LG, NG = Cf::NG, NKS = DK / 32;
    bf16_t* Qb = (bf16_t*)(C.lds + Cf::O_QB); bf16_t* Kb = (bf16_t*)(C.lds + Cf::O_KB); float* Gf = (float*)(C.lds + Cf::O_GF); bf16_t* Vt = (bf16_t*)(C.lds + Cf::O_VT);
    bf16_t* Sc = (bf16_t*)(C.lds + Cf::O_SC); bf16_t* Qe = (bf16_t*)(C.lds + Cf::O_QE); float* segs = (float*)(C.lds + Cf::O_SEG); float* red = (float*)(C.lds + Cf::O_RED);
    const bf16_t* ST = (const bf16_t*)(p.ws + WS_ST); const bf16_t* proj = (const bf16_t*)(p.ws + WS_R1); bf16_t* A = (bf16_t*)(p.ws + WS_A);
    const float* nw = (MODE ? p.hgrn_norm_w : p.gla_norm_w) + (l >> 1) * 128;
    const int r16 = C.lane & 15, g = C.lane >> 4, w = C.wave;
    const f32x4 nw4 = *(const f32x4*)(nw + 16 * w + 4 * g);
    float* par = (float*)(C.lds + Cf::O_PAR);
    LaRaw<MODE> R; int hcur = -1;
    if ((int)blockIdx.x < 2048) la_fetch<MODE, true>(C, (int)blockIdx.x >> 8, ((int)blockIdx.x >> 6) & 3, (int)blockIdx.x & 63, R);
    for (int it = blockIdx.x; it < 2048; it += gridDim.x) {
        const int bh = it >> 6, c = it & 63, b = bh >> 2, h = bh & 3;
        bf16x8 sfr[NKS];
        { const bf16_t* sp = ST + (size_t)it * DK * 128 + (size_t)(16 * w + r16) * DK + 8 * g;
#pragma unroll
          for (int ks = 0; ks < NKS; ++ks) sfr[ks] = *(const bf16x8*)(sp + 32 * ks); }
        if (h != hcur) { la_params<MODE>(C, l, h, par); hcur = h; __syncthreads(); }
        la_store<MODE, true>(C, R, par, Qb, Kb, Gf, Vt);
        { const int nx = it + (int)gridDim.x; if (nx < 2048) la_fetch<MODE, true>(C, nx >> 8, (nx >> 6) & 3, nx & 63, R); }
        for (int u = C.tid; u < 64 * 72 / 8; u += NTHR) *(u32x4*)(Sc + u * 8) = (u32x4){0u, 0u, 0u, 0u};
        u32x2 gwv[4];
#pragma unroll
        for (int nt = 0; nt < 4; ++nt) gwv[nt] = *(const u32x2*)(proj + ((size_t)b * SEQ_ + (size_t)c * 64 + 16 * nt + r16) * Cf::PITCH + Cf::GCOL + h * 128 + 16 * w + 4 * g);
        __syncthreads();
        la_cumsum<MODE>(C, Gf, segs);
        __syncthreads();
        for (int t = w; t < 10; t += 8) {
            const int I = (t >= 6) ? 3 : (t >= 3) ? 2 : (t >= 1) ? 1 : 0, J = t - I * (I + 1) / 2;
            f32x4 acc = (f32x4){0.f, 0.f, 0.f, 0.f};
#pragma unroll
            for (int ks = 0; ks < NKS; ++ks) {
                const int kc = 32 * ks + 8 * g;
                float gref[8], gj[8], gi[8], kv[8], qv[8];
                ld8f(Gf + (16 * J + 15) * LG + kc, gref); ld8f(Gf + (16 * J + r16) * LG + kc, gj); ld8f(Gf + (16 * I + r16) * LG + kc, gi);
                unpack8(*(const u32x4*)(Kb + (16 * J + r16) * LQ + kc), kv); unpack8(*(const u32x4*)(Qb + (16 * I + r16) * LQ + kc), qv);
#pragma unroll
                for (int e = 0; e < 8; ++e) { kv[e] *= __builtin_amdgcn_exp2f(gref[e] - gj[e]); qv[e] *= __builtin_amdgcn_exp2f(gi[e] - gref[e]); }
                acc = __builtin_amdgcn_mfma_f32_16x16x32_bf16(__builtin_bit_cast(bf16x8, pack8(kv)), __builtin_bit_cast(bf16x8, pack8(qv)), acc, 0, 0, 0);
            }
            if (I == J) {
#pragma unroll
                for (int e = 0; e < 4; ++e) if (4 * g + e > r16) acc[e] = 0.f;
            }
            u32x2 q; q.x = pk2(acc[0], acc[1]); q.y = pk2(acc[2], acc[3]);
            *(u32x2*)(Sc + (16 * I + r16) * 72 + 16 * J + 4 * g) = q;
        }
        for (int u = C.tid; u < 64 * NG; u += NTHR) {
            const int r = u / NG, kk = (u % NG) * 8;
            float qv[8], gi[8]; unpack8(*(const u32x4*)(Qb + r * LQ + kk), qv); ld8f(Gf + r * LG + kk, gi);
#pragma unroll
            for (int e = 0; e < 8; ++e) qv[e] *= __builtin_amdgcn_exp2f(gi[e]);
            *(u32x4*)(Qe + r * LQ + kk) = pack8(qv);
        }
        __syncthreads();
        f32x4 o[4];
        {
            const bf16x8 v0 = *(const bf16x8*)(Vt + (16 * w + r16) * 72 + 8 * g), v1 = *(const bf16x8*)(Vt + (16 * w + r16) * 72 + 32 + 8 * g);
#pragma unroll
            for (int nt = 0; nt < 4; ++nt) {
                f32x4 acc = (f32x4){0.f, 0.f, 0.f, 0.f};
                acc = __builtin_amdgcn_mfma_f32_16x16x32_bf16(v0, *(const bf16x8*)(Sc + (16 * nt + r16) * 72 + 8 * g), acc, 0, 0, 0);
                if (nt >= 2) acc = __builtin_amdgcn_mfma_f32_16x16x32_bf16(v1, *(const bf16x8*)(Sc + (16 * nt + r16) * 72 + 32 + 8 * g), acc, 0, 0, 0);
#pragma unroll
                for (int ks = 0; ks < NKS; ++ks) acc = __builtin_amdgcn_mfma_f32_16x16x32_bf16(sfr[ks], *(const bf16x8*)(Qe + (16 * nt + r16) * LQ + 32 * ks + 8 * g), acc, 0, 0, 0);
                o[nt] = acc;
                float ss = acc[0] * acc[0] + acc[1] * acc[1] + acc[2] * acc[2] + acc[3] * acc[3];
                ss += __shfl_xor(ss, 16); ss += __shfl_xor(ss, 32);
                if (g == 0) red[w * 64 + 16 * nt + r16] = ss;
            }
        }
        __syncthreads();
#pragma unroll
        for (int nt = 0; nt < 4; ++nt) {
            float tot = 0.f;
#pragma unroll
            for (int ww = 0; ww < 8; ++ww) tot += red[ww * 64 + 16 * nt + r16];
            const float rs = rsqrtf(tot * (1.f / 128.f) + 1e-6f);
            const size_t row = (size_t)b * SEQ_ + (size_t)c * 64 + 16 * nt + r16;
            const u32x2 gw = gwv[nt];
            u32x2 q; q.x = pk2(o[nt][0] * rs * nw4[0] * siluf_(bflo(gw.x)), o[nt][1] * rs * nw4[1] * siluf_(bfhi(gw.x)));
            q.y = pk2(o[nt][2] * rs * nw4[2] * siluf_(bflo(gw.y)), o[nt][3] * rs * nw4[3] * siluf_(bfhi(gw.y)));
            *(u32x2*)(A + row * 1024 + Cf::OCOL + h * 128 + 16 * w + 4 * g) = q;
        }
        __syncthreads();
    }
}


#define LAS __attribute__((address_space(3)))
#define XB_TMO      128
#define XB_XCNT(j)  (256  + 64 * (j))
#define XB_XSUB(j)  (1280 + 64 * (j))
#define XB_XGEN(j)  (2304 + 64 * (j))
#define XB_TOP      3328
#define XB_TOPGEN   3392
#define XCD_BAR_WORDS 3456
#define XB_SPIN_CAP (1u << 18)

__device__ __forceinline__ unsigned xb_ld(unsigned* p)              { return __hip_atomic_load(p, __ATOMIC_RELAXED, __HIP_MEMORY_SCOPE_AGENT); }
__device__ __forceinline__ unsigned xb_add(unsigned* p, unsigned v) { return __hip_atomic_fetch_add(p, v, __ATOMIC_RELAXED, __HIP_MEMORY_SCOPE_AGENT); }
__device__ __forceinline__ unsigned xb_xcc_id() { return (unsigned)__builtin_amdgcn_s_getreg((3 << 11) | 20) & 0xFu; }
#define XB_SPIN(cond, bar) do { unsigned _sp = 0; while (cond) { __builtin_amdgcn_s_sleep(1); \
    if ((++_sp & 255u) == 0u) { if (xb_ld(&(bar)[XB_TMO])) break; if (_sp > XB_SPIN_CAP) { atomicAdd(&(bar)[XB_TMO], 1u); break; } } } } while (0)

struct XcdBarrier {
    unsigned* bar; unsigned x;
    volatile LAS unsigned* st;
};

__device__ __forceinline__ XcdBarrier xcd_barrier_post(unsigned* bar, volatile LAS unsigned* st) {
    XcdBarrier b; b.bar = bar; b.x = xb_xcc_id(); b.st = st;
    if (threadIdx.x == 0) (void)xb_add(&bar[XB_XCNT(b.x)], 1u);
    return b;
}
__device__ __forceinline__ void xcd_barrier_complete(unsigned* bar, unsigned x, unsigned& nloc, unsigned& nx) {
    const unsigned G = gridDim.x * gridDim.y * gridDim.z;
    unsigned sum, cnt, mine, sp = 0u;
    for (;;) {
        sum = 0u; cnt = 0u; mine = 0u;
#pragma unroll
        for (unsigned j = 0; j < 16; ++j) { const unsigned c = xb_ld(&bar[XB_XCNT(j)]); sum += c; cnt += (c > 0u) ? 1u : 0u; mine = (j == x) ? c : mine; }
        if (sum == G) break;
        __builtin_amdgcn_s_sleep(1);
        if ((++sp & 255u) == 0u) { if (xb_ld(&bar[XB_TMO])) break; if (sp > XB_SPIN_CAP) { atomicAdd(&bar[XB_TMO], 1u); break; } }
    }
    nloc = mine > 0u ? mine : 1u; nx = cnt > 0u ? cnt : 1u;
}

__device__ __forceinline__ void xcd_barrier(const XcdBarrier& b) {
    asm volatile("s_waitcnt vmcnt(0)" ::: "memory");
    __syncthreads();
    if (threadIdx.x == 0) {
        unsigned* bar = b.bar;
        __builtin_amdgcn_s_waitcnt(0);
        unsigned nloc = b.st[0], nx = b.st[1];
        if (nloc == 0u) { xcd_barrier_complete(bar, b.x, nloc, nx); b.st[0] = nloc; b.st[1] = nx; }
        const unsigned old = xb_add(&bar[XB_XSUB(b.x)], 1u);
        const unsigned gen = old / nloc;
        if (old + 1u == (gen + 1u) * nloc) {
            __builtin_amdgcn_fence(__ATOMIC_RELEASE, "agent");
            asm volatile("s_waitcnt vmcnt(0)" ::: "memory");
            const unsigned og = xb_add(&bar[XB_TOP], 1u);
            const unsigned tg = og / nx;
            if (og + 1u == (tg + 1u) * nx) xb_add(&bar[XB_TOPGEN], 1u);
            else XB_SPIN(xb_ld(&bar[XB_TOPGEN]) == tg, bar);
            __builtin_amdgcn_fence(__ATOMIC_ACQUIRE, "agent");
            xb_add(&bar[XB_XGEN(b.x)], 1u);
            asm volatile("s_waitcnt vmcnt(0)" ::: "memory");
        } else {
            XB_SPIN(xb_ld(&bar[XB_XGEN(b.x)]) == gen, bar);
            __builtin_amdgcn_fence(__ATOMIC_ACQUIRE, "agent");
            asm volatile("s_waitcnt vmcnt(0)" ::: "memory");
        }
    }
    __syncthreads();
}

typedef unsigned u32x16 __attribute__((ext_vector_type(16)));
__device__ __forceinline__ void load_params(Params& p) {
    auto kp = __builtin_amdgcn_kernarg_segment_ptr();
    u32x16 a, b, c, d;
    asm volatile("s_load_dwordx16 %0, %4, 0x0\n\ts_load_dwordx16 %1, %4, 0x40\n\ts_load_dwordx16 %2, %4, 0x80\n\ts_load_dwordx16 %3, %4, 0xc0\n\ts_waitcnt lgkmcnt(0)"
                 : "=&s"(a), "=&s"(b), "=&s"(c), "=&s"(d) : "s"(kp) : "memory");
    unsigned long long q[32];
#pragma unroll
    for (int i = 0; i < 8; ++i) { q[i] = ((unsigned long long)a[2 * i + 1] << 32) | a[2 * i]; q[8 + i] = ((unsigned long long)b[2 * i + 1] << 32) | b[2 * i];
        q[16 + i] = ((unsigned long long)c[2 * i + 1] << 32) | c[2 * i]; q[24 + i] = ((unsigned long long)d[2 * i + 1] << 32) | d[2 * i]; }
    p.x = (const float*)(__attribute__((address_space(1))) const float*)q[0]; p.c = (const float*)(__attribute__((address_space(1))) const float*)q[1]; p.positions = (const int*)(__attribute__((address_space(1))) const int*)q[2]; p.mod_w = (const float*)(__attribute__((address_space(1))) const float*)q[3]; p.mod_b = (const float*)(__attribute__((address_space(1))) const float*)q[4]; p.norm_mix_w = (const float*)(__attribute__((address_space(1))) const float*)q[5]; p.norm_ffn_w = (const float*)(__attribute__((address_space(1))) const float*)q[6];
    p.ev_w_in = (const float*)(__attribute__((address_space(1))) const float*)q[7]; p.gla_gate_w = (const float*)(__attribute__((address_space(1))) const float*)q[8]; p.gla_gate_b = (const float*)(__attribute__((address_space(1))) const float*)q[9]; p.gla_norm_w = (const float*)(__attribute__((address_space(1))) const float*)q[10]; p.swa_sinks = (const float*)(__attribute__((address_space(1))) const float*)q[11]; p.ev_w_out = (const float*)(__attribute__((address_space(1))) const float*)q[12];
    p.od_w_in = (const float*)(__attribute__((address_space(1))) const float*)q[13]; p.diff_lambda = (const float*)(__attribute__((address_space(1))) const float*)q[14]; p.diff_norm_w = (const float*)(__attribute__((address_space(1))) const float*)q[15]; p.hgrn_lb_logits = (const float*)(__attribute__((address_space(1))) const float*)q[16]; p.hgrn_norm_w = (const float*)(__attribute__((address_space(1))) const float*)q[17]; p.od_w_out = (const float*)(__attribute__((address_space(1))) const float*)q[18];
    p.ffn_w_in = (const float*)(__attribute__((address_space(1))) const float*)q[19]; p.ffn_conv_w = (const float*)(__attribute__((address_space(1))) const float*)q[20]; p.ffn_conv_b = (const float*)(__attribute__((address_space(1))) const float*)q[21]; p.ffn_w_out = (const float*)(__attribute__((address_space(1))) const float*)q[22]; p.final_norm_w = (const float*)(__attribute__((address_space(1))) const float*)q[23];
    p.out = (float*)(__attribute__((address_space(1))) float*)q[24]; p.ws = (unsigned char*)(__attribute__((address_space(1))) unsigned char*)q[25];
}

#ifndef REP_SYNC
#define REP_SYNC 1
#endif
#ifndef REP_G
#define REP_G 1
#endif
#ifndef REP_R
#define REP_R 1
#endif
#ifndef REP_CV
#define REP_CV 1
#endif
#ifndef REP_P12
#define REP_P12 1
#endif
#ifndef STG_A
#define STG_A 0
#endif
#ifndef STG_B
#define STG_B 0
#endif
#ifndef ALIGN_RES
#define ALIGN_RES true
#endif
#ifndef REP_SWA
#define REP_SWA 1
#endif
#ifndef REP_LA
#define REP_LA 1
#endif
#ifndef REP_AT
#define REP_AT 1
#endif
#ifndef REP_SM
#define REP_SM 1
#endif
__global__ void __launch_bounds__(NTHR, 2) fwd_megakernel(Params pin) {
    extern __shared__ __attribute__((aligned(16))) unsigned char lds[];
    cg::grid_group grid = cg::this_grid();
    Ctx C; C.lds = lds; C.tid = threadIdx.x; C.lane = C.tid & 63; C.wave = __builtin_amdgcn_readfirstlane(C.tid >> 6);
    C.gw = blockIdx.x * 8 + C.wave; C.ngw = gridDim.x * 8;
    PG8_LAS unsigned char* ldsg = (PG8_LAS unsigned char*)lds;
    volatile LAS unsigned* bst = (volatile LAS unsigned*)(ldsg + (LDS_BYTES - 64));
    if (threadIdx.x < 2) bst[threadIdx.x] = 0u;
    __syncthreads();
    XcdBarrier xbar = xcd_barrier_post((unsigned*)(pin.ws + WS_BAR), bst);
#define GSYNC() do { for (int rs_ = 0; rs_ < REP_SYNC; ++rs_) xcd_barrier(xbar); } while (0)
#define RP() do { load_params(C.p); C.tid = otid_(); C.lane = C.tid & 63; C.wave = __builtin_amdgcn_readfirstlane(C.tid >> 6); C.gw = blockIdx.x * 8 + C.wave; } while (0)
#define WSP(off) (C.p.ws + (off))
#define STAGGER(ticks) do { if ((ticks) > 0 && (blockIdx.x & 1)) { const unsigned long long t0_ = __builtin_amdgcn_s_memrealtime(); while (__builtin_amdgcn_s_memrealtime() - t0_ < (unsigned long long)(ticks)) __builtin_amdgcn_s_sleep(16); } } while (0)

    if (pin.ws == nullptr) grid.sync();
    for (int rep_ = 0; rep_ < REP_SM; ++rep_) { RP(); phase_prologue(C); }
    GSYNC();
#if REP_CV > 1
    RP(); phase_convert(C, 0, false);
#endif
    RP(); phase_convert(C, 0);
    for (int rep_ = 0; rep_ < REP_SM; ++rep_) { RP(); phase_prep(C, C.p.x, C.p.norm_mix_w, (const float*)WSP(WS_MOD), 1024, (bf16_t*)WSP(WS_A), (float*)WSP(WS_ROWSS)); }
    GSYNC();
#pragma unroll 1
    for (int l = 0; l < 4; ++l) {
        const bool even = !(l & 1);
        {
            RP();
            const int N = even ? 2560 : 3584;
            pg8::Gemm g{(const bf16_t*)WSP(WS_A), (const bf16_t*)WSP(WS_WIN), T_, N, 1024}; pg8::StaticOrder S; S.init(T_, N, (int)gridDim.x, (int)blockIdx.x);
            pg8::EpiProj E{(bf16_t*)WSP(WS_R1), N, even ? 0x7C000u : 0xFFu, even ? 0x3C000u : 0xFu, QSCALE_, (const float*)WSP(WS_COS), (const float*)WSP(WS_SIN),
                           (const float*)WSP(WS_ROWSS) + (size_t)(2 * l) * T_, (const float*)WSP(WS_BIAS) + (size_t)l * BIAS_L};
            for (int rep_ = 0; rep_ < REP_G; ++rep_) pg8::gemm_phase<pg8::EpiProj, pg8::StaticOrder, true, true>(ldsg, g, S, E);
        }
        GSYNC();
        if (even) {
            for (int rep_ = 0; rep_ < REP_SWA; ++rep_) { RP(); phase_swa(C, l); }
            for (int rep_ = 0; rep_ < REP_LA; ++rep_) { RP(); phase_la_p1<0>(C, l); }
            GSYNC();
            RP(); phase_la_p2<0>(C);
            GSYNC();
#if REP_P12 > 1
            RP(); phase_la_p1<0>(C, l); GSYNC(); RP(); phase_la_p2<0>(C); GSYNC();
#endif
            for (int rep_ = 0; rep_ < REP_LA; ++rep_) { RP(); phase_la_p3<0>(C, l); }
        } else {
            for (int rep_ = 0; rep_ < REP_AT; ++rep_) {
                RP();
                const bf16_t* R1 = (const bf16_t*)WSP(WS_R1); bf16_t* X2 = (bf16_t*)WSP(WS_X2);
                const int G = (int)gridDim.x, bid = (int)blockIdx.x;
#pragma unroll 1
                for (int i = 0; i * G < 2048; ++i) {
                    const int L = i * G + ((i & 1) ? (G - 1 - bid) : bid);
                    if (L >= 2048) continue;
                    const int qb = 15 - (L >> 7), bh = (((L >> 2) & 7) << 4) | ((L & 3) << 2) | (((L >> 5) & 1) << 1) | ((L >> 6) & 1), b = bh >> 4, hv = bh & 15;
                    const attn_body::bf16* Q = (const attn_body::bf16*)(R1 + (hv >> 1) * 64);
                    const attn_body::bf16* K = (const attn_body::bf16*)(R1 + 512 + (hv >> 1) * 64);
                    const attn_body::bf16* V = (const attn_body::bf16*)(R1 + 1024 + (hv >> 2) * 128 + (hv & 1) * 64);
                    attn_body::attn_unit<8>(b, hv, qb, Q, K, V, (attn_body::bf16*)(X2 + hv * 64), (char*)lds);
                }
            }
            for (int rep_ = 0; rep_ < REP_LA; ++rep_) { RP(); phase_la_p1<1>(C, l); }
            GSYNC();
            RP(); phase_la_p2<1>(C);
#if REP_P12 > 1
            GSYNC(); RP(); phase_la_p1<1>(C, l); GSYNC(); RP(); phase_la_p2<1>(C);
#endif
            for (int rep_ = 0; rep_ < REP_SM; ++rep_) { RP(); phase_diff_combine(C, l); }
            GSYNC();
            for (int rep_ = 0; rep_ < REP_LA; ++rep_) { RP(); phase_la_p3<1>(C, l); }
        }
        GSYNC();
        STAGGER(STG_A);
        {
            RP();
            const float* modl = (const float*)WSP(WS_MOD) + (size_t)l * 8 * 6144;
            pg8::Gemm g{(const bf16_t*)WSP(WS_A), (const bf16_t*)WSP(WS_WOUT), T_, 1024, 1024}; pg8::StaticOrder S; S.init(T_, 1024, (int)gridDim.x, (int)blockIdx.x);
            void* XH = (void*)((char*)C.p.out + 64 * MiB_);
            pg8::EpiRes E{(l == 0) ? (const void*)C.p.x : (const void*)XH, XH, (l == 0) ? 1 : 0, 0, modl + 2048, (bf16_t*)WSP(WS_X2), C.p.norm_ffn_w + l * 1024, modl + 4096, (float*)WSP(WS_ROWSS) + (size_t)(2 * l + 1) * T_};
            pg8::gemm_phase<pg8::EpiRes, pg8::StaticOrder, ALIGN_RES, true>(ldsg, g, S, E);
        }
        GSYNC();
        {
            RP();
            pg8::Gemm g{(const bf16_t*)WSP(WS_X2), (const bf16_t*)WSP(WS_FIN), T_, 5632, 1024}; pg8::StaticOrder S; S.init(T_, 5632, (int)gridDim.x, (int)blockIdx.x);
            pg8::EpiFfn E{(bf16_t*)WSP(WS_R1), (float*)WSP(WS_HP), (float*)WSP(WS_HU), (float*)WSP(WS_HA), C.p.ffn_conv_w + (size_t)l * 3 * DFF_, C.p.ffn_conv_b + (size_t)l * DFF_,
                          (const float*)WSP(WS_ROWSS) + (size_t)(2 * l + 1) * T_, (const float*)WSP(WS_BIAS) + (size_t)l * BIAS_L + 8 * 3584};
            for (int rep_ = 0; rep_ < REP_G; ++rep_) pg8::gemm_phase<pg8::EpiFfn, pg8::StaticOrder, true, true>(ldsg, g, S, E);
        }
        GSYNC();
        for (int rep_ = 0; rep_ < REP_SM; ++rep_) { RP(); phase_ffn_fixup(C, l); }
#if REP_CV > 1
        if (l < 3) { RP(); phase_convert(C, l + 1, false); }
#endif
        if (l < 3) { RP(); phase_convert(C, l + 1); }
        GSYNC();
        STAGGER(STG_B);
        {
            RP();
            const float* modl = (const float*)WSP(WS_MOD) + (size_t)l * 8 * 6144;
            pg8::Gemm g{(const bf16_t*)WSP(WS_R1), (const bf16_t*)WSP((l & 1) ? WS_FOUT2 : WS_FOUT), T_, 1024, DFF_}; pg8::StaticOrder S; S.init(T_, 1024, (int)gridDim.x, (int)blockIdx.x);
            void* XH = (void*)((char*)C.p.out + 64 * MiB_);
            pg8::EpiRes E{XH, (l < 3) ? XH : (void*)WSP(WS_X2), 0, 0, modl + 5120, (l < 3) ? (bf16_t*)WSP(WS_A) : (bf16_t*)nullptr, C.p.norm_mix_w + ((l + 1) & 3) * 1024, modl + 6144 * 8 + 1024, (float*)WSP(WS_ROWSS) + (size_t)((2 * l + 2) & 7) * T_};
            pg8::gemm_phase<pg8::EpiRes, pg8::StaticOrder, ALIGN_RES, true>(ldsg, g, S, E);
        }
        GSYNC();
    }
    RP(); phase_final_norm(C, (const void*)WSP(WS_X2), C.p.out, C.p.final_norm_w);
}

extern "C" void kernel_launch(void* const* d_in, const int* in_sizes, int n_in, void* d_out, int out_size, void* d_ws, size_t ws_size, hipStream_t stream) {
    static int grid_blocks = 0;
    if (grid_blocks == 0) {
        if (n_in != 24 || ws_size < WS_END) { fprintf(stderr, "kernel_launch: unexpected n_in %d / ws %zu\n", n_in, ws_size); grid_blocks = -1; return; }
        int dev = 0, cus = 0, per_cu = 0;
        hipGetDevice(&dev); hipDeviceGetAttribute(&cus, hipDeviceAttributeMultiprocessorCount, dev);
        if (hipFuncSetAttribute((const void*)fwd_megakernel, hipFuncAttributeMaxDynamicSharedMemorySize, LDS_BYTES) != hipSuccess) { fprintf(stderr, "kernel_launch: hipFuncSetAttribute failed\n"); grid_blocks = -1; return; }
        if (hipOccupancyMaxActiveBlocksPerMultiprocessor(&per_cu, (const void*)fwd_megakernel, NTHR, LDS_BYTES) != hipSuccess || per_cu < 1) { fprintf(stderr, "kernel_launch: occupancy query gave %d\n", per_cu); per_cu = 1; }
        (void)hipGetLastError();
        grid_blocks = cus * per_cu;
    }
    if (grid_blocks < 0) return;
    Params p{};
    p.x = (const float*)d_in[0]; p.c = (const float*)d_in[1]; p.positions = (const int*)d_in[2]; p.mod_w = (const float*)d_in[3]; p.mod_b = (const float*)d_in[4];
    p.norm_mix_w = (const float*)d_in[5]; p.norm_ffn_w = (const float*)d_in[6]; p.ev_w_in = (const float*)d_in[7]; p.gla_gate_w = (const float*)d_in[8];
    p.gla_gate_b = (const float*)d_in[9]; p.gla_norm_w = (const float*)d_in[10]; p.swa_sinks = (const float*)d_in[11]; p.ev_w_out = (const float*)d_in[12];
    p.od_w_in = (const float*)d_in[13]; p.diff_lambda = (const float*)d_in[14]; p.diff_norm_w = (const float*)d_in[15]; p.hgrn_lb_logits = (const float*)d_in[16];
    p.hgrn_norm_w = (const float*)d_in[17]; p.od_w_out = (const float*)d_in[18]; p.ffn_w_in = (const float*)d_in[19]; p.ffn_conv_w = (const float*)d_in[20];
    p.ffn_conv_b = (const float*)d_in[21]; p.ffn_w_out = (const float*)d_in[22]; p.final_norm_w = (const float*)d_in[23];
    p.out = (float*)d_out; p.ws = (unsigned char*)d_ws;
    if (hipMemsetAsync((char*)d_ws + WS_BAR, 0, 16384, stream) != hipSuccess) { fprintf(stderr, "kernel_launch: memset failed\n"); return; }
    void* args[] = {&p};
    hipError_t e = hipLaunchCooperativeKernel((const void*)fwd_megakernel, dim3(grid_blocks), dim3(NTHR), args, LDS_BYTES, stream);
    if (e != hipSuccess) fprintf(stderr, "cooperative launch failed: %s (grid %d)\n", hipGetErrorString(e), grid_blocks);
}
```

```cpp
#include <hip/hip_runtime.h>
#include <hip/hip_cooperative_groups.h>
#include <hip/hip_bf16.h>
#include <cstdio>
#include <cstdint>
#include <cmath>
__device__ __forceinline__ int otid_() { int t = threadIdx.x; asm volatile("" : "+v"(t)); return t; }
namespace pg8 {
#define PG8_LAS __attribute__((address_space(3)))
typedef unsigned short bf16_t;
typedef short bf16x8 __attribute__((ext_vector_type(8)));
typedef float f32x4 __attribute__((ext_vector_type(4)));
typedef unsigned u32x4 __attribute__((ext_vector_type(4)));
constexpr int BM = 256, BK = 64, HALF = 128, HTB = HALF * BK * 2  , STAGE_BYTES = 8 * HTB, NXCD = 8, WGM = 8;

__host__ __device__ __forceinline__ int lds_byte(int r, int c) { const int st = (r >> 4) * 2 + (c >> 5), rr = r & 15, cc = c & 31, ob = rr * 64 + cc * 2; return st * 1024 + (ob ^ (((ob >> 9) & 1) << 5)); }
__host__ __device__ __forceinline__ void stage_rc(int b, int& R, int& C) { const int st = b / 1024, sb = b % 1024, swz = sb ^ (((sb >> 9) & 1) << 5); R = (st >> 1) * 16 + swz / 64; C = (st & 1) * 32 + (swz % 64) / 2; }
__host__ __device__ __forceinline__ int perm32(int rho) { const int n = rho >> 4, i = rho & 15; return 8 * (i >> 2) + 4 * n + (i & 3); }

struct Unit { int pm, pn; };
struct Gemm { const bf16_t* A; const bf16_t* Bt; int M, N, K; };

struct StaticOrder {
    int nM, nN, nwg, G, c;
    __host__ __device__ void init(int M, int N, int G_, int c_) { nM = M / BM; nN = N / BM; nwg = nM * nN; G = G_; c = c_; }
    __host__ __device__ bool next(int i, Unit& u) const {
        const long L = (long)i * G + c; if (L >= nwg) return false;
        int wgid = (int)L; { const int q = nwg / NXCD, r = nwg % NXCD, xcd = wgid % NXCD, off = wgid / NXCD; wgid = (xcd < r ? xcd * (q + 1) : r * (q + 1) + (xcd - r) * q) + off; }
        const int nig = WGM * nN, gid = wgid / nig, fm = gid * WGM, gsz = (nM - fm) < WGM ? (nM - fm) : WGM;
        u.pm = fm + ((wgid % nig) % gsz); u.pn = (wgid % nig) / gsz; return true;
    }
    __device__ __forceinline__ void a_ready(const Unit&) const {}
    __device__ __forceinline__ void done(const Unit&) const {}
};

__device__ __forceinline__ unsigned cvt_pk_bf16(float lo, float hi) { unsigned r; asm volatile("v_cvt_pk_bf16_f32 %0, %1, %2" : "=v"(r) : "v"(lo), "v"(hi)); return r; }
typedef float f32x2 __attribute__((ext_vector_type(2)));
template <class Epi, class Sched, bool ALIGN_EPI = false, bool SP2 = false>
__device__ __forceinline__ void gemm_phase(PG8_LAS unsigned char* lds, const Gemm g, const Sched& S, const Epi& E) {
    const int tid = otid_(), wid = __builtin_amdgcn_readfirstlane(tid >> 6), lane = tid & 63, wr = wid >> 2, wc = wid & 3, fr = lane & 15, fq = lane >> 4;
    const int K = g.K, nt = K / BK;
    unsigned voffA[2], voffB[2];
#pragma unroll
    for (int i = 0; i < 2; ++i) { int R, C; stage_rc(tid * 16 + i * 8192, R, C); const int Rb = Epi::PERM ? ((R & ~31) + perm32(R & 31)) : R;
        voffA[i] = (unsigned)(R * K + C) * 2u; voffB[i] = (unsigned)(Rb * K + C) * 2u; }
    const size_t kstep = (size_t)(BK * 2);
    const size_t hstep = (size_t)HALF * K * 2;
    const size_t tstep = 2 * hstep;
    const unsigned ldsw = (unsigned)wid * 1024u;
    const int aoff = lds_byte(wr * 64 + fr, fq * 8), boff = lds_byte(wc * 32 + fr, fq * 8);
#define PG8_SA(b, h) (((b) * 2 + (h)) * HTB)
#define PG8_SB(b, h) ((4 + (b) * 2 + (h)) * HTB)
#define PG8_STAGE(bufoff, gbase, voff) do { _Pragma("unroll") for (int _i = 0; _i < 2; ++_i) \
        __builtin_amdgcn_global_load_lds((const unsigned*)((const char*)(gbase) + (voff)[_i]), (PG8_LAS unsigned*)(lds + (bufoff) + ldsw + _i * 8192), 16, 0, 0); } while (0)
#define PG8_LDA(dst, b, h) do { _Pragma("unroll") for (int m = 0; m < 4; ++m) _Pragma("unroll") for (int k = 0; k < 2; ++k) dst[m][k] = *(const PG8_LAS bf16x8*)(lds + PG8_SA(b, h) + aoff + m * 2048 + k * 1024); } while (0)
#define PG8_LDB(dst, b, h) do { _Pragma("unroll") for (int n = 0; n < 2; ++n) _Pragma("unroll") for (int k = 0; k < 2; ++k) dst[n][k] = *(const PG8_LAS bf16x8*)(lds + PG8_SB(b, h) + boff + n * 2048 + k * 1024); } while (0)
#define PG8_MMA(ai, bj, At, Bt) do { __builtin_amdgcn_s_setprio(1); _Pragma("unroll") for (int m = 0; m < 4; ++m) _Pragma("unroll") for (int n = 0; n < 2; ++n) _Pragma("unroll") for (int k = 0; k < 2; ++k) \
        acc[ai][bj][m][n] = __builtin_amdgcn_mfma_f32_16x16x32_bf16(Bt[n][k], At[m][k], acc[ai][bj][m][n], 0, 0, 0); __builtin_amdgcn_s_setprio(0); } while (0)
#define PG8_WAIT_V(n) asm volatile("s_waitcnt vmcnt(" #n ")" ::: "memory")
#define PG8_WAIT_L(n) asm volatile("s_waitcnt lgkmcnt(" #n ")" ::: "memory")
#define PG8_BAR __builtin_amdgcn_s_barrier()
#define PG8_SCHED __builtin_amdgcn_sched_barrier(0)
    Unit cur, nxt; int ui = 0;
    if (!S.next(0, cur)) return;
    f32x4 acc[2][2][4][2];
#pragma unroll
    for (int a = 0; a < 2; ++a)
#pragma unroll
        for (int b = 0; b < 2; ++b)
#pragma unroll
            for (int m = 0; m < 4; ++m)
#pragma unroll
                for (int n = 0; n < 2; ++n) acc[a][b][m][n] = (f32x4){0.f, 0.f, 0.f, 0.f};
    bf16x8 At[4][2], B0[2][2], B1[2][2];
    const char* cA = (const char*)g.A + (size_t)cur.pm * tstep; const char* cB = (const char*)g.Bt + (size_t)cur.pn * tstep;
    S.a_ready(cur);
    if constexpr (SP2) {
        PG8_STAGE(PG8_SB(0, 0), cB, voffB); PG8_STAGE(PG8_SB(0, 1), cB + hstep, voffB); PG8_STAGE(PG8_SA(0, 0), cA, voffA); PG8_STAGE(PG8_SA(0, 1), cA + hstep, voffA);
        if (wr == 1) PG8_BAR;
        PG8_WAIT_V(2); PG8_BAR;
        PG8_STAGE(PG8_SB(1, 0), cB + kstep, voffB); PG8_STAGE(PG8_SA(1, 0), cA + kstep, voffA); PG8_STAGE(PG8_SB(1, 1), cB + hstep + kstep, voffB);
        PG8_WAIT_V(6); PG8_BAR;
    } else {
        PG8_STAGE(PG8_SB(0, 0), cB, voffB); PG8_STAGE(PG8_SA(0, 0), cA, voffA); PG8_STAGE(PG8_SB(0, 1), cB + hstep, voffB); PG8_STAGE(PG8_SA(0, 1), cA + hstep, voffA);
        if (wr == 1) PG8_BAR;
        PG8_WAIT_V(4); PG8_BAR;
        PG8_STAGE(PG8_SB(1, 0), cB + kstep, voffB); PG8_STAGE(PG8_SA(1, 0), cA + kstep, voffA); PG8_STAGE(PG8_SB(1, 1), cB + hstep + kstep, voffB);
        PG8_WAIT_V(6); PG8_BAR;
    }
    for (;;) {
        const bool has_next = S.next(ui + 1, nxt);
        const char* nA = has_next ? (const char*)g.A + (size_t)nxt.pm * tstep : cA; const char* nB = has_next ? (const char*)g.Bt + (size_t)nxt.pn * tstep : cB;
        for (int t = 0; t < nt; t += 2) {
            const bool last = (t == nt - 2);
            const char* a1 = cA + (size_t)(t + 1) * kstep;
            const char* a2 = last ? nA : cA + (size_t)(t + 2) * kstep; const char* b2 = last ? nB : cB + (size_t)(t + 2) * kstep;
            const char* a3 = a2 + kstep; const char* b3 = b2 + kstep;
            if (last && has_next) S.a_ready(nxt);
            if constexpr (SP2) {
            PG8_LDB(B0, 0, 0); PG8_LDB(B1, 0, 1); PG8_SCHED; PG8_LDA(At, 0, 0); PG8_STAGE(PG8_SA(1, 1), a1 + hstep, voffA);
            PG8_WAIT_V(8); PG8_WAIT_L(0); PG8_BAR; PG8_MMA(0, 0, At, B0); PG8_MMA(0, 1, At, B1); PG8_BAR; PG8_SCHED;
            PG8_LDA(At, 0, 1); PG8_STAGE(PG8_SB(0, 0), b2, voffB); PG8_STAGE(PG8_SB(0, 1), b2 + hstep, voffB); PG8_STAGE(PG8_SA(0, 0), a2, voffA);
            PG8_WAIT_V(8); PG8_WAIT_L(0); PG8_BAR; PG8_MMA(1, 0, At, B0); PG8_MMA(1, 1, At, B1); PG8_BAR; PG8_SCHED;
            PG8_LDB(B0, 1, 0); PG8_LDB(B1, 1, 1); PG8_SCHED; PG8_LDA(At, 1, 0); PG8_STAGE(PG8_SA(0, 1), a2 + hstep, voffA);
            PG8_WAIT_V(8); PG8_WAIT_L(0); PG8_BAR; PG8_MMA(0, 0, At, B0); PG8_MMA(0, 1, At, B1); PG8_BAR; PG8_SCHED;
            PG8_LDA(At, 1, 1); PG8_STAGE(PG8_SB(1, 0), b3, voffB); PG8_STAGE(PG8_SB(1, 1), b3 + hstep, voffB); PG8_STAGE(PG8_SA(1, 0), a3, voffA);
            PG8_WAIT_V(8); PG8_WAIT_L(0); PG8_BAR; PG8_MMA(1, 0, At, B0); PG8_MMA(1, 1, At, B1); PG8_BAR; PG8_SCHED;
            } else {
            PG8_LDB(B0, 0, 0); PG8_SCHED; PG8_LDA(At, 0, 0); PG8_STAGE(PG8_SA(1, 1), a1 + hstep, voffA);
            PG8_WAIT_L(8); PG8_BAR; PG8_WAIT_L(0); PG8_MMA(0, 0, At, B0); PG8_BAR; PG8_SCHED;
            PG8_LDB(B1, 0, 1); PG8_STAGE(PG8_SB(0, 0), b2, voffB);
            PG8_BAR; PG8_WAIT_L(0); PG8_MMA(0, 1, At, B1); PG8_BAR;
            PG8_LDA(At, 0, 1); PG8_STAGE(PG8_SA(0, 0), a2, voffA);
            PG8_BAR; PG8_WAIT_L(0); PG8_MMA(1, 0, At, B0); PG8_BAR; PG8_SCHED;
            PG8_STAGE(PG8_SB(0, 1), b2 + hstep, voffB);
            PG8_WAIT_V(6); PG8_BAR; PG8_MMA(1, 1, At, B1); PG8_BAR;
            PG8_LDB(B0, 1, 0); PG8_SCHED; PG8_LDA(At, 1, 0); PG8_STAGE(PG8_SA(0, 1), a2 + hstep, voffA);
            PG8_WAIT_L(8); PG8_BAR; PG8_WAIT_L(0); PG8_MMA(0, 0, At, B0); PG8_BAR; PG8_SCHED;
            PG8_LDB(B1, 1, 1); PG8_STAGE(PG8_SB(1, 0), b3, voffB);
            PG8_BAR; PG8_WAIT_L(0); PG8_MMA(0, 1, At, B1); PG8_BAR;
            PG8_LDA(At, 1, 1); PG8_STAGE(PG8_SA(1, 0), a3, voffA);
            PG8_BAR; PG8_WAIT_L(0); PG8_MMA(1, 0, At, B0); PG8_BAR; PG8_SCHED;
            PG8_STAGE(PG8_SB(1, 1), b3 + hstep, voffB);
            PG8_WAIT_V(6); PG8_BAR; PG8_MMA(1, 1, At, B1); PG8_BAR;
            }
        }
        if constexpr (ALIGN_EPI) { if (wr == 0) PG8_BAR; }
        if constexpr (!Epi::AFTER_DRAIN) { E(acc, cur, wr, wc, fr, fq); S.done(cur); }
        if (!has_next) break;
#pragma unroll
        for (int a = 0; a < 2; ++a)
#pragma unroll
            for (int b = 0; b < 2; ++b)
#pragma unroll
                for (int m = 0; m < 4; ++m)
#pragma unroll
                    for (int n = 0; n < 2; ++n) acc[a][b][m][n] = (f32x4){0.f, 0.f, 0.f, 0.f};
        cur = nxt; cA = nA; cB = nB; ++ui;
        if constexpr (ALIGN_EPI) { if (wr == 1) PG8_BAR; }
    }
    PG8_WAIT_V(0);
    if constexpr (!ALIGN_EPI) { if (wr == 0) PG8_BAR; }
    PG8_BAR;
    if constexpr (Epi::AFTER_DRAIN) { E.fused(acc, cur, wr, wc, fr, fq, lds, wid, lane); S.done(cur); }
#undef PG8_SA
#undef PG8_SB
#undef PG8_STAGE
#undef PG8_LDA
#undef PG8_LDB
#undef PG8_MMA
#undef PG8_WAIT_V
#undef PG8_WAIT_L
#undef PG8_BAR
#undef PG8_SCHED
}
}
#include <hip/hip_bf16.h>
namespace attn_body {
using bf16=__hip_bfloat16;
using bf16x8=__attribute__((ext_vector_type(8)))short;
using s16x4=__attribute__((ext_vector_type(4)))short;
using f32x16=__attribute__((ext_vector_type(16)))float;
using u32x4=__attribute__((ext_vector_type(4)))unsigned;
constexpr int BATCH=8,NHEAD=16,SEQ=4096,D=64,PITI=3584,PITO=1024;
constexpr int NW=8,QBLK=32,QB=QBLK*NW,KVBLK=64,NQB=SEQ/QB;
__device__ __forceinline__ int crow(int r,int hi){return (r&3)+8*(r>>2)+4*hi;}
#define SBAR() __builtin_amdgcn_sched_barrier(0)
__device__ __forceinline__ void cmask(f32x16&p0,f32x16&p1,int jb,int qrel,int hi){
  const float NEG=-INFINITY; int kb=64*jb+4*hi;
  #pragma unroll
  for(int r=0;r<16;++r){int kv=kb+(r&3)+8*(r>>2); if(kv>qrel)p0[r]=NEG; if(kv+32>qrel)p1[r]=NEG;}
}

constexpr int NSLOT=3, SLOTB=8192;
constexpr int LDS_K=0, LDS_V=NSLOT*SLOTB, LDS_WS=2*NSLOT*SLOTB, LDS_OST=LDS_WS+NW*64*4, LDS_BYTES=LDS_OST+NW*4096;
constexpr float C2=0.125f*1.4426950408889634f;
__device__ __forceinline__ void glds16(const void*gsrc,unsigned lds_dst){unsigned keep;
  asm volatile("s_mov_b32 %0, m0\n\ts_mov_b32 m0, %2\n\ts_nop 0\n\tglobal_load_lds_dwordx4 %1, off\n\ts_mov_b32 m0, %0":"=&s"(keep):"v"(gsrc),"s"(lds_dst):"memory");}
__device__ __forceinline__ float max3f(float a,float b,float c){float r;asm("v_max3_f32 %0, %1, %2, %3":"=v"(r):"v"(a),"v"(b),"v"(c));return r;}
__device__ __forceinline__ float max2f(float a,float b){float r;asm("v_max_f32_e32 %0, %1, %2":"=v"(r):"v"(a),"v"(b));return r;}
__device__ __forceinline__ float fadd_s(float a,float b){float r;asm("v_add_f32_e32 %0, %1, %2":"=v"(r):"v"(a),"v"(b));return r;}
__device__ __forceinline__ float fsub_s(float a,float b){float r;asm("v_sub_f32_e32 %0, %1, %2":"=v"(r):"v"(a),"v"(b));return r;}
typedef float f32x2_t __attribute__((ext_vector_type(2))); typedef __bf16 bf16x2_t __attribute__((ext_vector_type(2)));
__device__ __forceinline__ unsigned cvtpk_s(float lo,float hi){f32x2_t v={lo,hi};bf16x2_t b=__builtin_convertvector(v,bf16x2_t);return __builtin_bit_cast(unsigned,b);}
#define WAIT_BAR(N) asm volatile("s_waitcnt vmcnt(" #N ") lgkmcnt(0)\n\ts_barrier":::"memory")

__device__ __forceinline__ void qkt(f32x16&p0,f32x16&p1,const char*Kslot,const bf16x8*qr,const f32x16&negm,int r32,int hi){
  const char*kb=Kslot+hi*1024+r32*16;
  #pragma unroll
  for(int d0=0;d0<4;++d0){
    const bf16x8 b0=*reinterpret_cast<const bf16x8*>(kb+d0*2048);
    const bf16x8 b1=*reinterpret_cast<const bf16x8*>(kb+d0*2048+512);
    if(d0==0){p0=__builtin_amdgcn_mfma_f32_32x32x16_bf16(b0,qr[0],negm,0,0,0);p1=__builtin_amdgcn_mfma_f32_32x32x16_bf16(b1,qr[0],negm,0,0,0);}
    else{p0=__builtin_amdgcn_mfma_f32_32x32x16_bf16(b0,qr[d0],p0,0,0,0);p1=__builtin_amdgcn_mfma_f32_32x32x16_bf16(b1,qr[d0],p1,0,0,0);}}
}
typedef __attribute__((address_space(3))) const char* lds_cptr;
typedef short v4i16_t __attribute__((ext_vector_type(4)));
__device__ __forceinline__ void kload8(bf16x8*kf,lds_cptr kp){
  kf[0]=*(const __attribute__((address_space(3))) bf16x8*)(kp);      kf[1]=*(const __attribute__((address_space(3))) bf16x8*)(kp+512);
  kf[2]=*(const __attribute__((address_space(3))) bf16x8*)(kp+2048); kf[3]=*(const __attribute__((address_space(3))) bf16x8*)(kp+2560);
  kf[4]=*(const __attribute__((address_space(3))) bf16x8*)(kp+4096); kf[5]=*(const __attribute__((address_space(3))) bf16x8*)(kp+4608);
  kf[6]=*(const __attribute__((address_space(3))) bf16x8*)(kp+6144); kf[7]=*(const __attribute__((address_space(3))) bf16x8*)(kp+6656);
}
__device__ __forceinline__ void kload2(bf16x8*kf,lds_cptr kp,int j){ kf[2*j]=*(const __attribute__((address_space(3))) bf16x8*)(kp+j*2048); kf[2*j+1]=*(const __attribute__((address_space(3))) bf16x8*)(kp+j*2048+512); }
__device__ __forceinline__ s16x4 vtr(lds_cptr p){ return __builtin_bit_cast(s16x4,__builtin_amdgcn_ds_read_tr16_b64_v4i16((__attribute__((address_space(3))) v4i16_t*)p)); }
__device__ __forceinline__ float rowmax(const f32x16&p0,const f32x16&p1){
  float a=max3f(p0[0],p0[1],p1[0]),b=max3f(p0[2],p0[3],p1[1]);a=max3f(a,p1[2],p1[3]);
  #pragma unroll
  for(int r=4;r<16;r+=4){a=max3f(a,p0[r],p0[r+1]);b=max3f(b,p0[r+2],p0[r+3]);a=max3f(a,p1[r],p1[r+1]);b=max3f(b,p1[r+2],p1[r+3]);}
  const float m=max2f(a,b);
  auto rr=__builtin_amdgcn_permlane32_swap(__float_as_uint(m),__float_as_uint(m),false,false);
  return max2f(__uint_as_float(rr[0]),__uint_as_float(rr[1]));
}
__device__ __forceinline__ void pv(f32x16*o,int vb,bf16x8 pa0,bf16x8 pa1,bf16x8 pa2,bf16x8 pa3){
  #pragma unroll
  for(int d0=0;d0<2;++d0){s16x4 lo[4],hi[4];
    #pragma unroll
    for(int ks=0;ks<4;++ks){
      asm volatile("ds_read_b64_tr_b16 %0,%1 offset:%c2":"=&v"(lo[ks]):"v"(vb),"i"(d0*4096+ks*1024):"memory");
      asm volatile("ds_read_b64_tr_b16 %0,%1 offset:%c2":"=&v"(hi[ks]):"v"(vb),"i"(d0*4096+ks*1024+512):"memory");}
    asm volatile("s_waitcnt lgkmcnt(0)":::"memory");SBAR();
    #define PK(k) (bf16x8){lo[k][0],lo[k][1],lo[k][2],lo[k][3],hi[k][0],hi[k][1],hi[k][2],hi[k][3]}
    o[d0]=__builtin_amdgcn_mfma_f32_32x32x16_bf16(pa0,PK(0),o[d0],0,0,0);
    o[d0]=__builtin_amdgcn_mfma_f32_32x32x16_bf16(pa1,PK(1),o[d0],0,0,0);
    o[d0]=__builtin_amdgcn_mfma_f32_32x32x16_bf16(pa2,PK(2),o[d0],0,0,0);
    o[d0]=__builtin_amdgcn_mfma_f32_32x32x16_bf16(pa3,PK(3),o[d0],0,0,0);
    #undef PK
  }
}

#ifndef ATTN_STORE16
#define ATTN_STORE16(p,v) (*(u32x4*)(p)=(v))
#endif
template<int THRL> __device__ __forceinline__ void attn_unit(int b,int h,int qb,const bf16*Q,const bf16*__restrict__ K,const bf16*__restrict__ V,bf16*O,char*shm){
  const int tid=otid_(),lane=tid&63,r32=lane&31,hi=lane>>5; const int wid=__builtin_amdgcn_readfirstlane(tid>>6);
  const long rowbase=(long)b*SEQ; const int q0=qb*QB;
  const bf16*Qw=Q+(rowbase+q0+wid*QBLK)*PITI;
  const bf16*Kh=K+rowbase*PITI,*Vh=V+rowbase*PITI;
  const unsigned lds0=(unsigned)(uintptr_t)shm;
  float*wsf=(float*)(shm+LDS_WS)+wid*64;
  const bf16*ksrc=Kh+(long)lane*PITI+wid*8;
  const bf16*vsrc=Vh+(long)(16*(wid&3)+(lane>>2))*PITI+(wid>>2)*32+(lane&3)*8;
  const unsigned kdst=lds0+LDS_K+wid*1024, vdst=lds0+LDS_V+wid*1024;
  #define DMA_K(t,slot) glds16(ksrc+(long)(t)*KVBLK*PITI,(unsigned)__builtin_amdgcn_readfirstlane(kdst+(slot)))
  #define DMA_V(t,slot) glds16(vsrc+(long)(t)*KVBLK*PITI,(unsigned)__builtin_amdgcn_readfirstlane(vdst+(slot)))
  const int vb0=(int)(lds0+LDS_V)+((lane>>4)&1)*32+(lane&3)*8+(4*hi+((lane&15)>>2))*64;
  const char*Kbase=shm+LDS_K; bf16x8 kf[8];
  const lds_cptr shm3=(lds_cptr)shm; const lds_cptr kp0=shm3+LDS_K+hi*1024+r32*16; const lds_cptr vp0=shm3+LDS_V+((lane>>4)&1)*32+(lane&3)*8+(4*hi+((lane&15)>>2))*64;
  const int NT=(q0+QB)/KVBLK;
  DMA_K(0,0);DMA_V(0,0);DMA_K(1,SLOTB);
  bf16x8 qr[4];
  #pragma unroll
  for(int d0=0;d0<4;++d0)qr[d0]=*reinterpret_cast<const bf16x8*>(&Qw[(long)r32*PITI+d0*16+hi*8]);
  float mhat=0.f,l_reg=0.f;f32x16 o[2];o[0]=f32x16{};o[1]=f32x16{};f32x16 negm=f32x16{};asm volatile("":"+v"(negm));
  const int qrel=wid*QBLK+r32;
  #define CMASK(P0,P1,t) do{int jb_=(t)-(NT-4); if(jb_>=0)cmask(P0,P1,jb_,qrel,hi);}while(0)
  bool resc=false;
  #define START(P0,P1) do{ const float rm=rowmax(P0,P1); resc=false; \
    { const float dl=rm; mhat=fadd_s(mhat,dl); \
      _Pragma("unroll") for(int r=0;r<16;++r){P0[r]=fsub_s(P0[r],dl);P1[r]=fsub_s(P1[r],dl);} \
      _Pragma("unroll") for(int r=0;r<16;++r)negm[r]=-mhat; asm volatile("":"+v"(negm)); } \
    _Pragma("unroll") for(int r=0;r<16;++r)P0[r]=__builtin_amdgcn_exp2f(P0[r]); }while(0)
  #define RESC() do{ if(resc){ asm volatile("s_waitcnt lgkmcnt(0)":::"memory"); \
      _Pragma("unroll") for(int d_=0;d_<2;++d_) _Pragma("unroll") for(int r=0;r<16;++r)o[d_][r]*=wsf[crow(r,hi)]; } }while(0)
  f32x16 pA0,pA1,pB0,pB1;
  int sl_prev=0,sl_cur=0,sl_next=SLOTB;
  #define ROT() do{sl_prev=sl_cur;sl_cur=sl_next;sl_next=(sl_next==(NSLOT-1)*SLOTB)?0:sl_next+SLOTB;}while(0)
  DMA_K(2,2*SLOTB);
  WAIT_BAR(3);
  qkt(pA0,pA1,Kbase,qr,negm,r32,hi);asm volatile("s_nop 15\n\ts_nop 7":"+v"(pA0),"+v"(pA1));CMASK(pA0,pA1,0);
  START(pA0,pA1);
  _Pragma("unroll") for(int r=0;r<16;++r)pA1[r]=__builtin_amdgcn_exp2f(pA1[r]);
  WAIT_BAR(0);
  DMA_K(3,0);DMA_V(1,SLOTB);
  ROT();
  kload8(kf,kp0+sl_cur);
  WAIT_BAR(2);
  s16x4 vlo[8],vhi[8]; u32x4 pw0,pw1,pw2,pw3;
  #define PKW(P,B) cvtpk_s(P[B],P[B+1])
  #define PAF(k) __builtin_bit_cast(bf16x8,pw##k)
  #define VFR(i) (bf16x8){vlo[i][0],vlo[i][1],vlo[i][2],vlo[i][3],vhi[i][0],vhi[i][1],vhi[i][2],vhi[i][3]}
  #define PIN(x) asm volatile("":"+v"(x))
  #define MX3(a,b,c) __builtin_fmaxf(__builtin_fmaxf((a),(b)),(c))
  #define GAPA(MF,A0,A1,A2,A3,W0,W1,PW) do{ MF; sacc+=A0; sacc+=A1; sacc+=A2; sacc+=A3; PIN(sacc); W0; W1; PIN(PW); SBAR(); }while(0)
  #define EX(v) __builtin_amdgcn_exp2f(v)
  #define GAPB(MF,X,B) do{ MF; X[B]=EX(X[B]); X[B+1]=EX(X[B+1]); X[B+2]=EX(X[B+2]); X[B+3]=EX(X[B+3]); PIN(X); SBAR(); }while(0)
  #define VRD(i) do{ vlo[i]=vtr(vp_+(((i)>>2)*4096+((i)&3)*1024)); vhi[i]=vtr(vp_+(((i)>>2)*4096+((i)&3)*1024+512)); }while(0)
  #define KRD(G,j) do{ if(G){ kload2(kf,kp0+sl_next,j); SBAR(); } }while(0)
  #define STEP(C0,C1,P0,P1,t,GK,GV,GL) do{ SBAR(); \
    const lds_cptr vp_=vp0+sl_prev; \
    VRD(0); SBAR(); float sacc=(P0[0]+P0[1]); \
    GAPA(C0=__builtin_amdgcn_mfma_f32_32x32x16_bf16(kf[0],qr[0],negm,0,0,0), P0[2],P0[3],P0[4],P0[5],     pw0[0]=PKW(P0,0), pw0[1]=PKW(P0,2), pw0); \
    VRD(4); SBAR(); GAPA(C1=__builtin_amdgcn_mfma_f32_32x32x16_bf16(kf[1],qr[0],negm,0,0,0), P0[6],P0[7],P0[8],P0[9],     pw0[2]=PKW(P0,4), pw0[3]=PKW(P0,6), pw0); \
    VRD(1); SBAR(); GAPA(C0=__builtin_amdgcn_mfma_f32_32x32x16_bf16(kf[2],qr[1],C0,0,0,0),   P0[10],P0[11],P0[12],P0[13], pw1[0]=PKW(P0,8), pw1[1]=PKW(P0,10), pw1); \
    VRD(5); SBAR(); GAPA(C1=__builtin_amdgcn_mfma_f32_32x32x16_bf16(kf[3],qr[1],C1,0,0,0),   P0[14],P0[15],P1[0],P1[1],   pw1[2]=PKW(P0,12),pw1[3]=PKW(P0,14), pw1); \
    VRD(2); SBAR(); GAPA(C0=__builtin_amdgcn_mfma_f32_32x32x16_bf16(kf[4],qr[2],C0,0,0,0),   P1[2],P1[3],P1[4],P1[5],     pw2[0]=PKW(P1,0), pw2[1]=PKW(P1,2), pw2); \
    VRD(6); SBAR(); GAPA(C1=__builtin_amdgcn_mfma_f32_32x32x16_bf16(kf[5],qr[2],C1,0,0,0),   P1[6],P1[7],P1[8],P1[9],     pw2[2]=PKW(P1,4), pw2[3]=PKW(P1,6), pw2); \
    VRD(3); SBAR(); GAPA(C0=__builtin_amdgcn_mfma_f32_32x32x16_bf16(kf[6],qr[3],C0,0,0,0),   P1[10],P1[11],P1[12],P1[13], pw3[0]=PKW(P1,8), pw3[1]=PKW(P1,10), pw3); \
    VRD(7); SBAR(); GAPA(C1=__builtin_amdgcn_mfma_f32_32x32x16_bf16(kf[7],qr[3],C1,0,0,0),   P1[14],P1[15],0.f,0.f,       pw3[2]=PKW(P1,12),pw3[3]=PKW(P1,14), pw3); \
    l_reg+=sacc; \
    if(GK){DMA_K((t)+3,sl_cur);} if(GV){DMA_V((t)+1,sl_next);} \
    CMASK(C0,C1,t); \
    { float a=MX3(C0[0],C0[1],C1[0]),b=MX3(C0[2],C0[3],C1[1]); a=MX3(a,C1[2],C1[3]); \
      _Pragma("unroll") for(int r=4;r<16;r+=4){a=MX3(a,C0[r],C0[r+1]);b=MX3(b,C0[r+2],C0[r+3]);a=MX3(a,C1[r],C1[r+1]);b=MX3(b,C1[r+2],C1[r+3]);} \
      float rm=__builtin_fmaxf(a,b); { auto rr=__builtin_amdgcn_permlane32_swap(__float_as_uint(rm),__float_as_uint(rm),false,false); rm=__builtin_fmaxf(__uint_as_float(rr[0]),__uint_as_float(rr[1])); } \
      resc=false; \
      if(__builtin_expect(__any(rm>(float)THRL),0)){ const float dl=__builtin_fmaxf(rm,0.f); mhat+=dl; \
        _Pragma("unroll") for(int r=0;r<16;++r){C0[r]-=dl;C1[r]-=dl;} \
        _Pragma("unroll") for(int r=0;r<16;++r)negm[r]=-mhat; asm volatile("":"+v"(negm)); \
        const float f=__builtin_amdgcn_exp2f(-dl); l_reg*=f; if(hi==0)wsf[r32]=f; resc=true; } } \
    SBAR(); \
    GAPB(o[0]=__builtin_amdgcn_mfma_f32_32x32x16_bf16(PAF(0),VFR(0),o[0],0,0,0), C0,0); \
    GAPB(o[1]=__builtin_amdgcn_mfma_f32_32x32x16_bf16(PAF(0),VFR(4),o[1],0,0,0), C0,4); \
    KRD(GL,0); GAPB(o[0]=__builtin_amdgcn_mfma_f32_32x32x16_bf16(PAF(1),VFR(1),o[0],0,0,0), C0,8); \
    KRD(GL,1); GAPB(o[1]=__builtin_amdgcn_mfma_f32_32x32x16_bf16(PAF(1),VFR(5),o[1],0,0,0), C0,12); \
    KRD(GL,2); GAPB(o[0]=__builtin_amdgcn_mfma_f32_32x32x16_bf16(PAF(2),VFR(2),o[0],0,0,0), C1,0); \
    KRD(GL,3); GAPB(o[1]=__builtin_amdgcn_mfma_f32_32x32x16_bf16(PAF(2),VFR(6),o[1],0,0,0), C1,4); \
    GAPB(o[0]=__builtin_amdgcn_mfma_f32_32x32x16_bf16(PAF(3),VFR(3),o[0],0,0,0), C1,8); \
    GAPB(o[1]=__builtin_amdgcn_mfma_f32_32x32x16_bf16(PAF(3),VFR(7),o[1],0,0,0), C1,12); \
    }while(0)
  int t=1;
  #undef CMASK
  #define CMASK(P0,P1,t) do{}while(0)
  for(;t+5<NT;t+=2){
    STEP(pB0,pB1,pA0,pA1,t,true,true,true);     WAIT_BAR(2); RESC(); ROT();
    STEP(pA0,pA1,pB0,pB1,t+1,true,true,true);   WAIT_BAR(2); RESC(); ROT();
  }
  #undef CMASK
  #define CMASK(P0,P1,t) do{int jb_=(t)-(NT-4); if(jb_>=0)cmask(P0,P1,jb_,qrel,hi);}while(0)
  #define ENDW(tt) do{ if((tt)+3<NT){WAIT_BAR(2);} else if((tt)+2<NT){WAIT_BAR(1);} else {WAIT_BAR(0);} }while(0)
  for(;t+1<NT;t+=2){
    STEP(pB0,pB1,pA0,pA1,t,(t+3<NT),(t+1<NT),(t+1<NT));       ENDW(t);   RESC(); ROT();
    STEP(pA0,pA1,pB0,pB1,t+1,(t+4<NT),(t+2<NT),(t+2<NT));     ENDW(t+1); RESC(); ROT();
  }
  STEP(pB0,pB1,pA0,pA1,NT-1,false,false,false); RESC();
  { float sacc=pB0[0]+pB0[1]; _Pragma("unroll") for(int r=2;r<16;++r)sacc+=pB0[r]; _Pragma("unroll") for(int r=0;r<16;++r)sacc+=pB1[r]; l_reg+=sacc;
    pw0=(u32x4){PKW(pB0,0),PKW(pB0,2),PKW(pB0,4),PKW(pB0,6)};pw1=(u32x4){PKW(pB0,8),PKW(pB0,10),PKW(pB0,12),PKW(pB0,14)};pw2=(u32x4){PKW(pB1,0),PKW(pB1,2),PKW(pB1,4),PKW(pB1,6)};pw3=(u32x4){PKW(pB1,8),PKW(pB1,10),PKW(pB1,12),PKW(pB1,14)};
    SBAR(); pv(o,vb0+sl_cur,PAF(0),PAF(1),PAF(2),PAF(3)); }
  #undef PKW
  #undef PAF
  #undef VFR
  #undef PIN
  #undef MX3
  #undef GAPA
  #undef GAPB
  #undef EX
  #undef VRD
  #undef KRD
  #undef STEP
  #undef ENDW
  {auto rr=__builtin_amdgcn_permlane32_swap(__float_as_uint(l_reg),__float_as_uint(l_reg),false,false);l_reg=__uint_as_float(rr[0])+__uint_as_float(rr[1]);}
  if(hi==0)wsf[32+r32]=l_reg;asm volatile("s_waitcnt lgkmcnt(0)":::"memory");
  float rli[16];
  #pragma unroll
  for(int r=0;r<16;++r)rli[r]=__builtin_amdgcn_rcpf(wsf[32+crow(r,hi)]);
  bf16*Ow=O+(rowbase+q0+wid*QBLK)*PITO;
  { bf16*stg=(bf16*)(shm+LDS_OST)+wid*2048;
    #pragma unroll
    for(int r=0;r<16;++r){const int orow=crow(r,hi);
      #pragma unroll
      for(int d0=0;d0<2;++d0)stg[orow*64+d0*32+r32]=__float2bfloat16(o[d0][r]*rli[r]);}
    asm volatile("s_waitcnt lgkmcnt(0)":::"memory");
    #pragma unroll
    for(int i=0;i<4;++i){const int row=i*8+(lane>>3),ch=lane&7; const u32x4 v=*(const u32x4*)(stg+row*64+ch*8); ATTN_STORE16(Ow+(long)row*PITO+ch*8,v);} }
  asm volatile("s_waitcnt lgkmcnt(0)\n\ts_barrier":::"memory");
  #undef DMA_K
  #undef DMA_V
  #undef CMASK
  #undef START
  #undef RESC
  #undef ROT
}
constexpr int ATTN_LDS_BYTES=LDS_BYTES;
#undef SBAR
#undef WAIT_BAR
}

namespace cg = cooperative_groups;
typedef unsigned short bf16_t;
typedef float f32x4 __attribute__((ext_vector_type(4)));
typedef float f32x16 __attribute__((ext_vector_type(16)));
typedef unsigned u32x4 __attribute__((ext_vector_type(4)));
typedef unsigned u32x2 __attribute__((ext_vector_type(2)));
typedef short bf16x8 __attribute__((ext_vector_type(8)));
#define LAS3 __attribute__((address_space(3)))

constexpr int T_ = 32768, DM_ = 1024, SEQ_ = 4096, DFF_ = 2816;
constexpr int NTHR = 512;
constexpr int LDS_BYTES = 147456;
constexpr size_t MiB_ = 1u << 20;
constexpr size_t WS_MOD = 0, WS_COS = 1 * MiB_, WS_SIN = 2 * MiB_, WS_BAR = 3 * MiB_;
constexpr size_t WS_WIN = 4 * MiB_, WS_WOUT = 11 * MiB_, WS_FIN = 13 * MiB_, WS_FOUT = 24 * MiB_;
constexpr size_t WS_A = 32 * MiB_, WS_X2 = 96 * MiB_, WS_ST = 160 * MiB_, WS_TOT = 224 * MiB_, WS_R1 = 226 * MiB_, WS_BIAS = 450 * MiB_, WS_ROWSS = 452 * MiB_, WS_FOUT2 = 454 * MiB_, WS_END = 460 * MiB_;
constexpr int BIAS_L = 8 * (3584 + 5632);
constexpr size_t WS_HP = WS_ST, WS_HU = WS_ST + 12 * MiB_, WS_HA = WS_ST + 24 * MiB_;
constexpr float LOG2E_ = 1.4426950408889634f;
constexpr float QSCALE_ = 0.125f * 1.4426950408889634f;

struct Params {
    const float* x; const float* c; const int* positions; const float* mod_w; const float* mod_b; const float* norm_mix_w; const float* norm_ffn_w;
    const float* ev_w_in; const float* gla_gate_w; const float* gla_gate_b; const float* gla_norm_w; const float* swa_sinks; const float* ev_w_out;
    const float* od_w_in; const float* diff_lambda; const float* diff_norm_w; const float* hgrn_lb_logits; const float* hgrn_norm_w; const float* od_w_out;
    const float* ffn_w_in; const float* ffn_conv_w; const float* ffn_conv_b; const float* ffn_w_out; const float* final_norm_w;
    float* out; unsigned char* ws; unsigned long long pad[6];
};

__device__ __forceinline__ unsigned pk2(float lo, float hi) {
    typedef float f32x2_t __attribute__((ext_vector_type(2))); typedef __bf16 bf16x2_t __attribute__((ext_vector_type(2)));
    f32x2_t v = {lo, hi}; bf16x2_t b = __builtin_convertvector(v, bf16x2_t); return __builtin_bit_cast(unsigned, b);
}
__device__ __forceinline__ float bflo(unsigned u) { return __uint_as_float(u << 16); }
__device__ __forceinline__ float bfhi(unsigned u) { return __uint_as_float(u & 0xffff0000u); }
__device__ __forceinline__ float sigmoidf_(float x) { return __builtin_amdgcn_rcpf(1.f + __expf(-x)); }
__device__ __forceinline__ float siluf_(float x) { return x * __builtin_amdgcn_rcpf(1.f + __expf(-x)); }
__device__ __forceinline__ float wave_sum(float v) {
#pragma unroll
    for (int o = 1; o < 64; o <<= 1) v += __shfl_xor(v, o);
    return v;
}
__device__ __forceinline__ int crow_(int r, int hi) { return (r & 3) + 8 * (r >> 2) + 4 * hi; }

namespace pg8 {
struct EpiProj {
    static constexpr bool PERM = true, AFTER_DRAIN = false;
    bf16_t* O; int ldc; unsigned ropemask; unsigned scalemask; float scale; const float* cs; const float* sn; const float* rowss; const float* bias;
    __device__ __forceinline__ void operator()(const f32x4 (&acc)[2][2][4][2], const Unit& u, int, int, int, int) const {
        const int t_ = otid_(), l_ = t_ & 63, fr = l_ & 15, fq = l_ >> 4, wid_ = __builtin_amdgcn_readfirstlane(t_ >> 6), wr = wid_ >> 2, wc = wid_ & 3;
        const int row0 = u.pm * BM + wr * 64 + fr; const int col0 = u.pn * BM + wc * 32 + 8 * fq;
        float rs[2][4];
#pragma unroll
        for (int ai = 0; ai < 2; ++ai)
#pragma unroll
            for (int m = 0; m < 4; ++m) rs[ai][m] = rsqrtf(rowss[row0 + ai * HALF + m * 16] * (1.f / 1024.f) + 1e-6f);
        const float* bp = bias + (size_t)((u.pm * BM) >> 12) * ldc + col0;
#pragma unroll
        for (int bj = 0; bj < 2; ++bj) {
            const f32x4 bv0 = *(const f32x4*)(bp + bj * HALF), bv1 = *(const f32x4*)(bp + bj * HALF + 4);
            const int grp = u.pn * 2 + bj;
            const bool rope = ((ropemask >> grp) & 1u) && ((wc & 1) == 0);
            const float sc = ((scalemask >> grp) & 1u) ? scale : 1.f;
#pragma unroll
            for (int ai = 0; ai < 2; ++ai)
#pragma unroll
                for (int m = 0; m < 4; ++m) {
                    const int row = row0 + ai * HALF + m * 16;
                    f32x4 v0 = acc[ai][bj][m][0] * rs[ai][m] + bv0, v1 = acc[ai][bj][m][1] * rs[ai][m] + bv1;
                    if (rope) {
                        const f32x4 c0 = *(const f32x4*)(cs + (size_t)row * 8), c1 = *(const f32x4*)(cs + (size_t)row * 8 + 4);
                        const f32x4 s0 = *(const f32x4*)(sn + (size_t)row * 8), s1 = *(const f32x4*)(sn + (size_t)row * 8 + 4);
                        const float sg = (fq == 0) ? -1.f : 1.f;
#pragma unroll
                        for (int e = 0; e < 4; ++e) {
                            const float p0 = __shfl_xor(v0[e], 16), p1 = __shfl_xor(v1[e], 16);
                            const float r0 = v0[e] * c0[e] + sg * p0 * s0[e], r1 = v1[e] * c1[e] + sg * p1 * s1[e];
                            if (fq < 2) { v0[e] = r0; v1[e] = r1; }
                        }
                    }
                    v0 = v0 * sc; v1 = v1 * sc;
                    u32x4 w; w.x = pk2(v0[0], v0[1]); w.y = pk2(v0[2], v0[3]); w.z = pk2(v1[0], v1[1]); w.w = pk2(v1[2], v1[3]);
                    *(u32x4*)(O + (size_t)row * ldc + col0 + bj * HALF) = w;
                    asm volatile("" ::: "memory");
                }
        }
    }
};
typedef _Float16 h16x2 __attribute__((ext_vector_type(2)));
__device__ __forceinline__ unsigned pkh2(float lo, float hi) { typedef float f32x2_t __attribute__((ext_vector_type(2))); f32x2_t v = {lo, hi}; return __builtin_bit_cast(unsigned, __builtin_convertvector(v, h16x2)); }
__device__ __forceinline__ f32x4 unpkh4(unsigned w0, unsigned w1) { const h16x2 a = __builtin_bit_cast(h16x2, w0), b = __builtin_bit_cast(h16x2, w1); return (f32x4){(float)a[0], (float)a[1], (float)b[0], (float)b[1]}; }
struct EpiRes {
    static constexpr bool PERM = true, AFTER_DRAIN = false;
    const void* xin; void* xout; int inf32, outf32; const float* gate;
    bf16_t* Aout; const float* nw; const float* sc; float* rowss;
    __device__ __forceinline__ void operator()(const f32x4 (&acc)[2][2][4][2], const Unit& u, int, int, int, int) const {
        const int t_ = otid_(), l_ = t_ & 63, fr = l_ & 15, fq = l_ >> 4, wid_ = __builtin_amdgcn_readfirstlane(t_ >> 6), wr = wid_ >> 2, wc = wid_ & 3;
        const int col0 = u.pn * BM + wc * 32 + 8 * fq;
        const size_t boff = (size_t)((u.pm * BM) >> 12) * 6144 + col0;
        f32x4 gv[2][2];
#pragma unroll
        for (int bj = 0; bj < 2; ++bj)
#pragma unroll
            for (int n = 0; n < 2; ++n) gv[bj][n] = *(const f32x4*)(gate + boff + bj * HALF + n * 4);
        const int rowb = u.pm * BM + wr * 64 + fr;
        const unsigned eo0 = (unsigned)rowb * 1024u + (unsigned)col0;
        const char* xi = (const char*)xin; char* xo = (char*)xout; char* ao = (char*)Aout;
#pragma unroll
        for (int grp = 0; grp < 8; ++grp) {
            const int ai = grp >> 2, m = grp & 3;
            const unsigned eo = eo0 + (unsigned)(ai * HALF + m * 16) * 1024u;
            float ss = 0.f;
#pragma unroll
            for (int bj = 0; bj < 2; ++bj) {
                const unsigned e2 = eo + (unsigned)(bj * HALF);
                f32x4 x0, x1;
                if (inf32) { x0 = *(const f32x4*)(xi + e2 * 4u); x1 = *(const f32x4*)(xi + e2 * 4u + 16u); }
                else { const u32x4 h = *(const u32x4*)(xi + e2 * 2u); x0 = unpkh4(h.x, h.y); x1 = unpkh4(h.z, h.w); }
                const f32x4 xn0 = x0 + gv[bj][0] * acc[ai][bj][m][0], xn1 = x1 + gv[bj][1] * acc[ai][bj][m][1];
                if (outf32) { *(f32x4*)(xo + e2 * 4u) = xn0; *(f32x4*)(xo + e2 * 4u + 16u) = xn1; }
                else { u32x4 h; h.x = pkh2(xn0[0], xn0[1]); h.y = pkh2(xn0[2], xn0[3]); h.z = pkh2(xn1[0], xn1[1]); h.w = pkh2(xn1[2], xn1[3]); *(u32x4*)(xo + e2 * 2u) = h; }
                if (Aout) {
                    ss += ((xn0[0] * xn0[0] + xn0[1] * xn0[1]) + (xn0[2] * xn0[2] + xn0[3] * xn0[3])) + ((xn1[0] * xn1[0] + xn1[1] * xn1[1]) + (xn1[2] * xn1[2] + xn1[3] * xn1[3]));
                    const f32x4 a0 = xn0 * (*(const f32x4*)(nw + col0 + bj * HALF) * (*(const f32x4*)(sc + boff + bj * HALF) + 1.f));
                    const f32x4 a1 = xn1 * (*(const f32x4*)(nw + col0 + bj * HALF + 4) * (*(const f32x4*)(sc + boff + bj * HALF + 4) + 1.f));
                    u32x4 q; q.x = pk2(a0[0], a0[1]); q.y = pk2(a0[2], a0[3]); q.z = pk2(a1[0], a1[1]); q.w = pk2(a1[2], a1[3]);
                    *(u32x4*)(ao + e2 * 2u) = q;
                }
            }
            if (Aout) {
                ss += __shfl_xor(ss, 16); ss += __shfl_xor(ss, 32);
                if (fq == 0) atomicAdd(rowss + rowb + ai * HALF + m * 16, ss);
            }
            asm volatile("" ::: "memory");
        }
    }
};
struct EpiFfn {
    static constexpr bool PERM = true, AFTER_DRAIN = false;
    bf16_t* G; unsigned short* HP; unsigned short* HU; unsigned short* HA;   const float* cw; const float* cb; const float* rowss; const float* bias;
    __device__ __forceinline__ void operator()(const f32x4 (&acc)[2][2][4][2], const Unit& u, int, int, int, int) const {
        const int t_ = otid_(), l_ = t_ & 63, fr = l_ & 15, fq = l_ >> 4, wid_ = __builtin_amdgcn_readfirstlane(t_ >> 6), wr = wid_ >> 2, wc = wid_ & 3;
        const int ch0 = u.pn * 128 + wc * 32 + 8 * fq;
        f32x4 w0[2], w1[2], w2[2], bb[2];
#pragma unroll
        for (int n = 0; n < 2; ++n) { w0[n] = *(const f32x4*)(cw + ch0 + 4 * n); w1[n] = *(const f32x4*)(cw + DFF_ + ch0 + 4 * n); w2[n] = *(const f32x4*)(cw + 2 * DFF_ + ch0 + 4 * n); bb[n] = *(const f32x4*)(cb + ch0 + 4 * n); }
        const int lane = fr + 16 * fq;
        const int src1 = (lane & ~15) | ((fr + 15) & 15), src2 = (lane & ~15) | ((fr + 14) & 15);
        const float* bp = bias + (size_t)((u.pm * BM) >> 12) * 5632 + u.pn * BM + wc * 32 + 8 * fq;
        f32x4 ba[2], bu[2];
#pragma unroll
        for (int n = 0; n < 2; ++n) { ba[n] = *(const f32x4*)(bp + 4 * n); bu[n] = *(const f32x4*)(bp + HALF + 4 * n); }
#pragma unroll
        for (int ai = 0; ai < 2; ++ai) {
            const int seg = u.pm * 4 + ai * 2 + wr;
            f32x4 aprev[2]; aprev[0] = (f32x4){0.f, 0.f, 0.f, 0.f}; aprev[1] = (f32x4){0.f, 0.f, 0.f, 0.f};
#pragma unroll
            for (int m = 0; m < 4; ++m) {
                const int row = u.pm * BM + ai * HALF + wr * 64 + m * 16 + fr;
                const float rs = rsqrtf(rowss[row] * (1.f / 1024.f) + 1e-6f);
                f32x4 val[2], acur[2];
#pragma unroll
                for (int n = 0; n < 2; ++n) {
                    const f32x4 a = acc[ai][0][m][n] * rs + ba[n];
                    acur[n] = a;
                    const f32x4 ap = aprev[n];
#pragma unroll
                    for (int e = 0; e < 4; ++e) {
                        const float t1 = (fr == 15) ? ap[e] : a[e];
                        const float t2 = (fr >= 14) ? ap[e] : a[e];
                        const float p1 = __shfl(t1, src1), p2 = __shfl(t2, src2);
                        val[n][e] = w2[n][e] * a[e] + w1[n][e] * p1 + w0[n][e] * p2 + bb[n][e];
                    }
                }
                const f32x4 u0 = acc[ai][1][m][0] * rs + bu[0], u1 = acc[ai][1][m][1] * rs + bu[1];
                f32x4 g0, g1;
#pragma unroll
                for (int e = 0; e < 4; ++e) { g0[e] = siluf_(val[0][e]) * u0[e]; g1[e] = siluf_(val[1][e]) * u1[e]; }
                u32x4 w; w.x = pk2(g0[0], g0[1]); w.y = pk2(g0[2], g0[3]); w.z = pk2(g1[0], g1[1]); w.w = pk2(g1[2], g1[3]);
                *(u32x4*)(G + (size_t)row * DFF_ + ch0) = w;
                if (m == 0 && fr < 2) {
                    const size_t ho = (size_t)(seg * 2 + fr) * DFF_ + ch0;
                    u32x4 hp; hp.x = pkh2(val[0][0], val[0][1]); hp.y = pkh2(val[0][2], val[0][3]); hp.z = pkh2(val[1][0], val[1][1]); hp.w = pkh2(val[1][2], val[1][3]);
                    u32x4 hu; hu.x = pkh2(u0[0], u0[1]); hu.y = pkh2(u0[2], u0[3]); hu.z = pkh2(u1[0], u1[1]); hu.w = pkh2(u1[2], u1[3]);
                    *(u32x4*)(HP + ho) = hp; *(u32x4*)(HU + ho) = hu;
                }
                if (m == 3 && fr >= 14) {
                    const size_t ho = (size_t)(seg * 2 + (fr - 14)) * DFF_ + ch0;
                    u32x4 ha; ha.x = pkh2(acur[0][0], acur[0][1]); ha.y = pkh2(acur[0][2], acur[0][3]); ha.z = pkh2(acur[1][0], acur[1][1]); ha.w = pkh2(acur[1][2], acur[1][3]);
                    *(u32x4*)(HA + ho) = ha;
                }
                aprev[0] = acur[0]; aprev[1] = acur[1];
                asm volatile("" ::: "memory");
            }
        }
    }
};
}

struct Ctx { Params p; unsigned char* lds; int tid, lane, wave, gw, ngw; };

__device__ __forceinline__ void phase_prologue(const Ctx& C) {
    const Params& p = C.p;
    float* cact = (float*)C.lds;
    float* red = (float*)(C.lds + 32768);
    float* mod = (float*)(p.ws + WS_MOD);
    const int tid = C.tid;
    for (int i = tid; i < 8192; i += NTHR) { const float c = p.c[i]; cact[i] = c / (1.f + __expf(-c)); }
    __syncthreads();
    const int col = tid & 63, kp = tid >> 6;
    for (int g = blockIdx.x; g < 384; g += gridDim.x) {
        const int l = g / 96, j = (g % 96) * 64 + col;
        const float* w = p.mod_w + (size_t)l * 1024 * 6144 + (size_t)(kp * 128) * 6144 + j;
        float a0 = 0.f, a1 = 0.f, a2 = 0.f, a3 = 0.f, a4 = 0.f, a5 = 0.f, a6 = 0.f, a7 = 0.f;
        const float* ca = cact + kp * 128;
#pragma unroll 8
        for (int k = 0; k < 128; ++k) {
            const float wv = w[(size_t)k * 6144];
            a0 += ca[k] * wv; a1 += ca[1024 + k] * wv; a2 += ca[2048 + k] * wv; a3 += ca[3072 + k] * wv;
            a4 += ca[4096 + k] * wv; a5 += ca[5120 + k] * wv; a6 += ca[6144 + k] * wv; a7 += ca[7168 + k] * wv;
        }
        float* r = red + (kp * 8) * 64 + col;
        r[0] = a0; r[64] = a1; r[128] = a2; r[192] = a3; r[256] = a4; r[320] = a5; r[384] = a6; r[448] = a7;
        __syncthreads();
        { const int b = tid >> 6; float s = 0.f;
#pragma unroll
          for (int kk = 0; kk < 8; ++kk) s += red[(kk * 8 + b) * 64 + col];
          mod[(size_t)(l * 8 + b) * 6144 + j] = s + p.mod_b[l * 6144 + j]; }
        __syncthreads();
    }
    {
        u32x4* zb = (u32x4*)(p.ws + WS_BIAS); const int nzb = 4 * BIAS_L * 4 / 16;
        for (int i = blockIdx.x * NTHR + tid; i < nzb; i += gridDim.x * NTHR) zb[i] = (u32x4){0u, 0u, 0u, 0u};
        u32x4* zr = (u32x4*)(p.ws + WS_ROWSS);
        for (int i = blockIdx.x * NTHR + tid; i < 8 * T_ * 4 / 16; i += gridDim.x * NTHR) zr[i] = (u32x4){0u, 0u, 0u, 0u};
    }
    float* cs = (float*)(p.ws + WS_COS); float* sn = (float*)(p.ws + WS_SIN);
    const float invf[8] = {1.0f, 0.1939227432012558f, 0.03760603070259094f, 0.007292664609849453f, 0.0014142135623842478f, 0.00027424818836152554f, 5.3182957344688475e-05f, 1.0313385246263351e-05f};
    for (int r = blockIdx.x * NTHR + tid; r < T_; r += gridDim.x * NTHR) {
        const float pos = (float)p.positions[r];
        f32x4 c4[2], s4[2];
#pragma unroll
        for (int i = 0; i < 8; ++i) {
            const float ang = pos * invf[i];
            const double xr = (double)ang * 0.15915494309189535;
            const float f = (float)(xr - rint(xr));
            c4[i >> 2][i & 3] = __builtin_amdgcn_cosf(f); s4[i >> 2][i & 3] = __builtin_amdgcn_sinf(f);
        }
        *(f32x4*)(cs + (size_t)r * 8) = c4[0]; *(f32x4*)(cs + (size_t)r * 8 + 4) = c4[1];
        *(f32x4*)(sn + (size_t)r * 8) = s4[0]; *(f32x4*)(sn + (size_t)r * 8 + 4) = s4[1];
    }
}

__device__ __forceinline__ void tr_item(const float* W, int Nsrc, int srccol0, bf16_t* WT, int K, int dstrow0, int k0, float* scr, int lane) {
    float wv[32];
#pragma unroll
    for (int i = 0; i < 32; ++i) wv[i] = W[(size_t)(k0 + 2 * i + (lane >> 5)) * Nsrc + srccol0 + (lane & 31)];
#pragma unroll
    for (int i = 0; i < 32; ++i) scr[(2 * i + (lane >> 5)) * 33 + (lane & 31)] = wv[i];
    asm volatile("s_waitcnt lgkmcnt(0)" ::: "memory");
    const int c = lane & 7;
#pragma unroll
    for (int j = 0; j < 4; ++j) { const int n = (lane >> 3) + 8 * j; const float* s = scr + (8 * c) * 33 + n;
        u32x4 o; o.x = pk2(s[0 * 33], s[1 * 33]); o.y = pk2(s[2 * 33], s[3 * 33]); o.z = pk2(s[4 * 33], s[5 * 33]); o.w = pk2(s[6 * 33], s[7 * 33]);
        *(u32x4*)(WT + (size_t)(dstrow0 + n) * K + k0 + 8 * c) = o; }
    asm volatile("s_waitcnt lgkmcnt(0)" ::: "memory");
}
__device__ __forceinline__ void phase_convert(const Ctx& C, int l, bool do_bias = true) {
    const Params& p = C.p; const int j = l >> 1; const bool even = !(l & 1);
    float* scr = (float*)(C.lds + C.wave * 8704);
    bf16_t* WIN = (bf16_t*)(p.ws + WS_WIN); bf16_t* WOUT = (bf16_t*)(p.ws + WS_WOUT); bf16_t* FIN = (bf16_t*)(p.ws + WS_FIN); bf16_t* FOUT = (bf16_t*)(p.ws + ((l & 1) ? WS_FOUT2 : WS_FOUT));
    const int nA = even ? 80 : 112;
    const int IA = 16 * nA, IB = 16 * 32, IC = 16 * 176, ID = 44 * 32;
    const float* win = even ? p.ev_w_in + (size_t)j * 1024 * 2320 : p.od_w_in + (size_t)j * 1024 * 3584;
    const float* wout = even ? p.ev_w_out + (size_t)j * 1024 * 1024 : p.od_w_out + (size_t)j * 1024 * 1024;
    const float* fin = p.ffn_w_in + (size_t)l * 1024 * 5632; const float* fout = p.ffn_w_out + (size_t)l * 2816 * 1024;
    for (int it = C.gw; it < IA + IB + IC + ID; it += C.ngw) {
        int r = it;
        if (r < IA) { const int kb = r / nA, nb = r % nA, n0 = nb * 32; int sc = n0;
            if (even) { if (n0 >= 512 && n0 < 768) continue; if (n0 >= 1792) sc = n0 - 240; else if (n0 >= 768) sc = n0 - 256; }
            tr_item(win, even ? 2320 : 3584, sc, WIN, 1024, n0, kb * 64, scr, C.lane); continue; }
        r -= IA;
        if (r < IB) { const int kb = r / 32, nb = r % 32; tr_item(wout, 1024, nb * 32, WOUT, 1024, nb * 32, kb * 64, scr, C.lane); continue; }
        r -= IB;
        if (r < IC) { const int kb = r / 176, nb = r % 176, n0 = nb * 32; const int pn = n0 >> 8, jj = n0 & 255;
            const int sc = (jj < 128) ? pn * 128 + jj : 2816 + pn * 128 + (jj - 128);
            tr_item(fin, 5632, sc, FIN, 1024, n0, kb * 64, scr, C.lane); continue; }
        r -= IC;
        { const int kb = r / 32, nb = r % 32; tr_item(fout, 1024, nb * 32, FOUT, 2816, nb * 32, kb * 64, scr, C.lane); }
    }
    if (do_bias) {
        float* shl = (float*)(C.lds + 69632);
        const float* modl = (const float*)(p.ws + WS_MOD) + (size_t)l * 8 * 6144;
        __syncthreads();
        for (int i2 = C.tid; i2 < 2 * 8192; i2 += NTHR) { const int which = i2 >> 13, k = (i2 >> 3) & 1023, b = i2 & 7; shl[i2] = modl[(size_t)b * 6144 + (which ? 3072 : 0) + k]; }
        __syncthreads();
        float* bias_in = (float*)(p.ws + WS_BIAS) + (size_t)l * BIAS_L; float* bias_ff = bias_in + 8 * 3584;
        const int Nin = even ? 2560 : 3584, Nsrc = even ? 2320 : 3584;
        const float* gwp = p.gla_gate_w + (size_t)j * 16 * 256;
        for (int u = blockIdx.x * NTHR + C.tid; u < (Nin + 5632) * 16; u += gridDim.x * NTHR) {
            const bool ff = u >= Nin * 16; const int uu = ff ? u - Nin * 16 : u, N = ff ? 5632 : Nin, n = uu % N, kp = uu / N;
            float a[8];
#pragma unroll
            for (int b = 0; b < 8; ++b) a[b] = 0.f;
            const float* shp = shl + (ff ? 8192 : 0) + kp * 64 * 8;
            if (!ff && even && n >= 512 && n < 768) {
                float g[16];
#pragma unroll
                for (int r = 0; r < 16; ++r) g[r] = gwp[r * 256 + (n - 512)];
                for (int k = 0; k < 64; ++k) {
                    const float* wr = win + (size_t)(kp * 64 + k) * 2320 + 1536;
                    float wv = 0.f;
#pragma unroll
                    for (int r = 0; r < 16; ++r) wv += wr[r] * g[r];
                    const f32x4 s0 = *(const f32x4*)(shp + k * 8), s1 = *(const f32x4*)(shp + k * 8 + 4);
                    a[0] += s0[0] * wv; a[1] += s0[1] * wv; a[2] += s0[2] * wv; a[3] += s0[3] * wv; a[4] += s1[0] * wv; a[5] += s1[1] * wv; a[6] += s1[2] * wv; a[7] += s1[3] * wv;
                }
            } else {
                int sc; const float* W; int Ns;
                if (ff) { const int pn = n >> 8, jj = n & 255; sc = (jj < 128) ? pn * 128 + jj : 2816 + pn * 128 + (jj - 128); W = fin; Ns = 5632; }
                else { sc = n; if (even) { if (n >= 1792) sc = n - 240; else if (n >= 768) sc = n - 256; } W = win; Ns = Nsrc; }
                const float* wp = W + (size_t)(kp * 64) * Ns + sc;
#pragma unroll 8
                for (int k = 0; k < 64; ++k) {
                    const float wv = wp[(size_t)k * Ns];
                    const f32x4 s0 = *(const f32x4*)(shp + k * 8), s1 = *(const f32x4*)(shp + k * 8 + 4);
                    a[0] += s0[0] * wv; a[1] += s0[1] * wv; a[2] += s0[2] * wv; a[3] += s0[3] * wv; a[4] += s1[0] * wv; a[5] += s1[1] * wv; a[6] += s1[2] * wv; a[7] += s1[3] * wv;
                }
            }
            float* bo = (ff ? bias_ff : bias_in) + n;
#pragma unroll
            for (int b = 0; b < 8; ++b) atomicAdd(bo + (size_t)b * N, a[b]);
        }
    }
    if (even) {
        const float* gw = p.gla_gate_w + (size_t)j * 16 * 256;
        for (int u = blockIdx.x * NTHR + C.tid; u < 256 * 128; u += gridDim.x * NTHR) {
            const int k8 = u & 127, n = u >> 7;
            float g[16];
#pragma unroll
            for (int r = 0; r < 16; ++r) g[r] = gw[r * 256 + n];
            float o[8];
#pragma unroll
            for (int e = 0; e < 8; ++e) {
                const float* wr = win + (size_t)(k8 * 8 + e) * 2320 + 1536;
                const f32x4 a0 = *(const f32x4*)wr, a1 = *(const f32x4*)(wr + 4), a2 = *(const f32x4*)(wr + 8), a3 = *(const f32x4*)(wr + 12);
                o[e] = a0[0] * g[0] + a0[1] * g[1] + a0[2] * g[2] + a0[3] * g[3] + a1[0] * g[4] + a1[1] * g[5] + a1[2] * g[6] + a1[3] * g[7]
                     + a2[0] * g[8] + a2[1] * g[9] + a2[2] * g[10] + a2[3] * g[11] + a3[0] * g[12] + a3[1] * g[13] + a3[2] * g[14] + a3[3] * g[15];
            }
            u32x4 w; w.x = pk2(o[0], o[1]); w.y = pk2(o[2], o[3]); w.z = pk2(o[4], o[5]); w.w = pk2(o[6], o[7]);
            *(u32x4*)(WIN + (size_t)(512 + n) * 1024 + k8 * 8) = w;
        }
    }
}

__device__ __forceinline__ void phase_prep(const Ctx& C, const float* xin, const float* w, const float* modl, int scoff, bf16_t* out, float* rowss) {
    for (int row = C.gw; row < T_; row += C.ngw) {
        const f32x4* xr = (const f32x4*)(xin + (size_t)row * 1024) + C.lane;
        f32x4 v[4]; float ss = 0.f;
#pragma unroll
        for (int j = 0; j < 4; ++j) { v[j] = xr[64 * j]; ss += (v[j].x * v[j].x + v[j].y * v[j].y) + (v[j].z * v[j].z + v[j].w * v[j].w); }
        ss = wave_sum(ss);
        if (C.lane == 0) rowss[row] = ss;
        const float* mb = modl + (size_t)(row >> 12) * 6144;
        u32x2* o8 = (u32x2*)(out + (size_t)row * 1024) + C.lane;
#pragma unroll
        for (int j = 0; j < 4; ++j) {
            const int col = 4 * C.lane + 256 * j;
            const f32x4 w4 = *(const f32x4*)(w + col), sc = *(const f32x4*)(mb + scoff + col);
            const f32x4 y = v[j] * w4 * (sc + 1.f);
            u32x2 q; q.x = pk2(y.x, y.y); q.y = pk2(y.z, y.w); o8[64 * j] = q;
        }
    }
}
__device__ __forceinline__ void phase_final_norm(const Ctx& C, const void* xin  , float* out, const float* w) {
    for (int row = C.gw; row < T_; row += C.ngw) {
        const u32x2* xr = (const u32x2*)((const char*)xin + (size_t)row * 2048) + C.lane;
        f32x4* orow = (f32x4*)(out + (size_t)row * 1024) + C.lane;
        f32x4 v[4]; float ss = 0.f;
#pragma unroll
        for (int j = 0; j < 4; ++j) { const u32x2 h = xr[64 * j]; v[j] = pg8::unpkh4(h.x, h.y); ss += (v[j].x * v[j].x + v[j].y * v[j].y) + (v[j].z * v[j].z + v[j].w * v[j].w); }
        const float rs = rsqrtf(wave_sum(ss) * (1.f / 1024.f) + 1e-6f);
#pragma unroll
        for (int j = 0; j < 4; ++j) { const f32x4 w4 = *(const f32x4*)(w + 4 * C.lane + 256 * j); orow[64 * j] = (v[j] * rs) * w4; }
    }
}

__device__ __forceinline__ void phase_diff_combine(const Ctx& C, int l) {
    const Params& p = C.p; const int j = l >> 1;
    const float lam_init = 0.8f - 0.6f * expf(-0.3f * (float)l);
    const float* lv = p.diff_lambda + j * 256;
    const float s1 = wave_sum(lv[C.lane] * lv[64 + C.lane]), s2 = wave_sum(lv[128 + C.lane] * lv[192 + C.lane]);
    const float lam = expf(s1) - expf(s2) + lam_init;
    const bf16_t* X2 = (const bf16_t*)(p.ws + WS_X2); bf16_t* A = (bf16_t*)(p.ws + WS_A);
    const int head = C.lane >> 4, d0 = (C.lane & 15) * 8;
    const float* nw = p.diff_norm_w + j * 128 + d0;
    const f32x4 n0 = *(const f32x4*)nw, n1 = *(const f32x4*)(nw + 4);
    const float og = 1.f - lam_init;
    for (int row = C.gw; row < T_; row += C.ngw) {
        const bf16_t* src = X2 + (size_t)row * 1024 + head * 256 + d0;
        const u32x4 a = *(const u32x4*)src, b = *(const u32x4*)(src + 128);
        float od[8];
        od[0] = bflo(a.x) - lam * bflo(b.x); od[1] = bfhi(a.x) - lam * bfhi(b.x); od[2] = bflo(a.y) - lam * bflo(b.y); od[3] = bfhi(a.y) - lam * bfhi(b.y);
        od[4] = bflo(a.z) - lam * bflo(b.z); od[5] = bfhi(a.z) - lam * bfhi(b.z); od[6] = bflo(a.w) - lam * bflo(b.w); od[7] = bfhi(a.w) - lam * bfhi(b.w);
        float ss = 0.f;
#pragma unroll
        for (int e = 0; e < 8; ++e) ss += od[e] * od[e];
        ss += __shfl_xor(ss, 1); ss += __shfl_xor(ss, 2); ss += __shfl_xor(ss, 4); ss += __shfl_xor(ss, 8);
        const float rs = rsqrtf(ss * (1.f / 128.f) + 1e-6f) * og;
        u32x4 w; w.x = pk2(od[0] * rs * n0[0], od[1] * rs * n0[1]); w.y = pk2(od[2] * rs * n0[2], od[3] * rs * n0[3]);
        w.z = pk2(od[4] * rs * n1[0], od[5] * rs * n1[1]); w.w = pk2(od[6] * rs * n1[2], od[7] * rs * n1[3]);
        *(u32x4*)(A + (size_t)row * 1024 + head * 128 + d0) = w;
    }
}

__device__ __forceinline__ void phase_ffn_fixup(const Ctx& C, int l) {
    const Params& p = C.p;
    const unsigned short* HP = (const unsigned short*)(p.ws + WS_HP); const unsigned short* HU = (const unsigned short*)(p.ws + WS_HU); const unsigned short* HA = (const unsigned short*)(p.ws + WS_HA);
    bf16_t* G = (bf16_t*)(p.ws + WS_R1);
    const float* cw = p.ffn_conv_w + (size_t)l * 3 * DFF_;
    for (int u = blockIdx.x * NTHR + C.tid; u < 512 * 2 * 704; u += gridDim.x * NTHR) {
        const int c4 = u % 704, sj = u / 704, jj = sj & 1, seg = sj >> 1, ch = c4 * 4;
        const size_t ho = (size_t)sj * DFF_ + ch;
        const u32x2 hv = *(const u32x2*)(HP + ho), hu = *(const u32x2*)(HU + ho);
        f32x4 val = pg8::unpkh4(hv.x, hv.y); const f32x4 uu = pg8::unpkh4(hu.x, hu.y);
        if ((seg & 63) != 0) {
            const u32x2 h1 = *(const u32x2*)(HA + (size_t)((seg - 1) * 2 + 1) * DFF_ + ch), h2 = *(const u32x2*)(HA + (size_t)((seg - 1) * 2) * DFF_ + ch);
            const f32x4 am1 = pg8::unpkh4(h1.x, h1.y), am2 = pg8::unpkh4(h2.x, h2.y);
            const f32x4 w0 = *(const f32x4*)(cw + ch), w1 = *(const f32x4*)(cw + DFF_ + ch);
            if (jj == 0) val = val + w1 * am1 + w0 * am2; else val = val + w0 * am1;
        }
        u32x2 q; q.x = pk2(siluf_(val.x) * uu.x, siluf_(val.y) * uu.y); q.y = pk2(siluf_(val.z) * uu.z, siluf_(val.w) * uu.w);
        *(u32x2*)(G + (size_t)(seg * 64 + jj) * DFF_ + ch) = q;
    }
}

__device__ __forceinline__ void phase_swa(const Ctx& C, int l) {
    const Params& p = C.p;
    const bf16_t* proj = (const bf16_t*)(p.ws + WS_R1); bf16_t* A = (bf16_t*)(p.ws + WS_A);
    bf16_t* Ks = (bf16_t*)C.lds;
    bf16_t* Vt = (bf16_t*)(C.lds + 27648);
    const int tid = C.tid, lane = C.lane, wid = C.wave, r32 = lane & 31, hi = lane >> 5;
    const float* sinks = p.swa_sinks + (l >> 1) * 8;
    u32x4 kreg[3], vreg[3];
#define SWA_FETCH(uu) do { const int b_ = (uu) >> 7, kvh_ = ((uu) >> 6) & 1, q0_ = ((uu) & 63) * 64; const size_t rb_ = (size_t)b_ * SEQ_; \
        _Pragma("unroll") for (int i_ = 0; i_ < 3; ++i_) { const int c_ = tid + i_ * NTHR; \
            { const int kk_ = c_ >> 3, ch_ = c_ & 7, pl_ = q0_ - 128 + kk_; kreg[i_] = (u32x4){0u, 0u, 0u, 0u}; if (pl_ >= 0) kreg[i_] = *(const u32x4*)(proj + (rb_ + pl_) * 2560 + 2304 + kvh_ * 64 + ch_ * 8); } \
            { const int kk_ = c_ % 192, ch_ = c_ / 192, pl_ = q0_ - 128 + kk_; vreg[i_] = (u32x4){0u, 0u, 0u, 0u}; if (pl_ >= 0) vreg[i_] = *(const u32x4*)(proj + (rb_ + pl_) * 2560 + 2432 + kvh_ * 64 + ch_ * 8); } } } while (0)
    if ((int)blockIdx.x < 1024) SWA_FETCH((int)blockIdx.x);
    for (int u = blockIdx.x; u < 1024; u += gridDim.x) {
        const int b = u >> 7, kvh = (u >> 6) & 1, qb = u & 63, q0 = qb * 64; const size_t rowbase = (size_t)b * SEQ_;
#pragma unroll
        for (int i = 0; i < 3; ++i) {
            const int c = tid + i * NTHR;
            { const int kk = c >> 3, ch = c & 7; *(u32x4*)(Ks + kk * 72 + ch * 8) = kreg[i]; }
            { const int kk = c % 192, ch = c / 192; const u32x4 vv = vreg[i];
              bf16_t* vd = Vt + (ch * 8) * 200 + kk;
              vd[0] = (bf16_t)(vv.x & 0xffffu); vd[200] = (bf16_t)(vv.x >> 16); vd[400] = (bf16_t)(vv.y & 0xffffu); vd[600] = (bf16_t)(vv.y >> 16);
              vd[800] = (bf16_t)(vv.z & 0xffffu); vd[1000] = (bf16_t)(vv.z >> 16); vd[1200] = (bf16_t)(vv.w & 0xffffu); vd[1400] = (bf16_t)(vv.w >> 16); }
        }
        { const int nx = u + (int)gridDim.x; if (nx < 1024) SWA_FETCH(nx); }
        __syncthreads();
        const int g = wid >> 1, qh = kvh * 4 + g, qhalf = wid & 1, pq = q0 + 32 * qhalf + r32;
        const bf16_t* qsrc = proj + (rowbase + pq) * 2560 + 1792 + qh * 64;
        bf16x8 qr[4];
#pragma unroll
        for (int d0 = 0; d0 < 4; ++d0) qr[d0] = *(const bf16x8*)(qsrc + d0 * 16 + hi * 8);
        f32x16 s[5];
#pragma unroll
        for (int t = 0; t < 5; ++t) {
            f32x16 a = {};
#pragma unroll
            for (int d0 = 0; d0 < 4; ++d0) {
                const bf16x8 kf = *(const bf16x8*)(Ks + (32 * (qhalf + t) + r32) * 72 + d0 * 16 + hi * 8);
                a = __builtin_amdgcn_mfma_f32_32x32x16_bf16(kf, qr[d0], a, 0, 0, 0);
            }
            s[t] = a;
        }
        const float sink2 = sinks[qh] * LOG2E_;
        float mx = sink2;
#pragma unroll
        for (int t = 0; t < 5; ++t)
#pragma unroll
            for (int r = 0; r < 16; ++r) {
                const int pk = q0 - 128 + 32 * (qhalf + t) + crow_(r, hi);
                const bool valid = (pk >= 0) && (pk <= pq) && (pq - pk < 128);
                const float v = valid ? s[t][r] : -INFINITY; s[t][r] = v; mx = fmaxf(mx, v);
            }
        mx = fmaxf(mx, __shfl_xor(mx, 32));
        float sum = 0.f;
#pragma unroll
        for (int t = 0; t < 5; ++t)
#pragma unroll
            for (int r = 0; r < 16; ++r) { const float e = __builtin_amdgcn_exp2f(s[t][r] - mx); s[t][r] = e; sum += e; }
        sum += __shfl_xor(sum, 32);
        sum += __builtin_amdgcn_exp2f(sink2 - mx);
        const float inv = 1.f / sum;
        f32x16 o[2]; o[0] = f32x16{}; o[1] = f32x16{};
#pragma unroll
        for (int t = 0; t < 5; ++t)
#pragma unroll
            for (int ss = 0; ss < 2; ++ss) {
                u32x4 pw; pw.x = pk2(s[t][8 * ss + 0], s[t][8 * ss + 1]); pw.y = pk2(s[t][8 * ss + 2], s[t][8 * ss + 3]); pw.z = pk2(s[t][8 * ss + 4], s[t][8 * ss + 5]); pw.w = pk2(s[t][8 * ss + 6], s[t][8 * ss + 7]);
                const bf16x8 pf = __builtin_bit_cast(bf16x8, pw);
#pragma unroll
                for (int dt = 0; dt < 2; ++dt) {
                    const bf16_t* vp = Vt + (32 * dt + r32) * 200 + 32 * (qhalf + t) + 16 * ss + 4 * hi;
                    const u32x2 lo = *(const u32x2*)vp, h2 = *(const u32x2*)(vp + 8);
                    u32x4 vw; vw.x = lo.x; vw.y = lo.y; vw.z = h2.x; vw.w = h2.y;
                    o[dt] = __builtin_amdgcn_mfma_f32_32x32x16_bf16(__builtin_bit_cast(bf16x8, vw), pf, o[dt], 0, 0, 0);
                }
            }
        bf16_t* orow = A + (rowbase + pq) * 1024 + 512 + qh * 64;
#pragma unroll
        for (int dt = 0; dt < 2; ++dt)
#pragma unroll
            for (int g4 = 0; g4 < 4; ++g4) {
                u32x2 q; q.x = pk2(o[dt][4 * g4] * inv, o[dt][4 * g4 + 1] * inv); q.y = pk2(o[dt][4 * g4 + 2] * inv, o[dt][4 * g4 + 3] * inv);
                *(u32x2*)(orow + 32 * dt + 8 * g4 + 4 * hi) = q;
            }
        __syncthreads();
    }
}

template <int MODE> struct LaCfg {
    static constexpr int DK = MODE ? 128 : 64, LQ = DK + 8, LG = DK + 4, PITCH = MODE ? 3584 : 2560, NG = DK / 8;
    static constexpr int QCOL = MODE ? 1536 : 0, KCOL = MODE ? 0 : 256, ZCOL = MODE ? 2048 : 512, VCOL = MODE ? 2560 : 768, GCOL = MODE ? 3072 : 1280, OCOL = MODE ? 512 : 0;
    static constexpr int O_QB = 0, O_KB = O_QB + 64 * LQ * 2, O_GF = O_KB + 64 * LQ * 2, O_VT = O_GF + 64 * LG * 4, O_SC = O_VT + 128 * 72 * 2, O_QE = O_SC + 64 * 72 * 2,
                         O_KT = O_QE + 64 * LQ * 2  , O_SEG = O_KT + DK * 72 * 2, O_RED = O_SEG + 8 * 128 * 4, O_PAR = O_RED + 8 * 64 * 4, O_END = O_PAR + 128 * 4;
    static_assert(O_END <= LDS_BYTES, "LA LDS map");
};
__device__ __forceinline__ void unpack8(const u32x4 w, float (&f)[8]) { f[0] = bflo(w.x); f[1] = bfhi(w.x); f[2] = bflo(w.y); f[3] = bfhi(w.y); f[4] = bflo(w.z); f[5] = bfhi(w.z); f[6] = bflo(w.w); f[7] = bfhi(w.w); }
__device__ __forceinline__ u32x4 pack8(const float (&f)[8]) { u32x4 w; w.x = pk2(f[0], f[1]); w.y = pk2(f[2], f[3]); w.z = pk2(f[4], f[5]); w.w = pk2(f[6], f[7]); return w; }
__device__ __forceinline__ void ld8f(const float* p, float (&f)[8]) { const f32x4 a = *(const f32x4*)p, b = *(const f32x4*)(p + 4); f[0] = a[0]; f[1] = a[1]; f[2] = a[2]; f[3] = a[3]; f[4] = b[0]; f[5] = b[1]; f[6] = b[2]; f[7] = b[3]; }

template <int MODE> struct LaRaw { static constexpr int NI = 64 * LaCfg<MODE>::NG / NTHR; u32x4 z[NI], k[NI], q[NI], v[2]; };
template <int MODE, bool NEEDQ> __device__ __forceinline__ void la_fetch(const Ctx& C, int b, int h, int c, LaRaw<MODE>& R) {
    typedef LaCfg<MODE> Cf; const bf16_t* proj = (const bf16_t*)(C.p.ws + WS_R1);
    const size_t row0 = (size_t)b * SEQ_ + (size_t)c * 64;
#pragma unroll
    for (int it = 0; it < LaRaw<MODE>::NI; ++it) {
        const int u = C.tid + it * NTHR, r = u / Cf::NG, kk = (u % Cf::NG) * 8;
        const bf16_t* rp = proj + (row0 + r) * Cf::PITCH + h * Cf::DK + kk;
        R.z[it] = *(const u32x4*)(rp + Cf::ZCOL);
        if (MODE == 0) R.k[it] = *(const u32x4*)(rp + Cf::KCOL);
        if (NEEDQ) R.q[it] = *(const u32x4*)(rp + Cf::QCOL);
    }
#pragma unroll
    for (int it = 0; it < 2; ++it) {
        const int u = C.tid + it * NTHR, r = u & 63, g8 = u >> 6;
        R.v[it] = *(const u32x4*)(proj + (row0 + r) * Cf::PITCH + Cf::VCOL + h * 128 + g8 * 8);
    }
}
template <int MODE, bool NEEDQ> __device__ __forceinline__ void la_store(const Ctx& C, const LaRaw<MODE>& R, const float* par, bf16_t* Qb, bf16_t* Kb, float* Gf, bf16_t* Vt) {
    typedef LaCfg<MODE> Cf;
#pragma unroll
    for (int it = 0; it < LaRaw<MODE>::NI; ++it) {
        const int u = C.tid + it * NTHR, r = u / Cf::NG, kk = (u % Cf::NG) * 8;
        float z[8], kv[8], lg[8], pc[8];
        unpack8(R.z[it], z); ld8f(par + kk, pc);
        if (MODE == 0) {
            unpack8(R.k[it], kv);
#pragma unroll
            for (int e = 0; e < 8; ++e) { const float x = z[e] + pc[e]; lg[e] = (fminf(x, 0.f) * LOG2E_ - __log2f(1.f + __expf(-fabsf(x)))) * (1.f / 16.f); }
        } else {
#pragma unroll
            for (int e = 0; e < 8; ++e) {
                const float zz = fminf(fmaxf(z[e], -60.f), 60.f), ez = __expf(-zz), sg = __builtin_amdgcn_rcpf(1.f + ez), lb = pc[e];
                lg[e] = __log2f(lb + (1.f - lb) * sg); kv[e] = (1.f - lb) * (ez * sg);
            }
        }
        *(u32x4*)(Kb + r * Cf::LQ + kk) = pack8(kv);
        float* gd = Gf + r * Cf::LG + kk;
        *(f32x4*)gd = (f32x4){lg[0], lg[1], lg[2], lg[3]}; *(f32x4*)(gd + 4) = (f32x4){lg[4], lg[5], lg[6], lg[7]};
        if (NEEDQ) {
            float q[8]; unpack8(R.q[it], q);
#pragma unroll
            for (int e = 0; e < 8; ++e) q[e] = MODE ? siluf_(q[e]) * 0.08838834764831845f : q[e] * 0.125f;
            *(u32x4*)(Qb + r * Cf::LQ + kk) = pack8(q);
        }
    }
#pragma unroll
    for (int it = 0; it < 2; ++it) {
        const int u = C.tid + it * NTHR, r = u & 63, g8 = u >> 6;
        const u32x4 w = R.v[it];
        bf16_t* vd = Vt + (g8 * 8) * 72 + r;
        vd[0] = (bf16_t)(w.x & 0xffffu); vd[72] = (bf16_t)(w.x >> 16); vd[144] = (bf16_t)(w.y & 0xffffu); vd[216] = (bf16_t)(w.y >> 16);
        vd[288] = (bf16_t)(w.z & 0xffffu); vd[360] = (bf16_t)(w.z >> 16); vd[432] = (bf16_t)(w.w & 0xffffu); vd[504] = (bf16_t)(w.w >> 16);
    }
}
template <int MODE> __device__ __forceinline__ void la_params(const Ctx& C, int l, int h, float* par) {
    typedef LaCfg<MODE> Cf; const int j = l >> 1;
    if (C.tid < Cf::DK) {
        if (MODE == 0) par[C.tid] = C.p.gla_gate_b[j * 256 + h * 64 + C.tid];
        else { const float* lg0 = C.p.hgrn_lb_logits + h * 128 + C.tid; par[C.tid] = (j == 0) ? 0.f : sigmoidf_(lg0[512] - lg0[0]); }
    }
}
template <int MODE> __device__ __forceinline__ void la_cumsum(const Ctx& C, float* Gf, float* segs) {
    typedef LaCfg<MODE> Cf; constexpr int DK = Cf::DK, NSEG = NTHR / DK, RPS = 64 / NSEG;
    const int k = C.tid % DK, seg = C.tid / DK;
    float v[RPS];
#pragma unroll
    for (int i = 0; i < RPS; ++i) v[i] = Gf[(seg * RPS + i) * Cf::LG + k];
#pragma unroll
    for (int i = 1; i < RPS; ++i) v[i] += v[i - 1];
    segs[seg * DK + k] = v[RPS - 1];
    __syncthreads();
    float off = 0.f;
#pragma unroll
    for (int s = 0; s < NSEG; ++s) { const float t = segs[s * DK + k]; off += (s < seg) ? t : 0.f; }
#pragma unroll
    for (int i = 0; i < RPS; ++i) Gf[(seg * RPS + i) * Cf::LG + k] = v[i] + off;
}

template <int MODE> __device__ __forceinline__ void phase_la_p1(const Ctx& C, int l) {
    typedef LaCfg<MODE> Cf; const Params& p = C.p; constexpr int DK = Cf::DK, LQ = Cf::LQ, LG = Cf::LG, NG = Cf::NG;
    bf16_t* Kb = (bf16_t*)(C.lds + Cf::O_KB); float* Gf = (float*)(C.lds + Cf::O_GF); bf16_t* Vt = (bf16_t*)(C.lds + Cf::O_VT);
    bf16_t* KhT = (bf16_t*)(C.lds + Cf::O_KT); float* segs = (float*)(C.lds + Cf::O_SEG);
    bf16_t* ST = (bf16_t*)(p.ws + WS_ST); float* TOT = (float*)(p.ws + WS_TOT);
    const int r16 = C.lane & 15, g = C.lane >> 4, w = C.wave;
    float* par = (float*)(C.lds + Cf::O_PAR);
    LaRaw<MODE> R; int hcur = -1;
    if ((int)blockIdx.x < 2048) la_fetch<MODE, false>(C, (int)blockIdx.x >> 8, ((int)blockIdx.x >> 6) & 3, (int)blockIdx.x & 63, R);
    for (int it = blockIdx.x; it < 2048; it += gridDim.x) {
        const int bh = it >> 6, c = it & 63, b = bh >> 2, h = bh & 3;
        if (h != hcur) { la_params<MODE>(C, l, h, par); hcur = h; __syncthreads(); }
        la_store<MODE, false>(C, R, par, nullptr, Kb, Gf, Vt);
        { const int nx = it + (int)gridDim.x; if (nx < 2048) la_fetch<MODE, false>(C, nx >> 8, (nx >> 6) & 3, nx & 63, R); }
        __syncthreads();
        la_cumsum<MODE>(C, Gf, segs);
        __syncthreads();
        for (int u = C.tid; u < 64 * NG; u += NTHR) {
            const int r = u & 63, kk = (u >> 6) * 8;
            float kv[8], gj[8], gt[8];
            unpack8(*(const u32x4*)(Kb + r * LQ + kk), kv); ld8f(Gf + r * LG + kk, gj); ld8f(Gf + 63 * LG + kk, gt);
            bf16_t* kd = KhT + kk * 72 + r;
#pragma unroll
            for (int e = 0; e < 8; e += 2) { const unsigned pw = pk2(kv[e] * __builtin_amdgcn_exp2f(gt[e] - gj[e]), kv[e + 1] * __builtin_amdgcn_exp2f(gt[e + 1] - gj[e + 1]));
                kd[e * 72] = (bf16_t)(pw & 0xffffu); kd[(e + 1) * 72] = (bf16_t)(pw >> 16); }
        }
        if (C.tid < DK) TOT[(size_t)it * 128 + C.tid] = Gf[63 * LG + C.tid];
        __syncthreads();
        {
            const bf16x8 b0 = *(const bf16x8*)(Vt + (16 * w + r16) * 72 + 8 * g), b1 = *(const bf16x8*)(Vt + (16 * w + r16) * 72 + 32 + 8 * g);
            bf16_t* so = ST + (size_t)it * DK * 128 + (size_t)(16 * w + r16) * DK + 4 * g;
#pragma unroll
            for (int mt = 0; mt < DK / 16; ++mt) {
                const bf16x8 a0 = *(const bf16x8*)(KhT + (16 * mt + r16) * 72 + 8 * g), a1 = *(const bf16x8*)(KhT + (16 * mt + r16) * 72 + 32 + 8 * g);
                f32x4 acc = (f32x4){0.f, 0.f, 0.f, 0.f};
                acc = __builtin_amdgcn_mfma_f32_16x16x32_bf16(a0, b0, acc, 0, 0, 0);
                acc = __builtin_amdgcn_mfma_f32_16x16x32_bf16(a1, b1, acc, 0, 0, 0);
                u32x2 q; q.x = pk2(acc[0], acc[1]); q.y = pk2(acc[2], acc[3]);
                *(u32x2*)(so + 16 * mt) = q;
            }
        }
        __syncthreads();
    }
}

template <int MODE> __device__ __forceinline__ void phase_la_p2(const Ctx& C) {
    typedef LaCfg<MODE> Cf; const Params& p = C.p; constexpr int DK = Cf::DK, NQ = DK / 4;
    bf16_t* ST = (bf16_t*)(p.ws + WS_ST); const float* TOT = (const float*)(p.ws + WS_TOT);
    for (int u = blockIdx.x * NTHR + C.tid; u < 32 * 128 * NQ; u += gridDim.x * NTHR) {
        const int k4 = u % NQ, v = (u / NQ) & 127, bh = u / (NQ * 128);
        float S0 = 0.f, S1 = 0.f, S2 = 0.f, S3 = 0.f;
        bf16_t* base = ST + (size_t)bh * 64 * DK * 128 + (size_t)v * DK + k4 * 4;
        const float* tb = TOT + (size_t)bh * 64 * 128 + k4 * 4;
#pragma unroll 8
        for (int c = 0; c < 64; ++c) {
            u32x2* ptr = (u32x2*)(base + (size_t)c * DK * 128);
            const u32x2 w = *ptr; const f32x4 dc = *(const f32x4*)(tb + c * 128);
            u32x2 o; o.x = pk2(S0, S1); o.y = pk2(S2, S3);
            *ptr = o;
            S0 = S0 * __builtin_amdgcn_exp2f(dc[0]) + bflo(w.x); S1 = S1 * __builtin_amdgcn_exp2f(dc[1]) + bfhi(w.x);
            S2 = S2 * __builtin_amdgcn_exp2f(dc[2]) + bflo(w.y); S3 = S3 * __builtin_amdgcn_exp2f(dc[3]) + bfhi(w.y);
        }
    }
}

template <int MODE> __device__ __forceinline__ void phase_la_p3(const Ctx& C, int l) {
    typedef LaCfg<MODE> Cf; const Params& p = C.p; constexpr int DK = Cf::DK, LQ = Cf::LQ, LG = Cf::LG, NG = Cf::NG, NKS = DK / 32;
    bf16_t* Qb = (bf16_t*)(C.lds + Cf::O_QB); bf16_t* Kb = (bf16_t*)(C.lds + Cf::O_KB); float* Gf = (float*)(C.lds + Cf::O_GF); bf16_t* Vt = (bf16_t*)(C.lds + Cf::O_VT);
    bf16_t* Sc = (bf16_t*)(C.lds + Cf::O_SC); bf16_t* Qe = (bf16_t*)(C.lds + Cf::O_QE); float* segs = (float*)(C.lds + Cf::O_SEG); float* red = (float*)(C.lds + Cf::O_RED);
    const bf16_t* ST = (const bf16_t*)(p.ws + WS_ST); const bf16_t* proj = (const bf16_t*)(p.ws + WS_R1); bf16_t* A = (bf16_t*)(p.ws + WS_A);
    const float* nw = (MODE ? p.hgrn_norm_w : p.gla_norm_w) + (l >> 1) * 128;
    const int r16 = C.lane & 15, g = C.lane >> 4, w = C.wave;
    const f32x4 nw4 = *(const f32x4*)(nw + 16 * w + 4 * g);
    float* par = (float*)(C.lds + Cf::O_PAR);
    LaRaw<MODE> R; int hcur = -1;
    if ((int)blockIdx.x < 2048) la_fetch<MODE, true>(C, (int)blockIdx.x >> 8, ((int)blockIdx.x >> 6) & 3, (int)blockIdx.x & 63, R);
    for (int it = blockIdx.x; it < 2048; it += gridDim.x) {
        const int bh = it >> 6, c = it & 63, b = bh >> 2, h = bh & 3;
        bf16x8 sfr[NKS];
        { const bf16_t* sp = ST + (size_t)it * DK * 128 + (size_t)(16 * w + r16) * DK + 8 * g;
#pragma unroll
          for (int ks = 0; ks < NKS; ++ks) sfr[ks] = *(const bf16x8*)(sp + 32 * ks); }
        if (h != hcur) { la_params<MODE>(C, l, h, par); hcur = h; __syncthreads(); }
        la_store<MODE, true>(C, R, par, Qb, Kb, Gf, Vt);
        { const int nx = it + (int)gridDim.x; if (nx < 2048) la_fetch<MODE, true>(C, nx >> 8, (nx >> 6) & 3, nx & 63, R); }
        for (int u = C.tid; u < 64 * 72 / 8; u += NTHR) *(u32x4*)(Sc + u * 8) = (u32x4){0u, 0u, 0u, 0u};
        u32x2 gwv[4];
#pragma unroll
        for (int nt = 0; nt < 4; ++nt) gwv[nt] = *(const u32x2*)(proj + ((size_t)b * SEQ_ + (size_t)c * 64 + 16 * nt + r16) * Cf::PITCH + Cf::GCOL + h * 128 + 16 * w + 4 * g);
        __syncthreads();
        la_cumsum<MODE>(C, Gf, segs);
        __syncthreads();
        for (int t = w; t < 10; t += 8) {
            const int I = (t >= 6) ? 3 : (t >= 3) ? 2 : (t >= 1) ? 1 : 0, J = t - I * (I + 1) / 2;
            f32x4 acc = (f32x4){0.f, 0.f, 0.f, 0.f};
#pragma unroll
            for (int ks = 0; ks < NKS; ++ks) {
                const int kc = 32 * ks + 8 * g;
                float gref[8], gj[8], gi[8], kv[8], qv[8];
                ld8f(Gf + (16 * J + 15) * LG + kc, gref); ld8f(Gf + (16 * J + r16) * LG + kc, gj); ld8f(Gf + (16 * I + r16) * LG + kc, gi);
                unpack8(*(const u32x4*)(Kb + (16 * J + r16) * LQ + kc), kv); unpack8(*(const u32x4*)(Qb + (16 * I + r16) * LQ + kc), qv);
#pragma unroll
                for (int e = 0; e < 8; ++e) { kv[e] *= __builtin_amdgcn_exp2f(gref[e] - gj[e]); qv[e] *= __builtin_amdgcn_exp2f(gi[e] - gref[e]); }
                acc = __builtin_amdgcn_mfma_f32_16x16x32_bf16(__builtin_bit_cast(bf16x8, pack8(kv)), __builtin_bit_cast(bf16x8, pack8(qv)), acc, 0, 0, 0);
            }
            if (I == J) {
#pragma unroll
                for (int e = 0; e < 4; ++e) if (4 * g + e > r16) acc[e] = 0.f;
            }
            u32x2 q; q.x = pk2(acc[0], acc[1]); q.y = pk2(acc[2], acc[3]);
            *(u32x2*)(Sc + (16 * I + r16) * 72 + 16 * J + 4 * g) = q;
        }
        for (int u = C.tid; u < 64 * NG; u += NTHR) {
            const int r = u / NG, kk = (u % NG) * 8;
            float qv[8], gi[8]; unpack8(*(const u32x4*)(Qb + r * LQ + kk), qv); ld8f(Gf + r * LG + kk, gi);
#pragma unroll
            for (int e = 0; e < 8; ++e) qv[e] *= __builtin_amdgcn_exp2f(gi[e]);
            *(u32x4*)(Qe + r * LQ + kk) = pack8(qv);
        }
        __syncthreads();
        f32x4 o[4];
        {
            const bf16x8 v0 = *(const bf16x8*)(Vt + (16 * w + r16) * 72 + 8 * g), v1 = *(const bf16x8*)(Vt + (16 * w + r16) * 72 + 32 + 8 * g);
#pragma unroll
            for (int nt = 0; nt < 4; ++nt) {
                f32x4 acc = (f32x4){0.f, 0.f, 0.f, 0.f};
                acc = __builtin_amdgcn_mfma_f32_16x16x32_bf16(v0, *(const bf16x8*)(Sc + (16 * nt + r16) * 72 + 8 * g), acc, 0, 0, 0);
                if (nt >= 2) acc = __builtin_amdgcn_mfma_f32_16x16x32_bf16(v1, *(const bf16x8*)(Sc + (16 * nt + r16) * 72 + 32 + 8 * g), acc, 0, 0, 0);
#pragma unroll
                for (int ks = 0; ks < NKS; ++ks) acc = __builtin_amdgcn_mfma_f32_16x16x32_bf16(sfr[ks], *(const bf16x8*)(Qe + (16 * nt + r16) * LQ + 32 * ks + 8 * g), acc, 0, 0, 0);
                o[nt] = acc;
                float ss = acc[0] * acc[0] + acc[1] * acc[1] + acc[2] * acc[2] + acc[3] * acc[3];
                ss += __shfl_xor(ss, 16); ss += __shfl_xor(ss, 32);
                if (g == 0) red[w * 64 + 16 * nt + r16] = ss;
            }
        }
        __syncthreads();
#pragma unroll
        for (int nt = 0; nt < 4; ++nt) {
            float tot = 0.f;
#pragma unroll
            for (int ww = 0; ww < 8; ++ww) tot += red[ww * 64 + 16 * nt + r16];
            const float rs = rsqrtf(tot * (1.f / 128.f) + 1e-6f);
            const size_t row = (size_t)b * SEQ_ + (size_t)c * 64 + 16 * nt + r16;
            const u32x2 gw = gwv[nt];
            u32x2 q; q.x = pk2(o[nt][0] * rs * nw4[0] * siluf_(bflo(gw.x)), o[nt][1] * rs * nw4[1] * siluf_(bfhi(gw.x)));
            q.y = pk2(o[nt][2] * rs * nw4[2] * siluf_(bflo(gw.y)), o[nt][3] * rs * nw4[3] * siluf_(bfhi(gw.y)));
            *(u32x2*)(A + row * 1024 + Cf::OCOL + h * 128 + 16 * w + 4 * g) = q;
        }
        __syncthreads();
    }
}


#define LAS __attribute__((address_space(3)))
#define XB_TMO      128
#define XB_XCNT(j)  (256  + 64 * (j))
#define XB_XSUB(j)  (1280 + 64 * (j))
#define XB_XGEN(j)  (2304 + 64 * (j))
#define XB_TOP      3328
#define XB_TOPGEN   3392
#define XCD_BAR_WORDS 3456
#define XB_SPIN_CAP (1u << 18)

__device__ __forceinline__ unsigned xb_ld(unsigned* p)              { return __hip_atomic_load(p, __ATOMIC_RELAXED, __HIP_MEMORY_SCOPE_AGENT); }
__device__ __forceinline__ unsigned xb_add(unsigned* p, unsigned v) { return __hip_atomic_fetch_add(p, v, __ATOMIC_RELAXED, __HIP_MEMORY_SCOPE_AGENT); }
__device__ __forceinline__ unsigned xb_xcc_id() { return (unsigned)__builtin_amdgcn_s_getreg((3 << 11) | 20) & 0xFu; }
#define XB_SPIN(cond, bar) do { unsigned _sp = 0; while (cond) { __builtin_amdgcn_s_sleep(1); \
    if ((++_sp & 255u) == 0u) { if (xb_ld(&(bar)[XB_TMO])) break; if (_sp > XB_SPIN_CAP) { atomicAdd(&(bar)[XB_TMO], 1u); break; } } } } while (0)

struct XcdBarrier {
    unsigned* bar; unsigned x;
    volatile LAS unsigned* st;
};

__device__ __forceinline__ XcdBarrier xcd_barrier_post(unsigned* bar, volatile LAS unsigned* st) {
    XcdBarrier b; b.bar = bar; b.x = xb_xcc_id(); b.st = st;
    if (threadIdx.x == 0) (void)xb_add(&bar[XB_XCNT(b.x)], 1u);
    return b;
}
__device__ __forceinline__ void xcd_barrier_complete(unsigned* bar, unsigned x, unsigned& nloc, unsigned& nx) {
    const unsigned G = gridDim.x * gridDim.y * gridDim.z;
    unsigned sum, cnt, mine, sp = 0u;
    for (;;) {
        sum = 0u; cnt = 0u; mine = 0u;
#pragma unroll
        for (unsigned j = 0; j < 16; ++j) { const unsigned c = xb_ld(&bar[XB_XCNT(j)]); sum += c; cnt += (c > 0u) ? 1u : 0u; mine = (j == x) ? c : mine; }
        if (sum == G) break;
        __builtin_amdgcn_s_sleep(1);
        if ((++sp & 255u) == 0u) { if (xb_ld(&bar[XB_TMO])) break; if (sp > XB_SPIN_CAP) { atomicAdd(&bar[XB_TMO], 1u); break; } }
    }
    nloc = mine > 0u ? mine : 1u; nx = cnt > 0u ? cnt : 1u;
}

__device__ __forceinline__ void xcd_barrier(const XcdBarrier& b) {
    asm volatile("s_waitcnt vmcnt(0)" ::: "memory");
    __syncthreads();
    if (threadIdx.x == 0) {
        unsigned* bar = b.bar;
        __builtin_amdgcn_s_waitcnt(0);
        unsigned nloc = b.st[0], nx = b.st[1];
        if (nloc == 0u) { xcd_barrier_complete(bar, b.x, nloc, nx); b.st[0] = nloc; b.st[1] = nx; }
        const unsigned old = xb_add(&bar[XB_XSUB(b.x)], 1u);
        const unsigned gen = old / nloc;
        if (old + 1u == (gen + 1u) * nloc) {
            __builtin_amdgcn_fence(__ATOMIC_RELEASE, "agent");
            asm volatile("s_waitcnt vmcnt(0)" ::: "memory");
            const unsigned og = xb_add(&bar[XB_TOP], 1u);
            const unsigned tg = og / nx;
            if (og + 1u == (tg + 1u) * nx) xb_add(&bar[XB_TOPGEN], 1u);
            else XB_SPIN(xb_ld(&bar[XB_TOPGEN]) == tg, bar);
            __builtin_amdgcn_fence(__ATOMIC_ACQUIRE, "agent");
            xb_add(&bar[XB_XGEN(b.x)], 1u);
            asm volatile("s_waitcnt vmcnt(0)" ::: "memory");
        } else {
            XB_SPIN(xb_ld(&bar[XB_XGEN(b.x)]) == gen, bar);
            __builtin_amdgcn_fence(__ATOMIC_ACQUIRE, "agent");
            asm volatile("s_waitcnt vmcnt(0)" ::: "memory");
        }
    }
    __syncthreads();
}

typedef unsigned u32x16 __attribute__((ext_vector_type(16)));
__device__ __forceinline__ void load_params(Params& p) {
    auto kp = __builtin_amdgcn_kernarg_segment_ptr();
    u32x16 a, b, c, d;
    asm volatile("s_load_dwordx16 %0, %4, 0x0\n\ts_load_dwordx16 %1, %4, 0x40\n\ts_load_dwordx16 %2, %4, 0x80\n\ts_load_dwordx16 %3, %4, 0xc0\n\ts_waitcnt lgkmcnt(0)"
                 : "=&s"(a), "=&s"(b), "=&s"(c), "=&s"(d) : "s"(kp) : "memory");
    unsigned long long q[32];
#pragma unroll
    for (int i = 0; i < 8; ++i) { q[i] = ((unsigned long long)a[2 * i + 1] << 32) | a[2 * i]; q[8 + i] = ((unsigned long long)b[2 * i + 1] << 32) | b[2 * i];
        q[16 + i] = ((unsigned long long)c[2 * i + 1] << 32) | c[2 * i]; q[24 + i] = ((unsigned long long)d[2 * i + 1] << 32) | d[2 * i]; }
    p.x = (const float*)(__attribute__((address_space(1))) const float*)q[0]; p.c = (const float*)(__attribute__((address_space(1))) const float*)q[1]; p.positions = (const int*)(__attribute__((address_space(1))) const int*)q[2]; p.mod_w = (const float*)(__attribute__((address_space(1))) const float*)q[3]; p.mod_b = (const float*)(__attribute__((address_space(1))) const float*)q[4]; p.norm_mix_w = (const float*)(__attribute__((address_space(1))) const float*)q[5]; p.norm_ffn_w = (const float*)(__attribute__((address_space(1))) const float*)q[6];
    p.ev_w_in = (const float*)(__attribute__((address_space(1))) const float*)q[7]; p.gla_gate_w = (const float*)(__attribute__((address_space(1))) const float*)q[8]; p.gla_gate_b = (const float*)(__attribute__((address_space(1))) const float*)q[9]; p.gla_norm_w = (const float*)(__attribute__((address_space(1))) const float*)q[10]; p.swa_sinks = (const float*)(__attribute__((address_space(1))) const float*)q[11]; p.ev_w_out = (const float*)(__attribute__((address_space(1))) const float*)q[12];
    p.od_w_in = (const float*)(__attribute__((address_space(1))) const float*)q[13]; p.diff_lambda = (const float*)(__attribute__((address_space(1))) const float*)q[14]; p.diff_norm_w = (const float*)(__attribute__((address_space(1))) const float*)q[15]; p.hgrn_lb_logits = (const float*)(__attribute__((address_space(1))) const float*)q[16]; p.hgrn_norm_w = (const float*)(__attribute__((address_space(1))) const float*)q[17]; p.od_w_out = (const float*)(__attribute__((address_space(1))) const float*)q[18];
    p.ffn_w_in = (const float*)(__attribute__((address_space(1))) const float*)q[19]; p.ffn_conv_w = (const float*)(__attribute__((address_space(1))) const float*)q[20]; p.ffn_conv_b = (const float*)(__attribute__((address_space(1))) const float*)q[21]; p.ffn_w_out = (const float*)(__attribute__((address_space(1))) const float*)q[22]; p.final_norm_w = (const float*)(__attribute__((address_space(1))) const float*)q[23];
    p.out = (float*)(__attribute__((address_space(1))) float*)q[24]; p.ws = (unsigned char*)(__attribute__((address_space(1))) unsigned char*)q[25];
}

#ifndef REP_SYNC
#define REP_SYNC 1
#endif
#ifndef REP_G
#define REP_G 1
#endif
#ifndef REP_R
#define REP_R 1
#endif
#ifndef REP_CV
#define REP_CV 1
#endif
#ifndef REP_P12
#define REP_P12 1
#endif
#ifndef STG_A
#define STG_A 0
#endif
#ifndef STG_B
#define STG_B 0
#endif
#ifndef ALIGN_RES
#define ALIGN_RES true
#endif
#ifndef REP_SWA
#define REP_SWA 1
#endif
#ifndef REP_LA
#define REP_LA 1
#endif
#ifndef REP_AT
#define REP_AT 1
#endif
#ifndef REP_SM
#define REP_SM 1
#endif
__global__ void __launch_bounds__(NTHR, 2) fwd_megakernel(Params pin) {
    extern __shared__ __attribute__((aligned(16))) unsigned char lds[];
    cg::grid_group grid = cg::this_grid();
    Ctx C; C.lds = lds; C.tid = threadIdx.x; C.lane = C.tid & 63; C.wave = __builtin_amdgcn_readfirstlane(C.tid >> 6);
    C.gw = blockIdx.x * 8 + C.wave; C.ngw = gridDim.x * 8;
    PG8_LAS unsigned char* ldsg = (PG8_LAS unsigned char*)lds;
    volatile LAS unsigned* bst = (volatile LAS unsigned*)(ldsg + (LDS_BYTES - 64));
    if (threadIdx.x < 2) bst[threadIdx.x] = 0u;
    __syncthreads();
    XcdBarrier xbar = xcd_barrier_post((unsigned*)(pin.ws + WS_BAR), bst);
#define GSYNC() do { for (int rs_ = 0; rs_ < REP_SYNC; ++rs_) xcd_barrier(xbar); } while (0)
#define RP() do { load_params(C.p); C.tid = otid_(); C.lane = C.tid & 63; C.wave = __builtin_amdgcn_readfirstlane(C.tid >> 6); C.gw = blockIdx.x * 8 + C.wave; } while (0)
#define WSP(off) (C.p.ws + (off))
#define STAGGER(ticks) do { if ((ticks) > 0 && (blockIdx.x & 1)) { const unsigned long long t0_ = __builtin_amdgcn_s_memrealtime(); while (__builtin_amdgcn_s_memrealtime() - t0_ < (unsigned long long)(ticks)) __builtin_amdgcn_s_sleep(16); } } while (0)

    if (pin.ws == nullptr) grid.sync();
    for (int rep_ = 0; rep_ < REP_SM; ++rep_) { RP(); phase_prologue(C); }
    GSYNC();
#if REP_CV > 1
    RP(); phase_convert(C, 0, false);
#endif
    RP(); phase_convert(C, 0);
    for (int rep_ = 0; rep_ < REP_SM; ++rep_) { RP(); phase_prep(C, C.p.x, C.p.norm_mix_w, (const float*)WSP(WS_MOD), 1024, (bf16_t*)WSP(WS_A), (float*)WSP(WS_ROWSS)); }
    GSYNC();
#pragma unroll 1
    for (int l = 0; l < 4; ++l) {
        const bool even = !(l & 1);
        {
            RP();
            const int N = even ? 2560 : 3584;
            pg8::Gemm g{(const bf16_t*)WSP(WS_A), (const bf16_t*)WSP(WS_WIN), T_, N, 1024}; pg8::StaticOrder S; S.init(T_, N, (int)gridDim.x, (int)blockIdx.x);
            pg8::EpiProj E{(bf16_t*)WSP(WS_R1), N, even ? 0x7C000u : 0xFFu, even ? 0x3C000u : 0xFu, QSCALE_, (const float*)WSP(WS_COS), (const float*)WSP(WS_SIN),
                           (const float*)WSP(WS_ROWSS) + (size_t)(2 * l) * T_, (const float*)WSP(WS_BIAS) + (size_t)l * BIAS_L};
            for (int rep_ = 0; rep_ < REP_G; ++rep_) pg8::gemm_phase<pg8::EpiProj, pg8::StaticOrder, true, true>(ldsg, g, S, E);
        }
        GSYNC();
        if (even) {
            for (int rep_ = 0; rep_ < REP_SWA; ++rep_) { RP(); phase_swa(C, l); }
            for (int rep_ = 0; rep_ < REP_LA; ++rep_) { RP(); phase_la_p1<0>(C, l); }
            GSYNC();
            RP(); phase_la_p2<0>(C);
            GSYNC();
#if REP_P12 > 1
            RP(); phase_la_p1<0>(C, l); GSYNC(); RP(); phase_la_p2<0>(C); GSYNC();
#endif
            for (int rep_ = 0; rep_ < REP_LA; ++rep_) { RP(); phase_la_p3<0>(C, l); }
        } else {
            for (int rep_ = 0; rep_ < REP_AT; ++rep_) {
                RP();
                const bf16_t* R1 = (const bf16_t*)WSP(WS_R1); bf16_t* X2 = (bf16_t*)WSP(WS_X2);
                const int G = (int)gridDim.x, bid = (int)blockIdx.x;
#pragma unroll 1
                for (int i = 0; i * G < 2048; ++i) {
                    const int L = i * G + ((i & 1) ? (G - 1 - bid) : bid);
                    if (L >= 2048) continue;
                    const int qb = 15 - (L >> 7), bh = (((L >> 2) & 7) << 4) | ((L & 3) << 2) | (((L >> 5) & 1) << 1) | ((L >> 6) & 1), b = bh >> 4, hv = bh & 15;
                    const attn_body::bf16* Q = (const attn_body::bf16*)(R1 + (hv >> 1) * 64);
                    const attn_body::bf16* K = (const attn_body::bf16*)(R1 + 512 + (hv >> 1) * 64);
                    const attn_body::bf16* V = (const attn_body::bf16*)(R1 + 1024 + (hv >> 2) * 128 + (hv & 1) * 64);
                    attn_body::attn_unit<8>(b, hv, qb, Q, K, V, (attn_body::bf16*)(X2 + hv * 64), (char*)lds);
                }
            }
            for (int rep_ = 0; rep_ < REP_LA; ++rep_) { RP(); phase_la_p1<1>(C, l); }
            GSYNC();
            RP(); phase_la_p2<1>(C);
#if REP_P12 > 1
            GSYNC(); RP(); phase_la_p1<1>(C, l); GSYNC(); RP(); phase_la_p2<1>(C);
#endif
            for (int rep_ = 0; rep_ < REP_SM; ++rep_) { RP(); phase_diff_combine(C, l); }
            GSYNC();
            for (int rep_ = 0; rep_ < REP_LA; ++rep_) { RP(); phase_la_p3<1>(C, l); }
        }
        GSYNC();
        STAGGER(STG_A);
        {
            RP();
            const float* modl = (const float*)WSP(WS_MOD) + (size_t)l * 8 * 6144;
            pg8::Gemm g{(const bf16_t*)WSP(WS_A), (const bf16_t*)WSP(WS_WOUT), T_, 1024, 1024}; pg8::StaticOrder S; S.init(T_, 1024, (int)gridDim.x, (int)blockIdx.x);
            void* XH = (void*)((char*)C.p.out + 64 * MiB_);
            pg8::EpiRes E{(l == 0) ? (const void*)C.p.x : (const void*)XH, XH, (l == 0) ? 1 : 0, 0, modl + 2048, (bf16_t*)WSP(WS_X2), C.p.norm_ffn_w + l * 1024, modl + 4096, (float*)WSP(WS_ROWSS) + (size_t)(2 * l + 1) * T_};
            pg8::gemm_phase<pg8::EpiRes, pg8::StaticOrder, ALIGN_RES, true>(ldsg, g, S, E);
        }
        GSYNC();
        {
            RP();
            pg8::Gemm g{(const bf16_t*)WSP(WS_X2), (const bf16_t*)WSP(WS_FIN), T_, 5632, 1024}; pg8::StaticOrder S; S.init(T_, 5632, (int)gridDim.x, (int)blockIdx.x);
            pg8::EpiFfn E{(bf16_t*)WSP(WS_R1), (unsigned short*)WSP(WS_HP), (unsigned short*)WSP(WS_HU), (unsigned short*)WSP(WS_HA), C.p.ffn_conv_w + (size_t)l * 3 * DFF_, C.p.ffn_conv_b + (size_t)l * DFF_,
                          (const float*)WSP(WS_ROWSS) + (size_t)(2 * l + 1) * T_, (const float*)WSP(WS_BIAS) + (size_t)l * BIAS_L + 8 * 3584};
            for (int rep_ = 0; rep_ < REP_G; ++rep_) pg8::gemm_phase<pg8::EpiFfn, pg8::StaticOrder, true, true>(ldsg, g, S, E);
        }
        GSYNC();
        for (int rep_ = 0; rep_ < REP_SM; ++rep_) { RP(); phase_ffn_fixup(C, l); }
#if REP_CV > 1
        if (l < 3) { RP(); phase_convert(C, l + 1, false); }
#endif
        if (l < 3) { RP(); phase_convert(C, l + 1); }
        GSYNC();
        STAGGER(STG_B);
        {
            RP();
            const float* modl = (const float*)WSP(WS_MOD) + (size_t)l * 8 * 6144;
            pg8::Gemm g{(const bf16_t*)WSP(WS_R1), (const bf16_t*)WSP((l & 1) ? WS_FOUT2 : WS_FOUT), T_, 1024, DFF_}; pg8::StaticOrder S; S.init(T_, 1024, (int)gridDim.x, (int)blockIdx.x);
            void* XH = (void*)((char*)C.p.out + 64 * MiB_);
            pg8::EpiRes E{XH, (l < 3) ? XH : (void*)WSP(WS_X2), 0, 0, modl + 5120, (l < 3) ? (bf16_t*)WSP(WS_A) : (bf16_t*)nullptr, C.p.norm_mix_w + ((l + 1) & 3) * 1024, modl + 6144 * 8 + 1024, (float*)WSP(WS_ROWSS) + (size_t)((2 * l + 2) & 7) * T_};
            pg8::gemm_phase<pg8::EpiRes, pg8::StaticOrder, ALIGN_RES, true>(ldsg, g, S, E);
        }
        GSYNC();
    }
    RP(); phase_final_norm(C, (const void*)WSP(WS_X2), C.p.out, C.p.final_norm_w);
}

extern "C" void kernel_launch(void* const* d_in, const int* in_sizes, int n_in, void* d_out, int out_size, void* d_ws, size_t ws_size, hipStream_t stream) {
    static int grid_blocks = 0;
    if (grid_blocks == 0) {
        if (n_in != 24 || ws_size < WS_END) { fprintf(stderr, "kernel_launch: unexpected n_in %d / ws %zu\n", n_in, ws_size); grid_blocks = -1; return; }
        int dev = 0, cus = 0, per_cu = 0;
        hipGetDevice(&dev); hipDeviceGetAttribute(&cus, hipDeviceAttributeMultiprocessorCount, dev);
        if (hipFuncSetAttribute((const void*)fwd_megakernel, hipFuncAttributeMaxDynamicSharedMemorySize, LDS_BYTES) != hipSuccess) { fprintf(stderr, "kernel_launch: hipFuncSetAttribute failed\n"); grid_blocks = -1; return; }
        if (hipOccupancyMaxActiveBlocksPerMultiprocessor(&per_cu, (const void*)fwd_megakernel, NTHR, LDS_BYTES) != hipSuccess || per_cu < 1) { fprintf(stderr, "kernel_launch: occupancy query gave %d\n", per_cu); per_cu = 1; }
        (void)hipGetLastError();
        grid_blocks = cus * per_cu;
    }
    if (grid_blocks < 0) return;
    Params p{};
    p.x = (const float*)d_in[0]; p.c = (const float*)d_in[1]; p.positions = (const int*)d_in[2]; p.mod_w = (const float*)d_in[3]; p.mod_b = (const float*)d_in[4];
    p.norm_mix_w = (const float*)d_in[5]; p.norm_ffn_w = (const float*)d_in[6]; p.ev_w_in = (const float*)d_in[7]; p.gla_gate_w = (const float*)d_in[8];
    p.gla_gate_b = (const float*)d_in[9]; p.gla_norm_w = (const float*)d_in[10]; p.swa_sinks = (const float*)d_in[11]; p.ev_w_out = (const float*)d_in[12];
    p.od_w_in = (const float*)d_in[13]; p.diff_lambda = (const float*)d_in[14]; p.diff_norm_w = (const float*)d_in[15]; p.hgrn_lb_logits = (const float*)d_in[16];
    p.hgrn_norm_w = (const float*)d_in[17]; p.od_w_out = (const float*)d_in[18]; p.ffn_w_in = (const float*)d_in[19]; p.ffn_conv_w = (const float*)d_in[20];
    p.ffn_conv_b = (const float*)d_in[21]; p.ffn_w_out = (const float*)d_in[22]; p.final_norm_w = (const float*)d_in[23];
    p.out = (float*)d_out; p.ws = (unsigned char*)d_ws;
    if (hipMemsetAsync((char*)d_ws + WS_BAR, 0, 16384, stream) != hipSuccess) { fprintf(stderr, "kernel_launch: memset failed\n"); return; }
    void* args[] = {&p};
    hipError_t e = hipLaunchCooperativeKernel((const void*)fwd_megakernel, dim3(grid_blocks), dim3(NTHR), args, LDS_BYTES, stream);
    if (e != hipSuccess) fprintf(stderr, "cooperative launch failed: %s (grid %d)\n", hipGetErrorString(e), grid_blocks);
}
```

```cpp
#include <hip/hip_runtime.h>
#include <hip/hip_cooperative_groups.h>
#include <hip/hip_bf16.h>
#include <cstdio>
#include <cstdint>
#include <cmath>
__device__ __forceinline__ int otid_() { int t = threadIdx.x; asm volatile("" : "+v"(t)); return t; }
namespace pg8 {
#define PG8_LAS __attribute__((address_space(3)))
typedef unsigned short bf16_t;
typedef short bf16x8 __attribute__((ext_vector_type(8)));
typedef float f32x4 __attribute__((ext_vector_type(4)));
typedef unsigned u32x4 __attribute__((ext_vector_type(4)));
constexpr int BM = 256, BK = 64, HALF = 128, HTB = HALF * BK * 2  , STAGE_BYTES = 8 * HTB, NXCD = 8, WGM = 8;

__host__ __device__ __forceinline__ int lds_byte(int r, int c) { const int st = (r >> 4) * 2 + (c >> 5), rr = r & 15, cc = c & 31, ob = rr * 64 + cc * 2; return st * 1024 + (ob ^ (((ob >> 9) & 1) << 5)); }
__host__ __device__ __forceinline__ void stage_rc(int b, int& R, int& C) { const int st = b / 1024, sb = b % 1024, swz = sb ^ (((sb >> 9) & 1) << 5); R = (st >> 1) * 16 + swz / 64; C = (st & 1) * 32 + (swz % 64) / 2; }
__host__ __device__ __forceinline__ int perm32(int rho) { const int n = rho >> 4, i = rho & 15; return 8 * (i >> 2) + 4 * n + (i & 3); }

struct Unit { int pm, pn; };
struct Gemm { const bf16_t* A; const bf16_t* Bt; int M, N, K; };

struct StaticOrder {
    int nM, nN, nwg, G, c;
    __host__ __device__ void init(int M, int N, int G_, int c_) { nM = M / BM; nN = N / BM; nwg = nM * nN; G = G_; c = c_; }
    __host__ __device__ bool next(int i, Unit& u) const {
        const long L = (long)i * G + c; if (L >= nwg) return false;
        int wgid = (int)L; { const int q = nwg / NXCD, r = nwg % NXCD, xcd = wgid % NXCD, off = wgid / NXCD; wgid = (xcd < r ? xcd * (q + 1) : r * (q + 1) + (xcd - r) * q) + off; }
        const int nig = WGM * nN, gid = wgid / nig, fm = gid * WGM, gsz = (nM - fm) < WGM ? (nM - fm) : WGM;
        u.pm = fm + ((wgid % nig) % gsz); u.pn = (wgid % nig) / gsz; return true;
    }
    __device__ __forceinline__ void a_ready(const Unit&) const {}
    __device__ __forceinline__ void done(const Unit&) const {}
};

__device__ __forceinline__ unsigned cvt_pk_bf16(float lo, float hi) { unsigned r; asm volatile("v_cvt_pk_bf16_f32 %0, %1, %2" : "=v"(r) : "v"(lo), "v"(hi)); return r; }
typedef float f32x2 __attribute__((ext_vector_type(2)));
template <class Epi, class Sched, bool ALIGN_EPI = false, bool SP2 = false>
__device__ __forceinline__ void gemm_phase(PG8_LAS unsigned char* lds, const Gemm g, const Sched& S, const Epi& E) {
    const int tid = otid_(), wid = __builtin_amdgcn_readfirstlane(tid >> 6), lane = tid & 63, wr = wid >> 2, wc = wid & 3, fr = lane & 15, fq = lane >> 4;
    const int K = g.K, nt = K / BK;
    unsigned voffA[2], voffB[2];
#pragma unroll
    for (int i = 0; i < 2; ++i) { int R, C; stage_rc(tid * 16 + i * 8192, R, C); const int Rb = Epi::PERM ? ((R & ~31) + perm32(R & 31)) : R;
        voffA[i] = (unsigned)(R * K + C) * 2u; voffB[i] = (unsigned)(Rb * K + C) * 2u; }
    const size_t kstep = (size_t)(BK * 2);
    const size_t hstep = (size_t)HALF * K * 2;
    const size_t tstep = 2 * hstep;
    const unsigned ldsw = (unsigned)wid * 1024u;
    const int aoff = lds_byte(wr * 64 + fr, fq * 8), boff = lds_byte(wc * 32 + fr, fq * 8);
#define PG8_SA(b, h) (((b) * 2 + (h)) * HTB)
#define PG8_SB(b, h) ((4 + (b) * 2 + (h)) * HTB)
#define PG8_STAGE(bufoff, gbase, voff) do { _Pragma("unroll") for (int _i = 0; _i < 2; ++_i) \
        __builtin_amdgcn_global_load_lds((const unsigned*)((const char*)(gbase) + (voff)[_i]), (PG8_LAS unsigned*)(lds + (bufoff) + ldsw + _i * 8192), 16, 0, 0); } while (0)
#define PG8_LDA(dst, b, h) do { _Pragma("unroll") for (int m = 0; m < 4; ++m) _Pragma("unroll") for (int k = 0; k < 2; ++k) dst[m][k] = *(const PG8_LAS bf16x8*)(lds + PG8_SA(b, h) + aoff + m * 2048 + k * 1024); } while (0)
#define PG8_LDB(dst, b, h) do { _Pragma("unroll") for (int n = 0; n < 2; ++n) _Pragma("unroll") for (int k = 0; k < 2; ++k) dst[n][k] = *(const PG8_LAS bf16x8*)(lds + PG8_SB(b, h) + boff + n * 2048 + k * 1024); } while (0)
#define PG8_MMA(ai, bj, At, Bt) do { __builtin_amdgcn_s_setprio(1); _Pragma("unroll") for (int m = 0; m < 4; ++m) _Pragma("unroll") for (int n = 0; n < 2; ++n) _Pragma("unroll") for (int k = 0; k < 2; ++k) \
        acc[ai][bj][m][n] = __builtin_amdgcn_mfma_f32_16x16x32_bf16(Bt[n][k], At[m][k], acc[ai][bj][m][n], 0, 0, 0); __builtin_amdgcn_s_setprio(0); } while (0)
#define PG8_WAIT_V(n) asm volatile("s_waitcnt vmcnt(" #n ")" ::: "memory")
#define PG8_WAIT_L(n) asm volatile("s_waitcnt lgkmcnt(" #n ")" ::: "memory")
#define PG8_BAR __builtin_amdgcn_s_barrier()
#define PG8_SCHED __builtin_amdgcn_sched_barrier(0)
    Unit cur, nxt; int ui = 0;
    if (!S.next(0, cur)) return;
    f32x4 acc[2][2][4][2];
#pragma unroll
    for (int a = 0; a < 2; ++a)
#pragma unroll
        for (int b = 0; b < 2; ++b)
#pragma unroll
            for (int m = 0; m < 4; ++m)
#pragma unroll
                for (int n = 0; n < 2; ++n) acc[a][b][m][n] = (f32x4){0.f, 0.f, 0.f, 0.f};
    bf16x8 At[4][2], B0[2][2], B1[2][2];
    const char* cA = (const char*)g.A + (size_t)cur.pm * tstep; const char* cB = (const char*)g.Bt + (size_t)cur.pn * tstep;
    S.a_ready(cur);
    if constexpr (SP2) {
        PG8_STAGE(PG8_SB(0, 0), cB, voffB); PG8_STAGE(PG8_SB(0, 1), cB + hstep, voffB); PG8_STAGE(PG8_SA(0, 0), cA, voffA); PG8_STAGE(PG8_SA(0, 1), cA + hstep, voffA);
        if (wr == 1) PG8_BAR;
        PG8_WAIT_V(2); PG8_BAR;
        PG8_STAGE(PG8_SB(1, 0), cB + kstep, voffB); PG8_STAGE(PG8_SA(1, 0), cA + kstep, voffA); PG8_STAGE(PG8_SB(1, 1), cB + hstep + kstep, voffB);
        PG8_WAIT_V(6); PG8_BAR;
    } else {
        PG8_STAGE(PG8_SB(0, 0), cB, voffB); PG8_STAGE(PG8_SA(0, 0), cA, voffA); PG8_STAGE(PG8_SB(0, 1), cB + hstep, voffB); PG8_STAGE(PG8_SA(0, 1), cA + hstep, voffA);
        if (wr == 1) PG8_BAR;
        PG8_WAIT_V(4); PG8_BAR;
        PG8_STAGE(PG8_SB(1, 0), cB + kstep, voffB); PG8_STAGE(PG8_SA(1, 0), cA + kstep, voffA); PG8_STAGE(PG8_SB(1, 1), cB + hstep + kstep, voffB);
        PG8_WAIT_V(6); PG8_BAR;
    }
    for (;;) {
        const bool has_next = S.next(ui + 1, nxt);
        const char* nA = has_next ? (const char*)g.A + (size_t)nxt.pm * tstep : cA; const char* nB = has_next ? (const char*)g.Bt + (size_t)nxt.pn * tstep : cB;
        for (int t = 0; t < nt; t += 2) {
            const bool last = (t == nt - 2);
            const char* a1 = cA + (size_t)(t + 1) * kstep;
            const char* a2 = last ? nA : cA + (size_t)(t + 2) * kstep; const char* b2 = last ? nB : cB + (size_t)(t + 2) * kstep;
            const char* a3 = a2 + kstep; const char* b3 = b2 + kstep;
            if (last && has_next) S.a_ready(nxt);
            if constexpr (SP2) {
            PG8_LDB(B0, 0, 0); PG8_LDB(B1, 0, 1); PG8_SCHED; PG8_LDA(At, 0, 0); PG8_STAGE(PG8_SA(1, 1), a1 + hstep, voffA);
            PG8_WAIT_V(8); PG8_WAIT_L(0); PG8_BAR; PG8_MMA(0, 0, At, B0); PG8_MMA(0, 1, At, B1); PG8_BAR; PG8_SCHED;
            PG8_LDA(At, 0, 1); PG8_STAGE(PG8_SB(0, 0), b2, voffB); PG8_STAGE(PG8_SB(0, 1), b2 + hstep, voffB); PG8_STAGE(PG8_SA(0, 0), a2, voffA);
            PG8_WAIT_V(8); PG8_WAIT_L(0); PG8_BAR; PG8_MMA(1, 0, At, B0); PG8_MMA(1, 1, At, B1); PG8_BAR; PG8_SCHED;
            PG8_LDB(B0, 1, 0); PG8_LDB(B1, 1, 1); PG8_SCHED; PG8_LDA(At, 1, 0); PG8_STAGE(PG8_SA(0, 1), a2 + hstep, voffA);
            PG8_WAIT_V(8); PG8_WAIT_L(0); PG8_BAR; PG8_MMA(0, 0, At, B0); PG8_MMA(0, 1, At, B1); PG8_BAR; PG8_SCHED;
            PG8_LDA(At, 1, 1); PG8_STAGE(PG8_SB(1, 0), b3, voffB); PG8_STAGE(PG8_SB(1, 1), b3 + hstep, voffB); PG8_STAGE(PG8_SA(1, 0), a3, voffA);
            PG8_WAIT_V(8); PG8_WAIT_L(0); PG8_BAR; PG8_MMA(1, 0, At, B0); PG8_MMA(1, 1, At, B1); PG8_BAR; PG8_SCHED;
            } else {
            PG8_LDB(B0, 0, 0); PG8_SCHED; PG8_LDA(At, 0, 0); PG8_STAGE(PG8_SA(1, 1), a1 + hstep, voffA);
            PG8_WAIT_L(8); PG8_BAR; PG8_WAIT_L(0); PG8_MMA(0, 0, At, B0); PG8_BAR; PG8_SCHED;
            PG8_LDB(B1, 0, 1); PG8_STAGE(PG8_SB(0, 0), b2, voffB);
            PG8_BAR; PG8_WAIT_L(0); PG8_MMA(0, 1, At, B1); PG8_BAR;
            PG8_LDA(At, 0, 1); PG8_STAGE(PG8_SA(0, 0), a2, voffA);
            PG8_BAR; PG8_WAIT_L(0); PG8_MMA(1, 0, At, B0); PG8_BAR; PG8_SCHED;
            PG8_STAGE(PG8_SB(0, 1), b2 + hstep, voffB);
            PG8_WAIT_V(6); PG8_BAR; PG8_MMA(1, 1, At, B1); PG8_BAR;
            PG8_LDB(B0, 1, 0); PG8_SCHED; PG8_LDA(At, 1, 0); PG8_STAGE(PG8_SA(0, 1), a2 + hstep, voffA);
            PG8_WAIT_L(8); PG8_BAR; PG8_WAIT_L(0); PG8_MMA(0, 0, At, B0); PG8_BAR; PG8_SCHED;
            PG8_LDB(B1, 1, 1); PG8_STAGE(PG8_SB(1, 0), b3, voffB);
            PG8_BAR; PG8_WAIT_L(0); PG8_MMA(0, 1, At, B1); PG8_BAR;
            PG8_LDA(At, 1, 1); PG8_STAGE(PG8_SA(1, 0), a3, voffA);
            PG8_BAR; PG8_WAIT_L(0); PG8_MMA(1, 0, At, B0); PG8_BAR; PG8_SCHED;
            PG8_STAGE(PG8_SB(1, 1), b3 + hstep, voffB);
            PG8_WAIT_V(6); PG8_BAR; PG8_MMA(1, 1, At, B1); PG8_BAR;
            }
        }
        if constexpr (ALIGN_EPI) { if (wr == 0) PG8_BAR; }
        if constexpr (!Epi::AFTER_DRAIN) { E(acc, cur, wr, wc, fr, fq); S.done(cur); }
        if (!has_next) break;
#pragma unroll
        for (int a = 0; a < 2; ++a)
#pragma unroll
            for (int b = 0; b < 2; ++b)
#pragma unroll
                for (int m = 0; m < 4; ++m)
#pragma unroll
                    for (int n = 0; n < 2; ++n) acc[a][b][m][n] = (f32x4){0.f, 0.f, 0.f, 0.f};
        cur = nxt; cA = nA; cB = nB; ++ui;
        if constexpr (ALIGN_EPI) { if (wr == 1) PG8_BAR; }
    }
    PG8_WAIT_V(0);
    if constexpr (!ALIGN_EPI) { if (wr == 0) PG8_BAR; }
    PG8_BAR;
    if constexpr (Epi::AFTER_DRAIN) { E.fused(acc, cur, wr, wc, fr, fq, lds, wid, lane); S.done(cur); }
#undef PG8_SA
#undef PG8_SB
#undef PG8_STAGE
#undef PG8_LDA
#undef PG8_LDB
#undef PG8_MMA
#undef PG8_WAIT_V
#undef PG8_WAIT_L
#undef PG8_BAR
#undef PG8_SCHED
}
}
#include <hip/hip_bf16.h>
namespace attn_body {
using bf16=__hip_bfloat16;
using bf16x8=__attribute__((ext_vector_type(8)))short;
using s16x4=__attribute__((ext_vector_type(4)))short;
using f32x16=__attribute__((ext_vector_type(16)))float;
using u32x4=__attribute__((ext_vector_type(4)))unsigned;
constexpr int BATCH=8,NHEAD=16,SEQ=4096,D=64,PITI=3584,PITO=1024;
constexpr int NW=8,QBLK=32,QB=QBLK*NW,KVBLK=64,NQB=SEQ/QB;
__device__ __forceinline__ int crow(int r,int hi){return (r&3)+8*(r>>2)+4*hi;}
#define SBAR() __builtin_amdgcn_sched_barrier(0)
__device__ __forceinline__ void cmask(f32x16&p0,f32x16&p1,int jb,int qrel,int hi){
  const float NEG=-INFINITY; int kb=64*jb+4*hi;
  #pragma unroll
  for(int r=0;r<16;++r){int kv=kb+(r&3)+8*(r>>2); if(kv>qrel)p0[r]=NEG; if(kv+32>qrel)p1[r]=NEG;}
}

constexpr int NSLOT=3, SLOTB=8192;
constexpr int LDS_K=0, LDS_V=NSLOT*SLOTB, LDS_WS=2*NSLOT*SLOTB, LDS_OST=LDS_WS+NW*64*4, LDS_BYTES=LDS_OST+NW*4096;
constexpr float C2=0.125f*1.4426950408889634f;
__device__ __forceinline__ void glds16(const void*gsrc,unsigned lds_dst){unsigned keep;
  asm volatile("s_mov_b32 %0, m0\n\ts_mov_b32 m0, %2\n\ts_nop 0\n\tglobal_load_lds_dwordx4 %1, off\n\ts_mov_b32 m0, %0":"=&s"(keep):"v"(gsrc),"s"(lds_dst):"memory");}
__device__ __forceinline__ float max3f(float a,float b,float c){float r;asm("v_max3_f32 %0, %1, %2, %3":"=v"(r):"v"(a),"v"(b),"v"(c));return r;}
__device__ __forceinline__ float max2f(float a,float b){float r;asm("v_max_f32_e32 %0, %1, %2":"=v"(r):"v"(a),"v"(b));return r;}
__device__ __forceinline__ float fadd_s(float a,float b){float r;asm("v_add_f32_e32 %0, %1, %2":"=v"(r):"v"(a),"v"(b));return r;}
__device__ __forceinline__ float fsub_s(float a,float b){float r;asm("v_sub_f32_e32 %0, %1, %2":"=v"(r):"v"(a),"v"(b));return r;}
typedef float f32x2_t __attribute__((ext_vector_type(2))); typedef __bf16 bf16x2_t __attribute__((ext_vector_type(2)));
__device__ __forceinline__ unsigned cvtpk_s(float lo,float hi){f32x2_t v={lo,hi};bf16x2_t b=__builtin_convertvector(v,bf16x2_t);return __builtin_bit_cast(unsigned,b);}
#define WAIT_BAR(N) asm volatile("s_waitcnt vmcnt(" #N ") lgkmcnt(0)\n\ts_barrier":::"memory")

__device__ __forceinline__ void qkt(f32x16&p0,f32x16&p1,const char*Kslot,const bf16x8*qr,const f32x16&negm,int r32,int hi){
  const char*kb=Kslot+hi*1024+r32*16;
  #pragma unroll
  for(int d0=0;d0<4;++d0){
    const bf16x8 b0=*reinterpret_cast<const bf16x8*>(kb+d0*2048);
    const bf16x8 b1=*reinterpret_cast<const bf16x8*>(kb+d0*2048+512);
    if(d0==0){p0=__builtin_amdgcn_mfma_f32_32x32x16_bf16(b0,qr[0],negm,0,0,0);p1=__builtin_amdgcn_mfma_f32_32x32x16_bf16(b1,qr[0],negm,0,0,0);}
    else{p0=__builtin_amdgcn_mfma_f32_32x32x16_bf16(b0,qr[d0],p0,0,0,0);p1=__builtin_amdgcn_mfma_f32_32x32x16_bf16(b1,qr[d0],p1,0,0,0);}}
}
typedef __attribute__((address_space(3))) const char* lds_cptr;
typedef short v4i16_t __attribute__((ext_vector_type(4)));
__device__ __forceinline__ void kload8(bf16x8*kf,lds_cptr kp){
  kf[0]=*(const __attribute__((address_space(3))) bf16x8*)(kp);      kf[1]=*(const __attribute__((address_space(3))) bf16x8*)(kp+512);
  kf[2]=*(const __attribute__((address_space(3))) bf16x8*)(kp+2048); kf[3]=*(const __attribute__((address_space(3))) bf16x8*)(kp+2560);
  kf[4]=*(const __attribute__((address_space(3))) bf16x8*)(kp+4096); kf[5]=*(const __attribute__((address_space(3))) bf16x8*)(kp+4608);
  kf[6]=*(const __attribute__((address_space(3))) bf16x8*)(kp+6144); kf[7]=*(const __attribute__((address_space(3))) bf16x8*)(kp+6656);
}
__device__ __forceinline__ void kload2(bf16x8*kf,lds_cptr kp,int j){ kf[2*j]=*(const __attribute__((address_space(3))) bf16x8*)(kp+j*2048); kf[2*j+1]=*(const __attribute__((address_space(3))) bf16x8*)(kp+j*2048+512); }
__device__ __forceinline__ s16x4 vtr(lds_cptr p){ return __builtin_bit_cast(s16x4,__builtin_amdgcn_ds_read_tr16_b64_v4i16((__attribute__((address_space(3))) v4i16_t*)p)); }
__device__ __forceinline__ float rowmax(const f32x16&p0,const f32x16&p1){
  float a=max3f(p0[0],p0[1],p1[0]),b=max3f(p0[2],p0[3],p1[1]);a=max3f(a,p1[2],p1[3]);
  #pragma unroll
  for(int r=4;r<16;r+=4){a=max3f(a,p0[r],p0[r+1]);b=max3f(b,p0[r+2],p0[r+3]);a=max3f(a,p1[r],p1[r+1]);b=max3f(b,p1[r+2],p1[r+3]);}
  const float m=max2f(a,b);
  auto rr=__builtin_amdgcn_permlane32_swap(__float_as_uint(m),__float_as_uint(m),false,false);
  return max2f(__uint_as_float(rr[0]),__uint_as_float(rr[1]));
}
__device__ __forceinline__ void pv(f32x16*o,int vb,bf16x8 pa0,bf16x8 pa1,bf16x8 pa2,bf16x8 pa3){
  #pragma unroll
  for(int d0=0;d0<2;++d0){s16x4 lo[4],hi[4];
    #pragma unroll
    for(int ks=0;ks<4;++ks){
      asm volatile("ds_read_b64_tr_b16 %0,%1 offset:%c2":"=&v"(lo[ks]):"v"(vb),"i"(d0*4096+ks*1024):"memory");
      asm volatile("ds_read_b64_tr_b16 %0,%1 offset:%c2":"=&v"(hi[ks]):"v"(vb),"i"(d0*4096+ks*1024+512):"memory");}
    asm volatile("s_waitcnt lgkmcnt(0)":::"memory");SBAR();
    #define PK(k) (bf16x8){lo[k][0],lo[k][1],lo[k][2],lo[k][3],hi[k][0],hi[k][1],hi[k][2],hi[k][3]}
    o[d0]=__builtin_amdgcn_mfma_f32_32x32x16_bf16(pa0,PK(0),o[d0],0,0,0);
    o[d0]=__builtin_amdgcn_mfma_f32_32x32x16_bf16(pa1,PK(1),o[d0],0,0,0);
    o[d0]=__builtin_amdgcn_mfma_f32_32x32x16_bf16(pa2,PK(2),o[d0],0,0,0);
    o[d0]=__builtin_amdgcn_mfma_f32_32x32x16_bf16(pa3,PK(3),o[d0],0,0,0);
    #undef PK
  }
}

#ifndef ATTN_STORE16
#define ATTN_STORE16(p,v) (*(u32x4*)(p)=(v))
#endif
template<int THRL> __device__ __forceinline__ void attn_unit(int b,int h,int qb,const bf16*Q,const bf16*__restrict__ K,const bf16*__restrict__ V,bf16*O,char*shm){
  const int tid=otid_(),lane=tid&63,r32=lane&31,hi=lane>>5; const int wid=__builtin_amdgcn_readfirstlane(tid>>6);
  const long rowbase=(long)b*SEQ; const int q0=qb*QB;
  const bf16*Qw=Q+(rowbase+q0+wid*QBLK)*PITI;
  const bf16*Kh=K+rowbase*PITI,*Vh=V+rowbase*PITI;
  const unsigned lds0=(unsigned)(uintptr_t)shm;
  float*wsf=(float*)(shm+LDS_WS)+wid*64;
  const bf16*ksrc=Kh+(long)lane*PITI+wid*8;
  const bf16*vsrc=Vh+(long)(16*(wid&3)+(lane>>2))*PITI+(wid>>2)*32+(lane&3)*8;
  const unsigned kdst=lds0+LDS_K+wid*1024, vdst=lds0+LDS_V+wid*1024;
  #define DMA_K(t,slot) glds16(ksrc+(long)(t)*KVBLK*PITI,(unsigned)__builtin_amdgcn_readfirstlane(kdst+(slot)))
  #define DMA_V(t,slot) glds16(vsrc+(long)(t)*KVBLK*PITI,(unsigned)__builtin_amdgcn_readfirstlane(vdst+(slot)))
  const int vb0=(int)(lds0+LDS_V)+((lane>>4)&1)*32+(lane&3)*8+(4*hi+((lane&15)>>2))*64;
  const char*Kbase=shm+LDS_K; bf16x8 kf[8];
  const lds_cptr shm3=(lds_cptr)shm; const lds_cptr kp0=shm3+LDS_K+hi*1024+r32*16; const lds_cptr vp0=shm3+LDS_V+((lane>>4)&1)*32+(lane&3)*8+(4*hi+((lane&15)>>2))*64;
  const int NT=(q0+QB)/KVBLK;
  DMA_K(0,0);DMA_V(0,0);DMA_K(1,SLOTB);
  bf16x8 qr[4];
  #pragma unroll
  for(int d0=0;d0<4;++d0)qr[d0]=*reinterpret_cast<const bf16x8*>(&Qw[(long)r32*PITI+d0*16+hi*8]);
  float mhat=0.f,l_reg=0.f;f32x16 o[2];o[0]=f32x16{};o[1]=f32x16{};f32x16 negm=f32x16{};asm volatile("":"+v"(negm));
  const int qrel=wid*QBLK+r32;
  #define CMASK(P0,P1,t) do{int jb_=(t)-(NT-4); if(jb_>=0)cmask(P0,P1,jb_,qrel,hi);}while(0)
  bool resc=false;
  #define START(P0,P1) do{ const float rm=rowmax(P0,P1); resc=false; \
    { const float dl=rm; mhat=fadd_s(mhat,dl); \
      _Pragma("unroll") for(int r=0;r<16;++r){P0[r]=fsub_s(P0[r],dl);P1[r]=fsub_s(P1[r],dl);} \
      _Pragma("unroll") for(int r=0;r<16;++r)negm[r]=-mhat; asm volatile("":"+v"(negm)); } \
    _Pragma("unroll") for(int r=0;r<16;++r)P0[r]=__builtin_amdgcn_exp2f(P0[r]); }while(0)
  #define RESC() do{ if(resc){ asm volatile("s_waitcnt lgkmcnt(0)":::"memory"); \
      _Pragma("unroll") for(int d_=0;d_<2;++d_) _Pragma("unroll") for(int r=0;r<16;++r)o[d_][r]*=wsf[crow(r,hi)]; } }while(0)
  f32x16 pA0,pA1,pB0,pB1;
  int sl_prev=0,sl_cur=0,sl_next=SLOTB;
  #define ROT() do{sl_prev=sl_cur;sl_cur=sl_next;sl_next=(sl_next==(NSLOT-1)*SLOTB)?0:sl_next+SLOTB;}while(0)
  DMA_K(2,2*SLOTB);
  WAIT_BAR(3);
  qkt(pA0,pA1,Kbase,qr,negm,r32,hi);asm volatile("s_nop 15\n\ts_nop 7":"+v"(pA0),"+v"(pA1));CMASK(pA0,pA1,0);
  START(pA0,pA1);
  _Pragma("unroll") for(int r=0;r<16;++r)pA1[r]=__builtin_amdgcn_exp2f(pA1[r]);
  WAIT_BAR(0);
  DMA_K(3,0);DMA_V(1,SLOTB);
  ROT();
  kload8(kf,kp0+sl_cur);
  WAIT_BAR(2);
  s16x4 vlo[8],vhi[8]; u32x4 pw0,pw1,pw2,pw3;
  #define PKW(P,B) cvtpk_s(P[B],P[B+1])
  #define PAF(k) __builtin_bit_cast(bf16x8,pw##k)
  #define VFR(i) (bf16x8){vlo[i][0],vlo[i][1],vlo[i][2],vlo[i][3],vhi[i][0],vhi[i][1],vhi[i][2],vhi[i][3]}
  #define PIN(x) asm volatile("":"+v"(x))
  #define MX3(a,b,c) __builtin_fmaxf(__builtin_fmaxf((a),(b)),(c))
  #define GAPA(MF,A0,A1,A2,A3,W0,W1,PW) do{ MF; sacc+=A0; sacc+=A1; sacc+=A2; sacc+=A3; PIN(sacc); W0; W1; PIN(PW); SBAR(); }while(0)
  #define EX(v) __builtin_amdgcn_exp2f(v)
  #define GAPB(MF,X,B) do{ MF; X[B]=EX(X[B]); X[B+1]=EX(X[B+1]); X[B+2]=EX(X[B+2]); X[B+3]=EX(X[B+3]); PIN(X); SBAR(); }while(0)
  #define VRD(i) do{ vlo[i]=vtr(vp_+(((i)>>2)*4096+((i)&3)*1024)); vhi[i]=vtr(vp_+(((i)>>2)*4096+((i)&3)*1024+512)); }while(0)
  #define KRD(G,j) do{ if(G){ kload2(kf,kp0+sl_next,j); SBAR(); } }while(0)
  #define STEP(C0,C1,P0,P1,t,GK,GV,GL) do{ SBAR(); \
    const lds_cptr vp_=vp0+sl_prev; \
    VRD(0); SBAR(); float sacc=(P0[0]+P0[1]); \
    GAPA(C0=__builtin_amdgcn_mfma_f32_32x32x16_bf16(kf[0],qr[0],negm,0,0,0), P0[2],P0[3],P0[4],P0[5],     pw0[0]=PKW(P0,0), pw0[1]=PKW(P0,2), pw0); \
    VRD(4); SBAR(); GAPA(C1=__builtin_amdgcn_mfma_f32_32x32x16_bf16(kf[1],qr[0],negm,0,0,0), P0[6],P0[7],P0[8],P0[9],     pw0[2]=PKW(P0,4), pw0[3]=PKW(P0,6), pw0); \
    VRD(1); SBAR(); GAPA(C0=__builtin_amdgcn_mfma_f32_32x32x16_bf16(kf[2],qr[1],C0,0,0,0),   P0[10],P0[11],P0[12],P0[13], pw1[0]=PKW(P0,8), pw1[1]=PKW(P0,10), pw1); \
    VRD(5); SBAR(); GAPA(C1=__builtin_amdgcn_mfma_f32_32x32x16_bf16(kf[3],qr[1],C1,0,0,0),   P0[14],P0[15],P1[0],P1[1],   pw1[2]=PKW(P0,12),pw1[3]=PKW(P0,14), pw1); \
    VRD(2); SBAR(); GAPA(C0=__builtin_amdgcn_mfma_f32_32x32x16_bf16(kf[4],qr[2],C0,0,0,0),   P1[2],P1[3],P1[4],P1[5],     pw2[0]=PKW(P1,0), pw2[1]=PKW(P1,2), pw2); \
    VRD(6); SBAR(); GAPA(C1=__builtin_amdgcn_mfma_f32_32x32x16_bf16(kf[5],qr[2],C1,0,0,0),   P1[6],P1[7],P1[8],P1[9],     pw2[2]=PKW(P1,4), pw2[3]=PKW(P1,6), pw2); \
    VRD(3); SBAR(); GAPA(C0=__builtin_amdgcn_mfma_f32_32x32x16_bf16(kf[6],qr[3],C0,0,0,0),   P1[10],P1[11],P1[12],P1[13], pw3[0]=PKW(P1,8), pw3[1]=PKW(P1,10), pw3); \
    VRD(7); SBAR(); GAPA(C1=__builtin_amdgcn_mfma_f32_32x32x16_bf16(kf[7],qr[3],C1,0,0,0),   P1[14],P1[15],0.f,0.f,       pw3[2]=PKW(P1,12),pw3[3]=PKW(P1,14), pw3); \
    l_reg+=sacc; \
    if(GK){DMA_K((t)+3,sl_cur);} if(GV){DMA_V((t)+1,sl_next);} \
    CMASK(C0,C1,t); \
    { float a=MX3(C0[0],C0[1],C1[0]),b=MX3(C0[2],C0[3],C1[1]); a=MX3(a,C1[2],C1[3]); \
      _Pragma("unroll") for(int r=4;r<16;r+=4){a=MX3(a,C0[r],C0[r+1]);b=MX3(b,C0[r+2],C0[r+3]);a=MX3(a,C1[r],C1[r+1]);b=MX3(b,C1[r+2],C1[r+3]);} \
      float rm=__builtin_fmaxf(a,b); { auto rr=__builtin_amdgcn_permlane32_swap(__float_as_uint(rm),__float_as_uint(rm),false,false); rm=__builtin_fmaxf(__uint_as_float(rr[0]),__uint_as_float(rr[1])); } \
      resc=false; \
      if(__builtin_expect(__any(rm>(float)THRL),0)){ const float dl=__builtin_fmaxf(rm,0.f); mhat+=dl; \
        _Pragma("unroll") for(int r=0;r<16;++r){C0[r]-=dl;C1[r]-=dl;} \
        _Pragma("unroll") for(int r=0;r<16;++r)negm[r]=-mhat; asm volatile("":"+v"(negm)); \
        const float f=__builtin_amdgcn_exp2f(-dl); l_reg*=f; if(hi==0)wsf[r32]=f; resc=true; } } \
    SBAR(); \
    GAPB(o[0]=__builtin_amdgcn_mfma_f32_32x32x16_bf16(PAF(0),VFR(0),o[0],0,0,0), C0,0); \
    GAPB(o[1]=__builtin_amdgcn_mfma_f32_32x32x16_bf16(PAF(0),VFR(4),o[1],0,0,0), C0,4); \
    KRD(GL,0); GAPB(o[0]=__builtin_amdgcn_mfma_f32_32x32x16_bf16(PAF(1),VFR(1),o[0],0,0,0), C0,8); \
    KRD(GL,1); GAPB(o[1]=__builtin_amdgcn_mfma_f32_32x32x16_bf16(PAF(1),VFR(5),o[1],0,0,0), C0,12); \
    KRD(GL,2); GAPB(o[0]=__builtin_amdgcn_mfma_f32_32x32x16_bf16(PAF(2),VFR(2),o[0],0,0,0), C1,0); \
    KRD(GL,3); GAPB(o[1]=__builtin_amdgcn_mfma_f32_32x32x16_bf16(PAF(2),VFR(6),o[1],0,0,0), C1,4); \
    GAPB(o[0]=__builtin_amdgcn_mfma_f32_32x32x16_bf16(PAF(3),VFR(3),o[0],0,0,0), C1,8); \
    GAPB(o[1]=__builtin_amdgcn_mfma_f32_32x32x16_bf16(PAF(3),VFR(7),o[1],0,0,0), C1,12); \
    }while(0)
  int t=1;
  #undef CMASK
  #define CMASK(P0,P1,t) do{}while(0)
  for(;t+5<NT;t+=2){
    STEP(pB0,pB1,pA0,pA1,t,true,true,true);     WAIT_BAR(2); RESC(); ROT();
    STEP(pA0,pA1,pB0,pB1,t+1,true,true,true);   WAIT_BAR(2); RESC(); ROT();
  }
  #undef CMASK
  #define CMASK(P0,P1,t) do{int jb_=(t)-(NT-4); if(jb_>=0)cmask(P0,P1,jb_,qrel,hi);}while(0)
  #define ENDW(tt) do{ if((tt)+3<NT){WAIT_BAR(2);} else if((tt)+2<NT){WAIT_BAR(1);} else {WAIT_BAR(0);} }while(0)
  for(;t+1<NT;t+=2){
    STEP(pB0,pB1,pA0,pA1,t,(t+3<NT),(t+1<NT),(t+1<NT));       ENDW(t);   RESC(); ROT();
    STEP(pA0,pA1,pB0,pB1,t+1,(t+4<NT),(t+2<NT),(t+2<NT));     ENDW(t+1); RESC(); ROT();
  }
  STEP(pB0,pB1,pA0,pA1,NT-1,false,false,false); RESC();
  { float sacc=pB0[0]+pB0[1]; _Pragma("unroll") for(int r=2;r<16;++r)sacc+=pB0[r]; _Pragma("unroll") for(int r=0;r<16;++r)sacc+=pB1[r]; l_reg+=sacc;
    pw0=(u32x4){PKW(pB0,0),PKW(pB0,2),PKW(pB0,4),PKW(pB0,6)};pw1=(u32x4){PKW(pB0,8),PKW(pB0,10),PKW(pB0,12),PKW(pB0,14)};pw2=(u32x4){PKW(pB1,0),PKW(pB1,2),PKW(pB1,4),PKW(pB1,6)};pw3=(u32x4){PKW(pB1,8),PKW(pB1,10),PKW(pB1,12),PKW(pB1,14)};
    SBAR(); pv(o,vb0+sl_cur,PAF(0),PAF(1),PAF(2),PAF(3)); }
  #undef PKW
  #undef PAF
  #undef VFR
  #undef PIN
  #undef MX3
  #undef GAPA
  #undef GAPB
  #undef EX
  #undef VRD
  #undef KRD
  #undef STEP
  #undef ENDW
  {auto rr=__builtin_amdgcn_permlane32_swap(__float_as_uint(l_reg),__float_as_uint(l_reg),false,false);l_reg=__uint_as_float(rr[0])+__uint_as_float(rr[1]);}
  if(hi==0)wsf[32+r32]=l_reg;asm volatile("s_waitcnt lgkmcnt(0)":::"memory");
  float rli[16];
  #pragma unroll
  for(int r=0;r<16;++r)rli[r]=__builtin_amdgcn_rcpf(wsf[32+crow(r,hi)]);
  bf16*Ow=O+(rowbase+q0+wid*QBLK)*PITO;
  { bf16*stg=(bf16*)(shm+LDS_OST)+wid*2048;
    #pragma unroll
    for(int r=0;r<16;++r){const int orow=crow(r,hi);
      #pragma unroll
      for(int d0=0;d0<2;++d0)stg[orow*64+d0*32+r32]=__float2bfloat16(o[d0][r]*rli[r]);}
    asm volatile("s_waitcnt lgkmcnt(0)":::"memory");
    #pragma unroll
    for(int i=0;i<4;++i){const int row=i*8+(lane>>3),ch=lane&7; const u32x4 v=*(const u32x4*)(stg+row*64+ch*8); ATTN_STORE16(Ow+(long)row*PITO+ch*8,v);} }
  asm volatile("s_waitcnt lgkmcnt(0)\n\ts_barrier":::"memory");
  #undef DMA_K
  #undef DMA_V
  #undef CMASK
  #undef START
  #undef RESC
  #undef ROT
}
constexpr int ATTN_LDS_BYTES=LDS_BYTES;
#undef SBAR
#undef WAIT_BAR
}

namespace cg = cooperative_groups;
typedef unsigned short bf16_t;
typedef float f32x4 __attribute__((ext_vector_type(4)));
typedef float f32x16 __attribute__((ext_vector_type(16)));
typedef unsigned u32x4 __attribute__((ext_vector_type(4)));
typedef unsigned u32x2 __attribute__((ext_vector_type(2)));
typedef short bf16x8 __attribute__((ext_vector_type(8)));
#define LAS3 __attribute__((address_space(3)))

constexpr int T_ = 32768, DM_ = 1024, SEQ_ = 4096, DFF_ = 2816;
constexpr int NTHR = 512;
constexpr int LDS_BYTES = 147456;
constexpr size_t MiB_ = 1u << 20;
constexpr size_t WS_MOD = 0, WS_COS = 1 * MiB_, WS_SIN = 2 * MiB_, WS_BAR = 3 * MiB_;
constexpr size_t WS_WIN = 4 * MiB_, WS_WOUT = 11 * MiB_, WS_FIN = 13 * MiB_, WS_FOUT = 24 * MiB_;
constexpr size_t WS_A = 32 * MiB_, WS_X2 = 96 * MiB_, WS_ST = 160 * MiB_, WS_TOT = 224 * MiB_, WS_R1 = 226 * MiB_, WS_BIAS = 450 * MiB_, WS_ROWSS = 452 * MiB_, WS_FOUT2 = 454 * MiB_, WS_END = 460 * MiB_;
constexpr int BIAS_L = 8 * (3584 + 5632);
constexpr size_t WS_HP = WS_ST, WS_HU = WS_ST + 12 * MiB_, WS_HA = WS_ST + 24 * MiB_;
constexpr float LOG2E_ = 1.4426950408889634f;
constexpr float QSCALE_ = 0.125f * 1.4426950408889634f;

struct Params {
    const float* x; const float* c; const int* positions; const float* mod_w; const float* mod_b; const float* norm_mix_w; const float* norm_ffn_w;
    const float* ev_w_in; const float* gla_gate_w; const float* gla_gate_b; const float* gla_norm_w; const float* swa_sinks; const float* ev_w_out;
    const float* od_w_in; const float* diff_lambda; const float* diff_norm_w; const float* hgrn_lb_logits; const float* hgrn_norm_w; const float* od_w_out;
    const float* ffn_w_in; const float* ffn_conv_w; const float* ffn_conv_b; const float* ffn_w_out; const float* final_norm_w;
    float* out; unsigned char* ws; unsigned long long pad[6];
};

__device__ __forceinline__ unsigned pk2(float lo, float hi) {
    typedef float f32x2_t __attribute__((ext_vector_type(2))); typedef __bf16 bf16x2_t __attribute__((ext_vector_type(2)));
    f32x2_t v = {lo, hi}; bf16x2_t b = __builtin_convertvector(v, bf16x2_t); return __builtin_bit_cast(unsigned, b);
}
__device__ __forceinline__ float bflo(unsigned u) { return __uint_as_float(u << 16); }
__device__ __forceinline__ float bfhi(unsigned u) { return __uint_as_float(u & 0xffff0000u); }
__device__ __forceinline__ float sigmoidf_(float x) { return __builtin_amdgcn_rcpf(1.f + __expf(-x)); }
__device__ __forceinline__ float siluf_(float x) { return x * __builtin_amdgcn_rcpf(1.f + __expf(-x)); }
__device__ __forceinline__ float wave_sum(float v) {
#pragma unroll
    for (int o = 1; o < 64; o <<= 1) v += __shfl_xor(v, o);
    return v;
}
__device__ __forceinline__ int crow_(int r, int hi) { return (r & 3) + 8 * (r >> 2) + 4 * hi; }

namespace pg8 {
struct EpiProj {
    static constexpr bool PERM = true, AFTER_DRAIN = false;
    bf16_t* O; int ldc; unsigned ropemask; unsigned scalemask; float scale; const float* cs; const float* sn; const float* rowss; const float* bias;
    __device__ __forceinline__ void operator()(const f32x4 (&acc)[2][2][4][2], const Unit& u, int, int, int, int) const {
        const int t_ = otid_(), l_ = t_ & 63, fr = l_ & 15, fq = l_ >> 4, wid_ = __builtin_amdgcn_readfirstlane(t_ >> 6), wr = wid_ >> 2, wc = wid_ & 3;
        const int row0 = u.pm * BM + wr * 64 + fr; const int col0 = u.pn * BM + wc * 32 + 8 * fq;
        float rs[2][4];
#pragma unroll
        for (int ai = 0; ai < 2; ++ai)
#pragma unroll
            for (int m = 0; m < 4; ++m) rs[ai][m] = rsqrtf(rowss[row0 + ai * HALF + m * 16] * (1.f / 1024.f) + 1e-6f);
        const float* bp = bias + (size_t)((u.pm * BM) >> 12) * ldc + col0;
#pragma unroll
        for (int bj = 0; bj < 2; ++bj) {
            const f32x4 bv0 = *(const f32x4*)(bp + bj * HALF), bv1 = *(const f32x4*)(bp + bj * HALF + 4);
            const int grp = u.pn * 2 + bj;
            const bool rope = ((ropemask >> grp) & 1u) && ((wc & 1) == 0);
            const float sc = ((scalemask >> grp) & 1u) ? scale : 1.f;
#pragma unroll
            for (int ai = 0; ai < 2; ++ai)
#pragma unroll
                for (int m = 0; m < 4; ++m) {
                    const int row = row0 + ai * HALF + m * 16;
                    f32x4 v0 = acc[ai][bj][m][0] * rs[ai][m] + bv0, v1 = acc[ai][bj][m][1] * rs[ai][m] + bv1;
                    if (rope) {
                        const f32x4 c0 = *(const f32x4*)(cs + (size_t)row * 8), c1 = *(const f32x4*)(cs + (size_t)row * 8 + 4);
                        const f32x4 s0 = *(const f32x4*)(sn + (size_t)row * 8), s1 = *(const f32x4*)(sn + (size_t)row * 8 + 4);
                        const float sg = (fq == 0) ? -1.f : 1.f;
#pragma unroll
                        for (int e = 0; e < 4; ++e) {
                            const float p0 = __shfl_xor(v0[e], 16), p1 = __shfl_xor(v1[e], 16);
                            const float r0 = v0[e] * c0[e] + sg * p0 * s0[e], r1 = v1[e] * c1[e] + sg * p1 * s1[e];
                            if (fq < 2) { v0[e] = r0; v1[e] = r1; }
                        }
                    }
                    v0 = v0 * sc; v1 = v1 * sc;
                    u32x4 w; w.x = pk2(v0[0], v0[1]); w.y = pk2(v0[2], v0[3]); w.z = pk2(v1[0], v1[1]); w.w = pk2(v1[2], v1[3]);
                    *(u32x4*)(O + (size_t)row * ldc + col0 + bj * HALF) = w;
                    asm volatile("" ::: "memory");
                }
        }
    }
};
typedef _Float16 h16x2 __attribute__((ext_vector_type(2)));
__device__ __forceinline__ unsigned pkh2(float lo, float hi) { typedef float f32x2_t __attribute__((ext_vector_type(2))); f32x2_t v = {lo, hi}; return __builtin_bit_cast(unsigned, __builtin_convertvector(v, h16x2)); }
__device__ __forceinline__ f32x4 unpkh4(unsigned w0, unsigned w1) { const h16x2 a = __builtin_bit_cast(h16x2, w0), b = __builtin_bit_cast(h16x2, w1); return (f32x4){(float)a[0], (float)a[1], (float)b[0], (float)b[1]}; }
struct EpiRes {
    static constexpr bool PERM = true, AFTER_DRAIN = false;
    const void* xin; void* xout; int inf32, outf32; const float* gate;
    bf16_t* Aout; const float* nw; const float* sc; float* rowss;
    __device__ __forceinline__ void operator()(const f32x4 (&acc)[2][2][4][2], const Unit& u, int, int, int, int) const {
        const int t_ = otid_(), l_ = t_ & 63, fr = l_ & 15, fq = l_ >> 4, wid_ = __builtin_amdgcn_readfirstlane(t_ >> 6), wr = wid_ >> 2, wc = wid_ & 3;
        const int col0 = u.pn * BM + wc * 32 + 8 * fq;
        const size_t boff = (size_t)((u.pm * BM) >> 12) * 6144 + col0;
        f32x4 gv[2][2];
#pragma unroll
        for (int bj = 0; bj < 2; ++bj)
#pragma unroll
            for (int n = 0; n < 2; ++n) gv[bj][n] = *(const f32x4*)(gate + boff + bj * HALF + n * 4);
        const int rowb = u.pm * BM + wr * 64 + fr;
        const unsigned eo0 = (unsigned)rowb * 1024u + (unsigned)col0;
        const char* xi = (const char*)xin; char* xo = (char*)xout; char* ao = (char*)Aout;
#pragma unroll
        for (int grp = 0; grp < 8; ++grp) {
            const int ai = grp >> 2, m = grp & 3;
            const unsigned eo = eo0 + (unsigned)(ai * HALF + m * 16) * 1024u;
            float ss = 0.f;
#pragma unroll
            for (int bj = 0; bj < 2; ++bj) {
                const unsigned e2 = eo + (unsigned)(bj * HALF);
                f32x4 x0, x1;
                if (inf32) { x0 = *(const f32x4*)(xi + e2 * 4u); x1 = *(const f32x4*)(xi + e2 * 4u + 16u); }
                else { const u32x4 h = *(const u32x4*)(xi + e2 * 2u); x0 = unpkh4(h.x, h.y); x1 = unpkh4(h.z, h.w); }
                const f32x4 xn0 = x0 + gv[bj][0] * acc[ai][bj][m][0], xn1 = x1 + gv[bj][1] * acc[ai][bj][m][1];
                if (outf32) { *(f32x4*)(xo + e2 * 4u) = xn0; *(f32x4*)(xo + e2 * 4u + 16u) = xn1; }
                else { u32x4 h; h.x = pkh2(xn0[0], xn0[1]); h.y = pkh2(xn0[2], xn0[3]); h.z = pkh2(xn1[0], xn1[1]); h.w = pkh2(xn1[2], xn1[3]); *(u32x4*)(xo + e2 * 2u) = h; }
                if (Aout) {
                    ss += ((xn0[0] * xn0[0] + xn0[1] * xn0[1]) + (xn0[2] * xn0[2] + xn0[3] * xn0[3])) + ((xn1[0] * xn1[0] + xn1[1] * xn1[1]) + (xn1[2] * xn1[2] + xn1[3] * xn1[3]));
                    const f32x4 a0 = xn0 * (*(const f32x4*)(nw + col0 + bj * HALF) * (*(const f32x4*)(sc + boff + bj * HALF) + 1.f));
                    const f32x4 a1 = xn1 * (*(const f32x4*)(nw + col0 + bj * HALF + 4) * (*(const f32x4*)(sc + boff + bj * HALF + 4) + 1.f));
                    u32x4 q; q.x = pk2(a0[0], a0[1]); q.y = pk2(a0[2], a0[3]); q.z = pk2(a1[0], a1[1]); q.w = pk2(a1[2], a1[3]);
                    *(u32x4*)(ao + e2 * 2u) = q;
                }
            }
            if (Aout) {
                ss += __shfl_xor(ss, 16); ss += __shfl_xor(ss, 32);
                if (fq == 0) atomicAdd(rowss + rowb + ai * HALF + m * 16, ss);
            }
            asm volatile("" ::: "memory");
        }
    }
};
struct EpiFfn {
    static constexpr bool PERM = true, AFTER_DRAIN = false;
    bf16_t* G; unsigned short* HP; unsigned short* HU; unsigned short* HA;   const float* cw; const float* cb; const float* rowss; const float* bias;
    __device__ __forceinline__ void operator()(const f32x4 (&acc)[2][2][4][2], const Unit& u, int, int, int, int) const {
        const int t_ = otid_(), l_ = t_ & 63, fr = l_ & 15, fq = l_ >> 4, wid_ = __builtin_amdgcn_readfirstlane(t_ >> 6), wr = wid_ >> 2, wc = wid_ & 3;
        const int ch0 = u.pn * 128 + wc * 32 + 8 * fq;
        f32x4 w0[2], w1[2], w2[2], bb[2];
#pragma unroll
        for (int n = 0; n < 2; ++n) { w0[n] = *(const f32x4*)(cw + ch0 + 4 * n); w1[n] = *(const f32x4*)(cw + DFF_ + ch0 + 4 * n); w2[n] = *(const f32x4*)(cw + 2 * DFF_ + ch0 + 4 * n); bb[n] = *(const f32x4*)(cb + ch0 + 4 * n); }
        const int lane = fr + 16 * fq;
        const int src1 = (lane & ~15) | ((fr + 15) & 15), src2 = (lane & ~15) | ((fr + 14) & 15);
        const float* bp = bias + (size_t)((u.pm * BM) >> 12) * 5632 + u.pn * BM + wc * 32 + 8 * fq;
        f32x4 ba[2], bu[2];
#pragma unroll
        for (int n = 0; n < 2; ++n) { ba[n] = *(const f32x4*)(bp + 4 * n); bu[n] = *(const f32x4*)(bp + HALF + 4 * n); }
#pragma unroll
        for (int ai = 0; ai < 2; ++ai) {
            const int seg = u.pm * 4 + ai * 2 + wr;
            f32x4 aprev[2]; aprev[0] = (f32x4){0.f, 0.f, 0.f, 0.f}; aprev[1] = (f32x4){0.f, 0.f, 0.f, 0.f};
#pragma unroll
            for (int m = 0; m < 4; ++m) {
                const int row = u.pm * BM + ai * HALF + wr * 64 + m * 16 + fr;
                const float rs = rsqrtf(rowss[row] * (1.f / 1024.f) + 1e-6f);
                f32x4 val[2], acur[2];
#pragma unroll
                for (int n = 0; n < 2; ++n) {
                    const f32x4 a = acc[ai][0][m][n] * rs + ba[n];
                    acur[n] = a;
                    const f32x4 ap = aprev[n];
#pragma unroll
                    for (int e = 0; e < 4; ++e) {
                        const float t1 = (fr == 15) ? ap[e] : a[e];
                        const float t2 = (fr >= 14) ? ap[e] : a[e];
                        const float p1 = __shfl(t1, src1), p2 = __shfl(t2, src2);
                        val[n][e] = w2[n][e] * a[e] + w1[n][e] * p1 + w0[n][e] * p2 + bb[n][e];
                    }
                }
                const f32x4 u0 = acc[ai][1][m][0] * rs + bu[0], u1 = acc[ai][1][m][1] * rs + bu[1];
                f32x4 g0, g1;
#pragma unroll
                for (int e = 0; e < 4; ++e) { g0[e] = siluf_(val[0][e]) * u0[e]; g1[e] = siluf_(val[1][e]) * u1[e]; }
                u32x4 w; w.x = pk2(g0[0], g0[1]); w.y = pk2(g0[2], g0[3]); w.z = pk2(g1[0], g1[1]); w.w = pk2(g1[2], g1[3]);
                *(u32x4*)(G + (size_t)row * DFF_ + ch0) = w;
                if (m == 0 && fr < 2) {
                    const size_t ho = (size_t)(seg * 2 + fr) * DFF_ + ch0;
                    u32x4 hp; hp.x = pkh2(val[0][0], val[0][1]); hp.y = pkh2(val[0][2], val[0][3]); hp.z = pkh2(val[1][0], val[1][1]); hp.w = pkh2(val[1][2], val[1][3]);
                    u32x4 hu; hu.x = pkh2(u0[0], u0[1]); hu.y = pkh2(u0[2], u0[3]); hu.z = pkh2(u1[0], u1[1]); hu.w = pkh2(u1[2], u1[3]);
                    *(u32x4*)(HP + ho) = hp; *(u32x4*)(HU + ho) = hu;
                }
                if (m == 3 && fr >= 14) {
                    const size_t ho = (size_t)(seg * 2 + (fr - 14)) * DFF_ + ch0;
                    u32x4 ha; ha.x = pkh2(acur[0][0], acur[0][1]); ha.y = pkh2(acur[0][2], acur[0][3]); ha.z = pkh2(acur[1][0], acur[1][1]); ha.w = pkh2(acur[1][2], acur[1][3]);
                    *(u32x4*)(HA + ho) = ha;
                }
                aprev[0] = acur[0]; aprev[1] = acur[1];
                asm volatile("" ::: "memory");
            }
        }
    }
};
}

struct Ctx { Params p; unsigned char* lds; int tid, lane, wave, gw, ngw; };

__device__ __forceinline__ void phase_prologue(const Ctx& C) {
    const Params& p = C.p;
    float* cact = (float*)C.lds;
    float* red = (float*)(C.lds + 32768);
    float* mod = (float*)(p.ws + WS_MOD);
    const int tid = C.tid;
    for (int i = tid; i < 8192; i += NTHR) { const float c = p.c[i]; cact[i] = c / (1.f + __expf(-c)); }
    __syncthreads();
    const int col = tid & 63, kp = tid >> 6;
    for (int g = blockIdx.x; g < 384; g += gridDim.x) {
        const int l = g / 96, j = (g % 96) * 64 + col;
        const float* w = p.mod_w + (size_t)l * 1024 * 6144 + (size_t)(kp * 128) * 6144 + j;
        float a0 = 0.f, a1 = 0.f, a2 = 0.f, a3 = 0.f, a4 = 0.f, a5 = 0.f, a6 = 0.f, a7 = 0.f;
        const float* ca = cact + kp * 128;
#pragma unroll 8
        for (int k = 0; k < 128; ++k) {
            const float wv = w[(size_t)k * 6144];
            a0 += ca[k] * wv; a1 += ca[1024 + k] * wv; a2 += ca[2048 + k] * wv; a3 += ca[3072 + k] * wv;
            a4 += ca[4096 + k] * wv; a5 += ca[5120 + k] * wv; a6 += ca[6144 + k] * wv; a7 += ca[7168 + k] * wv;
        }
        float* r = red + (kp * 8) * 64 + col;
        r[0] = a0; r[64] = a1; r[128] = a2; r[192] = a3; r[256] = a4; r[320] = a5; r[384] = a6; r[448] = a7;
        __syncthreads();
        { const int b = tid >> 6; float s = 0.f;
#pragma unroll
          for (int kk = 0; kk < 8; ++kk) s += red[(kk * 8 + b) * 64 + col];
          mod[(size_t)(l * 8 + b) * 6144 + j] = s + p.mod_b[l * 6144 + j]; }
        __syncthreads();
    }
    {
        u32x4* zb = (u32x4*)(p.ws + WS_BIAS); const int nzb = 4 * BIAS_L * 4 / 16;
        for (int i = blockIdx.x * NTHR + tid; i < nzb; i += gridDim.x * NTHR) zb[i] = (u32x4){0u, 0u, 0u, 0u};
        u32x4* zr = (u32x4*)(p.ws + WS_ROWSS);
        for (int i = blockIdx.x * NTHR + tid; i < 8 * T_ * 4 / 16; i += gridDim.x * NTHR) zr[i] = (u32x4){0u, 0u, 0u, 0u};
    }
    float* cs = (float*)(p.ws + WS_COS); float* sn = (float*)(p.ws + WS_SIN);
    const float invf[8] = {1.0f, 0.1939227432012558f, 0.03760603070259094f, 0.007292664609849453f, 0.0014142135623842478f, 0.00027424818836152554f, 5.3182957344688475e-05f, 1.0313385246263351e-05f};
    for (int r = blockIdx.x * NTHR + tid; r < T_; r += gridDim.x * NTHR) {
        const float pos = (float)p.positions[r];
        f32x4 c4[2], s4[2];
#pragma unroll
        for (int i = 0; i < 8; ++i) {
            const float ang = pos * invf[i];
            const double xr = (double)ang * 0.15915494309189535;
            const float f = (float)(xr - rint(xr));
            c4[i >> 2][i & 3] = __builtin_amdgcn_cosf(f); s4[i >> 2][i & 3] = __builtin_amdgcn_sinf(f);
        }
        *(f32x4*)(cs + (size_t)r * 8) = c4[0]; *(f32x4*)(cs + (size_t)r * 8 + 4) = c4[1];
        *(f32x4*)(sn + (size_t)r * 8) = s4[0]; *(f32x4*)(sn + (size_t)r * 8 + 4) = s4[1];
    }
}

__device__ __forceinline__ void tr_item(const float* W, int Nsrc, int srccol0, bf16_t* WT, int K, int dstrow0, int k0, float* scr, int lane) {
    float wv[32];
#pragma unroll
    for (int i = 0; i < 32; ++i) wv[i] = W[(size_t)(k0 + 2 * i + (lane >> 5)) * Nsrc + srccol0 + (lane & 31)];
#pragma unroll
    for (int i = 0; i < 32; ++i) scr[(2 * i + (lane >> 5)) * 33 + (lane & 31)] = wv[i];
    asm volatile("s_waitcnt lgkmcnt(0)" ::: "memory");
    const int c = lane & 7;
#pragma unroll
    for (int j = 0; j < 4; ++j) { const int n = (lane >> 3) + 8 * j; const float* s = scr + (8 * c) * 33 + n;
        u32x4 o; o.x = pk2(s[0 * 33], s[1 * 33]); o.y = pk2(s[2 * 33], s[3 * 33]); o.z = pk2(s[4 * 33], s[5 * 33]); o.w = pk2(s[6 * 33], s[7 * 33]);
        *(u32x4*)(WT + (size_t)(dstrow0 + n) * K + k0 + 8 * c) = o; }
    asm volatile("s_waitcnt lgkmcnt(0)" ::: "memory");
}
__device__ __forceinline__ void phase_convert(const Ctx& C, int l, bool do_bias = true) {
    const Params& p = C.p; const int j = l >> 1; const bool even = !(l & 1);
    float* scr = (float*)(C.lds + C.wave * 8704);
    bf16_t* WIN = (bf16_t*)(p.ws + WS_WIN); bf16_t* WOUT = (bf16_t*)(p.ws + WS_WOUT); bf16_t* FIN = (bf16_t*)(p.ws + WS_FIN); bf16_t* FOUT = (bf16_t*)(p.ws + ((l & 1) ? WS_FOUT2 : WS_FOUT));
    const int nA = even ? 80 : 112;
    const int IA = 16 * nA, IB = 16 * 32, IC = 16 * 176, ID = 44 * 32;
    const float* win = even ? p.ev_w_in + (size_t)j * 1024 * 2320 : p.od_w_in + (size_t)j * 1024 * 3584;
    const float* wout = even ? p.ev_w_out + (size_t)j * 1024 * 1024 : p.od_w_out + (size_t)j * 1024 * 1024;
    const float* fin = p.ffn_w_in + (size_t)l * 1024 * 5632; const float* fout = p.ffn_w_out + (size_t)l * 2816 * 1024;
    for (int it = C.gw; it < IA + IB + IC + ID; it += C.ngw) {
        int r = it;
        if (r < IA) { const int kb = r / nA, nb = r % nA, n0 = nb * 32; int sc = n0;
            if (even) { if (n0 >= 512 && n0 < 768) continue; if (n0 >= 1792) sc = n0 - 240; else if (n0 >= 768) sc = n0 - 256; }
            tr_item(win, even ? 2320 : 3584, sc, WIN, 1024, n0, kb * 64, scr, C.lane); continue; }
        r -= IA;
        if (r < IB) { const int kb = r / 32, nb = r % 32; tr_item(wout, 1024, nb * 32, WOUT, 1024, nb * 32, kb * 64, scr, C.lane); continue; }
        r -= IB;
        if (r < IC) { const int kb = r / 176, nb = r % 176, n0 = nb * 32; const int pn = n0 >> 8, jj = n0 & 255;
            const int sc = (jj < 128) ? pn * 128 + jj : 2816 + pn * 128 + (jj - 128);
            tr_item(fin, 5632, sc, FIN, 1024, n0, kb * 64, scr, C.lane); continue; }
        r -= IC;
        { const int kb = r / 32, nb = r % 32; tr_item(fout, 1024, nb * 32, FOUT, 2816, nb * 32, kb * 64, scr, C.lane); }
    }
    if (do_bias) {
        float* shl = (float*)(C.lds + 69632);
        const float* modl = (const float*)(p.ws + WS_MOD) + (size_t)l * 8 * 6144;
        __syncthreads();
        for (int i2 = C.tid; i2 < 2 * 8192; i2 += NTHR) { const int which = i2 >> 13, k = (i2 >> 3) & 1023, b = i2 & 7; shl[i2] = modl[(size_t)b * 6144 + (which ? 3072 : 0) + k]; }
        __syncthreads();
        float* bias_in = (float*)(p.ws + WS_BIAS) + (size_t)l * BIAS_L; float* bias_ff = bias_in + 8 * 3584;
        const int Nin = even ? 2560 : 3584, Nsrc = even ? 2320 : 3584;
        const float* gwp = p.gla_gate_w + (size_t)j * 16 * 256;
        for (int u = blockIdx.x * NTHR + C.tid; u < (Nin + 5632) * 16; u += gridDim.x * NTHR) {
            const bool ff = u >= Nin * 16; const int uu = ff ? u - Nin * 16 : u, N = ff ? 5632 : Nin, n = uu % N, kp = uu / N;
            float a[8];
#pragma unroll
            for (int b = 0; b < 8; ++b) a[b] = 0.f;
            const float* shp = shl + (ff ? 8192 : 0) + kp * 64 * 8;
            if (!ff && even && n >= 512 && n < 768) {
                float g[16];
#pragma unroll
                for (int r = 0; r < 16; ++r) g[r] = gwp[r * 256 + (n - 512)];
                for (int k = 0; k < 64; ++k) {
                    const float* wr = win + (size_t)(kp * 64 + k) * 2320 + 1536;
                    float wv = 0.f;
#pragma unroll
                    for (int r = 0; r < 16; ++r) wv += wr[r] * g[r];
                    const f32x4 s0 = *(const f32x4*)(shp + k * 8), s1 = *(const f32x4*)(shp + k * 8 + 4);
                    a[0] += s0[0] * wv; a[1] += s0[1] * wv; a[2] += s0[2] * wv; a[3] += s0[3] * wv; a[4] += s1[0] * wv; a[5] += s1[1] * wv; a[6] += s1[2] * wv; a[7] += s1[3] * wv;
                }
            } else {
                int sc; const float* W; int Ns;
                if (ff) { const int pn = n >> 8, jj = n & 255; sc = (jj < 128) ? pn * 128 + jj : 2816 + pn * 128 + (jj - 128); W = fin; Ns = 5632; }
                else { sc = n; if (even) { if (n >= 1792) sc = n - 240; else if (n >= 768) sc = n - 256; } W = win; Ns = Nsrc; }
                const float* wp = W + (size_t)(kp * 64) * Ns + sc;
#pragma unroll 8
                for (int k = 0; k < 64; ++k) {
                    const float wv = wp[(size_t)k * Ns];
                    const f32x4 s0 = *(const f32x4*)(shp + k * 8), s1 = *(const f32x4*)(shp + k * 8 + 4);
                    a[0] += s0[0] * wv; a[1] += s0[1] * wv; a[2] += s0[2] * wv; a[3] += s0[3] * wv; a[4] += s1[0] * wv; a[5] += s1[1] * wv; a[6] += s1[2] * wv; a[7] += s1[3] * wv;
                }
            }
            float* bo = (ff ? bias_ff : bias_in) + n;
#pragma unroll
            for (int b = 0; b < 8; ++b) atomicAdd(bo + (size_t)b * N, a[b]);
        }
    }
    if (even) {
        const float* gw = p.gla_gate_w + (size_t)j * 16 * 256;
        for (int u = blockIdx.x * NTHR + C.tid; u < 256 * 128; u += gridDim.x * NTHR) {
            const int k8 = u & 127, n = u >> 7;
            float g[16];
#pragma unroll
            for (int r = 0; r < 16; ++r) g[r] = gw[r * 256 + n];
            float o[8];
#pragma unroll
            for (int e = 0; e < 8; ++e) {
                const float* wr = win + (size_t)(k8 * 8 + e) * 2320 + 1536;
                const f32x4 a0 = *(const f32x4*)wr, a1 = *(const f32x4*)(wr + 4), a2 = *(const f32x4*)(wr + 8), a3 = *(const f32x4*)(wr + 12);
                o[e] = a0[0] * g[0] + a0[1] * g[1] + a0[2] * g[2] + a0[3] * g[3] + a1[0] * g[4] + a1[1] * g[5] + a1[2] * g[6] + a1[3] * g[7]
                     + a2[0] * g[8] + a2[1] * g[9] + a2[2] * g[10] + a2[3] * g[11] + a3[0] * g[12] + a3[1] * g[13] + a3[2] * g[14] + a3[3] * g[15];
            }
            u32x4 w; w.x = pk2(o[0], o[1]); w.y = pk2(o[2], o[3]); w.z = pk2(o[4], o[5]); w.w = pk2(o[6], o[7]);
            *(u32x4*)(WIN + (size_t)(512 + n) * 1024 + k8 * 8) = w;
        }
    }
}

__device__ __forceinline__ void phase_bias_wt(const Ctx& C, int l) {
    const Params& p = C.p; const bool even = !(l & 1);
    const float* modl = (const float*)(p.ws + WS_MOD) + (size_t)l * 8 * 6144;
    float* bias_in = (float*)(p.ws + WS_BIAS) + (size_t)l * BIAS_L; float* bias_ff = bias_in + 8 * 3584;
#pragma unroll 1
    for (int which = 0; which < 2; ++which) {
        const bf16_t* WT = (const bf16_t*)(p.ws + (which ? WS_FIN : WS_WIN)); const int N = which ? 5632 : (even ? 2560 : 3584);
        float* bo = which ? bias_ff : bias_in;
        f32x4 sh[8][4];
#pragma unroll
        for (int b = 0; b < 8; ++b)
#pragma unroll
            for (int q = 0; q < 4; ++q) sh[b][q] = *(const f32x4*)(modl + (size_t)b * 6144 + (which ? 3072 : 0) + 16 * C.lane + 4 * q);
        for (int n = C.gw; n < N; n += C.ngw) {
            const u32x4 w0 = *(const u32x4*)(WT + (size_t)n * 1024 + 16 * C.lane), w1 = *(const u32x4*)(WT + (size_t)n * 1024 + 16 * C.lane + 8);
            const f32x4 wa = (f32x4){bflo(w0.x), bfhi(w0.x), bflo(w0.y), bfhi(w0.y)}, wb = (f32x4){bflo(w0.z), bfhi(w0.z), bflo(w0.w), bfhi(w0.w)};
            const f32x4 wc = (f32x4){bflo(w1.x), bfhi(w1.x), bflo(w1.y), bfhi(w1.y)}, wd = (f32x4){bflo(w1.z), bfhi(w1.z), bflo(w1.w), bfhi(w1.w)};
            float mine = 0.f;
#pragma unroll
            for (int b = 0; b < 8; ++b) {
                const f32x4 t = sh[b][0] * wa + sh[b][1] * wb + sh[b][2] * wc + sh[b][3] * wd;
                const float s = wave_sum((t[0] + t[1]) + (t[2] + t[3]));
                if (C.lane == b) mine = s;
            }
            if (C.lane < 8) bo[(size_t)C.lane * N + n] = mine;
        }
    }
}

__device__ __forceinline__ void phase_prep(const Ctx& C, const float* xin, const float* w, const float* modl, int scoff, bf16_t* out, float* rowss) {
    for (int row = C.gw; row < T_; row += C.ngw) {
        const f32x4* xr = (const f32x4*)(xin + (size_t)row * 1024) + C.lane;
        f32x4 v[4]; float ss = 0.f;
#pragma unroll
        for (int j = 0; j < 4; ++j) { v[j] = xr[64 * j]; ss += (v[j].x * v[j].x + v[j].y * v[j].y) + (v[j].z * v[j].z + v[j].w * v[j].w); }
        ss = wave_sum(ss);
        if (C.lane == 0) rowss[row] = ss;
        const float* mb = modl + (size_t)(row >> 12) * 6144;
        u32x2* o8 = (u32x2*)(out + (size_t)row * 1024) + C.lane;
#pragma unroll
        for (int j = 0; j < 4; ++j) {
            const int col = 4 * C.lane + 256 * j;
            const f32x4 w4 = *(const f32x4*)(w + col), sc = *(const f32x4*)(mb + scoff + col);
            const f32x4 y = v[j] * w4 * (sc + 1.f);
            u32x2 q; q.x = pk2(y.x, y.y); q.y = pk2(y.z, y.w); o8[64 * j] = q;
        }
    }
}
__device__ __forceinline__ void phase_final_norm(const Ctx& C, const void* xin  , float* out, const float* w) {
    for (int row = C.gw; row < T_; row += C.ngw) {
        const u32x2* xr = (const u32x2*)((const char*)xin + (size_t)row * 2048) + C.lane;
        f32x4* orow = (f32x4*)(out + (size_t)row * 1024) + C.lane;
        f32x4 v[4]; float ss = 0.f;
#pragma unroll
        for (int j = 0; j < 4; ++j) { const u32x2 h = xr[64 * j]; v[j] = pg8::unpkh4(h.x, h.y); ss += (v[j].x * v[j].x + v[j].y * v[j].y) + (v[j].z * v[j].z + v[j].w * v[j].w); }
        const float rs = rsqrtf(wave_sum(ss) * (1.f / 1024.f) + 1e-6f);
#pragma unroll
        for (int j = 0; j < 4; ++j) { const f32x4 w4 = *(const f32x4*)(w + 4 * C.lane + 256 * j); orow[64 * j] = (v[j] * rs) * w4; }
    }
}

__device__ __forceinline__ void phase_diff_combine(const Ctx& C, int l) {
    const Params& p = C.p; const int j = l >> 1;
    const float lam_init = 0.8f - 0.6f * expf(-0.3f * (float)l);
    const float* lv = p.diff_lambda + j * 256;
    const float s1 = wave_sum(lv[C.lane] * lv[64 + C.lane]), s2 = wave_sum(lv[128 + C.lane] * lv[192 + C.lane]);
    const float lam = expf(s1) - expf(s2) + lam_init;
    const bf16_t* X2 = (const bf16_t*)(p.ws + WS_X2); bf16_t* A = (bf16_t*)(p.ws + WS_A);
    const int head = C.lane >> 4, d0 = (C.lane & 15) * 8;
    const float* nw = p.diff_norm_w + j * 128 + d0;
    const f32x4 n0 = *(const f32x4*)nw, n1 = *(const f32x4*)(nw + 4);
    const float og = 1.f - lam_init;
    for (int row = C.gw; row < T_; row += C.ngw) {
        const bf16_t* src = X2 + (size_t)row * 1024 + head * 256 + d0;
        const u32x4 a = *(const u32x4*)src, b = *(const u32x4*)(src + 128);
        float od[8];
        od[0] = bflo(a.x) - lam * bflo(b.x); od[1] = bfhi(a.x) - lam * bfhi(b.x); od[2] = bflo(a.y) - lam * bflo(b.y); od[3] = bfhi(a.y) - lam * bfhi(b.y);
        od[4] = bflo(a.z) - lam * bflo(b.z); od[5] = bfhi(a.z) - lam * bfhi(b.z); od[6] = bflo(a.w) - lam * bflo(b.w); od[7] = bfhi(a.w) - lam * bfhi(b.w);
        float ss = 0.f;
#pragma unroll
        for (int e = 0; e < 8; ++e) ss += od[e] * od[e];
        ss += __shfl_xor(ss, 1); ss += __shfl_xor(ss, 2); ss += __shfl_xor(ss, 4); ss += __shfl_xor(ss, 8);
        const float rs = rsqrtf(ss * (1.f / 128.f) + 1e-6f) * og;
        u32x4 w; w.x = pk2(od[0] * rs * n0[0], od[1] * rs * n0[1]); w.y = pk2(od[2] * rs * n0[2], od[3] * rs * n0[3]);
        w.z = pk2(od[4] * rs * n1[0], od[5] * rs * n1[1]); w.w = pk2(od[6] * rs * n1[2], od[7] * rs * n1[3]);
        *(u32x4*)(A + (size_t)row * 1024 + head * 128 + d0) = w;
    }
}

__device__ __forceinline__ void phase_ffn_fixup(const Ctx& C, int l) {
    const Params& p = C.p;
    const unsigned short* HP = (const unsigned short*)(p.ws + WS_HP); const unsigned short* HU = (const unsigned short*)(p.ws + WS_HU); const unsigned short* HA = (const unsigned short*)(p.ws + WS_HA);
    bf16_t* G = (bf16_t*)(p.ws + WS_R1);
    const float* cw = p.ffn_conv_w + (size_t)l * 3 * DFF_;
    for (int u = blockIdx.x * NTHR + C.tid; u < 512 * 2 * 704; u += gridDim.x * NTHR) {
        const int c4 = u % 704, sj = u / 704, jj = sj & 1, seg = sj >> 1, ch = c4 * 4;
        const size_t ho = (size_t)sj * DFF_ + ch;
        const u32x2 hv = *(const u32x2*)(HP + ho), hu = *(const u32x2*)(HU + ho);
        f32x4 val = pg8::unpkh4(hv.x, hv.y); const f32x4 uu = pg8::unpkh4(hu.x, hu.y);
        if ((seg & 63) != 0) {
            const u32x2 h1 = *(const u32x2*)(HA + (size_t)((seg - 1) * 2 + 1) * DFF_ + ch), h2 = *(const u32x2*)(HA + (size_t)((seg - 1) * 2) * DFF_ + ch);
            const f32x4 am1 = pg8::unpkh4(h1.x, h1.y), am2 = pg8::unpkh4(h2.x, h2.y);
            const f32x4 w0 = *(const f32x4*)(cw + ch), w1 = *(const f32x4*)(cw + DFF_ + ch);
            if (jj == 0) val = val + w1 * am1 + w0 * am2; else val = val + w0 * am1;
        }
        u32x2 q; q.x = pk2(siluf_(val.x) * uu.x, siluf_(val.y) * uu.y); q.y = pk2(siluf_(val.z) * uu.z, siluf_(val.w) * uu.w);
        *(u32x2*)(G + (size_t)(seg * 64 + jj) * DFF_ + ch) = q;
    }
}

__device__ __forceinline__ void phase_swa(const Ctx& C, int l) {
    const Params& p = C.p;
    const bf16_t* proj = (const bf16_t*)(p.ws + WS_R1); bf16_t* A = (bf16_t*)(p.ws + WS_A);
    bf16_t* Ks = (bf16_t*)C.lds;
    bf16_t* Vt = (bf16_t*)(C.lds + 27648);
    const int tid = C.tid, lane = C.lane, wid = C.wave, r32 = lane & 31, hi = lane >> 5;
    const float* sinks = p.swa_sinks + (l >> 1) * 8;
    u32x4 kreg[3], vreg[3];
#define SWA_FETCH(uu) do { const int b_ = (uu) >> 7, kvh_ = ((uu) >> 6) & 1, q0_ = ((uu) & 63) * 64; const size_t rb_ = (size_t)b_ * SEQ_; \
        _Pragma("unroll") for (int i_ = 0; i_ < 3; ++i_) { const int c_ = tid + i_ * NTHR; \
            { const int kk_ = c_ >> 3, ch_ = c_ & 7, pl_ = q0_ - 128 + kk_; kreg[i_] = (u32x4){0u, 0u, 0u, 0u}; if (pl_ >= 0) kreg[i_] = *(const u32x4*)(proj + (rb_ + pl_) * 2560 + 2304 + kvh_ * 64 + ch_ * 8); } \
            { const int kk_ = c_ % 192, ch_ = c_ / 192, pl_ = q0_ - 128 + kk_; vreg[i_] = (u32x4){0u, 0u, 0u, 0u}; if (pl_ >= 0) vreg[i_] = *(const u32x4*)(proj + (rb_ + pl_) * 2560 + 2432 + kvh_ * 64 + ch_ * 8); } } } while (0)
    if ((int)blockIdx.x < 1024) SWA_FETCH((int)blockIdx.x);
    for (int u = blockIdx.x; u < 1024; u += gridDim.x) {
        const int b = u >> 7, kvh = (u >> 6) & 1, qb = u & 63, q0 = qb * 64; const size_t rowbase = (size_t)b * SEQ_;
#pragma unroll
        for (int i = 0; i < 3; ++i) {
            const int c = tid + i * NTHR;
            { const int kk = c >> 3, ch = c & 7; *(u32x4*)(Ks + kk * 72 + ch * 8) = kreg[i]; }
            { const int kk = c % 192, ch = c / 192; const u32x4 vv = vreg[i];
              bf16_t* vd = Vt + (ch * 8) * 200 + kk;
              vd[0] = (bf16_t)(vv.x & 0xffffu); vd[200] = (bf16_t)(vv.x >> 16); vd[400] = (bf16_t)(vv.y & 0xffffu); vd[600] = (bf16_t)(vv.y >> 16);
              vd[800] = (bf16_t)(vv.z & 0xffffu); vd[1000] = (bf16_t)(vv.z >> 16); vd[1200] = (bf16_t)(vv.w & 0xffffu); vd[1400] = (bf16_t)(vv.w >> 16); }
        }
        { const int nx = u + (int)gridDim.x; if (nx < 1024) SWA_FETCH(nx); }
        __syncthreads();
        const int g = wid >> 1, qh = kvh * 4 + g, qhalf = wid & 1, pq = q0 + 32 * qhalf + r32;
        const bf16_t* qsrc = proj + (rowbase + pq) * 2560 + 1792 + qh * 64;
        bf16x8 qr[4];
#pragma unroll
        for (int d0 = 0; d0 < 4; ++d0) qr[d0] = *(const bf16x8*)(qsrc + d0 * 16 + hi * 8);
        f32x16 s[5];
#pragma unroll
        for (int t = 0; t < 5; ++t) {
            f32x16 a = {};
#pragma unroll
            for (int d0 = 0; d0 < 4; ++d0) {
                const bf16x8 kf = *(const bf16x8*)(Ks + (32 * (qhalf + t) + r32) * 72 + d0 * 16 + hi * 8);
                a = __builtin_amdgcn_mfma_f32_32x32x16_bf16(kf, qr[d0], a, 0, 0, 0);
            }
            s[t] = a;
        }
        const float sink2 = sinks[qh] * LOG2E_;
        float mx = sink2;
#pragma unroll
        for (int t = 0; t < 5; ++t)
#pragma unroll
            for (int r = 0; r < 16; ++r) {
                const int pk = q0 - 128 + 32 * (qhalf + t) + crow_(r, hi);
                const bool valid = (pk >= 0) && (pk <= pq) && (pq - pk < 128);
                const float v = valid ? s[t][r] : -INFINITY; s[t][r] = v; mx = fmaxf(mx, v);
            }
        mx = fmaxf(mx, __shfl_xor(mx, 32));
        float sum = 0.f;
#pragma unroll
        for (int t = 0; t < 5; ++t)
#pragma unroll
            for (int r = 0; r < 16; ++r) { const float e = __builtin_amdgcn_exp2f(s[t][r] - mx); s[t][r] = e; sum += e; }
        sum += __shfl_xor(sum, 32);
        sum += __builtin_amdgcn_exp2f(sink2 - mx);
        const float inv = 1.f / sum;
        f32x16 o[2]; o[0] = f32x16{}; o[1] = f32x16{};
#pragma unroll
        for (int t = 0; t < 5; ++t)
#pragma unroll
            for (int ss = 0; ss < 2; ++ss) {
                u32x4 pw; pw.x = pk2(s[t][8 * ss + 0], s[t][8 * ss + 1]); pw.y = pk2(s[t][8 * ss + 2], s[t][8 * ss + 3]); pw.z = pk2(s[t][8 * ss + 4], s[t][8 * ss + 5]); pw.w = pk2(s[t][8 * ss + 6], s[t][8 * ss + 7]);
                const bf16x8 pf = __builtin_bit_cast(bf16x8, pw);
#pragma unroll
                for (int dt = 0; dt < 2; ++dt) {
                    const bf16_t* vp = Vt + (32 * dt + r32) * 200 + 32 * (qhalf + t) + 16 * ss + 4 * hi;
                    const u32x2 lo = *(const u32x2*)vp, h2 = *(const u32x2*)(vp + 8);
                    u32x4 vw; vw.x = lo.x; vw.y = lo.y; vw.z = h2.x; vw.w = h2.y;
                    o[dt] = __builtin_amdgcn_mfma_f32_32x32x16_bf16(__builtin_bit_cast(bf16x8, vw), pf, o[dt], 0, 0, 0);
                }
            }
        bf16_t* orow = A + (rowbase + pq) * 1024 + 512 + qh * 64;
#pragma unroll
        for (int dt = 0; dt < 2; ++dt)
#pragma unroll
            for (int g4 = 0; g4 < 4; ++g4) {
                u32x2 q; q.x = pk2(o[dt][4 * g4] * inv, o[dt][4 * g4 + 1] * inv); q.y = pk2(o[dt][4 * g4 + 2] * inv, o[dt][4 * g4 + 3] * inv);
                *(u32x2*)(orow + 32 * dt + 8 * g4 + 4 * hi) = q;
            }
        __syncthreads();
    }
}

template <int MODE> struct LaCfg {
    static constexpr int DK = MODE ? 128 : 64, LQ = DK + 8, LG = DK + 4, PITCH = MODE ? 3584 : 2560, NG = DK / 8;
    static constexpr int QCOL = MODE ? 1536 : 0, KCOL = MODE ? 0 : 256, ZCOL = MODE ? 2048 : 512, VCOL = MODE ? 2560 : 768, GCOL = MODE ? 3072 : 1280, OCOL = MODE ? 512 : 0;
    static constexpr int O_QB = 0, O_KB = O_QB + 64 * LQ * 2, O_GF = O_KB + 64 * LQ * 2, O_VT = O_GF + 64 * LG * 4, O_SC = O_VT + 128 * 72 * 2, O_QE = O_SC + 64 * 72 * 2,
                         O_KT = O_QE + 64 * LQ * 2  , O_SEG = O_KT + DK * 72 * 2, O_RED = O_SEG + 8 * 128 * 4, O_PAR = O_RED + 8 * 64 * 4, O_END = O_PAR + 128 * 4;
    static_assert(O_END <= LDS_BYTES, "LA LDS map");
};
__device__ __forceinline__ void unpack8(const u32x4 w, float (&f)[8]) { f[0] = bflo(w.x); f[1] = bfhi(w.x); f[2] = bflo(w.y); f[3] = bfhi(w.y); f[4] = bflo(w.z); f[5] = bfhi(w.z); f[6] = bflo(w.w); f[7] = bfhi(w.w); }
__device__ __forceinline__ u32x4 pack8(const float (&f)[8]) { u32x4 w; w.x = pk2(f[0], f[1]); w.y = pk2(f[2], f[3]); w.z = pk2(f[4], f[5]); w.w = pk2(f[6], f[7]); return w; }
__device__ __forceinline__ void ld8f(const float* p, float (&f)[8]) { const f32x4 a = *(const f32x4*)p, b = *(const f32x4*)(p + 4); f[0] = a[0]; f[1] = a[1]; f[2] = a[2]; f[3] = a[3]; f[4] = b[0]; f[5] = b[1]; f[6] = b[2]; f[7] = b[3]; }

template <int MODE> struct LaRaw { static constexpr int NI = 64 * LaCfg<MODE>::NG / NTHR; u32x4 z[NI], k[NI], q[NI], v[2]; };
template <int MODE, bool NEEDQ> __device__ __forceinline__ void la_fetch(const Ctx& C, int b, int h, int c, LaRaw<MODE>& R) {
    typedef LaCfg<MODE> Cf; const bf16_t* proj = (const bf16_t*)(C.p.ws + WS_R1);
    const size_t row0 = (size_t)b * SEQ_ + (size_t)c * 64;
#pragma unroll
    for (int it = 0; it < LaRaw<MODE>::NI; ++it) {
        const int u = C.tid + it * NTHR, r = u / Cf::NG, kk = (u % Cf::NG) * 8;
        const bf16_t* rp = proj + (row0 + r) * Cf::PITCH + h * Cf::DK + kk;
        R.z[it] = *(const u32x4*)(rp + Cf::ZCOL);
        if (MODE == 0) R.k[it] = *(const u32x4*)(rp + Cf::KCOL);
        if (NEEDQ) R.q[it] = *(const u32x4*)(rp + Cf::QCOL);
    }
#pragma unroll
    for (int it = 0; it < 2; ++it) {
        const int u = C.tid + it * NTHR, r = u & 63, g8 = u >> 6;
        R.v[it] = *(const u32x4*)(proj + (row0 + r) * Cf::PITCH + Cf::VCOL + h * 128 + g8 * 8);
    }
}
template <int MODE, bool NEEDQ> __device__ __forceinline__ void la_store(const Ctx& C, const LaRaw<MODE>& R, const float* par, bf16_t* Qb, bf16_t* Kb, float* Gf, bf16_t* Vt) {
    typedef LaCfg<MODE> Cf;
#pragma unroll
    for (int it = 0; it < LaRaw<MODE>::NI; ++it) {
        const int u = C.tid + it * NTHR, r = u / Cf::NG, kk = (u % Cf::NG) * 8;
        float z[8], kv[8], lg[8], pc[8];
        unpack8(R.z[it], z); ld8f(par + kk, pc);
        if (MODE == 0) {
            unpack8(R.k[it], kv);
#pragma unroll
            for (int e = 0; e < 8; ++e) { const float x = z[e] + pc[e]; lg[e] = (fminf(x, 0.f) * LOG2E_ - __log2f(1.f + __expf(-fabsf(x)))) * (1.f / 16.f); }
        } else {
#pragma unroll
            for (int e = 0; e < 8; ++e) {
                const float zz = fminf(fmaxf(z[e], -60.f), 60.f), ez = __expf(-zz), sg = __builtin_amdgcn_rcpf(1.f + ez), lb = pc[e];
                lg[e] = __log2f(lb + (1.f - lb) * sg); kv[e] = (1.f - lb) * (ez * sg);
            }
        }
        *(u32x4*)(Kb + r * Cf::LQ + kk) = pack8(kv);
        float* gd = Gf + r * Cf::LG + kk;
        *(f32x4*)gd = (f32x4){lg[0], lg[1], lg[2], lg[3]}; *(f32x4*)(gd + 4) = (f32x4){lg[4], lg[5], lg[6], lg[7]};
        if (NEEDQ) {
            float q[8]; unpack8(R.q[it], q);
#pragma unroll
            for (int e = 0; e < 8; ++e) q[e] = MODE ? siluf_(q[e]) * 0.08838834764831845f : q[e] * 0.125f;
            *(u32x4*)(Qb + r * Cf::LQ + kk) = pack8(q);
        }
    }
#pragma unroll
    for (int it = 0; it < 2; ++it) {
        const int u = C.tid + it * NTHR, r = u & 63, g8 = u >> 6;
        const u32x4 w = R.v[it];
        bf16_t* vd = Vt + (g8 * 8) * 72 + r;
        vd[0] = (bf16_t)(w.x & 0xffffu); vd[72] = (bf16_t)(w.x >> 16); vd[144] = (bf16_t)(w.y & 0xffffu); vd[216] = (bf16_t)(w.y >> 16);
        vd[288] = (bf16_t)(w.z & 0xffffu); vd[360] = (bf16_t)(w.z >> 16); vd[432] = (bf16_t)(w.w & 0xffffu); vd[504] = (bf16_t)(w.w >> 16);
    }
}
template <int MODE> __device__ __forceinline__ void la_params(const Ctx& C, int l, int h, float* par) {
    typedef LaCfg<MODE> Cf; const int j = l >> 1;
    if (C.tid < Cf::DK) {
        if (MODE == 0) par[C.tid] = C.p.gla_gate_b[j * 256 + h * 64 + C.tid];
        else { const float* lg0 = C.p.hgrn_lb_logits + h * 128 + C.tid; par[C.tid] = (j == 0) ? 0.f : sigmoidf_(lg0[512] - lg0[0]); }
    }
}
template <int MODE> __device__ __forceinline__ void la_cumsum(const Ctx& C, float* Gf, float* segs) {
    typedef LaCfg<MODE> Cf; constexpr int DK = Cf::DK, NSEG = NTHR / DK, RPS = 64 / NSEG;
    const int k = C.tid % DK, seg = C.tid / DK;
    float v[RPS];
#pragma unroll
    for (int i = 0; i < RPS; ++i) v[i] = Gf[(seg * RPS + i) * Cf::LG + k];
#pragma unroll
    for (int i = 1; i < RPS; ++i) v[i] += v[i - 1];
    segs[seg * DK + k] = v[RPS - 1];
    __syncthreads();
    float off = 0.f;
#pragma unroll
    for (int s = 0; s < NSEG; ++s) { const float t = segs[s * DK + k]; off += (s < seg) ? t : 0.f; }
#pragma unroll
    for (int i = 0; i < RPS; ++i) Gf[(seg * RPS + i) * Cf::LG + k] = v[i] + off;
}

template <int MODE> __device__ __forceinline__ void phase_la_p1(const Ctx& C, int l) {
    typedef LaCfg<MODE> Cf; const Params& p = C.p; constexpr int DK = Cf::DK, LQ = Cf::LQ, LG = Cf::LG, NG = Cf::NG;
    bf16_t* Kb = (bf16_t*)(C.lds + Cf::O_KB); float* Gf = (float*)(C.lds + Cf::O_GF); bf16_t* Vt = (bf16_t*)(C.lds + Cf::O_VT);
    bf16_t* KhT = (bf16_t*)(C.lds + Cf::O_KT); float* segs = (float*)(C.lds + Cf::O_SEG);
    bf16_t* ST = (bf16_t*)(p.ws + WS_ST); float* TOT = (float*)(p.ws + WS_TOT);
    const int r16 = C.lane & 15, g = C.lane >> 4, w = C.wave;
    float* par = (float*)(C.lds + Cf::O_PAR);
    LaRaw<MODE> R; int hcur = -1;
    if ((int)blockIdx.x < 2048) la_fetch<MODE, false>(C, (int)blockIdx.x >> 8, ((int)blockIdx.x >> 6) & 3, (int)blockIdx.x & 63, R);
    for (int it = blockIdx.x; it < 2048; it += gridDim.x) {
        const int bh = it >> 6, c = it & 63, b = bh >> 2, h = bh & 3;
        if (h != hcur) { la_params<MODE>(C, l, h, par); hcur = h; __syncthreads(); }
        la_store<MODE, false>(C, R, par, nullptr, Kb, Gf, Vt);
        { const int nx = it + (int)gridDim.x; if (nx < 2048) la_fetch<MODE, false>(C, nx >> 8, (nx >> 6) & 3, nx & 63, R); }
        __syncthreads();
        la_cumsum<MODE>(C, Gf, segs);
        __syncthreads();
        for (int u = C.tid; u < 64 * NG; u += NTHR) {
            const int r = u & 63, kk = (u >> 6) * 8;
            float kv[8], gj[8], gt[8];
            unpack8(*(const u32x4*)(Kb + r * LQ + kk), kv); ld8f(Gf + r * LG + kk, gj); ld8f(Gf + 63 * LG + kk, gt);
            bf16_t* kd = KhT + kk * 72 + r;
#pragma unroll
            for (int e = 0; e < 8; e += 2) { const unsigned pw = pk2(kv[e] * __builtin_amdgcn_exp2f(gt[e] - gj[e]), kv[e + 1] * __builtin_amdgcn_exp2f(gt[e + 1] - gj[e + 1]));
                kd[e * 72] = (bf16_t)(pw & 0xffffu); kd[(e + 1) * 72] = (bf16_t)(pw >> 16); }
        }
        if (C.tid < DK) TOT[(size_t)it * 128 + C.tid] = Gf[63 * LG + C.tid];
        __syncthreads();
        {
            const bf16x8 b0 = *(const bf16x8*)(Vt + (16 * w + r16) * 72 + 8 * g), b1 = *(const bf16x8*)(Vt + (16 * w + r16) * 72 + 32 + 8 * g);
            bf16_t* so = ST + (size_t)it * DK * 128 + (size_t)(16 * w + r16) * DK + 4 * g;
#pragma unroll
            for (int mt = 0; mt < DK / 16; ++mt) {
                const bf16x8 a0 = *(const bf16x8*)(KhT + (16 * mt + r16) * 72 + 8 * g), a1 = *(const bf16x8*)(KhT + (16 * mt + r16) * 72 + 32 + 8 * g);
                f32x4 acc = (f32x4){0.f, 0.f, 0.f, 0.f};
                acc = __builtin_amdgcn_mfma_f32_16x16x32_bf16(a0, b0, acc, 0, 0, 0);
                acc = __builtin_amdgcn_mfma_f32_16x16x32_bf16(a1, b1, acc, 0, 0, 0);
                u32x2 q; q.x = pk2(acc[0], acc[1]); q.y = pk2(acc[2], acc[3]);
                *(u32x2*)(so + 16 * mt) = q;
            }
        }
        __syncthreads();
    }
}

template <int MODE> __device__ __forceinline__ void phase_la_p2(const Ctx& C) {
    typedef LaCfg<MODE> Cf; const Params& p = C.p; constexpr int DK = Cf::DK, NQ = DK / 4;
    bf16_t* ST = (bf16_t*)(p.ws + WS_ST); const float* TOT = (const float*)(p.ws + WS_TOT);
    for (int u = blockIdx.x * NTHR + C.tid; u < 32 * 128 * NQ; u += gridDim.x * NTHR) {
        const int k4 = u % NQ, v = (u / NQ) & 127, bh = u / (NQ * 128);
        float S0 = 0.f, S1 = 0.f, S2 = 0.f, S3 = 0.f;
        bf16_t* base = ST + (size_t)bh * 64 * DK * 128 + (size_t)v * DK + k4 * 4;
        const float* tb = TOT + (size_t)bh * 64 * 128 + k4 * 4;
#pragma unroll 8
        for (int c = 0; c < 64; ++c) {
            u32x2* ptr = (u32x2*)(base + (size_t)c * DK * 128);
            const u32x2 w = *ptr; const f32x4 dc = *(const f32x4*)(tb + c * 128);
            u32x2 o; o.x = pk2(S0, S1); o.y = pk2(S2, S3);
            *ptr = o;
            S0 = S0 * __builtin_amdgcn_exp2f(dc[0]) + bflo(w.x); S1 = S1 * __builtin_amdgcn_exp2f(dc[1]) + bfhi(w.x);
            S2 = S2 * __builtin_amdgcn_exp2f(dc[2]) + bflo(w.y); S3 = S3 * __builtin_amdgcn_exp2f(dc[3]) + bfhi(w.y);
        }
    }
}

template <int MODE> __device__ __forceinline__ void phase_la_p3(const Ctx& C, int l) {
    typedef LaCfg<MODE> Cf; const Params& p = C.p; constexpr int DK = Cf::DK, LQ = Cf::LQ, LG = Cf::LG, NG = Cf::NG, NKS = DK / 32;
    bf16_t* Qb = (bf16_t*)(C.lds + Cf::O_QB); bf16_t* Kb = (bf16_t*)(C.lds + Cf::O_KB); float* Gf = (float*)(C.lds + Cf::O_GF); bf16_t* Vt = (bf16_t*)(C.lds + Cf::O_VT);
    bf16_t* Sc = (bf16_t*)(C.lds + Cf::O_SC); bf16_t* Qe = (bf16_t*)(C.lds + Cf::O_QE); float* segs = (float*)(C.lds + Cf::O_SEG); float* red = (float*)(C.lds + Cf::O_RED);
    const bf16_t* ST = (const bf16_t*)(p.ws + WS_ST); const bf16_t* proj = (const bf16_t*)(p.ws + WS_R1); bf16_t* A = (bf16_t*)(p.ws + WS_A);
    const float* nw = (MODE ? p.hgrn_norm_w : p.gla_norm_w) + (l >> 1) * 128;
    const int r16 = C.lane & 15, g = C.lane >> 4, w = C.wave;
    const f32x4 nw4 = *(const f32x4*)(nw + 16 * w + 4 * g);
    float* par = (float*)(C.lds + Cf::O_PAR);
    LaRaw<MODE> R; int hcur = -1;
    if ((int)blockIdx.x < 2048) la_fetch<MODE, true>(C, (int)blockIdx.x >> 8, ((int)blockIdx.x >> 6) & 3, (int)blockIdx.x & 63, R);
    for (int it = blockIdx.x; it < 2048; it += gridDim.x) {
        const int bh = it >> 6, c = it & 63, b = bh >> 2, h = bh & 3;
        bf16x8 sfr[NKS];
        { const bf16_t* sp = ST + (size_t)it * DK * 128 + (size_t)(16 * w + r16) * DK + 8 * g;
#pragma unroll
          for (int ks = 0; ks < NKS; ++ks) sfr[ks] = *(const bf16x8*)(sp + 32 * ks); }
        if (h != hcur) { la_params<MODE>(C, l, h, par); hcur = h; __syncthreads(); }
        la_store<MODE, true>(C, R, par, Qb, Kb, Gf, Vt);
        { const int nx = it + (int)gridDim.x; if (nx < 2048) la_fetch<MODE, true>(C, nx >> 8, (nx >> 6) & 3, nx & 63, R); }
        for (int u = C.tid; u < 64 * 72 / 8; u += NTHR) *(u32x4*)(Sc + u * 8) = (u32x4){0u, 0u, 0u, 0u};
        u32x2 gwv[4];
#pragma unroll
        for (int nt = 0; nt < 4; ++nt) gwv[nt] = *(const u32x2*)(proj + ((size_t)b * SEQ_ + (size_t)c * 64 + 16 * nt + r16) * Cf::PITCH + Cf::GCOL + h * 128 + 16 * w + 4 * g);
        __syncthreads();
        la_cumsum<MODE>(C, Gf, segs);
        __syncthreads();
        for (int t = w; t < 10; t += 8) {
            const int I = (t >= 6) ? 3 : (t >= 3) ? 2 : (t >= 1) ? 1 : 0, J = t - I * (I + 1) / 2;
            f32x4 acc = (f32x4){0.f, 0.f, 0.f, 0.f};
#pragma unroll
            for (int ks = 0; ks < NKS; ++ks) {
                const int kc = 32 * ks + 8 * g;
                float gref[8], gj[8], gi[8], kv[8], qv[8];
                ld8f(Gf + (16 * J + 15) * LG + kc, gref); ld8f(Gf + (16 * J + r16) * LG + kc, gj); ld8f(Gf + (16 * I + r16) * LG + kc, gi);
                unpack8(*(const u32x4*)(Kb + (16 * J + r16) * LQ + kc), kv); unpack8(*(const u32x4*)(Qb + (16 * I + r16) * LQ + kc), qv);
#pragma unroll
                for (int e = 0; e < 8; ++e) { kv[e] *= __builtin_amdgcn_exp2f(gref[e] - gj[e]); qv[e] *= __builtin_amdgcn_exp2f(gi[e] - gref[e]); }
                acc = __builtin_amdgcn_mfma_f32_16x16x32_bf16(__builtin_bit_cast(bf16x8, pack8(kv)), __builtin_bit_cast(bf16x8, pack8(qv)), acc, 0, 0, 0);
            }
            if (I == J) {
#pragma unroll
                for (int e = 0; e < 4; ++e) if (4 * g + e > r16) acc[e] = 0.f;
            }
            u32x2 q; q.x = pk2(acc[0], acc[1]); q.y = pk2(acc[2], acc[3]);
            *(u32x2*)(Sc + (16 * I + r16) * 72 + 16 * J + 4 * g) = q;
        }
        for (int u = C.tid; u < 64 * NG; u += NTHR) {
            const int r = u / NG, kk = (u % NG) * 8;
            float qv[8], gi[8]; unpack8(*(const u32x4*)(Qb + r * LQ + kk), qv); ld8f(Gf + r * LG + kk, gi);
#pragma unroll
            for (int e = 0; e < 8; ++e) qv[e] *= __builtin_amdgcn_exp2f(gi[e]);
            *(u32x4*)(Qe + r * LQ + kk) = pack8(qv);
        }
        __syncthreads();
        f32x4 o[4];
        {
            const bf16x8 v0 = *(const bf16x8*)(Vt + (16 * w + r16) * 72 + 8 * g), v1 = *(const bf16x8*)(Vt + (16 * w + r16) * 72 + 32 + 8 * g);
#pragma unroll
            for (int nt = 0; nt < 4; ++nt) {
                f32x4 acc = (f32x4){0.f, 0.f, 0.f, 0.f};
                acc = __builtin_amdgcn_mfma_f32_16x16x32_bf16(v0, *(const bf16x8*)(Sc + (16 * nt + r16) * 72 + 8 * g), acc, 0, 0, 0);
                if (nt >= 2) acc = __builtin_amdgcn_mfma_f32_16x16x32_bf16(v1, *(const bf16x8*)(Sc + (16 * nt + r16) * 72 + 32 + 8 * g), acc, 0, 0, 0);
#pragma unroll
                for (int ks = 0; ks < NKS; ++ks) acc = __builtin_amdgcn_mfma_f32_16x16x32_bf16(sfr[ks], *(const bf16x8*)(Qe + (16 * nt + r16) * LQ + 32 * ks + 8 * g), acc, 0, 0, 0);
                o[nt] = acc;
                float ss = acc[0] * acc[0] + acc[1] * acc[1] + acc[2] * acc[2] + acc[3] * acc[3];
                ss += __shfl_xor(ss, 16); ss += __shfl_xor(ss, 32);
                if (g == 0) red[w * 64 + 16 * nt + r16] = ss;
            }
        }
        __syncthreads();
#pragma unroll
        for (int nt = 0; nt < 4; ++nt) {
            float tot = 0.f;
#pragma unroll
            for (int ww = 0; ww < 8; ++ww) tot += red[ww * 64 + 16 * nt + r16];
            const float rs = rsqrtf(tot * (1.f / 128.f) + 1e-6f);
            const size_t row = (size_t)b * SEQ_ + (size_t)c * 64 + 16 * nt + r16;
            const u32x2 gw = gwv[nt];
            u32x2 q; q.x = pk2(o[nt][0] * rs * nw4[0] * siluf_(bflo(gw.x)), o[nt][1] * rs * nw4[1] * siluf_(bfhi(gw.x)));
            q.y = pk2(o[nt][2] * rs * nw4[2] * siluf_(bflo(gw.y)), o[nt][3] * rs * nw4[3] * siluf_(bfhi(gw.y)));
            *(u32x2*)(A + row * 1024 + Cf::OCOL + h * 128 + 16 * w + 4 * g) = q;
        }
        __syncthreads();
    }
}


#define LAS __attribute__((address_space(3)))
#define XB_TMO      128
#define XB_XCNT(j)  (256  + 64 * (j))
#define XB_XSUB(j)  (1280 + 64 * (j))
#define XB_XGEN(j)  (2304 + 64 * (j))
#define XB_TOP      3328
#define XB_TOPGEN   3392
#define XCD_BAR_WORDS 3456
#define XB_SPIN_CAP (1u << 18)

__device__ __forceinline__ unsigned xb_ld(unsigned* p)              { return __hip_atomic_load(p, __ATOMIC_RELAXED, __HIP_MEMORY_SCOPE_AGENT); }
__device__ __forceinline__ unsigned xb_add(unsigned* p, unsigned v) { return __hip_atomic_fetch_add(p, v, __ATOMIC_RELAXED, __HIP_MEMORY_SCOPE_AGENT); }
__device__ __forceinline__ unsigned xb_xcc_id() { return (unsigned)__builtin_amdgcn_s_getreg((3 << 11) | 20) & 0xFu; }
#define XB_SPIN(cond, bar) do { unsigned _sp = 0; while (cond) { __builtin_amdgcn_s_sleep(1); \
    if ((++_sp & 255u) == 0u) { if (xb_ld(&(bar)[XB_TMO])) break; if (_sp > XB_SPIN_CAP) { atomicAdd(&(bar)[XB_TMO], 1u); break; } } } } while (0)

struct XcdBarrier {
    unsigned* bar; unsigned x;
    volatile LAS unsigned* st;
};

__device__ __forceinline__ XcdBarrier xcd_barrier_post(unsigned* bar, volatile LAS unsigned* st) {
    XcdBarrier b; b.bar = bar; b.x = xb_xcc_id(); b.st = st;
    if (threadIdx.x == 0) (void)xb_add(&bar[XB_XCNT(b.x)], 1u);
    return b;
}
__device__ __forceinline__ void xcd_barrier_complete(unsigned* bar, unsigned x, unsigned& nloc, unsigned& nx) {
    const unsigned G = gridDim.x * gridDim.y * gridDim.z;
    unsigned sum, cnt, mine, sp = 0u;
    for (;;) {
        sum = 0u; cnt = 0u; mine = 0u;
#pragma unroll
        for (unsigned j = 0; j < 16; ++j) { const unsigned c = xb_ld(&bar[XB_XCNT(j)]); sum += c; cnt += (c > 0u) ? 1u : 0u; mine = (j == x) ? c : mine; }
        if (sum == G) break;
        __builtin_amdgcn_s_sleep(1);
        if ((++sp & 255u) == 0u) { if (xb_ld(&bar[XB_TMO])) break; if (sp > XB_SPIN_CAP) { atomicAdd(&bar[XB_TMO], 1u); break; } }
    }
    nloc = mine > 0u ? mine : 1u; nx = cnt > 0u ? cnt : 1u;
}

__device__ __forceinline__ void xcd_barrier(const XcdBarrier& b) {
    asm volatile("s_waitcnt vmcnt(0)" ::: "memory");
    __syncthreads();
    if (threadIdx.x == 0) {
        unsigned* bar = b.bar;
        __builtin_amdgcn_s_waitcnt(0);
        unsigned nloc = b.st[0], nx = b.st[1];
        if (nloc == 0u) { xcd_barrier_complete(bar, b.x, nloc, nx); b.st[0] = nloc; b.st[1] = nx; }
        const unsigned old = xb_add(&bar[XB_XSUB(b.x)], 1u);
        const unsigned gen = old / nloc;
        if (old + 1u == (gen + 1u) * nloc) {
            __builtin_amdgcn_fence(__ATOMIC_RELEASE, "agent");
            asm volatile("s_waitcnt vmcnt(0)" ::: "memory");
            const unsigned og = xb_add(&bar[XB_TOP], 1u);
            const unsigned tg = og / nx;
            if (og + 1u == (tg + 1u) * nx) xb_add(&bar[XB_TOPGEN], 1u);
            else XB_SPIN(xb_ld(&bar[XB_TOPGEN]) == tg, bar);
            __builtin_amdgcn_fence(__ATOMIC_ACQUIRE, "agent");
            xb_add(&bar[XB_XGEN(b.x)], 1u);
            asm volatile("s_waitcnt vmcnt(0)" ::: "memory");
        } else {
            XB_SPIN(xb_ld(&bar[XB_XGEN(b.x)]) == gen, bar);
            __builtin_amdgcn_fence(__ATOMIC_ACQUIRE, "agent");
            asm volatile("s_waitcnt vmcnt(0)" ::: "memory");
        }
    }
    __syncthreads();
}

typedef unsigned u32x16 __attribute__((ext_vector_type(16)));
__device__ __forceinline__ void load_params(Params& p) {
    auto kp = __builtin_amdgcn_kernarg_segment_ptr();
    u32x16 a, b, c, d;
    asm volatile("s_load_dwordx16 %0, %4, 0x0\n\ts_load_dwordx16 %1, %4, 0x40\n\ts_load_dwordx16 %2, %4, 0x80\n\ts_load_dwordx16 %3, %4, 0xc0\n\ts_waitcnt lgkmcnt(0)"
                 : "=&s"(a), "=&s"(b), "=&s"(c), "=&s"(d) : "s"(kp) : "memory");
    unsigned long long q[32];
#pragma unroll
    for (int i = 0; i < 8; ++i) { q[i] = ((unsigned long long)a[2 * i + 1] << 32) | a[2 * i]; q[8 + i] = ((unsigned long long)b[2 * i + 1] << 32) | b[2 * i];
        q[16 + i] = ((unsigned long long)c[2 * i + 1] << 32) | c[2 * i]; q[24 + i] = ((unsigned long long)d[2 * i + 1] << 32) | d[2 * i]; }
    p.x = (const float*)(__attribute__((address_space(1))) const float*)q[0]; p.c = (const float*)(__attribute__((address_space(1))) const float*)q[1]; p.positions = (const int*)(__attribute__((address_space(1))) const int*)q[2]; p.mod_w = (const float*)(__attribute__((address_space(1))) const float*)q[3]; p.mod_b = (const float*)(__attribute__((address_space(1))) const float*)q[4]; p.norm_mix_w = (const float*)(__attribute__((address_space(1))) const float*)q[5]; p.norm_ffn_w = (const float*)(__attribute__((address_space(1))) const float*)q[6];
    p.ev_w_in = (const float*)(__attribute__((address_space(1))) const float*)q[7]; p.gla_gate_w = (const float*)(__attribute__((address_space(1))) const float*)q[8]; p.gla_gate_b = (const float*)(__attribute__((address_space(1))) const float*)q[9]; p.gla_norm_w = (const float*)(__attribute__((address_space(1))) const float*)q[10]; p.swa_sinks = (const float*)(__attribute__((address_space(1))) const float*)q[11]; p.ev_w_out = (const float*)(__attribute__((address_space(1))) const float*)q[12];
    p.od_w_in = (const float*)(__attribute__((address_space(1))) const float*)q[13]; p.diff_lambda = (const float*)(__attribute__((address_space(1))) const float*)q[14]; p.diff_norm_w = (const float*)(__attribute__((address_space(1))) const float*)q[15]; p.hgrn_lb_logits = (const float*)(__attribute__((address_space(1))) const float*)q[16]; p.hgrn_norm_w = (const float*)(__attribute__((address_space(1))) const float*)q[17]; p.od_w_out = (const float*)(__attribute__((address_space(1))) const float*)q[18];
    p.ffn_w_in = (const float*)(__attribute__((address_space(1))) const float*)q[19]; p.ffn_conv_w = (const float*)(__attribute__((address_space(1))) const float*)q[20]; p.ffn_conv_b = (const float*)(__attribute__((address_space(1))) const float*)q[21]; p.ffn_w_out = (const float*)(__attribute__((address_space(1))) const float*)q[22]; p.final_norm_w = (const float*)(__attribute__((address_space(1))) const float*)q[23];
    p.out = (float*)(__attribute__((address_space(1))) float*)q[24]; p.ws = (unsigned char*)(__attribute__((address_space(1))) unsigned char*)q[25];
}

#ifndef REP_SYNC
#define REP_SYNC 1
#endif
#ifndef REP_G
#define REP_G 1
#endif
#ifndef REP_R
#define REP_R 1
#endif
#ifndef REP_CV
#define REP_CV 1
#endif
#ifndef REP_P12
#define REP_P12 1
#endif
#ifndef STG_A
#define STG_A 0
#endif
#ifndef STG_B
#define STG_B 0
#endif
#ifndef ALIGN_RES
#define ALIGN_RES true
#endif
#ifndef REP_SWA
#define REP_SWA 1
#endif
#ifndef REP_LA
#define REP_LA 1
#endif
#ifndef REP_AT
#define REP_AT 1
#endif
#ifndef REP_SM
#define REP_SM 1
#endif
__global__ void __launch_bounds__(NTHR, 2) fwd_megakernel(Params pin) {
    extern __shared__ __attribute__((aligned(16))) unsigned char lds[];
    cg::grid_group grid = cg::this_grid();
    Ctx C; C.lds = lds; C.tid = threadIdx.x; C.lane = C.tid & 63; C.wave = __builtin_amdgcn_readfirstlane(C.tid >> 6);
    C.gw = blockIdx.x * 8 + C.wave; C.ngw = gridDim.x * 8;
    PG8_LAS unsigned char* ldsg = (PG8_LAS unsigned char*)lds;
    volatile LAS unsigned* bst = (volatile LAS unsigned*)(ldsg + (LDS_BYTES - 64));
    if (threadIdx.x < 2) bst[threadIdx.x] = 0u;
    __syncthreads();
    XcdBarrier xbar = xcd_barrier_post((unsigned*)(pin.ws + WS_BAR), bst);
#define GSYNC() do { for (int rs_ = 0; rs_ < REP_SYNC; ++rs_) xcd_barrier(xbar); } while (0)
#define RP() do { load_params(C.p); C.tid = otid_(); C.lane = C.tid & 63; C.wave = __builtin_amdgcn_readfirstlane(C.tid >> 6); C.gw = blockIdx.x * 8 + C.wave; } while (0)
#define WSP(off) (C.p.ws + (off))
#define STAGGER(ticks) do { if ((ticks) > 0 && (blockIdx.x & 1)) { const unsigned long long t0_ = __builtin_amdgcn_s_memrealtime(); while (__builtin_amdgcn_s_memrealtime() - t0_ < (unsigned long long)(ticks)) __builtin_amdgcn_s_sleep(16); } } while (0)

    if (pin.ws == nullptr) grid.sync();
    for (int rep_ = 0; rep_ < REP_SM; ++rep_) { RP(); phase_prologue(C); }
    GSYNC();
#if REP_CV > 1
    RP(); phase_convert(C, 0, false);
#endif
    RP(); phase_convert(C, 0);
    for (int rep_ = 0; rep_ < REP_SM; ++rep_) { RP(); phase_prep(C, C.p.x, C.p.norm_mix_w, (const float*)WSP(WS_MOD), 1024, (bf16_t*)WSP(WS_A), (float*)WSP(WS_ROWSS)); }
    GSYNC();
#pragma unroll 1
    for (int l = 0; l < 4; ++l) {
        const bool even = !(l & 1);
        {
            RP();
            const int N = even ? 2560 : 3584;
            pg8::Gemm g{(const bf16_t*)WSP(WS_A), (const bf16_t*)WSP(WS_WIN), T_, N, 1024}; pg8::StaticOrder S; S.init(T_, N, (int)gridDim.x, (int)blockIdx.x);
            pg8::EpiProj E{(bf16_t*)WSP(WS_R1), N, even ? 0x7C000u : 0xFFu, even ? 0x3C000u : 0xFu, QSCALE_, (const float*)WSP(WS_COS), (const float*)WSP(WS_SIN),
                           (const float*)WSP(WS_ROWSS) + (size_t)(2 * l) * T_, (const float*)WSP(WS_BIAS) + (size_t)l * BIAS_L};
            for (int rep_ = 0; rep_ < REP_G; ++rep_) pg8::gemm_phase<pg8::EpiProj, pg8::StaticOrder, true, true>(ldsg, g, S, E);
        }
        GSYNC();
        if (even) {
            for (int rep_ = 0; rep_ < REP_SWA; ++rep_) { RP(); phase_swa(C, l); }
            for (int rep_ = 0; rep_ < REP_LA; ++rep_) { RP(); phase_la_p1<0>(C, l); }
            GSYNC();
            RP(); phase_la_p2<0>(C);
            GSYNC();
#if REP_P12 > 1
            RP(); phase_la_p1<0>(C, l); GSYNC(); RP(); phase_la_p2<0>(C); GSYNC();
#endif
            for (int rep_ = 0; rep_ < REP_LA; ++rep_) { RP(); phase_la_p3<0>(C, l); }
        } else {
            for (int rep_ = 0; rep_ < REP_AT; ++rep_) {
                RP();
                const bf16_t* R1 = (const bf16_t*)WSP(WS_R1); bf16_t* X2 = (bf16_t*)WSP(WS_X2);
                const int G = (int)gridDim.x, bid = (int)blockIdx.x;
#pragma unroll 1
                for (int i = 0; i * G < 2048; ++i) {
                    const int L = i * G + ((i & 1) ? (G - 1 - bid) : bid);
                    if (L >= 2048) continue;
                    const int qb = 15 - (L >> 7), bh = (((L >> 2) & 7) << 4) | ((L & 3) << 2) | (((L >> 5) & 1) << 1) | ((L >> 6) & 1), b = bh >> 4, hv = bh & 15;
                    const attn_body::bf16* Q = (const attn_body::bf16*)(R1 + (hv >> 1) * 64);
                    const attn_body::bf16* K = (const attn_body::bf16*)(R1 + 512 + (hv >> 1) * 64);
                    const attn_body::bf16* V = (const attn_body::bf16*)(R1 + 1024 + (hv >> 2) * 128 + (hv & 1) * 64);
                    attn_body::attn_unit<8>(b, hv, qb, Q, K, V, (attn_body::bf16*)(X2 + hv * 64), (char*)lds);
                }
            }
            for (int rep_ = 0; rep_ < REP_LA; ++rep_) { RP(); phase_la_p1<1>(C, l); }
            GSYNC();
            RP(); phase_la_p2<1>(C);
#if REP_P12 > 1
            GSYNC(); RP(); phase_la_p1<1>(C, l); GSYNC(); RP(); phase_la_p2<1>(C);
#endif
            for (int rep_ = 0; rep_ < REP_SM; ++rep_) { RP(); phase_diff_combine(C, l); }
            GSYNC();
            for (int rep_ = 0; rep_ < REP_LA; ++rep_) { RP(); phase_la_p3<1>(C, l); }
        }
        GSYNC();
        STAGGER(STG_A);
        {
            RP();
            const float* modl = (const float*)WSP(WS_MOD) + (size_t)l * 8 * 6144;
            pg8::Gemm g{(const bf16_t*)WSP(WS_A), (const bf16_t*)WSP(WS_WOUT), T_, 1024, 1024}; pg8::StaticOrder S; S.init(T_, 1024, (int)gridDim.x, (int)blockIdx.x);
            void* XH = (void*)((char*)C.p.out + 64 * MiB_);
            pg8::EpiRes E{(l == 0) ? (const void*)C.p.x : (const void*)XH, XH, (l == 0) ? 1 : 0, 0, modl + 2048, (bf16_t*)WSP(WS_X2), C.p.norm_ffn_w + l * 1024, modl + 4096, (float*)WSP(WS_ROWSS) + (size_t)(2 * l + 1) * T_};
            pg8::gemm_phase<pg8::EpiRes, pg8::StaticOrder, ALIGN_RES, true>(ldsg, g, S, E);
        }
        GSYNC();
        {
            RP();
            pg8::Gemm g{(const bf16_t*)WSP(WS_X2), (const bf16_t*)WSP(WS_FIN), T_, 5632, 1024}; pg8::StaticOrder S; S.init(T_, 5632, (int)gridDim.x, (int)blockIdx.x);
            pg8::EpiFfn E{(bf16_t*)WSP(WS_R1), (unsigned short*)WSP(WS_HP), (unsigned short*)WSP(WS_HU), (unsigned short*)WSP(WS_HA), C.p.ffn_conv_w + (size_t)l * 3 * DFF_, C.p.ffn_conv_b + (size_t)l * DFF_,
                          (const float*)WSP(WS_ROWSS) + (size_t)(2 * l + 1) * T_, (const float*)WSP(WS_BIAS) + (size_t)l * BIAS_L + 8 * 3584};
            for (int rep_ = 0; rep_ < REP_G; ++rep_) pg8::gemm_phase<pg8::EpiFfn, pg8::StaticOrder, true, true>(ldsg, g, S, E);
        }
        GSYNC();
        for (int rep_ = 0; rep_ < REP_SM; ++rep_) { RP(); phase_ffn_fixup(C, l); }
#if REP_CV > 1
        if (l < 3) { RP(); phase_convert(C, l + 1, false); }
#endif
        if (l < 3) { RP(); phase_convert(C, l + 1, false); }
        GSYNC();
        if (l < 3) { RP(); phase_bias_wt(C, l + 1); }
        {
            RP();
            const float* modl = (const float*)WSP(WS_MOD) + (size_t)l * 8 * 6144;
            pg8::Gemm g{(const bf16_t*)WSP(WS_R1), (const bf16_t*)WSP((l & 1) ? WS_FOUT2 : WS_FOUT), T_, 1024, DFF_}; pg8::StaticOrder S; S.init(T_, 1024, (int)gridDim.x, (int)blockIdx.x);
            void* XH = (void*)((char*)C.p.out + 64 * MiB_);
            pg8::EpiRes E{XH, (l < 3) ? XH : (void*)WSP(WS_X2), 0, 0, modl + 5120, (l < 3) ? (bf16_t*)WSP(WS_A) : (bf16_t*)nullptr, C.p.norm_mix_w + ((l + 1) & 3) * 1024, modl + 6144 * 8 + 1024, (float*)WSP(WS_ROWSS) + (size_t)((2 * l + 2) & 7) * T_};
            pg8::gemm_phase<pg8::EpiRes, pg8::StaticOrder, ALIGN_RES, true>(ldsg, g, S, E);
        }
        GSYNC();
    }
    RP(); phase_final_norm(C, (const void*)WSP(WS_X2), C.p.out, C.p.final_norm_w);
}

extern "C" void kernel_launch(void* const* d_in, const int* in_sizes, int n_in, void* d_out, int out_size, void* d_ws, size_t ws_size, hipStream_t stream) {
    static int grid_blocks = 0;
    if (grid_blocks == 0) {
        if (n_in != 24 || ws_size < WS_END) { fprintf(stderr, "kernel_launch: unexpected n_in %d / ws %zu\n", n_in, ws_size); grid_blocks = -1; return; }
        int dev = 0, cus = 0, per_cu = 0;
        hipGetDevice(&dev); hipDeviceGetAttribute(&cus, hipDeviceAttributeMultiprocessorCount, dev);
        if (hipFuncSetAttribute((const void*)fwd_megakernel, hipFuncAttributeMaxDynamicSharedMemorySize, LDS_BYTES) != hipSuccess) { fprintf(stderr, "kernel_launch: hipFuncSetAttribute failed\n"); grid_blocks = -1; return; }
        if (hipOccupancyMaxActiveBlocksPerMultiprocessor(&per_cu, (const void*)fwd_megakernel, NTHR, LDS_BYTES) != hipSuccess || per_cu < 1) { fprintf(stderr, "kernel_launch: occupancy query gave %d\n", per_cu); per_cu = 1; }
        (void)hipGetLastError();
        grid_blocks = cus * per_cu;
    }
    if (grid_blocks < 0) return;
    Params p{};
    p.x = (const float*)d_in[0]; p.c = (const float*)d_in[1]; p.positions = (const int*)d_in[2]; p.mod_w = (const float*)d_in[3]; p.mod_b = (const float*)d_in[4];
    p.norm_mix_w = (const float*)d_in[5]; p.norm_ffn_w = (const float*)d_in[6]; p.ev_w_in = (const float*)d_in[7]; p.gla_gate_w = (const float*)d_in[8];
    p.gla_gate_b = (const float*)d_in[9]; p.gla_norm_w = (const float*)d_in[10]; p.swa_sinks = (const float*)d_in[11]; p.ev_w_out = (const float*)d_in[12];
    p.od_w_in = (const float*)d_in[13]; p.diff_lambda = (const float*)d_in[14]; p.diff_norm_w = (const float*)d_in[15]; p.hgrn_lb_logits = (const float*)d_in[16];
    p.hgrn_norm_w = (const float*)d_in[17]; p.od_w_out = (const float*)d_in[18]; p.ffn_w_in = (const float*)d_in[19]; p.ffn_conv_w = (const float*)d_in[20];
    p.ffn_conv_b = (const float*)d_in[21]; p.ffn_w_out = (const float*)d_in[22]; p.final_norm_w = (const float*)d_in[23];
    p.out = (float*)d_out; p.ws = (unsigned char*)d_ws;
    if (hipMemsetAsync((char*)d_ws + WS_BAR, 0, 16384, stream) != hipSuccess) { fprintf(stderr, "kernel_launch: memset failed\n"); return; }
    void* args[] = {&p};
    hipError_t e = hipLaunchCooperativeKernel((const void*)fwd_megakernel, dim3(grid_blocks), dim3(NTHR), args, LDS_BYTES, stream);
    if (e != hipSuccess) fprintf(stderr, "cooperative launch failed: %s (grid %d)\n", hipGetErrorString(e), grid_blocks);
}
```

```cpp
#include <hip/hip_runtime.h>
#include <hip/hip_cooperative_groups.h>
#include <hip/hip_bf16.h>
#include <cstdio>
#include <cstdint>
#include <cmath>
__device__ __forceinline__ int otid_() { int t = threadIdx.x; asm volatile("" : "+v"(t)); return t; }
namespace pg8 {
#define PG8_LAS __attribute__((address_space(3)))
typedef unsigned short bf16_t;
typedef short bf16x8 __attribute__((ext_vector_type(8)));
typedef float f32x4 __attribute__((ext_vector_type(4)));
typedef unsigned u32x4 __attribute__((ext_vector_type(4)));
constexpr int BM = 256, BK = 64, HALF = 128, HTB = HALF * BK * 2  , STAGE_BYTES = 8 * HTB, NXCD = 8, WGM = 8;

__host__ __device__ __forceinline__ int lds_byte(int r, int c) { const int st = (r >> 4) * 2 + (c >> 5), rr = r & 15, cc = c & 31, ob = rr * 64 + cc * 2; return st * 1024 + (ob ^ (((ob >> 9) & 1) << 5)); }
__host__ __device__ __forceinline__ void stage_rc(int b, int& R, int& C) { const int st = b / 1024, sb = b % 1024, swz = sb ^ (((sb >> 9) & 1) << 5); R = (st >> 1) * 16 + swz / 64; C = (st & 1) * 32 + (swz % 64) / 2; }
__host__ __device__ __forceinline__ int perm32(int rho) { const int n = rho >> 4, i = rho & 15; return 8 * (i >> 2) + 4 * n + (i & 3); }

struct Unit { int pm, pn; };
struct Gemm { const bf16_t* A; const bf16_t* Bt; int M, N, K; };

struct StaticOrder {
    int nM, nN, nwg, G, c;
    __host__ __device__ void init(int M, int N, int G_, int c_) { nM = M / BM; nN = N / BM; nwg = nM * nN; G = G_; c = c_; }
    __host__ __device__ bool next(int i, Unit& u) const {
        const long L = (long)i * G + c; if (L >= nwg) return false;
        int wgid = (int)L; { const int q = nwg / NXCD, r = nwg % NXCD, xcd = wgid % NXCD, off = wgid / NXCD; wgid = (xcd < r ? xcd * (q + 1) : r * (q + 1) + (xcd - r) * q) + off; }
        const int nig = WGM * nN, gid = wgid / nig, fm = gid * WGM, gsz = (nM - fm) < WGM ? (nM - fm) : WGM;
        u.pm = fm + ((wgid % nig) % gsz); u.pn = (wgid % nig) / gsz; return true;
    }
    __device__ __forceinline__ void a_ready(const Unit&) const {}
    __device__ __forceinline__ void done(const Unit&) const {}
};

__device__ __forceinline__ unsigned cvt_pk_bf16(float lo, float hi) { unsigned r; asm volatile("v_cvt_pk_bf16_f32 %0, %1, %2" : "=v"(r) : "v"(lo), "v"(hi)); return r; }
typedef float f32x2 __attribute__((ext_vector_type(2)));
template <class Epi, class Sched, bool ALIGN_EPI = false, bool SP2 = false>
__device__ __forceinline__ void gemm_phase(PG8_LAS unsigned char* lds, const Gemm g, const Sched& S, const Epi& E) {
    const int tid = otid_(), wid = __builtin_amdgcn_readfirstlane(tid >> 6), lane = tid & 63, wr = wid >> 2, wc = wid & 3, fr = lane & 15, fq = lane >> 4;
    const int K = g.K, nt = K / BK;
    unsigned voffA[2], voffB[2];
#pragma unroll
    for (int i = 0; i < 2; ++i) { int R, C; stage_rc(tid * 16 + i * 8192, R, C); const int Rb = Epi::PERM ? ((R & ~31) + perm32(R & 31)) : R;
        voffA[i] = (unsigned)(R * K + C) * 2u; voffB[i] = (unsigned)(Rb * K + C) * 2u; }
    const size_t kstep = (size_t)(BK * 2);
    const size_t hstep = (size_t)HALF * K * 2;
    const size_t tstep = 2 * hstep;
    const unsigned ldsw = (unsigned)wid * 1024u;
    const int aoff = lds_byte(wr * 64 + fr, fq * 8), boff = lds_byte(wc * 32 + fr, fq * 8);
#define PG8_SA(b, h) (((b) * 2 + (h)) * HTB)
#define PG8_SB(b, h) ((4 + (b) * 2 + (h)) * HTB)
#define PG8_STAGE(bufoff, gbase, voff) do { _Pragma("unroll") for (int _i = 0; _i < 2; ++_i) \
        __builtin_amdgcn_global_load_lds((const unsigned*)((const char*)(gbase) + (voff)[_i]), (PG8_LAS unsigned*)(lds + (bufoff) + ldsw + _i * 8192), 16, 0, 0); } while (0)
#define PG8_LDA(dst, b, h) do { _Pragma("unroll") for (int m = 0; m < 4; ++m) _Pragma("unroll") for (int k = 0; k < 2; ++k) dst[m][k] = *(const PG8_LAS bf16x8*)(lds + PG8_SA(b, h) + aoff + m * 2048 + k * 1024); } while (0)
#define PG8_LDB(dst, b, h) do { _Pragma("unroll") for (int n = 0; n < 2; ++n) _Pragma("unroll") for (int k = 0; k < 2; ++k) dst[n][k] = *(const PG8_LAS bf16x8*)(lds + PG8_SB(b, h) + boff + n * 2048 + k * 1024); } while (0)
#define PG8_MMA(ai, bj, At, Bt) do { __builtin_amdgcn_s_setprio(1); _Pragma("unroll") for (int m = 0; m < 4; ++m) _Pragma("unroll") for (int n = 0; n < 2; ++n) _Pragma("unroll") for (int k = 0; k < 2; ++k) \
        acc[ai][bj][m][n] = __builtin_amdgcn_mfma_f32_16x16x32_bf16(Bt[n][k], At[m][k], acc[ai][bj][m][n], 0, 0, 0); __builtin_amdgcn_s_setprio(0); } while (0)
#define PG8_WAIT_V(n) asm volatile("s_waitcnt vmcnt(" #n ")" ::: "memory")
#define PG8_WAIT_L(n) asm volatile("s_waitcnt lgkmcnt(" #n ")" ::: "memory")
#define PG8_BAR __builtin_amdgcn_s_barrier()
#define PG8_SCHED __builtin_amdgcn_sched_barrier(0)
    Unit cur, nxt; int ui = 0;
    if (!S.next(0, cur)) return;
    f32x4 acc[2][2][4][2];
#pragma unroll
    for (int a = 0; a < 2; ++a)
#pragma unroll
        for (int b = 0; b < 2; ++b)
#pragma unroll
            for (int m = 0; m < 4; ++m)
#pragma unroll
                for (int n = 0; n < 2; ++n) acc[a][b][m][n] = (f32x4){0.f, 0.f, 0.f, 0.f};
    bf16x8 At[4][2], B0[2][2], B1[2][2];
    const char* cA = (const char*)g.A + (size_t)cur.pm * tstep; const char* cB = (const char*)g.Bt + (size_t)cur.pn * tstep;
    S.a_ready(cur);
    if constexpr (SP2) {
        PG8_STAGE(PG8_SB(0, 0), cB, voffB); PG8_STAGE(PG8_SB(0, 1), cB + hstep, voffB); PG8_STAGE(PG8_SA(0, 0), cA, voffA); PG8_STAGE(PG8_SA(0, 1), cA + hstep, voffA);
        if (wr == 1) PG8_BAR;
        PG8_WAIT_V(2); PG8_BAR;
        PG8_STAGE(PG8_SB(1, 0), cB + kstep, voffB); PG8_STAGE(PG8_SA(1, 0), cA + kstep, voffA); PG8_STAGE(PG8_SB(1, 1), cB + hstep + kstep, voffB);
        PG8_WAIT_V(6); PG8_BAR;
    } else {
        PG8_STAGE(PG8_SB(0, 0), cB, voffB); PG8_STAGE(PG8_SA(0, 0), cA, voffA); PG8_STAGE(PG8_SB(0, 1), cB + hstep, voffB); PG8_STAGE(PG8_SA(0, 1), cA + hstep, voffA);
        if (wr == 1) PG8_BAR;
        PG8_WAIT_V(4); PG8_BAR;
        PG8_STAGE(PG8_SB(1, 0), cB + kstep, voffB); PG8_STAGE(PG8_SA(1, 0), cA + kstep, voffA); PG8_STAGE(PG8_SB(1, 1), cB + hstep + kstep, voffB);
        PG8_WAIT_V(6); PG8_BAR;
    }
    for (;;) {
        const bool has_next = S.next(ui + 1, nxt);
        const char* nA = has_next ? (const char*)g.A + (size_t)nxt.pm * tstep : cA; const char* nB = has_next ? (const char*)g.Bt + (size_t)nxt.pn * tstep : cB;
        for (int t = 0; t < nt; t += 2) {
            const bool last = (t == nt - 2);
            const char* a1 = cA + (size_t)(t + 1) * kstep;
            const char* a2 = last ? nA : cA + (size_t)(t + 2) * kstep; const char* b2 = last ? nB : cB + (size_t)(t + 2) * kstep;
            const char* a3 = a2 + kstep; const char* b3 = b2 + kstep;
            if (last && has_next) S.a_ready(nxt);
            if constexpr (SP2) {
            PG8_LDB(B0, 0, 0); PG8_LDB(B1, 0, 1); PG8_SCHED; PG8_LDA(At, 0, 0); PG8_STAGE(PG8_SA(1, 1), a1 + hstep, voffA);
            PG8_WAIT_V(8); PG8_WAIT_L(0); PG8_BAR; PG8_MMA(0, 0, At, B0); PG8_MMA(0, 1, At, B1); PG8_BAR; PG8_SCHED;
            PG8_LDA(At, 0, 1); PG8_STAGE(PG8_SB(0, 0), b2, voffB); PG8_STAGE(PG8_SB(0, 1), b2 + hstep, voffB); PG8_STAGE(PG8_SA(0, 0), a2, voffA);
            PG8_WAIT_V(8); PG8_WAIT_L(0); PG8_BAR; PG8_MMA(1, 0, At, B0); PG8_MMA(1, 1, At, B1); PG8_BAR; PG8_SCHED;
            PG8_LDB(B0, 1, 0); PG8_LDB(B1, 1, 1); PG8_SCHED; PG8_LDA(At, 1, 0); PG8_STAGE(PG8_SA(0, 1), a2 + hstep, voffA);
            PG8_WAIT_V(8); PG8_WAIT_L(0); PG8_BAR; PG8_MMA(0, 0, At, B0); PG8_MMA(0, 1, At, B1); PG8_BAR; PG8_SCHED;
            PG8_LDA(At, 1, 1); PG8_STAGE(PG8_SB(1, 0), b3, voffB); PG8_STAGE(PG8_SB(1, 1), b3 + hstep, voffB); PG8_STAGE(PG8_SA(1, 0), a3, voffA);
            PG8_WAIT_V(8); PG8_WAIT_L(0); PG8_BAR; PG8_MMA(1, 0, At, B0); PG8_MMA(1, 1, At, B1); PG8_BAR; PG8_SCHED;
            } else {
            PG8_LDB(B0, 0, 0); PG8_SCHED; PG8_LDA(At, 0, 0); PG8_STAGE(PG8_SA(1, 1), a1 + hstep, voffA);
            PG8_WAIT_L(8); PG8_BAR; PG8_WAIT_L(0); PG8_MMA(0, 0, At, B0); PG8_BAR; PG8_SCHED;
            PG8_LDB(B1, 0, 1); PG8_STAGE(PG8_SB(0, 0), b2, voffB);
            PG8_BAR; PG8_WAIT_L(0); PG8_MMA(0, 1, At, B1); PG8_BAR;
            PG8_LDA(At, 0, 1); PG8_STAGE(PG8_SA(0, 0), a2, voffA);
            PG8_BAR; PG8_WAIT_L(0); PG8_MMA(1, 0, At, B0); PG8_BAR; PG8_SCHED;
            PG8_STAGE(PG8_SB(0, 1), b2 + hstep, voffB);
            PG8_WAIT_V(6); PG8_BAR; PG8_MMA(1, 1, At, B1); PG8_BAR;
            PG8_LDB(B0, 1, 0); PG8_SCHED; PG8_LDA(At, 1, 0); PG8_STAGE(PG8_SA(0, 1), a2 + hstep, voffA);
            PG8_WAIT_L(8); PG8_BAR; PG8_WAIT_L(0); PG8_MMA(0, 0, At, B0); PG8_BAR; PG8_SCHED;
            PG8_LDB(B1, 1, 1); PG8_STAGE(PG8_SB(1, 0), b3, voffB);
            PG8_BAR; PG8_WAIT_L(0); PG8_MMA(0, 1, At, B1); PG8_BAR;
            PG8_LDA(At, 1, 1); PG8_STAGE(PG8_SA(1, 0), a3, voffA);
            PG8_BAR; PG8_WAIT_L(0); PG8_MMA(1, 0, At, B0); PG8_BAR; PG8_SCHED;
            PG8_STAGE(PG8_SB(1, 1), b3 + hstep, voffB);
            PG8_WAIT_V(6); PG8_BAR; PG8_MMA(1, 1, At, B1); PG8_BAR;
            }
        }
        if constexpr (ALIGN_EPI) { if (wr == 0) PG8_BAR; }
        if constexpr (!Epi::AFTER_DRAIN) { E(acc, cur, wr, wc, fr, fq); S.done(cur); }
        if (!has_next) break;
#pragma unroll
        for (int a = 0; a < 2; ++a)
#pragma unroll
            for (int b = 0; b < 2; ++b)
#pragma unroll
                for (int m = 0; m < 4; ++m)
#pragma unroll
                    for (int n = 0; n < 2; ++n) acc[a][b][m][n] = (f32x4){0.f, 0.f, 0.f, 0.f};
        cur = nxt; cA = nA; cB = nB; ++ui;
        if constexpr (ALIGN_EPI) { if (wr == 1) PG8_BAR; }
    }
    PG8_WAIT_V(0);
    if constexpr (!ALIGN_EPI) { if (wr == 0) PG8_BAR; }
    PG8_BAR;
    if constexpr (Epi::AFTER_DRAIN) { E.fused(acc, cur, wr, wc, fr, fq, lds, wid, lane); S.done(cur); }
#undef PG8_SA
#undef PG8_SB
#undef PG8_STAGE
#undef PG8_LDA
#undef PG8_LDB
#undef PG8_MMA
#undef PG8_WAIT_V
#undef PG8_WAIT_L
#undef PG8_BAR
#undef PG8_SCHED
}
}
#include <hip/hip_bf16.h>
namespace attn_body {
using bf16=__hip_bfloat16;
using bf16x8=__attribute__((ext_vector_type(8)))short;
using s16x4=__attribute__((ext_vector_type(4)))short;
using f32x16=__attribute__((ext_vector_type(16)))float;
using u32x4=__attribute__((ext_vector_type(4)))unsigned;
constexpr int BATCH=8,NHEAD=16,SEQ=4096,D=64,PITI=3584,PITO=1024;
constexpr int NW=8,QBLK=32,QB=QBLK*NW,KVBLK=64,NQB=SEQ/QB;
__device__ __forceinline__ int crow(int r,int hi){return (r&3)+8*(r>>2)+4*hi;}
#define SBAR() __builtin_amdgcn_sched_barrier(0)
__device__ __forceinline__ void cmask(f32x16&p0,f32x16&p1,int jb,int qrel,int hi){
  const float NEG=-INFINITY; int kb=64*jb+4*hi;
  #pragma unroll
  for(int r=0;r<16;++r){int kv=kb+(r&3)+8*(r>>2); if(kv>qrel)p0[r]=NEG; if(kv+32>qrel)p1[r]=NEG;}
}

constexpr int NSLOT=3, SLOTB=8192;
constexpr int LDS_K=0, LDS_V=NSLOT*SLOTB, LDS_WS=2*NSLOT*SLOTB, LDS_OST=LDS_WS+NW*64*4, LDS_BYTES=LDS_OST+NW*4096;
constexpr float C2=0.125f*1.4426950408889634f;
__device__ __forceinline__ void glds16(const void*gsrc,unsigned lds_dst){unsigned keep;
  asm volatile("s_mov_b32 %0, m0\n\ts_mov_b32 m0, %2\n\ts_nop 0\n\tglobal_load_lds_dwordx4 %1, off\n\ts_mov_b32 m0, %0":"=&s"(keep):"v"(gsrc),"s"(lds_dst):"memory");}
__device__ __forceinline__ float max3f(float a,float b,float c){float r;asm("v_max3_f32 %0, %1, %2, %3":"=v"(r):"v"(a),"v"(b),"v"(c));return r;}
__device__ __forceinline__ float max2f(float a,float b){float r;asm("v_max_f32_e32 %0, %1, %2":"=v"(r):"v"(a),"v"(b));return r;}
__device__ __forceinline__ float fadd_s(float a,float b){float r;asm("v_add_f32_e32 %0, %1, %2":"=v"(r):"v"(a),"v"(b));return r;}
__device__ __forceinline__ float fsub_s(float a,float b){float r;asm("v_sub_f32_e32 %0, %1, %2":"=v"(r):"v"(a),"v"(b));return r;}
typedef float f32x2_t __attribute__((ext_vector_type(2))); typedef __bf16 bf16x2_t __attribute__((ext_vector_type(2)));
__device__ __forceinline__ unsigned cvtpk_s(float lo,float hi){f32x2_t v={lo,hi};bf16x2_t b=__builtin_convertvector(v,bf16x2_t);return __builtin_bit_cast(unsigned,b);}
#define WAIT_BAR(N) asm volatile("s_waitcnt vmcnt(" #N ") lgkmcnt(0)\n\ts_barrier":::"memory")

__device__ __forceinline__ void qkt(f32x16&p0,f32x16&p1,const char*Kslot,const bf16x8*qr,const f32x16&negm,int r32,int hi){
  const char*kb=Kslot+hi*1024+r32*16;
  #pragma unroll
  for(int d0=0;d0<4;++d0){
    const bf16x8 b0=*reinterpret_cast<const bf16x8*>(kb+d0*2048);
    const bf16x8 b1=*reinterpret_cast<const bf16x8*>(kb+d0*2048+512);
    if(d0==0){p0=__builtin_amdgcn_mfma_f32_32x32x16_bf16(b0,qr[0],negm,0,0,0);p1=__builtin_amdgcn_mfma_f32_32x32x16_bf16(b1,qr[0],negm,0,0,0);}
    else{p0=__builtin_amdgcn_mfma_f32_32x32x16_bf16(b0,qr[d0],p0,0,0,0);p1=__builtin_amdgcn_mfma_f32_32x32x16_bf16(b1,qr[d0],p1,0,0,0);}}
}
typedef __attribute__((address_space(3))) const char* lds_cptr;
typedef short v4i16_t __attribute__((ext_vector_type(4)));
__device__ __forceinline__ void kload8(bf16x8*kf,lds_cptr kp){
  kf[0]=*(const __attribute__((address_space(3))) bf16x8*)(kp);      kf[1]=*(const __attribute__((address_space(3))) bf16x8*)(kp+512);
  kf[2]=*(const __attribute__((address_space(3))) bf16x8*)(kp+2048); kf[3]=*(const __attribute__((address_space(3))) bf16x8*)(kp+2560);
  kf[4]=*(const __attribute__((address_space(3))) bf16x8*)(kp+4096); kf[5]=*(const __attribute__((address_space(3))) bf16x8*)(kp+4608);
  kf[6]=*(const __attribute__((address_space(3))) bf16x8*)(kp+6144); kf[7]=*(const __attribute__((address_space(3))) bf16x8*)(kp+6656);
}
__device__ __forceinline__ void kload2(bf16x8*kf,lds_cptr kp,int j){ kf[2*j]=*(const __attribute__((address_space(3))) bf16x8*)(kp+j*2048); kf[2*j+1]=*(const __attribute__((address_space(3))) bf16x8*)(kp+j*2048+512); }
__device__ __forceinline__ s16x4 vtr(lds_cptr p){ return __builtin_bit_cast(s16x4,__builtin_amdgcn_ds_read_tr16_b64_v4i16((__attribute__((address_space(3))) v4i16_t*)p)); }
__device__ __forceinline__ float rowmax(const f32x16&p0,const f32x16&p1){
  float a=max3f(p0[0],p0[1],p1[0]),b=max3f(p0[2],p0[3],p1[1]);a=max3f(a,p1[2],p1[3]);
  #pragma unroll
  for(int r=4;r<16;r+=4){a=max3f(a,p0[r],p0[r+1]);b=max3f(b,p0[r+2],p0[r+3]);a=max3f(a,p1[r],p1[r+1]);b=max3f(b,p1[r+2],p1[r+3]);}
  const float m=max2f(a,b);
  auto rr=__builtin_amdgcn_permlane32_swap(__float_as_uint(m),__float_as_uint(m),false,false);
  return max2f(__uint_as_float(rr[0]),__uint_as_float(rr[1]));
}
__device__ __forceinline__ void pv(f32x16*o,int vb,bf16x8 pa0,bf16x8 pa1,bf16x8 pa2,bf16x8 pa3){
  #pragma unroll
  for(int d0=0;d0<2;++d0){s16x4 lo[4],hi[4];
    #pragma unroll
    for(int ks=0;ks<4;++ks){
      asm volatile("ds_read_b64_tr_b16 %0,%1 offset:%c2":"=&v"(lo[ks]):"v"(vb),"i"(d0*4096+ks*1024):"memory");
      asm volatile("ds_read_b64_tr_b16 %0,%1 offset:%c2":"=&v"(hi[ks]):"v"(vb),"i"(d0*4096+ks*1024+512):"memory");}
    asm volatile("s_waitcnt lgkmcnt(0)":::"memory");SBAR();
    #define PK(k) (bf16x8){lo[k][0],lo[k][1],lo[k][2],lo[k][3],hi[k][0],hi[k][1],hi[k][2],hi[k][3]}
    o[d0]=__builtin_amdgcn_mfma_f32_32x32x16_bf16(pa0,PK(0),o[d0],0,0,0);
    o[d0]=__builtin_amdgcn_mfma_f32_32x32x16_bf16(pa1,PK(1),o[d0],0,0,0);
    o[d0]=__builtin_amdgcn_mfma_f32_32x32x16_bf16(pa2,PK(2),o[d0],0,0,0);
    o[d0]=__builtin_amdgcn_mfma_f32_32x32x16_bf16(pa3,PK(3),o[d0],0,0,0);
    #undef PK
  }
}

#ifndef ATTN_STORE16
#define ATTN_STORE16(p,v) (*(u32x4*)(p)=(v))
#endif
template<int THRL> __device__ __forceinline__ void attn_unit(int b,int h,int qb,const bf16*Q,const bf16*__restrict__ K,const bf16*__restrict__ V,bf16*O,char*shm){
  const int tid=otid_(),lane=tid&63,r32=lane&31,hi=lane>>5; const int wid=__builtin_amdgcn_readfirstlane(tid>>6);
  const long rowbase=(long)b*SEQ; const int q0=qb*QB;
  const bf16*Qw=Q+(rowbase+q0+wid*QBLK)*PITI;
  const bf16*Kh=K+rowbase*PITI,*Vh=V+rowbase*PITI;
  const unsigned lds0=(unsigned)(uintptr_t)shm;
  float*wsf=(float*)(shm+LDS_WS)+wid*64;
  const bf16*ksrc=Kh+(long)lane*PITI+wid*8;
  const bf16*vsrc=Vh+(long)(16*(wid&3)+(lane>>2))*PITI+(wid>>2)*32+(lane&3)*8;
  const unsigned kdst=lds0+LDS_K+wid*1024, vdst=lds0+LDS_V+wid*1024;
  #define DMA_K(t,slot) glds16(ksrc+(long)(t)*KVBLK*PITI,(unsigned)__builtin_amdgcn_readfirstlane(kdst+(slot)))
  #define DMA_V(t,slot) glds16(vsrc+(long)(t)*KVBLK*PITI,(unsigned)__builtin_amdgcn_readfirstlane(vdst+(slot)))
  const int vb0=(int)(lds0+LDS_V)+((lane>>4)&1)*32+(lane&3)*8+(4*hi+((lane&15)>>2))*64;
  const char*Kbase=shm+LDS_K; bf16x8 kf[8];
  const lds_cptr shm3=(lds_cptr)shm; const lds_cptr kp0=shm3+LDS_K+hi*1024+r32*16; const lds_cptr vp0=shm3+LDS_V+((lane>>4)&1)*32+(lane&3)*8+(4*hi+((lane&15)>>2))*64;
  const int NT=(q0+QB)/KVBLK;
  DMA_K(0,0);DMA_V(0,0);DMA_K(1,SLOTB);
  bf16x8 qr[4];
  #pragma unroll
  for(int d0=0;d0<4;++d0)qr[d0]=*reinterpret_cast<const bf16x8*>(&Qw[(long)r32*PITI+d0*16+hi*8]);
  float mhat=0.f,l_reg=0.f;f32x16 o[2];o[0]=f32x16{};o[1]=f32x16{};f32x16 negm=f32x16{};asm volatile("":"+v"(negm));
  const int qrel=wid*QBLK+r32;
  #define CMASK(P0,P1,t) do{int jb_=(t)-(NT-4); if(jb_>=0)cmask(P0,P1,jb_,qrel,hi);}while(0)
  bool resc=false;
  #define START(P0,P1) do{ const float rm=rowmax(P0,P1); resc=false; \
    { const float dl=rm; mhat=fadd_s(mhat,dl); \
      _Pragma("unroll") for(int r=0;r<16;++r){P0[r]=fsub_s(P0[r],dl);P1[r]=fsub_s(P1[r],dl);} \
      _Pragma("unroll") for(int r=0;r<16;++r)negm[r]=-mhat; asm volatile("":"+v"(negm)); } \
    _Pragma("unroll") for(int r=0;r<16;++r)P0[r]=__builtin_amdgcn_exp2f(P0[r]); }while(0)
  #define RESC() do{ if(resc){ asm volatile("s_waitcnt lgkmcnt(0)":::"memory"); \
      _Pragma("unroll") for(int d_=0;d_<2;++d_) _Pragma("unroll") for(int r=0;r<16;++r)o[d_][r]*=wsf[crow(r,hi)]; } }while(0)
  f32x16 pA0,pA1,pB0,pB1;
  int sl_prev=0,sl_cur=0,sl_next=SLOTB;
  #define ROT() do{sl_prev=sl_cur;sl_cur=sl_next;sl_next=(sl_next==(NSLOT-1)*SLOTB)?0:sl_next+SLOTB;}while(0)
  DMA_K(2,2*SLOTB);
  WAIT_BAR(3);
  qkt(pA0,pA1,Kbase,qr,negm,r32,hi);asm volatile("s_nop 15\n\ts_nop 7":"+v"(pA0),"+v"(pA1));CMASK(pA0,pA1,0);
  START(pA0,pA1);
  _Pragma("unroll") for(int r=0;r<16;++r)pA1[r]=__builtin_amdgcn_exp2f(pA1[r]);
  WAIT_BAR(0);
  DMA_K(3,0);DMA_V(1,SLOTB);
  ROT();
  kload8(kf,kp0+sl_cur);
  WAIT_BAR(2);
  s16x4 vlo[8],vhi[8]; u32x4 pw0,pw1,pw2,pw3;
  #define PKW(P,B) cvtpk_s(P[B],P[B+1])
  #define PAF(k) __builtin_bit_cast(bf16x8,pw##k)
  #define VFR(i) (bf16x8){vlo[i][0],vlo[i][1],vlo[i][2],vlo[i][3],vhi[i][0],vhi[i][1],vhi[i][2],vhi[i][3]}
  #define PIN(x) asm volatile("":"+v"(x))
  #define MX3(a,b,c) __builtin_fmaxf(__builtin_fmaxf((a),(b)),(c))
  #define GAPA(MF,A0,A1,A2,A3,W0,W1,PW) do{ MF; sacc+=A0; sacc+=A1; sacc+=A2; sacc+=A3; PIN(sacc); W0; W1; PIN(PW); SBAR(); }while(0)
  #define EX(v) __builtin_amdgcn_exp2f(v)
  #define GAPB(MF,X,B) do{ MF; X[B]=EX(X[B]); X[B+1]=EX(X[B+1]); X[B+2]=EX(X[B+2]); X[B+3]=EX(X[B+3]); PIN(X); SBAR(); }while(0)
  #define VRD(i) do{ vlo[i]=vtr(vp_+(((i)>>2)*4096+((i)&3)*1024)); vhi[i]=vtr(vp_+(((i)>>2)*4096+((i)&3)*1024+512)); }while(0)
  #define KRD(G,j) do{ if(G){ kload2(kf,kp0+sl_next,j); SBAR(); } }while(0)
  #define STEP(C0,C1,P0,P1,t,GK,GV,GL) do{ SBAR(); \
    const lds_cptr vp_=vp0+sl_prev; \
    VRD(0); SBAR(); float sacc=(P0[0]+P0[1]); \
    GAPA(C0=__builtin_amdgcn_mfma_f32_32x32x16_bf16(kf[0],qr[0],negm,0,0,0), P0[2],P0[3],P0[4],P0[5],     pw0[0]=PKW(P0,0), pw0[1]=PKW(P0,2), pw0); \
    VRD(4); SBAR(); GAPA(C1=__builtin_amdgcn_mfma_f32_32x32x16_bf16(kf[1],qr[0],negm,0,0,0), P0[6],P0[7],P0[8],P0[9],     pw0[2]=PKW(P0,4), pw0[3]=PKW(P0,6), pw0); \
    VRD(1); SBAR(); GAPA(C0=__builtin_amdgcn_mfma_f32_32x32x16_bf16(kf[2],qr[1],C0,0,0,0),   P0[10],P0[11],P0[12],P0[13], pw1[0]=PKW(P0,8), pw1[1]=PKW(P0,10), pw1); \
    VRD(5); SBAR(); GAPA(C1=__builtin_amdgcn_mfma_f32_32x32x16_bf16(kf[3],qr[1],C1,0,0,0),   P0[14],P0[15],P1[0],P1[1],   pw1[2]=PKW(P0,12),pw1[3]=PKW(P0,14), pw1); \
    VRD(2); SBAR(); GAPA(C0=__builtin_amdgcn_mfma_f32_32x32x16_bf16(kf[4],qr[2],C0,0,0,0),   P1[2],P1[3],P1[4],P1[5],     pw2[0]=PKW(P1,0), pw2[1]=PKW(P1,2), pw2); \
    VRD(6); SBAR(); GAPA(C1=__builtin_amdgcn_mfma_f32_32x32x16_bf16(kf[5],qr[2],C1,0,0,0),   P1[6],P1[7],P1[8],P1[9],     pw2[2]=PKW(P1,4), pw2[3]=PKW(P1,6), pw2); \
    VRD(3); SBAR(); GAPA(C0=__builtin_amdgcn_mfma_f32_32x32x16_bf16(kf[6],qr[3],C0,0,0,0),   P1[10],P1[11],P1[12],P1[13], pw3[0]=PKW(P1,8), pw3[1]=PKW(P1,10), pw3); \
    VRD(7); SBAR(); GAPA(C1=__builtin_amdgcn_mfma_f32_32x32x16_bf16(kf[7],qr[3],C1,0,0,0),   P1[14],P1[15],0.f,0.f,       pw3[2]=PKW(P1,12),pw3[3]=PKW(P1,14), pw3); \
    l_reg+=sacc; \
    if(GK){DMA_K((t)+3,sl_cur);} if(GV){DMA_V((t)+1,sl_next);} \
    CMASK(C0,C1,t); \
    { float a=MX3(C0[0],C0[1],C1[0]),b=MX3(C0[2],C0[3],C1[1]); a=MX3(a,C1[2],C1[3]); \
      _Pragma("unroll") for(int r=4;r<16;r+=4){a=MX3(a,C0[r],C0[r+1]);b=MX3(b,C0[r+2],C0[r+3]);a=MX3(a,C1[r],C1[r+1]);b=MX3(b,C1[r+2],C1[r+3]);} \
      float rm=__builtin_fmaxf(a,b); { auto rr=__builtin_amdgcn_permlane32_swap(__float_as_uint(rm),__float_as_uint(rm),false,false); rm=__builtin_fmaxf(__uint_as_float(rr[0]),__uint_as_float(rr[1])); } \
      resc=false; \
      if(__builtin_expect(__any(rm>(float)THRL),0)){ const float dl=__builtin_fmaxf(rm,0.f); mhat+=dl; \
        _Pragma("unroll") for(int r=0;r<16;++r){C0[r]-=dl;C1[r]-=dl;} \
        _Pragma("unroll") for(int r=0;r<16;++r)negm[r]=-mhat; asm volatile("":"+v"(negm)); \
        const float f=__builtin_amdgcn_exp2f(-dl); l_reg*=f; if(hi==0)wsf[r32]=f; resc=true; } } \
    SBAR(); \
    GAPB(o[0]=__builtin_amdgcn_mfma_f32_32x32x16_bf16(PAF(0),VFR(0),o[0],0,0,0), C0,0); \
    GAPB(o[1]=__builtin_amdgcn_mfma_f32_32x32x16_bf16(PAF(0),VFR(4),o[1],0,0,0), C0,4); \
    KRD(GL,0); GAPB(o[0]=__builtin_amdgcn_mfma_f32_32x32x16_bf16(PAF(1),VFR(1),o[0],0,0,0), C0,8); \
    KRD(GL,1); GAPB(o[1]=__builtin_amdgcn_mfma_f32_32x32x16_bf16(PAF(1),VFR(5),o[1],0,0,0), C0,12); \
    KRD(GL,2); GAPB(o[0]=__builtin_amdgcn_mfma_f32_32x32x16_bf16(PAF(2),VFR(2),o[0],0,0,0), C1,0); \
    KRD(GL,3); GAPB(o[1]=__builtin_amdgcn_mfma_f32_32x32x16_bf16(PAF(2),VFR(6),o[1],0,0,0), C1,4); \
    GAPB(o[0]=__builtin_amdgcn_mfma_f32_32x32x16_bf16(PAF(3),VFR(3),o[0],0,0,0), C1,8); \
    GAPB(o[1]=__builtin_amdgcn_mfma_f32_32x32x16_bf16(PAF(3),VFR(7),o[1],0,0,0), C1,12); \
    }while(0)
  int t=1;
  #undef CMASK
  #define CMASK(P0,P1,t) do{}while(0)
  for(;t+5<NT;t+=2){
    STEP(pB0,pB1,pA0,pA1,t,true,true,true);     WAIT_BAR(2); RESC(); ROT();
    STEP(pA0,pA1,pB0,pB1,t+1,true,true,true);   WAIT_BAR(2); RESC(); ROT();
  }
  #undef CMASK
  #define CMASK(P0,P1,t) do{int jb_=(t)-(NT-4); if(jb_>=0)cmask(P0,P1,jb_,qrel,hi);}while(0)
  #define ENDW(tt) do{ if((tt)+3<NT){WAIT_BAR(2);} else if((tt)+2<NT){WAIT_BAR(1);} else {WAIT_BAR(0);} }while(0)
  for(;t+1<NT;t+=2){
    STEP(pB0,pB1,pA0,pA1,t,(t+3<NT),(t+1<NT),(t+1<NT));       ENDW(t);   RESC(); ROT();
    STEP(pA0,pA1,pB0,pB1,t+1,(t+4<NT),(t+2<NT),(t+2<NT));     ENDW(t+1); RESC(); ROT();
  }
  STEP(pB0,pB1,pA0,pA1,NT-1,false,false,false); RESC();
  { float sacc=pB0[0]+pB0[1]; _Pragma("unroll") for(int r=2;r<16;++r)sacc+=pB0[r]; _Pragma("unroll") for(int r=0;r<16;++r)sacc+=pB1[r]; l_reg+=sacc;
    pw0=(u32x4){PKW(pB0,0),PKW(pB0,2),PKW(pB0,4),PKW(pB0,6)};pw1=(u32x4){PKW(pB0,8),PKW(pB0,10),PKW(pB0,12),PKW(pB0,14)};pw2=(u32x4){PKW(pB1,0),PKW(pB1,2),PKW(pB1,4),PKW(pB1,6)};pw3=(u32x4){PKW(pB1,8),PKW(pB1,10),PKW(pB1,12),PKW(pB1,14)};
    SBAR(); pv(o,vb0+sl_cur,PAF(0),PAF(1),PAF(2),PAF(3)); }
  #undef PKW
  #undef PAF
  #undef VFR
  #undef PIN
  #undef MX3
  #undef GAPA
  #undef GAPB
  #undef EX
  #undef VRD
  #undef KRD
  #undef STEP
  #undef ENDW
  {auto rr=__builtin_amdgcn_permlane32_swap(__float_as_uint(l_reg),__float_as_uint(l_reg),false,false);l_reg=__uint_as_float(rr[0])+__uint_as_float(rr[1]);}
  if(hi==0)wsf[32+r32]=l_reg;asm volatile("s_waitcnt lgkmcnt(0)":::"memory");
  float rli[16];
  #pragma unroll
  for(int r=0;r<16;++r)rli[r]=__builtin_amdgcn_rcpf(wsf[32+crow(r,hi)]);
  bf16*Ow=O+(rowbase+q0+wid*QBLK)*PITO;
  { bf16*stg=(bf16*)(shm+LDS_OST)+wid*2048;
    #pragma unroll
    for(int r=0;r<16;++r){const int orow=crow(r,hi);
      #pragma unroll
      for(int d0=0;d0<2;++d0)stg[orow*64+d0*32+r32]=__float2bfloat16(o[d0][r]*rli[r]);}
    asm volatile("s_waitcnt lgkmcnt(0)":::"memory");
    #pragma unroll
    for(int i=0;i<4;++i){const int row=i*8+(lane>>3),ch=lane&7; const u32x4 v=*(const u32x4*)(stg+row*64+ch*8); ATTN_STORE16(Ow+(long)row*PITO+ch*8,v);} }
  asm volatile("s_waitcnt lgkmcnt(0)\n\ts_barrier":::"memory");
  #undef DMA_K
  #undef DMA_V
  #undef CMASK
  #undef START
  #undef RESC
  #undef ROT
}
constexpr int ATTN_LDS_BYTES=LDS_BYTES;
#undef SBAR
#undef WAIT_BAR
}

namespace cg = cooperative_groups;
typedef unsigned short bf16_t;
typedef float f32x4 __attribute__((ext_vector_type(4)));
typedef float f32x16 __attribute__((ext_vector_type(16)));
typedef unsigned u32x4 __attribute__((ext_vector_type(4)));
typedef unsigned u32x2 __attribute__((ext_vector_type(2)));
typedef short bf16x8 __attribute__((ext_vector_type(8)));
#define LAS3 __attribute__((address_space(3)))

constexpr int T_ = 32768, DM_ = 1024, SEQ_ = 4096, DFF_ = 2816;
constexpr int NTHR = 512;
constexpr int LDS_BYTES = 147456;
constexpr size_t MiB_ = 1u << 20;
constexpr size_t WS_MOD = 0, WS_COS = 1 * MiB_, WS_SIN = 2 * MiB_, WS_BAR = 3 * MiB_;
constexpr size_t WS_WIN = 4 * MiB_, WS_WOUT = 11 * MiB_, WS_FIN = 13 * MiB_, WS_FOUT = 24 * MiB_;
constexpr size_t WS_A = 32 * MiB_, WS_X2 = 96 * MiB_, WS_ST = 160 * MiB_, WS_TOT = 224 * MiB_, WS_R1 = 226 * MiB_, WS_BIAS = 450 * MiB_, WS_ROWSS = 452 * MiB_, WS_FOUT2 = 454 * MiB_, WS_END = 460 * MiB_;
constexpr int BIAS_L = 8 * (3584 + 5632);
constexpr size_t WS_HP = WS_ST, WS_HU = WS_ST + 12 * MiB_, WS_HA = WS_ST + 24 * MiB_;
constexpr float LOG2E_ = 1.4426950408889634f;
constexpr float QSCALE_ = 0.125f * 1.4426950408889634f;

struct Params {
    const float* x; const float* c; const int* positions; const float* mod_w; const float* mod_b; const float* norm_mix_w; const float* norm_ffn_w;
    const float* ev_w_in; const float* gla_gate_w; const float* gla_gate_b; const float* gla_norm_w; const float* swa_sinks; const float* ev_w_out;
    const float* od_w_in; const float* diff_lambda; const float* diff_norm_w; const float* hgrn_lb_logits; const float* hgrn_norm_w; const float* od_w_out;
    const float* ffn_w_in; const float* ffn_conv_w; const float* ffn_conv_b; const float* ffn_w_out; const float* final_norm_w;
    float* out; unsigned char* ws; unsigned long long pad[6];
};

__device__ __forceinline__ unsigned pk2(float lo, float hi) {
    typedef float f32x2_t __attribute__((ext_vector_type(2))); typedef __bf16 bf16x2_t __attribute__((ext_vector_type(2)));
    f32x2_t v = {lo, hi}; bf16x2_t b = __builtin_convertvector(v, bf16x2_t); return __builtin_bit_cast(unsigned, b);
}
__device__ __forceinline__ float bflo(unsigned u) { return __uint_as_float(u << 16); }
__device__ __forceinline__ float bfhi(unsigned u) { return __uint_as_float(u & 0xffff0000u); }
__device__ __forceinline__ float sigmoidf_(float x) { return __builtin_amdgcn_rcpf(1.f + __expf(-x)); }
__device__ __forceinline__ float siluf_(float x) { return x * __builtin_amdgcn_rcpf(1.f + __expf(-x)); }
__device__ __forceinline__ float wave_sum(float v) {
#pragma unroll
    for (int o = 1; o < 64; o <<= 1) v += __shfl_xor(v, o);
    return v;
}
__device__ __forceinline__ int crow_(int r, int hi) { return (r & 3) + 8 * (r >> 2) + 4 * hi; }

namespace pg8 {
struct EpiProj {
    static constexpr bool PERM = true, AFTER_DRAIN = false;
    bf16_t* O; int ldc; unsigned ropemask; unsigned scalemask; float scale; const float* cs; const float* sn; const float* rowss; const float* bias;
    __device__ __forceinline__ void operator()(const f32x4 (&acc)[2][2][4][2], const Unit& u, int, int, int, int) const {
        const int t_ = otid_(), l_ = t_ & 63, fr = l_ & 15, fq = l_ >> 4, wid_ = __builtin_amdgcn_readfirstlane(t_ >> 6), wr = wid_ >> 2, wc = wid_ & 3;
        const int row0 = u.pm * BM + wr * 64 + fr; const int col0 = u.pn * BM + wc * 32 + 8 * fq;
        float rs[2][4];
#pragma unroll
        for (int ai = 0; ai < 2; ++ai)
#pragma unroll
            for (int m = 0; m < 4; ++m) rs[ai][m] = rsqrtf(rowss[row0 + ai * HALF + m * 16] * (1.f / 1024.f) + 1e-6f);
        const float* bp = bias + (size_t)((u.pm * BM) >> 12) * ldc + col0;
#pragma unroll
        for (int bj = 0; bj < 2; ++bj) {
            const f32x4 bv0 = *(const f32x4*)(bp + bj * HALF), bv1 = *(const f32x4*)(bp + bj * HALF + 4);
            const int grp = u.pn * 2 + bj;
            const bool rope = ((ropemask >> grp) & 1u) && ((wc & 1) == 0);
            const float sc = ((scalemask >> grp) & 1u) ? scale : 1.f;
#pragma unroll
            for (int ai = 0; ai < 2; ++ai)
#pragma unroll
                for (int m = 0; m < 4; ++m) {
                    const int row = row0 + ai * HALF + m * 16;
                    f32x4 v0 = acc[ai][bj][m][0] * rs[ai][m] + bv0, v1 = acc[ai][bj][m][1] * rs[ai][m] + bv1;
                    if (rope) {
                        const f32x4 c0 = *(const f32x4*)(cs + (size_t)row * 8), c1 = *(const f32x4*)(cs + (size_t)row * 8 + 4);
                        const f32x4 s0 = *(const f32x4*)(sn + (size_t)row * 8), s1 = *(const f32x4*)(sn + (size_t)row * 8 + 4);
                        const float sg = (fq == 0) ? -1.f : 1.f;
#pragma unroll
                        for (int e = 0; e < 4; ++e) {
                            const float p0 = __shfl_xor(v0[e], 16), p1 = __shfl_xor(v1[e], 16);
                            const float r0 = v0[e] * c0[e] + sg * p0 * s0[e], r1 = v1[e] * c1[e] + sg * p1 * s1[e];
                            if (fq < 2) { v0[e] = r0; v1[e] = r1; }
                        }
                    }
                    v0 = v0 * sc; v1 = v1 * sc;
                    u32x4 w; w.x = pk2(v0[0], v0[1]); w.y = pk2(v0[2], v0[3]); w.z = pk2(v1[0], v1[1]); w.w = pk2(v1[2], v1[3]);
                    *(u32x4*)(O + (size_t)row * ldc + col0 + bj * HALF) = w;
                    asm volatile("" ::: "memory");
                }
        }
    }
};
typedef _Float16 h16x2 __attribute__((ext_vector_type(2)));
__device__ __forceinline__ unsigned pkh2(float lo, float hi) { typedef float f32x2_t __attribute__((ext_vector_type(2))); f32x2_t v = {lo, hi}; return __builtin_bit_cast(unsigned, __builtin_convertvector(v, h16x2)); }
__device__ __forceinline__ f32x4 unpkh4(unsigned w0, unsigned w1) { const h16x2 a = __builtin_bit_cast(h16x2, w0), b = __builtin_bit_cast(h16x2, w1); return (f32x4){(float)a[0], (float)a[1], (float)b[0], (float)b[1]}; }
struct EpiRes {
    static constexpr bool PERM = true, AFTER_DRAIN = false;
    const void* xin; void* xout; int inf32, outf32; const float* gate;
    bf16_t* Aout; const float* nw; const float* sc; float* rowss;
    __device__ __forceinline__ void operator()(const f32x4 (&acc)[2][2][4][2], const Unit& u, int, int, int, int) const {
        const int t_ = otid_(), l_ = t_ & 63, fr = l_ & 15, fq = l_ >> 4, wid_ = __builtin_amdgcn_readfirstlane(t_ >> 6), wr = wid_ >> 2, wc = wid_ & 3;
        const int col0 = u.pn * BM + wc * 32 + 8 * fq;
        const size_t boff = (size_t)((u.pm * BM) >> 12) * 6144 + col0;
        f32x4 gv[2][2];
#pragma unroll
        for (int bj = 0; bj < 2; ++bj)
#pragma unroll
            for (int n = 0; n < 2; ++n) gv[bj][n] = *(const f32x4*)(gate + boff + bj * HALF + n * 4);
        const int rowb = u.pm * BM + wr * 64 + fr;
        const unsigned eo0 = (unsigned)rowb * 1024u + (unsigned)col0;
        const char* xi = (const char*)xin; char* xo = (char*)xout; char* ao = (char*)Aout;
#pragma unroll
        for (int grp = 0; grp < 8; ++grp) {
            const int ai = grp >> 2, m = grp & 3;
            const unsigned eo = eo0 + (unsigned)(ai * HALF + m * 16) * 1024u;
            float ss = 0.f;
#pragma unroll
            for (int bj = 0; bj < 2; ++bj) {
                const unsigned e2 = eo + (unsigned)(bj * HALF);
                f32x4 x0, x1;
                if (inf32) { x0 = *(const f32x4*)(xi + e2 * 4u); x1 = *(const f32x4*)(xi + e2 * 4u + 16u); }
                else { const u32x4 h = *(const u32x4*)(xi + e2 * 2u); x0 = unpkh4(h.x, h.y); x1 = unpkh4(h.z, h.w); }
                const f32x4 xn0 = x0 + gv[bj][0] * acc[ai][bj][m][0], xn1 = x1 + gv[bj][1] * acc[ai][bj][m][1];
                if (outf32) { *(f32x4*)(xo + e2 * 4u) = xn0; *(f32x4*)(xo + e2 * 4u + 16u) = xn1; }
                else { u32x4 h; h.x = pkh2(xn0[0], xn0[1]); h.y = pkh2(xn0[2], xn0[3]); h.z = pkh2(xn1[0], xn1[1]); h.w = pkh2(xn1[2], xn1[3]); *(u32x4*)(xo + e2 * 2u) = h; }
                if (Aout) {
                    ss += ((xn0[0] * xn0[0] + xn0[1] * xn0[1]) + (xn0[2] * xn0[2] + xn0[3] * xn0[3])) + ((xn1[0] * xn1[0] + xn1[1] * xn1[1]) + (xn1[2] * xn1[2] + xn1[3] * xn1[3]));
                    const f32x4 a0 = xn0 * (*(const f32x4*)(nw + col0 + bj * HALF) * (*(const f32x4*)(sc + boff + bj * HALF) + 1.f));
                    const f32x4 a1 = xn1 * (*(const f32x4*)(nw + col0 + bj * HALF + 4) * (*(const f32x4*)(sc + boff + bj * HALF + 4) + 1.f));
                    u32x4 q; q.x = pk2(a0[0], a0[1]); q.y = pk2(a0[2], a0[3]); q.z = pk2(a1[0], a1[1]); q.w = pk2(a1[2], a1[3]);
                    *(u32x4*)(ao + e2 * 2u) = q;
                }
            }
            if (Aout) {
                ss += __shfl_xor(ss, 16); ss += __shfl_xor(ss, 32);
                if (fq == 0) atomicAdd(rowss + rowb + ai * HALF + m * 16, ss);
            }
            asm volatile("" ::: "memory");
        }
    }
};
struct EpiFfn {
    static constexpr bool PERM = true, AFTER_DRAIN = false;
    bf16_t* G; unsigned short* HP; unsigned short* HU; unsigned short* HA;   const float* cw; const float* cb; const float* rowss; const float* bias;
    __device__ __forceinline__ void operator()(const f32x4 (&acc)[2][2][4][2], const Unit& u, int, int, int, int) const {
        const int t_ = otid_(), l_ = t_ & 63, fr = l_ & 15, fq = l_ >> 4, wid_ = __builtin_amdgcn_readfirstlane(t_ >> 6), wr = wid_ >> 2, wc = wid_ & 3;
        const int ch0 = u.pn * 128 + wc * 32 + 8 * fq;
        f32x4 w0[2], w1[2], w2[2], bb[2];
#pragma unroll
        for (int n = 0; n < 2; ++n) { w0[n] = *(const f32x4*)(cw + ch0 + 4 * n); w1[n] = *(const f32x4*)(cw + DFF_ + ch0 + 4 * n); w2[n] = *(const f32x4*)(cw + 2 * DFF_ + ch0 + 4 * n); bb[n] = *(const f32x4*)(cb + ch0 + 4 * n); }
        const int lane = fr + 16 * fq;
        const int src1 = (lane & ~15) | ((fr + 15) & 15), src2 = (lane & ~15) | ((fr + 14) & 15);
        const float* bp = bias + (size_t)((u.pm * BM) >> 12) * 5632 + u.pn * BM + wc * 32 + 8 * fq;
        f32x4 ba[2], bu[2];
#pragma unroll
        for (int n = 0; n < 2; ++n) { ba[n] = *(const f32x4*)(bp + 4 * n); bu[n] = *(const f32x4*)(bp + HALF + 4 * n); }
#pragma unroll
        for (int ai = 0; ai < 2; ++ai) {
            const int seg = u.pm * 4 + ai * 2 + wr;
            f32x4 aprev[2]; aprev[0] = (f32x4){0.f, 0.f, 0.f, 0.f}; aprev[1] = (f32x4){0.f, 0.f, 0.f, 0.f};
#pragma unroll
            for (int m = 0; m < 4; ++m) {
                const int row = u.pm * BM + ai * HALF + wr * 64 + m * 16 + fr;
                const float rs = rsqrtf(rowss[row] * (1.f / 1024.f) + 1e-6f);
                f32x4 val[2], acur[2];
#pragma unroll
                for (int n = 0; n < 2; ++n) {
                    const f32x4 a = acc[ai][0][m][n] * rs + ba[n];
                    acur[n] = a;
                    const f32x4 ap = aprev[n];
#pragma unroll
                    for (int e = 0; e < 4; ++e) {
                        const float t1 = (fr == 15) ? ap[e] : a[e];
                        const float t2 = (fr >= 14) ? ap[e] : a[e];
                        const float p1 = __shfl(t1, src1), p2 = __shfl(t2, src2);
                        val[n][e] = w2[n][e] * a[e] + w1[n][e] * p1 + w0[n][e] * p2 + bb[n][e];
                    }
                }
                const f32x4 u0 = acc[ai][1][m][0] * rs + bu[0], u1 = acc[ai][1][m][1] * rs + bu[1];
                f32x4 g0, g1;
#pragma unroll
                for (int e = 0; e < 4; ++e) { g0[e] = siluf_(val[0][e]) * u0[e]; g1[e] = siluf_(val[1][e]) * u1[e]; }
                u32x4 w; w.x = pk2(g0[0], g0[1]); w.y = pk2(g0[2], g0[3]); w.z = pk2(g1[0], g1[1]); w.w = pk2(g1[2], g1[3]);
                *(u32x4*)(G + (size_t)row * DFF_ + ch0) = w;
                if (m == 0 && fr < 2) {
                    const size_t ho = (size_t)(seg * 2 + fr) * DFF_ + ch0;
                    u32x4 hp; hp.x = pkh2(val[0][0], val[0][1]); hp.y = pkh2(val[0][2], val[0][3]); hp.z = pkh2(val[1][0], val[1][1]); hp.w = pkh2(val[1][2], val[1][3]);
                    u32x4 hu; hu.x = pkh2(u0[0], u0[1]); hu.y = pkh2(u0[2], u0[3]); hu.z = pkh2(u1[0], u1[1]); hu.w = pkh2(u1[2], u1[3]);
                    *(u32x4*)(HP + ho) = hp; *(u32x4*)(HU + ho) = hu;
                }
                if (m == 3 && fr >= 14) {
                    const size_t ho = (size_t)(seg * 2 + (fr - 14)) * DFF_ + ch0;
                    u32x4 ha; ha.x = pkh2(acur[0][0], acur[0][1]); ha.y = pkh2(acur[0][2], acur[0][3]); ha.z = pkh2(acur[1][0], acur[1][1]); ha.w = pkh2(acur[1][2], acur[1][3]);
                    *(u32x4*)(HA + ho) = ha;
                }
                aprev[0] = acur[0]; aprev[1] = acur[1];
                asm volatile("" ::: "memory");
            }
        }
    }
};
}

struct Ctx { Params p; unsigned char* lds; int tid, lane, wave, gw, ngw; };

__device__ __forceinline__ void phase_prologue(const Ctx& C) {
    const Params& p = C.p;
    float* cact = (float*)C.lds;
    float* red = (float*)(C.lds + 32768);
    float* mod = (float*)(p.ws + WS_MOD);
    const int tid = C.tid;
    for (int i = tid; i < 8192; i += NTHR) { const float c = p.c[i]; cact[i] = c / (1.f + __expf(-c)); }
    __syncthreads();
    const int col = tid & 63, kp = tid >> 6;
    for (int g = blockIdx.x; g < 384; g += gridDim.x) {
        const int l = g / 96, j = (g % 96) * 64 + col;
        const float* w = p.mod_w + (size_t)l * 1024 * 6144 + (size_t)(kp * 128) * 6144 + j;
        float a0 = 0.f, a1 = 0.f, a2 = 0.f, a3 = 0.f, a4 = 0.f, a5 = 0.f, a6 = 0.f, a7 = 0.f;
        const float* ca = cact + kp * 128;
#pragma unroll 8
        for (int k = 0; k < 128; ++k) {
            const float wv = w[(size_t)k * 6144];
            a0 += ca[k] * wv; a1 += ca[1024 + k] * wv; a2 += ca[2048 + k] * wv; a3 += ca[3072 + k] * wv;
            a4 += ca[4096 + k] * wv; a5 += ca[5120 + k] * wv; a6 += ca[6144 + k] * wv; a7 += ca[7168 + k] * wv;
        }
        float* r = red + (kp * 8) * 64 + col;
        r[0] = a0; r[64] = a1; r[128] = a2; r[192] = a3; r[256] = a4; r[320] = a5; r[384] = a6; r[448] = a7;
        __syncthreads();
        { const int b = tid >> 6; float s = 0.f;
#pragma unroll
          for (int kk = 0; kk < 8; ++kk) s += red[(kk * 8 + b) * 64 + col];
          mod[(size_t)(l * 8 + b) * 6144 + j] = s + p.mod_b[l * 6144 + j]; }
        __syncthreads();
    }
    {
        u32x4* zr = (u32x4*)(p.ws + WS_ROWSS);
        for (int i = blockIdx.x * NTHR + tid; i < 8 * T_ * 4 / 16; i += gridDim.x * NTHR) zr[i] = (u32x4){0u, 0u, 0u, 0u};
    }
    float* cs = (float*)(p.ws + WS_COS); float* sn = (float*)(p.ws + WS_SIN);
    const float invf[8] = {1.0f, 0.1939227432012558f, 0.03760603070259094f, 0.007292664609849453f, 0.0014142135623842478f, 0.00027424818836152554f, 5.3182957344688475e-05f, 1.0313385246263351e-05f};
    for (int r = blockIdx.x * NTHR + tid; r < T_; r += gridDim.x * NTHR) {
        const float pos = (float)p.positions[r];
        f32x4 c4[2], s4[2];
#pragma unroll
        for (int i = 0; i < 8; ++i) {
            const float ang = pos * invf[i];
            const double xr = (double)ang * 0.15915494309189535;
            const float f = (float)(xr - rint(xr));
            c4[i >> 2][i & 3] = __builtin_amdgcn_cosf(f); s4[i >> 2][i & 3] = __builtin_amdgcn_sinf(f);
        }
        *(f32x4*)(cs + (size_t)r * 8) = c4[0]; *(f32x4*)(cs + (size_t)r * 8 + 4) = c4[1];
        *(f32x4*)(sn + (size_t)r * 8) = s4[0]; *(f32x4*)(sn + (size_t)r * 8 + 4) = s4[1];
    }
}

__device__ __forceinline__ void tr_item(const float* W, int Nsrc, int srccol0, bf16_t* WT, int K, int dstrow0, int k0, float* scr, int lane) {
    float wv[32];
#pragma unroll
    for (int i = 0; i < 32; ++i) wv[i] = W[(size_t)(k0 + 2 * i + (lane >> 5)) * Nsrc + srccol0 + (lane & 31)];
#pragma unroll
    for (int i = 0; i < 32; ++i) scr[(2 * i + (lane >> 5)) * 33 + (lane & 31)] = wv[i];
    asm volatile("s_waitcnt lgkmcnt(0)" ::: "memory");
    const int c = lane & 7;
#pragma unroll
    for (int j = 0; j < 4; ++j) { const int n = (lane >> 3) + 8 * j; const float* s = scr + (8 * c) * 33 + n;
        u32x4 o; o.x = pk2(s[0 * 33], s[1 * 33]); o.y = pk2(s[2 * 33], s[3 * 33]); o.z = pk2(s[4 * 33], s[5 * 33]); o.w = pk2(s[6 * 33], s[7 * 33]);
        *(u32x4*)(WT + (size_t)(dstrow0 + n) * K + k0 + 8 * c) = o; }
    asm volatile("s_waitcnt lgkmcnt(0)" ::: "memory");
}
__device__ __forceinline__ void phase_convert(const Ctx& C, int l, bool do_bias = true) {
    const Params& p = C.p; const int j = l >> 1; const bool even = !(l & 1);
    float* scr = (float*)(C.lds + C.wave * 8704);
    bf16_t* WIN = (bf16_t*)(p.ws + WS_WIN); bf16_t* WOUT = (bf16_t*)(p.ws + WS_WOUT); bf16_t* FIN = (bf16_t*)(p.ws + WS_FIN); bf16_t* FOUT = (bf16_t*)(p.ws + ((l & 1) ? WS_FOUT2 : WS_FOUT));
    const int nA = even ? 80 : 112;
    const int IA = 16 * nA, IB = 16 * 32, IC = 16 * 176, ID = 44 * 32;
    const float* win = even ? p.ev_w_in + (size_t)j * 1024 * 2320 : p.od_w_in + (size_t)j * 1024 * 3584;
    const float* wout = even ? p.ev_w_out + (size_t)j * 1024 * 1024 : p.od_w_out + (size_t)j * 1024 * 1024;
    const float* fin = p.ffn_w_in + (size_t)l * 1024 * 5632; const float* fout = p.ffn_w_out + (size_t)l * 2816 * 1024;
    for (int it = C.gw; it < IA + IB + IC + ID; it += C.ngw) {
        int r = it;
        if (r < IA) { const int kb = r / nA, nb = r % nA, n0 = nb * 32; int sc = n0;
            if (even) { if (n0 >= 512 && n0 < 768) continue; if (n0 >= 1792) sc = n0 - 240; else if (n0 >= 768) sc = n0 - 256; }
            tr_item(win, even ? 2320 : 3584, sc, WIN, 1024, n0, kb * 64, scr, C.lane); continue; }
        r -= IA;
        if (r < IB) { const int kb = r / 32, nb = r % 32; tr_item(wout, 1024, nb * 32, WOUT, 1024, nb * 32, kb * 64, scr, C.lane); continue; }
        r -= IB;
        if (r < IC) { const int kb = r / 176, nb = r % 176, n0 = nb * 32; const int pn = n0 >> 8, jj = n0 & 255;
            const int sc = (jj < 128) ? pn * 128 + jj : 2816 + pn * 128 + (jj - 128);
            tr_item(fin, 5632, sc, FIN, 1024, n0, kb * 64, scr, C.lane); continue; }
        r -= IC;
        { const int kb = r / 32, nb = r % 32; tr_item(fout, 1024, nb * 32, FOUT, 2816, nb * 32, kb * 64, scr, C.lane); }
    }
    if (do_bias) {
        float* shl = (float*)(C.lds + 69632);
        const float* modl = (const float*)(p.ws + WS_MOD) + (size_t)l * 8 * 6144;
        __syncthreads();
        for (int i2 = C.tid; i2 < 2 * 8192; i2 += NTHR) { const int which = i2 >> 13, k = (i2 >> 3) & 1023, b = i2 & 7; shl[i2] = modl[(size_t)b * 6144 + (which ? 3072 : 0) + k]; }
        __syncthreads();
        float* bias_in = (float*)(p.ws + WS_BIAS) + (size_t)l * BIAS_L; float* bias_ff = bias_in + 8 * 3584;
        const int Nin = even ? 2560 : 3584, Nsrc = even ? 2320 : 3584;
        const float* gwp = p.gla_gate_w + (size_t)j * 16 * 256;
        for (int u = blockIdx.x * NTHR + C.tid; u < (Nin + 5632) * 16; u += gridDim.x * NTHR) {
            const bool ff = u >= Nin * 16; const int uu = ff ? u - Nin * 16 : u, N = ff ? 5632 : Nin, n = uu % N, kp = uu / N;
            float a[8];
#pragma unroll
            for (int b = 0; b < 8; ++b) a[b] = 0.f;
            const float* shp = shl + (ff ? 8192 : 0) + kp * 64 * 8;
            if (!ff && even && n >= 512 && n < 768) {
                float g[16];
#pragma unroll
                for (int r = 0; r < 16; ++r) g[r] = gwp[r * 256 + (n - 512)];
                for (int k = 0; k < 64; ++k) {
                    const float* wr = win + (size_t)(kp * 64 + k) * 2320 + 1536;
                    float wv = 0.f;
#pragma unroll
                    for (int r = 0; r < 16; ++r) wv += wr[r] * g[r];
                    const f32x4 s0 = *(const f32x4*)(shp + k * 8), s1 = *(const f32x4*)(shp + k * 8 + 4);
                    a[0] += s0[0] * wv; a[1] += s0[1] * wv; a[2] += s0[2] * wv; a[3] += s0[3] * wv; a[4] += s1[0] * wv; a[5] += s1[1] * wv; a[6] += s1[2] * wv; a[7] += s1[3] * wv;
                }
            } else {
                int sc; const float* W; int Ns;
                if (ff) { const int pn = n >> 8, jj = n & 255; sc = (jj < 128) ? pn * 128 + jj : 2816 + pn * 128 + (jj - 128); W = fin; Ns = 5632; }
                else { sc = n; if (even) { if (n >= 1792) sc = n - 240; else if (n >= 768) sc = n - 256; } W = win; Ns = Nsrc; }
                const float* wp = W + (size_t)(kp * 64) * Ns + sc;
#pragma unroll 8
                for (int k = 0; k < 64; ++k) {
                    const float wv = wp[(size_t)k * Ns];
                    const f32x4 s0 = *(const f32x4*)(shp + k * 8), s1 = *(const f32x4*)(shp + k * 8 + 4);
                    a[0] += s0[0] * wv; a[1] += s0[1] * wv; a[2] += s0[2] * wv; a[3] += s0[3] * wv; a[4] += s1[0] * wv; a[5] += s1[1] * wv; a[6] += s1[2] * wv; a[7] += s1[3] * wv;
                }
            }
            float* bo = (ff ? bias_ff : bias_in) + n;
#pragma unroll
            for (int b = 0; b < 8; ++b) atomicAdd(bo + (size_t)b * N, a[b]);
        }
    }
    if (even) {
        const float* gw = p.gla_gate_w + (size_t)j * 16 * 256;
        for (int u = blockIdx.x * NTHR + C.tid; u < 256 * 128; u += gridDim.x * NTHR) {
            const int k8 = u & 127, n = u >> 7;
            float g[16];
#pragma unroll
            for (int r = 0; r < 16; ++r) g[r] = gw[r * 256 + n];
            float o[8];
#pragma unroll
            for (int e = 0; e < 8; ++e) {
                const float* wr = win + (size_t)(k8 * 8 + e) * 2320 + 1536;
                const f32x4 a0 = *(const f32x4*)wr, a1 = *(const f32x4*)(wr + 4), a2 = *(const f32x4*)(wr + 8), a3 = *(const f32x4*)(wr + 12);
                o[e] = a0[0] * g[0] + a0[1] * g[1] + a0[2] * g[2] + a0[3] * g[3] + a1[0] * g[4] + a1[1] * g[5] + a1[2] * g[6] + a1[3] * g[7]
                     + a2[0] * g[8] + a2[1] * g[9] + a2[2] * g[10] + a2[3] * g[11] + a3[0] * g[12] + a3[1] * g[13] + a3[2] * g[14] + a3[3] * g[15];
            }
            u32x4 w; w.x = pk2(o[0], o[1]); w.y = pk2(o[2], o[3]); w.z = pk2(o[4], o[5]); w.w = pk2(o[6], o[7]);
            *(u32x4*)(WIN + (size_t)(512 + n) * 1024 + k8 * 8) = w;
        }
    }
}

__device__ __forceinline__ void phase_bias_wt(const Ctx& C, int l) {
    const Params& p = C.p; const bool even = !(l & 1);
    const float* modl = (const float*)(p.ws + WS_MOD) + (size_t)l * 8 * 6144;
    float* bias_in = (float*)(p.ws + WS_BIAS) + (size_t)l * BIAS_L; float* bias_ff = bias_in + 8 * 3584;
#pragma unroll 1
    for (int which = 0; which < 2; ++which) {
        const bf16_t* WT = (const bf16_t*)(p.ws + (which ? WS_FIN : WS_WIN)); const int N = which ? 5632 : (even ? 2560 : 3584);
        float* bo = which ? bias_ff : bias_in;
        f32x4 sh[8][4];
#pragma unroll
        for (int b = 0; b < 8; ++b)
#pragma unroll
            for (int q = 0; q < 4; ++q) sh[b][q] = *(const f32x4*)(modl + (size_t)b * 6144 + (which ? 3072 : 0) + 16 * C.lane + 4 * q);
        for (int n = C.gw; n < N; n += C.ngw) {
            const u32x4 w0 = *(const u32x4*)(WT + (size_t)n * 1024 + 16 * C.lane), w1 = *(const u32x4*)(WT + (size_t)n * 1024 + 16 * C.lane + 8);
            const f32x4 wa = (f32x4){bflo(w0.x), bfhi(w0.x), bflo(w0.y), bfhi(w0.y)}, wb = (f32x4){bflo(w0.z), bfhi(w0.z), bflo(w0.w), bfhi(w0.w)};
            const f32x4 wc = (f32x4){bflo(w1.x), bfhi(w1.x), bflo(w1.y), bfhi(w1.y)}, wd = (f32x4){bflo(w1.z), bfhi(w1.z), bflo(w1.w), bfhi(w1.w)};
            float mine = 0.f;
#pragma unroll
            for (int b = 0; b < 8; ++b) {
                const f32x4 t = sh[b][0] * wa + sh[b][1] * wb + sh[b][2] * wc + sh[b][3] * wd;
                const float s = wave_sum((t[0] + t[1]) + (t[2] + t[3]));
                if (C.lane == b) mine = s;
            }
            if (C.lane < 8) bo[(size_t)C.lane * N + n] = mine;
        }
    }
}

__device__ __forceinline__ void phase_prep(const Ctx& C, const float* xin, const float* w, const float* modl, int scoff, bf16_t* out, float* rowss) {
    for (int row = C.gw; row < T_; row += C.ngw) {
        const f32x4* xr = (const f32x4*)(xin + (size_t)row * 1024) + C.lane;
        f32x4 v[4]; float ss = 0.f;
#pragma unroll
        for (int j = 0; j < 4; ++j) { v[j] = xr[64 * j]; ss += (v[j].x * v[j].x + v[j].y * v[j].y) + (v[j].z * v[j].z + v[j].w * v[j].w); }
        ss = wave_sum(ss);
        if (C.lane == 0) rowss[row] = ss;
        const float* mb = modl + (size_t)(row >> 12) * 6144;
        u32x2* o8 = (u32x2*)(out + (size_t)row * 1024) + C.lane;
#pragma unroll
        for (int j = 0; j < 4; ++j) {
            const int col = 4 * C.lane + 256 * j;
            const f32x4 w4 = *(const f32x4*)(w + col), sc = *(const f32x4*)(mb + scoff + col);
            const f32x4 y = v[j] * w4 * (sc + 1.f);
            u32x2 q; q.x = pk2(y.x, y.y); q.y = pk2(y.z, y.w); o8[64 * j] = q;
        }
    }
}
__device__ __forceinline__ void phase_final_norm(const Ctx& C, const void* xin  , float* out, const float* w) {
    for (int row = C.gw; row < T_; row += C.ngw) {
        const u32x2* xr = (const u32x2*)((const char*)xin + (size_t)row * 2048) + C.lane;
        f32x4* orow = (f32x4*)(out + (size_t)row * 1024) + C.lane;
        f32x4 v[4]; float ss = 0.f;
#pragma unroll
        for (int j = 0; j < 4; ++j) { const u32x2 h = xr[64 * j]; v[j] = pg8::unpkh4(h.x, h.y); ss += (v[j].x * v[j].x + v[j].y * v[j].y) + (v[j].z * v[j].z + v[j].w * v[j].w); }
        const float rs = rsqrtf(wave_sum(ss) * (1.f / 1024.f) + 1e-6f);
#pragma unroll
        for (int j = 0; j < 4; ++j) { const f32x4 w4 = *(const f32x4*)(w + 4 * C.lane + 256 * j); orow[64 * j] = (v[j] * rs) * w4; }
    }
}

__device__ __forceinline__ void phase_diff_combine(const Ctx& C, int l) {
    const Params& p = C.p; const int j = l >> 1;
    const float lam_init = 0.8f - 0.6f * expf(-0.3f * (float)l);
    const float* lv = p.diff_lambda + j * 256;
    const float s1 = wave_sum(lv[C.lane] * lv[64 + C.lane]), s2 = wave_sum(lv[128 + C.lane] * lv[192 + C.lane]);
    const float lam = expf(s1) - expf(s2) + lam_init;
    const bf16_t* X2 = (const bf16_t*)(p.ws + WS_X2); bf16_t* A = (bf16_t*)(p.ws + WS_A);
    const int head = C.lane >> 4, d0 = (C.lane & 15) * 8;
    const float* nw = p.diff_norm_w + j * 128 + d0;
    const f32x4 n0 = *(const f32x4*)nw, n1 = *(const f32x4*)(nw + 4);
    const float og = 1.f - lam_init;
    for (int row = C.gw; row < T_; row += C.ngw) {
        const bf16_t* src = X2 + (size_t)row * 1024 + head * 256 + d0;
        const u32x4 a = *(const u32x4*)src, b = *(const u32x4*)(src + 128);
        float od[8];
        od[0] = bflo(a.x) - lam * bflo(b.x); od[1] = bfhi(a.x) - lam * bfhi(b.x); od[2] = bflo(a.y) - lam * bflo(b.y); od[3] = bfhi(a.y) - lam * bfhi(b.y);
        od[4] = bflo(a.z) - lam * bflo(b.z); od[5] = bfhi(a.z) - lam * bfhi(b.z); od[6] = bflo(a.w) - lam * bflo(b.w); od[7] = bfhi(a.w) - lam * bfhi(b.w);
        float ss = 0.f;
#pragma unroll
        for (int e = 0; e < 8; ++e) ss += od[e] * od[e];
        ss += __shfl_xor(ss, 1); ss += __shfl_xor(ss, 2); ss += __shfl_xor(ss, 4); ss += __shfl_xor(ss, 8);
        const float rs = rsqrtf(ss * (1.f / 128.f) + 1e-6f) * og;
        u32x4 w; w.x = pk2(od[0] * rs * n0[0], od[1] * rs * n0[1]); w.y = pk2(od[2] * rs * n0[2], od[3] * rs * n0[3]);
        w.z = pk2(od[4] * rs * n1[0], od[5] * rs * n1[1]); w.w = pk2(od[6] * rs * n1[2], od[7] * rs * n1[3]);
        *(u32x4*)(A + (size_t)row * 1024 + head * 128 + d0) = w;
    }
}

__device__ __forceinline__ void phase_ffn_fixup(const Ctx& C, int l) {
    const Params& p = C.p;
    const unsigned short* HP = (const unsigned short*)(p.ws + WS_HP); const unsigned short* HU = (const unsigned short*)(p.ws + WS_HU); const unsigned short* HA = (const unsigned short*)(p.ws + WS_HA);
    bf16_t* G = (bf16_t*)(p.ws + WS_R1);
    const float* cw = p.ffn_conv_w + (size_t)l * 3 * DFF_;
    for (int u = blockIdx.x * NTHR + C.tid; u < 512 * 2 * 704; u += gridDim.x * NTHR) {
        const int c4 = u % 704, sj = u / 704, jj = sj & 1, seg = sj >> 1, ch = c4 * 4;
        const size_t ho = (size_t)sj * DFF_ + ch;
        const u32x2 hv = *(const u32x2*)(HP + ho), hu = *(const u32x2*)(HU + ho);
        f32x4 val = pg8::unpkh4(hv.x, hv.y); const f32x4 uu = pg8::unpkh4(hu.x, hu.y);
        if ((seg & 63) != 0) {
            const u32x2 h1 = *(const u32x2*)(HA + (size_t)((seg - 1) * 2 + 1) * DFF_ + ch), h2 = *(const u32x2*)(HA + (size_t)((seg - 1) * 2) * DFF_ + ch);
            const f32x4 am1 = pg8::unpkh4(h1.x, h1.y), am2 = pg8::unpkh4(h2.x, h2.y);
            const f32x4 w0 = *(const f32x4*)(cw + ch), w1 = *(const f32x4*)(cw + DFF_ + ch);
            if (jj == 0) val = val + w1 * am1 + w0 * am2; else val = val + w0 * am1;
        }
        u32x2 q; q.x = pk2(siluf_(val.x) * uu.x, siluf_(val.y) * uu.y); q.y = pk2(siluf_(val.z) * uu.z, siluf_(val.w) * uu.w);
        *(u32x2*)(G + (size_t)(seg * 64 + jj) * DFF_ + ch) = q;
    }
}

__device__ __forceinline__ void phase_swa(const Ctx& C, int l) {
    const Params& p = C.p;
    const bf16_t* proj = (const bf16_t*)(p.ws + WS_R1); bf16_t* A = (bf16_t*)(p.ws + WS_A);
    bf16_t* Ks = (bf16_t*)C.lds;
    bf16_t* Vt = (bf16_t*)(C.lds + 27648);
    const int tid = C.tid, lane = C.lane, wid = C.wave, r32 = lane & 31, hi = lane >> 5;
    const float* sinks = p.swa_sinks + (l >> 1) * 8;
    u32x4 kreg[3], vreg[3];
#define SWA_FETCH(uu) do { const int b_ = (uu) >> 7, kvh_ = ((uu) >> 6) & 1, q0_ = ((uu) & 63) * 64; const size_t rb_ = (size_t)b_ * SEQ_; \
        _Pragma("unroll") for (int i_ = 0; i_ < 3; ++i_) { const int c_ = tid + i_ * NTHR; \
            { const int kk_ = c_ >> 3, ch_ = c_ & 7, pl_ = q0_ - 128 + kk_; kreg[i_] = (u32x4){0u, 0u, 0u, 0u}; if (pl_ >= 0) kreg[i_] = *(const u32x4*)(proj + (rb_ + pl_) * 2560 + 2304 + kvh_ * 64 + ch_ * 8); } \
            { const int kk_ = c_ % 192, ch_ = c_ / 192, pl_ = q0_ - 128 + kk_; vreg[i_] = (u32x4){0u, 0u, 0u, 0u}; if (pl_ >= 0) vreg[i_] = *(const u32x4*)(proj + (rb_ + pl_) * 2560 + 2432 + kvh_ * 64 + ch_ * 8); } } } while (0)
    if ((int)blockIdx.x < 1024) SWA_FETCH((int)blockIdx.x);
    for (int u = blockIdx.x; u < 1024; u += gridDim.x) {
        const int b = u >> 7, kvh = (u >> 6) & 1, qb = u & 63, q0 = qb * 64; const size_t rowbase = (size_t)b * SEQ_;
#pragma unroll
        for (int i = 0; i < 3; ++i) {
            const int c = tid + i * NTHR;
            { const int kk = c >> 3, ch = c & 7; *(u32x4*)(Ks + kk * 72 + ch * 8) = kreg[i]; }
            { const int kk = c % 192, ch = c / 192; const u32x4 vv = vreg[i];
              bf16_t* vd = Vt + (ch * 8) * 200 + kk;
              vd[0] = (bf16_t)(vv.x & 0xffffu); vd[200] = (bf16_t)(vv.x >> 16); vd[400] = (bf16_t)(vv.y & 0xffffu); vd[600] = (bf16_t)(vv.y >> 16);
              vd[800] = (bf16_t)(vv.z & 0xffffu); vd[1000] = (bf16_t)(vv.z >> 16); vd[1200] = (bf16_t)(vv.w & 0xffffu); vd[1400] = (bf16_t)(vv.w >> 16); }
        }
        { const int nx = u + (int)gridDim.x; if (nx < 1024) SWA_FETCH(nx); }
        __syncthreads();
        const int g = wid >> 1, qh = kvh * 4 + g, qhalf = wid & 1, pq = q0 + 32 * qhalf + r32;
        const bf16_t* qsrc = proj + (rowbase + pq) * 2560 + 1792 + qh * 64;
        bf16x8 qr[4];
#pragma unroll
        for (int d0 = 0; d0 < 4; ++d0) qr[d0] = *(const bf16x8*)(qsrc + d0 * 16 + hi * 8);
        f32x16 s[5];
#pragma unroll
        for (int t = 0; t < 5; ++t) {
            f32x16 a = {};
#pragma unroll
            for (int d0 = 0; d0 < 4; ++d0) {
                const bf16x8 kf = *(const bf16x8*)(Ks + (32 * (qhalf + t) + r32) * 72 + d0 * 16 + hi * 8);
                a = __builtin_amdgcn_mfma_f32_32x32x16_bf16(kf, qr[d0], a, 0, 0, 0);
            }
            s[t] = a;
        }
        const float sink2 = sinks[qh] * LOG2E_;
        float mx = sink2;
#pragma unroll
        for (int t = 0; t < 5; ++t)
#pragma unroll
            for (int r = 0; r < 16; ++r) {
                const int pk = q0 - 128 + 32 * (qhalf + t) + crow_(r, hi);
                const bool valid = (pk >= 0) && (pk <= pq) && (pq - pk < 128);
                const float v = valid ? s[t][r] : -INFINITY; s[t][r] = v; mx = fmaxf(mx, v);
            }
        mx = fmaxf(mx, __shfl_xor(mx, 32));
        float sum = 0.f;
#pragma unroll
        for (int t = 0; t < 5; ++t)
#pragma unroll
            for (int r = 0; r < 16; ++r) { const float e = __builtin_amdgcn_exp2f(s[t][r] - mx); s[t][r] = e; sum += e; }
        sum += __shfl_xor(sum, 32);
        sum += __builtin_amdgcn_exp2f(sink2 - mx);
        const float inv = 1.f / sum;
        f32x16 o[2]; o[0] = f32x16{}; o[1] = f32x16{};
#pragma unroll
        for (int t = 0; t < 5; ++t)
#pragma unroll
            for (int ss = 0; ss < 2; ++ss) {
                u32x4 pw; pw.x = pk2(s[t][8 * ss + 0], s[t][8 * ss + 1]); pw.y = pk2(s[t][8 * ss + 2], s[t][8 * ss + 3]); pw.z = pk2(s[t][8 * ss + 4], s[t][8 * ss + 5]); pw.w = pk2(s[t][8 * ss + 6], s[t][8 * ss + 7]);
                const bf16x8 pf = __builtin_bit_cast(bf16x8, pw);
#pragma unroll
                for (int dt = 0; dt < 2; ++dt) {
                    const bf16_t* vp = Vt + (32 * dt + r32) * 200 + 32 * (qhalf + t) + 16 * ss + 4 * hi;
                    const u32x2 lo = *(const u32x2*)vp, h2 = *(const u32x2*)(vp + 8);
                    u32x4 vw; vw.x = lo.x; vw.y = lo.y; vw.z = h2.x; vw.w = h2.y;
                    o[dt] = __builtin_amdgcn_mfma_f32_32x32x16_bf16(__builtin_bit_cast(bf16x8, vw), pf, o[dt], 0, 0, 0);
                }
            }
        bf16_t* orow = A + (rowbase + pq) * 1024 + 512 + qh * 64;
#pragma unroll
        for (int dt = 0; dt < 2; ++dt)
#pragma unroll
            for (int g4 = 0; g4 < 4; ++g4) {
                u32x2 q; q.x = pk2(o[dt][4 * g4] * inv, o[dt][4 * g4 + 1] * inv); q.y = pk2(o[dt][4 * g4 + 2] * inv, o[dt][4 * g4 + 3] * inv);
                *(u32x2*)(orow + 32 * dt + 8 * g4 + 4 * hi) = q;
            }
        __syncthreads();
    }
}

template <int MODE> struct LaCfg {
    static constexpr int DK = MODE ? 128 : 64, LQ = DK + 8, LG = DK + 4, PITCH = MODE ? 3584 : 2560, NG = DK / 8;
    static constexpr int QCOL = MODE ? 1536 : 0, KCOL = MODE ? 0 : 256, ZCOL = MODE ? 2048 : 512, VCOL = MODE ? 2560 : 768, GCOL = MODE ? 3072 : 1280, OCOL = MODE ? 512 : 0;
    static constexpr int O_QB = 0, O_KB = O_QB + 64 * LQ * 2, O_GF = O_KB + 64 * LQ * 2, O_VT = O_GF + 64 * LG * 4, O_SC = O_VT + 128 * 72 * 2, O_QE = O_SC + 64 * 72 * 2,
                         O_KT = O_QE + 64 * LQ * 2  , O_SEG = O_KT + DK * 72 * 2, O_RED = O_SEG + 8 * 128 * 4, O_PAR = O_RED + 8 * 64 * 4, O_END = O_PAR + 128 * 4;
    static_assert(O_END <= LDS_BYTES, "LA LDS map");
};
__device__ __forceinline__ void unpack8(const u32x4 w, float (&f)[8]) { f[0] = bflo(w.x); f[1] = bfhi(w.x); f[2] = bflo(w.y); f[3] = bfhi(w.y); f[4] = bflo(w.z); f[5] = bfhi(w.z); f[6] = bflo(w.w); f[7] = bfhi(w.w); }
__device__ __forceinline__ u32x4 pack8(const float (&f)[8]) { u32x4 w; w.x = pk2(f[0], f[1]); w.y = pk2(f[2], f[3]); w.z = pk2(f[4], f[5]); w.w = pk2(f[6], f[7]); return w; }
__device__ __forceinline__ void ld8f(const float* p, float (&f)[8]) { const f32x4 a = *(const f32x4*)p, b = *(const f32x4*)(p + 4); f[0] = a[0]; f[1] = a[1]; f[2] = a[2]; f[3] = a[3]; f[4] = b[0]; f[5] = b[1]; f[6] = b[2]; f[7] = b[3]; }

template <int MODE> struct LaRaw { static constexpr int NI = 64 * LaCfg<MODE>::NG / NTHR; u32x4 z[NI], k[NI], q[NI], v[2]; };
template <int MODE, bool NEEDQ> __device__ __forceinline__ void la_fetch(const Ctx& C, int b, int h, int c, LaRaw<MODE>& R) {
    typedef LaCfg<MODE> Cf; const bf16_t* proj = (const bf16_t*)(C.p.ws + WS_R1);
    const size_t row0 = (size_t)b * SEQ_ + (size_t)c * 64;
#pragma unroll
    for (int it = 0; it < LaRaw<MODE>::NI; ++it) {
        const int u = C.tid + it * NTHR, r = u / Cf::NG, kk = (u % Cf::NG) * 8;
        const bf16_t* rp = proj + (row0 + r) * Cf::PITCH + h * Cf::DK + kk;
        R.z[it] = *(const u32x4*)(rp + Cf::ZCOL);
        if (MODE == 0) R.k[it] = *(const u32x4*)(rp + Cf::KCOL);
        if (NEEDQ) R.q[it] = *(const u32x4*)(rp + Cf::QCOL);
    }
#pragma unroll
    for (int it = 0; it < 2; ++it) {
        const int u = C.tid + it * NTHR, r = u & 63, g8 = u >> 6;
        R.v[it] = *(const u32x4*)(proj + (row0 + r) * Cf::PITCH + Cf::VCOL + h * 128 + g8 * 8);
    }
}
template <int MODE, bool NEEDQ> __device__ __forceinline__ void la_store(const Ctx& C, const LaRaw<MODE>& R, const float* par, bf16_t* Qb, bf16_t* Kb, float* Gf, bf16_t* Vt) {
    typedef LaCfg<MODE> Cf;
#pragma unroll
    for (int it = 0; it < LaRaw<MODE>::NI; ++it) {
        const int u = C.tid + it * NTHR, r = u / Cf::NG, kk = (u % Cf::NG) * 8;
        float z[8], kv[8], lg[8], pc[8];
        unpack8(R.z[it], z); ld8f(par + kk, pc);
        if (MODE == 0) {
            unpack8(R.k[it], kv);
#pragma unroll
            for (int e = 0; e < 8; ++e) { const float x = z[e] + pc[e]; lg[e] = (fminf(x, 0.f) * LOG2E_ - __log2f(1.f + __expf(-fabsf(x)))) * (1.f / 16.f); }
        } else {
#pragma unroll
            for (int e = 0; e < 8; ++e) {
                const float zz = fminf(fmaxf(z[e], -60.f), 60.f), ez = __expf(-zz), sg = __builtin_amdgcn_rcpf(1.f + ez), lb = pc[e];
                lg[e] = __log2f(lb + (1.f - lb) * sg); kv[e] = (1.f - lb) * (ez * sg);
            }
        }
        *(u32x4*)(Kb + r * Cf::LQ + kk) = pack8(kv);
        float* gd = Gf + r * Cf::LG + kk;
        *(f32x4*)gd = (f32x4){lg[0], lg[1], lg[2], lg[3]}; *(f32x4*)(gd + 4) = (f32x4){lg[4], lg[5], lg[6], lg[7]};
        if (NEEDQ) {
            float q[8]; unpack8(R.q[it], q);
#pragma unroll
            for (int e = 0; e < 8; ++e) q[e] = MODE ? siluf_(q[e]) * 0.08838834764831845f : q[e] * 0.125f;
            *(u32x4*)(Qb + r * Cf::LQ + kk) = pack8(q);
        }
    }
#pragma unroll
    for (int it = 0; it < 2; ++it) {
        const int u = C.tid + it * NTHR, r = u & 63, g8 = u >> 6;
        const u32x4 w = R.v[it];
        bf16_t* vd = Vt + (g8 * 8) * 72 + r;
        vd[0] = (bf16_t)(w.x & 0xffffu); vd[72] = (bf16_t)(w.x >> 16); vd[144] = (bf16_t)(w.y & 0xffffu); vd[216] = (bf16_t)(w.y >> 16);
        vd[288] = (bf16_t)(w.z & 0xffffu); vd[360] = (bf16_t)(w.z >> 16); vd[432] = (bf16_t)(w.w & 0xffffu); vd[504] = (bf16_t)(w.w >> 16);
    }
}
template <int MODE> __device__ __forceinline__ void la_params(const Ctx& C, int l, int h, float* par) {
    typedef LaCfg<MODE> Cf; const int j = l >> 1;
    if (C.tid < Cf::DK) {
        if (MODE == 0) par[C.tid] = C.p.gla_gate_b[j * 256 + h * 64 + C.tid];
        else { const float* lg0 = C.p.hgrn_lb_logits + h * 128 + C.tid; par[C.tid] = (j == 0) ? 0.f : sigmoidf_(lg0[512] - lg0[0]); }
    }
}
template <int MODE> __device__ __forceinline__ void la_cumsum(const Ctx& C, float* Gf, float* segs) {
    typedef LaCfg<MODE> Cf; constexpr int DK = Cf::DK, NSEG = NTHR / DK, RPS = 64 / NSEG;
    const int k = C.tid % DK, seg = C.tid / DK;
    float v[RPS];
#pragma unroll
    for (int i = 0; i < RPS; ++i) v[i] = Gf[(seg * RPS + i) * Cf::LG + k];
#pragma unroll
    for (int i = 1; i < RPS; ++i) v[i] += v[i - 1];
    segs[seg * DK + k] = v[RPS - 1];
    __syncthreads();
    float off = 0.f;
#pragma unroll
    for (int s = 0; s < NSEG; ++s) { const float t = segs[s * DK + k]; off += (s < seg) ? t : 0.f; }
#pragma unroll
    for (int i = 0; i < RPS; ++i) Gf[(seg * RPS + i) * Cf::LG + k] = v[i] + off;
}

template <int MODE> __device__ __forceinline__ void phase_la_p1(const Ctx& C, int l) {
    typedef LaCfg<MODE> Cf; const Params& p = C.p; constexpr int DK = Cf::DK, LQ = Cf::LQ, LG = Cf::LG, NG = Cf::NG;
    bf16_t* Kb = (bf16_t*)(C.lds + Cf::O_KB); float* Gf = (float*)(C.lds + Cf::O_GF); bf16_t* Vt = (bf16_t*)(C.lds + Cf::O_VT);
    bf16_t* KhT = (bf16_t*)(C.lds + Cf::O_KT); float* segs = (float*)(C.lds + Cf::O_SEG);
    bf16_t* ST = (bf16_t*)(p.ws + WS_ST); float* TOT = (float*)(p.ws + WS_TOT);
    const int r16 = C.lane & 15, g = C.lane >> 4, w = C.wave;
    float* par = (float*)(C.lds + Cf::O_PAR);
    LaRaw<MODE> R; int hcur = -1;
    if ((int)blockIdx.x < 2048) la_fetch<MODE, false>(C, (int)blockIdx.x >> 8, ((int)blockIdx.x >> 6) & 3, (int)blockIdx.x & 63, R);
    for (int it = blockIdx.x; it < 2048; it += gridDim.x) {
        const int bh = it >> 6, c = it & 63, b = bh >> 2, h = bh & 3;
        if (h != hcur) { la_params<MODE>(C, l, h, par); hcur = h; __syncthreads(); }
        la_store<MODE, false>(C, R, par, nullptr, Kb, Gf, Vt);
        { const int nx = it + (int)gridDim.x; if (nx < 2048) la_fetch<MODE, false>(C, nx >> 8, (nx >> 6) & 3, nx & 63, R); }
        __syncthreads();
        la_cumsum<MODE>(C, Gf, segs);
        __syncthreads();
        for (int u = C.tid; u < 64 * NG; u += NTHR) {
            const int r = u & 63, kk = (u >> 6) * 8;
            float kv[8], gj[8], gt[8];
            unpack8(*(const u32x4*)(Kb + r * LQ + kk), kv); ld8f(Gf + r * LG + kk, gj); ld8f(Gf + 63 * LG + kk, gt);
            bf16_t* kd = KhT + kk * 72 + r;
#pragma unroll
            for (int e = 0; e < 8; e += 2) { const unsigned pw = pk2(kv[e] * __builtin_amdgcn_exp2f(gt[e] - gj[e]), kv[e + 1] * __builtin_amdgcn_exp2f(gt[e + 1] - gj[e + 1]));
                kd[e * 72] = (bf16_t)(pw & 0xffffu); kd[(e + 1) * 72] = (bf16_t)(pw >> 16); }
        }
        if (C.tid < DK) TOT[(size_t)it * 128 + C.tid] = Gf[63 * LG + C.tid];
        __syncthreads();
        {
            const bf16x8 b0 = *(const bf16x8*)(Vt + (16 * w + r16) * 72 + 8 * g), b1 = *(const bf16x8*)(Vt + (16 * w + r16) * 72 + 32 + 8 * g);
            bf16_t* so = ST + (size_t)it * DK * 128 + (size_t)(16 * w + r16) * DK + 4 * g;
#pragma unroll
            for (int mt = 0; mt < DK / 16; ++mt) {
                const bf16x8 a0 = *(const bf16x8*)(KhT + (16 * mt + r16) * 72 + 8 * g), a1 = *(const bf16x8*)(KhT + (16 * mt + r16) * 72 + 32 + 8 * g);
                f32x4 acc = (f32x4){0.f, 0.f, 0.f, 0.f};
                acc = __builtin_amdgcn_mfma_f32_16x16x32_bf16(a0, b0, acc, 0, 0, 0);
                acc = __builtin_amdgcn_mfma_f32_16x16x32_bf16(a1, b1, acc, 0, 0, 0);
                u32x2 q; q.x = pk2(acc[0], acc[1]); q.y = pk2(acc[2], acc[3]);
                *(u32x2*)(so + 16 * mt) = q;
            }
        }
        __syncthreads();
    }
}

template <int MODE> __device__ __forceinline__ void phase_la_p2(const Ctx& C) {
    typedef LaCfg<MODE> Cf; const Params& p = C.p; constexpr int DK = Cf::DK, NQ = DK / 4;
    bf16_t* ST = (bf16_t*)(p.ws + WS_ST); const float* TOT = (const float*)(p.ws + WS_TOT);
    for (int u = blockIdx.x * NTHR + C.tid; u < 32 * 128 * NQ; u += gridDim.x * NTHR) {
        const int k4 = u % NQ, v = (u / NQ) & 127, bh = u / (NQ * 128);
        float S0 = 0.f, S1 = 0.f, S2 = 0.f, S3 = 0.f;
        bf16_t* base = ST + (size_t)bh * 64 * DK * 128 + (size_t)v * DK + k4 * 4;
        const float* tb = TOT + (size_t)bh * 64 * 128 + k4 * 4;
#pragma unroll 8
        for (int c = 0; c < 64; ++c) {
            u32x2* ptr = (u32x2*)(base + (size_t)c * DK * 128);
            const u32x2 w = *ptr; const f32x4 dc = *(const f32x4*)(tb + c * 128);
            u32x2 o; o.x = pk2(S0, S1); o.y = pk2(S2, S3);
            *ptr = o;
            S0 = S0 * __builtin_amdgcn_exp2f(dc[0]) + bflo(w.x); S1 = S1 * __builtin_amdgcn_exp2f(dc[1]) + bfhi(w.x);
            S2 = S2 * __builtin_amdgcn_exp2f(dc[2]) + bflo(w.y); S3 = S3 * __builtin_amdgcn_exp2f(dc[3]) + bfhi(w.y);
        }
    }
}

template <int MODE> __device__ __forceinline__ void phase_la_p3(const Ctx& C, int l) {
    typedef LaCfg<MODE> Cf; const Params& p = C.p; constexpr int DK = Cf::DK, LQ = Cf::LQ, LG = Cf::LG, NG = Cf::NG, NKS = DK / 32;
    bf16_t* Qb = (bf16_t*)(C.lds + Cf::O_QB); bf16_t* Kb = (bf16_t*)(C.lds + Cf::O_KB); float* Gf = (float*)(C.lds + Cf::O_GF); bf16_t* Vt = (bf16_t*)(C.lds + Cf::O_VT);
    bf16_t* Sc = (bf16_t*)(C.lds + Cf::O_SC); bf16_t* Qe = (bf16_t*)(C.lds + Cf::O_QE); float* segs = (float*)(C.lds + Cf::O_SEG); float* red = (float*)(C.lds + Cf::O_RED);
    const bf16_t* ST = (const bf16_t*)(p.ws + WS_ST); const bf16_t* proj = (const bf16_t*)(p.ws + WS_R1); bf16_t* A = (bf16_t*)(p.ws + WS_A);
    const float* nw = (MODE ? p.hgrn_norm_w : p.gla_norm_w) + (l >> 1) * 128;
    const int r16 = C.lane & 15, g = C.lane >> 4, w = C.wave;
    const f32x4 nw4 = *(const f32x4*)(nw + 16 * w + 4 * g);
    float* par = (float*)(C.lds + Cf::O_PAR);
    LaRaw<MODE> R; int hcur = -1;
    if ((int)blockIdx.x < 2048) la_fetch<MODE, true>(C, (int)blockIdx.x >> 8, ((int)blockIdx.x >> 6) & 3, (int)blockIdx.x & 63, R);
    for (int it = blockIdx.x; it < 2048; it += gridDim.x) {
        const int bh = it >> 6, c = it & 63, b = bh >> 2, h = bh & 3;
        bf16x8 sfr[NKS];
        { const bf16_t* sp = ST + (size_t)it * DK * 128 + (size_t)(16 * w + r16) * DK + 8 * g;
#pragma unroll
          for (int ks = 0; ks < NKS; ++ks) sfr[ks] = *(const bf16x8*)(sp + 32 * ks); }
        if (h != hcur) { la_params<MODE>(C, l, h, par); hcur = h; __syncthreads(); }
        la_store<MODE, true>(C, R, par, Qb, Kb, Gf, Vt);
        { const int nx = it + (int)gridDim.x; if (nx < 2048) la_fetch<MODE, true>(C, nx >> 8, (nx >> 6) & 3, nx & 63, R); }
        for (int u = C.tid; u < 64 * 72 / 8; u += NTHR) *(u32x4*)(Sc + u * 8) = (u32x4){0u, 0u, 0u, 0u};
        u32x2 gwv[4];
#pragma unroll
        for (int nt = 0; nt < 4; ++nt) gwv[nt] = *(const u32x2*)(proj + ((size_t)b * SEQ_ + (size_t)c * 64 + 16 * nt + r16) * Cf::PITCH + Cf::GCOL + h * 128 + 16 * w + 4 * g);
        __syncthreads();
        la_cumsum<MODE>(C, Gf, segs);
        __syncthreads();
        for (int t = w; t < 10; t += 8) {
            const int I = (t >= 6) ? 3 : (t >= 3) ? 2 : (t >= 1) ? 1 : 0, J = t - I * (I + 1) / 2;
            f32x4 acc = (f32x4){0.f, 0.f, 0.f, 0.f};
#pragma unroll
            for (int ks = 0; ks < NKS; ++ks) {
                const int kc = 32 * ks + 8 * g;
                float gref[8], gj[8], gi[8], kv[8], qv[8];
                ld8f(Gf + (16 * J + 15) * LG + kc, gref); ld8f(Gf + (16 * J + r16) * LG + kc, gj); ld8f(Gf + (16 * I + r16) * LG + kc, gi);
                unpack8(*(const u32x4*)(Kb + (16 * J + r16) * LQ + kc), kv); unpack8(*(const u32x4*)(Qb + (16 * I + r16) * LQ + kc), qv);
#pragma unroll
                for (int e = 0; e < 8; ++e) { kv[e] *= __builtin_amdgcn_exp2f(gref[e] - gj[e]); qv[e] *= __builtin_amdgcn_exp2f(gi[e] - gref[e]); }
                acc = __builtin_amdgcn_mfma_f32_16x16x32_bf16(__builtin_bit_cast(bf16x8, pack8(kv)), __builtin_bit_cast(bf16x8, pack8(qv)), acc, 0, 0, 0);
            }
            if (I == J) {
#pragma unroll
                for (int e = 0; e < 4; ++e) if (4 * g + e > r16) acc[e] = 0.f;
            }
            u32x2 q; q.x = pk2(acc[0], acc[1]); q.y = pk2(acc[2], acc[3]);
            *(u32x2*)(Sc + (16 * I + r16) * 72 + 16 * J + 4 * g) = q;
        }
        for (int u = C.tid; u < 64 * NG; u += NTHR) {
            const int r = u / NG, kk = (u % NG) * 8;
            float qv[8], gi[8]; unpack8(*(const u32x4*)(Qb + r * LQ + kk), qv); ld8f(Gf + r * LG + kk, gi);
#pragma unroll
            for (int e = 0; e < 8; ++e) qv[e] *= __builtin_amdgcn_exp2f(gi[e]);
            *(u32x4*)(Qe + r * LQ + kk) = pack8(qv);
        }
        __syncthreads();
        f32x4 o[4];
        {
            const bf16x8 v0 = *(const bf16x8*)(Vt + (16 * w + r16) * 72 + 8 * g), v1 = *(const bf16x8*)(Vt + (16 * w + r16) * 72 + 32 + 8 * g);
#pragma unroll
            for (int nt = 0; nt < 4; ++nt) {
                f32x4 acc = (f32x4){0.f, 0.f, 0.f, 0.f};
                acc = __builtin_amdgcn_mfma_f32_16x16x32_bf16(v0, *(const bf16x8*)(Sc + (16 * nt + r16) * 72 + 8 * g), acc, 0, 0, 0);
                if (nt >= 2) acc = __builtin_amdgcn_mfma_f32_16x16x32_bf16(v1, *(const bf16x8*)(Sc + (16 * nt + r16) * 72 + 32 + 8 * g), acc, 0, 0, 0);
#pragma unroll
                for (int ks = 0; ks < NKS; ++ks) acc = __builtin_amdgcn_mfma_f32_16x16x32_bf16(sfr[ks], *(const bf16x8*)(Qe + (16 * nt + r16) * LQ + 32 * ks + 8 * g), acc, 0, 0, 0);
                o[nt] = acc;
                float ss = acc[0] * acc[0] + acc[1] * acc[1] + acc[2] * acc[2] + acc[3] * acc[3];
                ss += __shfl_xor(ss, 16); ss += __shfl_xor(ss, 32);
                if (g == 0) red[w * 64 + 16 * nt + r16] = ss;
            }
        }
        __syncthreads();
#pragma unroll
        for (int nt = 0; nt < 4; ++nt) {
            float tot = 0.f;
#pragma unroll
            for (int ww = 0; ww < 8; ++ww) tot += red[ww * 64 + 16 * nt + r16];
            const float rs = rsqrtf(tot * (1.f / 128.f) + 1e-6f);
            const size_t row = (size_t)b * SEQ_ + (size_t)c * 64 + 16 * nt + r16;
            const u32x2 gw = gwv[nt];
            u32x2 q; q.x = pk2(o[nt][0] * rs * nw4[0] * siluf_(bflo(gw.x)), o[nt][1] * rs * nw4[1] * siluf_(bfhi(gw.x)));
            q.y = pk2(o[nt][2] * rs * nw4[2] * siluf_(bflo(gw.y)), o[nt][3] * rs * nw4[3] * siluf_(bfhi(gw.y)));
            *(u32x2*)(A + row * 1024 + Cf::OCOL + h * 128 + 16 * w + 4 * g) = q;
        }
        __syncthreads();
    }
}


#define LAS __attribute__((address_space(3)))
#define XB_TMO      128
#define XB_XCNT(j)  (256  + 64 * (j))
#define XB_XSUB(j)  (1280 + 64 * (j))
#define XB_XGEN(j)  (2304 + 64 * (j))
#define XB_TOP      3328
#define XB_TOPGEN   3392
#define XCD_BAR_WORDS 3456
#define XB_SPIN_CAP (1u << 18)

__device__ __forceinline__ unsigned xb_ld(unsigned* p)              { return __hip_atomic_load(p, __ATOMIC_RELAXED, __HIP_MEMORY_SCOPE_AGENT); }
__device__ __forceinline__ unsigned xb_add(unsigned* p, unsigned v) { return __hip_atomic_fetch_add(p, v, __ATOMIC_RELAXED, __HIP_MEMORY_SCOPE_AGENT); }
__device__ __forceinline__ unsigned xb_xcc_id() { return (unsigned)__builtin_amdgcn_s_getreg((3 << 11) | 20) & 0xFu; }
#define XB_SPIN(cond, bar) do { unsigned _sp = 0; while (cond) { __builtin_amdgcn_s_sleep(1); \
    if ((++_sp & 255u) == 0u) { if (xb_ld(&(bar)[XB_TMO])) break; if (_sp > XB_SPIN_CAP) { atomicAdd(&(bar)[XB_TMO], 1u); break; } } } } while (0)

struct XcdBarrier {
    unsigned* bar; unsigned x;
    volatile LAS unsigned* st;
};

__device__ __forceinline__ XcdBarrier xcd_barrier_post(unsigned* bar, volatile LAS unsigned* st) {
    XcdBarrier b; b.bar = bar; b.x = xb_xcc_id(); b.st = st;
    if (threadIdx.x == 0) (void)xb_add(&bar[XB_XCNT(b.x)], 1u);
    return b;
}
__device__ __forceinline__ void xcd_barrier_complete(unsigned* bar, unsigned x, unsigned& nloc, unsigned& nx) {
    const unsigned G = gridDim.x * gridDim.y * gridDim.z;
    unsigned sum, cnt, mine, sp = 0u;
    for (;;) {
        sum = 0u; cnt = 0u; mine = 0u;
#pragma unroll
        for (unsigned j = 0; j < 16; ++j) { const unsigned c = xb_ld(&bar[XB_XCNT(j)]); sum += c; cnt += (c > 0u) ? 1u : 0u; mine = (j == x) ? c : mine; }
        if (sum == G) break;
        __builtin_amdgcn_s_sleep(1);
        if ((++sp & 255u) == 0u) { if (xb_ld(&bar[XB_TMO])) break; if (sp > XB_SPIN_CAP) { atomicAdd(&bar[XB_TMO], 1u); break; } }
    }
    nloc = mine > 0u ? mine : 1u; nx = cnt > 0u ? cnt : 1u;
}

__device__ __forceinline__ void xcd_barrier(const XcdBarrier& b) {
    asm volatile("s_waitcnt vmcnt(0)" ::: "memory");
    __syncthreads();
    if (threadIdx.x == 0) {
        unsigned* bar = b.bar;
        __builtin_amdgcn_s_waitcnt(0);
        unsigned nloc = b.st[0], nx = b.st[1];
        if (nloc == 0u) { xcd_barrier_complete(bar, b.x, nloc, nx); b.st[0] = nloc; b.st[1] = nx; }
        const unsigned old = xb_add(&bar[XB_XSUB(b.x)], 1u);
        const unsigned gen = old / nloc;
        if (old + 1u == (gen + 1u) * nloc) {
            __builtin_amdgcn_fence(__ATOMIC_RELEASE, "agent");
            asm volatile("s_waitcnt vmcnt(0)" ::: "memory");
            const unsigned og = xb_add(&bar[XB_TOP], 1u);
            const unsigned tg = og / nx;
            if (og + 1u == (tg + 1u) * nx) xb_add(&bar[XB_TOPGEN], 1u);
            else XB_SPIN(xb_ld(&bar[XB_TOPGEN]) == tg, bar);
            __builtin_amdgcn_fence(__ATOMIC_ACQUIRE, "agent");
            xb_add(&bar[XB_XGEN(b.x)], 1u);
            asm volatile("s_waitcnt vmcnt(0)" ::: "memory");
        } else {
            XB_SPIN(xb_ld(&bar[XB_XGEN(b.x)]) == gen, bar);
            __builtin_amdgcn_fence(__ATOMIC_ACQUIRE, "agent");
            asm volatile("s_waitcnt vmcnt(0)" ::: "memory");
        }
    }
    __syncthreads();
}

typedef unsigned u32x16 __attribute__((ext_vector_type(16)));
__device__ __forceinline__ void load_params(Params& p) {
    auto kp = __builtin_amdgcn_kernarg_segment_ptr();
    u32x16 a, b, c, d;
    asm volatile("s_load_dwordx16 %0, %4, 0x0\n\ts_load_dwordx16 %1, %4, 0x40\n\ts_load_dwordx16 %2, %4, 0x80\n\ts_load_dwordx16 %3, %4, 0xc0\n\ts_waitcnt lgkmcnt(0)"
                 : "=&s"(a), "=&s"(b), "=&s"(c), "=&s"(d) : "s"(kp) : "memory");
    unsigned long long q[32];
#pragma unroll
    for (int i = 0; i < 8; ++i) { q[i] = ((unsigned long long)a[2 * i + 1] << 32) | a[2 * i]; q[8 + i] = ((unsigned long long)b[2 * i + 1] << 32) | b[2 * i];
        q[16 + i] = ((unsigned long long)c[2 * i + 1] << 32) | c[2 * i]; q[24 + i] = ((unsigned long long)d[2 * i + 1] << 32) | d[2 * i]; }
    p.x = (const float*)(__attribute__((address_space(1))) const float*)q[0]; p.c = (const float*)(__attribute__((address_space(1))) const float*)q[1]; p.positions = (const int*)(__attribute__((address_space(1))) const int*)q[2]; p.mod_w = (const float*)(__attribute__((address_space(1))) const float*)q[3]; p.mod_b = (const float*)(__attribute__((address_space(1))) const float*)q[4]; p.norm_mix_w = (const float*)(__attribute__((address_space(1))) const float*)q[5]; p.norm_ffn_w = (const float*)(__attribute__((address_space(1))) const float*)q[6];
    p.ev_w_in = (const float*)(__attribute__((address_space(1))) const float*)q[7]; p.gla_gate_w = (const float*)(__attribute__((address_space(1))) const float*)q[8]; p.gla_gate_b = (const float*)(__attribute__((address_space(1))) const float*)q[9]; p.gla_norm_w = (const float*)(__attribute__((address_space(1))) const float*)q[10]; p.swa_sinks = (const float*)(__attribute__((address_space(1))) const float*)q[11]; p.ev_w_out = (const float*)(__attribute__((address_space(1))) const float*)q[12];
    p.od_w_in = (const float*)(__attribute__((address_space(1))) const float*)q[13]; p.diff_lambda = (const float*)(__attribute__((address_space(1))) const float*)q[14]; p.diff_norm_w = (const float*)(__attribute__((address_space(1))) const float*)q[15]; p.hgrn_lb_logits = (const float*)(__attribute__((address_space(1))) const float*)q[16]; p.hgrn_norm_w = (const float*)(__attribute__((address_space(1))) const float*)q[17]; p.od_w_out = (const float*)(__attribute__((address_space(1))) const float*)q[18];
    p.ffn_w_in = (const float*)(__attribute__((address_space(1))) const float*)q[19]; p.ffn_conv_w = (const float*)(__attribute__((address_space(1))) const float*)q[20]; p.ffn_conv_b = (const float*)(__attribute__((address_space(1))) const float*)q[21]; p.ffn_w_out = (const float*)(__attribute__((address_space(1))) const float*)q[22]; p.final_norm_w = (const float*)(__attribute__((address_space(1))) const float*)q[23];
    p.out = (float*)(__attribute__((address_space(1))) float*)q[24]; p.ws = (unsigned char*)(__attribute__((address_space(1))) unsigned char*)q[25];
}

#ifndef REP_SYNC
#define REP_SYNC 1
#endif
#ifndef REP_G
#define REP_G 1
#endif
#ifndef REP_R
#define REP_R 1
#endif
#ifndef REP_CV
#define REP_CV 1
#endif
#ifndef REP_P12
#define REP_P12 1
#endif
#ifndef STG_A
#define STG_A 0
#endif
#ifndef STG_B
#define STG_B 0
#endif
#ifndef ALIGN_RES
#define ALIGN_RES true
#endif
#ifndef REP_SWA
#define REP_SWA 1
#endif
#ifndef REP_LA
#define REP_LA 1
#endif
#ifndef REP_AT
#define REP_AT 1
#endif
#ifndef REP_SM
#define REP_SM 1
#endif
__global__ void __launch_bounds__(NTHR, 2) fwd_megakernel(Params pin) {
    extern __shared__ __attribute__((aligned(16))) unsigned char lds[];
    cg::grid_group grid = cg::this_grid();
    Ctx C; C.lds = lds; C.tid = threadIdx.x; C.lane = C.tid & 63; C.wave = __builtin_amdgcn_readfirstlane(C.tid >> 6);
    C.gw = blockIdx.x * 8 + C.wave; C.ngw = gridDim.x * 8;
    PG8_LAS unsigned char* ldsg = (PG8_LAS unsigned char*)lds;
    volatile LAS unsigned* bst = (volatile LAS unsigned*)(ldsg + (LDS_BYTES - 64));
    if (threadIdx.x < 2) bst[threadIdx.x] = 0u;
    __syncthreads();
    XcdBarrier xbar = xcd_barrier_post((unsigned*)(pin.ws + WS_BAR), bst);
#define GSYNC() do { for (int rs_ = 0; rs_ < REP_SYNC; ++rs_) xcd_barrier(xbar); } while (0)
#define RP() do { load_params(C.p); C.tid = otid_(); C.lane = C.tid & 63; C.wave = __builtin_amdgcn_readfirstlane(C.tid >> 6); C.gw = blockIdx.x * 8 + C.wave; } while (0)
#define WSP(off) (C.p.ws + (off))
#define STAGGER(ticks) do { if ((ticks) > 0 && (blockIdx.x & 1)) { const unsigned long long t0_ = __builtin_amdgcn_s_memrealtime(); while (__builtin_amdgcn_s_memrealtime() - t0_ < (unsigned long long)(ticks)) __builtin_amdgcn_s_sleep(16); } } while (0)

    if (pin.ws == nullptr) grid.sync();
    for (int rep_ = 0; rep_ < REP_SM; ++rep_) { RP(); phase_prologue(C); }
    GSYNC();
#if REP_CV > 1
    RP(); phase_convert(C, 0, false);
#endif
    RP(); phase_convert(C, 0, false);
    for (int rep_ = 0; rep_ < REP_SM; ++rep_) { RP(); phase_prep(C, C.p.x, C.p.norm_mix_w, (const float*)WSP(WS_MOD), 1024, (bf16_t*)WSP(WS_A), (float*)WSP(WS_ROWSS)); }
    GSYNC();
    RP(); phase_bias_wt(C, 0);
    GSYNC();
#pragma unroll 1
    for (int l = 0; l < 4; ++l) {
        const bool even = !(l & 1);
        {
            RP();
            const int N = even ? 2560 : 3584;
            pg8::Gemm g{(const bf16_t*)WSP(WS_A), (const bf16_t*)WSP(WS_WIN), T_, N, 1024}; pg8::StaticOrder S; S.init(T_, N, (int)gridDim.x, (int)blockIdx.x);
            pg8::EpiProj E{(bf16_t*)WSP(WS_R1), N, even ? 0x7C000u : 0xFFu, even ? 0x3C000u : 0xFu, QSCALE_, (const float*)WSP(WS_COS), (const float*)WSP(WS_SIN),
                           (const float*)WSP(WS_ROWSS) + (size_t)(2 * l) * T_, (const float*)WSP(WS_BIAS) + (size_t)l * BIAS_L};
            for (int rep_ = 0; rep_ < REP_G; ++rep_) pg8::gemm_phase<pg8::EpiProj, pg8::StaticOrder, true, true>(ldsg, g, S, E);
        }
        GSYNC();
        if (even) {
            for (int rep_ = 0; rep_ < REP_SWA; ++rep_) { RP(); phase_swa(C, l); }
            for (int rep_ = 0; rep_ < REP_LA; ++rep_) { RP(); phase_la_p1<0>(C, l); }
            GSYNC();
            RP(); phase_la_p2<0>(C);
            GSYNC();
#if REP_P12 > 1
            RP(); phase_la_p1<0>(C, l); GSYNC(); RP(); phase_la_p2<0>(C); GSYNC();
#endif
            for (int rep_ = 0; rep_ < REP_LA; ++rep_) { RP(); phase_la_p3<0>(C, l); }
        } else {
            for (int rep_ = 0; rep_ < REP_AT; ++rep_) {
                RP();
                const bf16_t* R1 = (const bf16_t*)WSP(WS_R1); bf16_t* X2 = (bf16_t*)WSP(WS_X2);
                const int G = (int)gridDim.x, bid = (int)blockIdx.x;
#pragma unroll 1
                for (int i = 0; i * G < 2048; ++i) {
                    const int L = i * G + ((i & 1) ? (G - 1 - bid) : bid);
                    if (L >= 2048) continue;
                    const int qb = 15 - (L >> 7), bh = (((L >> 2) & 7) << 4) | ((L & 3) << 2) | (((L >> 5) & 1) << 1) | ((L >> 6) & 1), b = bh >> 4, hv = bh & 15;
                    const attn_body::bf16* Q = (const attn_body::bf16*)(R1 + (hv >> 1) * 64);
                    const attn_body::bf16* K = (const attn_body::bf16*)(R1 + 512 + (hv >> 1) * 64);
                    const attn_body::bf16* V = (const attn_body::bf16*)(R1 + 1024 + (hv >> 2) * 128 + (hv & 1) * 64);
                    attn_body::attn_unit<8>(b, hv, qb, Q, K, V, (attn_body::bf16*)(X2 + hv * 64), (char*)lds);
                }
            }
            for (int rep_ = 0; rep_ < REP_LA; ++rep_) { RP(); phase_la_p1<1>(C, l); }
            GSYNC();
            RP(); phase_la_p2<1>(C);
#if REP_P12 > 1
            GSYNC(); RP(); phase_la_p1<1>(C, l); GSYNC(); RP(); phase_la_p2<1>(C);
#endif
            for (int rep_ = 0; rep_ < REP_SM; ++rep_) { RP(); phase_diff_combine(C, l); }
            GSYNC();
            for (int rep_ = 0; rep_ < REP_LA; ++rep_) { RP(); phase_la_p3<1>(C, l); }
        }
        GSYNC();
        STAGGER(STG_A);
        {
            RP();
            const float* modl = (const float*)WSP(WS_MOD) + (size_t)l * 8 * 6144;
            pg8::Gemm g{(const bf16_t*)WSP(WS_A), (const bf16_t*)WSP(WS_WOUT), T_, 1024, 1024}; pg8::StaticOrder S; S.init(T_, 1024, (int)gridDim.x, (int)blockIdx.x);
            void* XH = (void*)((char*)C.p.out + 64 * MiB_);
            pg8::EpiRes E{(l == 0) ? (const void*)C.p.x : (const void*)XH, XH, (l == 0) ? 1 : 0, 0, modl + 2048, (bf16_t*)WSP(WS_X2), C.p.norm_ffn_w + l * 1024, modl + 4096, (float*)WSP(WS_ROWSS) + (size_t)(2 * l + 1) * T_};
            pg8::gemm_phase<pg8::EpiRes, pg8::StaticOrder, ALIGN_RES, true>(ldsg, g, S, E);
        }
        GSYNC();
        {
            RP();
            pg8::Gemm g{(const bf16_t*)WSP(WS_X2), (const bf16_t*)WSP(WS_FIN), T_, 5632, 1024}; pg8::StaticOrder S; S.init(T_, 5632, (int)gridDim.x, (int)blockIdx.x);
            pg8::EpiFfn E{(bf16_t*)WSP(WS_R1), (unsigned short*)WSP(WS_HP), (unsigned short*)WSP(WS_HU), (unsigned short*)WSP(WS_HA), C.p.ffn_conv_w + (size_t)l * 3 * DFF_, C.p.ffn_conv_b + (size_t)l * DFF_,
                          (const float*)WSP(WS_ROWSS) + (size_t)(2 * l + 1) * T_, (const float*)WSP(WS_BIAS) + (size_t)l * BIAS_L + 8 * 3584};
            for (int rep_ = 0; rep_ < REP_G; ++rep_) pg8::gemm_phase<pg8::EpiFfn, pg8::StaticOrder, true, true>(ldsg, g, S, E);
        }
        GSYNC();
        for (int rep_ = 0; rep_ < REP_SM; ++rep_) { RP(); phase_ffn_fixup(C, l); }
#if REP_CV > 1
        if (l < 3) { RP(); phase_convert(C, l + 1, false); }
#endif
        if (l < 3) { RP(); phase_convert(C, l + 1, false); }
        GSYNC();
        if (l < 3) { RP(); phase_bias_wt(C, l + 1); }
        {
            RP();
            const float* modl = (const float*)WSP(WS_MOD) + (size_t)l * 8 * 6144;
            pg8::Gemm g{(const bf16_t*)WSP(WS_R1), (const bf16_t*)WSP((l & 1) ? WS_FOUT2 : WS_FOUT), T_, 1024, DFF_}; pg8::StaticOrder S; S.init(T_, 1024, (int)gridDim.x, (int)blockIdx.x);
            void* XH = (void*)((char*)C.p.out + 64 * MiB_);
            pg8::EpiRes E{XH, (l < 3) ? XH : (void*)WSP(WS_X2), 0, 0, modl + 5120, (l < 3) ? (bf16_t*)WSP(WS_A) : (bf16_t*)nullptr, C.p.norm_mix_w + ((l + 1) & 3) * 1024, modl + 6144 * 8 + 1024, (float*)WSP(WS_ROWSS) + (size_t)((2 * l + 2) & 7) * T_};
            pg8::gemm_phase<pg8::EpiRes, pg8::StaticOrder, ALIGN_RES, true>(ldsg, g, S, E);
        }
        GSYNC();
    }
    RP(); phase_final_norm(C, (const void*)WSP(WS_X2), C.p.out, C.p.final_norm_w);
}

extern "C" void kernel_launch(void* const* d_in, const int* in_sizes, int n_in, void* d_out, int out_size, void* d_ws, size_t ws_size, hipStream_t stream) {
    static int grid_blocks = 0;
    if (grid_blocks == 0) {
        if (n_in != 24 || ws_size < WS_END) { fprintf(stderr, "kernel_launch: unexpected n_in %d / ws %zu\n", n_in, ws_size); grid_blocks = -1; return; }
        int dev = 0, cus = 0, per_cu = 0;
        hipGetDevice(&dev); hipDeviceGetAttribute(&cus, hipDeviceAttributeMultiprocessorCount, dev);
        if (hipFuncSetAttribute((const void*)fwd_megakernel, hipFuncAttributeMaxDynamicSharedMemorySize, LDS_BYTES) != hipSuccess) { fprintf(stderr, "kernel_launch: hipFuncSetAttribute failed\n"); grid_blocks = -1; return; }
        if (hipOccupancyMaxActiveBlocksPerMultiprocessor(&per_cu, (const void*)fwd_megakernel, NTHR, LDS_BYTES) != hipSuccess || per_cu < 1) { fprintf(stderr, "kernel_launch: occupancy query gave %d\n", per_cu); per_cu = 1; }
        (void)hipGetLastError();
        grid_blocks = cus * per_cu;
    }
    if (grid_blocks < 0) return;
    Params p{};
    p.x = (const float*)d_in[0]; p.c = (const float*)d_in[1]; p.positions = (const int*)d_in[2]; p.mod_w = (const float*)d_in[3]; p.mod_b = (const float*)d_in[4];
    p.norm_mix_w = (const float*)d_in[5]; p.norm_ffn_w = (const float*)d_in[6]; p.ev_w_in = (const float*)d_in[7]; p.gla_gate_w = (const float*)d_in[8];
    p.gla_gate_b = (const float*)d_in[9]; p.gla_norm_w = (const float*)d_in[10]; p.swa_sinks = (const float*)d_in[11]; p.ev_w_out = (const float*)d_in[12];
    p.od_w_in = (const float*)d_in[13]; p.diff_lambda = (const float*)d_in[14]; p.diff_norm_w = (const float*)d_in[15]; p.hgrn_lb_logits = (const float*)d_in[16];
    p.hgrn_norm_w = (const float*)d_in[17]; p.od_w_out = (const float*)d_in[18]; p.ffn_w_in = (const float*)d_in[19]; p.ffn_conv_w = (const float*)d_in[20];
    p.ffn_conv_b = (const float*)d_in[21]; p.ffn_w_out = (const float*)d_in[22]; p.final_norm_w = (const float*)d_in[23];
    p.out = (float*)d_out; p.ws = (unsigned char*)d_ws;
    if (hipMemsetAsync((char*)d_ws + WS_BAR, 0, 16384, stream) != hipSuccess) { fprintf(stderr, "kernel_launch: memset failed\n"); return; }
    void* args[] = {&p};
    hipError_t e = hipLaunchCooperativeKernel((const void*)fwd_megakernel, dim3(grid_blocks), dim3(NTHR), args, LDS_BYTES, stream);
    if (e != hipSuccess) fprintf(stderr, "cooperative launch failed: %s (grid %d)\n", hipGetErrorString(e), grid_blocks);
}
```

```cpp
#include <hip/hip_runtime.h>
#include <hip/hip_cooperative_groups.h>
#include <hip/hip_bf16.h>
#include <cstdio>
#include <cstdint>
#include <cmath>
__device__ __forceinline__ int otid_() { int t = threadIdx.x; asm volatile("" : "+v"(t)); return t; }
namespace pg8 {
#define PG8_LAS __attribute__((address_space(3)))
typedef unsigned short bf16_t;
typedef short bf16x8 __attribute__((ext_vector_type(8)));
typedef float f32x4 __attribute__((ext_vector_type(4)));
typedef unsigned u32x4 __attribute__((ext_vector_type(4)));
constexpr int BM = 256, BK = 64, HALF = 128, HTB = HALF * BK * 2  , STAGE_BYTES = 8 * HTB, NXCD = 8, WGM = 8;

__host__ __device__ __forceinline__ int lds_byte(int r, int c) { const int st = (r >> 4) * 2 + (c >> 5), rr = r & 15, cc = c & 31, ob = rr * 64 + cc * 2; return st * 1024 + (ob ^ (((ob >> 9) & 1) << 5)); }
__host__ __device__ __forceinline__ void stage_rc(int b, int& R, int& C) { const int st = b / 1024, sb = b % 1024, swz = sb ^ (((sb >> 9) & 1) << 5); R = (st >> 1) * 16 + swz / 64; C = (st & 1) * 32 + (swz % 64) / 2; }
__host__ __device__ __forceinline__ int perm32(int rho) { const int n = rho >> 4, i = rho & 15; return 8 * (i >> 2) + 4 * n + (i & 3); }

struct Unit { int pm, pn; };
struct Gemm { const bf16_t* A; const bf16_t* Bt; int M, N, K; };

struct StaticOrder {
    int nM, nN, nwg, G, c;
    __host__ __device__ void init(int M, int N, int G_, int c_) { nM = M / BM; nN = N / BM; nwg = nM * nN; G = G_; c = c_; }
    __host__ __device__ bool next(int i, Unit& u) const {
        const long L = (long)i * G + c; if (L >= nwg) return false;
        int wgid = (int)L; { const int q = nwg / NXCD, r = nwg % NXCD, xcd = wgid % NXCD, off = wgid / NXCD; wgid = (xcd < r ? xcd * (q + 1) : r * (q + 1) + (xcd - r) * q) + off; }
        const int nig = WGM * nN, gid = wgid / nig, fm = gid * WGM, gsz = (nM - fm) < WGM ? (nM - fm) : WGM;
        u.pm = fm + ((wgid % nig) % gsz); u.pn = (wgid % nig) / gsz; return true;
    }
    __device__ __forceinline__ void a_ready(const Unit&) const {}
    __device__ __forceinline__ void done(const Unit&) const {}
};

__device__ __forceinline__ unsigned cvt_pk_bf16(float lo, float hi) { unsigned r; asm volatile("v_cvt_pk_bf16_f32 %0, %1, %2" : "=v"(r) : "v"(lo), "v"(hi)); return r; }
typedef float f32x2 __attribute__((ext_vector_type(2)));
template <class Epi, class Sched, bool ALIGN_EPI = false, bool SP2 = false>
__device__ __forceinline__ void gemm_phase(PG8_LAS unsigned char* lds, const Gemm g, const Sched& S, const Epi& E) {
    const int tid = otid_(), wid = __builtin_amdgcn_readfirstlane(tid >> 6), lane = tid & 63, wr = wid >> 2, wc = wid & 3, fr = lane & 15, fq = lane >> 4;
    const int K = g.K, nt = K / BK;
    unsigned voffA[2], voffB[2];
#pragma unroll
    for (int i = 0; i < 2; ++i) { int R, C; stage_rc(tid * 16 + i * 8192, R, C); const int Rb = Epi::PERM ? ((R & ~31) + perm32(R & 31)) : R;
        voffA[i] = (unsigned)(R * K + C) * 2u; voffB[i] = (unsigned)(Rb * K + C) * 2u; }
    const size_t kstep = (size_t)(BK * 2);
    const size_t hstep = (size_t)HALF * K * 2;
    const size_t tstep = 2 * hstep;
    const unsigned ldsw = (unsigned)wid * 1024u;
    const int aoff = lds_byte(wr * 64 + fr, fq * 8), boff = lds_byte(wc * 32 + fr, fq * 8);
#define PG8_SA(b, h) (((b) * 2 + (h)) * HTB)
#define PG8_SB(b, h) ((4 + (b) * 2 + (h)) * HTB)
#define PG8_STAGE(bufoff, gbase, voff) do { _Pragma("unroll") for (int _i = 0; _i < 2; ++_i) \
        __builtin_amdgcn_global_load_lds((const unsigned*)((const char*)(gbase) + (voff)[_i]), (PG8_LAS unsigned*)(lds + (bufoff) + ldsw + _i * 8192), 16, 0, 0); } while (0)
#define PG8_LDA(dst, b, h) do { _Pragma("unroll") for (int m = 0; m < 4; ++m) _Pragma("unroll") for (int k = 0; k < 2; ++k) dst[m][k] = *(const PG8_LAS bf16x8*)(lds + PG8_SA(b, h) + aoff + m * 2048 + k * 1024); } while (0)
#define PG8_LDB(dst, b, h) do { _Pragma("unroll") for (int n = 0; n < 2; ++n) _Pragma("unroll") for (int k = 0; k < 2; ++k) dst[n][k] = *(const PG8_LAS bf16x8*)(lds + PG8_SB(b, h) + boff + n * 2048 + k * 1024); } while (0)
#define PG8_MMA(ai, bj, At, Bt) do { __builtin_amdgcn_s_setprio(1); _Pragma("unroll") for (int m = 0; m < 4; ++m) _Pragma("unroll") for (int n = 0; n < 2; ++n) _Pragma("unroll") for (int k = 0; k < 2; ++k) \
        acc[ai][bj][m][n] = __builtin_amdgcn_mfma_f32_16x16x32_bf16(Bt[n][k], At[m][k], acc[ai][bj][m][n], 0, 0, 0); __builtin_amdgcn_s_setprio(0); } while (0)
#define PG8_WAIT_V(n) asm volatile("s_waitcnt vmcnt(" #n ")" ::: "memory")
#define PG8_WAIT_L(n) asm volatile("s_waitcnt lgkmcnt(" #n ")" ::: "memory")
#define PG8_BAR __builtin_amdgcn_s_barrier()
#define PG8_SCHED __builtin_amdgcn_sched_barrier(0)
    Unit cur, nxt; int ui = 0;
    if (!S.next(0, cur)) return;
    f32x4 acc[2][2][4][2];
#pragma unroll
    for (int a = 0; a < 2; ++a)
#pragma unroll
        for (int b = 0; b < 2; ++b)
#pragma unroll
            for (int m = 0; m < 4; ++m)
#pragma unroll
                for (int n = 0; n < 2; ++n) acc[a][b][m][n] = (f32x4){0.f, 0.f, 0.f, 0.f};
    bf16x8 At[4][2], B0[2][2], B1[2][2];
    const char* cA = (const char*)g.A + (size_t)cur.pm * tstep; const char* cB = (const char*)g.Bt + (size_t)cur.pn * tstep;
    S.a_ready(cur);
    if constexpr (SP2) {
        PG8_STAGE(PG8_SB(0, 0), cB, voffB); PG8_STAGE(PG8_SB(0, 1), cB + hstep, voffB); PG8_STAGE(PG8_SA(0, 0), cA, voffA); PG8_STAGE(PG8_SA(0, 1), cA + hstep, voffA);
        if (wr == 1) PG8_BAR;
        PG8_WAIT_V(2); PG8_BAR;
        PG8_STAGE(PG8_SB(1, 0), cB + kstep, voffB); PG8_STAGE(PG8_SA(1, 0), cA + kstep, voffA); PG8_STAGE(PG8_SB(1, 1), cB + hstep + kstep, voffB);
        PG8_WAIT_V(6); PG8_BAR;
    } else {
        PG8_STAGE(PG8_SB(0, 0), cB, voffB); PG8_STAGE(PG8_SA(0, 0), cA, voffA); PG8_STAGE(PG8_SB(0, 1), cB + hstep, voffB); PG8_STAGE(PG8_SA(0, 1), cA + hstep, voffA);
        if (wr == 1) PG8_BAR;
        PG8_WAIT_V(4); PG8_BAR;
        PG8_STAGE(PG8_SB(1, 0), cB + kstep, voffB); PG8_STAGE(PG8_SA(1, 0), cA + kstep, voffA); PG8_STAGE(PG8_SB(1, 1), cB + hstep + kstep, voffB);
        PG8_WAIT_V(6); PG8_BAR;
    }
    for (;;) {
        const bool has_next = S.next(ui + 1, nxt);
        const char* nA = has_next ? (const char*)g.A + (size_t)nxt.pm * tstep : cA; const char* nB = has_next ? (const char*)g.Bt + (size_t)nxt.pn * tstep : cB;
        for (int t = 0; t < nt; t += 2) {
            const bool last = (t == nt - 2);
            const char* a1 = cA + (size_t)(t + 1) * kstep;
            const char* a2 = last ? nA : cA + (size_t)(t + 2) * kstep; const char* b2 = last ? nB : cB + (size_t)(t + 2) * kstep;
            const char* a3 = a2 + kstep; const char* b3 = b2 + kstep;
            if (last && has_next) S.a_ready(nxt);
            if constexpr (SP2) {
            PG8_LDB(B0, 0, 0); PG8_LDB(B1, 0, 1); PG8_SCHED; PG8_LDA(At, 0, 0); PG8_STAGE(PG8_SA(1, 1), a1 + hstep, voffA);
            PG8_WAIT_V(8); PG8_WAIT_L(0); PG8_BAR; PG8_MMA(0, 0, At, B0); PG8_MMA(0, 1, At, B1); PG8_BAR; PG8_SCHED;
            PG8_LDA(At, 0, 1); PG8_STAGE(PG8_SB(0, 0), b2, voffB); PG8_STAGE(PG8_SB(0, 1), b2 + hstep, voffB); PG8_STAGE(PG8_SA(0, 0), a2, voffA);
            PG8_WAIT_V(8); PG8_WAIT_L(0); PG8_BAR; PG8_MMA(1, 0, At, B0); PG8_MMA(1, 1, At, B1); PG8_BAR; PG8_SCHED;
            PG8_LDB(B0, 1, 0); PG8_LDB(B1, 1, 1); PG8_SCHED; PG8_LDA(At, 1, 0); PG8_STAGE(PG8_SA(0, 1), a2 + hstep, voffA);
            PG8_WAIT_V(8); PG8_WAIT_L(0); PG8_BAR; PG8_MMA(0, 0, At, B0); PG8_MMA(0, 1, At, B1); PG8_BAR; PG8_SCHED;
            PG8_LDA(At, 1, 1); PG8_STAGE(PG8_SB(1, 0), b3, voffB); PG8_STAGE(PG8_SB(1, 1), b3 + hstep, voffB); PG8_STAGE(PG8_SA(1, 0), a3, voffA);
            PG8_WAIT_V(8); PG8_WAIT_L(0); PG8_BAR; PG8_MMA(1, 0, At, B0); PG8_MMA(1, 1, At, B1); PG8_BAR; PG8_SCHED;
            } else {
            PG8_LDB(B0, 0, 0); PG8_SCHED; PG8_LDA(At, 0, 0); PG8_STAGE(PG8_SA(1, 1), a1 + hstep, voffA);
            PG8_WAIT_L(8); PG8_BAR; PG8_WAIT_L(0); PG8_MMA(0, 0, At, B0); PG8_BAR; PG8_SCHED;
            PG8_LDB(B1, 0, 1); PG8_STAGE(PG8_SB(0, 0), b2, voffB);
            PG8_BAR; PG8_WAIT_L(0); PG8_MMA(0, 1, At, B1); PG8_BAR;
            PG8_LDA(At, 0, 1); PG8_STAGE(PG8_SA(0, 0), a2, voffA);
            PG8_BAR; PG8_WAIT_L(0); PG8_MMA(1, 0, At, B0); PG8_BAR; PG8_SCHED;
            PG8_STAGE(PG8_SB(0, 1), b2 + hstep, voffB);
            PG8_WAIT_V(6); PG8_BAR; PG8_MMA(1, 1, At, B1); PG8_BAR;
            PG8_LDB(B0, 1, 0); PG8_SCHED; PG8_LDA(At, 1, 0); PG8_STAGE(PG8_SA(0, 1), a2 + hstep, voffA);
            PG8_WAIT_L(8); PG8_BAR; PG8_WAIT_L(0); PG8_MMA(0, 0, At, B0); PG8_BAR; PG8_SCHED;
            PG8_LDB(B1, 1, 1); PG8_STAGE(PG8_SB(1, 0), b3, voffB);
            PG8_BAR; PG8_WAIT_L(0); PG8_MMA(0, 1, At, B1); PG8_BAR;
            PG8_LDA(At, 1, 1); PG8_STAGE(PG8_SA(1, 0), a3, voffA);
            PG8_BAR; PG8_WAIT_L(0); PG8_MMA(1, 0, At, B0); PG8_BAR; PG8_SCHED;
            PG8_STAGE(PG8_SB(1, 1), b3 + hstep, voffB);
            PG8_WAIT_V(6); PG8_BAR; PG8_MMA(1, 1, At, B1); PG8_BAR;
            }
        }
        if constexpr (ALIGN_EPI) { if (wr == 0) PG8_BAR; }
        if constexpr (!Epi::AFTER_DRAIN) { E(acc, cur, wr, wc, fr, fq); S.done(cur); }
        if (!has_next) break;
#pragma unroll
        for (int a = 0; a < 2; ++a)
#pragma unroll
            for (int b = 0; b < 2; ++b)
#pragma unroll
                for (int m = 0; m < 4; ++m)
#pragma unroll
                    for (int n = 0; n < 2; ++n) acc[a][b][m][n] = (f32x4){0.f, 0.f, 0.f, 0.f};
        cur = nxt; cA = nA; cB = nB; ++ui;
        if constexpr (ALIGN_EPI) { if (wr == 1) PG8_BAR; }
    }
    PG8_WAIT_V(0);
    if constexpr (!ALIGN_EPI) { if (wr == 0) PG8_BAR; }
    PG8_BAR;
    if constexpr (Epi::AFTER_DRAIN) { E.fused(acc, cur, wr, wc, fr, fq, lds, wid, lane); S.done(cur); }
#undef PG8_SA
#undef PG8_SB
#undef PG8_STAGE
#undef PG8_LDA
#undef PG8_LDB
#undef PG8_MMA
#undef PG8_WAIT_V
#undef PG8_WAIT_L
#undef PG8_BAR
#undef PG8_SCHED
}
}
#include <hip/hip_bf16.h>
namespace attn_body {
using bf16=__hip_bfloat16;
using bf16x8=__attribute__((ext_vector_type(8)))short;
using s16x4=__attribute__((ext_vector_type(4)))short;
using f32x16=__attribute__((ext_vector_type(16)))float;
using u32x4=__attribute__((ext_vector_type(4)))unsigned;
constexpr int BATCH=8,NHEAD=16,SEQ=4096,D=64,PITI=3584,PITO=1024;
constexpr int NW=8,QBLK=32,QB=QBLK*NW,KVBLK=64,NQB=SEQ/QB;
__device__ __forceinline__ int crow(int r,int hi){return (r&3)+8*(r>>2)+4*hi;}
#define SBAR() __builtin_amdgcn_sched_barrier(0)
__device__ __forceinline__ void cmask(f32x16&p0,f32x16&p1,int jb,int qrel,int hi){
  const float NEG=-INFINITY; int kb=64*jb+4*hi;
  #pragma unroll
  for(int r=0;r<16;++r){int kv=kb+(r&3)+8*(r>>2); if(kv>qrel)p0[r]=NEG; if(kv+32>qrel)p1[r]=NEG;}
}

constexpr int NSLOT=3, SLOTB=8192;
constexpr int LDS_K=0, LDS_V=NSLOT*SLOTB, LDS_WS=2*NSLOT*SLOTB, LDS_OST=LDS_WS+NW*64*4, LDS_BYTES=LDS_OST+NW*4096;
constexpr float C2=0.125f*1.4426950408889634f;
__device__ __forceinline__ void glds16(const void*gsrc,unsigned lds_dst){unsigned keep;
  asm volatile("s_mov_b32 %0, m0\n\ts_mov_b32 m0, %2\n\ts_nop 0\n\tglobal_load_lds_dwordx4 %1, off\n\ts_mov_b32 m0, %0":"=&s"(keep):"v"(gsrc),"s"(lds_dst):"memory");}
__device__ __forceinline__ float max3f(float a,float b,float c){float r;asm("v_max3_f32 %0, %1, %2, %3":"=v"(r):"v"(a),"v"(b),"v"(c));return r;}
__device__ __forceinline__ float max2f(float a,float b){float r;asm("v_max_f32_e32 %0, %1, %2":"=v"(r):"v"(a),"v"(b));return r;}
__device__ __forceinline__ float fadd_s(float a,float b){float r;asm("v_add_f32_e32 %0, %1, %2":"=v"(r):"v"(a),"v"(b));return r;}
__device__ __forceinline__ float fsub_s(float a,float b){float r;asm("v_sub_f32_e32 %0, %1, %2":"=v"(r):"v"(a),"v"(b));return r;}
typedef float f32x2_t __attribute__((ext_vector_type(2))); typedef __bf16 bf16x2_t __attribute__((ext_vector_type(2)));
__device__ __forceinline__ unsigned cvtpk_s(float lo,float hi){f32x2_t v={lo,hi};bf16x2_t b=__builtin_convertvector(v,bf16x2_t);return __builtin_bit_cast(unsigned,b);}
#define WAIT_BAR(N) asm volatile("s_waitcnt vmcnt(" #N ") lgkmcnt(0)\n\ts_barrier":::"memory")

__device__ __forceinline__ void qkt(f32x16&p0,f32x16&p1,const char*Kslot,const bf16x8*qr,const f32x16&negm,int r32,int hi){
  const char*kb=Kslot+hi*1024+r32*16;
  #pragma unroll
  for(int d0=0;d0<4;++d0){
    const bf16x8 b0=*reinterpret_cast<const bf16x8*>(kb+d0*2048);
    const bf16x8 b1=*reinterpret_cast<const bf16x8*>(kb+d0*2048+512);
    if(d0==0){p0=__builtin_amdgcn_mfma_f32_32x32x16_bf16(b0,qr[0],negm,0,0,0);p1=__builtin_amdgcn_mfma_f32_32x32x16_bf16(b1,qr[0],negm,0,0,0);}
    else{p0=__builtin_amdgcn_mfma_f32_32x32x16_bf16(b0,qr[d0],p0,0,0,0);p1=__builtin_amdgcn_mfma_f32_32x32x16_bf16(b1,qr[d0],p1,0,0,0);}}
}
typedef __attribute__((address_space(3))) const char* lds_cptr;
typedef short v4i16_t __attribute__((ext_vector_type(4)));
__device__ __forceinline__ void kload8(bf16x8*kf,lds_cptr kp){
  kf[0]=*(const __attribute__((address_space(3))) bf16x8*)(kp);      kf[1]=*(const __attribute__((address_space(3))) bf16x8*)(kp+512);
  kf[2]=*(const __attribute__((address_space(3))) bf16x8*)(kp+2048); kf[3]=*(const __attribute__((address_space(3))) bf16x8*)(kp+2560);
  kf[4]=*(const __attribute__((address_space(3))) bf16x8*)(kp+4096); kf[5]=*(const __attribute__((address_space(3))) bf16x8*)(kp+4608);
  kf[6]=*(const __attribute__((address_space(3))) bf16x8*)(kp+6144); kf[7]=*(const __attribute__((address_space(3))) bf16x8*)(kp+6656);
}
__device__ __forceinline__ void kload2(bf16x8*kf,lds_cptr kp,int j){ kf[2*j]=*(const __attribute__((address_space(3))) bf16x8*)(kp+j*2048); kf[2*j+1]=*(const __attribute__((address_space(3))) bf16x8*)(kp+j*2048+512); }
__device__ __forceinline__ s16x4 vtr(lds_cptr p){ return __builtin_bit_cast(s16x4,__builtin_amdgcn_ds_read_tr16_b64_v4i16((__attribute__((address_space(3))) v4i16_t*)p)); }
__device__ __forceinline__ float rowmax(const f32x16&p0,const f32x16&p1){
  float a=max3f(p0[0],p0[1],p1[0]),b=max3f(p0[2],p0[3],p1[1]);a=max3f(a,p1[2],p1[3]);
  #pragma unroll
  for(int r=4;r<16;r+=4){a=max3f(a,p0[r],p0[r+1]);b=max3f(b,p0[r+2],p0[r+3]);a=max3f(a,p1[r],p1[r+1]);b=max3f(b,p1[r+2],p1[r+3]);}
  const float m=max2f(a,b);
  auto rr=__builtin_amdgcn_permlane32_swap(__float_as_uint(m),__float_as_uint(m),false,false);
  return max2f(__uint_as_float(rr[0]),__uint_as_float(rr[1]));
}
__device__ __forceinline__ void pv(f32x16*o,int vb,bf16x8 pa0,bf16x8 pa1,bf16x8 pa2,bf16x8 pa3){
  #pragma unroll
  for(int d0=0;d0<2;++d0){s16x4 lo[4],hi[4];
    #pragma unroll
    for(int ks=0;ks<4;++ks){
      asm volatile("ds_read_b64_tr_b16 %0,%1 offset:%c2":"=&v"(lo[ks]):"v"(vb),"i"(d0*4096+ks*1024):"memory");
      asm volatile("ds_read_b64_tr_b16 %0,%1 offset:%c2":"=&v"(hi[ks]):"v"(vb),"i"(d0*4096+ks*1024+512):"memory");}
    asm volatile("s_waitcnt lgkmcnt(0)":::"memory");SBAR();
    #define PK(k) (bf16x8){lo[k][0],lo[k][1],lo[k][2],lo[k][3],hi[k][0],hi[k][1],hi[k][2],hi[k][3]}
    o[d0]=__builtin_amdgcn_mfma_f32_32x32x16_bf16(pa0,PK(0),o[d0],0,0,0);
    o[d0]=__builtin_amdgcn_mfma_f32_32x32x16_bf16(pa1,PK(1),o[d0],0,0,0);
    o[d0]=__builtin_amdgcn_mfma_f32_32x32x16_bf16(pa2,PK(2),o[d0],0,0,0);
    o[d0]=__builtin_amdgcn_mfma_f32_32x32x16_bf16(pa3,PK(3),o[d0],0,0,0);
    #undef PK
  }
}

#ifndef ATTN_STORE16
#define ATTN_STORE16(p,v) (*(u32x4*)(p)=(v))
#endif
template<int THRL> __device__ __forceinline__ void attn_unit(int b,int h,int qb,const bf16*Q,const bf16*__restrict__ K,const bf16*__restrict__ V,bf16*O,char*shm){
  const int tid=otid_(),lane=tid&63,r32=lane&31,hi=lane>>5; const int wid=__builtin_amdgcn_readfirstlane(tid>>6);
  const long rowbase=(long)b*SEQ; const int q0=qb*QB;
  const bf16*Qw=Q+(rowbase+q0+wid*QBLK)*PITI;
  const bf16*Kh=K+rowbase*PITI,*Vh=V+rowbase*PITI;
  const unsigned lds0=(unsigned)(uintptr_t)shm;
  float*wsf=(float*)(shm+LDS_WS)+wid*64;
  const bf16*ksrc=Kh+(long)lane*PITI+wid*8;
  const bf16*vsrc=Vh+(long)(16*(wid&3)+(lane>>2))*PITI+(wid>>2)*32+(lane&3)*8;
  const unsigned kdst=lds0+LDS_K+wid*1024, vdst=lds0+LDS_V+wid*1024;
  #define DMA_K(t,slot) glds16(ksrc+(long)(t)*KVBLK*PITI,(unsigned)__builtin_amdgcn_readfirstlane(kdst+(slot)))
  #define DMA_V(t,slot) glds16(vsrc+(long)(t)*KVBLK*PITI,(unsigned)__builtin_amdgcn_readfirstlane(vdst+(slot)))
  const int vb0=(int)(lds0+LDS_V)+((lane>>4)&1)*32+(lane&3)*8+(4*hi+((lane&15)>>2))*64;
  const char*Kbase=shm+LDS_K; bf16x8 kf[8];
  const lds_cptr shm3=(lds_cptr)shm; const lds_cptr kp0=shm3+LDS_K+hi*1024+r32*16; const lds_cptr vp0=shm3+LDS_V+((lane>>4)&1)*32+(lane&3)*8+(4*hi+((lane&15)>>2))*64;
  const int NT=(q0+QB)/KVBLK;
  DMA_K(0,0);DMA_V(0,0);DMA_K(1,SLOTB);
  bf16x8 qr[4];
  #pragma unroll
  for(int d0=0;d0<4;++d0)qr[d0]=*reinterpret_cast<const bf16x8*>(&Qw[(long)r32*PITI+d0*16+hi*8]);
  float mhat=0.f,l_reg=0.f;f32x16 o[2];o[0]=f32x16{};o[1]=f32x16{};f32x16 negm=f32x16{};asm volatile("":"+v"(negm));
  const int qrel=wid*QBLK+r32;
  #define CMASK(P0,P1,t) do{int jb_=(t)-(NT-4); if(jb_>=0)cmask(P0,P1,jb_,qrel,hi);}while(0)
  bool resc=false;
  #define START(P0,P1) do{ const float rm=rowmax(P0,P1); resc=false; \
    { const float dl=rm; mhat=fadd_s(mhat,dl); \
      _Pragma("unroll") for(int r=0;r<16;++r){P0[r]=fsub_s(P0[r],dl);P1[r]=fsub_s(P1[r],dl);} \
      _Pragma("unroll") for(int r=0;r<16;++r)negm[r]=-mhat; asm volatile("":"+v"(negm)); } \
    _Pragma("unroll") for(int r=0;r<16;++r)P0[r]=__builtin_amdgcn_exp2f(P0[r]); }while(0)
  #define RESC() do{ if(resc){ asm volatile("s_waitcnt lgkmcnt(0)":::"memory"); \
      _Pragma("unroll") for(int d_=0;d_<2;++d_) _Pragma("unroll") for(int r=0;r<16;++r)o[d_][r]*=wsf[crow(r,hi)]; } }while(0)
  f32x16 pA0,pA1,pB0,pB1;
  int sl_prev=0,sl_cur=0,sl_next=SLOTB;
  #define ROT() do{sl_prev=sl_cur;sl_cur=sl_next;sl_next=(sl_next==(NSLOT-1)*SLOTB)?0:sl_next+SLOTB;}while(0)
  DMA_K(2,2*SLOTB);
  WAIT_BAR(3);
  qkt(pA0,pA1,Kbase,qr,negm,r32,hi);asm volatile("s_nop 15\n\ts_nop 7":"+v"(pA0),"+v"(pA1));CMASK(pA0,pA1,0);
  START(pA0,pA1);
  _Pragma("unroll") for(int r=0;r<16;++r)pA1[r]=__builtin_amdgcn_exp2f(pA1[r]);
  WAIT_BAR(0);
  DMA_K(3,0);DMA_V(1,SLOTB);
  ROT();
  kload8(kf,kp0+sl_cur);
  WAIT_BAR(2);
  s16x4 vlo[8],vhi[8]; u32x4 pw0,pw1,pw2,pw3;
  #define PKW(P,B) cvtpk_s(P[B],P[B+1])
  #define PAF(k) __builtin_bit_cast(bf16x8,pw##k)
  #define VFR(i) (bf16x8){vlo[i][0],vlo[i][1],vlo[i][2],vlo[i][3],vhi[i][0],vhi[i][1],vhi[i][2],vhi[i][3]}
  #define PIN(x) asm volatile("":"+v"(x))
  #define MX3(a,b,c) __builtin_fmaxf(__builtin_fmaxf((a),(b)),(c))
  #define GAPA(MF,A0,A1,A2,A3,W0,W1,PW) do{ MF; sacc+=A0; sacc+=A1; sacc+=A2; sacc+=A3; PIN(sacc); W0; W1; PIN(PW); SBAR(); }while(0)
  #define EX(v) __builtin_amdgcn_exp2f(v)
  #define GAPB(MF,X,B) do{ MF; X[B]=EX(X[B]); X[B+1]=EX(X[B+1]); X[B+2]=EX(X[B+2]); X[B+3]=EX(X[B+3]); PIN(X); SBAR(); }while(0)
  #define VRD(i) do{ vlo[i]=vtr(vp_+(((i)>>2)*4096+((i)&3)*1024)); vhi[i]=vtr(vp_+(((i)>>2)*4096+((i)&3)*1024+512)); }while(0)
  #define KRD(G,j) do{ if(G){ kload2(kf,kp0+sl_next,j); SBAR(); } }while(0)
  #define STEP(C0,C1,P0,P1,t,GK,GV,GL) do{ SBAR(); \
    const lds_cptr vp_=vp0+sl_prev; \
    VRD(0); SBAR(); float sacc=(P0[0]+P0[1]); \
    GAPA(C0=__builtin_amdgcn_mfma_f32_32x32x16_bf16(kf[0],qr[0],negm,0,0,0), P0[2],P0[3],P0[4],P0[5],     pw0[0]=PKW(P0,0), pw0[1]=PKW(P0,2), pw0); \
    VRD(4); SBAR(); GAPA(C1=__builtin_amdgcn_mfma_f32_32x32x16_bf16(kf[1],qr[0],negm,0,0,0), P0[6],P0[7],P0[8],P0[9],     pw0[2]=PKW(P0,4), pw0[3]=PKW(P0,6), pw0); \
    VRD(1); SBAR(); GAPA(C0=__builtin_amdgcn_mfma_f32_32x32x16_bf16(kf[2],qr[1],C0,0,0,0),   P0[10],P0[11],P0[12],P0[13], pw1[0]=PKW(P0,8), pw1[1]=PKW(P0,10), pw1); \
    VRD(5); SBAR(); GAPA(C1=__builtin_amdgcn_mfma_f32_32x32x16_bf16(kf[3],qr[1],C1,0,0,0),   P0[14],P0[15],P1[0],P1[1],   pw1[2]=PKW(P0,12),pw1[3]=PKW(P0,14), pw1); \
    VRD(2); SBAR(); GAPA(C0=__builtin_amdgcn_mfma_f32_32x32x16_bf16(kf[4],qr[2],C0,0,0,0),   P1[2],P1[3],P1[4],P1[5],     pw2[0]=PKW(P1,0), pw2[1]=PKW(P1,2), pw2); \
    VRD(6); SBAR(); GAPA(C1=__builtin_amdgcn_mfma_f32_32x32x16_bf16(kf[5],qr[2],C1,0,0,0),   P1[6],P1[7],P1[8],P1[9],     pw2[2]=PKW(P1,4), pw2[3]=PKW(P1,6), pw2); \
    VRD(3); SBAR(); GAPA(C0=__builtin_amdgcn_mfma_f32_32x32x16_bf16(kf[6],qr[3],C0,0,0,0),   P1[10],P1[11],P1[12],P1[13], pw3[0]=PKW(P1,8), pw3[1]=PKW(P1,10), pw3); \
    VRD(7); SBAR(); GAPA(C1=__builtin_amdgcn_mfma_f32_32x32x16_bf16(kf[7],qr[3],C1,0,0,0),   P1[14],P1[15],0.f,0.f,       pw3[2]=PKW(P1,12),pw3[3]=PKW(P1,14), pw3); \
    l_reg+=sacc; \
    if(GK){DMA_K((t)+3,sl_cur);} if(GV){DMA_V((t)+1,sl_next);} \
    CMASK(C0,C1,t); \
    { float a=MX3(C0[0],C0[1],C1[0]),b=MX3(C0[2],C0[3],C1[1]); a=MX3(a,C1[2],C1[3]); \
      _Pragma("unroll") for(int r=4;r<16;r+=4){a=MX3(a,C0[r],C0[r+1]);b=MX3(b,C0[r+2],C0[r+3]);a=MX3(a,C1[r],C1[r+1]);b=MX3(b,C1[r+2],C1[r+3]);} \
      float rm=__builtin_fmaxf(a,b); { auto rr=__builtin_amdgcn_permlane32_swap(__float_as_uint(rm),__float_as_uint(rm),false,false); rm=__builtin_fmaxf(__uint_as_float(rr[0]),__uint_as_float(rr[1])); } \
      resc=false; \
      if(__builtin_expect(__any(rm>(float)THRL),0)){ const float dl=__builtin_fmaxf(rm,0.f); mhat+=dl; \
        _Pragma("unroll") for(int r=0;r<16;++r){C0[r]-=dl;C1[r]-=dl;} \
        _Pragma("unroll") for(int r=0;r<16;++r)negm[r]=-mhat; asm volatile("":"+v"(negm)); \
        const float f=__builtin_amdgcn_exp2f(-dl); l_reg*=f; if(hi==0)wsf[r32]=f; resc=true; } } \
    SBAR(); \
    GAPB(o[0]=__builtin_amdgcn_mfma_f32_32x32x16_bf16(PAF(0),VFR(0),o[0],0,0,0), C0,0); \
    GAPB(o[1]=__builtin_amdgcn_mfma_f32_32x32x16_bf16(PAF(0),VFR(4),o[1],0,0,0), C0,4); \
    KRD(GL,0); GAPB(o[0]=__builtin_amdgcn_mfma_f32_32x32x16_bf16(PAF(1),VFR(1),o[0],0,0,0), C0,8); \
    KRD(GL,1); GAPB(o[1]=__builtin_amdgcn_mfma_f32_32x32x16_bf16(PAF(1),VFR(5),o[1],0,0,0), C0,12); \
    KRD(GL,2); GAPB(o[0]=__builtin_amdgcn_mfma_f32_32x32x16_bf16(PAF(2),VFR(2),o[0],0,0,0), C1,0); \
    KRD(GL,3); GAPB(o[1]=__builtin_amdgcn_mfma_f32_32x32x16_bf16(PAF(2),VFR(6),o[1],0,0,0), C1,4); \
    GAPB(o[0]=__builtin_amdgcn_mfma_f32_32x32x16_bf16(PAF(3),VFR(3),o[0],0,0,0), C1,8); \
    GAPB(o[1]=__builtin_amdgcn_mfma_f32_32x32x16_bf16(PAF(3),VFR(7),o[1],0,0,0), C1,12); \
    }while(0)
  int t=1;
  #undef CMASK
  #define CMASK(P0,P1,t) do{}while(0)
  for(;t+5<NT;t+=2){
    STEP(pB0,pB1,pA0,pA1,t,true,true,true);     WAIT_BAR(2); RESC(); ROT();
    STEP(pA0,pA1,pB0,pB1,t+1,true,true,true);   WAIT_BAR(2); RESC(); ROT();
  }
  #undef CMASK
  #define CMASK(P0,P1,t) do{int jb_=(t)-(NT-4); if(jb_>=0)cmask(P0,P1,jb_,qrel,hi);}while(0)
  #define ENDW(tt) do{ if((tt)+3<NT){WAIT_BAR(2);} else if((tt)+2<NT){WAIT_BAR(1);} else {WAIT_BAR(0);} }while(0)
  for(;t+1<NT;t+=2){
    STEP(pB0,pB1,pA0,pA1,t,(t+3<NT),(t+1<NT),(t+1<NT));       ENDW(t);   RESC(); ROT();
    STEP(pA0,pA1,pB0,pB1,t+1,(t+4<NT),(t+2<NT),(t+2<NT));     ENDW(t+1); RESC(); ROT();
  }
  STEP(pB0,pB1,pA0,pA1,NT-1,false,false,false); RESC();
  { float sacc=pB0[0]+pB0[1]; _Pragma("unroll") for(int r=2;r<16;++r)sacc+=pB0[r]; _Pragma("unroll") for(int r=0;r<16;++r)sacc+=pB1[r]; l_reg+=sacc;
    pw0=(u32x4){PKW(pB0,0),PKW(pB0,2),PKW(pB0,4),PKW(pB0,6)};pw1=(u32x4){PKW(pB0,8),PKW(pB0,10),PKW(pB0,12),PKW(pB0,14)};pw2=(u32x4){PKW(pB1,0),PKW(pB1,2),PKW(pB1,4),PKW(pB1,6)};pw3=(u32x4){PKW(pB1,8),PKW(pB1,10),PKW(pB1,12),PKW(pB1,14)};
    SBAR(); pv(o,vb0+sl_cur,PAF(0),PAF(1),PAF(2),PAF(3)); }
  #undef PKW
  #undef PAF
  #undef VFR
  #undef PIN
  #undef MX3
  #undef GAPA
  #undef GAPB
  #undef EX
  #undef VRD
  #undef KRD
  #undef STEP
  #undef ENDW
  {auto rr=__builtin_amdgcn_permlane32_swap(__float_as_uint(l_reg),__float_as_uint(l_reg),false,false);l_reg=__uint_as_float(rr[0])+__uint_as_float(rr[1]);}
  if(hi==0)wsf[32+r32]=l_reg;asm volatile("s_waitcnt lgkmcnt(0)":::"memory");
  float rli[16];
  #pragma unroll
  for(int r=0;r<16;++r)rli[r]=__builtin_amdgcn_rcpf(wsf[32+crow(r,hi)]);
  bf16*Ow=O+(rowbase+q0+wid*QBLK)*PITO;
  { bf16*stg=(bf16*)(shm+LDS_OST)+wid*2048;
    #pragma unroll
    for(int r=0;r<16;++r){const int orow=crow(r,hi);
      #pragma unroll
      for(int d0=0;d0<2;++d0)stg[orow*64+d0*32+r32]=__float2bfloat16(o[d0][r]*rli[r]);}
    asm volatile("s_waitcnt lgkmcnt(0)":::"memory");
    #pragma unroll
    for(int i=0;i<4;++i){const int row=i*8+(lane>>3),ch=lane&7; const u32x4 v=*(const u32x4*)(stg+row*64+ch*8); ATTN_STORE16(Ow+(long)row*PITO+ch*8,v);} }
  asm volatile("s_waitcnt lgkmcnt(0)\n\ts_barrier":::"memory");
  #undef DMA_K
  #undef DMA_V
  #undef CMASK
  #undef START
  #undef RESC
  #undef ROT
}
constexpr int ATTN_LDS_BYTES=LDS_BYTES;
#undef SBAR
#undef WAIT_BAR
}

namespace cg = cooperative_groups;
typedef unsigned short bf16_t;
typedef float f32x4 __attribute__((ext_vector_type(4)));
typedef float f32x16 __attribute__((ext_vector_type(16)));
typedef unsigned u32x4 __attribute__((ext_vector_type(4)));
typedef unsigned u32x2 __attribute__((ext_vector_type(2)));
typedef short bf16x8 __attribute__((ext_vector_type(8)));
#define LAS3 __attribute__((address_space(3)))

constexpr int T_ = 32768, DM_ = 1024, SEQ_ = 4096, DFF_ = 2816;
constexpr int NTHR = 512;
constexpr int LDS_BYTES = 147456;
constexpr size_t MiB_ = 1u << 20;
constexpr size_t WS_MOD = 0, WS_COS = 1 * MiB_, WS_SIN = 2 * MiB_, WS_BAR = 3 * MiB_;
constexpr size_t WS_WIN = 4 * MiB_, WS_WOUT = 11 * MiB_, WS_FIN = 13 * MiB_, WS_FOUT = 24 * MiB_;
constexpr size_t WS_A = 32 * MiB_, WS_X2 = 96 * MiB_, WS_ST = 160 * MiB_, WS_TOT = 224 * MiB_, WS_R1 = 226 * MiB_, WS_BIAS = 450 * MiB_, WS_ROWSS = 452 * MiB_, WS_FOUT2 = 454 * MiB_, WS_END = 460 * MiB_;
constexpr int BIAS_L = 8 * (3584 + 5632);
constexpr size_t WS_HP = WS_ST, WS_HU = WS_ST + 12 * MiB_, WS_HA = WS_ST + 24 * MiB_;
constexpr float LOG2E_ = 1.4426950408889634f;
constexpr float QSCALE_ = 0.125f * 1.4426950408889634f;

struct Params {
    const float* x; const float* c; const int* positions; const float* mod_w; const float* mod_b; const float* norm_mix_w; const float* norm_ffn_w;
    const float* ev_w_in; const float* gla_gate_w; const float* gla_gate_b; const float* gla_norm_w; const float* swa_sinks; const float* ev_w_out;
    const float* od_w_in; const float* diff_lambda; const float* diff_norm_w; const float* hgrn_lb_logits; const float* hgrn_norm_w; const float* od_w_out;
    const float* ffn_w_in; const float* ffn_conv_w; const float* ffn_conv_b; const float* ffn_w_out; const float* final_norm_w;
    float* out; unsigned char* ws; unsigned long long pad[6];
};

__device__ __forceinline__ unsigned pk2(float lo, float hi) {
    typedef float f32x2_t __attribute__((ext_vector_type(2))); typedef __bf16 bf16x2_t __attribute__((ext_vector_type(2)));
    f32x2_t v = {lo, hi}; bf16x2_t b = __builtin_convertvector(v, bf16x2_t); return __builtin_bit_cast(unsigned, b);
}
__device__ __forceinline__ float bflo(unsigned u) { return __uint_as_float(u << 16); }
__device__ __forceinline__ float bfhi(unsigned u) { return __uint_as_float(u & 0xffff0000u); }
__device__ __forceinline__ float sigmoidf_(float x) { return __builtin_amdgcn_rcpf(1.f + __expf(-x)); }
__device__ __forceinline__ float siluf_(float x) { return x * __builtin_amdgcn_rcpf(1.f + __expf(-x)); }
__device__ __forceinline__ float wave_sum(float v) {
#pragma unroll
    for (int o = 1; o < 64; o <<= 1) v += __shfl_xor(v, o);
    return v;
}
__device__ __forceinline__ int crow_(int r, int hi) { return (r & 3) + 8 * (r >> 2) + 4 * hi; }

namespace pg8 {
struct EpiProj {
    static constexpr bool PERM = true, AFTER_DRAIN = false;
    bf16_t* O; int ldc; unsigned ropemask; unsigned scalemask; float scale; const float* cs; const float* sn; const float* rowss; const float* bias;
    __device__ __forceinline__ void operator()(const f32x4 (&acc)[2][2][4][2], const Unit& u, int, int, int, int) const {
        const int t_ = otid_(), l_ = t_ & 63, fr = l_ & 15, fq = l_ >> 4, wid_ = __builtin_amdgcn_readfirstlane(t_ >> 6), wr = wid_ >> 2, wc = wid_ & 3;
        const int row0 = u.pm * BM + wr * 64 + fr; const int col0 = u.pn * BM + wc * 32 + 8 * fq;
        float rs[2][4];
#pragma unroll
        for (int ai = 0; ai < 2; ++ai)
#pragma unroll
            for (int m = 0; m < 4; ++m) rs[ai][m] = rsqrtf(rowss[row0 + ai * HALF + m * 16] * (1.f / 1024.f) + 1e-6f);
        const float* bp = bias + (size_t)((u.pm * BM) >> 12) * ldc + col0;
#pragma unroll
        for (int bj = 0; bj < 2; ++bj) {
            const f32x4 bv0 = *(const f32x4*)(bp + bj * HALF), bv1 = *(const f32x4*)(bp + bj * HALF + 4);
            const int grp = u.pn * 2 + bj;
            const bool rope = ((ropemask >> grp) & 1u) && ((wc & 1) == 0);
            const float sc = ((scalemask >> grp) & 1u) ? scale : 1.f;
#pragma unroll
            for (int ai = 0; ai < 2; ++ai)
#pragma unroll
                for (int m = 0; m < 4; ++m) {
                    const int row = row0 + ai * HALF + m * 16;
                    f32x4 v0 = acc[ai][bj][m][0] * rs[ai][m] + bv0, v1 = acc[ai][bj][m][1] * rs[ai][m] + bv1;
                    if (rope) {
                        const f32x4 c0 = *(const f32x4*)(cs + (size_t)row * 8), c1 = *(const f32x4*)(cs + (size_t)row * 8 + 4);
                        const f32x4 s0 = *(const f32x4*)(sn + (size_t)row * 8), s1 = *(const f32x4*)(sn + (size_t)row * 8 + 4);
                        const float sg = (fq == 0) ? -1.f : 1.f;
#pragma unroll
                        for (int e = 0; e < 4; ++e) {
                            const float p0 = __shfl_xor(v0[e], 16), p1 = __shfl_xor(v1[e], 16);
                            const float r0 = v0[e] * c0[e] + sg * p0 * s0[e], r1 = v1[e] * c1[e] + sg * p1 * s1[e];
                            if (fq < 2) { v0[e] = r0; v1[e] = r1; }
                        }
                    }
                    v0 = v0 * sc; v1 = v1 * sc;
                    u32x4 w; w.x = pk2(v0[0], v0[1]); w.y = pk2(v0[2], v0[3]); w.z = pk2(v1[0], v1[1]); w.w = pk2(v1[2], v1[3]);
                    *(u32x4*)(O + (size_t)row * ldc + col0 + bj * HALF) = w;
                    asm volatile("" ::: "memory");
                }
        }
    }
};
typedef _Float16 h16x2 __attribute__((ext_vector_type(2)));
__device__ __forceinline__ unsigned pkh2(float lo, float hi) { typedef float f32x2_t __attribute__((ext_vector_type(2))); f32x2_t v = {lo, hi}; return __builtin_bit_cast(unsigned, __builtin_convertvector(v, h16x2)); }
__device__ __forceinline__ f32x4 unpkh4(unsigned w0, unsigned w1) { const h16x2 a = __builtin_bit_cast(h16x2, w0), b = __builtin_bit_cast(h16x2, w1); return (f32x4){(float)a[0], (float)a[1], (float)b[0], (float)b[1]}; }
struct EpiRes {
    static constexpr bool PERM = true, AFTER_DRAIN = false;
    const void* xin; void* xout; int inf32, outf32; const float* gate;
    bf16_t* Aout; const float* nw; const float* sc; float* rowss;
    __device__ __forceinline__ void operator()(const f32x4 (&acc)[2][2][4][2], const Unit& u, int, int, int, int) const {
        const int t_ = otid_(), l_ = t_ & 63, fr = l_ & 15, fq = l_ >> 4, wid_ = __builtin_amdgcn_readfirstlane(t_ >> 6), wr = wid_ >> 2, wc = wid_ & 3;
        const int col0 = u.pn * BM + wc * 32 + 8 * fq;
        const size_t boff = (size_t)((u.pm * BM) >> 12) * 6144 + col0;
        f32x4 gv[2][2];
#pragma unroll
        for (int bj = 0; bj < 2; ++bj)
#pragma unroll
            for (int n = 0; n < 2; ++n) gv[bj][n] = *(const f32x4*)(gate + boff + bj * HALF + n * 4);
        const int rowb = u.pm * BM + wr * 64 + fr;
        const unsigned eo0 = (unsigned)rowb * 1024u + (unsigned)col0;
        const char* xi = (const char*)xin; char* xo = (char*)xout; char* ao = (char*)Aout;
#pragma unroll
        for (int grp = 0; grp < 8; ++grp) {
            const int ai = grp >> 2, m = grp & 3;
            const unsigned eo = eo0 + (unsigned)(ai * HALF + m * 16) * 1024u;
            float ss = 0.f;
#pragma unroll
            for (int bj = 0; bj < 2; ++bj) {
                const unsigned e2 = eo + (unsigned)(bj * HALF);
                f32x4 x0, x1;
                if (inf32) { x0 = *(const f32x4*)(xi + e2 * 4u); x1 = *(const f32x4*)(xi + e2 * 4u + 16u); }
                else { const u32x4 h = *(const u32x4*)(xi + e2 * 2u); x0 = unpkh4(h.x, h.y); x1 = unpkh4(h.z, h.w); }
                const f32x4 xn0 = x0 + gv[bj][0] * acc[ai][bj][m][0], xn1 = x1 + gv[bj][1] * acc[ai][bj][m][1];
                if (outf32) { *(f32x4*)(xo + e2 * 4u) = xn0; *(f32x4*)(xo + e2 * 4u + 16u) = xn1; }
                else { u32x4 h; h.x = pkh2(xn0[0], xn0[1]); h.y = pkh2(xn0[2], xn0[3]); h.z = pkh2(xn1[0], xn1[1]); h.w = pkh2(xn1[2], xn1[3]); *(u32x4*)(xo + e2 * 2u) = h; }
                if (Aout) {
                    ss += ((xn0[0] * xn0[0] + xn0[1] * xn0[1]) + (xn0[2] * xn0[2] + xn0[3] * xn0[3])) + ((xn1[0] * xn1[0] + xn1[1] * xn1[1]) + (xn1[2] * xn1[2] + xn1[3] * xn1[3]));
                    const f32x4 a0 = xn0 * (*(const f32x4*)(nw + col0 + bj * HALF) * (*(const f32x4*)(sc + boff + bj * HALF) + 1.f));
                    const f32x4 a1 = xn1 * (*(const f32x4*)(nw + col0 + bj * HALF + 4) * (*(const f32x4*)(sc + boff + bj * HALF + 4) + 1.f));
                    u32x4 q; q.x = pk2(a0[0], a0[1]); q.y = pk2(a0[2], a0[3]); q.z = pk2(a1[0], a1[1]); q.w = pk2(a1[2], a1[3]);
                    *(u32x4*)(ao + e2 * 2u) = q;
                }
            }
            if (Aout) {
                ss += __shfl_xor(ss, 16); ss += __shfl_xor(ss, 32);
                if (fq == 0) atomicAdd(rowss + rowb + ai * HALF + m * 16, ss);
            }
            asm volatile("" ::: "memory");
        }
    }
};
struct EpiFfn {
    static constexpr bool PERM = true, AFTER_DRAIN = false;
    bf16_t* G; unsigned short* HP; unsigned short* HU; unsigned short* HA;   const float* cw; const float* cb; const float* rowss; const float* bias;
    __device__ __forceinline__ void operator()(const f32x4 (&acc)[2][2][4][2], const Unit& u, int, int, int, int) const {
        const int t_ = otid_(), l_ = t_ & 63, fr = l_ & 15, fq = l_ >> 4, wid_ = __builtin_amdgcn_readfirstlane(t_ >> 6), wr = wid_ >> 2, wc = wid_ & 3;
        const int ch0 = u.pn * 128 + wc * 32 + 8 * fq;
        f32x4 w0[2], w1[2], w2[2], bb[2];
#pragma unroll
        for (int n = 0; n < 2; ++n) { w0[n] = *(const f32x4*)(cw + ch0 + 4 * n); w1[n] = *(const f32x4*)(cw + DFF_ + ch0 + 4 * n); w2[n] = *(const f32x4*)(cw + 2 * DFF_ + ch0 + 4 * n); bb[n] = *(const f32x4*)(cb + ch0 + 4 * n); }
        const int lane = fr + 16 * fq;
        const int src1 = (lane & ~15) | ((fr + 15) & 15), src2 = (lane & ~15) | ((fr + 14) & 15);
        const float* bp = bias + (size_t)((u.pm * BM) >> 12) * 5632 + u.pn * BM + wc * 32 + 8 * fq;
        f32x4 ba[2], bu[2];
#pragma unroll
        for (int n = 0; n < 2; ++n) { ba[n] = *(const f32x4*)(bp + 4 * n); bu[n] = *(const f32x4*)(bp + HALF + 4 * n); }
#pragma unroll
        for (int ai = 0; ai < 2; ++ai) {
            const int seg = u.pm * 4 + ai * 2 + wr;
            unsigned apk[2][2] = {{0u, 0u}, {0u, 0u}};
#pragma unroll
            for (int m = 0; m < 4; ++m) {
                const int row = u.pm * BM + ai * HALF + wr * 64 + m * 16 + fr;
                const float rs = rsqrtf(rowss[row] * (1.f / 1024.f) + 1e-6f);
                f32x4 val[2], acur[2];
#pragma unroll
                for (int n = 0; n < 2; ++n) {
                    const f32x4 a = acc[ai][0][m][n] * rs + ba[n];
                    acur[n] = a;
                    const unsigned pa0 = pkh2(a[0], a[1]), pa1 = pkh2(a[2], a[3]);
                    const unsigned t10 = (fr == 15) ? apk[n][0] : pa0, t11 = (fr == 15) ? apk[n][1] : pa1;
                    const unsigned t20 = (fr >= 14) ? apk[n][0] : pa0, t21 = (fr >= 14) ? apk[n][1] : pa1;
                    const f32x4 p1 = unpkh4((unsigned)__shfl((int)t10, src1), (unsigned)__shfl((int)t11, src1));
                    const f32x4 p2 = unpkh4((unsigned)__shfl((int)t20, src2), (unsigned)__shfl((int)t21, src2));
                    val[n] = w2[n] * a + w1[n] * p1 + w0[n] * p2 + bb[n];
                    apk[n][0] = pa0; apk[n][1] = pa1;
                }
                const f32x4 u0 = acc[ai][1][m][0] * rs + bu[0], u1 = acc[ai][1][m][1] * rs + bu[1];
                f32x4 g0, g1;
#pragma unroll
                for (int e = 0; e < 4; ++e) { g0[e] = siluf_(val[0][e]) * u0[e]; g1[e] = siluf_(val[1][e]) * u1[e]; }
                u32x4 w; w.x = pk2(g0[0], g0[1]); w.y = pk2(g0[2], g0[3]); w.z = pk2(g1[0], g1[1]); w.w = pk2(g1[2], g1[3]);
                *(u32x4*)(G + (size_t)row * DFF_ + ch0) = w;
                if (m == 0 && fr < 2) {
                    const size_t ho = (size_t)(seg * 2 + fr) * DFF_ + ch0;
                    u32x4 hp; hp.x = pkh2(val[0][0], val[0][1]); hp.y = pkh2(val[0][2], val[0][3]); hp.z = pkh2(val[1][0], val[1][1]); hp.w = pkh2(val[1][2], val[1][3]);
                    u32x4 hu; hu.x = pkh2(u0[0], u0[1]); hu.y = pkh2(u0[2], u0[3]); hu.z = pkh2(u1[0], u1[1]); hu.w = pkh2(u1[2], u1[3]);
                    *(u32x4*)(HP + ho) = hp; *(u32x4*)(HU + ho) = hu;
                }
                if (m == 3 && fr >= 14) {
                    const size_t ho = (size_t)(seg * 2 + (fr - 14)) * DFF_ + ch0;
                    u32x4 ha; ha.x = pkh2(acur[0][0], acur[0][1]); ha.y = pkh2(acur[0][2], acur[0][3]); ha.z = pkh2(acur[1][0], acur[1][1]); ha.w = pkh2(acur[1][2], acur[1][3]);
                    *(u32x4*)(HA + ho) = ha;
                }
                asm volatile("" ::: "memory");
            }
        }
    }
};
}

struct Ctx { Params p; unsigned char* lds; int tid, lane, wave, gw, ngw; };

__device__ __forceinline__ void phase_prologue(const Ctx& C) {
    const Params& p = C.p;
    float* cact = (float*)C.lds;
    float* red = (float*)(C.lds + 32768);
    float* mod = (float*)(p.ws + WS_MOD);
    const int tid = C.tid;
    for (int i = tid; i < 8192; i += NTHR) { const float c = p.c[i]; cact[i] = c / (1.f + __expf(-c)); }
    __syncthreads();
    const int col = tid & 63, kp = tid >> 6;
    for (int g = blockIdx.x; g < 384; g += gridDim.x) {
        const int l = g / 96, j = (g % 96) * 64 + col;
        const float* w = p.mod_w + (size_t)l * 1024 * 6144 + (size_t)(kp * 128) * 6144 + j;
        float a0 = 0.f, a1 = 0.f, a2 = 0.f, a3 = 0.f, a4 = 0.f, a5 = 0.f, a6 = 0.f, a7 = 0.f;
        const float* ca = cact + kp * 128;
#pragma unroll 8
        for (int k = 0; k < 128; ++k) {
            const float wv = w[(size_t)k * 6144];
            a0 += ca[k] * wv; a1 += ca[1024 + k] * wv; a2 += ca[2048 + k] * wv; a3 += ca[3072 + k] * wv;
            a4 += ca[4096 + k] * wv; a5 += ca[5120 + k] * wv; a6 += ca[6144 + k] * wv; a7 += ca[7168 + k] * wv;
        }
        float* r = red + (kp * 8) * 64 + col;
        r[0] = a0; r[64] = a1; r[128] = a2; r[192] = a3; r[256] = a4; r[320] = a5; r[384] = a6; r[448] = a7;
        __syncthreads();
        { const int b = tid >> 6; float s = 0.f;
#pragma unroll
          for (int kk = 0; kk < 8; ++kk) s += red[(kk * 8 + b) * 64 + col];
          mod[(size_t)(l * 8 + b) * 6144 + j] = s + p.mod_b[l * 6144 + j]; }
        __syncthreads();
    }
    {
        u32x4* zr = (u32x4*)(p.ws + WS_ROWSS);
        for (int i = blockIdx.x * NTHR + tid; i < 8 * T_ * 4 / 16; i += gridDim.x * NTHR) zr[i] = (u32x4){0u, 0u, 0u, 0u};
    }
    float* cs = (float*)(p.ws + WS_COS); float* sn = (float*)(p.ws + WS_SIN);
    const float invf[8] = {1.0f, 0.1939227432012558f, 0.03760603070259094f, 0.007292664609849453f, 0.0014142135623842478f, 0.00027424818836152554f, 5.3182957344688475e-05f, 1.0313385246263351e-05f};
    for (int r = blockIdx.x * NTHR + tid; r < T_; r += gridDim.x * NTHR) {
        const float pos = (float)p.positions[r];
        f32x4 c4[2], s4[2];
#pragma unroll
        for (int i = 0; i < 8; ++i) {
            const float ang = pos * invf[i];
            const double xr = (double)ang * 0.15915494309189535;
            const float f = (float)(xr - rint(xr));
            c4[i >> 2][i & 3] = __builtin_amdgcn_cosf(f); s4[i >> 2][i & 3] = __builtin_amdgcn_sinf(f);
        }
        *(f32x4*)(cs + (size_t)r * 8) = c4[0]; *(f32x4*)(cs + (size_t)r * 8 + 4) = c4[1];
        *(f32x4*)(sn + (size_t)r * 8) = s4[0]; *(f32x4*)(sn + (size_t)r * 8 + 4) = s4[1];
    }
}

__device__ __forceinline__ void tr_item(const float* W, int Nsrc, int srccol0, bf16_t* WT, int K, int dstrow0, int k0, float* scr, int lane) {
    float wv[32];
#pragma unroll
    for (int i = 0; i < 32; ++i) wv[i] = W[(size_t)(k0 + 2 * i + (lane >> 5)) * Nsrc + srccol0 + (lane & 31)];
#pragma unroll
    for (int i = 0; i < 32; ++i) scr[(2 * i + (lane >> 5)) * 33 + (lane & 31)] = wv[i];
    asm volatile("s_waitcnt lgkmcnt(0)" ::: "memory");
    const int c = lane & 7;
#pragma unroll
    for (int j = 0; j < 4; ++j) { const int n = (lane >> 3) + 8 * j; const float* s = scr + (8 * c) * 33 + n;
        u32x4 o; o.x = pk2(s[0 * 33], s[1 * 33]); o.y = pk2(s[2 * 33], s[3 * 33]); o.z = pk2(s[4 * 33], s[5 * 33]); o.w = pk2(s[6 * 33], s[7 * 33]);
        *(u32x4*)(WT + (size_t)(dstrow0 + n) * K + k0 + 8 * c) = o; }
    asm volatile("s_waitcnt lgkmcnt(0)" ::: "memory");
}
__device__ __forceinline__ void phase_convert(const Ctx& C, int l, bool do_bias = true) {
    const Params& p = C.p; const int j = l >> 1; const bool even = !(l & 1);
    float* scr = (float*)(C.lds + C.wave * 8704);
    bf16_t* WIN = (bf16_t*)(p.ws + WS_WIN); bf16_t* WOUT = (bf16_t*)(p.ws + WS_WOUT); bf16_t* FIN = (bf16_t*)(p.ws + WS_FIN); bf16_t* FOUT = (bf16_t*)(p.ws + ((l & 1) ? WS_FOUT2 : WS_FOUT));
    const int nA = even ? 80 : 112;
    const int IA = 16 * nA, IB = 16 * 32, IC = 16 * 176, ID = 44 * 32;
    const float* win = even ? p.ev_w_in + (size_t)j * 1024 * 2320 : p.od_w_in + (size_t)j * 1024 * 3584;
    const float* wout = even ? p.ev_w_out + (size_t)j * 1024 * 1024 : p.od_w_out + (size_t)j * 1024 * 1024;
    const float* fin = p.ffn_w_in + (size_t)l * 1024 * 5632; const float* fout = p.ffn_w_out + (size_t)l * 2816 * 1024;
    for (int it = C.gw; it < IA + IB + IC + ID; it += C.ngw) {
        int r = it;
        if (r < IA) { const int kb = r / nA, nb = r % nA, n0 = nb * 32; int sc = n0;
            if (even) { if (n0 >= 512 && n0 < 768) continue; if (n0 >= 1792) sc = n0 - 240; else if (n0 >= 768) sc = n0 - 256; }
            tr_item(win, even ? 2320 : 3584, sc, WIN, 1024, n0, kb * 64, scr, C.lane); continue; }
        r -= IA;
        if (r < IB) { const int kb = r / 32, nb = r % 32; tr_item(wout, 1024, nb * 32, WOUT, 1024, nb * 32, kb * 64, scr, C.lane); continue; }
        r -= IB;
        if (r < IC) { const int kb = r / 176, nb = r % 176, n0 = nb * 32; const int pn = n0 >> 8, jj = n0 & 255;
            const int sc = (jj < 128) ? pn * 128 + jj : 2816 + pn * 128 + (jj - 128);
            tr_item(fin, 5632, sc, FIN, 1024, n0, kb * 64, scr, C.lane); continue; }
        r -= IC;
        { const int kb = r / 32, nb = r % 32; tr_item(fout, 1024, nb * 32, FOUT, 2816, nb * 32, kb * 64, scr, C.lane); }
    }
    if (do_bias) {
        float* shl = (float*)(C.lds + 69632);
        const float* modl = (const float*)(p.ws + WS_MOD) + (size_t)l * 8 * 6144;
        __syncthreads();
        for (int i2 = C.tid; i2 < 2 * 8192; i2 += NTHR) { const int which = i2 >> 13, k = (i2 >> 3) & 1023, b = i2 & 7; shl[i2] = modl[(size_t)b * 6144 + (which ? 3072 : 0) + k]; }
        __syncthreads();
        float* bias_in = (float*)(p.ws + WS_BIAS) + (size_t)l * BIAS_L; float* bias_ff = bias_in + 8 * 3584;
        const int Nin = even ? 2560 : 3584, Nsrc = even ? 2320 : 3584;
        const float* gwp = p.gla_gate_w + (size_t)j * 16 * 256;
        for (int u = blockIdx.x * NTHR + C.tid; u < (Nin + 5632) * 16; u += gridDim.x * NTHR) {
            const bool ff = u >= Nin * 16; const int uu = ff ? u - Nin * 16 : u, N = ff ? 5632 : Nin, n = uu % N, kp = uu / N;
            float a[8];
#pragma unroll
            for (int b = 0; b < 8; ++b) a[b] = 0.f;
            const float* shp = shl + (ff ? 8192 : 0) + kp * 64 * 8;
            if (!ff && even && n >= 512 && n < 768) {
                float g[16];
#pragma unroll
                for (int r = 0; r < 16; ++r) g[r] = gwp[r * 256 + (n - 512)];
                for (int k = 0; k < 64; ++k) {
                    const float* wr = win + (size_t)(kp * 64 + k) * 2320 + 1536;
                    float wv = 0.f;
#pragma unroll
                    for (int r = 0; r < 16; ++r) wv += wr[r] * g[r];
                    const f32x4 s0 = *(const f32x4*)(shp + k * 8), s1 = *(const f32x4*)(shp + k * 8 + 4);
                    a[0] += s0[0] * wv; a[1] += s0[1] * wv; a[2] += s0[2] * wv; a[3] += s0[3] * wv; a[4] += s1[0] * wv; a[5] += s1[1] * wv; a[6] += s1[2] * wv; a[7] += s1[3] * wv;
                }
            } else {
                int sc; const float* W; int Ns;
                if (ff) { const int pn = n >> 8, jj = n & 255; sc = (jj < 128) ? pn * 128 + jj : 2816 + pn * 128 + (jj - 128); W = fin; Ns = 5632; }
                else { sc = n; if (even) { if (n >= 1792) sc = n - 240; else if (n >= 768) sc = n - 256; } W = win; Ns = Nsrc; }
                const float* wp = W + (size_t)(kp * 64) * Ns + sc;
#pragma unroll 8
                for (int k = 0; k < 64; ++k) {
                    const float wv = wp[(size_t)k * Ns];
                    const f32x4 s0 = *(const f32x4*)(shp + k * 8), s1 = *(const f32x4*)(shp + k * 8 + 4);
                    a[0] += s0[0] * wv; a[1] += s0[1] * wv; a[2] += s0[2] * wv; a[3] += s0[3] * wv; a[4] += s1[0] * wv; a[5] += s1[1] * wv; a[6] += s1[2] * wv; a[7] += s1[3] * wv;
                }
            }
            float* bo = (ff ? bias_ff : bias_in) + n;
#pragma unroll
            for (int b = 0; b < 8; ++b) atomicAdd(bo + (size_t)b * N, a[b]);
        }
    }
    if (even) {
        const float* gw = p.gla_gate_w + (size_t)j * 16 * 256;
        for (int u = blockIdx.x * NTHR + C.tid; u < 256 * 128; u += gridDim.x * NTHR) {
            const int k8 = u & 127, n = u >> 7;
            float g[16];
#pragma unroll
            for (int r = 0; r < 16; ++r) g[r] = gw[r * 256 + n];
            float o[8];
#pragma unroll
            for (int e = 0; e < 8; ++e) {
                const float* wr = win + (size_t)(k8 * 8 + e) * 2320 + 1536;
                const f32x4 a0 = *(const f32x4*)wr, a1 = *(const f32x4*)(wr + 4), a2 = *(const f32x4*)(wr + 8), a3 = *(const f32x4*)(wr + 12);
                o[e] = a0[0] * g[0] + a0[1] * g[1] + a0[2] * g[2] + a0[3] * g[3] + a1[0] * g[4] + a1[1] * g[5] + a1[2] * g[6] + a1[3] * g[7]
                     + a2[0] * g[8] + a2[1] * g[9] + a2[2] * g[10] + a2[3] * g[11] + a3[0] * g[12] + a3[1] * g[13] + a3[2] * g[14] + a3[3] * g[15];
            }
            u32x4 w; w.x = pk2(o[0], o[1]); w.y = pk2(o[2], o[3]); w.z = pk2(o[4], o[5]); w.w = pk2(o[6], o[7]);
            *(u32x4*)(WIN + (size_t)(512 + n) * 1024 + k8 * 8) = w;
        }
    }
}

__device__ __forceinline__ void phase_bias_wt(const Ctx& C, int l) {
    const Params& p = C.p; const bool even = !(l & 1);
    const float* modl = (const float*)(p.ws + WS_MOD) + (size_t)l * 8 * 6144;
    float* bias_in = (float*)(p.ws + WS_BIAS) + (size_t)l * BIAS_L; float* bias_ff = bias_in + 8 * 3584;
#pragma unroll 1
    for (int which = 0; which < 2; ++which) {
        const bf16_t* WT = (const bf16_t*)(p.ws + (which ? WS_FIN : WS_WIN)); const int N = which ? 5632 : (even ? 2560 : 3584);
        float* bo = which ? bias_ff : bias_in;
        f32x4 sh[8][4];
#pragma unroll
        for (int b = 0; b < 8; ++b)
#pragma unroll
            for (int q = 0; q < 4; ++q) sh[b][q] = *(const f32x4*)(modl + (size_t)b * 6144 + (which ? 3072 : 0) + 16 * C.lane + 4 * q);
        for (int n = C.gw; n < N; n += C.ngw) {
            const u32x4 w0 = *(const u32x4*)(WT + (size_t)n * 1024 + 16 * C.lane), w1 = *(const u32x4*)(WT + (size_t)n * 1024 + 16 * C.lane + 8);
            const f32x4 wa = (f32x4){bflo(w0.x), bfhi(w0.x), bflo(w0.y), bfhi(w0.y)}, wb = (f32x4){bflo(w0.z), bfhi(w0.z), bflo(w0.w), bfhi(w0.w)};
            const f32x4 wc = (f32x4){bflo(w1.x), bfhi(w1.x), bflo(w1.y), bfhi(w1.y)}, wd = (f32x4){bflo(w1.z), bfhi(w1.z), bflo(w1.w), bfhi(w1.w)};
            float mine = 0.f;
#pragma unroll
            for (int b = 0; b < 8; ++b) {
                const f32x4 t = sh[b][0] * wa + sh[b][1] * wb + sh[b][2] * wc + sh[b][3] * wd;
                const float s = wave_sum((t[0] + t[1]) + (t[2] + t[3]));
                if (C.lane == b) mine = s;
            }
            if (C.lane < 8) bo[(size_t)C.lane * N + n] = mine;
        }
    }
}

__device__ __forceinline__ void phase_prep(const Ctx& C, const float* xin, const float* w, const float* modl, int scoff, bf16_t* out, float* rowss) {
    for (int row = C.gw; row < T_; row += C.ngw) {
        const f32x4* xr = (const f32x4*)(xin + (size_t)row * 1024) + C.lane;
        f32x4 v[4]; float ss = 0.f;
#pragma unroll
        for (int j = 0; j < 4; ++j) { v[j] = xr[64 * j]; ss += (v[j].x * v[j].x + v[j].y * v[j].y) + (v[j].z * v[j].z + v[j].w * v[j].w); }
        ss = wave_sum(ss);
        if (C.lane == 0) rowss[row] = ss;
        const float* mb = modl + (size_t)(row >> 12) * 6144;
        u32x2* o8 = (u32x2*)(out + (size_t)row * 1024) + C.lane;
#pragma unroll
        for (int j = 0; j < 4; ++j) {
            const int col = 4 * C.lane + 256 * j;
            const f32x4 w4 = *(const f32x4*)(w + col), sc = *(const f32x4*)(mb + scoff + col);
            const f32x4 y = v[j] * w4 * (sc + 1.f);
            u32x2 q; q.x = pk2(y.x, y.y); q.y = pk2(y.z, y.w); o8[64 * j] = q;
        }
    }
}
__device__ __forceinline__ void phase_final_norm(const Ctx& C, const void* xin  , float* out, const float* w) {
    for (int row = C.gw; row < T_; row += C.ngw) {
        const u32x2* xr = (const u32x2*)((const char*)xin + (size_t)row * 2048) + C.lane;
        f32x4* orow = (f32x4*)(out + (size_t)row * 1024) + C.lane;
        f32x4 v[4]; float ss = 0.f;
#pragma unroll
        for (int j = 0; j < 4; ++j) { const u32x2 h = xr[64 * j]; v[j] = pg8::unpkh4(h.x, h.y); ss += (v[j].x * v[j].x + v[j].y * v[j].y) + (v[j].z * v[j].z + v[j].w * v[j].w); }
        const float rs = rsqrtf(wave_sum(ss) * (1.f / 1024.f) + 1e-6f);
#pragma unroll
        for (int j = 0; j < 4; ++j) { const f32x4 w4 = *(const f32x4*)(w + 4 * C.lane + 256 * j); orow[64 * j] = (v[j] * rs) * w4; }
    }
}

__device__ __forceinline__ void phase_diff_combine(const Ctx& C, int l) {
    const Params& p = C.p; const int j = l >> 1;
    const float lam_init = 0.8f - 0.6f * expf(-0.3f * (float)l);
    const float* lv = p.diff_lambda + j * 256;
    const float s1 = wave_sum(lv[C.lane] * lv[64 + C.lane]), s2 = wave_sum(lv[128 + C.lane] * lv[192 + C.lane]);
    const float lam = expf(s1) - expf(s2) + lam_init;
    const bf16_t* X2 = (const bf16_t*)(p.ws + WS_X2); bf16_t* A = (bf16_t*)(p.ws + WS_A);
    const int head = C.lane >> 4, d0 = (C.lane & 15) * 8;
    const float* nw = p.diff_norm_w + j * 128 + d0;
    const f32x4 n0 = *(const f32x4*)nw, n1 = *(const f32x4*)(nw + 4);
    const float og = 1.f - lam_init;
    for (int row = C.gw; row < T_; row += C.ngw) {
        const bf16_t* src = X2 + (size_t)row * 1024 + head * 256 + d0;
        const u32x4 a = *(const u32x4*)src, b = *(const u32x4*)(src + 128);
        float od[8];
        od[0] = bflo(a.x) - lam * bflo(b.x); od[1] = bfhi(a.x) - lam * bfhi(b.x); od[2] = bflo(a.y) - lam * bflo(b.y); od[3] = bfhi(a.y) - lam * bfhi(b.y);
        od[4] = bflo(a.z) - lam * bflo(b.z); od[5] = bfhi(a.z) - lam * bfhi(b.z); od[6] = bflo(a.w) - lam * bflo(b.w); od[7] = bfhi(a.w) - lam * bfhi(b.w);
        float ss = 0.f;
#pragma unroll
        for (int e = 0; e < 8; ++e) ss += od[e] * od[e];
        ss += __shfl_xor(ss, 1); ss += __shfl_xor(ss, 2); ss += __shfl_xor(ss, 4); ss += __shfl_xor(ss, 8);
        const float rs = rsqrtf(ss * (1.f / 128.f) + 1e-6f) * og;
        u32x4 w; w.x = pk2(od[0] * rs * n0[0], od[1] * rs * n0[1]); w.y = pk2(od[2] * rs * n0[2], od[3] * rs * n0[3]);
        w.z = pk2(od[4] * rs * n1[0], od[5] * rs * n1[1]); w.w = pk2(od[6] * rs * n1[2], od[7] * rs * n1[3]);
        *(u32x4*)(A + (size_t)row * 1024 + head * 128 + d0) = w;
    }
}

__device__ __forceinline__ void phase_ffn_fixup(const Ctx& C, int l) {
    const Params& p = C.p;
    const unsigned short* HP = (const unsigned short*)(p.ws + WS_HP); const unsigned short* HU = (const unsigned short*)(p.ws + WS_HU); const unsigned short* HA = (const unsigned short*)(p.ws + WS_HA);
    bf16_t* G = (bf16_t*)(p.ws + WS_R1);
    const float* cw = p.ffn_conv_w + (size_t)l * 3 * DFF_;
    for (int u = blockIdx.x * NTHR + C.tid; u < 512 * 2 * 704; u += gridDim.x * NTHR) {
        const int c4 = u % 704, sj = u / 704, jj = sj & 1, seg = sj >> 1, ch = c4 * 4;
        const size_t ho = (size_t)sj * DFF_ + ch;
        const u32x2 hv = *(const u32x2*)(HP + ho), hu = *(const u32x2*)(HU + ho);
        f32x4 val = pg8::unpkh4(hv.x, hv.y); const f32x4 uu = pg8::unpkh4(hu.x, hu.y);
        if ((seg & 63) != 0) {
            const u32x2 h1 = *(const u32x2*)(HA + (size_t)((seg - 1) * 2 + 1) * DFF_ + ch), h2 = *(const u32x2*)(HA + (size_t)((seg - 1) * 2) * DFF_ + ch);
            const f32x4 am1 = pg8::unpkh4(h1.x, h1.y), am2 = pg8::unpkh4(h2.x, h2.y);
            const f32x4 w0 = *(const f32x4*)(cw + ch), w1 = *(const f32x4*)(cw + DFF_ + ch);
            if (jj == 0) val = val + w1 * am1 + w0 * am2; else val = val + w0 * am1;
        }
        u32x2 q; q.x = pk2(siluf_(val.x) * uu.x, siluf_(val.y) * uu.y); q.y = pk2(siluf_(val.z) * uu.z, siluf_(val.w) * uu.w);
        *(u32x2*)(G + (size_t)(seg * 64 + jj) * DFF_ + ch) = q;
    }
}

__device__ __forceinline__ void phase_swa(const Ctx& C, int l) {
    const Params& p = C.p;
    const bf16_t* proj = (const bf16_t*)(p.ws + WS_R1); bf16_t* A = (bf16_t*)(p.ws + WS_A);
    bf16_t* Ks = (bf16_t*)C.lds;
    bf16_t* Vt = (bf16_t*)(C.lds + 27648);
    const int tid = C.tid, lane = C.lane, wid = C.wave, r32 = lane & 31, hi = lane >> 5;
    const float* sinks = p.swa_sinks + (l >> 1) * 8;
    u32x4 kreg[3], vreg[3];
#define SWA_FETCH(uu) do { const int b_ = (uu) >> 7, kvh_ = ((uu) >> 6) & 1, q0_ = ((uu) & 63) * 64; const size_t rb_ = (size_t)b_ * SEQ_; \
        _Pragma("unroll") for (int i_ = 0; i_ < 3; ++i_) { const int c_ = tid + i_ * NTHR; \
            { const int kk_ = c_ >> 3, ch_ = c_ & 7, pl_ = q0_ - 128 + kk_; kreg[i_] = (u32x4){0u, 0u, 0u, 0u}; if (pl_ >= 0) kreg[i_] = *(const u32x4*)(proj + (rb_ + pl_) * 2560 + 2304 + kvh_ * 64 + ch_ * 8); } \
            { const int kk_ = c_ % 192, ch_ = c_ / 192, pl_ = q0_ - 128 + kk_; vreg[i_] = (u32x4){0u, 0u, 0u, 0u}; if (pl_ >= 0) vreg[i_] = *(const u32x4*)(proj + (rb_ + pl_) * 2560 + 2432 + kvh_ * 64 + ch_ * 8); } } } while (0)
    if ((int)blockIdx.x < 1024) SWA_FETCH((int)blockIdx.x);
    for (int u = blockIdx.x; u < 1024; u += gridDim.x) {
        const int b = u >> 7, kvh = (u >> 6) & 1, qb = u & 63, q0 = qb * 64; const size_t rowbase = (size_t)b * SEQ_;
#pragma unroll
        for (int i = 0; i < 3; ++i) {
            const int c = tid + i * NTHR;
            { const int kk = c >> 3, ch = c & 7; *(u32x4*)(Ks + kk * 72 + ch * 8) = kreg[i]; }
            { const int kk = c % 192, ch = c / 192; const u32x4 vv = vreg[i];
              bf16_t* vd = Vt + (ch * 8) * 200 + kk;
              vd[0] = (bf16_t)(vv.x & 0xffffu); vd[200] = (bf16_t)(vv.x >> 16); vd[400] = (bf16_t)(vv.y & 0xffffu); vd[600] = (bf16_t)(vv.y >> 16);
              vd[800] = (bf16_t)(vv.z & 0xffffu); vd[1000] = (bf16_t)(vv.z >> 16); vd[1200] = (bf16_t)(vv.w & 0xffffu); vd[1400] = (bf16_t)(vv.w >> 16); }
        }
        { const int nx = u + (int)gridDim.x; if (nx < 1024) SWA_FETCH(nx); }
        __syncthreads();
        const int g = wid >> 1, qh = kvh * 4 + g, qhalf = wid & 1, pq = q0 + 32 * qhalf + r32;
        const bf16_t* qsrc = proj + (rowbase + pq) * 2560 + 1792 + qh * 64;
        bf16x8 qr[4];
#pragma unroll
        for (int d0 = 0; d0 < 4; ++d0) qr[d0] = *(const bf16x8*)(qsrc + d0 * 16 + hi * 8);
        f32x16 s[5];
#pragma unroll
        for (int t = 0; t < 5; ++t) {
            f32x16 a = {};
#pragma unroll
            for (int d0 = 0; d0 < 4; ++d0) {
                const bf16x8 kf = *(const bf16x8*)(Ks + (32 * (qhalf + t) + r32) * 72 + d0 * 16 + hi * 8);
                a = __builtin_amdgcn_mfma_f32_32x32x16_bf16(kf, qr[d0], a, 0, 0, 0);
            }
            s[t] = a;
        }
        const float sink2 = sinks[qh] * LOG2E_;
        float mx = sink2;
#pragma unroll
        for (int t = 0; t < 5; ++t)
#pragma unroll
            for (int r = 0; r < 16; ++r) {
                const int pk = q0 - 128 + 32 * (qhalf + t) + crow_(r, hi);
                const bool valid = (pk >= 0) && (pk <= pq) && (pq - pk < 128);
                const float v = valid ? s[t][r] : -INFINITY; s[t][r] = v; mx = fmaxf(mx, v);
            }
        mx = fmaxf(mx, __shfl_xor(mx, 32));
        float sum = 0.f;
#pragma unroll
        for (int t = 0; t < 5; ++t)
#pragma unroll
            for (int r = 0; r < 16; ++r) { const float e = __builtin_amdgcn_exp2f(s[t][r] - mx); s[t][r] = e; sum += e; }
        sum += __shfl_xor(sum, 32);
        sum += __builtin_amdgcn_exp2f(sink2 - mx);
        const float inv = 1.f / sum;
        f32x16 o[2]; o[0] = f32x16{}; o[1] = f32x16{};
#pragma unroll
        for (int t = 0; t < 5; ++t)
#pragma unroll
            for (int ss = 0; ss < 2; ++ss) {
                u32x4 pw; pw.x = pk2(s[t][8 * ss + 0], s[t][8 * ss + 1]); pw.y = pk2(s[t][8 * ss + 2], s[t][8 * ss + 3]); pw.z = pk2(s[t][8 * ss + 4], s[t][8 * ss + 5]); pw.w = pk2(s[t][8 * ss + 6], s[t][8 * ss + 7]);
                const bf16x8 pf = __builtin_bit_cast(bf16x8, pw);
#pragma unroll
                for (int dt = 0; dt < 2; ++dt) {
                    const bf16_t* vp = Vt + (32 * dt + r32) * 200 + 32 * (qhalf + t) + 16 * ss + 4 * hi;
                    const u32x2 lo = *(const u32x2*)vp, h2 = *(const u32x2*)(vp + 8);
                    u32x4 vw; vw.x = lo.x; vw.y = lo.y; vw.z = h2.x; vw.w = h2.y;
                    o[dt] = __builtin_amdgcn_mfma_f32_32x32x16_bf16(__builtin_bit_cast(bf16x8, vw), pf, o[dt], 0, 0, 0);
                }
            }
        bf16_t* orow = A + (rowbase + pq) * 1024 + 512 + qh * 64;
#pragma unroll
        for (int dt = 0; dt < 2; ++dt)
#pragma unroll
            for (int g4 = 0; g4 < 4; ++g4) {
                u32x2 q; q.x = pk2(o[dt][4 * g4] * inv, o[dt][4 * g4 + 1] * inv); q.y = pk2(o[dt][4 * g4 + 2] * inv, o[dt][4 * g4 + 3] * inv);
                *(u32x2*)(orow + 32 * dt + 8 * g4 + 4 * hi) = q;
            }
        __syncthreads();
    }
}

template <int MODE> struct LaCfg {
    static constexpr int DK = MODE ? 128 : 64, LQ = DK + 8, LG = DK + 4, PITCH = MODE ? 3584 : 2560, NG = DK / 8;
    static constexpr int QCOL = MODE ? 1536 : 0, KCOL = MODE ? 0 : 256, ZCOL = MODE ? 2048 : 512, VCOL = MODE ? 2560 : 768, GCOL = MODE ? 3072 : 1280, OCOL = MODE ? 512 : 0;
    static constexpr int O_QB = 0, O_KB = O_QB + 64 * LQ * 2, O_GF = O_KB + 64 * LQ * 2, O_VT = O_GF + 64 * LG * 4, O_SC = O_VT + 128 * 72 * 2, O_QE = O_SC + 64 * 72 * 2,
                         O_KT = O_QE + 64 * LQ * 2  , O_SEG = O_KT + DK * 72 * 2, O_RED = O_SEG + 8 * 128 * 4, O_PAR = O_RED + 8 * 64 * 4, O_END = O_PAR + 128 * 4;
    static_assert(O_END <= LDS_BYTES, "LA LDS map");
};
__device__ __forceinline__ void unpack8(const u32x4 w, float (&f)[8]) { f[0] = bflo(w.x); f[1] = bfhi(w.x); f[2] = bflo(w.y); f[3] = bfhi(w.y); f[4] = bflo(w.z); f[5] = bfhi(w.z); f[6] = bflo(w.w); f[7] = bfhi(w.w); }
__device__ __forceinline__ u32x4 pack8(const float (&f)[8]) { u32x4 w; w.x = pk2(f[0], f[1]); w.y = pk2(f[2], f[3]); w.z = pk2(f[4], f[5]); w.w = pk2(f[6], f[7]); return w; }
__device__ __forceinline__ void ld8f(const float* p, float (&f)[8]) { const f32x4 a = *(const f32x4*)p, b = *(const f32x4*)(p + 4); f[0] = a[0]; f[1] = a[1]; f[2] = a[2]; f[3] = a[3]; f[4] = b[0]; f[5] = b[1]; f[6] = b[2]; f[7] = b[3]; }

template <int MODE> struct LaRaw { static constexpr int NI = 64 * LaCfg<MODE>::NG / NTHR; u32x4 z[NI], k[NI], q[NI], v[2]; };
template <int MODE, bool NEEDQ> __device__ __forceinline__ void la_fetch(const Ctx& C, int b, int h, int c, LaRaw<MODE>& R) {
    typedef LaCfg<MODE> Cf; const bf16_t* proj = (const bf16_t*)(C.p.ws + WS_R1);
    const size_t row0 = (size_t)b * SEQ_ + (size_t)c * 64;
#pragma unroll
    for (int it = 0; it < LaRaw<MODE>::NI; ++it) {
        const int u = C.tid + it * NTHR, r = u / Cf::NG, kk = (u % Cf::NG) * 8;
        const bf16_t* rp = proj + (row0 + r) * Cf::PITCH + h * Cf::DK + kk;
        R.z[it] = *(const u32x4*)(rp + Cf::ZCOL);
        if (MODE == 0) R.k[it] = *(const u32x4*)(rp + Cf::KCOL);
        if (NEEDQ) R.q[it] = *(const u32x4*)(rp + Cf::QCOL);
    }
#pragma unroll
    for (int it = 0; it < 2; ++it) {
        const int u = C.tid + it * NTHR, r = u & 63, g8 = u >> 6;
        R.v[it] = *(const u32x4*)(proj + (row0 + r) * Cf::PITCH + Cf::VCOL + h * 128 + g8 * 8);
    }
}
template <int MODE, bool NEEDQ> __device__ __forceinline__ void la_store(const Ctx& C, const LaRaw<MODE>& R, const float* par, bf16_t* Qb, bf16_t* Kb, float* Gf, bf16_t* Vt) {
    typedef LaCfg<MODE> Cf;
#pragma unroll
    for (int it = 0; it < LaRaw<MODE>::NI; ++it) {
        const int u = C.tid + it * NTHR, r = u / Cf::NG, kk = (u % Cf::NG) * 8;
        float z[8], kv[8], lg[8], pc[8];
        unpack8(R.z[it], z); ld8f(par + kk, pc);
        if (MODE == 0) {
            unpack8(R.k[it], kv);
#pragma unroll
            for (int e = 0; e < 8; ++e) { const float x = z[e] + pc[e]; lg[e] = (fminf(x, 0.f) * LOG2E_ - __log2f(1.f + __expf(-fabsf(x)))) * (1.f / 16.f); }
        } else {
#pragma unroll
            for (int e = 0; e < 8; ++e) {
                const float zz = fminf(fmaxf(z[e], -60.f), 60.f), ez = __expf(-zz), sg = __builtin_amdgcn_rcpf(1.f + ez), lb = pc[e];
                lg[e] = __log2f(lb + (1.f - lb) * sg); kv[e] = (1.f - lb) * (ez * sg);
            }
        }
        *(u32x4*)(Kb + r * Cf::LQ + kk) = pack8(kv);
        float* gd = Gf + r * Cf::LG + kk;
        *(f32x4*)gd = (f32x4){lg[0], lg[1], lg[2], lg[3]}; *(f32x4*)(gd + 4) = (f32x4){lg[4], lg[5], lg[6], lg[7]};
        if (NEEDQ) {
            float q[8]; unpack8(R.q[it], q);
#pragma unroll
            for (int e = 0; e < 8; ++e) q[e] = MODE ? siluf_(q[e]) * 0.08838834764831845f : q[e] * 0.125f;
            *(u32x4*)(Qb + r * Cf::LQ + kk) = pack8(q);
        }
    }
#pragma unroll
    for (int it = 0; it < 2; ++it) {
        const int u = C.tid + it * NTHR, r = u & 63, g8 = u >> 6;
        const u32x4 w = R.v[it];
        bf16_t* vd = Vt + (g8 * 8) * 72 + r;
        vd[0] = (bf16_t)(w.x & 0xffffu); vd[72] = (bf16_t)(w.x >> 16); vd[144] = (bf16_t)(w.y & 0xffffu); vd[216] = (bf16_t)(w.y >> 16);
        vd[288] = (bf16_t)(w.z & 0xffffu); vd[360] = (bf16_t)(w.z >> 16); vd[432] = (bf16_t)(w.w & 0xffffu); vd[504] = (bf16_t)(w.w >> 16);
    }
}
template <int MODE> __device__ __forceinline__ void la_params(const Ctx& C, int l, int h, float* par) {
    typedef LaCfg<MODE> Cf; const int j = l >> 1;
    if (C.tid < Cf::DK) {
        if (MODE == 0) par[C.tid] = C.p.gla_gate_b[j * 256 + h * 64 + C.tid];
        else { const float* lg0 = C.p.hgrn_lb_logits + h * 128 + C.tid; par[C.tid] = (j == 0) ? 0.f : sigmoidf_(lg0[512] - lg0[0]); }
    }
}
template <int MODE> __device__ __forceinline__ void la_cumsum(const Ctx& C, float* Gf, float* segs) {
    typedef LaCfg<MODE> Cf; constexpr int DK = Cf::DK, NSEG = NTHR / DK, RPS = 64 / NSEG;
    const int k = C.tid % DK, seg = C.tid / DK;
    float v[RPS];
#pragma unroll
    for (int i = 0; i < RPS; ++i) v[i] = Gf[(seg * RPS + i) * Cf::LG + k];
#pragma unroll
    for (int i = 1; i < RPS; ++i) v[i] += v[i - 1];
    segs[seg * DK + k] = v[RPS - 1];
    __syncthreads();
    float off = 0.f;
#pragma unroll
    for (int s = 0; s < NSEG; ++s) { const float t = segs[s * DK + k]; off += (s < seg) ? t : 0.f; }
#pragma unroll
    for (int i = 0; i < RPS; ++i) Gf[(seg * RPS + i) * Cf::LG + k] = v[i] + off;
}

template <int MODE> __device__ __forceinline__ void phase_la_p1(const Ctx& C, int l) {
    typedef LaCfg<MODE> Cf; const Params& p = C.p; constexpr int DK = Cf::DK, LQ = Cf::LQ, LG = Cf::LG, NG = Cf::NG;
    bf16_t* Kb = (bf16_t*)(C.lds + Cf::O_KB); float* Gf = (float*)(C.lds + Cf::O_GF); bf16_t* Vt = (bf16_t*)(C.lds + Cf::O_VT);
    bf16_t* KhT = (bf16_t*)(C.lds + Cf::O_KT); float* segs = (float*)(C.lds + Cf::O_SEG);
    bf16_t* ST = (bf16_t*)(p.ws + WS_ST); float* TOT = (float*)(p.ws + WS_TOT);
    const int r16 = C.lane & 15, g = C.lane >> 4, w = C.wave;
    float* par = (float*)(C.lds + Cf::O_PAR);
    LaRaw<MODE> R; int hcur = -1;
    if ((int)blockIdx.x < 2048) la_fetch<MODE, false>(C, (int)blockIdx.x >> 8, ((int)blockIdx.x >> 6) & 3, (int)blockIdx.x & 63, R);
    for (int it = blockIdx.x; it < 2048; it += gridDim.x) {
        const int bh = it >> 6, c = it & 63, b = bh >> 2, h = bh & 3;
        if (h != hcur) { la_params<MODE>(C, l, h, par); hcur = h; __syncthreads(); }
        la_store<MODE, false>(C, R, par, nullptr, Kb, Gf, Vt);
        { const int nx = it + (int)gridDim.x; if (nx < 2048) la_fetch<MODE, false>(C, nx >> 8, (nx >> 6) & 3, nx & 63, R); }
        __syncthreads();
        la_cumsum<MODE>(C, Gf, segs);
        __syncthreads();
        for (int u = C.tid; u < 64 * NG; u += NTHR) {
            const int r = u & 63, kk = (u >> 6) * 8;
            float kv[8], gj[8], gt[8];
            unpack8(*(const u32x4*)(Kb + r * LQ + kk), kv); ld8f(Gf + r * LG + kk, gj); ld8f(Gf + 63 * LG + kk, gt);
            bf16_t* kd = KhT + kk * 72 + r;
#pragma unroll
            for (int e = 0; e < 8; e += 2) { const unsigned pw = pk2(kv[e] * __builtin_amdgcn_exp2f(gt[e] - gj[e]), kv[e + 1] * __builtin_amdgcn_exp2f(gt[e + 1] - gj[e + 1]));
                kd[e * 72] = (bf16_t)(pw & 0xffffu); kd[(e + 1) * 72] = (bf16_t)(pw >> 16); }
        }
        if (C.tid < DK) TOT[(size_t)it * 128 + C.tid] = Gf[63 * LG + C.tid];
        __syncthreads();
        {
            const bf16x8 b0 = *(const bf16x8*)(Vt + (16 * w + r16) * 72 + 8 * g), b1 = *(const bf16x8*)(Vt + (16 * w + r16) * 72 + 32 + 8 * g);
            bf16_t* so = ST + (size_t)it * DK * 128 + (size_t)(16 * w + r16) * DK + 4 * g;
#pragma unroll
            for (int mt = 0; mt < DK / 16; ++mt) {
                const bf16x8 a0 = *(const bf16x8*)(KhT + (16 * mt + r16) * 72 + 8 * g), a1 = *(const bf16x8*)(KhT + (16 * mt + r16) * 72 + 32 + 8 * g);
                f32x4 acc = (f32x4){0.f, 0.f, 0.f, 0.f};
                acc = __builtin_amdgcn_mfma_f32_16x16x32_bf16(a0, b0, acc, 0, 0, 0);
                acc = __builtin_amdgcn_mfma_f32_16x16x32_bf16(a1, b1, acc, 0, 0, 0);
                u32x2 q; q.x = pk2(acc[0], acc[1]); q.y = pk2(acc[2], acc[3]);
                *(u32x2*)(so + 16 * mt) = q;
            }
        }
        __syncthreads();
    }
}

template <int MODE> __device__ __forceinline__ void phase_la_p2(const Ctx& C) {
    typedef LaCfg<MODE> Cf; const Params& p = C.p; constexpr int DK = Cf::DK, NQ = DK / 4;
    bf16_t* ST = (bf16_t*)(p.ws + WS_ST); const float* TOT = (const float*)(p.ws + WS_TOT);
    for (int u = blockIdx.x * NTHR + C.tid; u < 32 * 128 * NQ; u += gridDim.x * NTHR) {
        const int k4 = u % NQ, v = (u / NQ) & 127, bh = u / (NQ * 128);
        float S0 = 0.f, S1 = 0.f, S2 = 0.f, S3 = 0.f;
        bf16_t* base = ST + (size_t)bh * 64 * DK * 128 + (size_t)v * DK + k4 * 4;
        const float* tb = TOT + (size_t)bh * 64 * 128 + k4 * 4;
#pragma unroll 8
        for (int c = 0; c < 64; ++c) {
            u32x2* ptr = (u32x2*)(base + (size_t)c * DK * 128);
            const u32x2 w = *ptr; const f32x4 dc = *(const f32x4*)(tb + c * 128);
            u32x2 o; o.x = pk2(S0, S1); o.y = pk2(S2, S3);
            *ptr = o;
            S0 = S0 * __builtin_amdgcn_exp2f(dc[0]) + bflo(w.x); S1 = S1 * __builtin_amdgcn_exp2f(dc[1]) + bfhi(w.x);
            S2 = S2 * __builtin_amdgcn_exp2f(dc[2]) + bflo(w.y); S3 = S3 * __builtin_amdgcn_exp2f(dc[3]) + bfhi(w.y);
        }
    }
}

template <int MODE> __device__ __forceinline__ void phase_la_p3(const Ctx& C, int l) {
    typedef LaCfg<MODE> Cf; const Params& p = C.p; constexpr int DK = Cf::DK, LQ = Cf::LQ, LG = Cf::LG, NG = Cf::NG, NKS = DK / 32;
    bf16_t* Qb = (bf16_t*)(C.lds + Cf::O_QB); bf16_t* Kb = (bf16_t*)(C.lds + Cf::O_KB); float* Gf = (float*)(C.lds + Cf::O_GF); bf16_t* Vt = (bf16_t*)(C.lds + Cf::O_VT);
    bf16_t* Sc = (bf16_t*)(C.lds + Cf::O_SC); bf16_t* Qe = (bf16_t*)(C.lds + Cf::O_QE); float* segs = (float*)(C.lds + Cf::O_SEG); float* red = (float*)(C.lds + Cf::O_RED);
    const bf16_t* ST = (const bf16_t*)(p.ws + WS_ST); const bf16_t* proj = (const bf16_t*)(p.ws + WS_R1); bf16_t* A = (bf16_t*)(p.ws + WS_A);
    const float* nw = (MODE ? p.hgrn_norm_w : p.gla_norm_w) + (l >> 1) * 128;
    const int r16 = C.lane & 15, g = C.lane >> 4, w = C.wave;
    const f32x4 nw4 = *(const f32x4*)(nw + 16 * w + 4 * g);
    float* par = (float*)(C.lds + Cf::O_PAR);
    LaRaw<MODE> R; int hcur = -1;
    if ((int)blockIdx.x < 2048) la_fetch<MODE, true>(C, (int)blockIdx.x >> 8, ((int)blockIdx.x >> 6) & 3, (int)blockIdx.x & 63, R);
    for (int it = blockIdx.x; it < 2048; it += gridDim.x) {
        const int bh = it >> 6, c = it & 63, b = bh >> 2, h = bh & 3;
        bf16x8 sfr[NKS];
        { const bf16_t* sp = ST + (size_t)it * DK * 128 + (size_t)(16 * w + r16) * DK + 8 * g;
#pragma unroll
          for (int ks = 0; ks < NKS; ++ks) sfr[ks] = *(const bf16x8*)(sp + 32 * ks); }
        if (h != hcur) { la_params<MODE>(C, l, h, par); hcur = h; __syncthreads(); }
        la_store<MODE, true>(C, R, par, Qb, Kb, Gf, Vt);
        { const int nx = it + (int)gridDim.x; if (nx < 2048) la_fetch<MODE, true>(C, nx >> 8, (nx >> 6) & 3, nx & 63, R); }
        for (int u = C.tid; u < 64 * 72 / 8; u += NTHR) *(u32x4*)(Sc + u * 8) = (u32x4){0u, 0u, 0u, 0u};
        u32x2 gwv[4];
#pragma unroll
        for (int nt = 0; nt < 4; ++nt) gwv[nt] = *(const u32x2*)(proj + ((size_t)b * SEQ_ + (size_t)c * 64 + 16 * nt + r16) * Cf::PITCH + Cf::GCOL + h * 128 + 16 * w + 4 * g);
        __syncthreads();
        la_cumsum<MODE>(C, Gf, segs);
        __syncthreads();
        for (int t = w; t < 10; t += 8) {
            const int I = (t >= 6) ? 3 : (t >= 3) ? 2 : (t >= 1) ? 1 : 0, J = t - I * (I + 1) / 2;
            f32x4 acc = (f32x4){0.f, 0.f, 0.f, 0.f};
#pragma unroll
            for (int ks = 0; ks < NKS; ++ks) {
                const int kc = 32 * ks + 8 * g;
                float gref[8], gj[8], gi[8], kv[8], qv[8];
                ld8f(Gf + (16 * J + 15) * LG + kc, gref); ld8f(Gf + (16 * J + r16) * LG + kc, gj); ld8f(Gf + (16 * I + r16) * LG + kc, gi);
                unpack8(*(const u32x4*)(Kb + (16 * J + r16) * LQ + kc), kv); unpack8(*(const u32x4*)(Qb + (16 * I + r16) * LQ + kc), qv);
#pragma unroll
                for (int e = 0; e < 8; ++e) { kv[e] *= __builtin_amdgcn_exp2f(gref[e] - gj[e]); qv[e] *= __builtin_amdgcn_exp2f(gi[e] - gref[e]); }
                acc = __builtin_amdgcn_mfma_f32_16x16x32_bf16(__builtin_bit_cast(bf16x8, pack8(kv)), __builtin_bit_cast(bf16x8, pack8(qv)), acc, 0, 0, 0);
            }
            if (I == J) {
#pragma unroll
                for (int e = 0; e < 4; ++e) if (4 * g + e > r16) acc[e] = 0.f;
            }
            u32x2 q; q.x = pk2(acc[0], acc[1]); q.y = pk2(acc[2], acc[3]);
            *(u32x2*)(Sc + (16 * I + r16) * 72 + 16 * J + 4 * g) = q;
        }
        for (int u = C.tid; u < 64 * NG; u += NTHR) {
            const int r = u / NG, kk = (u % NG) * 8;
            float qv[8], gi[8]; unpack8(*(const u32x4*)(Qb + r * LQ + kk), qv); ld8f(Gf + r * LG + kk, gi);
#pragma unroll
            for (int e = 0; e < 8; ++e) qv[e] *= __builtin_amdgcn_exp2f(gi[e]);
            *(u32x4*)(Qe + r * LQ + kk) = pack8(qv);
        }
        __syncthreads();
        f32x4 o[4];
        {
            const bf16x8 v0 = *(const bf16x8*)(Vt + (16 * w + r16) * 72 + 8 * g), v1 = *(const bf16x8*)(Vt + (16 * w + r16) * 72 + 32 + 8 * g);
#pragma unroll
            for (int nt = 0; nt < 4; ++nt) {
                f32x4 acc = (f32x4){0.f, 0.f, 0.f, 0.f};
                acc = __builtin_amdgcn_mfma_f32_16x16x32_bf16(v0, *(const bf16x8*)(Sc + (16 * nt + r16) * 72 + 8 * g), acc, 0, 0, 0);
                if (nt >= 2) acc = __builtin_amdgcn_mfma_f32_16x16x32_bf16(v1, *(const bf16x8*)(Sc + (16 * nt + r16) * 72 + 32 + 8 * g), acc, 0, 0, 0);
#pragma unroll
                for (int ks = 0; ks < NKS; ++ks) acc = __builtin_amdgcn_mfma_f32_16x16x32_bf16(sfr[ks], *(const bf16x8*)(Qe + (16 * nt + r16) * LQ + 32 * ks + 8 * g), acc, 0, 0, 0);
                o[nt] = acc;
                float ss = acc[0] * acc[0] + acc[1] * acc[1] + acc[2] * acc[2] + acc[3] * acc[3];
                ss += __shfl_xor(ss, 16); ss += __shfl_xor(ss, 32);
                if (g == 0) red[w * 64 + 16 * nt + r16] = ss;
            }
        }
        __syncthreads();
#pragma unroll
        for (int nt = 0; nt < 4; ++nt) {
            float tot = 0.f;
#pragma unroll
            for (int ww = 0; ww < 8; ++ww) tot += red[ww * 64 + 16 * nt + r16];
            const float rs = rsqrtf(tot * (1.f / 128.f) + 1e-6f);
            const size_t row = (size_t)b * SEQ_ + (size_t)c * 64 + 16 * nt + r16;
            const u32x2 gw = gwv[nt];
            u32x2 q; q.x = pk2(o[nt][0] * rs * nw4[0] * siluf_(bflo(gw.x)), o[nt][1] * rs * nw4[1] * siluf_(bfhi(gw.x)));
            q.y = pk2(o[nt][2] * rs * nw4[2] * siluf_(bflo(gw.y)), o[nt][3] * rs * nw4[3] * siluf_(bfhi(gw.y)));
            *(u32x2*)(A + row * 1024 + Cf::OCOL + h * 128 + 16 * w + 4 * g) = q;
        }
        __syncthreads();
    }
}


#define LAS __attribute__((address_space(3)))
#define XB_TMO      128
#define XB_XCNT(j)  (256  + 64 * (j))
#define XB_XSUB(j)  (1280 + 64 * (j))
#define XB_XGEN(j)  (2304 + 64 * (j))
#define XB_TOP      3328
#define XB_TOPGEN   3392
#define XCD_BAR_WORDS 3456
#define XB_SPIN_CAP (1u << 18)

__device__ __forceinline__ unsigned xb_ld(unsigned* p)              { return __hip_atomic_load(p, __ATOMIC_RELAXED, __HIP_MEMORY_SCOPE_AGENT); }
__device__ __forceinline__ unsigned xb_add(unsigned* p, unsigned v) { return __hip_atomic_fetch_add(p, v, __ATOMIC_RELAXED, __HIP_MEMORY_SCOPE_AGENT); }
__device__ __forceinline__ unsigned xb_xcc_id() { return (unsigned)__builtin_amdgcn_s_getreg((3 << 11) | 20) & 0xFu; }
#define XB_SPIN(cond, bar) do { unsigned _sp = 0; while (cond) { __builtin_amdgcn_s_sleep(1); \
    if ((++_sp & 255u) == 0u) { if (xb_ld(&(bar)[XB_TMO])) break; if (_sp > XB_SPIN_CAP) { atomicAdd(&(bar)[XB_TMO], 1u); break; } } } } while (0)

struct XcdBarrier {
    unsigned* bar; unsigned x;
    volatile LAS unsigned* st;
};

__device__ __forceinline__ XcdBarrier xcd_barrier_post(unsigned* bar, volatile LAS unsigned* st) {
    XcdBarrier b; b.bar = bar; b.x = xb_xcc_id(); b.st = st;
    if (threadIdx.x == 0) (void)xb_add(&bar[XB_XCNT(b.x)], 1u);
    return b;
}
__device__ __forceinline__ void xcd_barrier_complete(unsigned* bar, unsigned x, unsigned& nloc, unsigned& nx) {
    const unsigned G = gridDim.x * gridDim.y * gridDim.z;
    unsigned sum, cnt, mine, sp = 0u;
    for (;;) {
        sum = 0u; cnt = 0u; mine = 0u;
#pragma unroll
        for (unsigned j = 0; j < 16; ++j) { const unsigned c = xb_ld(&bar[XB_XCNT(j)]); sum += c; cnt += (c > 0u) ? 1u : 0u; mine = (j == x) ? c : mine; }
        if (sum == G) break;
        __builtin_amdgcn_s_sleep(1);
        if ((++sp & 255u) == 0u) { if (xb_ld(&bar[XB_TMO])) break; if (sp > XB_SPIN_CAP) { atomicAdd(&bar[XB_TMO], 1u); break; } }
    }
    nloc = mine > 0u ? mine : 1u; nx = cnt > 0u ? cnt : 1u;
}

__device__ __forceinline__ void xcd_barrier(const XcdBarrier& b) {
    asm volatile("s_waitcnt vmcnt(0)" ::: "memory");
    __syncthreads();
    if (threadIdx.x == 0) {
        unsigned* bar = b.bar;
        __builtin_amdgcn_s_waitcnt(0);
        unsigned nloc = b.st[0], nx = b.st[1];
        if (nloc == 0u) { xcd_barrier_complete(bar, b.x, nloc, nx); b.st[0] = nloc; b.st[1] = nx; }
        const unsigned old = xb_add(&bar[XB_XSUB(b.x)], 1u);
        const unsigned gen = old / nloc;
        if (old + 1u == (gen + 1u) * nloc) {
            __builtin_amdgcn_fence(__ATOMIC_RELEASE, "agent");
            asm volatile("s_waitcnt vmcnt(0)" ::: "memory");
            const unsigned og = xb_add(&bar[XB_TOP], 1u);
            const unsigned tg = og / nx;
            if (og + 1u == (tg + 1u) * nx) xb_add(&bar[XB_TOPGEN], 1u);
            else XB_SPIN(xb_ld(&bar[XB_TOPGEN]) == tg, bar);
            __builtin_amdgcn_fence(__ATOMIC_ACQUIRE, "agent");
            xb_add(&bar[XB_XGEN(b.x)], 1u);
            asm volatile("s_waitcnt vmcnt(0)" ::: "memory");
        } else {
            XB_SPIN(xb_ld(&bar[XB_XGEN(b.x)]) == gen, bar);
            __builtin_amdgcn_fence(__ATOMIC_ACQUIRE, "agent");
            asm volatile("s_waitcnt vmcnt(0)" ::: "memory");
        }
    }
    __syncthreads();
}

typedef unsigned u32x16 __attribute__((ext_vector_type(16)));
__device__ __forceinline__ void load_params(Params& p) {
    auto kp = __builtin_amdgcn_kernarg_segment_ptr();
    u32x16 a, b, c, d;
    asm volatile("s_load_dwordx16 %0, %4, 0x0\n\ts_load_dwordx16 %1, %4, 0x40\n\ts_load_dwordx16 %2, %4, 0x80\n\ts_load_dwordx16 %3, %4, 0xc0\n\ts_waitcnt lgkmcnt(0)"
                 : "=&s"(a), "=&s"(b), "=&s"(c), "=&s"(d) : "s"(kp) : "memory");
    unsigned long long q[32];
#pragma unroll
    for (int i = 0; i < 8; ++i) { q[i] = ((unsigned long long)a[2 * i + 1] << 32) | a[2 * i]; q[8 + i] = ((unsigned long long)b[2 * i + 1] << 32) | b[2 * i];
        q[16 + i] = ((unsigned long long)c[2 * i + 1] << 32) | c[2 * i]; q[24 + i] = ((unsigned long long)d[2 * i + 1] << 32) | d[2 * i]; }
    p.x = (const float*)(__attribute__((address_space(1))) const float*)q[0]; p.c = (const float*)(__attribute__((address_space(1))) const float*)q[1]; p.positions = (const int*)(__attribute__((address_space(1))) const int*)q[2]; p.mod_w = (const float*)(__attribute__((address_space(1))) const float*)q[3]; p.mod_b = (const float*)(__attribute__((address_space(1))) const float*)q[4]; p.norm_mix_w = (const float*)(__attribute__((address_space(1))) const float*)q[5]; p.norm_ffn_w = (const float*)(__attribute__((address_space(1))) const float*)q[6];
    p.ev_w_in = (const float*)(__attribute__((address_space(1))) const float*)q[7]; p.gla_gate_w = (const float*)(__attribute__((address_space(1))) const float*)q[8]; p.gla_gate_b = (const float*)(__attribute__((address_space(1))) const float*)q[9]; p.gla_norm_w = (const float*)(__attribute__((address_space(1))) const float*)q[10]; p.swa_sinks = (const float*)(__attribute__((address_space(1))) const float*)q[11]; p.ev_w_out = (const float*)(__attribute__((address_space(1))) const float*)q[12];
    p.od_w_in = (const float*)(__attribute__((address_space(1))) const float*)q[13]; p.diff_lambda = (const float*)(__attribute__((address_space(1))) const float*)q[14]; p.diff_norm_w = (const float*)(__attribute__((address_space(1))) const float*)q[15]; p.hgrn_lb_logits = (const float*)(__attribute__((address_space(1))) const float*)q[16]; p.hgrn_norm_w = (const float*)(__attribute__((address_space(1))) const float*)q[17]; p.od_w_out = (const float*)(__attribute__((address_space(1))) const float*)q[18];
    p.ffn_w_in = (const float*)(__attribute__((address_space(1))) const float*)q[19]; p.ffn_conv_w = (const float*)(__attribute__((address_space(1))) const float*)q[20]; p.ffn_conv_b = (const float*)(__attribute__((address_space(1))) const float*)q[21]; p.ffn_w_out = (const float*)(__attribute__((address_space(1))) const float*)q[22]; p.final_norm_w = (const float*)(__attribute__((address_space(1))) const float*)q[23];
    p.out = (float*)(__attribute__((address_space(1))) float*)q[24]; p.ws = (unsigned char*)(__attribute__((address_space(1))) unsigned char*)q[25];
}

#ifndef REP_SYNC
#define REP_SYNC 1
#endif
#ifndef REP_G
#define REP_G 1
#endif
#ifndef REP_R
#define REP_R 1
#endif
#ifndef REP_CV
#define REP_CV 1
#endif
#ifndef REP_P12
#define REP_P12 1
#endif
#ifndef STG_A
#define STG_A 0
#endif
#ifndef STG_B
#define STG_B 0
#endif
#ifndef ALIGN_RES
#define ALIGN_RES true
#endif
#ifndef REP_SWA
#define REP_SWA 1
#endif
#ifndef REP_LA
#define REP_LA 1
#endif
#ifndef REP_AT
#define REP_AT 1
#endif
#ifndef REP_SM
#define REP_SM 1
#endif
__global__ void __launch_bounds__(NTHR, 2) fwd_megakernel(Params pin) {
    extern __shared__ __attribute__((aligned(16))) unsigned char lds[];
    cg::grid_group grid = cg::this_grid();
    Ctx C; C.lds = lds; C.tid = threadIdx.x; C.lane = C.tid & 63; C.wave = __builtin_amdgcn_readfirstlane(C.tid >> 6);
    C.gw = blockIdx.x * 8 + C.wave; C.ngw = gridDim.x * 8;
    PG8_LAS unsigned char* ldsg = (PG8_LAS unsigned char*)lds;
    volatile LAS unsigned* bst = (volatile LAS unsigned*)(ldsg + (LDS_BYTES - 64));
    if (threadIdx.x < 2) bst[threadIdx.x] = 0u;
    __syncthreads();
    XcdBarrier xbar = xcd_barrier_post((unsigned*)(pin.ws + WS_BAR), bst);
#define GSYNC() do { for (int rs_ = 0; rs_ < REP_SYNC; ++rs_) xcd_barrier(xbar); } while (0)
#define RP() do { load_params(C.p); C.tid = otid_(); C.lane = C.tid & 63; C.wave = __builtin_amdgcn_readfirstlane(C.tid >> 6); C.gw = blockIdx.x * 8 + C.wave; } while (0)
#define WSP(off) (C.p.ws + (off))
#define STAGGER(ticks) do { if ((ticks) > 0 && (blockIdx.x & 1)) { const unsigned long long t0_ = __builtin_amdgcn_s_memrealtime(); while (__builtin_amdgcn_s_memrealtime() - t0_ < (unsigned long long)(ticks)) __builtin_amdgcn_s_sleep(16); } } while (0)

    if (pin.ws == nullptr) grid.sync();
    for (int rep_ = 0; rep_ < REP_SM; ++rep_) { RP(); phase_prologue(C); }
    GSYNC();
#if REP_CV > 1
    RP(); phase_convert(C, 0, false);
#endif
    RP(); phase_convert(C, 0, false);
    for (int rep_ = 0; rep_ < REP_SM; ++rep_) { RP(); phase_prep(C, C.p.x, C.p.norm_mix_w, (const float*)WSP(WS_MOD), 1024, (bf16_t*)WSP(WS_A), (float*)WSP(WS_ROWSS)); }
    GSYNC();
    RP(); phase_bias_wt(C, 0);
    GSYNC();
#pragma unroll 1
    for (int l = 0; l < 4; ++l) {
        const bool even = !(l & 1);
        {
            RP();
            const int N = even ? 2560 : 3584;
            pg8::Gemm g{(const bf16_t*)WSP(WS_A), (const bf16_t*)WSP(WS_WIN), T_, N, 1024}; pg8::StaticOrder S; S.init(T_, N, (int)gridDim.x, (int)blockIdx.x);
            pg8::EpiProj E{(bf16_t*)WSP(WS_R1), N, even ? 0x7C000u : 0xFFu, even ? 0x3C000u : 0xFu, QSCALE_, (const float*)WSP(WS_COS), (const float*)WSP(WS_SIN),
                           (const float*)WSP(WS_ROWSS) + (size_t)(2 * l) * T_, (const float*)WSP(WS_BIAS) + (size_t)l * BIAS_L};
            for (int rep_ = 0; rep_ < REP_G; ++rep_) pg8::gemm_phase<pg8::EpiProj, pg8::StaticOrder, true, true>(ldsg, g, S, E);
        }
        GSYNC();
        if (even) {
            for (int rep_ = 0; rep_ < REP_SWA; ++rep_) { RP(); phase_swa(C, l); }
            for (int rep_ = 0; rep_ < REP_LA; ++rep_) { RP(); phase_la_p1<0>(C, l); }
            GSYNC();
            RP(); phase_la_p2<0>(C);
            GSYNC();
#if REP_P12 > 1
            RP(); phase_la_p1<0>(C, l); GSYNC(); RP(); phase_la_p2<0>(C); GSYNC();
#endif
            for (int rep_ = 0; rep_ < REP_LA; ++rep_) { RP(); phase_la_p3<0>(C, l); }
        } else {
            for (int rep_ = 0; rep_ < REP_AT; ++rep_) {
                RP();
                const bf16_t* R1 = (const bf16_t*)WSP(WS_R1); bf16_t* X2 = (bf16_t*)WSP(WS_X2);
                const int G = (int)gridDim.x, bid = (int)blockIdx.x;
#pragma unroll 1
                for (int i = 0; i * G < 2048; ++i) {
                    const int L = i * G + ((i & 1) ? (G - 1 - bid) : bid);
                    if (L >= 2048) continue;
                    const int qb = 15 - (L >> 7), bh = (((L >> 2) & 7) << 4) | ((L & 3) << 2) | (((L >> 5) & 1) << 1) | ((L >> 6) & 1), b = bh >> 4, hv = bh & 15;
                    const attn_body::bf16* Q = (const attn_body::bf16*)(R1 + (hv >> 1) * 64);
                    const attn_body::bf16* K = (const attn_body::bf16*)(R1 + 512 + (hv >> 1) * 64);
                    const attn_body::bf16* V = (const attn_body::bf16*)(R1 + 1024 + (hv >> 2) * 128 + (hv & 1) * 64);
                    attn_body::attn_unit<8>(b, hv, qb, Q, K, V, (attn_body::bf16*)(X2 + hv * 64), (char*)lds);
                }
            }
            for (int rep_ = 0; rep_ < REP_LA; ++rep_) { RP(); phase_la_p1<1>(C, l); }
            GSYNC();
            RP(); phase_la_p2<1>(C);
#if REP_P12 > 1
            GSYNC(); RP(); phase_la_p1<1>(C, l); GSYNC(); RP(); phase_la_p2<1>(C);
#endif
            for (int rep_ = 0; rep_ < REP_SM; ++rep_) { RP(); phase_diff_combine(C, l); }
            GSYNC();
            for (int rep_ = 0; rep_ < REP_LA; ++rep_) { RP(); phase_la_p3<1>(C, l); }
        }
        GSYNC();
        STAGGER(STG_A);
        {
            RP();
            const float* modl = (const float*)WSP(WS_MOD) + (size_t)l * 8 * 6144;
            pg8::Gemm g{(const bf16_t*)WSP(WS_A), (const bf16_t*)WSP(WS_WOUT), T_, 1024, 1024}; pg8::StaticOrder S; S.init(T_, 1024, (int)gridDim.x, (int)blockIdx.x);
            void* XH = (void*)((char*)C.p.out + 64 * MiB_);
            pg8::EpiRes E{(l == 0) ? (const void*)C.p.x : (const void*)XH, XH, (l == 0) ? 1 : 0, 0, modl + 2048, (bf16_t*)WSP(WS_X2), C.p.norm_ffn_w + l * 1024, modl + 4096, (float*)WSP(WS_ROWSS) + (size_t)(2 * l + 1) * T_};
            pg8::gemm_phase<pg8::EpiRes, pg8::StaticOrder, ALIGN_RES, true>(ldsg, g, S, E);
        }
        GSYNC();
        {
            RP();
            pg8::Gemm g{(const bf16_t*)WSP(WS_X2), (const bf16_t*)WSP(WS_FIN), T_, 5632, 1024}; pg8::StaticOrder S; S.init(T_, 5632, (int)gridDim.x, (int)blockIdx.x);
            pg8::EpiFfn E{(bf16_t*)WSP(WS_R1), (unsigned short*)WSP(WS_HP), (unsigned short*)WSP(WS_HU), (unsigned short*)WSP(WS_HA), C.p.ffn_conv_w + (size_t)l * 3 * DFF_, C.p.ffn_conv_b + (size_t)l * DFF_,
                          (const float*)WSP(WS_ROWSS) + (size_t)(2 * l + 1) * T_, (const float*)WSP(WS_BIAS) + (size_t)l * BIAS_L + 8 * 3584};
            for (int rep_ = 0; rep_ < REP_G; ++rep_) pg8::gemm_phase<pg8::EpiFfn, pg8::StaticOrder, true, true>(ldsg, g, S, E);
        }
        GSYNC();
        for (int rep_ = 0; rep_ < REP_SM; ++rep_) { RP(); phase_ffn_fixup(C, l); }
#if REP_CV > 1
        if (l < 3) { RP(); phase_convert(C, l + 1, false); }
#endif
        if (l < 3) { RP(); phase_convert(C, l + 1, false); }
        GSYNC();
        if (l < 3) { RP(); phase_bias_wt(C, l + 1); }
        {
            RP();
            const float* modl = (const float*)WSP(WS_MOD) + (size_t)l * 8 * 6144;
            pg8::Gemm g{(const bf16_t*)WSP(WS_R1), (const bf16_t*)WSP((l & 1) ? WS_FOUT2 : WS_FOUT), T_, 1024, DFF_}; pg8::StaticOrder S; S.init(T_, 1024, (int)gridDim.x, (int)blockIdx.x);
            void* XH = (void*)((char*)C.p.out + 64 * MiB_);
            pg8::EpiRes E{XH, (l < 3) ? XH : (void*)WSP(WS_X2), 0, 0, modl + 5120, (l < 3) ? (bf16_t*)WSP(WS_A) : (bf16_t*)nullptr, C.p.norm_mix_w + ((l + 1) & 3) * 1024, modl + 6144 * 8 + 1024, (float*)WSP(WS_ROWSS) + (size_t)((2 * l + 2) & 7) * T_};
            pg8::gemm_phase<pg8::EpiRes, pg8::StaticOrder, ALIGN_RES, true>(ldsg, g, S, E);
        }
        GSYNC();
    }
    RP(); phase_final_norm(C, (const void*)WSP(WS_X2), C.p.out, C.p.final_norm_w);
}

extern "C" void kernel_launch(void* const* d_in, const int* in_sizes, int n_in, void* d_out, int out_size, void* d_ws, size_t ws_size, hipStream_t stream) {
    static int grid_blocks = 0;
    if (grid_blocks == 0) {
        if (n_in != 24 || ws_size < WS_END) { fprintf(stderr, "kernel_launch: unexpected n_in %d / ws %zu\n", n_in, ws_size); grid_blocks = -1; return; }
        int dev = 0, cus = 0, per_cu = 0;
        hipGetDevice(&dev); hipDeviceGetAttribute(&cus, hipDeviceAttributeMultiprocessorCount, dev);
        if (hipFuncSetAttribute((const void*)fwd_megakernel, hipFuncAttributeMaxDynamicSharedMemorySize, LDS_BYTES) != hipSuccess) { fprintf(stderr, "kernel_launch: hipFuncSetAttribute failed\n"); grid_blocks = -1; return; }
        if (hipOccupancyMaxActiveBlocksPerMultiprocessor(&per_cu, (const void*)fwd_megakernel, NTHR, LDS_BYTES) != hipSuccess || per_cu < 1) { fprintf(stderr, "kernel_launch: occupancy query gave %d\n", per_cu); per_cu = 1; }
        (void)hipGetLastError();
        grid_blocks = cus * per_cu;
    }
    if (grid_blocks < 0) return;
    Params p{};
    p.x = (const float*)d_in[0]; p.c = (const float*)d_in[1]; p.positions = (const int*)d_in[2]; p.mod_w = (const float*)d_in[3]; p.mod_b = (const float*)d_in[4];
    p.norm_mix_w = (const float*)d_in[5]; p.norm_ffn_w = (const float*)d_in[6]; p.ev_w_in = (const float*)d_in[7]; p.gla_gate_w = (const float*)d_in[8];
    p.gla_gate_b = (const float*)d_in[9]; p.gla_norm_w = (const float*)d_in[10]; p.swa_sinks = (const float*)d_in[11]; p.ev_w_out = (const float*)d_in[12];
    p.od_w_in = (const float*)d_in[13]; p.diff_lambda = (const float*)d_in[14]; p.diff_norm_w = (const float*)d_in[15]; p.hgrn_lb_logits = (const float*)d_in[16];
    p.hgrn_norm_w = (const float*)d_in[17]; p.od_w_out = (const float*)d_in[18]; p.ffn_w_in = (const float*)d_in[19]; p.ffn_conv_w = (const float*)d_in[20];
    p.ffn_conv_b = (const float*)d_in[21]; p.ffn_w_out = (const float*)d_in[22]; p.final_norm_w = (const float*)d_in[23];
    p.out = (float*)d_out; p.ws = (unsigned char*)d_ws;
    if (hipMemsetAsync((char*)d_ws + WS_BAR, 0, 16384, stream) != hipSuccess) { fprintf(stderr, "kernel_launch: memset failed\n"); return; }
    void* args[] = {&p};
    hipError_t e = hipLaunchCooperativeKernel((const void*)fwd_megakernel, dim3(grid_blocks), dim3(NTHR), args, LDS_BYTES, stream);
    if (e != hipSuccess) fprintf(stderr, "cooperative launch failed: %s (grid %d)\n", hipGetErrorString(e), grid_blocks);
}
```
